# Optimizing an MI355X kernel written in HIP

```python
import math
import jax, jax.numpy as jnp
from jax import lax
import numpy as np

D_MODEL = 1024
BATCH = 8
SEQ = 4096
DEPTH = 2

N_META = 16
GRID_W = 64
N_MIXERS = 2
N_LRU_LAYERS = (DEPTH + 1) // 2
N_NA_LAYERS = DEPTH // 2

D_RNN = D_MODEL
LRU_BLOCKS = 4
LRU_BLOCK = D_RNN // LRU_BLOCKS
CONV_W = 4
LRU_C = 8.0

NA_HEADS = 16
NA_HEAD_DIM = D_MODEL // NA_HEADS
NA_MAX_KH = 8
NA_KW = 16

N_EXPERTS = 32
TOP_K = 4
D_EXPERT = D_MODEL
SWIGLU_LIMIT = 7.0
SWIGLU_ALPHA = 1.702
MOE_BLOCK = 512

DN_ALPHA = (2.0 * DEPTH) ** 0.25
DN_BETA = (8.0 * DEPTH) ** -0.25
LN_EPS = 1e-5

kernel_name = "hybrid_rglru_natten_moe_encoder"


def layer_norm(x, g, b):
    xf = x.astype(jnp.float32)
    mu = jnp.mean(xf, axis=-1, keepdims=True)
    var = jnp.mean(jnp.square(xf - mu), axis=-1, keepdims=True)
    y = (xf - mu) * lax.rsqrt(var + LN_EPS)
    return (y * g.astype(jnp.float32) + b.astype(jnp.float32)).astype(x.dtype)


def _lin_combine(c1, c2):
    a1, b1 = c1
    a2, b2 = c2
    return a1 * a2, a2 * b1 + b2


def linear_scan(a, b, reverse):
    _, h = lax.associative_scan(_lin_combine, (a, b), axis=1, reverse=reverse)
    return h


def rg_lru_direction(xc, wa, ba, wx, bx, lam, reverse):
    B_, L, _ = xc.shape
    xb = xc.reshape(B_, L, LRU_BLOCKS, LRU_BLOCK)
    gate_a = jax.nn.sigmoid(jnp.einsum('blni,nij->blnj', xb, wa).reshape(B_, L, D_RNN) + ba)
    gate_x = jax.nn.sigmoid(jnp.einsum('blni,nij->blnj', xb, wx).reshape(B_, L, D_RNN) + bx)
    log_a = (-LRU_C * gate_a.astype(jnp.float32)) * jax.nn.softplus(-lam.astype(jnp.float32))
    a = jnp.exp(log_a)
    mult = jnp.sqrt(-jnp.expm1(2.0 * log_a))
    start = L - 1 if reverse else 0
    is_start = (jnp.arange(L) == start)[None, :, None]
    mult = jnp.where(is_start, 1.0, mult)
    b = mult * (gate_x * xc).astype(jnp.float32)
    return linear_scan(a, b, reverse)


def rglru_mixer(x, w_in, conv_w, conv_b, wa, ba, wx, bx, lam, w_out):
    u = x @ w_in
    xr, y = u[..., :D_RNN], u[..., D_RNN:]
    xc = lax.conv_general_dilated(
        xr, conv_w[:, None, :], window_strides=(1,),
        padding=[(CONV_W // 2, CONV_W - 1 - CONV_W // 2)],
        dimension_numbers=('NWC', 'WIO', 'NWC'),
        feature_group_count=D_RNN) + conv_b
    h = (rg_lru_direction(xc, wa[0], ba[0], wx[0], bx[0], lam[0], False)
         + rg_lru_direction(xc, wa[1], ba[1], wx[1], bx[1], lam[1], True))
    return (h.astype(x.dtype) * jax.nn.gelu(y)) @ w_out


def na_mixer(x, w_qkv, rpb, meta_bias, w_out):
    B_, L, D = x.shape
    n_tok = L - N_META
    rows = n_tok // GRID_W
    kh = min(NA_MAX_KH, rows)
    kw = min(NA_KW, GRID_W)
    qkv = (x @ w_qkv).reshape(B_, L, 3, NA_HEADS, NA_HEAD_DIM)
    q = qkv[:, :, 0] * (NA_HEAD_DIM ** -0.5)
    k = qkv[:, :, 1]
    v = qkv[:, :, 2]
    qm, km, vm = q[:, :N_META], k[:, :N_META], v[:, :N_META]
    grid_shape = (B_, rows, GRID_W, NA_HEADS, NA_HEAD_DIM)
    qg = q[:, N_META:].reshape(grid_shape)
    kg = k[:, N_META:].reshape(grid_shape)
    vg = v[:, N_META:].reshape(grid_shape)

    row_start = jnp.clip(jnp.arange(rows) - kh // 2, 0, rows - kh)
    col_start = jnp.clip(jnp.arange(GRID_W) - kw // 2, 0, GRID_W - kw)
    col_idx = col_start[:, None] + jnp.arange(kw)[None, :]
    col_off = col_idx - jnp.arange(GRID_W)[:, None] + (NA_KW - 1)
    rpb_f = rpb.astype(jnp.float32)
    meta_b = meta_bias.astype(jnp.float32)

    def row_block(r):
        rs = row_start[r]
        q_r = lax.dynamic_index_in_dim(qg, r, axis=1, keepdims=False)
        k_rows = lax.dynamic_slice_in_dim(kg, rs, kh, axis=1)
        v_rows = lax.dynamic_slice_in_dim(vg, rs, kh, axis=1)
        k_win = k_rows[:, :, col_idx]
        v_win = v_rows[:, :, col_idx]
        row_off = rs + jnp.arange(kh) - r + (NA_MAX_KH - 1)
        bias = rpb_f[:, row_off[None, :, None], col_off[:, None, :]]
        s_win = jnp.einsum('bqhd,bjqkhd->bhqjk', q_r, k_win).astype(jnp.float32) + bias
        s_win = s_win.reshape(B_, NA_HEADS, GRID_W, kh * kw)
        s_meta = jnp.einsum('bqhd,bmhd->bhqm', q_r, km).astype(jnp.float32) + meta_b[:, None, :]
        p = jax.nn.softmax(jnp.concatenate([s_win, s_meta], axis=-1), axis=-1).astype(x.dtype)
        p_win = p[..., :kh * kw].reshape(B_, NA_HEADS, GRID_W, kh, kw)
        p_meta = p[..., kh * kw:]
        return (jnp.einsum('bhqjk,bjqkhd->bqhd', p_win, v_win)
                + jnp.einsum('bhqm,bmhd->bqhd', p_meta, vm))

    og = lax.map(row_block, jnp.arange(rows))
    og = jnp.moveaxis(og, 0, 1).reshape(B_, n_tok, D)
    s_mm = jnp.einsum('bqhd,bmhd->bhqm', qm, km).astype(jnp.float32) + meta_b[:, None, :]
    p_mm = jax.nn.softmax(s_mm, axis=-1).astype(x.dtype)
    om = jnp.einsum('bhqm,bmhd->bqhd', p_mm, vm).reshape(B_, N_META, D)
    return jnp.concatenate([om, og], axis=1) @ w_out


def moe_ffn(x, router_w, router_b, w_gu, b_gu, w_down, b_down):
    B_, L, D = x.shape
    xt = x.reshape(-1, D)
    n = xt.shape[0]
    logits = (xt @ router_w).astype(jnp.float32) + router_b.astype(jnp.float32)
    top_val, top_idx = lax.top_k(logits, TOP_K)
    gates = jax.nn.softmax(top_val, axis=-1).astype(x.dtype)
    n_slots = n * TOP_K
    flat_e = top_idx.reshape(-1).astype(jnp.int32)
    flat_tok = (jnp.arange(n_slots) // TOP_K).astype(jnp.int32)
    flat_gate = gates.reshape(-1)
    order = jnp.argsort(flat_e)
    sorted_e = flat_e[order]
    counts = jax.ops.segment_sum(jnp.ones((n_slots,), jnp.int32), flat_e, num_segments=N_EXPERTS)
    padded = (counts + MOE_BLOCK - 1) // MOE_BLOCK * MOE_BLOCK
    pad_end = jnp.cumsum(padded)
    pad_start = pad_end - padded
    start = jnp.cumsum(counts) - counts
    dest = pad_start[sorted_e] + (jnp.arange(n_slots, dtype=jnp.int32) - start[sorted_e])
    n_blocks = -(-(n_slots + N_EXPERTS * (MOE_BLOCK - 1)) // MOE_BLOCK)
    cap = n_blocks * MOE_BLOCK
    buf_tok = jnp.full((cap,), n, jnp.int32).at[dest].set(flat_tok[order])
    buf_gate = jnp.zeros((cap,), x.dtype).at[dest].set(flat_gate[order])
    block_e = jnp.minimum(
        jnp.searchsorted(pad_end, jnp.arange(n_blocks, dtype=jnp.int32) * MOE_BLOCK, side='right'),
        N_EXPERTS - 1)
    x_pad = jnp.concatenate([xt, jnp.zeros((1, D), x.dtype)], axis=0)

    def expert_block(args):
        tok, g, e = args
        xb = x_pad[tok]
        h = xb @ w_gu[e] + b_gu[e]
        glu = jnp.minimum(h[:, :D_EXPERT], SWIGLU_LIMIT)
        lin = jnp.clip(h[:, D_EXPERT:], -SWIGLU_LIMIT, SWIGLU_LIMIT)
        act = glu * jax.nn.sigmoid(SWIGLU_ALPHA * glu) * (lin + 1.0)
        return (act @ w_down[e] + b_down[e]) * g[:, None]

    y_blocks = lax.map(expert_block, (buf_tok.reshape(n_blocks, MOE_BLOCK),
                                      buf_gate.reshape(n_blocks, MOE_BLOCK), block_e))
    y = jnp.zeros((n + 1, D), x.dtype).at[buf_tok].add(y_blocks.reshape(cap, D))
    return y[:n].reshape(B_, L, D)


def setup_inputs(seed: int = 0) -> dict:
    key = jax.random.key(seed)
    ks = jax.random.split(key, 32)
    f32 = jnp.float32
    nrm = lambda k, shape, s: (jax.random.normal(k, shape, f32) * s).astype(f32)
    D = D_MODEL
    u = jax.random.uniform(ks[9], (N_LRU_LAYERS, 2, D_RNN), f32, 0.9, 0.999)
    sig = u ** (1.0 / LRU_C)
    lam = jnp.log(sig) - jnp.log1p(-sig)
    return {
        "x": nrm(ks[0], (BATCH, SEQ, D), 1.0),
        "meta_tokens": nrm(ks[1], (N_META, D), 1.0),
        "lru_w_in": nrm(ks[2], (N_LRU_LAYERS, D, 2 * D_RNN), D ** -0.5),
        "lru_conv_w": nrm(ks[3], (N_LRU_LAYERS, CONV_W, D_RNN), CONV_W ** -0.5),
        "lru_conv_b": nrm(ks[4], (N_LRU_LAYERS, D_RNN), 0.01),
        "lru_wa": nrm(ks[5], (N_LRU_LAYERS, 2, LRU_BLOCKS, LRU_BLOCK, LRU_BLOCK), LRU_BLOCK ** -0.5),
        "lru_ba": nrm(ks[6], (N_LRU_LAYERS, 2, D_RNN), 0.01),
        "lru_wx": nrm(ks[7], (N_LRU_LAYERS, 2, LRU_BLOCKS, LRU_BLOCK, LRU_BLOCK), LRU_BLOCK ** -0.5),
        "lru_bx": nrm(ks[8], (N_LRU_LAYERS, 2, D_RNN), 0.01),
        "lru_lambda": lam.astype(f32),
        "lru_w_out": nrm(ks[10], (N_LRU_LAYERS, D_RNN, D), DN_BETA * D_RNN ** -0.5),
        "na_w_qkv": nrm(ks[11], (N_NA_LAYERS, D, 3 * D), D ** -0.5),
        "na_rpb": nrm(ks[12], (N_NA_LAYERS, NA_HEADS, 2 * NA_MAX_KH - 1, 2 * NA_KW - 1), 0.02),
        "na_meta_bias": nrm(ks[13], (N_NA_LAYERS, NA_HEADS, N_META), 0.02),
        "na_w_out": nrm(ks[14], (N_NA_LAYERS, D, D), DN_BETA * D ** -0.5),
        "ln_mix_g": 1.0 + nrm(ks[15], (DEPTH, D), 0.01),
        "ln_mix_b": nrm(ks[16], (DEPTH, D), 0.01),
        "router_w": nrm(ks[17], (DEPTH, D, N_EXPERTS), D ** -0.5),
        "router_b": nrm(ks[18], (DEPTH, N_EXPERTS), 0.01),
        "moe_w_gu": nrm(ks[19], (DEPTH, N_EXPERTS, D, 2 * D_EXPERT), D ** -0.5),
        "moe_b_gu": nrm(ks[20], (DEPTH, N_EXPERTS, 2 * D_EXPERT), 0.01),
        "moe_w_down": nrm(ks[21], (DEPTH, N_EXPERTS, D_EXPERT, D), DN_BETA * D_EXPERT ** -0.5),
        "moe_b_down": nrm(ks[22], (DEPTH, N_EXPERTS, D), 0.01),
        "ln_ffn_g": 1.0 + nrm(ks[23], (DEPTH, D), 0.01),
        "ln_ffn_b": nrm(ks[24], (DEPTH, D), 0.01),
    }


def reference(x, meta_tokens, lru_w_in, lru_conv_w, lru_conv_b, lru_wa, lru_ba, lru_wx, lru_bx,
              lru_lambda, lru_w_out, na_w_qkv, na_rpb, na_meta_bias, na_w_out, ln_mix_g, ln_mix_b,
              router_w, router_b, moe_w_gu, moe_b_gu, moe_w_down, moe_b_down, ln_ffn_g, ln_ffn_b):
    B_ = x.shape[0]
    meta = jnp.broadcast_to(meta_tokens[None].astype(x.dtype), (B_, N_META, D_MODEL))
    h = jnp.concatenate([meta, x], axis=1)
    for i in range(DEPTH):
        j = i // N_MIXERS
        if i % N_MIXERS == 0:
            mix = rglru_mixer(h, lru_w_in[j], lru_conv_w[j], lru_conv_b[j], lru_wa[j], lru_ba[j],
                              lru_wx[j], lru_bx[j], lru_lambda[j], lru_w_out[j])
        else:
            mix = na_mixer(h, na_w_qkv[j], na_rpb[j], na_meta_bias[j], na_w_out[j])
        h = layer_norm(DN_ALPHA * h + mix, ln_mix_g[i], ln_mix_b[i])
        ffn = moe_ffn(h, router_w[i], router_b[i], moe_w_gu[i], moe_b_gu[i], moe_w_down[i], moe_b_down[i])
        h = layer_norm(DN_ALPHA * h + ffn, ln_ffn_g[i], ln_ffn_b[i])
    return h[:, N_META:]
```

```cpp
#include <hip/hip_runtime.h>
#include <hip/hip_cooperative_groups.h>
#include <cstdio>
#include <cstdint>
namespace cg = cooperative_groups;

#define LAS __attribute__((address_space(3)))
typedef unsigned short bf16_t;
typedef short bf16x8 __attribute__((ext_vector_type(8)));
typedef float f32x4 __attribute__((ext_vector_type(4)));
typedef float f32x2 __attribute__((ext_vector_type(2)));
typedef unsigned u32x4 __attribute__((ext_vector_type(4)));
typedef unsigned u32x2 __attribute__((ext_vector_type(2)));

constexpr int NB = 8, SEQ = 4096, D = 1024, NMETA = 16, LSEQ = SEQ + NMETA;
constexpr int NGRID = NB * SEQ;
constexpr int NTOK = NGRID + NB * NMETA;
constexpr int MPAD = 33024;
constexpr int NEXP = 32, TOPK = 4;
constexpr int PMAX = 139776;
constexpr int MTMAX = PMAX / 256;
constexpr float DN_ALPHA = 1.41421356237f;
constexpr float LN_EPS = 1e-5f;
constexpr int NTHREADS = 512, NWAVES = 8;

constexpr size_t MiB = 1u << 20;
constexpr size_t ACT_BYTES = (size_t)MPAD * D * 2;
constexpr size_t WS_CTL   = 0;
constexpr size_t WS_WIN   = 4 * MiB;
constexpr size_t WS_GATE  = WS_WIN + 4 * MiB;
constexpr size_t WS_LOUT  = WS_GATE + 2 * MiB;
constexpr size_t WS_QKV   = WS_LOUT + 2 * MiB;
constexpr size_t WS_NOUT  = WS_QKV + 6 * MiB;
constexpr size_t WS_WGU   = WS_NOUT + 2 * MiB;
constexpr size_t WS_WD    = WS_WGU + 256 * MiB;
constexpr size_t WS_HB    = WS_WD + 128 * MiB;
constexpr size_t WS_PRE   = WS_HB + 65 * MiB;
constexpr size_t WS_H     = WS_PRE + 129 * MiB;
constexpr size_t WS_SCR   = WS_H + 129 * MiB;
constexpr size_t WS_XR = WS_SCR, WS_XC = WS_XR + 65 * MiB, WS_GY = WS_XC + 65 * MiB, WS_LA = WS_GY + 65 * MiB, WS_BB = WS_LA + 130 * MiB, WS_HF = WS_BB + 130 * MiB, WS_G = WS_HF + 65 * MiB;
constexpr size_t WS_SCR_END0 = WS_G + 65 * MiB;
constexpr size_t WS_XS = WS_SCR, WS_ACT = WS_XS + 274 * MiB;
constexpr size_t WS_SCR_END1 = WS_ACT + 274 * MiB;
constexpr size_t WS_Q = WS_SCR, WS_K = WS_Q + 65 * MiB, WS_VT = WS_K + 65 * MiB, WS_O = WS_VT + 65 * MiB;
constexpr size_t WS_END = (WS_SCR_END0 > WS_SCR_END1 ? WS_SCR_END0 : WS_SCR_END1);
static_assert(ACT_BYTES <= 65 * MiB && (size_t)PMAX * D * 2 <= 274 * MiB && (size_t)MPAD * D * 4 <= 129 * MiB, "ws map");
static_assert(WS_END <= (size_t)2040 * MiB, "ws map must fit 4x the largest input tensor");
constexpr size_t CT_BC      = 4096;
constexpr size_t CT_TEXP    = CT_BC + 2 * 256 * 32 * 4;
constexpr size_t CT_SPL     = CT_TEXP + 2 * 1024 * 4;
constexpr size_t CT_EID     = 256 * 1024;
constexpr size_t CT_GATEV   = CT_EID + 2 * (size_t)NTOK * 4 * 4;
constexpr size_t CT_POS     = CT_GATEV + 2 * (size_t)NTOK * 4 * 4;
static_assert(CT_POS + 2 * (size_t)NTOK * 4 * 4 <= 4 * MiB, "ctl map");

constexpr int LDS_BYTES = 155648;

__device__ __forceinline__ unsigned f2bf(float f) { unsigned u = __builtin_bit_cast(unsigned, f); return (u + 0x7fffu + ((u >> 16) & 1u)) >> 16; }
__device__ __forceinline__ unsigned pk2(float lo, float hi) { return f2bf(lo) | (f2bf(hi) << 16); }
__device__ __forceinline__ unsigned cvt_pk_bf16(float lo, float hi) { unsigned r; asm volatile("v_cvt_pk_bf16_f32 %0, %1, %2" : "=v"(r) : "v"(lo), "v"(hi)); return r; }
__device__ __forceinline__ float bflo(unsigned w) { return __builtin_bit_cast(float, w << 16); }
__device__ __forceinline__ float bfhi(unsigned w) { return __builtin_bit_cast(float, w & 0xffff0000u); }
__device__ __forceinline__ float fast_exp2(float x) { return __builtin_amdgcn_exp2f(x); }
__device__ __forceinline__ float fast_rcp(float x) { return __builtin_amdgcn_rcpf(x); }
__device__ __forceinline__ float sigmoidf_(float x) { return fast_rcp(1.0f + fast_exp2(-1.44269504089f * x)); }
__device__ __forceinline__ float wave_sum(float v) {
#pragma unroll
    for (int o = 1; o < 64; o <<= 1) v += __shfl_xor(v, o);
    return v;
}
__device__ __forceinline__ int seqrow(int b, int s) { return s < NMETA ? NGRID + NMETA * b + s : SEQ * b + (s - NMETA); }

struct Params {
    const float* in[25];
    float* out;
    unsigned char* ws;
    int ph_lo, ph_hi;
};
struct Ctx {
    LAS unsigned char* lds;
    int tid, lane, wave, G, bid;
    unsigned char* ws;
    const float* const* in;
    float* out;
};
enum { I_X = 0, I_META, I_WIN, I_CONVW, I_CONVB, I_WA, I_BA, I_WX, I_BX, I_LAM, I_LOUT, I_WQKV, I_RPB, I_MBIAS, I_NOUT, I_LNMG, I_LNMB, I_RW, I_RB, I_WGU, I_BGU, I_WD, I_BD, I_LNFG, I_LNFB };

namespace pg8 {
constexpr int BM = 256, BK = 64, HALF = 128, HTB = HALF * BK * 2, STAGE_BYTES = 8 * HTB, NXCD = 8, WGM = 8;
__device__ __forceinline__ int lds_byte(int r, int c) { const int st = (r >> 4) * 2 + (c >> 5), rr = r & 15, cc = c & 31, ob = rr * 64 + cc * 2; return st * 1024 + (ob ^ (((ob >> 9) & 1) << 5)); }
__device__ __forceinline__ void stage_rc(int b, int& R, int& C) { const int st = b / 1024, sb = b % 1024, swz = sb ^ (((sb >> 9) & 1) << 5); R = (st >> 1) * 16 + swz / 64; C = (st & 1) * 32 + (swz % 64) / 2; }
__device__ __forceinline__ int perm32(int rho) { const int n = rho >> 4, i = rho & 15; return 8 * (i >> 2) + 4 * n + (i & 3); }

struct Unit { const char* Ab; const char* Bb; int pm, pn, aux; };

__device__ __forceinline__ void tile_of(int L, int nM, int nN, int& pm, int& pn) {
    const int nwg = nM * nN; int wgid = L;
    { const int q = nwg / NXCD, r = nwg % NXCD, xcd = wgid % NXCD, off = wgid / NXCD; wgid = (xcd < r ? xcd * (q + 1) : r * (q + 1) + (xcd - r) * q) + off; }
    const int nig = WGM * nN, gid = wgid / nig, fm = gid * WGM, gsz = (nM - fm) < WGM ? (nM - fm) : WGM;
    pm = fm + ((wgid % nig) % gsz); pn = (wgid % nig) / gsz;
}

template <class Epi, class Sched>
__device__ __forceinline__ void gemm_phase(LAS unsigned char* lds, const int K, const int lda, const int ldb, const Sched& S, const Epi& E) {
    const int tid = threadIdx.x, wid = __builtin_amdgcn_readfirstlane(tid >> 6), lane = tid & 63, wr = wid >> 2, wc = wid & 3, fr = lane & 15, fq = lane >> 4;
    const int nt = K / BK;
    unsigned voffA[2], voffB[2];
#pragma unroll
    for (int i = 0; i < 2; ++i) { int R, C; stage_rc(tid * 16 + i * 8192, R, C); const int Rb = Epi::PERM ? ((R & ~31) + perm32(R & 31)) : R;
        voffA[i] = (unsigned)(R * lda + C) * 2u; voffB[i] = (unsigned)(Rb * ldb + C) * 2u; }
    const size_t kstep = (size_t)(BK * 2);
    const size_t hstepA = (size_t)HALF * lda * 2, hstepB = (size_t)HALF * ldb * 2;
    const unsigned ldsw = (unsigned)wid * 1024u;
    const int aoff = lds_byte(wr * 64 + fr, fq * 8), boff = lds_byte(wc * 32 + fr, fq * 8);
#define PG8_SA(b, h) (((b) * 2 + (h)) * HTB)
#define PG8_SB(b, h) ((4 + (b) * 2 + (h)) * HTB)
#define PG8_STAGE(bufoff, gbase, voff) do { _Pragma("unroll") for (int _i = 0; _i < 2; ++_i) \
        __builtin_amdgcn_global_load_lds((const unsigned*)((const char*)(gbase) + (voff)[_i]), (LAS unsigned*)(lds + (bufoff) + ldsw + _i * 8192), 16, 0, 0); } while (0)
#define PG8_LDA(dst, b, h) do { _Pragma("unroll") for (int m = 0; m < 4; ++m) _Pragma("unroll") for (int k = 0; k < 2; ++k) dst[m][k] = *(const LAS bf16x8*)(lds + PG8_SA(b, h) + aoff + m * 2048 + k * 1024); } while (0)
#define PG8_LDB(dst, b, h) do { _Pragma("unroll") for (int n = 0; n < 2; ++n) _Pragma("unroll") for (int k = 0; k < 2; ++k) dst[n][k] = *(const LAS bf16x8*)(lds + PG8_SB(b, h) + boff + n * 2048 + k * 1024); } while (0)
#define PG8_MMA(ai, bj, At, Bt) do { __builtin_amdgcn_s_setprio(1); _Pragma("unroll") for (int m = 0; m < 4; ++m) _Pragma("unroll") for (int n = 0; n < 2; ++n) _Pragma("unroll") for (int k = 0; k < 2; ++k) \
        acc[ai][bj][m][n] = __builtin_amdgcn_mfma_f32_16x16x32_bf16(Bt[n][k], At[m][k], acc[ai][bj][m][n], 0, 0, 0); __builtin_amdgcn_s_setprio(0); } while (0)
#define PG8_WAIT_V(n) asm volatile("s_waitcnt vmcnt(" #n ")" ::: "memory")
#define PG8_WAIT_L(n) asm volatile("s_waitcnt lgkmcnt(" #n ")" ::: "memory")
#define PG8_BAR __builtin_amdgcn_s_barrier()
#define PG8_SCHED __builtin_amdgcn_sched_barrier(0)
    Unit cur, nxt; int ui = 0;
    if (!S.next(0, cur)) return;
    f32x4 acc[2][2][4][2];
#pragma unroll
    for (int a = 0; a < 2; ++a)
#pragma unroll
        for (int b = 0; b < 2; ++b)
#pragma unroll
            for (int m = 0; m < 4; ++m)
#pragma unroll
                for (int n = 0; n < 2; ++n) acc[a][b][m][n] = (f32x4){0.f, 0.f, 0.f, 0.f};
    bf16x8 At[4][2], B0[2][2], B1[2][2];
    const char* cA = cur.Ab; const char* cB = cur.Bb;
    PG8_STAGE(PG8_SB(0, 0), cB, voffB); PG8_STAGE(PG8_SB(0, 1), cB + hstepB, voffB); PG8_STAGE(PG8_SA(0, 0), cA, voffA); PG8_STAGE(PG8_SA(0, 1), cA + hstepA, voffA);
    if (wr == 1) PG8_BAR;
    PG8_WAIT_V(2); PG8_BAR;
    PG8_STAGE(PG8_SB(1, 0), cB + kstep, voffB); PG8_STAGE(PG8_SA(1, 0), cA + kstep, voffA); PG8_STAGE(PG8_SB(1, 1), cB + hstepB + kstep, voffB);
    PG8_WAIT_V(6); PG8_BAR;
    for (;;) {
        const bool has_next = S.next(ui + 1, nxt);
        const char* nA = has_next ? nxt.Ab : cA; const char* nB = has_next ? nxt.Bb : cB;
        for (int t = 0; t < nt; t += 2) {
            const bool last = (t == nt - 2);
            const char* a1 = cA + (size_t)(t + 1) * kstep;
            const char* a2 = last ? nA : cA + (size_t)(t + 2) * kstep; const char* b2 = last ? nB : cB + (size_t)(t + 2) * kstep;
            const char* a3 = a2 + kstep; const char* b3 = b2 + kstep;
            PG8_LDB(B0, 0, 0); PG8_LDB(B1, 0, 1); PG8_SCHED; PG8_LDA(At, 0, 0); PG8_STAGE(PG8_SA(1, 1), a1 + hstepA, voffA);
            PG8_WAIT_V(8); PG8_WAIT_L(0); PG8_BAR; PG8_MMA(0, 0, At, B0); PG8_MMA(0, 1, At, B1); PG8_BAR; PG8_SCHED;
            PG8_LDA(At, 0, 1); PG8_STAGE(PG8_SB(0, 0), b2, voffB); PG8_STAGE(PG8_SB(0, 1), b2 + hstepB, voffB); PG8_STAGE(PG8_SA(0, 0), a2, voffA);
            PG8_WAIT_V(8); PG8_WAIT_L(0); PG8_BAR; PG8_MMA(1, 0, At, B0); PG8_MMA(1, 1, At, B1); PG8_BAR; PG8_SCHED;
            PG8_LDB(B0, 1, 0); PG8_LDB(B1, 1, 1); PG8_SCHED; PG8_LDA(At, 1, 0); PG8_STAGE(PG8_SA(0, 1), a2 + hstepA, voffA);
            PG8_WAIT_V(8); PG8_WAIT_L(0); PG8_BAR; PG8_MMA(0, 0, At, B0); PG8_MMA(0, 1, At, B1); PG8_BAR; PG8_SCHED;
            PG8_LDA(At, 1, 1); PG8_STAGE(PG8_SB(1, 0), b3, voffB); PG8_STAGE(PG8_SB(1, 1), b3 + hstepB, voffB); PG8_STAGE(PG8_SA(1, 0), a3, voffA);
            PG8_WAIT_V(8); PG8_WAIT_L(0); PG8_BAR; PG8_MMA(1, 0, At, B0); PG8_MMA(1, 1, At, B1); PG8_BAR; PG8_SCHED;
        }
        if (wr == 0) PG8_BAR;
        E(acc, cur, wr, wc, fr, fq);
        if (!has_next) break;
#pragma unroll
        for (int a = 0; a < 2; ++a)
#pragma unroll
            for (int b = 0; b < 2; ++b)
#pragma unroll
                for (int m = 0; m < 4; ++m)
#pragma unroll
                    for (int n = 0; n < 2; ++n) acc[a][b][m][n] = (f32x4){0.f, 0.f, 0.f, 0.f};
        cur = nxt; cA = nA; cB = nB; ++ui;
        if (wr == 1) PG8_BAR;
    }
    PG8_WAIT_V(0);
    PG8_BAR;
#undef PG8_SA
#undef PG8_SB
#undef PG8_STAGE
#undef PG8_LDA
#undef PG8_LDB
#undef PG8_MMA
#undef PG8_WAIT_V
#undef PG8_WAIT_L
#undef PG8_BAR
#undef PG8_SCHED
}
}

using pg8::Unit;

struct DenseSched {
    const char* A; const char* Bt; int lda, ldb, nM, nN, G, c;
    __device__ __forceinline__ bool next(int i, Unit& u) const {
        const int L = i * G + c; if (L >= nM * nN) return false;
        pg8::tile_of(L, nM, nN, u.pm, u.pn); u.aux = 0;
        u.Ab = A + (size_t)u.pm * 256 * lda * 2; u.Bb = Bt + (size_t)u.pn * 256 * ldb * 2; return true;
    }
};
struct GateSched {
    const char* XC; const char* GT; int nM, G, c;
    __device__ __forceinline__ bool next(int i, Unit& u) const {
        const int per = nM * 4; const int L = i * G + c; if (L >= 4 * per) return false;
        const int nb = L / per; pg8::tile_of(L - nb * per, nM, 4, u.pm, u.pn); u.aux = nb;
        u.Ab = XC + ((size_t)u.pm * 256 * 1024 + 256 * nb) * 2; u.Bb = GT + ((size_t)nb * 1024 + 256 * u.pn) * 256 * 2; return true;
    }
};
struct QkvSched {
    const char* HB; const char* WT; int nM, G, c;
    __device__ __forceinline__ bool next(int i, Unit& u) const {
        const int n0 = nM * 8, n1 = 4 * nM; const int L = i * G + c; if (L >= n0 + n1) return false;
        if (L < n0) { pg8::tile_of(L, nM, 8, u.pm, u.pn); u.aux = 0; u.Ab = HB + (size_t)u.pm * 256 * 1024 * 2; u.Bb = WT + (size_t)u.pn * 256 * 1024 * 2; }
        else { pg8::tile_of(L - n0, 4, nM, u.pm, u.pn); u.aux = 1; u.Ab = WT + (size_t)(2048 + u.pm * 256) * 1024 * 2; u.Bb = HB + (size_t)u.pn * 256 * 1024 * 2; }
        return true;
    }
};
struct MoeSched {
    const char* A; const char* W; const int* texp; size_t wstride; int nM, nN, G, c;
    __device__ __forceinline__ bool next(int i, Unit& u) const {
        const int L = i * G + c; if (L >= nM * nN) return false;
        pg8::tile_of(L, nM, nN, u.pm, u.pn);
        const int e = __builtin_amdgcn_readfirstlane(__hip_atomic_load(texp + u.pm, __ATOMIC_RELAXED, __HIP_MEMORY_SCOPE_AGENT)); u.aux = e;
        u.Ab = A + (size_t)u.pm * 256 * 1024 * 2; u.Bb = W + (size_t)e * wstride + (size_t)u.pn * 256 * 1024 * 2; return true;
    }
};

#define EPI_ARGS const f32x4 (&acc)[2][2][4][2], const Unit& u, int wr, int wc, int fr, int fq
struct EpiWin {
    static constexpr bool PERM = true;
    bf16_t* XR; bf16_t* GY;
    __device__ __forceinline__ void operator()(EPI_ARGS) const {
        const int row0 = u.pm * 256 + wr * 64 + fr;
        if (u.pn < 4) {
            const int col0 = u.pn * 256 + wc * 32 + 8 * fq;
#pragma unroll
            for (int ai = 0; ai < 2; ++ai)
#pragma unroll
                for (int m = 0; m < 4; ++m) { bf16_t* rowp = XR + (size_t)(row0 + ai * 128 + m * 16) * D + col0;
#pragma unroll
                    for (int bj = 0; bj < 2; ++bj) { const f32x4 v0 = acc[ai][bj][m][0], v1 = acc[ai][bj][m][1];
                        u32x4 w; w.x = cvt_pk_bf16(v0[0], v0[1]); w.y = cvt_pk_bf16(v0[2], v0[3]); w.z = cvt_pk_bf16(v1[0], v1[1]); w.w = cvt_pk_bf16(v1[2], v1[3]);
                        *(u32x4*)(rowp + bj * 128) = w; } }
        } else {
#pragma unroll
            for (int ai = 0; ai < 2; ++ai)
#pragma unroll
                for (int m = 0; m < 4; ++m) { const int row = row0 + ai * 128 + m * 16;
#pragma unroll
                    for (int bj = 0; bj < 2; ++bj) { const int g = (u.pn - 4) * 8 + bj * 4 + wc;
                        float o[8];
#pragma unroll
                        for (int n = 0; n < 2; ++n)
#pragma unroll
                            for (int j = 0; j < 4; ++j) { const float v = acc[ai][bj][m][n][j]; const float z = 1.5957691216f * (v + 0.044715f * v * v * v); o[n * 4 + j] = v * sigmoidf_(z); }
                        u32x4 w; w.x = cvt_pk_bf16(o[0], o[1]); w.y = cvt_pk_bf16(o[2], o[3]); w.z = cvt_pk_bf16(o[4], o[5]); w.w = cvt_pk_bf16(o[6], o[7]);
                        *(u32x4*)(GY + ((size_t)g * MPAD + row) * 32 + 8 * fq) = w; } }
        }
    }
};
struct EpiGate {
    static constexpr bool PERM = true;
    const bf16_t* XC; bf16_t* LA; bf16_t* BB; const float* ba; const float* bx; const float* spl;
    __device__ __forceinline__ void operator()(EPI_ARGS) const {
        const int nb = u.aux, dir = u.pn >> 1, half = u.pn & 1;
        const int ch0 = 256 * nb + 128 * half + 32 * wc + 8 * fq, g = ch0 >> 5;
        const int row0 = u.pm * 256 + wr * 64 + fr;
#pragma unroll
        for (int ai = 0; ai < 2; ++ai)
#pragma unroll
            for (int m = 0; m < 4; ++m) { const int row = row0 + ai * 128 + m * 16;
                if (row < NTOK) {
                    float cba[8], cbx[8], csp[8];
                                { const f32x4 t0 = *(const f32x4*)(ba + dir * 1024 + ch0), t1 = *(const f32x4*)(ba + dir * 1024 + ch0 + 4);
                      const f32x4 s0 = *(const f32x4*)(bx + dir * 1024 + ch0), s1 = *(const f32x4*)(bx + dir * 1024 + ch0 + 4);
                      const f32x4 p0 = *(const f32x4*)(spl + dir * 1024 + ch0), p1 = *(const f32x4*)(spl + dir * 1024 + ch0 + 4);
#pragma unroll
                      for (int j = 0; j < 4; ++j) { cba[j] = t0[j]; cba[4 + j] = t1[j]; cbx[j] = s0[j]; cbx[4 + j] = s1[j]; csp[j] = p0[j]; csp[4 + j] = p1[j]; } }
                    const u32x4 xw = *(const u32x4*)(XC + (size_t)row * D + ch0);
                    float xc[8] = {bflo(xw.x), bfhi(xw.x), bflo(xw.y), bfhi(xw.y), bflo(xw.z), bfhi(xw.z), bflo(xw.w), bfhi(xw.w)};
                    const bool start = dir == 0 ? (row >= NGRID && ((row - NGRID) & 15) == 0) : (row < NGRID && (row & (SEQ - 1)) == SEQ - 1);
                    float la[8], bb[8];
#pragma unroll
                    for (int n = 0; n < 2; ++n)
#pragma unroll
                        for (int j = 0; j < 4; ++j) { const int i = n * 4 + j;
                            const float ga = sigmoidf_(acc[ai][0][m][n][j] + cba[i]), gx = sigmoidf_(acc[ai][1][m][n][j] + cbx[i]);
                            const float l2 = -csp[i] * ga;
                            const float a2 = fast_exp2(2.0f * l2);
                            const float mult = start ? 1.0f : __builtin_sqrtf(fmaxf(1.0f - a2, 0.0f));
                            la[i] = l2; bb[i] = mult * gx * xc[i]; }
                    u32x4 w; w.x = cvt_pk_bf16(la[0], la[1]); w.y = cvt_pk_bf16(la[2], la[3]); w.z = cvt_pk_bf16(la[4], la[5]); w.w = cvt_pk_bf16(la[6], la[7]);
                    const size_t o = (((size_t)dir * 32 + g) * MPAD + row) * 32 + 8 * fq;
                    *(u32x4*)(LA + o) = w;
                    w.x = cvt_pk_bf16(bb[0], bb[1]); w.y = cvt_pk_bf16(bb[2], bb[3]); w.z = cvt_pk_bf16(bb[4], bb[5]); w.w = cvt_pk_bf16(bb[6], bb[7]);
                    *(u32x4*)(BB + o) = w;
                }
                asm volatile("" ::: "memory"); }
    }
};
template <bool LAYER0> struct EpiRes {
    static constexpr bool PERM = false;
    float* PRE; const float* x; const float* meta; const float* H; int nrows;
    __device__ __forceinline__ void operator()(EPI_ARGS) const {
        const int row0 = u.pm * 256 + wr * 64 + fr, col0 = u.pn * 256 + wc * 32 + 4 * fq;
#pragma unroll
        for (int ai = 0; ai < 2; ++ai)
#pragma unroll
            for (int m = 0; m < 4; ++m) { const int row = row0 + ai * 128 + m * 16;
                if (row < nrows) {
                    const float* rp = LAYER0 ? (row < NGRID ? x + (size_t)row * D : meta + (size_t)((row - NGRID) & 15) * D) : H + (size_t)row * D;
#pragma unroll
                    for (int bj = 0; bj < 2; ++bj)
#pragma unroll
                        for (int n = 0; n < 2; ++n) { const int c = col0 + bj * 128 + n * 16; const f32x4 r = *(const f32x4*)(rp + c);
                            *(f32x4*)(PRE + (size_t)row * D + c) = r * DN_ALPHA + acc[ai][bj][m][n]; }
                }
                asm volatile("" ::: "memory"); }
    }
};
struct EpiGlu {
    static constexpr bool PERM = true;
    bf16_t* ACT; const float* bgu;
    __device__ __forceinline__ void operator()(EPI_ARGS) const {
        const int e = u.aux, f0 = 128 * u.pn + 32 * wc + 8 * fq;
        float bg[8], bl[8];
        { const float* p = bgu + (size_t)e * 2048 + f0; const f32x4 a0 = *(const f32x4*)p, a1 = *(const f32x4*)(p + 4), c0 = *(const f32x4*)(p + 1024), c1 = *(const f32x4*)(p + 1028);
#pragma unroll
          for (int j = 0; j < 4; ++j) { bg[j] = a0[j]; bg[4 + j] = a1[j]; bl[j] = c0[j]; bl[4 + j] = c1[j]; } }
        const int row0 = u.pm * 256 + wr * 64 + fr;
#pragma unroll
        for (int ai = 0; ai < 2; ++ai)
#pragma unroll
            for (int m = 0; m < 4; ++m) { const int row = row0 + ai * 128 + m * 16; float o[8];
#pragma unroll
                for (int n = 0; n < 2; ++n)
#pragma unroll
                    for (int j = 0; j < 4; ++j) { const int i = n * 4 + j;
                        const float glu = fminf(acc[ai][0][m][n][j] + bg[i], 7.0f);
                        const float lin = fminf(fmaxf(acc[ai][1][m][n][j] + bl[i], -7.0f), 7.0f);
                        o[i] = glu * sigmoidf_(1.702f * glu) * (lin + 1.0f); }
                u32x4 w; w.x = cvt_pk_bf16(o[0], o[1]); w.y = cvt_pk_bf16(o[2], o[3]); w.z = cvt_pk_bf16(o[4], o[5]); w.w = cvt_pk_bf16(o[6], o[7]);
                *(u32x4*)(ACT + (size_t)row * D + f0) = w; }
    }
};
struct EpiDown {
    static constexpr bool PERM = true;
    bf16_t* YS; const float* bd;
    __device__ __forceinline__ void operator()(EPI_ARGS) const {
        const int e = u.aux, row0 = u.pm * 256 + wr * 64 + fr, col0 = u.pn * 256 + wc * 32 + 8 * fq;
        f32x4 bv[2][2];
#pragma unroll
        for (int bj = 0; bj < 2; ++bj)
#pragma unroll
            for (int n = 0; n < 2; ++n) bv[bj][n] = *(const f32x4*)(bd + (size_t)e * D + col0 + bj * 128 + 4 * n);
#pragma unroll
        for (int ai = 0; ai < 2; ++ai)
#pragma unroll
            for (int m = 0; m < 4; ++m) { bf16_t* rowp = YS + (size_t)(row0 + ai * 128 + m * 16) * D + col0;
#pragma unroll
                for (int bj = 0; bj < 2; ++bj) { const f32x4 v0 = acc[ai][bj][m][0] + bv[bj][0], v1 = acc[ai][bj][m][1] + bv[bj][1];
                    u32x4 w; w.x = cvt_pk_bf16(v0[0], v0[1]); w.y = cvt_pk_bf16(v0[2], v0[3]); w.z = cvt_pk_bf16(v1[0], v1[1]); w.w = cvt_pk_bf16(v1[2], v1[3]);
                    *(u32x4*)(rowp + bj * 128) = w; } }
    }
};
struct EpiQkv {
    static constexpr bool PERM = true;
    bf16_t* Q; bf16_t* Kx; bf16_t* VT;
    __device__ __forceinline__ void operator()(EPI_ARGS) const {
        const int row0 = u.pm * 256 + wr * 64 + fr; bf16_t* base; int ldc, colt; float sc = 1.0f;
        if (u.aux == 0) { ldc = D; if (u.pn < 4) { base = Q; colt = u.pn * 256; sc = 0.125f; } else { base = Kx; colt = (u.pn - 4) * 256; } }
        else { base = VT; ldc = MPAD; colt = u.pn * 256; }
        const int col0 = colt + wc * 32 + 8 * fq;
#pragma unroll
        for (int ai = 0; ai < 2; ++ai)
#pragma unroll
            for (int m = 0; m < 4; ++m) { bf16_t* rowp = base + (size_t)(row0 + ai * 128 + m * 16) * ldc + col0;
#pragma unroll
                for (int bj = 0; bj < 2; ++bj) { const f32x4 v0 = acc[ai][bj][m][0] * sc, v1 = acc[ai][bj][m][1] * sc;
                    u32x4 w; w.x = cvt_pk_bf16(v0[0], v0[1]); w.y = cvt_pk_bf16(v0[2], v0[3]); w.z = cvt_pk_bf16(v1[0], v1[1]); w.w = cvt_pk_bf16(v1[2], v1[3]);
                    *(u32x4*)(rowp + bj * 128) = w; } }
    }
};

__device__ __forceinline__ void tr_item(const float* W, int ld, int kb, int n0, bf16_t* dst0, int K, LAS float* scr, int lane) {
    const int r = lane >> 4, q = lane & 15;
    f32x4 v[16];
#pragma unroll
    for (int i = 0; i < 16; ++i) v[i] = *(const f32x4*)(W + (size_t)(64 * kb + 4 * i + r) * ld + n0 + 4 * q);
#pragma unroll
    for (int i = 0; i < 16; ++i) { LAS float* s = scr + (4 * i + r) * 65 + 4 * q; s[0] = v[i][0]; s[1] = v[i][1]; s[2] = v[i][2]; s[3] = v[i][3]; }
    asm volatile("s_waitcnt lgkmcnt(0)" ::: "memory");
    const int c = lane & 7, nn = lane >> 3;
#pragma unroll
    for (int j = 0; j < 8; ++j) { const int n = nn + 8 * j; const LAS float* s = scr + (8 * c) * 65 + n;
        u32x4 o; o.x = pk2(s[0], s[65]); o.y = pk2(s[2 * 65], s[3 * 65]); o.z = pk2(s[4 * 65], s[5 * 65]); o.w = pk2(s[6 * 65], s[7 * 65]);
        *(u32x4*)(dst0 + (size_t)n * K + 64 * kb + 8 * c) = o; }
    asm volatile("s_waitcnt lgkmcnt(0)" ::: "memory");
}
__device__ __forceinline__ void phase_convert(const Ctx& C) {
    LAS float* scr = (LAS float*)(C.lds + C.wave * 16640);
    const int gw = C.bid * NWAVES + C.wave, NGW = C.G * NWAVES, lane = C.lane;
    constexpr int I0 = 512, I1 = 256, I2 = 256, I3 = 768, I4 = 256, I5 = 32768, I6 = 16384, NIT = I0 + I1 + I2 + I3 + I4 + I5 + I6;
    for (int it = gw; it < NIT; it += NGW) {
        int r = it;
        if (r < I0) { const int nbk = r & 31, kb = r >> 5; tr_item(C.in[I_WIN], 2048, kb, 64 * nbk, (bf16_t*)(C.ws + WS_WIN) + (size_t)(64 * nbk) * 1024, 1024, scr, lane); continue; } r -= I0;
        if (r < I1) { const int job = r >> 3, sub = r & 7, nbk = sub & 1, kb = sub >> 1;
            const int half = job & 1, which = (job >> 1) & 1, nb = (job >> 2) & 3, dir = job >> 4;
            const float* src = C.in[which ? I_WX : I_WA] + (size_t)(dir * 4 + nb) * 65536;
            bf16_t* dst = (bf16_t*)(C.ws + WS_GATE) + ((size_t)nb * 1024 + 256 * (2 * dir + half) + 128 * which + 64 * nbk) * 256;
            tr_item(src, 256, kb, 128 * half + 64 * nbk, dst, 256, scr, lane); continue; } r -= I1;
        if (r < I2) { const int nbk = r & 15, kb = r >> 4; tr_item(C.in[I_LOUT], 1024, kb, 64 * nbk, (bf16_t*)(C.ws + WS_LOUT) + (size_t)(64 * nbk) * 1024, 1024, scr, lane); continue; } r -= I2;
        if (r < I3) { const int nbk = r % 48, kb = r / 48; tr_item(C.in[I_WQKV], 3072, kb, 64 * nbk, (bf16_t*)(C.ws + WS_QKV) + (size_t)(64 * nbk) * 1024, 1024, scr, lane); continue; } r -= I3;
        if (r < I4) { const int nbk = r & 15, kb = r >> 4; tr_item(C.in[I_NOUT], 1024, kb, 64 * nbk, (bf16_t*)(C.ws + WS_NOUT) + (size_t)(64 * nbk) * 1024, 1024, scr, lane); continue; } r -= I4;
        if (r < I5) { const int mat = r >> 9, sub = r & 511, nbk = sub & 31, kb = sub >> 5; const int n0 = 64 * nbk, bj = n0 >> 10, f0 = n0 & 1023, pn = f0 >> 7, jj = f0 & 127;
            tr_item(C.in[I_WGU] + (size_t)mat * 1024 * 2048, 2048, kb, n0, (bf16_t*)(C.ws + WS_WGU) + ((size_t)mat * 2048 + 256 * pn + 128 * bj + jj) * 1024, 1024, scr, lane); continue; } r -= I5;
        { const int mat = r >> 8, sub = r & 255, nbk = sub & 15, kb = sub >> 4;
            tr_item(C.in[I_WD] + (size_t)mat * 1024 * 1024, 1024, kb, 64 * nbk, (bf16_t*)(C.ws + WS_WD) + ((size_t)mat * 1024 + 64 * nbk) * 1024, 1024, scr, lane); }
    }
    const int gt = C.bid * NTHREADS + C.tid, NGT = C.G * NTHREADS;
    for (int i = gt; i < 2048; i += NGT) ((float*)(C.ws + WS_CTL + CT_SPL))[i] = 8.0f * 1.44269504089f * log1pf(expf(-C.in[I_LAM][i]));
    for (int i = gt; i < NTOK * 128; i += NGT) { const int row = i >> 7, oc = i & 127;
        const float* src = (row < NGRID ? C.in[I_X] + (size_t)row * D : C.in[I_META] + (size_t)((row - NGRID) & 15) * D) + 8 * oc;
        const f32x4 a = *(const f32x4*)src, b = *(const f32x4*)(src + 4);
        u32x4 w; w.x = pk2(a[0], a[1]); w.y = pk2(a[2], a[3]); w.z = pk2(b[0], b[1]); w.w = pk2(b[2], b[3]);
        *(u32x4*)((bf16_t*)(C.ws + WS_HB) + (size_t)row * D + 8 * oc) = w; }
}

__device__ __forceinline__ void phase_conv(const Ctx& C) {
    const bf16_t* XR = (const bf16_t*)(C.ws + WS_XR); bf16_t* XC = (bf16_t*)(C.ws + WS_XC);
    const float* cw = C.in[I_CONVW]; const float* cb = C.in[I_CONVB];
    const int gt = C.bid * NTHREADS + C.tid, NGT = C.G * NTHREADS;
    for (int i = gt; i < NTOK * 128; i += NGT) { const int row = i >> 7, ch = 8 * (i & 127);
        int b, s; if (row < NGRID) { b = row >> 12; s = NMETA + (row & (SEQ - 1)); } else { b = (row - NGRID) >> 4; s = (row - NGRID) & 15; }
        float a[8];
        { const f32x4 t0 = *(const f32x4*)(cb + ch), t1 = *(const f32x4*)(cb + ch + 4);
#pragma unroll
          for (int j = 0; j < 4; ++j) { a[j] = t0[j]; a[4 + j] = t1[j]; } }
#pragma unroll
        for (int j = 0; j < 4; ++j) { const int sj = s - 2 + j;
            if (sj >= 0 && sj < LSEQ) { const u32x4 xw = *(const u32x4*)(XR + (size_t)seqrow(b, sj) * D + ch);
                const f32x4 w0 = *(const f32x4*)(cw + j * 1024 + ch), w1 = *(const f32x4*)(cw + j * 1024 + ch + 4);
                a[0] += w0[0] * bflo(xw.x); a[1] += w0[1] * bfhi(xw.x); a[2] += w0[2] * bflo(xw.y); a[3] += w0[3] * bfhi(xw.y);
                a[4] += w1[0] * bflo(xw.z); a[5] += w1[1] * bfhi(xw.z); a[6] += w1[2] * bflo(xw.w); a[7] += w1[3] * bfhi(xw.w); } }
        u32x4 w; w.x = pk2(a[0], a[1]); w.y = pk2(a[2], a[3]); w.z = pk2(a[4], a[5]); w.w = pk2(a[6], a[7]);
        *(u32x4*)(XC + (size_t)row * D + ch) = w; }
}

template <int N> __device__ __forceinline__ float dpp_shr(float oldv, float v) {
    return __builtin_bit_cast(float, __builtin_amdgcn_update_dpp(__builtin_bit_cast(int, oldv), __builtin_bit_cast(int, v), 0x110 + N, 0xf, 0xf, false));
}
__device__ __forceinline__ void scan_group(float (&a)[8], float (&b)[8]) {
#pragma unroll
    for (int c = 0; c < 8; ++c) {
        { const float ap = dpp_shr<1>(1.0f, a[c]), bp = dpp_shr<1>(0.0f, b[c]); b[c] = a[c] * bp + b[c]; a[c] = a[c] * ap; }
        { const float ap = dpp_shr<2>(1.0f, a[c]), bp = dpp_shr<2>(0.0f, b[c]); b[c] = a[c] * bp + b[c]; a[c] = a[c] * ap; }
        { const float ap = dpp_shr<4>(1.0f, a[c]), bp = dpp_shr<4>(0.0f, b[c]); b[c] = a[c] * bp + b[c]; a[c] = a[c] * ap; }
        { const float ap = dpp_shr<8>(1.0f, a[c]), bp = dpp_shr<8>(0.0f, b[c]); b[c] = a[c] * bp + b[c]; a[c] = a[c] * ap; }
    }
}
__device__ __forceinline__ void unpack8(const u32x4 w, float (&o)[8]) { o[0] = bflo(w.x); o[1] = bfhi(w.x); o[2] = bflo(w.y); o[3] = bfhi(w.y); o[4] = bflo(w.z); o[5] = bfhi(w.z); o[6] = bflo(w.w); o[7] = bfhi(w.w); }
__device__ __forceinline__ void phase_scan(const Ctx& C) {
    const bf16_t* LA = (const bf16_t*)(C.ws + WS_LA); const bf16_t* BB = (const bf16_t*)(C.ws + WS_BB); const bf16_t* GY = (const bf16_t*)(C.ws + WS_GY);
    bf16_t* HF = (bf16_t*)(C.ws + WS_HF); bf16_t* Gout = (bf16_t*)(C.ws + WS_G);
    LAS float* agg = (LAS float*)C.lds;
    const int lane = C.lane, w = C.wave, oct = lane >> 4, p = lane & 15;
    for (int item = C.bid; item < NB * 32; item += C.G) {
        const int b = item >> 5, g = item & 31;
        for (int dir = 0; dir < 2; ++dir) {
            const bf16_t* la = LA + (((size_t)dir * 32 + g) * MPAD) * 32 + 8 * oct;
            const bf16_t* bb = BB + (((size_t)dir * 32 + g) * MPAD) * 32 + 8 * oct;
            float S[8];
#pragma unroll
            for (int c = 0; c < 8; ++c) S[c] = 0.f;
            {
                const int u = p, s = dir ? LSEQ - 1 - u : u, row = seqrow(b, s);
                float a[8], x[8]; unpack8(*(const u32x4*)(la + (size_t)row * 32), a); unpack8(*(const u32x4*)(bb + (size_t)row * 32), x);
#pragma unroll
                for (int c = 0; c < 8; ++c) a[c] = fast_exp2(a[c]);
                scan_group(a, x);
                if (w == 0) {
                    if (dir == 0) { u32x4 o; o.x = pk2(x[0], x[1]); o.y = pk2(x[2], x[3]); o.z = pk2(x[4], x[5]); o.w = pk2(x[6], x[7]); *(u32x4*)(HF + ((size_t)g * MPAD + row) * 32 + 8 * oct) = o; }
                    else { float hf[8], gy[8]; unpack8(*(const u32x4*)(HF + ((size_t)g * MPAD + row) * 32 + 8 * oct), hf); unpack8(*(const u32x4*)(GY + ((size_t)g * MPAD + row) * 32 + 8 * oct), gy);
                        u32x4 o; o.x = pk2((hf[0] + x[0]) * gy[0], (hf[1] + x[1]) * gy[1]); o.y = pk2((hf[2] + x[2]) * gy[2], (hf[3] + x[3]) * gy[3]);
                        o.z = pk2((hf[4] + x[4]) * gy[4], (hf[5] + x[5]) * gy[5]); o.w = pk2((hf[6] + x[6]) * gy[6], (hf[7] + x[7]) * gy[7]);
                        *(u32x4*)(Gout + (size_t)row * D + 32 * g + 8 * oct) = o; }
                }
#pragma unroll
                for (int c = 0; c < 8; ++c) S[c] = __shfl(x[c], (lane & 48) | 15);
            }
            for (int r = 0; r < 8; ++r) {
                float Pw[4][8], Hw[4][8]; int rows[4];
                float Aw[8], Hc[8];
#pragma unroll
                for (int c = 0; c < 8; ++c) { Aw[c] = 1.f; Hc[c] = 0.f; }
                u32x4 ra[4], rb[4];
#pragma unroll
                for (int j = 0; j < 4; ++j) { const int u = 16 + 512 * r + 64 * w + 16 * j + p, s = dir ? LSEQ - 1 - u : u; rows[j] = seqrow(b, s);
                    ra[j] = *(const u32x4*)(la + (size_t)rows[j] * 32); rb[j] = *(const u32x4*)(bb + (size_t)rows[j] * 32); }
#pragma unroll
                for (int j = 0; j < 4; ++j) {
                    float a[8], x[8]; unpack8(ra[j], a); unpack8(rb[j], x);
#pragma unroll
                    for (int c = 0; c < 8; ++c) a[c] = fast_exp2(a[c]);
                    scan_group(a, x);
#pragma unroll
                    for (int c = 0; c < 8; ++c) { Hw[j][c] = a[c] * Hc[c] + x[c]; Pw[j][c] = a[c] * Aw[c]; }
#pragma unroll
                    for (int c = 0; c < 8; ++c) { Aw[c] = __shfl(Pw[j][c], (lane & 48) | 15); Hc[c] = __shfl(Hw[j][c], (lane & 48) | 15); }
                }
                LAS float* ag = agg + (r & 1) * 512;
                if (p == 0) {
#pragma unroll
                    for (int c = 0; c < 8; ++c) { ag[(w * 32 + oct * 8 + c) * 2] = Aw[c]; ag[(w * 32 + oct * 8 + c) * 2 + 1] = Hc[c]; }
                }
                __syncthreads();
                float Sin[8];
#pragma unroll
                for (int c = 0; c < 8; ++c) Sin[c] = S[c];
#pragma unroll
                for (int ww = 0; ww < 8; ++ww) {
#pragma unroll
                    for (int c = 0; c < 8; ++c) { const float A = ag[(ww * 32 + oct * 8 + c) * 2], H = ag[(ww * 32 + oct * 8 + c) * 2 + 1];
                        if (ww == w) Sin[c] = S[c];
                        S[c] = A * S[c] + H; }
                }
#pragma unroll
                for (int j = 0; j < 4; ++j) {
                    float h[8];
#pragma unroll
                    for (int c = 0; c < 8; ++c) h[c] = Pw[j][c] * Sin[c] + Hw[j][c];
                    const size_t go = ((size_t)g * MPAD + rows[j]) * 32 + 8 * oct;
                    if (dir == 0) { u32x4 o; o.x = pk2(h[0], h[1]); o.y = pk2(h[2], h[3]); o.z = pk2(h[4], h[5]); o.w = pk2(h[6], h[7]); *(u32x4*)(HF + go) = o; }
                    else { float hf[8], gy[8]; unpack8(*(const u32x4*)(HF + go), hf); unpack8(*(const u32x4*)(GY + go), gy);
                        u32x4 o; o.x = pk2((hf[0] + h[0]) * gy[0], (hf[1] + h[1]) * gy[1]); o.y = pk2((hf[2] + h[2]) * gy[2], (hf[3] + h[3]) * gy[3]);
                        o.z = pk2((hf[4] + h[4]) * gy[4], (hf[5] + h[5]) * gy[5]); o.w = pk2((hf[6] + h[6]) * gy[6], (hf[7] + h[7]) * gy[7]);
                        *(u32x4*)(Gout + (size_t)rows[j] * D + 32 * g + 8 * oct) = o; }
                }
            }
            __syncthreads();
        }
    }
}

constexpr int RWT_PITCH = 1028;
__device__ __forceinline__ void phase_lnr(const Ctx& C, int layer, int nrows) {
    const float* PRE = (const float*)(C.ws + WS_PRE); float* H = (float*)(C.ws + WS_H); bf16_t* HB = (bf16_t*)(C.ws + WS_HB);
    const float* lg = C.in[I_LNMG] + layer * D; const float* lb = C.in[I_LNMB] + layer * D;
    const float* rw = C.in[I_RW] + (size_t)layer * D * NEXP; const float* rb = C.in[I_RB] + layer * NEXP;
    int* eid = (int*)(C.ws + WS_CTL + CT_EID) + (size_t)layer * NTOK * 4; float* gatev = (float*)(C.ws + WS_CTL + CT_GATEV) + (size_t)layer * NTOK * 4;
    unsigned* bc = (unsigned*)(C.ws + WS_CTL + CT_BC) + ((size_t)layer * 256 + C.bid) * 32;
    LAS float* RWt = (LAS float*)C.lds; LAS unsigned* hist = (LAS unsigned*)(C.lds + 32 * RWT_PITCH * 4);
    const int lane = C.lane;
    for (int idx = C.tid; idx < D * NEXP; idx += NTHREADS) RWt[(idx & 31) * RWT_PITCH + (idx >> 5)] = rw[idx];
    if (C.tid < 32) hist[C.tid] = 0u;
    __syncthreads();
    f32x4 gg[4], gb[4];
#pragma unroll
    for (int j = 0; j < 4; ++j) { gg[j] = *(const f32x4*)(lg + 4 * lane + 256 * j); gb[j] = *(const f32x4*)(lb + 4 * lane + 256 * j); }
    const float rbias = rb[lane >> 1];
    const int gw = C.bid * NWAVES + C.wave, NGW = C.G * NWAVES;
    for (int row = gw; row < nrows; row += NGW) {
        f32x4 v[4]; float s = 0.f;
#pragma unroll
        for (int j = 0; j < 4; ++j) { v[j] = *(const f32x4*)(PRE + (size_t)row * D + 4 * lane + 256 * j); s += (v[j][0] + v[j][1]) + (v[j][2] + v[j][3]); }
        const float mean = wave_sum(s) * (1.0f / D); float q = 0.f;
#pragma unroll
        for (int j = 0; j < 4; ++j) { v[j] = v[j] - mean; q += (v[j][0] * v[j][0] + v[j][1] * v[j][1]) + (v[j][2] * v[j][2] + v[j][3] * v[j][3]); }
        const float rstd = 1.0f / sqrtf(wave_sum(q) * (1.0f / D) + LN_EPS);
#pragma unroll
        for (int j = 0; j < 4; ++j) { v[j] = v[j] * rstd * gg[j] + gb[j];
            *(f32x4*)(H + (size_t)row * D + 4 * lane + 256 * j) = v[j];
            u32x2 w; w.x = pk2(v[j][0], v[j][1]); w.y = pk2(v[j][2], v[j][3]); *(u32x2*)(HB + (size_t)row * D + 4 * lane + 256 * j) = w; }
        float pl[32];
#pragma unroll
        for (int e = 0; e < 32; ++e) { float a = 0.f;
#pragma unroll
            for (int j = 0; j < 4; ++j) { const f32x4 wv = *(const LAS f32x4*)(RWt + e * RWT_PITCH + 4 * lane + 256 * j); a += (v[j][0] * wv[0] + v[j][1] * wv[1]) + (v[j][2] * wv[2] + v[j][3] * wv[3]); }
            pl[e] = a; }
        float q16[16], q8[8], q4[4], q2[2], q1;
        { const bool hi = (lane & 32) != 0;
#pragma unroll
          for (int e = 0; e < 16; ++e) { const float mine = hi ? pl[16 + e] : pl[e], other = hi ? pl[e] : pl[16 + e]; q16[e] = mine + __shfl_xor(other, 32); } }
        { const bool hi = (lane & 16) != 0;
#pragma unroll
          for (int e = 0; e < 8; ++e) { const float mine = hi ? q16[8 + e] : q16[e], other = hi ? q16[e] : q16[8 + e]; q8[e] = mine + __shfl_xor(other, 16); } }
        { const bool hi = (lane & 8) != 0;
#pragma unroll
          for (int e = 0; e < 4; ++e) { const float mine = hi ? q8[4 + e] : q8[e], other = hi ? q8[e] : q8[4 + e]; q4[e] = mine + __shfl_xor(other, 8); } }
        { const bool hi = (lane & 4) != 0;
#pragma unroll
          for (int e = 0; e < 2; ++e) { const float mine = hi ? q4[2 + e] : q4[e], other = hi ? q4[e] : q4[2 + e]; q2[e] = mine + __shfl_xor(other, 4); } }
        { const bool hi = (lane & 2) != 0; const float mine = hi ? q2[1] : q2[0], other = hi ? q2[0] : q2[1]; q1 = mine + __shfl_xor(other, 2); }
        q1 += __shfl_xor(q1, 1);
        float lv = q1 + rbias; const int le = lane >> 1;
        float tv[4]; int te[4];
#pragma unroll
        for (int k = 0; k < 4; ++k) { float bv = lv; int be = le;
#pragma unroll
            for (int o = 1; o < 64; o <<= 1) { const float ov = __shfl_xor(bv, o); const int oe = __shfl_xor(be, o); if (ov > bv || (ov == bv && oe < be)) { bv = ov; be = oe; } }
            tv[k] = bv; te[k] = be; if (le == be) lv = -3.0e38f; }
        const float e1 = __expf(tv[1] - tv[0]), e2 = __expf(tv[2] - tv[0]), e3 = __expf(tv[3] - tv[0]); const float inv = 1.0f / (1.0f + e1 + e2 + e3);
        if (lane < 4) { const int ek = lane == 0 ? te[0] : lane == 1 ? te[1] : lane == 2 ? te[2] : te[3]; const float gk = (lane == 0 ? 1.0f : lane == 1 ? e1 : lane == 2 ? e2 : e3) * inv;
            eid[(size_t)row * 4 + lane] = ek; gatev[(size_t)row * 4 + lane] = gk; __hip_atomic_fetch_add(&hist[ek], 1u, __ATOMIC_RELAXED, __HIP_MEMORY_SCOPE_WORKGROUP); }
    }
    __syncthreads();
    if (C.tid < 32) bc[C.tid] = hist[C.tid];
}

__device__ __forceinline__ void phase_pos(const Ctx& C, int layer, int nrows) {
    const unsigned* bcAll = (const unsigned*)(C.ws + WS_CTL + CT_BC) + (size_t)layer * 256 * 32;
    const int* eid = (const int*)(C.ws + WS_CTL + CT_EID) + (size_t)layer * NTOK * 4; int* posv = (int*)(C.ws + WS_CTL + CT_POS) + (size_t)layer * NTOK * 4;
    int* texp = (int*)(C.ws + WS_CTL + CT_TEXP) + layer * 1024;
    const bf16_t* HB = (const bf16_t*)(C.ws + WS_HB); bf16_t* XS = (bf16_t*)(C.ws + WS_XS);
    LAS unsigned* partT = (LAS unsigned*)C.lds; LAS unsigned* partP = partT + 512; LAS unsigned* tot = partP + 512; LAS unsigned* cnt = tot + 32;
    const int lane = C.lane;
    { const int e = C.tid & 31, part = C.tid >> 5; unsigned t = 0, pr = 0;
      for (int bq = part; bq < C.G; bq += 16) { const unsigned v = __hip_atomic_load(bcAll + (size_t)bq * 32 + e, __ATOMIC_RELAXED, __HIP_MEMORY_SCOPE_AGENT); t += v; if (bq < C.bid) pr += v; }
      partT[part * 32 + e] = t; partP[part * 32 + e] = pr; }
    __syncthreads();
    if (C.tid < 32) { unsigned t = 0, pr = 0; for (int i = 0; i < 16; ++i) { t += partT[i * 32 + C.tid]; pr += partP[i * 32 + C.tid]; } tot[C.tid] = t; cnt[C.tid] = pr; }
    __syncthreads();
    if (C.tid < 32) { unsigned off = 0; for (int e = 0; e < C.tid; ++e) off += (tot[e] + 255u) & ~255u;
        const unsigned mine = (tot[C.tid] + 255u) & ~255u;
        if (C.bid == 0) { for (unsigned t = off >> 8; t < ((off + mine) >> 8); ++t) texp[t] = C.tid; if (C.tid == 31) texp[1023] = (int)((off + mine) >> 8); }
        cnt[C.tid] += off; }
    __syncthreads();
    const int gw = C.bid * NWAVES + C.wave, NGW = C.G * NWAVES;
    for (int row = gw; row < nrows; row += NGW) {
        int pos = 0;
        if (lane < 4) { const int e = eid[(size_t)row * 4 + lane]; pos = (int)__hip_atomic_fetch_add(&cnt[e], 1u, __ATOMIC_RELAXED, __HIP_MEMORY_SCOPE_WORKGROUP); posv[(size_t)row * 4 + lane] = pos; }
        const u32x4 r0 = *(const u32x4*)(HB + (size_t)row * D + 8 * lane), r1 = *(const u32x4*)(HB + (size_t)row * D + 512 + 8 * lane);
#pragma unroll
        for (int k = 0; k < 4; ++k) { const int pk = __shfl(pos, k); *(u32x4*)(XS + (size_t)pk * D + 8 * lane) = r0; *(u32x4*)(XS + (size_t)pk * D + 512 + 8 * lane) = r1; }
    }
}

__device__ __forceinline__ void phase_combine(const Ctx& C, int layer, int nrows, bool final_out) {
    float* H = (float*)(C.ws + WS_H); bf16_t* HB = (bf16_t*)(C.ws + WS_HB); const bf16_t* YS = (const bf16_t*)(C.ws + WS_XS);
    const float* lg = C.in[I_LNFG] + layer * D; const float* lb = C.in[I_LNFB] + layer * D;
    const float* gatev = (const float*)(C.ws + WS_CTL + CT_GATEV) + (size_t)layer * NTOK * 4; const int* posv = (const int*)(C.ws + WS_CTL + CT_POS) + (size_t)layer * NTOK * 4;
    const int lane = C.lane;
    f32x4 gg[4], gb[4];
#pragma unroll
    for (int j = 0; j < 4; ++j) { gg[j] = *(const f32x4*)(lg + 4 * lane + 256 * j); gb[j] = *(const f32x4*)(lb + 4 * lane + 256 * j); }
    const int gw = C.bid * NWAVES + C.wave, NGW = C.G * NWAVES;
    for (int row = gw; row < nrows; row += NGW) {
        f32x4 v[4];
#pragma unroll
        for (int j = 0; j < 4; ++j) v[j] = *(const f32x4*)(H + (size_t)row * D + 4 * lane + 256 * j) * DN_ALPHA;
#pragma unroll
        for (int k = 0; k < 4; ++k) { const float gk = gatev[(size_t)row * 4 + k]; const int pk = posv[(size_t)row * 4 + k];
#pragma unroll
            for (int j = 0; j < 4; ++j) { const u32x2 w = *(const u32x2*)(YS + (size_t)pk * D + 4 * lane + 256 * j);
                v[j][0] += gk * bflo(w.x); v[j][1] += gk * bfhi(w.x); v[j][2] += gk * bflo(w.y); v[j][3] += gk * bfhi(w.y); } }
        float s = 0.f;
#pragma unroll
        for (int j = 0; j < 4; ++j) s += (v[j][0] + v[j][1]) + (v[j][2] + v[j][3]);
        const float mean = wave_sum(s) * (1.0f / D); float q = 0.f;
#pragma unroll
        for (int j = 0; j < 4; ++j) { v[j] = v[j] - mean; q += (v[j][0] * v[j][0] + v[j][1] * v[j][1]) + (v[j][2] * v[j][2] + v[j][3] * v[j][3]); }
        const float rstd = 1.0f / sqrtf(wave_sum(q) * (1.0f / D) + LN_EPS);
#pragma unroll
        for (int j = 0; j < 4; ++j) { v[j] = v[j] * rstd * gg[j] + gb[j];
            if (final_out) *(f32x4*)(C.out + (size_t)row * D + 4 * lane + 256 * j) = v[j];
            else { *(f32x4*)(H + (size_t)row * D + 4 * lane + 256 * j) = v[j];
                u32x2 w; w.x = pk2(v[j][0], v[j][1]); w.y = pk2(v[j][2], v[j][3]); *(u32x2*)(HB + (size_t)row * D + 4 * lane + 256 * j) = w; } }
    }
}

constexpr int AT_KS = 0, AT_VTS = 73728, AT_VPITCH = 1168, AT_KM = AT_VTS + 64 * AT_VPITCH, AT_VTM = AT_KM + 2048, AT_RPB = AT_VTM + 2048, AT_MB = AT_RPB + 1920, AT_END = AT_MB + 64;
static_assert(AT_END <= LDS_BYTES, "attention LDS map");
__device__ __forceinline__ void phase_attn(const Ctx& C) {
    const bf16_t* Q = (const bf16_t*)(C.ws + WS_Q); const bf16_t* Kx = (const bf16_t*)(C.ws + WS_K); const bf16_t* VT = (const bf16_t*)(C.ws + WS_VT); bf16_t* O = (bf16_t*)(C.ws + WS_O);
    const float* rpb = C.in[I_RPB]; const float* mbias = C.in[I_MBIAS];
    LAS unsigned char* lds = C.lds;
    const int tid = C.tid, lane = C.lane, w = C.wave, lq = lane & 15, g = lane >> 4;
    for (int unit = C.bid; unit < NB * 16 * 32; unit += C.G) {
        const int rp = unit & 31, h = (unit >> 5) & 15, b = unit >> 9;
        const int R0 = min(max(2 * rp - 4, 0), 55);
        __syncthreads();
#pragma unroll
        for (int i = 0; i < 9; ++i) { const int idx = tid + 512 * i, ch = idx & 7, kc = (idx >> 3) & 63, jr = idx >> 9;
            const u32x4 v = *(const u32x4*)(Kx + (size_t)(b * SEQ + (R0 + jr) * 64 + kc) * D + 64 * h + 8 * ch);
            *(LAS u32x4*)(lds + AT_KS + ((jr * 64 + kc) * 8 + (ch ^ (kc & 7))) * 16) = v; }
#pragma unroll
        for (int i = 0; i < 9; ++i) { const int idx = tid + 512 * i, d = idx / 72, cx = idx - d * 72;
            const u32x4 v = *(const u32x4*)(VT + (size_t)(64 * h + d) * MPAD + b * SEQ + R0 * 64 + 8 * cx);
            *(LAS u32x4*)(lds + AT_VTS + d * AT_VPITCH + cx * 16) = v; }
        if (tid < 128) { const int m = tid >> 3, ch = tid & 7;
            const u32x4 v = *(const u32x4*)(Kx + (size_t)(NGRID + 16 * b + m) * D + 64 * h + 8 * ch);
            *(LAS u32x4*)(lds + AT_KM + (m * 8 + (ch ^ (m & 7))) * 16) = v; }
        else if (tid < 256) { const int i = tid - 128, d = i >> 1, hf = i & 1;
            const u32x4 v = *(const u32x4*)(VT + (size_t)(64 * h + d) * MPAD + NGRID + 16 * b + 8 * hf);
            *(LAS u32x4*)(lds + AT_VTM + d * 32 + hf * 16) = v; }
        if (tid < 465) ((LAS float*)(lds + AT_RPB))[tid] = rpb[h * 465 + tid];
        if (tid < 16) ((LAS float*)(lds + AT_MB))[tid] = mbias[h * 16 + tid];
        __syncthreads();
        const int qr = w >> 2, qg = w & 3, r = 2 * rp + qr, c0 = 16 * qg;
        const int rs = min(max(r - 4, 0), 56), jr0 = rs - R0;
        const int kcb = qg == 0 ? 0 : (qg == 1 ? 8 : (qg == 2 ? 24 : 32));
        const size_t qrow = (size_t)(b * SEQ + r * 64 + c0 + lq);
        bf16x8 qf[2];
#pragma unroll
        for (int ks = 0; ks < 2; ++ks) qf[ks] = *(const bf16x8*)(Q + qrow * D + 64 * h + 32 * ks + 8 * g);
        f32x4 sc[8][2], sm;
#pragma unroll
        for (int j = 0; j < 8; ++j)
#pragma unroll
            for (int blk = 0; blk < 2; ++blk) { f32x4 a = {0.f, 0.f, 0.f, 0.f}; const int kc = kcb + 16 * blk + lq;
#pragma unroll
                for (int ks = 0; ks < 2; ++ks) { const bf16x8 kf = *(const LAS bf16x8*)(lds + AT_KS + (((jr0 + j) * 64 + kc) * 8 + ((4 * ks + g) ^ (kc & 7))) * 16);
                    a = __builtin_amdgcn_mfma_f32_16x16x32_bf16(kf, qf[ks], a, 0, 0, 0); }
                sc[j][blk] = a; }
        { f32x4 a = {0.f, 0.f, 0.f, 0.f};
#pragma unroll
          for (int ks = 0; ks < 2; ++ks) { const bf16x8 kf = *(const LAS bf16x8*)(lds + AT_KM + (lq * 8 + ((4 * ks + g) ^ (lq & 7))) * 16);
              a = __builtin_amdgcn_mfma_f32_16x16x32_bf16(kf, qf[ks], a, 0, 0, 0); }
          sm = a; }
        const int c = c0 + lq, cs = min(max(c - 8, 0), 48);
        const LAS float* RP = (const LAS float*)(lds + AT_RPB); const LAS float* MB = (const LAS float*)(lds + AT_MB);
        float mx = -3.0e38f;
#pragma unroll
        for (int j = 0; j < 8; ++j) { const int ro = rs + j - r + 7;
#pragma unroll
            for (int blk = 0; blk < 2; ++blk)
#pragma unroll
                for (int e = 0; e < 4; ++e) { const int kc = kcb + 16 * blk + 4 * g + e; const bool valid = kc >= cs && kc < cs + 16;
                    const float bias = RP[valid ? ro * 31 + (kc - c + 15) : 0];
                    const float s = valid ? sc[j][blk][e] + bias : -1.0e30f; sc[j][blk][e] = s; mx = fmaxf(mx, s); } }
#pragma unroll
        for (int e = 0; e < 4; ++e) { sm[e] += MB[4 * g + e]; mx = fmaxf(mx, sm[e]); }
        mx = fmaxf(mx, __shfl_xor(mx, 16)); mx = fmaxf(mx, __shfl_xor(mx, 32));
        float sum = 0.f;
#pragma unroll
        for (int j = 0; j < 8; ++j)
#pragma unroll
            for (int blk = 0; blk < 2; ++blk)
#pragma unroll
                for (int e = 0; e < 4; ++e) { const float pv = fast_exp2((sc[j][blk][e] - mx) * 1.44269504089f); sc[j][blk][e] = pv; sum += pv; }
#pragma unroll
        for (int e = 0; e < 4; ++e) { const float pv = fast_exp2((sm[e] - mx) * 1.44269504089f); sm[e] = pv; sum += pv; }
        sum += __shfl_xor(sum, 16); sum += __shfl_xor(sum, 32);
        f32x4 o[4];
#pragma unroll
        for (int db = 0; db < 4; ++db) o[db] = (f32x4){0.f, 0.f, 0.f, 0.f};
#pragma unroll
        for (int j = 0; j < 8; ++j) {
            u32x4 pw; pw.x = cvt_pk_bf16(sc[j][0][0], sc[j][0][1]); pw.y = cvt_pk_bf16(sc[j][0][2], sc[j][0][3]); pw.z = cvt_pk_bf16(sc[j][1][0], sc[j][1][1]); pw.w = cvt_pk_bf16(sc[j][1][2], sc[j][1][3]);
            const bf16x8 pb = __builtin_bit_cast(bf16x8, pw);
#pragma unroll
            for (int db = 0; db < 4; ++db) { const int d = 16 * db + lq; const LAS unsigned char* vp = lds + AT_VTS + d * AT_VPITCH + ((jr0 + j) * 64 + kcb + 4 * g) * 2;
                const u32x2 lo = *(const LAS u32x2*)vp, hi = *(const LAS u32x2*)(vp + 32);
                u32x4 aw; aw.x = lo.x; aw.y = lo.y; aw.z = hi.x; aw.w = hi.y;
                o[db] = __builtin_amdgcn_mfma_f32_16x16x32_bf16(__builtin_bit_cast(bf16x8, aw), pb, o[db], 0, 0, 0); }
        }
        { u32x4 pw; pw.x = cvt_pk_bf16(sm[0], sm[1]); pw.y = cvt_pk_bf16(sm[2], sm[3]); pw.z = 0u; pw.w = 0u; const bf16x8 pb = __builtin_bit_cast(bf16x8, pw);
#pragma unroll
          for (int db = 0; db < 4; ++db) { const int d = 16 * db + lq; const u32x2 lo = *(const LAS u32x2*)(lds + AT_VTM + d * 32 + 8 * g);
              u32x4 aw; aw.x = lo.x; aw.y = lo.y; aw.z = 0u; aw.w = 0u;
              o[db] = __builtin_amdgcn_mfma_f32_16x16x32_bf16(__builtin_bit_cast(bf16x8, aw), pb, o[db], 0, 0, 0); } }
        const float inv = 1.0f / sum;
#pragma unroll
        for (int db = 0; db < 4; ++db) { u32x2 ow; ow.x = cvt_pk_bf16(o[db][0] * inv, o[db][1] * inv); ow.y = cvt_pk_bf16(o[db][2] * inv, o[db][3] * inv);
            *(u32x2*)(O + qrow * D + 64 * h + 16 * db + 4 * g) = ow; }
    }
}

constexpr int N_PHASES = 20;
__global__ void __launch_bounds__(NTHREADS, 2) hybrid_fwd(Params P) {
    extern __shared__ __attribute__((aligned(16))) unsigned char smem[];
    cg::grid_group grid = cg::this_grid();
    Ctx C; C.lds = (LAS unsigned char*)smem; C.tid = threadIdx.x; C.lane = C.tid & 63; C.wave = __builtin_amdgcn_readfirstlane(C.tid >> 6); C.G = gridDim.x; C.bid = blockIdx.x;
    C.ws = P.ws; C.in = P.in; C.out = P.out;
    unsigned char* ws = P.ws;
    const int lo = P.ph_lo, hi = P.ph_hi;
#ifndef PH_MASK
#define PH_MASK 0xFFFFFFFFu
#endif
#define IN(k) (((PH_MASK >> (k)) & 1u) && lo <= (k) && (k) < hi)
#define SEAM(k) do { if (IN(k) && IN((k) + 1)) grid.sync(); } while (0)
    if (IN(0)) phase_convert(C);
    SEAM(0);
    if (IN(1)) { DenseSched S{(const char*)(ws + WS_HB), (const char*)(ws + WS_WIN), 1024, 1024, 129, 8, C.G, C.bid}; EpiWin E{(bf16_t*)(ws + WS_XR), (bf16_t*)(ws + WS_GY)};
        pg8::gemm_phase(C.lds, 1024, 1024, 1024, S, E); }
    SEAM(1);
    if (IN(2)) phase_conv(C);
    SEAM(2);
    if (IN(3)) { GateSched S{(const char*)(ws + WS_XC), (const char*)(ws + WS_GATE), 129, C.G, C.bid};
        EpiGate E{(const bf16_t*)(ws + WS_XC), (bf16_t*)(ws + WS_LA), (bf16_t*)(ws + WS_BB), P.in[I_BA], P.in[I_BX], (const float*)(ws + WS_CTL + CT_SPL)};
        pg8::gemm_phase(C.lds, 256, 1024, 256, S, E); }
    SEAM(3);
    if (IN(4)) phase_scan(C);
    SEAM(4);
    if (IN(5)) { DenseSched S{(const char*)(ws + WS_G), (const char*)(ws + WS_LOUT), 1024, 1024, 129, 4, C.G, C.bid}; EpiRes<true> E{(float*)(ws + WS_PRE), P.in[I_X], P.in[I_META], nullptr, NTOK};
        pg8::gemm_phase(C.lds, 1024, 1024, 1024, S, E); }
    SEAM(5);
    if (IN(6)) phase_lnr(C, 0, NTOK);
    SEAM(6);
    if (IN(7)) phase_pos(C, 0, NTOK);
    SEAM(7);
    if (IN(8)) { const int* texp = (const int*)(ws + WS_CTL + CT_TEXP); const int nM = __builtin_amdgcn_readfirstlane(__hip_atomic_load(texp + 1023, __ATOMIC_RELAXED, __HIP_MEMORY_SCOPE_AGENT));
        MoeSched S{(const char*)(ws + WS_XS), (const char*)(ws + WS_WGU), texp, (size_t)2048 * 1024 * 2, nM, 8, C.G, C.bid}; EpiGlu E{(bf16_t*)(ws + WS_ACT), P.in[I_BGU]};
        pg8::gemm_phase(C.lds, 1024, 1024, 1024, S, E); }
    SEAM(8);
    if (IN(9)) { const int* texp = (const int*)(ws + WS_CTL + CT_TEXP); const int nM = __builtin_amdgcn_readfirstlane(__hip_atomic_load(texp + 1023, __ATOMIC_RELAXED, __HIP_MEMORY_SCOPE_AGENT));
        MoeSched S{(const char*)(ws + WS_ACT), (const char*)(ws + WS_WD), texp, (size_t)1024 * 1024 * 2, nM, 4, C.G, C.bid}; EpiDown E{(bf16_t*)(ws + WS_XS), P.in[I_BD]};
        pg8::gemm_phase(C.lds, 1024, 1024, 1024, S, E); }
    SEAM(9);
    if (IN(10)) phase_combine(C, 0, NTOK, false);
    SEAM(10);
    if (IN(11)) { QkvSched S{(const char*)(ws + WS_HB), (const char*)(ws + WS_QKV), 129, C.G, C.bid}; EpiQkv E{(bf16_t*)(ws + WS_Q), (bf16_t*)(ws + WS_K), (bf16_t*)(ws + WS_VT)};
        pg8::gemm_phase(C.lds, 1024, 1024, 1024, S, E); }
    SEAM(11);
    if (IN(12)) phase_attn(C);
    SEAM(12);
    if (IN(13)) { DenseSched S{(const char*)(ws + WS_O), (const char*)(ws + WS_NOUT), 1024, 1024, 128, 4, C.G, C.bid}; EpiRes<false> E{(float*)(ws + WS_PRE), nullptr, nullptr, (const float*)(ws + WS_H), NGRID};
        pg8::gemm_phase(C.lds, 1024, 1024, 1024, S, E); }
    SEAM(13);
    if (IN(14)) phase_lnr(C, 1, NGRID);
    SEAM(14);
    if (IN(15)) phase_pos(C, 1, NGRID);
    SEAM(15);
    if (IN(16)) { const int* texp = (const int*)(ws + WS_CTL + CT_TEXP) + 1024; const int nM = __builtin_amdgcn_readfirstlane(__hip_atomic_load(texp + 1023, __ATOMIC_RELAXED, __HIP_MEMORY_SCOPE_AGENT));
        MoeSched S{(const char*)(ws + WS_XS), (const char*)(ws + WS_WGU) + (size_t)32 * 2048 * 1024 * 2, texp, (size_t)2048 * 1024 * 2, nM, 8, C.G, C.bid}; EpiGlu E{(bf16_t*)(ws + WS_ACT), P.in[I_BGU] + 32 * 2048};
        pg8::gemm_phase(C.lds, 1024, 1024, 1024, S, E); }
    SEAM(16);
    if (IN(17)) { const int* texp = (const int*)(ws + WS_CTL + CT_TEXP) + 1024; const int nM = __builtin_amdgcn_readfirstlane(__hip_atomic_load(texp + 1023, __ATOMIC_RELAXED, __HIP_MEMORY_SCOPE_AGENT));
        MoeSched S{(const char*)(ws + WS_ACT), (const char*)(ws + WS_WD) + (size_t)32 * 1024 * 1024 * 2, texp, (size_t)1024 * 1024 * 2, nM, 4, C.G, C.bid}; EpiDown E{(bf16_t*)(ws + WS_XS), P.in[I_BD] + 32 * 1024};
        pg8::gemm_phase(C.lds, 1024, 1024, 1024, S, E); }
    SEAM(17);
    if (IN(18)) phase_combine(C, 1, NGRID, true);
#undef IN
#undef SEAM
}

#ifndef MK_PER_PHASE
#define MK_PER_PHASE 0
#endif
extern "C" void kernel_launch(void* const* d_in, const int* in_sizes, int n_in, void* d_out, int out_size, void* d_ws, size_t ws_size, hipStream_t stream) {
    static int grid = 0;
    if (grid == 0) {
        if (n_in != 25 || ws_size < WS_END || out_size != NGRID * D) { fprintf(stderr, "kernel_launch: unexpected problem (n_in %d, ws %zu, out %d)\n", n_in, ws_size, out_size); grid = -1; return; }
        int dev = 0, cus = 0, per_cu = 0;
        if (hipGetDevice(&dev) != hipSuccess || hipDeviceGetAttribute(&cus, hipDeviceAttributeMultiprocessorCount, dev) != hipSuccess) { grid = -1; return; }
        if (hipFuncSetAttribute((const void*)hybrid_fwd, hipFuncAttributeMaxDynamicSharedMemorySize, LDS_BYTES) != hipSuccess) { fprintf(stderr, "kernel_launch: hipFuncSetAttribute failed\n"); grid = -1; return; }
        if (hipOccupancyMaxActiveBlocksPerMultiprocessor(&per_cu, (const void*)hybrid_fwd, NTHREADS, LDS_BYTES) != hipSuccess || per_cu < 1) { fprintf(stderr, "kernel_launch: occupancy query failed (%d)\n", per_cu); grid = -1; return; }
        grid = cus * 1;
        if (grid > 256) grid = 256;
    }
    if (grid < 0) return;
    Params p{};
    for (int i = 0; i < 25; ++i) p.in[i] = (const float*)d_in[i];
    p.out = (float*)d_out; p.ws = (unsigned char*)d_ws;
#if MK_PER_PHASE
    for (int ph = 0; ph < 19; ++ph) { p.ph_lo = ph; p.ph_hi = ph + 1; void* args[] = {&p};
        hipError_t e = hipLaunchCooperativeKernel((void*)hybrid_fwd, dim3(grid), dim3(NTHREADS), args, LDS_BYTES, stream);
        if (e != hipSuccess) { fprintf(stderr, "launch phase %d failed: %s\n", ph, hipGetErrorString(e)); break; } }
#else
    p.ph_lo = 0; p.ph_hi = 19; void* args[] = {&p};
    hipError_t e = hipLaunchCooperativeKernel((void*)hybrid_fwd, dim3(grid), dim3(NTHREADS), args, LDS_BYTES, stream);
    if (e != hipSuccess) fprintf(stderr, "cooperative launch failed: %s (grid %d)\n", hipGetErrorString(e), grid);
#endif
}
```

```cpp
#include <hip/hip_runtime.h>
#include <hip/hip_cooperative_groups.h>
#include <cstdio>
#include <cstdint>
namespace cg = cooperative_groups;

#define LAS __attribute__((address_space(3)))
typedef unsigned short bf16_t;
typedef short bf16x8 __attribute__((ext_vector_type(8)));
typedef float f32x4 __attribute__((ext_vector_type(4)));
typedef float f32x2 __attribute__((ext_vector_type(2)));
typedef unsigned u32x4 __attribute__((ext_vector_type(4)));
typedef unsigned u32x2 __attribute__((ext_vector_type(2)));

constexpr int NB = 8, SEQ = 4096, D = 1024, NMETA = 16, LSEQ = SEQ + NMETA;
constexpr int NGRID = NB * SEQ;
constexpr int NTOK = NGRID + NB * NMETA;
constexpr int MPAD = 33024;
constexpr int NEXP = 32, TOPK = 4;
constexpr int PMAX = 139776;
constexpr int MTMAX = PMAX / 256;
constexpr float DN_ALPHA = 1.41421356237f;
constexpr float LN_EPS = 1e-5f;
constexpr int NTHREADS = 512, NWAVES = 8;

constexpr size_t MiB = 1u << 20;
constexpr size_t ACT_BYTES = (size_t)MPAD * D * 2;
constexpr size_t WS_CTL   = 0;
constexpr size_t WS_WIN   = 4 * MiB;
constexpr size_t WS_GATE  = WS_WIN + 4 * MiB;
constexpr size_t WS_LOUT  = WS_GATE + 2 * MiB;
constexpr size_t WS_QKV   = WS_LOUT + 2 * MiB;
constexpr size_t WS_NOUT  = WS_QKV + 6 * MiB;
constexpr size_t WS_WGU   = WS_NOUT + 2 * MiB;
constexpr size_t WS_WD    = WS_WGU + 256 * MiB;
constexpr size_t WS_HB    = WS_WD + 128 * MiB;
constexpr size_t WS_PRE   = WS_HB + 65 * MiB;
constexpr size_t WS_H     = WS_PRE + 129 * MiB;
constexpr size_t WS_SCR   = WS_H + 129 * MiB;
constexpr size_t WS_XR = WS_SCR, WS_XC = WS_XR + 65 * MiB, WS_GY = WS_XC + 65 * MiB, WS_LA = WS_GY + 65 * MiB, WS_BB = WS_LA + 130 * MiB, WS_HF = WS_BB + 130 * MiB, WS_G = WS_HF + 65 * MiB;
constexpr size_t WS_SCR_END0 = WS_G + 65 * MiB;
constexpr size_t WS_XS = WS_SCR, WS_ACT = WS_XS + 274 * MiB;
constexpr size_t WS_SCR_END1 = WS_ACT + 274 * MiB;
constexpr size_t WS_Q = WS_SCR, WS_K = WS_Q + 65 * MiB, WS_VT = WS_K + 65 * MiB, WS_O = WS_VT + 65 * MiB;
constexpr size_t WS_END = (WS_SCR_END0 > WS_SCR_END1 ? WS_SCR_END0 : WS_SCR_END1);
static_assert(ACT_BYTES <= 65 * MiB && (size_t)PMAX * D * 2 <= 274 * MiB && (size_t)MPAD * D * 4 <= 129 * MiB, "ws map");
static_assert(WS_END <= (size_t)2040 * MiB, "ws map must fit 4x the largest input tensor");
constexpr size_t CT_BC      = 4096;
constexpr size_t CT_TEXP    = CT_BC + 2 * 256 * 32 * 4;
constexpr size_t CT_SPL     = CT_TEXP + 2 * 1024 * 4;
constexpr size_t CT_EID     = 256 * 1024;
constexpr size_t CT_GATEV   = CT_EID + 2 * (size_t)NTOK * 4 * 4;
constexpr size_t CT_POS     = CT_GATEV + 2 * (size_t)NTOK * 4 * 4;
static_assert(CT_POS + 2 * (size_t)NTOK * 4 * 4 <= 4 * MiB, "ctl map");

constexpr int LDS_BYTES = 155648;

__device__ __forceinline__ unsigned f2bf(float f) { unsigned u = __builtin_bit_cast(unsigned, f); return (u + 0x7fffu + ((u >> 16) & 1u)) >> 16; }
__device__ __forceinline__ unsigned pk2(float lo, float hi) { return f2bf(lo) | (f2bf(hi) << 16); }
__device__ __forceinline__ unsigned cvt_pk_bf16(float lo, float hi) { unsigned r; asm volatile("v_cvt_pk_bf16_f32 %0, %1, %2" : "=v"(r) : "v"(lo), "v"(hi)); return r; }
__device__ __forceinline__ float bflo(unsigned w) { return __builtin_bit_cast(float, w << 16); }
__device__ __forceinline__ float bfhi(unsigned w) { return __builtin_bit_cast(float, w & 0xffff0000u); }
__device__ __forceinline__ float fast_exp2(float x) { return __builtin_amdgcn_exp2f(x); }
__device__ __forceinline__ float fast_rcp(float x) { return __builtin_amdgcn_rcpf(x); }
__device__ __forceinline__ float sigmoidf_(float x) { return fast_rcp(1.0f + fast_exp2(-1.44269504089f * x)); }
__device__ __forceinline__ float wave_sum(float v) {
#pragma unroll
    for (int o = 1; o < 64; o <<= 1) v += __shfl_xor(v, o);
    return v;
}
__device__ __forceinline__ int seqrow(int b, int s) { return s < NMETA ? NGRID + NMETA * b + s : SEQ * b + (s - NMETA); }

struct Params {
    const float* in[25];
    float* out;
    unsigned char* ws;
    int ph_lo, ph_hi;
};
struct Ctx {
    LAS unsigned char* lds;
    int tid, lane, wave, G, bid;
    unsigned char* ws;
    const float* const* in;
    float* out;
};
enum { I_X = 0, I_META, I_WIN, I_CONVW, I_CONVB, I_WA, I_BA, I_WX, I_BX, I_LAM, I_LOUT, I_WQKV, I_RPB, I_MBIAS, I_NOUT, I_LNMG, I_LNMB, I_RW, I_RB, I_WGU, I_BGU, I_WD, I_BD, I_LNFG, I_LNFB };

namespace pg8 {
constexpr int BM = 256, BK = 64, HALF = 128, HTB = HALF * BK * 2, STAGE_BYTES = 8 * HTB, NXCD = 8, WGM = 8;
__device__ __forceinline__ int lds_byte(int r, int c) { const int st = (r >> 4) * 2 + (c >> 5), rr = r & 15, cc = c & 31, ob = rr * 64 + cc * 2; return st * 1024 + (ob ^ (((ob >> 9) & 1) << 5)); }
__device__ __forceinline__ void stage_rc(int b, int& R, int& C) { const int st = b / 1024, sb = b % 1024, swz = sb ^ (((sb >> 9) & 1) << 5); R = (st >> 1) * 16 + swz / 64; C = (st & 1) * 32 + (swz % 64) / 2; }
__device__ __forceinline__ int perm32(int rho) { const int n = rho >> 4, i = rho & 15; return 8 * (i >> 2) + 4 * n + (i & 3); }

struct Unit { const char* Ab; const char* Bb; int pm, pn, aux; };

__device__ __forceinline__ void tile_of(int L, int nM, int nN, int& pm, int& pn) {
    const int nwg = nM * nN; int wgid = L;
    { const int q = nwg / NXCD, r = nwg % NXCD, xcd = wgid % NXCD, off = wgid / NXCD; wgid = (xcd < r ? xcd * (q + 1) : r * (q + 1) + (xcd - r) * q) + off; }
    const int nig = WGM * nN, gid = wgid / nig, fm = gid * WGM, gsz = (nM - fm) < WGM ? (nM - fm) : WGM;
    pm = fm + ((wgid % nig) % gsz); pn = (wgid % nig) / gsz;
}

template <class Epi, class Sched>
__device__ __forceinline__ void gemm_phase(LAS unsigned char* lds, const int K, const int lda, const int ldb, const Sched& S, const Epi& E) {
    const int tid = threadIdx.x, wid = __builtin_amdgcn_readfirstlane(tid >> 6), lane = tid & 63, wr = wid >> 2, wc = wid & 3, fr = lane & 15, fq = lane >> 4;
    const int nt = K / BK;
    unsigned voffA[2], voffB[2];
#pragma unroll
    for (int i = 0; i < 2; ++i) { int R, C; stage_rc(tid * 16 + i * 8192, R, C); const int Rb = Epi::PERM ? ((R & ~31) + perm32(R & 31)) : R;
        voffA[i] = (unsigned)(R * lda + C) * 2u; voffB[i] = (unsigned)(Rb * ldb + C) * 2u; }
    const size_t kstep = (size_t)(BK * 2);
    const size_t hstepA = (size_t)HALF * lda * 2, hstepB = (size_t)HALF * ldb * 2;
    const unsigned ldsw = (unsigned)wid * 1024u;
    const int aoff = lds_byte(wr * 64 + fr, fq * 8), boff = lds_byte(wc * 32 + fr, fq * 8);
#define PG8_SA(b, h) (((b) * 2 + (h)) * HTB)
#define PG8_SB(b, h) ((4 + (b) * 2 + (h)) * HTB)
#define PG8_STAGE(bufoff, gbase, voff) do { _Pragma("unroll") for (int _i = 0; _i < 2; ++_i) \
        __builtin_amdgcn_global_load_lds((const unsigned*)((const char*)(gbase) + (voff)[_i]), (LAS unsigned*)(lds + (bufoff) + ldsw + _i * 8192), 16, 0, 0); } while (0)
#define PG8_LDA(dst, b, h) do { _Pragma("unroll") for (int m = 0; m < 4; ++m) _Pragma("unroll") for (int k = 0; k < 2; ++k) dst[m][k] = *(const LAS bf16x8*)(lds + PG8_SA(b, h) + aoff + m * 2048 + k * 1024); } while (0)
#define PG8_LDB(dst, b, h) do { _Pragma("unroll") for (int n = 0; n < 2; ++n) _Pragma("unroll") for (int k = 0; k < 2; ++k) dst[n][k] = *(const LAS bf16x8*)(lds + PG8_SB(b, h) + boff + n * 2048 + k * 1024); } while (0)
#define PG8_MMA(ai, bj, At, Bt) do { __builtin_amdgcn_s_setprio(1); _Pragma("unroll") for (int m = 0; m < 4; ++m) _Pragma("unroll") for (int n = 0; n < 2; ++n) _Pragma("unroll") for (int k = 0; k < 2; ++k) \
        acc[ai][bj][m][n] = __builtin_amdgcn_mfma_f32_16x16x32_bf16(Bt[n][k], At[m][k], acc[ai][bj][m][n], 0, 0, 0); __builtin_amdgcn_s_setprio(0); } while (0)
#define PG8_WAIT_V(n) asm volatile("s_waitcnt vmcnt(" #n ")" ::: "memory")
#define PG8_WAIT_L(n) asm volatile("s_waitcnt lgkmcnt(" #n ")" ::: "memory")
#define PG8_BAR __builtin_amdgcn_s_barrier()
#define PG8_SCHED __builtin_amdgcn_sched_barrier(0)
    Unit cur, nxt; int ui = 0;
    if (!S.next(0, cur)) return;
    f32x4 acc[2][2][4][2];
#pragma unroll
    for (int a = 0; a < 2; ++a)
#pragma unroll
        for (int b = 0; b < 2; ++b)
#pragma unroll
            for (int m = 0; m < 4; ++m)
#pragma unroll
                for (int n = 0; n < 2; ++n) acc[a][b][m][n] = (f32x4){0.f, 0.f, 0.f, 0.f};
    bf16x8 At[4][2], B0[2][2], B1[2][2];
    const char* cA = cur.Ab; const char* cB = cur.Bb;
    PG8_STAGE(PG8_SB(0, 0), cB, voffB); PG8_STAGE(PG8_SB(0, 1), cB + hstepB, voffB); PG8_STAGE(PG8_SA(0, 0), cA, voffA); PG8_STAGE(PG8_SA(0, 1), cA + hstepA, voffA);
    if (wr == 1) PG8_BAR;
    PG8_WAIT_V(2); PG8_BAR;
    PG8_STAGE(PG8_SB(1, 0), cB + kstep, voffB); PG8_STAGE(PG8_SA(1, 0), cA + kstep, voffA); PG8_STAGE(PG8_SB(1, 1), cB + hstepB + kstep, voffB);
    PG8_WAIT_V(6); PG8_BAR;
    for (;;) {
        const bool has_next = S.next(ui + 1, nxt);
        const char* nA = has_next ? nxt.Ab : cA; const char* nB = has_next ? nxt.Bb : cB;
        for (int t = 0; t < nt; t += 2) {
            const bool last = (t == nt - 2);
            const char* a1 = cA + (size_t)(t + 1) * kstep;
            const char* a2 = last ? nA : cA + (size_t)(t + 2) * kstep; const char* b2 = last ? nB : cB + (size_t)(t + 2) * kstep;
            const char* a3 = a2 + kstep; const char* b3 = b2 + kstep;
            PG8_LDB(B0, 0, 0); PG8_LDB(B1, 0, 1); PG8_SCHED; PG8_LDA(At, 0, 0); PG8_STAGE(PG8_SA(1, 1), a1 + hstepA, voffA);
            PG8_WAIT_V(8); PG8_WAIT_L(0); PG8_BAR; PG8_MMA(0, 0, At, B0); PG8_MMA(0, 1, At, B1); PG8_BAR; PG8_SCHED;
            PG8_LDA(At, 0, 1); PG8_STAGE(PG8_SB(0, 0), b2, voffB); PG8_STAGE(PG8_SB(0, 1), b2 + hstepB, voffB); PG8_STAGE(PG8_SA(0, 0), a2, voffA);
            PG8_WAIT_V(8); PG8_WAIT_L(0); PG8_BAR; PG8_MMA(1, 0, At, B0); PG8_MMA(1, 1, At, B1); PG8_BAR; PG8_SCHED;
            PG8_LDB(B0, 1, 0); PG8_LDB(B1, 1, 1); PG8_SCHED; PG8_LDA(At, 1, 0); PG8_STAGE(PG8_SA(0, 1), a2 + hstepA, voffA);
            PG8_WAIT_V(8); PG8_WAIT_L(0); PG8_BAR; PG8_MMA(0, 0, At, B0); PG8_MMA(0, 1, At, B1); PG8_BAR; PG8_SCHED;
            PG8_LDA(At, 1, 1); PG8_STAGE(PG8_SB(1, 0), b3, voffB); PG8_STAGE(PG8_SB(1, 1), b3 + hstepB, voffB); PG8_STAGE(PG8_SA(1, 0), a3, voffA);
            PG8_WAIT_V(8); PG8_WAIT_L(0); PG8_BAR; PG8_MMA(1, 0, At, B0); PG8_MMA(1, 1, At, B1); PG8_BAR; PG8_SCHED;
        }
        if (wr == 0) PG8_BAR;
        E(acc, cur, wr, wc, fr, fq);
        if (!has_next) break;
#pragma unroll
        for (int a = 0; a < 2; ++a)
#pragma unroll
            for (int b = 0; b < 2; ++b)
#pragma unroll
                for (int m = 0; m < 4; ++m)
#pragma unroll
                    for (int n = 0; n < 2; ++n) acc[a][b][m][n] = (f32x4){0.f, 0.f, 0.f, 0.f};
        cur = nxt; cA = nA; cB = nB; ++ui;
        if (wr == 1) PG8_BAR;
    }
    PG8_WAIT_V(0);
    PG8_BAR;
#undef PG8_SA
#undef PG8_SB
#undef PG8_STAGE
#undef PG8_LDA
#undef PG8_LDB
#undef PG8_MMA
#undef PG8_WAIT_V
#undef PG8_WAIT_L
#undef PG8_BAR
#undef PG8_SCHED
}
}

using pg8::Unit;

struct DenseSched {
    const char* A; const char* Bt; int lda, ldb, nM, nN, G, c;
    __device__ __forceinline__ bool next(int i, Unit& u) const {
        const int L = i * G + c; if (L >= nM * nN) return false;
        pg8::tile_of(L, nM, nN, u.pm, u.pn); u.aux = 0;
        u.Ab = A + (size_t)u.pm * 256 * lda * 2; u.Bb = Bt + (size_t)u.pn * 256 * ldb * 2; return true;
    }
};
struct GateSched {
    const char* XC; const char* GT; int nM, G, c;
    __device__ __forceinline__ bool next(int i, Unit& u) const {
        const int per = nM * 4; const int L = i * G + c; if (L >= 4 * per) return false;
        const int nb = L / per; pg8::tile_of(L - nb * per, nM, 4, u.pm, u.pn); u.aux = nb;
        u.Ab = XC + ((size_t)u.pm * 256 * 1024 + 256 * nb) * 2; u.Bb = GT + ((size_t)nb * 1024 + 256 * u.pn) * 256 * 2; return true;
    }
};
struct QkvSched {
    const char* HB; const char* WT; int nM, G, c;
    __device__ __forceinline__ bool next(int i, Unit& u) const {
        const int n0 = nM * 8, n1 = 4 * nM; const int L = i * G + c; if (L >= n0 + n1) return false;
        if (L < n0) { pg8::tile_of(L, nM, 8, u.pm, u.pn); u.aux = 0; u.Ab = HB + (size_t)u.pm * 256 * 1024 * 2; u.Bb = WT + (size_t)u.pn * 256 * 1024 * 2; }
        else { pg8::tile_of(L - n0, 4, nM, u.pm, u.pn); u.aux = 1; u.Ab = WT + (size_t)(2048 + u.pm * 256) * 1024 * 2; u.Bb = HB + (size_t)u.pn * 256 * 1024 * 2; }
        return true;
    }
};
struct MoeSched {
    const char* A; const char* W; const int* texp; size_t wstride; int nM, nN, G, c;
    __device__ __forceinline__ bool next(int i, Unit& u) const {
        const int L = i * G + c; if (L >= nM * nN) return false;
        pg8::tile_of(L, nM, nN, u.pm, u.pn);
        const int e = __builtin_amdgcn_readfirstlane(__hip_atomic_load(texp + u.pm, __ATOMIC_RELAXED, __HIP_MEMORY_SCOPE_AGENT)); u.aux = e;
        u.Ab = A + (size_t)u.pm * 256 * 1024 * 2; u.Bb = W + (size_t)e * wstride + (size_t)u.pn * 256 * 1024 * 2; return true;
    }
};

#define EPI_ARGS const f32x4 (&acc)[2][2][4][2], const Unit& u, int wr, int wc, int fr, int fq
struct EpiWin {
    static constexpr bool PERM = true;
    bf16_t* XR; bf16_t* GY;
    __device__ __forceinline__ void operator()(EPI_ARGS) const {
        const int row0 = u.pm * 256 + wr * 64 + fr;
        if (u.pn < 4) {
            const int col0 = u.pn * 256 + wc * 32 + 8 * fq;
#pragma unroll
            for (int ai = 0; ai < 2; ++ai)
#pragma unroll
                for (int m = 0; m < 4; ++m) { bf16_t* rowp = XR + (size_t)(row0 + ai * 128 + m * 16) * D + col0;
#pragma unroll
                    for (int bj = 0; bj < 2; ++bj) { const f32x4 v0 = acc[ai][bj][m][0], v1 = acc[ai][bj][m][1];
                        u32x4 w; w.x = cvt_pk_bf16(v0[0], v0[1]); w.y = cvt_pk_bf16(v0[2], v0[3]); w.z = cvt_pk_bf16(v1[0], v1[1]); w.w = cvt_pk_bf16(v1[2], v1[3]);
                        *(u32x4*)(rowp + bj * 128) = w; } }
        } else {
#pragma unroll
            for (int ai = 0; ai < 2; ++ai)
#pragma unroll
                for (int m = 0; m < 4; ++m) { const int row = row0 + ai * 128 + m * 16;
#pragma unroll
                    for (int bj = 0; bj < 2; ++bj) { const int g = (u.pn - 4) * 8 + bj * 4 + wc;
                        float o[8];
#pragma unroll
                        for (int n = 0; n < 2; ++n)
#pragma unroll
                            for (int j = 0; j < 4; ++j) { const float v = acc[ai][bj][m][n][j]; const float z = 1.5957691216f * (v + 0.044715f * v * v * v); o[n * 4 + j] = v * sigmoidf_(z); }
                        u32x4 w; w.x = cvt_pk_bf16(o[0], o[1]); w.y = cvt_pk_bf16(o[2], o[3]); w.z = cvt_pk_bf16(o[4], o[5]); w.w = cvt_pk_bf16(o[6], o[7]);
                        *(u32x4*)(GY + ((size_t)g * MPAD + row) * 32 + 8 * fq) = w; } }
        }
    }
};
struct EpiGate {
    static constexpr bool PERM = true;
    const bf16_t* XC; bf16_t* LA; bf16_t* BB; const float* ba; const float* bx; const float* spl;
    __device__ __forceinline__ void operator()(EPI_ARGS) const {
        const int nb = u.aux, dir = u.pn >> 1, half = u.pn & 1;
        const int ch0 = 256 * nb + 128 * half + 32 * wc + 8 * fq, g = ch0 >> 5;
        const int row0 = u.pm * 256 + wr * 64 + fr;
#pragma unroll
        for (int ai = 0; ai < 2; ++ai)
#pragma unroll
            for (int m = 0; m < 4; ++m) { const int row = row0 + ai * 128 + m * 16;
                if (row < NTOK) {
                    float cba[8], cbx[8], csp[8];
                                { const f32x4 t0 = *(const f32x4*)(ba + dir * 1024 + ch0), t1 = *(const f32x4*)(ba + dir * 1024 + ch0 + 4);
                      const f32x4 s0 = *(const f32x4*)(bx + dir * 1024 + ch0), s1 = *(const f32x4*)(bx + dir * 1024 + ch0 + 4);
                      const f32x4 p0 = *(const f32x4*)(spl + dir * 1024 + ch0), p1 = *(const f32x4*)(spl + dir * 1024 + ch0 + 4);
#pragma unroll
                      for (int j = 0; j < 4; ++j) { cba[j] = t0[j]; cba[4 + j] = t1[j]; cbx[j] = s0[j]; cbx[4 + j] = s1[j]; csp[j] = p0[j]; csp[4 + j] = p1[j]; } }
                    const u32x4 xw = *(const u32x4*)(XC + (size_t)row * D + ch0);
                    float xc[8] = {bflo(xw.x), bfhi(xw.x), bflo(xw.y), bfhi(xw.y), bflo(xw.z), bfhi(xw.z), bflo(xw.w), bfhi(xw.w)};
                    const bool start = dir == 0 ? (row >= NGRID && ((row - NGRID) & 15) == 0) : (row < NGRID && (row & (SEQ - 1)) == SEQ - 1);
                    float la[8], bb[8];
#pragma unroll
                    for (int n = 0; n < 2; ++n)
#pragma unroll
                        for (int j = 0; j < 4; ++j) { const int i = n * 4 + j;
                            const float ga = sigmoidf_(acc[ai][0][m][n][j] + cba[i]), gx = sigmoidf_(acc[ai][1][m][n][j] + cbx[i]);
                            const float l2 = -csp[i] * ga;
                            const float a2 = fast_exp2(2.0f * l2);
                            const float mult = start ? 1.0f : __builtin_sqrtf(fmaxf(1.0f - a2, 0.0f));
                            la[i] = l2; bb[i] = mult * gx * xc[i]; }
                    u32x4 w; w.x = cvt_pk_bf16(la[0], la[1]); w.y = cvt_pk_bf16(la[2], la[3]); w.z = cvt_pk_bf16(la[4], la[5]); w.w = cvt_pk_bf16(la[6], la[7]);
                    const size_t o = (((size_t)dir * 32 + g) * MPAD + row) * 32 + 8 * fq;
                    *(u32x4*)(LA + o) = w;
                    w.x = cvt_pk_bf16(bb[0], bb[1]); w.y = cvt_pk_bf16(bb[2], bb[3]); w.z = cvt_pk_bf16(bb[4], bb[5]); w.w = cvt_pk_bf16(bb[6], bb[7]);
                    *(u32x4*)(BB + o) = w;
                }
                asm volatile("" ::: "memory"); }
    }
};
template <bool LAYER0> struct EpiRes {
    static constexpr bool PERM = false;
    float* PRE; const float* x; const float* meta; const float* H; int nrows;
    __device__ __forceinline__ void operator()(EPI_ARGS) const {
        const int row0 = u.pm * 256 + wr * 64 + fr, col0 = u.pn * 256 + wc * 32 + 4 * fq;
#pragma unroll
        for (int ai = 0; ai < 2; ++ai)
#pragma unroll
            for (int m = 0; m < 4; ++m) { const int row = row0 + ai * 128 + m * 16;
                if (row < nrows) {
                    const float* rp = LAYER0 ? (row < NGRID ? x + (size_t)row * D : meta + (size_t)((row - NGRID) & 15) * D) : H + (size_t)row * D;
#pragma unroll
                    for (int bj = 0; bj < 2; ++bj)
#pragma unroll
                        for (int n = 0; n < 2; ++n) { const int c = col0 + bj * 128 + n * 16; const f32x4 r = *(const f32x4*)(rp + c);
                            *(f32x4*)(PRE + (size_t)row * D + c) = r * DN_ALPHA + acc[ai][bj][m][n]; }
                }
                asm volatile("" ::: "memory"); }
    }
};
struct EpiGlu {
    static constexpr bool PERM = true;
    bf16_t* ACT; const float* bgu;
    __device__ __forceinline__ void operator()(EPI_ARGS) const {
        const int e = u.aux, f0 = 128 * u.pn + 32 * wc + 8 * fq;
        float bg[8], bl[8];
        { const float* p = bgu + (size_t)e * 2048 + f0; const f32x4 a0 = *(const f32x4*)p, a1 = *(const f32x4*)(p + 4), c0 = *(const f32x4*)(p + 1024), c1 = *(const f32x4*)(p + 1028);
#pragma unroll
          for (int j = 0; j < 4; ++j) { bg[j] = a0[j]; bg[4 + j] = a1[j]; bl[j] = c0[j]; bl[4 + j] = c1[j]; } }
        const int row0 = u.pm * 256 + wr * 64 + fr;
#pragma unroll
        for (int ai = 0; ai < 2; ++ai)
#pragma unroll
            for (int m = 0; m < 4; ++m) { const int row = row0 + ai * 128 + m * 16; float o[8];
#pragma unroll
                for (int n = 0; n < 2; ++n)
#pragma unroll
                    for (int j = 0; j < 4; ++j) { const int i = n * 4 + j;
                        const float glu = fminf(acc[ai][0][m][n][j] + bg[i], 7.0f);
                        const float lin = fminf(fmaxf(acc[ai][1][m][n][j] + bl[i], -7.0f), 7.0f);
                        o[i] = glu * sigmoidf_(1.702f * glu) * (lin + 1.0f); }
                u32x4 w; w.x = cvt_pk_bf16(o[0], o[1]); w.y = cvt_pk_bf16(o[2], o[3]); w.z = cvt_pk_bf16(o[4], o[5]); w.w = cvt_pk_bf16(o[6], o[7]);
                *(u32x4*)(ACT + (size_t)row * D + f0) = w; }
    }
};
struct EpiDown {
    static constexpr bool PERM = true;
    bf16_t* YS; const float* bd;
    __device__ __forceinline__ void operator()(EPI_ARGS) const {
        const int e = u.aux, row0 = u.pm * 256 + wr * 64 + fr, col0 = u.pn * 256 + wc * 32 + 8 * fq;
        f32x4 bv[2][2];
#pragma unroll
        for (int bj = 0; bj < 2; ++bj)
#pragma unroll
            for (int n = 0; n < 2; ++n) bv[bj][n] = *(const f32x4*)(bd + (size_t)e * D + col0 + bj * 128 + 4 * n);
#pragma unroll
        for (int ai = 0; ai < 2; ++ai)
#pragma unroll
            for (int m = 0; m < 4; ++m) { bf16_t* rowp = YS + (size_t)(row0 + ai * 128 + m * 16) * D + col0;
#pragma unroll
                for (int bj = 0; bj < 2; ++bj) { const f32x4 v0 = acc[ai][bj][m][0] + bv[bj][0], v1 = acc[ai][bj][m][1] + bv[bj][1];
                    u32x4 w; w.x = cvt_pk_bf16(v0[0], v0[1]); w.y = cvt_pk_bf16(v0[2], v0[3]); w.z = cvt_pk_bf16(v1[0], v1[1]); w.w = cvt_pk_bf16(v1[2], v1[3]);
                    *(u32x4*)(rowp + bj * 128) = w; } }
    }
};
struct EpiQkv {
    static constexpr bool PERM = true;
    bf16_t* Q; bf16_t* Kx; bf16_t* VT;
    __device__ __forceinline__ void operator()(EPI_ARGS) const {
        const int row0 = u.pm * 256 + wr * 64 + fr; bf16_t* base; int ldc, colt; float sc = 1.0f;
        if (u.aux == 0) { ldc = D; if (u.pn < 4) { base = Q; colt = u.pn * 256; sc = 0.125f; } else { base = Kx; colt = (u.pn - 4) * 256; } }
        else { base = VT; ldc = MPAD; colt = u.pn * 256; }
        const int col0 = colt + wc * 32 + 8 * fq;
#pragma unroll
        for (int ai = 0; ai < 2; ++ai)
#pragma unroll
            for (int m = 0; m < 4; ++m) { bf16_t* rowp = base + (size_t)(row0 + ai * 128 + m * 16) * ldc + col0;
#pragma unroll
                for (int bj = 0; bj < 2; ++bj) { const f32x4 v0 = acc[ai][bj][m][0] * sc, v1 = acc[ai][bj][m][1] * sc;
                    u32x4 w; w.x = cvt_pk_bf16(v0[0], v0[1]); w.y = cvt_pk_bf16(v0[2], v0[3]); w.z = cvt_pk_bf16(v1[0], v1[1]); w.w = cvt_pk_bf16(v1[2], v1[3]);
                    *(u32x4*)(rowp + bj * 128) = w; } }
    }
};

__device__ __forceinline__ void tr_item(const float* W, int ld, int kb, int n0, bf16_t* dst0, int K, LAS float* scr, int lane) {
    const int r = lane >> 4, q = lane & 15;
    f32x4 v[16];
#pragma unroll
    for (int i = 0; i < 16; ++i) v[i] = *(const f32x4*)(W + (size_t)(64 * kb + 4 * i + r) * ld + n0 + 4 * q);
#pragma unroll
    for (int i = 0; i < 16; ++i) { LAS float* s = scr + (4 * i + r) * 65 + 4 * q; s[0] = v[i][0]; s[1] = v[i][1]; s[2] = v[i][2]; s[3] = v[i][3]; }
    asm volatile("s_waitcnt lgkmcnt(0)" ::: "memory");
    const int c = lane & 7, nn = lane >> 3;
#pragma unroll
    for (int j = 0; j < 8; ++j) { const int n = nn + 8 * j; const LAS float* s = scr + (8 * c) * 65 + n;
        u32x4 o; o.x = pk2(s[0], s[65]); o.y = pk2(s[2 * 65], s[3 * 65]); o.z = pk2(s[4 * 65], s[5 * 65]); o.w = pk2(s[6 * 65], s[7 * 65]);
        *(u32x4*)(dst0 + (size_t)n * K + 64 * kb + 8 * c) = o; }
    asm volatile("s_waitcnt lgkmcnt(0)" ::: "memory");
}
__device__ __forceinline__ void phase_convert(const Ctx& C) {
    LAS float* scr = (LAS float*)(C.lds + C.wave * 16640);
    const int gw = C.bid * NWAVES + C.wave, NGW = C.G * NWAVES, lane = C.lane;
    constexpr int I0 = 512, I1 = 256, I2 = 256, I3 = 768, I4 = 256, I5 = 32768, I6 = 16384, NIT = I0 + I1 + I2 + I3 + I4 + I5 + I6;
    for (int it = gw; it < NIT; it += NGW) {
        int r = it;
        if (r < I0) { const int nbk = r & 31, kb = r >> 5; tr_item(C.in[I_WIN], 2048, kb, 64 * nbk, (bf16_t*)(C.ws + WS_WIN) + (size_t)(64 * nbk) * 1024, 1024, scr, lane); continue; } r -= I0;
        if (r < I1) { const int job = r >> 3, sub = r & 7, nbk = sub & 1, kb = sub >> 1;
            const int half = job & 1, which = (job >> 1) & 1, nb = (job >> 2) & 3, dir = job >> 4;
            const float* src = C.in[which ? I_WX : I_WA] + (size_t)(dir * 4 + nb) * 65536;
            bf16_t* dst = (bf16_t*)(C.ws + WS_GATE) + ((size_t)nb * 1024 + 256 * (2 * dir + half) + 128 * which + 64 * nbk) * 256;
            tr_item(src, 256, kb, 128 * half + 64 * nbk, dst, 256, scr, lane); continue; } r -= I1;
        if (r < I2) { const int nbk = r & 15, kb = r >> 4; tr_item(C.in[I_LOUT], 1024, kb, 64 * nbk, (bf16_t*)(C.ws + WS_LOUT) + (size_t)(64 * nbk) * 1024, 1024, scr, lane); continue; } r -= I2;
        if (r < I3) { const int nbk = r % 48, kb = r / 48; tr_item(C.in[I_WQKV], 3072, kb, 64 * nbk, (bf16_t*)(C.ws + WS_QKV) + (size_t)(64 * nbk) * 1024, 1024, scr, lane); continue; } r -= I3;
        if (r < I4) { const int nbk = r & 15, kb = r >> 4; tr_item(C.in[I_NOUT], 1024, kb, 64 * nbk, (bf16_t*)(C.ws + WS_NOUT) + (size_t)(64 * nbk) * 1024, 1024, scr, lane); continue; } r -= I4;
        if (r < I5) { const int mat = r >> 9, sub = r & 511, nbk = sub & 31, kb = sub >> 5; const int n0 = 64 * nbk, bj = n0 >> 10, f0 = n0 & 1023, pn = f0 >> 7, jj = f0 & 127;
            tr_item(C.in[I_WGU] + (size_t)mat * 1024 * 2048, 2048, kb, n0, (bf16_t*)(C.ws + WS_WGU) + ((size_t)mat * 2048 + 256 * pn + 128 * bj + jj) * 1024, 1024, scr, lane); continue; } r -= I5;
        { const int mat = r >> 8, sub = r & 255, nbk = sub & 15, kb = sub >> 4;
            tr_item(C.in[I_WD] + (size_t)mat * 1024 * 1024, 1024, kb, 64 * nbk, (bf16_t*)(C.ws + WS_WD) + ((size_t)mat * 1024 + 64 * nbk) * 1024, 1024, scr, lane); }
    }
    const int gt = C.bid * NTHREADS + C.tid, NGT = C.G * NTHREADS;
    for (int i = gt; i < 2048; i += NGT) ((float*)(C.ws + WS_CTL + CT_SPL))[i] = 8.0f * 1.44269504089f * log1pf(expf(-C.in[I_LAM][i]));
    for (int i = gt; i < NTOK * 128; i += NGT) { const int row = i >> 7, oc = i & 127;
        const float* src = (row < NGRID ? C.in[I_X] + (size_t)row * D : C.in[I_META] + (size_t)((row - NGRID) & 15) * D) + 8 * oc;
        const f32x4 a = *(const f32x4*)src, b = *(const f32x4*)(src + 4);
        u32x4 w; w.x = pk2(a[0], a[1]); w.y = pk2(a[2], a[3]); w.z = pk2(b[0], b[1]); w.w = pk2(b[2], b[3]);
        *(u32x4*)((bf16_t*)(C.ws + WS_HB) + (size_t)row * D + 8 * oc) = w; }
}

__device__ __forceinline__ void phase_conv(const Ctx& C) {
    const bf16_t* XR = (const bf16_t*)(C.ws + WS_XR); bf16_t* XC = (bf16_t*)(C.ws + WS_XC);
    const float* cw = C.in[I_CONVW]; const float* cb = C.in[I_CONVB];
    const int gt = C.bid * NTHREADS + C.tid, NGT = C.G * NTHREADS;
    for (int i = gt; i < NTOK * 128; i += NGT) { const int row = i >> 7, ch = 8 * (i & 127);
        int b, s; if (row < NGRID) { b = row >> 12; s = NMETA + (row & (SEQ - 1)); } else { b = (row - NGRID) >> 4; s = (row - NGRID) & 15; }
        float a[8];
        { const f32x4 t0 = *(const f32x4*)(cb + ch), t1 = *(const f32x4*)(cb + ch + 4);
#pragma unroll
          for (int j = 0; j < 4; ++j) { a[j] = t0[j]; a[4 + j] = t1[j]; } }
#pragma unroll
        for (int j = 0; j < 4; ++j) { const int sj = s - 2 + j;
            if (sj >= 0 && sj < LSEQ) { const u32x4 xw = *(const u32x4*)(XR + (size_t)seqrow(b, sj) * D + ch);
                const f32x4 w0 = *(const f32x4*)(cw + j * 1024 + ch), w1 = *(const f32x4*)(cw + j * 1024 + ch + 4);
                a[0] += w0[0] * bflo(xw.x); a[1] += w0[1] * bfhi(xw.x); a[2] += w0[2] * bflo(xw.y); a[3] += w0[3] * bfhi(xw.y);
                a[4] += w1[0] * bflo(xw.z); a[5] += w1[1] * bfhi(xw.z); a[6] += w1[2] * bflo(xw.w); a[7] += w1[3] * bfhi(xw.w); } }
        u32x4 w; w.x = pk2(a[0], a[1]); w.y = pk2(a[2], a[3]); w.z = pk2(a[4], a[5]); w.w = pk2(a[6], a[7]);
        *(u32x4*)(XC + (size_t)row * D + ch) = w; }
}

template <int N> __device__ __forceinline__ float dpp_shr(float oldv, float v) {
    return __builtin_bit_cast(float, __builtin_amdgcn_update_dpp(__builtin_bit_cast(int, oldv), __builtin_bit_cast(int, v), 0x110 + N, 0xf, 0xf, false));
}
__device__ __forceinline__ void scan_group(float (&a)[8], float (&b)[8]) {
#pragma unroll
    for (int c = 0; c < 8; ++c) {
        { const float ap = dpp_shr<1>(1.0f, a[c]), bp = dpp_shr<1>(0.0f, b[c]); b[c] = a[c] * bp + b[c]; a[c] = a[c] * ap; }
        { const float ap = dpp_shr<2>(1.0f, a[c]), bp = dpp_shr<2>(0.0f, b[c]); b[c] = a[c] * bp + b[c]; a[c] = a[c] * ap; }
        { const float ap = dpp_shr<4>(1.0f, a[c]), bp = dpp_shr<4>(0.0f, b[c]); b[c] = a[c] * bp + b[c]; a[c] = a[c] * ap; }
        { const float ap = dpp_shr<8>(1.0f, a[c]), bp = dpp_shr<8>(0.0f, b[c]); b[c] = a[c] * bp + b[c]; a[c] = a[c] * ap; }
    }
}
__device__ __forceinline__ void unpack8(const u32x4 w, float (&o)[8]) { o[0] = bflo(w.x); o[1] = bfhi(w.x); o[2] = bflo(w.y); o[3] = bfhi(w.y); o[4] = bflo(w.z); o[5] = bfhi(w.z); o[6] = bflo(w.w); o[7] = bfhi(w.w); }
__device__ __forceinline__ void phase_scan(const Ctx& C) {
    const bf16_t* LA = (const bf16_t*)(C.ws + WS_LA); const bf16_t* BB = (const bf16_t*)(C.ws + WS_BB); const bf16_t* GY = (const bf16_t*)(C.ws + WS_GY);
    bf16_t* HF = (bf16_t*)(C.ws + WS_HF); bf16_t* Gout = (bf16_t*)(C.ws + WS_G);
    LAS float* agg = (LAS float*)C.lds;
    const int lane = C.lane, w = C.wave, oct = lane >> 4, p = lane & 15;
    for (int item = C.bid; item < NB * 32; item += C.G) {
        const int b = item >> 5, g = item & 31;
        for (int dir = 0; dir < 2; ++dir) {
            const bf16_t* la = LA + (((size_t)dir * 32 + g) * MPAD) * 32 + 8 * oct;
            const bf16_t* bb = BB + (((size_t)dir * 32 + g) * MPAD) * 32 + 8 * oct;
            float S[8];
#pragma unroll
            for (int c = 0; c < 8; ++c) S[c] = 0.f;
            {
                const int u = p, s = dir ? LSEQ - 1 - u : u, row = seqrow(b, s);
                float a[8], x[8]; unpack8(*(const u32x4*)(la + (size_t)row * 32), a); unpack8(*(const u32x4*)(bb + (size_t)row * 32), x);
#pragma unroll
                for (int c = 0; c < 8; ++c) a[c] = fast_exp2(a[c]);
                scan_group(a, x);
                if (w == 0) {
                    if (dir == 0) { u32x4 o; o.x = pk2(x[0], x[1]); o.y = pk2(x[2], x[3]); o.z = pk2(x[4], x[5]); o.w = pk2(x[6], x[7]); *(u32x4*)(HF + ((size_t)g * MPAD + row) * 32 + 8 * oct) = o; }
                    else { float hf[8], gy[8]; unpack8(*(const u32x4*)(HF + ((size_t)g * MPAD + row) * 32 + 8 * oct), hf); unpack8(*(const u32x4*)(GY + ((size_t)g * MPAD + row) * 32 + 8 * oct), gy);
                        u32x4 o; o.x = pk2((hf[0] + x[0]) * gy[0], (hf[1] + x[1]) * gy[1]); o.y = pk2((hf[2] + x[2]) * gy[2], (hf[3] + x[3]) * gy[3]);
                        o.z = pk2((hf[4] + x[4]) * gy[4], (hf[5] + x[5]) * gy[5]); o.w = pk2((hf[6] + x[6]) * gy[6], (hf[7] + x[7]) * gy[7]);
                        *(u32x4*)(Gout + (size_t)row * D + 32 * g + 8 * oct) = o; }
                }
#pragma unroll
                for (int c = 0; c < 8; ++c) S[c] = __shfl(x[c], (lane & 48) | 15);
            }
            for (int r = 0; r < 8; ++r) {
                float Pw[4][8], Hw[4][8]; int rows[4];
                float Aw[8], Hc[8];
#pragma unroll
                for (int c = 0; c < 8; ++c) { Aw[c] = 1.f; Hc[c] = 0.f; }
                u32x4 ra[4], rb[4];
#pragma unroll
                for (int j = 0; j < 4; ++j) { const int u = 16 + 512 * r + 64 * w + 16 * j + p, s = dir ? LSEQ - 1 - u : u; rows[j] = seqrow(b, s);
                    ra[j] = *(const u32x4*)(la + (size_t)rows[j] * 32); rb[j] = *(const u32x4*)(bb + (size_t)rows[j] * 32); }
#pragma unroll
                for (int j = 0; j < 4; ++j) {
                    float a[8], x[8]; unpack8(ra[j], a); unpack8(rb[j], x);
#pragma unroll
                    for (int c = 0; c < 8; ++c) a[c] = fast_exp2(a[c]);
                    scan_group(a, x);
#pragma unroll
                    for (int c = 0; c < 8; ++c) { Hw[j][c] = a[c] * Hc[c] + x[c]; Pw[j][c] = a[c] * Aw[c]; }
#pragma unroll
                    for (int c = 0; c < 8; ++c) { Aw[c] = __shfl(Pw[j][c], (lane & 48) | 15); Hc[c] = __shfl(Hw[j][c], (lane & 48) | 15); }
                }
                LAS float* ag = agg + (r & 1) * 512;
                if (p == 0) {
#pragma unroll
                    for (int c = 0; c < 8; ++c) { ag[(w * 32 + oct * 8 + c) * 2] = Aw[c]; ag[(w * 32 + oct * 8 + c) * 2 + 1] = Hc[c]; }
                }
                __syncthreads();
                float Sin[8];
#pragma unroll
                for (int c = 0; c < 8; ++c) Sin[c] = S[c];
#pragma unroll
                for (int ww = 0; ww < 8; ++ww) {
#pragma unroll
                    for (int c = 0; c < 8; ++c) { const float A = ag[(ww * 32 + oct * 8 + c) * 2], H = ag[(ww * 32 + oct * 8 + c) * 2 + 1];
                        if (ww == w) Sin[c] = S[c];
                        S[c] = A * S[c] + H; }
                }
#pragma unroll
                for (int j = 0; j < 4; ++j) {
                    float h[8];
#pragma unroll
                    for (int c = 0; c < 8; ++c) h[c] = Pw[j][c] * Sin[c] + Hw[j][c];
                    const size_t go = ((size_t)g * MPAD + rows[j]) * 32 + 8 * oct;
                    if (dir == 0) { u32x4 o; o.x = pk2(h[0], h[1]); o.y = pk2(h[2], h[3]); o.z = pk2(h[4], h[5]); o.w = pk2(h[6], h[7]); *(u32x4*)(HF + go) = o; }
                    else { float hf[8], gy[8]; unpack8(*(const u32x4*)(HF + go), hf); unpack8(*(const u32x4*)(GY + go), gy);
                        u32x4 o; o.x = pk2((hf[0] + h[0]) * gy[0], (hf[1] + h[1]) * gy[1]); o.y = pk2((hf[2] + h[2]) * gy[2], (hf[3] + h[3]) * gy[3]);
                        o.z = pk2((hf[4] + h[4]) * gy[4], (hf[5] + h[5]) * gy[5]); o.w = pk2((hf[6] + h[6]) * gy[6], (hf[7] + h[7]) * gy[7]);
                        *(u32x4*)(Gout + (size_t)rows[j] * D + 32 * g + 8 * oct) = o; }
                }
            }
            __syncthreads();
        }
    }
}

constexpr int RWT_PITCH = 1028;
__device__ __forceinline__ void phase_lnr(const Ctx& C, int layer, int nrows) {
    const float* PRE = (const float*)(C.ws + WS_PRE); float* H = (float*)(C.ws + WS_H); bf16_t* HB = (bf16_t*)(C.ws + WS_HB);
    const float* lg = C.in[I_LNMG] + layer * D; const float* lb = C.in[I_LNMB] + layer * D;
    const float* rw = C.in[I_RW] + (size_t)layer * D * NEXP; const float* rb = C.in[I_RB] + layer * NEXP;
    int* eid = (int*)(C.ws + WS_CTL + CT_EID) + (size_t)layer * NTOK * 4; float* gatev = (float*)(C.ws + WS_CTL + CT_GATEV) + (size_t)layer * NTOK * 4;
    unsigned* bc = (unsigned*)(C.ws + WS_CTL + CT_BC) + ((size_t)layer * 256 + C.bid) * 32;
    LAS float* RWt = (LAS float*)C.lds; LAS unsigned* hist = (LAS unsigned*)(C.lds + 32 * RWT_PITCH * 4);
    const int lane = C.lane;
    for (int idx = C.tid; idx < D * NEXP; idx += NTHREADS) RWt[(idx & 31) * RWT_PITCH + (idx >> 5)] = rw[idx];
    if (C.tid < 32) hist[C.tid] = 0u;
    __syncthreads();
    f32x4 gg[4], gb[4];
#pragma unroll
    for (int j = 0; j < 4; ++j) { gg[j] = *(const f32x4*)(lg + 4 * lane + 256 * j); gb[j] = *(const f32x4*)(lb + 4 * lane + 256 * j); }
    const float rbias = rb[lane >> 1];
    const int gw = C.bid * NWAVES + C.wave, NGW = C.G * NWAVES;
    for (int row = gw; row < nrows; row += NGW) {
        f32x4 v[4]; float s = 0.f;
#pragma unroll
        for (int j = 0; j < 4; ++j) { v[j] = *(const f32x4*)(PRE + (size_t)row * D + 4 * lane + 256 * j); s += (v[j][0] + v[j][1]) + (v[j][2] + v[j][3]); }
        const float mean = wave_sum(s) * (1.0f / D); float q = 0.f;
#pragma unroll
        for (int j = 0; j < 4; ++j) { v[j] = v[j] - mean; q += (v[j][0] * v[j][0] + v[j][1] * v[j][1]) + (v[j][2] * v[j][2] + v[j][3] * v[j][3]); }
        const float rstd = 1.0f / sqrtf(wave_sum(q) * (1.0f / D) + LN_EPS);
#pragma unroll
        for (int j = 0; j < 4; ++j) { v[j] = v[j] * rstd * gg[j] + gb[j];
            *(f32x4*)(H + (size_t)row * D + 4 * lane + 256 * j) = v[j];
            u32x2 w; w.x = pk2(v[j][0], v[j][1]); w.y = pk2(v[j][2], v[j][3]); *(u32x2*)(HB + (size_t)row * D + 4 * lane + 256 * j) = w; }
        float pl[32];
#pragma unroll
        for (int e = 0; e < 32; ++e) { float a = 0.f;
#pragma unroll
            for (int j = 0; j < 4; ++j) { const f32x4 wv = *(const LAS f32x4*)(RWt + e * RWT_PITCH + 4 * lane + 256 * j); a += (v[j][0] * wv[0] + v[j][1] * wv[1]) + (v[j][2] * wv[2] + v[j][3] * wv[3]); }
            pl[e] = a; }
        float q16[16], q8[8], q4[4], q2[2], q1;
        { const bool hi = (lane & 32) != 0;
#pragma unroll
          for (int e = 0; e < 16; ++e) { const float mine = hi ? pl[16 + e] : pl[e], other = hi ? pl[e] : pl[16 + e]; q16[e] = mine + __shfl_xor(other, 32); } }
        { const bool hi = (lane & 16) != 0;
#pragma unroll
          for (int e = 0; e < 8; ++e) { const float mine = hi ? q16[8 + e] : q16[e], other = hi ? q16[e] : q16[8 + e]; q8[e] = mine + __shfl_xor(other, 16); } }
        { const bool hi = (lane & 8) != 0;
#pragma unroll
          for (int e = 0; e < 4; ++e) { const float mine = hi ? q8[4 + e] : q8[e], other = hi ? q8[e] : q8[4 + e]; q4[e] = mine + __shfl_xor(other, 8); } }
        { const bool hi = (lane & 4) != 0;
#pragma unroll
          for (int e = 0; e < 2; ++e) { const float mine = hi ? q4[2 + e] : q4[e], other = hi ? q4[e] : q4[2 + e]; q2[e] = mine + __shfl_xor(other, 4); } }
        { const bool hi = (lane & 2) != 0; const float mine = hi ? q2[1] : q2[0], other = hi ? q2[0] : q2[1]; q1 = mine + __shfl_xor(other, 2); }
        q1 += __shfl_xor(q1, 1);
        float lv = q1 + rbias; const int le = lane >> 1;
        float tv[4]; int te[4];
#pragma unroll
        for (int k = 0; k < 4; ++k) { float bv = lv; int be = le;
#pragma unroll
            for (int o = 1; o < 64; o <<= 1) { const float ov = __shfl_xor(bv, o); const int oe = __shfl_xor(be, o); if (ov > bv || (ov == bv && oe < be)) { bv = ov; be = oe; } }
            tv[k] = bv; te[k] = be; if (le == be) lv = -3.0e38f; }
        const float e1 = __expf(tv[1] - tv[0]), e2 = __expf(tv[2] - tv[0]), e3 = __expf(tv[3] - tv[0]); const float inv = 1.0f / (1.0f + e1 + e2 + e3);
        if (lane < 4) { const int ek = lane == 0 ? te[0] : lane == 1 ? te[1] : lane == 2 ? te[2] : te[3]; const float gk = (lane == 0 ? 1.0f : lane == 1 ? e1 : lane == 2 ? e2 : e3) * inv;
            eid[(size_t)row * 4 + lane] = ek; gatev[(size_t)row * 4 + lane] = gk; __hip_atomic_fetch_add(&hist[ek], 1u, __ATOMIC_RELAXED, __HIP_MEMORY_SCOPE_WORKGROUP); }
    }
    __syncthreads();
    if (C.tid < 32) bc[C.tid] = hist[C.tid];
}

__device__ __forceinline__ void phase_pos(const Ctx& C, int layer, int nrows) {
    const unsigned* bcAll = (const unsigned*)(C.ws + WS_CTL + CT_BC) + (size_t)layer * 256 * 32;
    const int* eid = (const int*)(C.ws + WS_CTL + CT_EID) + (size_t)layer * NTOK * 4; int* posv = (int*)(C.ws + WS_CTL + CT_POS) + (size_t)layer * NTOK * 4;
    int* texp = (int*)(C.ws + WS_CTL + CT_TEXP) + layer * 1024;
    const bf16_t* HB = (const bf16_t*)(C.ws + WS_HB); bf16_t* XS = (bf16_t*)(C.ws + WS_XS);
    LAS unsigned* partT = (LAS unsigned*)C.lds; LAS unsigned* partP = partT + 512; LAS unsigned* tot = partP + 512; LAS unsigned* cnt = tot + 32;
    const int lane = C.lane;
    { const int e = C.tid & 31, part = C.tid >> 5; unsigned t = 0, pr = 0;
      for (int bq = part; bq < C.G; bq += 16) { const unsigned v = __hip_atomic_load(bcAll + (size_t)bq * 32 + e, __ATOMIC_RELAXED, __HIP_MEMORY_SCOPE_AGENT); t += v; if (bq < C.bid) pr += v; }
      partT[part * 32 + e] = t; partP[part * 32 + e] = pr; }
    __syncthreads();
    if (C.tid < 32) { unsigned t = 0, pr = 0; for (int i = 0; i < 16; ++i) { t += partT[i * 32 + C.tid]; pr += partP[i * 32 + C.tid]; } tot[C.tid] = t; cnt[C.tid] = pr; }
    __syncthreads();
    if (C.tid < 32) { unsigned off = 0; for (int e = 0; e < C.tid; ++e) off += (tot[e] + 255u) & ~255u;
        const unsigned mine = (tot[C.tid] + 255u) & ~255u;
        if (C.bid == 0) { for (unsigned t = off >> 8; t < ((off + mine) >> 8); ++t) texp[t] = C.tid; if (C.tid == 31) texp[1023] = (int)((off + mine) >> 8); }
        cnt[C.tid] += off; }
    __syncthreads();
    const int gw = C.bid * NWAVES + C.wave, NGW = C.G * NWAVES;
    for (int row = gw; row < nrows; row += NGW) {
        int pos = 0;
        if (lane < 4) { const int e = eid[(size_t)row * 4 + lane]; pos = (int)__hip_atomic_fetch_add(&cnt[e], 1u, __ATOMIC_RELAXED, __HIP_MEMORY_SCOPE_WORKGROUP); posv[(size_t)row * 4 + lane] = pos; }
        const u32x4 r0 = *(const u32x4*)(HB + (size_t)row * D + 8 * lane), r1 = *(const u32x4*)(HB + (size_t)row * D + 512 + 8 * lane);
#pragma unroll
        for (int k = 0; k < 4; ++k) { const int pk = __shfl(pos, k); *(u32x4*)(XS + (size_t)pk * D + 8 * lane) = r0; *(u32x4*)(XS + (size_t)pk * D + 512 + 8 * lane) = r1; }
    }
}

__device__ __forceinline__ void phase_combine(const Ctx& C, int layer, int nrows, bool final_out) {
    float* H = (float*)(C.ws + WS_H); bf16_t* HB = (bf16_t*)(C.ws + WS_HB); const bf16_t* YS = (const bf16_t*)(C.ws + WS_XS);
    const float* lg = C.in[I_LNFG] + layer * D; const float* lb = C.in[I_LNFB] + layer * D;
    const float* gatev = (const float*)(C.ws + WS_CTL + CT_GATEV) + (size_t)layer * NTOK * 4; const int* posv = (const int*)(C.ws + WS_CTL + CT_POS) + (size_t)layer * NTOK * 4;
    const int lane = C.lane;
    f32x4 gg[4], gb[4];
#pragma unroll
    for (int j = 0; j < 4; ++j) { gg[j] = *(const f32x4*)(lg + 4 * lane + 256 * j); gb[j] = *(const f32x4*)(lb + 4 * lane + 256 * j); }
    const int gw = C.bid * NWAVES + C.wave, NGW = C.G * NWAVES;
    for (int row = gw; row < nrows; row += NGW) {
        f32x4 v[4];
#pragma unroll
        for (int j = 0; j < 4; ++j) v[j] = *(const f32x4*)(H + (size_t)row * D + 4 * lane + 256 * j) * DN_ALPHA;
#pragma unroll
        for (int k = 0; k < 4; ++k) { const float gk = gatev[(size_t)row * 4 + k]; const int pk = posv[(size_t)row * 4 + k];
#pragma unroll
            for (int j = 0; j < 4; ++j) { const u32x2 w = *(const u32x2*)(YS + (size_t)pk * D + 4 * lane + 256 * j);
                v[j][0] += gk * bflo(w.x); v[j][1] += gk * bfhi(w.x); v[j][2] += gk * bflo(w.y); v[j][3] += gk * bfhi(w.y); } }
        float s = 0.f;
#pragma unroll
        for (int j = 0; j < 4; ++j) s += (v[j][0] + v[j][1]) + (v[j][2] + v[j][3]);
        const float mean = wave_sum(s) * (1.0f / D); float q = 0.f;
#pragma unroll
        for (int j = 0; j < 4; ++j) { v[j] = v[j] - mean; q += (v[j][0] * v[j][0] + v[j][1] * v[j][1]) + (v[j][2] * v[j][2] + v[j][3] * v[j][3]); }
        const float rstd = 1.0f / sqrtf(wave_sum(q) * (1.0f / D) + LN_EPS);
#pragma unroll
        for (int j = 0; j < 4; ++j) { v[j] = v[j] * rstd * gg[j] + gb[j];
            if (final_out) *(f32x4*)(C.out + (size_t)row * D + 4 * lane + 256 * j) = v[j];
            else { *(f32x4*)(H + (size_t)row * D + 4 * lane + 256 * j) = v[j];
                u32x2 w; w.x = pk2(v[j][0], v[j][1]); w.y = pk2(v[j][2], v[j][3]); *(u32x2*)(HB + (size_t)row * D + 4 * lane + 256 * j) = w; } }
    }
}

constexpr int AT_KS = 0, AT_VTS = 73728, AT_VPITCH = 1168, AT_KM = AT_VTS + 64 * AT_VPITCH, AT_VTM = AT_KM + 2048, AT_RPB = AT_VTM + 2048, AT_MB = AT_RPB + 1920, AT_END = AT_MB + 64;
static_assert(AT_END <= LDS_BYTES, "attention LDS map");
__device__ __forceinline__ void phase_attn(const Ctx& C) {
    const bf16_t* Q = (const bf16_t*)(C.ws + WS_Q); const bf16_t* Kx = (const bf16_t*)(C.ws + WS_K); const bf16_t* VT = (const bf16_t*)(C.ws + WS_VT); bf16_t* O = (bf16_t*)(C.ws + WS_O);
    const float* rpb = C.in[I_RPB]; const float* mbias = C.in[I_MBIAS];
    LAS unsigned char* lds = C.lds;
    const int tid = C.tid, lane = C.lane, w = C.wave, lq = lane & 15, g = lane >> 4;
    for (int unit = C.bid; unit < NB * 16 * 32; unit += C.G) {
        const int rp = unit & 31, h = (unit >> 5) & 15, b = unit >> 9;
        const int R0 = min(max(2 * rp - 4, 0), 55);
        __syncthreads();
#pragma unroll
        for (int i = 0; i < 9; ++i) { const int idx = tid + 512 * i, ch = idx & 7, kc = (idx >> 3) & 63, jr = idx >> 9;
            const u32x4 v = *(const u32x4*)(Kx + (size_t)(b * SEQ + (R0 + jr) * 64 + kc) * D + 64 * h + 8 * ch);
            *(LAS u32x4*)(lds + AT_KS + ((jr * 64 + kc) * 8 + (ch ^ (kc & 7))) * 16) = v; }
#pragma unroll
        for (int i = 0; i < 9; ++i) { const int idx = tid + 512 * i, d = idx / 72, cx = idx - d * 72;
            const u32x4 v = *(const u32x4*)(VT + (size_t)(64 * h + d) * MPAD + b * SEQ + R0 * 64 + 8 * cx);
            *(LAS u32x4*)(lds + AT_VTS + d * AT_VPITCH + cx * 16) = v; }
        if (tid < 128) { const int m = tid >> 3, ch = tid & 7;
            const u32x4 v = *(const u32x4*)(Kx + (size_t)(NGRID + 16 * b + m) * D + 64 * h + 8 * ch);
            *(LAS u32x4*)(lds + AT_KM + (m * 8 + (ch ^ (m & 7))) * 16) = v; }
        else if (tid < 256) { const int i = tid - 128, d = i >> 1, hf = i & 1;
            const u32x4 v = *(const u32x4*)(VT + (size_t)(64 * h + d) * MPAD + NGRID + 16 * b + 8 * hf);
            *(LAS u32x4*)(lds + AT_VTM + d * 32 + hf * 16) = v; }
        if (tid < 465) ((LAS float*)(lds + AT_RPB))[tid] = rpb[h * 465 + tid];
        if (tid < 16) ((LAS float*)(lds + AT_MB))[tid] = mbias[h * 16 + tid];
        __syncthreads();
        const int qr = w >> 2, qg = w & 3, r = 2 * rp + qr, c0 = 16 * qg;
        const int rs = min(max(r - 4, 0), 56), jr0 = rs - R0;
        const int kcb = qg == 0 ? 0 : (qg == 1 ? 8 : (qg == 2 ? 24 : 32));
        const size_t qrow = (size_t)(b * SEQ + r * 64 + c0 + lq);
        bf16x8 qf[2];
#pragma unroll
        for (int ks = 0; ks < 2; ++ks) qf[ks] = *(const bf16x8*)(Q + qrow * D + 64 * h + 32 * ks + 8 * g);
        f32x4 sc[8][2], sm;
#pragma unroll
        for (int j = 0; j < 8; ++j)
#pragma unroll
            for (int blk = 0; blk < 2; ++blk) { f32x4 a = {0.f, 0.f, 0.f, 0.f}; const int kc = kcb + 16 * blk + lq;
#pragma unroll
                for (int ks = 0; ks < 2; ++ks) { const bf16x8 kf = *(const LAS bf16x8*)(lds + AT_KS + (((jr0 + j) * 64 + kc) * 8 + ((4 * ks + g) ^ (kc & 7))) * 16);
                    a = __builtin_amdgcn_mfma_f32_16x16x32_bf16(kf, qf[ks], a, 0, 0, 0); }
                sc[j][blk] = a; }
        { f32x4 a = {0.f, 0.f, 0.f, 0.f};
#pragma unroll
          for (int ks = 0; ks < 2; ++ks) { const bf16x8 kf = *(const LAS bf16x8*)(lds + AT_KM + (lq * 8 + ((4 * ks + g) ^ (lq & 7))) * 16);
              a = __builtin_amdgcn_mfma_f32_16x16x32_bf16(kf, qf[ks], a, 0, 0, 0); }
          sm = a; }
        const int c = c0 + lq, cs = min(max(c - 8, 0), 48);
        const LAS float* RP = (const LAS float*)(lds + AT_RPB); const LAS float* MB = (const LAS float*)(lds + AT_MB);
        float mx = -3.0e38f;
#pragma unroll
        for (int j = 0; j < 8; ++j) { const int ro = rs + j - r + 7;
#pragma unroll
            for (int blk = 0; blk < 2; ++blk)
#pragma unroll
                for (int e = 0; e < 4; ++e) { const int kc = kcb + 16 * blk + 4 * g + e; const bool valid = kc >= cs && kc < cs + 16;
                    const float bias = RP[valid ? ro * 31 + (kc - c + 15) : 0];
                    const float s = valid ? sc[j][blk][e] + bias : -1.0e30f; sc[j][blk][e] = s; mx = fmaxf(mx, s); } }
#pragma unroll
        for (int e = 0; e < 4; ++e) { sm[e] += MB[4 * g + e]; mx = fmaxf(mx, sm[e]); }
        mx = fmaxf(mx, __shfl_xor(mx, 16)); mx = fmaxf(mx, __shfl_xor(mx, 32));
        float sum = 0.f;
#pragma unroll
        for (int j = 0; j < 8; ++j)
#pragma unroll
            for (int blk = 0; blk < 2; ++blk)
#pragma unroll
                for (int e = 0; e < 4; ++e) { const float pv = fast_exp2((sc[j][blk][e] - mx) * 1.44269504089f); sc[j][blk][e] = pv; sum += pv; }
#pragma unroll
        for (int e = 0; e < 4; ++e) { const float pv = fast_exp2((sm[e] - mx) * 1.44269504089f); sm[e] = pv; sum += pv; }
        sum += __shfl_xor(sum, 16); sum += __shfl_xor(sum, 32);
        f32x4 o[4];
#pragma unroll
        for (int db = 0; db < 4; ++db) o[db] = (f32x4){0.f, 0.f, 0.f, 0.f};
#pragma unroll
        for (int j = 0; j < 8; ++j) {
            u32x4 pw; pw.x = cvt_pk_bf16(sc[j][0][0], sc[j][0][1]); pw.y = cvt_pk_bf16(sc[j][0][2], sc[j][0][3]); pw.z = cvt_pk_bf16(sc[j][1][0], sc[j][1][1]); pw.w = cvt_pk_bf16(sc[j][1][2], sc[j][1][3]);
            const bf16x8 pb = __builtin_bit_cast(bf16x8, pw);
#pragma unroll
            for (int db = 0; db < 4; ++db) { const int d = 16 * db + lq; const LAS unsigned char* vp = lds + AT_VTS + d * AT_VPITCH + ((jr0 + j) * 64 + kcb + 4 * g) * 2;
                const u32x2 lo = *(const LAS u32x2*)vp, hi = *(const LAS u32x2*)(vp + 32);
                u32x4 aw; aw.x = lo.x; aw.y = lo.y; aw.z = hi.x; aw.w = hi.y;
                o[db] = __builtin_amdgcn_mfma_f32_16x16x32_bf16(__builtin_bit_cast(bf16x8, aw), pb, o[db], 0, 0, 0); }
        }
        { u32x4 pw; pw.x = cvt_pk_bf16(sm[0], sm[1]); pw.y = cvt_pk_bf16(sm[2], sm[3]); pw.z = 0u; pw.w = 0u; const bf16x8 pb = __builtin_bit_cast(bf16x8, pw);
#pragma unroll
          for (int db = 0; db < 4; ++db) { const int d = 16 * db + lq; const u32x2 lo = *(const LAS u32x2*)(lds + AT_VTM + d * 32 + 8 * g);
              u32x4 aw; aw.x = lo.x; aw.y = lo.y; aw.z = 0u; aw.w = 0u;
              o[db] = __builtin_amdgcn_mfma_f32_16x16x32_bf16(__builtin_bit_cast(bf16x8, aw), pb, o[db], 0, 0, 0); } }
        const float inv = 1.0f / sum;
#pragma unroll
        for (int db = 0; db < 4; ++db) { u32x2 ow; ow.x = cvt_pk_bf16(o[db][0] * inv, o[db][1] * inv); ow.y = cvt_pk_bf16(o[db][2] * inv, o[db][3] * inv);
            *(u32x2*)(O + qrow * D + 64 * h + 16 * db + 4 * g) = ow; }
    }
}


#define XB_TMO      128
#define XB_XCNT(j)  (256  + 64 * (j))
#define XB_XSUB(j)  (1280 + 64 * (j))
#define XB_XGEN(j)  (2304 + 64 * (j))
#define XB_TOP      3328
#define XB_TOPGEN   3392
#define XCD_BAR_WORDS 3456
#define XB_SPIN_CAP (1u << 22)
__device__ __forceinline__ unsigned xb_ld(unsigned* p)              { return __hip_atomic_load(p, __ATOMIC_RELAXED, __HIP_MEMORY_SCOPE_AGENT); }
__device__ __forceinline__ unsigned xb_add(unsigned* p, unsigned v) { return __hip_atomic_fetch_add(p, v, __ATOMIC_RELAXED, __HIP_MEMORY_SCOPE_AGENT); }
__device__ __forceinline__ unsigned xb_xcc_id() { return (unsigned)__builtin_amdgcn_s_getreg((3 << 11) | 20) & 0xFu; }
#define XB_SPIN(cond, bar) do { unsigned _sp = 0; while (cond) { __builtin_amdgcn_s_sleep(1); \
    if ((++_sp & 255u) == 0u) { if (xb_ld(&(bar)[XB_TMO])) break; if (_sp > XB_SPIN_CAP) { atomicAdd(&(bar)[XB_TMO], 1u); break; } } } } while (0)
struct XcdBarrier { unsigned* bar; unsigned x; volatile LAS unsigned* st; };
__device__ __forceinline__ XcdBarrier xcd_barrier_post(unsigned* bar, volatile LAS unsigned* st) {
    XcdBarrier b; b.bar = bar; b.x = xb_xcc_id(); b.st = st;
    if (threadIdx.x == 0) (void)xb_add(&bar[XB_XCNT(b.x)], 1u);
    return b;
}
__device__ __forceinline__ void xcd_barrier_complete(unsigned* bar, unsigned x, unsigned& nloc, unsigned& nx) {
    const unsigned G = gridDim.x * gridDim.y * gridDim.z;
    unsigned sum, cnt, mine, sp = 0u;
    for (;;) {
        sum = 0u; cnt = 0u; mine = 0u;
#pragma unroll
        for (unsigned j = 0; j < 16; ++j) { const unsigned c = xb_ld(&bar[XB_XCNT(j)]); sum += c; cnt += (c > 0u) ? 1u : 0u; mine = (j == x) ? c : mine; }
        if (sum == G) break;
        __builtin_amdgcn_s_sleep(1);
        if ((++sp & 255u) == 0u) { if (xb_ld(&bar[XB_TMO])) break; if (sp > XB_SPIN_CAP) { atomicAdd(&bar[XB_TMO], 1u); break; } }
    }
    nloc = mine > 0u ? mine : 1u; nx = cnt > 0u ? cnt : 1u;
}
__device__ __forceinline__ void xcd_barrier(const XcdBarrier& b) {
    asm volatile("s_waitcnt vmcnt(0)" ::: "memory");
    __syncthreads();
    if (threadIdx.x == 0) {
        unsigned* bar = b.bar;
        __builtin_amdgcn_s_waitcnt(0);
        unsigned nloc = b.st[0], nx = b.st[1];
        if (nloc == 0u) { xcd_barrier_complete(bar, b.x, nloc, nx); b.st[0] = nloc; b.st[1] = nx; }
        const unsigned old = xb_add(&bar[XB_XSUB(b.x)], 1u);
        const unsigned gen = old / nloc;
        if (old + 1u == (gen + 1u) * nloc) {
            __builtin_amdgcn_fence(__ATOMIC_RELEASE, "agent");
            asm volatile("s_waitcnt vmcnt(0)" ::: "memory");
            const unsigned og = xb_add(&bar[XB_TOP], 1u);
            const unsigned tg = og / nx;
            if (og + 1u == (tg + 1u) * nx) xb_add(&bar[XB_TOPGEN], 1u);
            else XB_SPIN(xb_ld(&bar[XB_TOPGEN]) == tg, bar);
            __builtin_amdgcn_fence(__ATOMIC_ACQUIRE, "agent");
            xb_add(&bar[XB_XGEN(b.x)], 1u);
            asm volatile("s_waitcnt vmcnt(0)" ::: "memory");
        } else {
            XB_SPIN(xb_ld(&bar[XB_XGEN(b.x)]) == gen, bar);
            __builtin_amdgcn_fence(__ATOMIC_ACQUIRE, "agent");
            asm volatile("s_waitcnt vmcnt(0)" ::: "memory");
        }
    }
    __syncthreads();
}
constexpr size_t CT_BAR = 131072;
constexpr int LDS_BARST = LDS_BYTES - 64;

constexpr int N_PHASES = 20;
__global__ void __launch_bounds__(NTHREADS, 2) hybrid_fwd(Params P) {
    extern __shared__ __attribute__((aligned(16))) unsigned char smem[];
    cg::grid_group grid = cg::this_grid();
    Ctx C; C.lds = (LAS unsigned char*)smem; C.tid = threadIdx.x; C.lane = C.tid & 63; C.wave = __builtin_amdgcn_readfirstlane(C.tid >> 6); C.G = gridDim.x; C.bid = blockIdx.x;
    C.ws = P.ws; C.in = P.in; C.out = P.out;
    unsigned char* ws = P.ws;
    const int lo = P.ph_lo, hi = P.ph_hi;
#ifndef PH_MASK
#define PH_MASK 0xFFFFFFFFu
#endif
#define IN(k) (((PH_MASK >> (k)) & 1u) && lo <= (k) && (k) < hi)
#ifndef N_CG_SYNCS
#define N_CG_SYNCS 1
#endif
#define SEAM(k) do { if (IN(k) && IN((k) + 1)) { if ((k) < N_CG_SYNCS) grid.sync(); else xcd_barrier(bar); } } while (0)
    if (C.tid < 16) ((LAS unsigned*)(smem + LDS_BARST))[C.tid] = 0u;
    __syncthreads();
    const XcdBarrier bar = xcd_barrier_post((unsigned*)(ws + WS_CTL + CT_BAR), (volatile LAS unsigned*)(smem + LDS_BARST));
    if (IN(0)) phase_convert(C);
    SEAM(0);
    if (IN(1)) { DenseSched S{(const char*)(ws + WS_HB), (const char*)(ws + WS_WIN), 1024, 1024, 129, 8, C.G, C.bid}; EpiWin E{(bf16_t*)(ws + WS_XR), (bf16_t*)(ws + WS_GY)};
        pg8::gemm_phase(C.lds, 1024, 1024, 1024, S, E); }
    SEAM(1);
    if (IN(2)) phase_conv(C);
    SEAM(2);
    if (IN(3)) { GateSched S{(const char*)(ws + WS_XC), (const char*)(ws + WS_GATE), 129, C.G, C.bid};
        EpiGate E{(const bf16_t*)(ws + WS_XC), (bf16_t*)(ws + WS_LA), (bf16_t*)(ws + WS_BB), P.in[I_BA], P.in[I_BX], (const float*)(ws + WS_CTL + CT_SPL)};
        pg8::gemm_phase(C.lds, 256, 1024, 256, S, E); }
    SEAM(3);
    if (IN(4)) phase_scan(C);
    SEAM(4);
    if (IN(5)) { DenseSched S{(const char*)(ws + WS_G), (const char*)(ws + WS_LOUT), 1024, 1024, 129, 4, C.G, C.bid}; EpiRes<true> E{(float*)(ws + WS_PRE), P.in[I_X], P.in[I_META], nullptr, NTOK};
        pg8::gemm_phase(C.lds, 1024, 1024, 1024, S, E); }
    SEAM(5);
    if (IN(6)) phase_lnr(C, 0, NTOK);
    SEAM(6);
    if (IN(7)) phase_pos(C, 0, NTOK);
    SEAM(7);
    if (IN(8)) { const int* texp = (const int*)(ws + WS_CTL + CT_TEXP); const int nM = __builtin_amdgcn_readfirstlane(__hip_atomic_load(texp + 1023, __ATOMIC_RELAXED, __HIP_MEMORY_SCOPE_AGENT));
        MoeSched S{(const char*)(ws + WS_XS), (const char*)(ws + WS_WGU), texp, (size_t)2048 * 1024 * 2, nM, 8, C.G, C.bid}; EpiGlu E{(bf16_t*)(ws + WS_ACT), P.in[I_BGU]};
        pg8::gemm_phase(C.lds, 1024, 1024, 1024, S, E); }
    SEAM(8);
    if (IN(9)) { const int* texp = (const int*)(ws + WS_CTL + CT_TEXP); const int nM = __builtin_amdgcn_readfirstlane(__hip_atomic_load(texp + 1023, __ATOMIC_RELAXED, __HIP_MEMORY_SCOPE_AGENT));
        MoeSched S{(const char*)(ws + WS_ACT), (const char*)(ws + WS_WD), texp, (size_t)1024 * 1024 * 2, nM, 4, C.G, C.bid}; EpiDown E{(bf16_t*)(ws + WS_XS), P.in[I_BD]};
        pg8::gemm_phase(C.lds, 1024, 1024, 1024, S, E); }
    SEAM(9);
    if (IN(10)) phase_combine(C, 0, NTOK, false);
    SEAM(10);
    if (IN(11)) { QkvSched S{(const char*)(ws + WS_HB), (const char*)(ws + WS_QKV), 129, C.G, C.bid}; EpiQkv E{(bf16_t*)(ws + WS_Q), (bf16_t*)(ws + WS_K), (bf16_t*)(ws + WS_VT)};
        pg8::gemm_phase(C.lds, 1024, 1024, 1024, S, E); }
    SEAM(11);
    if (IN(12)) phase_attn(C);
    SEAM(12);
    if (IN(13)) { DenseSched S{(const char*)(ws + WS_O), (const char*)(ws + WS_NOUT), 1024, 1024, 128, 4, C.G, C.bid}; EpiRes<false> E{(float*)(ws + WS_PRE), nullptr, nullptr, (const float*)(ws + WS_H), NGRID};
        pg8::gemm_phase(C.lds, 1024, 1024, 1024, S, E); }
    SEAM(13);
    if (IN(14)) phase_lnr(C, 1, NGRID);
    SEAM(14);
    if (IN(15)) phase_pos(C, 1, NGRID);
    SEAM(15);
    if (IN(16)) { const int* texp = (const int*)(ws + WS_CTL + CT_TEXP) + 1024; const int nM = __builtin_amdgcn_readfirstlane(__hip_atomic_load(texp + 1023, __ATOMIC_RELAXED, __HIP_MEMORY_SCOPE_AGENT));
        MoeSched S{(const char*)(ws + WS_XS), (const char*)(ws + WS_WGU) + (size_t)32 * 2048 * 1024 * 2, texp, (size_t)2048 * 1024 * 2, nM, 8, C.G, C.bid}; EpiGlu E{(bf16_t*)(ws + WS_ACT), P.in[I_BGU] + 32 * 2048};
        pg8::gemm_phase(C.lds, 1024, 1024, 1024, S, E); }
    SEAM(16);
    if (IN(17)) { const int* texp = (const int*)(ws + WS_CTL + CT_TEXP) + 1024; const int nM = __builtin_amdgcn_readfirstlane(__hip_atomic_load(texp + 1023, __ATOMIC_RELAXED, __HIP_MEMORY_SCOPE_AGENT));
        MoeSched S{(const char*)(ws + WS_ACT), (const char*)(ws + WS_WD) + (size_t)32 * 1024 * 1024 * 2, texp, (size_t)1024 * 1024 * 2, nM, 4, C.G, C.bid}; EpiDown E{(bf16_t*)(ws + WS_XS), P.in[I_BD] + 32 * 1024};
        pg8::gemm_phase(C.lds, 1024, 1024, 1024, S, E); }
    SEAM(17);
    if (IN(18)) phase_combine(C, 1, NGRID, true);
#undef IN
#undef SEAM
}

#ifndef MK_PER_PHASE
#define MK_PER_PHASE 0
#endif
extern "C" void kernel_launch(void* const* d_in, const int* in_sizes, int n_in, void* d_out, int out_size, void* d_ws, size_t ws_size, hipStream_t stream) {
    static int grid = 0;
    if (grid == 0) {
        if (n_in != 25 || ws_size < WS_END || out_size != NGRID * D) { fprintf(stderr, "kernel_launch: unexpected problem (n_in %d, ws %zu, out %d)\n", n_in, ws_size, out_size); grid = -1; return; }
        int dev = 0, cus = 0, per_cu = 0;
        if (hipGetDevice(&dev) != hipSuccess || hipDeviceGetAttribute(&cus, hipDeviceAttributeMultiprocessorCount, dev) != hipSuccess) { grid = -1; return; }
        if (hipFuncSetAttribute((const void*)hybrid_fwd, hipFuncAttributeMaxDynamicSharedMemorySize, LDS_BYTES) != hipSuccess) { fprintf(stderr, "kernel_launch: hipFuncSetAttribute failed\n"); grid = -1; return; }
        if (hipOccupancyMaxActiveBlocksPerMultiprocessor(&per_cu, (const void*)hybrid_fwd, NTHREADS, LDS_BYTES) != hipSuccess || per_cu < 1) { fprintf(stderr, "kernel_launch: occupancy query failed (%d)\n", per_cu); grid = -1; return; }
        grid = cus * 1;
        if (grid > 256) grid = 256;
    }
    if (grid < 0) return;
    if (hipMemsetAsync((char*)d_ws + WS_CTL + CT_BAR, 0, 16384, stream) != hipSuccess) { fprintf(stderr, "kernel_launch: memset failed\n"); return; }
    Params p{};
    for (int i = 0; i < 25; ++i) p.in[i] = (const float*)d_in[i];
    p.out = (float*)d_out; p.ws = (unsigned char*)d_ws;
#if MK_PER_PHASE
    for (int ph = 0; ph < 19; ++ph) { p.ph_lo = ph; p.ph_hi = ph + 1; void* args[] = {&p};
        hipError_t e = hipLaunchCooperativeKernel((void*)hybrid_fwd, dim3(grid), dim3(NTHREADS), args, LDS_BYTES, stream);
        if (e != hipSuccess) { fprintf(stderr, "launch phase %d failed: %s\n", ph, hipGetErrorString(e)); break; } }
#else
    p.ph_lo = 0; p.ph_hi = 19; void* args[] = {&p};
    hipError_t e = hipLaunchCooperativeKernel((void*)hybrid_fwd, dim3(grid), dim3(NTHREADS), args, LDS_BYTES, stream);
    if (e != hipSuccess) fprintf(stderr, "cooperative launch failed: %s (grid %d)\n", hipGetErrorString(e), grid);
#endif
}
```

```cpp
#include <hip/hip_runtime.h>
#include <hip/hip_cooperative_groups.h>
#include <cstdio>
#include <cstdint>
namespace cg = cooperative_groups;

#define LAS __attribute__((address_space(3)))
typedef unsigned short bf16_t;
typedef short bf16x8 __attribute__((ext_vector_type(8)));
typedef float f32x4 __attribute__((ext_vector_type(4)));
typedef float f32x2 __attribute__((ext_vector_type(2)));
typedef unsigned u32x4 __attribute__((ext_vector_type(4)));
typedef unsigned u32x2 __attribute__((ext_vector_type(2)));

constexpr int NB = 8, SEQ = 4096, D = 1024, NMETA = 16, LSEQ = SEQ + NMETA;
constexpr int NGRID = NB * SEQ;
constexpr int NTOK = NGRID + NB * NMETA;
constexpr int MPAD = 33024;
constexpr int NEXP = 32, TOPK = 4;
constexpr int PMAX = 139776;
constexpr int MTMAX = PMAX / 256;
constexpr float DN_ALPHA = 1.41421356237f;
constexpr float LN_EPS = 1e-5f;
constexpr int NTHREADS = 512, NWAVES = 8;

constexpr size_t MiB = 1u << 20;
constexpr size_t ACT_BYTES = (size_t)MPAD * D * 2;
constexpr size_t WS_CTL   = 0;
constexpr size_t WS_WIN   = 4 * MiB;
constexpr size_t WS_GATE  = WS_WIN + 4 * MiB;
constexpr size_t WS_LOUT  = WS_GATE + 2 * MiB;
constexpr size_t WS_QKV   = WS_LOUT + 2 * MiB;
constexpr size_t WS_NOUT  = WS_QKV + 6 * MiB;
constexpr size_t WS_WGU   = WS_NOUT + 2 * MiB;
constexpr size_t WS_WD    = WS_WGU + 128 * MiB;
constexpr size_t WS_HB    = WS_WD + 64 * MiB;
constexpr size_t WS_HB8   = WS_HB + 65 * MiB;
constexpr size_t WS_PRE   = WS_HB8 + 33 * MiB;
constexpr size_t WS_H     = WS_PRE + 129 * MiB;
constexpr size_t WS_SCR   = WS_H + 129 * MiB;
constexpr size_t WS_XR = WS_SCR, WS_XC = WS_XR + 65 * MiB, WS_GY = WS_XC + 65 * MiB, WS_LA = WS_GY + 65 * MiB, WS_BB = WS_LA + 130 * MiB, WS_HF = WS_BB + 130 * MiB, WS_G = WS_HF + 65 * MiB;
constexpr size_t WS_SCR_END0 = WS_G + 65 * MiB;
constexpr size_t WS_XS = WS_SCR, WS_ACT = WS_XS + 137 * MiB, WS_YS = WS_ACT + 137 * MiB;
constexpr size_t WS_SCR_END1 = WS_YS + 274 * MiB;
constexpr size_t WS_Q = WS_SCR, WS_K = WS_Q + 65 * MiB, WS_VT = WS_K + 65 * MiB, WS_O = WS_VT + 65 * MiB;
constexpr size_t WS_END = (WS_SCR_END0 > WS_SCR_END1 ? WS_SCR_END0 : WS_SCR_END1);
static_assert(ACT_BYTES <= 65 * MiB && (size_t)PMAX * D * 2 <= 274 * MiB && (size_t)PMAX * D <= 137 * MiB && (size_t)MPAD * D <= 33 * MiB && (size_t)MPAD * D * 4 <= 129 * MiB, "ws map");
static_assert(WS_END <= (size_t)2040 * MiB, "ws map must fit 4x the largest input tensor");
constexpr size_t CT_BC      = 4096;
constexpr size_t CT_TEXP    = CT_BC + 2 * 256 * 32 * 4;
constexpr size_t CT_SPL     = CT_TEXP + 2 * 1024 * 4;
constexpr size_t CT_EID     = 256 * 1024;
constexpr size_t CT_GATEV   = CT_EID + 2 * (size_t)NTOK * 4 * 4;
constexpr size_t CT_POS     = CT_GATEV + 2 * (size_t)NTOK * 4 * 4;
static_assert(CT_POS + 2 * (size_t)NTOK * 4 * 4 <= 4 * MiB, "ctl map");

constexpr int LDS_BYTES = 155648;

__device__ __forceinline__ unsigned f2bf(float f) { unsigned u = __builtin_bit_cast(unsigned, f); return (u + 0x7fffu + ((u >> 16) & 1u)) >> 16; }
__device__ __forceinline__ unsigned pk2(float lo, float hi) { return f2bf(lo) | (f2bf(hi) << 16); }
__device__ __forceinline__ unsigned cvt_pk_bf16(float lo, float hi) { unsigned r; asm volatile("v_cvt_pk_bf16_f32 %0, %1, %2" : "=v"(r) : "v"(lo), "v"(hi)); return r; }
__device__ __forceinline__ unsigned pk4_fp8(float a, float b, float c, float d) { int w = __builtin_amdgcn_cvt_pk_fp8_f32(a, b, 0, false); w = __builtin_amdgcn_cvt_pk_fp8_f32(c, d, w, true); return (unsigned)w; }
__device__ __forceinline__ float bflo(unsigned w) { return __builtin_bit_cast(float, w << 16); }
__device__ __forceinline__ float bfhi(unsigned w) { return __builtin_bit_cast(float, w & 0xffff0000u); }
__device__ __forceinline__ float fast_exp2(float x) { return __builtin_amdgcn_exp2f(x); }
__device__ __forceinline__ float fast_rcp(float x) { return __builtin_amdgcn_rcpf(x); }
__device__ __forceinline__ float sigmoidf_(float x) { return fast_rcp(1.0f + fast_exp2(-1.44269504089f * x)); }
__device__ __forceinline__ float wave_sum(float v) {
#pragma unroll
    for (int o = 1; o < 64; o <<= 1) v += __shfl_xor(v, o);
    return v;
}
__device__ __forceinline__ int seqrow(int b, int s) { return s < NMETA ? NGRID + NMETA * b + s : SEQ * b + (s - NMETA); }

struct Params {
    const float* in[25];
    float* out;
    unsigned char* ws;
    int ph_lo, ph_hi;
};
struct Ctx {
    LAS unsigned char* lds;
    int G, bid;
    unsigned char* ws;
    const float* const* in;
    float* out;
};
__device__ __forceinline__ int fresh_tid() { int t = threadIdx.x; asm volatile("" : "+v"(t)); return t; }
#define PHASE_IDS const int tid = fresh_tid(); const int lane = tid & 63; const int wave = __builtin_amdgcn_readfirstlane(tid >> 6); (void)lane; (void)wave;
enum { I_X = 0, I_META, I_WIN, I_CONVW, I_CONVB, I_WA, I_BA, I_WX, I_BX, I_LAM, I_LOUT, I_WQKV, I_RPB, I_MBIAS, I_NOUT, I_LNMG, I_LNMB, I_RW, I_RB, I_WGU, I_BGU, I_WD, I_BD, I_LNFG, I_LNFB };

namespace pg8 {
constexpr int BM = 256, BK = 64, HALF = 128, HTB = HALF * BK * 2, STAGE_BYTES = 8 * HTB, NXCD = 8, WGM = 8;
__device__ __forceinline__ int lds_byte(int r, int c) { const int st = (r >> 4) * 2 + (c >> 5), rr = r & 15, cc = c & 31, ob = rr * 64 + cc * 2; return st * 1024 + (ob ^ (((ob >> 9) & 1) << 5)); }
__device__ __forceinline__ void stage_rc(int b, int& R, int& C) { const int st = b / 1024, sb = b % 1024, swz = sb ^ (((sb >> 9) & 1) << 5); R = (st >> 1) * 16 + swz / 64; C = (st & 1) * 32 + (swz % 64) / 2; }
__device__ __forceinline__ int perm32(int rho) { const int n = rho >> 4, i = rho & 15; return 8 * (i >> 2) + 4 * n + (i & 3); }

typedef int v8i __attribute__((ext_vector_type(8)));
typedef int v4i __attribute__((ext_vector_type(4)));
__device__ __forceinline__ v8i cat8(bf16x8 a, bf16x8 b) { const v4i x = __builtin_bit_cast(v4i, a), y = __builtin_bit_cast(v4i, b); return __builtin_shufflevector(x, y, 0, 1, 2, 3, 4, 5, 6, 7); }
struct Unit { unsigned ao, bo; int pm, pn, aux; };

__device__ __forceinline__ void tile_of(int L, int nM, int nN, int& pm, int& pn) {
    const int nwg = nM * nN; int wgid = L;
    { const int q = nwg / NXCD, r = nwg % NXCD, xcd = wgid % NXCD, off = wgid / NXCD; wgid = (xcd < r ? xcd * (q + 1) : r * (q + 1) + (xcd - r) * q) + off; }
    const int nig = WGM * nN, gid = wgid / nig, fm = gid * WGM, gsz = (nM - fm) < WGM ? (nM - fm) : WGM;
    pm = fm + ((wgid % nig) % gsz); pn = (wgid % nig) / gsz;
}

template <bool F8, class Epi, class Sched>
__device__ __forceinline__ void gemm_phase(LAS unsigned char* lds, const unsigned char* wsbase, const int K, const int lda, const int ldb, const Sched& S, const Epi& E) {
    const __amdgpu_buffer_rsrc_t rsrc = __builtin_amdgcn_make_buffer_rsrc((void*)wsbase, 0, 0xFFFFFFFF, 0x00020000);
    const int tid = fresh_tid(), wid = __builtin_amdgcn_readfirstlane(tid >> 6), lane = tid & 63, wr = wid >> 2, wc = wid & 3;
    const int nt = K / BK;
    int voffA, voffB;
    { int R, C; stage_rc(tid * 16, R, C); const int Rb = Epi::PERM ? ((R & ~31) + perm32(R & 31)) : R; voffA = (R * lda + C) * 2; voffB = (Rb * ldb + C) * 2; }
    const unsigned kstep = (unsigned)(BK * 2);
    const unsigned hstepA = (unsigned)HALF * lda * 2, hstepB = (unsigned)HALF * ldb * 2;
    const unsigned ldsw = (unsigned)wid * 1024u;
    const int aoff = lds_byte(wr * 64 + (lane & 15), (lane >> 4) * 8), boff = lds_byte(wc * 32 + (lane & 15), (lane >> 4) * 8);
#define PG8_SA(b, h) (((b) * 2 + (h)) * HTB)
#define PG8_SB(b, h) ((4 + (b) * 2 + (h)) * HTB)
#define PG8_STAGE(bufoff, gbase, voff) do { _Pragma("unroll") for (int _i = 0; _i < 2; ++_i) \
        __builtin_amdgcn_raw_ptr_buffer_load_lds(rsrc, (LAS void*)(lds + (bufoff) + ldsw + _i * 8192), 16, voff, (int)((gbase) + (unsigned)_i * (hstep##voff >> 1)), 0, 0); } while (0)
#define hstepvoffA hstepA
#define hstepvoffB hstepB
#define PG8_LDA(dst, b, h) do { _Pragma("unroll") for (int m = 0; m < 4; ++m) _Pragma("unroll") for (int k = 0; k < 2; ++k) dst[m][k] = *(const LAS bf16x8*)(lds + PG8_SA(b, h) + aoff + m * 2048 + k * 1024); } while (0)
#define PG8_LDB(dst, b, h) do { _Pragma("unroll") for (int n = 0; n < 2; ++n) _Pragma("unroll") for (int k = 0; k < 2; ++k) dst[n][k] = *(const LAS bf16x8*)(lds + PG8_SB(b, h) + boff + n * 2048 + k * 1024); } while (0)
#define PG8_MMA(ai, bj, At, Bt) do { __builtin_amdgcn_s_setprio(1); _Pragma("unroll") for (int m = 0; m < 4; ++m) _Pragma("unroll") for (int n = 0; n < 2; ++n) { \
        if constexpr (F8) { acc[ai][bj][m][n] = __builtin_amdgcn_mfma_scale_f32_16x16x128_f8f6f4(cat8(Bt[n][0], Bt[n][1]), cat8(At[m][0], At[m][1]), acc[ai][bj][m][n], 0, 0, 0, Epi::SCALE_W, 0, Epi::SCALE_A); } \
        else { _Pragma("unroll") for (int k = 0; k < 2; ++k) acc[ai][bj][m][n] = __builtin_amdgcn_mfma_f32_16x16x32_bf16(Bt[n][k], At[m][k], acc[ai][bj][m][n], 0, 0, 0); } } \
        __builtin_amdgcn_s_setprio(0); } while (0)
#define PG8_WAIT_V(n) asm volatile("s_waitcnt vmcnt(" #n ")" ::: "memory")
#define PG8_WAIT_L(n) asm volatile("s_waitcnt lgkmcnt(" #n ")" ::: "memory")
#define PG8_BAR __builtin_amdgcn_s_barrier()
#define PG8_SCHED __builtin_amdgcn_sched_barrier(0)
    Unit cur, nxt; int ui = 0;
    if (!S.next(0, cur)) return;
    f32x4 acc[2][2][4][2];
#pragma unroll
    for (int a = 0; a < 2; ++a)
#pragma unroll
        for (int b = 0; b < 2; ++b)
#pragma unroll
            for (int m = 0; m < 4; ++m)
#pragma unroll
                for (int n = 0; n < 2; ++n) acc[a][b][m][n] = (f32x4){0.f, 0.f, 0.f, 0.f};
    bf16x8 At[4][2], B0[2][2], B1[2][2];
    unsigned cA = cur.ao, cB = cur.bo;
    PG8_STAGE(PG8_SB(0, 0), cB, voffB); PG8_STAGE(PG8_SB(0, 1), cB + hstepB, voffB); PG8_STAGE(PG8_SA(0, 0), cA, voffA); PG8_STAGE(PG8_SA(0, 1), cA + hstepA, voffA);
    if (wr == 1) PG8_BAR;
    PG8_WAIT_V(2); PG8_BAR;
    PG8_STAGE(PG8_SB(1, 0), cB + kstep, voffB); PG8_STAGE(PG8_SA(1, 0), cA + kstep, voffA); PG8_STAGE(PG8_SB(1, 1), cB + hstepB + kstep, voffB);
    PG8_WAIT_V(6); PG8_BAR;
    for (;;) {
        const bool has_next = S.next(ui + 1, nxt);
        const unsigned nA = has_next ? nxt.ao : cA, nB = has_next ? nxt.bo : cB;
#pragma unroll 1
        for (int t = 0; t < nt; t += 2) {
            const bool last = (t == nt - 2);
            const unsigned a1 = cA + (unsigned)(t + 1) * kstep;
            const unsigned a2 = last ? nA : cA + (unsigned)(t + 2) * kstep, b2 = last ? nB : cB + (unsigned)(t + 2) * kstep;
            const unsigned a3 = a2 + kstep, b3 = b2 + kstep;
            PG8_LDB(B0, 0, 0); PG8_LDB(B1, 0, 1); PG8_SCHED; PG8_LDA(At, 0, 0); PG8_STAGE(PG8_SA(1, 1), a1 + hstepA, voffA);
            PG8_WAIT_V(8); PG8_WAIT_L(0); PG8_BAR; PG8_MMA(0, 0, At, B0); PG8_MMA(0, 1, At, B1); PG8_BAR; PG8_SCHED;
            PG8_LDA(At, 0, 1); PG8_STAGE(PG8_SB(0, 0), b2, voffB); PG8_STAGE(PG8_SB(0, 1), b2 + hstepB, voffB); PG8_STAGE(PG8_SA(0, 0), a2, voffA);
            PG8_WAIT_V(8); PG8_WAIT_L(0); PG8_BAR; PG8_MMA(1, 0, At, B0); PG8_MMA(1, 1, At, B1); PG8_BAR; PG8_SCHED;
            PG8_LDB(B0, 1, 0); PG8_LDB(B1, 1, 1); PG8_SCHED; PG8_LDA(At, 1, 0); PG8_STAGE(PG8_SA(0, 1), a2 + hstepA, voffA);
            PG8_WAIT_V(8); PG8_WAIT_L(0); PG8_BAR; PG8_MMA(0, 0, At, B0); PG8_MMA(0, 1, At, B1); PG8_BAR; PG8_SCHED;
            PG8_LDA(At, 1, 1); PG8_STAGE(PG8_SB(1, 0), b3, voffB); PG8_STAGE(PG8_SB(1, 1), b3 + hstepB, voffB); PG8_STAGE(PG8_SA(1, 0), a3, voffA);
            PG8_WAIT_V(8); PG8_WAIT_L(0); PG8_BAR; PG8_MMA(1, 0, At, B0); PG8_MMA(1, 1, At, B1); PG8_BAR; PG8_SCHED;
        }
        if (wr == 0) PG8_BAR;
        { const int l2 = fresh_tid() & 63; E(acc, cur, wr, wc, l2 & 15, l2 >> 4); }
        if (!has_next) break;
#pragma unroll
        for (int a = 0; a < 2; ++a)
#pragma unroll
            for (int b = 0; b < 2; ++b)
#pragma unroll
                for (int m = 0; m < 4; ++m)
#pragma unroll
                    for (int n = 0; n < 2; ++n) acc[a][b][m][n] = (f32x4){0.f, 0.f, 0.f, 0.f};
        cur = nxt; cA = nA; cB = nB; ++ui;
        if (wr == 1) PG8_BAR;
    }
    PG8_WAIT_V(0);
    PG8_BAR;
#undef PG8_SA
#undef PG8_SB
#undef PG8_STAGE
#undef hstepvoffA
#undef hstepvoffB
#undef PG8_LDA
#undef PG8_LDB
#undef PG8_MMA
#undef PG8_WAIT_V
#undef PG8_WAIT_L
#undef PG8_BAR
#undef PG8_SCHED
}
}

using pg8::Unit;

struct DenseSched {
    unsigned A, Bt; int lda, ldb, nM, nN, G, c;
    __device__ __forceinline__ bool next(int i, Unit& u) const {
        const int L = i * G + c; if (L >= nM * nN) return false;
        pg8::tile_of(L, nM, nN, u.pm, u.pn); u.aux = 0;
        u.ao = A + (unsigned)u.pm * 256 * lda * 2; u.bo = Bt + (unsigned)u.pn * 256 * ldb * 2; return true;
    }
};
struct GateSched {
    unsigned XC, GT; int nM, G, c;
    __device__ __forceinline__ bool next(int i, Unit& u) const {
        const int per = nM * 4; const int L = i * G + c; if (L >= 4 * per) return false;
        const int nb = L / per; pg8::tile_of(L - nb * per, nM, 4, u.pm, u.pn); u.aux = nb;
        u.ao = XC + ((unsigned)u.pm * 256 * 1024 + 256 * nb) * 2; u.bo = GT + ((unsigned)nb * 1024 + 256 * u.pn) * 256 * 2; return true;
    }
};
struct QkvSched {
    unsigned HB, WT; int nM, G, c;
    __device__ __forceinline__ bool next(int i, Unit& u) const {
        const int n0 = nM * 8, n1 = 4 * nM; const int L = i * G + c; if (L >= n0 + n1) return false;
        if (L < n0) { pg8::tile_of(L, nM, 8, u.pm, u.pn); u.aux = 0; u.ao = HB + (unsigned)u.pm * 256 * 1024 * 2; u.bo = WT + (unsigned)u.pn * 256 * 1024 * 2; }
        else { pg8::tile_of(L - n0, 4, nM, u.pm, u.pn); u.aux = 1; u.ao = WT + (unsigned)(2048 + u.pm * 256) * 1024 * 2; u.bo = HB + (unsigned)u.pn * 256 * 1024 * 2; }
        return true;
    }
};
struct MoeSched {
    unsigned A, W; const int* texp; unsigned wstride; int nM, nN, G, c;
    __device__ __forceinline__ bool next(int i, Unit& u) const {
        const int L = i * G + c; if (L >= nM * nN) return false;
        pg8::tile_of(L, nM, nN, u.pm, u.pn);
        const int e = __builtin_amdgcn_readfirstlane(__hip_atomic_load(texp + u.pm, __ATOMIC_RELAXED, __HIP_MEMORY_SCOPE_AGENT)); u.aux = e;
        u.ao = A + (unsigned)u.pm * 256 * 1024; u.bo = W + (unsigned)e * wstride + (unsigned)u.pn * 256 * 1024; return true;
    }
};

#define EPI_ARGS const f32x4 (&acc)[2][2][4][2], const Unit& u, int wr, int wc, int fr, int fq
struct EpiWin {
    static constexpr bool PERM = true;
    bf16_t* XR; bf16_t* GY;
    __device__ __forceinline__ void operator()(EPI_ARGS) const {
        const int row0 = u.pm * 256 + wr * 64 + fr;
        if (u.pn < 4) {
            const int col0 = u.pn * 256 + wc * 32 + 8 * fq;
#pragma unroll
            for (int ai = 0; ai < 2; ++ai)
#pragma unroll
                for (int m = 0; m < 4; ++m) { bf16_t* rowp = XR + (size_t)(row0 + ai * 128 + m * 16) * D + col0;
#pragma unroll
                    for (int bj = 0; bj < 2; ++bj) { const f32x4 v0 = acc[ai][bj][m][0], v1 = acc[ai][bj][m][1];
                        u32x4 w; w.x = cvt_pk_bf16(v0[0], v0[1]); w.y = cvt_pk_bf16(v0[2], v0[3]); w.z = cvt_pk_bf16(v1[0], v1[1]); w.w = cvt_pk_bf16(v1[2], v1[3]);
                        *(u32x4*)(rowp + bj * 128) = w; } }
        } else {
#pragma unroll
            for (int ai = 0; ai < 2; ++ai)
#pragma unroll
                for (int m = 0; m < 4; ++m) { const int row = row0 + ai * 128 + m * 16;
#pragma unroll
                    for (int bj = 0; bj < 2; ++bj) { const int g = (u.pn - 4) * 8 + bj * 4 + wc;
                        float o[8];
#pragma unroll
                        for (int n = 0; n < 2; ++n)
#pragma unroll
                            for (int j = 0; j < 4; ++j) { const float v = acc[ai][bj][m][n][j]; const float z = 1.5957691216f * (v + 0.044715f * v * v * v); o[n * 4 + j] = v * sigmoidf_(z); }
                        u32x4 w; w.x = cvt_pk_bf16(o[0], o[1]); w.y = cvt_pk_bf16(o[2], o[3]); w.z = cvt_pk_bf16(o[4], o[5]); w.w = cvt_pk_bf16(o[6], o[7]);
                        *(u32x4*)(GY + ((size_t)g * MPAD + row) * 32 + 8 * fq) = w; } }
        }
    }
};
struct EpiGate {
    static constexpr bool PERM = true;
    const bf16_t* XC; bf16_t* LA; bf16_t* BB; const float* ba; const float* bx; const float* spl;
    __device__ __forceinline__ void operator()(EPI_ARGS) const {
        const int nb = u.aux, dir = u.pn >> 1, half = u.pn & 1;
        const int ch0 = 256 * nb + 128 * half + 32 * wc + 8 * fq, g = ch0 >> 5;
        const int row0 = u.pm * 256 + wr * 64 + fr;
#pragma unroll
        for (int ai = 0; ai < 2; ++ai)
#pragma unroll
            for (int m = 0; m < 4; ++m) { const int row = row0 + ai * 128 + m * 16;
                if (row < NTOK) {
                    float cba[8], cbx[8], csp[8];
                                { const f32x4 t0 = *(const f32x4*)(ba + dir * 1024 + ch0), t1 = *(const f32x4*)(ba + dir * 1024 + ch0 + 4);
                      const f32x4 s0 = *(const f32x4*)(bx + dir * 1024 + ch0), s1 = *(const f32x4*)(bx + dir * 1024 + ch0 + 4);
                      const f32x4 p0 = *(const f32x4*)(spl + dir * 1024 + ch0), p1 = *(const f32x4*)(spl + dir * 1024 + ch0 + 4);
#pragma unroll
                      for (int j = 0; j < 4; ++j) { cba[j] = t0[j]; cba[4 + j] = t1[j]; cbx[j] = s0[j]; cbx[4 + j] = s1[j]; csp[j] = p0[j]; csp[4 + j] = p1[j]; } }
                    const u32x4 xw = *(const u32x4*)(XC + (size_t)row * D + ch0);
                    float xc[8] = {bflo(xw.x), bfhi(xw.x), bflo(xw.y), bfhi(xw.y), bflo(xw.z), bfhi(xw.z), bflo(xw.w), bfhi(xw.w)};
                    const bool start = dir == 0 ? (row >= NGRID && ((row - NGRID) & 15) == 0) : (row < NGRID && (row & (SEQ - 1)) == SEQ - 1);
                    float la[8], bb[8];
#pragma unroll
                    for (int n = 0; n < 2; ++n)
#pragma unroll
                        for (int j = 0; j < 4; ++j) { const int i = n * 4 + j;
                            const float ga = sigmoidf_(acc[ai][0][m][n][j] + cba[i]), gx = sigmoidf_(acc[ai][1][m][n][j] + cbx[i]);
                            const float l2 = -csp[i] * ga;
                            const float a2 = fast_exp2(2.0f * l2);
                            const float mult = start ? 1.0f : __builtin_sqrtf(fmaxf(1.0f - a2, 0.0f));
                            la[i] = l2; bb[i] = mult * gx * xc[i]; }
                    u32x4 w; w.x = cvt_pk_bf16(la[0], la[1]); w.y = cvt_pk_bf16(la[2], la[3]); w.z = cvt_pk_bf16(la[4], la[5]); w.w = cvt_pk_bf16(la[6], la[7]);
                    const size_t o = (((size_t)dir * 32 + g) * MPAD + row) * 32 + 8 * fq;
                    *(u32x4*)(LA + o) = w;
                    w.x = cvt_pk_bf16(bb[0], bb[1]); w.y = cvt_pk_bf16(bb[2], bb[3]); w.z = cvt_pk_bf16(bb[4], bb[5]); w.w = cvt_pk_bf16(bb[6], bb[7]);
                    *(u32x4*)(BB + o) = w;
                }
                asm volatile("" ::: "memory"); }
    }
};
template <bool LAYER0> struct EpiRes {
    static constexpr bool PERM = false;
    float* PRE; const float* x; const float* meta; const float* H; int nrows;
    __device__ __forceinline__ void operator()(EPI_ARGS) const {
        const int row0 = u.pm * 256 + wr * 64 + fr, col0 = u.pn * 256 + wc * 32 + 4 * fq;
#pragma unroll
        for (int ai = 0; ai < 2; ++ai)
#pragma unroll
            for (int m = 0; m < 4; ++m) { const int row = row0 + ai * 128 + m * 16;
                if (row < nrows) {
                    const float* rp = LAYER0 ? (row < NGRID ? x + (size_t)row * D : meta + (size_t)((row - NGRID) & 15) * D) : H + (size_t)row * D;
#pragma unroll
                    for (int bj = 0; bj < 2; ++bj)
#pragma unroll
                        for (int n = 0; n < 2; ++n) { const int c = col0 + bj * 128 + n * 16; const f32x4 r = *(const f32x4*)(rp + c);
                            *(f32x4*)(PRE + (size_t)row * D + c) = r * DN_ALPHA + acc[ai][bj][m][n]; }
                }
                asm volatile("" ::: "memory"); }
    }
};
struct EpiGlu {
    static constexpr bool PERM = true; static constexpr int SCALE_W = 0x79797979, SCALE_A = 0x7F7F7F7F;
    unsigned char* ACT; const float* bgu;
    __device__ __forceinline__ void operator()(EPI_ARGS) const {
        const int e = u.aux, f0 = 128 * u.pn + 32 * wc + 8 * fq;
        float bg[8], bl[8];
        { const float* p = bgu + (size_t)e * 2048 + f0; const f32x4 a0 = *(const f32x4*)p, a1 = *(const f32x4*)(p + 4), c0 = *(const f32x4*)(p + 1024), c1 = *(const f32x4*)(p + 1028);
#pragma unroll
          for (int j = 0; j < 4; ++j) { bg[j] = a0[j]; bg[4 + j] = a1[j]; bl[j] = c0[j]; bl[4 + j] = c1[j]; } }
        const int row0 = u.pm * 256 + wr * 64 + fr;
#pragma unroll
        for (int ai = 0; ai < 2; ++ai)
#pragma unroll
            for (int m = 0; m < 4; ++m) { const int row = row0 + ai * 128 + m * 16; float o[8];
#pragma unroll
                for (int n = 0; n < 2; ++n)
#pragma unroll
                    for (int j = 0; j < 4; ++j) { const int i = n * 4 + j;
                        const float glu = fminf(acc[ai][0][m][n][j] + bg[i], 7.0f);
                        const float lin = fminf(fmaxf(acc[ai][1][m][n][j] + bl[i], -7.0f), 7.0f);
                        o[i] = glu * sigmoidf_(1.702f * glu) * (lin + 1.0f); }
                u32x2 w; w.x = pk4_fp8(o[0] * 4.0f, o[1] * 4.0f, o[2] * 4.0f, o[3] * 4.0f); w.y = pk4_fp8(o[4] * 4.0f, o[5] * 4.0f, o[6] * 4.0f, o[7] * 4.0f);
                *(u32x2*)(ACT + (size_t)row * D + f0) = w; }
    }
};
struct EpiDown {
    static constexpr bool PERM = true; static constexpr int SCALE_W = 0x79797979, SCALE_A = 0x7D7D7D7D;
    bf16_t* YS; const float* bd;
    __device__ __forceinline__ void operator()(EPI_ARGS) const {
        const int e = u.aux, row0 = u.pm * 256 + wr * 64 + fr, col0 = u.pn * 256 + wc * 32 + 8 * fq;
        f32x4 bv[2][2];
#pragma unroll
        for (int bj = 0; bj < 2; ++bj)
#pragma unroll
            for (int n = 0; n < 2; ++n) bv[bj][n] = *(const f32x4*)(bd + (size_t)e * D + col0 + bj * 128 + 4 * n);
#pragma unroll
        for (int ai = 0; ai < 2; ++ai)
#pragma unroll
            for (int m = 0; m < 4; ++m) { bf16_t* rowp = YS + (size_t)(row0 + ai * 128 + m * 16) * D + col0;
#pragma unroll
                for (int bj = 0; bj < 2; ++bj) { const f32x4 v0 = acc[ai][bj][m][0] + bv[bj][0], v1 = acc[ai][bj][m][1] + bv[bj][1];
                    u32x4 w; w.x = cvt_pk_bf16(v0[0], v0[1]); w.y = cvt_pk_bf16(v0[2], v0[3]); w.z = cvt_pk_bf16(v1[0], v1[1]); w.w = cvt_pk_bf16(v1[2], v1[3]);
                    *(u32x4*)(rowp + bj * 128) = w; } }
    }
};
struct EpiQkv {
    static constexpr bool PERM = true;
    bf16_t* Q; bf16_t* Kx; bf16_t* VT;
    __device__ __forceinline__ void operator()(EPI_ARGS) const {
        const int row0 = u.pm * 256 + wr * 64 + fr; bf16_t* base; int ldc, colt; float sc = 1.0f;
        if (u.aux == 0) { ldc = D; if (u.pn < 4) { base = Q; colt = u.pn * 256; sc = 0.125f; } else { base = Kx; colt = (u.pn - 4) * 256; } }
        else { base = VT; ldc = MPAD; colt = u.pn * 256; }
        const int col0 = colt + wc * 32 + 8 * fq;
#pragma unroll
        for (int ai = 0; ai < 2; ++ai)
#pragma unroll
            for (int m = 0; m < 4; ++m) { bf16_t* rowp = base + (size_t)(row0 + ai * 128 + m * 16) * ldc + col0;
#pragma unroll
                for (int bj = 0; bj < 2; ++bj) { const f32x4 v0 = acc[ai][bj][m][0] * sc, v1 = acc[ai][bj][m][1] * sc;
                    u32x4 w; w.x = cvt_pk_bf16(v0[0], v0[1]); w.y = cvt_pk_bf16(v0[2], v0[3]); w.z = cvt_pk_bf16(v1[0], v1[1]); w.w = cvt_pk_bf16(v1[2], v1[3]);
                    *(u32x4*)(rowp + bj * 128) = w; } }
    }
};

__device__ __forceinline__ void tr_item(const float* W, int ld, int kb, int n0, bf16_t* dst0, int K, LAS float* scr, int lane) {
    const int r = lane >> 4, q = lane & 15;
    f32x4 v[16];
#pragma unroll
    for (int i = 0; i < 16; ++i) v[i] = *(const f32x4*)(W + (size_t)(64 * kb + 4 * i + r) * ld + n0 + 4 * q);
#pragma unroll
    for (int i = 0; i < 16; ++i) { LAS float* s = scr + (4 * i + r) * 65 + 4 * q; s[0] = v[i][0]; s[1] = v[i][1]; s[2] = v[i][2]; s[3] = v[i][3]; }
    asm volatile("s_waitcnt lgkmcnt(0)" ::: "memory");
    const int c = lane & 7, nn = lane >> 3;
#pragma unroll
    for (int j = 0; j < 8; ++j) { const int n = nn + 8 * j; const LAS float* s = scr + (8 * c) * 65 + n;
        u32x4 o; o.x = pk2(s[0], s[65]); o.y = pk2(s[2 * 65], s[3 * 65]); o.z = pk2(s[4 * 65], s[5 * 65]); o.w = pk2(s[6 * 65], s[7 * 65]);
        *(u32x4*)(dst0 + (size_t)n * K + 64 * kb + 8 * c) = o; }
    asm volatile("s_waitcnt lgkmcnt(0)" ::: "memory");
}
__device__ __forceinline__ void tr_item8(const float* W, int ld, int kb, int n0, unsigned char* dst0, int K, LAS float* scr, int lane) {
    const int r = lane >> 4, q = lane & 15;
    f32x4 v[16];
#pragma unroll
    for (int i = 0; i < 16; ++i) v[i] = *(const f32x4*)(W + (size_t)(64 * kb + 4 * i + r) * ld + n0 + 4 * q);
#pragma unroll
    for (int i = 0; i < 16; ++i) { LAS float* s = scr + (4 * i + r) * 65 + 4 * q; s[0] = v[i][0]; s[1] = v[i][1]; s[2] = v[i][2]; s[3] = v[i][3]; }
    asm volatile("s_waitcnt lgkmcnt(0)" ::: "memory");
    const int c = lane & 7, nn = lane >> 3;
#pragma unroll
    for (int j = 0; j < 8; ++j) { const int n = nn + 8 * j; const LAS float* s = scr + (8 * c) * 65 + n;
        u32x2 o; o.x = pk4_fp8(s[0] * 64.0f, s[65] * 64.0f, s[2 * 65] * 64.0f, s[3 * 65] * 64.0f); o.y = pk4_fp8(s[4 * 65] * 64.0f, s[5 * 65] * 64.0f, s[6 * 65] * 64.0f, s[7 * 65] * 64.0f);
        *(u32x2*)(dst0 + (size_t)n * K + 64 * kb + 8 * c) = o; }
    asm volatile("s_waitcnt lgkmcnt(0)" ::: "memory");
}
__device__ __forceinline__ void phase_convert(const Ctx& C) {
    PHASE_IDS
    LAS float* scr = (LAS float*)(C.lds + wave * 16640);
    const int gw = C.bid * NWAVES + wave, NGW = C.G * NWAVES;
    constexpr int I0 = 512, I1 = 256, I2 = 256, I3 = 768, I4 = 256, I5 = 32768, I6 = 16384, NIT = I0 + I1 + I2 + I3 + I4 + I5 + I6;
    for (int it = gw; it < NIT; it += NGW) {
        int r = it;
        if (r < I0) { const int nbk = r & 31, kb = r >> 5; tr_item(C.in[I_WIN], 2048, kb, 64 * nbk, (bf16_t*)(C.ws + WS_WIN) + (size_t)(64 * nbk) * 1024, 1024, scr, lane); continue; } r -= I0;
        if (r < I1) { const int job = r >> 3, sub = r & 7, nbk = sub & 1, kb = sub >> 1;
            const int half = job & 1, which = (job >> 1) & 1, nb = (job >> 2) & 3, dir = job >> 4;
            const float* src = C.in[which ? I_WX : I_WA] + (size_t)(dir * 4 + nb) * 65536;
            bf16_t* dst = (bf16_t*)(C.ws + WS_GATE) + ((size_t)nb * 1024 + 256 * (2 * dir + half) + 128 * which + 64 * nbk) * 256;
            tr_item(src, 256, kb, 128 * half + 64 * nbk, dst, 256, scr, lane); continue; } r -= I1;
        if (r < I2) { const int nbk = r & 15, kb = r >> 4; tr_item(C.in[I_LOUT], 1024, kb, 64 * nbk, (bf16_t*)(C.ws + WS_LOUT) + (size_t)(64 * nbk) * 1024, 1024, scr, lane); continue; } r -= I2;
        if (r < I3) { const int nbk = r % 48, kb = r / 48; tr_item(C.in[I_WQKV], 3072, kb, 64 * nbk, (bf16_t*)(C.ws + WS_QKV) + (size_t)(64 * nbk) * 1024, 1024, scr, lane); continue; } r -= I3;
        if (r < I4) { const int nbk = r & 15, kb = r >> 4; tr_item(C.in[I_NOUT], 1024, kb, 64 * nbk, (bf16_t*)(C.ws + WS_NOUT) + (size_t)(64 * nbk) * 1024, 1024, scr, lane); continue; } r -= I4;
        if (r < I5) { const int mat = r >> 9, sub = r & 511, nbk = sub & 31, kb = sub >> 5; const int n0 = 64 * nbk, bj = n0 >> 10, f0 = n0 & 1023, pn = f0 >> 7, jj = f0 & 127;
            tr_item8(C.in[I_WGU] + (size_t)mat * 1024 * 2048, 2048, kb, n0, (unsigned char*)(C.ws + WS_WGU) + ((size_t)mat * 2048 + 256 * pn + 128 * bj + jj) * 1024, 1024, scr, lane); continue; } r -= I5;
        { const int mat = r >> 8, sub = r & 255, nbk = sub & 15, kb = sub >> 4;
            tr_item8(C.in[I_WD] + (size_t)mat * 1024 * 1024, 1024, kb, 64 * nbk, (unsigned char*)(C.ws + WS_WD) + ((size_t)mat * 1024 + 64 * nbk) * 1024, 1024, scr, lane); }
    }
    const int gt = C.bid * NTHREADS + tid, NGT = C.G * NTHREADS;
    for (int i = gt; i < 2048; i += NGT) ((float*)(C.ws + WS_CTL + CT_SPL))[i] = 8.0f * 1.44269504089f * log1pf(expf(-C.in[I_LAM][i]));
    for (int i = gt; i < NTOK * 128; i += NGT) { const int row = i >> 7, oc = i & 127;
        const float* src = (row < NGRID ? C.in[I_X] + (size_t)row * D : C.in[I_META] + (size_t)((row - NGRID) & 15) * D) + 8 * oc;
        const f32x4 a = *(const f32x4*)src, b = *(const f32x4*)(src + 4);
        u32x4 w; w.x = pk2(a[0], a[1]); w.y = pk2(a[2], a[3]); w.z = pk2(b[0], b[1]); w.w = pk2(b[2], b[3]);
        *(u32x4*)((bf16_t*)(C.ws + WS_HB) + (size_t)row * D + 8 * oc) = w; }
}

__device__ __forceinline__ void phase_conv(const Ctx& C) {
    PHASE_IDS
    const bf16_t* XR = (const bf16_t*)(C.ws + WS_XR); bf16_t* XC = (bf16_t*)(C.ws + WS_XC);
    const float* cw = C.in[I_CONVW]; const float* cb = C.in[I_CONVB];
    const int gt = C.bid * NTHREADS + tid, NGT = C.G * NTHREADS;
    for (int i = gt; i < NTOK * 128; i += NGT) { const int row = i >> 7, ch = 8 * (i & 127);
        int b, s; if (row < NGRID) { b = row >> 12; s = NMETA + (row & (SEQ - 1)); } else { b = (row - NGRID) >> 4; s = (row - NGRID) & 15; }
        float a[8];
        { const f32x4 t0 = *(const f32x4*)(cb + ch), t1 = *(const f32x4*)(cb + ch + 4);
#pragma unroll
          for (int j = 0; j < 4; ++j) { a[j] = t0[j]; a[4 + j] = t1[j]; } }
#pragma unroll
        for (int j = 0; j < 4; ++j) { const int sj = s - 2 + j;
            if (sj >= 0 && sj < LSEQ) { const u32x4 xw = *(const u32x4*)(XR + (size_t)seqrow(b, sj) * D + ch);
                const f32x4 w0 = *(const f32x4*)(cw + j * 1024 + ch), w1 = *(const f32x4*)(cw + j * 1024 + ch + 4);
                a[0] += w0[0] * bflo(xw.x); a[1] += w0[1] * bfhi(xw.x); a[2] += w0[2] * bflo(xw.y); a[3] += w0[3] * bfhi(xw.y);
                a[4] += w1[0] * bflo(xw.z); a[5] += w1[1] * bfhi(xw.z); a[6] += w1[2] * bflo(xw.w); a[7] += w1[3] * bfhi(xw.w); } }
        u32x4 w; w.x = pk2(a[0], a[1]); w.y = pk2(a[2], a[3]); w.z = pk2(a[4], a[5]); w.w = pk2(a[6], a[7]);
        *(u32x4*)(XC + (size_t)row * D + ch) = w; }
}

template <int N> __device__ __forceinline__ float dpp_shr(float oldv, float v) {
    return __builtin_bit_cast(float, __builtin_amdgcn_update_dpp(__builtin_bit_cast(int, oldv), __builtin_bit_cast(int, v), 0x110 + N, 0xf, 0xf, false));
}
__device__ __forceinline__ void scan_group(float (&a)[8], float (&b)[8]) {
#pragma unroll
    for (int c = 0; c < 8; ++c) {
        { const float ap = dpp_shr<1>(1.0f, a[c]), bp = dpp_shr<1>(0.0f, b[c]); b[c] = a[c] * bp + b[c]; a[c] = a[c] * ap; }
        { const float ap = dpp_shr<2>(1.0f, a[c]), bp = dpp_shr<2>(0.0f, b[c]); b[c] = a[c] * bp + b[c]; a[c] = a[c] * ap; }
        { const float ap = dpp_shr<4>(1.0f, a[c]), bp = dpp_shr<4>(0.0f, b[c]); b[c] = a[c] * bp + b[c]; a[c] = a[c] * ap; }
        { const float ap = dpp_shr<8>(1.0f, a[c]), bp = dpp_shr<8>(0.0f, b[c]); b[c] = a[c] * bp + b[c]; a[c] = a[c] * ap; }
    }
}
__device__ __forceinline__ void unpack8(const u32x4 w, float (&o)[8]) { o[0] = bflo(w.x); o[1] = bfhi(w.x); o[2] = bflo(w.y); o[3] = bfhi(w.y); o[4] = bflo(w.z); o[5] = bfhi(w.z); o[6] = bflo(w.w); o[7] = bfhi(w.w); }
__device__ __forceinline__ void phase_scan(const Ctx& C) {
    PHASE_IDS
    const bf16_t* LA = (const bf16_t*)(C.ws + WS_LA); const bf16_t* BB = (const bf16_t*)(C.ws + WS_BB); const bf16_t* GY = (const bf16_t*)(C.ws + WS_GY);
    bf16_t* HF = (bf16_t*)(C.ws + WS_HF); bf16_t* Gout = (bf16_t*)(C.ws + WS_G);
    LAS float* agg = (LAS float*)C.lds;
    const int w = wave, oct = lane >> 4, p = lane & 15;
    for (int item = C.bid; item < NB * 32; item += C.G) {
        const int b = item >> 5, g = item & 31;
        for (int dir = 0; dir < 2; ++dir) {
            const bf16_t* la = LA + (((size_t)dir * 32 + g) * MPAD) * 32 + 8 * oct;
            const bf16_t* bb = BB + (((size_t)dir * 32 + g) * MPAD) * 32 + 8 * oct;
            float S[8];
#pragma unroll
            for (int c = 0; c < 8; ++c) S[c] = 0.f;
            {
                const int u = p, s = dir ? LSEQ - 1 - u : u, row = seqrow(b, s);
                float a[8], x[8]; unpack8(*(const u32x4*)(la + (size_t)row * 32), a); unpack8(*(const u32x4*)(bb + (size_t)row * 32), x);
#pragma unroll
                for (int c = 0; c < 8; ++c) a[c] = fast_exp2(a[c]);
                scan_group(a, x);
                if (w == 0) {
                    if (dir == 0) { u32x4 o; o.x = pk2(x[0], x[1]); o.y = pk2(x[2], x[3]); o.z = pk2(x[4], x[5]); o.w = pk2(x[6], x[7]); *(u32x4*)(HF + ((size_t)g * MPAD + row) * 32 + 8 * oct) = o; }
                    else { float hf[8], gy[8]; unpack8(*(const u32x4*)(HF + ((size_t)g * MPAD + row) * 32 + 8 * oct), hf); unpack8(*(const u32x4*)(GY + ((size_t)g * MPAD + row) * 32 + 8 * oct), gy);
                        u32x4 o; o.x = pk2((hf[0] + x[0]) * gy[0], (hf[1] + x[1]) * gy[1]); o.y = pk2((hf[2] + x[2]) * gy[2], (hf[3] + x[3]) * gy[3]);
                        o.z = pk2((hf[4] + x[4]) * gy[4], (hf[5] + x[5]) * gy[5]); o.w = pk2((hf[6] + x[6]) * gy[6], (hf[7] + x[7]) * gy[7]);
                        *(u32x4*)(Gout + (size_t)row * D + 32 * g + 8 * oct) = o; }
                }
#pragma unroll
                for (int c = 0; c < 8; ++c) S[c] = __shfl(x[c], (lane & 48) | 15);
            }
            for (int r = 0; r < 8; ++r) {
                float Pw[4][8], Hw[4][8]; int rows[4];
                float Aw[8], Hc[8];
#pragma unroll
                for (int c = 0; c < 8; ++c) { Aw[c] = 1.f; Hc[c] = 0.f; }
                u32x4 ra[4], rb[4];
#pragma unroll
                for (int j = 0; j < 4; ++j) { const int u = 16 + 512 * r + 64 * w + 16 * j + p, s = dir ? LSEQ - 1 - u : u; rows[j] = seqrow(b, s);
                    ra[j] = *(const u32x4*)(la + (size_t)rows[j] * 32); rb[j] = *(const u32x4*)(bb + (size_t)rows[j] * 32); }
#pragma unroll
                for (int j = 0; j < 4; ++j) {
                    float a[8], x[8]; unpack8(ra[j], a); unpack8(rb[j], x);
#pragma unroll
                    for (int c = 0; c < 8; ++c) a[c] = fast_exp2(a[c]);
                    scan_group(a, x);
#pragma unroll
                    for (int c = 0; c < 8; ++c) { Hw[j][c] = a[c] * Hc[c] + x[c]; Pw[j][c] = a[c] * Aw[c]; }
#pragma unroll
                    for (int c = 0; c < 8; ++c) { Aw[c] = __shfl(Pw[j][c], (lane & 48) | 15); Hc[c] = __shfl(Hw[j][c], (lane & 48) | 15); }
                }
                LAS float* ag = agg + (r & 1) * 512;
                if (p == 0) {
#pragma unroll
                    for (int c = 0; c < 8; ++c) { ag[(w * 32 + oct * 8 + c) * 2] = Aw[c]; ag[(w * 32 + oct * 8 + c) * 2 + 1] = Hc[c]; }
                }
                __syncthreads();
                float Sin[8];
#pragma unroll
                for (int c = 0; c < 8; ++c) Sin[c] = S[c];
#pragma unroll
                for (int ww = 0; ww < 8; ++ww) {
#pragma unroll
                    for (int c = 0; c < 8; ++c) { const float A = ag[(ww * 32 + oct * 8 + c) * 2], H = ag[(ww * 32 + oct * 8 + c) * 2 + 1];
                        if (ww == w) Sin[c] = S[c];
                        S[c] = A * S[c] + H; }
                }
#pragma unroll
                for (int j = 0; j < 4; ++j) {
                    float h[8];
#pragma unroll
                    for (int c = 0; c < 8; ++c) h[c] = Pw[j][c] * Sin[c] + Hw[j][c];
                    const size_t go = ((size_t)g * MPAD + rows[j]) * 32 + 8 * oct;
                    if (dir == 0) { u32x4 o; o.x = pk2(h[0], h[1]); o.y = pk2(h[2], h[3]); o.z = pk2(h[4], h[5]); o.w = pk2(h[6], h[7]); *(u32x4*)(HF + go) = o; }
                    else { float hf[8], gy[8]; unpack8(*(const u32x4*)(HF + go), hf); unpack8(*(const u32x4*)(GY + go), gy);
                        u32x4 o; o.x = pk2((hf[0] + h[0]) * gy[0], (hf[1] + h[1]) * gy[1]); o.y = pk2((hf[2] + h[2]) * gy[2], (hf[3] + h[3]) * gy[3]);
                        o.z = pk2((hf[4] + h[4]) * gy[4], (hf[5] + h[5]) * gy[5]); o.w = pk2((hf[6] + h[6]) * gy[6], (hf[7] + h[7]) * gy[7]);
                        *(u32x4*)(Gout + (size_t)rows[j] * D + 32 * g + 8 * oct) = o; }
                }
            }
            __syncthreads();
        }
    }
}

constexpr int RWT_PITCH = 1028;
__device__ __forceinline__ void phase_lnr(const Ctx& C, int layer, int nrows) {
    PHASE_IDS
    const float* PRE = (const float*)(C.ws + WS_PRE); float* H = (float*)(C.ws + WS_H); bf16_t* HB = (bf16_t*)(C.ws + WS_HB); unsigned char* HB8 = C.ws + WS_HB8;
    const float* lg = C.in[I_LNMG] + layer * D; const float* lb = C.in[I_LNMB] + layer * D;
    const float* rw = C.in[I_RW] + (size_t)layer * D * NEXP; const float* rb = C.in[I_RB] + layer * NEXP;
    int* eid = (int*)(C.ws + WS_CTL + CT_EID) + (size_t)layer * NTOK * 4; float* gatev = (float*)(C.ws + WS_CTL + CT_GATEV) + (size_t)layer * NTOK * 4;
    unsigned* bc = (unsigned*)(C.ws + WS_CTL + CT_BC) + ((size_t)layer * 256 + C.bid) * 32;
    LAS float* RWt = (LAS float*)C.lds; LAS unsigned* hist = (LAS unsigned*)(C.lds + 32 * RWT_PITCH * 4);
    for (int idx = tid; idx < D * NEXP; idx += NTHREADS) RWt[(idx & 31) * RWT_PITCH + (idx >> 5)] = rw[idx];
    if (tid < 32) hist[tid] = 0u;
    __syncthreads();
    f32x4 gg[4], gb[4];
#pragma unroll
    for (int j = 0; j < 4; ++j) { gg[j] = *(const f32x4*)(lg + 4 * lane + 256 * j); gb[j] = *(const f32x4*)(lb + 4 * lane + 256 * j); }
    const float rbias = rb[lane >> 1];
    const int gw = C.bid * NWAVES + wave, NGW = C.G * NWAVES;
    for (int row = gw; row < nrows; row += NGW) {
        f32x4 v[4]; float s = 0.f;
#pragma unroll
        for (int j = 0; j < 4; ++j) { v[j] = *(const f32x4*)(PRE + (size_t)row * D + 4 * lane + 256 * j); s += (v[j][0] + v[j][1]) + (v[j][2] + v[j][3]); }
        const float mean = wave_sum(s) * (1.0f / D); float q = 0.f;
#pragma unroll
        for (int j = 0; j < 4; ++j) { v[j] = v[j] - mean; q += (v[j][0] * v[j][0] + v[j][1] * v[j][1]) + (v[j][2] * v[j][2] + v[j][3] * v[j][3]); }
        const float rstd = 1.0f / sqrtf(wave_sum(q) * (1.0f / D) + LN_EPS);
#pragma unroll
        for (int j = 0; j < 4; ++j) { v[j] = v[j] * rstd * gg[j] + gb[j];
            *(f32x4*)(H + (size_t)row * D + 4 * lane + 256 * j) = v[j];
            u32x2 w; w.x = pk2(v[j][0], v[j][1]); w.y = pk2(v[j][2], v[j][3]); *(u32x2*)(HB + (size_t)row * D + 4 * lane + 256 * j) = w;
            *(unsigned*)(HB8 + (size_t)row * D + 4 * lane + 256 * j) = pk4_fp8(v[j][0], v[j][1], v[j][2], v[j][3]); }
        float pl[32];
#pragma unroll
        for (int e = 0; e < 32; ++e) { float a = 0.f;
#pragma unroll
            for (int j = 0; j < 4; ++j) { const f32x4 wv = *(const LAS f32x4*)(RWt + e * RWT_PITCH + 4 * lane + 256 * j); a += (v[j][0] * wv[0] + v[j][1] * wv[1]) + (v[j][2] * wv[2] + v[j][3] * wv[3]); }
            pl[e] = a; }
        float q16[16], q8[8], q4[4], q2[2], q1;
        { const bool hi = (lane & 32) != 0;
#pragma unroll
          for (int e = 0; e < 16; ++e) { const float mine = hi ? pl[16 + e] : pl[e], other = hi ? pl[e] : pl[16 + e]; q16[e] = mine + __shfl_xor(other, 32); } }
        { const bool hi = (lane & 16) != 0;
#pragma unroll
          for (int e = 0; e < 8; ++e) { const float mine = hi ? q16[8 + e] : q16[e], other = hi ? q16[e] : q16[8 + e]; q8[e] = mine + __shfl_xor(other, 16); } }
        { const bool hi = (lane & 8) != 0;
#pragma unroll
          for (int e = 0; e < 4; ++e) { const float mine = hi ? q8[4 + e] : q8[e], other = hi ? q8[e] : q8[4 + e]; q4[e] = mine + __shfl_xor(other, 8); } }
        { const bool hi = (lane & 4) != 0;
#pragma unroll
          for (int e = 0; e < 2; ++e) { const float mine = hi ? q4[2 + e] : q4[e], other = hi ? q4[e] : q4[2 + e]; q2[e] = mine + __shfl_xor(other, 4); } }
        { const bool hi = (lane & 2) != 0; const float mine = hi ? q2[1] : q2[0], other = hi ? q2[0] : q2[1]; q1 = mine + __shfl_xor(other, 2); }
        q1 += __shfl_xor(q1, 1);
        float lv = q1 + rbias; const int le = lane >> 1;
        float tv[4]; int te[4];
#pragma unroll
        for (int k = 0; k < 4; ++k) { float bv = lv; int be = le;
#pragma unroll
            for (int o = 1; o < 64; o <<= 1) { const float ov = __shfl_xor(bv, o); const int oe = __shfl_xor(be, o); if (ov > bv || (ov == bv && oe < be)) { bv = ov; be = oe; } }
            tv[k] = bv; te[k] = be; if (le == be) lv = -3.0e38f; }
        const float e1 = __expf(tv[1] - tv[0]), e2 = __expf(tv[2] - tv[0]), e3 = __expf(tv[3] - tv[0]); const float inv = 1.0f / (1.0f + e1 + e2 + e3);
        if (lane < 4) { const int ek = lane == 0 ? te[0] : lane == 1 ? te[1] : lane == 2 ? te[2] : te[3]; const float gk = (lane == 0 ? 1.0f : lane == 1 ? e1 : lane == 2 ? e2 : e3) * inv;
            eid[(size_t)row * 4 + lane] = ek; gatev[(size_t)row * 4 + lane] = gk; __hip_atomic_fetch_add(&hist[ek], 1u, __ATOMIC_RELAXED, __HIP_MEMORY_SCOPE_WORKGROUP); }
    }
    __syncthreads();
    if (tid < 32) bc[tid] = hist[tid];
}

__device__ __forceinline__ void phase_pos(const Ctx& C, int layer, int nrows) {
    PHASE_IDS
    const unsigned* bcAll = (const unsigned*)(C.ws + WS_CTL + CT_BC) + (size_t)layer * 256 * 32;
    const int* eid = (const int*)(C.ws + WS_CTL + CT_EID) + (size_t)layer * NTOK * 4; int* posv = (int*)(C.ws + WS_CTL + CT_POS) + (size_t)layer * NTOK * 4;
    int* texp = (int*)(C.ws + WS_CTL + CT_TEXP) + layer * 1024;
    const unsigned char* HB8 = C.ws + WS_HB8; unsigned char* XS = C.ws + WS_XS;
    LAS unsigned* partT = (LAS unsigned*)C.lds; LAS unsigned* partP = partT + 512; LAS unsigned* tot = partP + 512; LAS unsigned* cnt = tot + 32;
    { const int e = tid & 31, part = tid >> 5; unsigned t = 0, pr = 0;
      for (int bq = part; bq < C.G; bq += 16) { const unsigned v = __hip_atomic_load(bcAll + (size_t)bq * 32 + e, __ATOMIC_RELAXED, __HIP_MEMORY_SCOPE_AGENT); t += v; if (bq < C.bid) pr += v; }
      partT[part * 32 + e] = t; partP[part * 32 + e] = pr; }
    __syncthreads();
    if (tid < 32) { unsigned t = 0, pr = 0; for (int i = 0; i < 16; ++i) { t += partT[i * 32 + tid]; pr += partP[i * 32 + tid]; } tot[tid] = t; cnt[tid] = pr; }
    __syncthreads();
    if (tid < 32) { unsigned off = 0; for (int e = 0; e < tid; ++e) off += (tot[e] + 255u) & ~255u;
        const unsigned mine = (tot[tid] + 255u) & ~255u;
        if (C.bid == 0) { for (unsigned t = off >> 8; t < ((off + mine) >> 8); ++t) texp[t] = tid; if (tid == 31) texp[1023] = (int)((off + mine) >> 8); }
        cnt[tid] += off; }
    __syncthreads();
    const int gw = C.bid * NWAVES + wave, NGW = C.G * NWAVES;
    for (int row = gw; row < nrows; row += NGW) {
        int pos = 0;
        if (lane < 4) { const int e = eid[(size_t)row * 4 + lane]; pos = (int)__hip_atomic_fetch_add(&cnt[e], 1u, __ATOMIC_RELAXED, __HIP_MEMORY_SCOPE_WORKGROUP); posv[(size_t)row * 4 + lane] = pos; }
        const u32x4 r0 = *(const u32x4*)(HB8 + (size_t)row * D + 16 * lane);
#pragma unroll
        for (int k = 0; k < 4; ++k) { const int pk = __shfl(pos, k); *(u32x4*)(XS + (size_t)pk * D + 16 * lane) = r0; }
    }
}

__device__ __forceinline__ void phase_combine(const Ctx& C, int layer, int nrows, bool final_out) {
    PHASE_IDS
    float* H = (float*)(C.ws + WS_H); bf16_t* HB = (bf16_t*)(C.ws + WS_HB); const bf16_t* YS = (const bf16_t*)(C.ws + WS_YS);
    const float* lg = C.in[I_LNFG] + layer * D; const float* lb = C.in[I_LNFB] + layer * D;
    const float* gatev = (const float*)(C.ws + WS_CTL + CT_GATEV) + (size_t)layer * NTOK * 4; const int* posv = (const int*)(C.ws + WS_CTL + CT_POS) + (size_t)layer * NTOK * 4;
    f32x4 gg[4], gb[4];
#pragma unroll
    for (int j = 0; j < 4; ++j) { gg[j] = *(const f32x4*)(lg + 4 * lane + 256 * j); gb[j] = *(const f32x4*)(lb + 4 * lane + 256 * j); }
    const int gw = C.bid * NWAVES + wave, NGW = C.G * NWAVES;
    for (int row = gw; row < nrows; row += NGW) {
        f32x4 v[4];
#pragma unroll
        for (int j = 0; j < 4; ++j) v[j] = *(const f32x4*)(H + (size_t)row * D + 4 * lane + 256 * j) * DN_ALPHA;
#pragma unroll
        for (int k = 0; k < 4; ++k) { const float gk = gatev[(size_t)row * 4 + k]; const int pk = posv[(size_t)row * 4 + k];
#pragma unroll
            for (int j = 0; j < 4; ++j) { const u32x2 w = *(const u32x2*)(YS + (size_t)pk * D + 4 * lane + 256 * j);
                v[j][0] += gk * bflo(w.x); v[j][1] += gk * bfhi(w.x); v[j][2] += gk * bflo(w.y); v[j][3] += gk * bfhi(w.y); } }
        float s = 0.f;
#pragma unroll
        for (int j = 0; j < 4; ++j) s += (v[j][0] + v[j][1]) + (v[j][2] + v[j][3]);
        const float mean = wave_sum(s) * (1.0f / D); float q = 0.f;
#pragma unroll
        for (int j = 0; j < 4; ++j) { v[j] = v[j] - mean; q += (v[j][0] * v[j][0] + v[j][1] * v[j][1]) + (v[j][2] * v[j][2] + v[j][3] * v[j][3]); }
        const float rstd = 1.0f / sqrtf(wave_sum(q) * (1.0f / D) + LN_EPS);
#pragma unroll
        for (int j = 0; j < 4; ++j) { v[j] = v[j] * rstd * gg[j] + gb[j];
            if (final_out) *(f32x4*)(C.out + (size_t)row * D + 4 * lane + 256 * j) = v[j];
            else { *(f32x4*)(H + (size_t)row * D + 4 * lane + 256 * j) = v[j];
                u32x2 w; w.x = pk2(v[j][0], v[j][1]); w.y = pk2(v[j][2], v[j][3]); *(u32x2*)(HB + (size_t)row * D + 4 * lane + 256 * j) = w; } }
    }
}

constexpr int AT_KS = 0, AT_VTS = 73728, AT_VPITCH = 1168, AT_KM = AT_VTS + 64 * AT_VPITCH, AT_VTM = AT_KM + 2048, AT_RPB = AT_VTM + 2048, AT_MB = AT_RPB + 1920, AT_END = AT_MB + 64;
static_assert(AT_END <= LDS_BYTES, "attention LDS map");
__device__ __forceinline__ void phase_attn(const Ctx& C) {
    PHASE_IDS
    const bf16_t* Q = (const bf16_t*)(C.ws + WS_Q); const bf16_t* Kx = (const bf16_t*)(C.ws + WS_K); const bf16_t* VT = (const bf16_t*)(C.ws + WS_VT); bf16_t* O = (bf16_t*)(C.ws + WS_O);
    const float* rpb = C.in[I_RPB]; const float* mbias = C.in[I_MBIAS];
    LAS unsigned char* lds = C.lds;
    const int w = wave, lq = lane & 15, g = lane >> 4;
    for (int unit = C.bid; unit < NB * 16 * 32; unit += C.G) {
        const int rp = unit & 31, h = (unit >> 5) & 15, b = unit >> 9;
        const int R0 = min(max(2 * rp - 4, 0), 55);
        __syncthreads();
#pragma unroll
        for (int i = 0; i < 9; ++i) { const int idx = tid + 512 * i, ch = idx & 7, kc = (idx >> 3) & 63, jr = idx >> 9;
            const u32x4 v = *(const u32x4*)(Kx + (size_t)(b * SEQ + (R0 + jr) * 64 + kc) * D + 64 * h + 8 * ch);
            *(LAS u32x4*)(lds + AT_KS + ((jr * 64 + kc) * 8 + (ch ^ (kc & 7))) * 16) = v; }
#pragma unroll
        for (int i = 0; i < 9; ++i) { const int idx = tid + 512 * i, d = idx / 72, cx = idx - d * 72;
            const u32x4 v = *(const u32x4*)(VT + (size_t)(64 * h + d) * MPAD + b * SEQ + R0 * 64 + 8 * cx);
            *(LAS u32x4*)(lds + AT_VTS + d * AT_VPITCH + cx * 16) = v; }
        if (tid < 128) { const int m = tid >> 3, ch = tid & 7;
            const u32x4 v = *(const u32x4*)(Kx + (size_t)(NGRID + 16 * b + m) * D + 64 * h + 8 * ch);
            *(LAS u32x4*)(lds + AT_KM + (m * 8 + (ch ^ (m & 7))) * 16) = v; }
        else if (tid < 256) { const int i = tid - 128, d = i >> 1, hf = i & 1;
            const u32x4 v = *(const u32x4*)(VT + (size_t)(64 * h + d) * MPAD + NGRID + 16 * b + 8 * hf);
            *(LAS u32x4*)(lds + AT_VTM + d * 32 + hf * 16) = v; }
        if (tid < 465) ((LAS float*)(lds + AT_RPB))[tid] = rpb[h * 465 + tid];
        if (tid < 16) ((LAS float*)(lds + AT_MB))[tid] = mbias[h * 16 + tid];
        __syncthreads();
        const int qr = w >> 2, qg = w & 3, r = 2 * rp + qr, c0 = 16 * qg;
        const int rs = min(max(r - 4, 0), 56), jr0 = rs - R0;
        const int kcb = qg == 0 ? 0 : (qg == 1 ? 8 : (qg == 2 ? 24 : 32));
        const size_t qrow = (size_t)(b * SEQ + r * 64 + c0 + lq);
        bf16x8 qf[2];
#pragma unroll
        for (int ks = 0; ks < 2; ++ks) qf[ks] = *(const bf16x8*)(Q + qrow * D + 64 * h + 32 * ks + 8 * g);
        f32x4 sc[8][2], sm;
#pragma unroll
        for (int j = 0; j < 8; ++j)
#pragma unroll
            for (int blk = 0; blk < 2; ++blk) { f32x4 a = {0.f, 0.f, 0.f, 0.f}; const int kc = kcb + 16 * blk + lq;
#pragma unroll
                for (int ks = 0; ks < 2; ++ks) { const bf16x8 kf = *(const LAS bf16x8*)(lds + AT_KS + (((jr0 + j) * 64 + kc) * 8 + ((4 * ks + g) ^ (kc & 7))) * 16);
                    a = __builtin_amdgcn_mfma_f32_16x16x32_bf16(kf, qf[ks], a, 0, 0, 0); }
                sc[j][blk] = a; }
        { f32x4 a = {0.f, 0.f, 0.f, 0.f};
#pragma unroll
          for (int ks = 0; ks < 2; ++ks) { const bf16x8 kf = *(const LAS bf16x8*)(lds + AT_KM + (lq * 8 + ((4 * ks + g) ^ (lq & 7))) * 16);
              a = __builtin_amdgcn_mfma_f32_16x16x32_bf16(kf, qf[ks], a, 0, 0, 0); }
          sm = a; }
        const int c = c0 + lq, cs = min(max(c - 8, 0), 48);
        const LAS float* RP = (const LAS float*)(lds + AT_RPB); const LAS float* MB = (const LAS float*)(lds + AT_MB);
        float mx = -3.0e38f;
#pragma unroll
        for (int j = 0; j < 8; ++j) { const int ro = rs + j - r + 7;
#pragma unroll
            for (int blk = 0; blk < 2; ++blk)
#pragma unroll
                for (int e = 0; e < 4; ++e) { const int kc = kcb + 16 * blk + 4 * g + e; const bool valid = kc >= cs && kc < cs + 16;
                    const float bias = RP[valid ? ro * 31 + (kc - c + 15) : 0];
                    const float s = valid ? sc[j][blk][e] + bias : -1.0e30f; sc[j][blk][e] = s; mx = fmaxf(mx, s); } }
#pragma unroll
        for (int e = 0; e < 4; ++e) { sm[e] += MB[4 * g + e]; mx = fmaxf(mx, sm[e]); }
        mx = fmaxf(mx, __shfl_xor(mx, 16)); mx = fmaxf(mx, __shfl_xor(mx, 32));
        float sum = 0.f;
#pragma unroll
        for (int j = 0; j < 8; ++j)
#pragma unroll
            for (int blk = 0; blk < 2; ++blk)
#pragma unroll
                for (int e = 0; e < 4; ++e) { const float pv = fast_exp2((sc[j][blk][e] - mx) * 1.44269504089f); sc[j][blk][e] = pv; sum += pv; }
#pragma unroll
        for (int e = 0; e < 4; ++e) { const float pv = fast_exp2((sm[e] - mx) * 1.44269504089f); sm[e] = pv; sum += pv; }
        sum += __shfl_xor(sum, 16); sum += __shfl_xor(sum, 32);
        f32x4 o[4];
#pragma unroll
        for (int db = 0; db < 4; ++db) o[db] = (f32x4){0.f, 0.f, 0.f, 0.f};
#pragma unroll
        for (int j = 0; j < 8; ++j) {
            u32x4 pw; pw.x = cvt_pk_bf16(sc[j][0][0], sc[j][0][1]); pw.y = cvt_pk_bf16(sc[j][0][2], sc[j][0][3]); pw.z = cvt_pk_bf16(sc[j][1][0], sc[j][1][1]); pw.w = cvt_pk_bf16(sc[j][1][2], sc[j][1][3]);
            const bf16x8 pb = __builtin_bit_cast(bf16x8, pw);
#pragma unroll
            for (int db = 0; db < 4; ++db) { const int d = 16 * db + lq; const LAS unsigned char* vp = lds + AT_VTS + d * AT_VPITCH + ((jr0 + j) * 64 + kcb + 4 * g) * 2;
                const u32x2 lo = *(const LAS u32x2*)vp, hi = *(const LAS u32x2*)(vp + 32);
                u32x4 aw; aw.x = lo.x; aw.y = lo.y; aw.z = hi.x; aw.w = hi.y;
                o[db] = __builtin_amdgcn_mfma_f32_16x16x32_bf16(__builtin_bit_cast(bf16x8, aw), pb, o[db], 0, 0, 0); }
        }
        { u32x4 pw; pw.x = cvt_pk_bf16(sm[0], sm[1]); pw.y = cvt_pk_bf16(sm[2], sm[3]); pw.z = 0u; pw.w = 0u; const bf16x8 pb = __builtin_bit_cast(bf16x8, pw);
#pragma unroll
          for (int db = 0; db < 4; ++db) { const int d = 16 * db + lq; const u32x2 lo = *(const LAS u32x2*)(lds + AT_VTM + d * 32 + 8 * g);
              u32x4 aw; aw.x = lo.x; aw.y = lo.y; aw.z = 0u; aw.w = 0u;
              o[db] = __builtin_amdgcn_mfma_f32_16x16x32_bf16(__builtin_bit_cast(bf16x8, aw), pb, o[db], 0, 0, 0); } }
        const float inv = 1.0f / sum;
#pragma unroll
        for (int db = 0; db < 4; ++db) { u32x2 ow; ow.x = cvt_pk_bf16(o[db][0] * inv, o[db][1] * inv); ow.y = cvt_pk_bf16(o[db][2] * inv, o[db][3] * inv);
            *(u32x2*)(O + qrow * D + 64 * h + 16 * db + 4 * g) = ow; }
    }
}


#define XB_TMO      128
#define XB_XCNT(j)  (256  + 64 * (j))
#define XB_XSUB(j)  (1280 + 64 * (j))
#define XB_XGEN(j)  (2304 + 64 * (j))
#define XB_TOP      3328
#define XB_TOPGEN   3392
#define XCD_BAR_WORDS 3456
#define XB_SPIN_CAP (1u << 22)
__device__ __forceinline__ unsigned xb_ld(unsigned* p)              { return __hip_atomic_load(p, __ATOMIC_RELAXED, __HIP_MEMORY_SCOPE_AGENT); }
__device__ __forceinline__ unsigned xb_add(unsigned* p, unsigned v) { return __hip_atomic_fetch_add(p, v, __ATOMIC_RELAXED, __HIP_MEMORY_SCOPE_AGENT); }
__device__ __forceinline__ unsigned xb_xcc_id() { return (unsigned)__builtin_amdgcn_s_getreg((3 << 11) | 20) & 0xFu; }
#define XB_SPIN(cond, bar) do { unsigned _sp = 0; while (cond) { __builtin_amdgcn_s_sleep(1); \
    if ((++_sp & 255u) == 0u) { if (xb_ld(&(bar)[XB_TMO])) break; if (_sp > XB_SPIN_CAP) { atomicAdd(&(bar)[XB_TMO], 1u); break; } } } } while (0)
struct XcdBarrier { unsigned* bar; unsigned x; volatile LAS unsigned* st; };
__device__ __forceinline__ XcdBarrier xcd_barrier_post(unsigned* bar, volatile LAS unsigned* st) {
    XcdBarrier b; b.bar = bar; b.x = xb_xcc_id(); b.st = st;
    if (threadIdx.x == 0) (void)xb_add(&bar[XB_XCNT(b.x)], 1u);
    return b;
}
__device__ __forceinline__ void xcd_barrier_complete(unsigned* bar, unsigned x, unsigned& nloc, unsigned& nx) {
    const unsigned G = gridDim.x * gridDim.y * gridDim.z;
    unsigned sum, cnt, mine, sp = 0u;
    for (;;) {
        sum = 0u; cnt = 0u; mine = 0u;
#pragma unroll
        for (unsigned j = 0; j < 16; ++j) { const unsigned c = xb_ld(&bar[XB_XCNT(j)]); sum += c; cnt += (c > 0u) ? 1u : 0u; mine = (j == x) ? c : mine; }
        if (sum == G) break;
        __builtin_amdgcn_s_sleep(1);
        if ((++sp & 255u) == 0u) { if (xb_ld(&bar[XB_TMO])) break; if (sp > XB_SPIN_CAP) { atomicAdd(&bar[XB_TMO], 1u); break; } }
    }
    nloc = mine > 0u ? mine : 1u; nx = cnt > 0u ? cnt : 1u;
}
__device__ __forceinline__ void xcd_barrier(const XcdBarrier& b) {
    asm volatile("s_waitcnt vmcnt(0)" ::: "memory");
    __syncthreads();
    if (threadIdx.x == 0) {
        unsigned* bar = b.bar;
        __builtin_amdgcn_s_waitcnt(0);
        unsigned nloc = b.st[0], nx = b.st[1];
        if (nloc == 0u) { xcd_barrier_complete(bar, b.x, nloc, nx); b.st[0] = nloc; b.st[1] = nx; }
        const unsigned old = xb_add(&bar[XB_XSUB(b.x)], 1u);
        const unsigned gen = old / nloc;
        if (old + 1u == (gen + 1u) * nloc) {
            __builtin_amdgcn_fence(__ATOMIC_RELEASE, "agent");
            asm volatile("s_waitcnt vmcnt(0)" ::: "memory");
            const unsigned og = xb_add(&bar[XB_TOP], 1u);
            const unsigned tg = og / nx;
            if (og + 1u == (tg + 1u) * nx) xb_add(&bar[XB_TOPGEN], 1u);
            else XB_SPIN(xb_ld(&bar[XB_TOPGEN]) == tg, bar);
            __builtin_amdgcn_fence(__ATOMIC_ACQUIRE, "agent");
            xb_add(&bar[XB_XGEN(b.x)], 1u);
            asm volatile("s_waitcnt vmcnt(0)" ::: "memory");
        } else {
            XB_SPIN(xb_ld(&bar[XB_XGEN(b.x)]) == gen, bar);
            __builtin_amdgcn_fence(__ATOMIC_ACQUIRE, "agent");
            asm volatile("s_waitcnt vmcnt(0)" ::: "memory");
        }
    }
    __syncthreads();
}
constexpr size_t CT_BAR = 131072;
constexpr int LDS_BARST = LDS_BYTES - 64;

constexpr int N_PHASES = 20;
__global__ void __launch_bounds__(NTHREADS, 2) hybrid_fwd(Params P) {
    extern __shared__ __attribute__((aligned(16))) unsigned char smem[];
    cg::grid_group grid = cg::this_grid();
    Ctx C; C.lds = (LAS unsigned char*)smem; C.G = gridDim.x; C.bid = blockIdx.x;
    C.ws = P.ws; C.in = P.in; C.out = P.out;
    unsigned char* ws = P.ws;
    const int lo = P.ph_lo, hi = P.ph_hi;
#ifndef PH_MASK
#define PH_MASK 0xFFFFFFFFu
#endif
#define IN(k) (((PH_MASK >> (k)) & 1u) && lo <= (k) && (k) < hi)
#ifndef REPEAT_MASK
#define REPEAT_MASK 0u
#endif
#define REPS(k) ((((unsigned)REPEAT_MASK >> (k)) & 1u) ? 2 : 1)
#ifndef N_CG_SYNCS
#define N_CG_SYNCS 1
#endif
#define SEAM(k) do { if (IN(k) && IN((k) + 1)) { if ((k) < N_CG_SYNCS) grid.sync(); else xcd_barrier(bar); } } while (0)
    if (threadIdx.x < 16) ((LAS unsigned*)(smem + LDS_BARST))[threadIdx.x] = 0u;
    __syncthreads();
    const XcdBarrier bar = xcd_barrier_post((unsigned*)(ws + WS_CTL + CT_BAR), (volatile LAS unsigned*)(smem + LDS_BARST));
    #define PH_BODY_0 phase_convert(C);
    if (IN(0)) { PH_BODY_0 } if (REPS(0) > 1 && IN(0)) { xcd_barrier(bar); PH_BODY_0 }
    SEAM(0);
    #define PH_BODY_1 { DenseSched S{(unsigned)WS_HB, (unsigned)WS_WIN, 1024, 1024, 129, 8, C.G, C.bid}; EpiWin E{(bf16_t*)(ws + WS_XR), (bf16_t*)(ws + WS_GY)}; \
        pg8::gemm_phase<false>(C.lds, ws, 1024, 1024, 1024, S, E); }
    if (IN(1)) { PH_BODY_1 } if (REPS(1) > 1 && IN(1)) { xcd_barrier(bar); PH_BODY_1 }
    SEAM(1);
    #define PH_BODY_2 phase_conv(C);
    if (IN(2)) { PH_BODY_2 } if (REPS(2) > 1 && IN(2)) { xcd_barrier(bar); PH_BODY_2 }
    SEAM(2);
    #define PH_BODY_3 { GateSched S{(unsigned)WS_XC, (unsigned)WS_GATE, 129, C.G, C.bid}; \
        EpiGate E{(const bf16_t*)(ws + WS_XC), (bf16_t*)(ws + WS_LA), (bf16_t*)(ws + WS_BB), P.in[I_BA], P.in[I_BX], (const float*)(ws + WS_CTL + CT_SPL)}; \
        pg8::gemm_phase<false>(C.lds, ws, 256, 1024, 256, S, E); }
    if (IN(3)) { PH_BODY_3 } if (REPS(3) > 1 && IN(3)) { xcd_barrier(bar); PH_BODY_3 }
    SEAM(3);
    #define PH_BODY_4 phase_scan(C);
    if (IN(4)) { PH_BODY_4 } if (REPS(4) > 1 && IN(4)) { xcd_barrier(bar); PH_BODY_4 }
    SEAM(4);
    #define PH_BODY_5 { DenseSched S{(unsigned)WS_G, (unsigned)WS_LOUT, 1024, 1024, 129, 4, C.G, C.bid}; EpiRes<true> E{(float*)(ws + WS_PRE), P.in[I_X], P.in[I_META], nullptr, NTOK}; \
        pg8::gemm_phase<false>(C.lds, ws, 1024, 1024, 1024, S, E); }
    if (IN(5)) { PH_BODY_5 } if (REPS(5) > 1 && IN(5)) { xcd_barrier(bar); PH_BODY_5 }
    SEAM(5);
    #define PH_BODY_6 phase_lnr(C, 0, NTOK);
    if (IN(6)) { PH_BODY_6 } if (REPS(6) > 1 && IN(6)) { xcd_barrier(bar); PH_BODY_6 }
    SEAM(6);
    #define PH_BODY_7 phase_pos(C, 0, NTOK);
    if (IN(7)) { PH_BODY_7 } if (REPS(7) > 1 && IN(7)) { xcd_barrier(bar); PH_BODY_7 }
    SEAM(7);
    #define PH_BODY_8 { const int* texp = (const int*)(ws + WS_CTL + CT_TEXP); const int nM = __builtin_amdgcn_readfirstlane(__hip_atomic_load(texp + 1023, __ATOMIC_RELAXED, __HIP_MEMORY_SCOPE_AGENT)); \
        MoeSched S{(unsigned)WS_XS, (unsigned)WS_WGU, texp, 2048u * 1024u, nM, 8, C.G, C.bid}; EpiGlu E{(unsigned char*)(ws + WS_ACT), P.in[I_BGU]}; \
        pg8::gemm_phase<true>(C.lds, ws, 512, 512, 512, S, E); }
    if (IN(8)) { PH_BODY_8 } if (REPS(8) > 1 && IN(8)) { xcd_barrier(bar); PH_BODY_8 }
    SEAM(8);
    #define PH_BODY_9 { const int* texp = (const int*)(ws + WS_CTL + CT_TEXP); const int nM = __builtin_amdgcn_readfirstlane(__hip_atomic_load(texp + 1023, __ATOMIC_RELAXED, __HIP_MEMORY_SCOPE_AGENT)); \
        MoeSched S{(unsigned)WS_ACT, (unsigned)WS_WD, texp, 1024u * 1024u, nM, 4, C.G, C.bid}; EpiDown E{(bf16_t*)(ws + WS_YS), P.in[I_BD]}; \
        pg8::gemm_phase<true>(C.lds, ws, 512, 512, 512, S, E); }
    if (IN(9)) { PH_BODY_9 } if (REPS(9) > 1 && IN(9)) { xcd_barrier(bar); PH_BODY_9 }
    SEAM(9);
    #define PH_BODY_10 phase_combine(C, 0, NTOK, false);
    if (IN(10)) { PH_BODY_10 } if (REPS(10) > 1 && IN(10)) { xcd_barrier(bar); PH_BODY_10 }
    SEAM(10);
    #define PH_BODY_11 { QkvSched S{(unsigned)WS_HB, (unsigned)WS_QKV, 129, C.G, C.bid}; EpiQkv E{(bf16_t*)(ws + WS_Q), (bf16_t*)(ws + WS_K), (bf16_t*)(ws + WS_VT)}; \
        pg8::gemm_phase<false>(C.lds, ws, 1024, 1024, 1024, S, E); }
    if (IN(11)) { PH_BODY_11 } if (REPS(11) > 1 && IN(11)) { xcd_barrier(bar); PH_BODY_11 }
    SEAM(11);
    #define PH_BODY_12 phase_attn(C);
    if (IN(12)) { PH_BODY_12 } if (REPS(12) > 1 && IN(12)) { xcd_barrier(bar); PH_BODY_12 }
    SEAM(12);
    #define PH_BODY_13 { DenseSched S{(unsigned)WS_O, (unsigned)WS_NOUT, 1024, 1024, 128, 4, C.G, C.bid}; EpiRes<false> E{(float*)(ws + WS_PRE), nullptr, nullptr, (const float*)(ws + WS_H), NGRID}; \
        pg8::gemm_phase<false>(C.lds, ws, 1024, 1024, 1024, S, E); }
    if (IN(13)) { PH_BODY_13 } if (REPS(13) > 1 && IN(13)) { xcd_barrier(bar); PH_BODY_13 }
    SEAM(13);
    #define PH_BODY_14 phase_lnr(C, 1, NGRID);
    if (IN(14)) { PH_BODY_14 } if (REPS(14) > 1 && IN(14)) { xcd_barrier(bar); PH_BODY_14 }
    SEAM(14);
    #define PH_BODY_15 phase_pos(C, 1, NGRID);
    if (IN(15)) { PH_BODY_15 } if (REPS(15) > 1 && IN(15)) { xcd_barrier(bar); PH_BODY_15 }
    SEAM(15);
    #define PH_BODY_16 { const int* texp = (const int*)(ws + WS_CTL + CT_TEXP) + 1024; const int nM = __builtin_amdgcn_readfirstlane(__hip_atomic_load(texp + 1023, __ATOMIC_RELAXED, __HIP_MEMORY_SCOPE_AGENT)); \
        MoeSched S{(unsigned)WS_XS, (unsigned)(WS_WGU + (size_t)32 * 2048 * 1024), texp, 2048u * 1024u, nM, 8, C.G, C.bid}; EpiGlu E{(unsigned char*)(ws + WS_ACT), P.in[I_BGU] + 32 * 2048}; \
        pg8::gemm_phase<true>(C.lds, ws, 512, 512, 512, S, E); }
    if (IN(16)) { PH_BODY_16 } if (REPS(16) > 1 && IN(16)) { xcd_barrier(bar); PH_BODY_16 }
    SEAM(16);
    #define PH_BODY_17 { const int* texp = (const int*)(ws + WS_CTL + CT_TEXP) + 1024; const int nM = __builtin_amdgcn_readfirstlane(__hip_atomic_load(texp + 1023, __ATOMIC_RELAXED, __HIP_MEMORY_SCOPE_AGENT)); \
        MoeSched S{(unsigned)WS_ACT, (unsigned)(WS_WD + (size_t)32 * 1024 * 1024), texp, 1024u * 1024u, nM, 4, C.G, C.bid}; EpiDown E{(bf16_t*)(ws + WS_YS), P.in[I_BD] + 32 * 1024}; \
        pg8::gemm_phase<true>(C.lds, ws, 512, 512, 512, S, E); }
    if (IN(17)) { PH_BODY_17 } if (REPS(17) > 1 && IN(17)) { xcd_barrier(bar); PH_BODY_17 }
    SEAM(17);
    #define PH_BODY_18 phase_combine(C, 1, NGRID, true);
    if (IN(18)) { PH_BODY_18 } if (REPS(18) > 1 && IN(18)) { xcd_barrier(bar); PH_BODY_18 }
#undef IN
#undef SEAM
}

#ifndef MK_PER_PHASE
#define MK_PER_PHASE 0
#endif
extern "C" void kernel_launch(void* const* d_in, const int* in_sizes, int n_in, void* d_out, int out_size, void* d_ws, size_t ws_size, hipStream_t stream) {
    static int grid = 0;
    if (grid == 0) {
        if (n_in != 25 || ws_size < WS_END || out_size != NGRID * D) { fprintf(stderr, "kernel_launch: unexpected problem (n_in %d, ws %zu, out %d)\n", n_in, ws_size, out_size); grid = -1; return; }
        int dev = 0, cus = 0, per_cu = 0;
        if (hipGetDevice(&dev) != hipSuccess || hipDeviceGetAttribute(&cus, hipDeviceAttributeMultiprocessorCount, dev) != hipSuccess) { grid = -1; return; }
        if (hipFuncSetAttribute((const void*)hybrid_fwd, hipFuncAttributeMaxDynamicSharedMemorySize, LDS_BYTES) != hipSuccess) { fprintf(stderr, "kernel_launch: hipFuncSetAttribute failed\n"); grid = -1; return; }
        if (hipOccupancyMaxActiveBlocksPerMultiprocessor(&per_cu, (const void*)hybrid_fwd, NTHREADS, LDS_BYTES) != hipSuccess || per_cu < 1) { fprintf(stderr, "kernel_launch: occupancy query failed (%d)\n", per_cu); grid = -1; return; }
        grid = cus * 1;
        if (grid > 256) grid = 256;
    }
    if (grid < 0) return;
    if (hipMemsetAsync((char*)d_ws + WS_CTL + CT_BAR, 0, 16384, stream) != hipSuccess) { fprintf(stderr, "kernel_launch: memset failed\n"); return; }
    Params p{};
    for (int i = 0; i < 25; ++i) p.in[i] = (const float*)d_in[i];
    p.out = (float*)d_out; p.ws = (unsigned char*)d_ws;
#if MK_PER_PHASE
    for (int ph = 0; ph < 19; ++ph) { p.ph_lo = ph; p.ph_hi = ph + 1; void* args[] = {&p};
        hipError_t e = hipLaunchCooperativeKernel((void*)hybrid_fwd, dim3(grid), dim3(NTHREADS), args, LDS_BYTES, stream);
        if (e != hipSuccess) { fprintf(stderr, "launch phase %d failed: %s\n", ph, hipGetErrorString(e)); break; } }
#else
    p.ph_lo = 0; p.ph_hi = 19; void* args[] = {&p};
    hipError_t e = hipLaunchCooperativeKernel((void*)hybrid_fwd, dim3(grid), dim3(NTHREADS), args, LDS_BYTES, stream);
    if (e != hipSuccess) fprintf(stderr, "cooperative launch failed: %s (grid %d)\n", hipGetErrorString(e), grid);
#endif
}
```

```cpp
#include <hip/hip_runtime.h>
#include <hip/hip_cooperative_groups.h>
#include <cstdio>
#include <cstdint>
namespace cg = cooperative_groups;

#define LAS __attribute__((address_space(3)))
typedef unsigned short bf16_t;
typedef short bf16x8 __attribute__((ext_vector_type(8)));
typedef float f32x4 __attribute__((ext_vector_type(4)));
typedef float f32x2 __attribute__((ext_vector_type(2)));
typedef unsigned u32x4 __attribute__((ext_vector_type(4)));
typedef unsigned u32x2 __attribute__((ext_vector_type(2)));

constexpr int NB = 8, SEQ = 4096, D = 1024, NMETA = 16, LSEQ = SEQ + NMETA;
constexpr int NGRID = NB * SEQ;
constexpr int NTOK = NGRID + NB * NMETA;
constexpr int MPAD = 33024;
constexpr int NEXP = 32, TOPK = 4;
constexpr int PMAX = 139776;
constexpr int MTMAX = PMAX / 256;
constexpr float DN_ALPHA = 1.41421356237f;
constexpr float LN_EPS = 1e-5f;
constexpr int NTHREADS = 512, NWAVES = 8;

constexpr size_t MiB = 1u << 20;
constexpr size_t ACT_BYTES = (size_t)MPAD * D * 2;
constexpr size_t WS_CTL   = 0;
constexpr size_t WS_WIN   = 4 * MiB;
constexpr size_t WS_GATE  = WS_WIN + 4 * MiB;
constexpr size_t WS_LOUT  = WS_GATE + 2 * MiB;
constexpr size_t WS_QKV   = WS_LOUT + 2 * MiB;
constexpr size_t WS_NOUT  = WS_QKV + 6 * MiB;
constexpr size_t WS_WGU   = WS_NOUT + 2 * MiB;
constexpr size_t WS_WD    = WS_WGU + 128 * MiB;
constexpr size_t WS_HB    = WS_WD + 64 * MiB;
constexpr size_t WS_HB8   = WS_HB + 65 * MiB;
constexpr size_t WS_PRE   = WS_HB8 + 33 * MiB;
constexpr size_t WS_H     = WS_PRE + 129 * MiB;
constexpr size_t WS_SCR   = WS_H + 129 * MiB;
constexpr size_t WS_XR = WS_SCR, WS_XC = WS_XR + 65 * MiB, WS_GY = WS_XC + 65 * MiB, WS_LA = WS_GY + 65 * MiB, WS_BB = WS_LA + 130 * MiB, WS_HF = WS_BB + 130 * MiB, WS_G = WS_HF + 65 * MiB;
constexpr size_t WS_SCR_END0 = WS_G + 65 * MiB;
constexpr size_t WS_XS = WS_SCR, WS_ACT = WS_XS + 137 * MiB, WS_YS = WS_ACT + 137 * MiB;
constexpr size_t WS_SCR_END1 = WS_YS + 274 * MiB;
constexpr size_t WS_Q = WS_SCR, WS_K = WS_Q + 65 * MiB, WS_VT = WS_K + 65 * MiB, WS_O = WS_VT + 65 * MiB;
constexpr size_t WS_END = (WS_SCR_END0 > WS_SCR_END1 ? WS_SCR_END0 : WS_SCR_END1);
static_assert(ACT_BYTES <= 65 * MiB && (size_t)PMAX * D * 2 <= 274 * MiB && (size_t)PMAX * D <= 137 * MiB && (size_t)MPAD * D <= 33 * MiB && (size_t)MPAD * D * 4 <= 129 * MiB, "ws map");
static_assert(WS_END <= (size_t)2040 * MiB, "ws map must fit 4x the largest input tensor");
constexpr size_t CT_BC      = 4096;
constexpr size_t CT_TEXP    = CT_BC + 2 * 256 * 32 * 4;
constexpr size_t CT_SPL     = CT_TEXP + 2 * 1024 * 4;
constexpr size_t CT_EID     = 256 * 1024;
constexpr size_t CT_GATEV   = CT_EID + 2 * (size_t)NTOK * 4 * 4;
constexpr size_t CT_POS     = CT_GATEV + 2 * (size_t)NTOK * 4 * 4;
static_assert(CT_POS + 2 * (size_t)NTOK * 4 * 4 <= 4 * MiB, "ctl map");

constexpr int LDS_BYTES = 155648;

__device__ __forceinline__ unsigned f2bf(float f) { unsigned u = __builtin_bit_cast(unsigned, f); return (u + 0x7fffu + ((u >> 16) & 1u)) >> 16; }
__device__ __forceinline__ unsigned pk2(float lo, float hi) { return f2bf(lo) | (f2bf(hi) << 16); }
__device__ __forceinline__ unsigned cvt_pk_bf16(float lo, float hi) { unsigned r; asm volatile("v_cvt_pk_bf16_f32 %0, %1, %2" : "=v"(r) : "v"(lo), "v"(hi)); return r; }
__device__ __forceinline__ unsigned pk4_fp8(float a, float b, float c, float d) { int w = __builtin_amdgcn_cvt_pk_fp8_f32(a, b, 0, false); w = __builtin_amdgcn_cvt_pk_fp8_f32(c, d, w, true); return (unsigned)w; }
__device__ __forceinline__ float bflo(unsigned w) { return __builtin_bit_cast(float, w << 16); }
__device__ __forceinline__ float bfhi(unsigned w) { return __builtin_bit_cast(float, w & 0xffff0000u); }
__device__ __forceinline__ float fast_exp2(float x) { return __builtin_amdgcn_exp2f(x); }
__device__ __forceinline__ float fast_rcp(float x) { return __builtin_amdgcn_rcpf(x); }
__device__ __forceinline__ float sigmoidf_(float x) { return fast_rcp(1.0f + fast_exp2(-1.44269504089f * x)); }
__device__ __forceinline__ float wave_sum(float v) {
#pragma unroll
    for (int o = 1; o < 64; o <<= 1) v += __shfl_xor(v, o);
    return v;
}
template <int CTRL> __device__ __forceinline__ float dpp_movf(float v) { return __builtin_bit_cast(float, __builtin_amdgcn_update_dpp(0, __builtin_bit_cast(int, v), CTRL, 0xf, 0xf, true)); }
__device__ __forceinline__ float readlane_f(float v, int l) { return __builtin_bit_cast(float, __builtin_amdgcn_readlane(__builtin_bit_cast(int, v), l)); }
__device__ __forceinline__ float wave_sum_dpp(float v) {
    v += dpp_movf<0xB1>(v);
    v += dpp_movf<0x4E>(v);
    v += dpp_movf<0x141>(v);
    v += dpp_movf<0x140>(v);
    return (readlane_f(v, 0) + readlane_f(v, 16)) + (readlane_f(v, 32) + readlane_f(v, 48));
}
__device__ __forceinline__ int seqrow(int b, int s) { return s < NMETA ? NGRID + NMETA * b + s : SEQ * b + (s - NMETA); }

struct Params {
    const float* in[25];
    float* out;
    unsigned char* ws;
    int ph_lo, ph_hi;
};
struct Ctx {
    LAS unsigned char* lds;
    int G, bid;
    unsigned char* ws;
    const float* const* in;
    float* out;
};
__device__ __forceinline__ int fresh_tid() { int t = threadIdx.x; asm volatile("" : "+v"(t)); return t; }
#define PHASE_IDS const int tid = fresh_tid(); const int lane = tid & 63; const int wave = __builtin_amdgcn_readfirstlane(tid >> 6); (void)lane; (void)wave;
enum { I_X = 0, I_META, I_WIN, I_CONVW, I_CONVB, I_WA, I_BA, I_WX, I_BX, I_LAM, I_LOUT, I_WQKV, I_RPB, I_MBIAS, I_NOUT, I_LNMG, I_LNMB, I_RW, I_RB, I_WGU, I_BGU, I_WD, I_BD, I_LNFG, I_LNFB };

namespace pg8 {
constexpr int BM = 256, BK = 64, HALF = 128, HTB = HALF * BK * 2, STAGE_BYTES = 8 * HTB, NXCD = 8, WGM = 8;
__device__ __forceinline__ int lds_byte(int r, int c) { const int st = (r >> 4) * 2 + (c >> 5), rr = r & 15, cc = c & 31, ob = rr * 64 + cc * 2; return st * 1024 + (ob ^ (((ob >> 9) & 1) << 5)); }
__device__ __forceinline__ void stage_rc(int b, int& R, int& C) { const int st = b / 1024, sb = b % 1024, swz = sb ^ (((sb >> 9) & 1) << 5); R = (st >> 1) * 16 + swz / 64; C = (st & 1) * 32 + (swz % 64) / 2; }
__device__ __forceinline__ int perm32(int rho) { const int n = rho >> 4, i = rho & 15; return 8 * (i >> 2) + 4 * n + (i & 3); }

typedef int v8i __attribute__((ext_vector_type(8)));
typedef int v4i __attribute__((ext_vector_type(4)));
__device__ __forceinline__ v8i cat8(bf16x8 a, bf16x8 b) { const v4i x = __builtin_bit_cast(v4i, a), y = __builtin_bit_cast(v4i, b); return __builtin_shufflevector(x, y, 0, 1, 2, 3, 4, 5, 6, 7); }
struct Unit { unsigned ao, bo; int pm, pn, aux; };

__device__ __forceinline__ void tile_of(int L, int nM, int nN, int& pm, int& pn) {
    const int nwg = nM * nN; int wgid = L;
    { const int q = nwg / NXCD, r = nwg % NXCD, xcd = wgid % NXCD, off = wgid / NXCD; wgid = (xcd < r ? xcd * (q + 1) : r * (q + 1) + (xcd - r) * q) + off; }
    const int nig = WGM * nN, gid = wgid / nig, fm = gid * WGM, gsz = (nM - fm) < WGM ? (nM - fm) : WGM;
    pm = fm + ((wgid % nig) % gsz); pn = (wgid % nig) / gsz;
}

template <bool F8, class Epi, class Sched>
__device__ __forceinline__ void gemm_phase(LAS unsigned char* lds, const unsigned char* wsbase, const int K, const int lda, const int ldb, const Sched& S, const Epi& E) {
    const __amdgpu_buffer_rsrc_t rsrc = __builtin_amdgcn_make_buffer_rsrc((void*)wsbase, 0, 0xFFFFFFFF, 0x00020000);
    const int tid = fresh_tid(), wid = __builtin_amdgcn_readfirstlane(tid >> 6), lane = tid & 63, wr = wid >> 2, wc = wid & 3;
    const int nt = K / BK;
    int voffA, voffB;
    { int R, C; stage_rc(tid * 16, R, C); const int Rb = Epi::PERM ? ((R & ~31) + perm32(R & 31)) : R; voffA = (R * lda + C) * 2; voffB = (Rb * ldb + C) * 2; }
    const unsigned kstep = (unsigned)(BK * 2);
    const unsigned hstepA = (unsigned)HALF * lda * 2, hstepB = (unsigned)HALF * ldb * 2;
    const unsigned ldsw = (unsigned)wid * 1024u;
    const int aoff = lds_byte(wr * 64 + (lane & 15), (lane >> 4) * 8), boff = lds_byte(wc * 32 + (lane & 15), (lane >> 4) * 8);
#define PG8_SA(b, h) (((b) * 2 + (h)) * HTB)
#define PG8_SB(b, h) ((4 + (b) * 2 + (h)) * HTB)
#define PG8_STAGE(bufoff, gbase, voff) do { _Pragma("unroll") for (int _i = 0; _i < 2; ++_i) \
        __builtin_amdgcn_raw_ptr_buffer_load_lds(rsrc, (LAS void*)(lds + (bufoff) + ldsw + _i * 8192), 16, voff, (int)((gbase) + (unsigned)_i * (hstep##voff >> 1)), 0, 0); } while (0)
#define hstepvoffA hstepA
#define hstepvoffB hstepB
#define PG8_LDA(dst, b, h) do { _Pragma("unroll") for (int m = 0; m < 4; ++m) _Pragma("unroll") for (int k = 0; k < 2; ++k) dst[m][k] = *(const LAS bf16x8*)(lds + PG8_SA(b, h) + aoff + m * 2048 + k * 1024); } while (0)
#define PG8_LDB(dst, b, h) do { _Pragma("unroll") for (int n = 0; n < 2; ++n) _Pragma("unroll") for (int k = 0; k < 2; ++k) dst[n][k] = *(const LAS bf16x8*)(lds + PG8_SB(b, h) + boff + n * 2048 + k * 1024); } while (0)
#define PG8_MMA(ai, bj, At, Bt) do { __builtin_amdgcn_s_setprio(1); _Pragma("unroll") for (int m = 0; m < 4; ++m) _Pragma("unroll") for (int n = 0; n < 2; ++n) { \
        if constexpr (F8) { acc[ai][bj][m][n] = __builtin_amdgcn_mfma_scale_f32_16x16x128_f8f6f4(cat8(Bt[n][0], Bt[n][1]), cat8(At[m][0], At[m][1]), acc[ai][bj][m][n], 0, 0, 0, Epi::SCALE_W, 0, Epi::SCALE_A); } \
        else { _Pragma("unroll") for (int k = 0; k < 2; ++k) acc[ai][bj][m][n] = __builtin_amdgcn_mfma_f32_16x16x32_bf16(Bt[n][k], At[m][k], acc[ai][bj][m][n], 0, 0, 0); } } \
        __builtin_amdgcn_s_setprio(0); } while (0)
#define PG8_WAIT_V(n) asm volatile("s_waitcnt vmcnt(" #n ")" ::: "memory")
#define PG8_WAIT_L(n) asm volatile("s_waitcnt lgkmcnt(" #n ")" ::: "memory")
#define PG8_BAR __builtin_amdgcn_s_barrier()
#define PG8_SCHED __builtin_amdgcn_sched_barrier(0)
    Unit cur, nxt; int ui = 0;
    if (!S.next(0, cur)) return;
    f32x4 acc[2][2][4][2];
#pragma unroll
    for (int a = 0; a < 2; ++a)
#pragma unroll
        for (int b = 0; b < 2; ++b)
#pragma unroll
            for (int m = 0; m < 4; ++m)
#pragma unroll
                for (int n = 0; n < 2; ++n) acc[a][b][m][n] = (f32x4){0.f, 0.f, 0.f, 0.f};
    bf16x8 At[4][2], B0[2][2], B1[2][2];
    unsigned cA = cur.ao, cB = cur.bo;
    PG8_STAGE(PG8_SB(0, 0), cB, voffB); PG8_STAGE(PG8_SB(0, 1), cB + hstepB, voffB); PG8_STAGE(PG8_SA(0, 0), cA, voffA); PG8_STAGE(PG8_SA(0, 1), cA + hstepA, voffA);
    if (wr == 1) PG8_BAR;
    PG8_WAIT_V(2); PG8_BAR;
    PG8_STAGE(PG8_SB(1, 0), cB + kstep, voffB); PG8_STAGE(PG8_SA(1, 0), cA + kstep, voffA); PG8_STAGE(PG8_SB(1, 1), cB + hstepB + kstep, voffB);
    PG8_WAIT_V(6); PG8_BAR;
    for (;;) {
        const bool has_next = S.next(ui + 1, nxt);
        const unsigned nA = has_next ? nxt.ao : cA, nB = has_next ? nxt.bo : cB;
#pragma unroll 1
        for (int t = 0; t < nt; t += 2) {
            const bool last = (t == nt - 2);
            const unsigned a1 = cA + (unsigned)(t + 1) * kstep;
            const unsigned a2 = last ? nA : cA + (unsigned)(t + 2) * kstep, b2 = last ? nB : cB + (unsigned)(t + 2) * kstep;
            const unsigned a3 = a2 + kstep, b3 = b2 + kstep;
            PG8_LDB(B0, 0, 0); PG8_LDB(B1, 0, 1); PG8_SCHED; PG8_LDA(At, 0, 0); PG8_STAGE(PG8_SA(1, 1), a1 + hstepA, voffA);
            PG8_WAIT_V(8); PG8_WAIT_L(0); PG8_BAR; PG8_MMA(0, 0, At, B0); PG8_MMA(0, 1, At, B1); PG8_BAR; PG8_SCHED;
            PG8_LDA(At, 0, 1); PG8_STAGE(PG8_SB(0, 0), b2, voffB); PG8_STAGE(PG8_SB(0, 1), b2 + hstepB, voffB); PG8_STAGE(PG8_SA(0, 0), a2, voffA);
            PG8_WAIT_V(8); PG8_WAIT_L(0); PG8_BAR; PG8_MMA(1, 0, At, B0); PG8_MMA(1, 1, At, B1); PG8_BAR; PG8_SCHED;
            PG8_LDB(B0, 1, 0); PG8_LDB(B1, 1, 1); PG8_SCHED; PG8_LDA(At, 1, 0); PG8_STAGE(PG8_SA(0, 1), a2 + hstepA, voffA);
            PG8_WAIT_V(8); PG8_WAIT_L(0); PG8_BAR; PG8_MMA(0, 0, At, B0); PG8_MMA(0, 1, At, B1); PG8_BAR; PG8_SCHED;
            PG8_LDA(At, 1, 1); PG8_STAGE(PG8_SB(1, 0), b3, voffB); PG8_STAGE(PG8_SB(1, 1), b3 + hstepB, voffB); PG8_STAGE(PG8_SA(1, 0), a3, voffA);
            PG8_WAIT_V(8); PG8_WAIT_L(0); PG8_BAR; PG8_MMA(1, 0, At, B0); PG8_MMA(1, 1, At, B1); PG8_BAR; PG8_SCHED;
        }
        if (wr == 0) PG8_BAR;
        { const int l2 = fresh_tid() & 63; E(acc, cur, wr, wc, l2 & 15, l2 >> 4); }
        if (!has_next) break;
#pragma unroll
        for (int a = 0; a < 2; ++a)
#pragma unroll
            for (int b = 0; b < 2; ++b)
#pragma unroll
                for (int m = 0; m < 4; ++m)
#pragma unroll
                    for (int n = 0; n < 2; ++n) acc[a][b][m][n] = (f32x4){0.f, 0.f, 0.f, 0.f};
        cur = nxt; cA = nA; cB = nB; ++ui;
        if (wr == 1) PG8_BAR;
    }
    PG8_WAIT_V(0);
    PG8_BAR;
#undef PG8_SA
#undef PG8_SB
#undef PG8_STAGE
#undef hstepvoffA
#undef hstepvoffB
#undef PG8_LDA
#undef PG8_LDB
#undef PG8_MMA
#undef PG8_WAIT_V
#undef PG8_WAIT_L
#undef PG8_BAR
#undef PG8_SCHED
}
}

using pg8::Unit;

struct DenseSched {
    unsigned A, Bt; int lda, ldb, nM, nN, G, c;
    __device__ __forceinline__ bool next(int i, Unit& u) const {
        const int L = i * G + c; if (L >= nM * nN) return false;
        pg8::tile_of(L, nM, nN, u.pm, u.pn); u.aux = 0;
        u.ao = A + (unsigned)u.pm * 256 * lda * 2; u.bo = Bt + (unsigned)u.pn * 256 * ldb * 2; return true;
    }
};
struct GateSched {
    unsigned XC, GT; int nM, G, c;
    __device__ __forceinline__ bool next(int i, Unit& u) const {
        const int per = nM * 4; const int L = i * G + c; if (L >= 4 * per) return false;
        const int nb = L / per; pg8::tile_of(L - nb * per, nM, 4, u.pm, u.pn); u.aux = nb;
        u.ao = XC + ((unsigned)u.pm * 256 * 1024 + 256 * nb) * 2; u.bo = GT + ((unsigned)nb * 1024 + 256 * u.pn) * 256 * 2; return true;
    }
};
struct QkvSched {
    unsigned HB, WT; int nM, G, c;
    __device__ __forceinline__ bool next(int i, Unit& u) const {
        const int n0 = nM * 8, n1 = 4 * nM; const int L = i * G + c; if (L >= n0 + n1) return false;
        if (L < n0) { pg8::tile_of(L, nM, 8, u.pm, u.pn); u.aux = 0; u.ao = HB + (unsigned)u.pm * 256 * 1024 * 2; u.bo = WT + (unsigned)u.pn * 256 * 1024 * 2; }
        else { pg8::tile_of(L - n0, 4, nM, u.pm, u.pn); u.aux = 1; u.ao = WT + (unsigned)(2048 + u.pm * 256) * 1024 * 2; u.bo = HB + (unsigned)u.pn * 256 * 1024 * 2; }
        return true;
    }
};
struct MoeSched {
    unsigned A, W; const int* texp; unsigned wstride; int nM, nN, G, c;
    __device__ __forceinline__ bool next(int i, Unit& u) const {
        const int L = i * G + c; if (L >= nM * nN) return false;
        pg8::tile_of(L, nM, nN, u.pm, u.pn);
        const int e = __builtin_amdgcn_readfirstlane(__hip_atomic_load(texp + u.pm, __ATOMIC_RELAXED, __HIP_MEMORY_SCOPE_AGENT)); u.aux = e;
        u.ao = A + (unsigned)u.pm * 256 * 1024; u.bo = W + (unsigned)e * wstride + (unsigned)u.pn * 256 * 1024; return true;
    }
};

#define EPI_ARGS const f32x4 (&acc)[2][2][4][2], const Unit& u, int wr, int wc, int fr, int fq
struct EpiWin {
    static constexpr bool PERM = true;
    bf16_t* XR; bf16_t* GY;
    __device__ __forceinline__ void operator()(EPI_ARGS) const {
        const int row0 = u.pm * 256 + wr * 64 + fr;
        if (u.pn < 4) {
            const int col0 = u.pn * 256 + wc * 32 + 8 * fq;
#pragma unroll
            for (int ai = 0; ai < 2; ++ai)
#pragma unroll
                for (int m = 0; m < 4; ++m) { bf16_t* rowp = XR + (size_t)(row0 + ai * 128 + m * 16) * D + col0;
#pragma unroll
                    for (int bj = 0; bj < 2; ++bj) { const f32x4 v0 = acc[ai][bj][m][0], v1 = acc[ai][bj][m][1];
                        u32x4 w; w.x = cvt_pk_bf16(v0[0], v0[1]); w.y = cvt_pk_bf16(v0[2], v0[3]); w.z = cvt_pk_bf16(v1[0], v1[1]); w.w = cvt_pk_bf16(v1[2], v1[3]);
                        *(u32x4*)(rowp + bj * 128) = w; } }
        } else {
#pragma unroll
            for (int ai = 0; ai < 2; ++ai)
#pragma unroll
                for (int m = 0; m < 4; ++m) { const int row = row0 + ai * 128 + m * 16;
#pragma unroll
                    for (int bj = 0; bj < 2; ++bj) { const int g = (u.pn - 4) * 8 + bj * 4 + wc;
                        float o[8];
#pragma unroll
                        for (int n = 0; n < 2; ++n)
#pragma unroll
                            for (int j = 0; j < 4; ++j) { const float v = acc[ai][bj][m][n][j]; const float z = 1.5957691216f * (v + 0.044715f * v * v * v); o[n * 4 + j] = v * sigmoidf_(z); }
                        u32x4 w; w.x = cvt_pk_bf16(o[0], o[1]); w.y = cvt_pk_bf16(o[2], o[3]); w.z = cvt_pk_bf16(o[4], o[5]); w.w = cvt_pk_bf16(o[6], o[7]);
                        *(u32x4*)(GY + ((size_t)g * MPAD + row) * 32 + 8 * fq) = w; } }
        }
    }
};
struct EpiGate {
    static constexpr bool PERM = true;
    const bf16_t* XC; bf16_t* LA; bf16_t* BB; const float* ba; const float* bx; const float* spl;
    __device__ __forceinline__ void operator()(EPI_ARGS) const {
        const int nb = u.aux, dir = u.pn >> 1, half = u.pn & 1;
        const int ch0 = 256 * nb + 128 * half + 32 * wc + 8 * fq, g = ch0 >> 5;
        const int row0 = u.pm * 256 + wr * 64 + fr;
#pragma unroll
        for (int ai = 0; ai < 2; ++ai)
#pragma unroll
            for (int m = 0; m < 4; ++m) { const int row = row0 + ai * 128 + m * 16;
                if (row < NTOK) {
                    float cba[8], cbx[8], csp[8];
                                { const f32x4 t0 = *(const f32x4*)(ba + dir * 1024 + ch0), t1 = *(const f32x4*)(ba + dir * 1024 + ch0 + 4);
                      const f32x4 s0 = *(const f32x4*)(bx + dir * 1024 + ch0), s1 = *(const f32x4*)(bx + dir * 1024 + ch0 + 4);
                      const f32x4 p0 = *(const f32x4*)(spl + dir * 1024 + ch0), p1 = *(const f32x4*)(spl + dir * 1024 + ch0 + 4);
#pragma unroll
                      for (int j = 0; j < 4; ++j) { cba[j] = t0[j]; cba[4 + j] = t1[j]; cbx[j] = s0[j]; cbx[4 + j] = s1[j]; csp[j] = p0[j]; csp[4 + j] = p1[j]; } }
                    const u32x4 xw = *(const u32x4*)(XC + (size_t)row * D + ch0);
                    float xc[8] = {bflo(xw.x), bfhi(xw.x), bflo(xw.y), bfhi(xw.y), bflo(xw.z), bfhi(xw.z), bflo(xw.w), bfhi(xw.w)};
                    const bool start = dir == 0 ? (row >= NGRID && ((row - NGRID) & 15) == 0) : (row < NGRID && (row & (SEQ - 1)) == SEQ - 1);
                    float la[8], bb[8];
#pragma unroll
                    for (int n = 0; n < 2; ++n)
#pragma unroll
                        for (int j = 0; j < 4; ++j) { const int i = n * 4 + j;
                            const float ga = sigmoidf_(acc[ai][0][m][n][j] + cba[i]), gx = sigmoidf_(acc[ai][1][m][n][j] + cbx[i]);
                            const float l2 = -csp[i] * ga;
                            const float a2 = fast_exp2(2.0f * l2);
                            const float mult = start ? 1.0f : __builtin_sqrtf(fmaxf(1.0f - a2, 0.0f));
                            la[i] = l2; bb[i] = mult * gx * xc[i]; }
                    u32x4 w; w.x = cvt_pk_bf16(la[0], la[1]); w.y = cvt_pk_bf16(la[2], la[3]); w.z = cvt_pk_bf16(la[4], la[5]); w.w = cvt_pk_bf16(la[6], la[7]);
                    const size_t o = (((size_t)dir * 32 + g) * MPAD + row) * 32 + 8 * fq;
                    *(u32x4*)(LA + o) = w;
                    w.x = cvt_pk_bf16(bb[0], bb[1]); w.y = cvt_pk_bf16(bb[2], bb[3]); w.z = cvt_pk_bf16(bb[4], bb[5]); w.w = cvt_pk_bf16(bb[6], bb[7]);
                    *(u32x4*)(BB + o) = w;
                }
                asm volatile("" ::: "memory"); }
    }
};
template <bool LAYER0> struct EpiRes {
    static constexpr bool PERM = true;
    bf16_t* PRE; const float* x; const float* meta; const bf16_t* HB; int nrows;
    __device__ __forceinline__ void operator()(EPI_ARGS) const {
        const int row0 = u.pm * 256 + wr * 64 + fr, col0 = u.pn * 256 + wc * 32 + 8 * fq;
#pragma unroll
        for (int ai = 0; ai < 2; ++ai)
#pragma unroll
            for (int m = 0; m < 4; ++m) { const int row = row0 + ai * 128 + m * 16;
                if (row < nrows) {
#pragma unroll
                    for (int bj = 0; bj < 2; ++bj) { const int c = col0 + bj * 128; float r[8];
                        if (LAYER0) { const float* rp = (row < NGRID ? x + (size_t)row * D : meta + (size_t)((row - NGRID) & 15) * D) + c; const f32x4 r0 = *(const f32x4*)rp, r1 = *(const f32x4*)(rp + 4);
                            r[0] = r0[0]; r[1] = r0[1]; r[2] = r0[2]; r[3] = r0[3]; r[4] = r1[0]; r[5] = r1[1]; r[6] = r1[2]; r[7] = r1[3]; }
                        else { const u32x4 rw = *(const u32x4*)(HB + (size_t)row * D + c); r[0] = bflo(rw.x); r[1] = bfhi(rw.x); r[2] = bflo(rw.y); r[3] = bfhi(rw.y); r[4] = bflo(rw.z); r[5] = bfhi(rw.z); r[6] = bflo(rw.w); r[7] = bfhi(rw.w); }
                        const f32x4 a0 = acc[ai][bj][m][0], a1 = acc[ai][bj][m][1];
                        u32x4 w; w.x = cvt_pk_bf16(r[0] * DN_ALPHA + a0[0], r[1] * DN_ALPHA + a0[1]); w.y = cvt_pk_bf16(r[2] * DN_ALPHA + a0[2], r[3] * DN_ALPHA + a0[3]);
                        w.z = cvt_pk_bf16(r[4] * DN_ALPHA + a1[0], r[5] * DN_ALPHA + a1[1]); w.w = cvt_pk_bf16(r[6] * DN_ALPHA + a1[2], r[7] * DN_ALPHA + a1[3]);
                        *(u32x4*)(PRE + (size_t)row * D + c) = w; }
                }
                asm volatile("" ::: "memory"); }
    }
};
struct EpiGlu {
    static constexpr bool PERM = true; static constexpr int SCALE_W = 0x79797979, SCALE_A = 0x7F7F7F7F;
    unsigned char* ACT; const float* bgu;
    __device__ __forceinline__ void operator()(EPI_ARGS) const {
        const int e = u.aux, f0 = 128 * u.pn + 32 * wc + 8 * fq;
        float bg[8], bl[8];
        { const float* p = bgu + (size_t)e * 2048 + f0; const f32x4 a0 = *(const f32x4*)p, a1 = *(const f32x4*)(p + 4), c0 = *(const f32x4*)(p + 1024), c1 = *(const f32x4*)(p + 1028);
#pragma unroll
          for (int j = 0; j < 4; ++j) { bg[j] = a0[j]; bg[4 + j] = a1[j]; bl[j] = c0[j]; bl[4 + j] = c1[j]; } }
        const int row0 = u.pm * 256 + wr * 64 + fr;
#pragma unroll
        for (int ai = 0; ai < 2; ++ai)
#pragma unroll
            for (int m = 0; m < 4; ++m) { const int row = row0 + ai * 128 + m * 16; float o[8];
#pragma unroll
                for (int n = 0; n < 2; ++n)
#pragma unroll
                    for (int j = 0; j < 4; ++j) { const int i = n * 4 + j;
                        const float glu = fminf(acc[ai][0][m][n][j] + bg[i], 7.0f);
                        const float lin = fminf(fmaxf(acc[ai][1][m][n][j] + bl[i], -7.0f), 7.0f);
                        o[i] = glu * sigmoidf_(1.702f * glu) * (lin + 1.0f); }
                u32x2 w; w.x = pk4_fp8(o[0] * 4.0f, o[1] * 4.0f, o[2] * 4.0f, o[3] * 4.0f); w.y = pk4_fp8(o[4] * 4.0f, o[5] * 4.0f, o[6] * 4.0f, o[7] * 4.0f);
                *(u32x2*)(ACT + (size_t)row * D + f0) = w; }
    }
};
struct EpiDown {
    static constexpr bool PERM = true; static constexpr int SCALE_W = 0x79797979, SCALE_A = 0x7D7D7D7D;
    bf16_t* YS; const float* bd;
    __device__ __forceinline__ void operator()(EPI_ARGS) const {
        const int e = u.aux, row0 = u.pm * 256 + wr * 64 + fr, col0 = u.pn * 256 + wc * 32 + 8 * fq;
        f32x4 bv[2][2];
#pragma unroll
        for (int bj = 0; bj < 2; ++bj)
#pragma unroll
            for (int n = 0; n < 2; ++n) bv[bj][n] = *(const f32x4*)(bd + (size_t)e * D + col0 + bj * 128 + 4 * n);
#pragma unroll
        for (int ai = 0; ai < 2; ++ai)
#pragma unroll
            for (int m = 0; m < 4; ++m) { bf16_t* rowp = YS + (size_t)(row0 + ai * 128 + m * 16) * D + col0;
#pragma unroll
                for (int bj = 0; bj < 2; ++bj) { const f32x4 v0 = acc[ai][bj][m][0] + bv[bj][0], v1 = acc[ai][bj][m][1] + bv[bj][1];
                    u32x4 w; w.x = cvt_pk_bf16(v0[0], v0[1]); w.y = cvt_pk_bf16(v0[2], v0[3]); w.z = cvt_pk_bf16(v1[0], v1[1]); w.w = cvt_pk_bf16(v1[2], v1[3]);
                    *(u32x4*)(rowp + bj * 128) = w; } }
    }
};
struct EpiQkv {
    static constexpr bool PERM = true;
    bf16_t* Q; bf16_t* Kx; bf16_t* VT;
    __device__ __forceinline__ void operator()(EPI_ARGS) const {
        const int row0 = u.pm * 256 + wr * 64 + fr; bf16_t* base; int ldc, colt; float sc = 1.0f;
        if (u.aux == 0) { ldc = D; if (u.pn < 4) { base = Q; colt = u.pn * 256; sc = 0.125f; } else { base = Kx; colt = (u.pn - 4) * 256; } }
        else { base = VT; ldc = MPAD; colt = u.pn * 256; }
        const int col0 = colt + wc * 32 + 8 * fq;
#pragma unroll
        for (int ai = 0; ai < 2; ++ai)
#pragma unroll
            for (int m = 0; m < 4; ++m) { bf16_t* rowp = base + (size_t)(row0 + ai * 128 + m * 16) * ldc + col0;
#pragma unroll
                for (int bj = 0; bj < 2; ++bj) { const f32x4 v0 = acc[ai][bj][m][0] * sc, v1 = acc[ai][bj][m][1] * sc;
                    u32x4 w; w.x = cvt_pk_bf16(v0[0], v0[1]); w.y = cvt_pk_bf16(v0[2], v0[3]); w.z = cvt_pk_bf16(v1[0], v1[1]); w.w = cvt_pk_bf16(v1[2], v1[3]);
                    *(u32x4*)(rowp + bj * 128) = w; } }
    }
};

__device__ __forceinline__ void tr_item(const float* W, int ld, int kb, int n0, bf16_t* dst0, int K, LAS float* scr, int lane) {
    const int r = lane >> 4, q = lane & 15;
    f32x4 v[16];
#pragma unroll
    for (int i = 0; i < 16; ++i) v[i] = *(const f32x4*)(W + (size_t)(64 * kb + 4 * i + r) * ld + n0 + 4 * q);
#pragma unroll
    for (int i = 0; i < 16; ++i) { LAS float* s = scr + (4 * i + r) * 65 + 4 * q; s[0] = v[i][0]; s[1] = v[i][1]; s[2] = v[i][2]; s[3] = v[i][3]; }
    asm volatile("s_waitcnt lgkmcnt(0)" ::: "memory");
    const int c = lane & 7, nn = lane >> 3;
#pragma unroll
    for (int j = 0; j < 8; ++j) { const int n = nn + 8 * j; const LAS float* s = scr + (8 * c) * 65 + n;
        u32x4 o; o.x = pk2(s[0], s[65]); o.y = pk2(s[2 * 65], s[3 * 65]); o.z = pk2(s[4 * 65], s[5 * 65]); o.w = pk2(s[6 * 65], s[7 * 65]);
        *(u32x4*)(dst0 + (size_t)n * K + 64 * kb + 8 * c) = o; }
    asm volatile("s_waitcnt lgkmcnt(0)" ::: "memory");
}
__device__ __forceinline__ void tr_item8(const float* W, int ld, int kb, int n0, unsigned char* dst0, int K, LAS float* scr, int lane) {
    const int r = lane >> 4, q = lane & 15;
    f32x4 v[16];
#pragma unroll
    for (int i = 0; i < 16; ++i) v[i] = *(const f32x4*)(W + (size_t)(64 * kb + 4 * i + r) * ld + n0 + 4 * q);
#pragma unroll
    for (int i = 0; i < 16; ++i) { LAS float* s = scr + (4 * i + r) * 65 + 4 * q; s[0] = v[i][0]; s[1] = v[i][1]; s[2] = v[i][2]; s[3] = v[i][3]; }
    asm volatile("s_waitcnt lgkmcnt(0)" ::: "memory");
    const int c = lane & 7, nn = lane >> 3;
#pragma unroll
    for (int j = 0; j < 8; ++j) { const int n = nn + 8 * j; const LAS float* s = scr + (8 * c) * 65 + n;
        u32x2 o; o.x = pk4_fp8(s[0] * 64.0f, s[65] * 64.0f, s[2 * 65] * 64.0f, s[3 * 65] * 64.0f); o.y = pk4_fp8(s[4 * 65] * 64.0f, s[5 * 65] * 64.0f, s[6 * 65] * 64.0f, s[7 * 65] * 64.0f);
        *(u32x2*)(dst0 + (size_t)n * K + 64 * kb + 8 * c) = o; }
    asm volatile("s_waitcnt lgkmcnt(0)" ::: "memory");
}
__device__ __forceinline__ void phase_convert(const Ctx& C) {
    PHASE_IDS
    LAS float* scr = (LAS float*)(C.lds + wave * 16640);
    const int gw = C.bid * NWAVES + wave, NGW = C.G * NWAVES;
    constexpr int I0 = 512, I1 = 256, I2 = 256, I3 = 768, I4 = 256, I5 = 32768, I6 = 16384, NIT = I0 + I1 + I2 + I3 + I4 + I5 + I6;
    for (int it = gw; it < NIT; it += NGW) {
        int r = it;
        if (r < I0) { const int nbk = r & 31, kb = r >> 5; tr_item(C.in[I_WIN], 2048, kb, 64 * nbk, (bf16_t*)(C.ws + WS_WIN) + (size_t)(64 * nbk) * 1024, 1024, scr, lane); continue; } r -= I0;
        if (r < I1) { const int job = r >> 3, sub = r & 7, nbk = sub & 1, kb = sub >> 1;
            const int half = job & 1, which = (job >> 1) & 1, nb = (job >> 2) & 3, dir = job >> 4;
            const float* src = C.in[which ? I_WX : I_WA] + (size_t)(dir * 4 + nb) * 65536;
            bf16_t* dst = (bf16_t*)(C.ws + WS_GATE) + ((size_t)nb * 1024 + 256 * (2 * dir + half) + 128 * which + 64 * nbk) * 256;
            tr_item(src, 256, kb, 128 * half + 64 * nbk, dst, 256, scr, lane); continue; } r -= I1;
        if (r < I2) { const int nbk = r & 15, kb = r >> 4; tr_item(C.in[I_LOUT], 1024, kb, 64 * nbk, (bf16_t*)(C.ws + WS_LOUT) + (size_t)(64 * nbk) * 1024, 1024, scr, lane); continue; } r -= I2;
        if (r < I3) { const int nbk = r % 48, kb = r / 48; tr_item(C.in[I_WQKV], 3072, kb, 64 * nbk, (bf16_t*)(C.ws + WS_QKV) + (size_t)(64 * nbk) * 1024, 1024, scr, lane); continue; } r -= I3;
        if (r < I4) { const int nbk = r & 15, kb = r >> 4; tr_item(C.in[I_NOUT], 1024, kb, 64 * nbk, (bf16_t*)(C.ws + WS_NOUT) + (size_t)(64 * nbk) * 1024, 1024, scr, lane); continue; } r -= I4;
        if (r < I5) { const int mat = r >> 9, sub = r & 511, nbk = sub & 31, kb = sub >> 5; const int n0 = 64 * nbk, bj = n0 >> 10, f0 = n0 & 1023, pn = f0 >> 7, jj = f0 & 127;
            tr_item8(C.in[I_WGU] + (size_t)mat * 1024 * 2048, 2048, kb, n0, (unsigned char*)(C.ws + WS_WGU) + ((size_t)mat * 2048 + 256 * pn + 128 * bj + jj) * 1024, 1024, scr, lane); continue; } r -= I5;
        { const int mat = r >> 8, sub = r & 255, nbk = sub & 15, kb = sub >> 4;
            tr_item8(C.in[I_WD] + (size_t)mat * 1024 * 1024, 1024, kb, 64 * nbk, (unsigned char*)(C.ws + WS_WD) + ((size_t)mat * 1024 + 64 * nbk) * 1024, 1024, scr, lane); }
    }
    const int gt = C.bid * NTHREADS + tid, NGT = C.G * NTHREADS;
    for (int i = gt; i < 2048; i += NGT) ((float*)(C.ws + WS_CTL + CT_SPL))[i] = 8.0f * 1.44269504089f * log1pf(expf(-C.in[I_LAM][i]));
    for (int i = gt; i < NTOK * 128; i += NGT) { const int row = i >> 7, oc = i & 127;
        const float* src = (row < NGRID ? C.in[I_X] + (size_t)row * D : C.in[I_META] + (size_t)((row - NGRID) & 15) * D) + 8 * oc;
        const f32x4 a = *(const f32x4*)src, b = *(const f32x4*)(src + 4);
        u32x4 w; w.x = pk2(a[0], a[1]); w.y = pk2(a[2], a[3]); w.z = pk2(b[0], b[1]); w.w = pk2(b[2], b[3]);
        *(u32x4*)((bf16_t*)(C.ws + WS_HB) + (size_t)row * D + 8 * oc) = w; }
}

__device__ __forceinline__ void phase_conv(const Ctx& C) {
    PHASE_IDS
    const bf16_t* XR = (const bf16_t*)(C.ws + WS_XR); bf16_t* XC = (bf16_t*)(C.ws + WS_XC);
    const float* cw = C.in[I_CONVW]; const float* cb = C.in[I_CONVB];
    const int gt = C.bid * NTHREADS + tid, NGT = C.G * NTHREADS;
    for (int i = gt; i < NTOK * 128; i += NGT) { const int row = i >> 7, ch = 8 * (i & 127);
        int b, s; if (row < NGRID) { b = row >> 12; s = NMETA + (row & (SEQ - 1)); } else { b = (row - NGRID) >> 4; s = (row - NGRID) & 15; }
        float a[8];
        { const f32x4 t0 = *(const f32x4*)(cb + ch), t1 = *(const f32x4*)(cb + ch + 4);
#pragma unroll
          for (int j = 0; j < 4; ++j) { a[j] = t0[j]; a[4 + j] = t1[j]; } }
#pragma unroll
        for (int j = 0; j < 4; ++j) { const int sj = s - 2 + j;
            if (sj >= 0 && sj < LSEQ) { const u32x4 xw = *(const u32x4*)(XR + (size_t)seqrow(b, sj) * D + ch);
                const f32x4 w0 = *(const f32x4*)(cw + j * 1024 + ch), w1 = *(const f32x4*)(cw + j * 1024 + ch + 4);
                a[0] += w0[0] * bflo(xw.x); a[1] += w0[1] * bfhi(xw.x); a[2] += w0[2] * bflo(xw.y); a[3] += w0[3] * bfhi(xw.y);
                a[4] += w1[0] * bflo(xw.z); a[5] += w1[1] * bfhi(xw.z); a[6] += w1[2] * bflo(xw.w); a[7] += w1[3] * bfhi(xw.w); } }
        u32x4 w; w.x = pk2(a[0], a[1]); w.y = pk2(a[2], a[3]); w.z = pk2(a[4], a[5]); w.w = pk2(a[6], a[7]);
        *(u32x4*)(XC + (size_t)row * D + ch) = w; }
}

template <int N> __device__ __forceinline__ float dpp_shr(float oldv, float v) {
    return __builtin_bit_cast(float, __builtin_amdgcn_update_dpp(__builtin_bit_cast(int, oldv), __builtin_bit_cast(int, v), 0x110 + N, 0xf, 0xf, false));
}
__device__ __forceinline__ void scan_group(float (&a)[8], float (&b)[8]) {
#pragma unroll
    for (int c = 0; c < 8; ++c) {
        { const float ap = dpp_shr<1>(1.0f, a[c]), bp = dpp_shr<1>(0.0f, b[c]); b[c] = a[c] * bp + b[c]; a[c] = a[c] * ap; }
        { const float ap = dpp_shr<2>(1.0f, a[c]), bp = dpp_shr<2>(0.0f, b[c]); b[c] = a[c] * bp + b[c]; a[c] = a[c] * ap; }
        { const float ap = dpp_shr<4>(1.0f, a[c]), bp = dpp_shr<4>(0.0f, b[c]); b[c] = a[c] * bp + b[c]; a[c] = a[c] * ap; }
        { const float ap = dpp_shr<8>(1.0f, a[c]), bp = dpp_shr<8>(0.0f, b[c]); b[c] = a[c] * bp + b[c]; a[c] = a[c] * ap; }
    }
}
__device__ __forceinline__ void unpack8(const u32x4 w, float (&o)[8]) { o[0] = bflo(w.x); o[1] = bfhi(w.x); o[2] = bflo(w.y); o[3] = bfhi(w.y); o[4] = bflo(w.z); o[5] = bfhi(w.z); o[6] = bflo(w.w); o[7] = bfhi(w.w); }
__device__ __forceinline__ void phase_scan(const Ctx& C) {
    PHASE_IDS
    const bf16_t* LA = (const bf16_t*)(C.ws + WS_LA); const bf16_t* BB = (const bf16_t*)(C.ws + WS_BB); const bf16_t* GY = (const bf16_t*)(C.ws + WS_GY);
    bf16_t* HF = (bf16_t*)(C.ws + WS_HF); bf16_t* Gout = (bf16_t*)(C.ws + WS_G);
    LAS float* agg = (LAS float*)C.lds;
    const int w = wave, oct = lane >> 4, p = lane & 15;
    for (int item = C.bid; item < NB * 32; item += C.G) {
        const int b = item >> 5, g = item & 31;
        for (int dir = 0; dir < 2; ++dir) {
            const bf16_t* la = LA + (((size_t)dir * 32 + g) * MPAD) * 32 + 8 * oct;
            const bf16_t* bb = BB + (((size_t)dir * 32 + g) * MPAD) * 32 + 8 * oct;
            float S[8];
#pragma unroll
            for (int c = 0; c < 8; ++c) S[c] = 0.f;
            {
                const int u = p, s = dir ? LSEQ - 1 - u : u, row = seqrow(b, s);
                float a[8], x[8]; unpack8(*(const u32x4*)(la + (size_t)row * 32), a); unpack8(*(const u32x4*)(bb + (size_t)row * 32), x);
#pragma unroll
                for (int c = 0; c < 8; ++c) a[c] = fast_exp2(a[c]);
                scan_group(a, x);
                if (w == 0) {
                    if (dir == 0) { u32x4 o; o.x = pk2(x[0], x[1]); o.y = pk2(x[2], x[3]); o.z = pk2(x[4], x[5]); o.w = pk2(x[6], x[7]); *(u32x4*)(HF + ((size_t)g * MPAD + row) * 32 + 8 * oct) = o; }
                    else { float hf[8], gy[8]; unpack8(*(const u32x4*)(HF + ((size_t)g * MPAD + row) * 32 + 8 * oct), hf); unpack8(*(const u32x4*)(GY + ((size_t)g * MPAD + row) * 32 + 8 * oct), gy);
                        u32x4 o; o.x = pk2((hf[0] + x[0]) * gy[0], (hf[1] + x[1]) * gy[1]); o.y = pk2((hf[2] + x[2]) * gy[2], (hf[3] + x[3]) * gy[3]);
                        o.z = pk2((hf[4] + x[4]) * gy[4], (hf[5] + x[5]) * gy[5]); o.w = pk2((hf[6] + x[6]) * gy[6], (hf[7] + x[7]) * gy[7]);
                        *(u32x4*)(Gout + (size_t)row * D + 32 * g + 8 * oct) = o; }
                }
#pragma unroll
                for (int c = 0; c < 8; ++c) S[c] = __shfl(x[c], (lane & 48) | 15);
            }
            for (int r = 0; r < 8; ++r) {
                float Pw[4][8], Hw[4][8]; int rows[4];
                float Aw[8], Hc[8];
#pragma unroll
                for (int c = 0; c < 8; ++c) { Aw[c] = 1.f; Hc[c] = 0.f; }
                u32x4 ra[4], rb[4];
#pragma unroll
                for (int j = 0; j < 4; ++j) { const int u = 16 + 512 * r + 64 * w + 16 * j + p, s = dir ? LSEQ - 1 - u : u; rows[j] = seqrow(b, s);
                    ra[j] = *(const u32x4*)(la + (size_t)rows[j] * 32); rb[j] = *(const u32x4*)(bb + (size_t)rows[j] * 32); }
#pragma unroll
                for (int j = 0; j < 4; ++j) {
                    float a[8], x[8]; unpack8(ra[j], a); unpack8(rb[j], x);
#pragma unroll
                    for (int c = 0; c < 8; ++c) a[c] = fast_exp2(a[c]);
                    scan_group(a, x);
#pragma unroll
                    for (int c = 0; c < 8; ++c) { Hw[j][c] = a[c] * Hc[c] + x[c]; Pw[j][c] = a[c] * Aw[c]; }
#pragma unroll
                    for (int c = 0; c < 8; ++c) { Aw[c] = __shfl(Pw[j][c], (lane & 48) | 15); Hc[c] = __shfl(Hw[j][c], (lane & 48) | 15); }
                }
                LAS float* ag = agg + (r & 1) * 512;
                if (p == 0) {
#pragma unroll
                    for (int c = 0; c < 8; ++c) { ag[(w * 32 + oct * 8 + c) * 2] = Aw[c]; ag[(w * 32 + oct * 8 + c) * 2 + 1] = Hc[c]; }
                }
                __syncthreads();
                float Sin[8];
#pragma unroll
                for (int c = 0; c < 8; ++c) Sin[c] = S[c];
#pragma unroll
                for (int ww = 0; ww < 8; ++ww) {
#pragma unroll
                    for (int c = 0; c < 8; ++c) { const float A = ag[(ww * 32 + oct * 8 + c) * 2], H = ag[(ww * 32 + oct * 8 + c) * 2 + 1];
                        if (ww == w) Sin[c] = S[c];
                        S[c] = A * S[c] + H; }
                }
#pragma unroll
                for (int j = 0; j < 4; ++j) {
                    float h[8];
#pragma unroll
                    for (int c = 0; c < 8; ++c) h[c] = Pw[j][c] * Sin[c] + Hw[j][c];
                    const size_t go = ((size_t)g * MPAD + rows[j]) * 32 + 8 * oct;
                    if (dir == 0) { u32x4 o; o.x = pk2(h[0], h[1]); o.y = pk2(h[2], h[3]); o.z = pk2(h[4], h[5]); o.w = pk2(h[6], h[7]); *(u32x4*)(HF + go) = o; }
                    else { float hf[8], gy[8]; unpack8(*(const u32x4*)(HF + go), hf); unpack8(*(const u32x4*)(GY + go), gy);
                        u32x4 o; o.x = pk2((hf[0] + h[0]) * gy[0], (hf[1] + h[1]) * gy[1]); o.y = pk2((hf[2] + h[2]) * gy[2], (hf[3] + h[3]) * gy[3]);
                        o.z = pk2((hf[4] + h[4]) * gy[4], (hf[5] + h[5]) * gy[5]); o.w = pk2((hf[6] + h[6]) * gy[6], (hf[7] + h[7]) * gy[7]);
                        *(u32x4*)(Gout + (size_t)rows[j] * D + 32 * g + 8 * oct) = o; }
                }
            }
            __syncthreads();
        }
    }
}

constexpr int RWT_PITCH = 1028;
__device__ __forceinline__ void phase_lnr(const Ctx& C, int layer, int nrows) {
    PHASE_IDS
    const bf16_t* PRE = (const bf16_t*)(C.ws + WS_PRE); bf16_t* HB = (bf16_t*)(C.ws + WS_HB); unsigned char* HB8 = C.ws + WS_HB8;
    const float* lg = C.in[I_LNMG] + layer * D; const float* lb = C.in[I_LNMB] + layer * D;
    const float* rw = C.in[I_RW] + (size_t)layer * D * NEXP; const float* rb = C.in[I_RB] + layer * NEXP;
    int* eid = (int*)(C.ws + WS_CTL + CT_EID) + (size_t)layer * NTOK * 4; float* gatev = (float*)(C.ws + WS_CTL + CT_GATEV) + (size_t)layer * NTOK * 4;
    unsigned* bc = (unsigned*)(C.ws + WS_CTL + CT_BC) + ((size_t)layer * 256 + C.bid) * 32;
    LAS float* RWt = (LAS float*)C.lds; LAS unsigned* hist = (LAS unsigned*)(C.lds + 32 * RWT_PITCH * 4);
    { f32x4 wv[16];
#pragma unroll
      for (int i = 0; i < 16; ++i) wv[i] = *(const f32x4*)(rw + 4 * (tid + NTHREADS * i));
#pragma unroll
      for (int i = 0; i < 16; ++i) { const int idx4 = tid + NTHREADS * i, ch = idx4 >> 3, e4 = (idx4 & 7) * 4;
          const int c = 4 * ((ch & 511) >> 3) + 256 * (2 * (ch >> 9) + ((ch >> 2) & 1)) + (ch & 3);
          RWt[(e4 + 0) * RWT_PITCH + c] = wv[i][0]; RWt[(e4 + 1) * RWT_PITCH + c] = wv[i][1]; RWt[(e4 + 2) * RWT_PITCH + c] = wv[i][2]; RWt[(e4 + 3) * RWT_PITCH + c] = wv[i][3]; } }
    if (tid < 32) hist[tid] = 0u;
    __syncthreads();
    float gg[2][8], gb[2][8];
#pragma unroll
    for (int j = 0; j < 2; ++j) { const f32x4 a0 = *(const f32x4*)(lg + 8 * lane + 512 * j), a1 = *(const f32x4*)(lg + 8 * lane + 512 * j + 4), b0 = *(const f32x4*)(lb + 8 * lane + 512 * j), b1 = *(const f32x4*)(lb + 8 * lane + 512 * j + 4);
#pragma unroll
        for (int i = 0; i < 4; ++i) { gg[j][i] = a0[i]; gg[j][4 + i] = a1[i]; gb[j][i] = b0[i]; gb[j][4 + i] = b1[i]; } }
    const float rbias = rb[lane >> 1];
    const int gw = C.bid * NWAVES + wave, NGW = C.G * NWAVES;
    u32x4 nv[2];
    if (gw < nrows) {
#pragma unroll
        for (int j = 0; j < 2; ++j) nv[j] = *(const u32x4*)(PRE + (size_t)gw * D + 8 * lane + 512 * j); }
    for (int row = gw; row < nrows; row += NGW) {
        float v[2][8]; float s = 0.f;
#pragma unroll
        for (int j = 0; j < 2; ++j) { unpack8(nv[j], v[j]); s += ((v[j][0] + v[j][1]) + (v[j][2] + v[j][3])) + ((v[j][4] + v[j][5]) + (v[j][6] + v[j][7])); }
        if (row + NGW < nrows) {
#pragma unroll
            for (int j = 0; j < 2; ++j) nv[j] = *(const u32x4*)(PRE + (size_t)(row + NGW) * D + 8 * lane + 512 * j); }
        const float mean = wave_sum_dpp(s) * (1.0f / D); float q = 0.f;
#pragma unroll
        for (int j = 0; j < 2; ++j)
#pragma unroll
            for (int i = 0; i < 8; ++i) { v[j][i] -= mean; q += v[j][i] * v[j][i]; }
        const float rstd = 1.0f / sqrtf(wave_sum_dpp(q) * (1.0f / D) + LN_EPS);
#pragma unroll
        for (int j = 0; j < 2; ++j) {
#pragma unroll
            for (int i = 0; i < 8; ++i) v[j][i] = v[j][i] * rstd * gg[j][i] + gb[j][i];
            u32x4 w; w.x = pk2(v[j][0], v[j][1]); w.y = pk2(v[j][2], v[j][3]); w.z = pk2(v[j][4], v[j][5]); w.w = pk2(v[j][6], v[j][7]);
            *(u32x4*)(HB + (size_t)row * D + 8 * lane + 512 * j) = w;
            u32x2 w8; w8.x = pk4_fp8(v[j][0], v[j][1], v[j][2], v[j][3]); w8.y = pk4_fp8(v[j][4], v[j][5], v[j][6], v[j][7]);
            *(u32x2*)(HB8 + (size_t)row * D + 8 * lane + 512 * j) = w8; }
        float pl[32];
#pragma unroll
        for (int e0 = 0; e0 < 32; e0 += 4) {
            f32x4 wv[4][4];
#pragma unroll
            for (int ee = 0; ee < 4; ++ee)
#pragma unroll
                for (int jj = 0; jj < 4; ++jj) wv[ee][jj] = *(const LAS f32x4*)(RWt + (e0 + ee) * RWT_PITCH + 4 * lane + 256 * jj);
            __builtin_amdgcn_sched_barrier(0);
#pragma unroll
            for (int ee = 0; ee < 4; ++ee) { float a = 0.f;
#pragma unroll
                for (int jj = 0; jj < 4; ++jj) { const int j = jj >> 1, o = 4 * (jj & 1); a += (v[j][o] * wv[ee][jj][0] + v[j][o + 1] * wv[ee][jj][1]) + (v[j][o + 2] * wv[ee][jj][2] + v[j][o + 3] * wv[ee][jj][3]); }
                pl[e0 + ee] = a; }
        }
        float q16[16], q8[8], q4[4], q2[2], q1;
        { const bool hi = (lane & 32) != 0;
#pragma unroll
          for (int e = 0; e < 16; ++e) { const float mine = hi ? pl[16 + e] : pl[e], other = hi ? pl[e] : pl[16 + e]; q16[e] = mine + __shfl_xor(other, 32); } }
        { const bool hi = (lane & 16) != 0;
#pragma unroll
          for (int e = 0; e < 8; ++e) { const float mine = hi ? q16[8 + e] : q16[e], other = hi ? q16[e] : q16[8 + e]; q8[e] = mine + __shfl_xor(other, 16); } }
        { const bool hi = (lane & 8) != 0;
#pragma unroll
          for (int e = 0; e < 4; ++e) { const float mine = hi ? q8[4 + e] : q8[e], other = hi ? q8[e] : q8[4 + e]; q4[e] = mine + dpp_movf<0x128>(other); } }
        { const bool hi = (lane & 4) != 0;
#pragma unroll
          for (int e = 0; e < 2; ++e) { const float mine = hi ? q4[2 + e] : q4[e], other = hi ? q4[e] : q4[2 + e]; q2[e] = mine + __shfl_xor(other, 4); } }
        { const bool hi = (lane & 2) != 0; const float mine = hi ? q2[1] : q2[0], other = hi ? q2[0] : q2[1]; q1 = mine + dpp_movf<0x4E>(other); }
        q1 += dpp_movf<0xB1>(q1);
        const float lv = q1 + rbias; const int le = lane >> 1;
        int rank = 0;
#pragma unroll
        for (int j = 0; j < 32; ++j) { const float lj = readlane_f(lv, 2 * j); rank += (lj > lv || (lj == lv && j < le)) ? 1 : 0; }
        const unsigned long long m0 = __ballot(rank == 0);
        const float mxl = readlane_f(lv, (int)__builtin_ctzll(m0));
        const float pe = rank < 4 ? __expf(lv - mxl) : 0.f;
        const float den = wave_sum_dpp(pe) * 0.5f;
        if (rank < 4 && (lane & 1) == 0) { eid[(size_t)row * 4 + rank] = le; gatev[(size_t)row * 4 + rank] = pe / den;
            __hip_atomic_fetch_add(&hist[le], 1u, __ATOMIC_RELAXED, __HIP_MEMORY_SCOPE_WORKGROUP); }
    }
    __syncthreads();
    if (tid < 32) bc[tid] = hist[tid];
}

__device__ __forceinline__ void phase_pos(const Ctx& C, int layer, int nrows) {
    PHASE_IDS
    const unsigned* bcAll = (const unsigned*)(C.ws + WS_CTL + CT_BC) + (size_t)layer * 256 * 32;
    const int* eid = (const int*)(C.ws + WS_CTL + CT_EID) + (size_t)layer * NTOK * 4; int* posv = (int*)(C.ws + WS_CTL + CT_POS) + (size_t)layer * NTOK * 4;
    int* texp = (int*)(C.ws + WS_CTL + CT_TEXP) + layer * 1024;
    const unsigned char* HB8 = C.ws + WS_HB8; unsigned char* XS = C.ws + WS_XS;
    LAS unsigned* partT = (LAS unsigned*)C.lds; LAS unsigned* partP = partT + 512; LAS unsigned* tot = partP + 512; LAS unsigned* cnt = tot + 32;
    { const int e = tid & 31, part = tid >> 5; unsigned t = 0, pr = 0;
      unsigned vv[16];
#pragma unroll
      for (int i = 0; i < 16; ++i) { const int bq = part + 16 * i; vv[i] = bq < C.G ? bcAll[(size_t)bq * 32 + e] : 0u; }
#pragma unroll
      for (int i = 0; i < 16; ++i) { const int bq = part + 16 * i; t += vv[i]; if (bq < C.bid) pr += vv[i]; }
      partT[part * 32 + e] = t; partP[part * 32 + e] = pr; }
    __syncthreads();
    if (tid < 32) { unsigned t = 0, pr = 0; for (int i = 0; i < 16; ++i) { t += partT[i * 32 + tid]; pr += partP[i * 32 + tid]; } tot[tid] = t; cnt[tid] = pr; }
    __syncthreads();
    if (tid < 32) { unsigned off = 0; for (int e = 0; e < tid; ++e) off += (tot[e] + 255u) & ~255u;
        const unsigned mine = (tot[tid] + 255u) & ~255u;
        if (C.bid == 0) { for (unsigned t = off >> 8; t < ((off + mine) >> 8); ++t) texp[t] = tid; if (tid == 31) texp[1023] = (int)((off + mine) >> 8); }
        cnt[tid] += off; }
    __syncthreads();
    const int gw = C.bid * NWAVES + wave, NGW = C.G * NWAVES;
    for (int row = gw; row < nrows; row += NGW) {
        int pos = 0;
        if (lane < 4) { const int e = eid[(size_t)row * 4 + lane]; pos = (int)__hip_atomic_fetch_add(&cnt[e], 1u, __ATOMIC_RELAXED, __HIP_MEMORY_SCOPE_WORKGROUP); posv[(size_t)row * 4 + lane] = pos; }
        const u32x4 r0 = *(const u32x4*)(HB8 + (size_t)row * D + 16 * lane);
#pragma unroll
        for (int k = 0; k < 4; ++k) { const int pk = __shfl(pos, k); *(u32x4*)(XS + (size_t)pk * D + 16 * lane) = r0; }
    }
}

__device__ __forceinline__ void phase_combine(const Ctx& C, int layer, int nrows, bool final_out) {
    PHASE_IDS
    bf16_t* HB = (bf16_t*)(C.ws + WS_HB); const bf16_t* YS = (const bf16_t*)(C.ws + WS_YS);
    const float* lg = C.in[I_LNFG] + layer * D; const float* lb = C.in[I_LNFB] + layer * D;
    const float* gatev = (const float*)(C.ws + WS_CTL + CT_GATEV) + (size_t)layer * NTOK * 4; const int* posv = (const int*)(C.ws + WS_CTL + CT_POS) + (size_t)layer * NTOK * 4;
    float gg[2][8], gb[2][8];
#pragma unroll
    for (int j = 0; j < 2; ++j) { const f32x4 a0 = *(const f32x4*)(lg + 8 * lane + 512 * j), a1 = *(const f32x4*)(lg + 8 * lane + 512 * j + 4), b0 = *(const f32x4*)(lb + 8 * lane + 512 * j), b1 = *(const f32x4*)(lb + 8 * lane + 512 * j + 4);
#pragma unroll
        for (int i = 0; i < 4; ++i) { gg[j][i] = a0[i]; gg[j][4 + i] = a1[i]; gb[j][i] = b0[i]; gb[j][4 + i] = b1[i]; } }
    const int gw = C.bid * NWAVES + wave, NGW = C.G * NWAVES;
    for (int row = gw; row < nrows; row += NGW) {
        const f32x4 gk4 = *(const f32x4*)(gatev + (size_t)row * 4); const int pk0 = posv[(size_t)row * 4], pk1 = posv[(size_t)row * 4 + 1], pk2_ = posv[(size_t)row * 4 + 2], pk3 = posv[(size_t)row * 4 + 3];
        u32x4 hw[2], yw[4][2];
#pragma unroll
        for (int j = 0; j < 2; ++j) { hw[j] = *(const u32x4*)(HB + (size_t)row * D + 8 * lane + 512 * j);
            yw[0][j] = *(const u32x4*)(YS + (size_t)pk0 * D + 8 * lane + 512 * j); yw[1][j] = *(const u32x4*)(YS + (size_t)pk1 * D + 8 * lane + 512 * j);
            yw[2][j] = *(const u32x4*)(YS + (size_t)pk2_ * D + 8 * lane + 512 * j); yw[3][j] = *(const u32x4*)(YS + (size_t)pk3 * D + 8 * lane + 512 * j); }
        float v[2][8]; float s = 0.f;
#pragma unroll
        for (int j = 0; j < 2; ++j) { float h[8]; unpack8(hw[j], h);
#pragma unroll
            for (int i = 0; i < 8; ++i) v[j][i] = h[i] * DN_ALPHA;
#pragma unroll
            for (int k = 0; k < 4; ++k) { float y[8]; unpack8(yw[k][j], y);
#pragma unroll
                for (int i = 0; i < 8; ++i) v[j][i] += gk4[k] * y[i]; }
#pragma unroll
            for (int i = 0; i < 8; ++i) s += v[j][i]; }
        const float mean = wave_sum_dpp(s) * (1.0f / D); float q = 0.f;
#pragma unroll
        for (int j = 0; j < 2; ++j)
#pragma unroll
            for (int i = 0; i < 8; ++i) { v[j][i] -= mean; q += v[j][i] * v[j][i]; }
        const float rstd = 1.0f / sqrtf(wave_sum_dpp(q) * (1.0f / D) + LN_EPS);
#pragma unroll
        for (int j = 0; j < 2; ++j) {
#pragma unroll
            for (int i = 0; i < 8; ++i) v[j][i] = v[j][i] * rstd * gg[j][i] + gb[j][i];
            if (final_out) { *(f32x4*)(C.out + (size_t)row * D + 8 * lane + 512 * j) = (f32x4){v[j][0], v[j][1], v[j][2], v[j][3]}; *(f32x4*)(C.out + (size_t)row * D + 8 * lane + 512 * j + 4) = (f32x4){v[j][4], v[j][5], v[j][6], v[j][7]}; }
            else { u32x4 w; w.x = pk2(v[j][0], v[j][1]); w.y = pk2(v[j][2], v[j][3]); w.z = pk2(v[j][4], v[j][5]); w.w = pk2(v[j][6], v[j][7]); *(u32x4*)(HB + (size_t)row * D + 8 * lane + 512 * j) = w; } }
    }
}

constexpr int AT_KS = 0, AT_VTS = 73728, AT_VPITCH = 1168, AT_KM = AT_VTS + 64 * AT_VPITCH, AT_VTM = AT_KM + 2048, AT_RPB = AT_VTM + 2048, AT_MB = AT_RPB + 1920, AT_END = AT_MB + 64;
static_assert(AT_END <= LDS_BYTES, "attention LDS map");
__device__ __forceinline__ void phase_attn(const Ctx& C) {
    PHASE_IDS
    const bf16_t* Q = (const bf16_t*)(C.ws + WS_Q); const bf16_t* Kx = (const bf16_t*)(C.ws + WS_K); const bf16_t* VT = (const bf16_t*)(C.ws + WS_VT); bf16_t* O = (bf16_t*)(C.ws + WS_O);
    const float* rpb = C.in[I_RPB]; const float* mbias = C.in[I_MBIAS];
    LAS unsigned char* lds = C.lds;
    const int w = wave, lq = lane & 15, g = lane >> 4;
    for (int unit = C.bid; unit < NB * 16 * 32; unit += C.G) {
        const int rp = unit & 31, h = (unit >> 5) & 15, b = unit >> 9;
        const int R0 = min(max(2 * rp - 4, 0), 55);
        __syncthreads();
#pragma unroll
        for (int i = 0; i < 9; ++i) { const int idx = tid + 512 * i, ch = idx & 7, kc = (idx >> 3) & 63, jr = idx >> 9;
            const u32x4 v = *(const u32x4*)(Kx + (size_t)(b * SEQ + (R0 + jr) * 64 + kc) * D + 64 * h + 8 * ch);
            *(LAS u32x4*)(lds + AT_KS + ((jr * 64 + kc) * 8 + (ch ^ (kc & 7))) * 16) = v; }
#pragma unroll
        for (int i = 0; i < 9; ++i) { const int idx = tid + 512 * i, d = idx / 72, cx = idx - d * 72;
            const u32x4 v = *(const u32x4*)(VT + (size_t)(64 * h + d) * MPAD + b * SEQ + R0 * 64 + 8 * cx);
            *(LAS u32x4*)(lds + AT_VTS + d * AT_VPITCH + cx * 16) = v; }
        if (tid < 128) { const int m = tid >> 3, ch = tid & 7;
            const u32x4 v = *(const u32x4*)(Kx + (size_t)(NGRID + 16 * b + m) * D + 64 * h + 8 * ch);
            *(LAS u32x4*)(lds + AT_KM + (m * 8 + (ch ^ (m & 7))) * 16) = v; }
        else if (tid < 256) { const int i = tid - 128, d = i >> 1, hf = i & 1;
            const u32x4 v = *(const u32x4*)(VT + (size_t)(64 * h + d) * MPAD + NGRID + 16 * b + 8 * hf);
            *(LAS u32x4*)(lds + AT_VTM + d * 32 + hf * 16) = v; }
        if (tid < 465) ((LAS float*)(lds + AT_RPB))[tid] = rpb[h * 465 + tid];
        if (tid < 16) ((LAS float*)(lds + AT_MB))[tid] = mbias[h * 16 + tid];
        __syncthreads();
        const int qr = w >> 2, qg = w & 3, r = 2 * rp + qr, c0 = 16 * qg;
        const int rs = min(max(r - 4, 0), 56), jr0 = rs - R0;
        const int kcb = qg == 0 ? 0 : (qg == 1 ? 8 : (qg == 2 ? 24 : 32));
        const size_t qrow = (size_t)(b * SEQ + r * 64 + c0 + lq);
        bf16x8 qf[2];
#pragma unroll
        for (int ks = 0; ks < 2; ++ks) qf[ks] = *(const bf16x8*)(Q + qrow * D + 64 * h + 32 * ks + 8 * g);
        f32x4 sc[8][2], sm;
#pragma unroll
        for (int j = 0; j < 8; ++j)
#pragma unroll
            for (int blk = 0; blk < 2; ++blk) { f32x4 a = {0.f, 0.f, 0.f, 0.f}; const int kc = kcb + 16 * blk + lq;
#pragma unroll
                for (int ks = 0; ks < 2; ++ks) { const bf16x8 kf = *(const LAS bf16x8*)(lds + AT_KS + (((jr0 + j) * 64 + kc) * 8 + ((4 * ks + g) ^ (kc & 7))) * 16);
                    a = __builtin_amdgcn_mfma_f32_16x16x32_bf16(kf, qf[ks], a, 0, 0, 0); }
                sc[j][blk] = a; }
        { f32x4 a = {0.f, 0.f, 0.f, 0.f};
#pragma unroll
          for (int ks = 0; ks < 2; ++ks) { const bf16x8 kf = *(const LAS bf16x8*)(lds + AT_KM + (lq * 8 + ((4 * ks + g) ^ (lq & 7))) * 16);
              a = __builtin_amdgcn_mfma_f32_16x16x32_bf16(kf, qf[ks], a, 0, 0, 0); }
          sm = a; }
        const int c = c0 + lq, cs = min(max(c - 8, 0), 48);
        const LAS float* RP = (const LAS float*)(lds + AT_RPB); const LAS float* MB = (const LAS float*)(lds + AT_MB);
        float mx = -3.0e38f;
#pragma unroll
        for (int j = 0; j < 8; ++j) { const int ro = rs + j - r + 7;
#pragma unroll
            for (int blk = 0; blk < 2; ++blk)
#pragma unroll
                for (int e = 0; e < 4; ++e) { const int kc = kcb + 16 * blk + 4 * g + e; const bool valid = kc >= cs && kc < cs + 16;
                    const float bias = RP[valid ? ro * 31 + (kc - c + 15) : 0];
                    const float s = valid ? sc[j][blk][e] + bias : -1.0e30f; sc[j][blk][e] = s; mx = fmaxf(mx, s); } }
#pragma unroll
        for (int e = 0; e < 4; ++e) { sm[e] += MB[4 * g + e]; mx = fmaxf(mx, sm[e]); }
        mx = fmaxf(mx, __shfl_xor(mx, 16)); mx = fmaxf(mx, __shfl_xor(mx, 32));
        float sum = 0.f;
#pragma unroll
        for (int j = 0; j < 8; ++j)
#pragma unroll
            for (int blk = 0; blk < 2; ++blk)
#pragma unroll
                for (int e = 0; e < 4; ++e) { const float pv = fast_exp2((sc[j][blk][e] - mx) * 1.44269504089f); sc[j][blk][e] = pv; sum += pv; }
#pragma unroll
        for (int e = 0; e < 4; ++e) { const float pv = fast_exp2((sm[e] - mx) * 1.44269504089f); sm[e] = pv; sum += pv; }
        sum += __shfl_xor(sum, 16); sum += __shfl_xor(sum, 32);
        f32x4 o[4];
#pragma unroll
        for (int db = 0; db < 4; ++db) o[db] = (f32x4){0.f, 0.f, 0.f, 0.f};
#pragma unroll
        for (int j = 0; j < 8; ++j) {
            u32x4 pw; pw.x = cvt_pk_bf16(sc[j][0][0], sc[j][0][1]); pw.y = cvt_pk_bf16(sc[j][0][2], sc[j][0][3]); pw.z = cvt_pk_bf16(sc[j][1][0], sc[j][1][1]); pw.w = cvt_pk_bf16(sc[j][1][2], sc[j][1][3]);
            const bf16x8 pb = __builtin_bit_cast(bf16x8, pw);
#pragma unroll
            for (int db = 0; db < 4; ++db) { const int d = 16 * db + lq; const LAS unsigned char* vp = lds + AT_VTS + d * AT_VPITCH + ((jr0 + j) * 64 + kcb + 4 * g) * 2;
                const u32x2 lo = *(const LAS u32x2*)vp, hi = *(const LAS u32x2*)(vp + 32);
                u32x4 aw; aw.x = lo.x; aw.y = lo.y; aw.z = hi.x; aw.w = hi.y;
                o[db] = __builtin_amdgcn_mfma_f32_16x16x32_bf16(__builtin_bit_cast(bf16x8, aw), pb, o[db], 0, 0, 0); }
        }
        { u32x4 pw; pw.x = cvt_pk_bf16(sm[0], sm[1]); pw.y = cvt_pk_bf16(sm[2], sm[3]); pw.z = 0u; pw.w = 0u; const bf16x8 pb = __builtin_bit_cast(bf16x8, pw);
#pragma unroll
          for (int db = 0; db < 4; ++db) { const int d = 16 * db + lq; const u32x2 lo = *(const LAS u32x2*)(lds + AT_VTM + d * 32 + 8 * g);
              u32x4 aw; aw.x = lo.x; aw.y = lo.y; aw.z = 0u; aw.w = 0u;
              o[db] = __builtin_amdgcn_mfma_f32_16x16x32_bf16(__builtin_bit_cast(bf16x8, aw), pb, o[db], 0, 0, 0); } }
        const float inv = 1.0f / sum;
#pragma unroll
        for (int db = 0; db < 4; ++db) { u32x2 ow; ow.x = cvt_pk_bf16(o[db][0] * inv, o[db][1] * inv); ow.y = cvt_pk_bf16(o[db][2] * inv, o[db][3] * inv);
            *(u32x2*)(O + qrow * D + 64 * h + 16 * db + 4 * g) = ow; }
    }
}


#define XB_TMO      128
#define XB_XCNT(j)  (256  + 64 * (j))
#define XB_XSUB(j)  (1280 + 64 * (j))
#define XB_XGEN(j)  (2304 + 64 * (j))
#define XB_TOP      3328
#define XB_TOPGEN   3392
#define XCD_BAR_WORDS 3456
#define XB_SPIN_CAP (1u << 22)
__device__ __forceinline__ unsigned xb_ld(unsigned* p)              { return __hip_atomic_load(p, __ATOMIC_RELAXED, __HIP_MEMORY_SCOPE_AGENT); }
__device__ __forceinline__ unsigned xb_add(unsigned* p, unsigned v) { return __hip_atomic_fetch_add(p, v, __ATOMIC_RELAXED, __HIP_MEMORY_SCOPE_AGENT); }
__device__ __forceinline__ unsigned xb_xcc_id() { return (unsigned)__builtin_amdgcn_s_getreg((3 << 11) | 20) & 0xFu; }
#define XB_SPIN(cond, bar) do { unsigned _sp = 0; while (cond) { __builtin_amdgcn_s_sleep(1); \
    if ((++_sp & 255u) == 0u) { if (xb_ld(&(bar)[XB_TMO])) break; if (_sp > XB_SPIN_CAP) { atomicAdd(&(bar)[XB_TMO], 1u); break; } } } } while (0)
struct XcdBarrier { unsigned* bar; unsigned x; volatile LAS unsigned* st; };
__device__ __forceinline__ XcdBarrier xcd_barrier_post(unsigned* bar, volatile LAS unsigned* st) {
    XcdBarrier b; b.bar = bar; b.x = xb_xcc_id(); b.st = st;
    if (threadIdx.x == 0) (void)xb_add(&bar[XB_XCNT(b.x)], 1u);
    return b;
}
__device__ __forceinline__ void xcd_barrier_complete(unsigned* bar, unsigned x, unsigned& nloc, unsigned& nx) {
    const unsigned G = gridDim.x * gridDim.y * gridDim.z;
    unsigned sum, cnt, mine, sp = 0u;
    for (;;) {
        sum = 0u; cnt = 0u; mine = 0u;
#pragma unroll
        for (unsigned j = 0; j < 16; ++j) { const unsigned c = xb_ld(&bar[XB_XCNT(j)]); sum += c; cnt += (c > 0u) ? 1u : 0u; mine = (j == x) ? c : mine; }
        if (sum == G) break;
        __builtin_amdgcn_s_sleep(1);
        if ((++sp & 255u) == 0u) { if (xb_ld(&bar[XB_TMO])) break; if (sp > XB_SPIN_CAP) { atomicAdd(&bar[XB_TMO], 1u); break; } }
    }
    nloc = mine > 0u ? mine : 1u; nx = cnt > 0u ? cnt : 1u;
}
__device__ __forceinline__ void xcd_barrier(const XcdBarrier& b) {
    asm volatile("s_waitcnt vmcnt(0)" ::: "memory");
    __syncthreads();
    if (threadIdx.x == 0) {
        unsigned* bar = b.bar;
        __builtin_amdgcn_s_waitcnt(0);
        unsigned nloc = b.st[0], nx = b.st[1];
        if (nloc == 0u) { xcd_barrier_complete(bar, b.x, nloc, nx); b.st[0] = nloc; b.st[1] = nx; }
        const unsigned old = xb_add(&bar[XB_XSUB(b.x)], 1u);
        const unsigned gen = old / nloc;
        if (old + 1u == (gen + 1u) * nloc) {
            __builtin_amdgcn_fence(__ATOMIC_RELEASE, "agent");
            asm volatile("s_waitcnt vmcnt(0)" ::: "memory");
            const unsigned og = xb_add(&bar[XB_TOP], 1u);
            const unsigned tg = og / nx;
            if (og + 1u == (tg + 1u) * nx) xb_add(&bar[XB_TOPGEN], 1u);
            else XB_SPIN(xb_ld(&bar[XB_TOPGEN]) == tg, bar);
            __builtin_amdgcn_fence(__ATOMIC_ACQUIRE, "agent");
            xb_add(&bar[XB_XGEN(b.x)], 1u);
            asm volatile("s_waitcnt vmcnt(0)" ::: "memory");
        } else {
            XB_SPIN(xb_ld(&bar[XB_XGEN(b.x)]) == gen, bar);
            __builtin_amdgcn_fence(__ATOMIC_ACQUIRE, "agent");
            asm volatile("s_waitcnt vmcnt(0)" ::: "memory");
        }
    }
    __syncthreads();
}
constexpr size_t CT_BAR = 131072;
constexpr int LDS_BARST = LDS_BYTES - 64;

constexpr int N_PHASES = 20;
__global__ void __launch_bounds__(NTHREADS, 2) hybrid_fwd(Params P) {
    extern __shared__ __attribute__((aligned(16))) unsigned char smem[];
    cg::grid_group grid = cg::this_grid();
    Ctx C; C.lds = (LAS unsigned char*)smem; C.G = gridDim.x; C.bid = blockIdx.x;
    C.ws = P.ws; C.in = P.in; C.out = P.out;
    unsigned char* ws = P.ws;
    const int lo = P.ph_lo, hi = P.ph_hi;
#ifndef PH_MASK
#define PH_MASK 0xFFFFFFFFu
#endif
#define IN(k) (((PH_MASK >> (k)) & 1u) && lo <= (k) && (k) < hi)
#ifndef REPEAT_MASK
#define REPEAT_MASK 0u
#endif
#define REPS(k) ((((unsigned)REPEAT_MASK >> (k)) & 1u) ? 2 : 1)
#ifndef N_CG_SYNCS
#define N_CG_SYNCS 1
#endif
#define SEAM(k) do { if (IN(k) && IN((k) + 1)) { if ((k) < N_CG_SYNCS) grid.sync(); else xcd_barrier(bar); } } while (0)
    if (threadIdx.x < 16) ((LAS unsigned*)(smem + LDS_BARST))[threadIdx.x] = 0u;
    __syncthreads();
    const XcdBarrier bar = xcd_barrier_post((unsigned*)(ws + WS_CTL + CT_BAR), (volatile LAS unsigned*)(smem + LDS_BARST));
    #define PH_BODY_0 phase_convert(C);
    if (IN(0)) { PH_BODY_0 } if (REPS(0) > 1 && IN(0)) { xcd_barrier(bar); PH_BODY_0 }
    SEAM(0);
    #define PH_BODY_1 { DenseSched S{(unsigned)WS_HB, (unsigned)WS_WIN, 1024, 1024, 129, 8, C.G, C.bid}; EpiWin E{(bf16_t*)(ws + WS_XR), (bf16_t*)(ws + WS_GY)}; \
        pg8::gemm_phase<false>(C.lds, ws, 1024, 1024, 1024, S, E); }
    if (IN(1)) { PH_BODY_1 } if (REPS(1) > 1 && IN(1)) { xcd_barrier(bar); PH_BODY_1 }
    SEAM(1);
    #define PH_BODY_2 phase_conv(C);
    if (IN(2)) { PH_BODY_2 } if (REPS(2) > 1 && IN(2)) { xcd_barrier(bar); PH_BODY_2 }
    SEAM(2);
    #define PH_BODY_3 { GateSched S{(unsigned)WS_XC, (unsigned)WS_GATE, 129, C.G, C.bid}; \
        EpiGate E{(const bf16_t*)(ws + WS_XC), (bf16_t*)(ws + WS_LA), (bf16_t*)(ws + WS_BB), P.in[I_BA], P.in[I_BX], (const float*)(ws + WS_CTL + CT_SPL)}; \
        pg8::gemm_phase<false>(C.lds, ws, 256, 1024, 256, S, E); }
    if (IN(3)) { PH_BODY_3 } if (REPS(3) > 1 && IN(3)) { xcd_barrier(bar); PH_BODY_3 }
    SEAM(3);
    #define PH_BODY_4 phase_scan(C);
    if (IN(4)) { PH_BODY_4 } if (REPS(4) > 1 && IN(4)) { xcd_barrier(bar); PH_BODY_4 }
    SEAM(4);
    #define PH_BODY_5 { DenseSched S{(unsigned)WS_G, (unsigned)WS_LOUT, 1024, 1024, 129, 4, C.G, C.bid}; EpiRes<true> E{(bf16_t*)(ws + WS_PRE), P.in[I_X], P.in[I_META], nullptr, NTOK}; \
        pg8::gemm_phase<false>(C.lds, ws, 1024, 1024, 1024, S, E); }
    if (IN(5)) { PH_BODY_5 } if (REPS(5) > 1 && IN(5)) { xcd_barrier(bar); PH_BODY_5 }
    SEAM(5);
    #define PH_BODY_6 phase_lnr(C, 0, NTOK);
    if (IN(6)) { PH_BODY_6 } if (REPS(6) > 1 && IN(6)) { xcd_barrier(bar); PH_BODY_6 }
    SEAM(6);
    #define PH_BODY_7 phase_pos(C, 0, NTOK);
    if (IN(7)) { PH_BODY_7 } if (REPS(7) > 1 && IN(7)) { xcd_barrier(bar); PH_BODY_7 }
    SEAM(7);
    #define PH_BODY_8 { const int* texp = (const int*)(ws + WS_CTL + CT_TEXP); const int nM = __builtin_amdgcn_readfirstlane(__hip_atomic_load(texp + 1023, __ATOMIC_RELAXED, __HIP_MEMORY_SCOPE_AGENT)); \
        MoeSched S{(unsigned)WS_XS, (unsigned)WS_WGU, texp, 2048u * 1024u, nM, 8, C.G, C.bid}; EpiGlu E{(unsigned char*)(ws + WS_ACT), P.in[I_BGU]}; \
        pg8::gemm_phase<true>(C.lds, ws, 512, 512, 512, S, E); }
    if (IN(8)) { PH_BODY_8 } if (REPS(8) > 1 && IN(8)) { xcd_barrier(bar); PH_BODY_8 }
    SEAM(8);
    #define PH_BODY_9 { const int* texp = (const int*)(ws + WS_CTL + CT_TEXP); const int nM = __builtin_amdgcn_readfirstlane(__hip_atomic_load(texp + 1023, __ATOMIC_RELAXED, __HIP_MEMORY_SCOPE_AGENT)); \
        MoeSched S{(unsigned)WS_ACT, (unsigned)WS_WD, texp, 1024u * 1024u, nM, 4, C.G, C.bid}; EpiDown E{(bf16_t*)(ws + WS_YS), P.in[I_BD]}; \
        pg8::gemm_phase<true>(C.lds, ws, 512, 512, 512, S, E); }
    if (IN(9)) { PH_BODY_9 } if (REPS(9) > 1 && IN(9)) { xcd_barrier(bar); PH_BODY_9 }
    SEAM(9);
    #define PH_BODY_10 phase_combine(C, 0, NTOK, false);
    if (IN(10)) { PH_BODY_10 } if (REPS(10) > 1 && IN(10)) { xcd_barrier(bar); PH_BODY_10 }
    SEAM(10);
    #define PH_BODY_11 { QkvSched S{(unsigned)WS_HB, (unsigned)WS_QKV, 129, C.G, C.bid}; EpiQkv E{(bf16_t*)(ws + WS_Q), (bf16_t*)(ws + WS_K), (bf16_t*)(ws + WS_VT)}; \
        pg8::gemm_phase<false>(C.lds, ws, 1024, 1024, 1024, S, E); }
    if (IN(11)) { PH_BODY_11 } if (REPS(11) > 1 && IN(11)) { xcd_barrier(bar); PH_BODY_11 }
    SEAM(11);
    #define PH_BODY_12 phase_attn(C);
    if (IN(12)) { PH_BODY_12 } if (REPS(12) > 1 && IN(12)) { xcd_barrier(bar); PH_BODY_12 }
    SEAM(12);
    #define PH_BODY_13 { DenseSched S{(unsigned)WS_O, (unsigned)WS_NOUT, 1024, 1024, 128, 4, C.G, C.bid}; EpiRes<false> E{(bf16_t*)(ws + WS_PRE), nullptr, nullptr, (const bf16_t*)(ws + WS_HB), NGRID}; \
        pg8::gemm_phase<false>(C.lds, ws, 1024, 1024, 1024, S, E); }
    if (IN(13)) { PH_BODY_13 } if (REPS(13) > 1 && IN(13)) { xcd_barrier(bar); PH_BODY_13 }
    SEAM(13);
    #define PH_BODY_14 phase_lnr(C, 1, NGRID);
    if (IN(14)) { PH_BODY_14 } if (REPS(14) > 1 && IN(14)) { xcd_barrier(bar); PH_BODY_14 }
    SEAM(14);
    #define PH_BODY_15 phase_pos(C, 1, NGRID);
    if (IN(15)) { PH_BODY_15 } if (REPS(15) > 1 && IN(15)) { xcd_barrier(bar); PH_BODY_15 }
    SEAM(15);
    #define PH_BODY_16 { const int* texp = (const int*)(ws + WS_CTL + CT_TEXP) + 1024; const int nM = __builtin_amdgcn_readfirstlane(__hip_atomic_load(texp + 1023, __ATOMIC_RELAXED, __HIP_MEMORY_SCOPE_AGENT)); \
        MoeSched S{(unsigned)WS_XS, (unsigned)(WS_WGU + (size_t)32 * 2048 * 1024), texp, 2048u * 1024u, nM, 8, C.G, C.bid}; EpiGlu E{(unsigned char*)(ws + WS_ACT), P.in[I_BGU] + 32 * 2048}; \
        pg8::gemm_phase<true>(C.lds, ws, 512, 512, 512, S, E); }
    if (IN(16)) { PH_BODY_16 } if (REPS(16) > 1 && IN(16)) { xcd_barrier(bar); PH_BODY_16 }
    SEAM(16);
    #define PH_BODY_17 { const int* texp = (const int*)(ws + WS_CTL + CT_TEXP) + 1024; const int nM = __builtin_amdgcn_readfirstlane(__hip_atomic_load(texp + 1023, __ATOMIC_RELAXED, __HIP_MEMORY_SCOPE_AGENT)); \
        MoeSched S{(unsigned)WS_ACT, (unsigned)(WS_WD + (size_t)32 * 1024 * 1024), texp, 1024u * 1024u, nM, 4, C.G, C.bid}; EpiDown E{(bf16_t*)(ws + WS_YS), P.in[I_BD] + 32 * 1024}; \
        pg8::gemm_phase<true>(C.lds, ws, 512, 512, 512, S, E); }
    if (IN(17)) { PH_BODY_17 } if (REPS(17) > 1 && IN(17)) { xcd_barrier(bar); PH_BODY_17 }
    SEAM(17);
    #define PH_BODY_18 phase_combine(C, 1, NGRID, true);
    if (IN(18)) { PH_BODY_18 } if (REPS(18) > 1 && IN(18)) { xcd_barrier(bar); PH_BODY_18 }
#undef IN
#undef SEAM
}

#ifndef MK_PER_PHASE
#define MK_PER_PHASE 0
#endif
extern "C" void kernel_launch(void* const* d_in, const int* in_sizes, int n_in, void* d_out, int out_size, void* d_ws, size_t ws_size, hipStream_t stream) {
    static int grid = 0;
    if (grid == 0) {
        if (n_in != 25 || ws_size < WS_END || out_size != NGRID * D) { fprintf(stderr, "kernel_launch: unexpected problem (n_in %d, ws %zu, out %d)\n", n_in, ws_size, out_size); grid = -1; return; }
        int dev = 0, cus = 0, per_cu = 0;
        if (hipGetDevice(&dev) != hipSuccess || hipDeviceGetAttribute(&cus, hipDeviceAttributeMultiprocessorCount, dev) != hipSuccess) { grid = -1; return; }
        if (hipFuncSetAttribute((const void*)hybrid_fwd, hipFuncAttributeMaxDynamicSharedMemorySize, LDS_BYTES) != hipSuccess) { fprintf(stderr, "kernel_launch: hipFuncSetAttribute failed\n"); grid = -1; return; }
        if (hipOccupancyMaxActiveBlocksPerMultiprocessor(&per_cu, (const void*)hybrid_fwd, NTHREADS, LDS_BYTES) != hipSuccess || per_cu < 1) { fprintf(stderr, "kernel_launch: occupancy query failed (%d)\n", per_cu); grid = -1; return; }
        grid = cus * 1;
        if (grid > 256) grid = 256;
    }
    if (grid < 0) return;
    if (hipMemsetAsync((char*)d_ws + WS_CTL + CT_BAR, 0, 16384, stream) != hipSuccess) { fprintf(stderr, "kernel_launch: memset failed\n"); return; }
    Params p{};
    for (int i = 0; i < 25; ++i) p.in[i] = (const float*)d_in[i];
    p.out = (float*)d_out; p.ws = (unsigned char*)d_ws;
#if MK_PER_PHASE
    for (int ph = 0; ph < 19; ++ph) { p.ph_lo = ph; p.ph_hi = ph + 1; void* args[] = {&p};
        hipError_t e = hipLaunchCooperativeKernel((void*)hybrid_fwd, dim3(grid), dim3(NTHREADS), args, LDS_BYTES, stream);
        if (e != hipSuccess) { fprintf(stderr, "launch phase %d failed: %s\n", ph, hipGetErrorString(e)); break; } }
#else
    p.ph_lo = 0; p.ph_hi = 19; void* args[] = {&p};
    hipError_t e = hipLaunchCooperativeKernel((void*)hybrid_fwd, dim3(grid), dim3(NTHREADS), args, LDS_BYTES, stream);
    if (e != hipSuccess) fprintf(stderr, "cooperative launch failed: %s (grid %d)\n", hipGetErrorString(e), grid);
#endif
}
```

```cpp
#include <hip/hip_runtime.h>
#include <hip/hip_cooperative_groups.h>
#include <cstdio>
#include <cstdint>
namespace cg = cooperative_groups;

#define LAS __attribute__((address_space(3)))
typedef unsigned short bf16_t;
typedef short bf16x8 __attribute__((ext_vector_type(8)));
typedef float f32x4 __attribute__((ext_vector_type(4)));
typedef float f32x2 __attribute__((ext_vector_type(2)));
typedef unsigned u32x4 __attribute__((ext_vector_type(4)));
typedef unsigned u32x2 __attribute__((ext_vector_type(2)));

constexpr int NB = 8, SEQ = 4096, D = 1024, NMETA = 16, LSEQ = SEQ + NMETA;
constexpr int NGRID = NB * SEQ;
constexpr int NTOK = NGRID + NB * NMETA;
constexpr int MPAD = 33024;
constexpr int NEXP = 32, TOPK = 4;
constexpr int PMAX = 139776;
constexpr int MTMAX = PMAX / 256;
constexpr float DN_ALPHA = 1.41421356237f;
constexpr float LN_EPS = 1e-5f;
constexpr int NTHREADS = 512, NWAVES = 8;

constexpr size_t MiB = 1u << 20;
constexpr size_t ACT_BYTES = (size_t)MPAD * D * 2;
constexpr size_t WS_CTL   = 0;
constexpr size_t WS_WIN   = 4 * MiB;
constexpr size_t WS_GATE  = WS_WIN + 4 * MiB;
constexpr size_t WS_LOUT  = WS_GATE + 2 * MiB;
constexpr size_t WS_QKV   = WS_LOUT + 2 * MiB;
constexpr size_t WS_NOUT  = WS_QKV + 6 * MiB;
constexpr size_t WS_WGU   = WS_NOUT + 2 * MiB;
constexpr size_t WS_WD    = WS_WGU + 128 * MiB;
constexpr size_t WS_HB    = WS_WD + 64 * MiB;
constexpr size_t WS_HB8   = WS_HB + 65 * MiB;
constexpr size_t WS_PRE   = WS_HB8 + 33 * MiB;
constexpr size_t WS_H     = WS_PRE + 129 * MiB;
constexpr size_t WS_SCR   = WS_H + 129 * MiB;
constexpr size_t WS_XR = WS_SCR, WS_XC = WS_XR + 65 * MiB, WS_GY = WS_XC + 65 * MiB, WS_LA = WS_GY + 65 * MiB, WS_BB = WS_LA + 130 * MiB, WS_HF = WS_BB + 130 * MiB, WS_G = WS_HF + 65 * MiB;
constexpr size_t WS_SCR_END0 = WS_G + 65 * MiB;
constexpr size_t WS_XS = WS_SCR, WS_ACT = WS_XS + 137 * MiB, WS_YS = WS_ACT + 137 * MiB;
constexpr size_t WS_SCR_END1 = WS_YS + 274 * MiB;
constexpr size_t WS_Q = WS_SCR, WS_K = WS_Q + 65 * MiB, WS_VT = WS_K + 65 * MiB, WS_O = WS_VT + 65 * MiB;
constexpr size_t WS_BIAS = (WS_SCR_END0 > WS_SCR_END1 ? WS_SCR_END0 : WS_SCR_END1);
constexpr size_t WS_BD = WS_BIAS + 2 * 32 * 2048 * 4;
constexpr size_t WS_END = WS_BIAS + 1 * MiB;
static_assert(ACT_BYTES <= 65 * MiB && (size_t)PMAX * D * 2 <= 274 * MiB && (size_t)PMAX * D <= 137 * MiB && (size_t)MPAD * D <= 33 * MiB && (size_t)MPAD * D * 4 <= 129 * MiB, "ws map");
static_assert(WS_END <= (size_t)2040 * MiB, "ws map must fit 4x the largest input tensor");
constexpr size_t CT_BC      = 4096;
constexpr size_t CT_TEXP    = CT_BC + 2 * 256 * 32 * 4;
constexpr size_t CT_SPL     = CT_TEXP + 2 * 1024 * 4;
constexpr size_t CT_EID     = 256 * 1024;
constexpr size_t CT_GATEV   = CT_EID + 2 * (size_t)NTOK * 4 * 4;
constexpr size_t CT_POS     = CT_GATEV + 2 * (size_t)NTOK * 4 * 4;
static_assert(CT_POS + 2 * (size_t)NTOK * 4 * 4 <= 4 * MiB, "ctl map");

constexpr int LDS_BYTES = 155648;

__device__ __forceinline__ unsigned f2bf(float f) { unsigned u = __builtin_bit_cast(unsigned, f); return (u + 0x7fffu + ((u >> 16) & 1u)) >> 16; }
__device__ __forceinline__ unsigned cvt_pk_bf16(float lo, float hi);
__device__ __forceinline__ unsigned pk2(float lo, float hi) { return cvt_pk_bf16(lo, hi); }
typedef __bf16 bf16x2_t __attribute__((ext_vector_type(2)));
__device__ __forceinline__ unsigned cvt_pk_bf16(float lo, float hi) { const f32x2 v = {lo, hi}; return __builtin_bit_cast(unsigned, __builtin_convertvector(v, bf16x2_t)); }
__device__ __forceinline__ unsigned pk4_fp8(float a, float b, float c, float d) { int w = __builtin_amdgcn_cvt_pk_fp8_f32(a, b, 0, false); w = __builtin_amdgcn_cvt_pk_fp8_f32(c, d, w, true); return (unsigned)w; }
__device__ __forceinline__ float bflo(unsigned w) { return __builtin_bit_cast(float, w << 16); }
__device__ __forceinline__ float bfhi(unsigned w) { return __builtin_bit_cast(float, w & 0xffff0000u); }
__device__ __forceinline__ float fast_exp2(float x) { return __builtin_amdgcn_exp2f(x); }
__device__ __forceinline__ float fast_rcp(float x) { return __builtin_amdgcn_rcpf(x); }
__device__ __forceinline__ float sigmoidf_(float x) { return fast_rcp(1.0f + fast_exp2(-1.44269504089f * x)); }
__device__ __forceinline__ float wave_sum(float v) {
#pragma unroll
    for (int o = 1; o < 64; o <<= 1) v += __shfl_xor(v, o);
    return v;
}
template <int CTRL> __device__ __forceinline__ float dpp_movf(float v) { return __builtin_bit_cast(float, __builtin_amdgcn_update_dpp(0, __builtin_bit_cast(int, v), CTRL, 0xf, 0xf, true)); }
__device__ __forceinline__ float readlane_f(float v, int l) { return __builtin_bit_cast(float, __builtin_amdgcn_readlane(__builtin_bit_cast(int, v), l)); }
__device__ __forceinline__ float wave_sum_dpp(float v) {
    v += dpp_movf<0xB1>(v);
    v += dpp_movf<0x4E>(v);
    v += dpp_movf<0x141>(v);
    v += dpp_movf<0x140>(v);
    return (readlane_f(v, 0) + readlane_f(v, 16)) + (readlane_f(v, 32) + readlane_f(v, 48));
}
__device__ __forceinline__ int seqrow(int b, int s) { return s < NMETA ? NGRID + NMETA * b + s : SEQ * b + (s - NMETA); }

struct Params {
    const float* in[25];
    float* out;
    unsigned char* ws;
    int ph_lo, ph_hi;
};
struct Ctx {
    LAS unsigned char* lds;
    int G, bid, gc;
    unsigned char* ws;
    const float* const* in;
    float* out;
};
__device__ __forceinline__ int fresh_tid() { int t = threadIdx.x; asm volatile("" : "+v"(t)); return t; }
#define PHASE_IDS const int tid = fresh_tid(); const int lane = tid & 63; const int wave = __builtin_amdgcn_readfirstlane(tid >> 6); (void)lane; (void)wave;
enum { I_X = 0, I_META, I_WIN, I_CONVW, I_CONVB, I_WA, I_BA, I_WX, I_BX, I_LAM, I_LOUT, I_WQKV, I_RPB, I_MBIAS, I_NOUT, I_LNMG, I_LNMB, I_RW, I_RB, I_WGU, I_BGU, I_WD, I_BD, I_LNFG, I_LNFB };

namespace pg8 {
constexpr int BM = 256, BK = 64, HALF = 128, HTB = HALF * BK * 2, STAGE_BYTES = 8 * HTB, NXCD = 8, WGM = 8;
constexpr int SIDE_OFF = STAGE_BYTES, TEXP_OFF = STAGE_BYTES + 2048;
__device__ __forceinline__ int lds_byte(int r, int c) { const int st = (r >> 4) * 2 + (c >> 5), rr = r & 15, cc = c & 31, ob = rr * 64 + cc * 2; return st * 1024 + (ob ^ (((ob >> 9) & 1) << 5)); }
__device__ __forceinline__ void stage_rc(int b, int& R, int& C) { const int st = b / 1024, sb = b % 1024, swz = sb ^ (((sb >> 9) & 1) << 5); R = (st >> 1) * 16 + swz / 64; C = (st & 1) * 32 + (swz % 64) / 2; }
__device__ __forceinline__ int perm32(int rho) { const int n = rho >> 4, i = rho & 15; return 8 * (i >> 2) + 4 * n + (i & 3); }

typedef int v8i __attribute__((ext_vector_type(8)));
typedef int v4i __attribute__((ext_vector_type(4)));
__device__ __forceinline__ v8i cat8(bf16x8 a, bf16x8 b) { const v4i x = __builtin_bit_cast(v4i, a), y = __builtin_bit_cast(v4i, b); return __builtin_shufflevector(x, y, 0, 1, 2, 3, 4, 5, 6, 7); }
struct Unit { unsigned ao, bo; int pm, pn, aux; };

__device__ __forceinline__ void tile_of(int L, int nM, int nN, int& pm, int& pn) {
    const int nwg = nM * nN; int wgid = L;
    { const int q = nwg / NXCD, r = nwg % NXCD, xcd = wgid % NXCD, off = wgid / NXCD; wgid = (xcd < r ? xcd * (q + 1) : r * (q + 1) + (xcd - r) * q) + off; }
    const int nig = WGM * nN, gid = wgid / nig, fm = gid * WGM, gsz = (nM - fm) < WGM ? (nM - fm) : WGM;
    pm = fm + ((wgid % nig) % gsz); pn = (wgid % nig) / gsz;
}

template <bool F8, class Epi, class Sched>
__device__ __forceinline__ void gemm_phase(LAS unsigned char* lds, const unsigned char* wsbase, const int K, const int lda, const int ldb, const Sched& S, const Epi& E) {
    const __amdgpu_buffer_rsrc_t rsrc = __builtin_amdgcn_make_buffer_rsrc((void*)wsbase, 0, 0xFFFFFFFF, 0x00020000);
    const int tid = fresh_tid(), wid = __builtin_amdgcn_readfirstlane(tid >> 6), lane = tid & 63, wr = wid >> 2, wc = wid & 3;
    const int nt = K / BK;
    int voffA, voffB;
    { int R, C; stage_rc(tid * 16, R, C); const int Rb = Epi::PERM ? ((R & ~31) + perm32(R & 31)) : R; voffA = (R * lda + C) * 2; voffB = (Rb * ldb + C) * 2; }
    const unsigned kstep = (unsigned)(BK * 2);
    const unsigned hstepA = (unsigned)HALF * lda * 2, hstepB = (unsigned)HALF * ldb * 2;
    const unsigned ldsw = (unsigned)wid * 1024u;
    const int aoff = lds_byte(wr * 64 + (lane & 15), (lane >> 4) * 8), boff = lds_byte(wc * 32 + (lane & 15), (lane >> 4) * 8);
#define PG8_SA(b, h) (((b) * 2 + (h)) * HTB)
#define PG8_SB(b, h) ((4 + (b) * 2 + (h)) * HTB)
#define PG8_STAGE(bufoff, gbase, voff) do { _Pragma("unroll") for (int _i = 0; _i < 2; ++_i) \
        __builtin_amdgcn_raw_ptr_buffer_load_lds(rsrc, (LAS void*)(lds + (bufoff) + ldsw + _i * 8192), 16, voff, (int)((gbase) + (unsigned)_i * (hstep##voff >> 1)), 0, 0); } while (0)
#define hstepvoffA hstepA
#define hstepvoffB hstepB
#define PG8_LDA(dst, b, h) do { _Pragma("unroll") for (int m = 0; m < 4; ++m) _Pragma("unroll") for (int k = 0; k < 2; ++k) dst[m][k] = *(const LAS bf16x8*)(lds + PG8_SA(b, h) + aoff + m * 2048 + k * 1024); } while (0)
#define PG8_LDB(dst, b, h) do { _Pragma("unroll") for (int n = 0; n < 2; ++n) _Pragma("unroll") for (int k = 0; k < 2; ++k) dst[n][k] = *(const LAS bf16x8*)(lds + PG8_SB(b, h) + boff + n * 2048 + k * 1024); } while (0)
#define PG8_MMA(ai, bj, At, Bt) do { __builtin_amdgcn_s_setprio(1); _Pragma("unroll") for (int m = 0; m < 4; ++m) _Pragma("unroll") for (int n = 0; n < 2; ++n) { \
        if constexpr (F8) { acc[ai][bj][m][n] = __builtin_amdgcn_mfma_scale_f32_16x16x128_f8f6f4(cat8(Bt[n][0], Bt[n][1]), cat8(At[m][0], At[m][1]), acc[ai][bj][m][n], 0, 0, 0, Epi::SCALE_W, 0, Epi::SCALE_A); } \
        else { _Pragma("unroll") for (int k = 0; k < 2; ++k) acc[ai][bj][m][n] = __builtin_amdgcn_mfma_f32_16x16x32_bf16(Bt[n][k], At[m][k], acc[ai][bj][m][n], 0, 0, 0); } } \
        __builtin_amdgcn_s_setprio(0); } while (0)
#define PG8_WAIT_V(n) asm volatile("s_waitcnt vmcnt(" #n ")" ::: "memory")
#define PG8_WAIT_L(n) asm volatile("s_waitcnt lgkmcnt(" #n ")" ::: "memory")
#define PG8_BAR __builtin_amdgcn_s_barrier()
#define PG8_SCHED __builtin_amdgcn_sched_barrier(0)
    Unit cur, nxt; int ui = 0;
    if (!S.next(0, cur)) return;
    f32x4 acc[2][2][4][2];
#pragma unroll
    for (int a = 0; a < 2; ++a)
#pragma unroll
        for (int b = 0; b < 2; ++b)
#pragma unroll
            for (int m = 0; m < 4; ++m)
#pragma unroll
                for (int n = 0; n < 2; ++n) acc[a][b][m][n] = (f32x4){0.f, 0.f, 0.f, 0.f};
    bf16x8 At[4][2], B0[2][2], B1[2][2];
    unsigned cA = cur.ao, cB = cur.bo;
#define PG8_SIDE(unit, par) do { if constexpr (Epi::SIDE) { if (wid == 0) __builtin_amdgcn_raw_ptr_buffer_load_lds(rsrc, (LAS void*)(lds + SIDE_OFF + (par) * 1024), 16, lane * 16, (int)E.side_off(unit), 0, 0); } } while (0)
    PG8_SIDE(cur, 0);
    PG8_STAGE(PG8_SB(0, 0), cB, voffB); PG8_STAGE(PG8_SB(0, 1), cB + hstepB, voffB); PG8_STAGE(PG8_SA(0, 0), cA, voffA); PG8_STAGE(PG8_SA(0, 1), cA + hstepA, voffA);
    if (wr == 1) PG8_BAR;
    PG8_WAIT_V(2); PG8_BAR;
    PG8_STAGE(PG8_SB(1, 0), cB + kstep, voffB); PG8_STAGE(PG8_SA(1, 0), cA + kstep, voffA); PG8_STAGE(PG8_SB(1, 1), cB + hstepB + kstep, voffB);
    PG8_WAIT_V(6); PG8_BAR;
    for (;;) {
        const bool has_next = S.next(ui + 1, nxt);
        const unsigned nA = has_next ? nxt.ao : cA, nB = has_next ? nxt.bo : cB;
#pragma unroll 1
        for (int t = 0; t < nt; t += 2) {
            const bool last = (t == nt - 2);
            const unsigned a1 = cA + (unsigned)(t + 1) * kstep;
            const unsigned a2 = last ? nA : cA + (unsigned)(t + 2) * kstep, b2 = last ? nB : cB + (unsigned)(t + 2) * kstep;
            const unsigned a3 = a2 + kstep, b3 = b2 + kstep;
            PG8_LDB(B0, 0, 0); PG8_LDB(B1, 0, 1); PG8_SCHED; PG8_LDA(At, 0, 0); PG8_STAGE(PG8_SA(1, 1), a1 + hstepA, voffA);
            PG8_WAIT_V(8); PG8_WAIT_L(0); PG8_BAR; PG8_MMA(0, 0, At, B0); PG8_MMA(0, 1, At, B1); PG8_BAR; PG8_SCHED;
            PG8_LDA(At, 0, 1); PG8_STAGE(PG8_SB(0, 0), b2, voffB); PG8_STAGE(PG8_SB(0, 1), b2 + hstepB, voffB); PG8_STAGE(PG8_SA(0, 0), a2, voffA);
            PG8_WAIT_V(8); PG8_WAIT_L(0); PG8_BAR; PG8_MMA(1, 0, At, B0); PG8_MMA(1, 1, At, B1); PG8_BAR; PG8_SCHED;
            PG8_LDB(B0, 1, 0); PG8_LDB(B1, 1, 1); PG8_SCHED; PG8_LDA(At, 1, 0); PG8_STAGE(PG8_SA(0, 1), a2 + hstepA, voffA);
            PG8_WAIT_V(8); PG8_WAIT_L(0); PG8_BAR; PG8_MMA(0, 0, At, B0); PG8_MMA(0, 1, At, B1); PG8_BAR; PG8_SCHED;
            PG8_LDA(At, 1, 1); PG8_STAGE(PG8_SB(1, 0), b3, voffB); PG8_STAGE(PG8_SB(1, 1), b3 + hstepB, voffB); PG8_STAGE(PG8_SA(1, 0), a3, voffA);
            PG8_WAIT_V(8); PG8_WAIT_L(0); PG8_BAR; PG8_MMA(1, 0, At, B0); PG8_MMA(1, 1, At, B1); PG8_BAR; PG8_SCHED;
        }
        if (wr == 0) PG8_BAR;
        { const int l2 = fresh_tid() & 63; E(acc, cur, wr, wc, l2 & 15, l2 >> 4, (const LAS float*)(lds + SIDE_OFF + (ui & 1) * 1024)); }
        if (!has_next) break;
#pragma unroll
        for (int a = 0; a < 2; ++a)
#pragma unroll
            for (int b = 0; b < 2; ++b)
#pragma unroll
                for (int m = 0; m < 4; ++m)
#pragma unroll
                    for (int n = 0; n < 2; ++n) acc[a][b][m][n] = (f32x4){0.f, 0.f, 0.f, 0.f};
        cur = nxt; cA = nA; cB = nB; ++ui;
        if (wr == 1) PG8_BAR;
        PG8_SIDE(cur, ui & 1);
    }
    PG8_WAIT_V(0);
    PG8_BAR;
#undef PG8_SA
#undef PG8_SB
#undef PG8_STAGE
#undef PG8_SIDE
#undef hstepvoffA
#undef hstepvoffB
#undef PG8_LDA
#undef PG8_LDB
#undef PG8_MMA
#undef PG8_WAIT_V
#undef PG8_WAIT_L
#undef PG8_BAR
#undef PG8_SCHED
}
}

using pg8::Unit;

struct DenseSched {
    unsigned A, Bt; int lda, ldb, nM, nN, G, c;
    __device__ __forceinline__ bool next(int i, Unit& u) const {
        const int L = i * G + c; if (L >= nM * nN) return false;
        pg8::tile_of(L, nM, nN, u.pm, u.pn); u.aux = 0;
        u.ao = A + (unsigned)u.pm * 256 * lda * 2; u.bo = Bt + (unsigned)u.pn * 256 * ldb * 2; return true;
    }
};
struct GateSched {
    unsigned XC, GT; int nM, G, c;
    __device__ __forceinline__ bool next(int i, Unit& u) const {
        const int per = nM * 4; const int L = i * G + c; if (L >= 4 * per) return false;
        const int nb = L / per; pg8::tile_of(L - nb * per, nM, 4, u.pm, u.pn); u.aux = nb;
        u.ao = XC + ((unsigned)u.pm * 256 * 1024 + 256 * nb) * 2; u.bo = GT + ((unsigned)nb * 1024 + 256 * u.pn) * 256 * 2; return true;
    }
};
struct QkvSched {
    unsigned HB, WT; int nM, G, c;
    __device__ __forceinline__ bool next(int i, Unit& u) const {
        const int n0 = nM * 8, n1 = 4 * nM; const int L = i * G + c; if (L >= n0 + n1) return false;
        if (L < n0) { pg8::tile_of(L, nM, 8, u.pm, u.pn); u.aux = 0; u.ao = HB + (unsigned)u.pm * 256 * 1024 * 2; u.bo = WT + (unsigned)u.pn * 256 * 1024 * 2; }
        else { pg8::tile_of(L - n0, 4, nM, u.pm, u.pn); u.aux = 1; u.ao = WT + (unsigned)(2048 + u.pm * 256) * 1024 * 2; u.bo = HB + (unsigned)u.pn * 256 * 1024 * 2; }
        return true;
    }
};
struct MoeSched {
    unsigned A, W; const LAS int* texp; unsigned wstride; int nM, nN, G, c;
    __device__ __forceinline__ bool next(int i, Unit& u) const {
        const int L = i * G + c; if (L >= nM * nN) return false;
        pg8::tile_of(L, nM, nN, u.pm, u.pn);
        const int e = __builtin_amdgcn_readfirstlane(texp[u.pm]); u.aux = e;
        u.ao = A + (unsigned)u.pm * 256 * 1024; u.bo = W + (unsigned)e * wstride + (unsigned)u.pn * 256 * 1024; return true;
    }
};

#define EPI_ARGS const f32x4 (&acc)[2][2][4][2], const Unit& u, int wr, int wc, int fr, int fq, const LAS float* side
struct EpiWin {
    static constexpr bool PERM = true, SIDE = false;
    bf16_t* XR; bf16_t* GY;
    __device__ __forceinline__ void operator()(EPI_ARGS) const {
        const int row0 = u.pm * 256 + wr * 64 + fr;
        if (u.pn < 4) {
            const int col0 = u.pn * 256 + wc * 32 + 8 * fq;
#pragma unroll
            for (int ai = 0; ai < 2; ++ai)
#pragma unroll
                for (int m = 0; m < 4; ++m) { bf16_t* rowp = XR + (size_t)(row0 + ai * 128 + m * 16) * D + col0;
#pragma unroll
                    for (int bj = 0; bj < 2; ++bj) { const f32x4 v0 = acc[ai][bj][m][0], v1 = acc[ai][bj][m][1];
                        u32x4 w; w.x = cvt_pk_bf16(v0[0], v0[1]); w.y = cvt_pk_bf16(v0[2], v0[3]); w.z = cvt_pk_bf16(v1[0], v1[1]); w.w = cvt_pk_bf16(v1[2], v1[3]);
                        *(u32x4*)(rowp + bj * 128) = w; } }
        } else {
#pragma unroll
            for (int ai = 0; ai < 2; ++ai)
#pragma unroll
                for (int m = 0; m < 4; ++m) { const int row = row0 + ai * 128 + m * 16;
#pragma unroll
                    for (int bj = 0; bj < 2; ++bj) { const int g = (u.pn - 4) * 8 + bj * 4 + wc;
                        float o[8];
#pragma unroll
                        for (int n = 0; n < 2; ++n)
#pragma unroll
                            for (int j = 0; j < 4; ++j) { const float v = acc[ai][bj][m][n][j]; const float z = 1.5957691216f * (v + 0.044715f * v * v * v); o[n * 4 + j] = v * sigmoidf_(z); }
                        u32x4 w; w.x = cvt_pk_bf16(o[0], o[1]); w.y = cvt_pk_bf16(o[2], o[3]); w.z = cvt_pk_bf16(o[4], o[5]); w.w = cvt_pk_bf16(o[6], o[7]);
                        *(u32x4*)(GY + ((size_t)g * MPAD + row) * 32 + 8 * fq) = w; } }
        }
    }
};
struct EpiGate {
    static constexpr bool PERM = true, SIDE = false;
    const bf16_t* XC; bf16_t* LA; bf16_t* BB; const float* ba; const float* bx; const float* spl;
    __device__ __forceinline__ void operator()(EPI_ARGS) const {
        const int nb = u.aux, dir = u.pn >> 1, half = u.pn & 1;
        const int ch0 = 256 * nb + 128 * half + 32 * wc + 8 * fq, g = ch0 >> 5;
        const int row0 = u.pm * 256 + wr * 64 + fr;
        float cba[8], cbx[8], csp[8];
        { const f32x4 t0 = *(const f32x4*)(ba + dir * 1024 + ch0), t1 = *(const f32x4*)(ba + dir * 1024 + ch0 + 4);
          const f32x4 s0 = *(const f32x4*)(bx + dir * 1024 + ch0), s1 = *(const f32x4*)(bx + dir * 1024 + ch0 + 4);
          const f32x4 p0 = *(const f32x4*)(spl + dir * 1024 + ch0), p1 = *(const f32x4*)(spl + dir * 1024 + ch0 + 4);
#pragma unroll
          for (int j = 0; j < 4; ++j) { cba[j] = t0[j]; cba[4 + j] = t1[j]; cbx[j] = s0[j]; cbx[4 + j] = s1[j]; csp[j] = p0[j]; csp[4 + j] = p1[j]; } }
        u32x4 xnext = *(const u32x4*)(XC + (size_t)(row0 < NTOK ? row0 : 0) * D + ch0);
#pragma unroll
        for (int ai = 0; ai < 2; ++ai)
#pragma unroll
            for (int m = 0; m < 4; ++m) { const int row = row0 + ai * 128 + m * 16;
                const u32x4 xw = xnext;
                { const int it = ai * 4 + m + 1, rn = row0 + (it >> 2) * 128 + (it & 3) * 16; if (it < 8) xnext = *(const u32x4*)(XC + (size_t)(rn < NTOK ? rn : 0) * D + ch0); }
                if (row < NTOK) {
                    float xc[8] = {bflo(xw.x), bfhi(xw.x), bflo(xw.y), bfhi(xw.y), bflo(xw.z), bfhi(xw.z), bflo(xw.w), bfhi(xw.w)};
                    const bool start = dir == 0 ? (row >= NGRID && ((row - NGRID) & 15) == 0) : (row < NGRID && (row & (SEQ - 1)) == SEQ - 1);
                    float la[8], bb[8];
#pragma unroll
                    for (int n = 0; n < 2; ++n)
#pragma unroll
                        for (int j = 0; j < 4; ++j) { const int i = n * 4 + j;
                            const float ga = sigmoidf_(acc[ai][0][m][n][j] + cba[i]), gx = sigmoidf_(acc[ai][1][m][n][j] + cbx[i]);
                            const float l2 = -csp[i] * ga;
                            const float a2 = fast_exp2(2.0f * l2);
                            const float mult = start ? 1.0f : __builtin_sqrtf(fmaxf(1.0f - a2, 0.0f));
                            la[i] = l2; bb[i] = mult * gx * xc[i]; }
                    u32x4 w; w.x = cvt_pk_bf16(la[0], la[1]); w.y = cvt_pk_bf16(la[2], la[3]); w.z = cvt_pk_bf16(la[4], la[5]); w.w = cvt_pk_bf16(la[6], la[7]);
                    const size_t o = (((size_t)dir * 32 + g) * MPAD + row) * 32 + 8 * fq;
                    *(u32x4*)(LA + o) = w;
                    w.x = cvt_pk_bf16(bb[0], bb[1]); w.y = cvt_pk_bf16(bb[2], bb[3]); w.z = cvt_pk_bf16(bb[4], bb[5]); w.w = cvt_pk_bf16(bb[6], bb[7]);
                    *(u32x4*)(BB + o) = w;
                } }
    }
};
template <bool LAYER0> struct EpiRes {
    static constexpr bool PERM = true, SIDE = false;
    bf16_t* PRE; const float* x; const float* meta; const bf16_t* HB; int nrows;
    __device__ __forceinline__ void operator()(EPI_ARGS) const {
        const int row0 = u.pm * 256 + wr * 64 + fr, col0 = u.pn * 256 + wc * 32 + 8 * fq;
#pragma unroll
        for (int ai = 0; ai < 2; ++ai)
#pragma unroll
            for (int m = 0; m < 4; ++m) { const int row = row0 + ai * 128 + m * 16;
                if (row < nrows) {
#pragma unroll
                    for (int bj = 0; bj < 2; ++bj) { const int c = col0 + bj * 128; float r[8];
                        if (LAYER0) { const float* rp = (row < NGRID ? x + (size_t)row * D : meta + (size_t)((row - NGRID) & 15) * D) + c; const f32x4 r0 = *(const f32x4*)rp, r1 = *(const f32x4*)(rp + 4);
                            r[0] = r0[0]; r[1] = r0[1]; r[2] = r0[2]; r[3] = r0[3]; r[4] = r1[0]; r[5] = r1[1]; r[6] = r1[2]; r[7] = r1[3]; }
                        else { const u32x4 rw = *(const u32x4*)(HB + (size_t)row * D + c); r[0] = bflo(rw.x); r[1] = bfhi(rw.x); r[2] = bflo(rw.y); r[3] = bfhi(rw.y); r[4] = bflo(rw.z); r[5] = bfhi(rw.z); r[6] = bflo(rw.w); r[7] = bfhi(rw.w); }
                        const f32x4 a0 = acc[ai][bj][m][0], a1 = acc[ai][bj][m][1];
                        u32x4 w; w.x = cvt_pk_bf16(r[0] * DN_ALPHA + a0[0], r[1] * DN_ALPHA + a0[1]); w.y = cvt_pk_bf16(r[2] * DN_ALPHA + a0[2], r[3] * DN_ALPHA + a0[3]);
                        w.z = cvt_pk_bf16(r[4] * DN_ALPHA + a1[0], r[5] * DN_ALPHA + a1[1]); w.w = cvt_pk_bf16(r[6] * DN_ALPHA + a1[2], r[7] * DN_ALPHA + a1[3]);
                        *(u32x4*)(PRE + (size_t)row * D + c) = w; }
                }
                asm volatile("" ::: "memory"); }
    }
};
struct EpiGlu {
    static constexpr bool PERM = true, SIDE = true; static constexpr int SCALE_W = 0x79797979, SCALE_A = 0x7F7F7F7F;
    unsigned char* ACT; unsigned bias_off;
    __device__ __forceinline__ unsigned side_off(const Unit& u) const { return bias_off + (unsigned)((u.aux * 8 + u.pn) * 1024); }
    __device__ __forceinline__ void operator()(EPI_ARGS) const {
        const int f0 = 128 * u.pn + 32 * wc + 8 * fq;
        float bg[8], bl[8];
        { const LAS float* p = side + 32 * wc + 8 * fq; const f32x4 a0 = *(const LAS f32x4*)p, a1 = *(const LAS f32x4*)(p + 4), c0 = *(const LAS f32x4*)(p + 128), c1 = *(const LAS f32x4*)(p + 132);
#pragma unroll
          for (int j = 0; j < 4; ++j) { bg[j] = a0[j]; bg[4 + j] = a1[j]; bl[j] = c0[j]; bl[4 + j] = c1[j]; } }
        const int row0 = u.pm * 256 + wr * 64 + fr;
#pragma unroll
        for (int ai = 0; ai < 2; ++ai)
#pragma unroll
            for (int m = 0; m < 4; ++m) { const int row = row0 + ai * 128 + m * 16; float o[8];
#pragma unroll
                for (int n = 0; n < 2; ++n)
#pragma unroll
                    for (int j = 0; j < 4; ++j) { const int i = n * 4 + j;
                        const float glu = fminf(acc[ai][0][m][n][j] + bg[i], 7.0f);
                        const float lin = fminf(fmaxf(acc[ai][1][m][n][j] + bl[i], -7.0f), 7.0f);
                        o[i] = glu * sigmoidf_(1.702f * glu) * (lin + 1.0f); }
                u32x2 w; w.x = pk4_fp8(o[0] * 4.0f, o[1] * 4.0f, o[2] * 4.0f, o[3] * 4.0f); w.y = pk4_fp8(o[4] * 4.0f, o[5] * 4.0f, o[6] * 4.0f, o[7] * 4.0f);
                *(u32x2*)(ACT + (size_t)row * D + f0) = w; }
    }
};
struct EpiNull {
    static constexpr bool PERM = true, SIDE = false; static constexpr int SCALE_W = 0x79797979, SCALE_A = 0x7F7F7F7F;
    __device__ __forceinline__ void operator()(EPI_ARGS) const {
#pragma unroll
        for (int ai = 0; ai < 2; ++ai)
#pragma unroll
            for (int bj = 0; bj < 2; ++bj)
#pragma unroll
                for (int m = 0; m < 4; ++m)
#pragma unroll
                    for (int n = 0; n < 2; ++n) asm volatile("" :: "v"(acc[ai][bj][m][n]));
    }
};
struct EpiDown {
    static constexpr bool PERM = true, SIDE = true; static constexpr int SCALE_W = 0x79797979, SCALE_A = 0x7D7D7D7D;
    bf16_t* YS; unsigned bias_off;
    __device__ __forceinline__ unsigned side_off(const Unit& u) const { return bias_off + (unsigned)((u.aux * 4 + u.pn) * 1024); }
    __device__ __forceinline__ void operator()(EPI_ARGS) const {
        const int row0 = u.pm * 256 + wr * 64 + fr, col0 = u.pn * 256 + wc * 32 + 8 * fq;
        f32x4 bv[2][2];
#pragma unroll
        for (int bj = 0; bj < 2; ++bj)
#pragma unroll
            for (int n = 0; n < 2; ++n) bv[bj][n] = *(const LAS f32x4*)(side + wc * 32 + 8 * fq + bj * 128 + 4 * n);
#pragma unroll
        for (int ai = 0; ai < 2; ++ai)
#pragma unroll
            for (int m = 0; m < 4; ++m) { bf16_t* rowp = YS + (size_t)(row0 + ai * 128 + m * 16) * D + col0;
#pragma unroll
                for (int bj = 0; bj < 2; ++bj) { const f32x4 v0 = acc[ai][bj][m][0] + bv[bj][0], v1 = acc[ai][bj][m][1] + bv[bj][1];
                    u32x4 w; w.x = cvt_pk_bf16(v0[0], v0[1]); w.y = cvt_pk_bf16(v0[2], v0[3]); w.z = cvt_pk_bf16(v1[0], v1[1]); w.w = cvt_pk_bf16(v1[2], v1[3]);
                    *(u32x4*)(rowp + bj * 128) = w; } }
    }
};
struct EpiQkv {
    static constexpr bool PERM = true, SIDE = false;
    bf16_t* Q; bf16_t* Kx; bf16_t* VT;
    __device__ __forceinline__ void operator()(EPI_ARGS) const {
        const int row0 = u.pm * 256 + wr * 64 + fr; bf16_t* base; int ldc, colt; float sc = 1.0f;
        if (u.aux == 0) { ldc = D; if (u.pn < 4) { base = Q; colt = u.pn * 256; sc = 0.125f; } else { base = Kx; colt = (u.pn - 4) * 256; } }
        else { base = VT; ldc = MPAD; colt = u.pn * 256; }
        const int col0 = colt + wc * 32 + 8 * fq;
#pragma unroll
        for (int ai = 0; ai < 2; ++ai)
#pragma unroll
            for (int m = 0; m < 4; ++m) { bf16_t* rowp = base + (size_t)(row0 + ai * 128 + m * 16) * ldc + col0;
#pragma unroll
                for (int bj = 0; bj < 2; ++bj) { const f32x4 v0 = acc[ai][bj][m][0] * sc, v1 = acc[ai][bj][m][1] * sc;
                    u32x4 w; w.x = cvt_pk_bf16(v0[0], v0[1]); w.y = cvt_pk_bf16(v0[2], v0[3]); w.z = cvt_pk_bf16(v1[0], v1[1]); w.w = cvt_pk_bf16(v1[2], v1[3]);
                    *(u32x4*)(rowp + bj * 128) = w; } }
    }
};

__device__ __forceinline__ void tr_item(const float* W, int ld, int kb, int n0, bf16_t* dst0, int K, LAS float* scr, int lane) {
    const int r = lane >> 4, q = lane & 15;
    f32x4 v[16];
#pragma unroll
    for (int i = 0; i < 16; ++i) v[i] = *(const f32x4*)(W + (size_t)(64 * kb + 4 * i + r) * ld + n0 + 4 * q);
#pragma unroll
    for (int i = 0; i < 16; ++i) { LAS float* s = scr + (4 * i + r) * 65 + 4 * q; s[0] = v[i][0]; s[1] = v[i][1]; s[2] = v[i][2]; s[3] = v[i][3]; }
    asm volatile("s_waitcnt lgkmcnt(0)" ::: "memory");
    const int c = lane & 7, nn = lane >> 3;
#pragma unroll
    for (int j = 0; j < 8; ++j) { const int n = nn + 8 * j; const LAS float* s = scr + (8 * c) * 65 + n;
        u32x4 o; o.x = pk2(s[0], s[65]); o.y = pk2(s[2 * 65], s[3 * 65]); o.z = pk2(s[4 * 65], s[5 * 65]); o.w = pk2(s[6 * 65], s[7 * 65]);
        *(u32x4*)(dst0 + (size_t)n * K + 64 * kb + 8 * c) = o; }
    asm volatile("s_waitcnt lgkmcnt(0)" ::: "memory");
}
__device__ __forceinline__ void tr_item8(const float* W, int ld, int kb, int n0, unsigned char* dst0, int K, LAS float* scr, int lane) {
    const int r = lane >> 4, q = lane & 15;
    f32x4 v[16];
#pragma unroll
    for (int i = 0; i < 16; ++i) v[i] = *(const f32x4*)(W + (size_t)(64 * kb + 4 * i + r) * ld + n0 + 4 * q);
#pragma unroll
    for (int i = 0; i < 16; ++i) { LAS float* s = scr + (4 * i + r) * 65 + 4 * q; s[0] = v[i][0]; s[1] = v[i][1]; s[2] = v[i][2]; s[3] = v[i][3]; }
    asm volatile("s_waitcnt lgkmcnt(0)" ::: "memory");
    const int c = lane & 7, nn = lane >> 3;
#pragma unroll
    for (int j = 0; j < 8; ++j) { const int n = nn + 8 * j; const LAS float* s = scr + (8 * c) * 65 + n;
        u32x2 o; o.x = pk4_fp8(s[0] * 64.0f, s[65] * 64.0f, s[2 * 65] * 64.0f, s[3 * 65] * 64.0f); o.y = pk4_fp8(s[4 * 65] * 64.0f, s[5 * 65] * 64.0f, s[6 * 65] * 64.0f, s[7 * 65] * 64.0f);
        *(u32x2*)(dst0 + (size_t)n * K + 64 * kb + 8 * c) = o; }
    asm volatile("s_waitcnt lgkmcnt(0)" ::: "memory");
}
__device__ __forceinline__ void phase_convert(const Ctx& C) {
    PHASE_IDS
    LAS float* scr = (LAS float*)(C.lds + wave * 16640);
    const int gw = C.bid * NWAVES + wave, NGW = C.G * NWAVES;
    constexpr int I0 = 512, I1 = 256, I2 = 256, I3 = 768, I4 = 256, I5 = 32768, I6 = 16384, NIT = I0 + I1 + I2 + I3 + I4 + I5 + I6;
    for (int it = gw; it < NIT; it += NGW) {
        int r = it;
        if (r < I0) { const int nbk = r & 31, kb = r >> 5; tr_item(C.in[I_WIN], 2048, kb, 64 * nbk, (bf16_t*)(C.ws + WS_WIN) + (size_t)(64 * nbk) * 1024, 1024, scr, lane); continue; } r -= I0;
        if (r < I1) { const int job = r >> 3, sub = r & 7, nbk = sub & 1, kb = sub >> 1;
            const int half = job & 1, which = (job >> 1) & 1, nb = (job >> 2) & 3, dir = job >> 4;
            const float* src = C.in[which ? I_WX : I_WA] + (size_t)(dir * 4 + nb) * 65536;
            bf16_t* dst = (bf16_t*)(C.ws + WS_GATE) + ((size_t)nb * 1024 + 256 * (2 * dir + half) + 128 * which + 64 * nbk) * 256;
            tr_item(src, 256, kb, 128 * half + 64 * nbk, dst, 256, scr, lane); continue; } r -= I1;
        if (r < I2) { const int nbk = r & 15, kb = r >> 4; tr_item(C.in[I_LOUT], 1024, kb, 64 * nbk, (bf16_t*)(C.ws + WS_LOUT) + (size_t)(64 * nbk) * 1024, 1024, scr, lane); continue; } r -= I2;
        if (r < I3) { const int nbk = r % 48, kb = r / 48; tr_item(C.in[I_WQKV], 3072, kb, 64 * nbk, (bf16_t*)(C.ws + WS_QKV) + (size_t)(64 * nbk) * 1024, 1024, scr, lane); continue; } r -= I3;
        if (r < I4) { const int nbk = r & 15, kb = r >> 4; tr_item(C.in[I_NOUT], 1024, kb, 64 * nbk, (bf16_t*)(C.ws + WS_NOUT) + (size_t)(64 * nbk) * 1024, 1024, scr, lane); continue; } r -= I4;
        if (r < I5) { const int mat = r >> 9, sub = r & 511, nbk = sub & 31, kb = sub >> 5; const int n0 = 64 * nbk, bj = n0 >> 10, f0 = n0 & 1023, pn = f0 >> 7, jj = f0 & 127;
            tr_item8(C.in[I_WGU] + (size_t)mat * 1024 * 2048, 2048, kb, n0, (unsigned char*)(C.ws + WS_WGU) + ((size_t)mat * 2048 + 256 * pn + 128 * bj + jj) * 1024, 1024, scr, lane); continue; } r -= I5;
        { const int mat = r >> 8, sub = r & 255, nbk = sub & 15, kb = sub >> 4;
            tr_item8(C.in[I_WD] + (size_t)mat * 1024 * 1024, 1024, kb, 64 * nbk, (unsigned char*)(C.ws + WS_WD) + ((size_t)mat * 1024 + 64 * nbk) * 1024, 1024, scr, lane); }
    }
    const int gt = C.bid * NTHREADS + tid, NGT = C.G * NTHREADS;
    for (int i = gt; i < 2048; i += NGT) ((float*)(C.ws + WS_CTL + CT_SPL))[i] = 8.0f * 1.44269504089f * log1pf(expf(-C.in[I_LAM][i]));
    for (int i = gt; i < 2 * 32 * 2048; i += NGT) { const int le = i >> 11, r = i & 2047, pn = r >> 8, bj = (r >> 7) & 1, ii = r & 127;
        ((float*)(C.ws + WS_BIAS))[i] = C.in[I_BGU][(size_t)le * 2048 + bj * 1024 + 128 * pn + ii]; }
    for (int i = gt; i < 2 * 32 * 1024; i += NGT) ((float*)(C.ws + WS_BD))[i] = C.in[I_BD][i];
    for (int i = gt; i < NTOK * 128; i += NGT) { const int row = i >> 7, oc = i & 127;
        const float* src = (row < NGRID ? C.in[I_X] + (size_t)row * D : C.in[I_META] + (size_t)((row - NGRID) & 15) * D) + 8 * oc;
        const f32x4 a = *(const f32x4*)src, b = *(const f32x4*)(src + 4);
        u32x4 w; w.x = pk2(a[0], a[1]); w.y = pk2(a[2], a[3]); w.z = pk2(b[0], b[1]); w.w = pk2(b[2], b[3]);
        *(u32x4*)((bf16_t*)(C.ws + WS_HB) + (size_t)row * D + 8 * oc) = w; }
}

__device__ __forceinline__ void phase_conv(const Ctx& C) {
    PHASE_IDS
    const bf16_t* XR = (const bf16_t*)(C.ws + WS_XR); bf16_t* XC = (bf16_t*)(C.ws + WS_XC);
    const float* cw = C.in[I_CONVW]; const float* cb = C.in[I_CONVB];
    const int gt = C.bid * NTHREADS + tid, NGT = C.G * NTHREADS;
    for (int i = gt; i < NTOK * 128; i += NGT) { const int row = i >> 7, ch = 8 * (i & 127);
        int b, s; if (row < NGRID) { b = row >> 12; s = NMETA + (row & (SEQ - 1)); } else { b = (row - NGRID) >> 4; s = (row - NGRID) & 15; }
        float a[8];
        { const f32x4 t0 = *(const f32x4*)(cb + ch), t1 = *(const f32x4*)(cb + ch + 4);
#pragma unroll
          for (int j = 0; j < 4; ++j) { a[j] = t0[j]; a[4 + j] = t1[j]; } }
#pragma unroll
        for (int j = 0; j < 4; ++j) { const int sj = s - 2 + j;
            if (sj >= 0 && sj < LSEQ) { const u32x4 xw = *(const u32x4*)(XR + (size_t)seqrow(b, sj) * D + ch);
                const f32x4 w0 = *(const f32x4*)(cw + j * 1024 + ch), w1 = *(const f32x4*)(cw + j * 1024 + ch + 4);
                a[0] += w0[0] * bflo(xw.x); a[1] += w0[1] * bfhi(xw.x); a[2] += w0[2] * bflo(xw.y); a[3] += w0[3] * bfhi(xw.y);
                a[4] += w1[0] * bflo(xw.z); a[5] += w1[1] * bfhi(xw.z); a[6] += w1[2] * bflo(xw.w); a[7] += w1[3] * bfhi(xw.w); } }
        u32x4 w; w.x = pk2(a[0], a[1]); w.y = pk2(a[2], a[3]); w.z = pk2(a[4], a[5]); w.w = pk2(a[6], a[7]);
        *(u32x4*)(XC + (size_t)row * D + ch) = w; }
}

template <int N> __device__ __forceinline__ float dpp_shr(float oldv, float v) {
    return __builtin_bit_cast(float, __builtin_amdgcn_update_dpp(__builtin_bit_cast(int, oldv), __builtin_bit_cast(int, v), 0x110 + N, 0xf, 0xf, false));
}
__device__ __forceinline__ void scan_group(float (&a)[8], float (&b)[8]) {
#pragma unroll
    for (int c = 0; c < 8; ++c) {
        { const float ap = dpp_shr<1>(1.0f, a[c]), bp = dpp_shr<1>(0.0f, b[c]); b[c] = a[c] * bp + b[c]; a[c] = a[c] * ap; }
        { const float ap = dpp_shr<2>(1.0f, a[c]), bp = dpp_shr<2>(0.0f, b[c]); b[c] = a[c] * bp + b[c]; a[c] = a[c] * ap; }
        { const float ap = dpp_shr<4>(1.0f, a[c]), bp = dpp_shr<4>(0.0f, b[c]); b[c] = a[c] * bp + b[c]; a[c] = a[c] * ap; }
        { const float ap = dpp_shr<8>(1.0f, a[c]), bp = dpp_shr<8>(0.0f, b[c]); b[c] = a[c] * bp + b[c]; a[c] = a[c] * ap; }
    }
}
__device__ __forceinline__ void unpack8(const u32x4 w, float (&o)[8]) { o[0] = bflo(w.x); o[1] = bfhi(w.x); o[2] = bflo(w.y); o[3] = bfhi(w.y); o[4] = bflo(w.z); o[5] = bfhi(w.z); o[6] = bflo(w.w); o[7] = bfhi(w.w); }
__device__ __forceinline__ void phase_scan(const Ctx& C) {
    PHASE_IDS
    const bf16_t* LA = (const bf16_t*)(C.ws + WS_LA); const bf16_t* BB = (const bf16_t*)(C.ws + WS_BB); const bf16_t* GY = (const bf16_t*)(C.ws + WS_GY);
    bf16_t* HF = (bf16_t*)(C.ws + WS_HF); bf16_t* Gout = (bf16_t*)(C.ws + WS_G);
    LAS float* agg = (LAS float*)C.lds;
    const int w = wave, oct = lane >> 4, p = lane & 15;
    for (int item = C.bid; item < NB * 32; item += C.G) {
        const int b = item >> 5, g = item & 31;
        for (int dir = 0; dir < 2; ++dir) {
            const bf16_t* la = LA + (((size_t)dir * 32 + g) * MPAD) * 32 + 8 * oct;
            const bf16_t* bb = BB + (((size_t)dir * 32 + g) * MPAD) * 32 + 8 * oct;
            float S[8];
#pragma unroll
            for (int c = 0; c < 8; ++c) S[c] = 0.f;
            {
                const int u = p, s = dir ? LSEQ - 1 - u : u, row = seqrow(b, s);
                float a[8], x[8]; unpack8(*(const u32x4*)(la + (size_t)row * 32), a); unpack8(*(const u32x4*)(bb + (size_t)row * 32), x);
#pragma unroll
                for (int c = 0; c < 8; ++c) a[c] = fast_exp2(a[c]);
                scan_group(a, x);
                if (w == 0) {
                    if (dir == 0) { u32x4 o; o.x = pk2(x[0], x[1]); o.y = pk2(x[2], x[3]); o.z = pk2(x[4], x[5]); o.w = pk2(x[6], x[7]); *(u32x4*)(HF + ((size_t)g * MPAD + row) * 32 + 8 * oct) = o; }
                    else { float hf[8], gy[8]; unpack8(*(const u32x4*)(HF + ((size_t)g * MPAD + row) * 32 + 8 * oct), hf); unpack8(*(const u32x4*)(GY + ((size_t)g * MPAD + row) * 32 + 8 * oct), gy);
                        u32x4 o; o.x = pk2((hf[0] + x[0]) * gy[0], (hf[1] + x[1]) * gy[1]); o.y = pk2((hf[2] + x[2]) * gy[2], (hf[3] + x[3]) * gy[3]);
                        o.z = pk2((hf[4] + x[4]) * gy[4], (hf[5] + x[5]) * gy[5]); o.w = pk2((hf[6] + x[6]) * gy[6], (hf[7] + x[7]) * gy[7]);
                        *(u32x4*)(Gout + (size_t)row * D + 32 * g + 8 * oct) = o; }
                }
#pragma unroll
                for (int c = 0; c < 8; ++c) S[c] = __shfl(x[c], (lane & 48) | 15);
            }
            for (int r = 0; r < 8; ++r) {
                float Pw[4][8], Hw[4][8]; int rows[4];
                float Aw[8], Hc[8];
#pragma unroll
                for (int c = 0; c < 8; ++c) { Aw[c] = 1.f; Hc[c] = 0.f; }
                u32x4 ra[4], rb[4];
#pragma unroll
                for (int j = 0; j < 4; ++j) { const int u = 16 + 512 * r + 64 * w + 16 * j + p, s = dir ? LSEQ - 1 - u : u; rows[j] = seqrow(b, s);
                    ra[j] = *(const u32x4*)(la + (size_t)rows[j] * 32); rb[j] = *(const u32x4*)(bb + (size_t)rows[j] * 32); }
#pragma unroll
                for (int j = 0; j < 4; ++j) {
                    float a[8], x[8]; unpack8(ra[j], a); unpack8(rb[j], x);
#pragma unroll
                    for (int c = 0; c < 8; ++c) a[c] = fast_exp2(a[c]);
                    scan_group(a, x);
#pragma unroll
                    for (int c = 0; c < 8; ++c) { Hw[j][c] = a[c] * Hc[c] + x[c]; Pw[j][c] = a[c] * Aw[c]; }
#pragma unroll
                    for (int c = 0; c < 8; ++c) { Aw[c] = __shfl(Pw[j][c], (lane & 48) | 15); Hc[c] = __shfl(Hw[j][c], (lane & 48) | 15); }
                }
                LAS float* ag = agg + (r & 1) * 512;
                if (p == 0) {
#pragma unroll
                    for (int c = 0; c < 8; ++c) { ag[(w * 32 + oct * 8 + c) * 2] = Aw[c]; ag[(w * 32 + oct * 8 + c) * 2 + 1] = Hc[c]; }
                }
                __syncthreads();
                float Sin[8];
#pragma unroll
                for (int c = 0; c < 8; ++c) Sin[c] = S[c];
#pragma unroll
                for (int ww = 0; ww < 8; ++ww) {
#pragma unroll
                    for (int c = 0; c < 8; ++c) { const float A = ag[(ww * 32 + oct * 8 + c) * 2], H = ag[(ww * 32 + oct * 8 + c) * 2 + 1];
                        if (ww == w) Sin[c] = S[c];
                        S[c] = A * S[c] + H; }
                }
#pragma unroll
                for (int j = 0; j < 4; ++j) {
                    float h[8];
#pragma unroll
                    for (int c = 0; c < 8; ++c) h[c] = Pw[j][c] * Sin[c] + Hw[j][c];
                    const size_t go = ((size_t)g * MPAD + rows[j]) * 32 + 8 * oct;
                    if (dir == 0) { u32x4 o; o.x = pk2(h[0], h[1]); o.y = pk2(h[2], h[3]); o.z = pk2(h[4], h[5]); o.w = pk2(h[6], h[7]); *(u32x4*)(HF + go) = o; }
                    else { float hf[8], gy[8]; unpack8(*(const u32x4*)(HF + go), hf); unpack8(*(const u32x4*)(GY + go), gy);
                        u32x4 o; o.x = pk2((hf[0] + h[0]) * gy[0], (hf[1] + h[1]) * gy[1]); o.y = pk2((hf[2] + h[2]) * gy[2], (hf[3] + h[3]) * gy[3]);
                        o.z = pk2((hf[4] + h[4]) * gy[4], (hf[5] + h[5]) * gy[5]); o.w = pk2((hf[6] + h[6]) * gy[6], (hf[7] + h[7]) * gy[7]);
                        *(u32x4*)(Gout + (size_t)rows[j] * D + 32 * g + 8 * oct) = o; }
                }
            }
            __syncthreads();
        }
    }
}

template <int K> __device__ __forceinline__ f32x4 mini_mma(const bf16_t* W, int ldw, const bf16_t* A, int lda, int lane) {
    const bf16_t* wp = W + (size_t)(lane & 15) * ldw + 8 * (lane >> 4); const bf16_t* ap = A + (size_t)(lane & 15) * lda + 8 * (lane >> 4);
    f32x4 acc = {0.f, 0.f, 0.f, 0.f};
    constexpr int KB = K < 512 ? K : 512, NS = KB / 32;
#pragma unroll 1
    for (int k0 = 0; k0 < K; k0 += KB) { bf16x8 wf[NS], af[NS];
#pragma unroll
        for (int i = 0; i < NS; ++i) { wf[i] = *(const bf16x8*)(wp + k0 + 32 * i); af[i] = *(const bf16x8*)(ap + k0 + 32 * i); }
#pragma unroll
        for (int i = 0; i < NS; ++i) acc = __builtin_amdgcn_mfma_f32_16x16x32_bf16(wf[i], af[i], acc, 0, 0, 0); }
    return acc;
}
__device__ __forceinline__ void mini_win(const Ctx& C) {
    PHASE_IDS
    const bf16_t* HB = (const bf16_t*)(C.ws + WS_HB); const bf16_t* WT = (const bf16_t*)(C.ws + WS_WIN); bf16_t* XR = (bf16_t*)(C.ws + WS_XR); bf16_t* GY = (bf16_t*)(C.ws + WS_GY);
    const int fr = lane & 15, fq = lane >> 4;
    for (int wt = C.gc * NWAVES + wave; wt < 8 * 128; wt += C.G * NWAVES) { const int rg = wt & 7, cb = wt >> 3, row = NGRID + 16 * rg + fr, c = 16 * cb + 4 * fq;
        const f32x4 a = mini_mma<1024>(WT + (size_t)(16 * cb) * 1024, 1024, HB + (size_t)(NGRID + 16 * rg) * 1024, 1024, lane);
        if (c < 1024) { u32x2 w; w.x = cvt_pk_bf16(a[0], a[1]); w.y = cvt_pk_bf16(a[2], a[3]); *(u32x2*)(XR + (size_t)row * D + c) = w; }
        else { const int yc = c - 1024; float o[4];
#pragma unroll
            for (int j = 0; j < 4; ++j) { const float v = a[j]; const float z = 1.5957691216f * (v + 0.044715f * v * v * v); o[j] = v * sigmoidf_(z); }
            u32x2 w; w.x = cvt_pk_bf16(o[0], o[1]); w.y = cvt_pk_bf16(o[2], o[3]); *(u32x2*)(GY + ((size_t)(yc >> 5) * MPAD + row) * 32 + (yc & 31)) = w; } }
}
__device__ __forceinline__ void mini_gate(const Ctx& C) {
    PHASE_IDS
    const bf16_t* XC = (const bf16_t*)(C.ws + WS_XC); const bf16_t* GT = (const bf16_t*)(C.ws + WS_GATE); bf16_t* LA = (bf16_t*)(C.ws + WS_LA); bf16_t* BB = (bf16_t*)(C.ws + WS_BB);
    const float* ba = C.in[I_BA]; const float* bx = C.in[I_BX]; const float* spl = (const float*)(C.ws + WS_CTL + CT_SPL);
    const int fr = lane & 15, fq = lane >> 4;
    for (int wt = C.gc * NWAVES + wave; wt < 8 * 2 * 64; wt += C.G * NWAVES) { const int rg = wt & 7, dir = (wt >> 3) & 1, chg = wt >> 4, ch0 = 16 * chg, nb = ch0 >> 8, half = (ch0 >> 7) & 1, jj0 = ch0 & 127;
        const bf16_t* A = XC + (size_t)(NGRID + 16 * rg) * 1024 + 256 * nb; const bf16_t* Wa = GT + ((size_t)nb * 1024 + 256 * (2 * dir + half) + jj0) * 256;
        const f32x4 za = mini_mma<256>(Wa, 256, A, 1024, lane), zx = mini_mma<256>(Wa + 128 * 256, 256, A, 1024, lane);
        const int row = NGRID + 16 * rg + fr, ch = ch0 + 4 * fq;
        const f32x4 cba = *(const f32x4*)(ba + dir * 1024 + ch), cbx = *(const f32x4*)(bx + dir * 1024 + ch), csp = *(const f32x4*)(spl + dir * 1024 + ch);
        const u32x2 xw = *(const u32x2*)(XC + (size_t)row * D + ch); const float xc[4] = {bflo(xw.x), bfhi(xw.x), bflo(xw.y), bfhi(xw.y)};
        const bool start = dir == 0 && fr == 0;
        float la[4], bb[4];
#pragma unroll
        for (int j = 0; j < 4; ++j) { const float ga = sigmoidf_(za[j] + cba[j]), gx = sigmoidf_(zx[j] + cbx[j]); const float l2 = -csp[j] * ga; const float a2 = fast_exp2(2.0f * l2);
            const float mult = start ? 1.0f : __builtin_sqrtf(fmaxf(1.0f - a2, 0.0f)); la[j] = l2; bb[j] = mult * gx * xc[j]; }
        const size_t o = (((size_t)dir * 32 + (ch >> 5)) * MPAD + row) * 32 + (ch & 31);
        u32x2 w; w.x = cvt_pk_bf16(la[0], la[1]); w.y = cvt_pk_bf16(la[2], la[3]); *(u32x2*)(LA + o) = w;
        w.x = cvt_pk_bf16(bb[0], bb[1]); w.y = cvt_pk_bf16(bb[2], bb[3]); *(u32x2*)(BB + o) = w; }
}
__device__ __forceinline__ void mini_lout(const Ctx& C) {
    PHASE_IDS
    const bf16_t* G = (const bf16_t*)(C.ws + WS_G); const bf16_t* WT = (const bf16_t*)(C.ws + WS_LOUT); bf16_t* PRE = (bf16_t*)(C.ws + WS_PRE); const float* meta = C.in[I_META];
    const int fr = lane & 15, fq = lane >> 4;
    for (int wt = C.gc * NWAVES + wave; wt < 8 * 64; wt += C.G * NWAVES) { const int rg = wt & 7, cb = wt >> 3, row = NGRID + 16 * rg + fr, c = 16 * cb + 4 * fq;
        const f32x4 a = mini_mma<1024>(WT + (size_t)(16 * cb) * 1024, 1024, G + (size_t)(NGRID + 16 * rg) * 1024, 1024, lane);
        const f32x4 r = *(const f32x4*)(meta + (size_t)fr * D + c);
        u32x2 w; w.x = cvt_pk_bf16(r[0] * DN_ALPHA + a[0], r[1] * DN_ALPHA + a[1]); w.y = cvt_pk_bf16(r[2] * DN_ALPHA + a[2], r[3] * DN_ALPHA + a[3]); *(u32x2*)(PRE + (size_t)row * D + c) = w; }
}
__device__ __forceinline__ void mini_kv(const Ctx& C) {
    PHASE_IDS
    const bf16_t* HB = (const bf16_t*)(C.ws + WS_HB); const bf16_t* WT = (const bf16_t*)(C.ws + WS_QKV); bf16_t* Kx = (bf16_t*)(C.ws + WS_K); bf16_t* VT = (bf16_t*)(C.ws + WS_VT);
    const int fr = lane & 15, fq = lane >> 4;
    for (int wt = C.gc * NWAVES + wave; wt < 2 * 8 * 64; wt += C.G * NWAVES) { const int rg = wt & 7, cb = (wt >> 3) & 63, isv = wt >> 9;
        const bf16_t* A = HB + (size_t)(NGRID + 16 * rg) * 1024;
        if (!isv) { const f32x4 a = mini_mma<1024>(WT + (size_t)(1024 + 16 * cb) * 1024, 1024, A, 1024, lane);
            u32x2 w; w.x = cvt_pk_bf16(a[0], a[1]); w.y = cvt_pk_bf16(a[2], a[3]); *(u32x2*)(Kx + (size_t)(NGRID + 16 * rg + fr) * D + 16 * cb + 4 * fq) = w; }
        else { const f32x4 a = mini_mma<1024>(A, 1024, WT + (size_t)(2048 + 16 * cb) * 1024, 1024, lane);
            u32x2 w; w.x = cvt_pk_bf16(a[0], a[1]); w.y = cvt_pk_bf16(a[2], a[3]); *(u32x2*)(VT + (size_t)(16 * cb + fr) * MPAD + NGRID + 16 * rg + 4 * fq) = w; } }
}

constexpr int RWT_PITCH = 1028;
__device__ __forceinline__ void phase_lnr(const Ctx& C, int layer, int nrows) {
    PHASE_IDS
    const bf16_t* PRE = (const bf16_t*)(C.ws + WS_PRE); bf16_t* HB = (bf16_t*)(C.ws + WS_HB); unsigned char* HB8 = C.ws + WS_HB8;
    const float* lg = C.in[I_LNMG] + layer * D; const float* lb = C.in[I_LNMB] + layer * D;
    const float* rw = C.in[I_RW] + (size_t)layer * D * NEXP; const float* rb = C.in[I_RB] + layer * NEXP;
    int* eid = (int*)(C.ws + WS_CTL + CT_EID) + (size_t)layer * NTOK * 4; float* gatev = (float*)(C.ws + WS_CTL + CT_GATEV) + (size_t)layer * NTOK * 4;
    unsigned* bc = (unsigned*)(C.ws + WS_CTL + CT_BC) + ((size_t)layer * 256 + C.bid) * 32;
    LAS float* RWt = (LAS float*)C.lds; LAS unsigned* hist = (LAS unsigned*)(C.lds + 32 * RWT_PITCH * 4);
    { f32x4 wv[16];
#pragma unroll
      for (int i = 0; i < 16; ++i) wv[i] = *(const f32x4*)(rw + 4 * (tid + NTHREADS * i));
#pragma unroll
      for (int i = 0; i < 16; ++i) { const int idx4 = tid + NTHREADS * i, ch = idx4 >> 3, e4 = (idx4 & 7) * 4;
          const int c = 4 * ((ch & 511) >> 3) + 256 * (2 * (ch >> 9) + ((ch >> 2) & 1)) + (ch & 3);
          RWt[(e4 + 0) * RWT_PITCH + c] = wv[i][0]; RWt[(e4 + 1) * RWT_PITCH + c] = wv[i][1]; RWt[(e4 + 2) * RWT_PITCH + c] = wv[i][2]; RWt[(e4 + 3) * RWT_PITCH + c] = wv[i][3]; } }
    if (tid < 32) hist[tid] = 0u;
    __syncthreads();
    float gg[2][8], gb[2][8];
#pragma unroll
    for (int j = 0; j < 2; ++j) { const f32x4 a0 = *(const f32x4*)(lg + 8 * lane + 512 * j), a1 = *(const f32x4*)(lg + 8 * lane + 512 * j + 4), b0 = *(const f32x4*)(lb + 8 * lane + 512 * j), b1 = *(const f32x4*)(lb + 8 * lane + 512 * j + 4);
#pragma unroll
        for (int i = 0; i < 4; ++i) { gg[j][i] = a0[i]; gg[j][4 + i] = a1[i]; gb[j][i] = b0[i]; gb[j][4 + i] = b1[i]; } }
    const float rbias = rb[lane >> 1];
    const int gw = C.bid * NWAVES + wave, NGW = C.G * NWAVES;
    u32x4 nv[2];
    if (gw < nrows) {
#pragma unroll
        for (int j = 0; j < 2; ++j) nv[j] = *(const u32x4*)(PRE + (size_t)gw * D + 8 * lane + 512 * j); }
    for (int row = gw; row < nrows; row += NGW) {
        float v[2][8]; float s = 0.f;
#pragma unroll
        for (int j = 0; j < 2; ++j) { unpack8(nv[j], v[j]); s += ((v[j][0] + v[j][1]) + (v[j][2] + v[j][3])) + ((v[j][4] + v[j][5]) + (v[j][6] + v[j][7])); }
        if (row + NGW < nrows) {
#pragma unroll
            for (int j = 0; j < 2; ++j) nv[j] = *(const u32x4*)(PRE + (size_t)(row + NGW) * D + 8 * lane + 512 * j); }
        const float mean = wave_sum_dpp(s) * (1.0f / D); float q = 0.f;
#pragma unroll
        for (int j = 0; j < 2; ++j)
#pragma unroll
            for (int i = 0; i < 8; ++i) { v[j][i] -= mean; q += v[j][i] * v[j][i]; }
        const float rstd = 1.0f / sqrtf(wave_sum_dpp(q) * (1.0f / D) + LN_EPS);
#pragma unroll
        for (int j = 0; j < 2; ++j) {
#pragma unroll
            for (int i = 0; i < 8; ++i) v[j][i] = v[j][i] * rstd * gg[j][i] + gb[j][i];
            u32x4 w; w.x = pk2(v[j][0], v[j][1]); w.y = pk2(v[j][2], v[j][3]); w.z = pk2(v[j][4], v[j][5]); w.w = pk2(v[j][6], v[j][7]);
            *(u32x4*)(HB + (size_t)row * D + 8 * lane + 512 * j) = w;
            u32x2 w8; w8.x = pk4_fp8(v[j][0], v[j][1], v[j][2], v[j][3]); w8.y = pk4_fp8(v[j][4], v[j][5], v[j][6], v[j][7]);
            *(u32x2*)(HB8 + (size_t)row * D + 8 * lane + 512 * j) = w8; }
        float pl[32];
#pragma unroll
        for (int e0 = 0; e0 < 32; e0 += 4) {
            f32x4 wv[4][4];
#pragma unroll
            for (int ee = 0; ee < 4; ++ee)
#pragma unroll
                for (int jj = 0; jj < 4; ++jj) wv[ee][jj] = *(const LAS f32x4*)(RWt + (e0 + ee) * RWT_PITCH + 4 * lane + 256 * jj);
            __builtin_amdgcn_sched_barrier(0);
#pragma unroll
            for (int ee = 0; ee < 4; ++ee) { float a = 0.f;
#pragma unroll
                for (int jj = 0; jj < 4; ++jj) { const int j = jj >> 1, o = 4 * (jj & 1); a += (v[j][o] * wv[ee][jj][0] + v[j][o + 1] * wv[ee][jj][1]) + (v[j][o + 2] * wv[ee][jj][2] + v[j][o + 3] * wv[ee][jj][3]); }
                pl[e0 + ee] = a; }
        }
        float q16[16], q8[8], q4[4], q2[2], q1;
        { const bool hi = (lane & 32) != 0;
#pragma unroll
          for (int e = 0; e < 16; ++e) { const float mine = hi ? pl[16 + e] : pl[e], other = hi ? pl[e] : pl[16 + e]; q16[e] = mine + __shfl_xor(other, 32); } }
        { const bool hi = (lane & 16) != 0;
#pragma unroll
          for (int e = 0; e < 8; ++e) { const float mine = hi ? q16[8 + e] : q16[e], other = hi ? q16[e] : q16[8 + e]; q8[e] = mine + __shfl_xor(other, 16); } }
        { const bool hi = (lane & 8) != 0;
#pragma unroll
          for (int e = 0; e < 4; ++e) { const float mine = hi ? q8[4 + e] : q8[e], other = hi ? q8[e] : q8[4 + e]; q4[e] = mine + dpp_movf<0x128>(other); } }
        { const bool hi = (lane & 4) != 0;
#pragma unroll
          for (int e = 0; e < 2; ++e) { const float mine = hi ? q4[2 + e] : q4[e], other = hi ? q4[e] : q4[2 + e]; q2[e] = mine + __shfl_xor(other, 4); } }
        { const bool hi = (lane & 2) != 0; const float mine = hi ? q2[1] : q2[0], other = hi ? q2[0] : q2[1]; q1 = mine + dpp_movf<0x4E>(other); }
        q1 += dpp_movf<0xB1>(q1);
        float lv = q1 + rbias; lv = (lv == lv) ? lv : -3.0e38f;
        const int le = lane >> 1;
        int rank = 0;
#pragma unroll
        for (int j = 0; j < 32; ++j) { const float lj = readlane_f(lv, 2 * j); rank += (lj > lv || (lj == lv && j < le)) ? 1 : 0; }
        const unsigned long long m0 = __ballot(rank == 0);
        const float mxl = readlane_f(lv, (int)__builtin_ctzll(m0));
        const float pe = rank < 4 ? __expf(lv - mxl) : 0.f;
        const float den = wave_sum_dpp(pe) * 0.5f;
        if (rank < 4 && (lane & 1) == 0) { eid[(size_t)row * 4 + rank] = le; gatev[(size_t)row * 4 + rank] = pe / den;
            __hip_atomic_fetch_add(&hist[le], 1u, __ATOMIC_RELAXED, __HIP_MEMORY_SCOPE_WORKGROUP); }
    }
    __syncthreads();
    if (tid < 32) bc[tid] = hist[tid];
}

__device__ __forceinline__ void phase_pos(const Ctx& C, int layer, int nrows) {
    PHASE_IDS
    const unsigned* bcAll = (const unsigned*)(C.ws + WS_CTL + CT_BC) + (size_t)layer * 256 * 32;
    const int* eid = (const int*)(C.ws + WS_CTL + CT_EID) + (size_t)layer * NTOK * 4; int* posv = (int*)(C.ws + WS_CTL + CT_POS) + (size_t)layer * NTOK * 4;
    int* texp = (int*)(C.ws + WS_CTL + CT_TEXP) + layer * 1024;
    const unsigned char* HB8 = C.ws + WS_HB8; unsigned char* XS = C.ws + WS_XS;
    LAS unsigned* partT = (LAS unsigned*)C.lds; LAS unsigned* partP = partT + 512; LAS unsigned* tot = partP + 512; LAS unsigned* cnt = tot + 32;
    { const int e = tid & 31, part = tid >> 5; unsigned t = 0, pr = 0;
      unsigned vv[16];
#pragma unroll
      for (int i = 0; i < 16; ++i) { const int bq = part + 16 * i; vv[i] = bq < C.G ? bcAll[(size_t)bq * 32 + e] : 0u; }
#pragma unroll
      for (int i = 0; i < 16; ++i) { const int bq = part + 16 * i; t += vv[i]; if (bq < C.bid) pr += vv[i]; }
      partT[part * 32 + e] = t; partP[part * 32 + e] = pr; }
    __syncthreads();
    if (tid < 32) { unsigned t = 0, pr = 0; for (int i = 0; i < 16; ++i) { t += partT[i * 32 + tid]; pr += partP[i * 32 + tid]; } tot[tid] = t; cnt[tid] = pr; }
    __syncthreads();
    if (tid < 32) { unsigned off = 0; for (int e = 0; e < tid; ++e) off += (tot[e] + 255u) & ~255u;
        const unsigned mine = (tot[tid] + 255u) & ~255u;
        if (C.bid == 0) { for (unsigned t = off >> 8; t < ((off + mine) >> 8); ++t) texp[t] = tid; if (tid == 31) texp[1023] = (int)((off + mine) >> 8); }
        cnt[tid] += off; }
    __syncthreads();
    const int gw = C.bid * NWAVES + wave, NGW = C.G * NWAVES;
    for (int row = gw; row < nrows; row += NGW) {
        int pos = 0;
        if (lane < 4) { const int e = eid[(size_t)row * 4 + lane]; pos = (int)__hip_atomic_fetch_add(&cnt[e], 1u, __ATOMIC_RELAXED, __HIP_MEMORY_SCOPE_WORKGROUP); posv[(size_t)row * 4 + lane] = pos; }
        const u32x4 r0 = *(const u32x4*)(HB8 + (size_t)row * D + 16 * lane);
#pragma unroll
        for (int k = 0; k < 4; ++k) { const int pk = __shfl(pos, k); *(u32x4*)(XS + (size_t)pk * D + 16 * lane) = r0; }
    }
}

__device__ __forceinline__ void phase_combine(const Ctx& C, int layer, int nrows, bool final_out) {
    PHASE_IDS
    bf16_t* HB = (bf16_t*)(C.ws + WS_HB); const bf16_t* YS = (const bf16_t*)(C.ws + WS_YS);
    const float* lg = C.in[I_LNFG] + layer * D; const float* lb = C.in[I_LNFB] + layer * D;
    const float* gatev = (const float*)(C.ws + WS_CTL + CT_GATEV) + (size_t)layer * NTOK * 4; const int* posv = (const int*)(C.ws + WS_CTL + CT_POS) + (size_t)layer * NTOK * 4;
    float gg[2][8], gb[2][8];
#pragma unroll
    for (int j = 0; j < 2; ++j) { const f32x4 a0 = *(const f32x4*)(lg + 8 * lane + 512 * j), a1 = *(const f32x4*)(lg + 8 * lane + 512 * j + 4), b0 = *(const f32x4*)(lb + 8 * lane + 512 * j), b1 = *(const f32x4*)(lb + 8 * lane + 512 * j + 4);
#pragma unroll
        for (int i = 0; i < 4; ++i) { gg[j][i] = a0[i]; gg[j][4 + i] = a1[i]; gb[j][i] = b0[i]; gb[j][4 + i] = b1[i]; } }
    const int gw = C.bid * NWAVES + wave, NGW = C.G * NWAVES;
    for (int row = gw; row < nrows; row += NGW) {
        const f32x4 gk4 = *(const f32x4*)(gatev + (size_t)row * 4); const int pk0 = posv[(size_t)row * 4], pk1 = posv[(size_t)row * 4 + 1], pk2_ = posv[(size_t)row * 4 + 2], pk3 = posv[(size_t)row * 4 + 3];
        u32x4 hw[2], yw[4][2];
#pragma unroll
        for (int j = 0; j < 2; ++j) { hw[j] = *(const u32x4*)(HB + (size_t)row * D + 8 * lane + 512 * j);
            yw[0][j] = *(const u32x4*)(YS + (size_t)pk0 * D + 8 * lane + 512 * j); yw[1][j] = *(const u32x4*)(YS + (size_t)pk1 * D + 8 * lane + 512 * j);
            yw[2][j] = *(const u32x4*)(YS + (size_t)pk2_ * D + 8 * lane + 512 * j); yw[3][j] = *(const u32x4*)(YS + (size_t)pk3 * D + 8 * lane + 512 * j); }
        float v[2][8]; float s = 0.f;
#pragma unroll
        for (int j = 0; j < 2; ++j) { float h[8]; unpack8(hw[j], h);
#pragma unroll
            for (int i = 0; i < 8; ++i) v[j][i] = h[i] * DN_ALPHA;
#pragma unroll
            for (int k = 0; k < 4; ++k) { float y[8]; unpack8(yw[k][j], y);
#pragma unroll
                for (int i = 0; i < 8; ++i) v[j][i] += gk4[k] * y[i]; }
#pragma unroll
            for (int i = 0; i < 8; ++i) s += v[j][i]; }
        const float mean = wave_sum_dpp(s) * (1.0f / D); float q = 0.f;
#pragma unroll
        for (int j = 0; j < 2; ++j)
#pragma unroll
            for (int i = 0; i < 8; ++i) { v[j][i] -= mean; q += v[j][i] * v[j][i]; }
        const float rstd = 1.0f / sqrtf(wave_sum_dpp(q) * (1.0f / D) + LN_EPS);
#pragma unroll
        for (int j = 0; j < 2; ++j) {
#pragma unroll
            for (int i = 0; i < 8; ++i) v[j][i] = v[j][i] * rstd * gg[j][i] + gb[j][i];
            if (final_out) { *(f32x4*)(C.out + (size_t)row * D + 8 * lane + 512 * j) = (f32x4){v[j][0], v[j][1], v[j][2], v[j][3]}; *(f32x4*)(C.out + (size_t)row * D + 8 * lane + 512 * j + 4) = (f32x4){v[j][4], v[j][5], v[j][6], v[j][7]}; }
            else { u32x4 w; w.x = pk2(v[j][0], v[j][1]); w.y = pk2(v[j][2], v[j][3]); w.z = pk2(v[j][4], v[j][5]); w.w = pk2(v[j][6], v[j][7]); *(u32x4*)(HB + (size_t)row * D + 8 * lane + 512 * j) = w; } }
    }
}

constexpr int AT_KS = 0, AT_VTS = 73728, AT_VPITCH = 1168, AT_KM = AT_VTS + 64 * AT_VPITCH, AT_VTM = AT_KM + 2048, AT_RPB = AT_VTM + 2048, AT_MB = AT_RPB + 1920, AT_END = AT_MB + 64;
static_assert(AT_END <= LDS_BYTES, "attention LDS map");
__device__ __forceinline__ void phase_attn(const Ctx& C) {
    PHASE_IDS
    const bf16_t* Q = (const bf16_t*)(C.ws + WS_Q); const bf16_t* Kx = (const bf16_t*)(C.ws + WS_K); const bf16_t* VT = (const bf16_t*)(C.ws + WS_VT); bf16_t* O = (bf16_t*)(C.ws + WS_O);
    const float* rpb = C.in[I_RPB]; const float* mbias = C.in[I_MBIAS];
    LAS unsigned char* lds = C.lds;
    const int w = wave, lq = lane & 15, g = lane >> 4;
    for (int unit = C.bid; unit < NB * 16 * 32; unit += C.G) {
        const int rp = unit & 31, h = (unit >> 5) & 15, b = unit >> 9;
        const int R0 = min(max(2 * rp - 4, 0), 55);
        __syncthreads();
#pragma unroll
        for (int i = 0; i < 9; ++i) { const int idx = tid + 512 * i, ch = idx & 7, kc = (idx >> 3) & 63, jr = idx >> 9;
            const u32x4 v = *(const u32x4*)(Kx + (size_t)(b * SEQ + (R0 + jr) * 64 + kc) * D + 64 * h + 8 * ch);
            *(LAS u32x4*)(lds + AT_KS + ((jr * 64 + kc) * 8 + (ch ^ (kc & 7))) * 16) = v; }
#pragma unroll
        for (int i = 0; i < 9; ++i) { const int idx = tid + 512 * i, d = idx / 72, cx = idx - d * 72;
            const u32x4 v = *(const u32x4*)(VT + (size_t)(64 * h + d) * MPAD + b * SEQ + R0 * 64 + 8 * cx);
            *(LAS u32x4*)(lds + AT_VTS + d * AT_VPITCH + cx * 16) = v; }
        if (tid < 128) { const int m = tid >> 3, ch = tid & 7;
            const u32x4 v = *(const u32x4*)(Kx + (size_t)(NGRID + 16 * b + m) * D + 64 * h + 8 * ch);
            *(LAS u32x4*)(lds + AT_KM + (m * 8 + (ch ^ (m & 7))) * 16) = v; }
        else if (tid < 256) { const int i = tid - 128, d = i >> 1, hf = i & 1;
            const u32x4 v = *(const u32x4*)(VT + (size_t)(64 * h + d) * MPAD + NGRID + 16 * b + 8 * hf);
            *(LAS u32x4*)(lds + AT_VTM + d * 32 + hf * 16) = v; }
        if (tid < 465) ((LAS float*)(lds + AT_RPB))[tid] = rpb[h * 465 + tid];
        if (tid < 16) ((LAS float*)(lds + AT_MB))[tid] = mbias[h * 16 + tid];
        __syncthreads();
        const int qr = w >> 2, qg = w & 3, r = 2 * rp + qr, c0 = 16 * qg;
        const int rs = min(max(r - 4, 0), 56), jr0 = rs - R0;
        const int kcb = qg == 0 ? 0 : (qg == 1 ? 8 : (qg == 2 ? 24 : 32));
        const size_t qrow = (size_t)(b * SEQ + r * 64 + c0 + lq);
        bf16x8 qf[2];
#pragma unroll
        for (int ks = 0; ks < 2; ++ks) qf[ks] = *(const bf16x8*)(Q + qrow * D + 64 * h + 32 * ks + 8 * g);
        f32x4 sc[8][2], sm;
#pragma unroll
        for (int j = 0; j < 8; ++j)
#pragma unroll
            for (int blk = 0; blk < 2; ++blk) { f32x4 a = {0.f, 0.f, 0.f, 0.f}; const int kc = kcb + 16 * blk + lq;
#pragma unroll
                for (int ks = 0; ks < 2; ++ks) { const bf16x8 kf = *(const LAS bf16x8*)(lds + AT_KS + (((jr0 + j) * 64 + kc) * 8 + ((4 * ks + g) ^ (kc & 7))) * 16);
                    a = __builtin_amdgcn_mfma_f32_16x16x32_bf16(kf, qf[ks], a, 0, 0, 0); }
                sc[j][blk] = a; }
        { f32x4 a = {0.f, 0.f, 0.f, 0.f};
#pragma unroll
          for (int ks = 0; ks < 2; ++ks) { const bf16x8 kf = *(const LAS bf16x8*)(lds + AT_KM + (lq * 8 + ((4 * ks + g) ^ (lq & 7))) * 16);
              a = __builtin_amdgcn_mfma_f32_16x16x32_bf16(kf, qf[ks], a, 0, 0, 0); }
          sm = a; }
        const int c = c0 + lq, cs = min(max(c - 8, 0), 48);
        const LAS float* RP = (const LAS float*)(lds + AT_RPB); const LAS float* MB = (const LAS float*)(lds + AT_MB);
        float mx = -3.0e38f;
#pragma unroll
        for (int j = 0; j < 8; ++j) { const int ro = rs + j - r + 7;
#pragma unroll
            for (int blk = 0; blk < 2; ++blk)
#pragma unroll
                for (int e = 0; e < 4; ++e) { const int kc = kcb + 16 * blk + 4 * g + e; const bool valid = kc >= cs && kc < cs + 16;
                    const float bias = RP[valid ? ro * 31 + (kc - c + 15) : 0];
                    const float s = valid ? sc[j][blk][e] + bias : -1.0e30f; sc[j][blk][e] = s; mx = fmaxf(mx, s); } }
#pragma unroll
        for (int e = 0; e < 4; ++e) { sm[e] += MB[4 * g + e]; mx = fmaxf(mx, sm[e]); }
        mx = fmaxf(mx, __shfl_xor(mx, 16)); mx = fmaxf(mx, __shfl_xor(mx, 32));
        float sum = 0.f;
#pragma unroll
        for (int j = 0; j < 8; ++j)
#pragma unroll
            for (int blk = 0; blk < 2; ++blk)
#pragma unroll
                for (int e = 0; e < 4; ++e) { const float pv = fast_exp2((sc[j][blk][e] - mx) * 1.44269504089f); sc[j][blk][e] = pv; sum += pv; }
#pragma unroll
        for (int e = 0; e < 4; ++e) { const float pv = fast_exp2((sm[e] - mx) * 1.44269504089f); sm[e] = pv; sum += pv; }
        sum += __shfl_xor(sum, 16); sum += __shfl_xor(sum, 32);
        f32x4 o[4];
#pragma unroll
        for (int db = 0; db < 4; ++db) o[db] = (f32x4){0.f, 0.f, 0.f, 0.f};
#pragma unroll
        for (int j = 0; j < 8; ++j) {
            u32x4 pw; pw.x = cvt_pk_bf16(sc[j][0][0], sc[j][0][1]); pw.y = cvt_pk_bf16(sc[j][0][2], sc[j][0][3]); pw.z = cvt_pk_bf16(sc[j][1][0], sc[j][1][1]); pw.w = cvt_pk_bf16(sc[j][1][2], sc[j][1][3]);
            const bf16x8 pb = __builtin_bit_cast(bf16x8, pw);
#pragma unroll
            for (int db = 0; db < 4; ++db) { const int d = 16 * db + lq; const LAS unsigned char* vp = lds + AT_VTS + d * AT_VPITCH + ((jr0 + j) * 64 + kcb + 4 * g) * 2;
                const u32x2 lo = *(const LAS u32x2*)vp, hi = *(const LAS u32x2*)(vp + 32);
                u32x4 aw; aw.x = lo.x; aw.y = lo.y; aw.z = hi.x; aw.w = hi.y;
                o[db] = __builtin_amdgcn_mfma_f32_16x16x32_bf16(__builtin_bit_cast(bf16x8, aw), pb, o[db], 0, 0, 0); }
        }
        { u32x4 pw; pw.x = cvt_pk_bf16(sm[0], sm[1]); pw.y = cvt_pk_bf16(sm[2], sm[3]); pw.z = 0u; pw.w = 0u; const bf16x8 pb = __builtin_bit_cast(bf16x8, pw);
#pragma unroll
          for (int db = 0; db < 4; ++db) { const int d = 16 * db + lq; const u32x2 lo = *(const LAS u32x2*)(lds + AT_VTM + d * 32 + 8 * g);
              u32x4 aw; aw.x = lo.x; aw.y = lo.y; aw.z = 0u; aw.w = 0u;
              o[db] = __builtin_amdgcn_mfma_f32_16x16x32_bf16(__builtin_bit_cast(bf16x8, aw), pb, o[db], 0, 0, 0); } }
        const float inv = 1.0f / sum;
#pragma unroll
        for (int db = 0; db < 4; ++db) { u32x2 ow; ow.x = cvt_pk_bf16(o[db][0] * inv, o[db][1] * inv); ow.y = cvt_pk_bf16(o[db][2] * inv, o[db][3] * inv);
            *(u32x2*)(O + qrow * D + 64 * h + 16 * db + 4 * g) = ow; }
    }
}


#define XB_TMO      128
#define XB_XCNT(j)  (256  + 64 * (j))
#define XB_XSUB(j)  (1280 + 64 * (j))
#define XB_XGEN(j)  (2304 + 64 * (j))
#define XB_TOP      3328
#define XB_TOPGEN   3392
#define XCD_BAR_WORDS 3456
#define XB_SPIN_CAP (1u << 22)
__device__ __forceinline__ unsigned xb_ld(unsigned* p)              { return __hip_atomic_load(p, __ATOMIC_RELAXED, __HIP_MEMORY_SCOPE_AGENT); }
__device__ __forceinline__ unsigned xb_add(unsigned* p, unsigned v) { return __hip_atomic_fetch_add(p, v, __ATOMIC_RELAXED, __HIP_MEMORY_SCOPE_AGENT); }
__device__ __forceinline__ unsigned xb_xcc_id() { return (unsigned)__builtin_amdgcn_s_getreg((3 << 11) | 20) & 0xFu; }
#define XB_SPIN(cond, bar) do { unsigned _sp = 0; while (cond) { __builtin_amdgcn_s_sleep(1); \
    if ((++_sp & 255u) == 0u) { if (xb_ld(&(bar)[XB_TMO])) break; if (_sp > XB_SPIN_CAP) { atomicAdd(&(bar)[XB_TMO], 1u); break; } } } } while (0)
struct XcdBarrier { unsigned* bar; unsigned x; volatile LAS unsigned* st; };
__device__ __forceinline__ XcdBarrier xcd_barrier_post(unsigned* bar, volatile LAS unsigned* st) {
    XcdBarrier b; b.bar = bar; b.x = xb_xcc_id(); b.st = st;
    if (threadIdx.x == 0) st[2] = xb_add(&bar[XB_XCNT(b.x)], 1u);
    return b;
}
__device__ __forceinline__ void xcd_barrier_complete(unsigned* bar, unsigned x, unsigned& nloc, unsigned& nx) {
    const unsigned G = gridDim.x * gridDim.y * gridDim.z;
    unsigned sum, cnt, mine, sp = 0u;
    for (;;) {
        sum = 0u; cnt = 0u; mine = 0u;
#pragma unroll
        for (unsigned j = 0; j < 16; ++j) { const unsigned c = xb_ld(&bar[XB_XCNT(j)]); sum += c; cnt += (c > 0u) ? 1u : 0u; mine = (j == x) ? c : mine; }
        if (sum == G) break;
        __builtin_amdgcn_s_sleep(1);
        if ((++sp & 255u) == 0u) { if (xb_ld(&bar[XB_TMO])) break; if (sp > XB_SPIN_CAP) { atomicAdd(&bar[XB_TMO], 1u); break; } }
    }
    nloc = mine > 0u ? mine : 1u; nx = cnt > 0u ? cnt : 1u;
}
__device__ __forceinline__ void xcd_barrier(const XcdBarrier& b) {
    asm volatile("s_waitcnt vmcnt(0)" ::: "memory");
    __syncthreads();
    if (threadIdx.x == 0) {
        unsigned* bar = b.bar;
        __builtin_amdgcn_s_waitcnt(0);
        unsigned nloc = b.st[0], nx = b.st[1];
        if (nloc == 0u) { xcd_barrier_complete(bar, b.x, nloc, nx); b.st[0] = nloc; b.st[1] = nx; }
        const unsigned old = xb_add(&bar[XB_XSUB(b.x)], 1u);
        const unsigned gen = old / nloc;
        if (old + 1u == (gen + 1u) * nloc) {
            __builtin_amdgcn_fence(__ATOMIC_RELEASE, "agent");
            asm volatile("s_waitcnt vmcnt(0)" ::: "memory");
            const unsigned og = xb_add(&bar[XB_TOP], 1u);
            const unsigned tg = og / nx;
            if (og + 1u == (tg + 1u) * nx) xb_add(&bar[XB_TOPGEN], 1u);
            else XB_SPIN(xb_ld(&bar[XB_TOPGEN]) == tg, bar);
            __builtin_amdgcn_fence(__ATOMIC_ACQUIRE, "agent");
            xb_add(&bar[XB_XGEN(b.x)], 1u);
            asm volatile("s_waitcnt vmcnt(0)" ::: "memory");
        } else {
            XB_SPIN(xb_ld(&bar[XB_XGEN(b.x)]) == gen, bar);
            __builtin_amdgcn_fence(__ATOMIC_ACQUIRE, "agent");
            asm volatile("s_waitcnt vmcnt(0)" ::: "memory");
        }
    }
    __syncthreads();
}
__device__ __forceinline__ int moe_prep(const Ctx& C, const int* texp) {
    LAS int* t = (LAS int*)(C.lds + pg8::TEXP_OFF); const int tid = fresh_tid();
    const int a = texp[tid], b = texp[tid + 512];
    t[tid] = a; t[tid + 512] = b;
    __syncthreads();
    return __builtin_amdgcn_readfirstlane(t[1023]);
}
constexpr size_t CT_BAR = 131072;
constexpr int LDS_BARST = LDS_BYTES - 64;

constexpr int N_PHASES = 20;
__global__ void __launch_bounds__(NTHREADS, 2) hybrid_fwd(Params P) {
    extern __shared__ __attribute__((aligned(16))) unsigned char smem[];
    cg::grid_group grid = cg::this_grid();
    Ctx C; C.lds = (LAS unsigned char*)smem; C.G = gridDim.x; C.bid = blockIdx.x;
    C.ws = P.ws; C.in = P.in; C.out = P.out;
    unsigned char* ws = P.ws;
    const int lo = P.ph_lo, hi = P.ph_hi;
#ifndef PH_MASK
#define PH_MASK 0xFFFFFFFFu
#endif
#define IN(k) (((PH_MASK >> (k)) & 1u) && lo <= (k) && (k) < hi)
#ifndef REPEAT_MASK
#define REPEAT_MASK 0u
#endif
#define REPS(k) ((((unsigned)REPEAT_MASK >> (k)) & 1u) ? 2 : 1)
#ifndef N_CG_SYNCS
#define N_CG_SYNCS 1
#endif
#define SEAM(k) do { if (IN(k) && IN((k) + 1)) { if ((k) < N_CG_SYNCS) grid.sync(); else xcd_barrier(bar); } } while (0)
    if (threadIdx.x < 16) ((LAS unsigned*)(smem + LDS_BARST))[threadIdx.x] = 0u;
    __syncthreads();
    const XcdBarrier bar = xcd_barrier_post((unsigned*)(ws + WS_CTL + CT_BAR), (volatile LAS unsigned*)(smem + LDS_BARST));
    C.gc = C.bid;
    #define PH_BODY_0 phase_convert(C);
    if (IN(0)) { PH_BODY_0 } if (REPS(0) > 1 && IN(0)) { xcd_barrier(bar); PH_BODY_0 }
    SEAM(0);
    if (IN(0) && IN(1)) {
        unsigned* barw = (unsigned*)(ws + WS_CTL + CT_BAR); bool eq = (C.G % 8) == 0;
#pragma unroll
        for (int j = 0; j < 16; ++j) { const unsigned cj = xb_ld(&barw[XB_XCNT(j)]); eq = eq && (cj == (j < 8 ? (unsigned)(C.G / 8) : 0u)); }
        const unsigned rank = ((volatile LAS unsigned*)(smem + LDS_BARST))[2];
        if (eq) C.gc = (int)(rank * 8u + bar.x);
    }
    #define PH_BODY_1 { DenseSched S{(unsigned)WS_HB, (unsigned)WS_WIN, 1024, 1024, 128, 8, C.G, C.gc}; EpiWin E{(bf16_t*)(ws + WS_XR), (bf16_t*)(ws + WS_GY)}; \
        pg8::gemm_phase<false>(C.lds, ws, 1024, 1024, 1024, S, E); mini_win(C); }
    if (IN(1)) { PH_BODY_1 } if (REPS(1) > 1 && IN(1)) { xcd_barrier(bar); PH_BODY_1 }
    SEAM(1);
    #define PH_BODY_2 phase_conv(C);
    if (IN(2)) { PH_BODY_2 } if (REPS(2) > 1 && IN(2)) { xcd_barrier(bar); PH_BODY_2 }
    SEAM(2);
    #define PH_BODY_3 { GateSched S{(unsigned)WS_XC, (unsigned)WS_GATE, 128, C.G, C.gc}; \
        EpiGate E{(const bf16_t*)(ws + WS_XC), (bf16_t*)(ws + WS_LA), (bf16_t*)(ws + WS_BB), P.in[I_BA], P.in[I_BX], (const float*)(ws + WS_CTL + CT_SPL)}; \
        pg8::gemm_phase<false>(C.lds, ws, 256, 1024, 256, S, E); mini_gate(C); }
    if (IN(3)) { PH_BODY_3 } if (REPS(3) > 1 && IN(3)) { xcd_barrier(bar); PH_BODY_3 }
    SEAM(3);
    #define PH_BODY_4 phase_scan(C);
    if (IN(4)) { PH_BODY_4 } if (REPS(4) > 1 && IN(4)) { xcd_barrier(bar); PH_BODY_4 }
    SEAM(4);
    #define PH_BODY_5 { DenseSched S{(unsigned)WS_G, (unsigned)WS_LOUT, 1024, 1024, 128, 4, C.G, C.gc}; EpiRes<true> E{(bf16_t*)(ws + WS_PRE), P.in[I_X], P.in[I_META], nullptr, NTOK}; \
        pg8::gemm_phase<false>(C.lds, ws, 1024, 1024, 1024, S, E); mini_lout(C); }
    if (IN(5)) { PH_BODY_5 } if (REPS(5) > 1 && IN(5)) { xcd_barrier(bar); PH_BODY_5 }
    SEAM(5);
    #define PH_BODY_6 phase_lnr(C, 0, NTOK);
    if (IN(6)) { PH_BODY_6 } if (REPS(6) > 1 && IN(6)) { xcd_barrier(bar); PH_BODY_6 }
    SEAM(6);
    #define PH_BODY_7 phase_pos(C, 0, NTOK);
    if (IN(7)) { PH_BODY_7 } if (REPS(7) > 1 && IN(7)) { xcd_barrier(bar); PH_BODY_7 }
    SEAM(7);
    #define PH_BODY_8 { const int nM = moe_prep(C, (const int*)(ws + WS_CTL + CT_TEXP)); \
        MoeSched S{(unsigned)WS_XS, (unsigned)WS_WGU, (const LAS int*)(C.lds + pg8::TEXP_OFF), 2048u * 1024u, nM, 8, C.G, C.gc}; EpiGlu E{(unsigned char*)(ws + WS_ACT), (unsigned)WS_BIAS}; \
        pg8::gemm_phase<true>(C.lds, ws, 512, 512, 512, S, E); }
    if (IN(8)) { PH_BODY_8 } if (REPS(8) > 1 && IN(8)) { xcd_barrier(bar); PH_BODY_8 }
#ifdef PROBE_NULL8
    if (IN(8)) { xcd_barrier(bar); { const int nM = moe_prep(C, (const int*)(ws + WS_CTL + CT_TEXP));
        MoeSched S{(unsigned)WS_XS, (unsigned)WS_WGU, (const LAS int*)(C.lds + pg8::TEXP_OFF), 2048u * 1024u, nM, 8, C.G, C.gc}; EpiNull E{};
        pg8::gemm_phase<true>(C.lds, ws, 512, 512, 512, S, E); } }
#endif
    SEAM(8);
    #define PH_BODY_9 { const int nM = moe_prep(C, (const int*)(ws + WS_CTL + CT_TEXP)); \
        MoeSched S{(unsigned)WS_ACT, (unsigned)WS_WD, (const LAS int*)(C.lds + pg8::TEXP_OFF), 1024u * 1024u, nM, 4, C.G, C.gc}; EpiDown E{(bf16_t*)(ws + WS_YS), (unsigned)WS_BD}; \
        pg8::gemm_phase<true>(C.lds, ws, 512, 512, 512, S, E); }
    if (IN(9)) { PH_BODY_9 } if (REPS(9) > 1 && IN(9)) { xcd_barrier(bar); PH_BODY_9 }
    SEAM(9);
    #define PH_BODY_10 phase_combine(C, 0, NTOK, false);
    if (IN(10)) { PH_BODY_10 } if (REPS(10) > 1 && IN(10)) { xcd_barrier(bar); PH_BODY_10 }
    SEAM(10);
    #define PH_BODY_11 { QkvSched S{(unsigned)WS_HB, (unsigned)WS_QKV, 128, C.G, C.gc}; EpiQkv E{(bf16_t*)(ws + WS_Q), (bf16_t*)(ws + WS_K), (bf16_t*)(ws + WS_VT)}; \
        pg8::gemm_phase<false>(C.lds, ws, 1024, 1024, 1024, S, E); mini_kv(C); }
    if (IN(11)) { PH_BODY_11 } if (REPS(11) > 1 && IN(11)) { xcd_barrier(bar); PH_BODY_11 }
    SEAM(11);
    #define PH_BODY_12 phase_attn(C);
    if (IN(12)) { PH_BODY_12 } if (REPS(12) > 1 && IN(12)) { xcd_barrier(bar); PH_BODY_12 }
    SEAM(12);
    #define PH_BODY_13 { DenseSched S{(unsigned)WS_O, (unsigned)WS_NOUT, 1024, 1024, 128, 4, C.G, C.gc}; EpiRes<false> E{(bf16_t*)(ws + WS_PRE), nullptr, nullptr, (const bf16_t*)(ws + WS_HB), NGRID}; \
        pg8::gemm_phase<false>(C.lds, ws, 1024, 1024, 1024, S, E); }
    if (IN(13)) { PH_BODY_13 } if (REPS(13) > 1 && IN(13)) { xcd_barrier(bar); PH_BODY_13 }
    SEAM(13);
    #define PH_BODY_14 phase_lnr(C, 1, NGRID);
    if (IN(14)) { PH_BODY_14 } if (REPS(14) > 1 && IN(14)) { xcd_barrier(bar); PH_BODY_14 }
    SEAM(14);
    #define PH_BODY_15 phase_pos(C, 1, NGRID);
    if (IN(15)) { PH_BODY_15 } if (REPS(15) > 1 && IN(15)) { xcd_barrier(bar); PH_BODY_15 }
    SEAM(15);
    #define PH_BODY_16 { const int nM = moe_prep(C, (const int*)(ws + WS_CTL + CT_TEXP) + 1024); \
        MoeSched S{(unsigned)WS_XS, (unsigned)(WS_WGU + (size_t)32 * 2048 * 1024), (const LAS int*)(C.lds + pg8::TEXP_OFF), 2048u * 1024u, nM, 8, C.G, C.gc}; EpiGlu E{(unsigned char*)(ws + WS_ACT), (unsigned)(WS_BIAS + 32 * 2048 * 4)}; \
        pg8::gemm_phase<true>(C.lds, ws, 512, 512, 512, S, E); }
    if (IN(16)) { PH_BODY_16 } if (REPS(16) > 1 && IN(16)) { xcd_barrier(bar); PH_BODY_16 }
    SEAM(16);
    #define PH_BODY_17 { const int nM = moe_prep(C, (const int*)(ws + WS_CTL + CT_TEXP) + 1024); \
        MoeSched S{(unsigned)WS_ACT, (unsigned)(WS_WD + (size_t)32 * 1024 * 1024), (const LAS int*)(C.lds + pg8::TEXP_OFF), 1024u * 1024u, nM, 4, C.G, C.gc}; EpiDown E{(bf16_t*)(ws + WS_YS), (unsigned)(WS_BD + 32 * 1024 * 4)}; \
        pg8::gemm_phase<true>(C.lds, ws, 512, 512, 512, S, E); }
    if (IN(17)) { PH_BODY_17 } if (REPS(17) > 1 && IN(17)) { xcd_barrier(bar); PH_BODY_17 }
    SEAM(17);
    #define PH_BODY_18 phase_combine(C, 1, NGRID, true);
    if (IN(18)) { PH_BODY_18 } if (REPS(18) > 1 && IN(18)) { xcd_barrier(bar); PH_BODY_18 }
#undef IN
#undef SEAM
}

#ifndef MK_PER_PHASE
#define MK_PER_PHASE 0
#endif
extern "C" void kernel_launch(void* const* d_in, const int* in_sizes, int n_in, void* d_out, int out_size, void* d_ws, size_t ws_size, hipStream_t stream) {
    static int grid = 0;
    if (grid == 0) {
        if (n_in != 25 || ws_size < WS_END || out_size != NGRID * D) { fprintf(stderr, "kernel_launch: unexpected problem (n_in %d, ws %zu, out %d)\n", n_in, ws_size, out_size); grid = -1; return; }
        int dev = 0, cus = 0, per_cu = 0;
        if (hipGetDevice(&dev) != hipSuccess || hipDeviceGetAttribute(&cus, hipDeviceAttributeMultiprocessorCount, dev) != hipSuccess) { grid = -1; return; }
        if (hipFuncSetAttribute((const void*)hybrid_fwd, hipFuncAttributeMaxDynamicSharedMemorySize, LDS_BYTES) != hipSuccess) { fprintf(stderr, "kernel_launch: hipFuncSetAttribute failed\n"); grid = -1; return; }
        if (hipOccupancyMaxActiveBlocksPerMultiprocessor(&per_cu, (const void*)hybrid_fwd, NTHREADS, LDS_BYTES) != hipSuccess || per_cu < 1) { fprintf(stderr, "kernel_launch: occupancy query failed (%d)\n", per_cu); grid = -1; return; }
        grid = cus * 1;
        if (grid > 256) grid = 256;
    }
    if (grid < 0) return;
    if (hipMemsetAsync((char*)d_ws + WS_CTL + CT_BAR, 0, 16384, stream) != hipSuccess) { fprintf(stderr, "kernel_launch: memset failed\n"); return; }
    Params p{};
    for (int i = 0; i < 25; ++i) p.in[i] = (const float*)d_in[i];
    p.out = (float*)d_out; p.ws = (unsigned char*)d_ws;
#if MK_PER_PHASE
    for (int ph = 0; ph < 19; ++ph) { p.ph_lo = ph; p.ph_hi = ph + 1; void* args[] = {&p};
        hipError_t e = hipLaunchCooperativeKernel((void*)hybrid_fwd, dim3(grid), dim3(NTHREADS), args, LDS_BYTES, stream);
        if (e != hipSuccess) { fprintf(stderr, "launch phase %d failed: %s\n", ph, hipGetErrorString(e)); break; } }
#else
    p.ph_lo = 0; p.ph_hi = 19; void* args[] = {&p};
    hipError_t e = hipLaunchCooperativeKernel((void*)hybrid_fwd, dim3(grid), dim3(NTHREADS), args, LDS_BYTES, stream);
    if (e != hipSuccess) fprintf(stderr, "cooperative launch failed: %s (grid %d)\n", hipGetErrorString(e), grid);
#endif
}
```

```cpp
#include <hip/hip_runtime.h>
#include <hip/hip_cooperative_groups.h>
#include <cstdio>
#include <cstdint>
namespace cg = cooperative_groups;

#define LAS __attribute__((address_space(3)))
typedef unsigned short bf16_t;
typedef short bf16x8 __attribute__((ext_vector_type(8)));
typedef float f32x4 __attribute__((ext_vector_type(4)));
typedef float f32x2 __attribute__((ext_vector_type(2)));
typedef unsigned u32x4 __attribute__((ext_vector_type(4)));
typedef unsigned u32x2 __attribute__((ext_vector_type(2)));

constexpr int NB = 8, SEQ = 4096, D = 1024, NMETA = 16, LSEQ = SEQ + NMETA;
constexpr int NGRID = NB * SEQ;
constexpr int NTOK = NGRID + NB * NMETA;
constexpr int MPAD = 33024;
constexpr int NEXP = 32, TOPK = 4;
constexpr int PMAX = 139776;
constexpr int MTMAX = PMAX / 256;
constexpr float DN_ALPHA = 1.41421356237f;
constexpr float LN_EPS = 1e-5f;
constexpr int NTHREADS = 512, NWAVES = 8;

constexpr size_t MiB = 1u << 20;
constexpr size_t ACT_BYTES = (size_t)MPAD * D * 2;
constexpr size_t WS_CTL   = 0;
constexpr size_t WS_WIN   = 4 * MiB;
constexpr size_t WS_GATE  = WS_WIN + 4 * MiB;
constexpr size_t WS_LOUT  = WS_GATE + 2 * MiB;
constexpr size_t WS_QKV   = WS_LOUT + 2 * MiB;
constexpr size_t WS_NOUT  = WS_QKV + 6 * MiB;
constexpr size_t WS_WGU   = WS_NOUT + 2 * MiB;
constexpr size_t WS_WD    = WS_WGU + 128 * MiB;
constexpr size_t WS_HB    = WS_WD + 64 * MiB;
constexpr size_t WS_HB8   = WS_HB + 65 * MiB;
constexpr size_t WS_PRE   = WS_HB8 + 33 * MiB;
constexpr size_t WS_H     = WS_PRE + 129 * MiB;
constexpr size_t WS_SCR   = WS_H + 129 * MiB;
constexpr size_t WS_XR = WS_SCR, WS_XC = WS_XR + 65 * MiB, WS_GY = WS_XC + 65 * MiB, WS_LA = WS_GY + 65 * MiB, WS_BB = WS_LA + 130 * MiB, WS_HF = WS_BB + 130 * MiB, WS_G = WS_HF + 65 * MiB;
constexpr size_t WS_SCR_END0 = WS_G + 65 * MiB;
constexpr size_t WS_XS = WS_SCR, WS_ACT = WS_XS + 137 * MiB, WS_YS = WS_ACT + 137 * MiB;
constexpr size_t WS_SCR_END1 = WS_YS + 274 * MiB;
constexpr size_t WS_Q = WS_SCR, WS_K = WS_Q + 65 * MiB, WS_VT = WS_K + 65 * MiB, WS_O = WS_VT + 65 * MiB;
constexpr size_t WS_BIAS = (WS_SCR_END0 > WS_SCR_END1 ? WS_SCR_END0 : WS_SCR_END1);
constexpr size_t WS_BD = WS_BIAS + 2 * 32 * 2048 * 4;
constexpr size_t WS_END = WS_BIAS + 1 * MiB;
static_assert(ACT_BYTES <= 65 * MiB && (size_t)PMAX * D * 2 <= 274 * MiB && (size_t)PMAX * D <= 137 * MiB && (size_t)MPAD * D <= 33 * MiB && (size_t)MPAD * D * 4 <= 129 * MiB, "ws map");
static_assert(WS_END <= (size_t)2040 * MiB, "ws map must fit 4x the largest input tensor");
constexpr size_t CT_BC      = 4096;
constexpr size_t CT_TEXP    = CT_BC + 2 * 256 * 32 * 4;
constexpr size_t CT_SPL     = CT_TEXP + 2 * 1024 * 4;
constexpr size_t CT_EID     = 256 * 1024;
constexpr size_t CT_GATEV   = CT_EID + 2 * (size_t)NTOK * 4 * 4;
constexpr size_t CT_POS     = CT_GATEV + 2 * (size_t)NTOK * 4 * 4;
static_assert(CT_POS + 2 * (size_t)NTOK * 4 * 4 <= 4 * MiB, "ctl map");

constexpr int LDS_BYTES = 155648;

__device__ __forceinline__ unsigned f2bf(float f) { unsigned u = __builtin_bit_cast(unsigned, f); return (u + 0x7fffu + ((u >> 16) & 1u)) >> 16; }
__device__ __forceinline__ unsigned cvt_pk_bf16(float lo, float hi);
__device__ __forceinline__ unsigned pk2(float lo, float hi) { return cvt_pk_bf16(lo, hi); }
typedef __bf16 bf16x2_t __attribute__((ext_vector_type(2)));
__device__ __forceinline__ unsigned cvt_pk_bf16(float lo, float hi) { const f32x2 v = {lo, hi}; return __builtin_bit_cast(unsigned, __builtin_convertvector(v, bf16x2_t)); }
__device__ __forceinline__ unsigned pk4_fp8(float a, float b, float c, float d) { int w = __builtin_amdgcn_cvt_pk_fp8_f32(a, b, 0, false); w = __builtin_amdgcn_cvt_pk_fp8_f32(c, d, w, true); return (unsigned)w; }
__device__ __forceinline__ float bflo(unsigned w) { return __builtin_bit_cast(float, w << 16); }
__device__ __forceinline__ float bfhi(unsigned w) { return __builtin_bit_cast(float, w & 0xffff0000u); }
__device__ __forceinline__ float fast_exp2(float x) { return __builtin_amdgcn_exp2f(x); }
__device__ __forceinline__ float fast_rcp(float x) { return __builtin_amdgcn_rcpf(x); }
__device__ __forceinline__ float sigmoidf_(float x) { return fast_rcp(1.0f + fast_exp2(-1.44269504089f * x)); }
__device__ __forceinline__ float wave_sum(float v) {
#pragma unroll
    for (int o = 1; o < 64; o <<= 1) v += __shfl_xor(v, o);
    return v;
}
template <int CTRL> __device__ __forceinline__ float dpp_movf(float v) { return __builtin_bit_cast(float, __builtin_amdgcn_update_dpp(0, __builtin_bit_cast(int, v), CTRL, 0xf, 0xf, true)); }
__device__ __forceinline__ float readlane_f(float v, int l) { return __builtin_bit_cast(float, __builtin_amdgcn_readlane(__builtin_bit_cast(int, v), l)); }
__device__ __forceinline__ float wave_sum_dpp(float v) {
    v += dpp_movf<0xB1>(v);
    v += dpp_movf<0x4E>(v);
    v += dpp_movf<0x141>(v);
    v += dpp_movf<0x140>(v);
    return (readlane_f(v, 0) + readlane_f(v, 16)) + (readlane_f(v, 32) + readlane_f(v, 48));
}
__device__ __forceinline__ int seqrow(int b, int s) { return s < NMETA ? NGRID + NMETA * b + s : SEQ * b + (s - NMETA); }

struct Params {
    const float* in[25];
    float* out;
    unsigned char* ws;
    int ph_lo, ph_hi;
};
struct Ctx {
    LAS unsigned char* lds;
    int G, bid, gc;
    unsigned char* ws;
    const float* const* in;
    float* out;
};
__device__ __forceinline__ int fresh_tid() { int t = threadIdx.x; asm volatile("" : "+v"(t)); return t; }
__device__ __forceinline__ unsigned char* fresh_ws(unsigned char* p) { asm volatile("" : "+s"(p)); return p; }
#define PHASE_IDS unsigned char* const wsl = fresh_ws(C.ws); (void)wsl; const int tid = fresh_tid(); const int lane = tid & 63; const int wave = __builtin_amdgcn_readfirstlane(tid >> 6); (void)lane; (void)wave;
enum { I_X = 0, I_META, I_WIN, I_CONVW, I_CONVB, I_WA, I_BA, I_WX, I_BX, I_LAM, I_LOUT, I_WQKV, I_RPB, I_MBIAS, I_NOUT, I_LNMG, I_LNMB, I_RW, I_RB, I_WGU, I_BGU, I_WD, I_BD, I_LNFG, I_LNFB };

namespace pg8 {
constexpr int BM = 256, BK = 64, HALF = 128, HTB = HALF * BK * 2, STAGE_BYTES = 8 * HTB, NXCD = 8, WGM = 8;
constexpr int SIDE_OFF = STAGE_BYTES, TEXP_OFF = STAGE_BYTES + 2048;
__device__ __forceinline__ int lds_byte(int r, int c) { const int st = (r >> 4) * 2 + (c >> 5), rr = r & 15, cc = c & 31, ob = rr * 64 + cc * 2; return st * 1024 + (ob ^ (((ob >> 9) & 1) << 5)); }
__device__ __forceinline__ void stage_rc(int b, int& R, int& C) { const int st = b / 1024, sb = b % 1024, swz = sb ^ (((sb >> 9) & 1) << 5); R = (st >> 1) * 16 + swz / 64; C = (st & 1) * 32 + (swz % 64) / 2; }
__device__ __forceinline__ int perm32(int rho) { const int n = rho >> 4, i = rho & 15; return 8 * (i >> 2) + 4 * n + (i & 3); }

typedef int v8i __attribute__((ext_vector_type(8)));
typedef int v4i __attribute__((ext_vector_type(4)));
__device__ __forceinline__ v8i cat8(bf16x8 a, bf16x8 b) { const v4i x = __builtin_bit_cast(v4i, a), y = __builtin_bit_cast(v4i, b); return __builtin_shufflevector(x, y, 0, 1, 2, 3, 4, 5, 6, 7); }
struct Unit { unsigned ao, bo; int pm, pn, aux; };

__device__ __forceinline__ void tile_of(int L, int nM, int nN, int& pm, int& pn) {
    const int nwg = nM * nN; int wgid = L;
    { const int q = nwg / NXCD, r = nwg % NXCD, xcd = wgid % NXCD, off = wgid / NXCD; wgid = (xcd < r ? xcd * (q + 1) : r * (q + 1) + (xcd - r) * q) + off; }
    const int nig = WGM * nN, gid = wgid / nig, fm = gid * WGM, gsz = (nM - fm) < WGM ? (nM - fm) : WGM;
    pm = fm + ((wgid % nig) % gsz); pn = (wgid % nig) / gsz;
}

template <bool F8, class Epi, class Sched>
__device__ __forceinline__ void gemm_phase(LAS unsigned char* lds, const unsigned char* wsbase, const int K, const int lda, const int ldb, const Sched& S, const Epi& E) {
    const __amdgpu_buffer_rsrc_t rsrc = __builtin_amdgcn_make_buffer_rsrc((void*)wsbase, 0, 0xFFFFFFFF, 0x00020000);
    const int tid = fresh_tid(), wid = __builtin_amdgcn_readfirstlane(tid >> 6), lane = tid & 63, wr = wid >> 2, wc = wid & 3;
    const int nt = K / BK;
    int voffA, voffB;
    { int R, C; stage_rc(tid * 16, R, C); const int Rb = Epi::PERM ? ((R & ~31) + perm32(R & 31)) : R; voffA = (R * lda + C) * 2; voffB = (Rb * ldb + C) * 2; }
    const unsigned kstep = (unsigned)(BK * 2);
    const unsigned hstepA = (unsigned)HALF * lda * 2, hstepB = (unsigned)HALF * ldb * 2;
    const unsigned ldsw = (unsigned)wid * 1024u;
    const int aoff = lds_byte(wr * 64 + (lane & 15), (lane >> 4) * 8), boff = lds_byte(wc * 32 + (lane & 15), (lane >> 4) * 8);
#define PG8_SA(b, h) (((b) * 2 + (h)) * HTB)
#define PG8_SB(b, h) ((4 + (b) * 2 + (h)) * HTB)
#define PG8_STAGE(bufoff, gbase, voff) do { _Pragma("unroll") for (int _i = 0; _i < 2; ++_i) \
        __builtin_amdgcn_raw_ptr_buffer_load_lds(rsrc, (LAS void*)(lds + (bufoff) + ldsl + _i * 8192), 16, voff, __builtin_amdgcn_readfirstlane((int)((gbase) + (unsigned)_i * (hstep##voff >> 1))), 0, 0); } while (0)
#define hstepvoffA hstepA
#define hstepvoffB hstepB
#define PG8_LDA(dst, b, h) do { _Pragma("unroll") for (int m = 0; m < 4; ++m) _Pragma("unroll") for (int k = 0; k < 2; ++k) dst[m][k] = *(const LAS bf16x8*)(lds + PG8_SA(b, h) + aoff + m * 2048 + k * 1024); } while (0)
#define PG8_LDB(dst, b, h) do { _Pragma("unroll") for (int n = 0; n < 2; ++n) _Pragma("unroll") for (int k = 0; k < 2; ++k) dst[n][k] = *(const LAS bf16x8*)(lds + PG8_SB(b, h) + boff + n * 2048 + k * 1024); } while (0)
#define PG8_MMA(ai, bj, At, Bt) do { __builtin_amdgcn_s_setprio(1); _Pragma("unroll") for (int m = 0; m < 4; ++m) _Pragma("unroll") for (int n = 0; n < 2; ++n) { \
        if constexpr (F8) { acc[ai][bj][m][n] = __builtin_amdgcn_mfma_scale_f32_16x16x128_f8f6f4(cat8(Bt[n][0], Bt[n][1]), cat8(At[m][0], At[m][1]), acc[ai][bj][m][n], 0, 0, 0, Epi::SCALES, 1, Epi::SCALES); } \
        else { _Pragma("unroll") for (int k = 0; k < 2; ++k) acc[ai][bj][m][n] = __builtin_amdgcn_mfma_f32_16x16x32_bf16(Bt[n][k], At[m][k], acc[ai][bj][m][n], 0, 0, 0); } } \
        __builtin_amdgcn_s_setprio(0); } while (0)
#define PG8_WAIT_V(n) asm volatile("s_waitcnt vmcnt(" #n ")" ::: "memory")
#define PG8_WAIT_L(n) asm volatile("s_waitcnt lgkmcnt(" #n ")" ::: "memory")
#define PG8_BAR __builtin_amdgcn_s_barrier()
#define PG8_SCHED __builtin_amdgcn_sched_barrier(0)
    Unit cur, nxt; int ui = 0;
    if (!S.next(0, cur)) return;
    f32x4 acc[2][2][4][2];
#pragma unroll
    for (int a = 0; a < 2; ++a)
#pragma unroll
        for (int b = 0; b < 2; ++b)
#pragma unroll
            for (int m = 0; m < 4; ++m)
#pragma unroll
                for (int n = 0; n < 2; ++n) acc[a][b][m][n] = (f32x4){0.f, 0.f, 0.f, 0.f};
    bf16x8 At[4][2], B0[2][2], B1[2][2];
    unsigned cA = cur.ao, cB = cur.bo;
    unsigned ldsl = ldsw; asm volatile("" : "+s"(ldsl));
#define PG8_SIDE(unit, par) do { if constexpr (Epi::SIDE) { if (wid == 0) __builtin_amdgcn_raw_ptr_buffer_load_lds(rsrc, (LAS void*)(lds + SIDE_OFF + (par) * 1024), 16, lane * 16, (int)E.side_off(unit), 0, 0); } } while (0)
    PG8_SIDE(cur, 0);
    PG8_STAGE(PG8_SB(0, 0), cB, voffB); PG8_STAGE(PG8_SB(0, 1), cB + hstepB, voffB); PG8_STAGE(PG8_SA(0, 0), cA, voffA); PG8_STAGE(PG8_SA(0, 1), cA + hstepA, voffA);
    if (wr == 1) PG8_BAR;
    PG8_WAIT_V(2); PG8_BAR;
    PG8_STAGE(PG8_SB(1, 0), cB + kstep, voffB); PG8_STAGE(PG8_SA(1, 0), cA + kstep, voffA); PG8_STAGE(PG8_SB(1, 1), cB + hstepB + kstep, voffB);
    PG8_WAIT_V(6); PG8_BAR;
    for (;;) {
        const bool has_next = S.next(ui + 1, nxt);
        const unsigned nA = has_next ? nxt.ao : cA, nB = has_next ? nxt.bo : cB;
#pragma unroll 1
        for (int t = 0; t < nt; t += 2) {
            const bool last = (t == nt - 2);
            ldsl = ldsw; asm volatile("" : "+s"(ldsl));
            const unsigned a1 = cA + (unsigned)(t + 1) * kstep;
            const unsigned a2 = last ? nA : cA + (unsigned)(t + 2) * kstep, b2 = last ? nB : cB + (unsigned)(t + 2) * kstep;
            const unsigned a3 = a2 + kstep, b3 = b2 + kstep;
            PG8_LDB(B0, 0, 0); PG8_LDB(B1, 0, 1); PG8_SCHED; PG8_LDA(At, 0, 0); PG8_STAGE(PG8_SA(1, 1), a1 + hstepA, voffA);
            PG8_WAIT_V(8); PG8_WAIT_L(0); PG8_BAR; PG8_MMA(0, 0, At, B0); PG8_MMA(0, 1, At, B1); PG8_BAR; PG8_SCHED;
            PG8_LDA(At, 0, 1); PG8_STAGE(PG8_SB(0, 0), b2, voffB); PG8_STAGE(PG8_SB(0, 1), b2 + hstepB, voffB); PG8_STAGE(PG8_SA(0, 0), a2, voffA);
            PG8_WAIT_V(8); PG8_WAIT_L(0); PG8_BAR; PG8_MMA(1, 0, At, B0); PG8_MMA(1, 1, At, B1); PG8_BAR; PG8_SCHED;
            PG8_LDB(B0, 1, 0); PG8_LDB(B1, 1, 1); PG8_SCHED; PG8_LDA(At, 1, 0); PG8_STAGE(PG8_SA(0, 1), a2 + hstepA, voffA);
            PG8_WAIT_V(8); PG8_WAIT_L(0); PG8_BAR; PG8_MMA(0, 0, At, B0); PG8_MMA(0, 1, At, B1); PG8_BAR; PG8_SCHED;
            PG8_LDA(At, 1, 1); PG8_STAGE(PG8_SB(1, 0), b3, voffB); PG8_STAGE(PG8_SB(1, 1), b3 + hstepB, voffB); PG8_STAGE(PG8_SA(1, 0), a3, voffA);
            PG8_WAIT_V(8); PG8_WAIT_L(0); PG8_BAR; PG8_MMA(1, 0, At, B0); PG8_MMA(1, 1, At, B1); PG8_BAR; PG8_SCHED;
        }
        if (wr == 0) PG8_BAR;
        { const int l2 = fresh_tid() & 63; E(acc, cur, wr, wc, l2 & 15, l2 >> 4, (const LAS float*)(lds + SIDE_OFF + (ui & 1) * 1024)); }
        if (!has_next) break;
#pragma unroll
        for (int a = 0; a < 2; ++a)
#pragma unroll
            for (int b = 0; b < 2; ++b)
#pragma unroll
                for (int m = 0; m < 4; ++m)
#pragma unroll
                    for (int n = 0; n < 2; ++n) acc[a][b][m][n] = (f32x4){0.f, 0.f, 0.f, 0.f};
        cur = nxt; cA = nA; cB = nB; ++ui;
        if (wr == 1) PG8_BAR;
        PG8_SIDE(cur, ui & 1);
    }
    PG8_WAIT_V(0);
    PG8_BAR;
#undef PG8_SA
#undef PG8_SB
#undef PG8_STAGE
#undef PG8_SIDE
#undef hstepvoffA
#undef hstepvoffB
#undef PG8_LDA
#undef PG8_LDB
#undef PG8_MMA
#undef PG8_WAIT_V
#undef PG8_WAIT_L
#undef PG8_BAR
#undef PG8_SCHED
}
}

using pg8::Unit;

struct DenseSched {
    unsigned A, Bt; int lda, ldb, nM, nN, G, c;
    __device__ __forceinline__ bool next(int i, Unit& u) const {
        const int L = i * G + c; if (L >= nM * nN) return false;
        pg8::tile_of(L, nM, nN, u.pm, u.pn); u.aux = 0;
        u.ao = A + (unsigned)u.pm * 256 * lda * 2; u.bo = Bt + (unsigned)u.pn * 256 * ldb * 2; return true;
    }
};
struct GateSched {
    unsigned XC, GT; int nM, G, c;
    __device__ __forceinline__ bool next(int i, Unit& u) const {
        const int per = nM * 4; const int L = i * G + c; if (L >= 4 * per) return false;
        const int nb = L / per; pg8::tile_of(L - nb * per, nM, 4, u.pm, u.pn); u.aux = nb;
        u.ao = XC + ((unsigned)u.pm * 256 * 1024 + 256 * nb) * 2; u.bo = GT + ((unsigned)nb * 1024 + 256 * u.pn) * 256 * 2; return true;
    }
};
struct QkvSched {
    unsigned HB, WT; int nM, G, c;
    __device__ __forceinline__ bool next(int i, Unit& u) const {
        const int n0 = nM * 8, n1 = 4 * nM; const int L = i * G + c; if (L >= n0 + n1) return false;
        if (L < n0) { pg8::tile_of(L, nM, 8, u.pm, u.pn); u.aux = 0; u.ao = HB + (unsigned)u.pm * 256 * 1024 * 2; u.bo = WT + (unsigned)u.pn * 256 * 1024 * 2; }
        else { pg8::tile_of(L - n0, 4, nM, u.pm, u.pn); u.aux = 1; u.ao = WT + (unsigned)(2048 + u.pm * 256) * 1024 * 2; u.bo = HB + (unsigned)u.pn * 256 * 1024 * 2; }
        return true;
    }
};
struct MoeSched {
    unsigned A, W; const LAS int* texp; unsigned wstride; int nM, nN, G, c;
    __device__ __forceinline__ bool next(int i, Unit& u) const {
        const int L = i * G + c; if (L >= nM * nN) return false;
        pg8::tile_of(L, nM, nN, u.pm, u.pn);
        const int e = __builtin_amdgcn_readfirstlane(texp[u.pm]); u.aux = e;
        u.ao = A + (unsigned)u.pm * 256 * 1024; u.bo = W + (unsigned)e * wstride + (unsigned)u.pn * 256 * 1024; return true;
    }
};

#define EPI_ARGS const f32x4 (&acc)[2][2][4][2], const Unit& u, int wr, int wc, int fr, int fq, const LAS float* side
struct EpiWin {
    static constexpr bool PERM = true, SIDE = false;
    bf16_t* XR; bf16_t* GY;
    __device__ __forceinline__ void operator()(EPI_ARGS) const {
        const int row0 = u.pm * 256 + wr * 64 + fr;
        if (u.pn < 4) {
            const int col0 = u.pn * 256 + wc * 32 + 8 * fq;
#pragma unroll
            for (int ai = 0; ai < 2; ++ai)
#pragma unroll
                for (int m = 0; m < 4; ++m) { bf16_t* rowp = XR + (size_t)(row0 + ai * 128 + m * 16) * D + col0;
#pragma unroll
                    for (int bj = 0; bj < 2; ++bj) { const f32x4 v0 = acc[ai][bj][m][0], v1 = acc[ai][bj][m][1];
                        u32x4 w; w.x = cvt_pk_bf16(v0[0], v0[1]); w.y = cvt_pk_bf16(v0[2], v0[3]); w.z = cvt_pk_bf16(v1[0], v1[1]); w.w = cvt_pk_bf16(v1[2], v1[3]);
                        *(u32x4*)(rowp + bj * 128) = w; } }
        } else {
#pragma unroll
            for (int ai = 0; ai < 2; ++ai)
#pragma unroll
                for (int m = 0; m < 4; ++m) { const int row = row0 + ai * 128 + m * 16;
#pragma unroll
                    for (int bj = 0; bj < 2; ++bj) { const int g = (u.pn - 4) * 8 + bj * 4 + wc;
                        float o[8];
#pragma unroll
                        for (int n = 0; n < 2; ++n)
#pragma unroll
                            for (int j = 0; j < 4; ++j) { const float v = acc[ai][bj][m][n][j]; const float z = 1.5957691216f * (v + 0.044715f * v * v * v); o[n * 4 + j] = v * sigmoidf_(z); }
                        u32x4 w; w.x = cvt_pk_bf16(o[0], o[1]); w.y = cvt_pk_bf16(o[2], o[3]); w.z = cvt_pk_bf16(o[4], o[5]); w.w = cvt_pk_bf16(o[6], o[7]);
                        *(u32x4*)(GY + ((size_t)g * MPAD + row) * 32 + 8 * fq) = w; } }
        }
    }
};
struct EpiGate {
    static constexpr bool PERM = true, SIDE = false;
    const bf16_t* XC; bf16_t* LA; bf16_t* BB; const float* ba; const float* bx; const float* spl;
    __device__ __forceinline__ void operator()(EPI_ARGS) const {
        const int nb = u.aux, dir = u.pn >> 1, half = u.pn & 1;
        const int ch0 = 256 * nb + 128 * half + 32 * wc + 8 * fq, g = ch0 >> 5;
        const int row0 = u.pm * 256 + wr * 64 + fr;
        float cba[8], cbx[8], csp[8];
        { const f32x4 t0 = *(const f32x4*)(ba + dir * 1024 + ch0), t1 = *(const f32x4*)(ba + dir * 1024 + ch0 + 4);
          const f32x4 s0 = *(const f32x4*)(bx + dir * 1024 + ch0), s1 = *(const f32x4*)(bx + dir * 1024 + ch0 + 4);
          const f32x4 p0 = *(const f32x4*)(spl + dir * 1024 + ch0), p1 = *(const f32x4*)(spl + dir * 1024 + ch0 + 4);
#pragma unroll
          for (int j = 0; j < 4; ++j) { cba[j] = t0[j]; cba[4 + j] = t1[j]; cbx[j] = s0[j]; cbx[4 + j] = s1[j]; csp[j] = p0[j]; csp[4 + j] = p1[j]; } }
        u32x4 xnext = *(const u32x4*)(XC + (size_t)(row0 < NTOK ? row0 : 0) * D + ch0);
#pragma unroll
        for (int ai = 0; ai < 2; ++ai)
#pragma unroll
            for (int m = 0; m < 4; ++m) { const int row = row0 + ai * 128 + m * 16;
                const u32x4 xw = xnext;
                { const int it = ai * 4 + m + 1, rn = row0 + (it >> 2) * 128 + (it & 3) * 16; if (it < 8) xnext = *(const u32x4*)(XC + (size_t)(rn < NTOK ? rn : 0) * D + ch0); }
                if (row < NTOK) {
                    float xc[8] = {bflo(xw.x), bfhi(xw.x), bflo(xw.y), bfhi(xw.y), bflo(xw.z), bfhi(xw.z), bflo(xw.w), bfhi(xw.w)};
                    const bool start = dir == 0 ? (row >= NGRID && ((row - NGRID) & 15) == 0) : (row < NGRID && (row & (SEQ - 1)) == SEQ - 1);
                    float la[8], bb[8];
#pragma unroll
                    for (int n = 0; n < 2; ++n)
#pragma unroll
                        for (int j = 0; j < 4; ++j) { const int i = n * 4 + j;
                            const float ga = sigmoidf_(acc[ai][0][m][n][j] + cba[i]), gx = sigmoidf_(acc[ai][1][m][n][j] + cbx[i]);
                            const float l2 = -csp[i] * ga;
                            const float a2 = fast_exp2(2.0f * l2);
                            const float mult = start ? 1.0f : __builtin_sqrtf(fmaxf(1.0f - a2, 0.0f));
                            la[i] = l2; bb[i] = mult * gx * xc[i]; }
                    u32x4 w; w.x = cvt_pk_bf16(la[0], la[1]); w.y = cvt_pk_bf16(la[2], la[3]); w.z = cvt_pk_bf16(la[4], la[5]); w.w = cvt_pk_bf16(la[6], la[7]);
                    const size_t o = (((size_t)dir * 32 + g) * MPAD + row) * 32 + 8 * fq;
                    *(u32x4*)(LA + o) = w;
                    w.x = cvt_pk_bf16(bb[0], bb[1]); w.y = cvt_pk_bf16(bb[2], bb[3]); w.z = cvt_pk_bf16(bb[4], bb[5]); w.w = cvt_pk_bf16(bb[6], bb[7]);
                    *(u32x4*)(BB + o) = w;
                } }
    }
};
template <bool LAYER0> struct EpiRes {
    static constexpr bool PERM = true, SIDE = false;
    bf16_t* PRE; const float* x; const float* meta; const bf16_t* HB; int nrows;
    __device__ __forceinline__ void operator()(EPI_ARGS) const {
        const int row0 = u.pm * 256 + wr * 64 + fr, col0 = u.pn * 256 + wc * 32 + 8 * fq;
#pragma unroll
        for (int ai = 0; ai < 2; ++ai)
#pragma unroll
            for (int m = 0; m < 4; ++m) { const int row = row0 + ai * 128 + m * 16;
                if (row < nrows) {
#pragma unroll
                    for (int bj = 0; bj < 2; ++bj) { const int c = col0 + bj * 128; float r[8];
                        if (LAYER0) { const float* rp = (row < NGRID ? x + (size_t)row * D : meta + (size_t)((row - NGRID) & 15) * D) + c; const f32x4 r0 = *(const f32x4*)rp, r1 = *(const f32x4*)(rp + 4);
                            r[0] = r0[0]; r[1] = r0[1]; r[2] = r0[2]; r[3] = r0[3]; r[4] = r1[0]; r[5] = r1[1]; r[6] = r1[2]; r[7] = r1[3]; }
                        else { const u32x4 rw = *(const u32x4*)(HB + (size_t)row * D + c); r[0] = bflo(rw.x); r[1] = bfhi(rw.x); r[2] = bflo(rw.y); r[3] = bfhi(rw.y); r[4] = bflo(rw.z); r[5] = bfhi(rw.z); r[6] = bflo(rw.w); r[7] = bfhi(rw.w); }
                        const f32x4 a0 = acc[ai][bj][m][0], a1 = acc[ai][bj][m][1];
                        u32x4 w; w.x = cvt_pk_bf16(r[0] * DN_ALPHA + a0[0], r[1] * DN_ALPHA + a0[1]); w.y = cvt_pk_bf16(r[2] * DN_ALPHA + a0[2], r[3] * DN_ALPHA + a0[3]);
                        w.z = cvt_pk_bf16(r[4] * DN_ALPHA + a1[0], r[5] * DN_ALPHA + a1[1]); w.w = cvt_pk_bf16(r[6] * DN_ALPHA + a1[2], r[7] * DN_ALPHA + a1[3]);
                        *(u32x4*)(PRE + (size_t)row * D + c) = w; }
                }
                asm volatile("" ::: "memory"); }
    }
};
struct EpiGlu {
    static constexpr bool PERM = true, SIDE = true; static constexpr int SCALES = 0x7F79;
    unsigned char* ACT; unsigned bias_off;
    __device__ __forceinline__ unsigned side_off(const Unit& u) const { return bias_off + (unsigned)((u.aux * 8 + u.pn) * 1024); }
    __device__ __forceinline__ void operator()(EPI_ARGS) const {
        const int f0 = 128 * u.pn + 32 * wc + 8 * fq;
        float bg[8], bl[8];
        { const LAS float* p = side + 32 * wc + 8 * fq; const f32x4 a0 = *(const LAS f32x4*)p, a1 = *(const LAS f32x4*)(p + 4), c0 = *(const LAS f32x4*)(p + 128), c1 = *(const LAS f32x4*)(p + 132);
#pragma unroll
          for (int j = 0; j < 4; ++j) { bg[j] = a0[j]; bg[4 + j] = a1[j]; bl[j] = c0[j]; bl[4 + j] = c1[j]; } }
        const int row0 = u.pm * 256 + wr * 64 + fr;
#pragma unroll
        for (int ai = 0; ai < 2; ++ai)
#pragma unroll
            for (int m = 0; m < 4; ++m) { const int row = row0 + ai * 128 + m * 16; float o[8];
#pragma unroll
                for (int n = 0; n < 2; ++n)
#pragma unroll
                    for (int j = 0; j < 4; ++j) { const int i = n * 4 + j;
                        const float glu = fminf(acc[ai][0][m][n][j] + bg[i], 7.0f);
                        const float lin = fminf(fmaxf(acc[ai][1][m][n][j] + bl[i], -7.0f), 7.0f);
                        o[i] = glu * sigmoidf_(1.702f * glu) * (lin + 1.0f); }
                u32x2 w; w.x = pk4_fp8(o[0] * 4.0f, o[1] * 4.0f, o[2] * 4.0f, o[3] * 4.0f); w.y = pk4_fp8(o[4] * 4.0f, o[5] * 4.0f, o[6] * 4.0f, o[7] * 4.0f);
                *(u32x2*)(ACT + (size_t)row * D + f0) = w; }
    }
};
struct EpiNull {
    static constexpr bool PERM = true, SIDE = false; static constexpr int SCALES = 0x7F79;
    __device__ __forceinline__ void operator()(EPI_ARGS) const {
#pragma unroll
        for (int ai = 0; ai < 2; ++ai)
#pragma unroll
            for (int bj = 0; bj < 2; ++bj)
#pragma unroll
                for (int m = 0; m < 4; ++m)
#pragma unroll
                    for (int n = 0; n < 2; ++n) asm volatile("" :: "v"(acc[ai][bj][m][n]));
    }
};
struct EpiDown {
    static constexpr bool PERM = true, SIDE = true; static constexpr int SCALES = 0x7D79;
    bf16_t* YS; unsigned bias_off;
    __device__ __forceinline__ unsigned side_off(const Unit& u) const { return bias_off + (unsigned)((u.aux * 4 + u.pn) * 1024); }
    __device__ __forceinline__ void operator()(EPI_ARGS) const {
        const int row0 = u.pm * 256 + wr * 64 + fr, col0 = u.pn * 256 + wc * 32 + 8 * fq;
        f32x4 bv[2][2];
#pragma unroll
        for (int bj = 0; bj < 2; ++bj)
#pragma unroll
            for (int n = 0; n < 2; ++n) bv[bj][n] = *(const LAS f32x4*)(side + wc * 32 + 8 * fq + bj * 128 + 4 * n);
#pragma unroll
        for (int ai = 0; ai < 2; ++ai)
#pragma unroll
            for (int m = 0; m < 4; ++m) { bf16_t* rowp = YS + (size_t)(row0 + ai * 128 + m * 16) * D + col0;
#pragma unroll
                for (int bj = 0; bj < 2; ++bj) { const f32x4 v0 = acc[ai][bj][m][0] + bv[bj][0], v1 = acc[ai][bj][m][1] + bv[bj][1];
                    u32x4 w; w.x = cvt_pk_bf16(v0[0], v0[1]); w.y = cvt_pk_bf16(v0[2], v0[3]); w.z = cvt_pk_bf16(v1[0], v1[1]); w.w = cvt_pk_bf16(v1[2], v1[3]);
                    *(u32x4*)(rowp + bj * 128) = w; } }
    }
};
struct EpiQkv {
    static constexpr bool PERM = true, SIDE = false;
    bf16_t* Q; bf16_t* Kx; bf16_t* VT;
    __device__ __forceinline__ void operator()(EPI_ARGS) const {
        const int row0 = u.pm * 256 + wr * 64 + fr; bf16_t* base; int ldc, colt; float sc = 1.0f;
        if (u.aux == 0) { ldc = D; if (u.pn < 4) { base = Q; colt = u.pn * 256; sc = 0.125f * 1.44269504089f; } else { base = Kx; colt = (u.pn - 4) * 256; } }
        else { base = VT; ldc = MPAD; colt = u.pn * 256; }
        const int col0 = colt + wc * 32 + 8 * fq;
#pragma unroll
        for (int ai = 0; ai < 2; ++ai)
#pragma unroll
            for (int m = 0; m < 4; ++m) { bf16_t* rowp = base + (size_t)(row0 + ai * 128 + m * 16) * ldc + col0;
#pragma unroll
                for (int bj = 0; bj < 2; ++bj) { const f32x4 v0 = acc[ai][bj][m][0] * sc, v1 = acc[ai][bj][m][1] * sc;
                    u32x4 w; w.x = cvt_pk_bf16(v0[0], v0[1]); w.y = cvt_pk_bf16(v0[2], v0[3]); w.z = cvt_pk_bf16(v1[0], v1[1]); w.w = cvt_pk_bf16(v1[2], v1[3]);
                    *(u32x4*)(rowp + bj * 128) = w; } }
    }
};

__device__ __forceinline__ void tr_item(const float* W, int ld, int kb, int n0, bf16_t* dst0, int K, LAS float* scr, int lane) {
    const int r = lane >> 4, q = lane & 15;
    f32x4 v[16];
#pragma unroll
    for (int i = 0; i < 16; ++i) v[i] = *(const f32x4*)(W + (size_t)(64 * kb + 4 * i + r) * ld + n0 + 4 * q);
#pragma unroll
    for (int i = 0; i < 16; ++i) { LAS float* s = scr + (4 * i + r) * 65 + 4 * q; s[0] = v[i][0]; s[1] = v[i][1]; s[2] = v[i][2]; s[3] = v[i][3]; }
    asm volatile("s_waitcnt lgkmcnt(0)" ::: "memory");
    const int c = lane & 7, nn = lane >> 3;
#pragma unroll
    for (int j = 0; j < 8; ++j) { const int n = nn + 8 * j; const LAS float* s = scr + (8 * c) * 65 + n;
        u32x4 o; o.x = pk2(s[0], s[65]); o.y = pk2(s[2 * 65], s[3 * 65]); o.z = pk2(s[4 * 65], s[5 * 65]); o.w = pk2(s[6 * 65], s[7 * 65]);
        *(u32x4*)(dst0 + (size_t)n * K + 64 * kb + 8 * c) = o; }
    asm volatile("s_waitcnt lgkmcnt(0)" ::: "memory");
}
__device__ __forceinline__ void tr_item8(const float* W, int ld, int kb, int n0, unsigned char* dst0, int K, LAS float* scr, int lane) {
    const int r = lane >> 4, q = lane & 15;
    f32x4 v[16];
#pragma unroll
    for (int i = 0; i < 16; ++i) v[i] = *(const f32x4*)(W + (size_t)(64 * kb + 4 * i + r) * ld + n0 + 4 * q);
#pragma unroll
    for (int i = 0; i < 16; ++i) { LAS float* s = scr + (4 * i + r) * 65 + 4 * q; s[0] = v[i][0]; s[1] = v[i][1]; s[2] = v[i][2]; s[3] = v[i][3]; }
    asm volatile("s_waitcnt lgkmcnt(0)" ::: "memory");
    const int c = lane & 7, nn = lane >> 3;
#pragma unroll
    for (int j = 0; j < 8; ++j) { const int n = nn + 8 * j; const LAS float* s = scr + (8 * c) * 65 + n;
        u32x2 o; o.x = pk4_fp8(s[0] * 64.0f, s[65] * 64.0f, s[2 * 65] * 64.0f, s[3 * 65] * 64.0f); o.y = pk4_fp8(s[4 * 65] * 64.0f, s[5 * 65] * 64.0f, s[6 * 65] * 64.0f, s[7 * 65] * 64.0f);
        *(u32x2*)(dst0 + (size_t)n * K + 64 * kb + 8 * c) = o; }
    asm volatile("s_waitcnt lgkmcnt(0)" ::: "memory");
}
__device__ __forceinline__ void phase_convert(const Ctx& C) {
    PHASE_IDS
    LAS float* scr = (LAS float*)(C.lds + wave * 16640);
    const int gw = C.bid * NWAVES + wave, NGW = C.G * NWAVES;
    constexpr int I0 = 512, I1 = 256, I2 = 256, I3 = 768, I4 = 256, I5 = 32768, I6 = 16384, NIT = I0 + I1 + I2 + I3 + I4 + I5 + I6;
    for (int it = gw; it < NIT; it += NGW) {
        int r = it;
        if (r < I0) { const int nbk = r & 31, kb = r >> 5; tr_item(C.in[I_WIN], 2048, kb, 64 * nbk, (bf16_t*)(wsl + WS_WIN) + (size_t)(64 * nbk) * 1024, 1024, scr, lane); continue; } r -= I0;
        if (r < I1) { const int job = r >> 3, sub = r & 7, nbk = sub & 1, kb = sub >> 1;
            const int half = job & 1, which = (job >> 1) & 1, nb = (job >> 2) & 3, dir = job >> 4;
            const float* src = C.in[which ? I_WX : I_WA] + (size_t)(dir * 4 + nb) * 65536;
            bf16_t* dst = (bf16_t*)(wsl + WS_GATE) + ((size_t)nb * 1024 + 256 * (2 * dir + half) + 128 * which + 64 * nbk) * 256;
            tr_item(src, 256, kb, 128 * half + 64 * nbk, dst, 256, scr, lane); continue; } r -= I1;
        if (r < I2) { const int nbk = r & 15, kb = r >> 4; tr_item(C.in[I_LOUT], 1024, kb, 64 * nbk, (bf16_t*)(wsl + WS_LOUT) + (size_t)(64 * nbk) * 1024, 1024, scr, lane); continue; } r -= I2;
        if (r < I3) { const int nbk = r % 48, kb = r / 48; tr_item(C.in[I_WQKV], 3072, kb, 64 * nbk, (bf16_t*)(wsl + WS_QKV) + (size_t)(64 * nbk) * 1024, 1024, scr, lane); continue; } r -= I3;
        if (r < I4) { const int nbk = r & 15, kb = r >> 4; tr_item(C.in[I_NOUT], 1024, kb, 64 * nbk, (bf16_t*)(wsl + WS_NOUT) + (size_t)(64 * nbk) * 1024, 1024, scr, lane); continue; } r -= I4;
        if (r < I5) { const int mat = r >> 9, sub = r & 511, nbk = sub & 31, kb = sub >> 5; const int n0 = 64 * nbk, bj = n0 >> 10, f0 = n0 & 1023, pn = f0 >> 7, jj = f0 & 127;
            tr_item8(C.in[I_WGU] + (size_t)mat * 1024 * 2048, 2048, kb, n0, (unsigned char*)(wsl + WS_WGU) + ((size_t)mat * 2048 + 256 * pn + 128 * bj + jj) * 1024, 1024, scr, lane); continue; } r -= I5;
        { const int mat = r >> 8, sub = r & 255, nbk = sub & 15, kb = sub >> 4;
            tr_item8(C.in[I_WD] + (size_t)mat * 1024 * 1024, 1024, kb, 64 * nbk, (unsigned char*)(wsl + WS_WD) + ((size_t)mat * 1024 + 64 * nbk) * 1024, 1024, scr, lane); }
    }
    const int gt = C.bid * NTHREADS + tid, NGT = C.G * NTHREADS;
    for (int i = gt; i < 2048; i += NGT) ((float*)(wsl + WS_CTL + CT_SPL))[i] = 8.0f * 1.44269504089f * log1pf(expf(-C.in[I_LAM][i]));
    for (int i = gt; i < 2 * 32 * 2048; i += NGT) { const int le = i >> 11, r = i & 2047, pn = r >> 8, bj = (r >> 7) & 1, ii = r & 127;
        ((float*)(wsl + WS_BIAS))[i] = C.in[I_BGU][(size_t)le * 2048 + bj * 1024 + 128 * pn + ii]; }
    for (int i = gt; i < 2 * 32 * 1024; i += NGT) ((float*)(wsl + WS_BD))[i] = C.in[I_BD][i];
    for (int i = gt; i < NTOK * 128; i += NGT) { const int row = i >> 7, oc = i & 127;
        const float* src = (row < NGRID ? C.in[I_X] + (size_t)row * D : C.in[I_META] + (size_t)((row - NGRID) & 15) * D) + 8 * oc;
        const f32x4 a = *(const f32x4*)src, b = *(const f32x4*)(src + 4);
        u32x4 w; w.x = pk2(a[0], a[1]); w.y = pk2(a[2], a[3]); w.z = pk2(b[0], b[1]); w.w = pk2(b[2], b[3]);
        *(u32x4*)((bf16_t*)(wsl + WS_HB) + (size_t)row * D + 8 * oc) = w; }
}

__device__ __forceinline__ void phase_conv(const Ctx& C) {
    PHASE_IDS
    const bf16_t* XR = (const bf16_t*)(wsl + WS_XR); bf16_t* XC = (bf16_t*)(wsl + WS_XC);
    const float* cw = C.in[I_CONVW]; const float* cb = C.in[I_CONVB];
    const int gt = C.bid * NTHREADS + tid, NGT = C.G * NTHREADS;
    for (int i = gt; i < NTOK * 128; i += NGT) { const int row = i >> 7, ch = 8 * (i & 127);
        int b, s; if (row < NGRID) { b = row >> 12; s = NMETA + (row & (SEQ - 1)); } else { b = (row - NGRID) >> 4; s = (row - NGRID) & 15; }
        float a[8];
        { const f32x4 t0 = *(const f32x4*)(cb + ch), t1 = *(const f32x4*)(cb + ch + 4);
#pragma unroll
          for (int j = 0; j < 4; ++j) { a[j] = t0[j]; a[4 + j] = t1[j]; } }
#pragma unroll
        for (int j = 0; j < 4; ++j) { const int sj = s - 2 + j;
            if (sj >= 0 && sj < LSEQ) { const u32x4 xw = *(const u32x4*)(XR + (size_t)seqrow(b, sj) * D + ch);
                const f32x4 w0 = *(const f32x4*)(cw + j * 1024 + ch), w1 = *(const f32x4*)(cw + j * 1024 + ch + 4);
                a[0] += w0[0] * bflo(xw.x); a[1] += w0[1] * bfhi(xw.x); a[2] += w0[2] * bflo(xw.y); a[3] += w0[3] * bfhi(xw.y);
                a[4] += w1[0] * bflo(xw.z); a[5] += w1[1] * bfhi(xw.z); a[6] += w1[2] * bflo(xw.w); a[7] += w1[3] * bfhi(xw.w); } }
        u32x4 w; w.x = pk2(a[0], a[1]); w.y = pk2(a[2], a[3]); w.z = pk2(a[4], a[5]); w.w = pk2(a[6], a[7]);
        *(u32x4*)(XC + (size_t)row * D + ch) = w; }
}

template <int N> __device__ __forceinline__ float dpp_shr(float oldv, float v) {
    return __builtin_bit_cast(float, __builtin_amdgcn_update_dpp(__builtin_bit_cast(int, oldv), __builtin_bit_cast(int, v), 0x110 + N, 0xf, 0xf, false));
}
__device__ __forceinline__ void scan_group(float (&a)[8], float (&b)[8]) {
#pragma unroll
    for (int c = 0; c < 8; ++c) {
        { const float ap = dpp_shr<1>(1.0f, a[c]), bp = dpp_shr<1>(0.0f, b[c]); b[c] = a[c] * bp + b[c]; a[c] = a[c] * ap; }
        { const float ap = dpp_shr<2>(1.0f, a[c]), bp = dpp_shr<2>(0.0f, b[c]); b[c] = a[c] * bp + b[c]; a[c] = a[c] * ap; }
        { const float ap = dpp_shr<4>(1.0f, a[c]), bp = dpp_shr<4>(0.0f, b[c]); b[c] = a[c] * bp + b[c]; a[c] = a[c] * ap; }
        { const float ap = dpp_shr<8>(1.0f, a[c]), bp = dpp_shr<8>(0.0f, b[c]); b[c] = a[c] * bp + b[c]; a[c] = a[c] * ap; }
    }
}
__device__ __forceinline__ void unpack8(const u32x4 w, float (&o)[8]) { o[0] = bflo(w.x); o[1] = bfhi(w.x); o[2] = bflo(w.y); o[3] = bfhi(w.y); o[4] = bflo(w.z); o[5] = bfhi(w.z); o[6] = bflo(w.w); o[7] = bfhi(w.w); }
__device__ __forceinline__ void phase_scan(const Ctx& C) {
    PHASE_IDS
    const bf16_t* LA = (const bf16_t*)(wsl + WS_LA); const bf16_t* BB = (const bf16_t*)(wsl + WS_BB); const bf16_t* GY = (const bf16_t*)(wsl + WS_GY);
    bf16_t* HF = (bf16_t*)(wsl + WS_HF); bf16_t* Gout = (bf16_t*)(wsl + WS_G);
    LAS float* agg = (LAS float*)C.lds;
    const int w = wave, oct = lane >> 4, p = lane & 15;
    for (int item = C.bid; item < NB * 32; item += C.G) {
        const int b = item >> 5, g = item & 31;
        for (int dir = 0; dir < 2; ++dir) {
            const bf16_t* la = LA + (((size_t)dir * 32 + g) * MPAD) * 32 + 8 * oct;
            const bf16_t* bb = BB + (((size_t)dir * 32 + g) * MPAD) * 32 + 8 * oct;
            float S[8];
#pragma unroll
            for (int c = 0; c < 8; ++c) S[c] = 0.f;
            {
                const int u = p, s = dir ? LSEQ - 1 - u : u, row = seqrow(b, s);
                float a[8], x[8]; unpack8(*(const u32x4*)(la + (size_t)row * 32), a); unpack8(*(const u32x4*)(bb + (size_t)row * 32), x);
#pragma unroll
                for (int c = 0; c < 8; ++c) a[c] = fast_exp2(a[c]);
                scan_group(a, x);
                if (w == 0) {
                    if (dir == 0) { u32x4 o; o.x = pk2(x[0], x[1]); o.y = pk2(x[2], x[3]); o.z = pk2(x[4], x[5]); o.w = pk2(x[6], x[7]); *(u32x4*)(HF + ((size_t)g * MPAD + row) * 32 + 8 * oct) = o; }
                    else { float hf[8], gy[8]; unpack8(*(const u32x4*)(HF + ((size_t)g * MPAD + row) * 32 + 8 * oct), hf); unpack8(*(const u32x4*)(GY + ((size_t)g * MPAD + row) * 32 + 8 * oct), gy);
                        u32x4 o; o.x = pk2((hf[0] + x[0]) * gy[0], (hf[1] + x[1]) * gy[1]); o.y = pk2((hf[2] + x[2]) * gy[2], (hf[3] + x[3]) * gy[3]);
                        o.z = pk2((hf[4] + x[4]) * gy[4], (hf[5] + x[5]) * gy[5]); o.w = pk2((hf[6] + x[6]) * gy[6], (hf[7] + x[7]) * gy[7]);
                        *(u32x4*)(Gout + (size_t)row * D + 32 * g + 8 * oct) = o; }
                }
#pragma unroll
                for (int c = 0; c < 8; ++c) S[c] = __shfl(x[c], (lane & 48) | 15);
            }
            for (int r = 0; r < 8; ++r) {
                float Pw[4][8], Hw[4][8]; int rows[4];
                float Aw[8], Hc[8];
#pragma unroll
                for (int c = 0; c < 8; ++c) { Aw[c] = 1.f; Hc[c] = 0.f; }
                u32x4 ra[4], rb[4];
#pragma unroll
                for (int j = 0; j < 4; ++j) { const int u = 16 + 512 * r + 64 * w + 16 * j + p, s = dir ? LSEQ - 1 - u : u; rows[j] = seqrow(b, s);
                    ra[j] = *(const u32x4*)(la + (size_t)rows[j] * 32); rb[j] = *(const u32x4*)(bb + (size_t)rows[j] * 32); }
#pragma unroll
                for (int j = 0; j < 4; ++j) {
                    float a[8], x[8]; unpack8(ra[j], a); unpack8(rb[j], x);
#pragma unroll
                    for (int c = 0; c < 8; ++c) a[c] = fast_exp2(a[c]);
                    scan_group(a, x);
#pragma unroll
                    for (int c = 0; c < 8; ++c) { Hw[j][c] = a[c] * Hc[c] + x[c]; Pw[j][c] = a[c] * Aw[c]; }
#pragma unroll
                    for (int c = 0; c < 8; ++c) { Aw[c] = __shfl(Pw[j][c], (lane & 48) | 15); Hc[c] = __shfl(Hw[j][c], (lane & 48) | 15); }
                }
                LAS float* ag = agg + (r & 1) * 512;
                if (p == 0) {
#pragma unroll
                    for (int c = 0; c < 8; ++c) { ag[(w * 32 + oct * 8 + c) * 2] = Aw[c]; ag[(w * 32 + oct * 8 + c) * 2 + 1] = Hc[c]; }
                }
                __syncthreads();
                float Sin[8];
#pragma unroll
                for (int c = 0; c < 8; ++c) Sin[c] = S[c];
#pragma unroll
                for (int ww = 0; ww < 8; ++ww) {
#pragma unroll
                    for (int c = 0; c < 8; ++c) { const float A = ag[(ww * 32 + oct * 8 + c) * 2], H = ag[(ww * 32 + oct * 8 + c) * 2 + 1];
                        if (ww == w) Sin[c] = S[c];
                        S[c] = A * S[c] + H; }
                }
#pragma unroll
                for (int j = 0; j < 4; ++j) {
                    float h[8];
#pragma unroll
                    for (int c = 0; c < 8; ++c) h[c] = Pw[j][c] * Sin[c] + Hw[j][c];
                    const size_t go = ((size_t)g * MPAD + rows[j]) * 32 + 8 * oct;
                    if (dir == 0) { u32x4 o; o.x = pk2(h[0], h[1]); o.y = pk2(h[2], h[3]); o.z = pk2(h[4], h[5]); o.w = pk2(h[6], h[7]); *(u32x4*)(HF + go) = o; }
                    else { float hf[8], gy[8]; unpack8(*(const u32x4*)(HF + go), hf); unpack8(*(const u32x4*)(GY + go), gy);
                        u32x4 o; o.x = pk2((hf[0] + h[0]) * gy[0], (hf[1] + h[1]) * gy[1]); o.y = pk2((hf[2] + h[2]) * gy[2], (hf[3] + h[3]) * gy[3]);
                        o.z = pk2((hf[4] + h[4]) * gy[4], (hf[5] + h[5]) * gy[5]); o.w = pk2((hf[6] + h[6]) * gy[6], (hf[7] + h[7]) * gy[7]);
                        *(u32x4*)(Gout + (size_t)rows[j] * D + 32 * g + 8 * oct) = o; }
                }
            }
            __syncthreads();
        }
    }
}

template <int K> __device__ __forceinline__ f32x4 mini_mma(const bf16_t* W, int ldw, const bf16_t* A, int lda, int lane) {
    const bf16_t* wp = W + (size_t)(lane & 15) * ldw + 8 * (lane >> 4); const bf16_t* ap = A + (size_t)(lane & 15) * lda + 8 * (lane >> 4);
    f32x4 acc = {0.f, 0.f, 0.f, 0.f};
    constexpr int KB = K < 512 ? K : 512, NS = KB / 32;
#pragma unroll 1
    for (int k0 = 0; k0 < K; k0 += KB) { bf16x8 wf[NS], af[NS];
#pragma unroll
        for (int i = 0; i < NS; ++i) { wf[i] = *(const bf16x8*)(wp + k0 + 32 * i); af[i] = *(const bf16x8*)(ap + k0 + 32 * i); }
#pragma unroll
        for (int i = 0; i < NS; ++i) acc = __builtin_amdgcn_mfma_f32_16x16x32_bf16(wf[i], af[i], acc, 0, 0, 0); }
    return acc;
}
__device__ __forceinline__ void mini_win(const Ctx& C) {
    PHASE_IDS
    const bf16_t* HB = (const bf16_t*)(C.ws + WS_HB); const bf16_t* WT = (const bf16_t*)(C.ws + WS_WIN); bf16_t* XR = (bf16_t*)(C.ws + WS_XR); bf16_t* GY = (bf16_t*)(C.ws + WS_GY);
    const int fr = lane & 15, fq = lane >> 4;
    for (int wt = C.gc * NWAVES + wave; wt < 8 * 128; wt += C.G * NWAVES) { const int rg = wt & 7, cb = wt >> 3, row = NGRID + 16 * rg + fr, c = 16 * cb + 4 * fq;
        const f32x4 a = mini_mma<1024>(WT + (size_t)(16 * cb) * 1024, 1024, HB + (size_t)(NGRID + 16 * rg) * 1024, 1024, lane);
        if (c < 1024) { u32x2 w; w.x = cvt_pk_bf16(a[0], a[1]); w.y = cvt_pk_bf16(a[2], a[3]); *(u32x2*)(XR + (size_t)row * D + c) = w; }
        else { const int yc = c - 1024; float o[4];
#pragma unroll
            for (int j = 0; j < 4; ++j) { const float v = a[j]; const float z = 1.5957691216f * (v + 0.044715f * v * v * v); o[j] = v * sigmoidf_(z); }
            u32x2 w; w.x = cvt_pk_bf16(o[0], o[1]); w.y = cvt_pk_bf16(o[2], o[3]); *(u32x2*)(GY + ((size_t)(yc >> 5) * MPAD + row) * 32 + (yc & 31)) = w; } }
}
__device__ __forceinline__ void mini_gate(const Ctx& C) {
    PHASE_IDS
    const bf16_t* XC = (const bf16_t*)(C.ws + WS_XC); const bf16_t* GT = (const bf16_t*)(C.ws + WS_GATE); bf16_t* LA = (bf16_t*)(C.ws + WS_LA); bf16_t* BB = (bf16_t*)(C.ws + WS_BB);
    const float* ba = C.in[I_BA]; const float* bx = C.in[I_BX]; const float* spl = (const float*)(C.ws + WS_CTL + CT_SPL);
    const int fr = lane & 15, fq = lane >> 4;
    for (int wt = C.gc * NWAVES + wave; wt < 8 * 2 * 64; wt += C.G * NWAVES) { const int rg = wt & 7, dir = (wt >> 3) & 1, chg = wt >> 4, ch0 = 16 * chg, nb = ch0 >> 8, half = (ch0 >> 7) & 1, jj0 = ch0 & 127;
        const bf16_t* A = XC + (size_t)(NGRID + 16 * rg) * 1024 + 256 * nb; const bf16_t* Wa = GT + ((size_t)nb * 1024 + 256 * (2 * dir + half) + jj0) * 256;
        const f32x4 za = mini_mma<256>(Wa, 256, A, 1024, lane), zx = mini_mma<256>(Wa + 128 * 256, 256, A, 1024, lane);
        const int row = NGRID + 16 * rg + fr, ch = ch0 + 4 * fq;
        const f32x4 cba = *(const f32x4*)(ba + dir * 1024 + ch), cbx = *(const f32x4*)(bx + dir * 1024 + ch), csp = *(const f32x4*)(spl + dir * 1024 + ch);
        const u32x2 xw = *(const u32x2*)(XC + (size_t)row * D + ch); const float xc[4] = {bflo(xw.x), bfhi(xw.x), bflo(xw.y), bfhi(xw.y)};
        const bool start = dir == 0 && fr == 0;
        float la[4], bb[4];
#pragma unroll
        for (int j = 0; j < 4; ++j) { const float ga = sigmoidf_(za[j] + cba[j]), gx = sigmoidf_(zx[j] + cbx[j]); const float l2 = -csp[j] * ga; const float a2 = fast_exp2(2.0f * l2);
            const float mult = start ? 1.0f : __builtin_sqrtf(fmaxf(1.0f - a2, 0.0f)); la[j] = l2; bb[j] = mult * gx * xc[j]; }
        const size_t o = (((size_t)dir * 32 + (ch >> 5)) * MPAD + row) * 32 + (ch & 31);
        u32x2 w; w.x = cvt_pk_bf16(la[0], la[1]); w.y = cvt_pk_bf16(la[2], la[3]); *(u32x2*)(LA + o) = w;
        w.x = cvt_pk_bf16(bb[0], bb[1]); w.y = cvt_pk_bf16(bb[2], bb[3]); *(u32x2*)(BB + o) = w; }
}
__device__ __forceinline__ void mini_lout(const Ctx& C) {
    PHASE_IDS
    const bf16_t* G = (const bf16_t*)(C.ws + WS_G); const bf16_t* WT = (const bf16_t*)(C.ws + WS_LOUT); bf16_t* PRE = (bf16_t*)(C.ws + WS_PRE); const float* meta = C.in[I_META];
    const int fr = lane & 15, fq = lane >> 4;
    for (int wt = C.gc * NWAVES + wave; wt < 8 * 64; wt += C.G * NWAVES) { const int rg = wt & 7, cb = wt >> 3, row = NGRID + 16 * rg + fr, c = 16 * cb + 4 * fq;
        const f32x4 a = mini_mma<1024>(WT + (size_t)(16 * cb) * 1024, 1024, G + (size_t)(NGRID + 16 * rg) * 1024, 1024, lane);
        const f32x4 r = *(const f32x4*)(meta + (size_t)fr * D + c);
        u32x2 w; w.x = cvt_pk_bf16(r[0] * DN_ALPHA + a[0], r[1] * DN_ALPHA + a[1]); w.y = cvt_pk_bf16(r[2] * DN_ALPHA + a[2], r[3] * DN_ALPHA + a[3]); *(u32x2*)(PRE + (size_t)row * D + c) = w; }
}
__device__ __forceinline__ void mini_kv(const Ctx& C) {
    PHASE_IDS
    const bf16_t* HB = (const bf16_t*)(C.ws + WS_HB); const bf16_t* WT = (const bf16_t*)(C.ws + WS_QKV); bf16_t* Kx = (bf16_t*)(C.ws + WS_K); bf16_t* VT = (bf16_t*)(C.ws + WS_VT);
    const int fr = lane & 15, fq = lane >> 4;
    for (int wt = C.gc * NWAVES + wave; wt < 2 * 8 * 64; wt += C.G * NWAVES) { const int rg = wt & 7, cb = (wt >> 3) & 63, isv = wt >> 9;
        const bf16_t* A = HB + (size_t)(NGRID + 16 * rg) * 1024;
        if (!isv) { const f32x4 a = mini_mma<1024>(WT + (size_t)(1024 + 16 * cb) * 1024, 1024, A, 1024, lane);
            u32x2 w; w.x = cvt_pk_bf16(a[0], a[1]); w.y = cvt_pk_bf16(a[2], a[3]); *(u32x2*)(Kx + (size_t)(NGRID + 16 * rg + fr) * D + 16 * cb + 4 * fq) = w; }
        else { const f32x4 a = mini_mma<1024>(A, 1024, WT + (size_t)(2048 + 16 * cb) * 1024, 1024, lane);
            u32x2 w; w.x = cvt_pk_bf16(a[0], a[1]); w.y = cvt_pk_bf16(a[2], a[3]); *(u32x2*)(VT + (size_t)(16 * cb + fr) * MPAD + NGRID + 16 * rg + 4 * fq) = w; } }
}

constexpr int RWT_PITCH = 1028;
__device__ __forceinline__ void phase_lnr(const Ctx& C, int layer, int nrows) {
    PHASE_IDS
    const bf16_t* PRE = (const bf16_t*)(wsl + WS_PRE); bf16_t* HB = (bf16_t*)(wsl + WS_HB); unsigned char* HB8 = wsl + WS_HB8;
    const float* lg = C.in[I_LNMG] + layer * D; const float* lb = C.in[I_LNMB] + layer * D;
    const float* rw = C.in[I_RW] + (size_t)layer * D * NEXP; const float* rb = C.in[I_RB] + layer * NEXP;
    int* eid = (int*)(wsl + WS_CTL + CT_EID) + (size_t)layer * NTOK * 4; float* gatev = (float*)(wsl + WS_CTL + CT_GATEV) + (size_t)layer * NTOK * 4;
    unsigned* bc = (unsigned*)(wsl + WS_CTL + CT_BC) + ((size_t)layer * 256 + C.bid) * 32;
    LAS float* RWt = (LAS float*)C.lds; LAS unsigned* hist = (LAS unsigned*)(C.lds + 32 * RWT_PITCH * 4);
    { f32x4 wv[16];
#pragma unroll
      for (int i = 0; i < 16; ++i) wv[i] = *(const f32x4*)(rw + 4 * (tid + NTHREADS * i));
#pragma unroll
      for (int i = 0; i < 16; ++i) { const int idx4 = tid + NTHREADS * i, ch = idx4 >> 3, e4 = (idx4 & 7) * 4;
          const int c = 4 * ((ch & 511) >> 3) + 256 * (2 * (ch >> 9) + ((ch >> 2) & 1)) + (ch & 3);
          RWt[(e4 + 0) * RWT_PITCH + c] = wv[i][0]; RWt[(e4 + 1) * RWT_PITCH + c] = wv[i][1]; RWt[(e4 + 2) * RWT_PITCH + c] = wv[i][2]; RWt[(e4 + 3) * RWT_PITCH + c] = wv[i][3]; } }
    if (tid < 32) hist[tid] = 0u;
    __syncthreads();
    float gg[2][8], gb[2][8];
#pragma unroll
    for (int j = 0; j < 2; ++j) { const f32x4 a0 = *(const f32x4*)(lg + 8 * lane + 512 * j), a1 = *(const f32x4*)(lg + 8 * lane + 512 * j + 4), b0 = *(const f32x4*)(lb + 8 * lane + 512 * j), b1 = *(const f32x4*)(lb + 8 * lane + 512 * j + 4);
#pragma unroll
        for (int i = 0; i < 4; ++i) { gg[j][i] = a0[i]; gg[j][4 + i] = a1[i]; gb[j][i] = b0[i]; gb[j][4 + i] = b1[i]; } }
    const float rbias = rb[lane >> 1];
    const int gw = C.bid * NWAVES + wave, NGW = C.G * NWAVES;
    u32x4 nv[2];
    if (gw < nrows) {
#pragma unroll
        for (int j = 0; j < 2; ++j) nv[j] = *(const u32x4*)(PRE + (size_t)gw * D + 8 * lane + 512 * j); }
    for (int row = gw; row < nrows; row += NGW) {
        float v[2][8]; float s = 0.f;
#pragma unroll
        for (int j = 0; j < 2; ++j) { unpack8(nv[j], v[j]); s += ((v[j][0] + v[j][1]) + (v[j][2] + v[j][3])) + ((v[j][4] + v[j][5]) + (v[j][6] + v[j][7])); }
        if (row + NGW < nrows) {
#pragma unroll
            for (int j = 0; j < 2; ++j) nv[j] = *(const u32x4*)(PRE + (size_t)(row + NGW) * D + 8 * lane + 512 * j); }
        const float mean = wave_sum_dpp(s) * (1.0f / D); float q = 0.f;
#pragma unroll
        for (int j = 0; j < 2; ++j)
#pragma unroll
            for (int i = 0; i < 8; ++i) { v[j][i] -= mean; q += v[j][i] * v[j][i]; }
        const float rstd = 1.0f / sqrtf(wave_sum_dpp(q) * (1.0f / D) + LN_EPS);
#pragma unroll
        for (int j = 0; j < 2; ++j) {
#pragma unroll
            for (int i = 0; i < 8; ++i) v[j][i] = v[j][i] * rstd * gg[j][i] + gb[j][i];
            u32x4 w; w.x = pk2(v[j][0], v[j][1]); w.y = pk2(v[j][2], v[j][3]); w.z = pk2(v[j][4], v[j][5]); w.w = pk2(v[j][6], v[j][7]);
            *(u32x4*)(HB + (size_t)row * D + 8 * lane + 512 * j) = w;
            u32x2 w8; w8.x = pk4_fp8(v[j][0], v[j][1], v[j][2], v[j][3]); w8.y = pk4_fp8(v[j][4], v[j][5], v[j][6], v[j][7]);
            *(u32x2*)(HB8 + (size_t)row * D + 8 * lane + 512 * j) = w8; }
        float pl[32];
#pragma unroll
        for (int e0 = 0; e0 < 32; e0 += 4) {
            f32x4 wv[4][4];
#pragma unroll
            for (int ee = 0; ee < 4; ++ee)
#pragma unroll
                for (int jj = 0; jj < 4; ++jj) wv[ee][jj] = *(const LAS f32x4*)(RWt + (e0 + ee) * RWT_PITCH + 4 * lane + 256 * jj);
            __builtin_amdgcn_sched_barrier(0);
#pragma unroll
            for (int ee = 0; ee < 4; ++ee) { float a = 0.f;
#pragma unroll
                for (int jj = 0; jj < 4; ++jj) { const int j = jj >> 1, o = 4 * (jj & 1); a += (v[j][o] * wv[ee][jj][0] + v[j][o + 1] * wv[ee][jj][1]) + (v[j][o + 2] * wv[ee][jj][2] + v[j][o + 3] * wv[ee][jj][3]); }
                pl[e0 + ee] = a; }
        }
        float q16[16], q8[8], q4[4], q2[2], q1;
        { const bool hi = (lane & 32) != 0;
#pragma unroll
          for (int e = 0; e < 16; ++e) { const float mine = hi ? pl[16 + e] : pl[e], other = hi ? pl[e] : pl[16 + e]; q16[e] = mine + __shfl_xor(other, 32); } }
        { const bool hi = (lane & 16) != 0;
#pragma unroll
          for (int e = 0; e < 8; ++e) { const float mine = hi ? q16[8 + e] : q16[e], other = hi ? q16[e] : q16[8 + e]; q8[e] = mine + __shfl_xor(other, 16); } }
        { const bool hi = (lane & 8) != 0;
#pragma unroll
          for (int e = 0; e < 4; ++e) { const float mine = hi ? q8[4 + e] : q8[e], other = hi ? q8[e] : q8[4 + e]; q4[e] = mine + dpp_movf<0x128>(other); } }
        { const bool hi = (lane & 4) != 0;
#pragma unroll
          for (int e = 0; e < 2; ++e) { const float mine = hi ? q4[2 + e] : q4[e], other = hi ? q4[e] : q4[2 + e]; q2[e] = mine + __shfl_xor(other, 4); } }
        { const bool hi = (lane & 2) != 0; const float mine = hi ? q2[1] : q2[0], other = hi ? q2[0] : q2[1]; q1 = mine + dpp_movf<0x4E>(other); }
        q1 += dpp_movf<0xB1>(q1);
        float lv = q1 + rbias; lv = (lv == lv) ? lv : -3.0e38f;
        const int le = lane >> 1;
        int rank = 0;
#pragma unroll
        for (int j = 0; j < 32; ++j) { const float lj = readlane_f(lv, 2 * j); rank += (lj > lv || (lj == lv && j < le)) ? 1 : 0; }
        const unsigned long long m0 = __ballot(rank == 0);
        const float mxl = readlane_f(lv, (int)__builtin_ctzll(m0));
        const float pe = rank < 4 ? __expf(lv - mxl) : 0.f;
        const float den = wave_sum_dpp(pe) * 0.5f;
        if (rank < 4 && (lane & 1) == 0) { eid[(size_t)row * 4 + rank] = le; gatev[(size_t)row * 4 + rank] = pe / den;
            __hip_atomic_fetch_add(&hist[le], 1u, __ATOMIC_RELAXED, __HIP_MEMORY_SCOPE_WORKGROUP); }
    }
    __syncthreads();
    if (tid < 32) bc[tid] = hist[tid];
}

__device__ __forceinline__ void phase_pos(const Ctx& C, int layer, int nrows) {
    PHASE_IDS
    const unsigned* bcAll = (const unsigned*)(wsl + WS_CTL + CT_BC) + (size_t)layer * 256 * 32;
    const int* eid = (const int*)(wsl + WS_CTL + CT_EID) + (size_t)layer * NTOK * 4; int* posv = (int*)(wsl + WS_CTL + CT_POS) + (size_t)layer * NTOK * 4;
    int* texp = (int*)(wsl + WS_CTL + CT_TEXP) + layer * 1024;
    const unsigned char* HB8 = wsl + WS_HB8; unsigned char* XS = wsl + WS_XS;
    LAS unsigned* partT = (LAS unsigned*)C.lds; LAS unsigned* partP = partT + 512; LAS unsigned* tot = partP + 512; LAS unsigned* cnt = tot + 32;
    { const int e = tid & 31, part = tid >> 5; unsigned t = 0, pr = 0;
      unsigned vv[16];
#pragma unroll
      for (int i = 0; i < 16; ++i) { const int bq = part + 16 * i; vv[i] = bq < C.G ? bcAll[(size_t)bq * 32 + e] : 0u; }
#pragma unroll
      for (int i = 0; i < 16; ++i) { const int bq = part + 16 * i; t += vv[i]; if (bq < C.bid) pr += vv[i]; }
      partT[part * 32 + e] = t; partP[part * 32 + e] = pr; }
    __syncthreads();
    if (tid < 32) { unsigned t = 0, pr = 0; for (int i = 0; i < 16; ++i) { t += partT[i * 32 + tid]; pr += partP[i * 32 + tid]; } tot[tid] = t; cnt[tid] = pr; }
    __syncthreads();
    if (tid < 32) { unsigned off = 0; for (int e = 0; e < tid; ++e) off += (tot[e] + 255u) & ~255u;
        const unsigned mine = (tot[tid] + 255u) & ~255u;
        if (C.bid == 0) { for (unsigned t = off >> 8; t < ((off + mine) >> 8); ++t) texp[t] = tid; if (tid == 31) texp[1023] = (int)((off + mine) >> 8); }
        cnt[tid] += off; }
    __syncthreads();
    const int gw = C.bid * NWAVES + wave, NGW = C.G * NWAVES;
    for (int row = gw; row < nrows; row += NGW) {
        int pos = 0;
        if (lane < 4) { const int e = eid[(size_t)row * 4 + lane]; pos = (int)__hip_atomic_fetch_add(&cnt[e], 1u, __ATOMIC_RELAXED, __HIP_MEMORY_SCOPE_WORKGROUP); posv[(size_t)row * 4 + lane] = pos; }
        const u32x4 r0 = *(const u32x4*)(HB8 + (size_t)row * D + 16 * lane);
#pragma unroll
        for (int k = 0; k < 4; ++k) { const int pk = __shfl(pos, k); *(u32x4*)(XS + (size_t)pk * D + 16 * lane) = r0; }
    }
}

__device__ __forceinline__ void phase_combine(const Ctx& C, int layer, int nrows, bool final_out) {
    PHASE_IDS
    bf16_t* HB = (bf16_t*)(wsl + WS_HB); const bf16_t* YS = (const bf16_t*)(wsl + WS_YS);
    const float* lg = C.in[I_LNFG] + layer * D; const float* lb = C.in[I_LNFB] + layer * D;
    const float* gatev = (const float*)(wsl + WS_CTL + CT_GATEV) + (size_t)layer * NTOK * 4; const int* posv = (const int*)(wsl + WS_CTL + CT_POS) + (size_t)layer * NTOK * 4;
    float gg[2][8], gb[2][8];
#pragma unroll
    for (int j = 0; j < 2; ++j) { const f32x4 a0 = *(const f32x4*)(lg + 8 * lane + 512 * j), a1 = *(const f32x4*)(lg + 8 * lane + 512 * j + 4), b0 = *(const f32x4*)(lb + 8 * lane + 512 * j), b1 = *(const f32x4*)(lb + 8 * lane + 512 * j + 4);
#pragma unroll
        for (int i = 0; i < 4; ++i) { gg[j][i] = a0[i]; gg[j][4 + i] = a1[i]; gb[j][i] = b0[i]; gb[j][4 + i] = b1[i]; } }
    const int gw = C.bid * NWAVES + wave, NGW = C.G * NWAVES;
    for (int row = gw; row < nrows; row += NGW) {
        const f32x4 gk4 = *(const f32x4*)(gatev + (size_t)row * 4); const int pk0 = posv[(size_t)row * 4], pk1 = posv[(size_t)row * 4 + 1], pk2_ = posv[(size_t)row * 4 + 2], pk3 = posv[(size_t)row * 4 + 3];
        u32x4 hw[2], yw[4][2];
#pragma unroll
        for (int j = 0; j < 2; ++j) { hw[j] = *(const u32x4*)(HB + (size_t)row * D + 8 * lane + 512 * j);
            yw[0][j] = *(const u32x4*)(YS + (size_t)pk0 * D + 8 * lane + 512 * j); yw[1][j] = *(const u32x4*)(YS + (size_t)pk1 * D + 8 * lane + 512 * j);
            yw[2][j] = *(const u32x4*)(YS + (size_t)pk2_ * D + 8 * lane + 512 * j); yw[3][j] = *(const u32x4*)(YS + (size_t)pk3 * D + 8 * lane + 512 * j); }
        float v[2][8]; float s = 0.f;
#pragma unroll
        for (int j = 0; j < 2; ++j) { float h[8]; unpack8(hw[j], h);
#pragma unroll
            for (int i = 0; i < 8; ++i) v[j][i] = h[i] * DN_ALPHA;
#pragma unroll
            for (int k = 0; k < 4; ++k) { float y[8]; unpack8(yw[k][j], y);
#pragma unroll
                for (int i = 0; i < 8; ++i) v[j][i] += gk4[k] * y[i]; }
#pragma unroll
            for (int i = 0; i < 8; ++i) s += v[j][i]; }
        const float mean = wave_sum_dpp(s) * (1.0f / D); float q = 0.f;
#pragma unroll
        for (int j = 0; j < 2; ++j)
#pragma unroll
            for (int i = 0; i < 8; ++i) { v[j][i] -= mean; q += v[j][i] * v[j][i]; }
        const float rstd = 1.0f / sqrtf(wave_sum_dpp(q) * (1.0f / D) + LN_EPS);
#pragma unroll
        for (int j = 0; j < 2; ++j) {
#pragma unroll
            for (int i = 0; i < 8; ++i) v[j][i] = v[j][i] * rstd * gg[j][i] + gb[j][i];
            if (final_out) { *(f32x4*)(C.out + (size_t)row * D + 8 * lane + 512 * j) = (f32x4){v[j][0], v[j][1], v[j][2], v[j][3]}; *(f32x4*)(C.out + (size_t)row * D + 8 * lane + 512 * j + 4) = (f32x4){v[j][4], v[j][5], v[j][6], v[j][7]}; }
            else { u32x4 w; w.x = pk2(v[j][0], v[j][1]); w.y = pk2(v[j][2], v[j][3]); w.z = pk2(v[j][4], v[j][5]); w.w = pk2(v[j][6], v[j][7]); *(u32x4*)(HB + (size_t)row * D + 8 * lane + 512 * j) = w; } }
    }
}

constexpr int AT_KS = 0, AT_VTS = 73728, AT_VPITCH = 1168, AT_KM = AT_VTS + 64 * AT_VPITCH, AT_VTM = AT_KM + 2048, AT_RPB = AT_VTM + 2048, AT_MB = AT_RPB + 1920, AT_END = AT_MB + 64;
static_assert(AT_END <= LDS_BYTES, "attention LDS map");
__device__ __forceinline__ void phase_attn(const Ctx& C) {
    PHASE_IDS
    const bf16_t* Q = (const bf16_t*)(wsl + WS_Q); const bf16_t* Kx = (const bf16_t*)(wsl + WS_K); const bf16_t* VT = (const bf16_t*)(wsl + WS_VT); bf16_t* O = (bf16_t*)(wsl + WS_O);
    const float* rpb = C.in[I_RPB]; const float* mbias = C.in[I_MBIAS];
    LAS unsigned char* lds = C.lds;
    const int w = wave, lq = lane & 15, g = lane >> 4;
    int bidx[2][4];
    { const int qg_ = w & 3, c_ = 16 * qg_ + lq, cs_ = min(max(c_ - 8, 0), 48), kcb_ = qg_ == 0 ? 0 : (qg_ == 1 ? 8 : (qg_ == 2 ? 24 : 32));
#pragma unroll
      for (int blk = 0; blk < 2; ++blk)
#pragma unroll
          for (int e = 0; e < 4; ++e) { const int kc = kcb_ + 16 * blk + 4 * g + e; bidx[blk][e] = ((kc >= cs_ && kc < cs_ + 16) ? (kc - c_ + 15) : 31) * 4; } }
    const bool xmap = (C.G == 256); const int nu = xmap ? 16 : (NB * 16 * 32 - C.bid + C.G - 1) / C.G;
    u32x4 kreg[9], vreg[9], mreg = {0u, 0u, 0u, 0u}; float rpreg = 0.f, mbreg = 0.f;
#define AT_UNIT(i) (xmap ? (C.gc & 7) * 512 + (C.gc >> 3) + 32 * (i) : C.bid + C.G * (i))
    const __amdgpu_buffer_rsrc_t rsrc = __builtin_amdgcn_make_buffer_rsrc((void*)wsl, 0, 0xFFFFFFFF, 0x00020000);
    const int kvoff = (((tid >> 3) & 63) * D + 8 * (tid & 7)) * 2, vvoff = ((tid >> 3) * MPAD + 8 * (tid & 7)) * 2;
    const int mvoff = tid < 128 ? ((tid >> 3) * D + 8 * (tid & 7)) * 2 : (((tid - 128) >> 1) * MPAD + 8 * ((tid - 128) & 1)) * 2;
#define AT_ISSUE(unit_) do { const int rp_ = (unit_) & 31, h_ = ((unit_) >> 5) & 15, b_ = (unit_) >> 9, R0_ = min(max(2 * rp_ - 4, 0), 55); \
        const unsigned ks_ = (unsigned)WS_K + (unsigned)((b_ * SEQ + R0_ * 64) * D + 64 * h_) * 2u, vs_ = (unsigned)WS_VT + (unsigned)((64 * h_) * MPAD + b_ * SEQ + R0_ * 64) * 2u; \
        _Pragma("unroll") for (int i_ = 0; i_ < 9; ++i_) kreg[i_] = __builtin_amdgcn_raw_buffer_load_b128(rsrc, kvoff, (int)(ks_ + (unsigned)i_ * 64u * D * 2u), 0); \
        _Pragma("unroll") for (int i_ = 0; i_ < 9; ++i_) vreg[i_] = __builtin_amdgcn_raw_buffer_load_b128(rsrc, vvoff, (int)(vs_ + (unsigned)i_ * 128u), 0); \
        if (tid < 256) mreg = __builtin_amdgcn_raw_buffer_load_b128(rsrc, mvoff, (int)(tid < 128 ? (unsigned)WS_K + (unsigned)((NGRID + 16 * b_) * D + 64 * h_) * 2u : (unsigned)WS_VT + (unsigned)((64 * h_) * MPAD + NGRID + 16 * b_) * 2u), 0); \
        if (tid < 480) rpreg = (tid & 31) < 31 ? rpb[h_ * 465 + (tid >> 5) * 31 + (tid & 31)] * 1.44269504089f : -1.0e30f;        \
        if (tid < 16) mbreg = mbias[h_ * 16 + tid] * 1.44269504089f; } while (0)
    if (nu > 0) AT_ISSUE(AT_UNIT(0));
    for (int ui = 0; ui < nu; ++ui) {
        const int unit = AT_UNIT(ui);
        const int rp = unit & 31, h = (unit >> 5) & 15, b = unit >> 9;
        const int R0 = min(max(2 * rp - 4, 0), 55);
        __syncthreads();
#pragma unroll
        for (int i = 0; i < 9; ++i) { const int idx = tid + 512 * i, ch = idx & 7, kc = (idx >> 3) & 63, jr = idx >> 9;
            *(LAS u32x4*)(lds + AT_KS + ((jr * 64 + kc) * 8 + (ch ^ (kc & 7))) * 16) = kreg[i]; }
#pragma unroll
        for (int i = 0; i < 9; ++i) *(LAS u32x4*)(lds + AT_VTS + (tid >> 3) * AT_VPITCH + ((tid & 7) + 8 * i) * 16) = vreg[i];
        if (tid < 128) { const int m = tid >> 3, ch = tid & 7; *(LAS u32x4*)(lds + AT_KM + (m * 8 + (ch ^ (m & 7))) * 16) = mreg; }
        else if (tid < 256) { const int i = tid - 128, d = i >> 1, hf = i & 1; *(LAS u32x4*)(lds + AT_VTM + d * 32 + hf * 16) = mreg; }
        if (tid < 480) ((LAS float*)(lds + AT_RPB))[tid] = rpreg;
        if (tid < 16) ((LAS float*)(lds + AT_MB))[tid] = mbreg;
        __syncthreads();
        if (ui + 1 < nu) AT_ISSUE(AT_UNIT(ui + 1));
        const int qr = w >> 2, qg = w & 3, r = 2 * rp + qr, c0 = 16 * qg;
        const int rs = min(max(r - 4, 0), 56), jr0 = rs - R0;
        const int kcb = qg == 0 ? 0 : (qg == 1 ? 8 : (qg == 2 ? 24 : 32));
        const size_t qrow = (size_t)(b * SEQ + r * 64 + c0 + lq);
        bf16x8 qf[2];
#pragma unroll
        for (int ks = 0; ks < 2; ++ks) qf[ks] = *(const bf16x8*)(Q + qrow * D + 64 * h + 32 * ks + 8 * g);
        f32x4 sc[8][2], sm;
#pragma unroll
        for (int j = 0; j < 8; ++j)
#pragma unroll
            for (int blk = 0; blk < 2; ++blk) { f32x4 a = {0.f, 0.f, 0.f, 0.f}; const int kc = kcb + 16 * blk + lq;
#pragma unroll
                for (int ks = 0; ks < 2; ++ks) { const bf16x8 kf = *(const LAS bf16x8*)(lds + AT_KS + (((jr0 + j) * 64 + kc) * 8 + ((4 * ks + g) ^ (kc & 7))) * 16);
                    a = __builtin_amdgcn_mfma_f32_16x16x32_bf16(kf, qf[ks], a, 0, 0, 0); }
                sc[j][blk] = a; if (blk == 1 && (j & 1)) __builtin_amdgcn_sched_barrier(0); }
        { f32x4 a = {0.f, 0.f, 0.f, 0.f};
#pragma unroll
          for (int ks = 0; ks < 2; ++ks) { const bf16x8 kf = *(const LAS bf16x8*)(lds + AT_KM + (lq * 8 + ((4 * ks + g) ^ (lq & 7))) * 16);
              a = __builtin_amdgcn_mfma_f32_16x16x32_bf16(kf, qf[ks], a, 0, 0, 0); }
          sm = a; }
        const LAS unsigned char* RProw = lds + AT_RPB + (rs - r + 7) * 128; const LAS float* MB = (const LAS float*)(lds + AT_MB);
        float mx = -3.0e38f;
#pragma unroll
        for (int j = 0; j < 8; ++j)
#pragma unroll
            for (int blk = 0; blk < 2; ++blk)
#pragma unroll
                for (int e = 0; e < 4; ++e) { const float s = sc[j][blk][e] + *(const LAS float*)(RProw + j * 128 + bidx[blk][e]); sc[j][blk][e] = s; mx = fmaxf(mx, s); }
#pragma unroll
        for (int e = 0; e < 4; ++e) { sm[e] += MB[4 * g + e]; mx = fmaxf(mx, sm[e]); }
        mx = fmaxf(mx, __shfl_xor(mx, 16)); mx = fmaxf(mx, __shfl_xor(mx, 32));
        float sum = 0.f;
#pragma unroll
        for (int j = 0; j < 8; ++j)
#pragma unroll
            for (int blk = 0; blk < 2; ++blk)
#pragma unroll
                for (int e = 0; e < 4; ++e) { const float pv = fast_exp2(sc[j][blk][e] - mx); sc[j][blk][e] = pv; sum += pv; }
#pragma unroll
        for (int e = 0; e < 4; ++e) { const float pv = fast_exp2(sm[e] - mx); sm[e] = pv; sum += pv; }
        sum += __shfl_xor(sum, 16); sum += __shfl_xor(sum, 32);
        f32x4 o[4];
#pragma unroll
        for (int db = 0; db < 4; ++db) o[db] = (f32x4){0.f, 0.f, 0.f, 0.f};
#pragma unroll
        for (int j = 0; j < 8; ++j) {
            u32x4 pw; pw.x = cvt_pk_bf16(sc[j][0][0], sc[j][0][1]); pw.y = cvt_pk_bf16(sc[j][0][2], sc[j][0][3]); pw.z = cvt_pk_bf16(sc[j][1][0], sc[j][1][1]); pw.w = cvt_pk_bf16(sc[j][1][2], sc[j][1][3]);
            const bf16x8 pb = __builtin_bit_cast(bf16x8, pw);
#pragma unroll
            for (int db = 0; db < 4; ++db) { const int d = 16 * db + lq; const LAS unsigned char* vp = lds + AT_VTS + d * AT_VPITCH + ((jr0 + j) * 64 + kcb + 4 * g) * 2;
                const u32x2 lo = *(const LAS u32x2*)vp, hi = *(const LAS u32x2*)(vp + 32);
                u32x4 aw; aw.x = lo.x; aw.y = lo.y; aw.z = hi.x; aw.w = hi.y;
                o[db] = __builtin_amdgcn_mfma_f32_16x16x32_bf16(__builtin_bit_cast(bf16x8, aw), pb, o[db], 0, 0, 0); }
        }
        { u32x4 pw; pw.x = cvt_pk_bf16(sm[0], sm[1]); pw.y = cvt_pk_bf16(sm[2], sm[3]); pw.z = 0u; pw.w = 0u; const bf16x8 pb = __builtin_bit_cast(bf16x8, pw);
#pragma unroll
          for (int db = 0; db < 4; ++db) { const int d = 16 * db + lq; const u32x2 lo = *(const LAS u32x2*)(lds + AT_VTM + d * 32 + 8 * g);
              u32x4 aw; aw.x = lo.x; aw.y = lo.y; aw.z = 0u; aw.w = 0u;
              o[db] = __builtin_amdgcn_mfma_f32_16x16x32_bf16(__builtin_bit_cast(bf16x8, aw), pb, o[db], 0, 0, 0); } }
        const float inv = 1.0f / sum;
#pragma unroll
        for (int db = 0; db < 4; ++db) { u32x2 ow; ow.x = cvt_pk_bf16(o[db][0] * inv, o[db][1] * inv); ow.y = cvt_pk_bf16(o[db][2] * inv, o[db][3] * inv);
            *(u32x2*)(O + qrow * D + 64 * h + 16 * db + 4 * g) = ow; }
    }
#undef AT_UNIT
#undef AT_ISSUE
}


#define XB_TMO      128
#define XB_XCNT(j)  (256  + 64 * (j))
#define XB_XSUB(j)  (1280 + 64 * (j))
#define XB_XGEN(j)  (2304 + 64 * (j))
#define XB_TOP      3328
#define XB_TOPGEN   3392
#define XCD_BAR_WORDS 3456
#define XB_SPIN_CAP (1u << 22)
__device__ __forceinline__ unsigned xb_ld(unsigned* p)              { return __hip_atomic_load(p, __ATOMIC_RELAXED, __HIP_MEMORY_SCOPE_AGENT); }
__device__ __forceinline__ unsigned xb_add(unsigned* p, unsigned v) { return __hip_atomic_fetch_add(p, v, __ATOMIC_RELAXED, __HIP_MEMORY_SCOPE_AGENT); }
__device__ __forceinline__ unsigned xb_xcc_id() { return (unsigned)__builtin_amdgcn_s_getreg((3 << 11) | 20) & 0xFu; }
#define XB_SPIN(cond, bar) do { unsigned _sp = 0; while (cond) { __builtin_amdgcn_s_sleep(1); \
    if ((++_sp & 255u) == 0u) { if (xb_ld(&(bar)[XB_TMO])) break; if (_sp > XB_SPIN_CAP) { atomicAdd(&(bar)[XB_TMO], 1u); break; } } } } while (0)
struct XcdBarrier { unsigned* bar; unsigned x; volatile LAS unsigned* st; };
__device__ __forceinline__ XcdBarrier xcd_barrier_post(unsigned* bar, volatile LAS unsigned* st) {
    XcdBarrier b; b.bar = bar; b.x = xb_xcc_id(); b.st = st;
    if (threadIdx.x == 0) st[2] = xb_add(&bar[XB_XCNT(b.x)], 1u);
    return b;
}
__device__ __forceinline__ void xcd_barrier_complete(unsigned* bar, unsigned x, unsigned& nloc, unsigned& nx) {
    const unsigned G = gridDim.x * gridDim.y * gridDim.z;
    unsigned sum, cnt, mine, sp = 0u;
    for (;;) {
        sum = 0u; cnt = 0u; mine = 0u;
#pragma unroll
        for (unsigned j = 0; j < 16; ++j) { const unsigned c = xb_ld(&bar[XB_XCNT(j)]); sum += c; cnt += (c > 0u) ? 1u : 0u; mine = (j == x) ? c : mine; }
        if (sum == G) break;
        __builtin_amdgcn_s_sleep(1);
        if ((++sp & 255u) == 0u) { if (xb_ld(&bar[XB_TMO])) break; if (sp > XB_SPIN_CAP) { atomicAdd(&bar[XB_TMO], 1u); break; } }
    }
    nloc = mine > 0u ? mine : 1u; nx = cnt > 0u ? cnt : 1u;
}
__device__ __forceinline__ void xcd_barrier(const XcdBarrier& b) {
    asm volatile("s_waitcnt vmcnt(0)" ::: "memory");
    __syncthreads();
    if (threadIdx.x == 0) {
        unsigned* bar = b.bar;
        __builtin_amdgcn_s_waitcnt(0);
        unsigned nloc = b.st[0], nx = b.st[1];
        if (nloc == 0u) { xcd_barrier_complete(bar, b.x, nloc, nx); b.st[0] = nloc; b.st[1] = nx; }
        const unsigned old = xb_add(&bar[XB_XSUB(b.x)], 1u);
        const unsigned gen = old / nloc;
        if (old + 1u == (gen + 1u) * nloc) {
            __builtin_amdgcn_fence(__ATOMIC_RELEASE, "agent");
            asm volatile("s_waitcnt vmcnt(0)" ::: "memory");
            const unsigned og = xb_add(&bar[XB_TOP], 1u);
            const unsigned tg = og / nx;
            if (og + 1u == (tg + 1u) * nx) xb_add(&bar[XB_TOPGEN], 1u);
            else XB_SPIN(xb_ld(&bar[XB_TOPGEN]) == tg, bar);
            __builtin_amdgcn_fence(__ATOMIC_ACQUIRE, "agent");
            xb_add(&bar[XB_XGEN(b.x)], 1u);
            asm volatile("s_waitcnt vmcnt(0)" ::: "memory");
        } else {
            XB_SPIN(xb_ld(&bar[XB_XGEN(b.x)]) == gen, bar);
            __builtin_amdgcn_fence(__ATOMIC_ACQUIRE, "agent");
            asm volatile("s_waitcnt vmcnt(0)" ::: "memory");
        }
    }
    __syncthreads();
}
__device__ __forceinline__ int moe_prep(const Ctx& C, const int* texp) {
    LAS int* t = (LAS int*)(C.lds + pg8::TEXP_OFF); const int tid = fresh_tid();
    const int a = texp[tid], b = texp[tid + 512];
    t[tid] = a; t[tid + 512] = b;
    __syncthreads();
    return __builtin_amdgcn_readfirstlane(t[1023]);
}
constexpr size_t CT_BAR = 131072;
constexpr int LDS_BARST = LDS_BYTES - 64;

constexpr int N_PHASES = 20;
__global__ void __launch_bounds__(NTHREADS, 2) hybrid_fwd(Params P) {
    extern __shared__ __attribute__((aligned(16))) unsigned char smem[];
    cg::grid_group grid = cg::this_grid();
    Ctx C; C.lds = (LAS unsigned char*)smem; C.G = gridDim.x; C.bid = blockIdx.x;
    C.ws = P.ws; C.in = P.in; C.out = P.out;
    unsigned char* const ws0 = P.ws;
#define ws fresh_ws(ws0)
    const int lo = P.ph_lo, hi = P.ph_hi;
#ifndef PH_MASK
#define PH_MASK 0xFFFFFFFFu
#endif
#define IN(k) (((PH_MASK >> (k)) & 1u) && lo <= (k) && (k) < hi)
#ifndef REPEAT_MASK
#define REPEAT_MASK 0u
#endif
#define REPS(k) ((((unsigned)REPEAT_MASK >> (k)) & 1u) ? 2 : 1)
#ifndef N_CG_SYNCS
#define N_CG_SYNCS 1
#endif
#define SEAM(k) do { if (IN(k) && IN((k) + 1)) { if ((k) < N_CG_SYNCS) grid.sync(); else xcd_barrier(bar); } } while (0)
    if (threadIdx.x < 16) ((LAS unsigned*)(smem + LDS_BARST))[threadIdx.x] = 0u;
    __syncthreads();
    const XcdBarrier bar = xcd_barrier_post((unsigned*)(ws + WS_CTL + CT_BAR), (volatile LAS unsigned*)(smem + LDS_BARST));
    C.gc = C.bid;
    #define PH_BODY_0 phase_convert(C);
    if (IN(0)) { PH_BODY_0 } if (REPS(0) > 1 && IN(0)) { xcd_barrier(bar); PH_BODY_0 }
    SEAM(0);
    if (IN(0) && IN(1)) {
        unsigned* barw = (unsigned*)(ws + WS_CTL + CT_BAR); bool eq = (C.G % 8) == 0;
#pragma unroll
        for (int j = 0; j < 16; ++j) { const unsigned cj = xb_ld(&barw[XB_XCNT(j)]); eq = eq && (cj == (j < 8 ? (unsigned)(C.G / 8) : 0u)); }
        const unsigned rank = ((volatile LAS unsigned*)(smem + LDS_BARST))[2];
        C.gc = __builtin_amdgcn_readfirstlane(eq ? (int)(rank * 8u + bar.x) : C.bid);
    }
    #define PH_BODY_1 { DenseSched S{(unsigned)WS_HB, (unsigned)WS_WIN, 1024, 1024, 128, 8, C.G, C.gc}; EpiWin E{(bf16_t*)(ws + WS_XR), (bf16_t*)(ws + WS_GY)}; \
        pg8::gemm_phase<false>(C.lds, ws, 1024, 1024, 1024, S, E); mini_win(C); }
    if (IN(1)) { PH_BODY_1 } if (REPS(1) > 1 && IN(1)) { xcd_barrier(bar); PH_BODY_1 }
    SEAM(1);
    #define PH_BODY_2 phase_conv(C);
    if (IN(2)) { PH_BODY_2 } if (REPS(2) > 1 && IN(2)) { xcd_barrier(bar); PH_BODY_2 }
    SEAM(2);
    #define PH_BODY_3 { GateSched S{(unsigned)WS_XC, (unsigned)WS_GATE, 128, C.G, C.gc}; \
        EpiGate E{(const bf16_t*)(ws + WS_XC), (bf16_t*)(ws + WS_LA), (bf16_t*)(ws + WS_BB), P.in[I_BA], P.in[I_BX], (const float*)(ws + WS_CTL + CT_SPL)}; \
        pg8::gemm_phase<false>(C.lds, ws, 256, 1024, 256, S, E); mini_gate(C); }
    if (IN(3)) { PH_BODY_3 } if (REPS(3) > 1 && IN(3)) { xcd_barrier(bar); PH_BODY_3 }
    SEAM(3);
    #define PH_BODY_4 phase_scan(C);
    if (IN(4)) { PH_BODY_4 } if (REPS(4) > 1 && IN(4)) { xcd_barrier(bar); PH_BODY_4 }
    SEAM(4);
    #define PH_BODY_5 { DenseSched S{(unsigned)WS_G, (unsigned)WS_LOUT, 1024, 1024, 128, 4, C.G, C.gc}; EpiRes<true> E{(bf16_t*)(ws + WS_PRE), P.in[I_X], P.in[I_META], nullptr, NTOK}; \
        pg8::gemm_phase<false>(C.lds, ws, 1024, 1024, 1024, S, E); mini_lout(C); }
    if (IN(5)) { PH_BODY_5 } if (REPS(5) > 1 && IN(5)) { xcd_barrier(bar); PH_BODY_5 }
    SEAM(5);
    #define PH_BODY_6 phase_lnr(C, 0, NTOK);
    if (IN(6)) { PH_BODY_6 } if (REPS(6) > 1 && IN(6)) { xcd_barrier(bar); PH_BODY_6 }
    SEAM(6);
    #define PH_BODY_7 phase_pos(C, 0, NTOK);
    if (IN(7)) { PH_BODY_7 } if (REPS(7) > 1 && IN(7)) { xcd_barrier(bar); PH_BODY_7 }
    SEAM(7);
    #define PH_BODY_8 { const int nM = moe_prep(C, (const int*)(ws + WS_CTL + CT_TEXP)); \
        MoeSched S{(unsigned)WS_XS, (unsigned)WS_WGU, (const LAS int*)(C.lds + pg8::TEXP_OFF), 2048u * 1024u, nM, 8, C.G, C.gc}; EpiGlu E{(unsigned char*)(ws + WS_ACT), (unsigned)WS_BIAS}; \
        pg8::gemm_phase<true>(C.lds, ws, 512, 512, 512, S, E); }
    if (IN(8)) { PH_BODY_8 } if (REPS(8) > 1 && IN(8)) { xcd_barrier(bar); PH_BODY_8 }
#ifdef PROBE_NULL8
    if (IN(8)) { xcd_barrier(bar); { const int nM = moe_prep(C, (const int*)(ws + WS_CTL + CT_TEXP));
        MoeSched S{(unsigned)WS_XS, (unsigned)WS_WGU, (const LAS int*)(C.lds + pg8::TEXP_OFF), 2048u * 1024u, nM, 8, C.G, C.gc}; EpiNull E{};
        pg8::gemm_phase<true>(C.lds, ws, 512, 512, 512, S, E); } }
#endif
    SEAM(8);
    #define PH_BODY_9 { const int nM = moe_prep(C, (const int*)(ws + WS_CTL + CT_TEXP)); \
        MoeSched S{(unsigned)WS_ACT, (unsigned)WS_WD, (const LAS int*)(C.lds + pg8::TEXP_OFF), 1024u * 1024u, nM, 4, C.G, C.gc}; EpiDown E{(bf16_t*)(ws + WS_YS), (unsigned)WS_BD}; \
        pg8::gemm_phase<true>(C.lds, ws, 512, 512, 512, S, E); }
    if (IN(9)) { PH_BODY_9 } if (REPS(9) > 1 && IN(9)) { xcd_barrier(bar); PH_BODY_9 }
    SEAM(9);
    #define PH_BODY_10 phase_combine(C, 0, NTOK, false);
    if (IN(10)) { PH_BODY_10 } if (REPS(10) > 1 && IN(10)) { xcd_barrier(bar); PH_BODY_10 }
    SEAM(10);
    #define PH_BODY_11 { QkvSched S{(unsigned)WS_HB, (unsigned)WS_QKV, 128, C.G, C.gc}; EpiQkv E{(bf16_t*)(ws + WS_Q), (bf16_t*)(ws + WS_K), (bf16_t*)(ws + WS_VT)}; \
        pg8::gemm_phase<false>(C.lds, ws, 1024, 1024, 1024, S, E); mini_kv(C); }
    if (IN(11)) { PH_BODY_11 } if (REPS(11) > 1 && IN(11)) { xcd_barrier(bar); PH_BODY_11 }
    SEAM(11);
    #define PH_BODY_12 phase_attn(C);
    if (IN(12)) { PH_BODY_12 } if (REPS(12) > 1 && IN(12)) { xcd_barrier(bar); PH_BODY_12 }
    SEAM(12);
    #define PH_BODY_13 { DenseSched S{(unsigned)WS_O, (unsigned)WS_NOUT, 1024, 1024, 128, 4, C.G, C.gc}; EpiRes<false> E{(bf16_t*)(ws + WS_PRE), nullptr, nullptr, (const bf16_t*)(ws + WS_HB), NGRID}; \
        pg8::gemm_phase<false>(C.lds, ws, 1024, 1024, 1024, S, E); }
    if (IN(13)) { PH_BODY_13 } if (REPS(13) > 1 && IN(13)) { xcd_barrier(bar); PH_BODY_13 }
    SEAM(13);
    #define PH_BODY_14 phase_lnr(C, 1, NGRID);
    if (IN(14)) { PH_BODY_14 } if (REPS(14) > 1 && IN(14)) { xcd_barrier(bar); PH_BODY_14 }
    SEAM(14);
    #define PH_BODY_15 phase_pos(C, 1, NGRID);
    if (IN(15)) { PH_BODY_15 } if (REPS(15) > 1 && IN(15)) { xcd_barrier(bar); PH_BODY_15 }
    SEAM(15);
    #define PH_BODY_16 { const int nM = moe_prep(C, (const int*)(ws + WS_CTL + CT_TEXP) + 1024); \
        MoeSched S{(unsigned)WS_XS, (unsigned)(WS_WGU + (size_t)32 * 2048 * 1024), (const LAS int*)(C.lds + pg8::TEXP_OFF), 2048u * 1024u, nM, 8, C.G, C.gc}; EpiGlu E{(unsigned char*)(ws + WS_ACT), (unsigned)(WS_BIAS + 32 * 2048 * 4)}; \
        pg8::gemm_phase<true>(C.lds, ws, 512, 512, 512, S, E); }
    if (IN(16)) { PH_BODY_16 } if (REPS(16) > 1 && IN(16)) { xcd_barrier(bar); PH_BODY_16 }
    SEAM(16);
    #define PH_BODY_17 { const int nM = moe_prep(C, (const int*)(ws + WS_CTL + CT_TEXP) + 1024); \
        MoeSched S{(unsigned)WS_ACT, (unsigned)(WS_WD + (size_t)32 * 1024 * 1024), (const LAS int*)(C.lds + pg8::TEXP_OFF), 1024u * 1024u, nM, 4, C.G, C.gc}; EpiDown E{(bf16_t*)(ws + WS_YS), (unsigned)(WS_BD + 32 * 1024 * 4)}; \
        pg8::gemm_phase<true>(C.lds, ws, 512, 512, 512, S, E); }
    if (IN(17)) { PH_BODY_17 } if (REPS(17) > 1 && IN(17)) { xcd_barrier(bar); PH_BODY_17 }
    SEAM(17);
    #define PH_BODY_18 phase_combine(C, 1, NGRID, true);
    if (IN(18)) { PH_BODY_18 } if (REPS(18) > 1 && IN(18)) { xcd_barrier(bar); PH_BODY_18 }
#undef ws
#undef IN
#undef SEAM
}

#ifndef MK_PER_PHASE
#define MK_PER_PHASE 0
#endif
extern "C" void kernel_launch(void* const* d_in, const int* in_sizes, int n_in, void* d_out, int out_size, void* d_ws, size_t ws_size, hipStream_t stream) {
    static int grid = 0;
    if (grid == 0) {
        if (n_in != 25 || ws_size < WS_END || out_size != NGRID * D) { fprintf(stderr, "kernel_launch: unexpected problem (n_in %d, ws %zu, out %d)\n", n_in, ws_size, out_size); grid = -1; return; }
        int dev = 0, cus = 0, per_cu = 0;
        if (hipGetDevice(&dev) != hipSuccess || hipDeviceGetAttribute(&cus, hipDeviceAttributeMultiprocessorCount, dev) != hipSuccess) { grid = -1; return; }
        if (hipFuncSetAttribute((const void*)hybrid_fwd, hipFuncAttributeMaxDynamicSharedMemorySize, LDS_BYTES) != hipSuccess) { fprintf(stderr, "kernel_launch: hipFuncSetAttribute failed\n"); grid = -1; return; }
        if (hipOccupancyMaxActiveBlocksPerMultiprocessor(&per_cu, (const void*)hybrid_fwd, NTHREADS, LDS_BYTES) != hipSuccess || per_cu < 1) { fprintf(stderr, "kernel_launch: occupancy query failed (%d)\n", per_cu); grid = -1; return; }
        grid = cus * 1;
        if (grid > 256) grid = 256;
    }
    if (grid < 0) return;
    if (hipMemsetAsync((char*)d_ws + WS_CTL + CT_BAR, 0, 16384, stream) != hipSuccess) { fprintf(stderr, "kernel_launch: memset failed\n"); return; }
    Params p{};
    for (int i = 0; i < 25; ++i) p.in[i] = (const float*)d_in[i];
    p.out = (float*)d_out; p.ws = (unsigned char*)d_ws;
#if MK_PER_PHASE
    for (int ph = 0; ph < 19; ++ph) { p.ph_lo = ph; p.ph_hi = ph + 1; void* args[] = {&p};
        hipError_t e = hipLaunchCooperativeKernel((void*)hybrid_fwd, dim3(grid), dim3(NTHREADS), args, LDS_BYTES, stream);
        if (e != hipSuccess) { fprintf(stderr, "launch phase %d failed: %s\n", ph, hipGetErrorString(e)); break; } }
#else
    p.ph_lo = 0; p.ph_hi = 19; void* args[] = {&p};
    hipError_t e = hipLaunchCooperativeKernel((void*)hybrid_fwd, dim3(grid), dim3(NTHREADS), args, LDS_BYTES, stream);
    if (e != hipSuccess) fprintf(stderr, "cooperative launch failed: %s (grid %d)\n", hipGetErrorString(e), grid);
#endif
}
```

```cpp
#include <hip/hip_runtime.h>
#include <hip/hip_cooperative_groups.h>
#include <cstdio>
#include <cstdint>
namespace cg = cooperative_groups;

#define LAS __attribute__((address_space(3)))
typedef unsigned short bf16_t;
typedef short bf16x8 __attribute__((ext_vector_type(8)));
typedef float f32x4 __attribute__((ext_vector_type(4)));
typedef float f32x2 __attribute__((ext_vector_type(2)));
typedef unsigned u32x4 __attribute__((ext_vector_type(4)));
typedef unsigned u32x2 __attribute__((ext_vector_type(2)));

constexpr int NB = 8, SEQ = 4096, D = 1024, NMETA = 16, LSEQ = SEQ + NMETA;
constexpr int NGRID = NB * SEQ;
constexpr int NTOK = NGRID + NB * NMETA;
constexpr int MPAD = 33024;
constexpr int NEXP = 32, TOPK = 4;
constexpr int PMAX = 139776;
constexpr int MTMAX = PMAX / 256;
constexpr float DN_ALPHA = 1.41421356237f;
constexpr float LN_EPS = 1e-5f;
constexpr int NTHREADS = 512, NWAVES = 8;

constexpr size_t MiB = 1u << 20;
constexpr size_t ACT_BYTES = (size_t)MPAD * D * 2;
constexpr size_t WS_CTL   = 0;
constexpr size_t WS_WIN   = 4 * MiB;
constexpr size_t WS_GATE  = WS_WIN + 4 * MiB;
constexpr size_t WS_LOUT  = WS_GATE + 2 * MiB;
constexpr size_t WS_QKV   = WS_LOUT + 2 * MiB;
constexpr size_t WS_NOUT  = WS_QKV + 6 * MiB;
constexpr size_t WS_WGU   = WS_NOUT + 2 * MiB;
constexpr size_t WS_WD    = WS_WGU + 128 * MiB;
constexpr size_t WS_HB    = WS_WD + 64 * MiB;
constexpr size_t WS_HB8   = WS_HB + 65 * MiB;
constexpr size_t WS_PRE   = WS_HB8 + 33 * MiB;
constexpr size_t WS_H     = WS_PRE + 129 * MiB;
constexpr size_t WS_SCR   = WS_H + 129 * MiB;
constexpr size_t WS_XR = WS_SCR, WS_XC = WS_XR + 65 * MiB, WS_GY = WS_XC + 65 * MiB, WS_LA = WS_GY + 65 * MiB, WS_BB = WS_LA + 130 * MiB, WS_HF = WS_BB + 130 * MiB, WS_G = WS_HF + 65 * MiB;
constexpr size_t WS_SCR_END0 = WS_G + 65 * MiB;
constexpr size_t WS_XS = WS_SCR, WS_ACT = WS_XS + 137 * MiB, WS_YS = WS_ACT + 137 * MiB;
constexpr size_t WS_SCR_END1 = WS_YS + 274 * MiB;
constexpr size_t WS_Q = WS_SCR, WS_K = WS_Q + 65 * MiB, WS_VT = WS_K + 65 * MiB, WS_O = WS_VT + 65 * MiB;
constexpr size_t WS_BIAS = (WS_SCR_END0 > WS_SCR_END1 ? WS_SCR_END0 : WS_SCR_END1);
constexpr size_t WS_BD = WS_BIAS + 2 * 32 * 2048 * 4;
constexpr size_t WS_TOK = WS_BIAS + 1 * MiB;
constexpr size_t WS_END = WS_TOK + 2 * MiB;
static_assert((size_t)PMAX * 4 <= 1 * MiB, "token offset table");
static_assert(ACT_BYTES <= 65 * MiB && (size_t)PMAX * D * 2 <= 274 * MiB && (size_t)PMAX * D <= 137 * MiB && (size_t)MPAD * D <= 33 * MiB && (size_t)MPAD * D * 4 <= 129 * MiB, "ws map");
static_assert(WS_END <= (size_t)2040 * MiB, "ws map must fit 4x the largest input tensor");
constexpr size_t CT_BC      = 4096;
constexpr size_t CT_TEXP    = CT_BC + 2 * 256 * 32 * 4;
constexpr size_t CT_SPL     = CT_TEXP + 2 * 1024 * 4;
constexpr size_t CT_EID     = 256 * 1024;
constexpr size_t CT_GATEV   = CT_EID + 2 * (size_t)NTOK * 4 * 4;
constexpr size_t CT_POS     = CT_GATEV + 2 * (size_t)NTOK * 4 * 4;
static_assert(CT_POS + 2 * (size_t)NTOK * 4 * 4 <= 4 * MiB, "ctl map");

constexpr int LDS_BYTES = 155648;

__device__ __forceinline__ unsigned f2bf(float f) { unsigned u = __builtin_bit_cast(unsigned, f); return (u + 0x7fffu + ((u >> 16) & 1u)) >> 16; }
__device__ __forceinline__ unsigned cvt_pk_bf16(float lo, float hi);
__device__ __forceinline__ unsigned pk2(float lo, float hi) { return cvt_pk_bf16(lo, hi); }
typedef __bf16 bf16x2_t __attribute__((ext_vector_type(2)));
__device__ __forceinline__ unsigned cvt_pk_bf16(float lo, float hi) { const f32x2 v = {lo, hi}; return __builtin_bit_cast(unsigned, __builtin_convertvector(v, bf16x2_t)); }
__device__ __forceinline__ unsigned pk4_fp8(float a, float b, float c, float d) { int w = __builtin_amdgcn_cvt_pk_fp8_f32(a, b, 0, false); w = __builtin_amdgcn_cvt_pk_fp8_f32(c, d, w, true); return (unsigned)w; }
__device__ __forceinline__ float bflo(unsigned w) { return __builtin_bit_cast(float, w << 16); }
__device__ __forceinline__ float bfhi(unsigned w) { return __builtin_bit_cast(float, w & 0xffff0000u); }
__device__ __forceinline__ float fast_exp2(float x) { return __builtin_amdgcn_exp2f(x); }
__device__ __forceinline__ float fast_rcp(float x) { return __builtin_amdgcn_rcpf(x); }
__device__ __forceinline__ float sigmoidf_(float x) { return fast_rcp(1.0f + fast_exp2(-1.44269504089f * x)); }
__device__ __forceinline__ float wave_sum(float v) {
#pragma unroll
    for (int o = 1; o < 64; o <<= 1) v += __shfl_xor(v, o);
    return v;
}
template <int CTRL> __device__ __forceinline__ float dpp_movf(float v) { return __builtin_bit_cast(float, __builtin_amdgcn_update_dpp(0, __builtin_bit_cast(int, v), CTRL, 0xf, 0xf, true)); }
__device__ __forceinline__ float readlane_f(float v, int l) { return __builtin_bit_cast(float, __builtin_amdgcn_readlane(__builtin_bit_cast(int, v), l)); }
__device__ __forceinline__ float wave_sum_dpp(float v) {
    v += dpp_movf<0xB1>(v);
    v += dpp_movf<0x4E>(v);
    v += dpp_movf<0x141>(v);
    v += dpp_movf<0x140>(v);
    return (readlane_f(v, 0) + readlane_f(v, 16)) + (readlane_f(v, 32) + readlane_f(v, 48));
}
__device__ __forceinline__ int seqrow(int b, int s) { return s < NMETA ? NGRID + NMETA * b + s : SEQ * b + (s - NMETA); }

struct Params {
    const float* in[25];
    float* out;
    unsigned char* ws;
    int ph_lo, ph_hi;
};
struct Ctx {
    LAS unsigned char* lds;
    int G, bid, gc;
    unsigned char* ws;
    const float* const* in;
    float* out;
};
__device__ __forceinline__ int fresh_tid() { int t = threadIdx.x; asm volatile("" : "+v"(t)); return t; }
__device__ __forceinline__ unsigned char* fresh_ws(unsigned char* p) { asm volatile("" : "+s"(p)); return p; }
#define PHASE_IDS unsigned char* const wsl = fresh_ws(C.ws); (void)wsl; const int tid = fresh_tid(); const int lane = tid & 63; const int wave = __builtin_amdgcn_readfirstlane(tid >> 6); (void)lane; (void)wave;
enum { I_X = 0, I_META, I_WIN, I_CONVW, I_CONVB, I_WA, I_BA, I_WX, I_BX, I_LAM, I_LOUT, I_WQKV, I_RPB, I_MBIAS, I_NOUT, I_LNMG, I_LNMB, I_RW, I_RB, I_WGU, I_BGU, I_WD, I_BD, I_LNFG, I_LNFB };

namespace pg8 {
constexpr int BM = 256, BK = 64, HALF = 128, HTB = HALF * BK * 2, STAGE_BYTES = 8 * HTB, NXCD = 8, WGM = 8;
constexpr int SIDE_OFF = STAGE_BYTES, TEXP_OFF = STAGE_BYTES + 2048, TOK_OFF = STAGE_BYTES + 2048 + 4096;
__device__ __forceinline__ int lds_byte(int r, int c) { const int st = (r >> 4) * 2 + (c >> 5), rr = r & 15, cc = c & 31, ob = rr * 64 + cc * 2; return st * 1024 + (ob ^ (((ob >> 9) & 1) << 5)); }
__device__ __forceinline__ void stage_rc(int b, int& R, int& C) { const int st = b / 1024, sb = b % 1024, swz = sb ^ (((sb >> 9) & 1) << 5); R = (st >> 1) * 16 + swz / 64; C = (st & 1) * 32 + (swz % 64) / 2; }
__device__ __forceinline__ int perm32(int rho) { const int n = rho >> 4, i = rho & 15; return 8 * (i >> 2) + 4 * n + (i & 3); }

typedef int v8i __attribute__((ext_vector_type(8)));
typedef int v4i __attribute__((ext_vector_type(4)));
__device__ __forceinline__ v8i cat8(bf16x8 a, bf16x8 b) { const v4i x = __builtin_bit_cast(v4i, a), y = __builtin_bit_cast(v4i, b); return __builtin_shufflevector(x, y, 0, 1, 2, 3, 4, 5, 6, 7); }
struct Unit { unsigned ao, bo, to; int pm, pn, aux; };

__device__ __forceinline__ void tile_of(int L, int nM, int nN, int& pm, int& pn) {
    const int nwg = nM * nN; int wgid = L;
    { const int q = nwg / NXCD, r = nwg % NXCD, xcd = wgid % NXCD, off = wgid / NXCD; wgid = (xcd < r ? xcd * (q + 1) : r * (q + 1) + (xcd - r) * q) + off; }
    const int nig = WGM * nN, gid = wgid / nig, fm = gid * WGM, gsz = (nM - fm) < WGM ? (nM - fm) : WGM;
    pm = fm + ((wgid % nig) % gsz); pn = (wgid % nig) / gsz;
}

template <bool F8, bool GATHER, class Epi, class Sched>
__device__ __forceinline__ void gemm_phase(LAS unsigned char* lds, const unsigned char* wsbase, const int K, const int lda, const int ldb, const Sched& S, const Epi& E) {
    const __amdgpu_buffer_rsrc_t rsrc = __builtin_amdgcn_make_buffer_rsrc((void*)wsbase, 0, 0xFFFFFFFF, 0x00020000);
    const int tid = fresh_tid(), wid = __builtin_amdgcn_readfirstlane(tid >> 6), lane = tid & 63, wr = wid >> 2, wc = wid & 3;
    const int nt = K / BK;
    int f8scales = 0; if constexpr (F8) { f8scales = Epi::SCALES; asm volatile("" : "+v"(f8scales)); }
    int voffA, voffB;
    { int R, C; stage_rc(tid * 16, R, C); const int Rb = Epi::PERM ? ((R & ~31) + perm32(R & 31)) : R; voffA = ((GATHER ? 0 : R * lda) + C) * 2; voffB = (Rb * ldb + C) * 2; }
    const int tokb = (16 * (wid >> 1) + (lane >> 2)) * 4;
    const unsigned kstep = (unsigned)(BK * 2);
    const unsigned hstepA = (unsigned)HALF * lda * 2, hstepB = (unsigned)HALF * ldb * 2;
    const unsigned ldsw = (unsigned)wid * 1024u;
    const int aoff = lds_byte(wr * 64 + (lane & 15), (lane >> 4) * 8), boff = lds_byte(wc * 32 + (lane & 15), (lane >> 4) * 8);
#define PG8_SA(b, h) (((b) * 2 + (h)) * HTB)
#define PG8_SB(b, h) ((4 + (b) * 2 + (h)) * HTB)
#define PG8_STAGE(bufoff, gbase, voff) do { _Pragma("unroll") for (int _i = 0; _i < 2; ++_i) \
        __builtin_amdgcn_raw_ptr_buffer_load_lds(rsrc, (LAS void*)(lds + (bufoff) + ldsl + _i * 8192), 16, voff, __builtin_amdgcn_readfirstlane((int)((gbase) + (unsigned)_i * (hstep##voff >> 1))), 0, 0); } while (0)
#define hstepvoffA hstepA
#define hstepvoffB hstepB
#define PG8_STAGE_A(bufoff, aoffs, h, par) do { if constexpr (GATHER) { _Pragma("unroll") for (int _i = 0; _i < 2; ++_i) { \
            const int _tk = *(const LAS int*)(lds + TOK_OFF + (par) * 1024 + tokb + ((h) * 128 + _i * 64) * 4); \
            __builtin_amdgcn_raw_ptr_buffer_load_lds(rsrc, (LAS void*)(lds + (bufoff) + ldsl + _i * 8192), 16, _tk + voffA, __builtin_amdgcn_readfirstlane((int)(aoffs)), 0, 0); } } \
        else { PG8_STAGE(bufoff, (aoffs) + (unsigned)(h) * hstepA, voffA); } } while (0)
#define PG8_TOK(unit, par) do { if constexpr (GATHER) { if (wid == 0) __builtin_amdgcn_raw_ptr_buffer_load_lds(rsrc, (LAS void*)(lds + TOK_OFF + (par) * 1024), 16, lane * 16, (int)(unit).to, 0, 0); } } while (0)
#define PG8_LDA(dst, b, h) do { _Pragma("unroll") for (int m = 0; m < 4; ++m) _Pragma("unroll") for (int k = 0; k < 2; ++k) dst[m][k] = *(const LAS bf16x8*)(lds + PG8_SA(b, h) + aoff + m * 2048 + k * 1024); } while (0)
#define PG8_LDB(dst, b, h) do { _Pragma("unroll") for (int n = 0; n < 2; ++n) _Pragma("unroll") for (int k = 0; k < 2; ++k) dst[n][k] = *(const LAS bf16x8*)(lds + PG8_SB(b, h) + boff + n * 2048 + k * 1024); } while (0)
#define PG8_MMA(ai, bj, At, Bt) do { __builtin_amdgcn_s_setprio(1); _Pragma("unroll") for (int m = 0; m < 4; ++m) _Pragma("unroll") for (int n = 0; n < 2; ++n) { \
        if constexpr (F8) { asm volatile("v_mfma_scale_f32_16x16x128_f8f6f4 %0, %1, %2, %0, %3, %3 op_sel:[0,1,0] op_sel_hi:[0,0,0]" : "+v"(acc[ai][bj][m][n]) : "v"(cat8(Bt[n][0], Bt[n][1])), "v"(cat8(At[m][0], At[m][1])), "v"(f8scales)); } \
        else { _Pragma("unroll") for (int k = 0; k < 2; ++k) acc[ai][bj][m][n] = __builtin_amdgcn_mfma_f32_16x16x32_bf16(Bt[n][k], At[m][k], acc[ai][bj][m][n], 0, 0, 0); } } \
        __builtin_amdgcn_s_setprio(0); } while (0)
#define PG8_WAIT_V(n) asm volatile("s_waitcnt vmcnt(" #n ")" ::: "memory")
#define PG8_WAIT_L(n) asm volatile("s_waitcnt lgkmcnt(" #n ")" ::: "memory")
#define PG8_BAR __builtin_amdgcn_s_barrier()
#define PG8_SCHED __builtin_amdgcn_sched_barrier(0)
    Unit cur, nxt; int ui = 0;
    if (!S.next(0, cur)) return;
    f32x4 acc[2][2][4][2];
#pragma unroll
    for (int a = 0; a < 2; ++a)
#pragma unroll
        for (int b = 0; b < 2; ++b)
#pragma unroll
            for (int m = 0; m < 4; ++m)
#pragma unroll
                for (int n = 0; n < 2; ++n) acc[a][b][m][n] = (f32x4){0.f, 0.f, 0.f, 0.f};
    bf16x8 At[4][2], B0[2][2], B1[2][2];
    unsigned cA = cur.ao, cB = cur.bo;
    unsigned ldsl = ldsw; asm volatile("" : "+s"(ldsl));
#define PG8_SIDE(unit, par) do { if constexpr (Epi::SIDE) { if (wid == 0) __builtin_amdgcn_raw_ptr_buffer_load_lds(rsrc, (LAS void*)(lds + SIDE_OFF + (par) * 1024), 16, lane * 16, (int)E.side_off(unit), 0, 0); } } while (0)
    PG8_SIDE(cur, 0);
    if constexpr (GATHER) { PG8_TOK(cur, 0); asm volatile("s_waitcnt vmcnt(0)" ::: "memory"); PG8_BAR; }
    PG8_STAGE(PG8_SB(0, 0), cB, voffB); PG8_STAGE(PG8_SB(0, 1), cB + hstepB, voffB); PG8_STAGE_A(PG8_SA(0, 0), cA, 0, 0); PG8_STAGE_A(PG8_SA(0, 1), cA, 1, 0);
    if (wr == 1) PG8_BAR;
    PG8_WAIT_V(2); PG8_BAR;
    PG8_STAGE(PG8_SB(1, 0), cB + kstep, voffB); PG8_STAGE_A(PG8_SA(1, 0), cA + kstep, 0, 0); PG8_STAGE(PG8_SB(1, 1), cB + hstepB + kstep, voffB);
    PG8_WAIT_V(6); PG8_BAR;
    for (;;) {
        const bool has_next = S.next(ui + 1, nxt);
        if (has_next) PG8_TOK(nxt, (ui + 1) & 1);
        const unsigned nA = has_next ? nxt.ao : cA, nB = has_next ? nxt.bo : cB;
#pragma unroll 1
        for (int t = 0; t < nt; t += 2) {
            const bool last = (t == nt - 2);
            ldsl = ldsw; asm volatile("" : "+s"(ldsl));
            const int parc = ui & 1, parn = (ui + ((last && has_next) ? 1 : 0)) & 1;
            const unsigned a1 = cA + (unsigned)(t + 1) * kstep;
            const unsigned a2 = last ? nA : cA + (unsigned)(t + 2) * kstep, b2 = last ? nB : cB + (unsigned)(t + 2) * kstep;
            const unsigned a3 = a2 + kstep, b3 = b2 + kstep;
            PG8_LDB(B0, 0, 0); PG8_LDB(B1, 0, 1); PG8_SCHED; PG8_LDA(At, 0, 0); PG8_STAGE_A(PG8_SA(1, 1), a1, 1, parc);
            PG8_WAIT_V(8); PG8_WAIT_L(0); PG8_BAR; PG8_MMA(0, 0, At, B0); PG8_MMA(0, 1, At, B1); PG8_BAR; PG8_SCHED;
            PG8_LDA(At, 0, 1); PG8_STAGE(PG8_SB(0, 0), b2, voffB); PG8_STAGE(PG8_SB(0, 1), b2 + hstepB, voffB); PG8_STAGE_A(PG8_SA(0, 0), a2, 0, parn);
            PG8_WAIT_V(8); PG8_WAIT_L(0); PG8_BAR; PG8_MMA(1, 0, At, B0); PG8_MMA(1, 1, At, B1); PG8_BAR; PG8_SCHED;
            PG8_LDB(B0, 1, 0); PG8_LDB(B1, 1, 1); PG8_SCHED; PG8_LDA(At, 1, 0); PG8_STAGE_A(PG8_SA(0, 1), a2, 1, parn);
            PG8_WAIT_V(8); PG8_WAIT_L(0); PG8_BAR; PG8_MMA(0, 0, At, B0); PG8_MMA(0, 1, At, B1); PG8_BAR; PG8_SCHED;
            PG8_LDA(At, 1, 1); PG8_STAGE(PG8_SB(1, 0), b3, voffB); PG8_STAGE(PG8_SB(1, 1), b3 + hstepB, voffB); PG8_STAGE_A(PG8_SA(1, 0), a3, 0, parn);
            PG8_WAIT_V(8); PG8_WAIT_L(0); PG8_BAR; PG8_MMA(1, 0, At, B0); PG8_MMA(1, 1, At, B1); PG8_BAR; PG8_SCHED;
        }
        if constexpr (F8) asm volatile("s_nop 15\n\ts_nop 15" ::: "memory");
        if (wr == 0) PG8_BAR;
        { const int l2 = fresh_tid() & 63; E(acc, cur, wr, wc, l2 & 15, l2 >> 4, (const LAS float*)(lds + SIDE_OFF + (ui & 1) * 1024)); }
        if (!has_next) break;
#pragma unroll
        for (int a = 0; a < 2; ++a)
#pragma unroll
            for (int b = 0; b < 2; ++b)
#pragma unroll
                for (int m = 0; m < 4; ++m)
#pragma unroll
                    for (int n = 0; n < 2; ++n) acc[a][b][m][n] = (f32x4){0.f, 0.f, 0.f, 0.f};
        cur = nxt; cA = nA; cB = nB; ++ui;
        if (wr == 1) PG8_BAR;
        PG8_SIDE(cur, ui & 1);
    }
    PG8_WAIT_V(0);
    PG8_BAR;
#undef PG8_SA
#undef PG8_SB
#undef PG8_STAGE
#undef PG8_STAGE_A
#undef PG8_TOK
#undef PG8_SIDE
#undef hstepvoffA
#undef hstepvoffB
#undef PG8_LDA
#undef PG8_LDB
#undef PG8_MMA
#undef PG8_WAIT_V
#undef PG8_WAIT_L
#undef PG8_BAR
#undef PG8_SCHED
}
}

using pg8::Unit;

struct DenseSched {
    unsigned A, Bt; int lda, ldb, nM, nN, G, c;
    __device__ __forceinline__ bool next(int i, Unit& u) const {
        const int L = i * G + c; if (L >= nM * nN) return false;
        pg8::tile_of(L, nM, nN, u.pm, u.pn); u.aux = 0; u.to = 0;
        u.ao = A + (unsigned)u.pm * 256 * lda * 2; u.bo = Bt + (unsigned)u.pn * 256 * ldb * 2; return true;
    }
};
struct GateSched {
    unsigned XC, GT; int nM, G, c;
    __device__ __forceinline__ bool next(int i, Unit& u) const {
        const int per = nM * 4; const int L = i * G + c; if (L >= 4 * per) return false;
        const int nb = L / per; pg8::tile_of(L - nb * per, nM, 4, u.pm, u.pn); u.aux = nb; u.to = 0;
        u.ao = XC + ((unsigned)u.pm * 256 * 1024 + 256 * nb) * 2; u.bo = GT + ((unsigned)nb * 1024 + 256 * u.pn) * 256 * 2; return true;
    }
};
struct QkvSched {
    unsigned HB, WT; int nM, G, c;
    __device__ __forceinline__ bool next(int i, Unit& u) const {
        const int n0 = nM * 8, n1 = 4 * nM; const int L = i * G + c; if (L >= n0 + n1) return false; u.to = 0;
        if (L < n0) { pg8::tile_of(L, nM, 8, u.pm, u.pn); u.aux = 0; u.ao = HB + (unsigned)u.pm * 256 * 1024 * 2; u.bo = WT + (unsigned)u.pn * 256 * 1024 * 2; }
        else { pg8::tile_of(L - n0, 4, nM, u.pm, u.pn); u.aux = 1; u.ao = WT + (unsigned)(2048 + u.pm * 256) * 1024 * 2; u.bo = HB + (unsigned)u.pn * 256 * 1024 * 2; }
        return true;
    }
};
struct MoeSched {
    unsigned A, W, tok; const LAS int* texp; unsigned wstride; int nM, nN, G, c;
    __device__ __forceinline__ bool next(int i, Unit& u) const {
        const int L = i * G + c; if (L >= nM * nN) return false;
        pg8::tile_of(L, nM, nN, u.pm, u.pn);
        const int e = __builtin_amdgcn_readfirstlane(texp[u.pm]); u.aux = e;
        u.ao = tok ? A : A + (unsigned)u.pm * 256 * 1024; u.to = tok + (unsigned)u.pm * 1024; u.bo = W + (unsigned)e * wstride + (unsigned)u.pn * 256 * 1024; return true;
    }
};

#define EPI_ARGS const f32x4 (&acc)[2][2][4][2], const Unit& u, int wr, int wc, int fr, int fq, const LAS float* side
struct EpiWin {
    static constexpr bool PERM = true, SIDE = false;
    bf16_t* XR; bf16_t* GY;
    __device__ __forceinline__ void operator()(EPI_ARGS) const {
        const int row0 = u.pm * 256 + wr * 64 + fr;
        if (u.pn < 4) {
            const int col0 = u.pn * 256 + wc * 32 + 8 * fq;
#pragma unroll
            for (int ai = 0; ai < 2; ++ai)
#pragma unroll
                for (int m = 0; m < 4; ++m) { bf16_t* rowp = XR + (size_t)(row0 + ai * 128 + m * 16) * D + col0;
#pragma unroll
                    for (int bj = 0; bj < 2; ++bj) { const f32x4 v0 = acc[ai][bj][m][0], v1 = acc[ai][bj][m][1];
                        u32x4 w; w.x = cvt_pk_bf16(v0[0], v0[1]); w.y = cvt_pk_bf16(v0[2], v0[3]); w.z = cvt_pk_bf16(v1[0], v1[1]); w.w = cvt_pk_bf16(v1[2], v1[3]);
                        *(u32x4*)(rowp + bj * 128) = w; } }
        } else {
#pragma unroll
            for (int ai = 0; ai < 2; ++ai)
#pragma unroll
                for (int m = 0; m < 4; ++m) { const int row = row0 + ai * 128 + m * 16;
#pragma unroll
                    for (int bj = 0; bj < 2; ++bj) { const int g = (u.pn - 4) * 8 + bj * 4 + wc;
                        float o[8];
#pragma unroll
                        for (int n = 0; n < 2; ++n)
#pragma unroll
                            for (int j = 0; j < 4; ++j) { const float v = acc[ai][bj][m][n][j]; const float z = 1.5957691216f * (v + 0.044715f * v * v * v); o[n * 4 + j] = v * sigmoidf_(z); }
                        u32x4 w; w.x = cvt_pk_bf16(o[0], o[1]); w.y = cvt_pk_bf16(o[2], o[3]); w.z = cvt_pk_bf16(o[4], o[5]); w.w = cvt_pk_bf16(o[6], o[7]);
                        *(u32x4*)(GY + ((size_t)g * MPAD + row) * 32 + 8 * fq) = w; } }
        }
    }
};
struct EpiGate {
    static constexpr bool PERM = true, SIDE = false;
    const bf16_t* XC; bf16_t* LA; bf16_t* BB; const float* ba; const float* bx; const float* spl;
    __device__ __forceinline__ void operator()(EPI_ARGS) const {
        const int nb = u.aux, dir = u.pn >> 1, half = u.pn & 1;
        const int ch0 = 256 * nb + 128 * half + 32 * wc + 8 * fq, g = ch0 >> 5;
        const int row0 = u.pm * 256 + wr * 64 + fr;
        float cba[8], cbx[8], csp[8];
        { const f32x4 t0 = *(const f32x4*)(ba + dir * 1024 + ch0), t1 = *(const f32x4*)(ba + dir * 1024 + ch0 + 4);
          const f32x4 s0 = *(const f32x4*)(bx + dir * 1024 + ch0), s1 = *(const f32x4*)(bx + dir * 1024 + ch0 + 4);
          const f32x4 p0 = *(const f32x4*)(spl + dir * 1024 + ch0), p1 = *(const f32x4*)(spl + dir * 1024 + ch0 + 4);
#pragma unroll
          for (int j = 0; j < 4; ++j) { cba[j] = t0[j]; cba[4 + j] = t1[j]; cbx[j] = s0[j]; cbx[4 + j] = s1[j]; csp[j] = p0[j]; csp[4 + j] = p1[j]; } }
        u32x4 xnext = *(const u32x4*)(XC + (size_t)(row0 < NTOK ? row0 : 0) * D + ch0);
#pragma unroll
        for (int ai = 0; ai < 2; ++ai)
#pragma unroll
            for (int m = 0; m < 4; ++m) { const int row = row0 + ai * 128 + m * 16;
                const u32x4 xw = xnext;
                { const int it = ai * 4 + m + 1, rn = row0 + (it >> 2) * 128 + (it & 3) * 16; if (it < 8) xnext = *(const u32x4*)(XC + (size_t)(rn < NTOK ? rn : 0) * D + ch0); }
                if (row < NTOK) {
                    float xc[8] = {bflo(xw.x), bfhi(xw.x), bflo(xw.y), bfhi(xw.y), bflo(xw.z), bfhi(xw.z), bflo(xw.w), bfhi(xw.w)};
                    const bool start = dir == 0 ? (row >= NGRID && ((row - NGRID) & 15) == 0) : (row < NGRID && (row & (SEQ - 1)) == SEQ - 1);
                    float la[8], bb[8];
#pragma unroll
                    for (int n = 0; n < 2; ++n)
#pragma unroll
                        for (int j = 0; j < 4; ++j) { const int i = n * 4 + j;
                            const float ga = sigmoidf_(acc[ai][0][m][n][j] + cba[i]), gx = sigmoidf_(acc[ai][1][m][n][j] + cbx[i]);
                            const float l2 = -csp[i] * ga;
                            const float a2 = fast_exp2(2.0f * l2);
                            const float mult = start ? 1.0f : __builtin_sqrtf(fmaxf(1.0f - a2, 0.0f));
                            la[i] = l2; bb[i] = mult * gx * xc[i]; }
                    u32x4 w; w.x = cvt_pk_bf16(la[0], la[1]); w.y = cvt_pk_bf16(la[2], la[3]); w.z = cvt_pk_bf16(la[4], la[5]); w.w = cvt_pk_bf16(la[6], la[7]);
                    const size_t o = (((size_t)dir * 32 + g) * MPAD + row) * 32 + 8 * fq;
                    *(u32x4*)(LA + o) = w;
                    w.x = cvt_pk_bf16(bb[0], bb[1]); w.y = cvt_pk_bf16(bb[2], bb[3]); w.z = cvt_pk_bf16(bb[4], bb[5]); w.w = cvt_pk_bf16(bb[6], bb[7]);
                    *(u32x4*)(BB + o) = w;
                } }
    }
};
template <bool LAYER0> struct EpiRes {
    static constexpr bool PERM = true, SIDE = false;
    bf16_t* PRE; const float* x; const float* meta; const bf16_t* HB; int nrows;
    __device__ __forceinline__ void operator()(EPI_ARGS) const {
        const int row0 = u.pm * 256 + wr * 64 + fr, col0 = u.pn * 256 + wc * 32 + 8 * fq;
#pragma unroll
        for (int ai = 0; ai < 2; ++ai)
#pragma unroll
            for (int m = 0; m < 4; ++m) { const int row = row0 + ai * 128 + m * 16;
                if (row < nrows) {
#pragma unroll
                    for (int bj = 0; bj < 2; ++bj) { const int c = col0 + bj * 128; float r[8];
                        if (LAYER0) { const float* rp = (row < NGRID ? x + (size_t)row * D : meta + (size_t)((row - NGRID) & 15) * D) + c; const f32x4 r0 = *(const f32x4*)rp, r1 = *(const f32x4*)(rp + 4);
                            r[0] = r0[0]; r[1] = r0[1]; r[2] = r0[2]; r[3] = r0[3]; r[4] = r1[0]; r[5] = r1[1]; r[6] = r1[2]; r[7] = r1[3]; }
                        else { const u32x4 rw = *(const u32x4*)(HB + (size_t)row * D + c); r[0] = bflo(rw.x); r[1] = bfhi(rw.x); r[2] = bflo(rw.y); r[3] = bfhi(rw.y); r[4] = bflo(rw.z); r[5] = bfhi(rw.z); r[6] = bflo(rw.w); r[7] = bfhi(rw.w); }
                        const f32x4 a0 = acc[ai][bj][m][0], a1 = acc[ai][bj][m][1];
                        u32x4 w; w.x = cvt_pk_bf16(r[0] * DN_ALPHA + a0[0], r[1] * DN_ALPHA + a0[1]); w.y = cvt_pk_bf16(r[2] * DN_ALPHA + a0[2], r[3] * DN_ALPHA + a0[3]);
                        w.z = cvt_pk_bf16(r[4] * DN_ALPHA + a1[0], r[5] * DN_ALPHA + a1[1]); w.w = cvt_pk_bf16(r[6] * DN_ALPHA + a1[2], r[7] * DN_ALPHA + a1[3]);
                        *(u32x4*)(PRE + (size_t)row * D + c) = w; }
                }
                asm volatile("" ::: "memory"); }
    }
};
struct EpiGlu {
    static constexpr bool PERM = true, SIDE = true; static constexpr int SCALES = 0x7F79;
    unsigned char* ACT; unsigned bias_off;
    __device__ __forceinline__ unsigned side_off(const Unit& u) const { return bias_off + (unsigned)((u.aux * 8 + u.pn) * 1024); }
    __device__ __forceinline__ void operator()(EPI_ARGS) const {
        const int f0 = 128 * u.pn + 32 * wc + 8 * fq;
        float bg[8], bl[8];
        { const LAS float* p = side + 32 * wc + 8 * fq; const f32x4 a0 = *(const LAS f32x4*)p, a1 = *(const LAS f32x4*)(p + 4), c0 = *(const LAS f32x4*)(p + 128), c1 = *(const LAS f32x4*)(p + 132);
#pragma unroll
          for (int j = 0; j < 4; ++j) { bg[j] = a0[j]; bg[4 + j] = a1[j]; bl[j] = c0[j]; bl[4 + j] = c1[j]; } }
        const int row0 = u.pm * 256 + wr * 64 + fr;
#pragma unroll
        for (int ai = 0; ai < 2; ++ai)
#pragma unroll
            for (int m = 0; m < 4; ++m) { const int row = row0 + ai * 128 + m * 16; float o[8];
#pragma unroll
                for (int n = 0; n < 2; ++n)
#pragma unroll
                    for (int j = 0; j < 4; ++j) { const int i = n * 4 + j;
                        const float glu = fminf(acc[ai][0][m][n][j] + bg[i], 7.0f);
                        const float lin = fminf(fmaxf(acc[ai][1][m][n][j] + bl[i], -7.0f), 7.0f);
                        o[i] = glu * sigmoidf_(1.702f * glu) * (lin + 1.0f); }
                u32x2 w; w.x = pk4_fp8(o[0] * 4.0f, o[1] * 4.0f, o[2] * 4.0f, o[3] * 4.0f); w.y = pk4_fp8(o[4] * 4.0f, o[5] * 4.0f, o[6] * 4.0f, o[7] * 4.0f);
                *(u32x2*)(ACT + (size_t)row * D + f0) = w; }
    }
};
struct EpiNull {
    static constexpr bool PERM = true, SIDE = false; static constexpr int SCALES = 0x7F79;
    __device__ __forceinline__ void operator()(EPI_ARGS) const {
#pragma unroll
        for (int ai = 0; ai < 2; ++ai)
#pragma unroll
            for (int bj = 0; bj < 2; ++bj)
#pragma unroll
                for (int m = 0; m < 4; ++m)
#pragma unroll
                    for (int n = 0; n < 2; ++n) asm volatile("" :: "v"(acc[ai][bj][m][n]));
    }
};
struct EpiDown {
    static constexpr bool PERM = true, SIDE = true; static constexpr int SCALES = 0x7D79;
    bf16_t* YS; unsigned bias_off;
    __device__ __forceinline__ unsigned side_off(const Unit& u) const { return bias_off + (unsigned)((u.aux * 4 + u.pn) * 1024); }
    __device__ __forceinline__ void operator()(EPI_ARGS) const {
        const int row0 = u.pm * 256 + wr * 64 + fr, col0 = u.pn * 256 + wc * 32 + 8 * fq;
        f32x4 bv[2][2];
#pragma unroll
        for (int bj = 0; bj < 2; ++bj)
#pragma unroll
            for (int n = 0; n < 2; ++n) bv[bj][n] = *(const LAS f32x4*)(side + wc * 32 + 8 * fq + bj * 128 + 4 * n);
#pragma unroll
        for (int ai = 0; ai < 2; ++ai)
#pragma unroll
            for (int m = 0; m < 4; ++m) { bf16_t* rowp = YS + (size_t)(row0 + ai * 128 + m * 16) * D + col0;
#pragma unroll
                for (int bj = 0; bj < 2; ++bj) { const f32x4 v0 = acc[ai][bj][m][0] + bv[bj][0], v1 = acc[ai][bj][m][1] + bv[bj][1];
                    u32x4 w; w.x = cvt_pk_bf16(v0[0], v0[1]); w.y = cvt_pk_bf16(v0[2], v0[3]); w.z = cvt_pk_bf16(v1[0], v1[1]); w.w = cvt_pk_bf16(v1[2], v1[3]);
                    *(u32x4*)(rowp + bj * 128) = w; } }
    }
};
struct EpiQkv {
    static constexpr bool PERM = true, SIDE = false;
    bf16_t* Q; bf16_t* Kx; bf16_t* VT;
    __device__ __forceinline__ void operator()(EPI_ARGS) const {
        const int row0 = u.pm * 256 + wr * 64 + fr; bf16_t* base; int ldc, colt; float sc = 1.0f;
        if (u.aux == 0) { ldc = D; if (u.pn < 4) { base = Q; colt = u.pn * 256; sc = 0.125f * 1.44269504089f; } else { base = Kx; colt = (u.pn - 4) * 256; } }
        else { base = VT; ldc = MPAD; colt = u.pn * 256; }
        const int col0 = colt + wc * 32 + 8 * fq;
#pragma unroll
        for (int ai = 0; ai < 2; ++ai)
#pragma unroll
            for (int m = 0; m < 4; ++m) { bf16_t* rowp = base + (size_t)(row0 + ai * 128 + m * 16) * ldc + col0;
#pragma unroll
                for (int bj = 0; bj < 2; ++bj) { const f32x4 v0 = acc[ai][bj][m][0] * sc, v1 = acc[ai][bj][m][1] * sc;
                    u32x4 w; w.x = cvt_pk_bf16(v0[0], v0[1]); w.y = cvt_pk_bf16(v0[2], v0[3]); w.z = cvt_pk_bf16(v1[0], v1[1]); w.w = cvt_pk_bf16(v1[2], v1[3]);
                    *(u32x4*)(rowp + bj * 128) = w; } }
    }
};

__device__ __forceinline__ void tr_item(const float* W, int ld, int kb, int n0, bf16_t* dst0, int K, LAS float* scr, int lane) {
    const int r = lane >> 4, q = lane & 15;
    f32x4 v[16];
#pragma unroll
    for (int i = 0; i < 16; ++i) v[i] = __builtin_nontemporal_load((const f32x4*)(W + (size_t)(64 * kb + 4 * i + r) * ld + n0 + 4 * q));
#pragma unroll
    for (int i = 0; i < 16; ++i) { LAS float* s = scr + (4 * i + r) * 65 + 4 * q; s[0] = v[i][0]; s[1] = v[i][1]; s[2] = v[i][2]; s[3] = v[i][3]; }
    asm volatile("s_waitcnt lgkmcnt(0)" ::: "memory");
    const int c = lane & 7, nn = lane >> 3;
#pragma unroll
    for (int j = 0; j < 8; ++j) { const int n = nn + 8 * j; const LAS float* s = scr + (8 * c) * 65 + n;
        u32x4 o; o.x = pk2(s[0], s[65]); o.y = pk2(s[2 * 65], s[3 * 65]); o.z = pk2(s[4 * 65], s[5 * 65]); o.w = pk2(s[6 * 65], s[7 * 65]);
        *(u32x4*)(dst0 + (size_t)n * K + 64 * kb + 8 * c) = o; }
    asm volatile("s_waitcnt lgkmcnt(0)" ::: "memory");
}
__device__ __forceinline__ void tr_item8(const float* W, int ld, int kb, int n0, unsigned char* dst0, int K, LAS float* scr, int lane) {
    const int r = lane >> 4, q = lane & 15;
    f32x4 v[16];
#pragma unroll
    for (int i = 0; i < 16; ++i) v[i] = __builtin_nontemporal_load((const f32x4*)(W + (size_t)(64 * kb + 4 * i + r) * ld + n0 + 4 * q));
#pragma unroll
    for (int i = 0; i < 16; ++i) { LAS float* s = scr + (4 * i + r) * 65 + 4 * q; s[0] = v[i][0]; s[1] = v[i][1]; s[2] = v[i][2]; s[3] = v[i][3]; }
    asm volatile("s_waitcnt lgkmcnt(0)" ::: "memory");
    const int c = lane & 7, nn = lane >> 3;
#pragma unroll
    for (int j = 0; j < 8; ++j) { const int n = nn + 8 * j; const LAS float* s = scr + (8 * c) * 65 + n;
        u32x2 o; o.x = pk4_fp8(s[0] * 64.0f, s[65] * 64.0f, s[2 * 65] * 64.0f, s[3 * 65] * 64.0f); o.y = pk4_fp8(s[4 * 65] * 64.0f, s[5 * 65] * 64.0f, s[6 * 65] * 64.0f, s[7 * 65] * 64.0f);
        *(u32x2*)(dst0 + (size_t)n * K + 64 * kb + 8 * c) = o; }
    asm volatile("s_waitcnt lgkmcnt(0)" ::: "memory");
}
__device__ __forceinline__ void phase_convert(const Ctx& C) {
    PHASE_IDS
    LAS float* scr = (LAS float*)(C.lds + wave * 16640);
    const int gw = C.bid * NWAVES + wave, NGW = C.G * NWAVES;
    constexpr int I0 = 512, I1 = 256, I2 = 256, I3 = 768, I4 = 256, I5 = 32768, I6 = 16384, NIT = I0 + I1 + I2 + I3 + I4 + I5 + I6;
    for (int it = gw; it < NIT; it += NGW) {
        int r = it;
        if (r < I0) { const int nbk = r & 31, kb = r >> 5; tr_item(C.in[I_WIN], 2048, kb, 64 * nbk, (bf16_t*)(wsl + WS_WIN) + (size_t)(64 * nbk) * 1024, 1024, scr, lane); continue; } r -= I0;
        if (r < I1) { const int job = r >> 3, sub = r & 7, nbk = sub & 1, kb = sub >> 1;
            const int half = job & 1, which = (job >> 1) & 1, nb = (job >> 2) & 3, dir = job >> 4;
            const float* src = C.in[which ? I_WX : I_WA] + (size_t)(dir * 4 + nb) * 65536;
            bf16_t* dst = (bf16_t*)(wsl + WS_GATE) + ((size_t)nb * 1024 + 256 * (2 * dir + half) + 128 * which + 64 * nbk) * 256;
            tr_item(src, 256, kb, 128 * half + 64 * nbk, dst, 256, scr, lane); continue; } r -= I1;
        if (r < I2) { const int nbk = r & 15, kb = r >> 4; tr_item(C.in[I_LOUT], 1024, kb, 64 * nbk, (bf16_t*)(wsl + WS_LOUT) + (size_t)(64 * nbk) * 1024, 1024, scr, lane); continue; } r -= I2;
        if (r < I3) { const int nbk = r % 48, kb = r / 48; tr_item(C.in[I_WQKV], 3072, kb, 64 * nbk, (bf16_t*)(wsl + WS_QKV) + (size_t)(64 * nbk) * 1024, 1024, scr, lane); continue; } r -= I3;
        if (r < I4) { const int nbk = r & 15, kb = r >> 4; tr_item(C.in[I_NOUT], 1024, kb, 64 * nbk, (bf16_t*)(wsl + WS_NOUT) + (size_t)(64 * nbk) * 1024, 1024, scr, lane); continue; } r -= I4;
        if (r < I5) { const int mat = r >> 9, sub = r & 511, nbk = sub & 31, kb = sub >> 5; const int n0 = 64 * nbk, bj = n0 >> 10, f0 = n0 & 1023, pn = f0 >> 7, jj = f0 & 127;
            tr_item8(C.in[I_WGU] + (size_t)mat * 1024 * 2048, 2048, kb, n0, (unsigned char*)(wsl + WS_WGU) + ((size_t)mat * 2048 + 256 * pn + 128 * bj + jj) * 1024, 1024, scr, lane); continue; } r -= I5;
        { const int mat = r >> 8, sub = r & 255, nbk = sub & 15, kb = sub >> 4;
            tr_item8(C.in[I_WD] + (size_t)mat * 1024 * 1024, 1024, kb, 64 * nbk, (unsigned char*)(wsl + WS_WD) + ((size_t)mat * 1024 + 64 * nbk) * 1024, 1024, scr, lane); }
    }
    const int gt = C.bid * NTHREADS + tid, NGT = C.G * NTHREADS;
    for (int i = gt; i < 2048; i += NGT) ((float*)(wsl + WS_CTL + CT_SPL))[i] = 8.0f * 1.44269504089f * log1pf(expf(-C.in[I_LAM][i]));
    for (int i = gt; i < 2 * 32 * 2048; i += NGT) { const int le = i >> 11, r = i & 2047, pn = r >> 8, bj = (r >> 7) & 1, ii = r & 127;
        ((float*)(wsl + WS_BIAS))[i] = C.in[I_BGU][(size_t)le * 2048 + bj * 1024 + 128 * pn + ii]; }
    for (int i = gt; i < 2 * 32 * 1024; i += NGT) ((float*)(wsl + WS_BD))[i] = C.in[I_BD][i];
    for (int i = gt; i < NTOK * 128; i += NGT) { const int row = i >> 7, oc = i & 127;
        const float* src = (row < NGRID ? C.in[I_X] + (size_t)row * D : C.in[I_META] + (size_t)((row - NGRID) & 15) * D) + 8 * oc;
        const f32x4 a = *(const f32x4*)src, b = *(const f32x4*)(src + 4);
        u32x4 w; w.x = pk2(a[0], a[1]); w.y = pk2(a[2], a[3]); w.z = pk2(b[0], b[1]); w.w = pk2(b[2], b[3]);
        *(u32x4*)((bf16_t*)(wsl + WS_HB) + (size_t)row * D + 8 * oc) = w; }
}

__device__ __forceinline__ void phase_conv(const Ctx& C) {
    PHASE_IDS
    const bf16_t* XR = (const bf16_t*)(wsl + WS_XR); bf16_t* XC = (bf16_t*)(wsl + WS_XC);
    const float* cw = C.in[I_CONVW]; const float* cb = C.in[I_CONVB];
    const int gt = C.bid * NTHREADS + tid, NGT = C.G * NTHREADS;
    for (int i = gt; i < NTOK * 128; i += NGT) { const int row = i >> 7, ch = 8 * (i & 127);
        int b, s; if (row < NGRID) { b = row >> 12; s = NMETA + (row & (SEQ - 1)); } else { b = (row - NGRID) >> 4; s = (row - NGRID) & 15; }
        float a[8];
        { const f32x4 t0 = *(const f32x4*)(cb + ch), t1 = *(const f32x4*)(cb + ch + 4);
#pragma unroll
          for (int j = 0; j < 4; ++j) { a[j] = t0[j]; a[4 + j] = t1[j]; } }
#pragma unroll
        for (int j = 0; j < 4; ++j) { const int sj = s - 2 + j;
            if (sj >= 0 && sj < LSEQ) { const u32x4 xw = *(const u32x4*)(XR + (size_t)seqrow(b, sj) * D + ch);
                const f32x4 w0 = *(const f32x4*)(cw + j * 1024 + ch), w1 = *(const f32x4*)(cw + j * 1024 + ch + 4);
                a[0] += w0[0] * bflo(xw.x); a[1] += w0[1] * bfhi(xw.x); a[2] += w0[2] * bflo(xw.y); a[3] += w0[3] * bfhi(xw.y);
                a[4] += w1[0] * bflo(xw.z); a[5] += w1[1] * bfhi(xw.z); a[6] += w1[2] * bflo(xw.w); a[7] += w1[3] * bfhi(xw.w); } }
        u32x4 w; w.x = pk2(a[0], a[1]); w.y = pk2(a[2], a[3]); w.z = pk2(a[4], a[5]); w.w = pk2(a[6], a[7]);
        *(u32x4*)(XC + (size_t)row * D + ch) = w; }
}

template <int N> __device__ __forceinline__ float dpp_shr(float oldv, float v) {
    return __builtin_bit_cast(float, __builtin_amdgcn_update_dpp(__builtin_bit_cast(int, oldv), __builtin_bit_cast(int, v), 0x110 + N, 0xf, 0xf, false));
}
__device__ __forceinline__ void scan_group(float (&a)[8], float (&b)[8]) {
#pragma unroll
    for (int c = 0; c < 8; ++c) {
        { const float ap = dpp_shr<1>(1.0f, a[c]), bp = dpp_shr<1>(0.0f, b[c]); b[c] = a[c] * bp + b[c]; a[c] = a[c] * ap; }
        { const float ap = dpp_shr<2>(1.0f, a[c]), bp = dpp_shr<2>(0.0f, b[c]); b[c] = a[c] * bp + b[c]; a[c] = a[c] * ap; }
        { const float ap = dpp_shr<4>(1.0f, a[c]), bp = dpp_shr<4>(0.0f, b[c]); b[c] = a[c] * bp + b[c]; a[c] = a[c] * ap; }
        { const float ap = dpp_shr<8>(1.0f, a[c]), bp = dpp_shr<8>(0.0f, b[c]); b[c] = a[c] * bp + b[c]; a[c] = a[c] * ap; }
    }
}
__device__ __forceinline__ void unpack8(const u32x4 w, float (&o)[8]) { o[0] = bflo(w.x); o[1] = bfhi(w.x); o[2] = bflo(w.y); o[3] = bfhi(w.y); o[4] = bflo(w.z); o[5] = bfhi(w.z); o[6] = bflo(w.w); o[7] = bfhi(w.w); }
__device__ __forceinline__ void phase_scan(const Ctx& C) {
    PHASE_IDS
    const bf16_t* LA = (const bf16_t*)(wsl + WS_LA); const bf16_t* BB = (const bf16_t*)(wsl + WS_BB); const bf16_t* GY = (const bf16_t*)(wsl + WS_GY);
    bf16_t* HF = (bf16_t*)(wsl + WS_HF); bf16_t* Gout = (bf16_t*)(wsl + WS_G);
    LAS float* agg = (LAS float*)C.lds;
    const int w = wave, oct = lane >> 4, p = lane & 15;
    for (int item = C.bid; item < NB * 32; item += C.G) {
        const int b = item >> 5, g = item & 31;
        for (int dir = 0; dir < 2; ++dir) {
            const bf16_t* la = LA + (((size_t)dir * 32 + g) * MPAD) * 32 + 8 * oct;
            const bf16_t* bb = BB + (((size_t)dir * 32 + g) * MPAD) * 32 + 8 * oct;
            float S[8];
#pragma unroll
            for (int c = 0; c < 8; ++c) S[c] = 0.f;
            {
                const int u = p, s = dir ? LSEQ - 1 - u : u, row = seqrow(b, s);
                float a[8], x[8]; unpack8(*(const u32x4*)(la + (size_t)row * 32), a); unpack8(*(const u32x4*)(bb + (size_t)row * 32), x);
#pragma unroll
                for (int c = 0; c < 8; ++c) a[c] = fast_exp2(a[c]);
                scan_group(a, x);
                if (w == 0) {
                    if (dir == 0) { u32x4 o; o.x = pk2(x[0], x[1]); o.y = pk2(x[2], x[3]); o.z = pk2(x[4], x[5]); o.w = pk2(x[6], x[7]); *(u32x4*)(HF + ((size_t)g * MPAD + row) * 32 + 8 * oct) = o; }
                    else { float hf[8], gy[8]; unpack8(*(const u32x4*)(HF + ((size_t)g * MPAD + row) * 32 + 8 * oct), hf); unpack8(*(const u32x4*)(GY + ((size_t)g * MPAD + row) * 32 + 8 * oct), gy);
                        u32x4 o; o.x = pk2((hf[0] + x[0]) * gy[0], (hf[1] + x[1]) * gy[1]); o.y = pk2((hf[2] + x[2]) * gy[2], (hf[3] + x[3]) * gy[3]);
                        o.z = pk2((hf[4] + x[4]) * gy[4], (hf[5] + x[5]) * gy[5]); o.w = pk2((hf[6] + x[6]) * gy[6], (hf[7] + x[7]) * gy[7]);
                        *(u32x4*)(Gout + (size_t)row * D + 32 * g + 8 * oct) = o; }
                }
#pragma unroll
                for (int c = 0; c < 8; ++c) S[c] = __shfl(x[c], (lane & 48) | 15);
            }
            for (int r = 0; r < 8; ++r) {
                float Pw[4][8], Hw[4][8]; int rows[4];
                float Aw[8], Hc[8];
#pragma unroll
                for (int c = 0; c < 8; ++c) { Aw[c] = 1.f; Hc[c] = 0.f; }
                u32x4 ra[4], rb[4];
#pragma unroll
                for (int j = 0; j < 4; ++j) { const int u = 16 + 512 * r + 64 * w + 16 * j + p, s = dir ? LSEQ - 1 - u : u; rows[j] = seqrow(b, s);
                    ra[j] = *(const u32x4*)(la + (size_t)rows[j] * 32); rb[j] = *(const u32x4*)(bb + (size_t)rows[j] * 32); }
#pragma unroll
                for (int j = 0; j < 4; ++j) {
                    float a[8], x[8]; unpack8(ra[j], a); unpack8(rb[j], x);
#pragma unroll
                    for (int c = 0; c < 8; ++c) a[c] = fast_exp2(a[c]);
                    scan_group(a, x);
#pragma unroll
                    for (int c = 0; c < 8; ++c) { Hw[j][c] = a[c] * Hc[c] + x[c]; Pw[j][c] = a[c] * Aw[c]; }
#pragma unroll
                    for (int c = 0; c < 8; ++c) { Aw[c] = __shfl(Pw[j][c], (lane & 48) | 15); Hc[c] = __shfl(Hw[j][c], (lane & 48) | 15); }
                }
                LAS float* ag = agg + (r & 1) * 512;
                if (p == 0) {
#pragma unroll
                    for (int c = 0; c < 8; ++c) { ag[(w * 32 + oct * 8 + c) * 2] = Aw[c]; ag[(w * 32 + oct * 8 + c) * 2 + 1] = Hc[c]; }
                }
                __syncthreads();
                float Sin[8];
#pragma unroll
                for (int c = 0; c < 8; ++c) Sin[c] = S[c];
#pragma unroll
                for (int ww = 0; ww < 8; ++ww) {
#pragma unroll
                    for (int c = 0; c < 8; ++c) { const float A = ag[(ww * 32 + oct * 8 + c) * 2], H = ag[(ww * 32 + oct * 8 + c) * 2 + 1];
                        if (ww == w) Sin[c] = S[c];
                        S[c] = A * S[c] + H; }
                }
#pragma unroll
                for (int j = 0; j < 4; ++j) {
                    float h[8];
#pragma unroll
                    for (int c = 0; c < 8; ++c) h[c] = Pw[j][c] * Sin[c] + Hw[j][c];
                    const size_t go = ((size_t)g * MPAD + rows[j]) * 32 + 8 * oct;
                    if (dir == 0) { u32x4 o; o.x = pk2(h[0], h[1]); o.y = pk2(h[2], h[3]); o.z = pk2(h[4], h[5]); o.w = pk2(h[6], h[7]); *(u32x4*)(HF + go) = o; }
                    else { float hf[8], gy[8]; unpack8(*(const u32x4*)(HF + go), hf); unpack8(*(const u32x4*)(GY + go), gy);
                        u32x4 o; o.x = pk2((hf[0] + h[0]) * gy[0], (hf[1] + h[1]) * gy[1]); o.y = pk2((hf[2] + h[2]) * gy[2], (hf[3] + h[3]) * gy[3]);
                        o.z = pk2((hf[4] + h[4]) * gy[4], (hf[5] + h[5]) * gy[5]); o.w = pk2((hf[6] + h[6]) * gy[6], (hf[7] + h[7]) * gy[7]);
                        *(u32x4*)(Gout + (size_t)rows[j] * D + 32 * g + 8 * oct) = o; }
                }
            }
            __syncthreads();
        }
    }
}

template <int K> __device__ __forceinline__ f32x4 mini_mma(const bf16_t* W, int ldw, const bf16_t* A, int lda, int lane) {
    const bf16_t* wp = W + (size_t)(lane & 15) * ldw + 8 * (lane >> 4); const bf16_t* ap = A + (size_t)(lane & 15) * lda + 8 * (lane >> 4);
    f32x4 acc = {0.f, 0.f, 0.f, 0.f};
    constexpr int KB = K < 512 ? K : 512, NS = KB / 32;
#pragma unroll 1
    for (int k0 = 0; k0 < K; k0 += KB) { bf16x8 wf[NS], af[NS];
#pragma unroll
        for (int i = 0; i < NS; ++i) { wf[i] = *(const bf16x8*)(wp + k0 + 32 * i); af[i] = *(const bf16x8*)(ap + k0 + 32 * i); }
#pragma unroll
        for (int i = 0; i < NS; ++i) acc = __builtin_amdgcn_mfma_f32_16x16x32_bf16(wf[i], af[i], acc, 0, 0, 0); }
    return acc;
}
__device__ __forceinline__ void mini_win(const Ctx& C) {
    PHASE_IDS
    const bf16_t* HB = (const bf16_t*)(C.ws + WS_HB); const bf16_t* WT = (const bf16_t*)(C.ws + WS_WIN); bf16_t* XR = (bf16_t*)(C.ws + WS_XR); bf16_t* GY = (bf16_t*)(C.ws + WS_GY);
    const int fr = lane & 15, fq = lane >> 4;
    for (int wt = C.gc * NWAVES + wave; wt < 8 * 128; wt += C.G * NWAVES) { const int rg = wt & 7, cb = wt >> 3, row = NGRID + 16 * rg + fr, c = 16 * cb + 4 * fq;
        const f32x4 a = mini_mma<1024>(WT + (size_t)(16 * cb) * 1024, 1024, HB + (size_t)(NGRID + 16 * rg) * 1024, 1024, lane);
        if (c < 1024) { u32x2 w; w.x = cvt_pk_bf16(a[0], a[1]); w.y = cvt_pk_bf16(a[2], a[3]); *(u32x2*)(XR + (size_t)row * D + c) = w; }
        else { const int yc = c - 1024; float o[4];
#pragma unroll
            for (int j = 0; j < 4; ++j) { const float v = a[j]; const float z = 1.5957691216f * (v + 0.044715f * v * v * v); o[j] = v * sigmoidf_(z); }
            u32x2 w; w.x = cvt_pk_bf16(o[0], o[1]); w.y = cvt_pk_bf16(o[2], o[3]); *(u32x2*)(GY + ((size_t)(yc >> 5) * MPAD + row) * 32 + (yc & 31)) = w; } }
}
__device__ __forceinline__ void mini_gate(const Ctx& C) {
    PHASE_IDS
    const bf16_t* XC = (const bf16_t*)(C.ws + WS_XC); const bf16_t* GT = (const bf16_t*)(C.ws + WS_GATE); bf16_t* LA = (bf16_t*)(C.ws + WS_LA); bf16_t* BB = (bf16_t*)(C.ws + WS_BB);
    const float* ba = C.in[I_BA]; const float* bx = C.in[I_BX]; const float* spl = (const float*)(C.ws + WS_CTL + CT_SPL);
    const int fr = lane & 15, fq = lane >> 4;
    for (int wt = C.gc * NWAVES + wave; wt < 8 * 2 * 64; wt += C.G * NWAVES) { const int rg = wt & 7, dir = (wt >> 3) & 1, chg = wt >> 4, ch0 = 16 * chg, nb = ch0 >> 8, half = (ch0 >> 7) & 1, jj0 = ch0 & 127;
        const bf16_t* A = XC + (size_t)(NGRID + 16 * rg) * 1024 + 256 * nb; const bf16_t* Wa = GT + ((size_t)nb * 1024 + 256 * (2 * dir + half) + jj0) * 256;
        const f32x4 za = mini_mma<256>(Wa, 256, A, 1024, lane), zx = mini_mma<256>(Wa + 128 * 256, 256, A, 1024, lane);
        const int row = NGRID + 16 * rg + fr, ch = ch0 + 4 * fq;
        const f32x4 cba = *(const f32x4*)(ba + dir * 1024 + ch), cbx = *(const f32x4*)(bx + dir * 1024 + ch), csp = *(const f32x4*)(spl + dir * 1024 + ch);
        const u32x2 xw = *(const u32x2*)(XC + (size_t)row * D + ch); const float xc[4] = {bflo(xw.x), bfhi(xw.x), bflo(xw.y), bfhi(xw.y)};
        const bool start = dir == 0 && fr == 0;
        float la[4], bb[4];
#pragma unroll
        for (int j = 0; j < 4; ++j) { const float ga = sigmoidf_(za[j] + cba[j]), gx = sigmoidf_(zx[j] + cbx[j]); const float l2 = -csp[j] * ga; const float a2 = fast_exp2(2.0f * l2);
            const float mult = start ? 1.0f : __builtin_sqrtf(fmaxf(1.0f - a2, 0.0f)); la[j] = l2; bb[j] = mult * gx * xc[j]; }
        const size_t o = (((size_t)dir * 32 + (ch >> 5)) * MPAD + row) * 32 + (ch & 31);
        u32x2 w; w.x = cvt_pk_bf16(la[0], la[1]); w.y = cvt_pk_bf16(la[2], la[3]); *(u32x2*)(LA + o) = w;
        w.x = cvt_pk_bf16(bb[0], bb[1]); w.y = cvt_pk_bf16(bb[2], bb[3]); *(u32x2*)(BB + o) = w; }
}
__device__ __forceinline__ void mini_lout(const Ctx& C) {
    PHASE_IDS
    const bf16_t* G = (const bf16_t*)(C.ws + WS_G); const bf16_t* WT = (const bf16_t*)(C.ws + WS_LOUT); bf16_t* PRE = (bf16_t*)(C.ws + WS_PRE); const float* meta = C.in[I_META];
    const int fr = lane & 15, fq = lane >> 4;
    for (int wt = C.gc * NWAVES + wave; wt < 8 * 64; wt += C.G * NWAVES) { const int rg = wt & 7, cb = wt >> 3, row = NGRID + 16 * rg + fr, c = 16 * cb + 4 * fq;
        const f32x4 a = mini_mma<1024>(WT + (size_t)(16 * cb) * 1024, 1024, G + (size_t)(NGRID + 16 * rg) * 1024, 1024, lane);
        const f32x4 r = *(const f32x4*)(meta + (size_t)fr * D + c);
        u32x2 w; w.x = cvt_pk_bf16(r[0] * DN_ALPHA + a[0], r[1] * DN_ALPHA + a[1]); w.y = cvt_pk_bf16(r[2] * DN_ALPHA + a[2], r[3] * DN_ALPHA + a[3]); *(u32x2*)(PRE + (size_t)row * D + c) = w; }
}
__device__ __forceinline__ void mini_kv(const Ctx& C) {
    PHASE_IDS
    const bf16_t* HB = (const bf16_t*)(C.ws + WS_HB); const bf16_t* WT = (const bf16_t*)(C.ws + WS_QKV); bf16_t* Kx = (bf16_t*)(C.ws + WS_K); bf16_t* VT = (bf16_t*)(C.ws + WS_VT);
    const int fr = lane & 15, fq = lane >> 4;
    for (int wt = C.gc * NWAVES + wave; wt < 2 * 8 * 64; wt += C.G * NWAVES) { const int rg = wt & 7, cb = (wt >> 3) & 63, isv = wt >> 9;
        const bf16_t* A = HB + (size_t)(NGRID + 16 * rg) * 1024;
        if (!isv) { const f32x4 a = mini_mma<1024>(WT + (size_t)(1024 + 16 * cb) * 1024, 1024, A, 1024, lane);
            u32x2 w; w.x = cvt_pk_bf16(a[0], a[1]); w.y = cvt_pk_bf16(a[2], a[3]); *(u32x2*)(Kx + (size_t)(NGRID + 16 * rg + fr) * D + 16 * cb + 4 * fq) = w; }
        else { const f32x4 a = mini_mma<1024>(A, 1024, WT + (size_t)(2048 + 16 * cb) * 1024, 1024, lane);
            u32x2 w; w.x = cvt_pk_bf16(a[0], a[1]); w.y = cvt_pk_bf16(a[2], a[3]); *(u32x2*)(VT + (size_t)(16 * cb + fr) * MPAD + NGRID + 16 * rg + 4 * fq) = w; } }
}

constexpr int RWT_PITCH = 1028;
__device__ __forceinline__ void phase_lnr(const Ctx& C, int layer, int nrows) {
    PHASE_IDS
    const bf16_t* PRE = (const bf16_t*)(wsl + WS_PRE); bf16_t* HB = (bf16_t*)(wsl + WS_HB); unsigned char* HB8 = wsl + WS_HB8;
    const float* lg = C.in[I_LNMG] + layer * D; const float* lb = C.in[I_LNMB] + layer * D;
    const float* rw = C.in[I_RW] + (size_t)layer * D * NEXP; const float* rb = C.in[I_RB] + layer * NEXP;
    int* eid = (int*)(wsl + WS_CTL + CT_EID) + (size_t)layer * NTOK * 4; float* gatev = (float*)(wsl + WS_CTL + CT_GATEV) + (size_t)layer * NTOK * 4;
    unsigned* bc = (unsigned*)(wsl + WS_CTL + CT_BC) + ((size_t)layer * 256 + C.bid) * 32;
    LAS float* RWt = (LAS float*)C.lds; LAS unsigned* hist = (LAS unsigned*)(C.lds + 32 * RWT_PITCH * 4);
    { f32x4 wv[16];
#pragma unroll
      for (int i = 0; i < 16; ++i) wv[i] = *(const f32x4*)(rw + 4 * (tid + NTHREADS * i));
#pragma unroll
      for (int i = 0; i < 16; ++i) { const int idx4 = tid + NTHREADS * i, ch = idx4 >> 3, e4 = (idx4 & 7) * 4;
          const int c = 4 * ((ch & 511) >> 3) + 256 * (2 * (ch >> 9) + ((ch >> 2) & 1)) + (ch & 3);
          RWt[(e4 + 0) * RWT_PITCH + c] = wv[i][0]; RWt[(e4 + 1) * RWT_PITCH + c] = wv[i][1]; RWt[(e4 + 2) * RWT_PITCH + c] = wv[i][2]; RWt[(e4 + 3) * RWT_PITCH + c] = wv[i][3]; } }
    if (tid < 32) hist[tid] = 0u;
    __syncthreads();
    float gg[2][8], gb[2][8];
#pragma unroll
    for (int j = 0; j < 2; ++j) { const f32x4 a0 = *(const f32x4*)(lg + 8 * lane + 512 * j), a1 = *(const f32x4*)(lg + 8 * lane + 512 * j + 4), b0 = *(const f32x4*)(lb + 8 * lane + 512 * j), b1 = *(const f32x4*)(lb + 8 * lane + 512 * j + 4);
#pragma unroll
        for (int i = 0; i < 4; ++i) { gg[j][i] = a0[i]; gg[j][4 + i] = a1[i]; gb[j][i] = b0[i]; gb[j][4 + i] = b1[i]; } }
    const float rbias = rb[lane >> 1];
    const int gw = C.bid * NWAVES + wave, NGW = C.G * NWAVES;
    u32x4 nv[2];
    if (gw < nrows) {
#pragma unroll
        for (int j = 0; j < 2; ++j) nv[j] = *(const u32x4*)(PRE + (size_t)gw * D + 8 * lane + 512 * j); }
    for (int row = gw; row < nrows; row += NGW) {
        float v[2][8]; float s = 0.f;
#pragma unroll
        for (int j = 0; j < 2; ++j) { unpack8(nv[j], v[j]); s += ((v[j][0] + v[j][1]) + (v[j][2] + v[j][3])) + ((v[j][4] + v[j][5]) + (v[j][6] + v[j][7])); }
        if (row + NGW < nrows) {
#pragma unroll
            for (int j = 0; j < 2; ++j) nv[j] = *(const u32x4*)(PRE + (size_t)(row + NGW) * D + 8 * lane + 512 * j); }
        const float mean = wave_sum_dpp(s) * (1.0f / D); float q = 0.f;
#pragma unroll
        for (int j = 0; j < 2; ++j)
#pragma unroll
            for (int i = 0; i < 8; ++i) { v[j][i] -= mean; q += v[j][i] * v[j][i]; }
        const float rstd = 1.0f / sqrtf(wave_sum_dpp(q) * (1.0f / D) + LN_EPS);
#pragma unroll
        for (int j = 0; j < 2; ++j) {
#pragma unroll
            for (int i = 0; i < 8; ++i) v[j][i] = v[j][i] * rstd * gg[j][i] + gb[j][i];
            u32x4 w; w.x = pk2(v[j][0], v[j][1]); w.y = pk2(v[j][2], v[j][3]); w.z = pk2(v[j][4], v[j][5]); w.w = pk2(v[j][6], v[j][7]);
            *(u32x4*)(HB + (size_t)row * D + 8 * lane + 512 * j) = w;
            u32x2 w8; w8.x = pk4_fp8(v[j][0], v[j][1], v[j][2], v[j][3]); w8.y = pk4_fp8(v[j][4], v[j][5], v[j][6], v[j][7]);
            *(u32x2*)(HB8 + (size_t)row * D + 8 * lane + 512 * j) = w8; }
        float pl[32];
#pragma unroll
        for (int e0 = 0; e0 < 32; e0 += 4) {
            f32x4 wv[4][4];
#pragma unroll
            for (int ee = 0; ee < 4; ++ee)
#pragma unroll
                for (int jj = 0; jj < 4; ++jj) wv[ee][jj] = *(const LAS f32x4*)(RWt + (e0 + ee) * RWT_PITCH + 4 * lane + 256 * jj);
            __builtin_amdgcn_sched_barrier(0);
#pragma unroll
            for (int ee = 0; ee < 4; ++ee) { float a = 0.f;
#pragma unroll
                for (int jj = 0; jj < 4; ++jj) { const int j = jj >> 1, o = 4 * (jj & 1); a += (v[j][o] * wv[ee][jj][0] + v[j][o + 1] * wv[ee][jj][1]) + (v[j][o + 2] * wv[ee][jj][2] + v[j][o + 3] * wv[ee][jj][3]); }
                pl[e0 + ee] = a; }
        }
        float q16[16], q8[8], q4[4], q2[2], q1;
        { const bool hi = (lane & 32) != 0;
#pragma unroll
          for (int e = 0; e < 16; ++e) { const float mine = hi ? pl[16 + e] : pl[e], other = hi ? pl[e] : pl[16 + e]; q16[e] = mine + __shfl_xor(other, 32); } }
        { const bool hi = (lane & 16) != 0;
#pragma unroll
          for (int e = 0; e < 8; ++e) { const float mine = hi ? q16[8 + e] : q16[e], other = hi ? q16[e] : q16[8 + e]; q8[e] = mine + __shfl_xor(other, 16); } }
        { const bool hi = (lane & 8) != 0;
#pragma unroll
          for (int e = 0; e < 4; ++e) { const float mine = hi ? q8[4 + e] : q8[e], other = hi ? q8[e] : q8[4 + e]; q4[e] = mine + dpp_movf<0x128>(other); } }
        { const bool hi = (lane & 4) != 0;
#pragma unroll
          for (int e = 0; e < 2; ++e) { const float mine = hi ? q4[2 + e] : q4[e], other = hi ? q4[e] : q4[2 + e]; q2[e] = mine + __shfl_xor(other, 4); } }
        { const bool hi = (lane & 2) != 0; const float mine = hi ? q2[1] : q2[0], other = hi ? q2[0] : q2[1]; q1 = mine + dpp_movf<0x4E>(other); }
        q1 += dpp_movf<0xB1>(q1);
        float lv = q1 + rbias; lv = (lv == lv) ? lv : -3.0e38f;
        const int le = lane >> 1;
        int rank = 0;
#pragma unroll
        for (int j = 0; j < 32; ++j) { const float lj = readlane_f(lv, 2 * j); rank += (lj > lv || (lj == lv && j < le)) ? 1 : 0; }
        const unsigned long long m0 = __ballot(rank == 0);
        const float mxl = readlane_f(lv, (int)__builtin_ctzll(m0));
        const float pe = rank < 4 ? __expf(lv - mxl) : 0.f;
        const float den = wave_sum_dpp(pe) * 0.5f;
        if (rank < 4 && (lane & 1) == 0) { eid[(size_t)row * 4 + rank] = le; gatev[(size_t)row * 4 + rank] = pe / den;
            __hip_atomic_fetch_add(&hist[le], 1u, __ATOMIC_RELAXED, __HIP_MEMORY_SCOPE_WORKGROUP); }
    }
    __syncthreads();
    if (tid < 32) bc[tid] = hist[tid];
}

__device__ __forceinline__ void phase_pos(const Ctx& C, int layer, int nrows) {
    PHASE_IDS
    const unsigned* bcAll = (const unsigned*)(wsl + WS_CTL + CT_BC) + (size_t)layer * 256 * 32;
    const int* eid = (const int*)(wsl + WS_CTL + CT_EID) + (size_t)layer * NTOK * 4; int* posv = (int*)(wsl + WS_CTL + CT_POS) + (size_t)layer * NTOK * 4;
    int* texp = (int*)(wsl + WS_CTL + CT_TEXP) + layer * 1024;
    int* tokoff = (int*)(wsl + WS_TOK) + (size_t)layer * (1 * MiB / 4);
    LAS unsigned* partT = (LAS unsigned*)C.lds; LAS unsigned* partP = partT + 512; LAS unsigned* tot = partP + 512; LAS unsigned* cnt = tot + 32;
    { const int e = tid & 31, part = tid >> 5; unsigned t = 0, pr = 0;
      unsigned vv[16];
#pragma unroll
      for (int i = 0; i < 16; ++i) { const int bq = part + 16 * i; vv[i] = bq < C.G ? bcAll[(size_t)bq * 32 + e] : 0u; }
#pragma unroll
      for (int i = 0; i < 16; ++i) { const int bq = part + 16 * i; t += vv[i]; if (bq < C.bid) pr += vv[i]; }
      partT[part * 32 + e] = t; partP[part * 32 + e] = pr; }
    __syncthreads();
    if (tid < 32) { unsigned t = 0, pr = 0; for (int i = 0; i < 16; ++i) { t += partT[i * 32 + tid]; pr += partP[i * 32 + tid]; } tot[tid] = t; cnt[tid] = pr; }
    __syncthreads();
    if (tid < 32) { unsigned off = 0; for (int e = 0; e < tid; ++e) off += (tot[e] + 255u) & ~255u;
        const unsigned mine = (tot[tid] + 255u) & ~255u;
        if (C.bid == 0) { for (unsigned t = off >> 8; t < ((off + mine) >> 8); ++t) texp[t] = tid; if (tid == 31) texp[1023] = (int)((off + mine) >> 8);
            for (unsigned p = off + tot[tid]; p < off + mine; ++p) tokoff[p] = 0; }
        cnt[tid] += off; }
    __syncthreads();
    const int gw = C.bid * NWAVES + wave, NGW = C.G * NWAVES;
    for (int row = gw; row < nrows; row += NGW) {
        int pos = 0;
        if (lane < 4) { const int e = eid[(size_t)row * 4 + lane]; pos = (int)__hip_atomic_fetch_add(&cnt[e], 1u, __ATOMIC_RELAXED, __HIP_MEMORY_SCOPE_WORKGROUP); posv[(size_t)row * 4 + lane] = pos; }
        if (lane < 4) tokoff[pos] = row * 1024;
    }
}

__device__ __forceinline__ void phase_combine(const Ctx& C, int layer, int nrows, bool final_out) {
    PHASE_IDS
    bf16_t* HB = (bf16_t*)(wsl + WS_HB); const bf16_t* YS = (const bf16_t*)(wsl + WS_YS);
    const float* lg = C.in[I_LNFG] + layer * D; const float* lb = C.in[I_LNFB] + layer * D;
    const float* gatev = (const float*)(wsl + WS_CTL + CT_GATEV) + (size_t)layer * NTOK * 4; const int* posv = (const int*)(wsl + WS_CTL + CT_POS) + (size_t)layer * NTOK * 4;
    float gg[2][8], gb[2][8];
#pragma unroll
    for (int j = 0; j < 2; ++j) { const f32x4 a0 = *(const f32x4*)(lg + 8 * lane + 512 * j), a1 = *(const f32x4*)(lg + 8 * lane + 512 * j + 4), b0 = *(const f32x4*)(lb + 8 * lane + 512 * j), b1 = *(const f32x4*)(lb + 8 * lane + 512 * j + 4);
#pragma unroll
        for (int i = 0; i < 4; ++i) { gg[j][i] = a0[i]; gg[j][4 + i] = a1[i]; gb[j][i] = b0[i]; gb[j][4 + i] = b1[i]; } }
    const int gw = C.bid * NWAVES + wave, NGW = C.G * NWAVES;
    for (int row = gw; row < nrows; row += NGW) {
        const f32x4 gk4 = *(const f32x4*)(gatev + (size_t)row * 4); const int pk0 = posv[(size_t)row * 4], pk1 = posv[(size_t)row * 4 + 1], pk2_ = posv[(size_t)row * 4 + 2], pk3 = posv[(size_t)row * 4 + 3];
        u32x4 hw[2], yw[4][2];
#pragma unroll
        for (int j = 0; j < 2; ++j) { hw[j] = *(const u32x4*)(HB + (size_t)row * D + 8 * lane + 512 * j);
            yw[0][j] = *(const u32x4*)(YS + (size_t)pk0 * D + 8 * lane + 512 * j); yw[1][j] = *(const u32x4*)(YS + (size_t)pk1 * D + 8 * lane + 512 * j);
            yw[2][j] = *(const u32x4*)(YS + (size_t)pk2_ * D + 8 * lane + 512 * j); yw[3][j] = *(const u32x4*)(YS + (size_t)pk3 * D + 8 * lane + 512 * j); }
        float v[2][8]; float s = 0.f;
#pragma unroll
        for (int j = 0; j < 2; ++j) { float h[8]; unpack8(hw[j], h);
#pragma unroll
            for (int i = 0; i < 8; ++i) v[j][i] = h[i] * DN_ALPHA;
#pragma unroll
            for (int k = 0; k < 4; ++k) { float y[8]; unpack8(yw[k][j], y);
#pragma unroll
                for (int i = 0; i < 8; ++i) v[j][i] += gk4[k] * y[i]; }
#pragma unroll
            for (int i = 0; i < 8; ++i) s += v[j][i]; }
        const float mean = wave_sum_dpp(s) * (1.0f / D); float q = 0.f;
#pragma unroll
        for (int j = 0; j < 2; ++j)
#pragma unroll
            for (int i = 0; i < 8; ++i) { v[j][i] -= mean; q += v[j][i] * v[j][i]; }
        const float rstd = 1.0f / sqrtf(wave_sum_dpp(q) * (1.0f / D) + LN_EPS);
#pragma unroll
        for (int j = 0; j < 2; ++j) {
#pragma unroll
            for (int i = 0; i < 8; ++i) v[j][i] = v[j][i] * rstd * gg[j][i] + gb[j][i];
            if (final_out) { *(f32x4*)(C.out + (size_t)row * D + 8 * lane + 512 * j) = (f32x4){v[j][0], v[j][1], v[j][2], v[j][3]}; *(f32x4*)(C.out + (size_t)row * D + 8 * lane + 512 * j + 4) = (f32x4){v[j][4], v[j][5], v[j][6], v[j][7]}; }
            else { u32x4 w; w.x = pk2(v[j][0], v[j][1]); w.y = pk2(v[j][2], v[j][3]); w.z = pk2(v[j][4], v[j][5]); w.w = pk2(v[j][6], v[j][7]); *(u32x4*)(HB + (size_t)row * D + 8 * lane + 512 * j) = w; } }
    }
}

constexpr int AT_KS = 0, AT_VTS = 73728, AT_VPITCH = 1168, AT_KM = AT_VTS + 64 * AT_VPITCH, AT_VTM = AT_KM + 2048, AT_RPB = AT_VTM + 2048, AT_MB = AT_RPB + 1920, AT_END = AT_MB + 64;
static_assert(AT_END <= LDS_BYTES, "attention LDS map");
__device__ __forceinline__ void phase_attn(const Ctx& C) {
    PHASE_IDS
    const bf16_t* Q = (const bf16_t*)(wsl + WS_Q); const bf16_t* Kx = (const bf16_t*)(wsl + WS_K); const bf16_t* VT = (const bf16_t*)(wsl + WS_VT); bf16_t* O = (bf16_t*)(wsl + WS_O);
    const float* rpb = C.in[I_RPB]; const float* mbias = C.in[I_MBIAS];
    LAS unsigned char* lds = C.lds;
    const int w = wave, lq = lane & 15, g = lane >> 4;
    int bidx[2][4];
    { const int qg_ = w & 3, c_ = 16 * qg_ + lq, cs_ = min(max(c_ - 8, 0), 48), kcb_ = qg_ == 0 ? 0 : (qg_ == 1 ? 8 : (qg_ == 2 ? 24 : 32));
#pragma unroll
      for (int blk = 0; blk < 2; ++blk)
#pragma unroll
          for (int e = 0; e < 4; ++e) { const int kc = kcb_ + 16 * blk + 4 * g + e; bidx[blk][e] = ((kc >= cs_ && kc < cs_ + 16) ? (kc - c_ + 15) : 31) * 4; } }
    const bool xmap = (C.G == 256); const int nu = xmap ? 16 : (NB * 16 * 32 - C.bid + C.G - 1) / C.G;
    u32x4 kreg[9], vreg[9], mreg = {0u, 0u, 0u, 0u}; float rpreg = 0.f, mbreg = 0.f;
#define AT_UNIT(i) (xmap ? (C.gc & 7) * 512 + (C.gc >> 3) + 32 * (i) : C.bid + C.G * (i))
    const __amdgpu_buffer_rsrc_t rsrc = __builtin_amdgcn_make_buffer_rsrc((void*)wsl, 0, 0xFFFFFFFF, 0x00020000);
    const int kvoff = (((tid >> 3) & 63) * D + 8 * (tid & 7)) * 2, vvoff = ((tid >> 3) * MPAD + 8 * (tid & 7)) * 2;
    const int mvoff = tid < 128 ? ((tid >> 3) * D + 8 * (tid & 7)) * 2 : (((tid - 128) >> 1) * MPAD + 8 * ((tid - 128) & 1)) * 2;
#define AT_ISSUE(unit_) do { const int rp_ = (unit_) & 31, h_ = ((unit_) >> 5) & 15, b_ = (unit_) >> 9, R0_ = min(max(2 * rp_ - 4, 0), 55); \
        const unsigned ks_ = (unsigned)WS_K + (unsigned)((b_ * SEQ + R0_ * 64) * D + 64 * h_) * 2u, vs_ = (unsigned)WS_VT + (unsigned)((64 * h_) * MPAD + b_ * SEQ + R0_ * 64) * 2u; \
        _Pragma("unroll") for (int i_ = 0; i_ < 9; ++i_) kreg[i_] = __builtin_amdgcn_raw_buffer_load_b128(rsrc, kvoff, (int)(ks_ + (unsigned)i_ * 64u * D * 2u), 0); \
        _Pragma("unroll") for (int i_ = 0; i_ < 9; ++i_) vreg[i_] = __builtin_amdgcn_raw_buffer_load_b128(rsrc, vvoff, (int)(vs_ + (unsigned)i_ * 128u), 0); \
        if (tid < 256) mreg = __builtin_amdgcn_raw_buffer_load_b128(rsrc, mvoff, (int)(tid < 128 ? (unsigned)WS_K + (unsigned)((NGRID + 16 * b_) * D + 64 * h_) * 2u : (unsigned)WS_VT + (unsigned)((64 * h_) * MPAD + NGRID + 16 * b_) * 2u), 0); \
        if (tid < 480) rpreg = (tid & 31) < 31 ? rpb[h_ * 465 + (tid >> 5) * 31 + (tid & 31)] * 1.44269504089f : -1.0e30f;        \
        if (tid < 16) mbreg = mbias[h_ * 16 + tid] * 1.44269504089f; } while (0)
    if (nu > 0) AT_ISSUE(AT_UNIT(0));
    for (int ui = 0; ui < nu; ++ui) {
        const int unit = AT_UNIT(ui);
        const int rp = unit & 31, h = (unit >> 5) & 15, b = unit >> 9;
        const int R0 = min(max(2 * rp - 4, 0), 55);
        __syncthreads();
#pragma unroll
        for (int i = 0; i < 9; ++i) { const int idx = tid + 512 * i, ch = idx & 7, kc = (idx >> 3) & 63, jr = idx >> 9;
            *(LAS u32x4*)(lds + AT_KS + ((jr * 64 + kc) * 8 + (ch ^ (kc & 7))) * 16) = kreg[i]; }
#pragma unroll
        for (int i = 0; i < 9; ++i) *(LAS u32x4*)(lds + AT_VTS + (tid >> 3) * AT_VPITCH + ((tid & 7) + 8 * i) * 16) = vreg[i];
        if (tid < 128) { const int m = tid >> 3, ch = tid & 7; *(LAS u32x4*)(lds + AT_KM + (m * 8 + (ch ^ (m & 7))) * 16) = mreg; }
        else if (tid < 256) { const int i = tid - 128, d = i >> 1, hf = i & 1; *(LAS u32x4*)(lds + AT_VTM + d * 32 + hf * 16) = mreg; }
        if (tid < 480) ((LAS float*)(lds + AT_RPB))[tid] = rpreg;
        if (tid < 16) ((LAS float*)(lds + AT_MB))[tid] = mbreg;
        __syncthreads();
        if (ui + 1 < nu) AT_ISSUE(AT_UNIT(ui + 1));
        const int qr = w >> 2, qg = w & 3, r = 2 * rp + qr, c0 = 16 * qg;
        const int rs = min(max(r - 4, 0), 56), jr0 = rs - R0;
        const int kcb = qg == 0 ? 0 : (qg == 1 ? 8 : (qg == 2 ? 24 : 32));
        const size_t qrow = (size_t)(b * SEQ + r * 64 + c0 + lq);
        bf16x8 qf[2];
#pragma unroll
        for (int ks = 0; ks < 2; ++ks) qf[ks] = *(const bf16x8*)(Q + qrow * D + 64 * h + 32 * ks + 8 * g);
        f32x4 sc[8][2], sm;
#pragma unroll
        for (int j = 0; j < 8; ++j)
#pragma unroll
            for (int blk = 0; blk < 2; ++blk) { f32x4 a = {0.f, 0.f, 0.f, 0.f}; const int kc = kcb + 16 * blk + lq;
#pragma unroll
                for (int ks = 0; ks < 2; ++ks) { const bf16x8 kf = *(const LAS bf16x8*)(lds + AT_KS + (((jr0 + j) * 64 + kc) * 8 + ((4 * ks + g) ^ (kc & 7))) * 16);
                    a = __builtin_amdgcn_mfma_f32_16x16x32_bf16(kf, qf[ks], a, 0, 0, 0); }
                sc[j][blk] = a; if (blk == 1 && (j & 1)) __builtin_amdgcn_sched_barrier(0); }
        { f32x4 a = {0.f, 0.f, 0.f, 0.f};
#pragma unroll
          for (int ks = 0; ks < 2; ++ks) { const bf16x8 kf = *(const LAS bf16x8*)(lds + AT_KM + (lq * 8 + ((4 * ks + g) ^ (lq & 7))) * 16);
              a = __builtin_amdgcn_mfma_f32_16x16x32_bf16(kf, qf[ks], a, 0, 0, 0); }
          sm = a; }
        const LAS unsigned char* RProw = lds + AT_RPB + (rs - r + 7) * 128; const LAS float* MB = (const LAS float*)(lds + AT_MB);
        float mx = -3.0e38f;
#pragma unroll
        for (int j = 0; j < 8; ++j)
#pragma unroll
            for (int blk = 0; blk < 2; ++blk)
#pragma unroll
                for (int e = 0; e < 4; ++e) { const float s = sc[j][blk][e] + *(const LAS float*)(RProw + j * 128 + bidx[blk][e]); sc[j][blk][e] = s; mx = fmaxf(mx, s); }
#pragma unroll
        for (int e = 0; e < 4; ++e) { sm[e] += MB[4 * g + e]; mx = fmaxf(mx, sm[e]); }
        mx = fmaxf(mx, __shfl_xor(mx, 16)); mx = fmaxf(mx, __shfl_xor(mx, 32));
        float sum = 0.f;
#pragma unroll
        for (int j = 0; j < 8; ++j)
#pragma unroll
            for (int blk = 0; blk < 2; ++blk)
#pragma unroll
                for (int e = 0; e < 4; ++e) { const float pv = fast_exp2(sc[j][blk][e] - mx); sc[j][blk][e] = pv; sum += pv; }
#pragma unroll
        for (int e = 0; e < 4; ++e) { const float pv = fast_exp2(sm[e] - mx); sm[e] = pv; sum += pv; }
        sum += __shfl_xor(sum, 16); sum += __shfl_xor(sum, 32);
        f32x4 o[4];
#pragma unroll
        for (int db = 0; db < 4; ++db) o[db] = (f32x4){0.f, 0.f, 0.f, 0.f};
#pragma unroll
        for (int j = 0; j < 8; ++j) {
            u32x4 pw; pw.x = cvt_pk_bf16(sc[j][0][0], sc[j][0][1]); pw.y = cvt_pk_bf16(sc[j][0][2], sc[j][0][3]); pw.z = cvt_pk_bf16(sc[j][1][0], sc[j][1][1]); pw.w = cvt_pk_bf16(sc[j][1][2], sc[j][1][3]);
            const bf16x8 pb = __builtin_bit_cast(bf16x8, pw);
#pragma unroll
            for (int db = 0; db < 4; ++db) { const int d = 16 * db + lq; const LAS unsigned char* vp = lds + AT_VTS + d * AT_VPITCH + ((jr0 + j) * 64 + kcb + 4 * g) * 2;
                const u32x2 lo = *(const LAS u32x2*)vp, hi = *(const LAS u32x2*)(vp + 32);
                u32x4 aw; aw.x = lo.x; aw.y = lo.y; aw.z = hi.x; aw.w = hi.y;
                o[db] = __builtin_amdgcn_mfma_f32_16x16x32_bf16(__builtin_bit_cast(bf16x8, aw), pb, o[db], 0, 0, 0); }
        }
        { u32x4 pw; pw.x = cvt_pk_bf16(sm[0], sm[1]); pw.y = cvt_pk_bf16(sm[2], sm[3]); pw.z = 0u; pw.w = 0u; const bf16x8 pb = __builtin_bit_cast(bf16x8, pw);
#pragma unroll
          for (int db = 0; db < 4; ++db) { const int d = 16 * db + lq; const u32x2 lo = *(const LAS u32x2*)(lds + AT_VTM + d * 32 + 8 * g);
              u32x4 aw; aw.x = lo.x; aw.y = lo.y; aw.z = 0u; aw.w = 0u;
              o[db] = __builtin_amdgcn_mfma_f32_16x16x32_bf16(__builtin_bit_cast(bf16x8, aw), pb, o[db], 0, 0, 0); } }
        const float inv = 1.0f / sum;
#pragma unroll
        for (int db = 0; db < 4; ++db) { u32x2 ow; ow.x = cvt_pk_bf16(o[db][0] * inv, o[db][1] * inv); ow.y = cvt_pk_bf16(o[db][2] * inv, o[db][3] * inv);
            *(u32x2*)(O + qrow * D + 64 * h + 16 * db + 4 * g) = ow; }
    }
#undef AT_UNIT
#undef AT_ISSUE
}


#define XB_TMO      128
#define XB_XCNT(j)  (256  + 64 * (j))
#define XB_XSUB(j)  (1280 + 64 * (j))
#define XB_XGEN(j)  (2304 + 64 * (j))
#define XB_TOP      3328
#define XB_TOPGEN   3392
#define XCD_BAR_WORDS 3456
#define XB_SPIN_CAP (1u << 22)
__device__ __forceinline__ unsigned xb_ld(unsigned* p)              { return __hip_atomic_load(p, __ATOMIC_RELAXED, __HIP_MEMORY_SCOPE_AGENT); }
__device__ __forceinline__ unsigned xb_add(unsigned* p, unsigned v) { return __hip_atomic_fetch_add(p, v, __ATOMIC_RELAXED, __HIP_MEMORY_SCOPE_AGENT); }
__device__ __forceinline__ unsigned xb_xcc_id() { return (unsigned)__builtin_amdgcn_s_getreg((3 << 11) | 20) & 0xFu; }
#define XB_SPIN(cond, bar) do { unsigned _sp = 0; while (cond) { __builtin_amdgcn_s_sleep(1); \
    if ((++_sp & 255u) == 0u) { if (xb_ld(&(bar)[XB_TMO])) break; if (_sp > XB_SPIN_CAP) { atomicAdd(&(bar)[XB_TMO], 1u); break; } } } } while (0)
struct XcdBarrier { unsigned* bar; unsigned x; volatile LAS unsigned* st; };
__device__ __forceinline__ XcdBarrier xcd_barrier_post(unsigned* bar, volatile LAS unsigned* st) {
    XcdBarrier b; b.bar = bar; b.x = xb_xcc_id(); b.st = st;
    if (threadIdx.x == 0) st[2] = xb_add(&bar[XB_XCNT(b.x)], 1u);
    return b;
}
__device__ __forceinline__ void xcd_barrier_complete(unsigned* bar, unsigned x, unsigned& nloc, unsigned& nx) {
    const unsigned G = gridDim.x * gridDim.y * gridDim.z;
    unsigned sum, cnt, mine, sp = 0u;
    for (;;) {
        sum = 0u; cnt = 0u; mine = 0u;
#pragma unroll
        for (unsigned j = 0; j < 16; ++j) { const unsigned c = xb_ld(&bar[XB_XCNT(j)]); sum += c; cnt += (c > 0u) ? 1u : 0u; mine = (j == x) ? c : mine; }
        if (sum == G) break;
        __builtin_amdgcn_s_sleep(1);
        if ((++sp & 255u) == 0u) { if (xb_ld(&bar[XB_TMO])) break; if (sp > XB_SPIN_CAP) { atomicAdd(&bar[XB_TMO], 1u); break; } }
    }
    nloc = mine > 0u ? mine : 1u; nx = cnt > 0u ? cnt : 1u;
}
__device__ __forceinline__ void xcd_barrier(const XcdBarrier& b) {
    asm volatile("s_waitcnt vmcnt(0)" ::: "memory");
    __syncthreads();
    if (threadIdx.x == 0) {
        unsigned* bar = b.bar;
        __builtin_amdgcn_s_waitcnt(0);
        unsigned nloc = b.st[0], nx = b.st[1];
        if (nloc == 0u) { xcd_barrier_complete(bar, b.x, nloc, nx); b.st[0] = nloc; b.st[1] = nx; }
        const unsigned old = xb_add(&bar[XB_XSUB(b.x)], 1u);
        const unsigned gen = old / nloc;
        if (old + 1u == (gen + 1u) * nloc) {
            __builtin_amdgcn_fence(__ATOMIC_RELEASE, "agent");
            asm volatile("s_waitcnt vmcnt(0)" ::: "memory");
            const unsigned og = xb_add(&bar[XB_TOP], 1u);
            const unsigned tg = og / nx;
            if (og + 1u == (tg + 1u) * nx) xb_add(&bar[XB_TOPGEN], 1u);
            else XB_SPIN(xb_ld(&bar[XB_TOPGEN]) == tg, bar);
            __builtin_amdgcn_fence(__ATOMIC_ACQUIRE, "agent");
            xb_add(&bar[XB_XGEN(b.x)], 1u);
            asm volatile("s_waitcnt vmcnt(0)" ::: "memory");
        } else {
            XB_SPIN(xb_ld(&bar[XB_XGEN(b.x)]) == gen, bar);
            __builtin_amdgcn_fence(__ATOMIC_ACQUIRE, "agent");
            asm volatile("s_waitcnt vmcnt(0)" ::: "memory");
        }
    }
    __syncthreads();
}
__device__ __forceinline__ int moe_prep(const Ctx& C, const int* texp) {
    LAS int* t = (LAS int*)(C.lds + pg8::TEXP_OFF); const int tid = fresh_tid();
    const int a = texp[tid], b = texp[tid + 512];
    t[tid] = a; t[tid + 512] = b;
    __syncthreads();
    return __builtin_amdgcn_readfirstlane(t[1023]);
}
constexpr size_t CT_BAR = 131072;
constexpr int LDS_BARST = LDS_BYTES - 64;

constexpr int N_PHASES = 20;
__global__ void __launch_bounds__(NTHREADS, 2) hybrid_fwd(Params P) {
    extern __shared__ __attribute__((aligned(16))) unsigned char smem[];
    cg::grid_group grid = cg::this_grid();
    Ctx C; C.lds = (LAS unsigned char*)smem; C.G = gridDim.x; C.bid = blockIdx.x;
    C.ws = P.ws; C.in = P.in; C.out = P.out;
    unsigned char* const ws0 = P.ws;
#define ws fresh_ws(ws0)
    const int lo = P.ph_lo, hi = P.ph_hi;
#ifndef PH_MASK
#define PH_MASK 0xFFFFFFFFu
#endif
#define IN(k) (((PH_MASK >> (k)) & 1u) && lo <= (k) && (k) < hi)
#ifndef REPEAT_MASK
#define REPEAT_MASK 0u
#endif
#define REPS(k) ((((unsigned)REPEAT_MASK >> (k)) & 1u) ? 2 : 1)
#ifndef N_CG_SYNCS
#define N_CG_SYNCS 1
#endif
#define SEAM(k) do { if (IN(k) && IN((k) + 1)) { if ((k) < N_CG_SYNCS) grid.sync(); else xcd_barrier(bar); } } while (0)
    if (threadIdx.x < 16) ((LAS unsigned*)(smem + LDS_BARST))[threadIdx.x] = 0u;
    __syncthreads();
    const XcdBarrier bar = xcd_barrier_post((unsigned*)(ws + WS_CTL + CT_BAR), (volatile LAS unsigned*)(smem + LDS_BARST));
    C.gc = C.bid;
    #define PH_BODY_0 phase_convert(C);
    if (IN(0)) { PH_BODY_0 } if (REPS(0) > 1 && IN(0)) { xcd_barrier(bar); PH_BODY_0 }
    SEAM(0);
    if (IN(0) && IN(1)) {
        unsigned* barw = (unsigned*)(ws + WS_CTL + CT_BAR); bool eq = (C.G % 8) == 0;
#pragma unroll
        for (int j = 0; j < 16; ++j) { const unsigned cj = xb_ld(&barw[XB_XCNT(j)]); eq = eq && (cj == (j < 8 ? (unsigned)(C.G / 8) : 0u)); }
        const unsigned rank = ((volatile LAS unsigned*)(smem + LDS_BARST))[2];
        C.gc = __builtin_amdgcn_readfirstlane(eq ? (int)(rank * 8u + bar.x) : C.bid);
    }
    #define PH_BODY_1 { DenseSched S{(unsigned)WS_HB, (unsigned)WS_WIN, 1024, 1024, 128, 8, C.G, C.gc}; EpiWin E{(bf16_t*)(ws + WS_XR), (bf16_t*)(ws + WS_GY)}; \
        pg8::gemm_phase<false, false>(C.lds, ws, 1024, 1024, 1024, S, E); mini_win(C); }
    if (IN(1)) { PH_BODY_1 } if (REPS(1) > 1 && IN(1)) { xcd_barrier(bar); PH_BODY_1 }
    SEAM(1);
    #define PH_BODY_2 phase_conv(C);
    if (IN(2)) { PH_BODY_2 } if (REPS(2) > 1 && IN(2)) { xcd_barrier(bar); PH_BODY_2 }
    SEAM(2);
    #define PH_BODY_3 { GateSched S{(unsigned)WS_XC, (unsigned)WS_GATE, 128, C.G, C.gc}; \
        EpiGate E{(const bf16_t*)(ws + WS_XC), (bf16_t*)(ws + WS_LA), (bf16_t*)(ws + WS_BB), P.in[I_BA], P.in[I_BX], (const float*)(ws + WS_CTL + CT_SPL)}; \
        pg8::gemm_phase<false, false>(C.lds, ws, 256, 1024, 256, S, E); mini_gate(C); }
    if (IN(3)) { PH_BODY_3 } if (REPS(3) > 1 && IN(3)) { xcd_barrier(bar); PH_BODY_3 }
    SEAM(3);
    #define PH_BODY_4 phase_scan(C);
    if (IN(4)) { PH_BODY_4 } if (REPS(4) > 1 && IN(4)) { xcd_barrier(bar); PH_BODY_4 }
    SEAM(4);
    #define PH_BODY_5 { DenseSched S{(unsigned)WS_G, (unsigned)WS_LOUT, 1024, 1024, 128, 4, C.G, C.gc}; EpiRes<true> E{(bf16_t*)(ws + WS_PRE), P.in[I_X], P.in[I_META], nullptr, NTOK}; \
        pg8::gemm_phase<false, false>(C.lds, ws, 1024, 1024, 1024, S, E); mini_lout(C); }
    if (IN(5)) { PH_BODY_5 } if (REPS(5) > 1 && IN(5)) { xcd_barrier(bar); PH_BODY_5 }
    SEAM(5);
    #define PH_BODY_6 phase_lnr(C, 0, NTOK);
    if (IN(6)) { PH_BODY_6 } if (REPS(6) > 1 && IN(6)) { xcd_barrier(bar); PH_BODY_6 }
    SEAM(6);
    #define PH_BODY_7 phase_pos(C, 0, NTOK);
    if (IN(7)) { PH_BODY_7 } if (REPS(7) > 1 && IN(7)) { xcd_barrier(bar); PH_BODY_7 }
    SEAM(7);
    #define PH_BODY_8 { const int nM = moe_prep(C, (const int*)(ws + WS_CTL + CT_TEXP)); \
        MoeSched S{(unsigned)WS_HB8, (unsigned)WS_WGU, (unsigned)WS_TOK, (const LAS int*)(C.lds + pg8::TEXP_OFF), 2048u * 1024u, nM, 8, C.G, C.gc}; EpiGlu E{(unsigned char*)(ws + WS_ACT), (unsigned)WS_BIAS}; \
        pg8::gemm_phase<true, true>(C.lds, ws, 512, 512, 512, S, E); }
    if (IN(8)) { PH_BODY_8 } if (REPS(8) > 1 && IN(8)) { xcd_barrier(bar); PH_BODY_8 }
#ifdef PROBE_NULL8
    if (IN(8)) { xcd_barrier(bar); { const int nM = moe_prep(C, (const int*)(ws + WS_CTL + CT_TEXP));
        MoeSched S{(unsigned)WS_HB8, (unsigned)WS_WGU, (unsigned)WS_TOK, (const LAS int*)(C.lds + pg8::TEXP_OFF), 2048u * 1024u, nM, 8, C.G, C.gc}; EpiNull E{};
        pg8::gemm_phase<true, true>(C.lds, ws, 512, 512, 512, S, E); } }
#endif
    SEAM(8);
    #define PH_BODY_9 { const int nM = moe_prep(C, (const int*)(ws + WS_CTL + CT_TEXP)); \
        MoeSched S{(unsigned)WS_ACT, (unsigned)WS_WD, 0u, (const LAS int*)(C.lds + pg8::TEXP_OFF), 1024u * 1024u, nM, 4, C.G, C.gc}; EpiDown E{(bf16_t*)(ws + WS_YS), (unsigned)WS_BD}; \
        pg8::gemm_phase<true, false>(C.lds, ws, 512, 512, 512, S, E); }
    if (IN(9)) { PH_BODY_9 } if (REPS(9) > 1 && IN(9)) { xcd_barrier(bar); PH_BODY_9 }
    SEAM(9);
    #define PH_BODY_10 phase_combine(C, 0, NTOK, false);
    if (IN(10)) { PH_BODY_10 } if (REPS(10) > 1 && IN(10)) { xcd_barrier(bar); PH_BODY_10 }
    SEAM(10);
    #define PH_BODY_11 { QkvSched S{(unsigned)WS_HB, (unsigned)WS_QKV, 128, C.G, C.gc}; EpiQkv E{(bf16_t*)(ws + WS_Q), (bf16_t*)(ws + WS_K), (bf16_t*)(ws + WS_VT)}; \
        pg8::gemm_phase<false, false>(C.lds, ws, 1024, 1024, 1024, S, E); mini_kv(C); }
    if (IN(11)) { PH_BODY_11 } if (REPS(11) > 1 && IN(11)) { xcd_barrier(bar); PH_BODY_11 }
    SEAM(11);
    #define PH_BODY_12 phase_attn(C);
    if (IN(12)) { PH_BODY_12 } if (REPS(12) > 1 && IN(12)) { xcd_barrier(bar); PH_BODY_12 }
    SEAM(12);
    #define PH_BODY_13 { DenseSched S{(unsigned)WS_O, (unsigned)WS_NOUT, 1024, 1024, 128, 4, C.G, C.gc}; EpiRes<false> E{(bf16_t*)(ws + WS_PRE), nullptr, nullptr, (const bf16_t*)(ws + WS_HB), NGRID}; \
        pg8::gemm_phase<false, false>(C.lds, ws, 1024, 1024, 1024, S, E); }
    if (IN(13)) { PH_BODY_13 } if (REPS(13) > 1 && IN(13)) { xcd_barrier(bar); PH_BODY_13 }
    SEAM(13);
    #define PH_BODY_14 phase_lnr(C, 1, NGRID);
    if (IN(14)) { PH_BODY_14 } if (REPS(14) > 1 && IN(14)) { xcd_barrier(bar); PH_BODY_14 }
    SEAM(14);
    #define PH_BODY_15 phase_pos(C, 1, NGRID);
    if (IN(15)) { PH_BODY_15 } if (REPS(15) > 1 && IN(15)) { xcd_barrier(bar); PH_BODY_15 }
    SEAM(15);
    #define PH_BODY_16 { const int nM = moe_prep(C, (const int*)(ws + WS_CTL + CT_TEXP) + 1024); \
        MoeSched S{(unsigned)WS_HB8, (unsigned)(WS_WGU + (size_t)32 * 2048 * 1024), (unsigned)(WS_TOK + 1 * MiB), (const LAS int*)(C.lds + pg8::TEXP_OFF), 2048u * 1024u, nM, 8, C.G, C.gc}; EpiGlu E{(unsigned char*)(ws + WS_ACT), (unsigned)(WS_BIAS + 32 * 2048 * 4)}; \
        pg8::gemm_phase<true, true>(C.lds, ws, 512, 512, 512, S, E); }
    if (IN(16)) { PH_BODY_16 } if (REPS(16) > 1 && IN(16)) { xcd_barrier(bar); PH_BODY_16 }
    SEAM(16);
    #define PH_BODY_17 { const int nM = moe_prep(C, (const int*)(ws + WS_CTL + CT_TEXP) + 1024); \
        MoeSched S{(unsigned)WS_ACT, (unsigned)(WS_WD + (size_t)32 * 1024 * 1024), 0u, (const LAS int*)(C.lds + pg8::TEXP_OFF), 1024u * 1024u, nM, 4, C.G, C.gc}; EpiDown E{(bf16_t*)(ws + WS_YS), (unsigned)(WS_BD + 32 * 1024 * 4)}; \
        pg8::gemm_phase<true, false>(C.lds, ws, 512, 512, 512, S, E); }
    if (IN(17)) { PH_BODY_17 } if (REPS(17) > 1 && IN(17)) { xcd_barrier(bar); PH_BODY_17 }
    SEAM(17);
    #define PH_BODY_18 phase_combine(C, 1, NGRID, true);
    if (IN(18)) { PH_BODY_18 } if (REPS(18) > 1 && IN(18)) { xcd_barrier(bar); PH_BODY_18 }
#undef ws
#undef IN
#undef SEAM
}

#ifndef MK_PER_PHASE
#define MK_PER_PHASE 0
#endif
extern "C" void kernel_launch(void* const* d_in, const int* in_sizes, int n_in, void* d_out, int out_size, void* d_ws, size_t ws_size, hipStream_t stream) {
    static int grid = 0;
    if (grid == 0) {
        if (n_in != 25 || ws_size < WS_END || out_size != NGRID * D) { fprintf(stderr, "kernel_launch: unexpected problem (n_in %d, ws %zu, out %d)\n", n_in, ws_size, out_size); grid = -1; return; }
        int dev = 0, cus = 0, per_cu = 0;
        if (hipGetDevice(&dev) != hipSuccess || hipDeviceGetAttribute(&cus, hipDeviceAttributeMultiprocessorCount, dev) != hipSuccess) { grid = -1; return; }
        if (hipFuncSetAttribute((const void*)hybrid_fwd, hipFuncAttributeMaxDynamicSharedMemorySize, LDS_BYTES) != hipSuccess) { fprintf(stderr, "kernel_launch: hipFuncSetAttribute failed\n"); grid = -1; return; }
        if (hipOccupancyMaxActiveBlocksPerMultiprocessor(&per_cu, (const void*)hybrid_fwd, NTHREADS, LDS_BYTES) != hipSuccess || per_cu < 1) { fprintf(stderr, "kernel_launch: occupancy query failed (%d)\n", per_cu); grid = -1; return; }
        grid = cus * 1;
        if (grid > 256) grid = 256;
    }
    if (grid < 0) return;
    if (hipMemsetAsync((char*)d_ws + WS_CTL + CT_BAR, 0, 16384, stream) != hipSuccess) { fprintf(stderr, "kernel_launch: memset failed\n"); return; }
    Params p{};
    for (int i = 0; i < 25; ++i) p.in[i] = (const float*)d_in[i];
    p.out = (float*)d_out; p.ws = (unsigned char*)d_ws;
#if MK_PER_PHASE
    for (int ph = 0; ph < 19; ++ph) { p.ph_lo = ph; p.ph_hi = ph + 1; void* args[] = {&p};
        hipError_t e = hipLaunchCooperativeKernel((void*)hybrid_fwd, dim3(grid), dim3(NTHREADS), args, LDS_BYTES, stream);
        if (e != hipSuccess) { fprintf(stderr, "launch phase %d failed: %s\n", ph, hipGetErrorString(e)); break; } }
#else
    p.ph_lo = 0; p.ph_hi = 19; void* args[] = {&p};
    hipError_t e = hipLaunchCooperativeKernel((void*)hybrid_fwd, dim3(grid), dim3(NTHREADS), args, LDS_BYTES, stream);
    if (e != hipSuccess) fprintf(stderr, "cooperative launch failed: %s (grid %d)\n", hipGetErrorString(e), grid);
#endif
}
```

```cpp
#include <hip/hip_runtime.h>
#include <hip/hip_cooperative_groups.h>
#include <cstdio>
#include <cstdint>
namespace cg = cooperative_groups;

#define LAS __attribute__((address_space(3)))
typedef unsigned short bf16_t;
typedef short bf16x8 __attribute__((ext_vector_type(8)));
typedef float f32x4 __attribute__((ext_vector_type(4)));
typedef float f32x2 __attribute__((ext_vector_type(2)));
typedef unsigned u32x4 __attribute__((ext_vector_type(4)));
typedef unsigned u32x2 __attribute__((ext_vector_type(2)));

constexpr int NB = 8, SEQ = 4096, D = 1024, NMETA = 16, LSEQ = SEQ + NMETA;
constexpr int NGRID = NB * SEQ;
constexpr int NTOK = NGRID + NB * NMETA;
constexpr int MPAD = 33024;
constexpr int NEXP = 32, TOPK = 4;
constexpr int PMAX = 139776;
constexpr int MTMAX = PMAX / 256;
constexpr float DN_ALPHA = 1.41421356237f;
constexpr float LN_EPS = 1e-5f;
constexpr int NTHREADS = 512, NWAVES = 8;

constexpr size_t MiB = 1u << 20;
constexpr size_t ACT_BYTES = (size_t)MPAD * D * 2;
constexpr size_t WS_CTL   = 0;
constexpr size_t WS_WIN   = 4 * MiB;
constexpr size_t WS_GATE  = WS_WIN + 4 * MiB;
constexpr size_t WS_LOUT  = WS_GATE + 2 * MiB;
constexpr size_t WS_QKV   = WS_LOUT + 2 * MiB;
constexpr size_t WS_NOUT  = WS_QKV + 6 * MiB;
constexpr size_t WS_WGU   = WS_NOUT + 2 * MiB;
constexpr size_t WS_WD    = WS_WGU + 128 * MiB;
constexpr size_t WS_HB    = WS_WD + 64 * MiB;
constexpr size_t WS_HB8   = WS_HB + 65 * MiB;
constexpr size_t WS_PRE   = WS_HB8 + 33 * MiB;
constexpr size_t WS_H     = WS_PRE + 129 * MiB;
constexpr size_t WS_SCR   = WS_H + 129 * MiB;
constexpr size_t WS_XR = WS_SCR, WS_XC = WS_XR + 65 * MiB, WS_GY = WS_XC + 65 * MiB, WS_LA = WS_GY + 65 * MiB, WS_BB = WS_LA + 130 * MiB, WS_HF = WS_BB + 130 * MiB, WS_G = WS_HF + 65 * MiB;
constexpr size_t WS_SCR_END0 = WS_G + 65 * MiB;
constexpr size_t WS_XS = WS_SCR, WS_ACT = WS_XS + 137 * MiB, WS_YS = WS_ACT + 137 * MiB;
constexpr size_t WS_SCR_END1 = WS_YS + 274 * MiB;
constexpr size_t WS_Q = WS_SCR, WS_K = WS_Q + 65 * MiB, WS_VT = WS_K + 65 * MiB, WS_O = WS_VT + 65 * MiB;
constexpr size_t WS_BIAS = (WS_SCR_END0 > WS_SCR_END1 ? WS_SCR_END0 : WS_SCR_END1);
constexpr size_t WS_BD = WS_BIAS + 2 * 32 * 2048 * 4;
constexpr size_t WS_GBIAS = WS_BD + 2 * 32 * 1024 * 4;
constexpr size_t WS_TOK = WS_BIAS + 1 * MiB;
constexpr size_t WS_QKV8 = WS_TOK + 2 * MiB;
constexpr size_t WS_END = WS_QKV8 + 3 * MiB;
static_assert((size_t)PMAX * 4 <= 1 * MiB, "token offset table");
static_assert(ACT_BYTES <= 65 * MiB && (size_t)PMAX * D * 2 <= 274 * MiB && (size_t)PMAX * D <= 137 * MiB && (size_t)MPAD * D <= 33 * MiB && (size_t)MPAD * D * 4 <= 129 * MiB, "ws map");
static_assert(WS_END <= (size_t)2040 * MiB, "ws map must fit 4x the largest input tensor");
constexpr size_t CT_BC      = 4096;
constexpr size_t CT_TEXP    = CT_BC + 2 * 256 * 32 * 4;
constexpr size_t CT_SPL     = CT_TEXP + 2 * 1024 * 4;
constexpr size_t CT_EID     = 256 * 1024;
constexpr size_t CT_GATEV   = CT_EID + 2 * (size_t)NTOK * 4 * 4;
constexpr size_t CT_POS     = CT_GATEV + 2 * (size_t)NTOK * 4 * 4;
static_assert(CT_POS + 2 * (size_t)NTOK * 4 * 4 <= 4 * MiB, "ctl map");

constexpr int LDS_BYTES = 155648;

__device__ __forceinline__ unsigned f2bf(float f) { unsigned u = __builtin_bit_cast(unsigned, f); return (u + 0x7fffu + ((u >> 16) & 1u)) >> 16; }
__device__ __forceinline__ unsigned cvt_pk_bf16(float lo, float hi);
__device__ __forceinline__ unsigned pk2(float lo, float hi) { return cvt_pk_bf16(lo, hi); }
typedef __bf16 bf16x2_t __attribute__((ext_vector_type(2)));
__device__ __forceinline__ unsigned cvt_pk_bf16(float lo, float hi) { const f32x2 v = {lo, hi}; return __builtin_bit_cast(unsigned, __builtin_convertvector(v, bf16x2_t)); }
__device__ __forceinline__ unsigned pk4_fp8(float a, float b, float c, float d) { int w = __builtin_amdgcn_cvt_pk_fp8_f32(a, b, 0, false); w = __builtin_amdgcn_cvt_pk_fp8_f32(c, d, w, true); return (unsigned)w; }
__device__ __forceinline__ float bflo(unsigned w) { return __builtin_bit_cast(float, w << 16); }
__device__ __forceinline__ float bfhi(unsigned w) { return __builtin_bit_cast(float, w & 0xffff0000u); }
__device__ __forceinline__ void unpack8(const u32x4 w, float (&o)[8]);
__device__ __forceinline__ float fast_exp2(float x) { return __builtin_amdgcn_exp2f(x); }
__device__ __forceinline__ float fast_rcp(float x) { return __builtin_amdgcn_rcpf(x); }
__device__ __forceinline__ float sigmoidf_(float x) { return fast_rcp(1.0f + fast_exp2(-1.44269504089f * x)); }
__device__ __forceinline__ float wave_sum(float v) {
#pragma unroll
    for (int o = 1; o < 64; o <<= 1) v += __shfl_xor(v, o);
    return v;
}
template <int CTRL> __device__ __forceinline__ float dpp_movf(float v) { return __builtin_bit_cast(float, __builtin_amdgcn_update_dpp(0, __builtin_bit_cast(int, v), CTRL, 0xf, 0xf, true)); }
__device__ __forceinline__ float readlane_f(float v, int l) { return __builtin_bit_cast(float, __builtin_amdgcn_readlane(__builtin_bit_cast(int, v), l)); }
__device__ __forceinline__ float wave_sum_dpp(float v) {
    v += dpp_movf<0xB1>(v);
    v += dpp_movf<0x4E>(v);
    v += dpp_movf<0x141>(v);
    v += dpp_movf<0x140>(v);
    return (readlane_f(v, 0) + readlane_f(v, 16)) + (readlane_f(v, 32) + readlane_f(v, 48));
}
__device__ __forceinline__ int seqrow(int b, int s) { return s < NMETA ? NGRID + NMETA * b + s : SEQ * b + (s - NMETA); }

struct Params {
    const float* in[25];
    float* out;
    unsigned char* ws;
    int ph_lo, ph_hi;
};
struct Ctx {
    LAS unsigned char* lds;
    int G, bid, gc;
    unsigned char* ws;
    const float* const* in;
    float* out;
};
__device__ __forceinline__ int fresh_tid() { int t = threadIdx.x; asm volatile("" : "+v"(t)); return t; }
__device__ __forceinline__ unsigned char* fresh_ws(unsigned char* p) { asm volatile("" : "+s"(p)); return p; }
#define PHASE_IDS unsigned char* const wsl = fresh_ws(C.ws); (void)wsl; const int tid = fresh_tid(); const int lane = tid & 63; const int wave = __builtin_amdgcn_readfirstlane(tid >> 6); (void)lane; (void)wave;
enum { I_X = 0, I_META, I_WIN, I_CONVW, I_CONVB, I_WA, I_BA, I_WX, I_BX, I_LAM, I_LOUT, I_WQKV, I_RPB, I_MBIAS, I_NOUT, I_LNMG, I_LNMB, I_RW, I_RB, I_WGU, I_BGU, I_WD, I_BD, I_LNFG, I_LNFB };

namespace pg8 {
constexpr int BM = 256, BK = 64, HALF = 128, HTB = HALF * BK * 2, STAGE_BYTES = 8 * HTB, NXCD = 8, WGM = 8;
constexpr int SIDE_OFF = STAGE_BYTES, TEXP_OFF = STAGE_BYTES + 2048, TOK_OFF = STAGE_BYTES + 2048 + 4096;
__device__ __forceinline__ int lds_byte(int r, int c) { const int st = (r >> 4) * 2 + (c >> 5), rr = r & 15, cc = c & 31, ob = rr * 64 + cc * 2; return st * 1024 + (ob ^ (((ob >> 9) & 1) << 5)); }
__device__ __forceinline__ void stage_rc(int b, int& R, int& C) { const int st = b / 1024, sb = b % 1024, swz = sb ^ (((sb >> 9) & 1) << 5); R = (st >> 1) * 16 + swz / 64; C = (st & 1) * 32 + (swz % 64) / 2; }
__device__ __forceinline__ int perm32(int rho) { const int n = rho >> 4, i = rho & 15; return 8 * (i >> 2) + 4 * n + (i & 3); }

typedef int v8i __attribute__((ext_vector_type(8)));
typedef int v4i __attribute__((ext_vector_type(4)));
__device__ __forceinline__ v8i cat8(bf16x8 a, bf16x8 b) { const v4i x = __builtin_bit_cast(v4i, a), y = __builtin_bit_cast(v4i, b); return __builtin_shufflevector(x, y, 0, 1, 2, 3, 4, 5, 6, 7); }
struct Unit { unsigned ao, bo, to; int pm, pn, aux; };

__device__ __forceinline__ void tile_of(int L, int nM, int nN, int& pm, int& pn) {
    const int nwg = nM * nN; int wgid = L;
    { const int q = nwg / NXCD, r = nwg % NXCD, xcd = wgid % NXCD, off = wgid / NXCD; wgid = (xcd < r ? xcd * (q + 1) : r * (q + 1) + (xcd - r) * q) + off; }
    const int nig = WGM * nN, gid = wgid / nig, fm = gid * WGM, gsz = (nM - fm) < WGM ? (nM - fm) : WGM;
    pm = fm + ((wgid % nig) % gsz); pn = (wgid % nig) / gsz;
}

template <bool F8, bool GATHER, class Epi, class Sched>
__device__ __forceinline__ void gemm_phase(LAS unsigned char* lds, const unsigned char* wsbase, const int K, const int lda, const int ldb, const Sched& S, const Epi& E) {
    const __amdgpu_buffer_rsrc_t rsrc = __builtin_amdgcn_make_buffer_rsrc((void*)wsbase, 0, 0xFFFFFFFF, 0x00020000);
    const int tid = fresh_tid(), wid = __builtin_amdgcn_readfirstlane(tid >> 6), lane = tid & 63, wr = wid >> 2, wc = wid & 3;
    const int nt = K / BK;
    int f8scales = 0; if constexpr (F8) { f8scales = Epi::SCALES; asm volatile("" : "+v"(f8scales)); }
    int voffA, voffB;
    { int R, C; stage_rc(tid * 16, R, C); const int Rb = Epi::PERM ? ((R & ~31) + perm32(R & 31)) : R; voffA = ((GATHER ? 0 : R * lda) + C) * 2; voffB = (Rb * ldb + C) * 2; }
    const int tokb = (16 * (wid >> 1) + (lane >> 2)) * 4;
    const unsigned kstep = (unsigned)(BK * 2);
    const unsigned hstepA = (unsigned)HALF * lda * 2, hstepB = (unsigned)HALF * ldb * 2;
    const unsigned ldsw = (unsigned)wid * 1024u;
    const int aoff = lds_byte(wr * 64 + (lane & 15), (lane >> 4) * 8), boff = lds_byte(wc * 32 + (lane & 15), (lane >> 4) * 8);
#define PG8_SA(b, h) (((b) * 2 + (h)) * HTB)
#define PG8_SB(b, h) ((4 + (b) * 2 + (h)) * HTB)
#define PG8_STAGE(bufoff, gbase, voff) do { _Pragma("unroll") for (int _i = 0; _i < 2; ++_i) \
        __builtin_amdgcn_raw_ptr_buffer_load_lds(rsrc, (LAS void*)(lds + (bufoff) + ldsl + _i * 8192), 16, voff, __builtin_amdgcn_readfirstlane((int)((gbase) + (unsigned)_i * (hstep##voff >> 1))), 0, 0); } while (0)
#define hstepvoffA hstepA
#define hstepvoffB hstepB
#define PG8_STAGE_A(bufoff, aoffs, h, par) do { if constexpr (GATHER) { _Pragma("unroll") for (int _i = 0; _i < 2; ++_i) { \
            const int _tk = *(const LAS int*)(lds + TOK_OFF + (par) * 1024 + tokb + ((h) * 128 + _i * 64) * 4); \
            __builtin_amdgcn_raw_ptr_buffer_load_lds(rsrc, (LAS void*)(lds + (bufoff) + ldsl + _i * 8192), 16, _tk + voffA, __builtin_amdgcn_readfirstlane((int)(aoffs)), 0, 0); } } \
        else { PG8_STAGE(bufoff, (aoffs) + (unsigned)(h) * hstepA, voffA); } } while (0)
#define PG8_TOK(unit, par) do { if constexpr (GATHER) { if (wid == 0) __builtin_amdgcn_raw_ptr_buffer_load_lds(rsrc, (LAS void*)(lds + TOK_OFF + (par) * 1024), 16, lane * 16, (int)(unit).to, 0, 0); } } while (0)
#define PG8_LDA(dst, b, h) do { _Pragma("unroll") for (int m = 0; m < 4; ++m) _Pragma("unroll") for (int k = 0; k < 2; ++k) dst[m][k] = *(const LAS bf16x8*)(lds + PG8_SA(b, h) + aoff + m * 2048 + k * 1024); } while (0)
#define PG8_LDB(dst, b, h) do { _Pragma("unroll") for (int n = 0; n < 2; ++n) _Pragma("unroll") for (int k = 0; k < 2; ++k) dst[n][k] = *(const LAS bf16x8*)(lds + PG8_SB(b, h) + boff + n * 2048 + k * 1024); } while (0)
#define PG8_MMA(ai, bj, At, Bt) do { __builtin_amdgcn_s_setprio(1); _Pragma("unroll") for (int m = 0; m < 4; ++m) _Pragma("unroll") for (int n = 0; n < 2; ++n) { \
        if constexpr (F8) { asm volatile("v_mfma_scale_f32_16x16x128_f8f6f4 %0, %1, %2, %0, %3, %3 op_sel:[0,1,0] op_sel_hi:[0,0,0]" : "+v"(acc[ai][bj][m][n]) : "v"(cat8(Bt[n][0], Bt[n][1])), "v"(cat8(At[m][0], At[m][1])), "v"(f8scales)); } \
        else { _Pragma("unroll") for (int k = 0; k < 2; ++k) acc[ai][bj][m][n] = __builtin_amdgcn_mfma_f32_16x16x32_bf16(Bt[n][k], At[m][k], acc[ai][bj][m][n], 0, 0, 0); } } \
        __builtin_amdgcn_s_setprio(0); } while (0)
#define PG8_WAIT_V(n) asm volatile("s_waitcnt vmcnt(" #n ")" ::: "memory")
#define PG8_WAIT_L(n) asm volatile("s_waitcnt lgkmcnt(" #n ")" ::: "memory")
#define PG8_BAR __builtin_amdgcn_s_barrier()
#define PG8_SCHED __builtin_amdgcn_sched_barrier(0)
    Unit cur, nxt; int ui = 0;
    if (!S.next(0, cur)) return;
    f32x4 acc[2][2][4][2];
    bf16x8 At[4][2], B0[2][2], B1[2][2];
#define PG8_INIT(par) do { if constexpr (Epi::SIDE) { const int _l = fresh_tid() & 63; E.init(acc, (const LAS float*)(lds + SIDE_OFF + (par) * 1024), wc, _l >> 4); } \
        else { _Pragma("unroll") for (int a = 0; a < 2; ++a) _Pragma("unroll") for (int b = 0; b < 2; ++b) _Pragma("unroll") for (int m = 0; m < 4; ++m) _Pragma("unroll") for (int n = 0; n < 2; ++n) acc[a][b][m][n] = (f32x4){0.f, 0.f, 0.f, 0.f}; } } while (0)
    unsigned cA = cur.ao, cB = cur.bo;
    unsigned ldsl = ldsw; asm volatile("" : "+s"(ldsl));
#define PG8_SIDE(unit, par) do { if constexpr (Epi::SIDE) { if (wid == 0) __builtin_amdgcn_raw_ptr_buffer_load_lds(rsrc, (LAS void*)(lds + SIDE_OFF + (par) * 1024), 16, lane * 16, (int)E.side_off(unit), 0, 0); } } while (0)
    PG8_SIDE(cur, 0);
    if constexpr (GATHER) PG8_TOK(cur, 0);
    if constexpr (GATHER || Epi::SIDE) { asm volatile("s_waitcnt vmcnt(0)" ::: "memory"); PG8_BAR; }
    PG8_INIT(0);
    PG8_STAGE(PG8_SB(0, 0), cB, voffB); PG8_STAGE(PG8_SB(0, 1), cB + hstepB, voffB); PG8_STAGE_A(PG8_SA(0, 0), cA, 0, 0); PG8_STAGE_A(PG8_SA(0, 1), cA, 1, 0);
    if (wr == 1) PG8_BAR;
    PG8_WAIT_V(2); PG8_BAR;
    PG8_STAGE(PG8_SB(1, 0), cB + kstep, voffB); PG8_STAGE_A(PG8_SA(1, 0), cA + kstep, 0, 0); PG8_STAGE(PG8_SB(1, 1), cB + hstepB + kstep, voffB);
    PG8_WAIT_V(6); PG8_BAR;
    for (;;) {
        const bool has_next = S.next(ui + 1, nxt);
        if (has_next) { PG8_TOK(nxt, (ui + 1) & 1); PG8_SIDE(nxt, (ui + 1) & 1); }
        const unsigned nA = has_next ? nxt.ao : cA, nB = has_next ? nxt.bo : cB;
#pragma unroll 1
        for (int t = 0; t < nt; t += 2) {
            const bool last = (t == nt - 2);
            ldsl = ldsw; asm volatile("" : "+s"(ldsl));
            const int parc = ui & 1, parn = (ui + ((last && has_next) ? 1 : 0)) & 1;
            const unsigned a1 = cA + (unsigned)(t + 1) * kstep;
            const unsigned a2 = last ? nA : cA + (unsigned)(t + 2) * kstep, b2 = last ? nB : cB + (unsigned)(t + 2) * kstep;
            const unsigned a3 = a2 + kstep, b3 = b2 + kstep;
            PG8_LDB(B0, 0, 0); PG8_LDB(B1, 0, 1); PG8_SCHED; PG8_LDA(At, 0, 0); PG8_STAGE_A(PG8_SA(1, 1), a1, 1, parc);
            PG8_WAIT_V(8); PG8_WAIT_L(0); PG8_BAR; PG8_MMA(0, 0, At, B0); PG8_MMA(0, 1, At, B1); PG8_BAR; PG8_SCHED;
            PG8_LDA(At, 0, 1); PG8_STAGE(PG8_SB(0, 0), b2, voffB); PG8_STAGE(PG8_SB(0, 1), b2 + hstepB, voffB); PG8_STAGE_A(PG8_SA(0, 0), a2, 0, parn);
            PG8_WAIT_V(8); PG8_WAIT_L(0); PG8_BAR; PG8_MMA(1, 0, At, B0); PG8_MMA(1, 1, At, B1); PG8_BAR; PG8_SCHED;
            PG8_LDB(B0, 1, 0); PG8_LDB(B1, 1, 1); PG8_SCHED; PG8_LDA(At, 1, 0); PG8_STAGE_A(PG8_SA(0, 1), a2, 1, parn);
            PG8_WAIT_V(8); PG8_WAIT_L(0); PG8_BAR; PG8_MMA(0, 0, At, B0); PG8_MMA(0, 1, At, B1); PG8_BAR; PG8_SCHED;
            PG8_LDA(At, 1, 1); PG8_STAGE(PG8_SB(1, 0), b3, voffB); PG8_STAGE(PG8_SB(1, 1), b3 + hstepB, voffB); PG8_STAGE_A(PG8_SA(1, 0), a3, 0, parn);
            PG8_WAIT_V(8); PG8_WAIT_L(0); PG8_BAR; PG8_MMA(1, 0, At, B0); PG8_MMA(1, 1, At, B1); PG8_BAR; PG8_SCHED;
        }
        if constexpr (F8) asm volatile("s_nop 15\n\ts_nop 15" ::: "memory");
        if (wr == 0) PG8_BAR;
        { const int l2 = fresh_tid() & 63; E(acc, cur, wr, wc, l2 & 15, l2 >> 4, (const LAS float*)(lds + SIDE_OFF + (ui & 1) * 1024)); }
        if (!has_next) break;
        cur = nxt; cA = nA; cB = nB; ++ui;
        PG8_INIT(ui & 1);
        if (wr == 1) PG8_BAR;
    }
    PG8_WAIT_V(0);
    PG8_BAR;
#undef PG8_SA
#undef PG8_SB
#undef PG8_STAGE
#undef PG8_STAGE_A
#undef PG8_TOK
#undef PG8_SIDE
#undef PG8_INIT
#undef hstepvoffA
#undef hstepvoffB
#undef PG8_LDA
#undef PG8_LDB
#undef PG8_MMA
#undef PG8_WAIT_V
#undef PG8_WAIT_L
#undef PG8_BAR
#undef PG8_SCHED
}
}

using pg8::Unit;

struct DenseSched {
    unsigned A, Bt; int lda, ldb, nM, nN, G, c;
    __device__ __forceinline__ bool next(int i, Unit& u) const {
        const int L = i * G + c; if (L >= nM * nN) return false;
        pg8::tile_of(L, nM, nN, u.pm, u.pn); u.aux = 0; u.to = 0;
        u.ao = A + (unsigned)u.pm * 256 * lda * 2; u.bo = Bt + (unsigned)u.pn * 256 * ldb * 2; return true;
    }
};
struct GateSched {
    unsigned XC, GT; int nM, G, c;
    __device__ __forceinline__ bool next(int i, Unit& u) const {
        const int per = nM * 4; const int L = i * G + c; if (L >= 4 * per) return false;
        const int nb = L / per; pg8::tile_of(L - nb * per, nM, 4, u.pm, u.pn); u.aux = nb; u.to = 0;
        u.ao = XC + ((unsigned)u.pm * 256 * 1024 + 256 * nb) * 2; u.bo = GT + ((unsigned)nb * 1024 + 256 * u.pn) * 256 * 2; return true;
    }
};
struct QkvSched {
    unsigned HB, WT; int nM, G, c;
    __device__ __forceinline__ bool next(int i, Unit& u) const {
        const int n0 = nM * 8, n1 = 4 * nM; const int L = i * G + c; if (L >= n0 + n1) return false; u.to = 0;
        if (L < n0) { pg8::tile_of(L, nM, 8, u.pm, u.pn); u.aux = 0; u.ao = HB + (unsigned)u.pm * 256 * 1024; u.bo = WT + (unsigned)u.pn * 256 * 1024; }
        else { pg8::tile_of(L - n0, 4, nM, u.pm, u.pn); u.aux = 1; u.ao = WT + (unsigned)(2048 + u.pm * 256) * 1024; u.bo = HB + (unsigned)u.pn * 256 * 1024; }
        return true;
    }
};
struct MoeSched {
    unsigned A, W, tok; const LAS int* texp; unsigned wstride; int nM, nN, G, c;
    __device__ __forceinline__ bool next(int i, Unit& u) const {
        const int L = i * G + c; if (L >= nM * nN) return false;
        pg8::tile_of(L, nM, nN, u.pm, u.pn);
        const int e = __builtin_amdgcn_readfirstlane(texp[u.pm]); u.aux = e;
        u.ao = tok ? A : A + (unsigned)u.pm * 256 * 1024; u.to = tok + (unsigned)u.pm * 1024; u.bo = W + (unsigned)e * wstride + (unsigned)u.pn * 256 * 1024; return true;
    }
};

#define EPI_ARGS const f32x4 (&acc)[2][2][4][2], const Unit& u, int wr, int wc, int fr, int fq, const LAS float* side
struct EpiWin {
    static constexpr bool PERM = true, SIDE = false;
    bf16_t* XR; bf16_t* GY;
    __device__ __forceinline__ void operator()(EPI_ARGS) const {
        const int row0 = u.pm * 256 + wr * 64 + fr;
        if (u.pn < 4) {
            const int col0 = u.pn * 256 + wc * 32 + 8 * fq;
#pragma unroll
            for (int ai = 0; ai < 2; ++ai)
#pragma unroll
                for (int m = 0; m < 4; ++m) { bf16_t* rowp = XR + (size_t)(row0 + ai * 128 + m * 16) * D + col0;
#pragma unroll
                    for (int bj = 0; bj < 2; ++bj) { const f32x4 v0 = acc[ai][bj][m][0], v1 = acc[ai][bj][m][1];
                        u32x4 w; w.x = cvt_pk_bf16(v0[0], v0[1]); w.y = cvt_pk_bf16(v0[2], v0[3]); w.z = cvt_pk_bf16(v1[0], v1[1]); w.w = cvt_pk_bf16(v1[2], v1[3]);
                        *(u32x4*)(rowp + bj * 128) = w; } }
        } else {
#pragma unroll
            for (int ai = 0; ai < 2; ++ai)
#pragma unroll
                for (int m = 0; m < 4; ++m) { const int row = row0 + ai * 128 + m * 16;
#pragma unroll
                    for (int bj = 0; bj < 2; ++bj) { const int g = (u.pn - 4) * 8 + bj * 4 + wc;
                        float o[8];
#pragma unroll
                        for (int n = 0; n < 2; ++n)
#pragma unroll
                            for (int j = 0; j < 4; ++j) { const float v = acc[ai][bj][m][n][j]; const float z = 1.5957691216f * (v + 0.044715f * v * v * v); o[n * 4 + j] = v * sigmoidf_(z); }
                        u32x4 w; w.x = cvt_pk_bf16(o[0], o[1]); w.y = cvt_pk_bf16(o[2], o[3]); w.z = cvt_pk_bf16(o[4], o[5]); w.w = cvt_pk_bf16(o[6], o[7]);
                        *(u32x4*)(GY + ((size_t)g * MPAD + row) * 32 + 8 * fq) = w; } }
        }
    }
};
struct EpiGate {
    static constexpr bool PERM = true, SIDE = true;
    const bf16_t* XC; bf16_t* LA; bf16_t* BB; const float* spl; unsigned bias_off;
    __device__ __forceinline__ unsigned side_off(const Unit& u) const { return bias_off + (unsigned)((((u.pn >> 1) * 4 + u.aux) * 2 + (u.pn & 1)) * 1024); }
    __device__ __forceinline__ void init(f32x4 (&acc)[2][2][4][2], const LAS float* side, int wc, int fq) const {
#pragma unroll
        for (int bj = 0; bj < 2; ++bj)
#pragma unroll
            for (int n = 0; n < 2; ++n) { const f32x4 b = *(const LAS f32x4*)(side + 128 * bj + 32 * wc + 8 * fq + 4 * n);
#pragma unroll
                for (int ai = 0; ai < 2; ++ai)
#pragma unroll
                    for (int m = 0; m < 4; ++m) acc[ai][bj][m][n] = b; }
    }
    __device__ __forceinline__ void operator()(EPI_ARGS) const {
        const int nb = u.aux, dir = u.pn >> 1, half = u.pn & 1;
        const int ch0 = 256 * nb + 128 * half + 32 * wc + 8 * fq, g = ch0 >> 5;
        const int row0 = u.pm * 256 + wr * 64 + fr;
        float csp[8];
        { const f32x4 p0 = *(const f32x4*)(spl + dir * 1024 + ch0), p1 = *(const f32x4*)(spl + dir * 1024 + ch0 + 4);
#pragma unroll
          for (int j = 0; j < 4; ++j) { csp[j] = -p0[j]; csp[4 + j] = -p1[j]; } }
        u32x4 xnext = *(const u32x4*)(XC + (size_t)row0 * D + ch0);
#pragma unroll
        for (int ai = 0; ai < 2; ++ai)
#pragma unroll
            for (int m = 0; m < 4; ++m) { const int row = row0 + ai * 128 + m * 16;
                const u32x4 xw = xnext;
                { const int it = ai * 4 + m + 1, rn = row0 + (it >> 2) * 128 + (it & 3) * 16; if (it < 8) xnext = *(const u32x4*)(XC + (size_t)rn * D + ch0); }
                float xc[8]; unpack8(xw, xc);
                const bool start = dir == 1 && (row & (SEQ - 1)) == SEQ - 1;
                float la[8], bb[8];
#pragma unroll
                for (int n = 0; n < 2; ++n)
#pragma unroll
                    for (int j = 0; j < 4; ++j) { const int i = n * 4 + j;
                        const float l2 = csp[i] * sigmoidf_(acc[ai][0][m][n][j]); const float a2 = fast_exp2(2.0f * l2);
                        const float mult = start ? 1.0f : __builtin_amdgcn_sqrtf(fmaxf(1.0f - a2, 0.0f));
                        la[i] = l2; bb[i] = mult * sigmoidf_(acc[ai][1][m][n][j]) * xc[i]; }
                u32x4 w; w.x = cvt_pk_bf16(la[0], la[1]); w.y = cvt_pk_bf16(la[2], la[3]); w.z = cvt_pk_bf16(la[4], la[5]); w.w = cvt_pk_bf16(la[6], la[7]);
                const size_t o = (((size_t)dir * 32 + g) * MPAD + row) * 32 + 8 * fq;
                *(u32x4*)(LA + o) = w;
                w.x = cvt_pk_bf16(bb[0], bb[1]); w.y = cvt_pk_bf16(bb[2], bb[3]); w.z = cvt_pk_bf16(bb[4], bb[5]); w.w = cvt_pk_bf16(bb[6], bb[7]);
                *(u32x4*)(BB + o) = w; }
    }
};
template <bool LAYER0> struct EpiRes {
    static constexpr bool PERM = true, SIDE = false;
    bf16_t* PRE; const float* x; const float* meta; const bf16_t* HB; int nrows;
    __device__ __forceinline__ void operator()(EPI_ARGS) const {
        const int row0 = u.pm * 256 + wr * 64 + fr, col0 = u.pn * 256 + wc * 32 + 8 * fq;
#pragma unroll
        for (int ai = 0; ai < 2; ++ai)
#pragma unroll
            for (int m = 0; m < 4; ++m) { const int row = row0 + ai * 128 + m * 16;
                if (row < nrows) {
#pragma unroll
                    for (int bj = 0; bj < 2; ++bj) { const int c = col0 + bj * 128; float r[8];
                        if (LAYER0) { const float* rp = (row < NGRID ? x + (size_t)row * D : meta + (size_t)((row - NGRID) & 15) * D) + c; const f32x4 r0 = *(const f32x4*)rp, r1 = *(const f32x4*)(rp + 4);
                            r[0] = r0[0]; r[1] = r0[1]; r[2] = r0[2]; r[3] = r0[3]; r[4] = r1[0]; r[5] = r1[1]; r[6] = r1[2]; r[7] = r1[3]; }
                        else { const u32x4 rw = *(const u32x4*)(HB + (size_t)row * D + c); r[0] = bflo(rw.x); r[1] = bfhi(rw.x); r[2] = bflo(rw.y); r[3] = bfhi(rw.y); r[4] = bflo(rw.z); r[5] = bfhi(rw.z); r[6] = bflo(rw.w); r[7] = bfhi(rw.w); }
                        const f32x4 a0 = acc[ai][bj][m][0], a1 = acc[ai][bj][m][1];
                        u32x4 w; w.x = cvt_pk_bf16(r[0] * DN_ALPHA + a0[0], r[1] * DN_ALPHA + a0[1]); w.y = cvt_pk_bf16(r[2] * DN_ALPHA + a0[2], r[3] * DN_ALPHA + a0[3]);
                        w.z = cvt_pk_bf16(r[4] * DN_ALPHA + a1[0], r[5] * DN_ALPHA + a1[1]); w.w = cvt_pk_bf16(r[6] * DN_ALPHA + a1[2], r[7] * DN_ALPHA + a1[3]);
                        *(u32x4*)(PRE + (size_t)row * D + c) = w; }
                }
                asm volatile("" ::: "memory"); }
    }
};
struct EpiGlu {
    static constexpr bool PERM = true, SIDE = true; static constexpr int SCALES = 0x7F79;
    unsigned char* ACT; unsigned bias_off;
    __device__ __forceinline__ unsigned side_off(const Unit& u) const { return bias_off + (unsigned)((u.aux * 8 + u.pn) * 1024); }
    __device__ __forceinline__ void init(f32x4 (&acc)[2][2][4][2], const LAS float* side, int wc, int fq) const {
#pragma unroll
        for (int bj = 0; bj < 2; ++bj)
#pragma unroll
            for (int n = 0; n < 2; ++n) { const f32x4 b = *(const LAS f32x4*)(side + 128 * bj + 32 * wc + 8 * fq + 4 * n);
#pragma unroll
                for (int ai = 0; ai < 2; ++ai)
#pragma unroll
                    for (int m = 0; m < 4; ++m) acc[ai][bj][m][n] = b; }
    }
    __device__ __forceinline__ void operator()(EPI_ARGS) const {
        const int f0 = 128 * u.pn + 32 * wc + 8 * fq;
        const int row0 = u.pm * 256 + wr * 64 + fr;
#pragma unroll
        for (int ai = 0; ai < 2; ++ai)
#pragma unroll
            for (int m = 0; m < 4; ++m) { const int row = row0 + ai * 128 + m * 16; float o[8];
#pragma unroll
                for (int n = 0; n < 2; ++n)
#pragma unroll
                    for (int j = 0; j < 4; ++j) { const int i = n * 4 + j;
                        const float glu = fminf(acc[ai][0][m][n][j], 7.0f);
                        const float lin4 = __builtin_fmaf(__builtin_amdgcn_fmed3f(acc[ai][1][m][n][j], -7.0f, 7.0f), 4.0f, 4.0f);
                        const float r = fast_rcp(1.0f + fast_exp2(glu * (-1.702f * 1.44269504089f)));
                        o[i] = (glu * r) * lin4; }
                u32x2 w; w.x = pk4_fp8(o[0], o[1], o[2], o[3]); w.y = pk4_fp8(o[4], o[5], o[6], o[7]);
                *(u32x2*)(ACT + (size_t)row * D + f0) = w; }
    }
};
struct EpiNull {
    static constexpr bool PERM = true, SIDE = false; static constexpr int SCALES = 0x7F79;
    __device__ __forceinline__ void operator()(EPI_ARGS) const {
#pragma unroll
        for (int ai = 0; ai < 2; ++ai)
#pragma unroll
            for (int bj = 0; bj < 2; ++bj)
#pragma unroll
                for (int m = 0; m < 4; ++m)
#pragma unroll
                    for (int n = 0; n < 2; ++n) asm volatile("" :: "v"(acc[ai][bj][m][n]));
    }
};
struct EpiDown {
    static constexpr bool PERM = true, SIDE = true; static constexpr int SCALES = 0x7D79;
    bf16_t* YS; unsigned bias_off;
    __device__ __forceinline__ unsigned side_off(const Unit& u) const { return bias_off + (unsigned)((u.aux * 4 + u.pn) * 1024); }
    __device__ __forceinline__ void init(f32x4 (&acc)[2][2][4][2], const LAS float* side, int wc, int fq) const {
#pragma unroll
        for (int bj = 0; bj < 2; ++bj)
#pragma unroll
            for (int n = 0; n < 2; ++n) { const f32x4 b = *(const LAS f32x4*)(side + 128 * bj + 32 * wc + 8 * fq + 4 * n);
#pragma unroll
                for (int ai = 0; ai < 2; ++ai)
#pragma unroll
                    for (int m = 0; m < 4; ++m) acc[ai][bj][m][n] = b; }
    }
    __device__ __forceinline__ void operator()(EPI_ARGS) const {
        const int row0 = u.pm * 256 + wr * 64 + fr, col0 = u.pn * 256 + wc * 32 + 8 * fq;
#pragma unroll
        for (int ai = 0; ai < 2; ++ai)
#pragma unroll
            for (int m = 0; m < 4; ++m) { bf16_t* rowp = YS + (size_t)(row0 + ai * 128 + m * 16) * D + col0;
#pragma unroll
                for (int bj = 0; bj < 2; ++bj) { const f32x4 v0 = acc[ai][bj][m][0], v1 = acc[ai][bj][m][1];
                    u32x4 w; w.x = cvt_pk_bf16(v0[0], v0[1]); w.y = cvt_pk_bf16(v0[2], v0[3]); w.z = cvt_pk_bf16(v1[0], v1[1]); w.w = cvt_pk_bf16(v1[2], v1[3]);
                    *(u32x4*)(rowp + bj * 128) = w; } }
    }
};
struct EpiQkv {
    static constexpr bool PERM = true, SIDE = false; static constexpr int SCALES = 0x7F79;
    bf16_t* Q; bf16_t* Kx; bf16_t* VT;
    __device__ __forceinline__ void operator()(EPI_ARGS) const {
        const int row0 = u.pm * 256 + wr * 64 + fr; bf16_t* base; int ldc, colt; float sc = 1.0f;
        if (u.aux == 0) { ldc = D; if (u.pn < 4) { base = Q; colt = u.pn * 256; sc = 0.125f * 1.44269504089f; } else { base = Kx; colt = (u.pn - 4) * 256; } }
        else { base = VT; ldc = MPAD; colt = u.pn * 256; }
        const int col0 = colt + wc * 32 + 8 * fq;
#pragma unroll
        for (int ai = 0; ai < 2; ++ai)
#pragma unroll
            for (int m = 0; m < 4; ++m) { bf16_t* rowp = base + (size_t)(row0 + ai * 128 + m * 16) * ldc + col0;
#pragma unroll
                for (int bj = 0; bj < 2; ++bj) { const f32x4 v0 = acc[ai][bj][m][0] * sc, v1 = acc[ai][bj][m][1] * sc;
                    u32x4 w; w.x = cvt_pk_bf16(v0[0], v0[1]); w.y = cvt_pk_bf16(v0[2], v0[3]); w.z = cvt_pk_bf16(v1[0], v1[1]); w.w = cvt_pk_bf16(v1[2], v1[3]);
                    *(u32x4*)(rowp + bj * 128) = w; } }
    }
};

__device__ __forceinline__ void tr_item(const float* W, int ld, int kb, int n0, bf16_t* dst0, int K, LAS float* scr, int lane) {
    const int r = lane >> 4, q = lane & 15;
    f32x4 v[16];
#pragma unroll
    for (int i = 0; i < 16; ++i) v[i] = __builtin_nontemporal_load((const f32x4*)(W + (size_t)(64 * kb + 4 * i + r) * ld + n0 + 4 * q));
#pragma unroll
    for (int i = 0; i < 16; ++i) { LAS float* s = scr + (4 * i + r) * 65 + 4 * q; s[0] = v[i][0]; s[1] = v[i][1]; s[2] = v[i][2]; s[3] = v[i][3]; }
    asm volatile("s_waitcnt lgkmcnt(0)" ::: "memory");
    const int c = lane & 7, nn = lane >> 3;
#pragma unroll
    for (int j = 0; j < 8; ++j) { const int n = nn + 8 * j; const LAS float* s = scr + (8 * c) * 65 + n;
        u32x4 o; o.x = pk2(s[0], s[65]); o.y = pk2(s[2 * 65], s[3 * 65]); o.z = pk2(s[4 * 65], s[5 * 65]); o.w = pk2(s[6 * 65], s[7 * 65]);
        *(u32x4*)(dst0 + (size_t)n * K + 64 * kb + 8 * c) = o; }
    asm volatile("s_waitcnt lgkmcnt(0)" ::: "memory");
}
__device__ __forceinline__ void tr_item8(const float* W, int ld, int kb, int n0, unsigned char* dst0, int K, LAS float* scr, int lane) {
    const int r = lane >> 4, q = lane & 15;
    f32x4 v[16];
#pragma unroll
    for (int i = 0; i < 16; ++i) v[i] = __builtin_nontemporal_load((const f32x4*)(W + (size_t)(64 * kb + 4 * i + r) * ld + n0 + 4 * q));
#pragma unroll
    for (int i = 0; i < 16; ++i) { LAS float* s = scr + (4 * i + r) * 65 + 4 * q; s[0] = v[i][0]; s[1] = v[i][1]; s[2] = v[i][2]; s[3] = v[i][3]; }
    asm volatile("s_waitcnt lgkmcnt(0)" ::: "memory");
    const int c = lane & 7, nn = lane >> 3;
#pragma unroll
    for (int j = 0; j < 8; ++j) { const int n = nn + 8 * j; const LAS float* s = scr + (8 * c) * 65 + n;
        u32x2 o; o.x = pk4_fp8(s[0] * 64.0f, s[65] * 64.0f, s[2 * 65] * 64.0f, s[3 * 65] * 64.0f); o.y = pk4_fp8(s[4 * 65] * 64.0f, s[5 * 65] * 64.0f, s[6 * 65] * 64.0f, s[7 * 65] * 64.0f);
        *(u32x2*)(dst0 + (size_t)n * K + 64 * kb + 8 * c) = o; }
    asm volatile("s_waitcnt lgkmcnt(0)" ::: "memory");
}
__device__ __forceinline__ void phase_convert(const Ctx& C) {
    PHASE_IDS
    LAS float* scr = (LAS float*)(C.lds + wave * 16640);
    const int gw = C.bid * NWAVES + wave, NGW = C.G * NWAVES;
    constexpr int I0 = 512, I1 = 256, I2 = 256, I3 = 768, I4 = 256, I5 = 32768, I6 = 16384, I7 = 768, NIT = I0 + I1 + I2 + I3 + I4 + I5 + I6 + I7;
    for (int it = gw; it < NIT; it += NGW) {
        int r = it;
        if (r < I0) { const int nbk = r & 31, kb = r >> 5; tr_item(C.in[I_WIN], 2048, kb, 64 * nbk, (bf16_t*)(wsl + WS_WIN) + (size_t)(64 * nbk) * 1024, 1024, scr, lane); continue; } r -= I0;
        if (r < I1) { const int job = r >> 3, sub = r & 7, nbk = sub & 1, kb = sub >> 1;
            const int half = job & 1, which = (job >> 1) & 1, nb = (job >> 2) & 3, dir = job >> 4;
            const float* src = C.in[which ? I_WX : I_WA] + (size_t)(dir * 4 + nb) * 65536;
            bf16_t* dst = (bf16_t*)(wsl + WS_GATE) + ((size_t)nb * 1024 + 256 * (2 * dir + half) + 128 * which + 64 * nbk) * 256;
            tr_item(src, 256, kb, 128 * half + 64 * nbk, dst, 256, scr, lane); continue; } r -= I1;
        if (r < I2) { const int nbk = r & 15, kb = r >> 4; tr_item(C.in[I_LOUT], 1024, kb, 64 * nbk, (bf16_t*)(wsl + WS_LOUT) + (size_t)(64 * nbk) * 1024, 1024, scr, lane); continue; } r -= I2;
        if (r < I3) { const int nbk = r % 48, kb = r / 48; tr_item(C.in[I_WQKV], 3072, kb, 64 * nbk, (bf16_t*)(wsl + WS_QKV) + (size_t)(64 * nbk) * 1024, 1024, scr, lane); continue; } r -= I3;
        if (r < I4) { const int nbk = r & 15, kb = r >> 4; tr_item(C.in[I_NOUT], 1024, kb, 64 * nbk, (bf16_t*)(wsl + WS_NOUT) + (size_t)(64 * nbk) * 1024, 1024, scr, lane); continue; } r -= I4;
        if (r < I5) { const int mat = r >> 9, sub = r & 511, nbk = sub & 31, kb = sub >> 5; const int n0 = 64 * nbk, bj = n0 >> 10, f0 = n0 & 1023, pn = f0 >> 7, jj = f0 & 127;
            tr_item8(C.in[I_WGU] + (size_t)mat * 1024 * 2048, 2048, kb, n0, (unsigned char*)(wsl + WS_WGU) + ((size_t)mat * 2048 + 256 * pn + 128 * bj + jj) * 1024, 1024, scr, lane); continue; } r -= I5;
        if (r >= I6) { r -= I6; const int nbk = r % 48, kb = r / 48; tr_item8(C.in[I_WQKV], 3072, kb, 64 * nbk, (unsigned char*)(wsl + WS_QKV8) + (size_t)(64 * nbk) * 1024, 1024, scr, lane); continue; }
        { const int mat = r >> 8, sub = r & 255, nbk = sub & 15, kb = sub >> 4;
            tr_item8(C.in[I_WD] + (size_t)mat * 1024 * 1024, 1024, kb, 64 * nbk, (unsigned char*)(wsl + WS_WD) + ((size_t)mat * 1024 + 64 * nbk) * 1024, 1024, scr, lane); }
    }
    const int gt = C.bid * NTHREADS + tid, NGT = C.G * NTHREADS;
    for (int i = gt; i < 2048; i += NGT) ((float*)(wsl + WS_CTL + CT_SPL))[i] = 8.0f * 1.44269504089f * log1pf(expf(-C.in[I_LAM][i]));
    for (int i = gt; i < 2 * 32 * 2048; i += NGT) { const int le = i >> 11, r = i & 2047, pn = r >> 8, bj = (r >> 7) & 1, ii = r & 127;
        ((float*)(wsl + WS_BIAS))[i] = C.in[I_BGU][(size_t)le * 2048 + bj * 1024 + 128 * pn + ii]; }
    for (int i = gt; i < 2 * 32 * 1024; i += NGT) ((float*)(wsl + WS_BD))[i] = C.in[I_BD][i];
    for (int i = gt; i < 4096; i += NGT) { const int ut = i >> 8, which = (i >> 7) & 1, jj = i & 127, dir = ut >> 3, nb = (ut >> 1) & 3, half = ut & 1;
        ((float*)(wsl + WS_GBIAS))[i] = C.in[which ? I_BX : I_BA][dir * 1024 + 256 * nb + 128 * half + jj]; }
    for (int i = gt; i < NTOK * 128; i += NGT) { const int row = i >> 7, oc = i & 127;
        const float* src = (row < NGRID ? C.in[I_X] + (size_t)row * D : C.in[I_META] + (size_t)((row - NGRID) & 15) * D) + 8 * oc;
        const f32x4 a = *(const f32x4*)src, b = *(const f32x4*)(src + 4);
        u32x4 w; w.x = pk2(a[0], a[1]); w.y = pk2(a[2], a[3]); w.z = pk2(b[0], b[1]); w.w = pk2(b[2], b[3]);
        *(u32x4*)((bf16_t*)(wsl + WS_HB) + (size_t)row * D + 8 * oc) = w; }
}

__device__ __forceinline__ void phase_conv(const Ctx& C) {
    PHASE_IDS
    const bf16_t* XR = (const bf16_t*)(wsl + WS_XR); bf16_t* XC = (bf16_t*)(wsl + WS_XC);
    const float* cw = C.in[I_CONVW]; const float* cb = C.in[I_CONVB];
    const int gt = C.bid * NTHREADS + tid, NGT = C.G * NTHREADS;
    for (int i = gt; i < NTOK * 128; i += NGT) { const int row = i >> 7, ch = 8 * (i & 127);
        int b, s; if (row < NGRID) { b = row >> 12; s = NMETA + (row & (SEQ - 1)); } else { b = (row - NGRID) >> 4; s = (row - NGRID) & 15; }
        float a[8];
        { const f32x4 t0 = *(const f32x4*)(cb + ch), t1 = *(const f32x4*)(cb + ch + 4);
#pragma unroll
          for (int j = 0; j < 4; ++j) { a[j] = t0[j]; a[4 + j] = t1[j]; } }
#pragma unroll
        for (int j = 0; j < 4; ++j) { const int sj = s - 2 + j;
            if (sj >= 0 && sj < LSEQ) { const u32x4 xw = *(const u32x4*)(XR + (size_t)seqrow(b, sj) * D + ch);
                const f32x4 w0 = *(const f32x4*)(cw + j * 1024 + ch), w1 = *(const f32x4*)(cw + j * 1024 + ch + 4);
                a[0] += w0[0] * bflo(xw.x); a[1] += w0[1] * bfhi(xw.x); a[2] += w0[2] * bflo(xw.y); a[3] += w0[3] * bfhi(xw.y);
                a[4] += w1[0] * bflo(xw.z); a[5] += w1[1] * bfhi(xw.z); a[6] += w1[2] * bflo(xw.w); a[7] += w1[3] * bfhi(xw.w); } }
        u32x4 w; w.x = pk2(a[0], a[1]); w.y = pk2(a[2], a[3]); w.z = pk2(a[4], a[5]); w.w = pk2(a[6], a[7]);
        *(u32x4*)(XC + (size_t)row * D + ch) = w; }
}

template <int N> __device__ __forceinline__ float dpp_shr(float oldv, float v) {
    return __builtin_bit_cast(float, __builtin_amdgcn_update_dpp(__builtin_bit_cast(int, oldv), __builtin_bit_cast(int, v), 0x110 + N, 0xf, 0xf, false));
}
__device__ __forceinline__ void scan_group(float (&a)[8], float (&b)[8]) {
#pragma unroll
    for (int c = 0; c < 8; ++c) {
        { const float ap = dpp_shr<1>(1.0f, a[c]), bp = dpp_shr<1>(0.0f, b[c]); b[c] = a[c] * bp + b[c]; a[c] = a[c] * ap; }
        { const float ap = dpp_shr<2>(1.0f, a[c]), bp = dpp_shr<2>(0.0f, b[c]); b[c] = a[c] * bp + b[c]; a[c] = a[c] * ap; }
        { const float ap = dpp_shr<4>(1.0f, a[c]), bp = dpp_shr<4>(0.0f, b[c]); b[c] = a[c] * bp + b[c]; a[c] = a[c] * ap; }
        { const float ap = dpp_shr<8>(1.0f, a[c]), bp = dpp_shr<8>(0.0f, b[c]); b[c] = a[c] * bp + b[c]; a[c] = a[c] * ap; }
    }
}
__device__ __forceinline__ void unpack8(const u32x4 w, float (&o)[8]) { o[0] = bflo(w.x); o[1] = bfhi(w.x); o[2] = bflo(w.y); o[3] = bfhi(w.y); o[4] = bflo(w.z); o[5] = bfhi(w.z); o[6] = bflo(w.w); o[7] = bfhi(w.w); }
__device__ __forceinline__ void phase_scan(const Ctx& C) {
    PHASE_IDS
    const bf16_t* LA = (const bf16_t*)(wsl + WS_LA); const bf16_t* BB = (const bf16_t*)(wsl + WS_BB); const bf16_t* GY = (const bf16_t*)(wsl + WS_GY);
    bf16_t* HF = (bf16_t*)(wsl + WS_HF); bf16_t* Gout = (bf16_t*)(wsl + WS_G);
    LAS float* agg = (LAS float*)C.lds;
    const int w = wave, oct = lane >> 4, p = lane & 15;
    for (int item = C.bid; item < NB * 32; item += C.G) {
        const int b = item >> 5, g = item & 31;
        for (int dir = 0; dir < 2; ++dir) {
            const bf16_t* la = LA + (((size_t)dir * 32 + g) * MPAD) * 32 + 8 * oct;
            const bf16_t* bb = BB + (((size_t)dir * 32 + g) * MPAD) * 32 + 8 * oct;
            float S[8];
#pragma unroll
            for (int c = 0; c < 8; ++c) S[c] = 0.f;
            {
                const int u = p, s = dir ? LSEQ - 1 - u : u, row = seqrow(b, s);
                float a[8], x[8]; unpack8(*(const u32x4*)(la + (size_t)row * 32), a); unpack8(*(const u32x4*)(bb + (size_t)row * 32), x);
#pragma unroll
                for (int c = 0; c < 8; ++c) a[c] = fast_exp2(a[c]);
                scan_group(a, x);
                if (w == 0) {
                    if (dir == 0) { u32x4 o; o.x = pk2(x[0], x[1]); o.y = pk2(x[2], x[3]); o.z = pk2(x[4], x[5]); o.w = pk2(x[6], x[7]); *(u32x4*)(HF + ((size_t)g * MPAD + row) * 32 + 8 * oct) = o; }
                    else { float hf[8], gy[8]; unpack8(*(const u32x4*)(HF + ((size_t)g * MPAD + row) * 32 + 8 * oct), hf); unpack8(*(const u32x4*)(GY + ((size_t)g * MPAD + row) * 32 + 8 * oct), gy);
                        u32x4 o; o.x = pk2((hf[0] + x[0]) * gy[0], (hf[1] + x[1]) * gy[1]); o.y = pk2((hf[2] + x[2]) * gy[2], (hf[3] + x[3]) * gy[3]);
                        o.z = pk2((hf[4] + x[4]) * gy[4], (hf[5] + x[5]) * gy[5]); o.w = pk2((hf[6] + x[6]) * gy[6], (hf[7] + x[7]) * gy[7]);
                        *(u32x4*)(Gout + (size_t)row * D + 32 * g + 8 * oct) = o; }
                }
#pragma unroll
                for (int c = 0; c < 8; ++c) S[c] = __shfl(x[c], (lane & 48) | 15);
            }
            for (int r = 0; r < 8; ++r) {
                float Pw[4][8], Hw[4][8]; int rows[4];
                float Aw[8], Hc[8];
#pragma unroll
                for (int c = 0; c < 8; ++c) { Aw[c] = 1.f; Hc[c] = 0.f; }
                u32x4 ra[4], rb[4];
#pragma unroll
                for (int j = 0; j < 4; ++j) { const int u = 16 + 512 * r + 64 * w + 16 * j + p, s = dir ? LSEQ - 1 - u : u; rows[j] = seqrow(b, s);
                    ra[j] = *(const u32x4*)(la + (size_t)rows[j] * 32); rb[j] = *(const u32x4*)(bb + (size_t)rows[j] * 32); }
#pragma unroll
                for (int j = 0; j < 4; ++j) {
                    float a[8], x[8]; unpack8(ra[j], a); unpack8(rb[j], x);
#pragma unroll
                    for (int c = 0; c < 8; ++c) a[c] = fast_exp2(a[c]);
                    scan_group(a, x);
#pragma unroll
                    for (int c = 0; c < 8; ++c) { Hw[j][c] = a[c] * Hc[c] + x[c]; Pw[j][c] = a[c] * Aw[c]; }
#pragma unroll
                    for (int c = 0; c < 8; ++c) { Aw[c] = __shfl(Pw[j][c], (lane & 48) | 15); Hc[c] = __shfl(Hw[j][c], (lane & 48) | 15); }
                }
                LAS float* ag = agg + (r & 1) * 512;
                if (p == 0) {
#pragma unroll
                    for (int c = 0; c < 8; ++c) { ag[(w * 32 + oct * 8 + c) * 2] = Aw[c]; ag[(w * 32 + oct * 8 + c) * 2 + 1] = Hc[c]; }
                }
                __syncthreads();
                float Sin[8];
#pragma unroll
                for (int c = 0; c < 8; ++c) Sin[c] = S[c];
#pragma unroll
                for (int ww = 0; ww < 8; ++ww) {
#pragma unroll
                    for (int c = 0; c < 8; ++c) { const float A = ag[(ww * 32 + oct * 8 + c) * 2], H = ag[(ww * 32 + oct * 8 + c) * 2 + 1];
                        if (ww == w) Sin[c] = S[c];
                        S[c] = A * S[c] + H; }
                }
#pragma unroll
                for (int j = 0; j < 4; ++j) {
                    float h[8];
#pragma unroll
                    for (int c = 0; c < 8; ++c) h[c] = Pw[j][c] * Sin[c] + Hw[j][c];
                    const size_t go = ((size_t)g * MPAD + rows[j]) * 32 + 8 * oct;
                    if (dir == 0) { u32x4 o; o.x = pk2(h[0], h[1]); o.y = pk2(h[2], h[3]); o.z = pk2(h[4], h[5]); o.w = pk2(h[6], h[7]); *(u32x4*)(HF + go) = o; }
                    else { float hf[8], gy[8]; unpack8(*(const u32x4*)(HF + go), hf); unpack8(*(const u32x4*)(GY + go), gy);
                        u32x4 o; o.x = pk2((hf[0] + h[0]) * gy[0], (hf[1] + h[1]) * gy[1]); o.y = pk2((hf[2] + h[2]) * gy[2], (hf[3] + h[3]) * gy[3]);
                        o.z = pk2((hf[4] + h[4]) * gy[4], (hf[5] + h[5]) * gy[5]); o.w = pk2((hf[6] + h[6]) * gy[6], (hf[7] + h[7]) * gy[7]);
                        *(u32x4*)(Gout + (size_t)rows[j] * D + 32 * g + 8 * oct) = o; }
                }
            }
            __syncthreads();
        }
    }
}

template <int K> __device__ __forceinline__ f32x4 mini_mma(const bf16_t* W, int ldw, const bf16_t* A, int lda, int lane) {
    const bf16_t* wp = W + (size_t)(lane & 15) * ldw + 8 * (lane >> 4); const bf16_t* ap = A + (size_t)(lane & 15) * lda + 8 * (lane >> 4);
    f32x4 acc = {0.f, 0.f, 0.f, 0.f};
    constexpr int KB = K < 512 ? K : 512, NS = KB / 32;
#pragma unroll 1
    for (int k0 = 0; k0 < K; k0 += KB) { bf16x8 wf[NS], af[NS];
#pragma unroll
        for (int i = 0; i < NS; ++i) { wf[i] = *(const bf16x8*)(wp + k0 + 32 * i); af[i] = *(const bf16x8*)(ap + k0 + 32 * i); }
#pragma unroll
        for (int i = 0; i < NS; ++i) acc = __builtin_amdgcn_mfma_f32_16x16x32_bf16(wf[i], af[i], acc, 0, 0, 0); }
    return acc;
}
__device__ __forceinline__ void mini_win(const Ctx& C) {
    PHASE_IDS
    const bf16_t* HB = (const bf16_t*)(C.ws + WS_HB); const bf16_t* WT = (const bf16_t*)(C.ws + WS_WIN); bf16_t* XR = (bf16_t*)(C.ws + WS_XR); bf16_t* GY = (bf16_t*)(C.ws + WS_GY);
    const int fr = lane & 15, fq = lane >> 4;
    for (int wt = C.gc * NWAVES + wave; wt < 8 * 128; wt += C.G * NWAVES) { const int rg = wt & 7, cb = wt >> 3, row = NGRID + 16 * rg + fr, c = 16 * cb + 4 * fq;
        const f32x4 a = mini_mma<1024>(WT + (size_t)(16 * cb) * 1024, 1024, HB + (size_t)(NGRID + 16 * rg) * 1024, 1024, lane);
        if (c < 1024) { u32x2 w; w.x = cvt_pk_bf16(a[0], a[1]); w.y = cvt_pk_bf16(a[2], a[3]); *(u32x2*)(XR + (size_t)row * D + c) = w; }
        else { const int yc = c - 1024; float o[4];
#pragma unroll
            for (int j = 0; j < 4; ++j) { const float v = a[j]; const float z = 1.5957691216f * (v + 0.044715f * v * v * v); o[j] = v * sigmoidf_(z); }
            u32x2 w; w.x = cvt_pk_bf16(o[0], o[1]); w.y = cvt_pk_bf16(o[2], o[3]); *(u32x2*)(GY + ((size_t)(yc >> 5) * MPAD + row) * 32 + (yc & 31)) = w; } }
}
__device__ __forceinline__ void mini_gate(const Ctx& C) {
    PHASE_IDS
    const bf16_t* XC = (const bf16_t*)(C.ws + WS_XC); const bf16_t* GT = (const bf16_t*)(C.ws + WS_GATE); bf16_t* LA = (bf16_t*)(C.ws + WS_LA); bf16_t* BB = (bf16_t*)(C.ws + WS_BB);
    const float* ba = C.in[I_BA]; const float* bx = C.in[I_BX]; const float* spl = (const float*)(C.ws + WS_CTL + CT_SPL);
    const int fr = lane & 15, fq = lane >> 4;
    for (int wt = C.gc * NWAVES + wave; wt < 8 * 2 * 64; wt += C.G * NWAVES) { const int rg = wt & 7, dir = (wt >> 3) & 1, chg = wt >> 4, ch0 = 16 * chg, nb = ch0 >> 8, half = (ch0 >> 7) & 1, jj0 = ch0 & 127;
        const bf16_t* A = XC + (size_t)(NGRID + 16 * rg) * 1024 + 256 * nb; const bf16_t* Wa = GT + ((size_t)nb * 1024 + 256 * (2 * dir + half) + jj0) * 256;
        const f32x4 za = mini_mma<256>(Wa, 256, A, 1024, lane), zx = mini_mma<256>(Wa + 128 * 256, 256, A, 1024, lane);
        const int row = NGRID + 16 * rg + fr, ch = ch0 + 4 * fq;
        const f32x4 cba = *(const f32x4*)(ba + dir * 1024 + ch), cbx = *(const f32x4*)(bx + dir * 1024 + ch), csp = *(const f32x4*)(spl + dir * 1024 + ch);
        const u32x2 xw = *(const u32x2*)(XC + (size_t)row * D + ch); const float xc[4] = {bflo(xw.x), bfhi(xw.x), bflo(xw.y), bfhi(xw.y)};
        float la[4], bb[4];
#pragma unroll
        for (int j = 0; j < 4; ++j) { const float l2 = -csp[j] * sigmoidf_(za[j] + cba[j]); const float a2 = fast_exp2(2.0f * l2);
            const float mult = (dir == 0 && fr == 0) ? 1.0f : __builtin_amdgcn_sqrtf(fmaxf(1.0f - a2, 0.0f)); la[j] = l2; bb[j] = mult * sigmoidf_(zx[j] + cbx[j]) * xc[j]; }
        const size_t o = (((size_t)dir * 32 + (ch >> 5)) * MPAD + row) * 32 + (ch & 31);
        u32x2 w; w.x = cvt_pk_bf16(la[0], la[1]); w.y = cvt_pk_bf16(la[2], la[3]); *(u32x2*)(LA + o) = w;
        w.x = cvt_pk_bf16(bb[0], bb[1]); w.y = cvt_pk_bf16(bb[2], bb[3]); *(u32x2*)(BB + o) = w; }
}
__device__ __forceinline__ void mini_lout(const Ctx& C) {
    PHASE_IDS
    const bf16_t* G = (const bf16_t*)(C.ws + WS_G); const bf16_t* WT = (const bf16_t*)(C.ws + WS_LOUT); bf16_t* PRE = (bf16_t*)(C.ws + WS_PRE); const float* meta = C.in[I_META];
    const int fr = lane & 15, fq = lane >> 4;
    for (int wt = C.gc * NWAVES + wave; wt < 8 * 64; wt += C.G * NWAVES) { const int rg = wt & 7, cb = wt >> 3, row = NGRID + 16 * rg + fr, c = 16 * cb + 4 * fq;
        const f32x4 a = mini_mma<1024>(WT + (size_t)(16 * cb) * 1024, 1024, G + (size_t)(NGRID + 16 * rg) * 1024, 1024, lane);
        const f32x4 r = *(const f32x4*)(meta + (size_t)fr * D + c);
        u32x2 w; w.x = cvt_pk_bf16(r[0] * DN_ALPHA + a[0], r[1] * DN_ALPHA + a[1]); w.y = cvt_pk_bf16(r[2] * DN_ALPHA + a[2], r[3] * DN_ALPHA + a[3]); *(u32x2*)(PRE + (size_t)row * D + c) = w; }
}
__device__ __forceinline__ void mini_kv(const Ctx& C) {
    PHASE_IDS
    const bf16_t* HB = (const bf16_t*)(C.ws + WS_HB); const bf16_t* WT = (const bf16_t*)(C.ws + WS_QKV); bf16_t* Kx = (bf16_t*)(C.ws + WS_K); bf16_t* VT = (bf16_t*)(C.ws + WS_VT);
    const int fr = lane & 15, fq = lane >> 4;
    for (int wt = C.gc * NWAVES + wave; wt < 2 * 8 * 64; wt += C.G * NWAVES) { const int rg = wt & 7, cb = (wt >> 3) & 63, isv = wt >> 9;
        const bf16_t* A = HB + (size_t)(NGRID + 16 * rg) * 1024;
        if (!isv) { const f32x4 a = mini_mma<1024>(WT + (size_t)(1024 + 16 * cb) * 1024, 1024, A, 1024, lane);
            u32x2 w; w.x = cvt_pk_bf16(a[0], a[1]); w.y = cvt_pk_bf16(a[2], a[3]); *(u32x2*)(Kx + (size_t)(NGRID + 16 * rg + fr) * D + 16 * cb + 4 * fq) = w; }
        else { const f32x4 a = mini_mma<1024>(A, 1024, WT + (size_t)(2048 + 16 * cb) * 1024, 1024, lane);
            u32x2 w; w.x = cvt_pk_bf16(a[0], a[1]); w.y = cvt_pk_bf16(a[2], a[3]); *(u32x2*)(VT + (size_t)(16 * cb + fr) * MPAD + NGRID + 16 * rg + 4 * fq) = w; } }
}

constexpr int RWT_PITCH = 1028;
__device__ __forceinline__ void phase_lnr(const Ctx& C, int layer, int nrows) {
    PHASE_IDS
    const bf16_t* PRE = (const bf16_t*)(wsl + WS_PRE); bf16_t* HB = (bf16_t*)(wsl + WS_HB); unsigned char* HB8 = wsl + WS_HB8;
    const float* lg = C.in[I_LNMG] + layer * D; const float* lb = C.in[I_LNMB] + layer * D;
    const float* rw = C.in[I_RW] + (size_t)layer * D * NEXP; const float* rb = C.in[I_RB] + layer * NEXP;
    int* eid = (int*)(wsl + WS_CTL + CT_EID) + (size_t)layer * NTOK * 4; float* gatev = (float*)(wsl + WS_CTL + CT_GATEV) + (size_t)layer * NTOK * 4;
    unsigned* bc = (unsigned*)(wsl + WS_CTL + CT_BC) + ((size_t)layer * 256 + C.bid) * 32;
    LAS float* RWt = (LAS float*)C.lds; LAS unsigned* hist = (LAS unsigned*)(C.lds + 32 * RWT_PITCH * 4);
    { f32x4 wv[16];
#pragma unroll
      for (int i = 0; i < 16; ++i) wv[i] = *(const f32x4*)(rw + 4 * (tid + NTHREADS * i));
#pragma unroll
      for (int i = 0; i < 16; ++i) { const int idx4 = tid + NTHREADS * i, ch = idx4 >> 3, e4 = (idx4 & 7) * 4;
          const int c = 4 * ((ch & 511) >> 3) + 256 * (2 * (ch >> 9) + ((ch >> 2) & 1)) + (ch & 3);
          RWt[(e4 + 0) * RWT_PITCH + c] = wv[i][0]; RWt[(e4 + 1) * RWT_PITCH + c] = wv[i][1]; RWt[(e4 + 2) * RWT_PITCH + c] = wv[i][2]; RWt[(e4 + 3) * RWT_PITCH + c] = wv[i][3]; } }
    if (tid < 32) hist[tid] = 0u;
    __syncthreads();
    float gg[2][8], gb[2][8];
#pragma unroll
    for (int j = 0; j < 2; ++j) { const f32x4 a0 = *(const f32x4*)(lg + 8 * lane + 512 * j), a1 = *(const f32x4*)(lg + 8 * lane + 512 * j + 4), b0 = *(const f32x4*)(lb + 8 * lane + 512 * j), b1 = *(const f32x4*)(lb + 8 * lane + 512 * j + 4);
#pragma unroll
        for (int i = 0; i < 4; ++i) { gg[j][i] = a0[i]; gg[j][4 + i] = a1[i]; gb[j][i] = b0[i]; gb[j][4 + i] = b1[i]; } }
    const float rbias = rb[lane >> 1];
    const int gw = C.bid * NWAVES + wave, NGW = C.G * NWAVES;
    u32x4 nv[2];
    if (gw < nrows) {
#pragma unroll
        for (int j = 0; j < 2; ++j) nv[j] = *(const u32x4*)(PRE + (size_t)gw * D + 8 * lane + 512 * j); }
    for (int row = gw; row < nrows; row += NGW) {
        float v[2][8]; float s = 0.f;
#pragma unroll
        for (int j = 0; j < 2; ++j) { unpack8(nv[j], v[j]); s += ((v[j][0] + v[j][1]) + (v[j][2] + v[j][3])) + ((v[j][4] + v[j][5]) + (v[j][6] + v[j][7])); }
        if (row + NGW < nrows) {
#pragma unroll
            for (int j = 0; j < 2; ++j) nv[j] = *(const u32x4*)(PRE + (size_t)(row + NGW) * D + 8 * lane + 512 * j); }
        const float mean = wave_sum_dpp(s) * (1.0f / D); float q = 0.f;
#pragma unroll
        for (int j = 0; j < 2; ++j)
#pragma unroll
            for (int i = 0; i < 8; ++i) { v[j][i] -= mean; q += v[j][i] * v[j][i]; }
        const float rstd = __builtin_amdgcn_rsqf(wave_sum_dpp(q) * (1.0f / D) + LN_EPS);
#pragma unroll
        for (int j = 0; j < 2; ++j) {
#pragma unroll
            for (int i = 0; i < 8; ++i) v[j][i] = v[j][i] * rstd * gg[j][i] + gb[j][i];
            u32x4 w; w.x = pk2(v[j][0], v[j][1]); w.y = pk2(v[j][2], v[j][3]); w.z = pk2(v[j][4], v[j][5]); w.w = pk2(v[j][6], v[j][7]);
            *(u32x4*)(HB + (size_t)row * D + 8 * lane + 512 * j) = w;
            u32x2 w8; w8.x = pk4_fp8(v[j][0], v[j][1], v[j][2], v[j][3]); w8.y = pk4_fp8(v[j][4], v[j][5], v[j][6], v[j][7]);
            *(u32x2*)(HB8 + (size_t)row * D + 8 * lane + 512 * j) = w8; }
        float pl[32];
#pragma unroll
        for (int e0 = 0; e0 < 32; e0 += 4) {
            f32x4 wv[4][4];
#pragma unroll
            for (int ee = 0; ee < 4; ++ee)
#pragma unroll
                for (int jj = 0; jj < 4; ++jj) wv[ee][jj] = *(const LAS f32x4*)(RWt + (e0 + ee) * RWT_PITCH + 4 * lane + 256 * jj);
            __builtin_amdgcn_sched_barrier(0);
#pragma unroll
            for (int ee = 0; ee < 4; ++ee) { float a = 0.f;
#pragma unroll
                for (int jj = 0; jj < 4; ++jj) { const int j = jj >> 1, o = 4 * (jj & 1); a += (v[j][o] * wv[ee][jj][0] + v[j][o + 1] * wv[ee][jj][1]) + (v[j][o + 2] * wv[ee][jj][2] + v[j][o + 3] * wv[ee][jj][3]); }
                pl[e0 + ee] = a; }
        }
        float q16[16], q8[8], q4[4], q2[2], q1;
        { const bool hi = (lane & 32) != 0;
#pragma unroll
          for (int e = 0; e < 16; ++e) { const float mine = hi ? pl[16 + e] : pl[e], other = hi ? pl[e] : pl[16 + e]; q16[e] = mine + __shfl_xor(other, 32); } }
        { const bool hi = (lane & 16) != 0;
#pragma unroll
          for (int e = 0; e < 8; ++e) { const float mine = hi ? q16[8 + e] : q16[e], other = hi ? q16[e] : q16[8 + e]; q8[e] = mine + __shfl_xor(other, 16); } }
        { const bool hi = (lane & 8) != 0;
#pragma unroll
          for (int e = 0; e < 4; ++e) { const float mine = hi ? q8[4 + e] : q8[e], other = hi ? q8[e] : q8[4 + e]; q4[e] = mine + dpp_movf<0x128>(other); } }
        { const bool hi = (lane & 4) != 0;
#pragma unroll
          for (int e = 0; e < 2; ++e) { const float mine = hi ? q4[2 + e] : q4[e], other = hi ? q4[e] : q4[2 + e]; q2[e] = mine + __shfl_xor(other, 4); } }
        { const bool hi = (lane & 2) != 0; const float mine = hi ? q2[1] : q2[0], other = hi ? q2[0] : q2[1]; q1 = mine + dpp_movf<0x4E>(other); }
        q1 += dpp_movf<0xB1>(q1);
        float lv = q1 + rbias; lv = (lv == lv) ? lv : -3.0e38f;
        const int le = lane >> 1;
        int rank = 0;
#pragma unroll
        for (int j = 0; j < 32; ++j) { const float lj = readlane_f(lv, 2 * j); rank += (lj > lv || (lj == lv && j < le)) ? 1 : 0; }
        const unsigned long long m0 = __ballot(rank == 0);
        const float mxl = readlane_f(lv, (int)__builtin_ctzll(m0));
        const float pe = rank < 4 ? __expf(lv - mxl) : 0.f;
        const float den = wave_sum_dpp(pe) * 0.5f;
        if (rank < 4 && (lane & 1) == 0) { eid[(size_t)row * 4 + rank] = le; gatev[(size_t)row * 4 + rank] = pe / den;
            __hip_atomic_fetch_add(&hist[le], 1u, __ATOMIC_RELAXED, __HIP_MEMORY_SCOPE_WORKGROUP); }
    }
    __syncthreads();
    if (tid < 32) bc[tid] = hist[tid];
}

__device__ __forceinline__ void phase_pos(const Ctx& C, int layer, int nrows) {
    PHASE_IDS
    const unsigned* bcAll = (const unsigned*)(wsl + WS_CTL + CT_BC) + (size_t)layer * 256 * 32;
    const int* eid = (const int*)(wsl + WS_CTL + CT_EID) + (size_t)layer * NTOK * 4; int* posv = (int*)(wsl + WS_CTL + CT_POS) + (size_t)layer * NTOK * 4;
    int* texp = (int*)(wsl + WS_CTL + CT_TEXP) + layer * 1024;
    int* tokoff = (int*)(wsl + WS_TOK) + (size_t)layer * (1 * MiB / 4);
    LAS unsigned* partT = (LAS unsigned*)C.lds; LAS unsigned* partP = partT + 512; LAS unsigned* tot = partP + 512; LAS unsigned* cnt = tot + 32;
    { const int e = tid & 31, part = tid >> 5; unsigned t = 0, pr = 0;
      unsigned vv[16];
#pragma unroll
      for (int i = 0; i < 16; ++i) { const int bq = part + 16 * i; vv[i] = bq < C.G ? bcAll[(size_t)bq * 32 + e] : 0u; }
#pragma unroll
      for (int i = 0; i < 16; ++i) { const int bq = part + 16 * i; t += vv[i]; if (bq < C.bid) pr += vv[i]; }
      partT[part * 32 + e] = t; partP[part * 32 + e] = pr; }
    __syncthreads();
    if (tid < 32) { unsigned t = 0, pr = 0; for (int i = 0; i < 16; ++i) { t += partT[i * 32 + tid]; pr += partP[i * 32 + tid]; } tot[tid] = t; cnt[tid] = pr; }
    __syncthreads();
    if (tid < 32) { unsigned off = 0; for (int e = 0; e < tid; ++e) off += (tot[e] + 255u) & ~255u;
        const unsigned mine = (tot[tid] + 255u) & ~255u;
        if (C.bid == 0) { for (unsigned t = off >> 8; t < ((off + mine) >> 8); ++t) texp[t] = tid; if (tid == 31) texp[1023] = (int)((off + mine) >> 8);
            for (unsigned p = off + tot[tid]; p < off + mine; ++p) tokoff[p] = 0; }
        cnt[tid] += off; }
    __syncthreads();
    const int gw = C.bid * NWAVES + wave, NGW = C.G * NWAVES;
    for (int row = gw; row < nrows; row += NGW) {
        int pos = 0;
        if (lane < 4) { const int e = eid[(size_t)row * 4 + lane]; pos = (int)__hip_atomic_fetch_add(&cnt[e], 1u, __ATOMIC_RELAXED, __HIP_MEMORY_SCOPE_WORKGROUP); posv[(size_t)row * 4 + lane] = pos; }
        if (lane < 4) tokoff[pos] = row * 1024;
    }
}

__device__ __forceinline__ void phase_combine(const Ctx& C, int layer, int nrows, bool final_out) {
    PHASE_IDS
    bf16_t* HB = (bf16_t*)(wsl + WS_HB); unsigned char* HB8 = wsl + WS_HB8; const bf16_t* YS = (const bf16_t*)(wsl + WS_YS);
    const float* lg = C.in[I_LNFG] + layer * D; const float* lb = C.in[I_LNFB] + layer * D;
    const float* gatev = (const float*)(wsl + WS_CTL + CT_GATEV) + (size_t)layer * NTOK * 4; const int* posv = (const int*)(wsl + WS_CTL + CT_POS) + (size_t)layer * NTOK * 4;
    float gg[2][8], gb[2][8];
#pragma unroll
    for (int j = 0; j < 2; ++j) { const f32x4 a0 = *(const f32x4*)(lg + 8 * lane + 512 * j), a1 = *(const f32x4*)(lg + 8 * lane + 512 * j + 4), b0 = *(const f32x4*)(lb + 8 * lane + 512 * j), b1 = *(const f32x4*)(lb + 8 * lane + 512 * j + 4);
#pragma unroll
        for (int i = 0; i < 4; ++i) { gg[j][i] = a0[i]; gg[j][4 + i] = a1[i]; gb[j][i] = b0[i]; gb[j][4 + i] = b1[i]; } }
    const int gw = C.bid * NWAVES + wave, NGW = C.G * NWAVES;
    for (int row = gw; row < nrows; row += NGW) {
        const f32x4 gk4 = *(const f32x4*)(gatev + (size_t)row * 4); const int pk0 = posv[(size_t)row * 4], pk1 = posv[(size_t)row * 4 + 1], pk2_ = posv[(size_t)row * 4 + 2], pk3 = posv[(size_t)row * 4 + 3];
        u32x4 hw[2], yw[4][2];
#pragma unroll
        for (int j = 0; j < 2; ++j) { hw[j] = *(const u32x4*)(HB + (size_t)row * D + 8 * lane + 512 * j);
            yw[0][j] = *(const u32x4*)(YS + (size_t)pk0 * D + 8 * lane + 512 * j); yw[1][j] = *(const u32x4*)(YS + (size_t)pk1 * D + 8 * lane + 512 * j);
            yw[2][j] = *(const u32x4*)(YS + (size_t)pk2_ * D + 8 * lane + 512 * j); yw[3][j] = *(const u32x4*)(YS + (size_t)pk3 * D + 8 * lane + 512 * j); }
        float v[2][8]; float s = 0.f;
#pragma unroll
        for (int j = 0; j < 2; ++j) { float h[8]; unpack8(hw[j], h);
#pragma unroll
            for (int i = 0; i < 8; ++i) v[j][i] = h[i] * DN_ALPHA;
#pragma unroll
            for (int k = 0; k < 4; ++k) { float y[8]; unpack8(yw[k][j], y);
#pragma unroll
                for (int i = 0; i < 8; ++i) v[j][i] += gk4[k] * y[i]; }
#pragma unroll
            for (int i = 0; i < 8; ++i) s += v[j][i]; }
        const float mean = wave_sum_dpp(s) * (1.0f / D); float q = 0.f;
#pragma unroll
        for (int j = 0; j < 2; ++j)
#pragma unroll
            for (int i = 0; i < 8; ++i) { v[j][i] -= mean; q += v[j][i] * v[j][i]; }
        const float rstd = __builtin_amdgcn_rsqf(wave_sum_dpp(q) * (1.0f / D) + LN_EPS);
#pragma unroll
        for (int j = 0; j < 2; ++j) {
#pragma unroll
            for (int i = 0; i < 8; ++i) v[j][i] = v[j][i] * rstd * gg[j][i] + gb[j][i];
            if (final_out) { *(f32x4*)(C.out + (size_t)row * D + 8 * lane + 512 * j) = (f32x4){v[j][0], v[j][1], v[j][2], v[j][3]}; *(f32x4*)(C.out + (size_t)row * D + 8 * lane + 512 * j + 4) = (f32x4){v[j][4], v[j][5], v[j][6], v[j][7]}; }
            else { u32x4 w; w.x = pk2(v[j][0], v[j][1]); w.y = pk2(v[j][2], v[j][3]); w.z = pk2(v[j][4], v[j][5]); w.w = pk2(v[j][6], v[j][7]); *(u32x4*)(HB + (size_t)row * D + 8 * lane + 512 * j) = w;
                u32x2 w8; w8.x = pk4_fp8(v[j][0], v[j][1], v[j][2], v[j][3]); w8.y = pk4_fp8(v[j][4], v[j][5], v[j][6], v[j][7]); *(u32x2*)(HB8 + (size_t)row * D + 8 * lane + 512 * j) = w8; } }
    }
}

constexpr int AT_KS = 0, AT_VTS = 73728, AT_VPITCH = 1168, AT_KM = AT_VTS + 64 * AT_VPITCH, AT_VTM = AT_KM + 2048, AT_RPB = AT_VTM + 2048, AT_MB = AT_RPB + 1920, AT_END = AT_MB + 64;
static_assert(AT_END <= LDS_BYTES, "attention LDS map");
__device__ __forceinline__ void phase_attn(const Ctx& C) {
    PHASE_IDS
    const bf16_t* Q = (const bf16_t*)(wsl + WS_Q); const bf16_t* Kx = (const bf16_t*)(wsl + WS_K); const bf16_t* VT = (const bf16_t*)(wsl + WS_VT); bf16_t* O = (bf16_t*)(wsl + WS_O);
    const float* rpb = C.in[I_RPB]; const float* mbias = C.in[I_MBIAS];
    LAS unsigned char* lds = C.lds;
    const int w = wave, lq = lane & 15, g = lane >> 4;
    int bidx[2][4];
    { const int qg_ = w & 3, c_ = 16 * qg_ + lq, cs_ = min(max(c_ - 8, 0), 48), kcb_ = qg_ == 0 ? 0 : (qg_ == 1 ? 8 : (qg_ == 2 ? 24 : 32));
#pragma unroll
      for (int blk = 0; blk < 2; ++blk)
#pragma unroll
          for (int e = 0; e < 4; ++e) { const int kc = kcb_ + 16 * blk + 4 * g + e; bidx[blk][e] = ((kc >= cs_ && kc < cs_ + 16) ? (kc - c_ + 15) : 31) * 4; } }
    const bool xmap = (C.G == 256); const int nu = xmap ? 16 : (NB * 16 * 32 - C.bid + C.G - 1) / C.G;
    u32x4 kreg[9], vreg[9], mreg = {0u, 0u, 0u, 0u}; float rpreg = 0.f, mbreg = 0.f;
#define AT_UNIT(i) (xmap ? (C.gc & 7) * 512 + (C.gc >> 3) + 32 * (i) : C.bid + C.G * (i))
    const __amdgpu_buffer_rsrc_t rsrc = __builtin_amdgcn_make_buffer_rsrc((void*)wsl, 0, 0xFFFFFFFF, 0x00020000);
    const int kvoff = (((tid >> 3) & 63) * D + 8 * (tid & 7)) * 2, vvoff = ((tid >> 3) * MPAD + 8 * (tid & 7)) * 2;
    const int mvoff = tid < 128 ? ((tid >> 3) * D + 8 * (tid & 7)) * 2 : (((tid - 128) >> 1) * MPAD + 8 * ((tid - 128) & 1)) * 2;
#define AT_ISSUE(unit_) do { const int rp_ = (unit_) & 31, h_ = ((unit_) >> 5) & 15, b_ = (unit_) >> 9, R0_ = min(max(2 * rp_ - 4, 0), 55); \
        const unsigned ks_ = (unsigned)WS_K + (unsigned)((b_ * SEQ + R0_ * 64) * D + 64 * h_) * 2u, vs_ = (unsigned)WS_VT + (unsigned)((64 * h_) * MPAD + b_ * SEQ + R0_ * 64) * 2u; \
        _Pragma("unroll") for (int i_ = 0; i_ < 9; ++i_) kreg[i_] = __builtin_amdgcn_raw_buffer_load_b128(rsrc, kvoff, (int)(ks_ + (unsigned)i_ * 64u * D * 2u), 0); \
        _Pragma("unroll") for (int i_ = 0; i_ < 9; ++i_) vreg[i_] = __builtin_amdgcn_raw_buffer_load_b128(rsrc, vvoff, (int)(vs_ + (unsigned)i_ * 128u), 0); \
        if (tid < 256) mreg = __builtin_amdgcn_raw_buffer_load_b128(rsrc, mvoff, (int)(tid < 128 ? (unsigned)WS_K + (unsigned)((NGRID + 16 * b_) * D + 64 * h_) * 2u : (unsigned)WS_VT + (unsigned)((64 * h_) * MPAD + NGRID + 16 * b_) * 2u), 0); \
        if (tid < 480) rpreg = (tid & 31) < 31 ? rpb[h_ * 465 + (tid >> 5) * 31 + (tid & 31)] * 1.44269504089f : -1.0e30f;        \
        if (tid < 16) mbreg = mbias[h_ * 16 + tid] * 1.44269504089f; } while (0)
    if (nu > 0) AT_ISSUE(AT_UNIT(0));
    for (int ui = 0; ui < nu; ++ui) {
        const int unit = AT_UNIT(ui);
        const int rp = unit & 31, h = (unit >> 5) & 15, b = unit >> 9;
        const int R0 = min(max(2 * rp - 4, 0), 55);
        __syncthreads();
#pragma unroll
        for (int i = 0; i < 9; ++i) { const int idx = tid + 512 * i, ch = idx & 7, kc = (idx >> 3) & 63, jr = idx >> 9;
            *(LAS u32x4*)(lds + AT_KS + ((jr * 64 + kc) * 8 + (ch ^ (kc & 7))) * 16) = kreg[i]; }
#pragma unroll
        for (int i = 0; i < 9; ++i) *(LAS u32x4*)(lds + AT_VTS + (tid >> 3) * AT_VPITCH + ((tid & 7) + 8 * i) * 16) = vreg[i];
        if (tid < 128) { const int m = tid >> 3, ch = tid & 7; *(LAS u32x4*)(lds + AT_KM + (m * 8 + (ch ^ (m & 7))) * 16) = mreg; }
        else if (tid < 256) { const int i = tid - 128, d = i >> 1, hf = i & 1; *(LAS u32x4*)(lds + AT_VTM + d * 32 + hf * 16) = mreg; }
        if (tid < 480) ((LAS float*)(lds + AT_RPB))[tid] = rpreg;
        if (tid < 16) ((LAS float*)(lds + AT_MB))[tid] = mbreg;
        __syncthreads();
        if (ui + 1 < nu) AT_ISSUE(AT_UNIT(ui + 1));
        const int qr = w >> 2, qg = w & 3, r = 2 * rp + qr, c0 = 16 * qg;
        const int rs = min(max(r - 4, 0), 56), jr0 = rs - R0;
        const int kcb = qg == 0 ? 0 : (qg == 1 ? 8 : (qg == 2 ? 24 : 32));
        const size_t qrow = (size_t)(b * SEQ + r * 64 + c0 + lq);
        bf16x8 qf[2];
#pragma unroll
        for (int ks = 0; ks < 2; ++ks) qf[ks] = *(const bf16x8*)(Q + qrow * D + 64 * h + 32 * ks + 8 * g);
        f32x4 sc[8][2], sm;
#pragma unroll
        for (int j = 0; j < 8; ++j)
#pragma unroll
            for (int blk = 0; blk < 2; ++blk) { f32x4 a = {0.f, 0.f, 0.f, 0.f}; const int kc = kcb + 16 * blk + lq;
#pragma unroll
                for (int ks = 0; ks < 2; ++ks) { const bf16x8 kf = *(const LAS bf16x8*)(lds + AT_KS + (((jr0 + j) * 64 + kc) * 8 + ((4 * ks + g) ^ (kc & 7))) * 16);
                    a = __builtin_amdgcn_mfma_f32_16x16x32_bf16(kf, qf[ks], a, 0, 0, 0); }
                sc[j][blk] = a; if (blk == 1 && (j & 1)) __builtin_amdgcn_sched_barrier(0); }
        { f32x4 a = {0.f, 0.f, 0.f, 0.f};
#pragma unroll
          for (int ks = 0; ks < 2; ++ks) { const bf16x8 kf = *(const LAS bf16x8*)(lds + AT_KM + (lq * 8 + ((4 * ks + g) ^ (lq & 7))) * 16);
              a = __builtin_amdgcn_mfma_f32_16x16x32_bf16(kf, qf[ks], a, 0, 0, 0); }
          sm = a; }
        const LAS unsigned char* RProw = lds + AT_RPB + (rs - r + 7) * 128; const LAS float* MB = (const LAS float*)(lds + AT_MB);
        float mx = -3.0e38f;
#pragma unroll
        for (int j = 0; j < 8; ++j)
#pragma unroll
            for (int blk = 0; blk < 2; ++blk)
#pragma unroll
                for (int e = 0; e < 4; ++e) { const float s = sc[j][blk][e] + *(const LAS float*)(RProw + j * 128 + bidx[blk][e]); sc[j][blk][e] = s; mx = fmaxf(mx, s); }
#pragma unroll
        for (int e = 0; e < 4; ++e) { sm[e] += MB[4 * g + e]; mx = fmaxf(mx, sm[e]); }
        mx = fmaxf(mx, __shfl_xor(mx, 16)); mx = fmaxf(mx, __shfl_xor(mx, 32));
        float sum = 0.f;
#pragma unroll
        for (int j = 0; j < 8; ++j)
#pragma unroll
            for (int blk = 0; blk < 2; ++blk)
#pragma unroll
                for (int e = 0; e < 4; ++e) { const float pv = fast_exp2(sc[j][blk][e] - mx); sc[j][blk][e] = pv; sum += pv; }
#pragma unroll
        for (int e = 0; e < 4; ++e) { const float pv = fast_exp2(sm[e] - mx); sm[e] = pv; sum += pv; }
        sum += __shfl_xor(sum, 16); sum += __shfl_xor(sum, 32);
        f32x4 o[4];
#pragma unroll
        for (int db = 0; db < 4; ++db) o[db] = (f32x4){0.f, 0.f, 0.f, 0.f};
#pragma unroll
        for (int j = 0; j < 8; ++j) {
            u32x4 pw; pw.x = cvt_pk_bf16(sc[j][0][0], sc[j][0][1]); pw.y = cvt_pk_bf16(sc[j][0][2], sc[j][0][3]); pw.z = cvt_pk_bf16(sc[j][1][0], sc[j][1][1]); pw.w = cvt_pk_bf16(sc[j][1][2], sc[j][1][3]);
            const bf16x8 pb = __builtin_bit_cast(bf16x8, pw);
#pragma unroll
            for (int db = 0; db < 4; ++db) { const int d = 16 * db + lq; const LAS unsigned char* vp = lds + AT_VTS + d * AT_VPITCH + ((jr0 + j) * 64 + kcb + 4 * g) * 2;
                const u32x2 lo = *(const LAS u32x2*)vp, hi = *(const LAS u32x2*)(vp + 32);
                u32x4 aw; aw.x = lo.x; aw.y = lo.y; aw.z = hi.x; aw.w = hi.y;
                o[db] = __builtin_amdgcn_mfma_f32_16x16x32_bf16(__builtin_bit_cast(bf16x8, aw), pb, o[db], 0, 0, 0); }
        }
        { u32x4 pw; pw.x = cvt_pk_bf16(sm[0], sm[1]); pw.y = cvt_pk_bf16(sm[2], sm[3]); pw.z = 0u; pw.w = 0u; const bf16x8 pb = __builtin_bit_cast(bf16x8, pw);
#pragma unroll
          for (int db = 0; db < 4; ++db) { const int d = 16 * db + lq; const u32x2 lo = *(const LAS u32x2*)(lds + AT_VTM + d * 32 + 8 * g);
              u32x4 aw; aw.x = lo.x; aw.y = lo.y; aw.z = 0u; aw.w = 0u;
              o[db] = __builtin_amdgcn_mfma_f32_16x16x32_bf16(__builtin_bit_cast(bf16x8, aw), pb, o[db], 0, 0, 0); } }
        const float inv = 1.0f / sum;
#pragma unroll
        for (int db = 0; db < 4; ++db) { u32x2 ow; ow.x = cvt_pk_bf16(o[db][0] * inv, o[db][1] * inv); ow.y = cvt_pk_bf16(o[db][2] * inv, o[db][3] * inv);
            *(u32x2*)(O + qrow * D + 64 * h + 16 * db + 4 * g) = ow; }
    }
#undef AT_UNIT
#undef AT_ISSUE
}


#define XB_TMO      128
#define XB_XCNT(j)  (256  + 64 * (j))
#define XB_XSUB(j)  (1280 + 64 * (j))
#define XB_XGEN(j)  (2304 + 64 * (j))
#define XB_TOP      3328
#define XB_TOPGEN   3392
#define XCD_BAR_WORDS 3456
#define XB_SPIN_CAP (1u << 22)
__device__ __forceinline__ unsigned xb_ld(unsigned* p)              { return __hip_atomic_load(p, __ATOMIC_RELAXED, __HIP_MEMORY_SCOPE_AGENT); }
__device__ __forceinline__ unsigned xb_add(unsigned* p, unsigned v) { return __hip_atomic_fetch_add(p, v, __ATOMIC_RELAXED, __HIP_MEMORY_SCOPE_AGENT); }
__device__ __forceinline__ unsigned xb_xcc_id() { return (unsigned)__builtin_amdgcn_s_getreg((3 << 11) | 20) & 0xFu; }
#define XB_SPIN(cond, bar) do { unsigned _sp = 0; while (cond) { __builtin_amdgcn_s_sleep(1); \
    if ((++_sp & 255u) == 0u) { if (xb_ld(&(bar)[XB_TMO])) break; if (_sp > XB_SPIN_CAP) { atomicAdd(&(bar)[XB_TMO], 1u); break; } } } } while (0)
struct XcdBarrier { unsigned* bar; unsigned x; volatile LAS unsigned* st; };
__device__ __forceinline__ XcdBarrier xcd_barrier_post(unsigned* bar, volatile LAS unsigned* st) {
    XcdBarrier b; b.bar = bar; b.x = xb_xcc_id(); b.st = st;
    if (threadIdx.x == 0) st[2] = xb_add(&bar[XB_XCNT(b.x)], 1u);
    return b;
}
__device__ __forceinline__ void xcd_barrier_complete(unsigned* bar, unsigned x, unsigned& nloc, unsigned& nx) {
    const unsigned G = gridDim.x * gridDim.y * gridDim.z;
    unsigned sum, cnt, mine, sp = 0u;
    for (;;) {
        sum = 0u; cnt = 0u; mine = 0u;
#pragma unroll
        for (unsigned j = 0; j < 16; ++j) { const unsigned c = xb_ld(&bar[XB_XCNT(j)]); sum += c; cnt += (c > 0u) ? 1u : 0u; mine = (j == x) ? c : mine; }
        if (sum == G) break;
        __builtin_amdgcn_s_sleep(1);
        if ((++sp & 255u) == 0u) { if (xb_ld(&bar[XB_TMO])) break; if (sp > XB_SPIN_CAP) { atomicAdd(&bar[XB_TMO], 1u); break; } }
    }
    nloc = mine > 0u ? mine : 1u; nx = cnt > 0u ? cnt : 1u;
}
__device__ __forceinline__ void xcd_barrier(const XcdBarrier& b) {
    asm volatile("s_waitcnt vmcnt(0)" ::: "memory");
    __syncthreads();
    if (threadIdx.x == 0) {
        unsigned* bar = b.bar;
        __builtin_amdgcn_s_waitcnt(0);
        unsigned nloc = b.st[0], nx = b.st[1];
        if (nloc == 0u) { xcd_barrier_complete(bar, b.x, nloc, nx); b.st[0] = nloc; b.st[1] = nx; }
        const unsigned old = xb_add(&bar[XB_XSUB(b.x)], 1u);
        const unsigned gen = old / nloc;
        if (old + 1u == (gen + 1u) * nloc) {
            __builtin_amdgcn_fence(__ATOMIC_RELEASE, "agent");
            asm volatile("s_waitcnt vmcnt(0)" ::: "memory");
            const unsigned og = xb_add(&bar[XB_TOP], 1u);
            const unsigned tg = og / nx;
            if (og + 1u == (tg + 1u) * nx) xb_add(&bar[XB_TOPGEN], 1u);
            else XB_SPIN(xb_ld(&bar[XB_TOPGEN]) == tg, bar);
            __builtin_amdgcn_fence(__ATOMIC_ACQUIRE, "agent");
            xb_add(&bar[XB_XGEN(b.x)], 1u);
            asm volatile("s_waitcnt vmcnt(0)" ::: "memory");
        } else {
            XB_SPIN(xb_ld(&bar[XB_XGEN(b.x)]) == gen, bar);
            __builtin_amdgcn_fence(__ATOMIC_ACQUIRE, "agent");
            asm volatile("s_waitcnt vmcnt(0)" ::: "memory");
        }
    }
    __syncthreads();
}
__device__ __forceinline__ int moe_prep(const Ctx& C, const int* texp) {
    LAS int* t = (LAS int*)(C.lds + pg8::TEXP_OFF); const int tid = fresh_tid();
    const int a = texp[tid], b = texp[tid + 512];
    t[tid] = a; t[tid + 512] = b;
    __syncthreads();
    return __builtin_amdgcn_readfirstlane(t[1023]);
}
constexpr size_t CT_BAR = 131072;
constexpr int LDS_BARST = LDS_BYTES - 64;

constexpr int N_PHASES = 20;
__global__ void __launch_bounds__(NTHREADS, 2) hybrid_fwd(Params P) {
    extern __shared__ __attribute__((aligned(16))) unsigned char smem[];
    cg::grid_group grid = cg::this_grid();
    Ctx C; C.lds = (LAS unsigned char*)smem; C.G = gridDim.x; C.bid = blockIdx.x;
    C.ws = P.ws; C.in = P.in; C.out = P.out;
    unsigned char* const ws0 = P.ws;
#define ws fresh_ws(ws0)
    const int lo = P.ph_lo, hi = P.ph_hi;
#ifndef PH_MASK
#define PH_MASK 0xFFFFFFFFu
#endif
#define IN(k) (((PH_MASK >> (k)) & 1u) && lo <= (k) && (k) < hi)
#ifndef REPEAT_MASK
#define REPEAT_MASK 0u
#endif
#define REPS(k) ((((unsigned)REPEAT_MASK >> (k)) & 1u) ? 2 : 1)
#ifndef N_CG_SYNCS
#define N_CG_SYNCS 1
#endif
#define SEAM(k) do { if (IN(k) && IN((k) + 1)) { if ((k) < N_CG_SYNCS) grid.sync(); else xcd_barrier(bar); } } while (0)
    if (threadIdx.x < 16) ((LAS unsigned*)(smem + LDS_BARST))[threadIdx.x] = 0u;
    __syncthreads();
    const XcdBarrier bar = xcd_barrier_post((unsigned*)(ws + WS_CTL + CT_BAR), (volatile LAS unsigned*)(smem + LDS_BARST));
    C.gc = C.bid;
    #define PH_BODY_0 phase_convert(C);
    if (IN(0)) { PH_BODY_0 } if (REPS(0) > 1 && IN(0)) { xcd_barrier(bar); PH_BODY_0 }
    SEAM(0);
    if (IN(0) && IN(1)) {
        unsigned* barw = (unsigned*)(ws + WS_CTL + CT_BAR); bool eq = (C.G % 8) == 0;
#pragma unroll
        for (int j = 0; j < 16; ++j) { const unsigned cj = xb_ld(&barw[XB_XCNT(j)]); eq = eq && (cj == (j < 8 ? (unsigned)(C.G / 8) : 0u)); }
        const unsigned rank = ((volatile LAS unsigned*)(smem + LDS_BARST))[2];
        C.gc = __builtin_amdgcn_readfirstlane(eq ? (int)(rank * 8u + bar.x) : C.bid);
    }
    #define PH_BODY_1 { DenseSched S{(unsigned)WS_HB, (unsigned)WS_WIN, 1024, 1024, 128, 8, C.G, C.gc}; EpiWin E{(bf16_t*)(ws + WS_XR), (bf16_t*)(ws + WS_GY)}; \
        pg8::gemm_phase<false, false>(C.lds, ws, 1024, 1024, 1024, S, E); mini_win(C); }
    if (IN(1)) { PH_BODY_1 } if (REPS(1) > 1 && IN(1)) { xcd_barrier(bar); PH_BODY_1 }
    SEAM(1);
    #define PH_BODY_2 phase_conv(C);
    if (IN(2)) { PH_BODY_2 } if (REPS(2) > 1 && IN(2)) { xcd_barrier(bar); PH_BODY_2 }
    SEAM(2);
    #define PH_BODY_3 { GateSched S{(unsigned)WS_XC, (unsigned)WS_GATE, 128, C.G, C.gc}; \
        EpiGate E{(const bf16_t*)(ws + WS_XC), (bf16_t*)(ws + WS_LA), (bf16_t*)(ws + WS_BB), (const float*)(ws + WS_CTL + CT_SPL), (unsigned)WS_GBIAS}; \
        pg8::gemm_phase<false, false>(C.lds, ws, 256, 1024, 256, S, E); mini_gate(C); }
    if (IN(3)) { PH_BODY_3 } if (REPS(3) > 1 && IN(3)) { xcd_barrier(bar); PH_BODY_3 }
    SEAM(3);
    #define PH_BODY_4 phase_scan(C);
    if (IN(4)) { PH_BODY_4 } if (REPS(4) > 1 && IN(4)) { xcd_barrier(bar); PH_BODY_4 }
    SEAM(4);
    #define PH_BODY_5 { DenseSched S{(unsigned)WS_G, (unsigned)WS_LOUT, 1024, 1024, 128, 4, C.G, C.gc}; EpiRes<true> E{(bf16_t*)(ws + WS_PRE), P.in[I_X], P.in[I_META], nullptr, NTOK}; \
        pg8::gemm_phase<false, false>(C.lds, ws, 1024, 1024, 1024, S, E); mini_lout(C); }
    if (IN(5)) { PH_BODY_5 } if (REPS(5) > 1 && IN(5)) { xcd_barrier(bar); PH_BODY_5 }
    SEAM(5);
    #define PH_BODY_6 phase_lnr(C, 0, NTOK);
    if (IN(6)) { PH_BODY_6 } if (REPS(6) > 1 && IN(6)) { xcd_barrier(bar); PH_BODY_6 }
    SEAM(6);
    #define PH_BODY_7 phase_pos(C, 0, NTOK);
    if (IN(7)) { PH_BODY_7 } if (REPS(7) > 1 && IN(7)) { xcd_barrier(bar); PH_BODY_7 }
    SEAM(7);
    #define PH_BODY_8 { const int nM = moe_prep(C, (const int*)(ws + WS_CTL + CT_TEXP)); \
        MoeSched S{(unsigned)WS_HB8, (unsigned)WS_WGU, (unsigned)WS_TOK, (const LAS int*)(C.lds + pg8::TEXP_OFF), 2048u * 1024u, nM, 8, C.G, C.gc}; EpiGlu E{(unsigned char*)(ws + WS_ACT), (unsigned)WS_BIAS}; \
        pg8::gemm_phase<true, true>(C.lds, ws, 512, 512, 512, S, E); }
    if (IN(8)) { PH_BODY_8 } if (REPS(8) > 1 && IN(8)) { xcd_barrier(bar); PH_BODY_8 }
#ifdef PROBE_NULL8
    if (IN(8)) { xcd_barrier(bar); { const int nM = moe_prep(C, (const int*)(ws + WS_CTL + CT_TEXP));
        MoeSched S{(unsigned)WS_HB8, (unsigned)WS_WGU, (unsigned)WS_TOK, (const LAS int*)(C.lds + pg8::TEXP_OFF), 2048u * 1024u, nM, 8, C.G, C.gc}; EpiNull E{};
        pg8::gemm_phase<true, true>(C.lds, ws, 512, 512, 512, S, E); } }
#endif
    SEAM(8);
    #define PH_BODY_9 { const int nM = moe_prep(C, (const int*)(ws + WS_CTL + CT_TEXP)); \
        MoeSched S{(unsigned)WS_ACT, (unsigned)WS_WD, 0u, (const LAS int*)(C.lds + pg8::TEXP_OFF), 1024u * 1024u, nM, 4, C.G, C.gc}; EpiDown E{(bf16_t*)(ws + WS_YS), (unsigned)WS_BD}; \
        pg8::gemm_phase<true, false>(C.lds, ws, 512, 512, 512, S, E); }
    if (IN(9)) { PH_BODY_9 } if (REPS(9) > 1 && IN(9)) { xcd_barrier(bar); PH_BODY_9 }
    SEAM(9);
    #define PH_BODY_10 phase_combine(C, 0, NTOK, false);
    if (IN(10)) { PH_BODY_10 } if (REPS(10) > 1 && IN(10)) { xcd_barrier(bar); PH_BODY_10 }
    SEAM(10);
    #define PH_BODY_11 { QkvSched S{(unsigned)WS_HB8, (unsigned)WS_QKV8, 128, C.G, C.gc}; EpiQkv E{(bf16_t*)(ws + WS_Q), (bf16_t*)(ws + WS_K), (bf16_t*)(ws + WS_VT)}; \
        pg8::gemm_phase<true, false>(C.lds, ws, 512, 512, 512, S, E); mini_kv(C); }
    if (IN(11)) { PH_BODY_11 } if (REPS(11) > 1 && IN(11)) { xcd_barrier(bar); PH_BODY_11 }
    SEAM(11);
    #define PH_BODY_12 phase_attn(C);
    if (IN(12)) { PH_BODY_12 } if (REPS(12) > 1 && IN(12)) { xcd_barrier(bar); PH_BODY_12 }
    SEAM(12);
    #define PH_BODY_13 { DenseSched S{(unsigned)WS_O, (unsigned)WS_NOUT, 1024, 1024, 128, 4, C.G, C.gc}; EpiRes<false> E{(bf16_t*)(ws + WS_PRE), nullptr, nullptr, (const bf16_t*)(ws + WS_HB), NGRID}; \
        pg8::gemm_phase<false, false>(C.lds, ws, 1024, 1024, 1024, S, E); }
    if (IN(13)) { PH_BODY_13 } if (REPS(13) > 1 && IN(13)) { xcd_barrier(bar); PH_BODY_13 }
    SEAM(13);
    #define PH_BODY_14 phase_lnr(C, 1, NGRID);
    if (IN(14)) { PH_BODY_14 } if (REPS(14) > 1 && IN(14)) { xcd_barrier(bar); PH_BODY_14 }
    SEAM(14);
    #define PH_BODY_15 phase_pos(C, 1, NGRID);
    if (IN(15)) { PH_BODY_15 } if (REPS(15) > 1 && IN(15)) { xcd_barrier(bar); PH_BODY_15 }
    SEAM(15);
    #define PH_BODY_16 { const int nM = moe_prep(C, (const int*)(ws + WS_CTL + CT_TEXP) + 1024); \
        MoeSched S{(unsigned)WS_HB8, (unsigned)(WS_WGU + (size_t)32 * 2048 * 1024), (unsigned)(WS_TOK + 1 * MiB), (const LAS int*)(C.lds + pg8::TEXP_OFF), 2048u * 1024u, nM, 8, C.G, C.gc}; EpiGlu E{(unsigned char*)(ws + WS_ACT), (unsigned)(WS_BIAS + 32 * 2048 * 4)}; \
        pg8::gemm_phase<true, true>(C.lds, ws, 512, 512, 512, S, E); }
    if (IN(16)) { PH_BODY_16 } if (REPS(16) > 1 && IN(16)) { xcd_barrier(bar); PH_BODY_16 }
    SEAM(16);
    #define PH_BODY_17 { const int nM = moe_prep(C, (const int*)(ws + WS_CTL + CT_TEXP) + 1024); \
        MoeSched S{(unsigned)WS_ACT, (unsigned)(WS_WD + (size_t)32 * 1024 * 1024), 0u, (const LAS int*)(C.lds + pg8::TEXP_OFF), 1024u * 1024u, nM, 4, C.G, C.gc}; EpiDown E{(bf16_t*)(ws + WS_YS), (unsigned)(WS_BD + 32 * 1024 * 4)}; \
        pg8::gemm_phase<true, false>(C.lds, ws, 512, 512, 512, S, E); }
    if (IN(17)) { PH_BODY_17 } if (REPS(17) > 1 && IN(17)) { xcd_barrier(bar); PH_BODY_17 }
    SEAM(17);
    #define PH_BODY_18 phase_combine(C, 1, NGRID, true);
    if (IN(18)) { PH_BODY_18 } if (REPS(18) > 1 && IN(18)) { xcd_barrier(bar); PH_BODY_18 }
#undef ws
#undef IN
#undef SEAM
}

#ifndef MK_PER_PHASE
#define MK_PER_PHASE 0
#endif
extern "C" void kernel_launch(void* const* d_in, const int* in_sizes, int n_in, void* d_out, int out_size, void* d_ws, size_t ws_size, hipStream_t stream) {
    static int grid = 0;
    if (grid == 0) {
        if (n_in != 25 || ws_size < WS_END || out_size != NGRID * D) { fprintf(stderr, "kernel_launch: unexpected problem (n_in %d, ws %zu, out %d)\n", n_in, ws_size, out_size); grid = -1; return; }
        int dev = 0, cus = 0, per_cu = 0;
        if (hipGetDevice(&dev) != hipSuccess || hipDeviceGetAttribute(&cus, hipDeviceAttributeMultiprocessorCount, dev) != hipSuccess) { grid = -1; return; }
        if (hipFuncSetAttribute((const void*)hybrid_fwd, hipFuncAttributeMaxDynamicSharedMemorySize, LDS_BYTES) != hipSuccess) { fprintf(stderr, "kernel_launch: hipFuncSetAttribute failed\n"); grid = -1; return; }
        if (hipOccupancyMaxActiveBlocksPerMultiprocessor(&per_cu, (const void*)hybrid_fwd, NTHREADS, LDS_BYTES) != hipSuccess || per_cu < 1) { fprintf(stderr, "kernel_launch: occupancy query failed (%d)\n", per_cu); grid = -1; return; }
        grid = cus * 1;
        if (grid > 256) grid = 256;
    }
    if (grid < 0) return;
    if (hipMemsetAsync((char*)d_ws + WS_CTL + CT_BAR, 0, 16384, stream) != hipSuccess) { fprintf(stderr, "kernel_launch: memset failed\n"); return; }
    Params p{};
    for (int i = 0; i < 25; ++i) p.in[i] = (const float*)d_in[i];
    p.out = (float*)d_out; p.ws = (unsigned char*)d_ws;
#if MK_PER_PHASE
    for (int ph = 0; ph < 19; ++ph) { p.ph_lo = ph; p.ph_hi = ph + 1; void* args[] = {&p};
        hipError_t e = hipLaunchCooperativeKernel((void*)hybrid_fwd, dim3(grid), dim3(NTHREADS), args, LDS_BYTES, stream);
        if (e != hipSuccess) { fprintf(stderr, "launch phase %d failed: %s\n", ph, hipGetErrorString(e)); break; } }
#else
    p.ph_lo = 0; p.ph_hi = 19; void* args[] = {&p};
    hipError_t e = hipLaunchCooperativeKernel((void*)hybrid_fwd, dim3(grid), dim3(NTHREADS), args, LDS_BYTES, stream);
    if (e != hipSuccess) fprintf(stderr, "cooperative launch failed: %s (grid %d)\n", hipGetErrorString(e), grid);
#endif
}
```

```cpp
#include <hip/hip_runtime.h>
#include <hip/hip_cooperative_groups.h>
#include <cstdio>
#include <cstdint>
namespace cg = cooperative_groups;

#define LAS __attribute__((address_space(3)))
typedef unsigned short bf16_t;
typedef short bf16x8 __attribute__((ext_vector_type(8)));
typedef float f32x4 __attribute__((ext_vector_type(4)));
typedef float f32x2 __attribute__((ext_vector_type(2)));
typedef unsigned u32x4 __attribute__((ext_vector_type(4)));
typedef unsigned u32x2 __attribute__((ext_vector_type(2)));

constexpr int NB = 8, SEQ = 4096, D = 1024, NMETA = 16, LSEQ = SEQ + NMETA;
constexpr int NGRID = NB * SEQ;
constexpr int NTOK = NGRID + NB * NMETA;
constexpr int MPAD = 33024;
constexpr int NEXP = 32, TOPK = 4;
constexpr int PMAX = 139776;
constexpr int MTMAX = PMAX / 256;
constexpr float DN_ALPHA = 1.41421356237f;
constexpr float LN_EPS = 1e-5f;
constexpr int NTHREADS = 512, NWAVES = 8;

constexpr size_t MiB = 1u << 20;
constexpr size_t ACT_BYTES = (size_t)MPAD * D * 2;
constexpr size_t WS_CTL   = 0;
constexpr size_t WS_WIN   = 4 * MiB;
constexpr size_t WS_GATE  = WS_WIN + 4 * MiB;
constexpr size_t WS_LOUT  = WS_GATE + 2 * MiB;
constexpr size_t WS_QKV   = WS_LOUT + 2 * MiB;
constexpr size_t WS_NOUT  = WS_QKV + 6 * MiB;
constexpr size_t WS_WGU   = WS_NOUT + 2 * MiB;
constexpr size_t WS_WD    = WS_WGU + 128 * MiB;
constexpr size_t WS_HB    = WS_WD + 64 * MiB;
constexpr size_t WS_HB8   = WS_HB + 65 * MiB;
constexpr size_t WS_PRE   = WS_HB8 + 33 * MiB;
constexpr size_t WS_H     = WS_PRE + 129 * MiB;
constexpr size_t WS_SCR   = WS_H + 129 * MiB;
constexpr size_t WS_XR = WS_SCR, WS_XC = WS_XR + 65 * MiB, WS_GY = WS_XC + 65 * MiB, WS_LA = WS_GY + 65 * MiB, WS_BB = WS_LA + 130 * MiB, WS_HF = WS_BB + 130 * MiB, WS_G = WS_HF + 65 * MiB;
constexpr size_t WS_SCR_END0 = WS_G + 65 * MiB;
constexpr size_t WS_XS = WS_SCR, WS_ACT = WS_XS + 137 * MiB, WS_YS = WS_ACT + 137 * MiB;
constexpr size_t WS_SCR_END1 = WS_YS + 274 * MiB;
constexpr size_t WS_Q = WS_SCR, WS_K = WS_Q + 65 * MiB, WS_VT = WS_K + 65 * MiB, WS_O = WS_VT + 65 * MiB;
constexpr size_t WS_BIAS = (WS_SCR_END0 > WS_SCR_END1 ? WS_SCR_END0 : WS_SCR_END1);
constexpr size_t WS_BD = WS_BIAS + 2 * 32 * 2048 * 4;
constexpr size_t WS_GBIAS = WS_BD + 2 * 32 * 1024 * 4;
constexpr size_t WS_TOK = WS_BIAS + 1 * MiB;
constexpr size_t WS_QKV8 = WS_TOK + 2 * MiB;
constexpr size_t WS_END = WS_QKV8 + 3 * MiB;
static_assert((size_t)PMAX * 4 <= 1 * MiB, "token offset table");
static_assert(ACT_BYTES <= 65 * MiB && (size_t)PMAX * D * 2 <= 274 * MiB && (size_t)PMAX * D <= 137 * MiB && (size_t)MPAD * D <= 33 * MiB && (size_t)MPAD * D * 4 <= 129 * MiB, "ws map");
static_assert(WS_END <= (size_t)2040 * MiB, "ws map must fit 4x the largest input tensor");
constexpr size_t CT_BC      = 4096;
constexpr size_t CT_TEXP    = CT_BC + 2 * 256 * 32 * 4;
constexpr size_t CT_SPL     = CT_TEXP + 2 * 1024 * 4;
constexpr size_t CT_EID     = 256 * 1024;
constexpr size_t CT_GATEV   = CT_EID + 2 * (size_t)NTOK * 4 * 4;
constexpr size_t CT_POS     = CT_GATEV + 2 * (size_t)NTOK * 4 * 4;
static_assert(CT_POS + 2 * (size_t)NTOK * 4 * 4 <= 4 * MiB, "ctl map");

constexpr int LDS_BYTES = 155648;

__device__ __forceinline__ unsigned f2bf(float f) { unsigned u = __builtin_bit_cast(unsigned, f); return (u + 0x7fffu + ((u >> 16) & 1u)) >> 16; }
__device__ __forceinline__ unsigned cvt_pk_bf16(float lo, float hi);
__device__ __forceinline__ unsigned pk2(float lo, float hi) { return cvt_pk_bf16(lo, hi); }
typedef __bf16 bf16x2_t __attribute__((ext_vector_type(2)));
__device__ __forceinline__ unsigned cvt_pk_bf16(float lo, float hi) { const f32x2 v = {lo, hi}; return __builtin_bit_cast(unsigned, __builtin_convertvector(v, bf16x2_t)); }
__device__ __forceinline__ unsigned pk4_fp8(float a, float b, float c, float d) { int w = __builtin_amdgcn_cvt_pk_fp8_f32(a, b, 0, false); w = __builtin_amdgcn_cvt_pk_fp8_f32(c, d, w, true); return (unsigned)w; }
__device__ __forceinline__ float bflo(unsigned w) { return __builtin_bit_cast(float, w << 16); }
__device__ __forceinline__ float bfhi(unsigned w) { return __builtin_bit_cast(float, w & 0xffff0000u); }
__device__ __forceinline__ void unpack8(const u32x4 w, float (&o)[8]);
__device__ __forceinline__ float fast_exp2(float x) { return __builtin_amdgcn_exp2f(x); }
__device__ __forceinline__ float fast_rcp(float x) { return __builtin_amdgcn_rcpf(x); }
__device__ __forceinline__ float sigmoidf_(float x) { return fast_rcp(1.0f + fast_exp2(-1.44269504089f * x)); }
__device__ __forceinline__ float wave_sum(float v) {
#pragma unroll
    for (int o = 1; o < 64; o <<= 1) v += __shfl_xor(v, o);
    return v;
}
template <int CTRL> __device__ __forceinline__ float dpp_movf(float v) { return __builtin_bit_cast(float, __builtin_amdgcn_update_dpp(0, __builtin_bit_cast(int, v), CTRL, 0xf, 0xf, true)); }
__device__ __forceinline__ float readlane_f(float v, int l) { return __builtin_bit_cast(float, __builtin_amdgcn_readlane(__builtin_bit_cast(int, v), l)); }
__device__ __forceinline__ float wave_sum_dpp(float v) {
    v += dpp_movf<0xB1>(v);
    v += dpp_movf<0x4E>(v);
    v += dpp_movf<0x141>(v);
    v += dpp_movf<0x140>(v);
    return (readlane_f(v, 0) + readlane_f(v, 16)) + (readlane_f(v, 32) + readlane_f(v, 48));
}
__device__ __forceinline__ int seqrow(int b, int s) { return s < NMETA ? NGRID + NMETA * b + s : SEQ * b + (s - NMETA); }

struct Params {
    const float* in[25];
    float* out;
    unsigned char* ws;
    int ph_lo, ph_hi;
};
struct Ctx {
    LAS unsigned char* lds;
    int G, bid, gc;
    unsigned char* ws;
    const float* const* in;
    float* out;
};
__device__ __forceinline__ int fresh_tid() { int t = threadIdx.x; asm volatile("" : "+v"(t)); return t; }
__device__ __forceinline__ unsigned char* fresh_ws(unsigned char* p) { asm volatile("" : "+s"(p)); return p; }
#define PHASE_IDS unsigned char* const wsl = fresh_ws(C.ws); (void)wsl; const int tid = fresh_tid(); const int lane = tid & 63; const int wave = __builtin_amdgcn_readfirstlane(tid >> 6); (void)lane; (void)wave;
enum { I_X = 0, I_META, I_WIN, I_CONVW, I_CONVB, I_WA, I_BA, I_WX, I_BX, I_LAM, I_LOUT, I_WQKV, I_RPB, I_MBIAS, I_NOUT, I_LNMG, I_LNMB, I_RW, I_RB, I_WGU, I_BGU, I_WD, I_BD, I_LNFG, I_LNFB };

namespace pg8 {
constexpr int BM = 256, BK = 64, HALF = 128, HTB = HALF * BK * 2, STAGE_BYTES = 8 * HTB, NXCD = 8, WGM = 8;
constexpr int SIDE_OFF = STAGE_BYTES, TEXP_OFF = STAGE_BYTES + 2048, TOK_OFF = STAGE_BYTES + 2048 + 4096;
__device__ __forceinline__ int lds_byte(int r, int c) { const int st = (r >> 4) * 2 + (c >> 5), rr = r & 15, cc = c & 31, ob = rr * 64 + cc * 2; return st * 1024 + (ob ^ (((ob >> 9) & 1) << 5)); }
__device__ __forceinline__ void stage_rc(int b, int& R, int& C) { const int st = b / 1024, sb = b % 1024, swz = sb ^ (((sb >> 9) & 1) << 5); R = (st >> 1) * 16 + swz / 64; C = (st & 1) * 32 + (swz % 64) / 2; }
__device__ __forceinline__ int perm32(int rho) { const int n = rho >> 4, i = rho & 15; return 8 * (i >> 2) + 4 * n + (i & 3); }

typedef int v8i __attribute__((ext_vector_type(8)));
typedef int v4i __attribute__((ext_vector_type(4)));
__device__ __forceinline__ v8i cat8(bf16x8 a, bf16x8 b) { const v4i x = __builtin_bit_cast(v4i, a), y = __builtin_bit_cast(v4i, b); return __builtin_shufflevector(x, y, 0, 1, 2, 3, 4, 5, 6, 7); }
struct Unit { unsigned ao, bo, to; int pm, pn, aux; };

__device__ __forceinline__ void tile_of(int L, int nM, int nN, int& pm, int& pn) {
    const int nwg = nM * nN; int wgid = L;
    { const int q = nwg / NXCD, r = nwg % NXCD, xcd = wgid % NXCD, off = wgid / NXCD; wgid = (xcd < r ? xcd * (q + 1) : r * (q + 1) + (xcd - r) * q) + off; }
    const int nig = WGM * nN, gid = wgid / nig, fm = gid * WGM, gsz = (nM - fm) < WGM ? (nM - fm) : WGM;
    pm = fm + ((wgid % nig) % gsz); pn = (wgid % nig) / gsz;
}

template <bool F8, bool GATHER, class Epi, class Sched>
__device__ __forceinline__ void gemm_phase(LAS unsigned char* lds, const unsigned char* wsbase, const int K, const int lda, const int ldb, const Sched& S, const Epi& E) {
    const __amdgpu_buffer_rsrc_t rsrc = __builtin_amdgcn_make_buffer_rsrc((void*)wsbase, 0, 0xFFFFFFFF, 0x00020000);
    const int tid = fresh_tid(), wid = __builtin_amdgcn_readfirstlane(tid >> 6), lane = tid & 63, wr = wid >> 2, wc = wid & 3;
    const int nt = K / BK;
    int f8scales = 0; if constexpr (F8) { f8scales = Epi::SCALES; asm volatile("" : "+v"(f8scales)); }
    int voffA, voffB;
    { int R, C; stage_rc(tid * 16, R, C); const int Rb = Epi::PERM ? ((R & ~31) + perm32(R & 31)) : R; voffA = ((GATHER ? 0 : R * lda) + C) * 2; voffB = (Rb * ldb + C) * 2; }
    const int tokb = (16 * (wid >> 1) + (lane >> 2)) * 4;
    const unsigned kstep = (unsigned)(BK * 2);
    const unsigned hstepA = (unsigned)HALF * lda * 2, hstepB = (unsigned)HALF * ldb * 2;
    const unsigned ldsw = (unsigned)wid * 1024u;
    const int aoff = lds_byte(wr * 64 + (lane & 15), (lane >> 4) * 8), boff = lds_byte(wc * 32 + (lane & 15), (lane >> 4) * 8);
#define PG8_SA(b, h) (((b) * 2 + (h)) * HTB)
#define PG8_SB(b, h) ((4 + (b) * 2 + (h)) * HTB)
#define PG8_STAGE(bufoff, gbase, voff) do { _Pragma("unroll") for (int _i = 0; _i < 2; ++_i) \
        __builtin_amdgcn_raw_ptr_buffer_load_lds(rsrc, (LAS void*)(lds + (bufoff) + ldsl + _i * 8192), 16, voff, __builtin_amdgcn_readfirstlane((int)((gbase) + (unsigned)_i * (hstep##voff >> 1))), 0, 0); } while (0)
#define hstepvoffA hstepA
#define hstepvoffB hstepB
#define PG8_STAGE_A(bufoff, aoffs, h, par) do { if constexpr (GATHER) { _Pragma("unroll") for (int _i = 0; _i < 2; ++_i) { \
            const int _tk = *(const LAS int*)(lds + TOK_OFF + (par) * 1024 + tokb + ((h) * 128 + _i * 64) * 4); \
            __builtin_amdgcn_raw_ptr_buffer_load_lds(rsrc, (LAS void*)(lds + (bufoff) + ldsl + _i * 8192), 16, _tk + voffA, __builtin_amdgcn_readfirstlane((int)(aoffs)), 0, 0); } } \
        else { PG8_STAGE(bufoff, (aoffs) + (unsigned)(h) * hstepA, voffA); } } while (0)
#define PG8_TOK(unit, par) do { if constexpr (GATHER) { if (wid == 0) __builtin_amdgcn_raw_ptr_buffer_load_lds(rsrc, (LAS void*)(lds + TOK_OFF + (par) * 1024), 16, lane * 16, (int)(unit).to, 0, 0); } } while (0)
#define PG8_LDA(dst, b, h) do { _Pragma("unroll") for (int m = 0; m < 4; ++m) _Pragma("unroll") for (int k = 0; k < 2; ++k) dst[m][k] = *(const LAS bf16x8*)(lds + PG8_SA(b, h) + aoff + m * 2048 + k * 1024); } while (0)
#define PG8_LDB(dst, b, h) do { _Pragma("unroll") for (int n = 0; n < 2; ++n) _Pragma("unroll") for (int k = 0; k < 2; ++k) dst[n][k] = *(const LAS bf16x8*)(lds + PG8_SB(b, h) + boff + n * 2048 + k * 1024); } while (0)
#define PG8_MMA(ai, bj, At, Bt) do { __builtin_amdgcn_s_setprio(1); _Pragma("unroll") for (int m = 0; m < 4; ++m) _Pragma("unroll") for (int n = 0; n < 2; ++n) { \
        if constexpr (F8) { asm volatile("v_mfma_scale_f32_16x16x128_f8f6f4 %0, %1, %2, %0, %3, %3 op_sel:[0,1,0] op_sel_hi:[0,0,0]" : "+v"(acc[ai][bj][m][n]) : "v"(cat8(Bt[n][0], Bt[n][1])), "v"(cat8(At[m][0], At[m][1])), "v"(f8scales)); } \
        else { _Pragma("unroll") for (int k = 0; k < 2; ++k) acc[ai][bj][m][n] = __builtin_amdgcn_mfma_f32_16x16x32_bf16(Bt[n][k], At[m][k], acc[ai][bj][m][n], 0, 0, 0); } } \
        __builtin_amdgcn_s_setprio(0); } while (0)
#define PG8_WAIT_V(n) asm volatile("s_waitcnt vmcnt(" #n ")" ::: "memory")
#define PG8_WAIT_L(n) asm volatile("s_waitcnt lgkmcnt(" #n ")" ::: "memory")
#define PG8_BAR __builtin_amdgcn_s_barrier()
#define PG8_SCHED __builtin_amdgcn_sched_barrier(0)
    Unit cur, nxt; int ui = 0;
    if (!S.next(0, cur)) return;
    f32x4 acc[2][2][4][2];
    bf16x8 At[4][2], B0[2][2], B1[2][2];
#define PG8_INIT(par) do { if constexpr (Epi::SIDE) { const int _l = fresh_tid() & 63; E.init(acc, (const LAS float*)(lds + SIDE_OFF + (par) * 1024), wc, _l >> 4); } \
        else { _Pragma("unroll") for (int a = 0; a < 2; ++a) _Pragma("unroll") for (int b = 0; b < 2; ++b) _Pragma("unroll") for (int m = 0; m < 4; ++m) _Pragma("unroll") for (int n = 0; n < 2; ++n) acc[a][b][m][n] = (f32x4){0.f, 0.f, 0.f, 0.f}; } } while (0)
    unsigned cA = cur.ao, cB = cur.bo;
    unsigned ldsl = ldsw; asm volatile("" : "+s"(ldsl));
#define PG8_SIDE(unit, par) do { if constexpr (Epi::SIDE) { if (wid == 0) __builtin_amdgcn_raw_ptr_buffer_load_lds(rsrc, (LAS void*)(lds + SIDE_OFF + (par) * 1024), 16, lane * 16, (int)E.side_off(unit), 0, 0); } } while (0)
    PG8_SIDE(cur, 0);
    if constexpr (GATHER) PG8_TOK(cur, 0);
    if constexpr (GATHER || Epi::SIDE) { asm volatile("s_waitcnt vmcnt(0)" ::: "memory"); PG8_BAR; }
    PG8_INIT(0);
    PG8_STAGE(PG8_SB(0, 0), cB, voffB); PG8_STAGE(PG8_SB(0, 1), cB + hstepB, voffB); PG8_STAGE_A(PG8_SA(0, 0), cA, 0, 0); PG8_STAGE_A(PG8_SA(0, 1), cA, 1, 0);
    if (wr == 1) PG8_BAR;
    PG8_WAIT_V(2); PG8_BAR;
    PG8_STAGE(PG8_SB(1, 0), cB + kstep, voffB); PG8_STAGE_A(PG8_SA(1, 0), cA + kstep, 0, 0); PG8_STAGE(PG8_SB(1, 1), cB + hstepB + kstep, voffB);
    PG8_WAIT_V(6); PG8_BAR;
    for (;;) {
        const bool has_next = S.next(ui + 1, nxt);
        if (has_next) { PG8_TOK(nxt, (ui + 1) & 1); PG8_SIDE(nxt, (ui + 1) & 1); }
        const unsigned nA = has_next ? nxt.ao : cA, nB = has_next ? nxt.bo : cB;
#pragma unroll 1
        for (int t = 0; t < nt; t += 2) {
            const bool last = (t == nt - 2);
            ldsl = ldsw; asm volatile("" : "+s"(ldsl));
            const int parc = ui & 1, parn = (ui + ((last && has_next) ? 1 : 0)) & 1;
            const unsigned a1 = cA + (unsigned)(t + 1) * kstep;
            const unsigned a2 = last ? nA : cA + (unsigned)(t + 2) * kstep, b2 = last ? nB : cB + (unsigned)(t + 2) * kstep;
            const unsigned a3 = a2 + kstep, b3 = b2 + kstep;
            PG8_LDB(B0, 0, 0); PG8_LDB(B1, 0, 1); PG8_SCHED; PG8_LDA(At, 0, 0); PG8_STAGE_A(PG8_SA(1, 1), a1, 1, parc);
            PG8_WAIT_V(8); PG8_WAIT_L(0); PG8_BAR; PG8_MMA(0, 0, At, B0); PG8_MMA(0, 1, At, B1); PG8_BAR; PG8_SCHED;
            PG8_LDA(At, 0, 1); PG8_STAGE(PG8_SB(0, 0), b2, voffB); PG8_STAGE(PG8_SB(0, 1), b2 + hstepB, voffB); PG8_STAGE_A(PG8_SA(0, 0), a2, 0, parn);
            PG8_WAIT_V(8); PG8_WAIT_L(0); PG8_BAR; PG8_MMA(1, 0, At, B0); PG8_MMA(1, 1, At, B1); PG8_BAR; PG8_SCHED;
            PG8_LDB(B0, 1, 0); PG8_LDB(B1, 1, 1); PG8_SCHED; PG8_LDA(At, 1, 0); PG8_STAGE_A(PG8_SA(0, 1), a2, 1, parn);
            PG8_WAIT_V(8); PG8_WAIT_L(0); PG8_BAR; PG8_MMA(0, 0, At, B0); PG8_MMA(0, 1, At, B1); PG8_BAR; PG8_SCHED;
            PG8_LDA(At, 1, 1); PG8_STAGE(PG8_SB(1, 0), b3, voffB); PG8_STAGE(PG8_SB(1, 1), b3 + hstepB, voffB); PG8_STAGE_A(PG8_SA(1, 0), a3, 0, parn);
            PG8_WAIT_V(8); PG8_WAIT_L(0); PG8_BAR; PG8_MMA(1, 0, At, B0); PG8_MMA(1, 1, At, B1); PG8_BAR; PG8_SCHED;
        }
        if constexpr (F8) asm volatile("s_nop 15\n\ts_nop 15" ::: "memory");
        if (wr == 0) PG8_BAR;
        { const int l2 = fresh_tid() & 63; E(acc, cur, wr, wc, l2 & 15, l2 >> 4, (const LAS float*)(lds + SIDE_OFF + (ui & 1) * 1024)); }
        if (!has_next) break;
        cur = nxt; cA = nA; cB = nB; ++ui;
        PG8_INIT(ui & 1);
        if (wr == 1) PG8_BAR;
    }
    PG8_WAIT_V(0);
    PG8_BAR;
#undef PG8_SA
#undef PG8_SB
#undef PG8_STAGE
#undef PG8_STAGE_A
#undef PG8_TOK
#undef PG8_SIDE
#undef PG8_INIT
#undef hstepvoffA
#undef hstepvoffB
#undef PG8_LDA
#undef PG8_LDB
#undef PG8_MMA
#undef PG8_WAIT_V
#undef PG8_WAIT_L
#undef PG8_BAR
#undef PG8_SCHED
}
}

using pg8::Unit;

struct DenseSched {
    unsigned A, Bt; int lda, ldb, nM, nN, G, c;
    __device__ __forceinline__ bool next(int i, Unit& u) const {
        const int L = i * G + c; if (L >= nM * nN) return false;
        pg8::tile_of(L, nM, nN, u.pm, u.pn); u.aux = 0; u.to = 0;
        u.ao = A + (unsigned)u.pm * 256 * lda * 2; u.bo = Bt + (unsigned)u.pn * 256 * ldb * 2; return true;
    }
};
struct GateSched {
    unsigned XC, GT; int nM, G, c;
    __device__ __forceinline__ bool next(int i, Unit& u) const {
        const int per = nM * 4; const int L = i * G + c; if (L >= 4 * per) return false;
        const int nb = L / per; pg8::tile_of(L - nb * per, nM, 4, u.pm, u.pn); u.aux = nb; u.to = 0;
        u.ao = XC + ((unsigned)u.pm * 256 * 1024 + 256 * nb) * 2; u.bo = GT + ((unsigned)nb * 1024 + 256 * u.pn) * 256 * 2; return true;
    }
};
struct QkvSched {
    unsigned HB, WT; int nM, G, c;
    __device__ __forceinline__ bool next(int i, Unit& u) const {
        const int n0 = nM * 8, n1 = 4 * nM; const int L = i * G + c; if (L >= n0 + n1) return false; u.to = 0;
        if (L < n0) { pg8::tile_of(L, nM, 8, u.pm, u.pn); u.aux = 0; u.ao = HB + (unsigned)u.pm * 256 * 1024; u.bo = WT + (unsigned)u.pn * 256 * 1024; }
        else { pg8::tile_of(L - n0, 4, nM, u.pm, u.pn); u.aux = 1; u.ao = WT + (unsigned)(2048 + u.pm * 256) * 1024; u.bo = HB + (unsigned)u.pn * 256 * 1024; }
        return true;
    }
};
struct MoeSched {
    unsigned A, W, tok; const LAS int* texp; unsigned wstride; int nM, nN, G, c;
    __device__ __forceinline__ bool next(int i, Unit& u) const {
        const int L = i * G + c; if (L >= nM * nN) return false;
        pg8::tile_of(L, nM, nN, u.pm, u.pn);
        const int e = __builtin_amdgcn_readfirstlane(texp[u.pm]); u.aux = e;
        u.ao = tok ? A : A + (unsigned)u.pm * 256 * 1024; u.to = tok + (unsigned)u.pm * 1024; u.bo = W + (unsigned)e * wstride + (unsigned)u.pn * 256 * 1024; return true;
    }
};

#define EPI_ARGS const f32x4 (&acc)[2][2][4][2], const Unit& u, int wr, int wc, int fr, int fq, const LAS float* side
struct EpiWin {
    static constexpr bool PERM = true, SIDE = false;
    bf16_t* XR; bf16_t* GY;
    __device__ __forceinline__ void operator()(EPI_ARGS) const {
        const int row0 = u.pm * 256 + wr * 64 + fr;
        if (u.pn < 4) {
            const int col0 = u.pn * 256 + wc * 32 + 8 * fq;
#pragma unroll
            for (int ai = 0; ai < 2; ++ai)
#pragma unroll
                for (int m = 0; m < 4; ++m) { bf16_t* rowp = XR + (size_t)(row0 + ai * 128 + m * 16) * D + col0;
#pragma unroll
                    for (int bj = 0; bj < 2; ++bj) { const f32x4 v0 = acc[ai][bj][m][0], v1 = acc[ai][bj][m][1];
                        u32x4 w; w.x = cvt_pk_bf16(v0[0], v0[1]); w.y = cvt_pk_bf16(v0[2], v0[3]); w.z = cvt_pk_bf16(v1[0], v1[1]); w.w = cvt_pk_bf16(v1[2], v1[3]);
                        *(u32x4*)(rowp + bj * 128) = w; } }
        } else {
#pragma unroll
            for (int ai = 0; ai < 2; ++ai)
#pragma unroll
                for (int m = 0; m < 4; ++m) { const int row = row0 + ai * 128 + m * 16;
#pragma unroll
                    for (int bj = 0; bj < 2; ++bj) { const int g = (u.pn - 4) * 8 + bj * 4 + wc;
                        float o[8];
#pragma unroll
                        for (int n = 0; n < 2; ++n)
#pragma unroll
                            for (int j = 0; j < 4; ++j) { const float v = acc[ai][bj][m][n][j]; const float z = 1.5957691216f * (v + 0.044715f * v * v * v); o[n * 4 + j] = v * sigmoidf_(z); }
                        u32x4 w; w.x = cvt_pk_bf16(o[0], o[1]); w.y = cvt_pk_bf16(o[2], o[3]); w.z = cvt_pk_bf16(o[4], o[5]); w.w = cvt_pk_bf16(o[6], o[7]);
                        *(u32x4*)(GY + ((size_t)g * MPAD + row) * 32 + 8 * fq) = w; } }
        }
    }
};
struct EpiGate {
    static constexpr bool PERM = true, SIDE = true;
    const bf16_t* XC; bf16_t* LA; bf16_t* BB; const float* spl; unsigned bias_off;
    __device__ __forceinline__ unsigned side_off(const Unit& u) const { return bias_off + (unsigned)((((u.pn >> 1) * 4 + u.aux) * 2 + (u.pn & 1)) * 1024); }
    __device__ __forceinline__ void init(f32x4 (&acc)[2][2][4][2], const LAS float* side, int wc, int fq) const {
#pragma unroll
        for (int bj = 0; bj < 2; ++bj)
#pragma unroll
            for (int n = 0; n < 2; ++n) { const f32x4 b = *(const LAS f32x4*)(side + 128 * bj + 32 * wc + 8 * fq + 4 * n);
#pragma unroll
                for (int ai = 0; ai < 2; ++ai)
#pragma unroll
                    for (int m = 0; m < 4; ++m) acc[ai][bj][m][n] = b; }
    }
    __device__ __forceinline__ void operator()(EPI_ARGS) const {
        const int nb = u.aux, dir = u.pn >> 1, half = u.pn & 1;
        const int ch0 = 256 * nb + 128 * half + 32 * wc + 8 * fq, g = ch0 >> 5;
        const int row0 = u.pm * 256 + wr * 64 + fr;
        float csp[8];
        { const f32x4 p0 = *(const f32x4*)(spl + dir * 1024 + ch0), p1 = *(const f32x4*)(spl + dir * 1024 + ch0 + 4);
#pragma unroll
          for (int j = 0; j < 4; ++j) { csp[j] = -p0[j]; csp[4 + j] = -p1[j]; } }
        u32x4 xnext = *(const u32x4*)(XC + (size_t)row0 * D + ch0);
#pragma unroll
        for (int ai = 0; ai < 2; ++ai)
#pragma unroll
            for (int m = 0; m < 4; ++m) { const int row = row0 + ai * 128 + m * 16;
                const u32x4 xw = xnext;
                { const int it = ai * 4 + m + 1, rn = row0 + (it >> 2) * 128 + (it & 3) * 16; if (it < 8) xnext = *(const u32x4*)(XC + (size_t)rn * D + ch0); }
                float xc[8]; unpack8(xw, xc);
                const bool start = dir == 1 && (row & (SEQ - 1)) == SEQ - 1;
                float la[8], bb[8];
#pragma unroll
                for (int n = 0; n < 2; ++n)
#pragma unroll
                    for (int j = 0; j < 4; ++j) { const int i = n * 4 + j;
                        const float l2 = csp[i] * sigmoidf_(acc[ai][0][m][n][j]); const float a2 = fast_exp2(2.0f * l2);
                        const float mult = start ? 1.0f : __builtin_amdgcn_sqrtf(fmaxf(1.0f - a2, 0.0f));
                        la[i] = l2; bb[i] = mult * sigmoidf_(acc[ai][1][m][n][j]) * xc[i]; }
                u32x4 w; w.x = cvt_pk_bf16(la[0], la[1]); w.y = cvt_pk_bf16(la[2], la[3]); w.z = cvt_pk_bf16(la[4], la[5]); w.w = cvt_pk_bf16(la[6], la[7]);
                const size_t o = (((size_t)dir * 32 + g) * MPAD + row) * 32 + 8 * fq;
                *(u32x4*)(LA + o) = w;
                w.x = cvt_pk_bf16(bb[0], bb[1]); w.y = cvt_pk_bf16(bb[2], bb[3]); w.z = cvt_pk_bf16(bb[4], bb[5]); w.w = cvt_pk_bf16(bb[6], bb[7]);
                *(u32x4*)(BB + o) = w; }
    }
};
template <bool LAYER0> struct EpiRes {
    static constexpr bool PERM = true, SIDE = false;
    bf16_t* PRE; const float* x; const float* meta; const bf16_t* HB; int nrows;
    __device__ __forceinline__ void operator()(EPI_ARGS) const {
        const int row0 = u.pm * 256 + wr * 64 + fr, col0 = u.pn * 256 + wc * 32 + 8 * fq;
#pragma unroll
        for (int ai = 0; ai < 2; ++ai)
#pragma unroll
            for (int m = 0; m < 4; ++m) { const int row = row0 + ai * 128 + m * 16;
                if (row < nrows) {
#pragma unroll
                    for (int bj = 0; bj < 2; ++bj) { const int c = col0 + bj * 128; float r[8];
                        if (LAYER0) { const float* rp = (row < NGRID ? x + (size_t)row * D : meta + (size_t)((row - NGRID) & 15) * D) + c; const f32x4 r0 = *(const f32x4*)rp, r1 = *(const f32x4*)(rp + 4);
                            r[0] = r0[0]; r[1] = r0[1]; r[2] = r0[2]; r[3] = r0[3]; r[4] = r1[0]; r[5] = r1[1]; r[6] = r1[2]; r[7] = r1[3]; }
                        else { const u32x4 rw = *(const u32x4*)(HB + (size_t)row * D + c); r[0] = bflo(rw.x); r[1] = bfhi(rw.x); r[2] = bflo(rw.y); r[3] = bfhi(rw.y); r[4] = bflo(rw.z); r[5] = bfhi(rw.z); r[6] = bflo(rw.w); r[7] = bfhi(rw.w); }
                        const f32x4 a0 = acc[ai][bj][m][0], a1 = acc[ai][bj][m][1];
                        u32x4 w; w.x = cvt_pk_bf16(r[0] * DN_ALPHA + a0[0], r[1] * DN_ALPHA + a0[1]); w.y = cvt_pk_bf16(r[2] * DN_ALPHA + a0[2], r[3] * DN_ALPHA + a0[3]);
                        w.z = cvt_pk_bf16(r[4] * DN_ALPHA + a1[0], r[5] * DN_ALPHA + a1[1]); w.w = cvt_pk_bf16(r[6] * DN_ALPHA + a1[2], r[7] * DN_ALPHA + a1[3]);
                        *(u32x4*)(PRE + (size_t)row * D + c) = w; }
                }
                asm volatile("" ::: "memory"); }
    }
};
struct EpiGlu {
    static constexpr bool PERM = true, SIDE = true; static constexpr int SCALES = 0x7F79;
    unsigned char* ACT; unsigned bias_off;
    __device__ __forceinline__ unsigned side_off(const Unit& u) const { return bias_off + (unsigned)((u.aux * 8 + u.pn) * 1024); }
    __device__ __forceinline__ void init(f32x4 (&acc)[2][2][4][2], const LAS float* side, int wc, int fq) const {
#pragma unroll
        for (int bj = 0; bj < 2; ++bj)
#pragma unroll
            for (int n = 0; n < 2; ++n) { const f32x4 b = *(const LAS f32x4*)(side + 128 * bj + 32 * wc + 8 * fq + 4 * n);
#pragma unroll
                for (int ai = 0; ai < 2; ++ai)
#pragma unroll
                    for (int m = 0; m < 4; ++m) acc[ai][bj][m][n] = b; }
    }
    __device__ __forceinline__ void operator()(EPI_ARGS) const {
        const int f0 = 128 * u.pn + 32 * wc + 8 * fq;
        const int row0 = u.pm * 256 + wr * 64 + fr;
#pragma unroll
        for (int ai = 0; ai < 2; ++ai)
#pragma unroll
            for (int m = 0; m < 4; ++m) { const int row = row0 + ai * 128 + m * 16; float o[8];
#pragma unroll
                for (int n = 0; n < 2; ++n)
#pragma unroll
                    for (int j = 0; j < 4; ++j) { const int i = n * 4 + j;
                        const float glu = fminf(acc[ai][0][m][n][j], 7.0f);
                        const float lin4 = __builtin_fmaf(__builtin_amdgcn_fmed3f(acc[ai][1][m][n][j], -7.0f, 7.0f), 4.0f, 4.0f);
                        const float r = fast_rcp(1.0f + fast_exp2(glu * (-1.702f * 1.44269504089f)));
                        o[i] = (glu * r) * lin4; }
                u32x2 w; w.x = pk4_fp8(o[0], o[1], o[2], o[3]); w.y = pk4_fp8(o[4], o[5], o[6], o[7]);
                *(u32x2*)(ACT + (size_t)row * D + f0) = w; }
    }
};
struct EpiNull {
    static constexpr bool PERM = true, SIDE = false; static constexpr int SCALES = 0x7F79;
    __device__ __forceinline__ void operator()(EPI_ARGS) const {
#pragma unroll
        for (int ai = 0; ai < 2; ++ai)
#pragma unroll
            for (int bj = 0; bj < 2; ++bj)
#pragma unroll
                for (int m = 0; m < 4; ++m)
#pragma unroll
                    for (int n = 0; n < 2; ++n) asm volatile("" :: "v"(acc[ai][bj][m][n]));
    }
};
struct EpiDown {
    static constexpr bool PERM = true, SIDE = true; static constexpr int SCALES = 0x7D79;
    bf16_t* YS; unsigned bias_off;
    __device__ __forceinline__ unsigned side_off(const Unit& u) const { return bias_off + (unsigned)((u.aux * 4 + u.pn) * 1024); }
    __device__ __forceinline__ void init(f32x4 (&acc)[2][2][4][2], const LAS float* side, int wc, int fq) const {
#pragma unroll
        for (int bj = 0; bj < 2; ++bj)
#pragma unroll
            for (int n = 0; n < 2; ++n) { const f32x4 b = *(const LAS f32x4*)(side + 128 * bj + 32 * wc + 8 * fq + 4 * n);
#pragma unroll
                for (int ai = 0; ai < 2; ++ai)
#pragma unroll
                    for (int m = 0; m < 4; ++m) acc[ai][bj][m][n] = b; }
    }
    __device__ __forceinline__ void operator()(EPI_ARGS) const {
        const int row0 = u.pm * 256 + wr * 64 + fr, col0 = u.pn * 256 + wc * 32 + 8 * fq;
#pragma unroll
        for (int ai = 0; ai < 2; ++ai)
#pragma unroll
            for (int m = 0; m < 4; ++m) { bf16_t* rowp = YS + (size_t)(row0 + ai * 128 + m * 16) * D + col0;
#pragma unroll
                for (int bj = 0; bj < 2; ++bj) { const f32x4 v0 = acc[ai][bj][m][0], v1 = acc[ai][bj][m][1];
                    u32x4 w; w.x = cvt_pk_bf16(v0[0], v0[1]); w.y = cvt_pk_bf16(v0[2], v0[3]); w.z = cvt_pk_bf16(v1[0], v1[1]); w.w = cvt_pk_bf16(v1[2], v1[3]);
                    *(u32x4*)(rowp + bj * 128) = w; } }
    }
};
struct EpiQkv {
    static constexpr bool PERM = true, SIDE = false; static constexpr int SCALES = 0x7F79;
    bf16_t* Q; bf16_t* Kx; bf16_t* VT;
    __device__ __forceinline__ void operator()(EPI_ARGS) const {
        const int row0 = u.pm * 256 + wr * 64 + fr; bf16_t* base; int ldc, colt; float sc = 1.0f;
        if (u.aux == 0) { ldc = D; if (u.pn < 4) { base = Q; colt = u.pn * 256; sc = 0.125f * 1.44269504089f; } else { base = Kx; colt = (u.pn - 4) * 256; } }
        else { base = VT; ldc = MPAD; colt = u.pn * 256; }
        const int col0 = colt + wc * 32 + 8 * fq;
#pragma unroll
        for (int ai = 0; ai < 2; ++ai)
#pragma unroll
            for (int m = 0; m < 4; ++m) { bf16_t* rowp = base + (size_t)(row0 + ai * 128 + m * 16) * ldc + col0;
#pragma unroll
                for (int bj = 0; bj < 2; ++bj) { const f32x4 v0 = acc[ai][bj][m][0] * sc, v1 = acc[ai][bj][m][1] * sc;
                    u32x4 w; w.x = cvt_pk_bf16(v0[0], v0[1]); w.y = cvt_pk_bf16(v0[2], v0[3]); w.z = cvt_pk_bf16(v1[0], v1[1]); w.w = cvt_pk_bf16(v1[2], v1[3]);
                    *(u32x4*)(rowp + bj * 128) = w; } }
    }
};

__device__ __forceinline__ void tr_item(const float* W, int ld, int kb, int n0, bf16_t* dst0, int K, LAS float* scr, int lane) {
    const int r = lane >> 4, q = lane & 15;
    f32x4 v[16];
#pragma unroll
    for (int i = 0; i < 16; ++i) v[i] = __builtin_nontemporal_load((const f32x4*)(W + (size_t)(64 * kb + 4 * i + r) * ld + n0 + 4 * q));
#pragma unroll
    for (int i = 0; i < 16; ++i) { LAS float* s = scr + (4 * i + r) * 65 + 4 * q; s[0] = v[i][0]; s[1] = v[i][1]; s[2] = v[i][2]; s[3] = v[i][3]; }
    asm volatile("s_waitcnt lgkmcnt(0)" ::: "memory");
    const int c = lane & 7, nn = lane >> 3;
#pragma unroll
    for (int j = 0; j < 8; ++j) { const int n = nn + 8 * j; const LAS float* s = scr + (8 * c) * 65 + n;
        u32x4 o; o.x = pk2(s[0], s[65]); o.y = pk2(s[2 * 65], s[3 * 65]); o.z = pk2(s[4 * 65], s[5 * 65]); o.w = pk2(s[6 * 65], s[7 * 65]);
        *(u32x4*)(dst0 + (size_t)n * K + 64 * kb + 8 * c) = o; }
    asm volatile("s_waitcnt lgkmcnt(0)" ::: "memory");
}
__device__ __forceinline__ void tr_item8(const float* W, int ld, int kb, int n0, unsigned char* dst0, int K, LAS float* scr, int lane) {
    const int r = lane >> 4, q = lane & 15;
    f32x4 v[16];
#pragma unroll
    for (int i = 0; i < 16; ++i) v[i] = __builtin_nontemporal_load((const f32x4*)(W + (size_t)(64 * kb + 4 * i + r) * ld + n0 + 4 * q));
#pragma unroll
    for (int i = 0; i < 16; ++i) { LAS float* s = scr + (4 * i + r) * 65 + 4 * q; s[0] = v[i][0]; s[1] = v[i][1]; s[2] = v[i][2]; s[3] = v[i][3]; }
    asm volatile("s_waitcnt lgkmcnt(0)" ::: "memory");
    const int c = lane & 7, nn = lane >> 3;
#pragma unroll
    for (int j = 0; j < 8; ++j) { const int n = nn + 8 * j; const LAS float* s = scr + (8 * c) * 65 + n;
        u32x2 o; o.x = pk4_fp8(s[0] * 64.0f, s[65] * 64.0f, s[2 * 65] * 64.0f, s[3 * 65] * 64.0f); o.y = pk4_fp8(s[4 * 65] * 64.0f, s[5 * 65] * 64.0f, s[6 * 65] * 64.0f, s[7 * 65] * 64.0f);
        *(u32x2*)(dst0 + (size_t)n * K + 64 * kb + 8 * c) = o; }
    asm volatile("s_waitcnt lgkmcnt(0)" ::: "memory");
}
__device__ __forceinline__ void phase_convert(const Ctx& C) {
    PHASE_IDS
    LAS float* scr = (LAS float*)(C.lds + wave * 16640);
    const int gw = C.bid * NWAVES + wave, NGW = C.G * NWAVES;
    constexpr int I0 = 512, I1 = 256, I2 = 256, I3 = 768, I4 = 256, I5 = 32768, I6 = 16384, I7 = 768, NIT = I0 + I1 + I2 + I3 + I4 + I5 + I6 + I7;
    for (int it = gw; it < NIT; it += NGW) {
        int r = it;
        if (r < I0) { const int nbk = r & 31, kb = r >> 5; tr_item(C.in[I_WIN], 2048, kb, 64 * nbk, (bf16_t*)(wsl + WS_WIN) + (size_t)(64 * nbk) * 1024, 1024, scr, lane); continue; } r -= I0;
        if (r < I1) { const int job = r >> 3, sub = r & 7, nbk = sub & 1, kb = sub >> 1;
            const int half = job & 1, which = (job >> 1) & 1, nb = (job >> 2) & 3, dir = job >> 4;
            const float* src = C.in[which ? I_WX : I_WA] + (size_t)(dir * 4 + nb) * 65536;
            bf16_t* dst = (bf16_t*)(wsl + WS_GATE) + ((size_t)nb * 1024 + 256 * (2 * dir + half) + 128 * which + 64 * nbk) * 256;
            tr_item(src, 256, kb, 128 * half + 64 * nbk, dst, 256, scr, lane); continue; } r -= I1;
        if (r < I2) { const int nbk = r & 15, kb = r >> 4; tr_item(C.in[I_LOUT], 1024, kb, 64 * nbk, (bf16_t*)(wsl + WS_LOUT) + (size_t)(64 * nbk) * 1024, 1024, scr, lane); continue; } r -= I2;
        if (r < I3) { const int nbk = r % 48, kb = r / 48; tr_item(C.in[I_WQKV], 3072, kb, 64 * nbk, (bf16_t*)(wsl + WS_QKV) + (size_t)(64 * nbk) * 1024, 1024, scr, lane); continue; } r -= I3;
        if (r < I4) { const int nbk = r & 15, kb = r >> 4; tr_item(C.in[I_NOUT], 1024, kb, 64 * nbk, (bf16_t*)(wsl + WS_NOUT) + (size_t)(64 * nbk) * 1024, 1024, scr, lane); continue; } r -= I4;
        if (r < I5) { const int mat = r >> 9, sub = r & 511, nbk = sub & 31, kb = sub >> 5; const int n0 = 64 * nbk, bj = n0 >> 10, f0 = n0 & 1023, pn = f0 >> 7, jj = f0 & 127;
            tr_item8(C.in[I_WGU] + (size_t)mat * 1024 * 2048, 2048, kb, n0, (unsigned char*)(wsl + WS_WGU) + ((size_t)mat * 2048 + 256 * pn + 128 * bj + jj) * 1024, 1024, scr, lane); continue; } r -= I5;
        if (r >= I6) { r -= I6; const int nbk = r % 48, kb = r / 48; tr_item8(C.in[I_WQKV], 3072, kb, 64 * nbk, (unsigned char*)(wsl + WS_QKV8) + (size_t)(64 * nbk) * 1024, 1024, scr, lane); continue; }
        { const int mat = r >> 8, sub = r & 255, nbk = sub & 15, kb = sub >> 4;
            tr_item8(C.in[I_WD] + (size_t)mat * 1024 * 1024, 1024, kb, 64 * nbk, (unsigned char*)(wsl + WS_WD) + ((size_t)mat * 1024 + 64 * nbk) * 1024, 1024, scr, lane); }
    }
    const int gt = C.bid * NTHREADS + tid, NGT = C.G * NTHREADS;
    for (int i = gt; i < 2048; i += NGT) ((float*)(wsl + WS_CTL + CT_SPL))[i] = 8.0f * 1.44269504089f * log1pf(expf(-C.in[I_LAM][i]));
    for (int i = gt; i < 2 * 32 * 2048; i += NGT) { const int le = i >> 11, r = i & 2047, pn = r >> 8, bj = (r >> 7) & 1, ii = r & 127;
        ((float*)(wsl + WS_BIAS))[i] = C.in[I_BGU][(size_t)le * 2048 + bj * 1024 + 128 * pn + ii]; }
    for (int i = gt; i < 2 * 32 * 1024; i += NGT) ((float*)(wsl + WS_BD))[i] = C.in[I_BD][i];
    for (int i = gt; i < 4096; i += NGT) { const int ut = i >> 8, which = (i >> 7) & 1, jj = i & 127, dir = ut >> 3, nb = (ut >> 1) & 3, half = ut & 1;
        ((float*)(wsl + WS_GBIAS))[i] = C.in[which ? I_BX : I_BA][dir * 1024 + 256 * nb + 128 * half + jj]; }
    for (int i = gt; i < NTOK * 128; i += NGT) { const int row = i >> 7, oc = i & 127;
        const float* src = (row < NGRID ? C.in[I_X] + (size_t)row * D : C.in[I_META] + (size_t)((row - NGRID) & 15) * D) + 8 * oc;
        const f32x4 a = *(const f32x4*)src, b = *(const f32x4*)(src + 4);
        u32x4 w; w.x = pk2(a[0], a[1]); w.y = pk2(a[2], a[3]); w.z = pk2(b[0], b[1]); w.w = pk2(b[2], b[3]);
        *(u32x4*)((bf16_t*)(wsl + WS_HB) + (size_t)row * D + 8 * oc) = w; }
}

__device__ __forceinline__ void phase_conv(const Ctx& C) {
    PHASE_IDS
    const bf16_t* XR = (const bf16_t*)(wsl + WS_XR); bf16_t* XC = (bf16_t*)(wsl + WS_XC);
    const float* cw = C.in[I_CONVW]; const float* cb = C.in[I_CONVB];
    const int gt = C.bid * NTHREADS + tid, NGT = C.G * NTHREADS;
    for (int i = gt; i < NTOK * 128; i += NGT) { const int row = i >> 7, ch = 8 * (i & 127);
        int b, s; if (row < NGRID) { b = row >> 12; s = NMETA + (row & (SEQ - 1)); } else { b = (row - NGRID) >> 4; s = (row - NGRID) & 15; }
        float a[8];
        { const f32x4 t0 = *(const f32x4*)(cb + ch), t1 = *(const f32x4*)(cb + ch + 4);
#pragma unroll
          for (int j = 0; j < 4; ++j) { a[j] = t0[j]; a[4 + j] = t1[j]; } }
#pragma unroll
        for (int j = 0; j < 4; ++j) { const int sj = s - 2 + j;
            if (sj >= 0 && sj < LSEQ) { const u32x4 xw = *(const u32x4*)(XR + (size_t)seqrow(b, sj) * D + ch);
                const f32x4 w0 = *(const f32x4*)(cw + j * 1024 + ch), w1 = *(const f32x4*)(cw + j * 1024 + ch + 4);
                a[0] += w0[0] * bflo(xw.x); a[1] += w0[1] * bfhi(xw.x); a[2] += w0[2] * bflo(xw.y); a[3] += w0[3] * bfhi(xw.y);
                a[4] += w1[0] * bflo(xw.z); a[5] += w1[1] * bfhi(xw.z); a[6] += w1[2] * bflo(xw.w); a[7] += w1[3] * bfhi(xw.w); } }
        u32x4 w; w.x = pk2(a[0], a[1]); w.y = pk2(a[2], a[3]); w.z = pk2(a[4], a[5]); w.w = pk2(a[6], a[7]);
        *(u32x4*)(XC + (size_t)row * D + ch) = w; }
}

template <int N> __device__ __forceinline__ float dpp_shr(float oldv, float v) {
    return __builtin_bit_cast(float, __builtin_amdgcn_update_dpp(__builtin_bit_cast(int, oldv), __builtin_bit_cast(int, v), 0x110 + N, 0xf, 0xf, false));
}
__device__ __forceinline__ void scan_group(float (&a)[8], float (&b)[8]) {
#pragma unroll
    for (int c = 0; c < 8; ++c) {
        { const float ap = dpp_shr<1>(1.0f, a[c]), bp = dpp_shr<1>(0.0f, b[c]); b[c] = a[c] * bp + b[c]; a[c] = a[c] * ap; }
        { const float ap = dpp_shr<2>(1.0f, a[c]), bp = dpp_shr<2>(0.0f, b[c]); b[c] = a[c] * bp + b[c]; a[c] = a[c] * ap; }
        { const float ap = dpp_shr<4>(1.0f, a[c]), bp = dpp_shr<4>(0.0f, b[c]); b[c] = a[c] * bp + b[c]; a[c] = a[c] * ap; }
        { const float ap = dpp_shr<8>(1.0f, a[c]), bp = dpp_shr<8>(0.0f, b[c]); b[c] = a[c] * bp + b[c]; a[c] = a[c] * ap; }
    }
}
__device__ __forceinline__ void unpack8(const u32x4 w, float (&o)[8]) { o[0] = bflo(w.x); o[1] = bfhi(w.x); o[2] = bflo(w.y); o[3] = bfhi(w.y); o[4] = bflo(w.z); o[5] = bfhi(w.z); o[6] = bflo(w.w); o[7] = bfhi(w.w); }
__device__ __forceinline__ void phase_scan(const Ctx& C) {
    PHASE_IDS
    const bf16_t* LA = (const bf16_t*)(wsl + WS_LA); const bf16_t* BB = (const bf16_t*)(wsl + WS_BB); const bf16_t* GY = (const bf16_t*)(wsl + WS_GY);
    bf16_t* HF = (bf16_t*)(wsl + WS_HF); bf16_t* Gout = (bf16_t*)(wsl + WS_G);
    LAS float* agg = (LAS float*)C.lds;
    const int w = wave, oct = lane >> 4, p = lane & 15;
    for (int item = C.bid; item < NB * 32; item += C.G) {
        const int b = item >> 5, g = item & 31;
        for (int dir = 0; dir < 2; ++dir) {
            const bf16_t* la = LA + (((size_t)dir * 32 + g) * MPAD) * 32 + 8 * oct;
            const bf16_t* bb = BB + (((size_t)dir * 32 + g) * MPAD) * 32 + 8 * oct;
            float S[8];
#pragma unroll
            for (int c = 0; c < 8; ++c) S[c] = 0.f;
            {
                const int u = p, s = dir ? LSEQ - 1 - u : u, row = seqrow(b, s);
                float a[8], x[8]; unpack8(*(const u32x4*)(la + (size_t)row * 32), a); unpack8(*(const u32x4*)(bb + (size_t)row * 32), x);
#pragma unroll
                for (int c = 0; c < 8; ++c) a[c] = fast_exp2(a[c]);
                scan_group(a, x);
                if (w == 0) {
                    if (dir == 0) { u32x4 o; o.x = pk2(x[0], x[1]); o.y = pk2(x[2], x[3]); o.z = pk2(x[4], x[5]); o.w = pk2(x[6], x[7]); *(u32x4*)(HF + ((size_t)g * MPAD + row) * 32 + 8 * oct) = o; }
                    else { float hf[8], gy[8]; unpack8(*(const u32x4*)(HF + ((size_t)g * MPAD + row) * 32 + 8 * oct), hf); unpack8(*(const u32x4*)(GY + ((size_t)g * MPAD + row) * 32 + 8 * oct), gy);
                        u32x4 o; o.x = pk2((hf[0] + x[0]) * gy[0], (hf[1] + x[1]) * gy[1]); o.y = pk2((hf[2] + x[2]) * gy[2], (hf[3] + x[3]) * gy[3]);
                        o.z = pk2((hf[4] + x[4]) * gy[4], (hf[5] + x[5]) * gy[5]); o.w = pk2((hf[6] + x[6]) * gy[6], (hf[7] + x[7]) * gy[7]);
                        *(u32x4*)(Gout + (size_t)row * D + 32 * g + 8 * oct) = o; }
                }
#pragma unroll
                for (int c = 0; c < 8; ++c) S[c] = __shfl(x[c], (lane & 48) | 15);
            }
            for (int r = 0; r < 8; ++r) {
                float Pw[4][8], Hw[4][8]; int rows[4];
                float Aw[8], Hc[8];
#pragma unroll
                for (int c = 0; c < 8; ++c) { Aw[c] = 1.f; Hc[c] = 0.f; }
                u32x4 ra[4], rb[4];
#pragma unroll
                for (int j = 0; j < 4; ++j) { const int u = 16 + 512 * r + 64 * w + 16 * j + p, s = dir ? LSEQ - 1 - u : u; rows[j] = seqrow(b, s);
                    ra[j] = *(const u32x4*)(la + (size_t)rows[j] * 32); rb[j] = *(const u32x4*)(bb + (size_t)rows[j] * 32); }
#pragma unroll
                for (int j = 0; j < 4; ++j) {
                    float a[8], x[8]; unpack8(ra[j], a); unpack8(rb[j], x);
#pragma unroll
                    for (int c = 0; c < 8; ++c) a[c] = fast_exp2(a[c]);
                    scan_group(a, x);
#pragma unroll
                    for (int c = 0; c < 8; ++c) { Hw[j][c] = a[c] * Hc[c] + x[c]; Pw[j][c] = a[c] * Aw[c]; }
#pragma unroll
                    for (int c = 0; c < 8; ++c) { Aw[c] = __shfl(Pw[j][c], (lane & 48) | 15); Hc[c] = __shfl(Hw[j][c], (lane & 48) | 15); }
                }
                LAS float* ag = agg + (r & 1) * 512;
                if (p == 0) {
#pragma unroll
                    for (int c = 0; c < 8; ++c) { ag[(w * 32 + oct * 8 + c) * 2] = Aw[c]; ag[(w * 32 + oct * 8 + c) * 2 + 1] = Hc[c]; }
                }
                __syncthreads();
                float Sin[8];
#pragma unroll
                for (int c = 0; c < 8; ++c) Sin[c] = S[c];
#pragma unroll
                for (int ww = 0; ww < 8; ++ww) {
#pragma unroll
                    for (int c = 0; c < 8; ++c) { const float A = ag[(ww * 32 + oct * 8 + c) * 2], H = ag[(ww * 32 + oct * 8 + c) * 2 + 1];
                        if (ww == w) Sin[c] = S[c];
                        S[c] = A * S[c] + H; }
                }
#pragma unroll
                for (int j = 0; j < 4; ++j) {
                    float h[8];
#pragma unroll
                    for (int c = 0; c < 8; ++c) h[c] = Pw[j][c] * Sin[c] + Hw[j][c];
                    const size_t go = ((size_t)g * MPAD + rows[j]) * 32 + 8 * oct;
                    if (dir == 0) { u32x4 o; o.x = pk2(h[0], h[1]); o.y = pk2(h[2], h[3]); o.z = pk2(h[4], h[5]); o.w = pk2(h[6], h[7]); *(u32x4*)(HF + go) = o; }
                    else { float hf[8], gy[8]; unpack8(*(const u32x4*)(HF + go), hf); unpack8(*(const u32x4*)(GY + go), gy);
                        u32x4 o; o.x = pk2((hf[0] + h[0]) * gy[0], (hf[1] + h[1]) * gy[1]); o.y = pk2((hf[2] + h[2]) * gy[2], (hf[3] + h[3]) * gy[3]);
                        o.z = pk2((hf[4] + h[4]) * gy[4], (hf[5] + h[5]) * gy[5]); o.w = pk2((hf[6] + h[6]) * gy[6], (hf[7] + h[7]) * gy[7]);
                        *(u32x4*)(Gout + (size_t)rows[j] * D + 32 * g + 8 * oct) = o; }
                }
            }
            __syncthreads();
        }
    }
}

template <int K> __device__ __forceinline__ f32x4 mini_mma(const bf16_t* W, int ldw, const bf16_t* A, int lda, int lane) {
    const bf16_t* wp = W + (size_t)(lane & 15) * ldw + 8 * (lane >> 4); const bf16_t* ap = A + (size_t)(lane & 15) * lda + 8 * (lane >> 4);
    f32x4 acc = {0.f, 0.f, 0.f, 0.f};
    constexpr int KB = K < 512 ? K : 512, NS = KB / 32;
#pragma unroll 1
    for (int k0 = 0; k0 < K; k0 += KB) { bf16x8 wf[NS], af[NS];
#pragma unroll
        for (int i = 0; i < NS; ++i) { wf[i] = *(const bf16x8*)(wp + k0 + 32 * i); af[i] = *(const bf16x8*)(ap + k0 + 32 * i); }
#pragma unroll
        for (int i = 0; i < NS; ++i) acc = __builtin_amdgcn_mfma_f32_16x16x32_bf16(wf[i], af[i], acc, 0, 0, 0); }
    return acc;
}
__device__ __forceinline__ void mini_win(const Ctx& C) {
    PHASE_IDS
    const bf16_t* HB = (const bf16_t*)(C.ws + WS_HB); const bf16_t* WT = (const bf16_t*)(C.ws + WS_WIN); bf16_t* XR = (bf16_t*)(C.ws + WS_XR); bf16_t* GY = (bf16_t*)(C.ws + WS_GY);
    const int fr = lane & 15, fq = lane >> 4;
    for (int wt = C.gc * NWAVES + wave; wt < 8 * 128; wt += C.G * NWAVES) { const int rg = wt & 7, cb = wt >> 3, row = NGRID + 16 * rg + fr, c = 16 * cb + 4 * fq;
        const f32x4 a = mini_mma<1024>(WT + (size_t)(16 * cb) * 1024, 1024, HB + (size_t)(NGRID + 16 * rg) * 1024, 1024, lane);
        if (c < 1024) { u32x2 w; w.x = cvt_pk_bf16(a[0], a[1]); w.y = cvt_pk_bf16(a[2], a[3]); *(u32x2*)(XR + (size_t)row * D + c) = w; }
        else { const int yc = c - 1024; float o[4];
#pragma unroll
            for (int j = 0; j < 4; ++j) { const float v = a[j]; const float z = 1.5957691216f * (v + 0.044715f * v * v * v); o[j] = v * sigmoidf_(z); }
            u32x2 w; w.x = cvt_pk_bf16(o[0], o[1]); w.y = cvt_pk_bf16(o[2], o[3]); *(u32x2*)(GY + ((size_t)(yc >> 5) * MPAD + row) * 32 + (yc & 31)) = w; } }
}
__device__ __forceinline__ void mini_gate(const Ctx& C) {
    PHASE_IDS
    const bf16_t* XC = (const bf16_t*)(C.ws + WS_XC); const bf16_t* GT = (const bf16_t*)(C.ws + WS_GATE); bf16_t* LA = (bf16_t*)(C.ws + WS_LA); bf16_t* BB = (bf16_t*)(C.ws + WS_BB);
    const float* ba = C.in[I_BA]; const float* bx = C.in[I_BX]; const float* spl = (const float*)(C.ws + WS_CTL + CT_SPL);
    const int fr = lane & 15, fq = lane >> 4;
    for (int wt = C.gc * NWAVES + wave; wt < 8 * 2 * 64; wt += C.G * NWAVES) { const int rg = wt & 7, dir = (wt >> 3) & 1, chg = wt >> 4, ch0 = 16 * chg, nb = ch0 >> 8, half = (ch0 >> 7) & 1, jj0 = ch0 & 127;
        const bf16_t* A = XC + (size_t)(NGRID + 16 * rg) * 1024 + 256 * nb; const bf16_t* Wa = GT + ((size_t)nb * 1024 + 256 * (2 * dir + half) + jj0) * 256;
        const f32x4 za = mini_mma<256>(Wa, 256, A, 1024, lane), zx = mini_mma<256>(Wa + 128 * 256, 256, A, 1024, lane);
        const int row = NGRID + 16 * rg + fr, ch = ch0 + 4 * fq;
        const f32x4 cba = *(const f32x4*)(ba + dir * 1024 + ch), cbx = *(const f32x4*)(bx + dir * 1024 + ch), csp = *(const f32x4*)(spl + dir * 1024 + ch);
        const u32x2 xw = *(const u32x2*)(XC + (size_t)row * D + ch); const float xc[4] = {bflo(xw.x), bfhi(xw.x), bflo(xw.y), bfhi(xw.y)};
        float la[4], bb[4];
#pragma unroll
        for (int j = 0; j < 4; ++j) { const float l2 = -csp[j] * sigmoidf_(za[j] + cba[j]); const float a2 = fast_exp2(2.0f * l2);
            const float mult = (dir == 0 && fr == 0) ? 1.0f : __builtin_amdgcn_sqrtf(fmaxf(1.0f - a2, 0.0f)); la[j] = l2; bb[j] = mult * sigmoidf_(zx[j] + cbx[j]) * xc[j]; }
        const size_t o = (((size_t)dir * 32 + (ch >> 5)) * MPAD + row) * 32 + (ch & 31);
        u32x2 w; w.x = cvt_pk_bf16(la[0], la[1]); w.y = cvt_pk_bf16(la[2], la[3]); *(u32x2*)(LA + o) = w;
        w.x = cvt_pk_bf16(bb[0], bb[1]); w.y = cvt_pk_bf16(bb[2], bb[3]); *(u32x2*)(BB + o) = w; }
}
__device__ __forceinline__ void mini_lout(const Ctx& C) {
    PHASE_IDS
    const bf16_t* G = (const bf16_t*)(C.ws + WS_G); const bf16_t* WT = (const bf16_t*)(C.ws + WS_LOUT); bf16_t* PRE = (bf16_t*)(C.ws + WS_PRE); const float* meta = C.in[I_META];
    const int fr = lane & 15, fq = lane >> 4;
    for (int wt = C.gc * NWAVES + wave; wt < 8 * 64; wt += C.G * NWAVES) { const int rg = wt & 7, cb = wt >> 3, row = NGRID + 16 * rg + fr, c = 16 * cb + 4 * fq;
        const f32x4 a = mini_mma<1024>(WT + (size_t)(16 * cb) * 1024, 1024, G + (size_t)(NGRID + 16 * rg) * 1024, 1024, lane);
        const f32x4 r = *(const f32x4*)(meta + (size_t)fr * D + c);
        u32x2 w; w.x = cvt_pk_bf16(r[0] * DN_ALPHA + a[0], r[1] * DN_ALPHA + a[1]); w.y = cvt_pk_bf16(r[2] * DN_ALPHA + a[2], r[3] * DN_ALPHA + a[3]); *(u32x2*)(PRE + (size_t)row * D + c) = w; }
}
__device__ __forceinline__ void mini_kv(const Ctx& C) {
    PHASE_IDS
    const bf16_t* HB = (const bf16_t*)(C.ws + WS_HB); const bf16_t* WT = (const bf16_t*)(C.ws + WS_QKV); bf16_t* Kx = (bf16_t*)(C.ws + WS_K); bf16_t* VT = (bf16_t*)(C.ws + WS_VT);
    const int fr = lane & 15, fq = lane >> 4;
    for (int wt = C.gc * NWAVES + wave; wt < 2 * 8 * 64; wt += C.G * NWAVES) { const int rg = wt & 7, cb = (wt >> 3) & 63, isv = wt >> 9;
        const bf16_t* A = HB + (size_t)(NGRID + 16 * rg) * 1024;
        if (!isv) { const f32x4 a = mini_mma<1024>(WT + (size_t)(1024 + 16 * cb) * 1024, 1024, A, 1024, lane);
            u32x2 w; w.x = cvt_pk_bf16(a[0], a[1]); w.y = cvt_pk_bf16(a[2], a[3]); *(u32x2*)(Kx + (size_t)(NGRID + 16 * rg + fr) * D + 16 * cb + 4 * fq) = w; }
        else { const f32x4 a = mini_mma<1024>(A, 1024, WT + (size_t)(2048 + 16 * cb) * 1024, 1024, lane);
            u32x2 w; w.x = cvt_pk_bf16(a[0], a[1]); w.y = cvt_pk_bf16(a[2], a[3]); *(u32x2*)(VT + (size_t)(16 * cb + fr) * MPAD + NGRID + 16 * rg + 4 * fq) = w; } }
}

constexpr int RWT_PITCH = 1028;
__device__ __forceinline__ void phase_lnr(const Ctx& C, int layer, int nrows) {
    PHASE_IDS
    const bf16_t* PRE = (const bf16_t*)(wsl + WS_PRE); bf16_t* HB = (bf16_t*)(wsl + WS_HB); unsigned char* HB8 = wsl + WS_HB8;
    const float* lg = C.in[I_LNMG] + layer * D; const float* lb = C.in[I_LNMB] + layer * D;
    const float* rw = C.in[I_RW] + (size_t)layer * D * NEXP; const float* rb = C.in[I_RB] + layer * NEXP;
    int* eid = (int*)(wsl + WS_CTL + CT_EID) + (size_t)layer * NTOK * 4; float* gatev = (float*)(wsl + WS_CTL + CT_GATEV) + (size_t)layer * NTOK * 4;
    unsigned* bc = (unsigned*)(wsl + WS_CTL + CT_BC) + ((size_t)layer * 256 + C.bid) * 32;
    LAS float* RWt = (LAS float*)C.lds; LAS unsigned* hist = (LAS unsigned*)(C.lds + 32 * RWT_PITCH * 4);
    { f32x4 wv[16];
#pragma unroll
      for (int i = 0; i < 16; ++i) wv[i] = *(const f32x4*)(rw + 4 * (tid + NTHREADS * i));
#pragma unroll
      for (int i = 0; i < 16; ++i) { const int idx4 = tid + NTHREADS * i, ch = idx4 >> 3, e4 = (idx4 & 7) * 4;
          const int c = 4 * ((ch & 511) >> 3) + 256 * (2 * (ch >> 9) + ((ch >> 2) & 1)) + (ch & 3);
          RWt[(e4 + 0) * RWT_PITCH + c] = wv[i][0]; RWt[(e4 + 1) * RWT_PITCH + c] = wv[i][1]; RWt[(e4 + 2) * RWT_PITCH + c] = wv[i][2]; RWt[(e4 + 3) * RWT_PITCH + c] = wv[i][3]; } }
    if (tid < 32) hist[tid] = 0u;
    __syncthreads();
    float gg[2][8], gb[2][8];
#pragma unroll
    for (int j = 0; j < 2; ++j) { const f32x4 a0 = *(const f32x4*)(lg + 8 * lane + 512 * j), a1 = *(const f32x4*)(lg + 8 * lane + 512 * j + 4), b0 = *(const f32x4*)(lb + 8 * lane + 512 * j), b1 = *(const f32x4*)(lb + 8 * lane + 512 * j + 4);
#pragma unroll
        for (int i = 0; i < 4; ++i) { gg[j][i] = a0[i]; gg[j][4 + i] = a1[i]; gb[j][i] = b0[i]; gb[j][4 + i] = b1[i]; } }
    const float rbias = rb[lane >> 1];
    const int gw = C.bid * NWAVES + wave, NGW = C.G * NWAVES;
    u32x4 nv[2];
    if (gw < nrows) {
#pragma unroll
        for (int j = 0; j < 2; ++j) nv[j] = *(const u32x4*)(PRE + (size_t)gw * D + 8 * lane + 512 * j); }
    for (int row = gw; row < nrows; row += NGW) {
        float v[2][8]; float s = 0.f;
#pragma unroll
        for (int j = 0; j < 2; ++j) { unpack8(nv[j], v[j]); s += ((v[j][0] + v[j][1]) + (v[j][2] + v[j][3])) + ((v[j][4] + v[j][5]) + (v[j][6] + v[j][7])); }
        if (row + NGW < nrows) {
#pragma unroll
            for (int j = 0; j < 2; ++j) nv[j] = *(const u32x4*)(PRE + (size_t)(row + NGW) * D + 8 * lane + 512 * j); }
        const float mean = wave_sum_dpp(s) * (1.0f / D); float q = 0.f;
#pragma unroll
        for (int j = 0; j < 2; ++j)
#pragma unroll
            for (int i = 0; i < 8; ++i) { v[j][i] -= mean; q += v[j][i] * v[j][i]; }
        const float rstd = __builtin_amdgcn_rsqf(wave_sum_dpp(q) * (1.0f / D) + LN_EPS);
#pragma unroll
        for (int j = 0; j < 2; ++j) {
#pragma unroll
            for (int i = 0; i < 8; ++i) v[j][i] = v[j][i] * rstd * gg[j][i] + gb[j][i];
            u32x4 w; w.x = pk2(v[j][0], v[j][1]); w.y = pk2(v[j][2], v[j][3]); w.z = pk2(v[j][4], v[j][5]); w.w = pk2(v[j][6], v[j][7]);
            *(u32x4*)(HB + (size_t)row * D + 8 * lane + 512 * j) = w;
            u32x2 w8; w8.x = pk4_fp8(v[j][0], v[j][1], v[j][2], v[j][3]); w8.y = pk4_fp8(v[j][4], v[j][5], v[j][6], v[j][7]);
            *(u32x2*)(HB8 + (size_t)row * D + 8 * lane + 512 * j) = w8; }
        float pl[32];
#pragma unroll
        for (int e0 = 0; e0 < 32; e0 += 4) {
            f32x4 wv[4][4];
#pragma unroll
            for (int ee = 0; ee < 4; ++ee)
#pragma unroll
                for (int jj = 0; jj < 4; ++jj) wv[ee][jj] = *(const LAS f32x4*)(RWt + (e0 + ee) * RWT_PITCH + 4 * lane + 256 * jj);
            __builtin_amdgcn_sched_barrier(0);
#pragma unroll
            for (int ee = 0; ee < 4; ++ee) { float a = 0.f;
#pragma unroll
                for (int jj = 0; jj < 4; ++jj) { const int j = jj >> 1, o = 4 * (jj & 1); a += (v[j][o] * wv[ee][jj][0] + v[j][o + 1] * wv[ee][jj][1]) + (v[j][o + 2] * wv[ee][jj][2] + v[j][o + 3] * wv[ee][jj][3]); }
                pl[e0 + ee] = a; }
        }
        float q16[16], q8[8], q4[4], q2[2], q1;
        { const bool hi = (lane & 32) != 0;
#pragma unroll
          for (int e = 0; e < 16; ++e) { const float mine = hi ? pl[16 + e] : pl[e], other = hi ? pl[e] : pl[16 + e]; q16[e] = mine + __shfl_xor(other, 32); } }
        { const bool hi = (lane & 16) != 0;
#pragma unroll
          for (int e = 0; e < 8; ++e) { const float mine = hi ? q16[8 + e] : q16[e], other = hi ? q16[e] : q16[8 + e]; q8[e] = mine + __shfl_xor(other, 16); } }
        { const bool hi = (lane & 8) != 0;
#pragma unroll
          for (int e = 0; e < 4; ++e) { const float mine = hi ? q8[4 + e] : q8[e], other = hi ? q8[e] : q8[4 + e]; q4[e] = mine + dpp_movf<0x128>(other); } }
        { const bool hi = (lane & 4) != 0;
#pragma unroll
          for (int e = 0; e < 2; ++e) { const float mine = hi ? q4[2 + e] : q4[e], other = hi ? q4[e] : q4[2 + e]; q2[e] = mine + __shfl_xor(other, 4); } }
        { const bool hi = (lane & 2) != 0; const float mine = hi ? q2[1] : q2[0], other = hi ? q2[0] : q2[1]; q1 = mine + dpp_movf<0x4E>(other); }
        q1 += dpp_movf<0xB1>(q1);
        float lv = q1 + rbias; lv = (lv == lv) ? lv : -3.0e38f;
        const int le = lane >> 1;
        int rank = 0;
#pragma unroll
        for (int j = 0; j < 32; ++j) { const float lj = readlane_f(lv, 2 * j); rank += (lj > lv || (lj == lv && j < le)) ? 1 : 0; }
        const unsigned long long m0 = __ballot(rank == 0);
        const float mxl = readlane_f(lv, (int)__builtin_ctzll(m0));
        const float pe = rank < 4 ? __expf(lv - mxl) : 0.f;
        const float den = wave_sum_dpp(pe) * 0.5f;
        if (rank < 4 && (lane & 1) == 0) { eid[(size_t)row * 4 + rank] = le; gatev[(size_t)row * 4 + rank] = pe / den;
            __hip_atomic_fetch_add(&hist[le], 1u, __ATOMIC_RELAXED, __HIP_MEMORY_SCOPE_WORKGROUP); }
    }
    __syncthreads();
    if (tid < 32) bc[tid] = hist[tid];
}

__device__ __forceinline__ void phase_pos(const Ctx& C, int layer, int nrows) {
    PHASE_IDS
    const unsigned* bcAll = (const unsigned*)(wsl + WS_CTL + CT_BC) + (size_t)layer * 256 * 32;
    const int* eid = (const int*)(wsl + WS_CTL + CT_EID) + (size_t)layer * NTOK * 4; int* posv = (int*)(wsl + WS_CTL + CT_POS) + (size_t)layer * NTOK * 4;
    int* texp = (int*)(wsl + WS_CTL + CT_TEXP) + layer * 1024;
    int* tokoff = (int*)(wsl + WS_TOK) + (size_t)layer * (1 * MiB / 4);
    LAS unsigned* partT = (LAS unsigned*)C.lds; LAS unsigned* partP = partT + 512; LAS unsigned* tot = partP + 512; LAS unsigned* cnt = tot + 32;
    { const int e = tid & 31, part = tid >> 5; unsigned t = 0, pr = 0;
      unsigned vv[16];
#pragma unroll
      for (int i = 0; i < 16; ++i) { const int bq = part + 16 * i; vv[i] = bq < C.G ? bcAll[(size_t)bq * 32 + e] : 0u; }
#pragma unroll
      for (int i = 0; i < 16; ++i) { const int bq = part + 16 * i; t += vv[i]; if (bq < C.bid) pr += vv[i]; }
      partT[part * 32 + e] = t; partP[part * 32 + e] = pr; }
    __syncthreads();
    if (tid < 32) { unsigned t = 0, pr = 0; for (int i = 0; i < 16; ++i) { t += partT[i * 32 + tid]; pr += partP[i * 32 + tid]; } tot[tid] = t; cnt[tid] = pr; }
    __syncthreads();
    if (tid < 32) { unsigned off = 0; for (int e = 0; e < tid; ++e) off += (tot[e] + 255u) & ~255u;
        const unsigned mine = (tot[tid] + 255u) & ~255u;
        if (C.bid == 0) { for (unsigned t = off >> 8; t < ((off + mine) >> 8); ++t) texp[t] = tid; if (tid == 31) texp[1023] = (int)((off + mine) >> 8);
            for (unsigned p = off + tot[tid]; p < off + mine; ++p) tokoff[p] = 0; }
        cnt[tid] += off; }
    __syncthreads();
    const int gw = C.bid * NWAVES + wave, NGW = C.G * NWAVES;
    for (int row = gw; row < nrows; row += NGW) {
        int pos = 0;
        if (lane < 4) { const int e = eid[(size_t)row * 4 + lane]; pos = (int)__hip_atomic_fetch_add(&cnt[e], 1u, __ATOMIC_RELAXED, __HIP_MEMORY_SCOPE_WORKGROUP); posv[(size_t)row * 4 + lane] = pos; }
        if (lane < 4) tokoff[pos] = row * 1024;
    }
}

__device__ __forceinline__ void phase_combine(const Ctx& C, int layer, int nrows, bool final_out) {
    PHASE_IDS
    bf16_t* HB = (bf16_t*)(wsl + WS_HB); unsigned char* HB8 = wsl + WS_HB8; const bf16_t* YS = (const bf16_t*)(wsl + WS_YS);
    const float* lg = C.in[I_LNFG] + layer * D; const float* lb = C.in[I_LNFB] + layer * D;
    const float* gatev = (const float*)(wsl + WS_CTL + CT_GATEV) + (size_t)layer * NTOK * 4; const int* posv = (const int*)(wsl + WS_CTL + CT_POS) + (size_t)layer * NTOK * 4;
    float gg[2][8], gb[2][8];
#pragma unroll
    for (int j = 0; j < 2; ++j) { const f32x4 a0 = *(const f32x4*)(lg + 8 * lane + 512 * j), a1 = *(const f32x4*)(lg + 8 * lane + 512 * j + 4), b0 = *(const f32x4*)(lb + 8 * lane + 512 * j), b1 = *(const f32x4*)(lb + 8 * lane + 512 * j + 4);
#pragma unroll
        for (int i = 0; i < 4; ++i) { gg[j][i] = a0[i]; gg[j][4 + i] = a1[i]; gb[j][i] = b0[i]; gb[j][4 + i] = b1[i]; } }
    const int gw = C.bid * NWAVES + wave, NGW = C.G * NWAVES;
    for (int row = gw; row < nrows; row += NGW) {
        const f32x4 gk4 = *(const f32x4*)(gatev + (size_t)row * 4); const int pk0 = posv[(size_t)row * 4], pk1 = posv[(size_t)row * 4 + 1], pk2_ = posv[(size_t)row * 4 + 2], pk3 = posv[(size_t)row * 4 + 3];
        u32x4 hw[2], yw[4][2];
#pragma unroll
        for (int j = 0; j < 2; ++j) { hw[j] = *(const u32x4*)(HB + (size_t)row * D + 8 * lane + 512 * j);
            yw[0][j] = *(const u32x4*)(YS + (size_t)pk0 * D + 8 * lane + 512 * j); yw[1][j] = *(const u32x4*)(YS + (size_t)pk1 * D + 8 * lane + 512 * j);
            yw[2][j] = *(const u32x4*)(YS + (size_t)pk2_ * D + 8 * lane + 512 * j); yw[3][j] = *(const u32x4*)(YS + (size_t)pk3 * D + 8 * lane + 512 * j); }
        float v[2][8]; float s = 0.f;
#pragma unroll
        for (int j = 0; j < 2; ++j) { float h[8]; unpack8(hw[j], h);
#pragma unroll
            for (int i = 0; i < 8; ++i) v[j][i] = h[i] * DN_ALPHA;
#pragma unroll
            for (int k = 0; k < 4; ++k) { float y[8]; unpack8(yw[k][j], y);
#pragma unroll
                for (int i = 0; i < 8; ++i) v[j][i] += gk4[k] * y[i]; }
#pragma unroll
            for (int i = 0; i < 8; ++i) s += v[j][i]; }
        const float mean = wave_sum_dpp(s) * (1.0f / D); float q = 0.f;
#pragma unroll
        for (int j = 0; j < 2; ++j)
#pragma unroll
            for (int i = 0; i < 8; ++i) { v[j][i] -= mean; q += v[j][i] * v[j][i]; }
        const float rstd = __builtin_amdgcn_rsqf(wave_sum_dpp(q) * (1.0f / D) + LN_EPS);
#pragma unroll
        for (int j = 0; j < 2; ++j) {
#pragma unroll
            for (int i = 0; i < 8; ++i) v[j][i] = v[j][i] * rstd * gg[j][i] + gb[j][i];
            if (final_out) { *(f32x4*)(C.out + (size_t)row * D + 8 * lane + 512 * j) = (f32x4){v[j][0], v[j][1], v[j][2], v[j][3]}; *(f32x4*)(C.out + (size_t)row * D + 8 * lane + 512 * j + 4) = (f32x4){v[j][4], v[j][5], v[j][6], v[j][7]}; }
            else { u32x4 w; w.x = pk2(v[j][0], v[j][1]); w.y = pk2(v[j][2], v[j][3]); w.z = pk2(v[j][4], v[j][5]); w.w = pk2(v[j][6], v[j][7]); *(u32x4*)(HB + (size_t)row * D + 8 * lane + 512 * j) = w;
                u32x2 w8; w8.x = pk4_fp8(v[j][0], v[j][1], v[j][2], v[j][3]); w8.y = pk4_fp8(v[j][4], v[j][5], v[j][6], v[j][7]); *(u32x2*)(HB8 + (size_t)row * D + 8 * lane + 512 * j) = w8; } }
    }
}

constexpr int AT_KS = 0, AT_VTS = 73728, AT_VPITCH = 1168, AT_KM = AT_VTS + 64 * AT_VPITCH, AT_VTM = AT_KM + 2048, AT_RPB = AT_VTM + 2048, AT_MB = AT_RPB + 1920, AT_END = AT_MB + 64;
static_assert(AT_END <= LDS_BYTES, "attention LDS map");
__device__ __forceinline__ void phase_attn(const Ctx& C) {
    PHASE_IDS
    bf16_t* O = (bf16_t*)(wsl + WS_O);
    const float* rpb = C.in[I_RPB]; const float* mbias = C.in[I_MBIAS];
    LAS unsigned char* lds = C.lds;
    const int w = wave, lq = lane & 15, g = lane >> 4;
    const int qr = w >> 2, qg = w & 3, c0 = 16 * qg, kcb = qg == 0 ? 0 : (qg == 1 ? 8 : (qg == 2 ? 24 : 32));
    int bidx[2][4];
    { const int c_ = c0 + lq, cs_ = min(max(c_ - 8, 0), 48);
#pragma unroll
      for (int blk = 0; blk < 2; ++blk)
#pragma unroll
          for (int e = 0; e < 4; ++e) { const int kc = kcb + 16 * blk + 4 * g + e; bidx[blk][e] = ((kc >= cs_ && kc < cs_ + 16) ? (kc - c_ + 15) : 31) * 4; } }
    const __amdgpu_buffer_rsrc_t rsrc = __builtin_amdgcn_make_buffer_rsrc((void*)wsl, 0, 0xFFFFFFFF, 0x00020000);
    const int kvoff = (((tid >> 3) & 63) * D + 8 * (tid & 7)) * 2, vvoff = ((tid >> 3) * MPAD + 8 * (tid & 7)) * 2;
    const int qvoff = (lq * D + 8 * g) * 2;
    const int mvoff = tid < 128 ? ((tid >> 3) * D + 8 * (tid & 7)) * 2 : (((tid - 128) >> 1) * MPAD + 8 * ((tid - 128) & 1)) * 2;
    const int klds = AT_KS + ((((tid >> 3) & 63)) * 8 + ((tid & 7) ^ ((tid >> 3) & 7))) * 16;
    const int vlds = AT_VTS + (tid >> 3) * AT_VPITCH + (tid & 7) * 16;
    for (int su = (C.G == 256 ? C.gc : C.bid); su < 256; su += C.G) {
        int bh, strip; if (C.G == 256) { bh = (su & 7) * 16 + (su >> 4); strip = (su >> 3) & 1; } else { bh = su >> 1; strip = su & 1; }
        const int b = bh >> 4, h = bh & 15, rp0 = strip * 16;
        const unsigned kbase = (unsigned)WS_K + (unsigned)((b * SEQ) * D + 64 * h) * 2u, vbase = (unsigned)WS_VT + (unsigned)((64 * h) * MPAD + b * SEQ) * 2u;
        const unsigned qbase = (unsigned)WS_Q + (unsigned)((b * SEQ + qr * 64 + c0) * D + 64 * h) * 2u;
        int R0 = min(max(2 * rp0 - 4, 0), 55);
        __syncthreads();
        {
            u32x4 kreg[9], vreg[9];
#pragma unroll
            for (int i = 0; i < 9; ++i) { kreg[i] = __builtin_amdgcn_raw_buffer_load_b128(rsrc, kvoff, (int)(kbase + (unsigned)(R0 + i) * 64u * D * 2u), 0);
                vreg[i] = __builtin_amdgcn_raw_buffer_load_b128(rsrc, vvoff, (int)(vbase + (unsigned)(R0 + i) * 128u), 0); }
            u32x4 mreg = {0u, 0u, 0u, 0u};
            if (tid < 256) mreg = __builtin_amdgcn_raw_buffer_load_b128(rsrc, mvoff, (int)(tid < 128 ? (unsigned)WS_K + (unsigned)((NGRID + 16 * b) * D + 64 * h) * 2u : (unsigned)WS_VT + (unsigned)((64 * h) * MPAD + NGRID + 16 * b) * 2u), 0);
            float rpreg = 0.f, mbreg = 0.f;
            if (tid < 480) rpreg = (tid & 31) < 31 ? rpb[h * 465 + (tid >> 5) * 31 + (tid & 31)] * 1.44269504089f : -1.0e30f;
            if (tid < 16) mbreg = mbias[h * 16 + tid] * 1.44269504089f;
#pragma unroll
            for (int i = 0; i < 9; ++i) { const int slot = (R0 + i) % 9; *(LAS u32x4*)(lds + klds + slot * 8192) = kreg[i]; *(LAS u32x4*)(lds + vlds + slot * 128) = vreg[i]; }
            if (tid < 128) { const int m = tid >> 3, ch = tid & 7; *(LAS u32x4*)(lds + AT_KM + (m * 8 + (ch ^ (m & 7))) * 16) = mreg; }
            else if (tid < 256) { const int i = tid - 128, d = i >> 1, hf = i & 1; *(LAS u32x4*)(lds + AT_VTM + d * 32 + hf * 16) = mreg; }
            if (tid < 480) ((LAS float*)(lds + AT_RPB))[tid] = rpreg;
            if (tid < 16) ((LAS float*)(lds + AT_MB))[tid] = mbreg;
        }
        u32x4 qreg[2];
        qreg[0] = __builtin_amdgcn_raw_buffer_load_b128(rsrc, qvoff, (int)(qbase + (unsigned)(2 * rp0) * 64u * D * 2u), 0);
        qreg[1] = __builtin_amdgcn_raw_buffer_load_b128(rsrc, qvoff, (int)(qbase + (unsigned)(2 * rp0) * 64u * D * 2u + 64u), 0);
        __syncthreads();
        for (int rp = rp0; rp < rp0 + 16; ++rp) {
            const int R0n = rp + 1 < rp0 + 16 ? min(max(2 * (rp + 1) - 4, 0), 55) : R0, nnew = R0n - R0;
            const u32x4 qcur[2] = {qreg[0], qreg[1]};
            u32x4 nk[2], nv[2];
#pragma unroll
            for (int i = 0; i < 2; ++i) if (i < nnew) { nk[i] = __builtin_amdgcn_raw_buffer_load_b128(rsrc, kvoff, (int)(kbase + (unsigned)(R0 + 9 + i) * 64u * D * 2u), 0);
                nv[i] = __builtin_amdgcn_raw_buffer_load_b128(rsrc, vvoff, (int)(vbase + (unsigned)(R0 + 9 + i) * 128u), 0); }
            if (rp + 1 < rp0 + 16) { qreg[0] = __builtin_amdgcn_raw_buffer_load_b128(rsrc, qvoff, (int)(qbase + (unsigned)(2 * rp + 2) * 64u * D * 2u), 0);
                qreg[1] = __builtin_amdgcn_raw_buffer_load_b128(rsrc, qvoff, (int)(qbase + (unsigned)(2 * rp + 2) * 64u * D * 2u + 64u), 0); }
            const int r = 2 * rp + qr;
            const int rs = min(max(r - 4, 0), 56), s0 = rs % 9;
            const size_t qrow = (size_t)(b * SEQ + r * 64 + c0 + lq);
            bf16x8 qf[2]; qf[0] = __builtin_bit_cast(bf16x8, qcur[0]); qf[1] = __builtin_bit_cast(bf16x8, qcur[1]);
            f32x4 sc[8][2], sm;
#pragma unroll
            for (int j = 0; j < 8; ++j) { const int slot = s0 + j - (s0 + j >= 9 ? 9 : 0);
#pragma unroll
                for (int blk = 0; blk < 2; ++blk) { f32x4 a = {0.f, 0.f, 0.f, 0.f}; const int kc = kcb + 16 * blk + lq;
#pragma unroll
                    for (int ks = 0; ks < 2; ++ks) { const bf16x8 kf = *(const LAS bf16x8*)(lds + AT_KS + slot * 8192 + (kc * 8 + ((4 * ks + g) ^ (kc & 7))) * 16);
                        a = __builtin_amdgcn_mfma_f32_16x16x32_bf16(kf, qf[ks], a, 0, 0, 0); }
                    sc[j][blk] = a; } }
            { f32x4 a = {0.f, 0.f, 0.f, 0.f};
#pragma unroll
              for (int ks = 0; ks < 2; ++ks) { const bf16x8 kf = *(const LAS bf16x8*)(lds + AT_KM + (lq * 8 + ((4 * ks + g) ^ (lq & 7))) * 16);
                  a = __builtin_amdgcn_mfma_f32_16x16x32_bf16(kf, qf[ks], a, 0, 0, 0); }
              sm = a; }
            const LAS unsigned char* RProw = lds + AT_RPB + (rs - r + 7) * 128; const LAS float* MB = (const LAS float*)(lds + AT_MB);
            float mx = -3.0e38f;
#pragma unroll
            for (int j = 0; j < 8; ++j)
#pragma unroll
                for (int blk = 0; blk < 2; ++blk)
#pragma unroll
                    for (int e = 0; e < 4; ++e) { const float sv = sc[j][blk][e] + *(const LAS float*)(RProw + j * 128 + bidx[blk][e]); sc[j][blk][e] = sv; mx = fmaxf(mx, sv); }
#pragma unroll
            for (int e = 0; e < 4; ++e) { sm[e] += MB[4 * g + e]; mx = fmaxf(mx, sm[e]); }
            mx = fmaxf(mx, __shfl_xor(mx, 16)); mx = fmaxf(mx, __shfl_xor(mx, 32));
            float sum = 0.f;
#pragma unroll
            for (int j = 0; j < 8; ++j)
#pragma unroll
                for (int blk = 0; blk < 2; ++blk)
#pragma unroll
                    for (int e = 0; e < 4; ++e) { const float pv = fast_exp2(sc[j][blk][e] - mx); sc[j][blk][e] = pv; sum += pv; }
#pragma unroll
            for (int e = 0; e < 4; ++e) { const float pv = fast_exp2(sm[e] - mx); sm[e] = pv; sum += pv; }
            sum += __shfl_xor(sum, 16); sum += __shfl_xor(sum, 32);
            f32x4 o[4];
#pragma unroll
            for (int db = 0; db < 4; ++db) o[db] = (f32x4){0.f, 0.f, 0.f, 0.f};
#pragma unroll
            for (int j = 0; j < 8; ++j) { const int slot = s0 + j - (s0 + j >= 9 ? 9 : 0);
                u32x4 pw; pw.x = cvt_pk_bf16(sc[j][0][0], sc[j][0][1]); pw.y = cvt_pk_bf16(sc[j][0][2], sc[j][0][3]); pw.z = cvt_pk_bf16(sc[j][1][0], sc[j][1][1]); pw.w = cvt_pk_bf16(sc[j][1][2], sc[j][1][3]);
                const bf16x8 pb = __builtin_bit_cast(bf16x8, pw);
#pragma unroll
                for (int db = 0; db < 4; ++db) { const int d = 16 * db + lq; const LAS unsigned char* vp = lds + AT_VTS + d * AT_VPITCH + (slot * 64 + kcb + 4 * g) * 2;
                    const u32x2 lo = *(const LAS u32x2*)vp, hi = *(const LAS u32x2*)(vp + 32);
                    u32x4 aw; aw.x = lo.x; aw.y = lo.y; aw.z = hi.x; aw.w = hi.y;
                    o[db] = __builtin_amdgcn_mfma_f32_16x16x32_bf16(__builtin_bit_cast(bf16x8, aw), pb, o[db], 0, 0, 0); }
            }
            { u32x4 pw; pw.x = cvt_pk_bf16(sm[0], sm[1]); pw.y = cvt_pk_bf16(sm[2], sm[3]); pw.z = 0u; pw.w = 0u; const bf16x8 pb = __builtin_bit_cast(bf16x8, pw);
#pragma unroll
              for (int db = 0; db < 4; ++db) { const int d = 16 * db + lq; const u32x2 lo = *(const LAS u32x2*)(lds + AT_VTM + d * 32 + 8 * g);
                  u32x4 aw; aw.x = lo.x; aw.y = lo.y; aw.z = 0u; aw.w = 0u;
                  o[db] = __builtin_amdgcn_mfma_f32_16x16x32_bf16(__builtin_bit_cast(bf16x8, aw), pb, o[db], 0, 0, 0); } }
            const float inv = 1.0f / sum;
#pragma unroll
            for (int db = 0; db < 4; ++db) { u32x2 ow; ow.x = cvt_pk_bf16(o[db][0] * inv, o[db][1] * inv); ow.y = cvt_pk_bf16(o[db][2] * inv, o[db][3] * inv);
                *(u32x2*)(O + qrow * D + 64 * h + 16 * db + 4 * g) = ow; }
            __syncthreads();
#pragma unroll
            for (int i = 0; i < 2; ++i) if (i < nnew) { const int slot = (R0 + 9 + i) % 9; *(LAS u32x4*)(lds + klds + slot * 8192) = nk[i]; *(LAS u32x4*)(lds + vlds + slot * 128) = nv[i]; }
            R0 = R0n;
            __syncthreads();
        }
    }
}
#define XB_TMO      128
#define XB_XCNT(j)  (256  + 64 * (j))
#define XB_XSUB(j)  (1280 + 64 * (j))
#define XB_XGEN(j)  (2304 + 64 * (j))
#define XB_TOP      3328
#define XB_TOPGEN   3392
#define XCD_BAR_WORDS 3456
#define XB_SPIN_CAP (1u << 22)
__device__ __forceinline__ unsigned xb_ld(unsigned* p)              { return __hip_atomic_load(p, __ATOMIC_RELAXED, __HIP_MEMORY_SCOPE_AGENT); }
__device__ __forceinline__ unsigned xb_add(unsigned* p, unsigned v) { return __hip_atomic_fetch_add(p, v, __ATOMIC_RELAXED, __HIP_MEMORY_SCOPE_AGENT); }
__device__ __forceinline__ unsigned xb_xcc_id() { return (unsigned)__builtin_amdgcn_s_getreg((3 << 11) | 20) & 0xFu; }
#define XB_SPIN(cond, bar) do { unsigned _sp = 0; while (cond) { __builtin_amdgcn_s_sleep(1); \
    if ((++_sp & 255u) == 0u) { if (xb_ld(&(bar)[XB_TMO])) break; if (_sp > XB_SPIN_CAP) { atomicAdd(&(bar)[XB_TMO], 1u); break; } } } } while (0)
struct XcdBarrier { unsigned* bar; unsigned x; volatile LAS unsigned* st; };
__device__ __forceinline__ XcdBarrier xcd_barrier_post(unsigned* bar, volatile LAS unsigned* st) {
    XcdBarrier b; b.bar = bar; b.x = xb_xcc_id(); b.st = st;
    if (threadIdx.x == 0) st[2] = xb_add(&bar[XB_XCNT(b.x)], 1u);
    return b;
}
__device__ __forceinline__ void xcd_barrier_complete(unsigned* bar, unsigned x, unsigned& nloc, unsigned& nx) {
    const unsigned G = gridDim.x * gridDim.y * gridDim.z;
    unsigned sum, cnt, mine, sp = 0u;
    for (;;) {
        sum = 0u; cnt = 0u; mine = 0u;
#pragma unroll
        for (unsigned j = 0; j < 16; ++j) { const unsigned c = xb_ld(&bar[XB_XCNT(j)]); sum += c; cnt += (c > 0u) ? 1u : 0u; mine = (j == x) ? c : mine; }
        if (sum == G) break;
        __builtin_amdgcn_s_sleep(1);
        if ((++sp & 255u) == 0u) { if (xb_ld(&bar[XB_TMO])) break; if (sp > XB_SPIN_CAP) { atomicAdd(&bar[XB_TMO], 1u); break; } }
    }
    nloc = mine > 0u ? mine : 1u; nx = cnt > 0u ? cnt : 1u;
}
__device__ __forceinline__ void xcd_barrier(const XcdBarrier& b) {
    asm volatile("s_waitcnt vmcnt(0)" ::: "memory");
    __syncthreads();
    if (threadIdx.x == 0) {
        unsigned* bar = b.bar;
        __builtin_amdgcn_s_waitcnt(0);
        unsigned nloc = b.st[0], nx = b.st[1];
        if (nloc == 0u) { xcd_barrier_complete(bar, b.x, nloc, nx); b.st[0] = nloc; b.st[1] = nx; }
        const unsigned old = xb_add(&bar[XB_XSUB(b.x)], 1u);
        const unsigned gen = old / nloc;
        if (old + 1u == (gen + 1u) * nloc) {
            __builtin_amdgcn_fence(__ATOMIC_RELEASE, "agent");
            asm volatile("s_waitcnt vmcnt(0)" ::: "memory");
            const unsigned og = xb_add(&bar[XB_TOP], 1u);
            const unsigned tg = og / nx;
            if (og + 1u == (tg + 1u) * nx) xb_add(&bar[XB_TOPGEN], 1u);
            else XB_SPIN(xb_ld(&bar[XB_TOPGEN]) == tg, bar);
            __builtin_amdgcn_fence(__ATOMIC_ACQUIRE, "agent");
            xb_add(&bar[XB_XGEN(b.x)], 1u);
            asm volatile("s_waitcnt vmcnt(0)" ::: "memory");
        } else {
            XB_SPIN(xb_ld(&bar[XB_XGEN(b.x)]) == gen, bar);
            __builtin_amdgcn_fence(__ATOMIC_ACQUIRE, "agent");
            asm volatile("s_waitcnt vmcnt(0)" ::: "memory");
        }
    }
    __syncthreads();
}
__device__ __forceinline__ int moe_prep(const Ctx& C, const int* texp) {
    LAS int* t = (LAS int*)(C.lds + pg8::TEXP_OFF); const int tid = fresh_tid();
    const int a = texp[tid], b = texp[tid + 512];
    t[tid] = a; t[tid + 512] = b;
    __syncthreads();
    return __builtin_amdgcn_readfirstlane(t[1023]);
}
constexpr size_t CT_BAR = 131072;
constexpr int LDS_BARST = LDS_BYTES - 64;

constexpr int N_PHASES = 20;
__global__ void __launch_bounds__(NTHREADS, 2) hybrid_fwd(Params P) {
    extern __shared__ __attribute__((aligned(16))) unsigned char smem[];
    cg::grid_group grid = cg::this_grid();
    Ctx C; C.lds = (LAS unsigned char*)smem; C.G = gridDim.x; C.bid = blockIdx.x;
    C.ws = P.ws; C.in = P.in; C.out = P.out;
    unsigned char* const ws0 = P.ws;
#define ws fresh_ws(ws0)
    const int lo = P.ph_lo, hi = P.ph_hi;
#ifndef PH_MASK
#define PH_MASK 0xFFFFFFFFu
#endif
#define IN(k) (((PH_MASK >> (k)) & 1u) && lo <= (k) && (k) < hi)
#ifndef REPEAT_MASK
#define REPEAT_MASK 0u
#endif
#define REPS(k) ((((unsigned)REPEAT_MASK >> (k)) & 1u) ? 2 : 1)
#ifndef N_CG_SYNCS
#define N_CG_SYNCS 0
#endif
#define SEAM(k) do { if (IN(k) && IN((k) + 1)) { if ((k) < N_CG_SYNCS) grid.sync(); else xcd_barrier(bar); } } while (0)
    if (threadIdx.x < 16) ((LAS unsigned*)(smem + LDS_BARST))[threadIdx.x] = 0u;
    __syncthreads();
    const XcdBarrier bar = xcd_barrier_post((unsigned*)(ws + WS_CTL + CT_BAR), (volatile LAS unsigned*)(smem + LDS_BARST));
    C.gc = C.bid;
    #define PH_BODY_0 phase_convert(C);
    if (IN(0)) { PH_BODY_0 } if (REPS(0) > 1 && IN(0)) { xcd_barrier(bar); PH_BODY_0 }
    SEAM(0);
    if (IN(0) && IN(1)) {
        unsigned* barw = (unsigned*)(ws + WS_CTL + CT_BAR); bool eq = (C.G % 8) == 0;
#pragma unroll
        for (int j = 0; j < 16; ++j) { const unsigned cj = xb_ld(&barw[XB_XCNT(j)]); eq = eq && (cj == (j < 8 ? (unsigned)(C.G / 8) : 0u)); }
        const unsigned rank = ((volatile LAS unsigned*)(smem + LDS_BARST))[2];
        C.gc = __builtin_amdgcn_readfirstlane(eq ? (int)(rank * 8u + bar.x) : C.bid);
    }
    #define PH_BODY_1 { DenseSched S{(unsigned)WS_HB, (unsigned)WS_WIN, 1024, 1024, 128, 8, C.G, C.gc}; EpiWin E{(bf16_t*)(ws + WS_XR), (bf16_t*)(ws + WS_GY)}; \
        pg8::gemm_phase<false, false>(C.lds, ws, 1024, 1024, 1024, S, E); mini_win(C); }
    if (IN(1)) { PH_BODY_1 } if (REPS(1) > 1 && IN(1)) { xcd_barrier(bar); PH_BODY_1 }
    SEAM(1);
    #define PH_BODY_2 phase_conv(C);
    if (IN(2)) { PH_BODY_2 } if (REPS(2) > 1 && IN(2)) { xcd_barrier(bar); PH_BODY_2 }
    SEAM(2);
    #define PH_BODY_3 { GateSched S{(unsigned)WS_XC, (unsigned)WS_GATE, 128, C.G, C.gc}; \
        EpiGate E{(const bf16_t*)(ws + WS_XC), (bf16_t*)(ws + WS_LA), (bf16_t*)(ws + WS_BB), (const float*)(ws + WS_CTL + CT_SPL), (unsigned)WS_GBIAS}; \
        pg8::gemm_phase<false, false>(C.lds, ws, 256, 1024, 256, S, E); mini_gate(C); }
    if (IN(3)) { PH_BODY_3 } if (REPS(3) > 1 && IN(3)) { xcd_barrier(bar); PH_BODY_3 }
    SEAM(3);
    #define PH_BODY_4 phase_scan(C);
    if (IN(4)) { PH_BODY_4 } if (REPS(4) > 1 && IN(4)) { xcd_barrier(bar); PH_BODY_4 }
    SEAM(4);
    #define PH_BODY_5 { DenseSched S{(unsigned)WS_G, (unsigned)WS_LOUT, 1024, 1024, 128, 4, C.G, C.gc}; EpiRes<true> E{(bf16_t*)(ws + WS_PRE), P.in[I_X], P.in[I_META], nullptr, NTOK}; \
        pg8::gemm_phase<false, false>(C.lds, ws, 1024, 1024, 1024, S, E); mini_lout(C); }
    if (IN(5)) { PH_BODY_5 } if (REPS(5) > 1 && IN(5)) { xcd_barrier(bar); PH_BODY_5 }
    SEAM(5);
    #define PH_BODY_6 phase_lnr(C, 0, NTOK);
    if (IN(6)) { PH_BODY_6 } if (REPS(6) > 1 && IN(6)) { xcd_barrier(bar); PH_BODY_6 }
    SEAM(6);
    #define PH_BODY_7 phase_pos(C, 0, NTOK);
    if (IN(7)) { PH_BODY_7 } if (REPS(7) > 1 && IN(7)) { xcd_barrier(bar); PH_BODY_7 }
    SEAM(7);
    #define PH_BODY_8 { const int nM = moe_prep(C, (const int*)(ws + WS_CTL + CT_TEXP)); \
        MoeSched S{(unsigned)WS_HB8, (unsigned)WS_WGU, (unsigned)WS_TOK, (const LAS int*)(C.lds + pg8::TEXP_OFF), 2048u * 1024u, nM, 8, C.G, C.gc}; EpiGlu E{(unsigned char*)(ws + WS_ACT), (unsigned)WS_BIAS}; \
        pg8::gemm_phase<true, true>(C.lds, ws, 512, 512, 512, S, E); }
    if (IN(8)) { PH_BODY_8 } if (REPS(8) > 1 && IN(8)) { xcd_barrier(bar); PH_BODY_8 }
#ifdef PROBE_NULL8
    if (IN(8)) { xcd_barrier(bar); { const int nM = moe_prep(C, (const int*)(ws + WS_CTL + CT_TEXP));
        MoeSched S{(unsigned)WS_HB8, (unsigned)WS_WGU, (unsigned)WS_TOK, (const LAS int*)(C.lds + pg8::TEXP_OFF), 2048u * 1024u, nM, 8, C.G, C.gc}; EpiNull E{};
        pg8::gemm_phase<true, true>(C.lds, ws, 512, 512, 512, S, E); } }
#endif
    SEAM(8);
    #define PH_BODY_9 { const int nM = moe_prep(C, (const int*)(ws + WS_CTL + CT_TEXP)); \
        MoeSched S{(unsigned)WS_ACT, (unsigned)WS_WD, 0u, (const LAS int*)(C.lds + pg8::TEXP_OFF), 1024u * 1024u, nM, 4, C.G, C.gc}; EpiDown E{(bf16_t*)(ws + WS_YS), (unsigned)WS_BD}; \
        pg8::gemm_phase<true, false>(C.lds, ws, 512, 512, 512, S, E); }
    if (IN(9)) { PH_BODY_9 } if (REPS(9) > 1 && IN(9)) { xcd_barrier(bar); PH_BODY_9 }
    SEAM(9);
    #define PH_BODY_10 phase_combine(C, 0, NTOK, false);
    if (IN(10)) { PH_BODY_10 } if (REPS(10) > 1 && IN(10)) { xcd_barrier(bar); PH_BODY_10 }
    SEAM(10);
    #define PH_BODY_11 { QkvSched S{(unsigned)WS_HB8, (unsigned)WS_QKV8, 128, C.G, C.gc}; EpiQkv E{(bf16_t*)(ws + WS_Q), (bf16_t*)(ws + WS_K), (bf16_t*)(ws + WS_VT)}; \
        pg8::gemm_phase<true, false>(C.lds, ws, 512, 512, 512, S, E); mini_kv(C); }
    if (IN(11)) { PH_BODY_11 } if (REPS(11) > 1 && IN(11)) { xcd_barrier(bar); PH_BODY_11 }
    SEAM(11);
    #define PH_BODY_12 phase_attn(C);
    if (IN(12)) { PH_BODY_12 } if (REPS(12) > 1 && IN(12)) { xcd_barrier(bar); PH_BODY_12 }
    SEAM(12);
    #define PH_BODY_13 { DenseSched S{(unsigned)WS_O, (unsigned)WS_NOUT, 1024, 1024, 128, 4, C.G, C.gc}; EpiRes<false> E{(bf16_t*)(ws + WS_PRE), nullptr, nullptr, (const bf16_t*)(ws + WS_HB), NGRID}; \
        pg8::gemm_phase<false, false>(C.lds, ws, 1024, 1024, 1024, S, E); }
    if (IN(13)) { PH_BODY_13 } if (REPS(13) > 1 && IN(13)) { xcd_barrier(bar); PH_BODY_13 }
    SEAM(13);
    #define PH_BODY_14 phase_lnr(C, 1, NGRID);
    if (IN(14)) { PH_BODY_14 } if (REPS(14) > 1 && IN(14)) { xcd_barrier(bar); PH_BODY_14 }
    SEAM(14);
    #define PH_BODY_15 phase_pos(C, 1, NGRID);
    if (IN(15)) { PH_BODY_15 } if (REPS(15) > 1 && IN(15)) { xcd_barrier(bar); PH_BODY_15 }
    SEAM(15);
    #define PH_BODY_16 { const int nM = moe_prep(C, (const int*)(ws + WS_CTL + CT_TEXP) + 1024); \
        MoeSched S{(unsigned)WS_HB8, (unsigned)(WS_WGU + (size_t)32 * 2048 * 1024), (unsigned)(WS_TOK + 1 * MiB), (const LAS int*)(C.lds + pg8::TEXP_OFF), 2048u * 1024u, nM, 8, C.G, C.gc}; EpiGlu E{(unsigned char*)(ws + WS_ACT), (unsigned)(WS_BIAS + 32 * 2048 * 4)}; \
        pg8::gemm_phase<true, true>(C.lds, ws, 512, 512, 512, S, E); }
    if (IN(16)) { PH_BODY_16 } if (REPS(16) > 1 && IN(16)) { xcd_barrier(bar); PH_BODY_16 }
    SEAM(16);
    #define PH_BODY_17 { const int nM = moe_prep(C, (const int*)(ws + WS_CTL + CT_TEXP) + 1024); \
        MoeSched S{(unsigned)WS_ACT, (unsigned)(WS_WD + (size_t)32 * 1024 * 1024), 0u, (const LAS int*)(C.lds + pg8::TEXP_OFF), 1024u * 1024u, nM, 4, C.G, C.gc}; EpiDown E{(bf16_t*)(ws + WS_YS), (unsigned)(WS_BD + 32 * 1024 * 4)}; \
        pg8::gemm_phase<true, false>(C.lds, ws, 512, 512, 512, S, E); }
    if (IN(17)) { PH_BODY_17 } if (REPS(17) > 1 && IN(17)) { xcd_barrier(bar); PH_BODY_17 }
    SEAM(17);
    #define PH_BODY_18 phase_combine(C, 1, NGRID, true);
    if (IN(18)) { PH_BODY_18 } if (REPS(18) > 1 && IN(18)) { xcd_barrier(bar); PH_BODY_18 }
#undef ws
#undef IN
#undef SEAM
}

#ifndef MK_PER_PHASE
#define MK_PER_PHASE 0
#endif
extern "C" void kernel_launch(void* const* d_in, const int* in_sizes, int n_in, void* d_out, int out_size, void* d_ws, size_t ws_size, hipStream_t stream) {
    static int grid = 0;
    if (grid == 0) {
        if (n_in != 25 || ws_size < WS_END || out_size != NGRID * D) { fprintf(stderr, "kernel_launch: unexpected problem (n_in %d, ws %zu, out %d)\n", n_in, ws_size, out_size); grid = -1; return; }
        int dev = 0, cus = 0, per_cu = 0;
        if (hipGetDevice(&dev) != hipSuccess || hipDeviceGetAttribute(&cus, hipDeviceAttributeMultiprocessorCount, dev) != hipSuccess) { grid = -1; return; }
        if (hipFuncSetAttribute((const void*)hybrid_fwd, hipFuncAttributeMaxDynamicSharedMemorySize, LDS_BYTES) != hipSuccess) { fprintf(stderr, "kernel_launch: hipFuncSetAttribute failed\n"); grid = -1; return; }
        if (hipOccupancyMaxActiveBlocksPerMultiprocessor(&per_cu, (const void*)hybrid_fwd, NTHREADS, LDS_BYTES) != hipSuccess || per_cu < 1) { fprintf(stderr, "kernel_launch: occupancy query failed (%d)\n", per_cu); grid = -1; return; }
        grid = cus * 1;
        if (grid > 256) grid = 256;
    }
    if (grid < 0) return;
    if (hipMemsetAsync((char*)d_ws + WS_CTL + CT_BAR, 0, 16384, stream) != hipSuccess) { fprintf(stderr, "kernel_launch: memset failed\n"); return; }
    Params p{};
    for (int i = 0; i < 25; ++i) p.in[i] = (const float*)d_in[i];
    p.out = (float*)d_out; p.ws = (unsigned char*)d_ws;
#if MK_PER_PHASE
    for (int ph = 0; ph < 19; ++ph) { p.ph_lo = ph; p.ph_hi = ph + 1; void* args[] = {&p};
        hipError_t e = hipLaunchCooperativeKernel((void*)hybrid_fwd, dim3(grid), dim3(NTHREADS), args, LDS_BYTES, stream);
        if (e != hipSuccess) { fprintf(stderr, "launch phase %d failed: %s\n", ph, hipGetErrorString(e)); break; } }
#else
    p.ph_lo = 0; p.ph_hi = 19; void* args[] = {&p};
    hipError_t e = hipLaunchCooperativeKernel((void*)hybrid_fwd, dim3(grid), dim3(NTHREADS), args, LDS_BYTES, stream);
    if (e != hipSuccess) fprintf(stderr, "cooperative launch failed: %s (grid %d)\n", hipGetErrorString(e), grid);
#endif
}
```

```cpp
#include <hip/hip_runtime.h>
#include <hip/hip_cooperative_groups.h>
#include <cstdio>
#include <cstdint>
namespace cg = cooperative_groups;

#define LAS __attribute__((address_space(3)))
typedef unsigned short bf16_t;
typedef short bf16x8 __attribute__((ext_vector_type(8)));
typedef float f32x4 __attribute__((ext_vector_type(4)));
typedef float f32x2 __attribute__((ext_vector_type(2)));
typedef unsigned u32x4 __attribute__((ext_vector_type(4)));
typedef unsigned u32x2 __attribute__((ext_vector_type(2)));

constexpr int NB = 8, SEQ = 4096, D = 1024, NMETA = 16, LSEQ = SEQ + NMETA;
constexpr int NGRID = NB * SEQ;
constexpr int NTOK = NGRID + NB * NMETA;
constexpr int MPAD = 33024;
constexpr int NEXP = 32, TOPK = 4;
constexpr int PMAX = 139776;
constexpr int MTMAX = PMAX / 256;
constexpr float DN_ALPHA = 1.41421356237f;
constexpr float LN_EPS = 1e-5f;
constexpr int NTHREADS = 512, NWAVES = 8;

constexpr size_t MiB = 1u << 20;
constexpr size_t ACT_BYTES = (size_t)MPAD * D * 2;
constexpr size_t WS_CTL   = 0;
constexpr size_t WS_WIN   = 4 * MiB;
constexpr size_t WS_GATE  = WS_WIN + 4 * MiB;
constexpr size_t WS_LOUT  = WS_GATE + 2 * MiB;
constexpr size_t WS_QKV   = WS_LOUT + 2 * MiB;
constexpr size_t WS_NOUT  = WS_QKV + 6 * MiB;
constexpr size_t WS_WGU   = WS_NOUT + 2 * MiB;
constexpr size_t WS_WD    = WS_WGU + 128 * MiB;
constexpr size_t WS_HB    = WS_WD + 64 * MiB;
constexpr size_t WS_HB8   = WS_HB + 65 * MiB;
constexpr size_t WS_PRE   = WS_HB8 + 33 * MiB;
constexpr size_t WS_H     = WS_PRE + 129 * MiB;
constexpr size_t WS_SCR   = WS_H + 129 * MiB;
constexpr size_t WS_XR = WS_SCR, WS_XC = WS_XR + 65 * MiB, WS_GY = WS_XC + 65 * MiB, WS_LA = WS_GY + 65 * MiB, WS_BB = WS_LA + 130 * MiB, WS_HF = WS_BB + 130 * MiB, WS_G = WS_HF + 65 * MiB;
constexpr size_t WS_SCR_END0 = WS_G + 65 * MiB;
constexpr size_t WS_XS = WS_SCR, WS_ACT = WS_XS + 137 * MiB, WS_YS = WS_ACT + 137 * MiB;
constexpr size_t WS_SCR_END1 = WS_YS + 274 * MiB;
constexpr size_t WS_Q = WS_SCR, WS_K = WS_Q + 65 * MiB, WS_VT = WS_K + 65 * MiB, WS_O = WS_VT + 65 * MiB;
constexpr size_t WS_BIAS = (WS_SCR_END0 > WS_SCR_END1 ? WS_SCR_END0 : WS_SCR_END1);
constexpr size_t WS_BD = WS_BIAS + 2 * 32 * 2048 * 4;
constexpr size_t WS_GBIAS = WS_BD + 2 * 32 * 1024 * 4;
constexpr size_t WS_TOK = WS_BIAS + 1 * MiB;
constexpr size_t WS_QKV8 = WS_TOK + 2 * MiB;
constexpr size_t WS_END = WS_QKV8 + 3 * MiB;
static_assert((size_t)PMAX * 4 <= 1 * MiB, "token offset table");
static_assert(ACT_BYTES <= 65 * MiB && (size_t)PMAX * D * 2 <= 274 * MiB && (size_t)PMAX * D <= 137 * MiB && (size_t)MPAD * D <= 33 * MiB && (size_t)MPAD * D * 4 <= 129 * MiB, "ws map");
static_assert(WS_END <= (size_t)2040 * MiB, "ws map must fit 4x the largest input tensor");
constexpr size_t CT_BC      = 4096;
constexpr size_t CT_TEXP    = CT_BC + 2 * 256 * 32 * 4;
constexpr size_t CT_SPL     = CT_TEXP + 2 * 1024 * 4;
constexpr size_t CT_EID     = 256 * 1024;
constexpr size_t CT_GATEV   = CT_EID + 2 * (size_t)NTOK * 4 * 4;
constexpr size_t CT_POS     = CT_GATEV + 2 * (size_t)NTOK * 4 * 4;
static_assert(CT_POS + 2 * (size_t)NTOK * 4 * 4 <= 4 * MiB, "ctl map");

constexpr int LDS_BYTES = 155648;

__device__ __forceinline__ unsigned f2bf(float f) { unsigned u = __builtin_bit_cast(unsigned, f); return (u + 0x7fffu + ((u >> 16) & 1u)) >> 16; }
__device__ __forceinline__ unsigned cvt_pk_bf16(float lo, float hi);
__device__ __forceinline__ unsigned pk2(float lo, float hi) { return cvt_pk_bf16(lo, hi); }
typedef __bf16 bf16x2_t __attribute__((ext_vector_type(2)));
__device__ __forceinline__ unsigned cvt_pk_bf16(float lo, float hi) { const f32x2 v = {lo, hi}; return __builtin_bit_cast(unsigned, __builtin_convertvector(v, bf16x2_t)); }
__device__ __forceinline__ unsigned pk4_fp8(float a, float b, float c, float d) { int w = __builtin_amdgcn_cvt_pk_fp8_f32(a, b, 0, false); w = __builtin_amdgcn_cvt_pk_fp8_f32(c, d, w, true); return (unsigned)w; }
__device__ __forceinline__ float dot2_bf16(unsigned a, unsigned b, float c) { return __builtin_amdgcn_fdot2_f32_bf16(__builtin_bit_cast(bf16x2_t, a), __builtin_bit_cast(bf16x2_t, b), c, false); }
__device__ __forceinline__ float bflo(unsigned w) { return __builtin_bit_cast(float, w << 16); }
__device__ __forceinline__ float bfhi(unsigned w) { return __builtin_bit_cast(float, w & 0xffff0000u); }
__device__ __forceinline__ void unpack8(const u32x4 w, float (&o)[8]);
__device__ __forceinline__ float fast_exp2(float x) { return __builtin_amdgcn_exp2f(x); }
__device__ __forceinline__ float fast_rcp(float x) { return __builtin_amdgcn_rcpf(x); }
__device__ __forceinline__ float sigmoidf_(float x) { return fast_rcp(1.0f + fast_exp2(-1.44269504089f * x)); }
__device__ __forceinline__ float wave_sum(float v) {
#pragma unroll
    for (int o = 1; o < 64; o <<= 1) v += __shfl_xor(v, o);
    return v;
}
template <int CTRL> __device__ __forceinline__ float dpp_movf(float v) { return __builtin_bit_cast(float, __builtin_amdgcn_update_dpp(0, __builtin_bit_cast(int, v), CTRL, 0xf, 0xf, true)); }
__device__ __forceinline__ float readlane_f(float v, int l) { return __builtin_bit_cast(float, __builtin_amdgcn_readlane(__builtin_bit_cast(int, v), l)); }
__device__ __forceinline__ float wave_sum_dpp(float v) {
    v += dpp_movf<0xB1>(v);
    v += dpp_movf<0x4E>(v);
    v += dpp_movf<0x141>(v);
    v += dpp_movf<0x140>(v);
    return (readlane_f(v, 0) + readlane_f(v, 16)) + (readlane_f(v, 32) + readlane_f(v, 48));
}
__device__ __forceinline__ int seqrow(int b, int s) { return s < NMETA ? NGRID + NMETA * b + s : SEQ * b + (s - NMETA); }

struct Params {
    const float* in[25];
    float* out;
    unsigned char* ws;
    int ph_lo, ph_hi;
};
struct Ctx {
    LAS unsigned char* lds;
    int G, bid, gc;
    unsigned char* ws;
    const float* const* in;
    float* out;
};
__device__ __forceinline__ int fresh_tid() { int t = threadIdx.x; asm volatile("" : "+v"(t)); return t; }
__device__ __forceinline__ unsigned char* fresh_ws(unsigned char* p) { asm volatile("" : "+s"(p)); return p; }
#define PHASE_IDS unsigned char* const wsl = fresh_ws(C.ws); (void)wsl; const int tid = fresh_tid(); const int lane = tid & 63; const int wave = __builtin_amdgcn_readfirstlane(tid >> 6); (void)lane; (void)wave;
enum { I_X = 0, I_META, I_WIN, I_CONVW, I_CONVB, I_WA, I_BA, I_WX, I_BX, I_LAM, I_LOUT, I_WQKV, I_RPB, I_MBIAS, I_NOUT, I_LNMG, I_LNMB, I_RW, I_RB, I_WGU, I_BGU, I_WD, I_BD, I_LNFG, I_LNFB };

namespace pg8 {
constexpr int BM = 256, BK = 64, HALF = 128, HTB = HALF * BK * 2, STAGE_BYTES = 8 * HTB, NXCD = 8, WGM = 8;
constexpr int SIDE_OFF = STAGE_BYTES, TEXP_OFF = STAGE_BYTES + 2048, TOK_OFF = STAGE_BYTES + 2048 + 4096;
__device__ __forceinline__ int lds_byte(int r, int c) { const int st = (r >> 4) * 2 + (c >> 5), rr = r & 15, cc = c & 31, ob = rr * 64 + cc * 2; return st * 1024 + (ob ^ (((ob >> 9) & 1) << 5)); }
__device__ __forceinline__ void stage_rc(int b, int& R, int& C) { const int st = b / 1024, sb = b % 1024, swz = sb ^ (((sb >> 9) & 1) << 5); R = (st >> 1) * 16 + swz / 64; C = (st & 1) * 32 + (swz % 64) / 2; }
__device__ __forceinline__ int perm32(int rho) { const int n = rho >> 4, i = rho & 15; return 8 * (i >> 2) + 4 * n + (i & 3); }

typedef int v8i __attribute__((ext_vector_type(8)));
typedef int v4i __attribute__((ext_vector_type(4)));
__device__ __forceinline__ v8i cat8(bf16x8 a, bf16x8 b) { const v4i x = __builtin_bit_cast(v4i, a), y = __builtin_bit_cast(v4i, b); return __builtin_shufflevector(x, y, 0, 1, 2, 3, 4, 5, 6, 7); }
struct Unit { unsigned ao, bo, to; int pm, pn, aux; };

__device__ __forceinline__ void tile_of(int L, int nM, int nN, int& pm, int& pn) {
    const int nwg = nM * nN; int wgid = L;
    { const int q = nwg / NXCD, r = nwg % NXCD, xcd = wgid % NXCD, off = wgid / NXCD; wgid = (xcd < r ? xcd * (q + 1) : r * (q + 1) + (xcd - r) * q) + off; }
    const int nig = WGM * nN, gid = wgid / nig, fm = gid * WGM, gsz = (nM - fm) < WGM ? (nM - fm) : WGM;
    pm = fm + ((wgid % nig) % gsz); pn = (wgid % nig) / gsz;
}

template <bool F8, bool GATHER, class Epi, class Sched>
__device__ __forceinline__ void gemm_phase(LAS unsigned char* lds, const unsigned char* wsbase, const int K, const int lda, const int ldb, const Sched& S, const Epi& E) {
    const __amdgpu_buffer_rsrc_t rsrc = __builtin_amdgcn_make_buffer_rsrc((void*)wsbase, 0, 0xFFFFFFFF, 0x00020000);
    const int tid = fresh_tid(), wid = __builtin_amdgcn_readfirstlane(tid >> 6), lane = tid & 63, wr = wid >> 2, wc = wid & 3;
    const int nt = K / BK;
    int f8scales = 0; if constexpr (F8) { f8scales = Epi::SCALES; asm volatile("" : "+v"(f8scales)); }
    int voffA, voffB;
    { int R, C; stage_rc(tid * 16, R, C); const int Rb = Epi::PERM ? ((R & ~31) + perm32(R & 31)) : R; voffA = ((GATHER ? 0 : R * lda) + C) * 2; voffB = (Rb * ldb + C) * 2; }
    const int tokb = (16 * (wid >> 1) + (lane >> 2)) * 4;
    const unsigned kstep = (unsigned)(BK * 2);
    const unsigned hstepA = (unsigned)HALF * lda * 2, hstepB = (unsigned)HALF * ldb * 2;
    const unsigned ldsw = (unsigned)wid * 1024u;
    const int aoff = lds_byte(wr * 64 + (lane & 15), (lane >> 4) * 8), boff = lds_byte(wc * 32 + (lane & 15), (lane >> 4) * 8);
#define PG8_SA(b, h) (((b) * 2 + (h)) * HTB)
#define PG8_SB(b, h) ((4 + (b) * 2 + (h)) * HTB)
#define PG8_STAGE(bufoff, gbase, voff) do { _Pragma("unroll") for (int _i = 0; _i < 2; ++_i) \
        __builtin_amdgcn_raw_ptr_buffer_load_lds(rsrc, (LAS void*)(lds + (bufoff) + ldsl + _i * 8192), 16, voff, __builtin_amdgcn_readfirstlane((int)((gbase) + (unsigned)_i * (hstep##voff >> 1))), 0, 0); } while (0)
#define hstepvoffA hstepA
#define hstepvoffB hstepB
#define PG8_STAGE_A(bufoff, aoffs, h, par) do { if constexpr (GATHER) { _Pragma("unroll") for (int _i = 0; _i < 2; ++_i) { \
            const int _tk = *(const LAS int*)(lds + TOK_OFF + (par) * 1024 + tokb + ((h) * 128 + _i * 64) * 4); \
            __builtin_amdgcn_raw_ptr_buffer_load_lds(rsrc, (LAS void*)(lds + (bufoff) + ldsl + _i * 8192), 16, _tk + voffA, __builtin_amdgcn_readfirstlane((int)(aoffs)), 0, 0); } } \
        else { PG8_STAGE(bufoff, (aoffs) + (unsigned)(h) * hstepA, voffA); } } while (0)
#define PG8_TOK(unit, par) do { if constexpr (GATHER) { if (wid == 0) __builtin_amdgcn_raw_ptr_buffer_load_lds(rsrc, (LAS void*)(lds + TOK_OFF + (par) * 1024), 16, lane * 16, (int)(unit).to, 0, 0); } } while (0)
#define PG8_LDA(dst, b, h) do { _Pragma("unroll") for (int m = 0; m < 4; ++m) _Pragma("unroll") for (int k = 0; k < 2; ++k) dst[m][k] = *(const LAS bf16x8*)(lds + PG8_SA(b, h) + aoff + m * 2048 + k * 1024); } while (0)
#define PG8_LDB(dst, b, h) do { _Pragma("unroll") for (int n = 0; n < 2; ++n) _Pragma("unroll") for (int k = 0; k < 2; ++k) dst[n][k] = *(const LAS bf16x8*)(lds + PG8_SB(b, h) + boff + n * 2048 + k * 1024); } while (0)
#define PG8_MMA(ai, bj, At, Bt) do { __builtin_amdgcn_s_setprio(1); _Pragma("unroll") for (int m = 0; m < 4; ++m) _Pragma("unroll") for (int n = 0; n < 2; ++n) { \
        if constexpr (F8) { asm volatile("v_mfma_scale_f32_16x16x128_f8f6f4 %0, %1, %2, %0, %3, %3 op_sel:[0,1,0] op_sel_hi:[0,0,0]" : "+v"(acc[ai][bj][m][n]) : "v"(cat8(Bt[n][0], Bt[n][1])), "v"(cat8(At[m][0], At[m][1])), "v"(f8scales)); } \
        else { _Pragma("unroll") for (int k = 0; k < 2; ++k) acc[ai][bj][m][n] = __builtin_amdgcn_mfma_f32_16x16x32_bf16(Bt[n][k], At[m][k], acc[ai][bj][m][n], 0, 0, 0); } } \
        __builtin_amdgcn_s_setprio(0); } while (0)
#define PG8_WAIT_V(n) asm volatile("s_waitcnt vmcnt(" #n ")" ::: "memory")
#define PG8_WAIT_L(n) asm volatile("s_waitcnt lgkmcnt(" #n ")" ::: "memory")
#define PG8_BAR __builtin_amdgcn_s_barrier()
#define PG8_SCHED __builtin_amdgcn_sched_barrier(0)
    Unit cur, nxt; int ui = 0;
    if (!S.next(0, cur)) return;
    f32x4 acc[2][2][4][2];
    bf16x8 At[4][2], B0[2][2], B1[2][2];
#define PG8_INIT(par) do { if constexpr (Epi::SIDE) { const int _l = fresh_tid() & 63; E.init(acc, (const LAS float*)(lds + SIDE_OFF + (par) * 1024), wc, _l >> 4); } \
        else { _Pragma("unroll") for (int a = 0; a < 2; ++a) _Pragma("unroll") for (int b = 0; b < 2; ++b) _Pragma("unroll") for (int m = 0; m < 4; ++m) _Pragma("unroll") for (int n = 0; n < 2; ++n) acc[a][b][m][n] = (f32x4){0.f, 0.f, 0.f, 0.f}; } } while (0)
    unsigned cA = cur.ao, cB = cur.bo;
    unsigned ldsl = ldsw; asm volatile("" : "+s"(ldsl));
#define PG8_SIDE(unit, par) do { if constexpr (Epi::SIDE) { if (wid == 0) __builtin_amdgcn_raw_ptr_buffer_load_lds(rsrc, (LAS void*)(lds + SIDE_OFF + (par) * 1024), 16, lane * 16, (int)E.side_off(unit), 0, 0); } } while (0)
    PG8_SIDE(cur, 0);
    if constexpr (GATHER) PG8_TOK(cur, 0);
    if constexpr (GATHER || Epi::SIDE) { asm volatile("s_waitcnt vmcnt(0)" ::: "memory"); PG8_BAR; }
    PG8_INIT(0);
    PG8_STAGE(PG8_SB(0, 0), cB, voffB); PG8_STAGE(PG8_SB(0, 1), cB + hstepB, voffB); PG8_STAGE_A(PG8_SA(0, 0), cA, 0, 0); PG8_STAGE_A(PG8_SA(0, 1), cA, 1, 0);
    if (wr == 1) PG8_BAR;
    PG8_WAIT_V(2); PG8_BAR;
    PG8_STAGE(PG8_SB(1, 0), cB + kstep, voffB); PG8_STAGE_A(PG8_SA(1, 0), cA + kstep, 0, 0); PG8_STAGE(PG8_SB(1, 1), cB + hstepB + kstep, voffB);
    PG8_WAIT_V(6); PG8_BAR;
    for (;;) {
        const bool has_next = S.next(ui + 1, nxt);
        if (has_next) { PG8_TOK(nxt, (ui + 1) & 1); PG8_SIDE(nxt, (ui + 1) & 1); }
        const unsigned nA = has_next ? nxt.ao : cA, nB = has_next ? nxt.bo : cB;
#pragma unroll 1
        for (int t = 0; t < nt; t += 2) {
            const bool last = (t == nt - 2);
            ldsl = ldsw; asm volatile("" : "+s"(ldsl));
            const int parc = ui & 1, parn = (ui + ((last && has_next) ? 1 : 0)) & 1;
            const unsigned a1 = cA + (unsigned)(t + 1) * kstep;
            const unsigned a2 = last ? nA : cA + (unsigned)(t + 2) * kstep, b2 = last ? nB : cB + (unsigned)(t + 2) * kstep;
            const unsigned a3 = a2 + kstep, b3 = b2 + kstep;
            PG8_LDB(B0, 0, 0); PG8_LDB(B1, 0, 1); PG8_SCHED; PG8_LDA(At, 0, 0); PG8_STAGE_A(PG8_SA(1, 1), a1, 1, parc);
            PG8_WAIT_V(8); PG8_WAIT_L(0); PG8_BAR; PG8_MMA(0, 0, At, B0); PG8_MMA(0, 1, At, B1); PG8_BAR; PG8_SCHED;
            PG8_LDA(At, 0, 1); PG8_STAGE(PG8_SB(0, 0), b2, voffB); PG8_STAGE(PG8_SB(0, 1), b2 + hstepB, voffB); PG8_STAGE_A(PG8_SA(0, 0), a2, 0, parn);
            PG8_WAIT_V(8); PG8_WAIT_L(0); PG8_BAR; PG8_MMA(1, 0, At, B0); PG8_MMA(1, 1, At, B1); PG8_BAR; PG8_SCHED;
            PG8_LDB(B0, 1, 0); PG8_LDB(B1, 1, 1); PG8_SCHED; PG8_LDA(At, 1, 0); PG8_STAGE_A(PG8_SA(0, 1), a2, 1, parn);
            PG8_WAIT_V(8); PG8_WAIT_L(0); PG8_BAR; PG8_MMA(0, 0, At, B0); PG8_MMA(0, 1, At, B1); PG8_BAR; PG8_SCHED;
            PG8_LDA(At, 1, 1); PG8_STAGE(PG8_SB(1, 0), b3, voffB); PG8_STAGE(PG8_SB(1, 1), b3 + hstepB, voffB); PG8_STAGE_A(PG8_SA(1, 0), a3, 0, parn);
            PG8_WAIT_V(8); PG8_WAIT_L(0); PG8_BAR; PG8_MMA(1, 0, At, B0); PG8_MMA(1, 1, At, B1); PG8_BAR; PG8_SCHED;
        }
        if constexpr (F8) asm volatile("s_nop 15\n\ts_nop 15" ::: "memory");
        if (wr == 0) PG8_BAR;
        { const int l2 = fresh_tid() & 63; E(acc, cur, wr, wc, l2 & 15, l2 >> 4, (const LAS float*)(lds + SIDE_OFF + (ui & 1) * 1024)); }
        if (!has_next) break;
        cur = nxt; cA = nA; cB = nB; ++ui;
        PG8_INIT(ui & 1);
        if (wr == 1) PG8_BAR;
    }
    PG8_WAIT_V(0);
    PG8_BAR;
#undef PG8_SA
#undef PG8_SB
#undef PG8_STAGE
#undef PG8_STAGE_A
#undef PG8_TOK
#undef PG8_SIDE
#undef PG8_INIT
#undef hstepvoffA
#undef hstepvoffB
#undef PG8_LDA
#undef PG8_LDB
#undef PG8_MMA
#undef PG8_WAIT_V
#undef PG8_WAIT_L
#undef PG8_BAR
#undef PG8_SCHED
}
}

using pg8::Unit;

struct DenseSched {
    unsigned A, Bt; int lda, ldb, nM, nN, G, c;
    __device__ __forceinline__ bool next(int i, Unit& u) const {
        const int L = i * G + c; if (L >= nM * nN) return false;
        pg8::tile_of(L, nM, nN, u.pm, u.pn); u.aux = 0; u.to = 0;
        u.ao = A + (unsigned)u.pm * 256 * lda * 2; u.bo = Bt + (unsigned)u.pn * 256 * ldb * 2; return true;
    }
};
struct GateSched {
    unsigned XC, GT; int nM, G, c;
    __device__ __forceinline__ bool next(int i, Unit& u) const {
        const int per = nM * 4; const int L = i * G + c; if (L >= 4 * per) return false;
        const int nb = L / per; pg8::tile_of(L - nb * per, nM, 4, u.pm, u.pn); u.aux = nb; u.to = 0;
        u.ao = XC + ((unsigned)u.pm * 256 * 1024 + 256 * nb) * 2; u.bo = GT + ((unsigned)nb * 1024 + 256 * u.pn) * 256 * 2; return true;
    }
};
struct QkvSched {
    unsigned HB, WT; int nM, G, c;
    __device__ __forceinline__ bool next(int i, Unit& u) const {
        const int n0 = nM * 8, n1 = 4 * nM; const int L = i * G + c; if (L >= n0 + n1) return false; u.to = 0;
        if (L < n0) { pg8::tile_of(L, nM, 8, u.pm, u.pn); u.aux = 0; u.ao = HB + (unsigned)u.pm * 256 * 1024; u.bo = WT + (unsigned)u.pn * 256 * 1024; }
        else { pg8::tile_of(L - n0, 4, nM, u.pm, u.pn); u.aux = 1; u.ao = WT + (unsigned)(2048 + u.pm * 256) * 1024; u.bo = HB + (unsigned)u.pn * 256 * 1024; }
        return true;
    }
};
struct MoeSched {
    unsigned A, W, tok; const LAS int* texp; unsigned wstride; int nM, nN, G, c;
    __device__ __forceinline__ bool next(int i, Unit& u) const {
        const int L = i * G + c; if (L >= nM * nN) return false;
        pg8::tile_of(L, nM, nN, u.pm, u.pn);
        const int e = __builtin_amdgcn_readfirstlane(texp[u.pm]); u.aux = e;
        u.ao = tok ? A : A + (unsigned)u.pm * 256 * 1024; u.to = tok + (unsigned)u.pm * 1024; u.bo = W + (unsigned)e * wstride + (unsigned)u.pn * 256 * 1024; return true;
    }
};

#define EPI_ARGS const f32x4 (&acc)[2][2][4][2], const Unit& u, int wr, int wc, int fr, int fq, const LAS float* side
struct EpiWin {
    static constexpr bool PERM = true, SIDE = false;
    bf16_t* XR; bf16_t* GY;
    __device__ __forceinline__ void operator()(EPI_ARGS) const {
        const int row0 = u.pm * 256 + wr * 64 + fr;
        if (u.pn < 4) {
            const int col0 = u.pn * 256 + wc * 32 + 8 * fq;
#pragma unroll
            for (int ai = 0; ai < 2; ++ai)
#pragma unroll
                for (int m = 0; m < 4; ++m) { bf16_t* rowp = XR + (size_t)(row0 + ai * 128 + m * 16) * D + col0;
#pragma unroll
                    for (int bj = 0; bj < 2; ++bj) { const f32x4 v0 = acc[ai][bj][m][0], v1 = acc[ai][bj][m][1];
                        u32x4 w; w.x = cvt_pk_bf16(v0[0], v0[1]); w.y = cvt_pk_bf16(v0[2], v0[3]); w.z = cvt_pk_bf16(v1[0], v1[1]); w.w = cvt_pk_bf16(v1[2], v1[3]);
                        *(u32x4*)(rowp + bj * 128) = w; } }
        } else {
#pragma unroll
            for (int ai = 0; ai < 2; ++ai)
#pragma unroll
                for (int m = 0; m < 4; ++m) { const int row = row0 + ai * 128 + m * 16;
#pragma unroll
                    for (int bj = 0; bj < 2; ++bj) { const int g = (u.pn - 4) * 8 + bj * 4 + wc;
                        float o[8];
#pragma unroll
                        for (int n = 0; n < 2; ++n)
#pragma unroll
                            for (int j = 0; j < 4; ++j) { const float v = acc[ai][bj][m][n][j]; const float z = 1.5957691216f * (v + 0.044715f * v * v * v); o[n * 4 + j] = v * sigmoidf_(z); }
                        u32x4 w; w.x = cvt_pk_bf16(o[0], o[1]); w.y = cvt_pk_bf16(o[2], o[3]); w.z = cvt_pk_bf16(o[4], o[5]); w.w = cvt_pk_bf16(o[6], o[7]);
                        *(u32x4*)(GY + ((size_t)g * MPAD + row) * 32 + 8 * fq) = w; } }
        }
    }
};
struct EpiGate {
    static constexpr bool PERM = true, SIDE = true;
    const bf16_t* XC; bf16_t* LA; bf16_t* BB; const float* spl; unsigned bias_off;
    __device__ __forceinline__ unsigned side_off(const Unit& u) const { return bias_off + (unsigned)((((u.pn >> 1) * 4 + u.aux) * 2 + (u.pn & 1)) * 1024); }
    __device__ __forceinline__ void init(f32x4 (&acc)[2][2][4][2], const LAS float* side, int wc, int fq) const {
#pragma unroll
        for (int bj = 0; bj < 2; ++bj)
#pragma unroll
            for (int n = 0; n < 2; ++n) { const f32x4 b = *(const LAS f32x4*)(side + 128 * bj + 32 * wc + 8 * fq + 4 * n);
#pragma unroll
                for (int ai = 0; ai < 2; ++ai)
#pragma unroll
                    for (int m = 0; m < 4; ++m) acc[ai][bj][m][n] = b; }
    }
    __device__ __forceinline__ void operator()(EPI_ARGS) const {
        const int nb = u.aux, dir = u.pn >> 1, half = u.pn & 1;
        const int ch0 = 256 * nb + 128 * half + 32 * wc + 8 * fq, g = ch0 >> 5;
        const int row0 = u.pm * 256 + wr * 64 + fr;
        float csp[8];
        { const f32x4 p0 = *(const f32x4*)(spl + dir * 1024 + ch0), p1 = *(const f32x4*)(spl + dir * 1024 + ch0 + 4);
#pragma unroll
          for (int j = 0; j < 4; ++j) { csp[j] = -p0[j]; csp[4 + j] = -p1[j]; } }
        u32x4 xnext = *(const u32x4*)(XC + (size_t)row0 * D + ch0);
#pragma unroll
        for (int ai = 0; ai < 2; ++ai)
#pragma unroll
            for (int m = 0; m < 4; ++m) { const int row = row0 + ai * 128 + m * 16;
                const u32x4 xw = xnext;
                { const int it = ai * 4 + m + 1, rn = row0 + (it >> 2) * 128 + (it & 3) * 16; if (it < 8) xnext = *(const u32x4*)(XC + (size_t)rn * D + ch0); }
                float xc[8]; unpack8(xw, xc);
                const bool start = dir == 1 && (row & (SEQ - 1)) == SEQ - 1;
                float la[8], bb[8];
#pragma unroll
                for (int n = 0; n < 2; ++n)
#pragma unroll
                    for (int j = 0; j < 4; ++j) { const int i = n * 4 + j;
                        const float l2 = csp[i] * sigmoidf_(acc[ai][0][m][n][j]); const float a2 = fast_exp2(2.0f * l2);
                        const float mult = start ? 1.0f : __builtin_amdgcn_sqrtf(fmaxf(1.0f - a2, 0.0f));
                        la[i] = l2; bb[i] = mult * sigmoidf_(acc[ai][1][m][n][j]) * xc[i]; }
                u32x4 w; w.x = cvt_pk_bf16(la[0], la[1]); w.y = cvt_pk_bf16(la[2], la[3]); w.z = cvt_pk_bf16(la[4], la[5]); w.w = cvt_pk_bf16(la[6], la[7]);
                const size_t o = (((size_t)dir * 32 + g) * MPAD + row) * 32 + 8 * fq;
                *(u32x4*)(LA + o) = w;
                w.x = cvt_pk_bf16(bb[0], bb[1]); w.y = cvt_pk_bf16(bb[2], bb[3]); w.z = cvt_pk_bf16(bb[4], bb[5]); w.w = cvt_pk_bf16(bb[6], bb[7]);
                *(u32x4*)(BB + o) = w; }
    }
};
template <bool LAYER0> struct EpiRes {
    static constexpr bool PERM = true, SIDE = false;
    bf16_t* PRE; const float* x; const float* meta; const bf16_t* HB; int nrows;
    __device__ __forceinline__ void operator()(EPI_ARGS) const {
        const int row0 = u.pm * 256 + wr * 64 + fr, col0 = u.pn * 256 + wc * 32 + 8 * fq;
#pragma unroll
        for (int ai = 0; ai < 2; ++ai)
#pragma unroll
            for (int m = 0; m < 4; ++m) { const int row = row0 + ai * 128 + m * 16;
                if (row < nrows) {
#pragma unroll
                    for (int bj = 0; bj < 2; ++bj) { const int c = col0 + bj * 128; float r[8];
                        if (LAYER0) { const float* rp = (row < NGRID ? x + (size_t)row * D : meta + (size_t)((row - NGRID) & 15) * D) + c; const f32x4 r0 = *(const f32x4*)rp, r1 = *(const f32x4*)(rp + 4);
                            r[0] = r0[0]; r[1] = r0[1]; r[2] = r0[2]; r[3] = r0[3]; r[4] = r1[0]; r[5] = r1[1]; r[6] = r1[2]; r[7] = r1[3]; }
                        else { const u32x4 rw = *(const u32x4*)(HB + (size_t)row * D + c); r[0] = bflo(rw.x); r[1] = bfhi(rw.x); r[2] = bflo(rw.y); r[3] = bfhi(rw.y); r[4] = bflo(rw.z); r[5] = bfhi(rw.z); r[6] = bflo(rw.w); r[7] = bfhi(rw.w); }
                        const f32x4 a0 = acc[ai][bj][m][0], a1 = acc[ai][bj][m][1];
                        u32x4 w; w.x = cvt_pk_bf16(r[0] * DN_ALPHA + a0[0], r[1] * DN_ALPHA + a0[1]); w.y = cvt_pk_bf16(r[2] * DN_ALPHA + a0[2], r[3] * DN_ALPHA + a0[3]);
                        w.z = cvt_pk_bf16(r[4] * DN_ALPHA + a1[0], r[5] * DN_ALPHA + a1[1]); w.w = cvt_pk_bf16(r[6] * DN_ALPHA + a1[2], r[7] * DN_ALPHA + a1[3]);
                        *(u32x4*)(PRE + (size_t)row * D + c) = w; }
                }
                asm volatile("" ::: "memory"); }
    }
};
struct EpiGlu {
    static constexpr bool PERM = true, SIDE = true; static constexpr int SCALES = 0x7F79;
    unsigned char* ACT; unsigned bias_off;
    __device__ __forceinline__ unsigned side_off(const Unit& u) const { return bias_off + (unsigned)((u.aux * 8 + u.pn) * 1024); }
    __device__ __forceinline__ void init(f32x4 (&acc)[2][2][4][2], const LAS float* side, int wc, int fq) const {
#pragma unroll
        for (int bj = 0; bj < 2; ++bj)
#pragma unroll
            for (int n = 0; n < 2; ++n) { const f32x4 b = *(const LAS f32x4*)(side + 128 * bj + 32 * wc + 8 * fq + 4 * n);
#pragma unroll
                for (int ai = 0; ai < 2; ++ai)
#pragma unroll
                    for (int m = 0; m < 4; ++m) acc[ai][bj][m][n] = b; }
    }
    __device__ __forceinline__ void operator()(EPI_ARGS) const {
        const int f0 = 128 * u.pn + 32 * wc + 8 * fq;
        const int row0 = u.pm * 256 + wr * 64 + fr;
#pragma unroll
        for (int ai = 0; ai < 2; ++ai)
#pragma unroll
            for (int m = 0; m < 4; ++m) { const int row = row0 + ai * 128 + m * 16; float o[8];
#pragma unroll
                for (int n = 0; n < 2; ++n)
#pragma unroll
                    for (int j = 0; j < 4; ++j) { const int i = n * 4 + j;
                        const float glu = fminf(acc[ai][0][m][n][j], 7.0f);
                        const float lin4 = __builtin_fmaf(__builtin_amdgcn_fmed3f(acc[ai][1][m][n][j], -7.0f, 7.0f), 4.0f, 4.0f);
                        const float r = fast_rcp(1.0f + fast_exp2(glu * (-1.702f * 1.44269504089f)));
                        o[i] = (glu * r) * lin4; }
                u32x2 w; w.x = pk4_fp8(o[0], o[1], o[2], o[3]); w.y = pk4_fp8(o[4], o[5], o[6], o[7]);
                *(u32x2*)(ACT + (size_t)row * D + f0) = w; }
    }
};
struct EpiNull {
    static constexpr bool PERM = true, SIDE = false; static constexpr int SCALES = 0x7F79;
    __device__ __forceinline__ void operator()(EPI_ARGS) const {
#pragma unroll
        for (int ai = 0; ai < 2; ++ai)
#pragma unroll
            for (int bj = 0; bj < 2; ++bj)
#pragma unroll
                for (int m = 0; m < 4; ++m)
#pragma unroll
                    for (int n = 0; n < 2; ++n) asm volatile("" :: "v"(acc[ai][bj][m][n]));
    }
};
struct EpiDown {
    static constexpr bool PERM = true, SIDE = true; static constexpr int SCALES = 0x7D79;
    bf16_t* YS; unsigned bias_off;
    __device__ __forceinline__ unsigned side_off(const Unit& u) const { return bias_off + (unsigned)((u.aux * 4 + u.pn) * 1024); }
    __device__ __forceinline__ void init(f32x4 (&acc)[2][2][4][2], const LAS float* side, int wc, int fq) const {
#pragma unroll
        for (int bj = 0; bj < 2; ++bj)
#pragma unroll
            for (int n = 0; n < 2; ++n) { const f32x4 b = *(const LAS f32x4*)(side + 128 * bj + 32 * wc + 8 * fq + 4 * n);
#pragma unroll
                for (int ai = 0; ai < 2; ++ai)
#pragma unroll
                    for (int m = 0; m < 4; ++m) acc[ai][bj][m][n] = b; }
    }
    __device__ __forceinline__ void operator()(EPI_ARGS) const {
        const int row0 = u.pm * 256 + wr * 64 + fr, col0 = u.pn * 256 + wc * 32 + 8 * fq;
#pragma unroll
        for (int ai = 0; ai < 2; ++ai)
#pragma unroll
            for (int m = 0; m < 4; ++m) { bf16_t* rowp = YS + (size_t)(row0 + ai * 128 + m * 16) * D + col0;
#pragma unroll
                for (int bj = 0; bj < 2; ++bj) { const f32x4 v0 = acc[ai][bj][m][0], v1 = acc[ai][bj][m][1];
                    u32x4 w; w.x = cvt_pk_bf16(v0[0], v0[1]); w.y = cvt_pk_bf16(v0[2], v0[3]); w.z = cvt_pk_bf16(v1[0], v1[1]); w.w = cvt_pk_bf16(v1[2], v1[3]);
                    *(u32x4*)(rowp + bj * 128) = w; } }
    }
};
struct EpiQkv {
    static constexpr bool PERM = true, SIDE = false; static constexpr int SCALES = 0x7F79;
    bf16_t* Q; bf16_t* Kx; bf16_t* VT;
    __device__ __forceinline__ void operator()(EPI_ARGS) const {
        const int row0 = u.pm * 256 + wr * 64 + fr; bf16_t* base; int ldc, colt; float sc = 1.0f;
        if (u.aux == 0) { ldc = D; if (u.pn < 4) { base = Q; colt = u.pn * 256; sc = 0.125f * 1.44269504089f; } else { base = Kx; colt = (u.pn - 4) * 256; } }
        else { base = VT; ldc = MPAD; colt = u.pn * 256; }
        const int col0 = colt + wc * 32 + 8 * fq;
#pragma unroll
        for (int ai = 0; ai < 2; ++ai)
#pragma unroll
            for (int m = 0; m < 4; ++m) { bf16_t* rowp = base + (size_t)(row0 + ai * 128 + m * 16) * ldc + col0;
#pragma unroll
                for (int bj = 0; bj < 2; ++bj) { const f32x4 v0 = acc[ai][bj][m][0] * sc, v1 = acc[ai][bj][m][1] * sc;
                    u32x4 w; w.x = cvt_pk_bf16(v0[0], v0[1]); w.y = cvt_pk_bf16(v0[2], v0[3]); w.z = cvt_pk_bf16(v1[0], v1[1]); w.w = cvt_pk_bf16(v1[2], v1[3]);
                    *(u32x4*)(rowp + bj * 128) = w; } }
    }
};

struct CvItem { const float* src; unsigned char* dst; int ld, pitch, f8; };
__device__ __forceinline__ CvItem cv_item(const Ctx& C, unsigned char* wsl, int it) {
    constexpr int I0 = 512, I1 = 256, I2 = 256, I3 = 768, I4 = 256, I5 = 32768, I6 = 16384;
    CvItem q; int r = it;
    if (r < I0) { const int nbk = r & 63, kb = r >> 6; q.src = C.in[I_WIN] + (size_t)(128 * kb) * 2048 + 32 * nbk; q.ld = 2048; q.dst = wsl + WS_WIN + ((size_t)(32 * nbk) * 1024 + 128 * kb) * 2; q.pitch = 2048; q.f8 = 0; return q; } r -= I0;
    if (r < I1) { const int job = r >> 3, sub = r & 7, nbk = sub & 3, kb = sub >> 2;
        const int half = job & 1, which = (job >> 1) & 1, nb = (job >> 2) & 3, dir = job >> 4;
        q.src = C.in[which ? I_WX : I_WA] + (size_t)(dir * 4 + nb) * 65536 + (size_t)(128 * kb) * 256 + 128 * half + 32 * nbk; q.ld = 256;
        q.dst = wsl + WS_GATE + (((size_t)nb * 1024 + 256 * (2 * dir + half) + 128 * which + 32 * nbk) * 256 + 128 * kb) * 2; q.pitch = 512; q.f8 = 0; return q; } r -= I1;
    if (r < I2) { const int nbk = r & 31, kb = r >> 5; q.src = C.in[I_LOUT] + (size_t)(128 * kb) * 1024 + 32 * nbk; q.ld = 1024; q.dst = wsl + WS_LOUT + ((size_t)(32 * nbk) * 1024 + 128 * kb) * 2; q.pitch = 2048; q.f8 = 0; return q; } r -= I2;
    if (r < I3) { const int nbk = r % 96, kb = r / 96; q.src = C.in[I_WQKV] + (size_t)(128 * kb) * 3072 + 32 * nbk; q.ld = 3072; q.dst = wsl + WS_QKV + ((size_t)(32 * nbk) * 1024 + 128 * kb) * 2; q.pitch = 2048; q.f8 = 0; return q; } r -= I3;
    if (r < I4) { const int nbk = r & 31, kb = r >> 5; q.src = C.in[I_NOUT] + (size_t)(128 * kb) * 1024 + 32 * nbk; q.ld = 1024; q.dst = wsl + WS_NOUT + ((size_t)(32 * nbk) * 1024 + 128 * kb) * 2; q.pitch = 2048; q.f8 = 0; return q; } r -= I4;
    q.f8 = 1; q.pitch = 1024;
    if (r < I5) { const int mat = r >> 9, sub = r & 511, nbk = sub & 63, kb = sub >> 6; const int n0 = 32 * nbk, bj = n0 >> 10, f0 = n0 & 1023, pn = f0 >> 7, jj = f0 & 127;
        q.src = C.in[I_WGU] + (size_t)mat * 1024 * 2048 + (size_t)(128 * kb) * 2048 + n0; q.ld = 2048; q.dst = wsl + WS_WGU + ((size_t)mat * 2048 + 256 * pn + 128 * bj + jj) * 1024 + 128 * kb; return q; } r -= I5;
    if (r < I6) { const int mat = r >> 8, sub = r & 255, nbk = sub & 31, kb = sub >> 5;
        q.src = C.in[I_WD] + (size_t)mat * 1024 * 1024 + (size_t)(128 * kb) * 1024 + 32 * nbk; q.ld = 1024; q.dst = wsl + WS_WD + ((size_t)mat * 1024 + 32 * nbk) * 1024 + 128 * kb; return q; } r -= I6;
    { const int nbk = r % 96, kb = r / 96; q.src = C.in[I_WQKV] + (size_t)(128 * kb) * 3072 + 32 * nbk; q.ld = 3072; q.dst = wsl + WS_QKV8 + (size_t)(32 * nbk) * 1024 + 128 * kb; return q; }
}
__device__ __forceinline__ void phase_convert(const Ctx& C) {
    PHASE_IDS
    LAS float* scr = (LAS float*)(C.lds + wave * 16896);
    const int gw = C.bid * NWAVES + wave, NGW = C.G * NWAVES;
    constexpr int NIT = 512 + 256 + 256 + 768 + 256 + 32768 + 16384 + 768;
    if (gw < NIT) {
        const int r = lane >> 3, q4 = lane & 7, c = lane & 15, nn = lane >> 4;
        CvItem cur = cv_item(C, wsl, gw); int it = gw;
        f32x4 v[16];
#pragma unroll
        for (int i = 0; i < 16; ++i) v[i] = __builtin_nontemporal_load((const f32x4*)(cur.src + (size_t)(8 * i + r) * cur.ld + 4 * q4));
        for (;;) {
#pragma unroll
            for (int i = 0; i < 16; ++i) { LAS float* sp = scr + (8 * i + r) * 33 + 4 * q4; sp[0] = v[i][0]; sp[1] = v[i][1]; sp[2] = v[i][2]; sp[3] = v[i][3]; }
            const int nit = it + NGW; CvItem nxt = cur;
            if (nit < NIT) { nxt = cv_item(C, wsl, nit);
#pragma unroll
                for (int i = 0; i < 16; ++i) v[i] = __builtin_nontemporal_load((const f32x4*)(nxt.src + (size_t)(8 * i + r) * nxt.ld + 4 * q4)); }
            asm volatile("s_waitcnt lgkmcnt(0)" ::: "memory");
            if (cur.f8) {
#pragma unroll
                for (int j = 0; j < 8; ++j) { const int n = nn + 4 * j; const LAS float* sp = scr + (8 * c) * 33 + n;
                    u32x2 o; o.x = pk4_fp8(sp[0] * 64.0f, sp[33] * 64.0f, sp[2 * 33] * 64.0f, sp[3 * 33] * 64.0f); o.y = pk4_fp8(sp[4 * 33] * 64.0f, sp[5 * 33] * 64.0f, sp[6 * 33] * 64.0f, sp[7 * 33] * 64.0f);
                    *(u32x2*)(cur.dst + (size_t)n * cur.pitch + 8 * c) = o; }
            } else {
#pragma unroll
                for (int j = 0; j < 8; ++j) { const int n = nn + 4 * j; const LAS float* sp = scr + (8 * c) * 33 + n;
                    u32x4 o; o.x = pk2(sp[0], sp[33]); o.y = pk2(sp[2 * 33], sp[3 * 33]); o.z = pk2(sp[4 * 33], sp[5 * 33]); o.w = pk2(sp[6 * 33], sp[7 * 33]);
                    *(u32x4*)(cur.dst + (size_t)n * cur.pitch + 16 * c) = o; }
            }
            asm volatile("s_waitcnt lgkmcnt(0)" ::: "memory");
            if (nit >= NIT) break;
            cur = nxt; it = nit;
        }
    }
    const int gt = C.bid * NTHREADS + tid, NGT = C.G * NTHREADS;
    for (int i = gt; i < 2048; i += NGT) ((float*)(wsl + WS_CTL + CT_SPL))[i] = 8.0f * 1.44269504089f * log1pf(expf(-C.in[I_LAM][i]));
    for (int i = gt; i < 2 * 32 * 2048; i += NGT) { const int le = i >> 11, r = i & 2047, pn = r >> 8, bj = (r >> 7) & 1, ii = r & 127;
        ((float*)(wsl + WS_BIAS))[i] = C.in[I_BGU][(size_t)le * 2048 + bj * 1024 + 128 * pn + ii]; }
    for (int i = gt; i < 2 * 32 * 1024; i += NGT) ((float*)(wsl + WS_BD))[i] = C.in[I_BD][i];
    for (int i = gt; i < 4096; i += NGT) { const int ut = i >> 8, which = (i >> 7) & 1, jj = i & 127, dir = ut >> 3, nb = (ut >> 1) & 3, half = ut & 1;
        ((float*)(wsl + WS_GBIAS))[i] = C.in[which ? I_BX : I_BA][dir * 1024 + 256 * nb + 128 * half + jj]; }
    for (int i0 = gt; i0 < NTOK * 128; i0 += 4 * NGT) { f32x4 a[4], b[4];
#pragma unroll
        for (int u = 0; u < 4; ++u) { const int i = i0 + u * NGT; if (i < NTOK * 128) { const int row = i >> 7, oc = i & 127;
            const float* src = (row < NGRID ? C.in[I_X] + (size_t)row * D : C.in[I_META] + (size_t)((row - NGRID) & 15) * D) + 8 * oc;
            a[u] = __builtin_nontemporal_load((const f32x4*)src); b[u] = __builtin_nontemporal_load((const f32x4*)(src + 4)); } }
#pragma unroll
        for (int u = 0; u < 4; ++u) { const int i = i0 + u * NGT; if (i < NTOK * 128) { const int row = i >> 7, oc = i & 127;
            u32x4 w; w.x = pk2(a[u][0], a[u][1]); w.y = pk2(a[u][2], a[u][3]); w.z = pk2(b[u][0], b[u][1]); w.w = pk2(b[u][2], b[u][3]);
            *(u32x4*)((bf16_t*)(wsl + WS_HB) + (size_t)row * D + 8 * oc) = w; } } }
}

__device__ __forceinline__ void phase_conv(const Ctx& C) {
    PHASE_IDS
    const bf16_t* XR = (const bf16_t*)(wsl + WS_XR); bf16_t* XC = (bf16_t*)(wsl + WS_XC);
    const float* cw = C.in[I_CONVW]; const float* cb = C.in[I_CONVB];
    const int gt = C.bid * NTHREADS + tid, NGT = C.G * NTHREADS;
    for (int i = gt; i < NTOK * 128; i += NGT) { const int row = i >> 7, ch = 8 * (i & 127);
        int b, s; if (row < NGRID) { b = row >> 12; s = NMETA + (row & (SEQ - 1)); } else { b = (row - NGRID) >> 4; s = (row - NGRID) & 15; }
        float a[8];
        { const f32x4 t0 = *(const f32x4*)(cb + ch), t1 = *(const f32x4*)(cb + ch + 4);
#pragma unroll
          for (int j = 0; j < 4; ++j) { a[j] = t0[j]; a[4 + j] = t1[j]; } }
#pragma unroll
        for (int j = 0; j < 4; ++j) { const int sj = s - 2 + j;
            if (sj >= 0 && sj < LSEQ) { const u32x4 xw = *(const u32x4*)(XR + (size_t)seqrow(b, sj) * D + ch);
                const f32x4 w0 = *(const f32x4*)(cw + j * 1024 + ch), w1 = *(const f32x4*)(cw + j * 1024 + ch + 4);
                a[0] += w0[0] * bflo(xw.x); a[1] += w0[1] * bfhi(xw.x); a[2] += w0[2] * bflo(xw.y); a[3] += w0[3] * bfhi(xw.y);
                a[4] += w1[0] * bflo(xw.z); a[5] += w1[1] * bfhi(xw.z); a[6] += w1[2] * bflo(xw.w); a[7] += w1[3] * bfhi(xw.w); } }
        u32x4 w; w.x = pk2(a[0], a[1]); w.y = pk2(a[2], a[3]); w.z = pk2(a[4], a[5]); w.w = pk2(a[6], a[7]);
        *(u32x4*)(XC + (size_t)row * D + ch) = w; }
}

template <int N> __device__ __forceinline__ float dpp_shr(float oldv, float v) {
    return __builtin_bit_cast(float, __builtin_amdgcn_update_dpp(__builtin_bit_cast(int, oldv), __builtin_bit_cast(int, v), 0x110 + N, 0xf, 0xf, false));
}
__device__ __forceinline__ void scan_group(float (&a)[8], float (&b)[8]) {
#pragma unroll
    for (int c = 0; c < 8; ++c) {
        { const float ap = dpp_shr<1>(1.0f, a[c]), bp = dpp_shr<1>(0.0f, b[c]); b[c] = a[c] * bp + b[c]; a[c] = a[c] * ap; }
        { const float ap = dpp_shr<2>(1.0f, a[c]), bp = dpp_shr<2>(0.0f, b[c]); b[c] = a[c] * bp + b[c]; a[c] = a[c] * ap; }
        { const float ap = dpp_shr<4>(1.0f, a[c]), bp = dpp_shr<4>(0.0f, b[c]); b[c] = a[c] * bp + b[c]; a[c] = a[c] * ap; }
        { const float ap = dpp_shr<8>(1.0f, a[c]), bp = dpp_shr<8>(0.0f, b[c]); b[c] = a[c] * bp + b[c]; a[c] = a[c] * ap; }
    }
}
__device__ __forceinline__ void unpack8(const u32x4 w, float (&o)[8]) { o[0] = bflo(w.x); o[1] = bfhi(w.x); o[2] = bflo(w.y); o[3] = bfhi(w.y); o[4] = bflo(w.z); o[5] = bfhi(w.z); o[6] = bflo(w.w); o[7] = bfhi(w.w); }
__device__ __forceinline__ void phase_scan(const Ctx& C) {
    PHASE_IDS
    const bf16_t* LA = (const bf16_t*)(wsl + WS_LA); const bf16_t* BB = (const bf16_t*)(wsl + WS_BB); const bf16_t* GY = (const bf16_t*)(wsl + WS_GY);
    bf16_t* HF = (bf16_t*)(wsl + WS_HF); bf16_t* Gout = (bf16_t*)(wsl + WS_G);
    LAS float* agg = (LAS float*)C.lds;
    const int w = wave, oct = lane >> 4, p = lane & 15;
    for (int it0 = (C.G == 256 ? C.gc : C.bid); it0 < NB * 32; it0 += C.G) {
        const int item = (C.G == 256) ? (((it0 >> 3) >> 2) << 5) + ((it0 & 7) << 2) + ((it0 >> 3) & 3) : it0;
        const int b = item >> 5, g = item & 31;
        for (int dir = 0; dir < 2; ++dir) {
            const bf16_t* la = LA + (((size_t)dir * 32 + g) * MPAD) * 32 + 8 * oct;
            const bf16_t* bb = BB + (((size_t)dir * 32 + g) * MPAD) * 32 + 8 * oct;
            float S[8];
#pragma unroll
            for (int c = 0; c < 8; ++c) S[c] = 0.f;
            {
                const int u = p, s = dir ? LSEQ - 1 - u : u, row = seqrow(b, s);
                float a[8], x[8]; unpack8(*(const u32x4*)(la + (size_t)row * 32), a); unpack8(*(const u32x4*)(bb + (size_t)row * 32), x);
#pragma unroll
                for (int c = 0; c < 8; ++c) a[c] = fast_exp2(a[c]);
                scan_group(a, x);
                if (w == 0) {
                    if (dir == 0) { u32x4 o; o.x = pk2(x[0], x[1]); o.y = pk2(x[2], x[3]); o.z = pk2(x[4], x[5]); o.w = pk2(x[6], x[7]); *(u32x4*)(HF + ((size_t)g * MPAD + row) * 32 + 8 * oct) = o; }
                    else { float hf[8], gy[8]; unpack8(*(const u32x4*)(HF + ((size_t)g * MPAD + row) * 32 + 8 * oct), hf); unpack8(*(const u32x4*)(GY + ((size_t)g * MPAD + row) * 32 + 8 * oct), gy);
                        u32x4 o; o.x = pk2((hf[0] + x[0]) * gy[0], (hf[1] + x[1]) * gy[1]); o.y = pk2((hf[2] + x[2]) * gy[2], (hf[3] + x[3]) * gy[3]);
                        o.z = pk2((hf[4] + x[4]) * gy[4], (hf[5] + x[5]) * gy[5]); o.w = pk2((hf[6] + x[6]) * gy[6], (hf[7] + x[7]) * gy[7]);
                        *(u32x4*)(Gout + (size_t)row * D + 32 * g + 8 * oct) = o; }
                }
#pragma unroll
                for (int c = 0; c < 8; ++c) S[c] = __shfl(x[c], (lane & 48) | 15);
            }
            u32x4 na[4], nb[4];
#pragma unroll
            for (int j = 0; j < 4; ++j) { const int u = 16 + 64 * w + 16 * j + p, s = dir ? LSEQ - 1 - u : u; const int rw = seqrow(b, s);
                na[j] = *(const u32x4*)(la + (size_t)rw * 32); nb[j] = *(const u32x4*)(bb + (size_t)rw * 32); }
            for (int r = 0; r < 8; ++r) {
                float Pw[4][8], Hw[4][8]; int rows[4];
                float Aw[8], Hc[8];
#pragma unroll
                for (int c = 0; c < 8; ++c) { Aw[c] = 1.f; Hc[c] = 0.f; }
                u32x4 ra[4], rb[4], rhf[4], rgy[4];
#pragma unroll
                for (int j = 0; j < 4; ++j) { const int u = 16 + 512 * r + 64 * w + 16 * j + p, s = dir ? LSEQ - 1 - u : u; rows[j] = seqrow(b, s); ra[j] = na[j]; rb[j] = nb[j]; }
                if (r < 7) {
#pragma unroll
                    for (int j = 0; j < 4; ++j) { const int u = 16 + 512 * (r + 1) + 64 * w + 16 * j + p, s = dir ? LSEQ - 1 - u : u; const int rw = seqrow(b, s);
                        na[j] = *(const u32x4*)(la + (size_t)rw * 32); nb[j] = *(const u32x4*)(bb + (size_t)rw * 32); } }
                if (dir == 1) {
#pragma unroll
                    for (int j = 0; j < 4; ++j) { const size_t go = ((size_t)g * MPAD + rows[j]) * 32 + 8 * oct; rhf[j] = *(const u32x4*)(HF + go); rgy[j] = *(const u32x4*)(GY + go); } }
#pragma unroll
                for (int j = 0; j < 4; ++j) {
                    float a[8], x[8]; unpack8(ra[j], a); unpack8(rb[j], x);
#pragma unroll
                    for (int c = 0; c < 8; ++c) a[c] = fast_exp2(a[c]);
                    scan_group(a, x);
#pragma unroll
                    for (int c = 0; c < 8; ++c) { Hw[j][c] = a[c] * Hc[c] + x[c]; Pw[j][c] = a[c] * Aw[c]; }
#pragma unroll
                    for (int c = 0; c < 8; ++c) { Aw[c] = __shfl(Pw[j][c], (lane & 48) | 15); Hc[c] = __shfl(Hw[j][c], (lane & 48) | 15); }
                }
                LAS float* ag = agg + (r & 1) * 512;
                if (p == 0) {
#pragma unroll
                    for (int c = 0; c < 8; ++c) { ag[(w * 32 + oct * 8 + c) * 2] = Aw[c]; ag[(w * 32 + oct * 8 + c) * 2 + 1] = Hc[c]; }
                }
                __syncthreads();
                float Sin[8];
#pragma unroll
                for (int c = 0; c < 8; ++c) Sin[c] = S[c];
#pragma unroll
                for (int ww = 0; ww < 8; ++ww) {
#pragma unroll
                    for (int c = 0; c < 8; ++c) { const float A = ag[(ww * 32 + oct * 8 + c) * 2], H = ag[(ww * 32 + oct * 8 + c) * 2 + 1];
                        if (ww == w) Sin[c] = S[c];
                        S[c] = A * S[c] + H; }
                }
#pragma unroll
                for (int j = 0; j < 4; ++j) {
                    float h[8];
#pragma unroll
                    for (int c = 0; c < 8; ++c) h[c] = Pw[j][c] * Sin[c] + Hw[j][c];
                    const size_t go = ((size_t)g * MPAD + rows[j]) * 32 + 8 * oct;
                    if (dir == 0) { u32x4 o; o.x = pk2(h[0], h[1]); o.y = pk2(h[2], h[3]); o.z = pk2(h[4], h[5]); o.w = pk2(h[6], h[7]); *(u32x4*)(HF + go) = o; }
                    else { float hf[8], gy[8]; unpack8(rhf[j], hf); unpack8(rgy[j], gy);
                        u32x4 o; o.x = pk2((hf[0] + h[0]) * gy[0], (hf[1] + h[1]) * gy[1]); o.y = pk2((hf[2] + h[2]) * gy[2], (hf[3] + h[3]) * gy[3]);
                        o.z = pk2((hf[4] + h[4]) * gy[4], (hf[5] + h[5]) * gy[5]); o.w = pk2((hf[6] + h[6]) * gy[6], (hf[7] + h[7]) * gy[7]);
                        *(u32x4*)(Gout + (size_t)rows[j] * D + 32 * g + 8 * oct) = o; }
                }
            }
            __syncthreads();
        }
    }
}

template <int K> __device__ __forceinline__ f32x4 mini_mma(const bf16_t* W, int ldw, const bf16_t* A, int lda, int lane) {
    const bf16_t* wp = W + (size_t)(lane & 15) * ldw + 8 * (lane >> 4); const bf16_t* ap = A + (size_t)(lane & 15) * lda + 8 * (lane >> 4);
    f32x4 acc = {0.f, 0.f, 0.f, 0.f};
    constexpr int KB = K < 512 ? K : 512, NS = KB / 32;
#pragma unroll 1
    for (int k0 = 0; k0 < K; k0 += KB) { bf16x8 wf[NS], af[NS];
#pragma unroll
        for (int i = 0; i < NS; ++i) { wf[i] = *(const bf16x8*)(wp + k0 + 32 * i); af[i] = *(const bf16x8*)(ap + k0 + 32 * i); }
#pragma unroll
        for (int i = 0; i < NS; ++i) acc = __builtin_amdgcn_mfma_f32_16x16x32_bf16(wf[i], af[i], acc, 0, 0, 0); }
    return acc;
}
__device__ __forceinline__ void mini_win(const Ctx& C) {
    PHASE_IDS
    const bf16_t* HB = (const bf16_t*)(C.ws + WS_HB); const bf16_t* WT = (const bf16_t*)(C.ws + WS_WIN); bf16_t* XR = (bf16_t*)(C.ws + WS_XR); bf16_t* GY = (bf16_t*)(C.ws + WS_GY);
    const int fr = lane & 15, fq = lane >> 4;
    for (int wt = C.gc * NWAVES + wave; wt < 8 * 128; wt += C.G * NWAVES) { const int rg = wt & 7, cb = wt >> 3, row = NGRID + 16 * rg + fr, c = 16 * cb + 4 * fq;
        const f32x4 a = mini_mma<1024>(WT + (size_t)(16 * cb) * 1024, 1024, HB + (size_t)(NGRID + 16 * rg) * 1024, 1024, lane);
        if (c < 1024) { u32x2 w; w.x = cvt_pk_bf16(a[0], a[1]); w.y = cvt_pk_bf16(a[2], a[3]); *(u32x2*)(XR + (size_t)row * D + c) = w; }
        else { const int yc = c - 1024; float o[4];
#pragma unroll
            for (int j = 0; j < 4; ++j) { const float v = a[j]; const float z = 1.5957691216f * (v + 0.044715f * v * v * v); o[j] = v * sigmoidf_(z); }
            u32x2 w; w.x = cvt_pk_bf16(o[0], o[1]); w.y = cvt_pk_bf16(o[2], o[3]); *(u32x2*)(GY + ((size_t)(yc >> 5) * MPAD + row) * 32 + (yc & 31)) = w; } }
}
__device__ __forceinline__ void mini_gate(const Ctx& C) {
    PHASE_IDS
    const bf16_t* XC = (const bf16_t*)(C.ws + WS_XC); const bf16_t* GT = (const bf16_t*)(C.ws + WS_GATE); bf16_t* LA = (bf16_t*)(C.ws + WS_LA); bf16_t* BB = (bf16_t*)(C.ws + WS_BB);
    const float* ba = C.in[I_BA]; const float* bx = C.in[I_BX]; const float* spl = (const float*)(C.ws + WS_CTL + CT_SPL);
    const int fr = lane & 15, fq = lane >> 4;
    for (int wt = C.gc * NWAVES + wave; wt < 8 * 2 * 64; wt += C.G * NWAVES) { const int rg = wt & 7, dir = (wt >> 3) & 1, chg = wt >> 4, ch0 = 16 * chg, nb = ch0 >> 8, half = (ch0 >> 7) & 1, jj0 = ch0 & 127;
        const bf16_t* A = XC + (size_t)(NGRID + 16 * rg) * 1024 + 256 * nb; const bf16_t* Wa = GT + ((size_t)nb * 1024 + 256 * (2 * dir + half) + jj0) * 256;
        const f32x4 za = mini_mma<256>(Wa, 256, A, 1024, lane), zx = mini_mma<256>(Wa + 128 * 256, 256, A, 1024, lane);
        const int row = NGRID + 16 * rg + fr, ch = ch0 + 4 * fq;
        const f32x4 cba = *(const f32x4*)(ba + dir * 1024 + ch), cbx = *(const f32x4*)(bx + dir * 1024 + ch), csp = *(const f32x4*)(spl + dir * 1024 + ch);
        const u32x2 xw = *(const u32x2*)(XC + (size_t)row * D + ch); const float xc[4] = {bflo(xw.x), bfhi(xw.x), bflo(xw.y), bfhi(xw.y)};
        float la[4], bb[4];
#pragma unroll
        for (int j = 0; j < 4; ++j) { const float l2 = -csp[j] * sigmoidf_(za[j] + cba[j]); const float a2 = fast_exp2(2.0f * l2);
            const float mult = (dir == 0 && fr == 0) ? 1.0f : __builtin_amdgcn_sqrtf(fmaxf(1.0f - a2, 0.0f)); la[j] = l2; bb[j] = mult * sigmoidf_(zx[j] + cbx[j]) * xc[j]; }
        const size_t o = (((size_t)dir * 32 + (ch >> 5)) * MPAD + row) * 32 + (ch & 31);
        u32x2 w; w.x = cvt_pk_bf16(la[0], la[1]); w.y = cvt_pk_bf16(la[2], la[3]); *(u32x2*)(LA + o) = w;
        w.x = cvt_pk_bf16(bb[0], bb[1]); w.y = cvt_pk_bf16(bb[2], bb[3]); *(u32x2*)(BB + o) = w; }
}
__device__ __forceinline__ void mini_lout(const Ctx& C) {
    PHASE_IDS
    const bf16_t* G = (const bf16_t*)(C.ws + WS_G); const bf16_t* WT = (const bf16_t*)(C.ws + WS_LOUT); bf16_t* PRE = (bf16_t*)(C.ws + WS_PRE); const float* meta = C.in[I_META];
    const int fr = lane & 15, fq = lane >> 4;
    for (int wt = C.gc * NWAVES + wave; wt < 8 * 64; wt += C.G * NWAVES) { const int rg = wt & 7, cb = wt >> 3, row = NGRID + 16 * rg + fr, c = 16 * cb + 4 * fq;
        const f32x4 a = mini_mma<1024>(WT + (size_t)(16 * cb) * 1024, 1024, G + (size_t)(NGRID + 16 * rg) * 1024, 1024, lane);
        const f32x4 r = *(const f32x4*)(meta + (size_t)fr * D + c);
        u32x2 w; w.x = cvt_pk_bf16(r[0] * DN_ALPHA + a[0], r[1] * DN_ALPHA + a[1]); w.y = cvt_pk_bf16(r[2] * DN_ALPHA + a[2], r[3] * DN_ALPHA + a[3]); *(u32x2*)(PRE + (size_t)row * D + c) = w; }
}
__device__ __forceinline__ void mini_kv(const Ctx& C) {
    PHASE_IDS
    const bf16_t* HB = (const bf16_t*)(C.ws + WS_HB); const bf16_t* WT = (const bf16_t*)(C.ws + WS_QKV); bf16_t* Kx = (bf16_t*)(C.ws + WS_K); bf16_t* VT = (bf16_t*)(C.ws + WS_VT);
    const int fr = lane & 15, fq = lane >> 4;
    for (int wt = C.gc * NWAVES + wave; wt < 2 * 8 * 64; wt += C.G * NWAVES) { const int rg = wt & 7, cb = (wt >> 3) & 63, isv = wt >> 9;
        const bf16_t* A = HB + (size_t)(NGRID + 16 * rg) * 1024;
        if (!isv) { const f32x4 a = mini_mma<1024>(WT + (size_t)(1024 + 16 * cb) * 1024, 1024, A, 1024, lane);
            u32x2 w; w.x = cvt_pk_bf16(a[0], a[1]); w.y = cvt_pk_bf16(a[2], a[3]); *(u32x2*)(Kx + (size_t)(NGRID + 16 * rg + fr) * D + 16 * cb + 4 * fq) = w; }
        else { const f32x4 a = mini_mma<1024>(A, 1024, WT + (size_t)(2048 + 16 * cb) * 1024, 1024, lane);
            u32x2 w; w.x = cvt_pk_bf16(a[0], a[1]); w.y = cvt_pk_bf16(a[2], a[3]); *(u32x2*)(VT + (size_t)(16 * cb + fr) * MPAD + NGRID + 16 * rg + 4 * fq) = w; } }
}

constexpr int RWT_PITCH = 516;
__device__ __forceinline__ void phase_lnr(const Ctx& C, int layer, int nrows) {
    PHASE_IDS
    const bf16_t* PRE = (const bf16_t*)(wsl + WS_PRE); bf16_t* HB = (bf16_t*)(wsl + WS_HB); unsigned char* HB8 = wsl + WS_HB8;
    const float* lg = C.in[I_LNMG] + layer * D; const float* lb = C.in[I_LNMB] + layer * D;
    const float* rw = C.in[I_RW] + (size_t)layer * D * NEXP; const float* rb = C.in[I_RB] + layer * NEXP;
    int* eid = (int*)(wsl + WS_CTL + CT_EID) + (size_t)layer * NTOK * 4; float* gatev = (float*)(wsl + WS_CTL + CT_GATEV) + (size_t)layer * NTOK * 4;
    unsigned* bc = (unsigned*)(wsl + WS_CTL + CT_BC) + ((size_t)layer * 256 + C.bid) * 32;
    LAS unsigned* RWt = (LAS unsigned*)C.lds; LAS unsigned* hist = (LAS unsigned*)(C.lds + 32 * RWT_PITCH * 4);
#pragma unroll
    for (int i = 0; i < 8; ++i) { const int idx = tid + NTHREADS * i, pc = idx >> 3, e4 = (idx & 7) * 4, ch = 2 * pc;
        const f32x4 w0 = *(const f32x4*)(rw + (size_t)ch * NEXP + e4), w1 = *(const f32x4*)(rw + (size_t)(ch + 1) * NEXP + e4);
        const int slot = 4 * ((ch & 511) >> 3) + 256 * (ch >> 9) + ((ch & 7) >> 1);
        RWt[(e4 + 0) * RWT_PITCH + slot] = pk2(w0[0], w1[0]); RWt[(e4 + 1) * RWT_PITCH + slot] = pk2(w0[1], w1[1]); RWt[(e4 + 2) * RWT_PITCH + slot] = pk2(w0[2], w1[2]); RWt[(e4 + 3) * RWT_PITCH + slot] = pk2(w0[3], w1[3]); }
    if (tid < 32) hist[tid] = 0u;
    __syncthreads();
    float gg[2][8], gb[2][8];
#pragma unroll
    for (int j = 0; j < 2; ++j) { const f32x4 a0 = *(const f32x4*)(lg + 8 * lane + 512 * j), a1 = *(const f32x4*)(lg + 8 * lane + 512 * j + 4), b0 = *(const f32x4*)(lb + 8 * lane + 512 * j), b1 = *(const f32x4*)(lb + 8 * lane + 512 * j + 4);
#pragma unroll
        for (int i = 0; i < 4; ++i) { gg[j][i] = a0[i]; gg[j][4 + i] = a1[i]; gb[j][i] = b0[i]; gb[j][4 + i] = b1[i]; } }
    const float rbias = rb[lane >> 1];
    const int gw = C.bid * NWAVES + wave, NGW = C.G * NWAVES;
    u32x4 nv[2];
    if (gw < nrows) {
#pragma unroll
        for (int j = 0; j < 2; ++j) nv[j] = *(const u32x4*)(PRE + (size_t)gw * D + 8 * lane + 512 * j); }
    for (int row = gw; row < nrows; row += NGW) {
        float v[2][8]; float s = 0.f; u32x4 hp[2];
#pragma unroll
        for (int j = 0; j < 2; ++j) { unpack8(nv[j], v[j]); s += ((v[j][0] + v[j][1]) + (v[j][2] + v[j][3])) + ((v[j][4] + v[j][5]) + (v[j][6] + v[j][7])); }
        if (row + NGW < nrows) {
#pragma unroll
            for (int j = 0; j < 2; ++j) nv[j] = *(const u32x4*)(PRE + (size_t)(row + NGW) * D + 8 * lane + 512 * j); }
        const float mean = wave_sum_dpp(s) * (1.0f / D); float q = 0.f;
#pragma unroll
        for (int j = 0; j < 2; ++j)
#pragma unroll
            for (int i = 0; i < 8; ++i) { v[j][i] -= mean; q += v[j][i] * v[j][i]; }
        const float rstd = __builtin_amdgcn_rsqf(wave_sum_dpp(q) * (1.0f / D) + LN_EPS);
#pragma unroll
        for (int j = 0; j < 2; ++j) {
#pragma unroll
            for (int i = 0; i < 8; ++i) v[j][i] = v[j][i] * rstd * gg[j][i] + gb[j][i];
            u32x4 w; w.x = pk2(v[j][0], v[j][1]); w.y = pk2(v[j][2], v[j][3]); w.z = pk2(v[j][4], v[j][5]); w.w = pk2(v[j][6], v[j][7]);
            *(u32x4*)(HB + (size_t)row * D + 8 * lane + 512 * j) = w; hp[j] = w;
            u32x2 w8; w8.x = pk4_fp8(v[j][0], v[j][1], v[j][2], v[j][3]); w8.y = pk4_fp8(v[j][4], v[j][5], v[j][6], v[j][7]);
            *(u32x2*)(HB8 + (size_t)row * D + 8 * lane + 512 * j) = w8; }
        float pl[32];
#pragma unroll
        for (int e0 = 0; e0 < 32; e0 += 8) {
            u32x4 wv[8][2];
#pragma unroll
            for (int ee = 0; ee < 8; ++ee)
#pragma unroll
                for (int j = 0; j < 2; ++j) wv[ee][j] = *(const LAS u32x4*)(RWt + (e0 + ee) * RWT_PITCH + 4 * lane + 256 * j);
            __builtin_amdgcn_sched_barrier(0);
#pragma unroll
            for (int ee = 0; ee < 8; ++ee) { float a = 0.f;
#pragma unroll
                for (int j = 0; j < 2; ++j) { a = dot2_bf16(hp[j].x, wv[ee][j].x, a);
                    a = dot2_bf16(hp[j].y, wv[ee][j].y, a);
                    a = dot2_bf16(hp[j].z, wv[ee][j].z, a);
                    a = dot2_bf16(hp[j].w, wv[ee][j].w, a); }
                pl[e0 + ee] = a; }
        }
        float q16[16], q8[8], q4[4], q2[2], q1;
        { const bool hi = (lane & 32) != 0;
#pragma unroll
          for (int e = 0; e < 16; ++e) { const float mine = hi ? pl[16 + e] : pl[e], other = hi ? pl[e] : pl[16 + e]; q16[e] = mine + __shfl_xor(other, 32); } }
        { const bool hi = (lane & 16) != 0;
#pragma unroll
          for (int e = 0; e < 8; ++e) { const float mine = hi ? q16[8 + e] : q16[e], other = hi ? q16[e] : q16[8 + e]; q8[e] = mine + __shfl_xor(other, 16); } }
        { const bool hi = (lane & 8) != 0;
#pragma unroll
          for (int e = 0; e < 4; ++e) { const float mine = hi ? q8[4 + e] : q8[e], other = hi ? q8[e] : q8[4 + e]; q4[e] = mine + dpp_movf<0x128>(other); } }
        { const bool hi = (lane & 4) != 0;
#pragma unroll
          for (int e = 0; e < 2; ++e) { const float mine = hi ? q4[2 + e] : q4[e], other = hi ? q4[e] : q4[2 + e]; q2[e] = mine + __shfl_xor(other, 4); } }
        { const bool hi = (lane & 2) != 0; const float mine = hi ? q2[1] : q2[0], other = hi ? q2[0] : q2[1]; q1 = mine + dpp_movf<0x4E>(other); }
        q1 += dpp_movf<0xB1>(q1);
        float lv = q1 + rbias; lv = (lv == lv) ? lv : -3.0e38f;
        const int le = lane >> 1;
        int rank = 0;
#pragma unroll
        for (int j = 0; j < 32; ++j) { const float lj = readlane_f(lv, 2 * j); rank += (lj > lv || (lj == lv && j < le)) ? 1 : 0; }
        const unsigned long long m0 = __ballot(rank == 0);
        const float mxl = readlane_f(lv, (int)__builtin_ctzll(m0));
        const float pe = rank < 4 ? __expf(lv - mxl) : 0.f;
        const float den = wave_sum_dpp(pe) * 0.5f;
        if (rank < 4 && (lane & 1) == 0) { eid[(size_t)row * 4 + rank] = le; gatev[(size_t)row * 4 + rank] = pe / den;
            __hip_atomic_fetch_add(&hist[le], 1u, __ATOMIC_RELAXED, __HIP_MEMORY_SCOPE_WORKGROUP); }
    }
    __syncthreads();
    if (tid < 32) bc[tid] = hist[tid];
}

__device__ __forceinline__ void phase_pos(const Ctx& C, int layer, int nrows) {
    PHASE_IDS
    const unsigned* bcAll = (const unsigned*)(wsl + WS_CTL + CT_BC) + (size_t)layer * 256 * 32;
    const int* eid = (const int*)(wsl + WS_CTL + CT_EID) + (size_t)layer * NTOK * 4; int* posv = (int*)(wsl + WS_CTL + CT_POS) + (size_t)layer * NTOK * 4;
    int* texp = (int*)(wsl + WS_CTL + CT_TEXP) + layer * 1024;
    int* tokoff = (int*)(wsl + WS_TOK) + (size_t)layer * (1 * MiB / 4);
    LAS unsigned* partT = (LAS unsigned*)C.lds; LAS unsigned* partP = partT + 512; LAS unsigned* tot = partP + 512; LAS unsigned* cnt = tot + 32;
    { const int e = tid & 31, part = tid >> 5; unsigned t = 0, pr = 0;
      unsigned vv[16];
#pragma unroll
      for (int i = 0; i < 16; ++i) { const int bq = part + 16 * i; vv[i] = bq < C.G ? bcAll[(size_t)bq * 32 + e] : 0u; }
#pragma unroll
      for (int i = 0; i < 16; ++i) { const int bq = part + 16 * i; t += vv[i]; if (bq < C.bid) pr += vv[i]; }
      partT[part * 32 + e] = t; partP[part * 32 + e] = pr; }
    __syncthreads();
    if (tid < 32) { unsigned t = 0, pr = 0; for (int i = 0; i < 16; ++i) { t += partT[i * 32 + tid]; pr += partP[i * 32 + tid]; } tot[tid] = t; cnt[tid] = pr; }
    __syncthreads();
    if (tid < 32) { unsigned off = 0; for (int e = 0; e < tid; ++e) off += (tot[e] + 255u) & ~255u;
        const unsigned mine = (tot[tid] + 255u) & ~255u;
        if (C.bid == 0) { for (unsigned t = off >> 8; t < ((off + mine) >> 8); ++t) texp[t] = tid; if (tid == 31) texp[1023] = (int)((off + mine) >> 8);
            for (unsigned p = off + tot[tid]; p < off + mine; ++p) tokoff[p] = 0; }
        cnt[tid] += off; }
    __syncthreads();
    const int gw = C.bid * NWAVES + wave, NGW = C.G * NWAVES;
    for (int row = gw; row < nrows; row += NGW) {
        int pos = 0;
        if (lane < 4) { const int e = eid[(size_t)row * 4 + lane]; pos = (int)__hip_atomic_fetch_add(&cnt[e], 1u, __ATOMIC_RELAXED, __HIP_MEMORY_SCOPE_WORKGROUP); posv[(size_t)row * 4 + lane] = pos; }
        if (lane < 4) tokoff[pos] = row * 1024;
    }
}

__device__ __forceinline__ void phase_combine(const Ctx& C, int layer, int nrows, bool final_out) {
    PHASE_IDS
    bf16_t* HB = (bf16_t*)(wsl + WS_HB); unsigned char* HB8 = wsl + WS_HB8; const bf16_t* YS = (const bf16_t*)(wsl + WS_YS);
    const float* lg = C.in[I_LNFG] + layer * D; const float* lb = C.in[I_LNFB] + layer * D;
    const float* gatev = (const float*)(wsl + WS_CTL + CT_GATEV) + (size_t)layer * NTOK * 4; const int* posv = (const int*)(wsl + WS_CTL + CT_POS) + (size_t)layer * NTOK * 4;
    float gg[2][8], gb[2][8];
#pragma unroll
    for (int j = 0; j < 2; ++j) { const f32x4 a0 = *(const f32x4*)(lg + 8 * lane + 512 * j), a1 = *(const f32x4*)(lg + 8 * lane + 512 * j + 4), b0 = *(const f32x4*)(lb + 8 * lane + 512 * j), b1 = *(const f32x4*)(lb + 8 * lane + 512 * j + 4);
#pragma unroll
        for (int i = 0; i < 4; ++i) { gg[j][i] = a0[i]; gg[j][4 + i] = a1[i]; gb[j][i] = b0[i]; gb[j][4 + i] = b1[i]; } }
    const int gw = C.bid * NWAVES + wave, NGW = C.G * NWAVES;
    f32x4 g1 = {0.f, 0.f, 0.f, 0.f}, g2 = g1; int p1[4] = {0, 0, 0, 0}, p2[4] = {0, 0, 0, 0};
    u32x4 hwn[2], ywn[4][2];
#define CB_ROUTE(row_, gq, pq) do { gq = *(const f32x4*)(gatev + (size_t)(row_) * 4); const u32x4 _pp = *(const u32x4*)(posv + (size_t)(row_) * 4); pq[0] = (int)_pp.x; pq[1] = (int)_pp.y; pq[2] = (int)_pp.z; pq[3] = (int)_pp.w; } while (0)
#define CB_DATA(row_, pq) do { _Pragma("unroll") for (int j = 0; j < 2; ++j) { hwn[j] = *(const u32x4*)(HB + (size_t)(row_) * D + 8 * lane + 512 * j); \
            _Pragma("unroll") for (int k = 0; k < 4; ++k) ywn[k][j] = *(const u32x4*)(YS + (size_t)pq[k] * D + 8 * lane + 512 * j); } } while (0)
    if (gw < nrows) { CB_ROUTE(gw, g1, p1); CB_DATA(gw, p1); }
    if (gw + NGW < nrows) CB_ROUTE(gw + NGW, g2, p2);
    for (int row = gw; row < nrows; row += NGW) {
        const f32x4 gk4 = g1; u32x4 hw[2], yw[4][2];
#pragma unroll
        for (int j = 0; j < 2; ++j) { hw[j] = hwn[j];
#pragma unroll
            for (int k = 0; k < 4; ++k) yw[k][j] = ywn[k][j]; }
        g1 = g2;
#pragma unroll
        for (int k = 0; k < 4; ++k) p1[k] = p2[k];
        if (row + NGW < nrows) CB_DATA(row + NGW, p1);
        if (row + 2 * NGW < nrows) CB_ROUTE(row + 2 * NGW, g2, p2);
        float v[2][8]; float s = 0.f;
#pragma unroll
        for (int j = 0; j < 2; ++j) { float h[8]; unpack8(hw[j], h);
#pragma unroll
            for (int i = 0; i < 8; ++i) v[j][i] = h[i] * DN_ALPHA;
#pragma unroll
            for (int k = 0; k < 4; ++k) { float y[8]; unpack8(yw[k][j], y);
#pragma unroll
                for (int i = 0; i < 8; ++i) v[j][i] += gk4[k] * y[i]; }
#pragma unroll
            for (int i = 0; i < 8; ++i) s += v[j][i]; }
        const float mean = wave_sum_dpp(s) * (1.0f / D); float q = 0.f;
#pragma unroll
        for (int j = 0; j < 2; ++j)
#pragma unroll
            for (int i = 0; i < 8; ++i) { v[j][i] -= mean; q += v[j][i] * v[j][i]; }
        const float rstd = __builtin_amdgcn_rsqf(wave_sum_dpp(q) * (1.0f / D) + LN_EPS);
#pragma unroll
        for (int j = 0; j < 2; ++j) {
#pragma unroll
            for (int i = 0; i < 8; ++i) v[j][i] = v[j][i] * rstd * gg[j][i] + gb[j][i];
            if (final_out) { *(f32x4*)(C.out + (size_t)row * D + 8 * lane + 512 * j) = (f32x4){v[j][0], v[j][1], v[j][2], v[j][3]}; *(f32x4*)(C.out + (size_t)row * D + 8 * lane + 512 * j + 4) = (f32x4){v[j][4], v[j][5], v[j][6], v[j][7]}; }
            else { u32x4 w; w.x = pk2(v[j][0], v[j][1]); w.y = pk2(v[j][2], v[j][3]); w.z = pk2(v[j][4], v[j][5]); w.w = pk2(v[j][6], v[j][7]); *(u32x4*)(HB + (size_t)row * D + 8 * lane + 512 * j) = w;
                u32x2 w8; w8.x = pk4_fp8(v[j][0], v[j][1], v[j][2], v[j][3]); w8.y = pk4_fp8(v[j][4], v[j][5], v[j][6], v[j][7]); *(u32x2*)(HB8 + (size_t)row * D + 8 * lane + 512 * j) = w8; } }
    }
#undef CB_ROUTE
#undef CB_DATA
}

constexpr int AT_KS = 0, AT_VTS = 73728, AT_VPITCH = 1168, AT_KM = AT_VTS + 64 * AT_VPITCH, AT_VTM = AT_KM + 2048, AT_RPB = AT_VTM + 2048, AT_MB = AT_RPB + 1920, AT_END = AT_MB + 64;
static_assert(AT_END <= LDS_BYTES, "attention LDS map");
__device__ __forceinline__ void phase_attn(const Ctx& C) {
    PHASE_IDS
    bf16_t* O = (bf16_t*)(wsl + WS_O);
    const float* rpb = C.in[I_RPB]; const float* mbias = C.in[I_MBIAS];
    LAS unsigned char* lds = C.lds;
    const int w = wave, lq = lane & 15, g = lane >> 4;
    const int qr = w >> 2, qg = w & 3, c0 = 16 * qg, kcb = qg == 0 ? 0 : (qg == 1 ? 8 : (qg == 2 ? 24 : 32));
    int bidx[2][4];
    { const int c_ = c0 + lq, cs_ = min(max(c_ - 8, 0), 48);
#pragma unroll
      for (int blk = 0; blk < 2; ++blk)
#pragma unroll
          for (int e = 0; e < 4; ++e) { const int kc = kcb + 16 * blk + 4 * g + e; bidx[blk][e] = ((kc >= cs_ && kc < cs_ + 16) ? (kc - c_ + 15) : 31) * 4; } }
    const __amdgpu_buffer_rsrc_t rsrc = __builtin_amdgcn_make_buffer_rsrc((void*)wsl, 0, 0xFFFFFFFF, 0x00020000);
    const int kvoff = (((tid >> 3) & 63) * D + 8 * (tid & 7)) * 2, vvoff = ((tid >> 3) * MPAD + 8 * (tid & 7)) * 2;
    const int qvoff = (lq * D + 8 * g) * 2;
    const int mvoff = tid < 128 ? ((tid >> 3) * D + 8 * (tid & 7)) * 2 : (((tid - 128) >> 1) * MPAD + 8 * ((tid - 128) & 1)) * 2;
    const int klds = AT_KS + ((((tid >> 3) & 63)) * 8 + ((tid & 7) ^ ((tid >> 3) & 7))) * 16;
    const int vlds = AT_VTS + (tid >> 3) * AT_VPITCH + (tid & 7) * 16;
    for (int su = (C.G == 256 ? C.gc : C.bid); su < 256; su += C.G) {
        int bh, strip; if (C.G == 256) { bh = (su & 7) * 16 + (su >> 4); strip = (su >> 3) & 1; } else { bh = su >> 1; strip = su & 1; }
        const int b = bh >> 4, h = bh & 15, rp0 = strip * 16;
        const unsigned kbase = (unsigned)WS_K + (unsigned)((b * SEQ) * D + 64 * h) * 2u, vbase = (unsigned)WS_VT + (unsigned)((64 * h) * MPAD + b * SEQ) * 2u;
        const unsigned qbase = (unsigned)WS_Q + (unsigned)((b * SEQ + qr * 64 + c0) * D + 64 * h) * 2u;
        int R0 = min(max(2 * rp0 - 4, 0), 55);
        __syncthreads();
        {
            u32x4 kreg[9], vreg[9];
#pragma unroll
            for (int i = 0; i < 9; ++i) { kreg[i] = __builtin_amdgcn_raw_buffer_load_b128(rsrc, kvoff, (int)(kbase + (unsigned)(R0 + i) * 64u * D * 2u), 0);
                vreg[i] = __builtin_amdgcn_raw_buffer_load_b128(rsrc, vvoff, (int)(vbase + (unsigned)(R0 + i) * 128u), 0); }
            u32x4 mreg = {0u, 0u, 0u, 0u};
            if (tid < 256) mreg = __builtin_amdgcn_raw_buffer_load_b128(rsrc, mvoff, (int)(tid < 128 ? (unsigned)WS_K + (unsigned)((NGRID + 16 * b) * D + 64 * h) * 2u : (unsigned)WS_VT + (unsigned)((64 * h) * MPAD + NGRID + 16 * b) * 2u), 0);
            float rpreg = 0.f, mbreg = 0.f;
            if (tid < 480) rpreg = (tid & 31) < 31 ? rpb[h * 465 + (tid >> 5) * 31 + (tid & 31)] * 1.44269504089f : -1.0e30f;
            if (tid < 16) mbreg = mbias[h * 16 + tid] * 1.44269504089f;
#pragma unroll
            for (int i = 0; i < 9; ++i) { const int slot = (R0 + i) % 9; *(LAS u32x4*)(lds + klds + slot * 8192) = kreg[i]; *(LAS u32x4*)(lds + vlds + slot * 128) = vreg[i]; }
            if (tid < 128) { const int m = tid >> 3, ch = tid & 7; *(LAS u32x4*)(lds + AT_KM + (m * 8 + (ch ^ (m & 7))) * 16) = mreg; }
            else if (tid < 256) { const int i = tid - 128, d = i >> 1, hf = i & 1; *(LAS u32x4*)(lds + AT_VTM + d * 32 + hf * 16) = mreg; }
            if (tid < 480) ((LAS float*)(lds + AT_RPB))[tid] = rpreg;
            if (tid < 16) ((LAS float*)(lds + AT_MB))[tid] = mbreg;
        }
        u32x4 qreg[2];
        qreg[0] = __builtin_amdgcn_raw_buffer_load_b128(rsrc, qvoff, (int)(qbase + (unsigned)(2 * rp0) * 64u * D * 2u), 0);
        qreg[1] = __builtin_amdgcn_raw_buffer_load_b128(rsrc, qvoff, (int)(qbase + (unsigned)(2 * rp0) * 64u * D * 2u + 64u), 0);
        __syncthreads();
        for (int rp = rp0; rp < rp0 + 16; ++rp) {
            const int R0n = rp + 1 < rp0 + 16 ? min(max(2 * (rp + 1) - 4, 0), 55) : R0, nnew = R0n - R0;
            const u32x4 qcur[2] = {qreg[0], qreg[1]};
            u32x4 nk[2], nv[2];
#pragma unroll
            for (int i = 0; i < 2; ++i) if (i < nnew) { nk[i] = __builtin_amdgcn_raw_buffer_load_b128(rsrc, kvoff, (int)(kbase + (unsigned)(R0 + 9 + i) * 64u * D * 2u), 0);
                nv[i] = __builtin_amdgcn_raw_buffer_load_b128(rsrc, vvoff, (int)(vbase + (unsigned)(R0 + 9 + i) * 128u), 0); }
            if (rp + 1 < rp0 + 16) { qreg[0] = __builtin_amdgcn_raw_buffer_load_b128(rsrc, qvoff, (int)(qbase + (unsigned)(2 * rp + 2) * 64u * D * 2u), 0);
                qreg[1] = __builtin_amdgcn_raw_buffer_load_b128(rsrc, qvoff, (int)(qbase + (unsigned)(2 * rp + 2) * 64u * D * 2u + 64u), 0); }
            const int r = 2 * rp + qr;
            const int rs = min(max(r - 4, 0), 56), s0 = rs % 9;
            const size_t qrow = (size_t)(b * SEQ + r * 64 + c0 + lq);
            bf16x8 qf[2]; qf[0] = __builtin_bit_cast(bf16x8, qcur[0]); qf[1] = __builtin_bit_cast(bf16x8, qcur[1]);
            f32x4 sc[8][2], sm;
#pragma unroll
            for (int j = 0; j < 8; ++j) { const int slot = s0 + j - (s0 + j >= 9 ? 9 : 0);
#pragma unroll
                for (int blk = 0; blk < 2; ++blk) { f32x4 a = {0.f, 0.f, 0.f, 0.f}; const int kc = kcb + 16 * blk + lq;
#pragma unroll
                    for (int ks = 0; ks < 2; ++ks) { const bf16x8 kf = *(const LAS bf16x8*)(lds + AT_KS + slot * 8192 + (kc * 8 + ((4 * ks + g) ^ (kc & 7))) * 16);
                        a = __builtin_amdgcn_mfma_f32_16x16x32_bf16(kf, qf[ks], a, 0, 0, 0); }
                    sc[j][blk] = a; } }
            { f32x4 a = {0.f, 0.f, 0.f, 0.f};
#pragma unroll
              for (int ks = 0; ks < 2; ++ks) { const bf16x8 kf = *(const LAS bf16x8*)(lds + AT_KM + (lq * 8 + ((4 * ks + g) ^ (lq & 7))) * 16);
                  a = __builtin_amdgcn_mfma_f32_16x16x32_bf16(kf, qf[ks], a, 0, 0, 0); }
              sm = a; }
            const LAS unsigned char* RProw = lds + AT_RPB + (rs - r + 7) * 128; const LAS float* MB = (const LAS float*)(lds + AT_MB);
            float mx = -3.0e38f;
#pragma unroll
            for (int j = 0; j < 8; ++j)
#pragma unroll
                for (int blk = 0; blk < 2; ++blk)
#pragma unroll
                    for (int e = 0; e < 4; ++e) { const float sv = sc[j][blk][e] + *(const LAS float*)(RProw + j * 128 + bidx[blk][e]); sc[j][blk][e] = sv; mx = fmaxf(mx, sv); }
#pragma unroll
            for (int e = 0; e < 4; ++e) { sm[e] += MB[4 * g + e]; mx = fmaxf(mx, sm[e]); }
            mx = fmaxf(mx, __shfl_xor(mx, 16)); mx = fmaxf(mx, __shfl_xor(mx, 32));
            float sum = 0.f;
#pragma unroll
            for (int j = 0; j < 8; ++j)
#pragma unroll
                for (int blk = 0; blk < 2; ++blk)
#pragma unroll
                    for (int e = 0; e < 4; ++e) { const float pv = fast_exp2(sc[j][blk][e] - mx); sc[j][blk][e] = pv; sum += pv; }
#pragma unroll
            for (int e = 0; e < 4; ++e) { const float pv = fast_exp2(sm[e] - mx); sm[e] = pv; sum += pv; }
            sum += __shfl_xor(sum, 16); sum += __shfl_xor(sum, 32);
            f32x4 o[4];
#pragma unroll
            for (int db = 0; db < 4; ++db) o[db] = (f32x4){0.f, 0.f, 0.f, 0.f};
#pragma unroll
            for (int j = 0; j < 8; ++j) { const int slot = s0 + j - (s0 + j >= 9 ? 9 : 0);
                u32x4 pw; pw.x = cvt_pk_bf16(sc[j][0][0], sc[j][0][1]); pw.y = cvt_pk_bf16(sc[j][0][2], sc[j][0][3]); pw.z = cvt_pk_bf16(sc[j][1][0], sc[j][1][1]); pw.w = cvt_pk_bf16(sc[j][1][2], sc[j][1][3]);
                const bf16x8 pb = __builtin_bit_cast(bf16x8, pw);
#pragma unroll
                for (int db = 0; db < 4; ++db) { const int d = 16 * db + lq; const LAS unsigned char* vp = lds + AT_VTS + d * AT_VPITCH + (slot * 64 + kcb + 4 * g) * 2;
                    const u32x2 lo = *(const LAS u32x2*)vp, hi = *(const LAS u32x2*)(vp + 32);
                    u32x4 aw; aw.x = lo.x; aw.y = lo.y; aw.z = hi.x; aw.w = hi.y;
                    o[db] = __builtin_amdgcn_mfma_f32_16x16x32_bf16(__builtin_bit_cast(bf16x8, aw), pb, o[db], 0, 0, 0); }
            }
            { u32x4 pw; pw.x = cvt_pk_bf16(sm[0], sm[1]); pw.y = cvt_pk_bf16(sm[2], sm[3]); pw.z = 0u; pw.w = 0u; const bf16x8 pb = __builtin_bit_cast(bf16x8, pw);
#pragma unroll
              for (int db = 0; db < 4; ++db) { const int d = 16 * db + lq; const u32x2 lo = *(const LAS u32x2*)(lds + AT_VTM + d * 32 + 8 * g);
                  u32x4 aw; aw.x = lo.x; aw.y = lo.y; aw.z = 0u; aw.w = 0u;
                  o[db] = __builtin_amdgcn_mfma_f32_16x16x32_bf16(__builtin_bit_cast(bf16x8, aw), pb, o[db], 0, 0, 0); } }
            const float inv = 1.0f / sum;
#pragma unroll
            for (int db = 0; db < 4; ++db) { u32x2 ow; ow.x = cvt_pk_bf16(o[db][0] * inv, o[db][1] * inv); ow.y = cvt_pk_bf16(o[db][2] * inv, o[db][3] * inv);
                *(u32x2*)(O + qrow * D + 64 * h + 16 * db + 4 * g) = ow; }
            __syncthreads();
#pragma unroll
            for (int i = 0; i < 2; ++i) if (i < nnew) { const int slot = (R0 + 9 + i) % 9; *(LAS u32x4*)(lds + klds + slot * 8192) = nk[i]; *(LAS u32x4*)(lds + vlds + slot * 128) = nv[i]; }
            R0 = R0n;
            __syncthreads();
        }
    }
}
#define XB_TMO      128
#define XB_XCNT(j)  (256  + 64 * (j))
#define XB_XSUB(j)  (1280 + 64 * (j))
#define XB_XGEN(j)  (2304 + 64 * (j))
#define XB_TOP      3328
#define XB_TOPGEN   3392
#define XCD_BAR_WORDS 3456
#define XB_SPIN_CAP (1u << 22)
__device__ __forceinline__ unsigned xb_ld(unsigned* p)              { return __hip_atomic_load(p, __ATOMIC_RELAXED, __HIP_MEMORY_SCOPE_AGENT); }
__device__ __forceinline__ unsigned xb_add(unsigned* p, unsigned v) { return __hip_atomic_fetch_add(p, v, __ATOMIC_RELAXED, __HIP_MEMORY_SCOPE_AGENT); }
__device__ __forceinline__ unsigned xb_xcc_id() { return (unsigned)__builtin_amdgcn_s_getreg((3 << 11) | 20) & 0xFu; }
#define XB_SPIN(cond, bar) do { unsigned _sp = 0; while (cond) { __builtin_amdgcn_s_sleep(1); \
    if ((++_sp & 255u) == 0u) { if (xb_ld(&(bar)[XB_TMO])) break; if (_sp > XB_SPIN_CAP) { atomicAdd(&(bar)[XB_TMO], 1u); break; } } } } while (0)
struct XcdBarrier { unsigned* bar; unsigned x; volatile LAS unsigned* st; };
__device__ __forceinline__ XcdBarrier xcd_barrier_post(unsigned* bar, volatile LAS unsigned* st) {
    XcdBarrier b; b.bar = bar; b.x = xb_xcc_id(); b.st = st;
    if (threadIdx.x == 0) st[2] = xb_add(&bar[XB_XCNT(b.x)], 1u);
    return b;
}
__device__ __forceinline__ void xcd_barrier_complete(unsigned* bar, unsigned x, unsigned& nloc, unsigned& nx) {
    const unsigned G = gridDim.x * gridDim.y * gridDim.z;
    unsigned sum, cnt, mine, sp = 0u;
    for (;;) {
        sum = 0u; cnt = 0u; mine = 0u;
#pragma unroll
        for (unsigned j = 0; j < 16; ++j) { const unsigned c = xb_ld(&bar[XB_XCNT(j)]); sum += c; cnt += (c > 0u) ? 1u : 0u; mine = (j == x) ? c : mine; }
        if (sum == G) break;
        __builtin_amdgcn_s_sleep(1);
        if ((++sp & 255u) == 0u) { if (xb_ld(&bar[XB_TMO])) break; if (sp > XB_SPIN_CAP) { atomicAdd(&bar[XB_TMO], 1u); break; } }
    }
    nloc = mine > 0u ? mine : 1u; nx = cnt > 0u ? cnt : 1u;
}
__device__ __forceinline__ void xcd_barrier(const XcdBarrier& b) {
    asm volatile("s_waitcnt vmcnt(0)" ::: "memory");
    __syncthreads();
    if (threadIdx.x == 0) {
        unsigned* bar = b.bar;
        __builtin_amdgcn_s_waitcnt(0);
        unsigned nloc = b.st[0], nx = b.st[1];
        if (nloc == 0u) { xcd_barrier_complete(bar, b.x, nloc, nx); b.st[0] = nloc; b.st[1] = nx; }
        const unsigned old = xb_add(&bar[XB_XSUB(b.x)], 1u);
        const unsigned gen = old / nloc;
        if (old + 1u == (gen + 1u) * nloc) {
            __builtin_amdgcn_fence(__ATOMIC_RELEASE, "agent");
            asm volatile("s_waitcnt vmcnt(0)" ::: "memory");
            const unsigned og = xb_add(&bar[XB_TOP], 1u);
            const unsigned tg = og / nx;
            if (og + 1u == (tg + 1u) * nx) xb_add(&bar[XB_TOPGEN], 1u);
            else XB_SPIN(xb_ld(&bar[XB_TOPGEN]) == tg, bar);
            __builtin_amdgcn_fence(__ATOMIC_ACQUIRE, "agent");
            xb_add(&bar[XB_XGEN(b.x)], 1u);
            asm volatile("s_waitcnt vmcnt(0)" ::: "memory");
        } else {
            XB_SPIN(xb_ld(&bar[XB_XGEN(b.x)]) == gen, bar);
            __builtin_amdgcn_fence(__ATOMIC_ACQUIRE, "agent");
            asm volatile("s_waitcnt vmcnt(0)" ::: "memory");
        }
    }
    __syncthreads();
}
__device__ __forceinline__ int moe_prep(const Ctx& C, const int* texp) {
    LAS int* t = (LAS int*)(C.lds + pg8::TEXP_OFF); const int tid = fresh_tid();
    const int a = texp[tid], b = texp[tid + 512];
    t[tid] = a; t[tid + 512] = b;
    __syncthreads();
    return __builtin_amdgcn_readfirstlane(t[1023]);
}
constexpr size_t CT_BAR = 131072;
constexpr int LDS_BARST = LDS_BYTES - 64;

constexpr int N_PHASES = 20;
__global__ void __launch_bounds__(NTHREADS, 2) hybrid_fwd(Params P) {
    extern __shared__ __attribute__((aligned(16))) unsigned char smem[];
    cg::grid_group grid = cg::this_grid();
    Ctx C; C.lds = (LAS unsigned char*)smem; C.G = gridDim.x; C.bid = blockIdx.x;
    C.ws = P.ws; C.in = P.in; C.out = P.out;
    unsigned char* const ws0 = P.ws;
#define ws fresh_ws(ws0)
    const int lo = P.ph_lo, hi = P.ph_hi;
#ifndef PH_MASK
#define PH_MASK 0xFFFFFFFFu
#endif
#define IN(k) (((PH_MASK >> (k)) & 1u) && lo <= (k) && (k) < hi)
#ifndef REPEAT_MASK
#define REPEAT_MASK 0u
#endif
#define REPS(k) ((((unsigned)REPEAT_MASK >> (k)) & 1u) ? 2 : 1)
#ifndef N_CG_SYNCS
#define N_CG_SYNCS 0
#endif
#define SEAM(k) do { if (IN(k) && IN((k) + 1)) { if ((k) < N_CG_SYNCS) grid.sync(); else xcd_barrier(bar); } } while (0)
    if (threadIdx.x < 16) ((LAS unsigned*)(smem + LDS_BARST))[threadIdx.x] = 0u;
    __syncthreads();
    const XcdBarrier bar = xcd_barrier_post((unsigned*)(ws + WS_CTL + CT_BAR), (volatile LAS unsigned*)(smem + LDS_BARST));
    C.gc = C.bid;
    #define PH_BODY_0 phase_convert(C);
    if (IN(0)) { PH_BODY_0 } if (REPS(0) > 1 && IN(0)) { xcd_barrier(bar); PH_BODY_0 }
    SEAM(0);
    if (IN(0) && IN(1)) {
        unsigned* barw = (unsigned*)(ws + WS_CTL + CT_BAR); bool eq = (C.G % 8) == 0;
#pragma unroll
        for (int j = 0; j < 16; ++j) { const unsigned cj = xb_ld(&barw[XB_XCNT(j)]); eq = eq && (cj == (j < 8 ? (unsigned)(C.G / 8) : 0u)); }
        const unsigned rank = ((volatile LAS unsigned*)(smem + LDS_BARST))[2];
        C.gc = __builtin_amdgcn_readfirstlane(eq ? (int)(rank * 8u + bar.x) : C.bid);
    }
    #define PH_BODY_1 { DenseSched S{(unsigned)WS_HB, (unsigned)WS_WIN, 1024, 1024, 128, 8, C.G, C.gc}; EpiWin E{(bf16_t*)(ws + WS_XR), (bf16_t*)(ws + WS_GY)}; \
        pg8::gemm_phase<false, false>(C.lds, ws, 1024, 1024, 1024, S, E); mini_win(C); }
    if (IN(1)) { PH_BODY_1 } if (REPS(1) > 1 && IN(1)) { xcd_barrier(bar); PH_BODY_1 }
    SEAM(1);
    #define PH_BODY_2 phase_conv(C);
    if (IN(2)) { PH_BODY_2 } if (REPS(2) > 1 && IN(2)) { xcd_barrier(bar); PH_BODY_2 }
    SEAM(2);
    #define PH_BODY_3 { GateSched S{(unsigned)WS_XC, (unsigned)WS_GATE, 128, C.G, C.gc}; \
        EpiGate E{(const bf16_t*)(ws + WS_XC), (bf16_t*)(ws + WS_LA), (bf16_t*)(ws + WS_BB), (const float*)(ws + WS_CTL + CT_SPL), (unsigned)WS_GBIAS}; \
        pg8::gemm_phase<false, false>(C.lds, ws, 256, 1024, 256, S, E); mini_gate(C); }
    if (IN(3)) { PH_BODY_3 } if (REPS(3) > 1 && IN(3)) { xcd_barrier(bar); PH_BODY_3 }
    SEAM(3);
    #define PH_BODY_4 phase_scan(C);
    if (IN(4)) { PH_BODY_4 } if (REPS(4) > 1 && IN(4)) { xcd_barrier(bar); PH_BODY_4 }
    SEAM(4);
    #define PH_BODY_5 { DenseSched S{(unsigned)WS_G, (unsigned)WS_LOUT, 1024, 1024, 128, 4, C.G, C.gc}; EpiRes<true> E{(bf16_t*)(ws + WS_PRE), P.in[I_X], P.in[I_META], nullptr, NTOK}; \
        pg8::gemm_phase<false, false>(C.lds, ws, 1024, 1024, 1024, S, E); mini_lout(C); }
    if (IN(5)) { PH_BODY_5 } if (REPS(5) > 1 && IN(5)) { xcd_barrier(bar); PH_BODY_5 }
    SEAM(5);
    #define PH_BODY_6 phase_lnr(C, 0, NTOK);
    if (IN(6)) { PH_BODY_6 } if (REPS(6) > 1 && IN(6)) { xcd_barrier(bar); PH_BODY_6 }
    SEAM(6);
    #define PH_BODY_7 phase_pos(C, 0, NTOK);
    if (IN(7)) { PH_BODY_7 } if (REPS(7) > 1 && IN(7)) { xcd_barrier(bar); PH_BODY_7 }
    SEAM(7);
    #define PH_BODY_8 { const int nM = moe_prep(C, (const int*)(ws + WS_CTL + CT_TEXP)); \
        MoeSched S{(unsigned)WS_HB8, (unsigned)WS_WGU, (unsigned)WS_TOK, (const LAS int*)(C.lds + pg8::TEXP_OFF), 2048u * 1024u, nM, 8, C.G, C.gc}; EpiGlu E{(unsigned char*)(ws + WS_ACT), (unsigned)WS_BIAS}; \
        pg8::gemm_phase<true, true>(C.lds, ws, 512, 512, 512, S, E); }
    if (IN(8)) { PH_BODY_8 } if (REPS(8) > 1 && IN(8)) { xcd_barrier(bar); PH_BODY_8 }
#ifdef PROBE_NULL8
    if (IN(8)) { xcd_barrier(bar); { const int nM = moe_prep(C, (const int*)(ws + WS_CTL + CT_TEXP));
        MoeSched S{(unsigned)WS_HB8, (unsigned)WS_WGU, (unsigned)WS_TOK, (const LAS int*)(C.lds + pg8::TEXP_OFF), 2048u * 1024u, nM, 8, C.G, C.gc}; EpiNull E{};
        pg8::gemm_phase<true, true>(C.lds, ws, 512, 512, 512, S, E); } }
#endif
    SEAM(8);
    #define PH_BODY_9 { const int nM = moe_prep(C, (const int*)(ws + WS_CTL + CT_TEXP)); \
        MoeSched S{(unsigned)WS_ACT, (unsigned)WS_WD, 0u, (const LAS int*)(C.lds + pg8::TEXP_OFF), 1024u * 1024u, nM, 4, C.G, C.gc}; EpiDown E{(bf16_t*)(ws + WS_YS), (unsigned)WS_BD}; \
        pg8::gemm_phase<true, false>(C.lds, ws, 512, 512, 512, S, E); }
    if (IN(9)) { PH_BODY_9 } if (REPS(9) > 1 && IN(9)) { xcd_barrier(bar); PH_BODY_9 }
    SEAM(9);
    #define PH_BODY_10 phase_combine(C, 0, NTOK, false);
    if (IN(10)) { PH_BODY_10 } if (REPS(10) > 1 && IN(10)) { xcd_barrier(bar); PH_BODY_10 }
    SEAM(10);
    #define PH_BODY_11 { QkvSched S{(unsigned)WS_HB8, (unsigned)WS_QKV8, 128, C.G, C.gc}; EpiQkv E{(bf16_t*)(ws + WS_Q), (bf16_t*)(ws + WS_K), (bf16_t*)(ws + WS_VT)}; \
        pg8::gemm_phase<true, false>(C.lds, ws, 512, 512, 512, S, E); mini_kv(C); }
    if (IN(11)) { PH_BODY_11 } if (REPS(11) > 1 && IN(11)) { xcd_barrier(bar); PH_BODY_11 }
    SEAM(11);
    #define PH_BODY_12 phase_attn(C);
    if (IN(12)) { PH_BODY_12 } if (REPS(12) > 1 && IN(12)) { xcd_barrier(bar); PH_BODY_12 }
    SEAM(12);
    #define PH_BODY_13 { DenseSched S{(unsigned)WS_O, (unsigned)WS_NOUT, 1024, 1024, 128, 4, C.G, C.gc}; EpiRes<false> E{(bf16_t*)(ws + WS_PRE), nullptr, nullptr, (const bf16_t*)(ws + WS_HB), NGRID}; \
        pg8::gemm_phase<false, false>(C.lds, ws, 1024, 1024, 1024, S, E); }
    if (IN(13)) { PH_BODY_13 } if (REPS(13) > 1 && IN(13)) { xcd_barrier(bar); PH_BODY_13 }
    SEAM(13);
    #define PH_BODY_14 phase_lnr(C, 1, NGRID);
    if (IN(14)) { PH_BODY_14 } if (REPS(14) > 1 && IN(14)) { xcd_barrier(bar); PH_BODY_14 }
    SEAM(14);
    #define PH_BODY_15 phase_pos(C, 1, NGRID);
    if (IN(15)) { PH_BODY_15 } if (REPS(15) > 1 && IN(15)) { xcd_barrier(bar); PH_BODY_15 }
    SEAM(15);
    #define PH_BODY_16 { const int nM = moe_prep(C, (const int*)(ws + WS_CTL + CT_TEXP) + 1024); \
        MoeSched S{(unsigned)WS_HB8, (unsigned)(WS_WGU + (size_t)32 * 2048 * 1024), (unsigned)(WS_TOK + 1 * MiB), (const LAS int*)(C.lds + pg8::TEXP_OFF), 2048u * 1024u, nM, 8, C.G, C.gc}; EpiGlu E{(unsigned char*)(ws + WS_ACT), (unsigned)(WS_BIAS + 32 * 2048 * 4)}; \
        pg8::gemm_phase<true, true>(C.lds, ws, 512, 512, 512, S, E); }
    if (IN(16)) { PH_BODY_16 } if (REPS(16) > 1 && IN(16)) { xcd_barrier(bar); PH_BODY_16 }
    SEAM(16);
    #define PH_BODY_17 { const int nM = moe_prep(C, (const int*)(ws + WS_CTL + CT_TEXP) + 1024); \
        MoeSched S{(unsigned)WS_ACT, (unsigned)(WS_WD + (size_t)32 * 1024 * 1024), 0u, (const LAS int*)(C.lds + pg8::TEXP_OFF), 1024u * 1024u, nM, 4, C.G, C.gc}; EpiDown E{(bf16_t*)(ws + WS_YS), (unsigned)(WS_BD + 32 * 1024 * 4)}; \
        pg8::gemm_phase<true, false>(C.lds, ws, 512, 512, 512, S, E); }
    if (IN(17)) { PH_BODY_17 } if (REPS(17) > 1 && IN(17)) { xcd_barrier(bar); PH_BODY_17 }
    SEAM(17);
    #define PH_BODY_18 phase_combine(C, 1, NGRID, true);
    if (IN(18)) { PH_BODY_18 } if (REPS(18) > 1 && IN(18)) { xcd_barrier(bar); PH_BODY_18 }
#undef ws
#undef IN
#undef SEAM
}

#ifndef MK_PER_PHASE
#define MK_PER_PHASE 0
#endif
extern "C" void kernel_launch(void* const* d_in, const int* in_sizes, int n_in, void* d_out, int out_size, void* d_ws, size_t ws_size, hipStream_t stream) {
    static int grid = 0;
    if (grid == 0) {
        if (n_in != 25 || ws_size < WS_END || out_size != NGRID * D) { fprintf(stderr, "kernel_launch: unexpected problem (n_in %d, ws %zu, out %d)\n", n_in, ws_size, out_size); grid = -1; return; }
        int dev = 0, cus = 0, per_cu = 0;
        if (hipGetDevice(&dev) != hipSuccess || hipDeviceGetAttribute(&cus, hipDeviceAttributeMultiprocessorCount, dev) != hipSuccess) { grid = -1; return; }
        if (hipFuncSetAttribute((const void*)hybrid_fwd, hipFuncAttributeMaxDynamicSharedMemorySize, LDS_BYTES) != hipSuccess) { fprintf(stderr, "kernel_launch: hipFuncSetAttribute failed\n"); grid = -1; return; }
        if (hipOccupancyMaxActiveBlocksPerMultiprocessor(&per_cu, (const void*)hybrid_fwd, NTHREADS, LDS_BYTES) != hipSuccess || per_cu < 1) { fprintf(stderr, "kernel_launch: occupancy query failed (%d)\n", per_cu); grid = -1; return; }
        grid = cus * 1;
        if (grid > 256) grid = 256;
    }
    if (grid < 0) return;
    if (hipMemsetAsync((char*)d_ws + WS_CTL + CT_BAR, 0, 16384, stream) != hipSuccess) { fprintf(stderr, "kernel_launch: memset failed\n"); return; }
    Params p{};
    for (int i = 0; i < 25; ++i) p.in[i] = (const float*)d_in[i];
    p.out = (float*)d_out; p.ws = (unsigned char*)d_ws;
#if MK_PER_PHASE
    for (int ph = 0; ph < 19; ++ph) { p.ph_lo = ph; p.ph_hi = ph + 1; void* args[] = {&p};
        hipError_t e = hipLaunchCooperativeKernel((void*)hybrid_fwd, dim3(grid), dim3(NTHREADS), args, LDS_BYTES, stream);
        if (e != hipSuccess) { fprintf(stderr, "launch phase %d failed: %s\n", ph, hipGetErrorString(e)); break; } }
#else
    p.ph_lo = 0; p.ph_hi = 19; void* args[] = {&p};
    hipError_t e = hipLaunchCooperativeKernel((void*)hybrid_fwd, dim3(grid), dim3(NTHREADS), args, LDS_BYTES, stream);
    if (e != hipSuccess) fprintf(stderr, "cooperative launch failed: %s (grid %d)\n", hipGetErrorString(e), grid);
#endif
}
```

```cpp
#include <hip/hip_runtime.h>
#include <hip/hip_cooperative_groups.h>
#include <cstdio>
#include <cstdint>
namespace cg = cooperative_groups;

#define LAS __attribute__((address_space(3)))
typedef unsigned short bf16_t;
typedef short bf16x8 __attribute__((ext_vector_type(8)));
typedef float f32x4 __attribute__((ext_vector_type(4)));
typedef float f32x2 __attribute__((ext_vector_type(2)));
typedef unsigned u32x4 __attribute__((ext_vector_type(4)));
typedef unsigned u32x2 __attribute__((ext_vector_type(2)));

constexpr int NB = 8, SEQ = 4096, D = 1024, NMETA = 16, LSEQ = SEQ + NMETA;
constexpr int NGRID = NB * SEQ;
constexpr int NTOK = NGRID + NB * NMETA;
constexpr int MPAD = 33024;
constexpr int NEXP = 32, TOPK = 4;
constexpr int PMAX = 139776;
constexpr int MTMAX = PMAX / 256;
constexpr float DN_ALPHA = 1.41421356237f;
constexpr float LN_EPS = 1e-5f;
constexpr int NTHREADS = 512, NWAVES = 8;

constexpr size_t MiB = 1u << 20;
constexpr size_t ACT_BYTES = (size_t)MPAD * D * 2;
constexpr size_t WS_CTL   = 0;
constexpr size_t WS_WIN   = 4 * MiB;
constexpr size_t WS_GATE  = WS_WIN + 4 * MiB;
constexpr size_t WS_LOUT  = WS_GATE + 2 * MiB;
constexpr size_t WS_QKV   = WS_LOUT + 2 * MiB;
constexpr size_t WS_NOUT  = WS_QKV + 6 * MiB;
constexpr size_t WS_WGU   = WS_NOUT + 2 * MiB;
constexpr size_t WS_WD    = WS_WGU + 128 * MiB;
constexpr size_t WS_HB    = WS_WD + 64 * MiB;
constexpr size_t WS_HB8   = WS_HB + 65 * MiB;
constexpr size_t WS_PRE   = WS_HB8 + 33 * MiB;
constexpr size_t WS_H     = WS_PRE + 129 * MiB;
constexpr size_t WS_SCR   = WS_H + 129 * MiB;
constexpr size_t WS_XR = WS_SCR, WS_XC = WS_XR + 65 * MiB, WS_GY = WS_XC + 65 * MiB, WS_LA = WS_GY + 65 * MiB, WS_BB = WS_LA + 130 * MiB, WS_HF = WS_BB + 130 * MiB, WS_G = WS_HF + 65 * MiB;
constexpr size_t WS_SCR_END0 = WS_G + 65 * MiB;
constexpr size_t WS_XS = WS_SCR, WS_ACT = WS_XS + 137 * MiB, WS_YS = WS_ACT + 137 * MiB;
constexpr size_t WS_SCR_END1 = WS_YS + 274 * MiB;
constexpr size_t WS_Q = WS_SCR, WS_K = WS_Q + 65 * MiB, WS_VT = WS_K + 65 * MiB, WS_O = WS_VT + 65 * MiB;
constexpr size_t WS_BIAS = (WS_SCR_END0 > WS_SCR_END1 ? WS_SCR_END0 : WS_SCR_END1);
constexpr size_t WS_BD = WS_BIAS + 2 * 32 * 2048 * 4;
constexpr size_t WS_GBIAS = WS_BD + 2 * 32 * 1024 * 4;
constexpr size_t WS_TOK = WS_BIAS + 1 * MiB;
constexpr size_t WS_QKV8 = WS_TOK + 2 * MiB;
constexpr size_t WS_END = WS_QKV8 + 3 * MiB;
static_assert((size_t)PMAX * 4 <= 1 * MiB, "token offset table");
static_assert(ACT_BYTES <= 65 * MiB && (size_t)PMAX * D * 2 <= 274 * MiB && (size_t)PMAX * D <= 137 * MiB && (size_t)MPAD * D <= 33 * MiB && (size_t)MPAD * D * 4 <= 129 * MiB, "ws map");
static_assert(WS_END <= (size_t)2040 * MiB, "ws map must fit 4x the largest input tensor");
constexpr size_t CT_BC      = 4096;
constexpr size_t CT_TEXP    = CT_BC + 2 * 256 * 32 * 4;
constexpr size_t CT_SPL     = CT_TEXP + 2 * 1024 * 4;
constexpr size_t CT_EID     = 256 * 1024;
constexpr size_t CT_GATEV   = CT_EID + 2 * (size_t)NTOK * 4 * 4;
constexpr size_t CT_POS     = CT_GATEV + 2 * (size_t)NTOK * 4 * 4;
static_assert(CT_POS + 2 * (size_t)NTOK * 4 * 4 <= 4 * MiB, "ctl map");

constexpr int LDS_BYTES = 155648;

__device__ __forceinline__ unsigned f2bf(float f) { unsigned u = __builtin_bit_cast(unsigned, f); return (u + 0x7fffu + ((u >> 16) & 1u)) >> 16; }
__device__ __forceinline__ unsigned cvt_pk_bf16(float lo, float hi);
__device__ __forceinline__ unsigned pk2(float lo, float hi) { return cvt_pk_bf16(lo, hi); }
typedef __bf16 bf16x2_t __attribute__((ext_vector_type(2)));
__device__ __forceinline__ unsigned cvt_pk_bf16(float lo, float hi) { const f32x2 v = {lo, hi}; return __builtin_bit_cast(unsigned, __builtin_convertvector(v, bf16x2_t)); }
__device__ __forceinline__ unsigned pk4_fp8(float a, float b, float c, float d) { int w = __builtin_amdgcn_cvt_pk_fp8_f32(a, b, 0, false); w = __builtin_amdgcn_cvt_pk_fp8_f32(c, d, w, true); return (unsigned)w; }
__device__ __forceinline__ float dot2_bf16(unsigned a, unsigned b, float c) { return __builtin_amdgcn_fdot2_f32_bf16(__builtin_bit_cast(bf16x2_t, a), __builtin_bit_cast(bf16x2_t, b), c, false); }
__device__ __forceinline__ float bflo(unsigned w) { return __builtin_bit_cast(float, w << 16); }
__device__ __forceinline__ float bfhi(unsigned w) { return __builtin_bit_cast(float, w & 0xffff0000u); }
__device__ __forceinline__ void unpack8(const u32x4 w, float (&o)[8]);
__device__ __forceinline__ float fast_exp2(float x) { return __builtin_amdgcn_exp2f(x); }
__device__ __forceinline__ float fast_rcp(float x) { return __builtin_amdgcn_rcpf(x); }
__device__ __forceinline__ float sigmoidf_(float x) { return fast_rcp(1.0f + fast_exp2(-1.44269504089f * x)); }
__device__ __forceinline__ float wave_sum(float v) {
#pragma unroll
    for (int o = 1; o < 64; o <<= 1) v += __shfl_xor(v, o);
    return v;
}
template <int CTRL> __device__ __forceinline__ float dpp_movf(float v) { return __builtin_bit_cast(float, __builtin_amdgcn_update_dpp(0, __builtin_bit_cast(int, v), CTRL, 0xf, 0xf, true)); }
__device__ __forceinline__ float readlane_f(float v, int l) { return __builtin_bit_cast(float, __builtin_amdgcn_readlane(__builtin_bit_cast(int, v), l)); }
__device__ __forceinline__ float wave_sum_dpp(float v) {
    v += dpp_movf<0xB1>(v);
    v += dpp_movf<0x4E>(v);
    v += dpp_movf<0x141>(v);
    v += dpp_movf<0x140>(v);
    return (readlane_f(v, 0) + readlane_f(v, 16)) + (readlane_f(v, 32) + readlane_f(v, 48));
}
__device__ __forceinline__ int seqrow(int b, int s) { return s < NMETA ? NGRID + NMETA * b + s : SEQ * b + (s - NMETA); }

struct Params {
    const float* in[25];
    float* out;
    unsigned char* ws;
    int ph_lo, ph_hi;
};
struct Ctx {
    LAS unsigned char* lds;
    int G, bid, gc;
    unsigned char* ws;
    const float* const* in;
    float* out;
};
__device__ __forceinline__ int fresh_tid() { int t = threadIdx.x; asm volatile("" : "+v"(t)); return t; }
__device__ __forceinline__ unsigned char* fresh_ws(unsigned char* p) { asm volatile("" : "+s"(p)); return p; }
#define PHASE_IDS unsigned char* const wsl = fresh_ws(C.ws); (void)wsl; const int tid = fresh_tid(); const int lane = tid & 63; const int wave = __builtin_amdgcn_readfirstlane(tid >> 6); (void)lane; (void)wave;
enum { I_X = 0, I_META, I_WIN, I_CONVW, I_CONVB, I_WA, I_BA, I_WX, I_BX, I_LAM, I_LOUT, I_WQKV, I_RPB, I_MBIAS, I_NOUT, I_LNMG, I_LNMB, I_RW, I_RB, I_WGU, I_BGU, I_WD, I_BD, I_LNFG, I_LNFB };

namespace pg8 {
constexpr int BM = 256, BK = 64, HALF = 128, HTB = HALF * BK * 2, STAGE_BYTES = 8 * HTB, NXCD = 8, WGM = 8;
constexpr int SIDE_OFF = STAGE_BYTES, TEXP_OFF = STAGE_BYTES + 2048, TOK_OFF = STAGE_BYTES + 2048 + 4096;
__device__ __forceinline__ int lds_byte(int r, int c) { const int st = (r >> 4) * 2 + (c >> 5), rr = r & 15, cc = c & 31, ob = rr * 64 + cc * 2; return st * 1024 + (ob ^ (((ob >> 9) & 1) << 5)); }
__device__ __forceinline__ void stage_rc(int b, int& R, int& C) { const int st = b / 1024, sb = b % 1024, swz = sb ^ (((sb >> 9) & 1) << 5); R = (st >> 1) * 16 + swz / 64; C = (st & 1) * 32 + (swz % 64) / 2; }
__device__ __forceinline__ int perm32(int rho) { const int n = rho >> 4, i = rho & 15; return 8 * (i >> 2) + 4 * n + (i & 3); }

typedef int v8i __attribute__((ext_vector_type(8)));
typedef int v4i __attribute__((ext_vector_type(4)));
__device__ __forceinline__ v8i cat8(bf16x8 a, bf16x8 b) { const v4i x = __builtin_bit_cast(v4i, a), y = __builtin_bit_cast(v4i, b); return __builtin_shufflevector(x, y, 0, 1, 2, 3, 4, 5, 6, 7); }
struct Unit { unsigned ao, bo, to; int pm, pn, aux; };

__device__ __forceinline__ void tile_of(int L, int nM, int nN, int& pm, int& pn) {
    const int nwg = nM * nN; int wgid = L;
    { const int q = nwg / NXCD, r = nwg % NXCD, xcd = wgid % NXCD, off = wgid / NXCD; wgid = (xcd < r ? xcd * (q + 1) : r * (q + 1) + (xcd - r) * q) + off; }
    const int nig = WGM * nN, gid = wgid / nig, fm = gid * WGM, gsz = (nM - fm) < WGM ? (nM - fm) : WGM;
    pm = fm + ((wgid % nig) % gsz); pn = (wgid % nig) / gsz;
}

template <bool F8, bool GATHER, class Epi, class Sched>
__device__ __forceinline__ void gemm_phase(LAS unsigned char* lds, const unsigned char* wsbase, const int K, const int lda, const int ldb, const Sched& S, const Epi& E) {
    const __amdgpu_buffer_rsrc_t rsrc = __builtin_amdgcn_make_buffer_rsrc((void*)wsbase, 0, 0xFFFFFFFF, 0x00020000);
    const int tid = fresh_tid(), wid = __builtin_amdgcn_readfirstlane(tid >> 6), lane = tid & 63, wr = wid >> 2, wc = wid & 3;
    const int nt = K / BK;
    int f8scales = 0; if constexpr (F8) { f8scales = Epi::SCALES; asm volatile("" : "+v"(f8scales)); }
    int voffA, voffB;
    { int R, C; stage_rc(tid * 16, R, C); const int Rb = Epi::PERM ? ((R & ~31) + perm32(R & 31)) : R; voffA = ((GATHER ? 0 : R * lda) + C) * 2; voffB = (Rb * ldb + C) * 2; }
    const int tokb = (16 * (wid >> 1) + (lane >> 2)) * 4;
    const unsigned kstep = (unsigned)(BK * 2);
    const unsigned hstepA = (unsigned)HALF * lda * 2, hstepB = (unsigned)HALF * ldb * 2;
    const unsigned ldsw = (unsigned)wid * 1024u;
    const int aoff = lds_byte(wr * 64 + (lane & 15), (lane >> 4) * 8), boff = lds_byte(wc * 32 + (lane & 15), (lane >> 4) * 8);
#define PG8_SA(b, h) (((b) * 2 + (h)) * HTB)
#define PG8_SB(b, h) ((4 + (b) * 2 + (h)) * HTB)
#define PG8_STAGE(bufoff, gbase, voff) do { _Pragma("unroll") for (int _i = 0; _i < 2; ++_i) \
        __builtin_amdgcn_raw_ptr_buffer_load_lds(rsrc, (LAS void*)(lds + (bufoff) + ldsl + _i * 8192), 16, voff, __builtin_amdgcn_readfirstlane((int)((gbase) + (unsigned)_i * (hstep##voff >> 1))), 0, 0); } while (0)
#define hstepvoffA hstepA
#define hstepvoffB hstepB
#define PG8_STAGE_A(bufoff, aoffs, h, par) do { if constexpr (GATHER) { _Pragma("unroll") for (int _i = 0; _i < 2; ++_i) { \
            const int _tk = *(const LAS int*)(lds + TOK_OFF + (par) * 1024 + tokb + ((h) * 128 + _i * 64) * 4); \
            __builtin_amdgcn_raw_ptr_buffer_load_lds(rsrc, (LAS void*)(lds + (bufoff) + ldsl + _i * 8192), 16, _tk + voffA, __builtin_amdgcn_readfirstlane((int)(aoffs)), 0, 0); } } \
        else { PG8_STAGE(bufoff, (aoffs) + (unsigned)(h) * hstepA, voffA); } } while (0)
#define PG8_TOK(unit, par) do { if constexpr (GATHER) { if (wid == 0) __builtin_amdgcn_raw_ptr_buffer_load_lds(rsrc, (LAS void*)(lds + TOK_OFF + (par) * 1024), 16, lane * 16, (int)(unit).to, 0, 0); } } while (0)
#define PG8_LDA(dst, b, h) do { _Pragma("unroll") for (int m = 0; m < 4; ++m) _Pragma("unroll") for (int k = 0; k < 2; ++k) dst[m][k] = *(const LAS bf16x8*)(lds + PG8_SA(b, h) + aoff + m * 2048 + k * 1024); } while (0)
#define PG8_LDB(dst, b, h) do { _Pragma("unroll") for (int n = 0; n < 2; ++n) _Pragma("unroll") for (int k = 0; k < 2; ++k) dst[n][k] = *(const LAS bf16x8*)(lds + PG8_SB(b, h) + boff + n * 2048 + k * 1024); } while (0)
#define PG8_MMA(ai, bj, At, Bt) do { __builtin_amdgcn_s_setprio(1); _Pragma("unroll") for (int m = 0; m < 4; ++m) _Pragma("unroll") for (int n = 0; n < 2; ++n) { \
        if constexpr (F8) { asm volatile("v_mfma_scale_f32_16x16x128_f8f6f4 %0, %1, %2, %0, %3, %3 op_sel:[0,1,0] op_sel_hi:[0,0,0]" : "+v"(acc[ai][bj][m][n]) : "v"(cat8(Bt[n][0], Bt[n][1])), "v"(cat8(At[m][0], At[m][1])), "v"(f8scales)); } \
        else { _Pragma("unroll") for (int k = 0; k < 2; ++k) acc[ai][bj][m][n] = __builtin_amdgcn_mfma_f32_16x16x32_bf16(Bt[n][k], At[m][k], acc[ai][bj][m][n], 0, 0, 0); } } \
        __builtin_amdgcn_s_setprio(0); } while (0)
#define PG8_WAIT_V(n) asm volatile("s_waitcnt vmcnt(" #n ")" ::: "memory")
#define PG8_WAIT_L(n) asm volatile("s_waitcnt lgkmcnt(" #n ")" ::: "memory")
#define PG8_BAR __builtin_amdgcn_s_barrier()
#define PG8_SCHED __builtin_amdgcn_sched_barrier(0)
    Unit cur, nxt; int ui = 0;
    if (!S.next(0, cur)) return;
    f32x4 acc[2][2][4][2];
    bf16x8 At[4][2], B0[2][2], B1[2][2];
#define PG8_INIT(par) do { if constexpr (Epi::SIDE) { const int _l = fresh_tid() & 63; E.init(acc, (const LAS float*)(lds + SIDE_OFF + (par) * 1024), wc, _l >> 4); } \
        else { _Pragma("unroll") for (int a = 0; a < 2; ++a) _Pragma("unroll") for (int b = 0; b < 2; ++b) _Pragma("unroll") for (int m = 0; m < 4; ++m) _Pragma("unroll") for (int n = 0; n < 2; ++n) acc[a][b][m][n] = (f32x4){0.f, 0.f, 0.f, 0.f}; } } while (0)
    unsigned cA = cur.ao, cB = cur.bo;
    unsigned ldsl = ldsw; asm volatile("" : "+s"(ldsl));
#define PG8_SIDE(unit, par) do { if constexpr (Epi::SIDE) { if (wid == 0) __builtin_amdgcn_raw_ptr_buffer_load_lds(rsrc, (LAS void*)(lds + SIDE_OFF + (par) * 1024), 16, lane * 16, (int)E.side_off(unit), 0, 0); } } while (0)
    PG8_SIDE(cur, 0);
    if constexpr (GATHER) PG8_TOK(cur, 0);
    if constexpr (GATHER || Epi::SIDE) { asm volatile("s_waitcnt vmcnt(0)" ::: "memory"); PG8_BAR; }
    PG8_INIT(0);
    PG8_STAGE(PG8_SB(0, 0), cB, voffB); PG8_STAGE(PG8_SB(0, 1), cB + hstepB, voffB); PG8_STAGE_A(PG8_SA(0, 0), cA, 0, 0); PG8_STAGE_A(PG8_SA(0, 1), cA, 1, 0);
    if (wr == 1) PG8_BAR;
    PG8_WAIT_V(2); PG8_BAR;
    PG8_STAGE(PG8_SB(1, 0), cB + kstep, voffB); PG8_STAGE_A(PG8_SA(1, 0), cA + kstep, 0, 0); PG8_STAGE(PG8_SB(1, 1), cB + hstepB + kstep, voffB);
    PG8_WAIT_V(6); PG8_BAR;
    for (;;) {
        const bool has_next = S.next(ui + 1, nxt);
        if (has_next) { PG8_TOK(nxt, (ui + 1) & 1); PG8_SIDE(nxt, (ui + 1) & 1); }
        const unsigned nA = has_next ? nxt.ao : cA, nB = has_next ? nxt.bo : cB;
#pragma unroll 1
        for (int t = 0; t < nt; t += 2) {
            const bool last = (t == nt - 2);
            ldsl = ldsw; asm volatile("" : "+s"(ldsl));
            const int parc = ui & 1, parn = (ui + ((last && has_next) ? 1 : 0)) & 1;
            const unsigned a1 = cA + (unsigned)(t + 1) * kstep;
            const unsigned a2 = last ? nA : cA + (unsigned)(t + 2) * kstep, b2 = last ? nB : cB + (unsigned)(t + 2) * kstep;
            const unsigned a3 = a2 + kstep, b3 = b2 + kstep;
            PG8_LDB(B0, 0, 0); PG8_LDB(B1, 0, 1); PG8_SCHED; PG8_LDA(At, 0, 0); PG8_STAGE_A(PG8_SA(1, 1), a1, 1, parc);
            PG8_WAIT_V(8); PG8_WAIT_L(0); PG8_BAR; PG8_MMA(0, 0, At, B0); PG8_MMA(0, 1, At, B1); PG8_BAR; PG8_SCHED;
            PG8_LDA(At, 0, 1); PG8_STAGE(PG8_SB(0, 0), b2, voffB); PG8_STAGE(PG8_SB(0, 1), b2 + hstepB, voffB); PG8_STAGE_A(PG8_SA(0, 0), a2, 0, parn);
            PG8_WAIT_V(8); PG8_WAIT_L(0); PG8_BAR; PG8_MMA(1, 0, At, B0); PG8_MMA(1, 1, At, B1); PG8_BAR; PG8_SCHED;
            PG8_LDB(B0, 1, 0); PG8_LDB(B1, 1, 1); PG8_SCHED; PG8_LDA(At, 1, 0); PG8_STAGE_A(PG8_SA(0, 1), a2, 1, parn);
            PG8_WAIT_V(8); PG8_WAIT_L(0); PG8_BAR; PG8_MMA(0, 0, At, B0); PG8_MMA(0, 1, At, B1); PG8_BAR; PG8_SCHED;
            PG8_LDA(At, 1, 1); PG8_STAGE(PG8_SB(1, 0), b3, voffB); PG8_STAGE(PG8_SB(1, 1), b3 + hstepB, voffB); PG8_STAGE_A(PG8_SA(1, 0), a3, 0, parn);
            PG8_WAIT_V(8); PG8_WAIT_L(0); PG8_BAR; PG8_MMA(1, 0, At, B0); PG8_MMA(1, 1, At, B1); PG8_BAR; PG8_SCHED;
        }
        if constexpr (F8) asm volatile("s_nop 15\n\ts_nop 15" ::: "memory");
        if (wr == 0) PG8_BAR;
        { const int l2 = fresh_tid() & 63; E(acc, cur, wr, wc, l2 & 15, l2 >> 4, (const LAS float*)(lds + SIDE_OFF + (ui & 1) * 1024)); }
        if (!has_next) break;
        cur = nxt; cA = nA; cB = nB; ++ui;
        PG8_INIT(ui & 1);
        if (wr == 1) PG8_BAR;
    }
    PG8_WAIT_V(0);
    PG8_BAR;
#undef PG8_SA
#undef PG8_SB
#undef PG8_STAGE
#undef PG8_STAGE_A
#undef PG8_TOK
#undef PG8_SIDE
#undef PG8_INIT
#undef hstepvoffA
#undef hstepvoffB
#undef PG8_LDA
#undef PG8_LDB
#undef PG8_MMA
#undef PG8_WAIT_V
#undef PG8_WAIT_L
#undef PG8_BAR
#undef PG8_SCHED
}
}

using pg8::Unit;

struct DenseSched {
    unsigned A, Bt; int lda, ldb, nM, nN, G, c;
    __device__ __forceinline__ bool next(int i, Unit& u) const {
        const int L = i * G + c; if (L >= nM * nN) return false;
        pg8::tile_of(L, nM, nN, u.pm, u.pn); u.aux = 0; u.to = 0;
        u.ao = A + (unsigned)u.pm * 256 * lda * 2; u.bo = Bt + (unsigned)u.pn * 256 * ldb * 2; return true;
    }
};
struct GateSched {
    unsigned XC, GT; int nM, G, c;
    __device__ __forceinline__ bool next(int i, Unit& u) const {
        const int per = nM * 4; const int L = i * G + c; if (L >= 4 * per) return false;
        const int nb = L / per; pg8::tile_of(L - nb * per, nM, 4, u.pm, u.pn); u.aux = nb; u.to = 0;
        u.ao = XC + ((unsigned)u.pm * 256 * 1024 + 256 * nb) * 2; u.bo = GT + ((unsigned)nb * 1024 + 256 * u.pn) * 256 * 2; return true;
    }
};
struct QkvSched {
    unsigned HB, WT; int nM, G, c;
    __device__ __forceinline__ bool next(int i, Unit& u) const {
        const int n0 = nM * 8, n1 = 4 * nM; const int L = i * G + c; if (L >= n0 + n1) return false; u.to = 0;
        if (L < n0) { pg8::tile_of(L, nM, 8, u.pm, u.pn); u.aux = 0; u.ao = HB + (unsigned)u.pm * 256 * 1024; u.bo = WT + (unsigned)u.pn * 256 * 1024; }
        else { pg8::tile_of(L - n0, 4, nM, u.pm, u.pn); u.aux = 1; u.ao = WT + (unsigned)(2048 + u.pm * 256) * 1024; u.bo = HB + (unsigned)u.pn * 256 * 1024; }
        return true;
    }
};
struct MoeSched {
    unsigned A, W, tok; const LAS int* texp; unsigned wstride; int nM, nN, G, c;
    __device__ __forceinline__ bool next(int i, Unit& u) const {
        const int L = i * G + c; if (L >= nM * nN) return false;
        pg8::tile_of(L, nM, nN, u.pm, u.pn);
        const int e = __builtin_amdgcn_readfirstlane(texp[u.pm]); u.aux = e;
        u.ao = tok ? A : A + (unsigned)u.pm * 256 * 1024; u.to = tok + (unsigned)u.pm * 1024; u.bo = W + (unsigned)e * wstride + (unsigned)u.pn * 256 * 1024; return true;
    }
};

#define EPI_ARGS const f32x4 (&acc)[2][2][4][2], const Unit& u, int wr, int wc, int fr, int fq, const LAS float* side
struct EpiWin {
    static constexpr bool PERM = true, SIDE = false;
    bf16_t* XR; bf16_t* GY;
    __device__ __forceinline__ void operator()(EPI_ARGS) const {
        const int row0 = u.pm * 256 + wr * 64 + fr;
        if (u.pn < 4) {
            const int col0 = u.pn * 256 + wc * 32 + 8 * fq;
#pragma unroll
            for (int ai = 0; ai < 2; ++ai)
#pragma unroll
                for (int m = 0; m < 4; ++m) { bf16_t* rowp = XR + (size_t)(row0 + ai * 128 + m * 16) * D + col0;
#pragma unroll
                    for (int bj = 0; bj < 2; ++bj) { const f32x4 v0 = acc[ai][bj][m][0], v1 = acc[ai][bj][m][1];
                        u32x4 w; w.x = cvt_pk_bf16(v0[0], v0[1]); w.y = cvt_pk_bf16(v0[2], v0[3]); w.z = cvt_pk_bf16(v1[0], v1[1]); w.w = cvt_pk_bf16(v1[2], v1[3]);
                        *(u32x4*)(rowp + bj * 128) = w; } }
        } else {
#pragma unroll
            for (int ai = 0; ai < 2; ++ai)
#pragma unroll
                for (int m = 0; m < 4; ++m) { const int row = row0 + ai * 128 + m * 16;
#pragma unroll
                    for (int bj = 0; bj < 2; ++bj) { const int g = (u.pn - 4) * 8 + bj * 4 + wc;
                        float o[8];
#pragma unroll
                        for (int n = 0; n < 2; ++n)
#pragma unroll
                            for (int j = 0; j < 4; ++j) { const float v = acc[ai][bj][m][n][j]; const float z = 1.5957691216f * (v + 0.044715f * v * v * v); o[n * 4 + j] = v * sigmoidf_(z); }
                        u32x4 w; w.x = cvt_pk_bf16(o[0], o[1]); w.y = cvt_pk_bf16(o[2], o[3]); w.z = cvt_pk_bf16(o[4], o[5]); w.w = cvt_pk_bf16(o[6], o[7]);
                        *(u32x4*)(GY + ((size_t)g * MPAD + row) * 32 + 8 * fq) = w; } }
        }
    }
};
struct EpiGate {
    static constexpr bool PERM = true, SIDE = true;
    const bf16_t* XC; bf16_t* LA; bf16_t* BB; const float* spl; unsigned bias_off;
    __device__ __forceinline__ unsigned side_off(const Unit& u) const { return bias_off + (unsigned)((((u.pn >> 1) * 4 + u.aux) * 2 + (u.pn & 1)) * 1024); }
    __device__ __forceinline__ void init(f32x4 (&acc)[2][2][4][2], const LAS float* side, int wc, int fq) const {
#pragma unroll
        for (int bj = 0; bj < 2; ++bj)
#pragma unroll
            for (int n = 0; n < 2; ++n) { const f32x4 b = *(const LAS f32x4*)(side + 128 * bj + 32 * wc + 8 * fq + 4 * n);
#pragma unroll
                for (int ai = 0; ai < 2; ++ai)
#pragma unroll
                    for (int m = 0; m < 4; ++m) acc[ai][bj][m][n] = b; }
    }
    __device__ __forceinline__ void operator()(EPI_ARGS) const {
        const int nb = u.aux, dir = u.pn >> 1, half = u.pn & 1;
        const int ch0 = 256 * nb + 128 * half + 32 * wc + 8 * fq, g = ch0 >> 5;
        const int row0 = u.pm * 256 + wr * 64 + fr;
        float csp[8];
        { const f32x4 p0 = *(const f32x4*)(spl + dir * 1024 + ch0), p1 = *(const f32x4*)(spl + dir * 1024 + ch0 + 4);
#pragma unroll
          for (int j = 0; j < 4; ++j) { csp[j] = -p0[j]; csp[4 + j] = -p1[j]; } }
        u32x4 xnext = *(const u32x4*)(XC + (size_t)row0 * D + ch0);
#pragma unroll
        for (int ai = 0; ai < 2; ++ai)
#pragma unroll
            for (int m = 0; m < 4; ++m) { const int row = row0 + ai * 128 + m * 16;
                const u32x4 xw = xnext;
                { const int it = ai * 4 + m + 1, rn = row0 + (it >> 2) * 128 + (it & 3) * 16; if (it < 8) xnext = *(const u32x4*)(XC + (size_t)rn * D + ch0); }
                float xc[8]; unpack8(xw, xc);
                const bool start = dir == 1 && (row & (SEQ - 1)) == SEQ - 1;
                float la[8], bb[8];
#pragma unroll
                for (int n = 0; n < 2; ++n)
#pragma unroll
                    for (int j = 0; j < 4; ++j) { const int i = n * 4 + j;
                        const float l2 = csp[i] * sigmoidf_(acc[ai][0][m][n][j]); const float a2 = fast_exp2(2.0f * l2);
                        const float mult = start ? 1.0f : __builtin_amdgcn_sqrtf(fmaxf(1.0f - a2, 0.0f));
                        la[i] = l2; bb[i] = mult * sigmoidf_(acc[ai][1][m][n][j]) * xc[i]; }
                u32x4 w; w.x = cvt_pk_bf16(la[0], la[1]); w.y = cvt_pk_bf16(la[2], la[3]); w.z = cvt_pk_bf16(la[4], la[5]); w.w = cvt_pk_bf16(la[6], la[7]);
                const size_t o = (((size_t)dir * 32 + g) * MPAD + row) * 32 + 8 * fq;
                *(u32x4*)(LA + o) = w;
                w.x = cvt_pk_bf16(bb[0], bb[1]); w.y = cvt_pk_bf16(bb[2], bb[3]); w.z = cvt_pk_bf16(bb[4], bb[5]); w.w = cvt_pk_bf16(bb[6], bb[7]);
                *(u32x4*)(BB + o) = w; }
    }
};
template <bool LAYER0> struct EpiRes {
    static constexpr bool PERM = true, SIDE = false;
    bf16_t* PRE; const float* x; const float* meta; const bf16_t* HB; int nrows;
    __device__ __forceinline__ void operator()(EPI_ARGS) const {
        const int row0 = u.pm * 256 + wr * 64 + fr, col0 = u.pn * 256 + wc * 32 + 8 * fq;
#pragma unroll
        for (int ai = 0; ai < 2; ++ai)
#pragma unroll
            for (int m = 0; m < 4; ++m) { const int row = row0 + ai * 128 + m * 16;
                if (row < nrows) {
#pragma unroll
                    for (int bj = 0; bj < 2; ++bj) { const int c = col0 + bj * 128; float r[8];
                        if (LAYER0) { const float* rp = (row < NGRID ? x + (size_t)row * D : meta + (size_t)((row - NGRID) & 15) * D) + c; const f32x4 r0 = *(const f32x4*)rp, r1 = *(const f32x4*)(rp + 4);
                            r[0] = r0[0]; r[1] = r0[1]; r[2] = r0[2]; r[3] = r0[3]; r[4] = r1[0]; r[5] = r1[1]; r[6] = r1[2]; r[7] = r1[3]; }
                        else { const u32x4 rw = *(const u32x4*)(HB + (size_t)row * D + c); r[0] = bflo(rw.x); r[1] = bfhi(rw.x); r[2] = bflo(rw.y); r[3] = bfhi(rw.y); r[4] = bflo(rw.z); r[5] = bfhi(rw.z); r[6] = bflo(rw.w); r[7] = bfhi(rw.w); }
                        const f32x4 a0 = acc[ai][bj][m][0], a1 = acc[ai][bj][m][1];
                        u32x4 w; w.x = cvt_pk_bf16(r[0] * DN_ALPHA + a0[0], r[1] * DN_ALPHA + a0[1]); w.y = cvt_pk_bf16(r[2] * DN_ALPHA + a0[2], r[3] * DN_ALPHA + a0[3]);
                        w.z = cvt_pk_bf16(r[4] * DN_ALPHA + a1[0], r[5] * DN_ALPHA + a1[1]); w.w = cvt_pk_bf16(r[6] * DN_ALPHA + a1[2], r[7] * DN_ALPHA + a1[3]);
                        *(u32x4*)(PRE + (size_t)row * D + c) = w; }
                }
                asm volatile("" ::: "memory"); }
    }
};
struct EpiGlu {
    static constexpr bool PERM = true, SIDE = true; static constexpr int SCALES = 0x7F79;
    unsigned char* ACT; unsigned bias_off;
    __device__ __forceinline__ unsigned side_off(const Unit& u) const { return bias_off + (unsigned)((u.aux * 8 + u.pn) * 1024); }
    __device__ __forceinline__ void init(f32x4 (&acc)[2][2][4][2], const LAS float* side, int wc, int fq) const {
#pragma unroll
        for (int bj = 0; bj < 2; ++bj)
#pragma unroll
            for (int n = 0; n < 2; ++n) { const f32x4 b = *(const LAS f32x4*)(side + 128 * bj + 32 * wc + 8 * fq + 4 * n);
#pragma unroll
                for (int ai = 0; ai < 2; ++ai)
#pragma unroll
                    for (int m = 0; m < 4; ++m) acc[ai][bj][m][n] = b; }
    }
    __device__ __forceinline__ void operator()(EPI_ARGS) const {
        const int f0 = 128 * u.pn + 32 * wc + 8 * fq;
        const int row0 = u.pm * 256 + wr * 64 + fr;
#pragma unroll
        for (int ai = 0; ai < 2; ++ai)
#pragma unroll
            for (int m = 0; m < 4; ++m) { const int row = row0 + ai * 128 + m * 16; float o[8];
#pragma unroll
                for (int n = 0; n < 2; ++n)
#pragma unroll
                    for (int j = 0; j < 4; ++j) { const int i = n * 4 + j;
                        const float glu = fminf(acc[ai][0][m][n][j], 7.0f);
                        const float lin4 = __builtin_fmaf(__builtin_amdgcn_fmed3f(acc[ai][1][m][n][j], -7.0f, 7.0f), 4.0f, 4.0f);
                        const float r = fast_rcp(1.0f + fast_exp2(glu * (-1.702f * 1.44269504089f)));
                        o[i] = (glu * r) * lin4; }
                u32x2 w; w.x = pk4_fp8(o[0], o[1], o[2], o[3]); w.y = pk4_fp8(o[4], o[5], o[6], o[7]);
                *(u32x2*)(ACT + (size_t)row * D + f0) = w; }
    }
};
struct EpiNull {
    static constexpr bool PERM = true, SIDE = false; static constexpr int SCALES = 0x7F79;
    __device__ __forceinline__ void operator()(EPI_ARGS) const {
#pragma unroll
        for (int ai = 0; ai < 2; ++ai)
#pragma unroll
            for (int bj = 0; bj < 2; ++bj)
#pragma unroll
                for (int m = 0; m < 4; ++m)
#pragma unroll
                    for (int n = 0; n < 2; ++n) asm volatile("" :: "v"(acc[ai][bj][m][n]));
    }
};
struct EpiDown {
    static constexpr bool PERM = true, SIDE = true; static constexpr int SCALES = 0x7D79;
    bf16_t* YS; unsigned bias_off;
    __device__ __forceinline__ unsigned side_off(const Unit& u) const { return bias_off + (unsigned)((u.aux * 4 + u.pn) * 1024); }
    __device__ __forceinline__ void init(f32x4 (&acc)[2][2][4][2], const LAS float* side, int wc, int fq) const {
#pragma unroll
        for (int bj = 0; bj < 2; ++bj)
#pragma unroll
            for (int n = 0; n < 2; ++n) { const f32x4 b = *(const LAS f32x4*)(side + 128 * bj + 32 * wc + 8 * fq + 4 * n);
#pragma unroll
                for (int ai = 0; ai < 2; ++ai)
#pragma unroll
                    for (int m = 0; m < 4; ++m) acc[ai][bj][m][n] = b; }
    }
    __device__ __forceinline__ void operator()(EPI_ARGS) const {
        const int row0 = u.pm * 256 + wr * 64 + fr, col0 = u.pn * 256 + wc * 32 + 8 * fq;
#pragma unroll
        for (int ai = 0; ai < 2; ++ai)
#pragma unroll
            for (int m = 0; m < 4; ++m) { bf16_t* rowp = YS + (size_t)(row0 + ai * 128 + m * 16) * D + col0;
#pragma unroll
                for (int bj = 0; bj < 2; ++bj) { const f32x4 v0 = acc[ai][bj][m][0], v1 = acc[ai][bj][m][1];
                    u32x4 w; w.x = cvt_pk_bf16(v0[0], v0[1]); w.y = cvt_pk_bf16(v0[2], v0[3]); w.z = cvt_pk_bf16(v1[0], v1[1]); w.w = cvt_pk_bf16(v1[2], v1[3]);
                    *(u32x4*)(rowp + bj * 128) = w; } }
    }
};
struct EpiQkv {
    static constexpr bool PERM = true, SIDE = false; static constexpr int SCALES = 0x7F79;
    bf16_t* Q; bf16_t* Kx; bf16_t* VT;
    __device__ __forceinline__ void operator()(EPI_ARGS) const {
        const int row0 = u.pm * 256 + wr * 64 + fr; bf16_t* base; int ldc, colt; float sc = 1.0f;
        if (u.aux == 0) { ldc = D; if (u.pn < 4) { base = Q; colt = u.pn * 256; sc = 0.125f * 1.44269504089f; } else { base = Kx; colt = (u.pn - 4) * 256; } }
        else { base = VT; ldc = MPAD; colt = u.pn * 256; }
        const int col0 = colt + wc * 32 + 8 * fq;
#pragma unroll
        for (int ai = 0; ai < 2; ++ai)
#pragma unroll
            for (int m = 0; m < 4; ++m) { bf16_t* rowp = base + (size_t)(row0 + ai * 128 + m * 16) * ldc + col0;
#pragma unroll
                for (int bj = 0; bj < 2; ++bj) { const f32x4 v0 = acc[ai][bj][m][0] * sc, v1 = acc[ai][bj][m][1] * sc;
                    u32x4 w; w.x = cvt_pk_bf16(v0[0], v0[1]); w.y = cvt_pk_bf16(v0[2], v0[3]); w.z = cvt_pk_bf16(v1[0], v1[1]); w.w = cvt_pk_bf16(v1[2], v1[3]);
                    *(u32x4*)(rowp + bj * 128) = w; } }
    }
};

struct CvItem { const float* src; unsigned char* dst; int ld, pitch, f8; };
__device__ __forceinline__ CvItem cv_item(const Ctx& C, unsigned char* wsl, int it) {
    constexpr int I0 = 512, I1 = 256, I2 = 256, I3 = 768, I4 = 256, I5 = 32768, I6 = 16384;
    CvItem q; int r = it;
    if (r < I0) { const int nbk = r & 63, kb = r >> 6; q.src = C.in[I_WIN] + (size_t)(128 * kb) * 2048 + 32 * nbk; q.ld = 2048; q.dst = wsl + WS_WIN + ((size_t)(32 * nbk) * 1024 + 128 * kb) * 2; q.pitch = 2048; q.f8 = 0; return q; } r -= I0;
    if (r < I1) { const int job = r >> 3, sub = r & 7, nbk = sub & 3, kb = sub >> 2;
        const int half = job & 1, which = (job >> 1) & 1, nb = (job >> 2) & 3, dir = job >> 4;
        q.src = C.in[which ? I_WX : I_WA] + (size_t)(dir * 4 + nb) * 65536 + (size_t)(128 * kb) * 256 + 128 * half + 32 * nbk; q.ld = 256;
        q.dst = wsl + WS_GATE + (((size_t)nb * 1024 + 256 * (2 * dir + half) + 128 * which + 32 * nbk) * 256 + 128 * kb) * 2; q.pitch = 512; q.f8 = 0; return q; } r -= I1;
    if (r < I2) { const int nbk = r & 31, kb = r >> 5; q.src = C.in[I_LOUT] + (size_t)(128 * kb) * 1024 + 32 * nbk; q.ld = 1024; q.dst = wsl + WS_LOUT + ((size_t)(32 * nbk) * 1024 + 128 * kb) * 2; q.pitch = 2048; q.f8 = 0; return q; } r -= I2;
    if (r < I3) { const int nbk = r % 96, kb = r / 96; q.src = C.in[I_WQKV] + (size_t)(128 * kb) * 3072 + 32 * nbk; q.ld = 3072; q.dst = wsl + WS_QKV + ((size_t)(32 * nbk) * 1024 + 128 * kb) * 2; q.pitch = 2048; q.f8 = 0; return q; } r -= I3;
    if (r < I4) { const int nbk = r & 31, kb = r >> 5; q.src = C.in[I_NOUT] + (size_t)(128 * kb) * 1024 + 32 * nbk; q.ld = 1024; q.dst = wsl + WS_NOUT + ((size_t)(32 * nbk) * 1024 + 128 * kb) * 2; q.pitch = 2048; q.f8 = 0; return q; } r -= I4;
    q.f8 = 1; q.pitch = 1024;
    if (r < I5) { const int mat = r >> 9, sub = r & 511, nbk = sub & 63, kb = sub >> 6; const int n0 = 32 * nbk, bj = n0 >> 10, f0 = n0 & 1023, pn = f0 >> 7, jj = f0 & 127;
        q.src = C.in[I_WGU] + (size_t)mat * 1024 * 2048 + (size_t)(128 * kb) * 2048 + n0; q.ld = 2048; q.dst = wsl + WS_WGU + ((size_t)mat * 2048 + 256 * pn + 128 * bj + jj) * 1024 + 128 * kb; return q; } r -= I5;
    if (r < I6) { const int mat = r >> 8, sub = r & 255, nbk = sub & 31, kb = sub >> 5;
        q.src = C.in[I_WD] + (size_t)mat * 1024 * 1024 + (size_t)(128 * kb) * 1024 + 32 * nbk; q.ld = 1024; q.dst = wsl + WS_WD + ((size_t)mat * 1024 + 32 * nbk) * 1024 + 128 * kb; return q; } r -= I6;
    { const int nbk = r % 96, kb = r / 96; q.src = C.in[I_WQKV] + (size_t)(128 * kb) * 3072 + 32 * nbk; q.ld = 3072; q.dst = wsl + WS_QKV8 + (size_t)(32 * nbk) * 1024 + 128 * kb; return q; }
}
__device__ __forceinline__ void phase_convert(const Ctx& C) {
    PHASE_IDS
    LAS float* scr = (LAS float*)(C.lds + wave * 16896);
    const int gw = C.bid * NWAVES + wave, NGW = C.G * NWAVES;
    constexpr int NIT = 512 + 256 + 256 + 768 + 256 + 32768 + 16384 + 768;
    if (gw < NIT) {
        const int r = lane >> 3, q4 = lane & 7, c = lane & 15, nn = lane >> 4;
        CvItem cur = cv_item(C, wsl, gw); int it = gw;
        f32x4 v[16];
#pragma unroll
        for (int i = 0; i < 16; ++i) v[i] = __builtin_nontemporal_load((const f32x4*)(cur.src + (size_t)(8 * i + r) * cur.ld + 4 * q4));
        for (;;) {
#pragma unroll
            for (int i = 0; i < 16; ++i) { LAS float* sp = scr + (8 * i + r) * 33 + 4 * q4; sp[0] = v[i][0]; sp[1] = v[i][1]; sp[2] = v[i][2]; sp[3] = v[i][3]; }
            const int nit = it + NGW; CvItem nxt = cur;
            if (nit < NIT) { nxt = cv_item(C, wsl, nit);
#pragma unroll
                for (int i = 0; i < 16; ++i) v[i] = __builtin_nontemporal_load((const f32x4*)(nxt.src + (size_t)(8 * i + r) * nxt.ld + 4 * q4)); }
            asm volatile("s_waitcnt lgkmcnt(0)" ::: "memory");
            if (cur.f8) {
#pragma unroll
                for (int j = 0; j < 8; ++j) { const int n = nn + 4 * j; const LAS float* sp = scr + (8 * c) * 33 + n;
                    u32x2 o; o.x = pk4_fp8(sp[0] * 64.0f, sp[33] * 64.0f, sp[2 * 33] * 64.0f, sp[3 * 33] * 64.0f); o.y = pk4_fp8(sp[4 * 33] * 64.0f, sp[5 * 33] * 64.0f, sp[6 * 33] * 64.0f, sp[7 * 33] * 64.0f);
                    *(u32x2*)(cur.dst + (size_t)n * cur.pitch + 8 * c) = o; }
            } else {
#pragma unroll
                for (int j = 0; j < 8; ++j) { const int n = nn + 4 * j; const LAS float* sp = scr + (8 * c) * 33 + n;
                    u32x4 o; o.x = pk2(sp[0], sp[33]); o.y = pk2(sp[2 * 33], sp[3 * 33]); o.z = pk2(sp[4 * 33], sp[5 * 33]); o.w = pk2(sp[6 * 33], sp[7 * 33]);
                    *(u32x4*)(cur.dst + (size_t)n * cur.pitch + 16 * c) = o; }
            }
            asm volatile("s_waitcnt lgkmcnt(0)" ::: "memory");
            if (nit >= NIT) break;
            cur = nxt; it = nit;
        }
    }
    const int gt = C.bid * NTHREADS + tid, NGT = C.G * NTHREADS;
    for (int i = gt; i < 2048; i += NGT) ((float*)(wsl + WS_CTL + CT_SPL))[i] = 8.0f * 1.44269504089f * log1pf(expf(-C.in[I_LAM][i]));
    for (int i = gt; i < 2 * 32 * 2048; i += NGT) { const int le = i >> 11, r = i & 2047, pn = r >> 8, bj = (r >> 7) & 1, ii = r & 127;
        ((float*)(wsl + WS_BIAS))[i] = C.in[I_BGU][(size_t)le * 2048 + bj * 1024 + 128 * pn + ii]; }
    for (int i = gt; i < 2 * 32 * 1024; i += NGT) ((float*)(wsl + WS_BD))[i] = C.in[I_BD][i];
    for (int i = gt; i < 4096; i += NGT) { const int ut = i >> 8, which = (i >> 7) & 1, jj = i & 127, dir = ut >> 3, nb = (ut >> 1) & 3, half = ut & 1;
        ((float*)(wsl + WS_GBIAS))[i] = C.in[which ? I_BX : I_BA][dir * 1024 + 256 * nb + 128 * half + jj]; }
    for (int i0 = gt; i0 < NTOK * 128; i0 += 4 * NGT) { f32x4 a[4], b[4];
#pragma unroll
        for (int u = 0; u < 4; ++u) { const int i = i0 + u * NGT; if (i < NTOK * 128) { const int row = i >> 7, oc = i & 127;
            const float* src = (row < NGRID ? C.in[I_X] + (size_t)row * D : C.in[I_META] + (size_t)((row - NGRID) & 15) * D) + 8 * oc;
            a[u] = __builtin_nontemporal_load((const f32x4*)src); b[u] = __builtin_nontemporal_load((const f32x4*)(src + 4)); } }
#pragma unroll
        for (int u = 0; u < 4; ++u) { const int i = i0 + u * NGT; if (i < NTOK * 128) { const int row = i >> 7, oc = i & 127;
            u32x4 w; w.x = pk2(a[u][0], a[u][1]); w.y = pk2(a[u][2], a[u][3]); w.z = pk2(b[u][0], b[u][1]); w.w = pk2(b[u][2], b[u][3]);
            *(u32x4*)((bf16_t*)(wsl + WS_HB) + (size_t)row * D + 8 * oc) = w; } } }
}

__device__ __forceinline__ void phase_conv(const Ctx& C) {
    PHASE_IDS
    const bf16_t* XR = (const bf16_t*)(wsl + WS_XR); bf16_t* XC = (bf16_t*)(wsl + WS_XC);
    const float* cw = C.in[I_CONVW]; const float* cb = C.in[I_CONVB];
    const int gt = C.bid * NTHREADS + tid, NGT = C.G * NTHREADS;
    for (int i = gt; i < NTOK * 128; i += NGT) { const int row = i >> 7, ch = 8 * (i & 127);
        int b, s; if (row < NGRID) { b = row >> 12; s = NMETA + (row & (SEQ - 1)); } else { b = (row - NGRID) >> 4; s = (row - NGRID) & 15; }
        float a[8];
        { const f32x4 t0 = *(const f32x4*)(cb + ch), t1 = *(const f32x4*)(cb + ch + 4);
#pragma unroll
          for (int j = 0; j < 4; ++j) { a[j] = t0[j]; a[4 + j] = t1[j]; } }
#pragma unroll
        for (int j = 0; j < 4; ++j) { const int sj = s - 2 + j;
            if (sj >= 0 && sj < LSEQ) { const u32x4 xw = *(const u32x4*)(XR + (size_t)seqrow(b, sj) * D + ch);
                const f32x4 w0 = *(const f32x4*)(cw + j * 1024 + ch), w1 = *(const f32x4*)(cw + j * 1024 + ch + 4);
                a[0] += w0[0] * bflo(xw.x); a[1] += w0[1] * bfhi(xw.x); a[2] += w0[2] * bflo(xw.y); a[3] += w0[3] * bfhi(xw.y);
                a[4] += w1[0] * bflo(xw.z); a[5] += w1[1] * bfhi(xw.z); a[6] += w1[2] * bflo(xw.w); a[7] += w1[3] * bfhi(xw.w); } }
        u32x4 w; w.x = pk2(a[0], a[1]); w.y = pk2(a[2], a[3]); w.z = pk2(a[4], a[5]); w.w = pk2(a[6], a[7]);
        *(u32x4*)(XC + (size_t)row * D + ch) = w; }
}

template <int N> __device__ __forceinline__ float dpp_shr(float oldv, float v) {
    return __builtin_bit_cast(float, __builtin_amdgcn_update_dpp(__builtin_bit_cast(int, oldv), __builtin_bit_cast(int, v), 0x110 + N, 0xf, 0xf, false));
}
__device__ __forceinline__ void scan_group(float (&a)[8], float (&b)[8]) {
#pragma unroll
    for (int c = 0; c < 8; ++c) {
        { const float ap = dpp_shr<1>(1.0f, a[c]), bp = dpp_shr<1>(0.0f, b[c]); b[c] = a[c] * bp + b[c]; a[c] = a[c] * ap; }
        { const float ap = dpp_shr<2>(1.0f, a[c]), bp = dpp_shr<2>(0.0f, b[c]); b[c] = a[c] * bp + b[c]; a[c] = a[c] * ap; }
        { const float ap = dpp_shr<4>(1.0f, a[c]), bp = dpp_shr<4>(0.0f, b[c]); b[c] = a[c] * bp + b[c]; a[c] = a[c] * ap; }
        { const float ap = dpp_shr<8>(1.0f, a[c]), bp = dpp_shr<8>(0.0f, b[c]); b[c] = a[c] * bp + b[c]; a[c] = a[c] * ap; }
    }
}
__device__ __forceinline__ void unpack8(const u32x4 w, float (&o)[8]) { o[0] = bflo(w.x); o[1] = bfhi(w.x); o[2] = bflo(w.y); o[3] = bfhi(w.y); o[4] = bflo(w.z); o[5] = bfhi(w.z); o[6] = bflo(w.w); o[7] = bfhi(w.w); }
__device__ __forceinline__ void phase_scan(const Ctx& C) {
    PHASE_IDS
    const bf16_t* LA = (const bf16_t*)(wsl + WS_LA); const bf16_t* BB = (const bf16_t*)(wsl + WS_BB); const bf16_t* GY = (const bf16_t*)(wsl + WS_GY);
    bf16_t* HF = (bf16_t*)(wsl + WS_HF); bf16_t* Gout = (bf16_t*)(wsl + WS_G);
    LAS float* agg = (LAS float*)C.lds;
    const int w = wave, oct = lane >> 4, p = lane & 15;
    for (int it0 = (C.G == 256 ? C.gc : C.bid); it0 < NB * 32; it0 += C.G) {
        const int item = (C.G == 256) ? (((it0 >> 3) >> 2) << 5) + ((it0 & 7) << 2) + ((it0 >> 3) & 3) : it0;
        const int b = item >> 5, g = item & 31;
        for (int dir = 0; dir < 2; ++dir) {
            const bf16_t* la = LA + (((size_t)dir * 32 + g) * MPAD) * 32 + 8 * oct;
            const bf16_t* bb = BB + (((size_t)dir * 32 + g) * MPAD) * 32 + 8 * oct;
            float S[8];
#pragma unroll
            for (int c = 0; c < 8; ++c) S[c] = 0.f;
            {
                const int u = p, s = dir ? LSEQ - 1 - u : u, row = seqrow(b, s);
                float a[8], x[8]; unpack8(*(const u32x4*)(la + (size_t)row * 32), a); unpack8(*(const u32x4*)(bb + (size_t)row * 32), x);
#pragma unroll
                for (int c = 0; c < 8; ++c) a[c] = fast_exp2(a[c]);
                scan_group(a, x);
                if (w == 0) {
                    if (dir == 0) { u32x4 o; o.x = pk2(x[0], x[1]); o.y = pk2(x[2], x[3]); o.z = pk2(x[4], x[5]); o.w = pk2(x[6], x[7]); *(u32x4*)(HF + ((size_t)g * MPAD + row) * 32 + 8 * oct) = o; }
                    else { float hf[8], gy[8]; unpack8(*(const u32x4*)(HF + ((size_t)g * MPAD + row) * 32 + 8 * oct), hf); unpack8(*(const u32x4*)(GY + ((size_t)g * MPAD + row) * 32 + 8 * oct), gy);
                        u32x4 o; o.x = pk2((hf[0] + x[0]) * gy[0], (hf[1] + x[1]) * gy[1]); o.y = pk2((hf[2] + x[2]) * gy[2], (hf[3] + x[3]) * gy[3]);
                        o.z = pk2((hf[4] + x[4]) * gy[4], (hf[5] + x[5]) * gy[5]); o.w = pk2((hf[6] + x[6]) * gy[6], (hf[7] + x[7]) * gy[7]);
                        *(u32x4*)(Gout + (size_t)row * D + 32 * g + 8 * oct) = o; }
                }
#pragma unroll
                for (int c = 0; c < 8; ++c) S[c] = __shfl(x[c], (lane & 48) | 15);
            }
            u32x4 na[4], nb[4];
#pragma unroll
            for (int j = 0; j < 4; ++j) { const int u = 16 + 64 * w + 16 * j + p, s = dir ? LSEQ - 1 - u : u; const int rw = seqrow(b, s);
                na[j] = __builtin_nontemporal_load((const u32x4*)(la + (size_t)rw * 32)); nb[j] = __builtin_nontemporal_load((const u32x4*)(bb + (size_t)rw * 32)); }
            for (int r = 0; r < 8; ++r) {
                float Pw[4][8], Hw[4][8]; int rows[4];
                float Aw[8], Hc[8];
#pragma unroll
                for (int c = 0; c < 8; ++c) { Aw[c] = 1.f; Hc[c] = 0.f; }
                u32x4 ra[4], rb[4], rhf[4], rgy[4];
#pragma unroll
                for (int j = 0; j < 4; ++j) { const int u = 16 + 512 * r + 64 * w + 16 * j + p, s = dir ? LSEQ - 1 - u : u; rows[j] = seqrow(b, s); ra[j] = na[j]; rb[j] = nb[j]; }
                if (r < 7) {
#pragma unroll
                    for (int j = 0; j < 4; ++j) { const int u = 16 + 512 * (r + 1) + 64 * w + 16 * j + p, s = dir ? LSEQ - 1 - u : u; const int rw = seqrow(b, s);
                        na[j] = __builtin_nontemporal_load((const u32x4*)(la + (size_t)rw * 32)); nb[j] = __builtin_nontemporal_load((const u32x4*)(bb + (size_t)rw * 32)); } }
                if (dir == 1) {
#pragma unroll
                    for (int j = 0; j < 4; ++j) { const size_t go = ((size_t)g * MPAD + rows[j]) * 32 + 8 * oct; rhf[j] = *(const u32x4*)(HF + go); rgy[j] = __builtin_nontemporal_load((const u32x4*)(GY + go)); } }
#pragma unroll
                for (int j = 0; j < 4; ++j) {
                    float a[8], x[8]; unpack8(ra[j], a); unpack8(rb[j], x);
#pragma unroll
                    for (int c = 0; c < 8; ++c) a[c] = fast_exp2(a[c]);
                    scan_group(a, x);
#pragma unroll
                    for (int c = 0; c < 8; ++c) { Hw[j][c] = a[c] * Hc[c] + x[c]; Pw[j][c] = a[c] * Aw[c]; }
#pragma unroll
                    for (int c = 0; c < 8; ++c) { Aw[c] = __shfl(Pw[j][c], (lane & 48) | 15); Hc[c] = __shfl(Hw[j][c], (lane & 48) | 15); }
                }
                LAS float* ag = agg + (r & 1) * 512;
                if (p == 0) {
#pragma unroll
                    for (int c = 0; c < 8; ++c) { ag[(w * 32 + oct * 8 + c) * 2] = Aw[c]; ag[(w * 32 + oct * 8 + c) * 2 + 1] = Hc[c]; }
                }
                __syncthreads();
                float Sin[8];
#pragma unroll
                for (int c = 0; c < 8; ++c) Sin[c] = S[c];
#pragma unroll
                for (int ww = 0; ww < 8; ++ww) {
#pragma unroll
                    for (int c = 0; c < 8; ++c) { const float A = ag[(ww * 32 + oct * 8 + c) * 2], H = ag[(ww * 32 + oct * 8 + c) * 2 + 1];
                        if (ww == w) Sin[c] = S[c];
                        S[c] = A * S[c] + H; }
                }
#pragma unroll
                for (int j = 0; j < 4; ++j) {
                    float h[8];
#pragma unroll
                    for (int c = 0; c < 8; ++c) h[c] = Pw[j][c] * Sin[c] + Hw[j][c];
                    const size_t go = ((size_t)g * MPAD + rows[j]) * 32 + 8 * oct;
                    if (dir == 0) { u32x4 o; o.x = pk2(h[0], h[1]); o.y = pk2(h[2], h[3]); o.z = pk2(h[4], h[5]); o.w = pk2(h[6], h[7]); *(u32x4*)(HF + go) = o; }
                    else { float hf[8], gy[8]; unpack8(rhf[j], hf); unpack8(rgy[j], gy);
                        u32x4 o; o.x = pk2((hf[0] + h[0]) * gy[0], (hf[1] + h[1]) * gy[1]); o.y = pk2((hf[2] + h[2]) * gy[2], (hf[3] + h[3]) * gy[3]);
                        o.z = pk2((hf[4] + h[4]) * gy[4], (hf[5] + h[5]) * gy[5]); o.w = pk2((hf[6] + h[6]) * gy[6], (hf[7] + h[7]) * gy[7]);
                        *(u32x4*)(Gout + (size_t)rows[j] * D + 32 * g + 8 * oct) = o; }
                }
            }
            __syncthreads();
        }
    }
}

template <int K> __device__ __forceinline__ f32x4 mini_mma(const bf16_t* W, int ldw, const bf16_t* A, int lda, int lane) {
    const bf16_t* wp = W + (size_t)(lane & 15) * ldw + 8 * (lane >> 4); const bf16_t* ap = A + (size_t)(lane & 15) * lda + 8 * (lane >> 4);
    f32x4 acc = {0.f, 0.f, 0.f, 0.f};
    constexpr int KB = K < 512 ? K : 512, NS = KB / 32;
#pragma unroll 1
    for (int k0 = 0; k0 < K; k0 += KB) { bf16x8 wf[NS], af[NS];
#pragma unroll
        for (int i = 0; i < NS; ++i) { wf[i] = *(const bf16x8*)(wp + k0 + 32 * i); af[i] = *(const bf16x8*)(ap + k0 + 32 * i); }
#pragma unroll
        for (int i = 0; i < NS; ++i) acc = __builtin_amdgcn_mfma_f32_16x16x32_bf16(wf[i], af[i], acc, 0, 0, 0); }
    return acc;
}
__device__ __forceinline__ void mini_win(const Ctx& C) {
    PHASE_IDS
    const bf16_t* HB = (const bf16_t*)(C.ws + WS_HB); const bf16_t* WT = (const bf16_t*)(C.ws + WS_WIN); bf16_t* XR = (bf16_t*)(C.ws + WS_XR); bf16_t* GY = (bf16_t*)(C.ws + WS_GY);
    const int fr = lane & 15, fq = lane >> 4;
    for (int wt = C.gc * NWAVES + wave; wt < 8 * 128; wt += C.G * NWAVES) { const int rg = wt & 7, cb = wt >> 3, row = NGRID + 16 * rg + fr, c = 16 * cb + 4 * fq;
        const f32x4 a = mini_mma<1024>(WT + (size_t)(16 * cb) * 1024, 1024, HB + (size_t)(NGRID + 16 * rg) * 1024, 1024, lane);
        if (c < 1024) { u32x2 w; w.x = cvt_pk_bf16(a[0], a[1]); w.y = cvt_pk_bf16(a[2], a[3]); *(u32x2*)(XR + (size_t)row * D + c) = w; }
        else { const int yc = c - 1024; float o[4];
#pragma unroll
            for (int j = 0; j < 4; ++j) { const float v = a[j]; const float z = 1.5957691216f * (v + 0.044715f * v * v * v); o[j] = v * sigmoidf_(z); }
            u32x2 w; w.x = cvt_pk_bf16(o[0], o[1]); w.y = cvt_pk_bf16(o[2], o[3]); *(u32x2*)(GY + ((size_t)(yc >> 5) * MPAD + row) * 32 + (yc & 31)) = w; } }
}
__device__ __forceinline__ void mini_gate(const Ctx& C) {
    PHASE_IDS
    const bf16_t* XC = (const bf16_t*)(C.ws + WS_XC); const bf16_t* GT = (const bf16_t*)(C.ws + WS_GATE); bf16_t* LA = (bf16_t*)(C.ws + WS_LA); bf16_t* BB = (bf16_t*)(C.ws + WS_BB);
    const float* ba = C.in[I_BA]; const float* bx = C.in[I_BX]; const float* spl = (const float*)(C.ws + WS_CTL + CT_SPL);
    const int fr = lane & 15, fq = lane >> 4;
    for (int wt = C.gc * NWAVES + wave; wt < 8 * 2 * 64; wt += C.G * NWAVES) { const int rg = wt & 7, dir = (wt >> 3) & 1, chg = wt >> 4, ch0 = 16 * chg, nb = ch0 >> 8, half = (ch0 >> 7) & 1, jj0 = ch0 & 127;
        const bf16_t* A = XC + (size_t)(NGRID + 16 * rg) * 1024 + 256 * nb; const bf16_t* Wa = GT + ((size_t)nb * 1024 + 256 * (2 * dir + half) + jj0) * 256;
        const f32x4 za = mini_mma<256>(Wa, 256, A, 1024, lane), zx = mini_mma<256>(Wa + 128 * 256, 256, A, 1024, lane);
        const int row = NGRID + 16 * rg + fr, ch = ch0 + 4 * fq;
        const f32x4 cba = *(const f32x4*)(ba + dir * 1024 + ch), cbx = *(const f32x4*)(bx + dir * 1024 + ch), csp = *(const f32x4*)(spl + dir * 1024 + ch);
        const u32x2 xw = *(const u32x2*)(XC + (size_t)row * D + ch); const float xc[4] = {bflo(xw.x), bfhi(xw.x), bflo(xw.y), bfhi(xw.y)};
        float la[4], bb[4];
#pragma unroll
        for (int j = 0; j < 4; ++j) { const float l2 = -csp[j] * sigmoidf_(za[j] + cba[j]); const float a2 = fast_exp2(2.0f * l2);
            const float mult = (dir == 0 && fr == 0) ? 1.0f : __builtin_amdgcn_sqrtf(fmaxf(1.0f - a2, 0.0f)); la[j] = l2; bb[j] = mult * sigmoidf_(zx[j] + cbx[j]) * xc[j]; }
        const size_t o = (((size_t)dir * 32 + (ch >> 5)) * MPAD + row) * 32 + (ch & 31);
        u32x2 w; w.x = cvt_pk_bf16(la[0], la[1]); w.y = cvt_pk_bf16(la[2], la[3]); *(u32x2*)(LA + o) = w;
        w.x = cvt_pk_bf16(bb[0], bb[1]); w.y = cvt_pk_bf16(bb[2], bb[3]); *(u32x2*)(BB + o) = w; }
}
__device__ __forceinline__ void mini_lout(const Ctx& C) {
    PHASE_IDS
    const bf16_t* G = (const bf16_t*)(C.ws + WS_G); const bf16_t* WT = (const bf16_t*)(C.ws + WS_LOUT); bf16_t* PRE = (bf16_t*)(C.ws + WS_PRE); const float* meta = C.in[I_META];
    const int fr = lane & 15, fq = lane >> 4;
    for (int wt = C.gc * NWAVES + wave; wt < 8 * 64; wt += C.G * NWAVES) { const int rg = wt & 7, cb = wt >> 3, row = NGRID + 16 * rg + fr, c = 16 * cb + 4 * fq;
        const f32x4 a = mini_mma<1024>(WT + (size_t)(16 * cb) * 1024, 1024, G + (size_t)(NGRID + 16 * rg) * 1024, 1024, lane);
        const f32x4 r = *(const f32x4*)(meta + (size_t)fr * D + c);
        u32x2 w; w.x = cvt_pk_bf16(r[0] * DN_ALPHA + a[0], r[1] * DN_ALPHA + a[1]); w.y = cvt_pk_bf16(r[2] * DN_ALPHA + a[2], r[3] * DN_ALPHA + a[3]); *(u32x2*)(PRE + (size_t)row * D + c) = w; }
}
__device__ __forceinline__ void mini_kv(const Ctx& C) {
    PHASE_IDS
    const bf16_t* HB = (const bf16_t*)(C.ws + WS_HB); const bf16_t* WT = (const bf16_t*)(C.ws + WS_QKV); bf16_t* Kx = (bf16_t*)(C.ws + WS_K); bf16_t* VT = (bf16_t*)(C.ws + WS_VT);
    const int fr = lane & 15, fq = lane >> 4;
    for (int wt = C.gc * NWAVES + wave; wt < 2 * 8 * 64; wt += C.G * NWAVES) { const int rg = wt & 7, cb = (wt >> 3) & 63, isv = wt >> 9;
        const bf16_t* A = HB + (size_t)(NGRID + 16 * rg) * 1024;
        if (!isv) { const f32x4 a = mini_mma<1024>(WT + (size_t)(1024 + 16 * cb) * 1024, 1024, A, 1024, lane);
            u32x2 w; w.x = cvt_pk_bf16(a[0], a[1]); w.y = cvt_pk_bf16(a[2], a[3]); *(u32x2*)(Kx + (size_t)(NGRID + 16 * rg + fr) * D + 16 * cb + 4 * fq) = w; }
        else { const f32x4 a = mini_mma<1024>(A, 1024, WT + (size_t)(2048 + 16 * cb) * 1024, 1024, lane);
            u32x2 w; w.x = cvt_pk_bf16(a[0], a[1]); w.y = cvt_pk_bf16(a[2], a[3]); *(u32x2*)(VT + (size_t)(16 * cb + fr) * MPAD + NGRID + 16 * rg + 4 * fq) = w; } }
}

constexpr int RWT_PITCH = 516;
__device__ __forceinline__ void phase_lnr(const Ctx& C, int layer, int nrows) {
    PHASE_IDS
    const bf16_t* PRE = (const bf16_t*)(wsl + WS_PRE); bf16_t* HB = (bf16_t*)(wsl + WS_HB); unsigned char* HB8 = wsl + WS_HB8;
    const float* lg = C.in[I_LNMG] + layer * D; const float* lb = C.in[I_LNMB] + layer * D;
    const float* rw = C.in[I_RW] + (size_t)layer * D * NEXP; const float* rb = C.in[I_RB] + layer * NEXP;
    int* eid = (int*)(wsl + WS_CTL + CT_EID) + (size_t)layer * NTOK * 4; float* gatev = (float*)(wsl + WS_CTL + CT_GATEV) + (size_t)layer * NTOK * 4;
    unsigned* bc = (unsigned*)(wsl + WS_CTL + CT_BC) + ((size_t)layer * 256 + C.bid) * 32;
    LAS unsigned* RWt = (LAS unsigned*)C.lds; LAS unsigned* hist = (LAS unsigned*)(C.lds + 32 * RWT_PITCH * 4);
#pragma unroll
    for (int i = 0; i < 8; ++i) { const int idx = tid + NTHREADS * i, pc = idx >> 3, e4 = (idx & 7) * 4, ch = 2 * pc;
        const f32x4 w0 = *(const f32x4*)(rw + (size_t)ch * NEXP + e4), w1 = *(const f32x4*)(rw + (size_t)(ch + 1) * NEXP + e4);
        const int slot = 4 * ((ch & 511) >> 3) + 256 * (ch >> 9) + ((ch & 7) >> 1);
        RWt[(e4 + 0) * RWT_PITCH + slot] = pk2(w0[0], w1[0]); RWt[(e4 + 1) * RWT_PITCH + slot] = pk2(w0[1], w1[1]); RWt[(e4 + 2) * RWT_PITCH + slot] = pk2(w0[2], w1[2]); RWt[(e4 + 3) * RWT_PITCH + slot] = pk2(w0[3], w1[3]); }
    if (tid < 32) hist[tid] = 0u;
    __syncthreads();
    float gg[2][8], gb[2][8];
#pragma unroll
    for (int j = 0; j < 2; ++j) { const f32x4 a0 = *(const f32x4*)(lg + 8 * lane + 512 * j), a1 = *(const f32x4*)(lg + 8 * lane + 512 * j + 4), b0 = *(const f32x4*)(lb + 8 * lane + 512 * j), b1 = *(const f32x4*)(lb + 8 * lane + 512 * j + 4);
#pragma unroll
        for (int i = 0; i < 4; ++i) { gg[j][i] = a0[i]; gg[j][4 + i] = a1[i]; gb[j][i] = b0[i]; gb[j][4 + i] = b1[i]; } }
    const float rbias = rb[lane >> 1];
    const int gw = C.bid * NWAVES + wave, NGW = C.G * NWAVES;
    u32x4 nv[2];
    if (gw < nrows) {
#pragma unroll
        for (int j = 0; j < 2; ++j) nv[j] = __builtin_nontemporal_load((const u32x4*)(PRE + (size_t)gw * D + 8 * lane + 512 * j)); }
    for (int row = gw; row < nrows; row += NGW) {
        float v[2][8]; float s = 0.f; u32x4 hp[2];
#pragma unroll
        for (int j = 0; j < 2; ++j) { unpack8(nv[j], v[j]); s += ((v[j][0] + v[j][1]) + (v[j][2] + v[j][3])) + ((v[j][4] + v[j][5]) + (v[j][6] + v[j][7])); }
        if (row + NGW < nrows) {
#pragma unroll
            for (int j = 0; j < 2; ++j) nv[j] = __builtin_nontemporal_load((const u32x4*)(PRE + (size_t)(row + NGW) * D + 8 * lane + 512 * j)); }
        const float mean = wave_sum_dpp(s) * (1.0f / D); float q = 0.f;
#pragma unroll
        for (int j = 0; j < 2; ++j)
#pragma unroll
            for (int i = 0; i < 8; ++i) { v[j][i] -= mean; q += v[j][i] * v[j][i]; }
        const float rstd = __builtin_amdgcn_rsqf(wave_sum_dpp(q) * (1.0f / D) + LN_EPS);
#pragma unroll
        for (int j = 0; j < 2; ++j) {
#pragma unroll
            for (int i = 0; i < 8; ++i) v[j][i] = v[j][i] * rstd * gg[j][i] + gb[j][i];
            u32x4 w; w.x = pk2(v[j][0], v[j][1]); w.y = pk2(v[j][2], v[j][3]); w.z = pk2(v[j][4], v[j][5]); w.w = pk2(v[j][6], v[j][7]);
            *(u32x4*)(HB + (size_t)row * D + 8 * lane + 512 * j) = w; hp[j] = w;
            u32x2 w8; w8.x = pk4_fp8(v[j][0], v[j][1], v[j][2], v[j][3]); w8.y = pk4_fp8(v[j][4], v[j][5], v[j][6], v[j][7]);
            *(u32x2*)(HB8 + (size_t)row * D + 8 * lane + 512 * j) = w8; }
        float pl[32];
#pragma unroll
        for (int e0 = 0; e0 < 32; e0 += 8) {
            u32x4 wv[8][2];
#pragma unroll
            for (int ee = 0; ee < 8; ++ee)
#pragma unroll
                for (int j = 0; j < 2; ++j) wv[ee][j] = *(const LAS u32x4*)(RWt + (e0 + ee) * RWT_PITCH + 4 * lane + 256 * j);
            __builtin_amdgcn_sched_barrier(0);
#pragma unroll
            for (int ee = 0; ee < 8; ++ee) { float a = 0.f;
#pragma unroll
                for (int j = 0; j < 2; ++j) { a = dot2_bf16(hp[j].x, wv[ee][j].x, a);
                    a = dot2_bf16(hp[j].y, wv[ee][j].y, a);
                    a = dot2_bf16(hp[j].z, wv[ee][j].z, a);
                    a = dot2_bf16(hp[j].w, wv[ee][j].w, a); }
                pl[e0 + ee] = a; }
        }
        float q16[16], q8[8], q4[4], q2[2], q1;
        { const bool hi = (lane & 32) != 0;
#pragma unroll
          for (int e = 0; e < 16; ++e) { const float mine = hi ? pl[16 + e] : pl[e], other = hi ? pl[e] : pl[16 + e]; q16[e] = mine + __shfl_xor(other, 32); } }
        { const bool hi = (lane & 16) != 0;
#pragma unroll
          for (int e = 0; e < 8; ++e) { const float mine = hi ? q16[8 + e] : q16[e], other = hi ? q16[e] : q16[8 + e]; q8[e] = mine + __shfl_xor(other, 16); } }
        { const bool hi = (lane & 8) != 0;
#pragma unroll
          for (int e = 0; e < 4; ++e) { const float mine = hi ? q8[4 + e] : q8[e], other = hi ? q8[e] : q8[4 + e]; q4[e] = mine + dpp_movf<0x128>(other); } }
        { const bool hi = (lane & 4) != 0;
#pragma unroll
          for (int e = 0; e < 2; ++e) { const float mine = hi ? q4[2 + e] : q4[e], other = hi ? q4[e] : q4[2 + e]; q2[e] = mine + __shfl_xor(other, 4); } }
        { const bool hi = (lane & 2) != 0; const float mine = hi ? q2[1] : q2[0], other = hi ? q2[0] : q2[1]; q1 = mine + dpp_movf<0x4E>(other); }
        q1 += dpp_movf<0xB1>(q1);
        float lv = q1 + rbias; lv = (lv == lv) ? lv : -3.0e38f;
        const int le = lane >> 1;
        int rank = 0;
#pragma unroll
        for (int j = 0; j < 32; ++j) { const float lj = readlane_f(lv, 2 * j); rank += (lj > lv || (lj == lv && j < le)) ? 1 : 0; }
        const unsigned long long m0 = __ballot(rank == 0);
        const float mxl = readlane_f(lv, (int)__builtin_ctzll(m0));
        const float pe = rank < 4 ? __expf(lv - mxl) : 0.f;
        const float den = wave_sum_dpp(pe) * 0.5f;
        if (rank < 4 && (lane & 1) == 0) { eid[(size_t)row * 4 + rank] = le; gatev[(size_t)row * 4 + rank] = pe / den;
            __hip_atomic_fetch_add(&hist[le], 1u, __ATOMIC_RELAXED, __HIP_MEMORY_SCOPE_WORKGROUP); }
    }
    __syncthreads();
    if (tid < 32) bc[tid] = hist[tid];
}

__device__ __forceinline__ void phase_pos(const Ctx& C, int layer, int nrows) {
    PHASE_IDS
    const unsigned* bcAll = (const unsigned*)(wsl + WS_CTL + CT_BC) + (size_t)layer * 256 * 32;
    const int* eid = (const int*)(wsl + WS_CTL + CT_EID) + (size_t)layer * NTOK * 4; int* posv = (int*)(wsl + WS_CTL + CT_POS) + (size_t)layer * NTOK * 4;
    int* texp = (int*)(wsl + WS_CTL + CT_TEXP) + layer * 1024;
    int* tokoff = (int*)(wsl + WS_TOK) + (size_t)layer * (1 * MiB / 4);
    LAS unsigned* partT = (LAS unsigned*)C.lds; LAS unsigned* partP = partT + 512; LAS unsigned* tot = partP + 512; LAS unsigned* cnt = tot + 32;
    { const int e = tid & 31, part = tid >> 5; unsigned t = 0, pr = 0;
      unsigned vv[16];
#pragma unroll
      for (int i = 0; i < 16; ++i) { const int bq = part + 16 * i; vv[i] = bq < C.G ? bcAll[(size_t)bq * 32 + e] : 0u; }
#pragma unroll
      for (int i = 0; i < 16; ++i) { const int bq = part + 16 * i; t += vv[i]; if (bq < C.bid) pr += vv[i]; }
      partT[part * 32 + e] = t; partP[part * 32 + e] = pr; }
    __syncthreads();
    if (tid < 32) { unsigned t = 0, pr = 0; for (int i = 0; i < 16; ++i) { t += partT[i * 32 + tid]; pr += partP[i * 32 + tid]; } tot[tid] = t; cnt[tid] = pr; }
    __syncthreads();
    if (tid < 32) { unsigned off = 0; for (int e = 0; e < tid; ++e) off += (tot[e] + 255u) & ~255u;
        const unsigned mine = (tot[tid] + 255u) & ~255u;
        if (C.bid == 0) { for (unsigned t = off >> 8; t < ((off + mine) >> 8); ++t) texp[t] = tid; if (tid == 31) texp[1023] = (int)((off + mine) >> 8);
            for (unsigned p = off + tot[tid]; p < off + mine; ++p) tokoff[p] = 0; }
        cnt[tid] += off; }
    __syncthreads();
    const int gw = C.bid * NWAVES + wave, NGW = C.G * NWAVES;
    for (int row = gw; row < nrows; row += NGW) {
        int pos = 0;
        if (lane < 4) { const int e = eid[(size_t)row * 4 + lane]; pos = (int)__hip_atomic_fetch_add(&cnt[e], 1u, __ATOMIC_RELAXED, __HIP_MEMORY_SCOPE_WORKGROUP); posv[(size_t)row * 4 + lane] = pos; }
        if (lane < 4) tokoff[pos] = row * 1024;
    }
}

__device__ __forceinline__ void phase_combine(const Ctx& C, int layer, int nrows, bool final_out) {
    PHASE_IDS
    bf16_t* HB = (bf16_t*)(wsl + WS_HB); unsigned char* HB8 = wsl + WS_HB8; const bf16_t* YS = (const bf16_t*)(wsl + WS_YS);
    const float* lg = C.in[I_LNFG] + layer * D; const float* lb = C.in[I_LNFB] + layer * D;
    const float* gatev = (const float*)(wsl + WS_CTL + CT_GATEV) + (size_t)layer * NTOK * 4; const int* posv = (const int*)(wsl + WS_CTL + CT_POS) + (size_t)layer * NTOK * 4;
    float gg[2][8], gb[2][8];
#pragma unroll
    for (int j = 0; j < 2; ++j) { const f32x4 a0 = *(const f32x4*)(lg + 8 * lane + 512 * j), a1 = *(const f32x4*)(lg + 8 * lane + 512 * j + 4), b0 = *(const f32x4*)(lb + 8 * lane + 512 * j), b1 = *(const f32x4*)(lb + 8 * lane + 512 * j + 4);
#pragma unroll
        for (int i = 0; i < 4; ++i) { gg[j][i] = a0[i]; gg[j][4 + i] = a1[i]; gb[j][i] = b0[i]; gb[j][4 + i] = b1[i]; } }
    const int gw = C.bid * NWAVES + wave, NGW = C.G * NWAVES;
    f32x4 g1 = {0.f, 0.f, 0.f, 0.f}, g2 = g1; int p1[4] = {0, 0, 0, 0}, p2[4] = {0, 0, 0, 0};
    u32x4 hwn[2], ywn[4][2];
#define CB_ROUTE(row_, gq, pq) do { gq = *(const f32x4*)(gatev + (size_t)(row_) * 4); const u32x4 _pp = *(const u32x4*)(posv + (size_t)(row_) * 4); pq[0] = (int)_pp.x; pq[1] = (int)_pp.y; pq[2] = (int)_pp.z; pq[3] = (int)_pp.w; } while (0)
#define CB_DATA(row_, pq) do { _Pragma("unroll") for (int j = 0; j < 2; ++j) { hwn[j] = *(const u32x4*)(HB + (size_t)(row_) * D + 8 * lane + 512 * j); \
            _Pragma("unroll") for (int k = 0; k < 4; ++k) ywn[k][j] = __builtin_nontemporal_load((const u32x4*)(YS + (size_t)pq[k] * D + 8 * lane + 512 * j)); } } while (0)
    if (gw < nrows) { CB_ROUTE(gw, g1, p1); CB_DATA(gw, p1); }
    if (gw + NGW < nrows) CB_ROUTE(gw + NGW, g2, p2);
    for (int row = gw; row < nrows; row += NGW) {
        const f32x4 gk4 = g1; u32x4 hw[2], yw[4][2];
#pragma unroll
        for (int j = 0; j < 2; ++j) { hw[j] = hwn[j];
#pragma unroll
            for (int k = 0; k < 4; ++k) yw[k][j] = ywn[k][j]; }
        g1 = g2;
#pragma unroll
        for (int k = 0; k < 4; ++k) p1[k] = p2[k];
        if (row + NGW < nrows) CB_DATA(row + NGW, p1);
        if (row + 2 * NGW < nrows) CB_ROUTE(row + 2 * NGW, g2, p2);
        float v[2][8]; float s = 0.f;
#pragma unroll
        for (int j = 0; j < 2; ++j) { float h[8]; unpack8(hw[j], h);
#pragma unroll
            for (int i = 0; i < 8; ++i) v[j][i] = h[i] * DN_ALPHA;
#pragma unroll
            for (int k = 0; k < 4; ++k) { float y[8]; unpack8(yw[k][j], y);
#pragma unroll
                for (int i = 0; i < 8; ++i) v[j][i] += gk4[k] * y[i]; }
#pragma unroll
            for (int i = 0; i < 8; ++i) s += v[j][i]; }
        const float mean = wave_sum_dpp(s) * (1.0f / D); float q = 0.f;
#pragma unroll
        for (int j = 0; j < 2; ++j)
#pragma unroll
            for (int i = 0; i < 8; ++i) { v[j][i] -= mean; q += v[j][i] * v[j][i]; }
        const float rstd = __builtin_amdgcn_rsqf(wave_sum_dpp(q) * (1.0f / D) + LN_EPS);
#pragma unroll
        for (int j = 0; j < 2; ++j) {
#pragma unroll
            for (int i = 0; i < 8; ++i) v[j][i] = v[j][i] * rstd * gg[j][i] + gb[j][i];
            if (final_out) { *(f32x4*)(C.out + (size_t)row * D + 8 * lane + 512 * j) = (f32x4){v[j][0], v[j][1], v[j][2], v[j][3]}; *(f32x4*)(C.out + (size_t)row * D + 8 * lane + 512 * j + 4) = (f32x4){v[j][4], v[j][5], v[j][6], v[j][7]}; }
            else { u32x4 w; w.x = pk2(v[j][0], v[j][1]); w.y = pk2(v[j][2], v[j][3]); w.z = pk2(v[j][4], v[j][5]); w.w = pk2(v[j][6], v[j][7]); *(u32x4*)(HB + (size_t)row * D + 8 * lane + 512 * j) = w;
                u32x2 w8; w8.x = pk4_fp8(v[j][0], v[j][1], v[j][2], v[j][3]); w8.y = pk4_fp8(v[j][4], v[j][5], v[j][6], v[j][7]); *(u32x2*)(HB8 + (size_t)row * D + 8 * lane + 512 * j) = w8; } }
    }
#undef CB_ROUTE
#undef CB_DATA
}

constexpr int AT_KS = 0, AT_VTS = 73728, AT_VPITCH = 1168, AT_KM = AT_VTS + 64 * AT_VPITCH, AT_VTM = AT_KM + 2048, AT_RPB = AT_VTM + 2048, AT_MB = AT_RPB + 1920, AT_END = AT_MB + 64;
static_assert(AT_END <= LDS_BYTES, "attention LDS map");
__device__ __forceinline__ void phase_attn(const Ctx& C) {
    PHASE_IDS
    bf16_t* O = (bf16_t*)(wsl + WS_O);
    const float* rpb = C.in[I_RPB]; const float* mbias = C.in[I_MBIAS];
    LAS unsigned char* lds = C.lds;
    const int w = wave, lq = lane & 15, g = lane >> 4;
    const int qr = w >> 2, qg = w & 3, c0 = 16 * qg, kcb = qg == 0 ? 0 : (qg == 1 ? 8 : (qg == 2 ? 24 : 32));
    int bidx[2][4];
    { const int c_ = c0 + lq, cs_ = min(max(c_ - 8, 0), 48);
#pragma unroll
      for (int blk = 0; blk < 2; ++blk)
#pragma unroll
          for (int e = 0; e < 4; ++e) { const int kc = kcb + 16 * blk + 4 * g + e; bidx[blk][e] = ((kc >= cs_ && kc < cs_ + 16) ? (kc - c_ + 15) : 31) * 4; } }
    const __amdgpu_buffer_rsrc_t rsrc = __builtin_amdgcn_make_buffer_rsrc((void*)wsl, 0, 0xFFFFFFFF, 0x00020000);
    const int kvoff = (((tid >> 3) & 63) * D + 8 * (tid & 7)) * 2, vvoff = ((tid >> 3) * MPAD + 8 * (tid & 7)) * 2;
    const int qvoff = (lq * D + 8 * g) * 2;
    const int mvoff = tid < 128 ? ((tid >> 3) * D + 8 * (tid & 7)) * 2 : (((tid - 128) >> 1) * MPAD + 8 * ((tid - 128) & 1)) * 2;
    const int klds = AT_KS + ((((tid >> 3) & 63)) * 8 + ((tid & 7) ^ ((tid >> 3) & 7))) * 16;
    const int vlds = AT_VTS + (tid >> 3) * AT_VPITCH + (tid & 7) * 16;
    for (int su = (C.G == 256 ? C.gc : C.bid); su < 256; su += C.G) {
        int bh, strip; if (C.G == 256) { bh = (su & 7) * 16 + (su >> 4); strip = (su >> 3) & 1; } else { bh = su >> 1; strip = su & 1; }
        const int b = bh >> 4, h = bh & 15, rp0 = strip * 16;
        const unsigned kbase = (unsigned)WS_K + (unsigned)((b * SEQ) * D + 64 * h) * 2u, vbase = (unsigned)WS_VT + (unsigned)((64 * h) * MPAD + b * SEQ) * 2u;
        const unsigned qbase = (unsigned)WS_Q + (unsigned)((b * SEQ + qr * 64 + c0) * D + 64 * h) * 2u;
        int R0 = min(max(2 * rp0 - 4, 0), 55);
        __syncthreads();
        {
            u32x4 kreg[9], vreg[9];
#pragma unroll
            for (int i = 0; i < 9; ++i) { kreg[i] = __builtin_amdgcn_raw_buffer_load_b128(rsrc, kvoff, (int)(kbase + (unsigned)(R0 + i) * 64u * D * 2u), 0);
                vreg[i] = __builtin_amdgcn_raw_buffer_load_b128(rsrc, vvoff, (int)(vbase + (unsigned)(R0 + i) * 128u), 0); }
            u32x4 mreg = {0u, 0u, 0u, 0u};
            if (tid < 256) mreg = __builtin_amdgcn_raw_buffer_load_b128(rsrc, mvoff, (int)(tid < 128 ? (unsigned)WS_K + (unsigned)((NGRID + 16 * b) * D + 64 * h) * 2u : (unsigned)WS_VT + (unsigned)((64 * h) * MPAD + NGRID + 16 * b) * 2u), 0);
            float rpreg = 0.f, mbreg = 0.f;
            if (tid < 480) rpreg = (tid & 31) < 31 ? rpb[h * 465 + (tid >> 5) * 31 + (tid & 31)] * 1.44269504089f : -1.0e30f;
            if (tid < 16) mbreg = mbias[h * 16 + tid] * 1.44269504089f;
#pragma unroll
            for (int i = 0; i < 9; ++i) { const int slot = (R0 + i) % 9; *(LAS u32x4*)(lds + klds + slot * 8192) = kreg[i]; *(LAS u32x4*)(lds + vlds + slot * 128) = vreg[i]; }
            if (tid < 128) { const int m = tid >> 3, ch = tid & 7; *(LAS u32x4*)(lds + AT_KM + (m * 8 + (ch ^ (m & 7))) * 16) = mreg; }
            else if (tid < 256) { const int i = tid - 128, d = i >> 1, hf = i & 1; *(LAS u32x4*)(lds + AT_VTM + d * 32 + hf * 16) = mreg; }
            if (tid < 480) ((LAS float*)(lds + AT_RPB))[tid] = rpreg;
            if (tid < 16) ((LAS float*)(lds + AT_MB))[tid] = mbreg;
        }
        u32x4 qreg[2];
        qreg[0] = __builtin_amdgcn_raw_buffer_load_b128(rsrc, qvoff, (int)(qbase + (unsigned)(2 * rp0) * 64u * D * 2u), 0);
        qreg[1] = __builtin_amdgcn_raw_buffer_load_b128(rsrc, qvoff, (int)(qbase + (unsigned)(2 * rp0) * 64u * D * 2u + 64u), 0);
        __syncthreads();
        for (int rp = rp0; rp < rp0 + 16; ++rp) {
            const int R0n = rp + 1 < rp0 + 16 ? min(max(2 * (rp + 1) - 4, 0), 55) : R0, nnew = R0n - R0;
            const u32x4 qcur[2] = {qreg[0], qreg[1]};
            u32x4 nk[2], nv[2];
#pragma unroll
            for (int i = 0; i < 2; ++i) if (i < nnew) { nk[i] = __builtin_amdgcn_raw_buffer_load_b128(rsrc, kvoff, (int)(kbase + (unsigned)(R0 + 9 + i) * 64u * D * 2u), 0);
                nv[i] = __builtin_amdgcn_raw_buffer_load_b128(rsrc, vvoff, (int)(vbase + (unsigned)(R0 + 9 + i) * 128u), 0); }
            if (rp + 1 < rp0 + 16) { qreg[0] = __builtin_amdgcn_raw_buffer_load_b128(rsrc, qvoff, (int)(qbase + (unsigned)(2 * rp + 2) * 64u * D * 2u), 0);
                qreg[1] = __builtin_amdgcn_raw_buffer_load_b128(rsrc, qvoff, (int)(qbase + (unsigned)(2 * rp + 2) * 64u * D * 2u + 64u), 0); }
            const int r = 2 * rp + qr;
            const int rs = min(max(r - 4, 0), 56), s0 = rs % 9;
            const size_t qrow = (size_t)(b * SEQ + r * 64 + c0 + lq);
            bf16x8 qf[2]; qf[0] = __builtin_bit_cast(bf16x8, qcur[0]); qf[1] = __builtin_bit_cast(bf16x8, qcur[1]);
            f32x4 sc[8][2], sm;
#pragma unroll
            for (int j = 0; j < 8; ++j) { const int slot = s0 + j - (s0 + j >= 9 ? 9 : 0);
#pragma unroll
                for (int blk = 0; blk < 2; ++blk) { f32x4 a = {0.f, 0.f, 0.f, 0.f}; const int kc = kcb + 16 * blk + lq;
#pragma unroll
                    for (int ks = 0; ks < 2; ++ks) { const bf16x8 kf = *(const LAS bf16x8*)(lds + AT_KS + slot * 8192 + (kc * 8 + ((4 * ks + g) ^ (kc & 7))) * 16);
                        a = __builtin_amdgcn_mfma_f32_16x16x32_bf16(kf, qf[ks], a, 0, 0, 0); }
                    sc[j][blk] = a; } }
            { f32x4 a = {0.f, 0.f, 0.f, 0.f};
#pragma unroll
              for (int ks = 0; ks < 2; ++ks) { const bf16x8 kf = *(const LAS bf16x8*)(lds + AT_KM + (lq * 8 + ((4 * ks + g) ^ (lq & 7))) * 16);
                  a = __builtin_amdgcn_mfma_f32_16x16x32_bf16(kf, qf[ks], a, 0, 0, 0); }
              sm = a; }
            const LAS unsigned char* RProw = lds + AT_RPB + (rs - r + 7) * 128; const LAS float* MB = (const LAS float*)(lds + AT_MB);
            float mx = -3.0e38f;
#pragma unroll
            for (int j = 0; j < 8; ++j)
#pragma unroll
                for (int blk = 0; blk < 2; ++blk)
#pragma unroll
                    for (int e = 0; e < 4; ++e) { const float sv = sc[j][blk][e] + *(const LAS float*)(RProw + j * 128 + bidx[blk][e]); sc[j][blk][e] = sv; mx = fmaxf(mx, sv); }
#pragma unroll
            for (int e = 0; e < 4; ++e) { sm[e] += MB[4 * g + e]; mx = fmaxf(mx, sm[e]); }
            mx = fmaxf(mx, __shfl_xor(mx, 16)); mx = fmaxf(mx, __shfl_xor(mx, 32));
            float sum = 0.f;
#pragma unroll
            for (int j = 0; j < 8; ++j)
#pragma unroll
                for (int blk = 0; blk < 2; ++blk)
#pragma unroll
                    for (int e = 0; e < 4; ++e) { const float pv = fast_exp2(sc[j][blk][e] - mx); sc[j][blk][e] = pv; sum += pv; }
#pragma unroll
            for (int e = 0; e < 4; ++e) { const float pv = fast_exp2(sm[e] - mx); sm[e] = pv; sum += pv; }
            sum += __shfl_xor(sum, 16); sum += __shfl_xor(sum, 32);
            f32x4 o[4];
#pragma unroll
            for (int db = 0; db < 4; ++db) o[db] = (f32x4){0.f, 0.f, 0.f, 0.f};
#pragma unroll
            for (int j = 0; j < 8; ++j) { const int slot = s0 + j - (s0 + j >= 9 ? 9 : 0);
                u32x4 pw; pw.x = cvt_pk_bf16(sc[j][0][0], sc[j][0][1]); pw.y = cvt_pk_bf16(sc[j][0][2], sc[j][0][3]); pw.z = cvt_pk_bf16(sc[j][1][0], sc[j][1][1]); pw.w = cvt_pk_bf16(sc[j][1][2], sc[j][1][3]);
                const bf16x8 pb = __builtin_bit_cast(bf16x8, pw);
#pragma unroll
                for (int db = 0; db < 4; ++db) { const int d = 16 * db + lq; const LAS unsigned char* vp = lds + AT_VTS + d * AT_VPITCH + (slot * 64 + kcb + 4 * g) * 2;
                    const u32x2 lo = *(const LAS u32x2*)vp, hi = *(const LAS u32x2*)(vp + 32);
                    u32x4 aw; aw.x = lo.x; aw.y = lo.y; aw.z = hi.x; aw.w = hi.y;
                    o[db] = __builtin_amdgcn_mfma_f32_16x16x32_bf16(__builtin_bit_cast(bf16x8, aw), pb, o[db], 0, 0, 0); }
            }
            { u32x4 pw; pw.x = cvt_pk_bf16(sm[0], sm[1]); pw.y = cvt_pk_bf16(sm[2], sm[3]); pw.z = 0u; pw.w = 0u; const bf16x8 pb = __builtin_bit_cast(bf16x8, pw);
#pragma unroll
              for (int db = 0; db < 4; ++db) { const int d = 16 * db + lq; const u32x2 lo = *(const LAS u32x2*)(lds + AT_VTM + d * 32 + 8 * g);
                  u32x4 aw; aw.x = lo.x; aw.y = lo.y; aw.z = 0u; aw.w = 0u;
                  o[db] = __builtin_amdgcn_mfma_f32_16x16x32_bf16(__builtin_bit_cast(bf16x8, aw), pb, o[db], 0, 0, 0); } }
            const float inv = 1.0f / sum;
#pragma unroll
            for (int db = 0; db < 4; ++db) { u32x2 ow; ow.x = cvt_pk_bf16(o[db][0] * inv, o[db][1] * inv); ow.y = cvt_pk_bf16(o[db][2] * inv, o[db][3] * inv);
                *(u32x2*)(O + qrow * D + 64 * h + 16 * db + 4 * g) = ow; }
            __syncthreads();
#pragma unroll
            for (int i = 0; i < 2; ++i) if (i < nnew) { const int slot = (R0 + 9 + i) % 9; *(LAS u32x4*)(lds + klds + slot * 8192) = nk[i]; *(LAS u32x4*)(lds + vlds + slot * 128) = nv[i]; }
            R0 = R0n;
            __syncthreads();
        }
    }
}
#define XB_TMO      128
#define XB_XCNT(j)  (256  + 64 * (j))
#define XB_XSUB(j)  (1280 + 64 * (j))
#define XB_XGEN(j)  (2304 + 64 * (j))
#define XB_TOP      3328
#define XB_TOPGEN   3392
#define XCD_BAR_WORDS 3456
#define XB_SPIN_CAP (1u << 22)
__device__ __forceinline__ unsigned xb_ld(unsigned* p)              { return __hip_atomic_load(p, __ATOMIC_RELAXED, __HIP_MEMORY_SCOPE_AGENT); }
__device__ __forceinline__ unsigned xb_add(unsigned* p, unsigned v) { return __hip_atomic_fetch_add(p, v, __ATOMIC_RELAXED, __HIP_MEMORY_SCOPE_AGENT); }
__device__ __forceinline__ unsigned xb_xcc_id() { return (unsigned)__builtin_amdgcn_s_getreg((3 << 11) | 20) & 0xFu; }
#define XB_SPIN(cond, bar) do { unsigned _sp = 0; while (cond) { __builtin_amdgcn_s_sleep(1); \
    if ((++_sp & 255u) == 0u) { if (xb_ld(&(bar)[XB_TMO])) break; if (_sp > XB_SPIN_CAP) { atomicAdd(&(bar)[XB_TMO], 1u); break; } } } } while (0)
struct XcdBarrier { unsigned* bar; unsigned x; volatile LAS unsigned* st; };
__device__ __forceinline__ XcdBarrier xcd_barrier_post(unsigned* bar, volatile LAS unsigned* st) {
    XcdBarrier b; b.bar = bar; b.x = xb_xcc_id(); b.st = st;
    if (threadIdx.x == 0) st[2] = xb_add(&bar[XB_XCNT(b.x)], 1u);
    return b;
}
__device__ __forceinline__ void xcd_barrier_complete(unsigned* bar, unsigned x, unsigned& nloc, unsigned& nx) {
    const unsigned G = gridDim.x * gridDim.y * gridDim.z;
    unsigned sum, cnt, mine, sp = 0u;
    for (;;) {
        sum = 0u; cnt = 0u; mine = 0u;
#pragma unroll
        for (unsigned j = 0; j < 16; ++j) { const unsigned c = xb_ld(&bar[XB_XCNT(j)]); sum += c; cnt += (c > 0u) ? 1u : 0u; mine = (j == x) ? c : mine; }
        if (sum == G) break;
        __builtin_amdgcn_s_sleep(1);
        if ((++sp & 255u) == 0u) { if (xb_ld(&bar[XB_TMO])) break; if (sp > XB_SPIN_CAP) { atomicAdd(&bar[XB_TMO], 1u); break; } }
    }
    nloc = mine > 0u ? mine : 1u; nx = cnt > 0u ? cnt : 1u;
}
__device__ __forceinline__ void xcd_barrier(const XcdBarrier& b) {
    asm volatile("s_waitcnt vmcnt(0)" ::: "memory");
    __syncthreads();
    if (threadIdx.x == 0) {
        unsigned* bar = b.bar;
        __builtin_amdgcn_s_waitcnt(0);
        unsigned nloc = b.st[0], nx = b.st[1];
        if (nloc == 0u) { xcd_barrier_complete(bar, b.x, nloc, nx); b.st[0] = nloc; b.st[1] = nx; }
        const unsigned old = xb_add(&bar[XB_XSUB(b.x)], 1u);
        const unsigned gen = old / nloc;
        if (old + 1u == (gen + 1u) * nloc) {
            __builtin_amdgcn_fence(__ATOMIC_RELEASE, "agent");
            asm volatile("s_waitcnt vmcnt(0)" ::: "memory");
            const unsigned og = xb_add(&bar[XB_TOP], 1u);
            const unsigned tg = og / nx;
            if (og + 1u == (tg + 1u) * nx) xb_add(&bar[XB_TOPGEN], 1u);
            else XB_SPIN(xb_ld(&bar[XB_TOPGEN]) == tg, bar);
            __builtin_amdgcn_fence(__ATOMIC_ACQUIRE, "agent");
            xb_add(&bar[XB_XGEN(b.x)], 1u);
            asm volatile("s_waitcnt vmcnt(0)" ::: "memory");
        } else {
            XB_SPIN(xb_ld(&bar[XB_XGEN(b.x)]) == gen, bar);
            __builtin_amdgcn_fence(__ATOMIC_ACQUIRE, "agent");
            asm volatile("s_waitcnt vmcnt(0)" ::: "memory");
        }
    }
    __syncthreads();
}
__device__ __forceinline__ int moe_prep(const Ctx& C, const int* texp) {
    LAS int* t = (LAS int*)(C.lds + pg8::TEXP_OFF); const int tid = fresh_tid();
    const int a = texp[tid], b = texp[tid + 512];
    t[tid] = a; t[tid + 512] = b;
    __syncthreads();
    return __builtin_amdgcn_readfirstlane(t[1023]);
}
constexpr size_t CT_BAR = 131072;
constexpr int LDS_BARST = LDS_BYTES - 64;

constexpr int N_PHASES = 20;
__global__ void __launch_bounds__(NTHREADS, 2) hybrid_fwd(Params P) {
    extern __shared__ __attribute__((aligned(16))) unsigned char smem[];
    cg::grid_group grid = cg::this_grid();
    Ctx C; C.lds = (LAS unsigned char*)smem; C.G = gridDim.x; C.bid = blockIdx.x;
    C.ws = P.ws; C.in = P.in; C.out = P.out;
    unsigned char* const ws0 = P.ws;
#define ws fresh_ws(ws0)
    const int lo = P.ph_lo, hi = P.ph_hi;
#ifndef PH_MASK
#define PH_MASK 0xFFFFFFFFu
#endif
#define IN(k) (((PH_MASK >> (k)) & 1u) && lo <= (k) && (k) < hi)
#ifndef REPEAT_MASK
#define REPEAT_MASK 0u
#endif
#define REPS(k) ((((unsigned)REPEAT_MASK >> (k)) & 1u) ? 2 : 1)
#ifndef N_CG_SYNCS
#define N_CG_SYNCS 0
#endif
#define SEAM(k) do { if (IN(k) && IN((k) + 1)) { if ((k) < N_CG_SYNCS) grid.sync(); else xcd_barrier(bar); } } while (0)
    if (threadIdx.x < 16) ((LAS unsigned*)(smem + LDS_BARST))[threadIdx.x] = 0u;
    __syncthreads();
    const XcdBarrier bar = xcd_barrier_post((unsigned*)(ws + WS_CTL + CT_BAR), (volatile LAS unsigned*)(smem + LDS_BARST));
    C.gc = C.bid;
    #define PH_BODY_0 phase_convert(C);
    if (IN(0)) { PH_BODY_0 } if (REPS(0) > 1 && IN(0)) { xcd_barrier(bar); PH_BODY_0 }
    SEAM(0);
    if (IN(0) && IN(1)) {
        unsigned* barw = (unsigned*)(ws + WS_CTL + CT_BAR); bool eq = (C.G % 8) == 0;
#pragma unroll
        for (int j = 0; j < 16; ++j) { const unsigned cj = xb_ld(&barw[XB_XCNT(j)]); eq = eq && (cj == (j < 8 ? (unsigned)(C.G / 8) : 0u)); }
        const unsigned rank = ((volatile LAS unsigned*)(smem + LDS_BARST))[2];
        C.gc = __builtin_amdgcn_readfirstlane(eq ? (int)(rank * 8u + bar.x) : C.bid);
    }
    #define PH_BODY_1 { DenseSched S{(unsigned)WS_HB, (unsigned)WS_WIN, 1024, 1024, 128, 8, C.G, C.gc}; EpiWin E{(bf16_t*)(ws + WS_XR), (bf16_t*)(ws + WS_GY)}; \
        pg8::gemm_phase<false, false>(C.lds, ws, 1024, 1024, 1024, S, E); mini_win(C); }
    if (IN(1)) { PH_BODY_1 } if (REPS(1) > 1 && IN(1)) { xcd_barrier(bar); PH_BODY_1 }
    SEAM(1);
    #define PH_BODY_2 phase_conv(C);
    if (IN(2)) { PH_BODY_2 } if (REPS(2) > 1 && IN(2)) { xcd_barrier(bar); PH_BODY_2 }
    SEAM(2);
    #define PH_BODY_3 { GateSched S{(unsigned)WS_XC, (unsigned)WS_GATE, 128, C.G, C.gc}; \
        EpiGate E{(const bf16_t*)(ws + WS_XC), (bf16_t*)(ws + WS_LA), (bf16_t*)(ws + WS_BB), (const float*)(ws + WS_CTL + CT_SPL), (unsigned)WS_GBIAS}; \
        pg8::gemm_phase<false, false>(C.lds, ws, 256, 1024, 256, S, E); mini_gate(C); }
    if (IN(3)) { PH_BODY_3 } if (REPS(3) > 1 && IN(3)) { xcd_barrier(bar); PH_BODY_3 }
    SEAM(3);
    #define PH_BODY_4 phase_scan(C);
    if (IN(4)) { PH_BODY_4 } if (REPS(4) > 1 && IN(4)) { xcd_barrier(bar); PH_BODY_4 }
    SEAM(4);
    #define PH_BODY_5 { DenseSched S{(unsigned)WS_G, (unsigned)WS_LOUT, 1024, 1024, 128, 4, C.G, C.gc}; EpiRes<true> E{(bf16_t*)(ws + WS_PRE), P.in[I_X], P.in[I_META], nullptr, NTOK}; \
        pg8::gemm_phase<false, false>(C.lds, ws, 1024, 1024, 1024, S, E); mini_lout(C); }
    if (IN(5)) { PH_BODY_5 } if (REPS(5) > 1 && IN(5)) { xcd_barrier(bar); PH_BODY_5 }
    SEAM(5);
    #define PH_BODY_6 phase_lnr(C, 0, NTOK);
    if (IN(6)) { PH_BODY_6 } if (REPS(6) > 1 && IN(6)) { xcd_barrier(bar); PH_BODY_6 }
    SEAM(6);
    #define PH_BODY_7 phase_pos(C, 0, NTOK);
    if (IN(7)) { PH_BODY_7 } if (REPS(7) > 1 && IN(7)) { xcd_barrier(bar); PH_BODY_7 }
    SEAM(7);
    #define PH_BODY_8 { const int nM = moe_prep(C, (const int*)(ws + WS_CTL + CT_TEXP)); \
        MoeSched S{(unsigned)WS_HB8, (unsigned)WS_WGU, (unsigned)WS_TOK, (const LAS int*)(C.lds + pg8::TEXP_OFF), 2048u * 1024u, nM, 8, C.G, C.gc}; EpiGlu E{(unsigned char*)(ws + WS_ACT), (unsigned)WS_BIAS}; \
        pg8::gemm_phase<true, true>(C.lds, ws, 512, 512, 512, S, E); }
    if (IN(8)) { PH_BODY_8 } if (REPS(8) > 1 && IN(8)) { xcd_barrier(bar); PH_BODY_8 }
#ifdef PROBE_NULL8
    if (IN(8)) { xcd_barrier(bar); { const int nM = moe_prep(C, (const int*)(ws + WS_CTL + CT_TEXP));
        MoeSched S{(unsigned)WS_HB8, (unsigned)WS_WGU, (unsigned)WS_TOK, (const LAS int*)(C.lds + pg8::TEXP_OFF), 2048u * 1024u, nM, 8, C.G, C.gc}; EpiNull E{};
        pg8::gemm_phase<true, true>(C.lds, ws, 512, 512, 512, S, E); } }
#endif
    SEAM(8);
    #define PH_BODY_9 { const int nM = moe_prep(C, (const int*)(ws + WS_CTL + CT_TEXP)); \
        MoeSched S{(unsigned)WS_ACT, (unsigned)WS_WD, 0u, (const LAS int*)(C.lds + pg8::TEXP_OFF), 1024u * 1024u, nM, 4, C.G, C.gc}; EpiDown E{(bf16_t*)(ws + WS_YS), (unsigned)WS_BD}; \
        pg8::gemm_phase<true, false>(C.lds, ws, 512, 512, 512, S, E); }
    if (IN(9)) { PH_BODY_9 } if (REPS(9) > 1 && IN(9)) { xcd_barrier(bar); PH_BODY_9 }
    SEAM(9);
    #define PH_BODY_10 phase_combine(C, 0, NTOK, false);
    if (IN(10)) { PH_BODY_10 } if (REPS(10) > 1 && IN(10)) { xcd_barrier(bar); PH_BODY_10 }
    SEAM(10);
    #define PH_BODY_11 { QkvSched S{(unsigned)WS_HB8, (unsigned)WS_QKV8, 128, C.G, C.gc}; EpiQkv E{(bf16_t*)(ws + WS_Q), (bf16_t*)(ws + WS_K), (bf16_t*)(ws + WS_VT)}; \
        pg8::gemm_phase<true, false>(C.lds, ws, 512, 512, 512, S, E); mini_kv(C); }
    if (IN(11)) { PH_BODY_11 } if (REPS(11) > 1 && IN(11)) { xcd_barrier(bar); PH_BODY_11 }
    SEAM(11);
    #define PH_BODY_12 phase_attn(C);
    if (IN(12)) { PH_BODY_12 } if (REPS(12) > 1 && IN(12)) { xcd_barrier(bar); PH_BODY_12 }
    SEAM(12);
    #define PH_BODY_13 { DenseSched S{(unsigned)WS_O, (unsigned)WS_NOUT, 1024, 1024, 128, 4, C.G, C.gc}; EpiRes<false> E{(bf16_t*)(ws + WS_PRE), nullptr, nullptr, (const bf16_t*)(ws + WS_HB), NGRID}; \
        pg8::gemm_phase<false, false>(C.lds, ws, 1024, 1024, 1024, S, E); }
    if (IN(13)) { PH_BODY_13 } if (REPS(13) > 1 && IN(13)) { xcd_barrier(bar); PH_BODY_13 }
    SEAM(13);
    #define PH_BODY_14 phase_lnr(C, 1, NGRID);
    if (IN(14)) { PH_BODY_14 } if (REPS(14) > 1 && IN(14)) { xcd_barrier(bar); PH_BODY_14 }
    SEAM(14);
    #define PH_BODY_15 phase_pos(C, 1, NGRID);
    if (IN(15)) { PH_BODY_15 } if (REPS(15) > 1 && IN(15)) { xcd_barrier(bar); PH_BODY_15 }
    SEAM(15);
    #define PH_BODY_16 { const int nM = moe_prep(C, (const int*)(ws + WS_CTL + CT_TEXP) + 1024); \
        MoeSched S{(unsigned)WS_HB8, (unsigned)(WS_WGU + (size_t)32 * 2048 * 1024), (unsigned)(WS_TOK + 1 * MiB), (const LAS int*)(C.lds + pg8::TEXP_OFF), 2048u * 1024u, nM, 8, C.G, C.gc}; EpiGlu E{(unsigned char*)(ws + WS_ACT), (unsigned)(WS_BIAS + 32 * 2048 * 4)}; \
        pg8::gemm_phase<true, true>(C.lds, ws, 512, 512, 512, S, E); }
    if (IN(16)) { PH_BODY_16 } if (REPS(16) > 1 && IN(16)) { xcd_barrier(bar); PH_BODY_16 }
    SEAM(16);
    #define PH_BODY_17 { const int nM = moe_prep(C, (const int*)(ws + WS_CTL + CT_TEXP) + 1024); \
        MoeSched S{(unsigned)WS_ACT, (unsigned)(WS_WD + (size_t)32 * 1024 * 1024), 0u, (const LAS int*)(C.lds + pg8::TEXP_OFF), 1024u * 1024u, nM, 4, C.G, C.gc}; EpiDown E{(bf16_t*)(ws + WS_YS), (unsigned)(WS_BD + 32 * 1024 * 4)}; \
        pg8::gemm_phase<true, false>(C.lds, ws, 512, 512, 512, S, E); }
    if (IN(17)) { PH_BODY_17 } if (REPS(17) > 1 && IN(17)) { xcd_barrier(bar); PH_BODY_17 }
    SEAM(17);
    #define PH_BODY_18 phase_combine(C, 1, NGRID, true);
    if (IN(18)) { PH_BODY_18 } if (REPS(18) > 1 && IN(18)) { xcd_barrier(bar); PH_BODY_18 }
#undef ws
#undef IN
#undef SEAM
}

#ifndef MK_PER_PHASE
#define MK_PER_PHASE 0
#endif
extern "C" void kernel_launch(void* const* d_in, const int* in_sizes, int n_in, void* d_out, int out_size, void* d_ws, size_t ws_size, hipStream_t stream) {
    static int grid = 0;
    if (grid == 0) {
        if (n_in != 25 || ws_size < WS_END || out_size != NGRID * D) { fprintf(stderr, "kernel_launch: unexpected problem (n_in %d, ws %zu, out %d)\n", n_in, ws_size, out_size); grid = -1; return; }
        int dev = 0, cus = 0, per_cu = 0;
        if (hipGetDevice(&dev) != hipSuccess || hipDeviceGetAttribute(&cus, hipDeviceAttributeMultiprocessorCount, dev) != hipSuccess) { grid = -1; return; }
        if (hipFuncSetAttribute((const void*)hybrid_fwd, hipFuncAttributeMaxDynamicSharedMemorySize, LDS_BYTES) != hipSuccess) { fprintf(stderr, "kernel_launch: hipFuncSetAttribute failed\n"); grid = -1; return; }
        if (hipOccupancyMaxActiveBlocksPerMultiprocessor(&per_cu, (const void*)hybrid_fwd, NTHREADS, LDS_BYTES) != hipSuccess || per_cu < 1) { fprintf(stderr, "kernel_launch: occupancy query failed (%d)\n", per_cu); grid = -1; return; }
        grid = cus * 1;
        if (grid > 256) grid = 256;
    }
    if (grid < 0) return;
    if (hipMemsetAsync((char*)d_ws + WS_CTL + CT_BAR, 0, 16384, stream) != hipSuccess) { fprintf(stderr, "kernel_launch: memset failed\n"); return; }
    Params p{};
    for (int i = 0; i < 25; ++i) p.in[i] = (const float*)d_in[i];
    p.out = (float*)d_out; p.ws = (unsigned char*)d_ws;
#if MK_PER_PHASE
    for (int ph = 0; ph < 19; ++ph) { p.ph_lo = ph; p.ph_hi = ph + 1; void* args[] = {&p};
        hipError_t e = hipLaunchCooperativeKernel((void*)hybrid_fwd, dim3(grid), dim3(NTHREADS), args, LDS_BYTES, stream);
        if (e != hipSuccess) { fprintf(stderr, "launch phase %d failed: %s\n", ph, hipGetErrorString(e)); break; } }
#else
    p.ph_lo = 0; p.ph_hi = 19; void* args[] = {&p};
    hipError_t e = hipLaunchCooperativeKernel((void*)hybrid_fwd, dim3(grid), dim3(NTHREADS), args, LDS_BYTES, stream);
    if (e != hipSuccess) fprintf(stderr, "cooperative launch failed: %s (grid %d)\n", hipGetErrorString(e), grid);
#endif
}
```

```cpp
#include <hip/hip_runtime.h>
#include <hip/hip_cooperative_groups.h>
#include <cstdio>
#include <cstdint>
namespace cg = cooperative_groups;

#define LAS __attribute__((address_space(3)))
typedef unsigned short bf16_t;
typedef short bf16x8 __attribute__((ext_vector_type(8)));
typedef float f32x4 __attribute__((ext_vector_type(4)));
typedef float f32x2 __attribute__((ext_vector_type(2)));
typedef unsigned u32x4 __attribute__((ext_vector_type(4)));
typedef unsigned u32x2 __attribute__((ext_vector_type(2)));

constexpr int NB = 8, SEQ = 4096, D = 1024, NMETA = 16, LSEQ = SEQ + NMETA;
constexpr int NGRID = NB * SEQ;
constexpr int NTOK = NGRID + NB * NMETA;
constexpr int MPAD = 33024;
constexpr int NEXP = 32, TOPK = 4;
constexpr int PMAX = 139776;
constexpr int MTMAX = PMAX / 256;
constexpr float DN_ALPHA = 1.41421356237f;
constexpr float LN_EPS = 1e-5f;
constexpr int NTHREADS = 512, NWAVES = 8;

constexpr size_t MiB = 1u << 20;
constexpr size_t ACT_BYTES = (size_t)MPAD * D * 2;
constexpr size_t WS_CTL   = 0;
constexpr size_t WS_WIN   = 4 * MiB;
constexpr size_t WS_GATE  = WS_WIN + 4 * MiB;
constexpr size_t WS_LOUT  = WS_GATE + 2 * MiB;
constexpr size_t WS_QKV   = WS_LOUT + 2 * MiB;
constexpr size_t WS_NOUT  = WS_QKV + 6 * MiB;
constexpr size_t WS_WGU   = WS_NOUT + 2 * MiB;
constexpr size_t WS_WD    = WS_WGU + 128 * MiB;
constexpr size_t WS_HB    = WS_WD + 64 * MiB;
constexpr size_t WS_HB8   = WS_HB + 65 * MiB;
constexpr size_t WS_PRE   = WS_HB8 + 33 * MiB;
constexpr size_t WS_H     = WS_PRE + 129 * MiB;
constexpr size_t WS_SCR   = WS_H + 129 * MiB;
constexpr size_t WS_XR = WS_SCR, WS_XC = WS_XR + 65 * MiB, WS_GY = WS_XC + 65 * MiB, WS_LA = WS_GY + 65 * MiB, WS_BB = WS_LA + 130 * MiB, WS_HF = WS_BB + 130 * MiB, WS_G = WS_HF + 65 * MiB;
constexpr size_t WS_SCR_END0 = WS_G + 65 * MiB;
constexpr size_t WS_XS = WS_SCR, WS_ACT = WS_XS + 137 * MiB, WS_YS = WS_ACT + 137 * MiB;
constexpr size_t WS_SCR_END1 = WS_YS + 274 * MiB;
constexpr size_t WS_Q = WS_SCR, WS_K = WS_Q + 65 * MiB, WS_VT = WS_K + 65 * MiB, WS_O = WS_VT + 65 * MiB;
constexpr size_t WS_BIAS = (WS_SCR_END0 > WS_SCR_END1 ? WS_SCR_END0 : WS_SCR_END1);
constexpr size_t WS_BD = WS_BIAS + 2 * 32 * 2048 * 4;
constexpr size_t WS_GBIAS = WS_BD + 2 * 32 * 1024 * 4;
constexpr size_t WS_TOK = WS_BIAS + 1 * MiB;
constexpr size_t WS_QKV8 = WS_TOK + 2 * MiB;
constexpr size_t WS_END = WS_QKV8 + 3 * MiB;
static_assert((size_t)PMAX * 4 <= 1 * MiB, "token offset table");
static_assert(ACT_BYTES <= 65 * MiB && (size_t)PMAX * D * 2 <= 274 * MiB && (size_t)PMAX * D <= 137 * MiB && (size_t)MPAD * D <= 33 * MiB && (size_t)MPAD * D * 4 <= 129 * MiB, "ws map");
static_assert(WS_END <= (size_t)2040 * MiB, "ws map must fit 4x the largest input tensor");
constexpr size_t CT_BC      = 4096;
constexpr size_t CT_TEXP    = CT_BC + 2 * 256 * 32 * 4;
constexpr size_t CT_SPL     = CT_TEXP + 2 * 1024 * 4;
constexpr size_t CT_EID     = 256 * 1024;
constexpr size_t CT_GATEV   = CT_EID + 2 * (size_t)NTOK * 4 * 4;
constexpr size_t CT_POS     = CT_GATEV + 2 * (size_t)NTOK * 4 * 4;
static_assert(CT_POS + 2 * (size_t)NTOK * 4 * 4 <= 4 * MiB, "ctl map");

constexpr int LDS_BYTES = 155648;

__device__ __forceinline__ unsigned f2bf(float f) { unsigned u = __builtin_bit_cast(unsigned, f); return (u + 0x7fffu + ((u >> 16) & 1u)) >> 16; }
__device__ __forceinline__ unsigned cvt_pk_bf16(float lo, float hi);
__device__ __forceinline__ unsigned pk2(float lo, float hi) { return cvt_pk_bf16(lo, hi); }
typedef __bf16 bf16x2_t __attribute__((ext_vector_type(2)));
__device__ __forceinline__ unsigned cvt_pk_bf16(float lo, float hi) { const f32x2 v = {lo, hi}; return __builtin_bit_cast(unsigned, __builtin_convertvector(v, bf16x2_t)); }
__device__ __forceinline__ unsigned pk4_fp8(float a, float b, float c, float d) { int w = __builtin_amdgcn_cvt_pk_fp8_f32(a, b, 0, false); w = __builtin_amdgcn_cvt_pk_fp8_f32(c, d, w, true); return (unsigned)w; }
__device__ __forceinline__ float dot2_bf16(unsigned a, unsigned b, float c) { return __builtin_amdgcn_fdot2_f32_bf16(__builtin_bit_cast(bf16x2_t, a), __builtin_bit_cast(bf16x2_t, b), c, false); }
__device__ __forceinline__ void unpack8_fp8(const u32x2 w, float (&o)[8]) { const f32x2 a = __builtin_amdgcn_cvt_pk_f32_fp8((int)w.x, false), b = __builtin_amdgcn_cvt_pk_f32_fp8((int)w.x, true), c = __builtin_amdgcn_cvt_pk_f32_fp8((int)w.y, false), d = __builtin_amdgcn_cvt_pk_f32_fp8((int)w.y, true);
    o[0] = a.x; o[1] = a.y; o[2] = b.x; o[3] = b.y; o[4] = c.x; o[5] = c.y; o[6] = d.x; o[7] = d.y; }
__device__ __forceinline__ float bflo(unsigned w) { return __builtin_bit_cast(float, w << 16); }
__device__ __forceinline__ float bfhi(unsigned w) { return __builtin_bit_cast(float, w & 0xffff0000u); }
__device__ __forceinline__ void unpack8(const u32x4 w, float (&o)[8]);
__device__ __forceinline__ float fast_exp2(float x) { return __builtin_amdgcn_exp2f(x); }
__device__ __forceinline__ float fast_rcp(float x) { return __builtin_amdgcn_rcpf(x); }
__device__ __forceinline__ float sigmoidf_(float x) { return fast_rcp(1.0f + fast_exp2(-1.44269504089f * x)); }
__device__ __forceinline__ float wave_sum(float v) {
#pragma unroll
    for (int o = 1; o < 64; o <<= 1) v += __shfl_xor(v, o);
    return v;
}
template <int CTRL> __device__ __forceinline__ float dpp_movf(float v) { return __builtin_bit_cast(float, __builtin_amdgcn_update_dpp(0, __builtin_bit_cast(int, v), CTRL, 0xf, 0xf, true)); }
__device__ __forceinline__ float readlane_f(float v, int l) { return __builtin_bit_cast(float, __builtin_amdgcn_readlane(__builtin_bit_cast(int, v), l)); }
__device__ __forceinline__ float wave_sum_dpp(float v) {
    v += dpp_movf<0xB1>(v);
    v += dpp_movf<0x4E>(v);
    v += dpp_movf<0x141>(v);
    v += dpp_movf<0x140>(v);
    return (readlane_f(v, 0) + readlane_f(v, 16)) + (readlane_f(v, 32) + readlane_f(v, 48));
}
__device__ __forceinline__ int seqrow(int b, int s) { return s < NMETA ? NGRID + NMETA * b + s : SEQ * b + (s - NMETA); }

struct Params {
    const float* in[25];
    float* out;
    unsigned char* ws;
    int ph_lo, ph_hi;
};
struct Ctx {
    LAS unsigned char* lds;
    int G, bid, gc;
    unsigned char* ws;
    const float* const* in;
    float* out;
};
__device__ __forceinline__ int fresh_tid() { int t = threadIdx.x; asm volatile("" : "+v"(t)); return t; }
__device__ __forceinline__ unsigned char* fresh_ws(unsigned char* p) { asm volatile("" : "+s"(p)); return p; }
#define PHASE_IDS unsigned char* const wsl = fresh_ws(C.ws); (void)wsl; const int tid = fresh_tid(); const int lane = tid & 63; const int wave = __builtin_amdgcn_readfirstlane(tid >> 6); (void)lane; (void)wave;
enum { I_X = 0, I_META, I_WIN, I_CONVW, I_CONVB, I_WA, I_BA, I_WX, I_BX, I_LAM, I_LOUT, I_WQKV, I_RPB, I_MBIAS, I_NOUT, I_LNMG, I_LNMB, I_RW, I_RB, I_WGU, I_BGU, I_WD, I_BD, I_LNFG, I_LNFB };

namespace pg8 {
constexpr int BM = 256, BK = 64, HALF = 128, HTB = HALF * BK * 2, STAGE_BYTES = 8 * HTB, NXCD = 8, WGM = 8;
constexpr int SIDE_OFF = STAGE_BYTES, TEXP_OFF = STAGE_BYTES + 2048, TOK_OFF = STAGE_BYTES + 2048 + 4096;
__device__ __forceinline__ int lds_byte(int r, int c) { const int st = (r >> 4) * 2 + (c >> 5), rr = r & 15, cc = c & 31, ob = rr * 64 + cc * 2; return st * 1024 + (ob ^ (((ob >> 9) & 1) << 5)); }
__device__ __forceinline__ void stage_rc(int b, int& R, int& C) { const int st = b / 1024, sb = b % 1024, swz = sb ^ (((sb >> 9) & 1) << 5); R = (st >> 1) * 16 + swz / 64; C = (st & 1) * 32 + (swz % 64) / 2; }
__device__ __forceinline__ int perm32(int rho) { const int n = rho >> 4, i = rho & 15; return 8 * (i >> 2) + 4 * n + (i & 3); }

typedef int v8i __attribute__((ext_vector_type(8)));
typedef int v4i __attribute__((ext_vector_type(4)));
__device__ __forceinline__ v8i cat8(bf16x8 a, bf16x8 b) { const v4i x = __builtin_bit_cast(v4i, a), y = __builtin_bit_cast(v4i, b); return __builtin_shufflevector(x, y, 0, 1, 2, 3, 4, 5, 6, 7); }
struct Unit { unsigned ao, bo, to; int pm, pn, aux; };

__device__ __forceinline__ void tile_of(int L, int nM, int nN, int& pm, int& pn) {
    const int nwg = nM * nN; int wgid = L;
    { const int q = nwg / NXCD, r = nwg % NXCD, xcd = wgid % NXCD, off = wgid / NXCD; wgid = (xcd < r ? xcd * (q + 1) : r * (q + 1) + (xcd - r) * q) + off; }
    const int nig = WGM * nN, gid = wgid / nig, fm = gid * WGM, gsz = (nM - fm) < WGM ? (nM - fm) : WGM;
    pm = fm + ((wgid % nig) % gsz); pn = (wgid % nig) / gsz;
}

template <bool F8, bool GATHER, class Epi, class Sched>
__device__ __forceinline__ void gemm_phase(LAS unsigned char* lds, const unsigned char* wsbase, const int K, const int lda, const int ldb, const Sched& S, const Epi& E) {
    const __amdgpu_buffer_rsrc_t rsrc = __builtin_amdgcn_make_buffer_rsrc((void*)wsbase, 0, 0xFFFFFFFF, 0x00020000);
    const int tid = fresh_tid(), wid = __builtin_amdgcn_readfirstlane(tid >> 6), lane = tid & 63, wr = wid >> 2, wc = wid & 3;
    const int nt = K / BK;
    int f8scales = 0; if constexpr (F8) { f8scales = Epi::SCALES; asm volatile("" : "+v"(f8scales)); }
    int voffA, voffB;
    { int R, C; stage_rc(tid * 16, R, C); const int Rb = Epi::PERM ? ((R & ~31) + perm32(R & 31)) : R; voffA = ((GATHER ? 0 : R * lda) + C) * 2; voffB = (Rb * ldb + C) * 2; }
    const int tokb = (16 * (wid >> 1) + (lane >> 2)) * 4;
    const unsigned kstep = (unsigned)(BK * 2);
    const unsigned hstepA = (unsigned)HALF * lda * 2, hstepB = (unsigned)HALF * ldb * 2;
    const unsigned ldsw = (unsigned)wid * 1024u;
    const int aoff = lds_byte(wr * 64 + (lane & 15), (lane >> 4) * 8), boff = lds_byte(wc * 32 + (lane & 15), (lane >> 4) * 8);
#define PG8_SA(b, h) (((b) * 2 + (h)) * HTB)
#define PG8_SB(b, h) ((4 + (b) * 2 + (h)) * HTB)
#define PG8_STAGE(bufoff, gbase, voff) do { _Pragma("unroll") for (int _i = 0; _i < 2; ++_i) \
        __builtin_amdgcn_raw_ptr_buffer_load_lds(rsrc, (LAS void*)(lds + (bufoff) + ldsl + _i * 8192), 16, voff, __builtin_amdgcn_readfirstlane((int)((gbase) + (unsigned)_i * (hstep##voff >> 1))), 0, 0); } while (0)
#define hstepvoffA hstepA
#define hstepvoffB hstepB
#define PG8_STAGE_A(bufoff, aoffs, h, par) do { if constexpr (GATHER) { _Pragma("unroll") for (int _i = 0; _i < 2; ++_i) { \
            const int _tk = *(const LAS int*)(lds + TOK_OFF + (par) * 1024 + tokb + ((h) * 128 + _i * 64) * 4); \
            __builtin_amdgcn_raw_ptr_buffer_load_lds(rsrc, (LAS void*)(lds + (bufoff) + ldsl + _i * 8192), 16, _tk + voffA, __builtin_amdgcn_readfirstlane((int)(aoffs)), 0, 0); } } \
        else { PG8_STAGE(bufoff, (aoffs) + (unsigned)(h) * hstepA, voffA); } } while (0)
#define PG8_TOK(unit, par) do { if constexpr (GATHER) { if (wid == 0) __builtin_amdgcn_raw_ptr_buffer_load_lds(rsrc, (LAS void*)(lds + TOK_OFF + (par) * 1024), 16, lane * 16, (int)(unit).to, 0, 0); } } while (0)
#define PG8_LDA(dst, b, h) do { _Pragma("unroll") for (int m = 0; m < 4; ++m) _Pragma("unroll") for (int k = 0; k < 2; ++k) dst[m][k] = *(const LAS bf16x8*)(lds + PG8_SA(b, h) + aoff + m * 2048 + k * 1024); } while (0)
#define PG8_LDB(dst, b, h) do { _Pragma("unroll") for (int n = 0; n < 2; ++n) _Pragma("unroll") for (int k = 0; k < 2; ++k) dst[n][k] = *(const LAS bf16x8*)(lds + PG8_SB(b, h) + boff + n * 2048 + k * 1024); } while (0)
#define PG8_MMA(ai, bj, At, Bt) do { __builtin_amdgcn_s_setprio(1); _Pragma("unroll") for (int m = 0; m < 4; ++m) _Pragma("unroll") for (int n = 0; n < 2; ++n) { \
        if constexpr (F8) { asm volatile("v_mfma_scale_f32_16x16x128_f8f6f4 %0, %1, %2, %0, %3, %3 op_sel:[0,1,0] op_sel_hi:[0,0,0]" : "+v"(acc[ai][bj][m][n]) : "v"(cat8(Bt[n][0], Bt[n][1])), "v"(cat8(At[m][0], At[m][1])), "v"(f8scales)); } \
        else { _Pragma("unroll") for (int k = 0; k < 2; ++k) acc[ai][bj][m][n] = __builtin_amdgcn_mfma_f32_16x16x32_bf16(Bt[n][k], At[m][k], acc[ai][bj][m][n], 0, 0, 0); } } \
        __builtin_amdgcn_s_setprio(0); } while (0)
#define PG8_WAIT_V(n) asm volatile("s_waitcnt vmcnt(" #n ")" ::: "memory")
#define PG8_WAIT_L(n) asm volatile("s_waitcnt lgkmcnt(" #n ")" ::: "memory")
#define PG8_BAR __builtin_amdgcn_s_barrier()
#define PG8_SCHED __builtin_amdgcn_sched_barrier(0)
    Unit cur, nxt; int ui = 0;
    if (!S.next(0, cur)) return;
    f32x4 acc[2][2][4][2];
    bf16x8 At[4][2], B0[2][2], B1[2][2];
#define PG8_INIT(par) do { if constexpr (Epi::SIDE) { const int _l = fresh_tid() & 63; E.init(acc, (const LAS float*)(lds + SIDE_OFF + (par) * 1024), wc, _l >> 4); } \
        else { _Pragma("unroll") for (int a = 0; a < 2; ++a) _Pragma("unroll") for (int b = 0; b < 2; ++b) _Pragma("unroll") for (int m = 0; m < 4; ++m) _Pragma("unroll") for (int n = 0; n < 2; ++n) acc[a][b][m][n] = (f32x4){0.f, 0.f, 0.f, 0.f}; } } while (0)
    unsigned cA = cur.ao, cB = cur.bo;
    unsigned ldsl = ldsw; asm volatile("" : "+s"(ldsl));
#define PG8_SIDE(unit, par) do { if constexpr (Epi::SIDE) { if (wid == 0) __builtin_amdgcn_raw_ptr_buffer_load_lds(rsrc, (LAS void*)(lds + SIDE_OFF + (par) * 1024), 16, lane * 16, (int)E.side_off(unit), 0, 0); } } while (0)
    PG8_SIDE(cur, 0);
    if constexpr (GATHER) PG8_TOK(cur, 0);
    if constexpr (GATHER || Epi::SIDE) { asm volatile("s_waitcnt vmcnt(0)" ::: "memory"); PG8_BAR; }
    PG8_INIT(0);
    PG8_STAGE(PG8_SB(0, 0), cB, voffB); PG8_STAGE(PG8_SB(0, 1), cB + hstepB, voffB); PG8_STAGE_A(PG8_SA(0, 0), cA, 0, 0); PG8_STAGE_A(PG8_SA(0, 1), cA, 1, 0);
    if (wr == 1) PG8_BAR;
    PG8_WAIT_V(2); PG8_BAR;
    PG8_STAGE(PG8_SB(1, 0), cB + kstep, voffB); PG8_STAGE_A(PG8_SA(1, 0), cA + kstep, 0, 0); PG8_STAGE(PG8_SB(1, 1), cB + hstepB + kstep, voffB);
    PG8_WAIT_V(6); PG8_BAR;
    for (;;) {
        const bool has_next = S.next(ui + 1, nxt);
        if (has_next) { PG8_TOK(nxt, (ui + 1) & 1); PG8_SIDE(nxt, (ui + 1) & 1); }
        const unsigned nA = has_next ? nxt.ao : cA, nB = has_next ? nxt.bo : cB;
#pragma unroll 1
        for (int t = 0; t < nt; t += 2) {
            const bool last = (t == nt - 2);
            ldsl = ldsw; asm volatile("" : "+s"(ldsl));
            const int parc = ui & 1, parn = (ui + ((last && has_next) ? 1 : 0)) & 1;
            const unsigned a1 = cA + (unsigned)(t + 1) * kstep;
            const unsigned a2 = last ? nA : cA + (unsigned)(t + 2) * kstep, b2 = last ? nB : cB + (unsigned)(t + 2) * kstep;
            const unsigned a3 = a2 + kstep, b3 = b2 + kstep;
            PG8_LDB(B0, 0, 0); PG8_LDB(B1, 0, 1); PG8_SCHED; PG8_LDA(At, 0, 0); PG8_STAGE_A(PG8_SA(1, 1), a1, 1, parc);
            PG8_WAIT_V(8); PG8_WAIT_L(0); PG8_BAR; PG8_MMA(0, 0, At, B0); PG8_MMA(0, 1, At, B1); PG8_BAR; PG8_SCHED;
            PG8_LDA(At, 0, 1); PG8_STAGE(PG8_SB(0, 0), b2, voffB); PG8_STAGE(PG8_SB(0, 1), b2 + hstepB, voffB); PG8_STAGE_A(PG8_SA(0, 0), a2, 0, parn);
            PG8_WAIT_V(8); PG8_WAIT_L(0); PG8_BAR; PG8_MMA(1, 0, At, B0); PG8_MMA(1, 1, At, B1); PG8_BAR; PG8_SCHED;
            PG8_LDB(B0, 1, 0); PG8_LDB(B1, 1, 1); PG8_SCHED; PG8_LDA(At, 1, 0); PG8_STAGE_A(PG8_SA(0, 1), a2, 1, parn);
            PG8_WAIT_V(8); PG8_WAIT_L(0); PG8_BAR; PG8_MMA(0, 0, At, B0); PG8_MMA(0, 1, At, B1); PG8_BAR; PG8_SCHED;
            PG8_LDA(At, 1, 1); PG8_STAGE(PG8_SB(1, 0), b3, voffB); PG8_STAGE(PG8_SB(1, 1), b3 + hstepB, voffB); PG8_STAGE_A(PG8_SA(1, 0), a3, 0, parn);
            PG8_WAIT_V(8); PG8_WAIT_L(0); PG8_BAR; PG8_MMA(1, 0, At, B0); PG8_MMA(1, 1, At, B1); PG8_BAR; PG8_SCHED;
        }
        if constexpr (F8) asm volatile("s_nop 15\n\ts_nop 15" ::: "memory");
        if (wr == 0) PG8_BAR;
        { const int l2 = fresh_tid() & 63; E(acc, cur, wr, wc, l2 & 15, l2 >> 4, (const LAS float*)(lds + SIDE_OFF + (ui & 1) * 1024)); }
        if (!has_next) break;
        cur = nxt; cA = nA; cB = nB; ++ui;
        PG8_INIT(ui & 1);
        if (wr == 1) PG8_BAR;
    }
    PG8_WAIT_V(0);
    PG8_BAR;
#undef PG8_SA
#undef PG8_SB
#undef PG8_STAGE
#undef PG8_STAGE_A
#undef PG8_TOK
#undef PG8_SIDE
#undef PG8_INIT
#undef hstepvoffA
#undef hstepvoffB
#undef PG8_LDA
#undef PG8_LDB
#undef PG8_MMA
#undef PG8_WAIT_V
#undef PG8_WAIT_L
#undef PG8_BAR
#undef PG8_SCHED
}
}

using pg8::Unit;

struct DenseSched {
    unsigned A, Bt; int lda, ldb, nM, nN, G, c;
    __device__ __forceinline__ bool next(int i, Unit& u) const {
        const int L = i * G + c; if (L >= nM * nN) return false;
        pg8::tile_of(L, nM, nN, u.pm, u.pn); u.aux = 0; u.to = 0;
        u.ao = A + (unsigned)u.pm * 256 * lda * 2; u.bo = Bt + (unsigned)u.pn * 256 * ldb * 2; return true;
    }
};
struct GateSched {
    unsigned XC, GT; int nM, G, c;
    __device__ __forceinline__ bool next(int i, Unit& u) const {
        const int per = nM * 4; const int L = i * G + c; if (L >= 4 * per) return false;
        const int nb = L / per; pg8::tile_of(L - nb * per, nM, 4, u.pm, u.pn); u.aux = nb; u.to = 0;
        u.ao = XC + ((unsigned)u.pm * 256 * 1024 + 256 * nb) * 2; u.bo = GT + ((unsigned)nb * 1024 + 256 * u.pn) * 256 * 2; return true;
    }
};
struct QkvSched {
    unsigned HB, WT; int nM, G, c;
    __device__ __forceinline__ bool next(int i, Unit& u) const {
        const int n0 = nM * 8, n1 = 4 * nM; const int L = i * G + c; if (L >= n0 + n1) return false; u.to = 0;
        if (L < n0) { pg8::tile_of(L, nM, 8, u.pm, u.pn); u.aux = 0; u.ao = HB + (unsigned)u.pm * 256 * 1024; u.bo = WT + (unsigned)u.pn * 256 * 1024; }
        else { pg8::tile_of(L - n0, 4, nM, u.pm, u.pn); u.aux = 1; u.ao = WT + (unsigned)(2048 + u.pm * 256) * 1024; u.bo = HB + (unsigned)u.pn * 256 * 1024; }
        return true;
    }
};
struct MoeSched {
    unsigned A, W, tok; const LAS int* texp; unsigned wstride; int nM, nN, G, c;
    __device__ __forceinline__ bool next(int i, Unit& u) const {
        const int L = i * G + c; if (L >= nM * nN) return false;
        pg8::tile_of(L, nM, nN, u.pm, u.pn);
        const int e = __builtin_amdgcn_readfirstlane(texp[u.pm]); u.aux = e;
        u.ao = tok ? A : A + (unsigned)u.pm * 256 * 1024; u.to = tok + (unsigned)u.pm * 1024; u.bo = W + (unsigned)e * wstride + (unsigned)u.pn * 256 * 1024; return true;
    }
};

#define EPI_ARGS const f32x4 (&acc)[2][2][4][2], const Unit& u, int wr, int wc, int fr, int fq, const LAS float* side
struct EpiWin {
    static constexpr bool PERM = true, SIDE = false;
    bf16_t* XR; bf16_t* GY;
    __device__ __forceinline__ void operator()(EPI_ARGS) const {
        const int row0 = u.pm * 256 + wr * 64 + fr;
        if (u.pn < 4) {
            const int col0 = u.pn * 256 + wc * 32 + 8 * fq;
#pragma unroll
            for (int ai = 0; ai < 2; ++ai)
#pragma unroll
                for (int m = 0; m < 4; ++m) { bf16_t* rowp = XR + (size_t)(row0 + ai * 128 + m * 16) * D + col0;
#pragma unroll
                    for (int bj = 0; bj < 2; ++bj) { const f32x4 v0 = acc[ai][bj][m][0], v1 = acc[ai][bj][m][1];
                        u32x4 w; w.x = cvt_pk_bf16(v0[0], v0[1]); w.y = cvt_pk_bf16(v0[2], v0[3]); w.z = cvt_pk_bf16(v1[0], v1[1]); w.w = cvt_pk_bf16(v1[2], v1[3]);
                        *(u32x4*)(rowp + bj * 128) = w; } }
        } else {
#pragma unroll
            for (int ai = 0; ai < 2; ++ai)
#pragma unroll
                for (int m = 0; m < 4; ++m) { const int row = row0 + ai * 128 + m * 16;
#pragma unroll
                    for (int bj = 0; bj < 2; ++bj) { const int g = (u.pn - 4) * 8 + bj * 4 + wc;
                        float o[8];
#pragma unroll
                        for (int n = 0; n < 2; ++n)
#pragma unroll
                            for (int j = 0; j < 4; ++j) { const float v = acc[ai][bj][m][n][j]; const float z = 1.5957691216f * (v + 0.044715f * v * v * v); o[n * 4 + j] = v * sigmoidf_(z); }
                        u32x4 w; w.x = cvt_pk_bf16(o[0], o[1]); w.y = cvt_pk_bf16(o[2], o[3]); w.z = cvt_pk_bf16(o[4], o[5]); w.w = cvt_pk_bf16(o[6], o[7]);
                        *(u32x4*)(GY + ((size_t)g * MPAD + row) * 32 + 8 * fq) = w; } }
        }
    }
};
struct EpiGate {
    static constexpr bool PERM = true, SIDE = true;
    const bf16_t* XC; bf16_t* LA; bf16_t* BB; const float* spl; unsigned bias_off;
    __device__ __forceinline__ unsigned side_off(const Unit& u) const { return bias_off + (unsigned)((((u.pn >> 1) * 4 + u.aux) * 2 + (u.pn & 1)) * 1024); }
    __device__ __forceinline__ void init(f32x4 (&acc)[2][2][4][2], const LAS float* side, int wc, int fq) const {
#pragma unroll
        for (int bj = 0; bj < 2; ++bj)
#pragma unroll
            for (int n = 0; n < 2; ++n) { const f32x4 b = *(const LAS f32x4*)(side + 128 * bj + 32 * wc + 8 * fq + 4 * n);
#pragma unroll
                for (int ai = 0; ai < 2; ++ai)
#pragma unroll
                    for (int m = 0; m < 4; ++m) acc[ai][bj][m][n] = b; }
    }
    __device__ __forceinline__ void operator()(EPI_ARGS) const {
        const int nb = u.aux, dir = u.pn >> 1, half = u.pn & 1;
        const int ch0 = 256 * nb + 128 * half + 32 * wc + 8 * fq, g = ch0 >> 5;
        const int row0 = u.pm * 256 + wr * 64 + fr;
        float csp[8];
        { const f32x4 p0 = *(const f32x4*)(spl + dir * 1024 + ch0), p1 = *(const f32x4*)(spl + dir * 1024 + ch0 + 4);
#pragma unroll
          for (int j = 0; j < 4; ++j) { csp[j] = -p0[j]; csp[4 + j] = -p1[j]; } }
        u32x4 xnext = *(const u32x4*)(XC + (size_t)row0 * D + ch0);
#pragma unroll
        for (int ai = 0; ai < 2; ++ai)
#pragma unroll
            for (int m = 0; m < 4; ++m) { const int row = row0 + ai * 128 + m * 16;
                const u32x4 xw = xnext;
                { const int it = ai * 4 + m + 1, rn = row0 + (it >> 2) * 128 + (it & 3) * 16; if (it < 8) xnext = *(const u32x4*)(XC + (size_t)rn * D + ch0); }
                float xc[8]; unpack8(xw, xc);
                const bool start = dir == 1 && (row & (SEQ - 1)) == SEQ - 1;
                float la[8], bb[8];
#pragma unroll
                for (int n = 0; n < 2; ++n)
#pragma unroll
                    for (int j = 0; j < 4; ++j) { const int i = n * 4 + j;
                        const float l2 = csp[i] * sigmoidf_(acc[ai][0][m][n][j]); const float a2 = fast_exp2(2.0f * l2);
                        const float mult = start ? 1.0f : __builtin_amdgcn_sqrtf(fmaxf(1.0f - a2, 0.0f));
                        la[i] = l2; bb[i] = mult * sigmoidf_(acc[ai][1][m][n][j]) * xc[i]; }
                u32x4 w; w.x = cvt_pk_bf16(la[0], la[1]); w.y = cvt_pk_bf16(la[2], la[3]); w.z = cvt_pk_bf16(la[4], la[5]); w.w = cvt_pk_bf16(la[6], la[7]);
                const size_t o = (((size_t)dir * 32 + g) * MPAD + row) * 32 + 8 * fq;
                *(u32x4*)(LA + o) = w;
                w.x = cvt_pk_bf16(bb[0], bb[1]); w.y = cvt_pk_bf16(bb[2], bb[3]); w.z = cvt_pk_bf16(bb[4], bb[5]); w.w = cvt_pk_bf16(bb[6], bb[7]);
                *(u32x4*)(BB + o) = w; }
    }
};
template <bool LAYER0> struct EpiRes {
    static constexpr bool PERM = true, SIDE = false;
    bf16_t* PRE; const float* x; const float* meta; const bf16_t* HB; int nrows;
    __device__ __forceinline__ void operator()(EPI_ARGS) const {
        const int row0 = u.pm * 256 + wr * 64 + fr, col0 = u.pn * 256 + wc * 32 + 8 * fq;
#pragma unroll
        for (int ai = 0; ai < 2; ++ai)
#pragma unroll
            for (int m = 0; m < 4; ++m) { const int row = row0 + ai * 128 + m * 16;
                if (row < nrows) {
#pragma unroll
                    for (int bj = 0; bj < 2; ++bj) { const int c = col0 + bj * 128; float r[8];
                        if (LAYER0) { const float* rp = (row < NGRID ? x + (size_t)row * D : meta + (size_t)((row - NGRID) & 15) * D) + c; const f32x4 r0 = *(const f32x4*)rp, r1 = *(const f32x4*)(rp + 4);
                            r[0] = r0[0]; r[1] = r0[1]; r[2] = r0[2]; r[3] = r0[3]; r[4] = r1[0]; r[5] = r1[1]; r[6] = r1[2]; r[7] = r1[3]; }
                        else { const u32x4 rw = *(const u32x4*)(HB + (size_t)row * D + c); r[0] = bflo(rw.x); r[1] = bfhi(rw.x); r[2] = bflo(rw.y); r[3] = bfhi(rw.y); r[4] = bflo(rw.z); r[5] = bfhi(rw.z); r[6] = bflo(rw.w); r[7] = bfhi(rw.w); }
                        const f32x4 a0 = acc[ai][bj][m][0], a1 = acc[ai][bj][m][1];
                        u32x4 w; w.x = cvt_pk_bf16(r[0] * DN_ALPHA + a0[0], r[1] * DN_ALPHA + a0[1]); w.y = cvt_pk_bf16(r[2] * DN_ALPHA + a0[2], r[3] * DN_ALPHA + a0[3]);
                        w.z = cvt_pk_bf16(r[4] * DN_ALPHA + a1[0], r[5] * DN_ALPHA + a1[1]); w.w = cvt_pk_bf16(r[6] * DN_ALPHA + a1[2], r[7] * DN_ALPHA + a1[3]);
                        *(u32x4*)(PRE + (size_t)row * D + c) = w; }
                }
                asm volatile("" ::: "memory"); }
    }
};
struct EpiGlu {
    static constexpr bool PERM = true, SIDE = true; static constexpr int SCALES = 0x7F79;
    unsigned char* ACT; unsigned bias_off;
    __device__ __forceinline__ unsigned side_off(const Unit& u) const { return bias_off + (unsigned)((u.aux * 8 + u.pn) * 1024); }
    __device__ __forceinline__ void init(f32x4 (&acc)[2][2][4][2], const LAS float* side, int wc, int fq) const {
#pragma unroll
        for (int bj = 0; bj < 2; ++bj)
#pragma unroll
            for (int n = 0; n < 2; ++n) { const f32x4 b = *(const LAS f32x4*)(side + 128 * bj + 32 * wc + 8 * fq + 4 * n);
#pragma unroll
                for (int ai = 0; ai < 2; ++ai)
#pragma unroll
                    for (int m = 0; m < 4; ++m) acc[ai][bj][m][n] = b; }
    }
    __device__ __forceinline__ void operator()(EPI_ARGS) const {
        const int f0 = 128 * u.pn + 32 * wc + 8 * fq;
        const int row0 = u.pm * 256 + wr * 64 + fr;
#pragma unroll
        for (int ai = 0; ai < 2; ++ai)
#pragma unroll
            for (int m = 0; m < 4; ++m) { const int row = row0 + ai * 128 + m * 16; float o[8];
#pragma unroll
                for (int n = 0; n < 2; ++n)
#pragma unroll
                    for (int j = 0; j < 4; ++j) { const int i = n * 4 + j;
                        const float glu = fminf(acc[ai][0][m][n][j], 7.0f);
                        const float lin4 = __builtin_fmaf(__builtin_amdgcn_fmed3f(acc[ai][1][m][n][j], -7.0f, 7.0f), 4.0f, 4.0f);
                        const float r = fast_rcp(1.0f + fast_exp2(glu * (-1.702f * 1.44269504089f)));
                        o[i] = (glu * r) * lin4; }
                u32x2 w; w.x = pk4_fp8(o[0], o[1], o[2], o[3]); w.y = pk4_fp8(o[4], o[5], o[6], o[7]);
                *(u32x2*)(ACT + (size_t)row * D + f0) = w; }
    }
};
struct EpiNull {
    static constexpr bool PERM = true, SIDE = false; static constexpr int SCALES = 0x7F79;
    __device__ __forceinline__ void operator()(EPI_ARGS) const {
#pragma unroll
        for (int ai = 0; ai < 2; ++ai)
#pragma unroll
            for (int bj = 0; bj < 2; ++bj)
#pragma unroll
                for (int m = 0; m < 4; ++m)
#pragma unroll
                    for (int n = 0; n < 2; ++n) asm volatile("" :: "v"(acc[ai][bj][m][n]));
    }
};
struct EpiDown {
    static constexpr bool PERM = true, SIDE = true; static constexpr int SCALES = 0x7D79;
    unsigned char* YS; unsigned bias_off;
    __device__ __forceinline__ unsigned side_off(const Unit& u) const { return bias_off + (unsigned)((u.aux * 4 + u.pn) * 1024); }
    __device__ __forceinline__ void init(f32x4 (&acc)[2][2][4][2], const LAS float* side, int wc, int fq) const {
#pragma unroll
        for (int bj = 0; bj < 2; ++bj)
#pragma unroll
            for (int n = 0; n < 2; ++n) { const f32x4 b = *(const LAS f32x4*)(side + 128 * bj + 32 * wc + 8 * fq + 4 * n);
#pragma unroll
                for (int ai = 0; ai < 2; ++ai)
#pragma unroll
                    for (int m = 0; m < 4; ++m) acc[ai][bj][m][n] = b; }
    }
    __device__ __forceinline__ void operator()(EPI_ARGS) const {
        const int row0 = u.pm * 256 + wr * 64 + fr, col0 = u.pn * 256 + wc * 32 + 8 * fq;
#pragma unroll
        for (int ai = 0; ai < 2; ++ai)
#pragma unroll
            for (int m = 0; m < 4; ++m) { unsigned char* rowp = YS + (size_t)(row0 + ai * 128 + m * 16) * D + col0;
#pragma unroll
                for (int bj = 0; bj < 2; ++bj) { const f32x4 v0 = acc[ai][bj][m][0] * 8.0f, v1 = acc[ai][bj][m][1] * 8.0f;
                    u32x2 w; w.x = pk4_fp8(v0[0], v0[1], v0[2], v0[3]); w.y = pk4_fp8(v1[0], v1[1], v1[2], v1[3]);
                    *(u32x2*)(rowp + bj * 128) = w; } }
    }
};
struct EpiQkv {
    static constexpr bool PERM = true, SIDE = false; static constexpr int SCALES = 0x7F79;
    bf16_t* Q; bf16_t* Kx; bf16_t* VT;
    __device__ __forceinline__ void operator()(EPI_ARGS) const {
        const int row0 = u.pm * 256 + wr * 64 + fr; bf16_t* base; int ldc, colt; float sc = 1.0f;
        if (u.aux == 0) { ldc = D; if (u.pn < 4) { base = Q; colt = u.pn * 256; sc = 0.125f * 1.44269504089f; } else { base = Kx; colt = (u.pn - 4) * 256; } }
        else { base = VT; ldc = MPAD; colt = u.pn * 256; }
        const int col0 = colt + wc * 32 + 8 * fq;
#pragma unroll
        for (int ai = 0; ai < 2; ++ai)
#pragma unroll
            for (int m = 0; m < 4; ++m) { bf16_t* rowp = base + (size_t)(row0 + ai * 128 + m * 16) * ldc + col0;
#pragma unroll
                for (int bj = 0; bj < 2; ++bj) { const f32x4 v0 = acc[ai][bj][m][0] * sc, v1 = acc[ai][bj][m][1] * sc;
                    u32x4 w; w.x = cvt_pk_bf16(v0[0], v0[1]); w.y = cvt_pk_bf16(v0[2], v0[3]); w.z = cvt_pk_bf16(v1[0], v1[1]); w.w = cvt_pk_bf16(v1[2], v1[3]);
                    *(u32x4*)(rowp + bj * 128) = w; } }
    }
};

struct CvItem { const float* src; unsigned char* dst; int ld, pitch, f8; };
__device__ __forceinline__ CvItem cv_item(const Ctx& C, unsigned char* wsl, int it) {
    constexpr int I0 = 512, I1 = 256, I2 = 256, I3 = 768, I4 = 256, I5 = 32768, I6 = 16384;
    CvItem q; int r = it;
    if (r < I0) { const int nbk = r & 63, kb = r >> 6; q.src = C.in[I_WIN] + (size_t)(128 * kb) * 2048 + 32 * nbk; q.ld = 2048; q.dst = wsl + WS_WIN + ((size_t)(32 * nbk) * 1024 + 128 * kb) * 2; q.pitch = 2048; q.f8 = 0; return q; } r -= I0;
    if (r < I1) { const int job = r >> 3, sub = r & 7, nbk = sub & 3, kb = sub >> 2;
        const int half = job & 1, which = (job >> 1) & 1, nb = (job >> 2) & 3, dir = job >> 4;
        q.src = C.in[which ? I_WX : I_WA] + (size_t)(dir * 4 + nb) * 65536 + (size_t)(128 * kb) * 256 + 128 * half + 32 * nbk; q.ld = 256;
        q.dst = wsl + WS_GATE + (((size_t)nb * 1024 + 256 * (2 * dir + half) + 128 * which + 32 * nbk) * 256 + 128 * kb) * 2; q.pitch = 512; q.f8 = 0; return q; } r -= I1;
    if (r < I2) { const int nbk = r & 31, kb = r >> 5; q.src = C.in[I_LOUT] + (size_t)(128 * kb) * 1024 + 32 * nbk; q.ld = 1024; q.dst = wsl + WS_LOUT + ((size_t)(32 * nbk) * 1024 + 128 * kb) * 2; q.pitch = 2048; q.f8 = 0; return q; } r -= I2;
    if (r < I3) { const int nbk = r % 96, kb = r / 96; q.src = C.in[I_WQKV] + (size_t)(128 * kb) * 3072 + 32 * nbk; q.ld = 3072; q.dst = wsl + WS_QKV + ((size_t)(32 * nbk) * 1024 + 128 * kb) * 2; q.pitch = 2048; q.f8 = 0; return q; } r -= I3;
    if (r < I4) { const int nbk = r & 31, kb = r >> 5; q.src = C.in[I_NOUT] + (size_t)(128 * kb) * 1024 + 32 * nbk; q.ld = 1024; q.dst = wsl + WS_NOUT + ((size_t)(32 * nbk) * 1024 + 128 * kb) * 2; q.pitch = 2048; q.f8 = 0; return q; } r -= I4;
    q.f8 = 1; q.pitch = 1024;
    if (r < I5) { const int mat = r >> 9, sub = r & 511, nbk = sub & 63, kb = sub >> 6; const int n0 = 32 * nbk, bj = n0 >> 10, f0 = n0 & 1023, pn = f0 >> 7, jj = f0 & 127;
        q.src = C.in[I_WGU] + (size_t)mat * 1024 * 2048 + (size_t)(128 * kb) * 2048 + n0; q.ld = 2048; q.dst = wsl + WS_WGU + ((size_t)mat * 2048 + 256 * pn + 128 * bj + jj) * 1024 + 128 * kb; return q; } r -= I5;
    if (r < I6) { const int mat = r >> 8, sub = r & 255, nbk = sub & 31, kb = sub >> 5;
        q.src = C.in[I_WD] + (size_t)mat * 1024 * 1024 + (size_t)(128 * kb) * 1024 + 32 * nbk; q.ld = 1024; q.dst = wsl + WS_WD + ((size_t)mat * 1024 + 32 * nbk) * 1024 + 128 * kb; return q; } r -= I6;
    { const int nbk = r % 96, kb = r / 96; q.src = C.in[I_WQKV] + (size_t)(128 * kb) * 3072 + 32 * nbk; q.ld = 3072; q.dst = wsl + WS_QKV8 + (size_t)(32 * nbk) * 1024 + 128 * kb; return q; }
}
__device__ __forceinline__ void phase_convert(const Ctx& C) {
    PHASE_IDS
    LAS float* scr = (LAS float*)(C.lds + wave * 16896);
    const int gw = C.bid * NWAVES + wave, NGW = C.G * NWAVES;
    constexpr int NIT = 512 + 256 + 256 + 768 + 256 + 32768 + 16384 + 768;
    if (gw < NIT) {
        const int r = lane >> 3, q4 = lane & 7, c = lane & 15, nn = lane >> 4;
        CvItem cur = cv_item(C, wsl, gw); int it = gw;
        f32x4 v[16];
#pragma unroll
        for (int i = 0; i < 16; ++i) v[i] = __builtin_nontemporal_load((const f32x4*)(cur.src + (size_t)(8 * i + r) * cur.ld + 4 * q4));
        for (;;) {
#pragma unroll
            for (int i = 0; i < 16; ++i) { LAS float* sp = scr + (8 * i + r) * 33 + 4 * q4; sp[0] = v[i][0]; sp[1] = v[i][1]; sp[2] = v[i][2]; sp[3] = v[i][3]; }
            const int nit = it + NGW; CvItem nxt = cur;
            if (nit < NIT) { nxt = cv_item(C, wsl, nit);
#pragma unroll
                for (int i = 0; i < 16; ++i) v[i] = __builtin_nontemporal_load((const f32x4*)(nxt.src + (size_t)(8 * i + r) * nxt.ld + 4 * q4)); }
            asm volatile("s_waitcnt lgkmcnt(0)" ::: "memory");
            if (cur.f8) {
#pragma unroll
                for (int j = 0; j < 8; ++j) { const int n = nn + 4 * j; const LAS float* sp = scr + (8 * c) * 33 + n;
                    u32x2 o; o.x = pk4_fp8(sp[0] * 64.0f, sp[33] * 64.0f, sp[2 * 33] * 64.0f, sp[3 * 33] * 64.0f); o.y = pk4_fp8(sp[4 * 33] * 64.0f, sp[5 * 33] * 64.0f, sp[6 * 33] * 64.0f, sp[7 * 33] * 64.0f);
                    *(u32x2*)(cur.dst + (size_t)n * cur.pitch + 8 * c) = o; }
            } else {
#pragma unroll
                for (int j = 0; j < 8; ++j) { const int n = nn + 4 * j; const LAS float* sp = scr + (8 * c) * 33 + n;
                    u32x4 o; o.x = pk2(sp[0], sp[33]); o.y = pk2(sp[2 * 33], sp[3 * 33]); o.z = pk2(sp[4 * 33], sp[5 * 33]); o.w = pk2(sp[6 * 33], sp[7 * 33]);
                    *(u32x4*)(cur.dst + (size_t)n * cur.pitch + 16 * c) = o; }
            }
            asm volatile("s_waitcnt lgkmcnt(0)" ::: "memory");
            if (nit >= NIT) break;
            cur = nxt; it = nit;
        }
    }
    const int gt = C.bid * NTHREADS + tid, NGT = C.G * NTHREADS;
    for (int i = gt; i < 2048; i += NGT) ((float*)(wsl + WS_CTL + CT_SPL))[i] = 8.0f * 1.44269504089f * log1pf(expf(-C.in[I_LAM][i]));
    for (int i = gt; i < 2 * 32 * 2048; i += NGT) { const int le = i >> 11, r = i & 2047, pn = r >> 8, bj = (r >> 7) & 1, ii = r & 127;
        ((float*)(wsl + WS_BIAS))[i] = C.in[I_BGU][(size_t)le * 2048 + bj * 1024 + 128 * pn + ii]; }
    for (int i = gt; i < 2 * 32 * 1024; i += NGT) ((float*)(wsl + WS_BD))[i] = C.in[I_BD][i];
    for (int i = gt; i < 4096; i += NGT) { const int ut = i >> 8, which = (i >> 7) & 1, jj = i & 127, dir = ut >> 3, nb = (ut >> 1) & 3, half = ut & 1;
        ((float*)(wsl + WS_GBIAS))[i] = C.in[which ? I_BX : I_BA][dir * 1024 + 256 * nb + 128 * half + jj]; }
    for (int i0 = gt; i0 < NTOK * 128; i0 += 4 * NGT) { f32x4 a[4], b[4];
#pragma unroll
        for (int u = 0; u < 4; ++u) { const int i = i0 + u * NGT; if (i < NTOK * 128) { const int row = i >> 7, oc = i & 127;
            const float* src = (row < NGRID ? C.in[I_X] + (size_t)row * D : C.in[I_META] + (size_t)((row - NGRID) & 15) * D) + 8 * oc;
            a[u] = __builtin_nontemporal_load((const f32x4*)src); b[u] = __builtin_nontemporal_load((const f32x4*)(src + 4)); } }
#pragma unroll
        for (int u = 0; u < 4; ++u) { const int i = i0 + u * NGT; if (i < NTOK * 128) { const int row = i >> 7, oc = i & 127;
            u32x4 w; w.x = pk2(a[u][0], a[u][1]); w.y = pk2(a[u][2], a[u][3]); w.z = pk2(b[u][0], b[u][1]); w.w = pk2(b[u][2], b[u][3]);
            *(u32x4*)((bf16_t*)(wsl + WS_HB) + (size_t)row * D + 8 * oc) = w; } } }
}

__device__ __forceinline__ void phase_conv(const Ctx& C) {
    PHASE_IDS
    const bf16_t* XR = (const bf16_t*)(wsl + WS_XR); bf16_t* XC = (bf16_t*)(wsl + WS_XC);
    const float* cw = C.in[I_CONVW]; const float* cb = C.in[I_CONVB];
    const int gt = C.bid * NTHREADS + tid, NGT = C.G * NTHREADS;
    for (int i = gt; i < NTOK * 128; i += NGT) { const int row = i >> 7, ch = 8 * (i & 127);
        int b, s; if (row < NGRID) { b = row >> 12; s = NMETA + (row & (SEQ - 1)); } else { b = (row - NGRID) >> 4; s = (row - NGRID) & 15; }
        float a[8];
        { const f32x4 t0 = *(const f32x4*)(cb + ch), t1 = *(const f32x4*)(cb + ch + 4);
#pragma unroll
          for (int j = 0; j < 4; ++j) { a[j] = t0[j]; a[4 + j] = t1[j]; } }
#pragma unroll
        for (int j = 0; j < 4; ++j) { const int sj = s - 2 + j;
            if (sj >= 0 && sj < LSEQ) { const u32x4 xw = *(const u32x4*)(XR + (size_t)seqrow(b, sj) * D + ch);
                const f32x4 w0 = *(const f32x4*)(cw + j * 1024 + ch), w1 = *(const f32x4*)(cw + j * 1024 + ch + 4);
                a[0] += w0[0] * bflo(xw.x); a[1] += w0[1] * bfhi(xw.x); a[2] += w0[2] * bflo(xw.y); a[3] += w0[3] * bfhi(xw.y);
                a[4] += w1[0] * bflo(xw.z); a[5] += w1[1] * bfhi(xw.z); a[6] += w1[2] * bflo(xw.w); a[7] += w1[3] * bfhi(xw.w); } }
        u32x4 w; w.x = pk2(a[0], a[1]); w.y = pk2(a[2], a[3]); w.z = pk2(a[4], a[5]); w.w = pk2(a[6], a[7]);
        *(u32x4*)(XC + (size_t)row * D + ch) = w; }
}

template <int N> __device__ __forceinline__ float dpp_shr(float oldv, float v) {
    return __builtin_bit_cast(float, __builtin_amdgcn_update_dpp(__builtin_bit_cast(int, oldv), __builtin_bit_cast(int, v), 0x110 + N, 0xf, 0xf, false));
}
__device__ __forceinline__ void scan_group(float (&a)[8], float (&b)[8]) {
#pragma unroll
    for (int c = 0; c < 8; ++c) {
        { const float ap = dpp_shr<1>(1.0f, a[c]), bp = dpp_shr<1>(0.0f, b[c]); b[c] = a[c] * bp + b[c]; a[c] = a[c] * ap; }
        { const float ap = dpp_shr<2>(1.0f, a[c]), bp = dpp_shr<2>(0.0f, b[c]); b[c] = a[c] * bp + b[c]; a[c] = a[c] * ap; }
        { const float ap = dpp_shr<4>(1.0f, a[c]), bp = dpp_shr<4>(0.0f, b[c]); b[c] = a[c] * bp + b[c]; a[c] = a[c] * ap; }
        { const float ap = dpp_shr<8>(1.0f, a[c]), bp = dpp_shr<8>(0.0f, b[c]); b[c] = a[c] * bp + b[c]; a[c] = a[c] * ap; }
    }
}
__device__ __forceinline__ void unpack8(const u32x4 w, float (&o)[8]) { o[0] = bflo(w.x); o[1] = bfhi(w.x); o[2] = bflo(w.y); o[3] = bfhi(w.y); o[4] = bflo(w.z); o[5] = bfhi(w.z); o[6] = bflo(w.w); o[7] = bfhi(w.w); }
__device__ __forceinline__ void phase_scan(const Ctx& C) {
    PHASE_IDS
    const bf16_t* LA = (const bf16_t*)(wsl + WS_LA); const bf16_t* BB = (const bf16_t*)(wsl + WS_BB); const bf16_t* GY = (const bf16_t*)(wsl + WS_GY);
    bf16_t* HF = (bf16_t*)(wsl + WS_HF); bf16_t* Gout = (bf16_t*)(wsl + WS_G);
    LAS float* agg = (LAS float*)C.lds;
    const int w = wave, oct = lane >> 4, p = lane & 15;
    for (int it0 = (C.G == 256 ? C.gc : C.bid); it0 < NB * 32; it0 += C.G) {
        const int item = (C.G == 256) ? (((it0 >> 3) >> 2) << 5) + ((it0 & 7) << 2) + ((it0 >> 3) & 3) : it0;
        const int b = item >> 5, g = item & 31;
        for (int dir = 0; dir < 2; ++dir) {
            const bf16_t* la = LA + (((size_t)dir * 32 + g) * MPAD) * 32 + 8 * oct;
            const bf16_t* bb = BB + (((size_t)dir * 32 + g) * MPAD) * 32 + 8 * oct;
            float S[8];
#pragma unroll
            for (int c = 0; c < 8; ++c) S[c] = 0.f;
            {
                const int u = p, s = dir ? LSEQ - 1 - u : u, row = seqrow(b, s);
                float a[8], x[8]; unpack8(*(const u32x4*)(la + (size_t)row * 32), a); unpack8(*(const u32x4*)(bb + (size_t)row * 32), x);
#pragma unroll
                for (int c = 0; c < 8; ++c) a[c] = fast_exp2(a[c]);
                scan_group(a, x);
                if (w == 0) {
                    if (dir == 0) { u32x4 o; o.x = pk2(x[0], x[1]); o.y = pk2(x[2], x[3]); o.z = pk2(x[4], x[5]); o.w = pk2(x[6], x[7]); *(u32x4*)(HF + ((size_t)g * MPAD + row) * 32 + 8 * oct) = o; }
                    else { float hf[8], gy[8]; unpack8(*(const u32x4*)(HF + ((size_t)g * MPAD + row) * 32 + 8 * oct), hf); unpack8(*(const u32x4*)(GY + ((size_t)g * MPAD + row) * 32 + 8 * oct), gy);
                        u32x4 o; o.x = pk2((hf[0] + x[0]) * gy[0], (hf[1] + x[1]) * gy[1]); o.y = pk2((hf[2] + x[2]) * gy[2], (hf[3] + x[3]) * gy[3]);
                        o.z = pk2((hf[4] + x[4]) * gy[4], (hf[5] + x[5]) * gy[5]); o.w = pk2((hf[6] + x[6]) * gy[6], (hf[7] + x[7]) * gy[7]);
                        *(u32x4*)(Gout + (size_t)row * D + 32 * g + 8 * oct) = o; }
                }
#pragma unroll
                for (int c = 0; c < 8; ++c) S[c] = __shfl(x[c], (lane & 48) | 15);
            }
            u32x4 na[4], nb[4];
#pragma unroll
            for (int j = 0; j < 4; ++j) { const int u = 16 + 64 * w + 16 * j + p, s = dir ? LSEQ - 1 - u : u; const int rw = seqrow(b, s);
                na[j] = __builtin_nontemporal_load((const u32x4*)(la + (size_t)rw * 32)); nb[j] = __builtin_nontemporal_load((const u32x4*)(bb + (size_t)rw * 32)); }
            for (int r = 0; r < 8; ++r) {
                float Pw[4][8], Hw[4][8]; int rows[4];
                float Aw[8], Hc[8];
#pragma unroll
                for (int c = 0; c < 8; ++c) { Aw[c] = 1.f; Hc[c] = 0.f; }
                u32x4 ra[4], rb[4], rhf[4], rgy[4];
#pragma unroll
                for (int j = 0; j < 4; ++j) { const int u = 16 + 512 * r + 64 * w + 16 * j + p, s = dir ? LSEQ - 1 - u : u; rows[j] = seqrow(b, s); ra[j] = na[j]; rb[j] = nb[j]; }
                if (r < 7) {
#pragma unroll
                    for (int j = 0; j < 4; ++j) { const int u = 16 + 512 * (r + 1) + 64 * w + 16 * j + p, s = dir ? LSEQ - 1 - u : u; const int rw = seqrow(b, s);
                        na[j] = __builtin_nontemporal_load((const u32x4*)(la + (size_t)rw * 32)); nb[j] = __builtin_nontemporal_load((const u32x4*)(bb + (size_t)rw * 32)); } }
                if (dir == 1) {
#pragma unroll
                    for (int j = 0; j < 4; ++j) { const size_t go = ((size_t)g * MPAD + rows[j]) * 32 + 8 * oct; rhf[j] = *(const u32x4*)(HF + go); rgy[j] = __builtin_nontemporal_load((const u32x4*)(GY + go)); } }
#pragma unroll
                for (int j = 0; j < 4; ++j) {
                    float a[8], x[8]; unpack8(ra[j], a); unpack8(rb[j], x);
#pragma unroll
                    for (int c = 0; c < 8; ++c) a[c] = fast_exp2(a[c]);
                    scan_group(a, x);
#pragma unroll
                    for (int c = 0; c < 8; ++c) { Hw[j][c] = a[c] * Hc[c] + x[c]; Pw[j][c] = a[c] * Aw[c]; }
#pragma unroll
                    for (int c = 0; c < 8; ++c) { Aw[c] = __shfl(Pw[j][c], (lane & 48) | 15); Hc[c] = __shfl(Hw[j][c], (lane & 48) | 15); }
                }
                LAS float* ag = agg + (r & 1) * 512;
                if (p == 0) {
#pragma unroll
                    for (int c = 0; c < 8; ++c) { ag[(w * 32 + oct * 8 + c) * 2] = Aw[c]; ag[(w * 32 + oct * 8 + c) * 2 + 1] = Hc[c]; }
                }
                __syncthreads();
                float Sin[8];
#pragma unroll
                for (int c = 0; c < 8; ++c) Sin[c] = S[c];
#pragma unroll
                for (int ww = 0; ww < 8; ++ww) {
#pragma unroll
                    for (int c = 0; c < 8; ++c) { const float A = ag[(ww * 32 + oct * 8 + c) * 2], H = ag[(ww * 32 + oct * 8 + c) * 2 + 1];
                        if (ww == w) Sin[c] = S[c];
                        S[c] = A * S[c] + H; }
                }
#pragma unroll
                for (int j = 0; j < 4; ++j) {
                    float h[8];
#pragma unroll
                    for (int c = 0; c < 8; ++c) h[c] = Pw[j][c] * Sin[c] + Hw[j][c];
                    const size_t go = ((size_t)g * MPAD + rows[j]) * 32 + 8 * oct;
                    if (dir == 0) { u32x4 o; o.x = pk2(h[0], h[1]); o.y = pk2(h[2], h[3]); o.z = pk2(h[4], h[5]); o.w = pk2(h[6], h[7]); *(u32x4*)(HF + go) = o; }
                    else { float hf[8], gy[8]; unpack8(rhf[j], hf); unpack8(rgy[j], gy);
                        u32x4 o; o.x = pk2((hf[0] + h[0]) * gy[0], (hf[1] + h[1]) * gy[1]); o.y = pk2((hf[2] + h[2]) * gy[2], (hf[3] + h[3]) * gy[3]);
                        o.z = pk2((hf[4] + h[4]) * gy[4], (hf[5] + h[5]) * gy[5]); o.w = pk2((hf[6] + h[6]) * gy[6], (hf[7] + h[7]) * gy[7]);
                        *(u32x4*)(Gout + (size_t)rows[j] * D + 32 * g + 8 * oct) = o; }
                }
            }
            __syncthreads();
        }
    }
}

template <int K> __device__ __forceinline__ f32x4 mini_mma(const bf16_t* W, int ldw, const bf16_t* A, int lda, int lane) {
    const bf16_t* wp = W + (size_t)(lane & 15) * ldw + 8 * (lane >> 4); const bf16_t* ap = A + (size_t)(lane & 15) * lda + 8 * (lane >> 4);
    f32x4 acc = {0.f, 0.f, 0.f, 0.f};
    constexpr int KB = K < 512 ? K : 512, NS = KB / 32;
#pragma unroll 1
    for (int k0 = 0; k0 < K; k0 += KB) { bf16x8 wf[NS], af[NS];
#pragma unroll
        for (int i = 0; i < NS; ++i) { wf[i] = *(const bf16x8*)(wp + k0 + 32 * i); af[i] = *(const bf16x8*)(ap + k0 + 32 * i); }
#pragma unroll
        for (int i = 0; i < NS; ++i) acc = __builtin_amdgcn_mfma_f32_16x16x32_bf16(wf[i], af[i], acc, 0, 0, 0); }
    return acc;
}
__device__ __forceinline__ void mini_win(const Ctx& C) {
    PHASE_IDS
    const bf16_t* HB = (const bf16_t*)(C.ws + WS_HB); const bf16_t* WT = (const bf16_t*)(C.ws + WS_WIN); bf16_t* XR = (bf16_t*)(C.ws + WS_XR); bf16_t* GY = (bf16_t*)(C.ws + WS_GY);
    const int fr = lane & 15, fq = lane >> 4;
    for (int wt = C.gc * NWAVES + wave; wt < 8 * 128; wt += C.G * NWAVES) { const int rg = wt & 7, cb = wt >> 3, row = NGRID + 16 * rg + fr, c = 16 * cb + 4 * fq;
        const f32x4 a = mini_mma<1024>(WT + (size_t)(16 * cb) * 1024, 1024, HB + (size_t)(NGRID + 16 * rg) * 1024, 1024, lane);
        if (c < 1024) { u32x2 w; w.x = cvt_pk_bf16(a[0], a[1]); w.y = cvt_pk_bf16(a[2], a[3]); *(u32x2*)(XR + (size_t)row * D + c) = w; }
        else { const int yc = c - 1024; float o[4];
#pragma unroll
            for (int j = 0; j < 4; ++j) { const float v = a[j]; const float z = 1.5957691216f * (v + 0.044715f * v * v * v); o[j] = v * sigmoidf_(z); }
            u32x2 w; w.x = cvt_pk_bf16(o[0], o[1]); w.y = cvt_pk_bf16(o[2], o[3]); *(u32x2*)(GY + ((size_t)(yc >> 5) * MPAD + row) * 32 + (yc & 31)) = w; } }
}
__device__ __forceinline__ void mini_gate(const Ctx& C) {
    PHASE_IDS
    const bf16_t* XC = (const bf16_t*)(C.ws + WS_XC); const bf16_t* GT = (const bf16_t*)(C.ws + WS_GATE); bf16_t* LA = (bf16_t*)(C.ws + WS_LA); bf16_t* BB = (bf16_t*)(C.ws + WS_BB);
    const float* ba = C.in[I_BA]; const float* bx = C.in[I_BX]; const float* spl = (const float*)(C.ws + WS_CTL + CT_SPL);
    const int fr = lane & 15, fq = lane >> 4;
    for (int wt = C.gc * NWAVES + wave; wt < 8 * 2 * 64; wt += C.G * NWAVES) { const int rg = wt & 7, dir = (wt >> 3) & 1, chg = wt >> 4, ch0 = 16 * chg, nb = ch0 >> 8, half = (ch0 >> 7) & 1, jj0 = ch0 & 127;
        const bf16_t* A = XC + (size_t)(NGRID + 16 * rg) * 1024 + 256 * nb; const bf16_t* Wa = GT + ((size_t)nb * 1024 + 256 * (2 * dir + half) + jj0) * 256;
        const f32x4 za = mini_mma<256>(Wa, 256, A, 1024, lane), zx = mini_mma<256>(Wa + 128 * 256, 256, A, 1024, lane);
        const int row = NGRID + 16 * rg + fr, ch = ch0 + 4 * fq;
        const f32x4 cba = *(const f32x4*)(ba + dir * 1024 + ch), cbx = *(const f32x4*)(bx + dir * 1024 + ch), csp = *(const f32x4*)(spl + dir * 1024 + ch);
        const u32x2 xw = *(const u32x2*)(XC + (size_t)row * D + ch); const float xc[4] = {bflo(xw.x), bfhi(xw.x), bflo(xw.y), bfhi(xw.y)};
        float la[4], bb[4];
#pragma unroll
        for (int j = 0; j < 4; ++j) { const float l2 = -csp[j] * sigmoidf_(za[j] + cba[j]); const float a2 = fast_exp2(2.0f * l2);
            const float mult = (dir == 0 && fr == 0) ? 1.0f : __builtin_amdgcn_sqrtf(fmaxf(1.0f - a2, 0.0f)); la[j] = l2; bb[j] = mult * sigmoidf_(zx[j] + cbx[j]) * xc[j]; }
        const size_t o = (((size_t)dir * 32 + (ch >> 5)) * MPAD + row) * 32 + (ch & 31);
        u32x2 w; w.x = cvt_pk_bf16(la[0], la[1]); w.y = cvt_pk_bf16(la[2], la[3]); *(u32x2*)(LA + o) = w;
        w.x = cvt_pk_bf16(bb[0], bb[1]); w.y = cvt_pk_bf16(bb[2], bb[3]); *(u32x2*)(BB + o) = w; }
}
__device__ __forceinline__ void mini_lout(const Ctx& C) {
    PHASE_IDS
    const bf16_t* G = (const bf16_t*)(C.ws + WS_G); const bf16_t* WT = (const bf16_t*)(C.ws + WS_LOUT); bf16_t* PRE = (bf16_t*)(C.ws + WS_PRE); const float* meta = C.in[I_META];
    const int fr = lane & 15, fq = lane >> 4;
    for (int wt = C.gc * NWAVES + wave; wt < 8 * 64; wt += C.G * NWAVES) { const int rg = wt & 7, cb = wt >> 3, row = NGRID + 16 * rg + fr, c = 16 * cb + 4 * fq;
        const f32x4 a = mini_mma<1024>(WT + (size_t)(16 * cb) * 1024, 1024, G + (size_t)(NGRID + 16 * rg) * 1024, 1024, lane);
        const f32x4 r = *(const f32x4*)(meta + (size_t)fr * D + c);
        u32x2 w; w.x = cvt_pk_bf16(r[0] * DN_ALPHA + a[0], r[1] * DN_ALPHA + a[1]); w.y = cvt_pk_bf16(r[2] * DN_ALPHA + a[2], r[3] * DN_ALPHA + a[3]); *(u32x2*)(PRE + (size_t)row * D + c) = w; }
}
__device__ __forceinline__ void mini_kv(const Ctx& C) {
    PHASE_IDS
    const bf16_t* HB = (const bf16_t*)(C.ws + WS_HB); const bf16_t* WT = (const bf16_t*)(C.ws + WS_QKV); bf16_t* Kx = (bf16_t*)(C.ws + WS_K); bf16_t* VT = (bf16_t*)(C.ws + WS_VT);
    const int fr = lane & 15, fq = lane >> 4;
    for (int wt = C.gc * NWAVES + wave; wt < 2 * 8 * 64; wt += C.G * NWAVES) { const int rg = wt & 7, cb = (wt >> 3) & 63, isv = wt >> 9;
        const bf16_t* A = HB + (size_t)(NGRID + 16 * rg) * 1024;
        if (!isv) { const f32x4 a = mini_mma<1024>(WT + (size_t)(1024 + 16 * cb) * 1024, 1024, A, 1024, lane);
            u32x2 w; w.x = cvt_pk_bf16(a[0], a[1]); w.y = cvt_pk_bf16(a[2], a[3]); *(u32x2*)(Kx + (size_t)(NGRID + 16 * rg + fr) * D + 16 * cb + 4 * fq) = w; }
        else { const f32x4 a = mini_mma<1024>(A, 1024, WT + (size_t)(2048 + 16 * cb) * 1024, 1024, lane);
            u32x2 w; w.x = cvt_pk_bf16(a[0], a[1]); w.y = cvt_pk_bf16(a[2], a[3]); *(u32x2*)(VT + (size_t)(16 * cb + fr) * MPAD + NGRID + 16 * rg + 4 * fq) = w; } }
}

constexpr int RWT_PITCH = 516;
__device__ __forceinline__ void phase_lnr(const Ctx& C, int layer, int nrows) {
    PHASE_IDS
    const bf16_t* PRE = (const bf16_t*)(wsl + WS_PRE); bf16_t* HB = (bf16_t*)(wsl + WS_HB); unsigned char* HB8 = wsl + WS_HB8;
    const float* lg = C.in[I_LNMG] + layer * D; const float* lb = C.in[I_LNMB] + layer * D;
    const float* rw = C.in[I_RW] + (size_t)layer * D * NEXP; const float* rb = C.in[I_RB] + layer * NEXP;
    int* eid = (int*)(wsl + WS_CTL + CT_EID) + (size_t)layer * NTOK * 4; float* gatev = (float*)(wsl + WS_CTL + CT_GATEV) + (size_t)layer * NTOK * 4;
    unsigned* bc = (unsigned*)(wsl + WS_CTL + CT_BC) + ((size_t)layer * 256 + C.bid) * 32;
    LAS unsigned* RWt = (LAS unsigned*)C.lds; LAS unsigned* hist = (LAS unsigned*)(C.lds + 32 * RWT_PITCH * 4);
#pragma unroll
    for (int i = 0; i < 8; ++i) { const int idx = tid + NTHREADS * i, pc = idx >> 3, e4 = (idx & 7) * 4, ch = 2 * pc;
        const f32x4 w0 = *(const f32x4*)(rw + (size_t)ch * NEXP + e4), w1 = *(const f32x4*)(rw + (size_t)(ch + 1) * NEXP + e4);
        const int slot = 4 * ((ch & 511) >> 3) + 256 * (ch >> 9) + ((ch & 7) >> 1);
        RWt[(e4 + 0) * RWT_PITCH + slot] = pk2(w0[0], w1[0]); RWt[(e4 + 1) * RWT_PITCH + slot] = pk2(w0[1], w1[1]); RWt[(e4 + 2) * RWT_PITCH + slot] = pk2(w0[2], w1[2]); RWt[(e4 + 3) * RWT_PITCH + slot] = pk2(w0[3], w1[3]); }
    if (tid < 32) hist[tid] = 0u;
    __syncthreads();
    float gg[2][8], gb[2][8];
#pragma unroll
    for (int j = 0; j < 2; ++j) { const f32x4 a0 = *(const f32x4*)(lg + 8 * lane + 512 * j), a1 = *(const f32x4*)(lg + 8 * lane + 512 * j + 4), b0 = *(const f32x4*)(lb + 8 * lane + 512 * j), b1 = *(const f32x4*)(lb + 8 * lane + 512 * j + 4);
#pragma unroll
        for (int i = 0; i < 4; ++i) { gg[j][i] = a0[i]; gg[j][4 + i] = a1[i]; gb[j][i] = b0[i]; gb[j][4 + i] = b1[i]; } }
    const float rbias = rb[lane >> 1];
    const int gw = C.bid * NWAVES + wave, NGW = C.G * NWAVES;
    u32x4 nv[2];
    if (gw < nrows) {
#pragma unroll
        for (int j = 0; j < 2; ++j) nv[j] = __builtin_nontemporal_load((const u32x4*)(PRE + (size_t)gw * D + 8 * lane + 512 * j)); }
    for (int row = gw; row < nrows; row += NGW) {
        float v[2][8]; float s = 0.f; u32x4 hp[2];
#pragma unroll
        for (int j = 0; j < 2; ++j) { unpack8(nv[j], v[j]); s += ((v[j][0] + v[j][1]) + (v[j][2] + v[j][3])) + ((v[j][4] + v[j][5]) + (v[j][6] + v[j][7])); }
        if (row + NGW < nrows) {
#pragma unroll
            for (int j = 0; j < 2; ++j) nv[j] = __builtin_nontemporal_load((const u32x4*)(PRE + (size_t)(row + NGW) * D + 8 * lane + 512 * j)); }
        const float mean = wave_sum_dpp(s) * (1.0f / D); float q = 0.f;
#pragma unroll
        for (int j = 0; j < 2; ++j)
#pragma unroll
            for (int i = 0; i < 8; ++i) { v[j][i] -= mean; q += v[j][i] * v[j][i]; }
        const float rstd = __builtin_amdgcn_rsqf(wave_sum_dpp(q) * (1.0f / D) + LN_EPS);
#pragma unroll
        for (int j = 0; j < 2; ++j) {
#pragma unroll
            for (int i = 0; i < 8; ++i) v[j][i] = v[j][i] * rstd * gg[j][i] + gb[j][i];
            u32x4 w; w.x = pk2(v[j][0], v[j][1]); w.y = pk2(v[j][2], v[j][3]); w.z = pk2(v[j][4], v[j][5]); w.w = pk2(v[j][6], v[j][7]);
            *(u32x4*)(HB + (size_t)row * D + 8 * lane + 512 * j) = w; hp[j] = w;
            u32x2 w8; w8.x = pk4_fp8(v[j][0], v[j][1], v[j][2], v[j][3]); w8.y = pk4_fp8(v[j][4], v[j][5], v[j][6], v[j][7]);
            *(u32x2*)(HB8 + (size_t)row * D + 8 * lane + 512 * j) = w8; }
        float pl[32];
#pragma unroll
        for (int e0 = 0; e0 < 32; e0 += 8) {
            u32x4 wv[8][2];
#pragma unroll
            for (int ee = 0; ee < 8; ++ee)
#pragma unroll
                for (int j = 0; j < 2; ++j) wv[ee][j] = *(const LAS u32x4*)(RWt + (e0 + ee) * RWT_PITCH + 4 * lane + 256 * j);
            __builtin_amdgcn_sched_barrier(0);
#pragma unroll
            for (int ee = 0; ee < 8; ++ee) { float a = 0.f;
#pragma unroll
                for (int j = 0; j < 2; ++j) { a = dot2_bf16(hp[j].x, wv[ee][j].x, a);
                    a = dot2_bf16(hp[j].y, wv[ee][j].y, a);
                    a = dot2_bf16(hp[j].z, wv[ee][j].z, a);
                    a = dot2_bf16(hp[j].w, wv[ee][j].w, a); }
                pl[e0 + ee] = a; }
        }
        float q16[16], q8[8], q4[4], q2[2], q1;
        { const bool hi = (lane & 32) != 0;
#pragma unroll
          for (int e = 0; e < 16; ++e) { const float mine = hi ? pl[16 + e] : pl[e], other = hi ? pl[e] : pl[16 + e]; q16[e] = mine + __shfl_xor(other, 32); } }
        { const bool hi = (lane & 16) != 0;
#pragma unroll
          for (int e = 0; e < 8; ++e) { const float mine = hi ? q16[8 + e] : q16[e], other = hi ? q16[e] : q16[8 + e]; q8[e] = mine + __shfl_xor(other, 16); } }
        { const bool hi = (lane & 8) != 0;
#pragma unroll
          for (int e = 0; e < 4; ++e) { const float mine = hi ? q8[4 + e] : q8[e], other = hi ? q8[e] : q8[4 + e]; q4[e] = mine + dpp_movf<0x128>(other); } }
        { const bool hi = (lane & 4) != 0;
#pragma unroll
          for (int e = 0; e < 2; ++e) { const float mine = hi ? q4[2 + e] : q4[e], other = hi ? q4[e] : q4[2 + e]; q2[e] = mine + __shfl_xor(other, 4); } }
        { const bool hi = (lane & 2) != 0; const float mine = hi ? q2[1] : q2[0], other = hi ? q2[0] : q2[1]; q1 = mine + dpp_movf<0x4E>(other); }
        q1 += dpp_movf<0xB1>(q1);
        float lv = q1 + rbias; lv = (lv == lv) ? lv : -3.0e38f;
        const int le = lane >> 1;
        int rank = 0;
#pragma unroll
        for (int j = 0; j < 32; ++j) { const float lj = readlane_f(lv, 2 * j); rank += (lj > lv || (lj == lv && j < le)) ? 1 : 0; }
        const unsigned long long m0 = __ballot(rank == 0);
        const float mxl = readlane_f(lv, (int)__builtin_ctzll(m0));
        const float pe = rank < 4 ? __expf(lv - mxl) : 0.f;
        const float den = wave_sum_dpp(pe) * 0.5f;
        if (rank < 4 && (lane & 1) == 0) { eid[(size_t)row * 4 + rank] = le; gatev[(size_t)row * 4 + rank] = pe / den;
            __hip_atomic_fetch_add(&hist[le], 1u, __ATOMIC_RELAXED, __HIP_MEMORY_SCOPE_WORKGROUP); }
    }
    __syncthreads();
    if (tid < 32) bc[tid] = hist[tid];
}

__device__ __forceinline__ void phase_pos(const Ctx& C, int layer, int nrows) {
    PHASE_IDS
    const unsigned* bcAll = (const unsigned*)(wsl + WS_CTL + CT_BC) + (size_t)layer * 256 * 32;
    const int* eid = (const int*)(wsl + WS_CTL + CT_EID) + (size_t)layer * NTOK * 4; int* posv = (int*)(wsl + WS_CTL + CT_POS) + (size_t)layer * NTOK * 4;
    int* texp = (int*)(wsl + WS_CTL + CT_TEXP) + layer * 1024;
    int* tokoff = (int*)(wsl + WS_TOK) + (size_t)layer * (1 * MiB / 4);
    LAS unsigned* partT = (LAS unsigned*)C.lds; LAS unsigned* partP = partT + 512; LAS unsigned* tot = partP + 512; LAS unsigned* cnt = tot + 32;
    { const int e = tid & 31, part = tid >> 5; unsigned t = 0, pr = 0;
      unsigned vv[16];
#pragma unroll
      for (int i = 0; i < 16; ++i) { const int bq = part + 16 * i; vv[i] = bq < C.G ? bcAll[(size_t)bq * 32 + e] : 0u; }
#pragma unroll
      for (int i = 0; i < 16; ++i) { const int bq = part + 16 * i; t += vv[i]; if (bq < C.bid) pr += vv[i]; }
      partT[part * 32 + e] = t; partP[part * 32 + e] = pr; }
    __syncthreads();
    if (tid < 32) { unsigned t = 0, pr = 0; for (int i = 0; i < 16; ++i) { t += partT[i * 32 + tid]; pr += partP[i * 32 + tid]; } tot[tid] = t; cnt[tid] = pr; }
    __syncthreads();
    if (tid < 32) { unsigned off = 0; for (int e = 0; e < tid; ++e) off += (tot[e] + 255u) & ~255u;
        const unsigned mine = (tot[tid] + 255u) & ~255u;
        if (C.bid == 0) { for (unsigned t = off >> 8; t < ((off + mine) >> 8); ++t) texp[t] = tid; if (tid == 31) texp[1023] = (int)((off + mine) >> 8);
            for (unsigned p = off + tot[tid]; p < off + mine; ++p) tokoff[p] = 0; }
        cnt[tid] += off; }
    __syncthreads();
    const int gw = C.bid * NWAVES + wave, NGW = C.G * NWAVES;
    for (int row = gw; row < nrows; row += NGW) {
        int pos = 0;
        if (lane < 4) { const int e = eid[(size_t)row * 4 + lane]; pos = (int)__hip_atomic_fetch_add(&cnt[e], 1u, __ATOMIC_RELAXED, __HIP_MEMORY_SCOPE_WORKGROUP); posv[(size_t)row * 4 + lane] = pos; }
        if (lane < 4) tokoff[pos] = row * 1024;
    }
}

__device__ __forceinline__ void phase_combine(const Ctx& C, int layer, int nrows, bool final_out) {
    PHASE_IDS
    bf16_t* HB = (bf16_t*)(wsl + WS_HB); unsigned char* HB8 = wsl + WS_HB8; const unsigned char* YS = wsl + WS_YS;
    const float* lg = C.in[I_LNFG] + layer * D; const float* lb = C.in[I_LNFB] + layer * D;
    const float* gatev = (const float*)(wsl + WS_CTL + CT_GATEV) + (size_t)layer * NTOK * 4; const int* posv = (const int*)(wsl + WS_CTL + CT_POS) + (size_t)layer * NTOK * 4;
    float gg[2][8], gb[2][8];
#pragma unroll
    for (int j = 0; j < 2; ++j) { const f32x4 a0 = *(const f32x4*)(lg + 8 * lane + 512 * j), a1 = *(const f32x4*)(lg + 8 * lane + 512 * j + 4), b0 = *(const f32x4*)(lb + 8 * lane + 512 * j), b1 = *(const f32x4*)(lb + 8 * lane + 512 * j + 4);
#pragma unroll
        for (int i = 0; i < 4; ++i) { gg[j][i] = a0[i]; gg[j][4 + i] = a1[i]; gb[j][i] = b0[i]; gb[j][4 + i] = b1[i]; } }
    const int gw = C.bid * NWAVES + wave, NGW = C.G * NWAVES;
    f32x4 g1 = {0.f, 0.f, 0.f, 0.f}, g2 = g1; int p1[4] = {0, 0, 0, 0}, p2[4] = {0, 0, 0, 0};
    u32x4 hwn[2]; u32x2 ywn[4][2];
#define CB_ROUTE(row_, gq, pq) do { gq = *(const f32x4*)(gatev + (size_t)(row_) * 4); const u32x4 _pp = *(const u32x4*)(posv + (size_t)(row_) * 4); pq[0] = (int)_pp.x; pq[1] = (int)_pp.y; pq[2] = (int)_pp.z; pq[3] = (int)_pp.w; } while (0)
#define CB_DATA(row_, pq) do { _Pragma("unroll") for (int j = 0; j < 2; ++j) { hwn[j] = *(const u32x4*)(HB + (size_t)(row_) * D + 8 * lane + 512 * j); \
            _Pragma("unroll") for (int k = 0; k < 4; ++k) ywn[k][j] = __builtin_nontemporal_load((const u32x2*)(YS + (size_t)pq[k] * D + 8 * lane + 512 * j)); } } while (0)
    if (gw < nrows) { CB_ROUTE(gw, g1, p1); CB_DATA(gw, p1); }
    if (gw + NGW < nrows) CB_ROUTE(gw + NGW, g2, p2);
    for (int row = gw; row < nrows; row += NGW) {
        const f32x4 gk4 = g1 * 0.125f; u32x4 hw[2]; u32x2 yw[4][2];
#pragma unroll
        for (int j = 0; j < 2; ++j) { hw[j] = hwn[j];
#pragma unroll
            for (int k = 0; k < 4; ++k) yw[k][j] = ywn[k][j]; }
        g1 = g2;
#pragma unroll
        for (int k = 0; k < 4; ++k) p1[k] = p2[k];
        if (row + NGW < nrows) CB_DATA(row + NGW, p1);
        if (row + 2 * NGW < nrows) CB_ROUTE(row + 2 * NGW, g2, p2);
        float v[2][8]; float s = 0.f;
#pragma unroll
        for (int j = 0; j < 2; ++j) { float h[8]; unpack8(hw[j], h);
#pragma unroll
            for (int i = 0; i < 8; ++i) v[j][i] = h[i] * DN_ALPHA;
#pragma unroll
            for (int k = 0; k < 4; ++k) { float y[8]; unpack8_fp8(yw[k][j], y);
#pragma unroll
                for (int i = 0; i < 8; ++i) v[j][i] += gk4[k] * y[i]; }
#pragma unroll
            for (int i = 0; i < 8; ++i) s += v[j][i]; }
        const float mean = wave_sum_dpp(s) * (1.0f / D); float q = 0.f;
#pragma unroll
        for (int j = 0; j < 2; ++j)
#pragma unroll
            for (int i = 0; i < 8; ++i) { v[j][i] -= mean; q += v[j][i] * v[j][i]; }
        const float rstd = __builtin_amdgcn_rsqf(wave_sum_dpp(q) * (1.0f / D) + LN_EPS);
#pragma unroll
        for (int j = 0; j < 2; ++j) {
#pragma unroll
            for (int i = 0; i < 8; ++i) v[j][i] = v[j][i] * rstd * gg[j][i] + gb[j][i];
            if (final_out) { *(f32x4*)(C.out + (size_t)row * D + 8 * lane + 512 * j) = (f32x4){v[j][0], v[j][1], v[j][2], v[j][3]}; *(f32x4*)(C.out + (size_t)row * D + 8 * lane + 512 * j + 4) = (f32x4){v[j][4], v[j][5], v[j][6], v[j][7]}; }
            else { u32x4 w; w.x = pk2(v[j][0], v[j][1]); w.y = pk2(v[j][2], v[j][3]); w.z = pk2(v[j][4], v[j][5]); w.w = pk2(v[j][6], v[j][7]); *(u32x4*)(HB + (size_t)row * D + 8 * lane + 512 * j) = w;
                u32x2 w8; w8.x = pk4_fp8(v[j][0], v[j][1], v[j][2], v[j][3]); w8.y = pk4_fp8(v[j][4], v[j][5], v[j][6], v[j][7]); *(u32x2*)(HB8 + (size_t)row * D + 8 * lane + 512 * j) = w8; } }
    }
#undef CB_ROUTE
#undef CB_DATA
}

constexpr int AT_KS = 0, AT_VTS = 73728, AT_VPITCH = 1168, AT_KM = AT_VTS + 64 * AT_VPITCH, AT_VTM = AT_KM + 2048, AT_RPB = AT_VTM + 2048, AT_MB = AT_RPB + 1920, AT_END = AT_MB + 64;
static_assert(AT_END <= LDS_BYTES, "attention LDS map");
__device__ __forceinline__ void phase_attn(const Ctx& C) {
    PHASE_IDS
    bf16_t* O = (bf16_t*)(wsl + WS_O);
    const float* rpb = C.in[I_RPB]; const float* mbias = C.in[I_MBIAS];
    LAS unsigned char* lds = C.lds;
    const int w = wave, lq = lane & 15, g = lane >> 4;
    const int qr = w >> 2, qg = w & 3, c0 = 16 * qg, kcb = qg == 0 ? 0 : (qg == 1 ? 8 : (qg == 2 ? 24 : 32));
    int bidx[2][4];
    { const int c_ = c0 + lq, cs_ = min(max(c_ - 8, 0), 48);
#pragma unroll
      for (int blk = 0; blk < 2; ++blk)
#pragma unroll
          for (int e = 0; e < 4; ++e) { const int kc = kcb + 16 * blk + 4 * g + e; bidx[blk][e] = ((kc >= cs_ && kc < cs_ + 16) ? (kc - c_ + 15) : 31) * 4; } }
    const __amdgpu_buffer_rsrc_t rsrc = __builtin_amdgcn_make_buffer_rsrc((void*)wsl, 0, 0xFFFFFFFF, 0x00020000);
    const int kvoff = (((tid >> 3) & 63) * D + 8 * (tid & 7)) * 2, vvoff = ((tid >> 3) * MPAD + 8 * (tid & 7)) * 2;
    const int qvoff = (lq * D + 8 * g) * 2;
    const int mvoff = tid < 128 ? ((tid >> 3) * D + 8 * (tid & 7)) * 2 : (((tid - 128) >> 1) * MPAD + 8 * ((tid - 128) & 1)) * 2;
    const int klds = AT_KS + ((((tid >> 3) & 63)) * 8 + ((tid & 7) ^ ((tid >> 3) & 7))) * 16;
    const int vlds = AT_VTS + (tid >> 3) * AT_VPITCH + (tid & 7) * 16;
    for (int su = (C.G == 256 ? C.gc : C.bid); su < 256; su += C.G) {
        int bh, strip; if (C.G == 256) { bh = (su & 7) * 16 + (su >> 4); strip = (su >> 3) & 1; } else { bh = su >> 1; strip = su & 1; }
        const int b = bh >> 4, h = bh & 15, rp0 = strip * 16;
        const unsigned kbase = (unsigned)WS_K + (unsigned)((b * SEQ) * D + 64 * h) * 2u, vbase = (unsigned)WS_VT + (unsigned)((64 * h) * MPAD + b * SEQ) * 2u;
        const unsigned qbase = (unsigned)WS_Q + (unsigned)((b * SEQ + qr * 64 + c0) * D + 64 * h) * 2u;
        int R0 = min(max(2 * rp0 - 4, 0), 55);
        __syncthreads();
        {
            u32x4 kreg[9], vreg[9];
#pragma unroll
            for (int i = 0; i < 9; ++i) { kreg[i] = __builtin_amdgcn_raw_buffer_load_b128(rsrc, kvoff, (int)(kbase + (unsigned)(R0 + i) * 64u * D * 2u), 0);
                vreg[i] = __builtin_amdgcn_raw_buffer_load_b128(rsrc, vvoff, (int)(vbase + (unsigned)(R0 + i) * 128u), 0); }
            u32x4 mreg = {0u, 0u, 0u, 0u};
            if (tid < 256) mreg = __builtin_amdgcn_raw_buffer_load_b128(rsrc, mvoff, (int)(tid < 128 ? (unsigned)WS_K + (unsigned)((NGRID + 16 * b) * D + 64 * h) * 2u : (unsigned)WS_VT + (unsigned)((64 * h) * MPAD + NGRID + 16 * b) * 2u), 0);
            float rpreg = 0.f, mbreg = 0.f;
            if (tid < 480) rpreg = (tid & 31) < 31 ? rpb[h * 465 + (tid >> 5) * 31 + (tid & 31)] * 1.44269504089f : -1.0e30f;
            if (tid < 16) mbreg = mbias[h * 16 + tid] * 1.44269504089f;
#pragma unroll
            for (int i = 0; i < 9; ++i) { const int slot = (R0 + i) % 9; *(LAS u32x4*)(lds + klds + slot * 8192) = kreg[i]; *(LAS u32x4*)(lds + vlds + slot * 128) = vreg[i]; }
            if (tid < 128) { const int m = tid >> 3, ch = tid & 7; *(LAS u32x4*)(lds + AT_KM + (m * 8 + (ch ^ (m & 7))) * 16) = mreg; }
            else if (tid < 256) { const int i = tid - 128, d = i >> 1, hf = i & 1; *(LAS u32x4*)(lds + AT_VTM + d * 32 + hf * 16) = mreg; }
            if (tid < 480) ((LAS float*)(lds + AT_RPB))[tid] = rpreg;
            if (tid < 16) ((LAS float*)(lds + AT_MB))[tid] = mbreg;
        }
        u32x4 qreg[2];
        qreg[0] = __builtin_amdgcn_raw_buffer_load_b128(rsrc, qvoff, (int)(qbase + (unsigned)(2 * rp0) * 64u * D * 2u), 0);
        qreg[1] = __builtin_amdgcn_raw_buffer_load_b128(rsrc, qvoff, (int)(qbase + (unsigned)(2 * rp0) * 64u * D * 2u + 64u), 0);
        __syncthreads();
        for (int rp = rp0; rp < rp0 + 16; ++rp) {
            const int R0n = rp + 1 < rp0 + 16 ? min(max(2 * (rp + 1) - 4, 0), 55) : R0, nnew = R0n - R0;
            const u32x4 qcur[2] = {qreg[0], qreg[1]};
            u32x4 nk[2], nv[2];
#pragma unroll
            for (int i = 0; i < 2; ++i) if (i < nnew) { nk[i] = __builtin_amdgcn_raw_buffer_load_b128(rsrc, kvoff, (int)(kbase + (unsigned)(R0 + 9 + i) * 64u * D * 2u), 0);
                nv[i] = __builtin_amdgcn_raw_buffer_load_b128(rsrc, vvoff, (int)(vbase + (unsigned)(R0 + 9 + i) * 128u), 0); }
            if (rp + 1 < rp0 + 16) { qreg[0] = __builtin_amdgcn_raw_buffer_load_b128(rsrc, qvoff, (int)(qbase + (unsigned)(2 * rp + 2) * 64u * D * 2u), 0);
                qreg[1] = __builtin_amdgcn_raw_buffer_load_b128(rsrc, qvoff, (int)(qbase + (unsigned)(2 * rp + 2) * 64u * D * 2u + 64u), 0); }
            const int r = 2 * rp + qr;
            const int rs = min(max(r - 4, 0), 56), s0 = rs % 9;
            const size_t qrow = (size_t)(b * SEQ + r * 64 + c0 + lq);
            bf16x8 qf[2]; qf[0] = __builtin_bit_cast(bf16x8, qcur[0]); qf[1] = __builtin_bit_cast(bf16x8, qcur[1]);
            f32x4 sc[8][2], sm;
#pragma unroll
            for (int j = 0; j < 8; ++j) { const int slot = s0 + j - (s0 + j >= 9 ? 9 : 0);
#pragma unroll
                for (int blk = 0; blk < 2; ++blk) { f32x4 a = {0.f, 0.f, 0.f, 0.f}; const int kc = kcb + 16 * blk + lq;
#pragma unroll
                    for (int ks = 0; ks < 2; ++ks) { const bf16x8 kf = *(const LAS bf16x8*)(lds + AT_KS + slot * 8192 + (kc * 8 + ((4 * ks + g) ^ (kc & 7))) * 16);
                        a = __builtin_amdgcn_mfma_f32_16x16x32_bf16(kf, qf[ks], a, 0, 0, 0); }
                    sc[j][blk] = a; } }
            { f32x4 a = {0.f, 0.f, 0.f, 0.f};
#pragma unroll
              for (int ks = 0; ks < 2; ++ks) { const bf16x8 kf = *(const LAS bf16x8*)(lds + AT_KM + (lq * 8 + ((4 * ks + g) ^ (lq & 7))) * 16);
                  a = __builtin_amdgcn_mfma_f32_16x16x32_bf16(kf, qf[ks], a, 0, 0, 0); }
              sm = a; }
            const LAS unsigned char* RProw = lds + AT_RPB + (rs - r + 7) * 128; const LAS float* MB = (const LAS float*)(lds + AT_MB);
            float mx = -3.0e38f;
#pragma unroll
            for (int j = 0; j < 8; ++j)
#pragma unroll
                for (int blk = 0; blk < 2; ++blk)
#pragma unroll
                    for (int e = 0; e < 4; ++e) { const float sv = sc[j][blk][e] + *(const LAS float*)(RProw + j * 128 + bidx[blk][e]); sc[j][blk][e] = sv; mx = fmaxf(mx, sv); }
#pragma unroll
            for (int e = 0; e < 4; ++e) { sm[e] += MB[4 * g + e]; mx = fmaxf(mx, sm[e]); }
            mx = fmaxf(mx, __shfl_xor(mx, 16)); mx = fmaxf(mx, __shfl_xor(mx, 32));
            float sum = 0.f;
#pragma unroll
            for (int j = 0; j < 8; ++j)
#pragma unroll
                for (int blk = 0; blk < 2; ++blk)
#pragma unroll
                    for (int e = 0; e < 4; ++e) { const float pv = fast_exp2(sc[j][blk][e] - mx); sc[j][blk][e] = pv; sum += pv; }
#pragma unroll
            for (int e = 0; e < 4; ++e) { const float pv = fast_exp2(sm[e] - mx); sm[e] = pv; sum += pv; }
            sum += __shfl_xor(sum, 16); sum += __shfl_xor(sum, 32);
            f32x4 o[4];
#pragma unroll
            for (int db = 0; db < 4; ++db) o[db] = (f32x4){0.f, 0.f, 0.f, 0.f};
#pragma unroll
            for (int j = 0; j < 8; ++j) { const int slot = s0 + j - (s0 + j >= 9 ? 9 : 0);
                u32x4 pw; pw.x = cvt_pk_bf16(sc[j][0][0], sc[j][0][1]); pw.y = cvt_pk_bf16(sc[j][0][2], sc[j][0][3]); pw.z = cvt_pk_bf16(sc[j][1][0], sc[j][1][1]); pw.w = cvt_pk_bf16(sc[j][1][2], sc[j][1][3]);
                const bf16x8 pb = __builtin_bit_cast(bf16x8, pw);
#pragma unroll
                for (int db = 0; db < 4; ++db) { const int d = 16 * db + lq; const LAS unsigned char* vp = lds + AT_VTS + d * AT_VPITCH + (slot * 64 + kcb + 4 * g) * 2;
                    const u32x2 lo = *(const LAS u32x2*)vp, hi = *(const LAS u32x2*)(vp + 32);
                    u32x4 aw; aw.x = lo.x; aw.y = lo.y; aw.z = hi.x; aw.w = hi.y;
                    o[db] = __builtin_amdgcn_mfma_f32_16x16x32_bf16(__builtin_bit_cast(bf16x8, aw), pb, o[db], 0, 0, 0); }
            }
            { u32x4 pw; pw.x = cvt_pk_bf16(sm[0], sm[1]); pw.y = cvt_pk_bf16(sm[2], sm[3]); pw.z = 0u; pw.w = 0u; const bf16x8 pb = __builtin_bit_cast(bf16x8, pw);
#pragma unroll
              for (int db = 0; db < 4; ++db) { const int d = 16 * db + lq; const u32x2 lo = *(const LAS u32x2*)(lds + AT_VTM + d * 32 + 8 * g);
                  u32x4 aw; aw.x = lo.x; aw.y = lo.y; aw.z = 0u; aw.w = 0u;
                  o[db] = __builtin_amdgcn_mfma_f32_16x16x32_bf16(__builtin_bit_cast(bf16x8, aw), pb, o[db], 0, 0, 0); } }
            const float inv = 1.0f / sum;
#pragma unroll
            for (int db = 0; db < 4; ++db) { u32x2 ow; ow.x = cvt_pk_bf16(o[db][0] * inv, o[db][1] * inv); ow.y = cvt_pk_bf16(o[db][2] * inv, o[db][3] * inv);
                *(u32x2*)(O + qrow * D + 64 * h + 16 * db + 4 * g) = ow; }
            __syncthreads();
#pragma unroll
            for (int i = 0; i < 2; ++i) if (i < nnew) { const int slot = (R0 + 9 + i) % 9; *(LAS u32x4*)(lds + klds + slot * 8192) = nk[i]; *(LAS u32x4*)(lds + vlds + slot * 128) = nv[i]; }
            R0 = R0n;
            __syncthreads();
        }
    }
}
#define XB_TMO      128
#define XB_XCNT(j)  (256  + 64 * (j))
#define XB_XSUB(j)  (1280 + 64 * (j))
#define XB_XGEN(j)  (2304 + 64 * (j))
#define XB_TOP      3328
#define XB_TOPGEN   3392
#define XCD_BAR_WORDS 3456
#define XB_SPIN_CAP (1u << 22)
__device__ __forceinline__ unsigned xb_ld(unsigned* p)              { return __hip_atomic_load(p, __ATOMIC_RELAXED, __HIP_MEMORY_SCOPE_AGENT); }
__device__ __forceinline__ unsigned xb_add(unsigned* p, unsigned v) { return __hip_atomic_fetch_add(p, v, __ATOMIC_RELAXED, __HIP_MEMORY_SCOPE_AGENT); }
__device__ __forceinline__ unsigned xb_xcc_id() { return (unsigned)__builtin_amdgcn_s_getreg((3 << 11) | 20) & 0xFu; }
#define XB_SPIN(cond, bar) do { unsigned _sp = 0; while (cond) { __builtin_amdgcn_s_sleep(1); \
    if ((++_sp & 255u) == 0u) { if (xb_ld(&(bar)[XB_TMO])) break; if (_sp > XB_SPIN_CAP) { atomicAdd(&(bar)[XB_TMO], 1u); break; } } } } while (0)
struct XcdBarrier { unsigned* bar; unsigned x; volatile LAS unsigned* st; };
__device__ __forceinline__ XcdBarrier xcd_barrier_post(unsigned* bar, volatile LAS unsigned* st) {
    XcdBarrier b; b.bar = bar; b.x = xb_xcc_id(); b.st = st;
    if (threadIdx.x == 0) st[2] = xb_add(&bar[XB_XCNT(b.x)], 1u);
    return b;
}
__device__ __forceinline__ void xcd_barrier_complete(unsigned* bar, unsigned x, unsigned& nloc, unsigned& nx) {
    const unsigned G = gridDim.x * gridDim.y * gridDim.z;
    unsigned sum, cnt, mine, sp = 0u;
    for (;;) {
        sum = 0u; cnt = 0u; mine = 0u;
#pragma unroll
        for (unsigned j = 0; j < 16; ++j) { const unsigned c = xb_ld(&bar[XB_XCNT(j)]); sum += c; cnt += (c > 0u) ? 1u : 0u; mine = (j == x) ? c : mine; }
        if (sum == G) break;
        __builtin_amdgcn_s_sleep(1);
        if ((++sp & 255u) == 0u) { if (xb_ld(&bar[XB_TMO])) break; if (sp > XB_SPIN_CAP) { atomicAdd(&bar[XB_TMO], 1u); break; } }
    }
    nloc = mine > 0u ? mine : 1u; nx = cnt > 0u ? cnt : 1u;
}
__device__ __forceinline__ void xcd_barrier(const XcdBarrier& b) {
    asm volatile("s_waitcnt vmcnt(0)" ::: "memory");
    __syncthreads();
    if (threadIdx.x == 0) {
        unsigned* bar = b.bar;
        __builtin_amdgcn_s_waitcnt(0);
        unsigned nloc = b.st[0], nx = b.st[1];
        if (nloc == 0u) { xcd_barrier_complete(bar, b.x, nloc, nx); b.st[0] = nloc; b.st[1] = nx; }
        const unsigned old = xb_add(&bar[XB_XSUB(b.x)], 1u);
        const unsigned gen = old / nloc;
        if (old + 1u == (gen + 1u) * nloc) {
            __builtin_amdgcn_fence(__ATOMIC_RELEASE, "agent");
            asm volatile("s_waitcnt vmcnt(0)" ::: "memory");
            const unsigned og = xb_add(&bar[XB_TOP], 1u);
            const unsigned tg = og / nx;
            if (og + 1u == (tg + 1u) * nx) xb_add(&bar[XB_TOPGEN], 1u);
            else XB_SPIN(xb_ld(&bar[XB_TOPGEN]) == tg, bar);
            __builtin_amdgcn_fence(__ATOMIC_ACQUIRE, "agent");
            xb_add(&bar[XB_XGEN(b.x)], 1u);
            asm volatile("s_waitcnt vmcnt(0)" ::: "memory");
        } else {
            XB_SPIN(xb_ld(&bar[XB_XGEN(b.x)]) == gen, bar);
            __builtin_amdgcn_fence(__ATOMIC_ACQUIRE, "agent");
            asm volatile("s_waitcnt vmcnt(0)" ::: "memory");
        }
    }
    __syncthreads();
}
__device__ __forceinline__ int moe_prep(const Ctx& C, const int* texp) {
    LAS int* t = (LAS int*)(C.lds + pg8::TEXP_OFF); const int tid = fresh_tid();
    const int a = texp[tid], b = texp[tid + 512];
    t[tid] = a; t[tid + 512] = b;
    __syncthreads();
    return __builtin_amdgcn_readfirstlane(t[1023]);
}
constexpr size_t CT_BAR = 131072;
constexpr int LDS_BARST = LDS_BYTES - 64;

constexpr int N_PHASES = 20;
__global__ void __launch_bounds__(NTHREADS, 2) hybrid_fwd(Params P) {
    extern __shared__ __attribute__((aligned(16))) unsigned char smem[];
    cg::grid_group grid = cg::this_grid();
    Ctx C; C.lds = (LAS unsigned char*)smem; C.G = gridDim.x; C.bid = blockIdx.x;
    C.ws = P.ws; C.in = P.in; C.out = P.out;
    unsigned char* const ws0 = P.ws;
#define ws fresh_ws(ws0)
    const int lo = P.ph_lo, hi = P.ph_hi;
#ifndef PH_MASK
#define PH_MASK 0xFFFFFFFFu
#endif
#define IN(k) (((PH_MASK >> (k)) & 1u) && lo <= (k) && (k) < hi)
#ifndef REPEAT_MASK
#define REPEAT_MASK 0u
#endif
#define REPS(k) ((((unsigned)REPEAT_MASK >> (k)) & 1u) ? 2 : 1)
#ifndef N_CG_SYNCS
#define N_CG_SYNCS 0
#endif
#define SEAM(k) do { if (IN(k) && IN((k) + 1)) { if ((k) < N_CG_SYNCS) grid.sync(); else xcd_barrier(bar); } } while (0)
    if (threadIdx.x < 16) ((LAS unsigned*)(smem + LDS_BARST))[threadIdx.x] = 0u;
    __syncthreads();
    const XcdBarrier bar = xcd_barrier_post((unsigned*)(ws + WS_CTL + CT_BAR), (volatile LAS unsigned*)(smem + LDS_BARST));
    C.gc = C.bid;
    #define PH_BODY_0 phase_convert(C);
    if (IN(0)) { PH_BODY_0 } if (REPS(0) > 1 && IN(0)) { xcd_barrier(bar); PH_BODY_0 }
    SEAM(0);
    if (IN(0) && IN(1)) {
        unsigned* barw = (unsigned*)(ws + WS_CTL + CT_BAR); bool eq = (C.G % 8) == 0;
#pragma unroll
        for (int j = 0; j < 16; ++j) { const unsigned cj = xb_ld(&barw[XB_XCNT(j)]); eq = eq && (cj == (j < 8 ? (unsigned)(C.G / 8) : 0u)); }
        const unsigned rank = ((volatile LAS unsigned*)(smem + LDS_BARST))[2];
        C.gc = __builtin_amdgcn_readfirstlane(eq ? (int)(rank * 8u + bar.x) : C.bid);
    }
    #define PH_BODY_1 { DenseSched S{(unsigned)WS_HB, (unsigned)WS_WIN, 1024, 1024, 128, 8, C.G, C.gc}; EpiWin E{(bf16_t*)(ws + WS_XR), (bf16_t*)(ws + WS_GY)}; \
        pg8::gemm_phase<false, false>(C.lds, ws, 1024, 1024, 1024, S, E); mini_win(C); }
    if (IN(1)) { PH_BODY_1 } if (REPS(1) > 1 && IN(1)) { xcd_barrier(bar); PH_BODY_1 }
    SEAM(1);
    #define PH_BODY_2 phase_conv(C);
    if (IN(2)) { PH_BODY_2 } if (REPS(2) > 1 && IN(2)) { xcd_barrier(bar); PH_BODY_2 }
    SEAM(2);
    #define PH_BODY_3 { GateSched S{(unsigned)WS_XC, (unsigned)WS_GATE, 128, C.G, C.gc}; \
        EpiGate E{(const bf16_t*)(ws + WS_XC), (bf16_t*)(ws + WS_LA), (bf16_t*)(ws + WS_BB), (const float*)(ws + WS_CTL + CT_SPL), (unsigned)WS_GBIAS}; \
        pg8::gemm_phase<false, false>(C.lds, ws, 256, 1024, 256, S, E); mini_gate(C); }
    if (IN(3)) { PH_BODY_3 } if (REPS(3) > 1 && IN(3)) { xcd_barrier(bar); PH_BODY_3 }
    SEAM(3);
    #define PH_BODY_4 phase_scan(C);
    if (IN(4)) { PH_BODY_4 } if (REPS(4) > 1 && IN(4)) { xcd_barrier(bar); PH_BODY_4 }
    SEAM(4);
    #define PH_BODY_5 { DenseSched S{(unsigned)WS_G, (unsigned)WS_LOUT, 1024, 1024, 128, 4, C.G, C.gc}; EpiRes<true> E{(bf16_t*)(ws + WS_PRE), P.in[I_X], P.in[I_META], nullptr, NTOK}; \
        pg8::gemm_phase<false, false>(C.lds, ws, 1024, 1024, 1024, S, E); mini_lout(C); }
    if (IN(5)) { PH_BODY_5 } if (REPS(5) > 1 && IN(5)) { xcd_barrier(bar); PH_BODY_5 }
    SEAM(5);
    #define PH_BODY_6 phase_lnr(C, 0, NTOK);
    if (IN(6)) { PH_BODY_6 } if (REPS(6) > 1 && IN(6)) { xcd_barrier(bar); PH_BODY_6 }
    SEAM(6);
    #define PH_BODY_7 phase_pos(C, 0, NTOK);
    if (IN(7)) { PH_BODY_7 } if (REPS(7) > 1 && IN(7)) { xcd_barrier(bar); PH_BODY_7 }
    SEAM(7);
    #define PH_BODY_8 { const int nM = moe_prep(C, (const int*)(ws + WS_CTL + CT_TEXP)); \
        MoeSched S{(unsigned)WS_HB8, (unsigned)WS_WGU, (unsigned)WS_TOK, (const LAS int*)(C.lds + pg8::TEXP_OFF), 2048u * 1024u, nM, 8, C.G, C.gc}; EpiGlu E{(unsigned char*)(ws + WS_ACT), (unsigned)WS_BIAS}; \
        pg8::gemm_phase<true, true>(C.lds, ws, 512, 512, 512, S, E); }
    if (IN(8)) { PH_BODY_8 } if (REPS(8) > 1 && IN(8)) { xcd_barrier(bar); PH_BODY_8 }
#ifdef PROBE_NULL8
    if (IN(8)) { xcd_barrier(bar); { const int nM = moe_prep(C, (const int*)(ws + WS_CTL + CT_TEXP));
        MoeSched S{(unsigned)WS_HB8, (unsigned)WS_WGU, (unsigned)WS_TOK, (const LAS int*)(C.lds + pg8::TEXP_OFF), 2048u * 1024u, nM, 8, C.G, C.gc}; EpiNull E{};
        pg8::gemm_phase<true, true>(C.lds, ws, 512, 512, 512, S, E); } }
#endif
    SEAM(8);
    #define PH_BODY_9 { const int nM = moe_prep(C, (const int*)(ws + WS_CTL + CT_TEXP)); \
        MoeSched S{(unsigned)WS_ACT, (unsigned)WS_WD, 0u, (const LAS int*)(C.lds + pg8::TEXP_OFF), 1024u * 1024u, nM, 4, C.G, C.gc}; EpiDown E{(unsigned char*)(ws + WS_YS), (unsigned)WS_BD}; \
        pg8::gemm_phase<true, false>(C.lds, ws, 512, 512, 512, S, E); }
    if (IN(9)) { PH_BODY_9 } if (REPS(9) > 1 && IN(9)) { xcd_barrier(bar); PH_BODY_9 }
    SEAM(9);
    #define PH_BODY_10 phase_combine(C, 0, NTOK, false);
    if (IN(10)) { PH_BODY_10 } if (REPS(10) > 1 && IN(10)) { xcd_barrier(bar); PH_BODY_10 }
    SEAM(10);
    #define PH_BODY_11 { QkvSched S{(unsigned)WS_HB8, (unsigned)WS_QKV8, 128, C.G, C.gc}; EpiQkv E{(bf16_t*)(ws + WS_Q), (bf16_t*)(ws + WS_K), (bf16_t*)(ws + WS_VT)}; \
        pg8::gemm_phase<true, false>(C.lds, ws, 512, 512, 512, S, E); mini_kv(C); }
    if (IN(11)) { PH_BODY_11 } if (REPS(11) > 1 && IN(11)) { xcd_barrier(bar); PH_BODY_11 }
    SEAM(11);
    #define PH_BODY_12 phase_attn(C);
    if (IN(12)) { PH_BODY_12 } if (REPS(12) > 1 && IN(12)) { xcd_barrier(bar); PH_BODY_12 }
    SEAM(12);
    #define PH_BODY_13 { DenseSched S{(unsigned)WS_O, (unsigned)WS_NOUT, 1024, 1024, 128, 4, C.G, C.gc}; EpiRes<false> E{(bf16_t*)(ws + WS_PRE), nullptr, nullptr, (const bf16_t*)(ws + WS_HB), NGRID}; \
        pg8::gemm_phase<false, false>(C.lds, ws, 1024, 1024, 1024, S, E); }
    if (IN(13)) { PH_BODY_13 } if (REPS(13) > 1 && IN(13)) { xcd_barrier(bar); PH_BODY_13 }
    SEAM(13);
    #define PH_BODY_14 phase_lnr(C, 1, NGRID);
    if (IN(14)) { PH_BODY_14 } if (REPS(14) > 1 && IN(14)) { xcd_barrier(bar); PH_BODY_14 }
    SEAM(14);
    #define PH_BODY_15 phase_pos(C, 1, NGRID);
    if (IN(15)) { PH_BODY_15 } if (REPS(15) > 1 && IN(15)) { xcd_barrier(bar); PH_BODY_15 }
    SEAM(15);
    #define PH_BODY_16 { const int nM = moe_prep(C, (const int*)(ws + WS_CTL + CT_TEXP) + 1024); \
        MoeSched S{(unsigned)WS_HB8, (unsigned)(WS_WGU + (size_t)32 * 2048 * 1024), (unsigned)(WS_TOK + 1 * MiB), (const LAS int*)(C.lds + pg8::TEXP_OFF), 2048u * 1024u, nM, 8, C.G, C.gc}; EpiGlu E{(unsigned char*)(ws + WS_ACT), (unsigned)(WS_BIAS + 32 * 2048 * 4)}; \
        pg8::gemm_phase<true, true>(C.lds, ws, 512, 512, 512, S, E); }
    if (IN(16)) { PH_BODY_16 } if (REPS(16) > 1 && IN(16)) { xcd_barrier(bar); PH_BODY_16 }
    SEAM(16);
    #define PH_BODY_17 { const int nM = moe_prep(C, (const int*)(ws + WS_CTL + CT_TEXP) + 1024); \
        MoeSched S{(unsigned)WS_ACT, (unsigned)(WS_WD + (size_t)32 * 1024 * 1024), 0u, (const LAS int*)(C.lds + pg8::TEXP_OFF), 1024u * 1024u, nM, 4, C.G, C.gc}; EpiDown E{(unsigned char*)(ws + WS_YS), (unsigned)(WS_BD + 32 * 1024 * 4)}; \
        pg8::gemm_phase<true, false>(C.lds, ws, 512, 512, 512, S, E); }
    if (IN(17)) { PH_BODY_17 } if (REPS(17) > 1 && IN(17)) { xcd_barrier(bar); PH_BODY_17 }
    SEAM(17);
    #define PH_BODY_18 phase_combine(C, 1, NGRID, true);
    if (IN(18)) { PH_BODY_18 } if (REPS(18) > 1 && IN(18)) { xcd_barrier(bar); PH_BODY_18 }
#undef ws
#undef IN
#undef SEAM
}

#ifndef MK_PER_PHASE
#define MK_PER_PHASE 0
#endif
extern "C" void kernel_launch(void* const* d_in, const int* in_sizes, int n_in, void* d_out, int out_size, void* d_ws, size_t ws_size, hipStream_t stream) {
    static int grid = 0;
    if (grid == 0) {
        if (n_in != 25 || ws_size < WS_END || out_size != NGRID * D) { fprintf(stderr, "kernel_launch: unexpected problem (n_in %d, ws %zu, out %d)\n", n_in, ws_size, out_size); grid = -1; return; }
        int dev = 0, cus = 0, per_cu = 0;
        if (hipGetDevice(&dev) != hipSuccess || hipDeviceGetAttribute(&cus, hipDeviceAttributeMultiprocessorCount, dev) != hipSuccess) { grid = -1; return; }
        if (hipFuncSetAttribute((const void*)hybrid_fwd, hipFuncAttributeMaxDynamicSharedMemorySize, LDS_BYTES) != hipSuccess) { fprintf(stderr, "kernel_launch: hipFuncSetAttribute failed\n"); grid = -1; return; }
        if (hipOccupancyMaxActiveBlocksPerMultiprocessor(&per_cu, (const void*)hybrid_fwd, NTHREADS, LDS_BYTES) != hipSuccess || per_cu < 1) { fprintf(stderr, "kernel_launch: occupancy query failed (%d)\n", per_cu); grid = -1; return; }
        grid = cus * 1;
        if (grid > 256) grid = 256;
    }
    if (grid < 0) return;
    if (hipMemsetAsync((char*)d_ws + WS_CTL + CT_BAR, 0, 16384, stream) != hipSuccess) { fprintf(stderr, "kernel_launch: memset failed\n"); return; }
    Params p{};
    for (int i = 0; i < 25; ++i) p.in[i] = (const float*)d_in[i];
    p.out = (float*)d_out; p.ws = (unsigned char*)d_ws;
#if MK_PER_PHASE
    for (int ph = 0; ph < 19; ++ph) { p.ph_lo = ph; p.ph_hi = ph + 1; void* args[] = {&p};
        hipError_t e = hipLaunchCooperativeKernel((void*)hybrid_fwd, dim3(grid), dim3(NTHREADS), args, LDS_BYTES, stream);
        if (e != hipSuccess) { fprintf(stderr, "launch phase %d failed: %s\n", ph, hipGetErrorString(e)); break; } }
#else
    p.ph_lo = 0; p.ph_hi = 19; void* args[] = {&p};
    hipError_t e = hipLaunchCooperativeKernel((void*)hybrid_fwd, dim3(grid), dim3(NTHREADS), args, LDS_BYTES, stream);
    if (e != hipSuccess) fprintf(stderr, "cooperative launch failed: %s (grid %d)\n", hipGetErrorString(e), grid);
#endif
}
```

```cpp
#include <hip/hip_runtime.h>
#include <hip/hip_cooperative_groups.h>
#include <cstdio>
#include <cstdint>
namespace cg = cooperative_groups;

#define LAS __attribute__((address_space(3)))
typedef unsigned short bf16_t;
typedef short bf16x8 __attribute__((ext_vector_type(8)));
typedef float f32x4 __attribute__((ext_vector_type(4)));
typedef float f32x2 __attribute__((ext_vector_type(2)));
typedef unsigned u32x4 __attribute__((ext_vector_type(4)));
typedef unsigned u32x2 __attribute__((ext_vector_type(2)));

constexpr int NB = 8, SEQ = 4096, D = 1024, NMETA = 16, LSEQ = SEQ + NMETA;
constexpr int NGRID = NB * SEQ;
constexpr int NTOK = NGRID + NB * NMETA;
constexpr int MPAD = 33024;
constexpr int NEXP = 32, TOPK = 4;
constexpr int PMAX = 139776;
constexpr int MTMAX = PMAX / 256;
constexpr float DN_ALPHA = 1.41421356237f;
constexpr float LN_EPS = 1e-5f;
constexpr int NTHREADS = 512, NWAVES = 8;

constexpr size_t MiB = 1u << 20;
constexpr size_t ACT_BYTES = (size_t)MPAD * D * 2;
constexpr size_t WS_CTL   = 0;
constexpr size_t WS_WIN   = 4 * MiB;
constexpr size_t WS_GATE  = WS_WIN + 4 * MiB;
constexpr size_t WS_LOUT  = WS_GATE + 2 * MiB;
constexpr size_t WS_QKV   = WS_LOUT + 2 * MiB;
constexpr size_t WS_NOUT  = WS_QKV + 6 * MiB;
constexpr size_t WS_WGU   = WS_NOUT + 2 * MiB;
constexpr size_t WS_WD    = WS_WGU + 128 * MiB;
constexpr size_t WS_HB    = WS_WD + 64 * MiB;
constexpr size_t WS_HB8   = WS_HB + 65 * MiB;
constexpr size_t WS_PRE   = WS_HB8 + 33 * MiB;
constexpr size_t WS_H     = WS_PRE + 129 * MiB;
constexpr size_t WS_SCR   = WS_H + 129 * MiB;
constexpr size_t WS_XR = WS_SCR, WS_XC = WS_XR + 65 * MiB, WS_GY = WS_XC + 65 * MiB, WS_LA = WS_GY + 65 * MiB, WS_BB = WS_LA + 130 * MiB, WS_HF = WS_BB + 130 * MiB, WS_G = WS_HF + 65 * MiB;
constexpr size_t WS_SCR_END0 = WS_G + 65 * MiB;
constexpr size_t WS_XS = WS_SCR, WS_ACT = WS_XS + 137 * MiB, WS_YS = WS_ACT + 137 * MiB;
constexpr size_t WS_SCR_END1 = WS_YS + 274 * MiB;
constexpr size_t WS_Q = WS_SCR, WS_K = WS_Q + 65 * MiB, WS_VT = WS_K + 65 * MiB, WS_O = WS_VT + 65 * MiB;
constexpr size_t WS_BIAS = (WS_SCR_END0 > WS_SCR_END1 ? WS_SCR_END0 : WS_SCR_END1);
constexpr size_t WS_BD = WS_BIAS + 2 * 32 * 2048 * 4;
constexpr size_t WS_GBIAS = WS_BD + 2 * 32 * 1024 * 4;
constexpr size_t WS_TOK = WS_BIAS + 1 * MiB;
constexpr size_t WS_QKV8 = WS_TOK + 2 * MiB;
constexpr size_t WS_END = WS_QKV8 + 3 * MiB;
static_assert((size_t)PMAX * 4 <= 1 * MiB, "token offset table");
static_assert(ACT_BYTES <= 65 * MiB && (size_t)PMAX * D * 2 <= 274 * MiB && (size_t)PMAX * D <= 137 * MiB && (size_t)MPAD * D <= 33 * MiB && (size_t)MPAD * D * 4 <= 129 * MiB, "ws map");
static_assert(WS_END <= (size_t)2040 * MiB, "ws map must fit 4x the largest input tensor");
constexpr size_t CT_BC      = 4096;
constexpr size_t CT_TEXP    = CT_BC + 2 * 256 * 32 * 4;
constexpr size_t CT_SPL     = CT_TEXP + 2 * 1024 * 4;
constexpr size_t CT_EID     = 256 * 1024;
constexpr size_t CT_GATEV   = CT_EID + 2 * (size_t)NTOK * 4 * 4;
constexpr size_t CT_POS     = CT_GATEV + 2 * (size_t)NTOK * 4 * 4;
static_assert(CT_POS + 2 * (size_t)NTOK * 4 * 4 <= 4 * MiB, "ctl map");

constexpr int LDS_BYTES = 155648;

__device__ __forceinline__ unsigned f2bf(float f) { unsigned u = __builtin_bit_cast(unsigned, f); return (u + 0x7fffu + ((u >> 16) & 1u)) >> 16; }
__device__ __forceinline__ unsigned cvt_pk_bf16(float lo, float hi);
__device__ __forceinline__ unsigned pk2(float lo, float hi) { return cvt_pk_bf16(lo, hi); }
typedef __bf16 bf16x2_t __attribute__((ext_vector_type(2)));
__device__ __forceinline__ unsigned cvt_pk_bf16(float lo, float hi) { const f32x2 v = {lo, hi}; return __builtin_bit_cast(unsigned, __builtin_convertvector(v, bf16x2_t)); }
__device__ __forceinline__ unsigned pk4_fp8(float a, float b, float c, float d) { int w = __builtin_amdgcn_cvt_pk_fp8_f32(a, b, 0, false); w = __builtin_amdgcn_cvt_pk_fp8_f32(c, d, w, true); return (unsigned)w; }
__device__ __forceinline__ float dot2_bf16(unsigned a, unsigned b, float c) { return __builtin_amdgcn_fdot2_f32_bf16(__builtin_bit_cast(bf16x2_t, a), __builtin_bit_cast(bf16x2_t, b), c, false); }
__device__ __forceinline__ void unpack8_fp8(const u32x2 w, float (&o)[8]) { const f32x2 a = __builtin_amdgcn_cvt_pk_f32_fp8((int)w.x, false), b = __builtin_amdgcn_cvt_pk_f32_fp8((int)w.x, true), c = __builtin_amdgcn_cvt_pk_f32_fp8((int)w.y, false), d = __builtin_amdgcn_cvt_pk_f32_fp8((int)w.y, true);
    o[0] = a.x; o[1] = a.y; o[2] = b.x; o[3] = b.y; o[4] = c.x; o[5] = c.y; o[6] = d.x; o[7] = d.y; }
__device__ __forceinline__ float bflo(unsigned w) { return __builtin_bit_cast(float, w << 16); }
__device__ __forceinline__ float bfhi(unsigned w) { return __builtin_bit_cast(float, w & 0xffff0000u); }
__device__ __forceinline__ void unpack8(const u32x4 w, float (&o)[8]);
__device__ __forceinline__ float fast_exp2(float x) { return __builtin_amdgcn_exp2f(x); }
__device__ __forceinline__ float fast_rcp(float x) { return __builtin_amdgcn_rcpf(x); }
__device__ __forceinline__ float sigmoidf_(float x) { return fast_rcp(1.0f + fast_exp2(-1.44269504089f * x)); }
__device__ __forceinline__ float wave_sum(float v) {
#pragma unroll
    for (int o = 1; o < 64; o <<= 1) v += __shfl_xor(v, o);
    return v;
}
template <int CTRL> __device__ __forceinline__ float dpp_movf(float v) { return __builtin_bit_cast(float, __builtin_amdgcn_update_dpp(0, __builtin_bit_cast(int, v), CTRL, 0xf, 0xf, true)); }
__device__ __forceinline__ float readlane_f(float v, int l) { return __builtin_bit_cast(float, __builtin_amdgcn_readlane(__builtin_bit_cast(int, v), l)); }
__device__ __forceinline__ float wave_sum_dpp(float v) {
    v += dpp_movf<0xB1>(v);
    v += dpp_movf<0x4E>(v);
    v += dpp_movf<0x141>(v);
    v += dpp_movf<0x140>(v);
    return (readlane_f(v, 0) + readlane_f(v, 16)) + (readlane_f(v, 32) + readlane_f(v, 48));
}
__device__ __forceinline__ int seqrow(int b, int s) { return s < NMETA ? NGRID + NMETA * b + s : SEQ * b + (s - NMETA); }

struct Params {
    const float* in[25];
    float* out;
    unsigned char* ws;
    int ph_lo, ph_hi;
};
struct Ctx {
    LAS unsigned char* lds;
    int G, bid, gc;
    unsigned char* ws;
    const float* const* in;
    float* out;
};
__device__ __forceinline__ int fresh_tid() { int t = threadIdx.x; asm volatile("" : "+v"(t)); return t; }
__device__ __forceinline__ unsigned char* fresh_ws(unsigned char* p) { asm volatile("" : "+s"(p)); return p; }
#define PHASE_IDS unsigned char* const wsl = fresh_ws(C.ws); (void)wsl; const int tid = fresh_tid(); const int lane = tid & 63; const int wave = __builtin_amdgcn_readfirstlane(tid >> 6); (void)lane; (void)wave;
enum { I_X = 0, I_META, I_WIN, I_CONVW, I_CONVB, I_WA, I_BA, I_WX, I_BX, I_LAM, I_LOUT, I_WQKV, I_RPB, I_MBIAS, I_NOUT, I_LNMG, I_LNMB, I_RW, I_RB, I_WGU, I_BGU, I_WD, I_BD, I_LNFG, I_LNFB };

namespace pg8 {
constexpr int BM = 256, BK = 64, HALF = 128, HTB = HALF * BK * 2, STAGE_BYTES = 8 * HTB, NXCD = 8, WGM = 8;
constexpr int SIDE_OFF = STAGE_BYTES, TEXP_OFF = STAGE_BYTES + 2048, TOK_OFF = STAGE_BYTES + 2048 + 4096;
__device__ __forceinline__ int lds_byte(int r, int c) { const int st = (r >> 4) * 2 + (c >> 5), rr = r & 15, cc = c & 31, ob = rr * 64 + cc * 2; return st * 1024 + (ob ^ (((ob >> 9) & 1) << 5)); }
__device__ __forceinline__ void stage_rc(int b, int& R, int& C) { const int st = b / 1024, sb = b % 1024, swz = sb ^ (((sb >> 9) & 1) << 5); R = (st >> 1) * 16 + swz / 64; C = (st & 1) * 32 + (swz % 64) / 2; }
__device__ __forceinline__ int perm32(int rho) { const int n = rho >> 4, i = rho & 15; return 8 * (i >> 2) + 4 * n + (i & 3); }

typedef int v8i __attribute__((ext_vector_type(8)));
typedef int v4i __attribute__((ext_vector_type(4)));
__device__ __forceinline__ v8i cat8(bf16x8 a, bf16x8 b) { const v4i x = __builtin_bit_cast(v4i, a), y = __builtin_bit_cast(v4i, b); return __builtin_shufflevector(x, y, 0, 1, 2, 3, 4, 5, 6, 7); }
struct Unit { unsigned ao, bo, to; int pm, pn, aux; };

__device__ __forceinline__ void tile_of(int L, int nM, int nN, int& pm, int& pn) {
    const int nwg = nM * nN; int wgid = L;
    { const int q = nwg / NXCD, r = nwg % NXCD, xcd = wgid % NXCD, off = wgid / NXCD; wgid = (xcd < r ? xcd * (q + 1) : r * (q + 1) + (xcd - r) * q) + off; }
    const int nig = WGM * nN, gid = wgid / nig, fm = gid * WGM, gsz = (nM - fm) < WGM ? (nM - fm) : WGM;
    pm = fm + ((wgid % nig) % gsz); pn = (wgid % nig) / gsz;
}

template <bool F8, bool GATHER, class Epi, class Sched>
__device__ __forceinline__ void gemm_phase(LAS unsigned char* lds, const unsigned char* wsbase, const int K, const int lda, const int ldb, const Sched& S, const Epi& E) {
    const __amdgpu_buffer_rsrc_t rsrc = __builtin_amdgcn_make_buffer_rsrc((void*)wsbase, 0, 0xFFFFFFFF, 0x00020000);
    const int tid = fresh_tid(), wid = __builtin_amdgcn_readfirstlane(tid >> 6), lane = tid & 63, wr = wid >> 2, wc = wid & 3;
    const int nt = K / BK;
    int f8scales = 0; if constexpr (F8) { f8scales = Epi::SCALES; asm volatile("" : "+v"(f8scales)); }
    int voffA, voffB;
    { int R, C; stage_rc(tid * 16, R, C); const int Rb = Epi::PERM ? ((R & ~31) + perm32(R & 31)) : R; voffA = ((GATHER ? 0 : R * lda) + C) * 2; voffB = (Rb * ldb + C) * 2; }
    const int tokb = (16 * (wid >> 1) + (lane >> 2)) * 4;
    const unsigned kstep = (unsigned)(BK * 2);
    const unsigned hstepA = (unsigned)HALF * lda * 2, hstepB = (unsigned)HALF * ldb * 2;
    const unsigned ldsw = (unsigned)wid * 1024u;
    const int aoff = lds_byte(wr * 64 + (lane & 15), (lane >> 4) * 8), boff = lds_byte(wc * 32 + (lane & 15), (lane >> 4) * 8);
#define PG8_SA(b, h) (((b) * 2 + (h)) * HTB)
#define PG8_SB(b, h) ((4 + (b) * 2 + (h)) * HTB)
#define PG8_STAGE(bufoff, gbase, voff) do { _Pragma("unroll") for (int _i = 0; _i < 2; ++_i) \
        __builtin_amdgcn_raw_ptr_buffer_load_lds(rsrc, (LAS void*)(lds + (bufoff) + ldsl + _i * 8192), 16, voff, __builtin_amdgcn_readfirstlane((int)((gbase) + (unsigned)_i * (hstep##voff >> 1))), 0, 0); } while (0)
#define hstepvoffA hstepA
#define hstepvoffB hstepB
#define PG8_STAGE_A(bufoff, aoffs, h, par) do { if constexpr (GATHER) { _Pragma("unroll") for (int _i = 0; _i < 2; ++_i) { \
            const int _tk = *(const LAS int*)(lds + TOK_OFF + (par) * 1024 + tokb + ((h) * 128 + _i * 64) * 4); \
            __builtin_amdgcn_raw_ptr_buffer_load_lds(rsrc, (LAS void*)(lds + (bufoff) + ldsl + _i * 8192), 16, _tk + voffA, __builtin_amdgcn_readfirstlane((int)(aoffs)), 0, 0); } } \
        else { PG8_STAGE(bufoff, (aoffs) + (unsigned)(h) * hstepA, voffA); } } while (0)
#define PG8_TOK(unit, par) do { if constexpr (GATHER) { if (wid == 0) __builtin_amdgcn_raw_ptr_buffer_load_lds(rsrc, (LAS void*)(lds + TOK_OFF + (par) * 1024), 16, lane * 16, (int)(unit).to, 0, 0); } } while (0)
#define PG8_LDA(dst, b, h) do { _Pragma("unroll") for (int m = 0; m < 4; ++m) _Pragma("unroll") for (int k = 0; k < 2; ++k) dst[m][k] = *(const LAS bf16x8*)(lds + PG8_SA(b, h) + aoff + m * 2048 + k * 1024); } while (0)
#define PG8_LDB(dst, b, h) do { _Pragma("unroll") for (int n = 0; n < 2; ++n) _Pragma("unroll") for (int k = 0; k < 2; ++k) dst[n][k] = *(const LAS bf16x8*)(lds + PG8_SB(b, h) + boff + n * 2048 + k * 1024); } while (0)
#define PG8_MMA(ai, bj, At, Bt) do { __builtin_amdgcn_s_setprio(1); _Pragma("unroll") for (int m = 0; m < 4; ++m) _Pragma("unroll") for (int n = 0; n < 2; ++n) { \
        if constexpr (F8) { asm volatile("v_mfma_scale_f32_16x16x128_f8f6f4 %0, %1, %2, %0, %3, %3 op_sel:[0,1,0] op_sel_hi:[0,0,0]" : "+v"(acc[ai][bj][m][n]) : "v"(cat8(Bt[n][0], Bt[n][1])), "v"(cat8(At[m][0], At[m][1])), "v"(f8scales)); } \
        else { _Pragma("unroll") for (int k = 0; k < 2; ++k) acc[ai][bj][m][n] = __builtin_amdgcn_mfma_f32_16x16x32_bf16(Bt[n][k], At[m][k], acc[ai][bj][m][n], 0, 0, 0); } } \
        __builtin_amdgcn_s_setprio(0); } while (0)
#define PG8_WAIT_V(n) asm volatile("s_waitcnt vmcnt(" #n ")" ::: "memory")
#define PG8_WAIT_L(n) asm volatile("s_waitcnt lgkmcnt(" #n ")" ::: "memory")
#define PG8_BAR __builtin_amdgcn_s_barrier()
#define PG8_SCHED __builtin_amdgcn_sched_barrier(0)
    Unit cur, nxt; int ui = 0;
    if (!S.next(0, cur)) return;
    f32x4 acc[2][2][4][2];
    bf16x8 At[4][2], B0[2][2], B1[2][2];
#define PG8_INIT(par) do { if constexpr (Epi::SIDE) { const int _l = fresh_tid() & 63; E.init(acc, (const LAS float*)(lds + SIDE_OFF + (par) * 1024), wc, _l >> 4); } \
        else { _Pragma("unroll") for (int a = 0; a < 2; ++a) _Pragma("unroll") for (int b = 0; b < 2; ++b) _Pragma("unroll") for (int m = 0; m < 4; ++m) _Pragma("unroll") for (int n = 0; n < 2; ++n) acc[a][b][m][n] = (f32x4){0.f, 0.f, 0.f, 0.f}; } } while (0)
    unsigned cA = cur.ao, cB = cur.bo;
    unsigned ldsl = ldsw; asm volatile("" : "+s"(ldsl));
#define PG8_SIDE(unit, par) do { if constexpr (Epi::SIDE) { if (wid == 0) __builtin_amdgcn_raw_ptr_buffer_load_lds(rsrc, (LAS void*)(lds + SIDE_OFF + (par) * 1024), 16, lane * 16, (int)E.side_off(unit), 0, 0); } } while (0)
    PG8_SIDE(cur, 0);
    if constexpr (GATHER) PG8_TOK(cur, 0);
    if constexpr (GATHER || Epi::SIDE) { asm volatile("s_waitcnt vmcnt(0)" ::: "memory"); PG8_BAR; }
    PG8_INIT(0);
    PG8_STAGE(PG8_SB(0, 0), cB, voffB); PG8_STAGE(PG8_SB(0, 1), cB + hstepB, voffB); PG8_STAGE_A(PG8_SA(0, 0), cA, 0, 0); PG8_STAGE_A(PG8_SA(0, 1), cA, 1, 0);
    if (wr == 1) PG8_BAR;
    PG8_WAIT_V(2); PG8_BAR;
    PG8_STAGE(PG8_SB(1, 0), cB + kstep, voffB); PG8_STAGE_A(PG8_SA(1, 0), cA + kstep, 0, 0); PG8_STAGE(PG8_SB(1, 1), cB + hstepB + kstep, voffB);
    PG8_WAIT_V(6); PG8_BAR;
    for (;;) {
        const bool has_next = S.next(ui + 1, nxt);
        if (has_next) { PG8_TOK(nxt, (ui + 1) & 1); PG8_SIDE(nxt, (ui + 1) & 1); }
        const unsigned nA = has_next ? nxt.ao : cA, nB = has_next ? nxt.bo : cB;
#pragma unroll 1
        for (int t = 0; t < nt; t += 2) {
            const bool last = (t == nt - 2);
            ldsl = ldsw; asm volatile("" : "+s"(ldsl));
            const int parc = ui & 1, parn = (ui + ((last && has_next) ? 1 : 0)) & 1;
            const unsigned a1 = cA + (unsigned)(t + 1) * kstep;
            const unsigned a2 = last ? nA : cA + (unsigned)(t + 2) * kstep, b2 = last ? nB : cB + (unsigned)(t + 2) * kstep;
            const unsigned a3 = a2 + kstep, b3 = b2 + kstep;
            PG8_LDB(B0, 0, 0); PG8_LDB(B1, 0, 1); PG8_SCHED; PG8_LDA(At, 0, 0); PG8_STAGE_A(PG8_SA(1, 1), a1, 1, parc);
            PG8_WAIT_V(8); PG8_WAIT_L(0); PG8_BAR; PG8_MMA(0, 0, At, B0); PG8_MMA(0, 1, At, B1); PG8_BAR; PG8_SCHED;
            PG8_LDA(At, 0, 1); PG8_STAGE(PG8_SB(0, 0), b2, voffB); PG8_STAGE(PG8_SB(0, 1), b2 + hstepB, voffB); PG8_STAGE_A(PG8_SA(0, 0), a2, 0, parn);
            PG8_WAIT_V(8); PG8_WAIT_L(0); PG8_BAR; PG8_MMA(1, 0, At, B0); PG8_MMA(1, 1, At, B1); PG8_BAR; PG8_SCHED;
            PG8_LDB(B0, 1, 0); PG8_LDB(B1, 1, 1); PG8_SCHED; PG8_LDA(At, 1, 0); PG8_STAGE_A(PG8_SA(0, 1), a2, 1, parn);
            PG8_WAIT_V(8); PG8_WAIT_L(0); PG8_BAR; PG8_MMA(0, 0, At, B0); PG8_MMA(0, 1, At, B1); PG8_BAR; PG8_SCHED;
            PG8_LDA(At, 1, 1); PG8_STAGE(PG8_SB(1, 0), b3, voffB); PG8_STAGE(PG8_SB(1, 1), b3 + hstepB, voffB); PG8_STAGE_A(PG8_SA(1, 0), a3, 0, parn);
            PG8_WAIT_V(8); PG8_WAIT_L(0); PG8_BAR; PG8_MMA(1, 0, At, B0); PG8_MMA(1, 1, At, B1); PG8_BAR; PG8_SCHED;
        }
        if constexpr (F8) asm volatile("s_nop 15\n\ts_nop 15" ::: "memory");
        if (wr == 0) PG8_BAR;
        { const int l2 = fresh_tid() & 63; E(acc, cur, wr, wc, l2 & 15, l2 >> 4, (const LAS float*)(lds + SIDE_OFF + (ui & 1) * 1024)); }
        if (!has_next) break;
        cur = nxt; cA = nA; cB = nB; ++ui;
        PG8_INIT(ui & 1);
        if (wr == 1) PG8_BAR;
    }
    PG8_WAIT_V(0);
    PG8_BAR;
#undef PG8_SA
#undef PG8_SB
#undef PG8_STAGE
#undef PG8_STAGE_A
#undef PG8_TOK
#undef PG8_SIDE
#undef PG8_INIT
#undef hstepvoffA
#undef hstepvoffB
#undef PG8_LDA
#undef PG8_LDB
#undef PG8_MMA
#undef PG8_WAIT_V
#undef PG8_WAIT_L
#undef PG8_BAR
#undef PG8_SCHED
}
}

using pg8::Unit;

struct DenseSched {
    unsigned A, Bt; int lda, ldb, nM, nN, G, c;
    __device__ __forceinline__ bool next(int i, Unit& u) const {
        const int L = i * G + c; if (L >= nM * nN) return false;
        pg8::tile_of(L, nM, nN, u.pm, u.pn); u.aux = 0; u.to = 0;
        u.ao = A + (unsigned)u.pm * 256 * lda * 2; u.bo = Bt + (unsigned)u.pn * 256 * ldb * 2; return true;
    }
};
struct GateSched {
    unsigned XC, GT; int nM, G, c;
    __device__ __forceinline__ bool next(int i, Unit& u) const {
        const int per = nM * 4; const int L = i * G + c; if (L >= 4 * per) return false;
        const int nb = L / per; pg8::tile_of(L - nb * per, nM, 4, u.pm, u.pn); u.aux = nb; u.to = 0;
        u.ao = XC + ((unsigned)u.pm * 256 * 1024 + 256 * nb) * 2; u.bo = GT + ((unsigned)nb * 1024 + 256 * u.pn) * 256 * 2; return true;
    }
};
struct QkvSched {
    unsigned HB, WT; int nM, G, c;
    __device__ __forceinline__ bool next(int i, Unit& u) const {
        const int n0 = nM * 8, n1 = 4 * nM; const int L = i * G + c; if (L >= n0 + n1) return false; u.to = 0;
        if (L < n0) { pg8::tile_of(L, nM, 8, u.pm, u.pn); u.aux = 0; u.ao = HB + (unsigned)u.pm * 256 * 1024; u.bo = WT + (unsigned)u.pn * 256 * 1024; }
        else { pg8::tile_of(L - n0, 4, nM, u.pm, u.pn); u.aux = 1; u.ao = WT + (unsigned)(2048 + u.pm * 256) * 1024; u.bo = HB + (unsigned)u.pn * 256 * 1024; }
        return true;
    }
};
struct MoeSched {
    unsigned A, W, tok; const LAS int* texp; unsigned wstride; int nM, nN, G, c;
    __device__ __forceinline__ bool next(int i, Unit& u) const {
        const int L = i * G + c; if (L >= nM * nN) return false;
        pg8::tile_of(L, nM, nN, u.pm, u.pn);
        const int e = __builtin_amdgcn_readfirstlane(texp[u.pm]); u.aux = e;
        u.ao = tok ? A : A + (unsigned)u.pm * 256 * 1024; u.to = tok + (unsigned)u.pm * 1024; u.bo = W + (unsigned)e * wstride + (unsigned)u.pn * 256 * 1024; return true;
    }
};

#define EPI_ARGS const f32x4 (&acc)[2][2][4][2], const Unit& u, int wr, int wc, int fr, int fq, const LAS float* side
struct EpiWin {
    static constexpr bool PERM = true, SIDE = false;
    bf16_t* XR; bf16_t* GY;
    __device__ __forceinline__ void operator()(EPI_ARGS) const {
        const int row0 = u.pm * 256 + wr * 64 + fr;
        if (u.pn < 4) {
            const int col0 = u.pn * 256 + wc * 32 + 8 * fq;
#pragma unroll
            for (int ai = 0; ai < 2; ++ai)
#pragma unroll
                for (int m = 0; m < 4; ++m) { bf16_t* rowp = XR + (size_t)(row0 + ai * 128 + m * 16) * D + col0;
#pragma unroll
                    for (int bj = 0; bj < 2; ++bj) { const f32x4 v0 = acc[ai][bj][m][0], v1 = acc[ai][bj][m][1];
                        u32x4 w; w.x = cvt_pk_bf16(v0[0], v0[1]); w.y = cvt_pk_bf16(v0[2], v0[3]); w.z = cvt_pk_bf16(v1[0], v1[1]); w.w = cvt_pk_bf16(v1[2], v1[3]);
                        *(u32x4*)(rowp + bj * 128) = w; } }
        } else {
#pragma unroll
            for (int ai = 0; ai < 2; ++ai)
#pragma unroll
                for (int m = 0; m < 4; ++m) { const int row = row0 + ai * 128 + m * 16;
#pragma unroll
                    for (int bj = 0; bj < 2; ++bj) { const int g = (u.pn - 4) * 8 + bj * 4 + wc;
                        float o[8];
#pragma unroll
                        for (int n = 0; n < 2; ++n)
#pragma unroll
                            for (int j = 0; j < 4; ++j) { const float v = acc[ai][bj][m][n][j]; const float z = 1.5957691216f * (v + 0.044715f * v * v * v); o[n * 4 + j] = v * sigmoidf_(z); }
                        u32x4 w; w.x = cvt_pk_bf16(o[0], o[1]); w.y = cvt_pk_bf16(o[2], o[3]); w.z = cvt_pk_bf16(o[4], o[5]); w.w = cvt_pk_bf16(o[6], o[7]);
                        *(u32x4*)(GY + ((size_t)g * MPAD + row) * 32 + 8 * fq) = w; } }
        }
    }
};
struct EpiGate {
    static constexpr bool PERM = true, SIDE = true;
    const bf16_t* XC; bf16_t* LA; bf16_t* BB; const float* spl; unsigned bias_off;
    __device__ __forceinline__ unsigned side_off(const Unit& u) const { return bias_off + (unsigned)((((u.pn >> 1) * 4 + u.aux) * 2 + (u.pn & 1)) * 1024); }
    __device__ __forceinline__ void init(f32x4 (&acc)[2][2][4][2], const LAS float* side, int wc, int fq) const {
#pragma unroll
        for (int bj = 0; bj < 2; ++bj)
#pragma unroll
            for (int n = 0; n < 2; ++n) { const f32x4 b = *(const LAS f32x4*)(side + 128 * bj + 32 * wc + 8 * fq + 4 * n);
#pragma unroll
                for (int ai = 0; ai < 2; ++ai)
#pragma unroll
                    for (int m = 0; m < 4; ++m) acc[ai][bj][m][n] = b; }
    }
    __device__ __forceinline__ void operator()(EPI_ARGS) const {
        const int nb = u.aux, dir = u.pn >> 1, half = u.pn & 1;
        const int ch0 = 256 * nb + 128 * half + 32 * wc + 8 * fq, g = ch0 >> 5;
        const int row0 = u.pm * 256 + wr * 64 + fr;
        float csp[8];
        { const f32x4 p0 = *(const f32x4*)(spl + dir * 1024 + ch0), p1 = *(const f32x4*)(spl + dir * 1024 + ch0 + 4);
#pragma unroll
          for (int j = 0; j < 4; ++j) { csp[j] = -p0[j]; csp[4 + j] = -p1[j]; } }
        u32x4 xnext = *(const u32x4*)(XC + (size_t)row0 * D + ch0);
#pragma unroll
        for (int ai = 0; ai < 2; ++ai)
#pragma unroll
            for (int m = 0; m < 4; ++m) { const int row = row0 + ai * 128 + m * 16;
                const u32x4 xw = xnext;
                { const int it = ai * 4 + m + 1, rn = row0 + (it >> 2) * 128 + (it & 3) * 16; if (it < 8) xnext = *(const u32x4*)(XC + (size_t)rn * D + ch0); }
                float xc[8]; unpack8(xw, xc);
                const bool start = dir == 1 && (row & (SEQ - 1)) == SEQ - 1;
                float la[8], bb[8];
#pragma unroll
                for (int n = 0; n < 2; ++n)
#pragma unroll
                    for (int j = 0; j < 4; ++j) { const int i = n * 4 + j;
                        const float l2 = csp[i] * sigmoidf_(acc[ai][0][m][n][j]); const float a2 = fast_exp2(2.0f * l2);
                        const float mult = start ? 1.0f : __builtin_amdgcn_sqrtf(fmaxf(1.0f - a2, 0.0f));
                        la[i] = l2; bb[i] = mult * sigmoidf_(acc[ai][1][m][n][j]) * xc[i]; }
                u32x4 w; w.x = cvt_pk_bf16(la[0], la[1]); w.y = cvt_pk_bf16(la[2], la[3]); w.z = cvt_pk_bf16(la[4], la[5]); w.w = cvt_pk_bf16(la[6], la[7]);
                const size_t o = (((size_t)dir * 32 + g) * MPAD + row) * 32 + 8 * fq;
                *(u32x4*)(LA + o) = w;
                w.x = cvt_pk_bf16(bb[0], bb[1]); w.y = cvt_pk_bf16(bb[2], bb[3]); w.z = cvt_pk_bf16(bb[4], bb[5]); w.w = cvt_pk_bf16(bb[6], bb[7]);
                *(u32x4*)(BB + o) = w; }
    }
};
template <bool LAYER0> struct EpiRes {
    static constexpr bool PERM = true, SIDE = false;
    bf16_t* PRE; const float* x; const float* meta; const bf16_t* HB; int nrows;
    __device__ __forceinline__ void operator()(EPI_ARGS) const {
        const int row0 = u.pm * 256 + wr * 64 + fr, col0 = u.pn * 256 + wc * 32 + 8 * fq;
#pragma unroll
        for (int ai = 0; ai < 2; ++ai)
#pragma unroll
            for (int m = 0; m < 4; ++m) { const int row = row0 + ai * 128 + m * 16;
                if (row < nrows) {
#pragma unroll
                    for (int bj = 0; bj < 2; ++bj) { const int c = col0 + bj * 128; float r[8];
                        if (LAYER0) { const float* rp = (row < NGRID ? x + (size_t)row * D : meta + (size_t)((row - NGRID) & 15) * D) + c; const f32x4 r0 = *(const f32x4*)rp, r1 = *(const f32x4*)(rp + 4);
                            r[0] = r0[0]; r[1] = r0[1]; r[2] = r0[2]; r[3] = r0[3]; r[4] = r1[0]; r[5] = r1[1]; r[6] = r1[2]; r[7] = r1[3]; }
                        else { const u32x4 rw = *(const u32x4*)(HB + (size_t)row * D + c); r[0] = bflo(rw.x); r[1] = bfhi(rw.x); r[2] = bflo(rw.y); r[3] = bfhi(rw.y); r[4] = bflo(rw.z); r[5] = bfhi(rw.z); r[6] = bflo(rw.w); r[7] = bfhi(rw.w); }
                        const f32x4 a0 = acc[ai][bj][m][0], a1 = acc[ai][bj][m][1];
                        u32x4 w; w.x = cvt_pk_bf16(r[0] * DN_ALPHA + a0[0], r[1] * DN_ALPHA + a0[1]); w.y = cvt_pk_bf16(r[2] * DN_ALPHA + a0[2], r[3] * DN_ALPHA + a0[3]);
                        w.z = cvt_pk_bf16(r[4] * DN_ALPHA + a1[0], r[5] * DN_ALPHA + a1[1]); w.w = cvt_pk_bf16(r[6] * DN_ALPHA + a1[2], r[7] * DN_ALPHA + a1[3]);
                        *(u32x4*)(PRE + (size_t)row * D + c) = w; }
                }
                asm volatile("" ::: "memory"); }
    }
};
struct EpiGlu {
    static constexpr bool PERM = true, SIDE = true; static constexpr int SCALES = 0x7F79;
    unsigned char* ACT; unsigned bias_off;
    __device__ __forceinline__ unsigned side_off(const Unit& u) const { return bias_off + (unsigned)((u.aux * 8 + u.pn) * 1024); }
    __device__ __forceinline__ void init(f32x4 (&acc)[2][2][4][2], const LAS float* side, int wc, int fq) const {
#pragma unroll
        for (int bj = 0; bj < 2; ++bj)
#pragma unroll
            for (int n = 0; n < 2; ++n) { const f32x4 b = *(const LAS f32x4*)(side + 128 * bj + 32 * wc + 8 * fq + 4 * n);
#pragma unroll
                for (int ai = 0; ai < 2; ++ai)
#pragma unroll
                    for (int m = 0; m < 4; ++m) acc[ai][bj][m][n] = b; }
    }
    __device__ __forceinline__ void operator()(EPI_ARGS) const {
        const int f0 = 128 * u.pn + 32 * wc + 8 * fq;
        const int row0 = u.pm * 256 + wr * 64 + fr;
#pragma unroll
        for (int ai = 0; ai < 2; ++ai)
#pragma unroll
            for (int m = 0; m < 4; ++m) { const int row = row0 + ai * 128 + m * 16; float o[8];
#pragma unroll
                for (int n = 0; n < 2; ++n)
#pragma unroll
                    for (int j = 0; j < 4; ++j) { const int i = n * 4 + j;
                        const float glu = fminf(acc[ai][0][m][n][j], 7.0f);
                        const float lin1 = __builtin_amdgcn_fmed3f(acc[ai][1][m][n][j], -6.0f, 8.0f);
                        const float r4 = fast_rcp(__builtin_fmaf(fast_exp2(glu * (-1.702f * 1.44269504089f)), 0.25f, 0.25f));
                        o[i] = (glu * r4) * lin1; }
                u32x2 w; w.x = pk4_fp8(o[0], o[1], o[2], o[3]); w.y = pk4_fp8(o[4], o[5], o[6], o[7]);
                *(u32x2*)(ACT + (size_t)row * D + f0) = w; }
    }
};
struct EpiNull {
    static constexpr bool PERM = true, SIDE = false; static constexpr int SCALES = 0x7F79;
    __device__ __forceinline__ void operator()(EPI_ARGS) const {
#pragma unroll
        for (int ai = 0; ai < 2; ++ai)
#pragma unroll
            for (int bj = 0; bj < 2; ++bj)
#pragma unroll
                for (int m = 0; m < 4; ++m)
#pragma unroll
                    for (int n = 0; n < 2; ++n) asm volatile("" :: "v"(acc[ai][bj][m][n]));
    }
};
struct EpiDown {
    static constexpr bool PERM = true, SIDE = true; static constexpr int SCALES = 0x7D79;
    unsigned char* YS; unsigned bias_off;
    __device__ __forceinline__ unsigned side_off(const Unit& u) const { return bias_off + (unsigned)((u.aux * 4 + u.pn) * 1024); }
    __device__ __forceinline__ void init(f32x4 (&acc)[2][2][4][2], const LAS float* side, int wc, int fq) const {
#pragma unroll
        for (int bj = 0; bj < 2; ++bj)
#pragma unroll
            for (int n = 0; n < 2; ++n) { const f32x4 b = *(const LAS f32x4*)(side + 128 * bj + 32 * wc + 8 * fq + 4 * n);
#pragma unroll
                for (int ai = 0; ai < 2; ++ai)
#pragma unroll
                    for (int m = 0; m < 4; ++m) acc[ai][bj][m][n] = b; }
    }
    __device__ __forceinline__ void operator()(EPI_ARGS) const {
        const int row0 = u.pm * 256 + wr * 64 + fr, col0 = u.pn * 256 + wc * 32 + 8 * fq;
#pragma unroll
        for (int ai = 0; ai < 2; ++ai)
#pragma unroll
            for (int m = 0; m < 4; ++m) { unsigned char* rowp = YS + (size_t)(row0 + ai * 128 + m * 16) * D + col0;
#pragma unroll
                for (int bj = 0; bj < 2; ++bj) { const f32x4 v0 = acc[ai][bj][m][0] * 8.0f, v1 = acc[ai][bj][m][1] * 8.0f;
                    u32x2 w; w.x = pk4_fp8(v0[0], v0[1], v0[2], v0[3]); w.y = pk4_fp8(v1[0], v1[1], v1[2], v1[3]);
                    *(u32x2*)(rowp + bj * 128) = w; } }
    }
};
struct EpiQkv {
    static constexpr bool PERM = true, SIDE = false; static constexpr int SCALES = 0x7F79;
    bf16_t* Q; bf16_t* Kx; bf16_t* VT;
    __device__ __forceinline__ void operator()(EPI_ARGS) const {
        const int row0 = u.pm * 256 + wr * 64 + fr; bf16_t* base; int ldc, colt; float sc = 1.0f;
        if (u.aux == 0) { ldc = D; if (u.pn < 4) { base = Q; colt = u.pn * 256; sc = 0.125f * 1.44269504089f; } else { base = Kx; colt = (u.pn - 4) * 256; } }
        else { base = VT; ldc = MPAD; colt = u.pn * 256; }
        const int col0 = colt + wc * 32 + 8 * fq;
#pragma unroll
        for (int ai = 0; ai < 2; ++ai)
#pragma unroll
            for (int m = 0; m < 4; ++m) { bf16_t* rowp = base + (size_t)(row0 + ai * 128 + m * 16) * ldc + col0;
#pragma unroll
                for (int bj = 0; bj < 2; ++bj) { const f32x4 v0 = acc[ai][bj][m][0] * sc, v1 = acc[ai][bj][m][1] * sc;
                    u32x4 w; w.x = cvt_pk_bf16(v0[0], v0[1]); w.y = cvt_pk_bf16(v0[2], v0[3]); w.z = cvt_pk_bf16(v1[0], v1[1]); w.w = cvt_pk_bf16(v1[2], v1[3]);
                    *(u32x4*)(rowp + bj * 128) = w; } }
    }
};

struct CvItem { const float* src; unsigned char* dst; int ld, pitch, f8; };
__device__ __forceinline__ CvItem cv_item(const Ctx& C, unsigned char* wsl, int it) {
    constexpr int I0 = 512, I1 = 256, I2 = 256, I3 = 768, I4 = 256, I5 = 32768, I6 = 16384;
    CvItem q; int r = it;
    if (r < I0) { const int nbk = r & 63, kb = r >> 6; q.src = C.in[I_WIN] + (size_t)(128 * kb) * 2048 + 32 * nbk; q.ld = 2048; q.dst = wsl + WS_WIN + ((size_t)(32 * nbk) * 1024 + 128 * kb) * 2; q.pitch = 2048; q.f8 = 0; return q; } r -= I0;
    if (r < I1) { const int job = r >> 3, sub = r & 7, nbk = sub & 3, kb = sub >> 2;
        const int half = job & 1, which = (job >> 1) & 1, nb = (job >> 2) & 3, dir = job >> 4;
        q.src = C.in[which ? I_WX : I_WA] + (size_t)(dir * 4 + nb) * 65536 + (size_t)(128 * kb) * 256 + 128 * half + 32 * nbk; q.ld = 256;
        q.dst = wsl + WS_GATE + (((size_t)nb * 1024 + 256 * (2 * dir + half) + 128 * which + 32 * nbk) * 256 + 128 * kb) * 2; q.pitch = 512; q.f8 = 0; return q; } r -= I1;
    if (r < I2) { const int nbk = r & 31, kb = r >> 5; q.src = C.in[I_LOUT] + (size_t)(128 * kb) * 1024 + 32 * nbk; q.ld = 1024; q.dst = wsl + WS_LOUT + ((size_t)(32 * nbk) * 1024 + 128 * kb) * 2; q.pitch = 2048; q.f8 = 0; return q; } r -= I2;
    if (r < I3) { const int nbk = r % 96, kb = r / 96; q.src = C.in[I_WQKV] + (size_t)(128 * kb) * 3072 + 32 * nbk; q.ld = 3072; q.dst = wsl + WS_QKV + ((size_t)(32 * nbk) * 1024 + 128 * kb) * 2; q.pitch = 2048; q.f8 = 0; return q; } r -= I3;
    if (r < I4) { const int nbk = r & 31, kb = r >> 5; q.src = C.in[I_NOUT] + (size_t)(128 * kb) * 1024 + 32 * nbk; q.ld = 1024; q.dst = wsl + WS_NOUT + ((size_t)(32 * nbk) * 1024 + 128 * kb) * 2; q.pitch = 2048; q.f8 = 0; return q; } r -= I4;
    q.f8 = 1; q.pitch = 1024;
    if (r < I5) { const int mat = r >> 9, sub = r & 511, nbk = sub & 63, kb = sub >> 6; const int n0 = 32 * nbk, bj = n0 >> 10, f0 = n0 & 1023, pn = f0 >> 7, jj = f0 & 127;
        q.src = C.in[I_WGU] + (size_t)mat * 1024 * 2048 + (size_t)(128 * kb) * 2048 + n0; q.ld = 2048; q.dst = wsl + WS_WGU + ((size_t)mat * 2048 + 256 * pn + 128 * bj + jj) * 1024 + 128 * kb; return q; } r -= I5;
    if (r < I6) { const int mat = r >> 8, sub = r & 255, nbk = sub & 31, kb = sub >> 5;
        q.src = C.in[I_WD] + (size_t)mat * 1024 * 1024 + (size_t)(128 * kb) * 1024 + 32 * nbk; q.ld = 1024; q.dst = wsl + WS_WD + ((size_t)mat * 1024 + 32 * nbk) * 1024 + 128 * kb; return q; } r -= I6;
    { const int nbk = r % 96, kb = r / 96; q.src = C.in[I_WQKV] + (size_t)(128 * kb) * 3072 + 32 * nbk; q.ld = 3072; q.dst = wsl + WS_QKV8 + (size_t)(32 * nbk) * 1024 + 128 * kb; return q; }
}
__device__ __forceinline__ void phase_convert(const Ctx& C) {
    PHASE_IDS
    LAS float* scr = (LAS float*)(C.lds + wave * 16896);
    const int gw = C.bid * NWAVES + wave, NGW = C.G * NWAVES;
    constexpr int NIT = 512 + 256 + 256 + 768 + 256 + 32768 + 16384 + 768;
    if (gw < NIT) {
        const int r = lane >> 3, q4 = lane & 7, c = lane & 15, nn = lane >> 4;
        CvItem cur = cv_item(C, wsl, gw); int it = gw;
        f32x4 v[16];
#pragma unroll
        for (int i = 0; i < 16; ++i) v[i] = __builtin_nontemporal_load((const f32x4*)(cur.src + (size_t)(8 * i + r) * cur.ld + 4 * q4));
        for (;;) {
#pragma unroll
            for (int i = 0; i < 16; ++i) { LAS float* sp = scr + (8 * i + r) * 33 + 4 * q4; sp[0] = v[i][0]; sp[1] = v[i][1]; sp[2] = v[i][2]; sp[3] = v[i][3]; }
            const int nit = it + NGW; CvItem nxt = cur;
            if (nit < NIT) { nxt = cv_item(C, wsl, nit);
#pragma unroll
                for (int i = 0; i < 16; ++i) v[i] = __builtin_nontemporal_load((const f32x4*)(nxt.src + (size_t)(8 * i + r) * nxt.ld + 4 * q4)); }
            asm volatile("s_waitcnt lgkmcnt(0)" ::: "memory");
            if (cur.f8) {
#pragma unroll
                for (int j = 0; j < 8; ++j) { const int n = nn + 4 * j; const LAS float* sp = scr + (8 * c) * 33 + n;
                    u32x2 o; o.x = pk4_fp8(sp[0] * 64.0f, sp[33] * 64.0f, sp[2 * 33] * 64.0f, sp[3 * 33] * 64.0f); o.y = pk4_fp8(sp[4 * 33] * 64.0f, sp[5 * 33] * 64.0f, sp[6 * 33] * 64.0f, sp[7 * 33] * 64.0f);
                    *(u32x2*)(cur.dst + (size_t)n * cur.pitch + 8 * c) = o; }
            } else {
#pragma unroll
                for (int j = 0; j < 8; ++j) { const int n = nn + 4 * j; const LAS float* sp = scr + (8 * c) * 33 + n;
                    u32x4 o; o.x = pk2(sp[0], sp[33]); o.y = pk2(sp[2 * 33], sp[3 * 33]); o.z = pk2(sp[4 * 33], sp[5 * 33]); o.w = pk2(sp[6 * 33], sp[7 * 33]);
                    *(u32x4*)(cur.dst + (size_t)n * cur.pitch + 16 * c) = o; }
            }
            asm volatile("s_waitcnt lgkmcnt(0)" ::: "memory");
            if (nit >= NIT) break;
            cur = nxt; it = nit;
        }
    }
    const int gt = C.bid * NTHREADS + tid, NGT = C.G * NTHREADS;
    for (int i = gt; i < 2048; i += NGT) ((float*)(wsl + WS_CTL + CT_SPL))[i] = 8.0f * 1.44269504089f * log1pf(expf(-C.in[I_LAM][i]));
    for (int i = gt; i < 2 * 32 * 2048; i += NGT) { const int le = i >> 11, r = i & 2047, pn = r >> 8, bj = (r >> 7) & 1, ii = r & 127;
        ((float*)(wsl + WS_BIAS))[i] = C.in[I_BGU][(size_t)le * 2048 + bj * 1024 + 128 * pn + ii] + (bj ? 1.0f : 0.0f); }
    for (int i = gt; i < 2 * 32 * 1024; i += NGT) ((float*)(wsl + WS_BD))[i] = C.in[I_BD][i];
    for (int i = gt; i < 4096; i += NGT) { const int ut = i >> 8, which = (i >> 7) & 1, jj = i & 127, dir = ut >> 3, nb = (ut >> 1) & 3, half = ut & 1;
        ((float*)(wsl + WS_GBIAS))[i] = C.in[which ? I_BX : I_BA][dir * 1024 + 256 * nb + 128 * half + jj]; }
    for (int i0 = gt; i0 < NTOK * 128; i0 += 4 * NGT) { f32x4 a[4], b[4];
#pragma unroll
        for (int u = 0; u < 4; ++u) { const int i = i0 + u * NGT; if (i < NTOK * 128) { const int row = i >> 7, oc = i & 127;
            const float* src = (row < NGRID ? C.in[I_X] + (size_t)row * D : C.in[I_META] + (size_t)((row - NGRID) & 15) * D) + 8 * oc;
            a[u] = __builtin_nontemporal_load((const f32x4*)src); b[u] = __builtin_nontemporal_load((const f32x4*)(src + 4)); } }
#pragma unroll
        for (int u = 0; u < 4; ++u) { const int i = i0 + u * NGT; if (i < NTOK * 128) { const int row = i >> 7, oc = i & 127;
            u32x4 w; w.x = pk2(a[u][0], a[u][1]); w.y = pk2(a[u][2], a[u][3]); w.z = pk2(b[u][0], b[u][1]); w.w = pk2(b[u][2], b[u][3]);
            *(u32x4*)((bf16_t*)(wsl + WS_HB) + (size_t)row * D + 8 * oc) = w; } } }
}

__device__ __forceinline__ void phase_conv(const Ctx& C) {
    PHASE_IDS
    const bf16_t* XR = (const bf16_t*)(wsl + WS_XR); bf16_t* XC = (bf16_t*)(wsl + WS_XC);
    const float* cw = C.in[I_CONVW]; const float* cb = C.in[I_CONVB];
    const int gt = C.bid * NTHREADS + tid, NGT = C.G * NTHREADS;
    for (int i = gt; i < NTOK * 128; i += NGT) { const int row = i >> 7, ch = 8 * (i & 127);
        int b, s; if (row < NGRID) { b = row >> 12; s = NMETA + (row & (SEQ - 1)); } else { b = (row - NGRID) >> 4; s = (row - NGRID) & 15; }
        float a[8];
        { const f32x4 t0 = *(const f32x4*)(cb + ch), t1 = *(const f32x4*)(cb + ch + 4);
#pragma unroll
          for (int j = 0; j < 4; ++j) { a[j] = t0[j]; a[4 + j] = t1[j]; } }
#pragma unroll
        for (int j = 0; j < 4; ++j) { const int sj = s - 2 + j;
            if (sj >= 0 && sj < LSEQ) { const u32x4 xw = *(const u32x4*)(XR + (size_t)seqrow(b, sj) * D + ch);
                const f32x4 w0 = *(const f32x4*)(cw + j * 1024 + ch), w1 = *(const f32x4*)(cw + j * 1024 + ch + 4);
                a[0] += w0[0] * bflo(xw.x); a[1] += w0[1] * bfhi(xw.x); a[2] += w0[2] * bflo(xw.y); a[3] += w0[3] * bfhi(xw.y);
                a[4] += w1[0] * bflo(xw.z); a[5] += w1[1] * bfhi(xw.z); a[6] += w1[2] * bflo(xw.w); a[7] += w1[3] * bfhi(xw.w); } }
        u32x4 w; w.x = pk2(a[0], a[1]); w.y = pk2(a[2], a[3]); w.z = pk2(a[4], a[5]); w.w = pk2(a[6], a[7]);
        *(u32x4*)(XC + (size_t)row * D + ch) = w; }
}

template <int N> __device__ __forceinline__ float dpp_shr(float oldv, float v) {
    return __builtin_bit_cast(float, __builtin_amdgcn_update_dpp(__builtin_bit_cast(int, oldv), __builtin_bit_cast(int, v), 0x110 + N, 0xf, 0xf, false));
}
__device__ __forceinline__ void scan_group(float (&a)[8], float (&b)[8]) {
#pragma unroll
    for (int c = 0; c < 8; ++c) {
        { const float ap = dpp_shr<1>(1.0f, a[c]), bp = dpp_shr<1>(0.0f, b[c]); b[c] = a[c] * bp + b[c]; a[c] = a[c] * ap; }
        { const float ap = dpp_shr<2>(1.0f, a[c]), bp = dpp_shr<2>(0.0f, b[c]); b[c] = a[c] * bp + b[c]; a[c] = a[c] * ap; }
        { const float ap = dpp_shr<4>(1.0f, a[c]), bp = dpp_shr<4>(0.0f, b[c]); b[c] = a[c] * bp + b[c]; a[c] = a[c] * ap; }
        { const float ap = dpp_shr<8>(1.0f, a[c]), bp = dpp_shr<8>(0.0f, b[c]); b[c] = a[c] * bp + b[c]; a[c] = a[c] * ap; }
    }
}
__device__ __forceinline__ void unpack8(const u32x4 w, float (&o)[8]) { o[0] = bflo(w.x); o[1] = bfhi(w.x); o[2] = bflo(w.y); o[3] = bfhi(w.y); o[4] = bflo(w.z); o[5] = bfhi(w.z); o[6] = bflo(w.w); o[7] = bfhi(w.w); }
__device__ __forceinline__ void phase_scan(const Ctx& C) {
    PHASE_IDS
    const bf16_t* LA = (const bf16_t*)(wsl + WS_LA); const bf16_t* BB = (const bf16_t*)(wsl + WS_BB); const bf16_t* GY = (const bf16_t*)(wsl + WS_GY);
    bf16_t* HF = (bf16_t*)(wsl + WS_HF); bf16_t* Gout = (bf16_t*)(wsl + WS_G);
    LAS float* agg = (LAS float*)C.lds;
    const int w = wave, oct = lane >> 4, p = lane & 15;
    for (int it0 = (C.G == 256 ? C.gc : C.bid); it0 < NB * 32; it0 += C.G) {
        const int item = (C.G == 256) ? (((it0 >> 3) >> 2) << 5) + ((it0 & 7) << 2) + ((it0 >> 3) & 3) : it0;
        const int b = item >> 5, g = item & 31;
        for (int dir = 0; dir < 2; ++dir) {
            const bf16_t* la = LA + (((size_t)dir * 32 + g) * MPAD) * 32 + 8 * oct;
            const bf16_t* bb = BB + (((size_t)dir * 32 + g) * MPAD) * 32 + 8 * oct;
            float S[8];
#pragma unroll
            for (int c = 0; c < 8; ++c) S[c] = 0.f;
            {
                const int u = p, s = dir ? LSEQ - 1 - u : u, row = seqrow(b, s);
                float a[8], x[8]; unpack8(*(const u32x4*)(la + (size_t)row * 32), a); unpack8(*(const u32x4*)(bb + (size_t)row * 32), x);
#pragma unroll
                for (int c = 0; c < 8; ++c) a[c] = fast_exp2(a[c]);
                scan_group(a, x);
                if (w == 0) {
                    if (dir == 0) { u32x4 o; o.x = pk2(x[0], x[1]); o.y = pk2(x[2], x[3]); o.z = pk2(x[4], x[5]); o.w = pk2(x[6], x[7]); *(u32x4*)(HF + ((size_t)g * MPAD + row) * 32 + 8 * oct) = o; }
                    else { float hf[8], gy[8]; unpack8(*(const u32x4*)(HF + ((size_t)g * MPAD + row) * 32 + 8 * oct), hf); unpack8(*(const u32x4*)(GY + ((size_t)g * MPAD + row) * 32 + 8 * oct), gy);
                        u32x4 o; o.x = pk2((hf[0] + x[0]) * gy[0], (hf[1] + x[1]) * gy[1]); o.y = pk2((hf[2] + x[2]) * gy[2], (hf[3] + x[3]) * gy[3]);
                        o.z = pk2((hf[4] + x[4]) * gy[4], (hf[5] + x[5]) * gy[5]); o.w = pk2((hf[6] + x[6]) * gy[6], (hf[7] + x[7]) * gy[7]);
                        *(u32x4*)(Gout + (size_t)row * D + 32 * g + 8 * oct) = o; }
                }
#pragma unroll
                for (int c = 0; c < 8; ++c) S[c] = __shfl(x[c], (lane & 48) | 15);
            }
            u32x4 na[4], nb[4];
#pragma unroll
            for (int j = 0; j < 4; ++j) { const int u = 16 + 64 * w + 16 * j + p, s = dir ? LSEQ - 1 - u : u; const int rw = seqrow(b, s);
                na[j] = __builtin_nontemporal_load((const u32x4*)(la + (size_t)rw * 32)); nb[j] = __builtin_nontemporal_load((const u32x4*)(bb + (size_t)rw * 32)); }
            for (int r = 0; r < 8; ++r) {
                float Pw[4][8], Hw[4][8]; int rows[4];
                float Aw[8], Hc[8];
#pragma unroll
                for (int c = 0; c < 8; ++c) { Aw[c] = 1.f; Hc[c] = 0.f; }
                u32x4 ra[4], rb[4], rhf[4], rgy[4];
#pragma unroll
                for (int j = 0; j < 4; ++j) { const int u = 16 + 512 * r + 64 * w + 16 * j + p, s = dir ? LSEQ - 1 - u : u; rows[j] = seqrow(b, s); ra[j] = na[j]; rb[j] = nb[j]; }
                if (r < 7) {
#pragma unroll
                    for (int j = 0; j < 4; ++j) { const int u = 16 + 512 * (r + 1) + 64 * w + 16 * j + p, s = dir ? LSEQ - 1 - u : u; const int rw = seqrow(b, s);
                        na[j] = __builtin_nontemporal_load((const u32x4*)(la + (size_t)rw * 32)); nb[j] = __builtin_nontemporal_load((const u32x4*)(bb + (size_t)rw * 32)); } }
                if (dir == 1) {
#pragma unroll
                    for (int j = 0; j < 4; ++j) { const size_t go = ((size_t)g * MPAD + rows[j]) * 32 + 8 * oct; rhf[j] = *(const u32x4*)(HF + go); rgy[j] = __builtin_nontemporal_load((const u32x4*)(GY + go)); } }
#pragma unroll
                for (int j = 0; j < 4; ++j) {
                    float a[8], x[8]; unpack8(ra[j], a); unpack8(rb[j], x);
#pragma unroll
                    for (int c = 0; c < 8; ++c) a[c] = fast_exp2(a[c]);
                    scan_group(a, x);
#pragma unroll
                    for (int c = 0; c < 8; ++c) { Hw[j][c] = a[c] * Hc[c] + x[c]; Pw[j][c] = a[c] * Aw[c]; }
#pragma unroll
                    for (int c = 0; c < 8; ++c) { Aw[c] = __shfl(Pw[j][c], (lane & 48) | 15); Hc[c] = __shfl(Hw[j][c], (lane & 48) | 15); }
                }
                LAS float* ag = agg + (r & 1) * 512;
                if (p == 0) {
#pragma unroll
                    for (int c = 0; c < 8; ++c) { ag[(w * 32 + oct * 8 + c) * 2] = Aw[c]; ag[(w * 32 + oct * 8 + c) * 2 + 1] = Hc[c]; }
                }
                __syncthreads();
                float Sin[8];
#pragma unroll
                for (int c = 0; c < 8; ++c) Sin[c] = S[c];
#pragma unroll
                for (int ww = 0; ww < 8; ++ww) {
#pragma unroll
                    for (int c = 0; c < 8; ++c) { const float A = ag[(ww * 32 + oct * 8 + c) * 2], H = ag[(ww * 32 + oct * 8 + c) * 2 + 1];
                        if (ww == w) Sin[c] = S[c];
                        S[c] = A * S[c] + H; }
                }
#pragma unroll
                for (int j = 0; j < 4; ++j) {
                    float h[8];
#pragma unroll
                    for (int c = 0; c < 8; ++c) h[c] = Pw[j][c] * Sin[c] + Hw[j][c];
                    const size_t go = ((size_t)g * MPAD + rows[j]) * 32 + 8 * oct;
                    if (dir == 0) { u32x4 o; o.x = pk2(h[0], h[1]); o.y = pk2(h[2], h[3]); o.z = pk2(h[4], h[5]); o.w = pk2(h[6], h[7]); *(u32x4*)(HF + go) = o; }
                    else { float hf[8], gy[8]; unpack8(rhf[j], hf); unpack8(rgy[j], gy);
                        u32x4 o; o.x = pk2((hf[0] + h[0]) * gy[0], (hf[1] + h[1]) * gy[1]); o.y = pk2((hf[2] + h[2]) * gy[2], (hf[3] + h[3]) * gy[3]);
                        o.z = pk2((hf[4] + h[4]) * gy[4], (hf[5] + h[5]) * gy[5]); o.w = pk2((hf[6] + h[6]) * gy[6], (hf[7] + h[7]) * gy[7]);
                        *(u32x4*)(Gout + (size_t)rows[j] * D + 32 * g + 8 * oct) = o; }
                }
            }
            __syncthreads();
        }
    }
}

template <int K> __device__ __forceinline__ f32x4 mini_mma(const bf16_t* W, int ldw, const bf16_t* A, int lda, int lane) {
    const bf16_t* wp = W + (size_t)(lane & 15) * ldw + 8 * (lane >> 4); const bf16_t* ap = A + (size_t)(lane & 15) * lda + 8 * (lane >> 4);
    f32x4 acc = {0.f, 0.f, 0.f, 0.f};
    constexpr int KB = K < 512 ? K : 512, NS = KB / 32;
#pragma unroll 1
    for (int k0 = 0; k0 < K; k0 += KB) { bf16x8 wf[NS], af[NS];
#pragma unroll
        for (int i = 0; i < NS; ++i) { wf[i] = *(const bf16x8*)(wp + k0 + 32 * i); af[i] = *(const bf16x8*)(ap + k0 + 32 * i); }
#pragma unroll
        for (int i = 0; i < NS; ++i) acc = __builtin_amdgcn_mfma_f32_16x16x32_bf16(wf[i], af[i], acc, 0, 0, 0); }
    return acc;
}
__device__ __forceinline__ void mini_win(const Ctx& C) {
    PHASE_IDS
    const bf16_t* HB = (const bf16_t*)(C.ws + WS_HB); const bf16_t* WT = (const bf16_t*)(C.ws + WS_WIN); bf16_t* XR = (bf16_t*)(C.ws + WS_XR); bf16_t* GY = (bf16_t*)(C.ws + WS_GY);
    const int fr = lane & 15, fq = lane >> 4;
    for (int wt = C.gc * NWAVES + wave; wt < 8 * 128; wt += C.G * NWAVES) { const int rg = wt & 7, cb = wt >> 3, row = NGRID + 16 * rg + fr, c = 16 * cb + 4 * fq;
        const f32x4 a = mini_mma<1024>(WT + (size_t)(16 * cb) * 1024, 1024, HB + (size_t)(NGRID + 16 * rg) * 1024, 1024, lane);
        if (c < 1024) { u32x2 w; w.x = cvt_pk_bf16(a[0], a[1]); w.y = cvt_pk_bf16(a[2], a[3]); *(u32x2*)(XR + (size_t)row * D + c) = w; }
        else { const int yc = c - 1024; float o[4];
#pragma unroll
            for (int j = 0; j < 4; ++j) { const float v = a[j]; const float z = 1.5957691216f * (v + 0.044715f * v * v * v); o[j] = v * sigmoidf_(z); }
            u32x2 w; w.x = cvt_pk_bf16(o[0], o[1]); w.y = cvt_pk_bf16(o[2], o[3]); *(u32x2*)(GY + ((size_t)(yc >> 5) * MPAD + row) * 32 + (yc & 31)) = w; } }
}
__device__ __forceinline__ void mini_gate(const Ctx& C) {
    PHASE_IDS
    const bf16_t* XC = (const bf16_t*)(C.ws + WS_XC); const bf16_t* GT = (const bf16_t*)(C.ws + WS_GATE); bf16_t* LA = (bf16_t*)(C.ws + WS_LA); bf16_t* BB = (bf16_t*)(C.ws + WS_BB);
    const float* ba = C.in[I_BA]; const float* bx = C.in[I_BX]; const float* spl = (const float*)(C.ws + WS_CTL + CT_SPL);
    const int fr = lane & 15, fq = lane >> 4;
    for (int wt = C.gc * NWAVES + wave; wt < 8 * 2 * 64; wt += C.G * NWAVES) { const int rg = wt & 7, dir = (wt >> 3) & 1, chg = wt >> 4, ch0 = 16 * chg, nb = ch0 >> 8, half = (ch0 >> 7) & 1, jj0 = ch0 & 127;
        const bf16_t* A = XC + (size_t)(NGRID + 16 * rg) * 1024 + 256 * nb; const bf16_t* Wa = GT + ((size_t)nb * 1024 + 256 * (2 * dir + half) + jj0) * 256;
        const f32x4 za = mini_mma<256>(Wa, 256, A, 1024, lane), zx = mini_mma<256>(Wa + 128 * 256, 256, A, 1024, lane);
        const int row = NGRID + 16 * rg + fr, ch = ch0 + 4 * fq;
        const f32x4 cba = *(const f32x4*)(ba + dir * 1024 + ch), cbx = *(const f32x4*)(bx + dir * 1024 + ch), csp = *(const f32x4*)(spl + dir * 1024 + ch);
        const u32x2 xw = *(const u32x2*)(XC + (size_t)row * D + ch); const float xc[4] = {bflo(xw.x), bfhi(xw.x), bflo(xw.y), bfhi(xw.y)};
        float la[4], bb[4];
#pragma unroll
        for (int j = 0; j < 4; ++j) { const float l2 = -csp[j] * sigmoidf_(za[j] + cba[j]); const float a2 = fast_exp2(2.0f * l2);
            const float mult = (dir == 0 && fr == 0) ? 1.0f : __builtin_amdgcn_sqrtf(fmaxf(1.0f - a2, 0.0f)); la[j] = l2; bb[j] = mult * sigmoidf_(zx[j] + cbx[j]) * xc[j]; }
        const size_t o = (((size_t)dir * 32 + (ch >> 5)) * MPAD + row) * 32 + (ch & 31);
        u32x2 w; w.x = cvt_pk_bf16(la[0], la[1]); w.y = cvt_pk_bf16(la[2], la[3]); *(u32x2*)(LA + o) = w;
        w.x = cvt_pk_bf16(bb[0], bb[1]); w.y = cvt_pk_bf16(bb[2], bb[3]); *(u32x2*)(BB + o) = w; }
}
__device__ __forceinline__ void mini_lout(const Ctx& C) {
    PHASE_IDS
    const bf16_t* G = (const bf16_t*)(C.ws + WS_G); const bf16_t* WT = (const bf16_t*)(C.ws + WS_LOUT); bf16_t* PRE = (bf16_t*)(C.ws + WS_PRE); const float* meta = C.in[I_META];
    const int fr = lane & 15, fq = lane >> 4;
    for (int wt = C.gc * NWAVES + wave; wt < 8 * 64; wt += C.G * NWAVES) { const int rg = wt & 7, cb = wt >> 3, row = NGRID + 16 * rg + fr, c = 16 * cb + 4 * fq;
        const f32x4 a = mini_mma<1024>(WT + (size_t)(16 * cb) * 1024, 1024, G + (size_t)(NGRID + 16 * rg) * 1024, 1024, lane);
        const f32x4 r = *(const f32x4*)(meta + (size_t)fr * D + c);
        u32x2 w; w.x = cvt_pk_bf16(r[0] * DN_ALPHA + a[0], r[1] * DN_ALPHA + a[1]); w.y = cvt_pk_bf16(r[2] * DN_ALPHA + a[2], r[3] * DN_ALPHA + a[3]); *(u32x2*)(PRE + (size_t)row * D + c) = w; }
}
__device__ __forceinline__ void mini_kv(const Ctx& C) {
    PHASE_IDS
    const bf16_t* HB = (const bf16_t*)(C.ws + WS_HB); const bf16_t* WT = (const bf16_t*)(C.ws + WS_QKV); bf16_t* Kx = (bf16_t*)(C.ws + WS_K); bf16_t* VT = (bf16_t*)(C.ws + WS_VT);
    const int fr = lane & 15, fq = lane >> 4;
    for (int wt = C.gc * NWAVES + wave; wt < 2 * 8 * 64; wt += C.G * NWAVES) { const int rg = wt & 7, cb = (wt >> 3) & 63, isv = wt >> 9;
        const bf16_t* A = HB + (size_t)(NGRID + 16 * rg) * 1024;
        if (!isv) { const f32x4 a = mini_mma<1024>(WT + (size_t)(1024 + 16 * cb) * 1024, 1024, A, 1024, lane);
            u32x2 w; w.x = cvt_pk_bf16(a[0], a[1]); w.y = cvt_pk_bf16(a[2], a[3]); *(u32x2*)(Kx + (size_t)(NGRID + 16 * rg + fr) * D + 16 * cb + 4 * fq) = w; }
        else { const f32x4 a = mini_mma<1024>(A, 1024, WT + (size_t)(2048 + 16 * cb) * 1024, 1024, lane);
            u32x2 w; w.x = cvt_pk_bf16(a[0], a[1]); w.y = cvt_pk_bf16(a[2], a[3]); *(u32x2*)(VT + (size_t)(16 * cb + fr) * MPAD + NGRID + 16 * rg + 4 * fq) = w; } }
}

constexpr int RWT_PITCH = 516;
__device__ __forceinline__ void phase_lnr(const Ctx& C, int layer, int nrows) {
    PHASE_IDS
    const bf16_t* PRE = (const bf16_t*)(wsl + WS_PRE); bf16_t* HB = (bf16_t*)(wsl + WS_HB); unsigned char* HB8 = wsl + WS_HB8;
    const float* lg = C.in[I_LNMG] + layer * D; const float* lb = C.in[I_LNMB] + layer * D;
    const float* rw = C.in[I_RW] + (size_t)layer * D * NEXP; const float* rb = C.in[I_RB] + layer * NEXP;
    int* eid = (int*)(wsl + WS_CTL + CT_EID) + (size_t)layer * NTOK * 4; float* gatev = (float*)(wsl + WS_CTL + CT_GATEV) + (size_t)layer * NTOK * 4;
    unsigned* bc = (unsigned*)(wsl + WS_CTL + CT_BC) + ((size_t)layer * 256 + C.bid) * 32;
    LAS unsigned* RWt = (LAS unsigned*)C.lds; LAS unsigned* hist = (LAS unsigned*)(C.lds + 32 * RWT_PITCH * 4);
#pragma unroll
    for (int i = 0; i < 8; ++i) { const int idx = tid + NTHREADS * i, pc = idx >> 3, e4 = (idx & 7) * 4, ch = 2 * pc;
        const f32x4 w0 = *(const f32x4*)(rw + (size_t)ch * NEXP + e4), w1 = *(const f32x4*)(rw + (size_t)(ch + 1) * NEXP + e4);
        const int slot = 4 * ((ch & 511) >> 3) + 256 * (ch >> 9) + ((ch & 7) >> 1);
        RWt[(e4 + 0) * RWT_PITCH + slot] = pk2(w0[0], w1[0]); RWt[(e4 + 1) * RWT_PITCH + slot] = pk2(w0[1], w1[1]); RWt[(e4 + 2) * RWT_PITCH + slot] = pk2(w0[2], w1[2]); RWt[(e4 + 3) * RWT_PITCH + slot] = pk2(w0[3], w1[3]); }
    if (tid < 32) hist[tid] = 0u;
    __syncthreads();
    float gg[2][8], gb[2][8];
#pragma unroll
    for (int j = 0; j < 2; ++j) { const f32x4 a0 = *(const f32x4*)(lg + 8 * lane + 512 * j), a1 = *(const f32x4*)(lg + 8 * lane + 512 * j + 4), b0 = *(const f32x4*)(lb + 8 * lane + 512 * j), b1 = *(const f32x4*)(lb + 8 * lane + 512 * j + 4);
#pragma unroll
        for (int i = 0; i < 4; ++i) { gg[j][i] = a0[i]; gg[j][4 + i] = a1[i]; gb[j][i] = b0[i]; gb[j][4 + i] = b1[i]; } }
    const float rbias = rb[lane >> 1];
    const int gw = C.bid * NWAVES + wave, NGW = C.G * NWAVES;
    u32x4 nv[2];
    if (gw < nrows) {
#pragma unroll
        for (int j = 0; j < 2; ++j) nv[j] = __builtin_nontemporal_load((const u32x4*)(PRE + (size_t)gw * D + 8 * lane + 512 * j)); }
    for (int row = gw; row < nrows; row += NGW) {
        float v[2][8]; float s = 0.f; u32x4 hp[2];
#pragma unroll
        for (int j = 0; j < 2; ++j) { unpack8(nv[j], v[j]); s += ((v[j][0] + v[j][1]) + (v[j][2] + v[j][3])) + ((v[j][4] + v[j][5]) + (v[j][6] + v[j][7])); }
        if (row + NGW < nrows) {
#pragma unroll
            for (int j = 0; j < 2; ++j) nv[j] = __builtin_nontemporal_load((const u32x4*)(PRE + (size_t)(row + NGW) * D + 8 * lane + 512 * j)); }
        const float mean = wave_sum_dpp(s) * (1.0f / D); float q = 0.f;
#pragma unroll
        for (int j = 0; j < 2; ++j)
#pragma unroll
            for (int i = 0; i < 8; ++i) { v[j][i] -= mean; q += v[j][i] * v[j][i]; }
        const float rstd = __builtin_amdgcn_rsqf(wave_sum_dpp(q) * (1.0f / D) + LN_EPS);
#pragma unroll
        for (int j = 0; j < 2; ++j) {
#pragma unroll
            for (int i = 0; i < 8; ++i) v[j][i] = v[j][i] * rstd * gg[j][i] + gb[j][i];
            u32x4 w; w.x = pk2(v[j][0], v[j][1]); w.y = pk2(v[j][2], v[j][3]); w.z = pk2(v[j][4], v[j][5]); w.w = pk2(v[j][6], v[j][7]);
            *(u32x4*)(HB + (size_t)row * D + 8 * lane + 512 * j) = w; hp[j] = w;
            u32x2 w8; w8.x = pk4_fp8(v[j][0], v[j][1], v[j][2], v[j][3]); w8.y = pk4_fp8(v[j][4], v[j][5], v[j][6], v[j][7]);
            *(u32x2*)(HB8 + (size_t)row * D + 8 * lane + 512 * j) = w8; }
        float pl[32];
#pragma unroll
        for (int e0 = 0; e0 < 32; e0 += 8) {
            u32x4 wv[8][2];
#pragma unroll
            for (int ee = 0; ee < 8; ++ee)
#pragma unroll
                for (int j = 0; j < 2; ++j) wv[ee][j] = *(const LAS u32x4*)(RWt + (e0 + ee) * RWT_PITCH + 4 * lane + 256 * j);
            __builtin_amdgcn_sched_barrier(0);
#pragma unroll
            for (int ee = 0; ee < 8; ++ee) { float a = 0.f;
#pragma unroll
                for (int j = 0; j < 2; ++j) { a = dot2_bf16(hp[j].x, wv[ee][j].x, a);
                    a = dot2_bf16(hp[j].y, wv[ee][j].y, a);
                    a = dot2_bf16(hp[j].z, wv[ee][j].z, a);
                    a = dot2_bf16(hp[j].w, wv[ee][j].w, a); }
                pl[e0 + ee] = a; }
        }
        float q16[16], q8[8], q4[4], q2[2], q1;
        { const bool hi = (lane & 32) != 0;
#pragma unroll
          for (int e = 0; e < 16; ++e) { const float mine = hi ? pl[16 + e] : pl[e], other = hi ? pl[e] : pl[16 + e]; q16[e] = mine + __shfl_xor(other, 32); } }
        { const bool hi = (lane & 16) != 0;
#pragma unroll
          for (int e = 0; e < 8; ++e) { const float mine = hi ? q16[8 + e] : q16[e], other = hi ? q16[e] : q16[8 + e]; q8[e] = mine + __shfl_xor(other, 16); } }
        { const bool hi = (lane & 8) != 0;
#pragma unroll
          for (int e = 0; e < 4; ++e) { const float mine = hi ? q8[4 + e] : q8[e], other = hi ? q8[e] : q8[4 + e]; q4[e] = mine + dpp_movf<0x128>(other); } }
        { const bool hi = (lane & 4) != 0;
#pragma unroll
          for (int e = 0; e < 2; ++e) { const float mine = hi ? q4[2 + e] : q4[e], other = hi ? q4[e] : q4[2 + e]; q2[e] = mine + __shfl_xor(other, 4); } }
        { const bool hi = (lane & 2) != 0; const float mine = hi ? q2[1] : q2[0], other = hi ? q2[0] : q2[1]; q1 = mine + dpp_movf<0x4E>(other); }
        q1 += dpp_movf<0xB1>(q1);
        float lv = q1 + rbias; lv = (lv == lv) ? lv : -3.0e38f;
        const int le = lane >> 1;
        int rank = 0;
#pragma unroll
        for (int j = 0; j < 32; ++j) { const float lj = readlane_f(lv, 2 * j); rank += (lj > lv || (lj == lv && j < le)) ? 1 : 0; }
        const unsigned long long m0 = __ballot(rank == 0);
        const float mxl = readlane_f(lv, (int)__builtin_ctzll(m0));
        const float pe = rank < 4 ? __expf(lv - mxl) : 0.f;
        const float den = wave_sum_dpp(pe) * 0.5f;
        if (rank < 4 && (lane & 1) == 0) { eid[(size_t)row * 4 + rank] = le; gatev[(size_t)row * 4 + rank] = pe / den;
            __hip_atomic_fetch_add(&hist[le], 1u, __ATOMIC_RELAXED, __HIP_MEMORY_SCOPE_WORKGROUP); }
    }
    __syncthreads();
    if (tid < 32) bc[tid] = hist[tid];
}

__device__ __forceinline__ void phase_pos(const Ctx& C, int layer, int nrows) {
    PHASE_IDS
    const unsigned* bcAll = (const unsigned*)(wsl + WS_CTL + CT_BC) + (size_t)layer * 256 * 32;
    const int* eid = (const int*)(wsl + WS_CTL + CT_EID) + (size_t)layer * NTOK * 4; int* posv = (int*)(wsl + WS_CTL + CT_POS) + (size_t)layer * NTOK * 4;
    int* texp = (int*)(wsl + WS_CTL + CT_TEXP) + layer * 1024;
    int* tokoff = (int*)(wsl + WS_TOK) + (size_t)layer * (1 * MiB / 4);
    LAS unsigned* partT = (LAS unsigned*)C.lds; LAS unsigned* partP = partT + 512; LAS unsigned* tot = partP + 512; LAS unsigned* cnt = tot + 32;
    { const int e = tid & 31, part = tid >> 5; unsigned t = 0, pr = 0;
      unsigned vv[16];
#pragma unroll
      for (int i = 0; i < 16; ++i) { const int bq = part + 16 * i; vv[i] = bq < C.G ? bcAll[(size_t)bq * 32 + e] : 0u; }
#pragma unroll
      for (int i = 0; i < 16; ++i) { const int bq = part + 16 * i; t += vv[i]; if (bq < C.bid) pr += vv[i]; }
      partT[part * 32 + e] = t; partP[part * 32 + e] = pr; }
    __syncthreads();
    if (tid < 32) { unsigned t = 0, pr = 0; for (int i = 0; i < 16; ++i) { t += partT[i * 32 + tid]; pr += partP[i * 32 + tid]; } tot[tid] = t; cnt[tid] = pr; }
    __syncthreads();
    if (tid < 32) { unsigned off = 0; for (int e = 0; e < tid; ++e) off += (tot[e] + 255u) & ~255u;
        const unsigned mine = (tot[tid] + 255u) & ~255u;
        if (C.bid == 0) { for (unsigned t = off >> 8; t < ((off + mine) >> 8); ++t) texp[t] = tid; if (tid == 31) texp[1023] = (int)((off + mine) >> 8);
            for (unsigned p = off + tot[tid]; p < off + mine; ++p) tokoff[p] = 0; }
        cnt[tid] += off; }
    __syncthreads();
    const int gw = C.bid * NWAVES + wave, NGW = C.G * NWAVES;
    for (int row = gw; row < nrows; row += NGW) {
        int pos = 0;
        if (lane < 4) { const int e = eid[(size_t)row * 4 + lane]; pos = (int)__hip_atomic_fetch_add(&cnt[e], 1u, __ATOMIC_RELAXED, __HIP_MEMORY_SCOPE_WORKGROUP); posv[(size_t)row * 4 + lane] = pos; }
        if (lane < 4) tokoff[pos] = row * 1024;
    }
}

__device__ __forceinline__ void phase_combine(const Ctx& C, int layer, int nrows, bool final_out) {
    PHASE_IDS
    bf16_t* HB = (bf16_t*)(wsl + WS_HB); unsigned char* HB8 = wsl + WS_HB8; const unsigned char* YS = wsl + WS_YS;
    const float* lg = C.in[I_LNFG] + layer * D; const float* lb = C.in[I_LNFB] + layer * D;
    const float* gatev = (const float*)(wsl + WS_CTL + CT_GATEV) + (size_t)layer * NTOK * 4; const int* posv = (const int*)(wsl + WS_CTL + CT_POS) + (size_t)layer * NTOK * 4;
    float gg[2][8], gb[2][8];
#pragma unroll
    for (int j = 0; j < 2; ++j) { const f32x4 a0 = *(const f32x4*)(lg + 8 * lane + 512 * j), a1 = *(const f32x4*)(lg + 8 * lane + 512 * j + 4), b0 = *(const f32x4*)(lb + 8 * lane + 512 * j), b1 = *(const f32x4*)(lb + 8 * lane + 512 * j + 4);
#pragma unroll
        for (int i = 0; i < 4; ++i) { gg[j][i] = a0[i]; gg[j][4 + i] = a1[i]; gb[j][i] = b0[i]; gb[j][4 + i] = b1[i]; } }
    const int gw = C.bid * NWAVES + wave, NGW = C.G * NWAVES;
    f32x4 g1 = {0.f, 0.f, 0.f, 0.f}, g2 = g1; int p1[4] = {0, 0, 0, 0}, p2[4] = {0, 0, 0, 0};
    u32x4 hwn[2]; u32x2 ywn[4][2];
#define CB_ROUTE(row_, gq, pq) do { gq = *(const f32x4*)(gatev + (size_t)(row_) * 4); const u32x4 _pp = *(const u32x4*)(posv + (size_t)(row_) * 4); pq[0] = (int)_pp.x; pq[1] = (int)_pp.y; pq[2] = (int)_pp.z; pq[3] = (int)_pp.w; } while (0)
#define CB_DATA(row_, pq) do { _Pragma("unroll") for (int j = 0; j < 2; ++j) { hwn[j] = *(const u32x4*)(HB + (size_t)(row_) * D + 8 * lane + 512 * j); \
            _Pragma("unroll") for (int k = 0; k < 4; ++k) ywn[k][j] = __builtin_nontemporal_load((const u32x2*)(YS + (size_t)pq[k] * D + 8 * lane + 512 * j)); } } while (0)
    if (gw < nrows) { CB_ROUTE(gw, g1, p1); CB_DATA(gw, p1); }
    if (gw + NGW < nrows) CB_ROUTE(gw + NGW, g2, p2);
    for (int row = gw; row < nrows; row += NGW) {
        const f32x4 gk4 = g1 * 0.125f; u32x4 hw[2]; u32x2 yw[4][2];
#pragma unroll
        for (int j = 0; j < 2; ++j) { hw[j] = hwn[j];
#pragma unroll
            for (int k = 0; k < 4; ++k) yw[k][j] = ywn[k][j]; }
        g1 = g2;
#pragma unroll
        for (int k = 0; k < 4; ++k) p1[k] = p2[k];
        if (row + NGW < nrows) CB_DATA(row + NGW, p1);
        if (row + 2 * NGW < nrows) CB_ROUTE(row + 2 * NGW, g2, p2);
        float v[2][8]; float s = 0.f;
#pragma unroll
        for (int j = 0; j < 2; ++j) { float h[8]; unpack8(hw[j], h);
#pragma unroll
            for (int i = 0; i < 8; ++i) v[j][i] = h[i] * DN_ALPHA;
#pragma unroll
            for (int k = 0; k < 4; ++k) { float y[8]; unpack8_fp8(yw[k][j], y);
#pragma unroll
                for (int i = 0; i < 8; ++i) v[j][i] += gk4[k] * y[i]; }
#pragma unroll
            for (int i = 0; i < 8; ++i) s += v[j][i]; }
        const float mean = wave_sum_dpp(s) * (1.0f / D); float q = 0.f;
#pragma unroll
        for (int j = 0; j < 2; ++j)
#pragma unroll
            for (int i = 0; i < 8; ++i) { v[j][i] -= mean; q += v[j][i] * v[j][i]; }
        const float rstd = __builtin_amdgcn_rsqf(wave_sum_dpp(q) * (1.0f / D) + LN_EPS);
#pragma unroll
        for (int j = 0; j < 2; ++j) {
#pragma unroll
            for (int i = 0; i < 8; ++i) v[j][i] = v[j][i] * rstd * gg[j][i] + gb[j][i];
            if (final_out) { *(f32x4*)(C.out + (size_t)row * D + 8 * lane + 512 * j) = (f32x4){v[j][0], v[j][1], v[j][2], v[j][3]}; *(f32x4*)(C.out + (size_t)row * D + 8 * lane + 512 * j + 4) = (f32x4){v[j][4], v[j][5], v[j][6], v[j][7]}; }
            else { u32x4 w; w.x = pk2(v[j][0], v[j][1]); w.y = pk2(v[j][2], v[j][3]); w.z = pk2(v[j][4], v[j][5]); w.w = pk2(v[j][6], v[j][7]); *(u32x4*)(HB + (size_t)row * D + 8 * lane + 512 * j) = w;
                u32x2 w8; w8.x = pk4_fp8(v[j][0], v[j][1], v[j][2], v[j][3]); w8.y = pk4_fp8(v[j][4], v[j][5], v[j][6], v[j][7]); *(u32x2*)(HB8 + (size_t)row * D + 8 * lane + 512 * j) = w8; } }
    }
#undef CB_ROUTE
#undef CB_DATA
}

constexpr int AT_KS = 0, AT_VTS = 73728, AT_VPITCH = 1168, AT_KM = AT_VTS + 64 * AT_VPITCH, AT_VTM = AT_KM + 2048, AT_RPB = AT_VTM + 2048, AT_MB = AT_RPB + 1920, AT_END = AT_MB + 64;
static_assert(AT_END <= LDS_BYTES, "attention LDS map");
__device__ __forceinline__ void phase_attn(const Ctx& C) {
    PHASE_IDS
    bf16_t* O = (bf16_t*)(wsl + WS_O);
    const float* rpb = C.in[I_RPB]; const float* mbias = C.in[I_MBIAS];
    LAS unsigned char* lds = C.lds;
    const int w = wave, lq = lane & 15, g = lane >> 4;
    const int qr = w >> 2, qg = w & 3, c0 = 16 * qg, kcb = qg == 0 ? 0 : (qg == 1 ? 8 : (qg == 2 ? 24 : 32));
    int bidx[2][4];
    { const int c_ = c0 + lq, cs_ = min(max(c_ - 8, 0), 48);
#pragma unroll
      for (int blk = 0; blk < 2; ++blk)
#pragma unroll
          for (int e = 0; e < 4; ++e) { const int kc = kcb + 16 * blk + 4 * g + e; bidx[blk][e] = ((kc >= cs_ && kc < cs_ + 16) ? (kc - c_ + 15) : 31) * 4; } }
    const __amdgpu_buffer_rsrc_t rsrc = __builtin_amdgcn_make_buffer_rsrc((void*)wsl, 0, 0xFFFFFFFF, 0x00020000);
    const int kvoff = (((tid >> 3) & 63) * D + 8 * (tid & 7)) * 2, vvoff = ((tid >> 3) * MPAD + 8 * (tid & 7)) * 2;
    const int qvoff = (lq * D + 8 * g) * 2;
    const int mvoff = tid < 128 ? ((tid >> 3) * D + 8 * (tid & 7)) * 2 : (((tid - 128) >> 1) * MPAD + 8 * ((tid - 128) & 1)) * 2;
    const int klds = AT_KS + ((((tid >> 3) & 63)) * 8 + ((tid & 7) ^ ((tid >> 3) & 7))) * 16;
    const int vlds = AT_VTS + (tid >> 3) * AT_VPITCH + (tid & 7) * 16;
    for (int su = (C.G == 256 ? C.gc : C.bid); su < 256; su += C.G) {
        int bh, strip; if (C.G == 256) { bh = (su & 7) * 16 + (su >> 4); strip = (su >> 3) & 1; } else { bh = su >> 1; strip = su & 1; }
        const int b = bh >> 4, h = bh & 15, rp0 = strip * 16;
        const unsigned kbase = (unsigned)WS_K + (unsigned)((b * SEQ) * D + 64 * h) * 2u, vbase = (unsigned)WS_VT + (unsigned)((64 * h) * MPAD + b * SEQ) * 2u;
        const unsigned qbase = (unsigned)WS_Q + (unsigned)((b * SEQ + qr * 64 + c0) * D + 64 * h) * 2u;
        int R0 = min(max(2 * rp0 - 4, 0), 55);
        __syncthreads();
        {
            u32x4 kreg[9], vreg[9];
#pragma unroll
            for (int i = 0; i < 9; ++i) { kreg[i] = __builtin_amdgcn_raw_buffer_load_b128(rsrc, kvoff, (int)(kbase + (unsigned)(R0 + i) * 64u * D * 2u), 0);
                vreg[i] = __builtin_amdgcn_raw_buffer_load_b128(rsrc, vvoff, (int)(vbase + (unsigned)(R0 + i) * 128u), 0); }
            u32x4 mreg = {0u, 0u, 0u, 0u};
            if (tid < 256) mreg = __builtin_amdgcn_raw_buffer_load_b128(rsrc, mvoff, (int)(tid < 128 ? (unsigned)WS_K + (unsigned)((NGRID + 16 * b) * D + 64 * h) * 2u : (unsigned)WS_VT + (unsigned)((64 * h) * MPAD + NGRID + 16 * b) * 2u), 0);
            float rpreg = 0.f, mbreg = 0.f;
            if (tid < 480) rpreg = (tid & 31) < 31 ? rpb[h * 465 + (tid >> 5) * 31 + (tid & 31)] * 1.44269504089f : -1.0e30f;
            if (tid < 16) mbreg = mbias[h * 16 + tid] * 1.44269504089f;
#pragma unroll
            for (int i = 0; i < 9; ++i) { const int slot = (R0 + i) % 9; *(LAS u32x4*)(lds + klds + slot * 8192) = kreg[i]; *(LAS u32x4*)(lds + vlds + slot * 128) = vreg[i]; }
            if (tid < 128) { const int m = tid >> 3, ch = tid & 7; *(LAS u32x4*)(lds + AT_KM + (m * 8 + (ch ^ (m & 7))) * 16) = mreg; }
            else if (tid < 256) { const int i = tid - 128, d = i >> 1, hf = i & 1; *(LAS u32x4*)(lds + AT_VTM + d * 32 + hf * 16) = mreg; }
            if (tid < 480) ((LAS float*)(lds + AT_RPB))[tid] = rpreg;
            if (tid < 16) ((LAS float*)(lds + AT_MB))[tid] = mbreg;
        }
        u32x4 qreg[2];
        qreg[0] = __builtin_amdgcn_raw_buffer_load_b128(rsrc, qvoff, (int)(qbase + (unsigned)(2 * rp0) * 64u * D * 2u), 0);
        qreg[1] = __builtin_amdgcn_raw_buffer_load_b128(rsrc, qvoff, (int)(qbase + (unsigned)(2 * rp0) * 64u * D * 2u + 64u), 0);
        __syncthreads();
        for (int rp = rp0; rp < rp0 + 16; ++rp) {
            const int R0n = rp + 1 < rp0 + 16 ? min(max(2 * (rp + 1) - 4, 0), 55) : R0, nnew = R0n - R0;
            const u32x4 qcur[2] = {qreg[0], qreg[1]};
            u32x4 nk[2], nv[2];
#pragma unroll
            for (int i = 0; i < 2; ++i) if (i < nnew) { nk[i] = __builtin_amdgcn_raw_buffer_load_b128(rsrc, kvoff, (int)(kbase + (unsigned)(R0 + 9 + i) * 64u * D * 2u), 0);
                nv[i] = __builtin_amdgcn_raw_buffer_load_b128(rsrc, vvoff, (int)(vbase + (unsigned)(R0 + 9 + i) * 128u), 0); }
            if (rp + 1 < rp0 + 16) { qreg[0] = __builtin_amdgcn_raw_buffer_load_b128(rsrc, qvoff, (int)(qbase + (unsigned)(2 * rp + 2) * 64u * D * 2u), 0);
                qreg[1] = __builtin_amdgcn_raw_buffer_load_b128(rsrc, qvoff, (int)(qbase + (unsigned)(2 * rp + 2) * 64u * D * 2u + 64u), 0); }
            const int r = 2 * rp + qr;
            const int rs = min(max(r - 4, 0), 56), s0 = rs % 9;
            const size_t qrow = (size_t)(b * SEQ + r * 64 + c0 + lq);
            bf16x8 qf[2]; qf[0] = __builtin_bit_cast(bf16x8, qcur[0]); qf[1] = __builtin_bit_cast(bf16x8, qcur[1]);
            f32x4 sc[8][2], sm;
#pragma unroll
            for (int j = 0; j < 8; ++j) { const int slot = s0 + j - (s0 + j >= 9 ? 9 : 0);
#pragma unroll
                for (int blk = 0; blk < 2; ++blk) { f32x4 a = {0.f, 0.f, 0.f, 0.f}; const int kc = kcb + 16 * blk + lq;
#pragma unroll
                    for (int ks = 0; ks < 2; ++ks) { const bf16x8 kf = *(const LAS bf16x8*)(lds + AT_KS + slot * 8192 + (kc * 8 + ((4 * ks + g) ^ (kc & 7))) * 16);
                        a = __builtin_amdgcn_mfma_f32_16x16x32_bf16(kf, qf[ks], a, 0, 0, 0); }
                    sc[j][blk] = a; } }
            { f32x4 a = {0.f, 0.f, 0.f, 0.f};
#pragma unroll
              for (int ks = 0; ks < 2; ++ks) { const bf16x8 kf = *(const LAS bf16x8*)(lds + AT_KM + (lq * 8 + ((4 * ks + g) ^ (lq & 7))) * 16);
                  a = __builtin_amdgcn_mfma_f32_16x16x32_bf16(kf, qf[ks], a, 0, 0, 0); }
              sm = a; }
            const LAS unsigned char* RProw = lds + AT_RPB + (rs - r + 7) * 128; const LAS float* MB = (const LAS float*)(lds + AT_MB);
            float mx = -3.0e38f;
#pragma unroll
            for (int j = 0; j < 8; ++j)
#pragma unroll
                for (int blk = 0; blk < 2; ++blk)
#pragma unroll
                    for (int e = 0; e < 4; ++e) { const float sv = sc[j][blk][e] + *(const LAS float*)(RProw + j * 128 + bidx[blk][e]); sc[j][blk][e] = sv; mx = fmaxf(mx, sv); }
#pragma unroll
            for (int e = 0; e < 4; ++e) { sm[e] += MB[4 * g + e]; mx = fmaxf(mx, sm[e]); }
            mx = fmaxf(mx, __shfl_xor(mx, 16)); mx = fmaxf(mx, __shfl_xor(mx, 32));
            float sum = 0.f;
#pragma unroll
            for (int j = 0; j < 8; ++j)
#pragma unroll
                for (int blk = 0; blk < 2; ++blk)
#pragma unroll
                    for (int e = 0; e < 4; ++e) { const float pv = fast_exp2(sc[j][blk][e] - mx); sc[j][blk][e] = pv; sum += pv; }
#pragma unroll
            for (int e = 0; e < 4; ++e) { const float pv = fast_exp2(sm[e] - mx); sm[e] = pv; sum += pv; }
            sum += __shfl_xor(sum, 16); sum += __shfl_xor(sum, 32);
            f32x4 o[4];
#pragma unroll
            for (int db = 0; db < 4; ++db) o[db] = (f32x4){0.f, 0.f, 0.f, 0.f};
#pragma unroll
            for (int j = 0; j < 8; ++j) { const int slot = s0 + j - (s0 + j >= 9 ? 9 : 0);
                u32x4 pw; pw.x = cvt_pk_bf16(sc[j][0][0], sc[j][0][1]); pw.y = cvt_pk_bf16(sc[j][0][2], sc[j][0][3]); pw.z = cvt_pk_bf16(sc[j][1][0], sc[j][1][1]); pw.w = cvt_pk_bf16(sc[j][1][2], sc[j][1][3]);
                const bf16x8 pb = __builtin_bit_cast(bf16x8, pw);
#pragma unroll
                for (int db = 0; db < 4; ++db) { const int d = 16 * db + lq; const LAS unsigned char* vp = lds + AT_VTS + d * AT_VPITCH + (slot * 64 + kcb + 4 * g) * 2;
                    const u32x2 lo = *(const LAS u32x2*)vp, hi = *(const LAS u32x2*)(vp + 32);
                    u32x4 aw; aw.x = lo.x; aw.y = lo.y; aw.z = hi.x; aw.w = hi.y;
                    o[db] = __builtin_amdgcn_mfma_f32_16x16x32_bf16(__builtin_bit_cast(bf16x8, aw), pb, o[db], 0, 0, 0); }
            }
            { u32x4 pw; pw.x = cvt_pk_bf16(sm[0], sm[1]); pw.y = cvt_pk_bf16(sm[2], sm[3]); pw.z = 0u; pw.w = 0u; const bf16x8 pb = __builtin_bit_cast(bf16x8, pw);
#pragma unroll
              for (int db = 0; db < 4; ++db) { const int d = 16 * db + lq; const u32x2 lo = *(const LAS u32x2*)(lds + AT_VTM + d * 32 + 8 * g);
                  u32x4 aw; aw.x = lo.x; aw.y = lo.y; aw.z = 0u; aw.w = 0u;
                  o[db] = __builtin_amdgcn_mfma_f32_16x16x32_bf16(__builtin_bit_cast(bf16x8, aw), pb, o[db], 0, 0, 0); } }
            const float inv = 1.0f / sum;
#pragma unroll
            for (int db = 0; db < 4; ++db) { u32x2 ow; ow.x = cvt_pk_bf16(o[db][0] * inv, o[db][1] * inv); ow.y = cvt_pk_bf16(o[db][2] * inv, o[db][3] * inv);
                *(u32x2*)(O + qrow * D + 64 * h + 16 * db + 4 * g) = ow; }
            __syncthreads();
#pragma unroll
            for (int i = 0; i < 2; ++i) if (i < nnew) { const int slot = (R0 + 9 + i) % 9; *(LAS u32x4*)(lds + klds + slot * 8192) = nk[i]; *(LAS u32x4*)(lds + vlds + slot * 128) = nv[i]; }
            R0 = R0n;
            __syncthreads();
        }
    }
}
#define XB_TMO      128
#define XB_XCNT(j)  (256  + 64 * (j))
#define XB_XSUB(j)  (1280 + 64 * (j))
#define XB_XGEN(j)  (2304 + 64 * (j))
#define XB_TOP      3328
#define XB_TOPGEN   3392
#define XCD_BAR_WORDS 3456
#define XB_SPIN_CAP (1u << 22)
__device__ __forceinline__ unsigned xb_ld(unsigned* p)              { return __hip_atomic_load(p, __ATOMIC_RELAXED, __HIP_MEMORY_SCOPE_AGENT); }
__device__ __forceinline__ unsigned xb_add(unsigned* p, unsigned v) { return __hip_atomic_fetch_add(p, v, __ATOMIC_RELAXED, __HIP_MEMORY_SCOPE_AGENT); }
__device__ __forceinline__ unsigned xb_xcc_id() { return (unsigned)__builtin_amdgcn_s_getreg((3 << 11) | 20) & 0xFu; }
#define XB_SPIN(cond, bar) do { unsigned _sp = 0; while (cond) { __builtin_amdgcn_s_sleep(1); \
    if ((++_sp & 255u) == 0u) { if (xb_ld(&(bar)[XB_TMO])) break; if (_sp > XB_SPIN_CAP) { atomicAdd(&(bar)[XB_TMO], 1u); break; } } } } while (0)
struct XcdBarrier { unsigned* bar; unsigned x; volatile LAS unsigned* st; };
__device__ __forceinline__ XcdBarrier xcd_barrier_post(unsigned* bar, volatile LAS unsigned* st) {
    XcdBarrier b; b.bar = bar; b.x = xb_xcc_id(); b.st = st;
    if (threadIdx.x == 0) st[2] = xb_add(&bar[XB_XCNT(b.x)], 1u);
    return b;
}
__device__ __forceinline__ void xcd_barrier_complete(unsigned* bar, unsigned x, unsigned& nloc, unsigned& nx) {
    const unsigned G = gridDim.x * gridDim.y * gridDim.z;
    unsigned sum, cnt, mine, sp = 0u;
    for (;;) {
        sum = 0u; cnt = 0u; mine = 0u;
#pragma unroll
        for (unsigned j = 0; j < 16; ++j) { const unsigned c = xb_ld(&bar[XB_XCNT(j)]); sum += c; cnt += (c > 0u) ? 1u : 0u; mine = (j == x) ? c : mine; }
        if (sum == G) break;
        __builtin_amdgcn_s_sleep(1);
        if ((++sp & 255u) == 0u) { if (xb_ld(&bar[XB_TMO])) break; if (sp > XB_SPIN_CAP) { atomicAdd(&bar[XB_TMO], 1u); break; } }
    }
    nloc = mine > 0u ? mine : 1u; nx = cnt > 0u ? cnt : 1u;
}
__device__ __forceinline__ void xcd_barrier(const XcdBarrier& b) {
    asm volatile("s_waitcnt vmcnt(0)" ::: "memory");
    __syncthreads();
    if (threadIdx.x == 0) {
        unsigned* bar = b.bar;
        __builtin_amdgcn_s_waitcnt(0);
        unsigned nloc = b.st[0], nx = b.st[1];
        if (nloc == 0u) { xcd_barrier_complete(bar, b.x, nloc, nx); b.st[0] = nloc; b.st[1] = nx; }
        const unsigned old = xb_add(&bar[XB_XSUB(b.x)], 1u);
        const unsigned gen = old / nloc;
        if (old + 1u == (gen + 1u) * nloc) {
            __builtin_amdgcn_fence(__ATOMIC_RELEASE, "agent");
            asm volatile("s_waitcnt vmcnt(0)" ::: "memory");
            const unsigned og = xb_add(&bar[XB_TOP], 1u);
            const unsigned tg = og / nx;
            if (og + 1u == (tg + 1u) * nx) xb_add(&bar[XB_TOPGEN], 1u);
            else XB_SPIN(xb_ld(&bar[XB_TOPGEN]) == tg, bar);
            __builtin_amdgcn_fence(__ATOMIC_ACQUIRE, "agent");
            xb_add(&bar[XB_XGEN(b.x)], 1u);
            asm volatile("s_waitcnt vmcnt(0)" ::: "memory");
        } else {
            XB_SPIN(xb_ld(&bar[XB_XGEN(b.x)]) == gen, bar);
            __builtin_amdgcn_fence(__ATOMIC_ACQUIRE, "agent");
            asm volatile("s_waitcnt vmcnt(0)" ::: "memory");
        }
    }
    __syncthreads();
}
__device__ __forceinline__ int moe_prep(const Ctx& C, const int* texp) {
    LAS int* t = (LAS int*)(C.lds + pg8::TEXP_OFF); const int tid = fresh_tid();
    const int a = texp[tid], b = texp[tid + 512];
    t[tid] = a; t[tid + 512] = b;
    __syncthreads();
    return __builtin_amdgcn_readfirstlane(t[1023]);
}
constexpr size_t CT_BAR = 131072;
constexpr int LDS_BARST = LDS_BYTES - 64;

constexpr int N_PHASES = 20;
__global__ void __launch_bounds__(NTHREADS, 2) hybrid_fwd(Params P) {
    extern __shared__ __attribute__((aligned(16))) unsigned char smem[];
    cg::grid_group grid = cg::this_grid();
    Ctx C; C.lds = (LAS unsigned char*)smem; C.G = gridDim.x; C.bid = blockIdx.x;
    C.ws = P.ws; C.in = P.in; C.out = P.out;
    unsigned char* const ws0 = P.ws;
#define ws fresh_ws(ws0)
    const int lo = P.ph_lo, hi = P.ph_hi;
#ifndef PH_MASK
#define PH_MASK 0xFFFFFFFFu
#endif
#define IN(k) (((PH_MASK >> (k)) & 1u) && lo <= (k) && (k) < hi)
#ifndef REPEAT_MASK
#define REPEAT_MASK 0u
#endif
#define REPS(k) ((((unsigned)REPEAT_MASK >> (k)) & 1u) ? 2 : 1)
#ifndef N_CG_SYNCS
#define N_CG_SYNCS 0
#endif
#define SEAM(k) do { if (IN(k) && IN((k) + 1)) { if ((k) < N_CG_SYNCS) grid.sync(); else xcd_barrier(bar); } } while (0)
    if (threadIdx.x < 16) ((LAS unsigned*)(smem + LDS_BARST))[threadIdx.x] = 0u;
    __syncthreads();
    const XcdBarrier bar = xcd_barrier_post((unsigned*)(ws + WS_CTL + CT_BAR), (volatile LAS unsigned*)(smem + LDS_BARST));
    C.gc = C.bid;
    #define PH_BODY_0 phase_convert(C);
    if (IN(0)) { PH_BODY_0 } if (REPS(0) > 1 && IN(0)) { xcd_barrier(bar); PH_BODY_0 }
    SEAM(0);
    if (IN(0) && IN(1)) {
        unsigned* barw = (unsigned*)(ws + WS_CTL + CT_BAR); bool eq = (C.G % 8) == 0;
#pragma unroll
        for (int j = 0; j < 16; ++j) { const unsigned cj = xb_ld(&barw[XB_XCNT(j)]); eq = eq && (cj == (j < 8 ? (unsigned)(C.G / 8) : 0u)); }
        const unsigned rank = ((volatile LAS unsigned*)(smem + LDS_BARST))[2];
        C.gc = __builtin_amdgcn_readfirstlane(eq ? (int)(rank * 8u + bar.x) : C.bid);
    }
    #define PH_BODY_1 { DenseSched S{(unsigned)WS_HB, (unsigned)WS_WIN, 1024, 1024, 128, 8, C.G, C.gc}; EpiWin E{(bf16_t*)(ws + WS_XR), (bf16_t*)(ws + WS_GY)}; \
        pg8::gemm_phase<false, false>(C.lds, ws, 1024, 1024, 1024, S, E); mini_win(C); }
    if (IN(1)) { PH_BODY_1 } if (REPS(1) > 1 && IN(1)) { xcd_barrier(bar); PH_BODY_1 }
    SEAM(1);
    #define PH_BODY_2 phase_conv(C);
    if (IN(2)) { PH_BODY_2 } if (REPS(2) > 1 && IN(2)) { xcd_barrier(bar); PH_BODY_2 }
    SEAM(2);
    #define PH_BODY_3 { GateSched S{(unsigned)WS_XC, (unsigned)WS_GATE, 128, C.G, C.gc}; \
        EpiGate E{(const bf16_t*)(ws + WS_XC), (bf16_t*)(ws + WS_LA), (bf16_t*)(ws + WS_BB), (const float*)(ws + WS_CTL + CT_SPL), (unsigned)WS_GBIAS}; \
        pg8::gemm_phase<false, false>(C.lds, ws, 256, 1024, 256, S, E); mini_gate(C); }
    if (IN(3)) { PH_BODY_3 } if (REPS(3) > 1 && IN(3)) { xcd_barrier(bar); PH_BODY_3 }
    SEAM(3);
    #define PH_BODY_4 phase_scan(C);
    if (IN(4)) { PH_BODY_4 } if (REPS(4) > 1 && IN(4)) { xcd_barrier(bar); PH_BODY_4 }
    SEAM(4);
    #define PH_BODY_5 { DenseSched S{(unsigned)WS_G, (unsigned)WS_LOUT, 1024, 1024, 128, 4, C.G, C.gc}; EpiRes<true> E{(bf16_t*)(ws + WS_PRE), P.in[I_X], P.in[I_META], nullptr, NTOK}; \
        pg8::gemm_phase<false, false>(C.lds, ws, 1024, 1024, 1024, S, E); mini_lout(C); }
    if (IN(5)) { PH_BODY_5 } if (REPS(5) > 1 && IN(5)) { xcd_barrier(bar); PH_BODY_5 }
    SEAM(5);
    #define PH_BODY_6 phase_lnr(C, 0, NTOK);
    if (IN(6)) { PH_BODY_6 } if (REPS(6) > 1 && IN(6)) { xcd_barrier(bar); PH_BODY_6 }
    SEAM(6);
    #define PH_BODY_7 phase_pos(C, 0, NTOK);
    if (IN(7)) { PH_BODY_7 } if (REPS(7) > 1 && IN(7)) { xcd_barrier(bar); PH_BODY_7 }
    SEAM(7);
    #define PH_BODY_8 { const int nM = moe_prep(C, (const int*)(ws + WS_CTL + CT_TEXP)); \
        MoeSched S{(unsigned)WS_HB8, (unsigned)WS_WGU, (unsigned)WS_TOK, (const LAS int*)(C.lds + pg8::TEXP_OFF), 2048u * 1024u, nM, 8, C.G, C.gc}; EpiGlu E{(unsigned char*)(ws + WS_ACT), (unsigned)WS_BIAS}; \
        pg8::gemm_phase<true, true>(C.lds, ws, 512, 512, 512, S, E); }
    if (IN(8)) { PH_BODY_8 } if (REPS(8) > 1 && IN(8)) { xcd_barrier(bar); PH_BODY_8 }
#ifdef PROBE_NULL8
    if (IN(8)) { xcd_barrier(bar); { const int nM = moe_prep(C, (const int*)(ws + WS_CTL + CT_TEXP));
        MoeSched S{(unsigned)WS_HB8, (unsigned)WS_WGU, (unsigned)WS_TOK, (const LAS int*)(C.lds + pg8::TEXP_OFF), 2048u * 1024u, nM, 8, C.G, C.gc}; EpiNull E{};
        pg8::gemm_phase<true, true>(C.lds, ws, 512, 512, 512, S, E); } }
#endif
    SEAM(8);
    #define PH_BODY_9 { const int nM = moe_prep(C, (const int*)(ws + WS_CTL + CT_TEXP)); \
        MoeSched S{(unsigned)WS_ACT, (unsigned)WS_WD, 0u, (const LAS int*)(C.lds + pg8::TEXP_OFF), 1024u * 1024u, nM, 4, C.G, C.gc}; EpiDown E{(unsigned char*)(ws + WS_YS), (unsigned)WS_BD}; \
        pg8::gemm_phase<true, false>(C.lds, ws, 512, 512, 512, S, E); }
    if (IN(9)) { PH_BODY_9 } if (REPS(9) > 1 && IN(9)) { xcd_barrier(bar); PH_BODY_9 }
    SEAM(9);
    #define PH_BODY_10 phase_combine(C, 0, NTOK, false);
    if (IN(10)) { PH_BODY_10 } if (REPS(10) > 1 && IN(10)) { xcd_barrier(bar); PH_BODY_10 }
    SEAM(10);
    #define PH_BODY_11 { QkvSched S{(unsigned)WS_HB8, (unsigned)WS_QKV8, 128, C.G, C.gc}; EpiQkv E{(bf16_t*)(ws + WS_Q), (bf16_t*)(ws + WS_K), (bf16_t*)(ws + WS_VT)}; \
        pg8::gemm_phase<true, false>(C.lds, ws, 512, 512, 512, S, E); mini_kv(C); }
    if (IN(11)) { PH_BODY_11 } if (REPS(11) > 1 && IN(11)) { xcd_barrier(bar); PH_BODY_11 }
    SEAM(11);
    #define PH_BODY_12 phase_attn(C);
    if (IN(12)) { PH_BODY_12 } if (REPS(12) > 1 && IN(12)) { xcd_barrier(bar); PH_BODY_12 }
    SEAM(12);
    #define PH_BODY_13 { DenseSched S{(unsigned)WS_O, (unsigned)WS_NOUT, 1024, 1024, 128, 4, C.G, C.gc}; EpiRes<false> E{(bf16_t*)(ws + WS_PRE), nullptr, nullptr, (const bf16_t*)(ws + WS_HB), NGRID}; \
        pg8::gemm_phase<false, false>(C.lds, ws, 1024, 1024, 1024, S, E); }
    if (IN(13)) { PH_BODY_13 } if (REPS(13) > 1 && IN(13)) { xcd_barrier(bar); PH_BODY_13 }
    SEAM(13);
    #define PH_BODY_14 phase_lnr(C, 1, NGRID);
    if (IN(14)) { PH_BODY_14 } if (REPS(14) > 1 && IN(14)) { xcd_barrier(bar); PH_BODY_14 }
    SEAM(14);
    #define PH_BODY_15 phase_pos(C, 1, NGRID);
    if (IN(15)) { PH_BODY_15 } if (REPS(15) > 1 && IN(15)) { xcd_barrier(bar); PH_BODY_15 }
    SEAM(15);
    #define PH_BODY_16 { const int nM = moe_prep(C, (const int*)(ws + WS_CTL + CT_TEXP) + 1024); \
        MoeSched S{(unsigned)WS_HB8, (unsigned)(WS_WGU + (size_t)32 * 2048 * 1024), (unsigned)(WS_TOK + 1 * MiB), (const LAS int*)(C.lds + pg8::TEXP_OFF), 2048u * 1024u, nM, 8, C.G, C.gc}; EpiGlu E{(unsigned char*)(ws + WS_ACT), (unsigned)(WS_BIAS + 32 * 2048 * 4)}; \
        pg8::gemm_phase<true, true>(C.lds, ws, 512, 512, 512, S, E); }
    if (IN(16)) { PH_BODY_16 } if (REPS(16) > 1 && IN(16)) { xcd_barrier(bar); PH_BODY_16 }
    SEAM(16);
    #define PH_BODY_17 { const int nM = moe_prep(C, (const int*)(ws + WS_CTL + CT_TEXP) + 1024); \
        MoeSched S{(unsigned)WS_ACT, (unsigned)(WS_WD + (size_t)32 * 1024 * 1024), 0u, (const LAS int*)(C.lds + pg8::TEXP_OFF), 1024u * 1024u, nM, 4, C.G, C.gc}; EpiDown E{(unsigned char*)(ws + WS_YS), (unsigned)(WS_BD + 32 * 1024 * 4)}; \
        pg8::gemm_phase<true, false>(C.lds, ws, 512, 512, 512, S, E); }
    if (IN(17)) { PH_BODY_17 } if (REPS(17) > 1 && IN(17)) { xcd_barrier(bar); PH_BODY_17 }
    SEAM(17);
    #define PH_BODY_18 phase_combine(C, 1, NGRID, true);
    if (IN(18)) { PH_BODY_18 } if (REPS(18) > 1 && IN(18)) { xcd_barrier(bar); PH_BODY_18 }
#undef ws
#undef IN
#undef SEAM
}

#ifndef MK_PER_PHASE
#define MK_PER_PHASE 0
#endif
extern "C" void kernel_launch(void* const* d_in, const int* in_sizes, int n_in, void* d_out, int out_size, void* d_ws, size_t ws_size, hipStream_t stream) {
    static int grid = 0;
    if (grid == 0) {
        if (n_in != 25 || ws_size < WS_END || out_size != NGRID * D) { fprintf(stderr, "kernel_launch: unexpected problem (n_in %d, ws %zu, out %d)\n", n_in, ws_size, out_size); grid = -1; return; }
        int dev = 0, cus = 0, per_cu = 0;
        if (hipGetDevice(&dev) != hipSuccess || hipDeviceGetAttribute(&cus, hipDeviceAttributeMultiprocessorCount, dev) != hipSuccess) { grid = -1; return; }
        if (hipFuncSetAttribute((const void*)hybrid_fwd, hipFuncAttributeMaxDynamicSharedMemorySize, LDS_BYTES) != hipSuccess) { fprintf(stderr, "kernel_launch: hipFuncSetAttribute failed\n"); grid = -1; return; }
        if (hipOccupancyMaxActiveBlocksPerMultiprocessor(&per_cu, (const void*)hybrid_fwd, NTHREADS, LDS_BYTES) != hipSuccess || per_cu < 1) { fprintf(stderr, "kernel_launch: occupancy query failed (%d)\n", per_cu); grid = -1; return; }
        grid = cus * 1;
        if (grid > 256) grid = 256;
    }
    if (grid < 0) return;
    if (hipMemsetAsync((char*)d_ws + WS_CTL + CT_BAR, 0, 16384, stream) != hipSuccess) { fprintf(stderr, "kernel_launch: memset failed\n"); return; }
    Params p{};
    for (int i = 0; i < 25; ++i) p.in[i] = (const float*)d_in[i];
    p.out = (float*)d_out; p.ws = (unsigned char*)d_ws;
#if MK_PER_PHASE
    for (int ph = 0; ph < 19; ++ph) { p.ph_lo = ph; p.ph_hi = ph + 1; void* args[] = {&p};
        hipError_t e = hipLaunchCooperativeKernel((void*)hybrid_fwd, dim3(grid), dim3(NTHREADS), args, LDS_BYTES, stream);
        if (e != hipSuccess) { fprintf(stderr, "launch phase %d failed: %s\n", ph, hipGetErrorString(e)); break; } }
#else
    p.ph_lo = 0; p.ph_hi = 19; void* args[] = {&p};
    hipError_t e = hipLaunchCooperativeKernel((void*)hybrid_fwd, dim3(grid), dim3(NTHREADS), args, LDS_BYTES, stream);
    if (e != hipSuccess) fprintf(stderr, "cooperative launch failed: %s (grid %d)\n", hipGetErrorString(e), grid);
#endif
}
```

```cpp
#include <hip/hip_runtime.h>
#include <hip/hip_cooperative_groups.h>
#include <cstdio>
#include <cstdint>
namespace cg = cooperative_groups;

#define LAS __attribute__((address_space(3)))
typedef unsigned short bf16_t;
typedef short bf16x8 __attribute__((ext_vector_type(8)));
typedef float f32x4 __attribute__((ext_vector_type(4)));
typedef float f32x2 __attribute__((ext_vector_type(2)));
typedef unsigned u32x4 __attribute__((ext_vector_type(4)));
typedef unsigned u32x2 __attribute__((ext_vector_type(2)));

constexpr int NB = 8, SEQ = 4096, D = 1024, NMETA = 16, LSEQ = SEQ + NMETA;
constexpr int NGRID = NB * SEQ;
constexpr int NTOK = NGRID + NB * NMETA;
constexpr int MPAD = 33024;
constexpr int NEXP = 32, TOPK = 4;
constexpr int PMAX = 139776;
constexpr int MTMAX = PMAX / 256;
constexpr float DN_ALPHA = 1.41421356237f;
constexpr float LN_EPS = 1e-5f;
constexpr int NTHREADS = 512, NWAVES = 8;

constexpr size_t MiB = 1u << 20;
constexpr size_t ACT_BYTES = (size_t)MPAD * D * 2;
constexpr size_t WS_CTL   = 0;
constexpr size_t WS_WIN   = 4 * MiB;
constexpr size_t WS_GATE  = WS_WIN + 4 * MiB;
constexpr size_t WS_LOUT  = WS_GATE + 2 * MiB;
constexpr size_t WS_QKV   = WS_LOUT + 2 * MiB;
constexpr size_t WS_NOUT  = WS_QKV + 6 * MiB;
constexpr size_t WS_WGU   = WS_NOUT + 2 * MiB;
constexpr size_t WS_WD    = WS_WGU + 128 * MiB;
constexpr size_t WS_HB    = WS_WD + 64 * MiB;
constexpr size_t WS_HB8   = WS_HB + 65 * MiB;
constexpr size_t WS_PRE   = WS_HB8 + 33 * MiB;
constexpr size_t WS_H     = WS_PRE + 129 * MiB;
constexpr size_t WS_SCR   = WS_H + 129 * MiB;
constexpr size_t WS_XR = WS_SCR, WS_XC = WS_XR + 65 * MiB, WS_GY = WS_XC + 65 * MiB, WS_LA = WS_GY + 65 * MiB, WS_BB = WS_LA + 130 * MiB, WS_HF = WS_BB + 130 * MiB, WS_G = WS_HF + 65 * MiB;
constexpr size_t WS_SCR_END0 = WS_G + 65 * MiB;
constexpr size_t WS_XS = WS_SCR, WS_ACT = WS_XS + 137 * MiB, WS_YS = WS_ACT + 137 * MiB;
constexpr size_t WS_SCR_END1 = WS_YS + 274 * MiB;
constexpr size_t WS_Q = WS_SCR, WS_K = WS_Q + 65 * MiB, WS_VT = WS_K + 65 * MiB, WS_O = WS_VT + 65 * MiB;
constexpr size_t WS_BIAS = (WS_SCR_END0 > WS_SCR_END1 ? WS_SCR_END0 : WS_SCR_END1);
constexpr size_t WS_BD = WS_BIAS + 2 * 32 * 2048 * 4;
constexpr size_t WS_GBIAS = WS_BD + 2 * 32 * 1024 * 4;
constexpr size_t WS_TOK = WS_BIAS + 1 * MiB;
constexpr size_t WS_QKV8 = WS_TOK + 2 * MiB;
constexpr size_t WS_END = WS_QKV8 + 3 * MiB;
static_assert((size_t)PMAX * 4 <= 1 * MiB, "token offset table");
static_assert(ACT_BYTES <= 65 * MiB && (size_t)PMAX * D * 2 <= 274 * MiB && (size_t)PMAX * D <= 137 * MiB && (size_t)MPAD * D <= 33 * MiB && (size_t)MPAD * D * 4 <= 129 * MiB, "ws map");
static_assert(WS_END <= (size_t)2040 * MiB, "ws map must fit 4x the largest input tensor");
constexpr size_t CT_BC      = 4096;
constexpr size_t CT_TEXP    = CT_BC + 2 * 256 * 32 * 4;
constexpr size_t CT_SPL     = CT_TEXP + 2 * 1024 * 4;
constexpr size_t CT_EID     = 256 * 1024;
constexpr size_t CT_GATEV   = CT_EID + 2 * (size_t)NTOK * 4 * 4;
constexpr size_t CT_POS     = CT_GATEV + 2 * (size_t)NTOK * 4 * 4;
static_assert(CT_POS + 2 * (size_t)NTOK * 4 * 4 <= 4 * MiB, "ctl map");

constexpr int LDS_BYTES = 155648;

__device__ __forceinline__ unsigned f2bf(float f) { unsigned u = __builtin_bit_cast(unsigned, f); return (u + 0x7fffu + ((u >> 16) & 1u)) >> 16; }
__device__ __forceinline__ unsigned cvt_pk_bf16(float lo, float hi);
__device__ __forceinline__ unsigned pk2(float lo, float hi) { return cvt_pk_bf16(lo, hi); }
typedef __bf16 bf16x2_t __attribute__((ext_vector_type(2)));
__device__ __forceinline__ unsigned cvt_pk_bf16(float lo, float hi) { const f32x2 v = {lo, hi}; return __builtin_bit_cast(unsigned, __builtin_convertvector(v, bf16x2_t)); }
__device__ __forceinline__ unsigned pk4_fp8(float a, float b, float c, float d) { int w = __builtin_amdgcn_cvt_pk_fp8_f32(a, b, 0, false); w = __builtin_amdgcn_cvt_pk_fp8_f32(c, d, w, true); return (unsigned)w; }
__device__ __forceinline__ float dot2_bf16(unsigned a, unsigned b, float c) { return __builtin_amdgcn_fdot2_f32_bf16(__builtin_bit_cast(bf16x2_t, a), __builtin_bit_cast(bf16x2_t, b), c, false); }
__device__ __forceinline__ void unpack8_fp8(const u32x2 w, float (&o)[8]) { const f32x2 a = __builtin_amdgcn_cvt_pk_f32_fp8((int)w.x, false), b = __builtin_amdgcn_cvt_pk_f32_fp8((int)w.x, true), c = __builtin_amdgcn_cvt_pk_f32_fp8((int)w.y, false), d = __builtin_amdgcn_cvt_pk_f32_fp8((int)w.y, true);
    o[0] = a.x; o[1] = a.y; o[2] = b.x; o[3] = b.y; o[4] = c.x; o[5] = c.y; o[6] = d.x; o[7] = d.y; }
__device__ __forceinline__ float bflo(unsigned w) { return __builtin_bit_cast(float, w << 16); }
__device__ __forceinline__ float bfhi(unsigned w) { return __builtin_bit_cast(float, w & 0xffff0000u); }
__device__ __forceinline__ void unpack8(const u32x4 w, float (&o)[8]);
__device__ __forceinline__ float fast_exp2(float x) { return __builtin_amdgcn_exp2f(x); }
__device__ __forceinline__ float fast_rcp(float x) { return __builtin_amdgcn_rcpf(x); }
__device__ __forceinline__ float sigmoidf_(float x) { return fast_rcp(1.0f + fast_exp2(-1.44269504089f * x)); }
__device__ __forceinline__ float wave_sum(float v) {
#pragma unroll
    for (int o = 1; o < 64; o <<= 1) v += __shfl_xor(v, o);
    return v;
}
template <int CTRL> __device__ __forceinline__ float dpp_movf(float v) { return __builtin_bit_cast(float, __builtin_amdgcn_update_dpp(0, __builtin_bit_cast(int, v), CTRL, 0xf, 0xf, true)); }
__device__ __forceinline__ float readlane_f(float v, int l) { return __builtin_bit_cast(float, __builtin_amdgcn_readlane(__builtin_bit_cast(int, v), l)); }
__device__ __forceinline__ float wave_sum_dpp(float v) {
    v += dpp_movf<0xB1>(v);
    v += dpp_movf<0x4E>(v);
    v += dpp_movf<0x141>(v);
    v += dpp_movf<0x140>(v);
    return (readlane_f(v, 0) + readlane_f(v, 16)) + (readlane_f(v, 32) + readlane_f(v, 48));
}
__device__ __forceinline__ int seqrow(int b, int s) { return s < NMETA ? NGRID + NMETA * b + s : SEQ * b + (s - NMETA); }

struct Params {
    const float* in[25];
    float* out;
    unsigned char* ws;
    int ph_lo, ph_hi;
};
struct Ctx {
    LAS unsigned char* lds;
    int G, bid, gc;
    unsigned char* ws;
    const float* const* in;
    float* out;
};
__device__ __forceinline__ int fresh_tid() { int t = threadIdx.x; asm volatile("" : "+v"(t)); return t; }
__device__ __forceinline__ unsigned char* fresh_ws(unsigned char* p) { asm volatile("" : "+s"(p)); return p; }
#define PHASE_IDS unsigned char* const wsl = fresh_ws(C.ws); (void)wsl; const int tid = fresh_tid(); const int lane = tid & 63; const int wave = __builtin_amdgcn_readfirstlane(tid >> 6); (void)lane; (void)wave;
enum { I_X = 0, I_META, I_WIN, I_CONVW, I_CONVB, I_WA, I_BA, I_WX, I_BX, I_LAM, I_LOUT, I_WQKV, I_RPB, I_MBIAS, I_NOUT, I_LNMG, I_LNMB, I_RW, I_RB, I_WGU, I_BGU, I_WD, I_BD, I_LNFG, I_LNFB };

namespace pg8 {
constexpr int BM = 256, BK = 64, HALF = 128, HTB = HALF * BK * 2, STAGE_BYTES = 8 * HTB, NXCD = 8, WGM = 8;
constexpr int SIDE_OFF = STAGE_BYTES, TEXP_OFF = STAGE_BYTES + 2048, TOK_OFF = STAGE_BYTES + 2048 + 4096;
__device__ __forceinline__ int lds_byte(int r, int c) { const int st = (r >> 4) * 2 + (c >> 5), rr = r & 15, cc = c & 31, ob = rr * 64 + cc * 2; return st * 1024 + (ob ^ (((ob >> 9) & 1) << 5)); }
__device__ __forceinline__ void stage_rc(int b, int& R, int& C) { const int st = b / 1024, sb = b % 1024, swz = sb ^ (((sb >> 9) & 1) << 5); R = (st >> 1) * 16 + swz / 64; C = (st & 1) * 32 + (swz % 64) / 2; }
__device__ __forceinline__ int perm32(int rho) { const int n = rho >> 4, i = rho & 15; return 8 * (i >> 2) + 4 * n + (i & 3); }

typedef int v8i __attribute__((ext_vector_type(8)));
typedef int v4i __attribute__((ext_vector_type(4)));
__device__ __forceinline__ v8i cat8(bf16x8 a, bf16x8 b) { const v4i x = __builtin_bit_cast(v4i, a), y = __builtin_bit_cast(v4i, b); return __builtin_shufflevector(x, y, 0, 1, 2, 3, 4, 5, 6, 7); }
struct Unit { unsigned ao, bo, to; int pm, pn, aux; };

__device__ __forceinline__ void tile_of(int L, int nM, int nN, int& pm, int& pn) {
    const int nwg = nM * nN; int wgid = L;
    { const int q = nwg / NXCD, r = nwg % NXCD, xcd = wgid % NXCD, off = wgid / NXCD; wgid = (xcd < r ? xcd * (q + 1) : r * (q + 1) + (xcd - r) * q) + off; }
    const int nig = WGM * nN, gid = wgid / nig, fm = gid * WGM, gsz = (nM - fm) < WGM ? (nM - fm) : WGM;
    pm = fm + ((wgid % nig) % gsz); pn = (wgid % nig) / gsz;
}

template <bool F8, bool GATHER, class Epi, class Sched>
__device__ __forceinline__ void gemm_phase(LAS unsigned char* lds, const unsigned char* wsbase, const int K, const int lda, const int ldb, const Sched& S, const Epi& E) {
    const __amdgpu_buffer_rsrc_t rsrc = __builtin_amdgcn_make_buffer_rsrc((void*)wsbase, 0, 0xFFFFFFFF, 0x00020000);
    const int tid = fresh_tid(), wid = __builtin_amdgcn_readfirstlane(tid >> 6), lane = tid & 63, wr = wid >> 2, wc = wid & 3;
    const int nt = K / BK;
    int f8scales = 0; if constexpr (F8) { f8scales = Epi::SCALES; asm volatile("" : "+v"(f8scales)); }
    int voffA, voffB;
    { int R, C; stage_rc(tid * 16, R, C); const int Rb = Epi::PERM ? ((R & ~31) + perm32(R & 31)) : R; voffA = ((GATHER ? 0 : R * lda) + C) * 2; voffB = (Rb * ldb + C) * 2; }
    const int tokb = (16 * (wid >> 1) + (lane >> 2)) * 4;
    const unsigned kstep = (unsigned)(BK * 2);
    const unsigned hstepA = (unsigned)HALF * lda * 2, hstepB = (unsigned)HALF * ldb * 2;
    const unsigned ldsw = (unsigned)wid * 1024u;
    const int aoff = lds_byte(wr * 64 + (lane & 15), (lane >> 4) * 8), boff = lds_byte(wc * 32 + (lane & 15), (lane >> 4) * 8);
#define PG8_SA(b, h) (((b) * 2 + (h)) * HTB)
#define PG8_SB(b, h) ((4 + (b) * 2 + (h)) * HTB)
#define PG8_STAGE(bufoff, gbase, voff) do { _Pragma("unroll") for (int _i = 0; _i < 2; ++_i) \
        __builtin_amdgcn_raw_ptr_buffer_load_lds(rsrc, (LAS void*)(lds + (bufoff) + ldsl + _i * 8192), 16, voff, __builtin_amdgcn_readfirstlane((int)((gbase) + (unsigned)_i * (hstep##voff >> 1))), 0, 0); } while (0)
#define hstepvoffA hstepA
#define hstepvoffB hstepB
#define PG8_STAGE_A(bufoff, aoffs, h, par) do { if constexpr (GATHER) { _Pragma("unroll") for (int _i = 0; _i < 2; ++_i) { \
            const int _tk = *(const LAS int*)(lds + TOK_OFF + (par) * 1024 + tokb + ((h) * 128 + _i * 64) * 4); \
            __builtin_amdgcn_raw_ptr_buffer_load_lds(rsrc, (LAS void*)(lds + (bufoff) + ldsl + _i * 8192), 16, _tk + voffA, __builtin_amdgcn_readfirstlane((int)(aoffs)), 0, 0); } } \
        else { PG8_STAGE(bufoff, (aoffs) + (unsigned)(h) * hstepA, voffA); } } while (0)
#define PG8_TOK(unit, par) do { if constexpr (GATHER) { if (wid == 0) __builtin_amdgcn_raw_ptr_buffer_load_lds(rsrc, (LAS void*)(lds + TOK_OFF + (par) * 1024), 16, lane * 16, (int)(unit).to, 0, 0); } } while (0)
#define PG8_LDA(dst, b, h) do { _Pragma("unroll") for (int m = 0; m < 4; ++m) _Pragma("unroll") for (int k = 0; k < 2; ++k) dst[m][k] = *(const LAS bf16x8*)(lds + PG8_SA(b, h) + aoff + m * 2048 + k * 1024); } while (0)
#define PG8_LDB(dst, b, h) do { _Pragma("unroll") for (int n = 0; n < 2; ++n) _Pragma("unroll") for (int k = 0; k < 2; ++k) dst[n][k] = *(const LAS bf16x8*)(lds + PG8_SB(b, h) + boff + n * 2048 + k * 1024); } while (0)
#define PG8_MMA(ai, bj, At, Bt) do { __builtin_amdgcn_s_setprio(1); _Pragma("unroll") for (int m = 0; m < 4; ++m) _Pragma("unroll") for (int n = 0; n < 2; ++n) { \
        if constexpr (F8) { asm volatile("v_mfma_scale_f32_16x16x128_f8f6f4 %0, %1, %2, %0, %3, %3 op_sel:[0,1,0] op_sel_hi:[0,0,0]" : "+v"(acc[ai][bj][m][n]) : "v"(cat8(Bt[n][0], Bt[n][1])), "v"(cat8(At[m][0], At[m][1])), "v"(f8scales)); } \
        else { _Pragma("unroll") for (int k = 0; k < 2; ++k) acc[ai][bj][m][n] = __builtin_amdgcn_mfma_f32_16x16x32_bf16(Bt[n][k], At[m][k], acc[ai][bj][m][n], 0, 0, 0); } } \
        __builtin_amdgcn_s_setprio(0); } while (0)
#define PG8_WAIT_V(n) asm volatile("s_waitcnt vmcnt(" #n ")" ::: "memory")
#define PG8_WAIT_L(n) asm volatile("s_waitcnt lgkmcnt(" #n ")" ::: "memory")
#define PG8_BAR __builtin_amdgcn_s_barrier()
#define PG8_SCHED __builtin_amdgcn_sched_barrier(0)
    Unit cur, nxt; int ui = 0;
    if (!S.next(0, cur)) return;
    f32x4 acc[2][2][4][2];
    bf16x8 At[4][2], B0[2][2], B1[2][2];
#define PG8_INIT(par) do { if constexpr (Epi::SIDE) { const int _l = fresh_tid() & 63; E.init(acc, (const LAS float*)(lds + SIDE_OFF + (par) * 1024), wc, _l >> 4); } \
        else { _Pragma("unroll") for (int a = 0; a < 2; ++a) _Pragma("unroll") for (int b = 0; b < 2; ++b) _Pragma("unroll") for (int m = 0; m < 4; ++m) _Pragma("unroll") for (int n = 0; n < 2; ++n) acc[a][b][m][n] = (f32x4){0.f, 0.f, 0.f, 0.f}; } } while (0)
    unsigned cA = cur.ao, cB = cur.bo;
    unsigned ldsl = ldsw; asm volatile("" : "+s"(ldsl));
#define PG8_SIDE(unit, par) do { if constexpr (Epi::SIDE) { if (wid == 0) __builtin_amdgcn_raw_ptr_buffer_load_lds(rsrc, (LAS void*)(lds + SIDE_OFF + (par) * 1024), 16, lane * 16, (int)E.side_off(unit), 0, 0); } } while (0)
    PG8_SIDE(cur, 0);
    if constexpr (GATHER) PG8_TOK(cur, 0);
    if constexpr (GATHER || Epi::SIDE) { asm volatile("s_waitcnt vmcnt(0)" ::: "memory"); PG8_BAR; }
    PG8_INIT(0);
    PG8_STAGE(PG8_SB(0, 0), cB, voffB); PG8_STAGE(PG8_SB(0, 1), cB + hstepB, voffB); PG8_STAGE_A(PG8_SA(0, 0), cA, 0, 0); PG8_STAGE_A(PG8_SA(0, 1), cA, 1, 0);
    if (wr == 1) PG8_BAR;
    PG8_WAIT_V(2); PG8_BAR;
    PG8_STAGE(PG8_SB(1, 0), cB + kstep, voffB); PG8_STAGE_A(PG8_SA(1, 0), cA + kstep, 0, 0); PG8_STAGE(PG8_SB(1, 1), cB + hstepB + kstep, voffB);
    PG8_WAIT_V(6); PG8_BAR;
    for (;;) {
        const bool has_next = S.next(ui + 1, nxt);
        if (has_next) { PG8_TOK(nxt, (ui + 1) & 1); PG8_SIDE(nxt, (ui + 1) & 1); }
        const unsigned nA = has_next ? nxt.ao : cA, nB = has_next ? nxt.bo : cB;
#pragma unroll 1
        for (int t = 0; t < nt; t += 2) {
            const bool last = (t == nt - 2);
            ldsl = ldsw; asm volatile("" : "+s"(ldsl));
            const int parc = ui & 1, parn = (ui + ((last && has_next) ? 1 : 0)) & 1;
            const unsigned a1 = cA + (unsigned)(t + 1) * kstep;
            const unsigned a2 = last ? nA : cA + (unsigned)(t + 2) * kstep, b2 = last ? nB : cB + (unsigned)(t + 2) * kstep;
            const unsigned a3 = a2 + kstep, b3 = b2 + kstep;
            PG8_LDB(B0, 0, 0); PG8_LDB(B1, 0, 1); PG8_SCHED; PG8_LDA(At, 0, 0); PG8_STAGE_A(PG8_SA(1, 1), a1, 1, parc);
            PG8_WAIT_V(8); PG8_WAIT_L(0); PG8_BAR; PG8_MMA(0, 0, At, B0); PG8_MMA(0, 1, At, B1); PG8_BAR; PG8_SCHED;
            PG8_LDA(At, 0, 1); PG8_STAGE(PG8_SB(0, 0), b2, voffB); PG8_STAGE(PG8_SB(0, 1), b2 + hstepB, voffB); PG8_STAGE_A(PG8_SA(0, 0), a2, 0, parn);
            PG8_WAIT_V(8); PG8_WAIT_L(0); PG8_BAR; PG8_MMA(1, 0, At, B0); PG8_MMA(1, 1, At, B1); PG8_BAR; PG8_SCHED;
            PG8_LDB(B0, 1, 0); PG8_LDB(B1, 1, 1); PG8_SCHED; PG8_LDA(At, 1, 0); PG8_STAGE_A(PG8_SA(0, 1), a2, 1, parn);
            PG8_WAIT_V(8); PG8_WAIT_L(0); PG8_BAR; PG8_MMA(0, 0, At, B0); PG8_MMA(0, 1, At, B1); PG8_BAR; PG8_SCHED;
            PG8_LDA(At, 1, 1); PG8_STAGE(PG8_SB(1, 0), b3, voffB); PG8_STAGE(PG8_SB(1, 1), b3 + hstepB, voffB); PG8_STAGE_A(PG8_SA(1, 0), a3, 0, parn);
            PG8_WAIT_V(8); PG8_WAIT_L(0); PG8_BAR; PG8_MMA(1, 0, At, B0); PG8_MMA(1, 1, At, B1); PG8_BAR; PG8_SCHED;
        }
        if constexpr (F8) asm volatile("s_nop 15\n\ts_nop 15" ::: "memory");
        if (wr == 0) PG8_BAR;
        { const int l2 = fresh_tid() & 63; E(acc, cur, wr, wc, l2 & 15, l2 >> 4, (const LAS float*)(lds + SIDE_OFF + (ui & 1) * 1024)); }
        if (!has_next) break;
        cur = nxt; cA = nA; cB = nB; ++ui;
        PG8_INIT(ui & 1);
        if (wr == 1) PG8_BAR;
    }
    PG8_WAIT_V(0);
    PG8_BAR;
#undef PG8_SA
#undef PG8_SB
#undef PG8_STAGE
#undef PG8_STAGE_A
#undef PG8_TOK
#undef PG8_SIDE
#undef PG8_INIT
#undef hstepvoffA
#undef hstepvoffB
#undef PG8_LDA
#undef PG8_LDB
#undef PG8_MMA
#undef PG8_WAIT_V
#undef PG8_WAIT_L
#undef PG8_BAR
#undef PG8_SCHED
}
}

using pg8::Unit;

struct DenseSched {
    unsigned A, Bt; int lda, ldb, nM, nN, G, c;
    __device__ __forceinline__ bool next(int i, Unit& u) const {
        const int L = i * G + c; if (L >= nM * nN) return false;
        pg8::tile_of(L, nM, nN, u.pm, u.pn); u.aux = 0; u.to = 0;
        u.ao = A + (unsigned)u.pm * 256 * lda * 2; u.bo = Bt + (unsigned)u.pn * 256 * ldb * 2; return true;
    }
};
struct GateSched {
    unsigned XC, GT; int nM, G, c;
    __device__ __forceinline__ bool next(int i, Unit& u) const {
        const int per = nM * 4; const int L = i * G + c; if (L >= 4 * per) return false;
        const int nb = L / per; pg8::tile_of(L - nb * per, nM, 4, u.pm, u.pn); u.aux = nb; u.to = 0;
        u.ao = XC + ((unsigned)u.pm * 256 * 1024 + 256 * nb) * 2; u.bo = GT + ((unsigned)nb * 1024 + 256 * u.pn) * 256 * 2; return true;
    }
};
struct QkvSched {
    unsigned HB, WT; int nM, G, c;
    __device__ __forceinline__ bool next(int i, Unit& u) const {
        const int n0 = nM * 8, n1 = 4 * nM; const int L = i * G + c; if (L >= n0 + n1) return false; u.to = 0;
        if (L < n0) { pg8::tile_of(L, nM, 8, u.pm, u.pn); u.aux = 0; u.ao = HB + (unsigned)u.pm * 256 * 1024; u.bo = WT + (unsigned)u.pn * 256 * 1024; }
        else { pg8::tile_of(L - n0, 4, nM, u.pm, u.pn); u.aux = 1; u.ao = WT + (unsigned)(2048 + u.pm * 256) * 1024; u.bo = HB + (unsigned)u.pn * 256 * 1024; }
        return true;
    }
};
struct MoeSched {
    unsigned A, W, tok; const LAS int* texp; unsigned wstride; int nM, nN, G, c;
    __device__ __forceinline__ bool next(int i, Unit& u) const {
        const int L = i * G + c; if (L >= nM * nN) return false;
        pg8::tile_of(L, nM, nN, u.pm, u.pn);
        const int e = __builtin_amdgcn_readfirstlane(texp[u.pm]); u.aux = e;
        u.ao = tok ? A : A + (unsigned)u.pm * 256 * 1024; u.to = tok + (unsigned)u.pm * 1024; u.bo = W + (unsigned)e * wstride + (unsigned)u.pn * 256 * 1024; return true;
    }
};

#define EPI_ARGS const f32x4 (&acc)[2][2][4][2], const Unit& u, int wr, int wc, int fr, int fq, const LAS float* side
struct EpiWin {
    static constexpr bool PERM = true, SIDE = false;
    bf16_t* XR; bf16_t* GY;
    __device__ __forceinline__ void operator()(EPI_ARGS) const {
        const int row0 = u.pm * 256 + wr * 64 + fr;
        if (u.pn < 4) {
            const int col0 = u.pn * 256 + wc * 32 + 8 * fq;
#pragma unroll
            for (int ai = 0; ai < 2; ++ai)
#pragma unroll
                for (int m = 0; m < 4; ++m) { bf16_t* rowp = XR + (size_t)(row0 + ai * 128 + m * 16) * D + col0;
#pragma unroll
                    for (int bj = 0; bj < 2; ++bj) { const f32x4 v0 = acc[ai][bj][m][0], v1 = acc[ai][bj][m][1];
                        u32x4 w; w.x = cvt_pk_bf16(v0[0], v0[1]); w.y = cvt_pk_bf16(v0[2], v0[3]); w.z = cvt_pk_bf16(v1[0], v1[1]); w.w = cvt_pk_bf16(v1[2], v1[3]);
                        *(u32x4*)(rowp + bj * 128) = w; } }
        } else {
#pragma unroll
            for (int ai = 0; ai < 2; ++ai)
#pragma unroll
                for (int m = 0; m < 4; ++m) { const int row = row0 + ai * 128 + m * 16;
#pragma unroll
                    for (int bj = 0; bj < 2; ++bj) { const int g = (u.pn - 4) * 8 + bj * 4 + wc;
                        float o[8];
#pragma unroll
                        for (int n = 0; n < 2; ++n)
#pragma unroll
                            for (int j = 0; j < 4; ++j) { const float v = acc[ai][bj][m][n][j]; const float z = 1.5957691216f * (v + 0.044715f * v * v * v); o[n * 4 + j] = v * sigmoidf_(z); }
                        u32x4 w; w.x = cvt_pk_bf16(o[0], o[1]); w.y = cvt_pk_bf16(o[2], o[3]); w.z = cvt_pk_bf16(o[4], o[5]); w.w = cvt_pk_bf16(o[6], o[7]);
                        *(u32x4*)(GY + ((size_t)g * MPAD + row) * 32 + 8 * fq) = w; } }
        }
    }
};
struct EpiGate {
    static constexpr bool PERM = true, SIDE = true;
    const bf16_t* XC; unsigned char* LB; const float* spl; unsigned bias_off;
    __device__ __forceinline__ unsigned side_off(const Unit& u) const { return bias_off + (unsigned)((((u.pn >> 1) * 4 + u.aux) * 2 + (u.pn & 1)) * 1024); }
    __device__ __forceinline__ void init(f32x4 (&acc)[2][2][4][2], const LAS float* side, int wc, int fq) const {
#pragma unroll
        for (int bj = 0; bj < 2; ++bj)
#pragma unroll
            for (int n = 0; n < 2; ++n) { const f32x4 b = *(const LAS f32x4*)(side + 128 * bj + 32 * wc + 8 * fq + 4 * n);
#pragma unroll
                for (int ai = 0; ai < 2; ++ai)
#pragma unroll
                    for (int m = 0; m < 4; ++m) acc[ai][bj][m][n] = b; }
    }
    __device__ __forceinline__ void operator()(EPI_ARGS) const {
        const int nb = u.aux, dir = u.pn >> 1, half = u.pn & 1;
        const int ch0 = 256 * nb + 128 * half + 32 * wc + 8 * fq, g = ch0 >> 5;
        const int row0 = u.pm * 256 + wr * 64 + fr;
        float csp[8];
        { const f32x4 p0 = *(const f32x4*)(spl + dir * 1024 + ch0), p1 = *(const f32x4*)(spl + dir * 1024 + ch0 + 4);
#pragma unroll
          for (int j = 0; j < 4; ++j) { csp[j] = -2.0f * p0[j]; csp[4 + j] = -2.0f * p1[j]; } }
        u32x4 xnext = *(const u32x4*)(XC + (size_t)row0 * D + ch0);
#pragma unroll
        for (int ai = 0; ai < 2; ++ai)
#pragma unroll
            for (int m = 0; m < 4; ++m) { const int row = row0 + ai * 128 + m * 16;
                const u32x4 xw = xnext;
                { const int it = ai * 4 + m + 1, rn = row0 + (it >> 2) * 128 + (it & 3) * 16; if (it < 8) xnext = *(const u32x4*)(XC + (size_t)rn * D + ch0); }
                float xc[8]; unpack8(xw, xc);
                const bool start = dir == 1 && (row & (SEQ - 1)) == SEQ - 1;
                float sg[8], bb[8];
#pragma unroll
                for (int n = 0; n < 2; ++n)
#pragma unroll
                    for (int j = 0; j < 4; ++j) { const int i = n * 4 + j;
                        const float sga = sigmoidf_(acc[ai][0][m][n][j]); const float a2 = fast_exp2(csp[i] * sga);
                        const float mult = start ? 8.0f : 8.0f * __builtin_amdgcn_sqrtf(fmaxf(1.0f - a2, 0.0f));
                        sg[i] = sga * 256.0f; bb[i] = __builtin_amdgcn_fmed3f(mult * sigmoidf_(acc[ai][1][m][n][j]) * xc[i], -448.0f, 448.0f); }
                u32x4 w; w.x = pk4_fp8(sg[0], sg[1], sg[2], sg[3]); w.y = pk4_fp8(sg[4], sg[5], sg[6], sg[7]); w.z = pk4_fp8(bb[0], bb[1], bb[2], bb[3]); w.w = pk4_fp8(bb[4], bb[5], bb[6], bb[7]);
                *(u32x4*)(LB + (((size_t)dir * 32 + g) * MPAD + row) * 64 + 16 * fq) = w; }
    }
};
template <bool LAYER0> struct EpiRes {
    static constexpr bool PERM = true, SIDE = false;
    bf16_t* PRE; const float* x; const float* meta; const bf16_t* HB; int nrows;
    __device__ __forceinline__ void operator()(EPI_ARGS) const {
        const int row0 = u.pm * 256 + wr * 64 + fr, col0 = u.pn * 256 + wc * 32 + 8 * fq;
#pragma unroll
        for (int ai = 0; ai < 2; ++ai)
#pragma unroll
            for (int m = 0; m < 4; ++m) { const int row = row0 + ai * 128 + m * 16;
                if (row < nrows) {
#pragma unroll
                    for (int bj = 0; bj < 2; ++bj) { const int c = col0 + bj * 128; float r[8];
                        if (LAYER0) { const float* rp = (row < NGRID ? x + (size_t)row * D : meta + (size_t)((row - NGRID) & 15) * D) + c; const f32x4 r0 = *(const f32x4*)rp, r1 = *(const f32x4*)(rp + 4);
                            r[0] = r0[0]; r[1] = r0[1]; r[2] = r0[2]; r[3] = r0[3]; r[4] = r1[0]; r[5] = r1[1]; r[6] = r1[2]; r[7] = r1[3]; }
                        else { const u32x4 rw = *(const u32x4*)(HB + (size_t)row * D + c); r[0] = bflo(rw.x); r[1] = bfhi(rw.x); r[2] = bflo(rw.y); r[3] = bfhi(rw.y); r[4] = bflo(rw.z); r[5] = bfhi(rw.z); r[6] = bflo(rw.w); r[7] = bfhi(rw.w); }
                        const f32x4 a0 = acc[ai][bj][m][0], a1 = acc[ai][bj][m][1];
                        u32x4 w; w.x = cvt_pk_bf16(r[0] * DN_ALPHA + a0[0], r[1] * DN_ALPHA + a0[1]); w.y = cvt_pk_bf16(r[2] * DN_ALPHA + a0[2], r[3] * DN_ALPHA + a0[3]);
                        w.z = cvt_pk_bf16(r[4] * DN_ALPHA + a1[0], r[5] * DN_ALPHA + a1[1]); w.w = cvt_pk_bf16(r[6] * DN_ALPHA + a1[2], r[7] * DN_ALPHA + a1[3]);
                        *(u32x4*)(PRE + (size_t)row * D + c) = w; }
                }
                asm volatile("" ::: "memory"); }
    }
};
struct EpiGlu {
    static constexpr bool PERM = true, SIDE = true; static constexpr int SCALES = 0x7F79;
    unsigned char* ACT; unsigned bias_off;
    __device__ __forceinline__ unsigned side_off(const Unit& u) const { return bias_off + (unsigned)((u.aux * 8 + u.pn) * 1024); }
    __device__ __forceinline__ void init(f32x4 (&acc)[2][2][4][2], const LAS float* side, int wc, int fq) const {
#pragma unroll
        for (int bj = 0; bj < 2; ++bj)
#pragma unroll
            for (int n = 0; n < 2; ++n) { const f32x4 b = *(const LAS f32x4*)(side + 128 * bj + 32 * wc + 8 * fq + 4 * n);
#pragma unroll
                for (int ai = 0; ai < 2; ++ai)
#pragma unroll
                    for (int m = 0; m < 4; ++m) acc[ai][bj][m][n] = b; }
    }
    __device__ __forceinline__ void operator()(EPI_ARGS) const {
        const int f0 = 128 * u.pn + 32 * wc + 8 * fq;
        const int row0 = u.pm * 256 + wr * 64 + fr;
#pragma unroll
        for (int ai = 0; ai < 2; ++ai)
#pragma unroll
            for (int m = 0; m < 4; ++m) { const int row = row0 + ai * 128 + m * 16; float o[8];
#pragma unroll
                for (int n = 0; n < 2; ++n)
#pragma unroll
                    for (int j = 0; j < 4; ++j) { const int i = n * 4 + j;
                        const float glu = fminf(acc[ai][0][m][n][j], 7.0f);
                        const float lin1 = __builtin_amdgcn_fmed3f(acc[ai][1][m][n][j], -6.0f, 8.0f);
                        const float r4 = fast_rcp(__builtin_fmaf(fast_exp2(glu * (-1.702f * 1.44269504089f)), 0.25f, 0.25f));
                        o[i] = (glu * r4) * lin1; }
                u32x2 w; w.x = pk4_fp8(o[0], o[1], o[2], o[3]); w.y = pk4_fp8(o[4], o[5], o[6], o[7]);
                *(u32x2*)(ACT + (size_t)row * D + f0) = w; }
    }
};
struct EpiNull {
    static constexpr bool PERM = true, SIDE = false; static constexpr int SCALES = 0x7F79;
    __device__ __forceinline__ void operator()(EPI_ARGS) const {
#pragma unroll
        for (int ai = 0; ai < 2; ++ai)
#pragma unroll
            for (int bj = 0; bj < 2; ++bj)
#pragma unroll
                for (int m = 0; m < 4; ++m)
#pragma unroll
                    for (int n = 0; n < 2; ++n) asm volatile("" :: "v"(acc[ai][bj][m][n]));
    }
};
struct EpiDown {
    static constexpr bool PERM = true, SIDE = true; static constexpr int SCALES = 0x7D79;
    unsigned char* YS; unsigned bias_off;
    __device__ __forceinline__ unsigned side_off(const Unit& u) const { return bias_off + (unsigned)((u.aux * 4 + u.pn) * 1024); }
    __device__ __forceinline__ void init(f32x4 (&acc)[2][2][4][2], const LAS float* side, int wc, int fq) const {
#pragma unroll
        for (int bj = 0; bj < 2; ++bj)
#pragma unroll
            for (int n = 0; n < 2; ++n) { const f32x4 b = *(const LAS f32x4*)(side + 128 * bj + 32 * wc + 8 * fq + 4 * n);
#pragma unroll
                for (int ai = 0; ai < 2; ++ai)
#pragma unroll
                    for (int m = 0; m < 4; ++m) acc[ai][bj][m][n] = b; }
    }
    __device__ __forceinline__ void operator()(EPI_ARGS) const {
        const int row0 = u.pm * 256 + wr * 64 + fr, col0 = u.pn * 256 + wc * 32 + 8 * fq;
#pragma unroll
        for (int ai = 0; ai < 2; ++ai)
#pragma unroll
            for (int m = 0; m < 4; ++m) { unsigned char* rowp = YS + (size_t)(row0 + ai * 128 + m * 16) * D + col0;
#pragma unroll
                for (int bj = 0; bj < 2; ++bj) { const f32x4 v0 = acc[ai][bj][m][0] * 8.0f, v1 = acc[ai][bj][m][1] * 8.0f;
                    u32x2 w; w.x = pk4_fp8(v0[0], v0[1], v0[2], v0[3]); w.y = pk4_fp8(v1[0], v1[1], v1[2], v1[3]);
                    *(u32x2*)(rowp + bj * 128) = w; } }
    }
};
struct EpiQkv {
    static constexpr bool PERM = true, SIDE = false; static constexpr int SCALES = 0x7F79;
    bf16_t* Q; bf16_t* Kx; bf16_t* VT;
    __device__ __forceinline__ void operator()(EPI_ARGS) const {
        const int row0 = u.pm * 256 + wr * 64 + fr; bf16_t* base; int ldc, colt; float sc = 1.0f;
        if (u.aux == 0) { ldc = D; if (u.pn < 4) { base = Q; colt = u.pn * 256; sc = 0.125f * 1.44269504089f; } else { base = Kx; colt = (u.pn - 4) * 256; } }
        else { base = VT; ldc = MPAD; colt = u.pn * 256; }
        const int col0 = colt + wc * 32 + 8 * fq;
#pragma unroll
        for (int ai = 0; ai < 2; ++ai)
#pragma unroll
            for (int m = 0; m < 4; ++m) { bf16_t* rowp = base + (size_t)(row0 + ai * 128 + m * 16) * ldc + col0;
#pragma unroll
                for (int bj = 0; bj < 2; ++bj) { const f32x4 v0 = acc[ai][bj][m][0] * sc, v1 = acc[ai][bj][m][1] * sc;
                    u32x4 w; w.x = cvt_pk_bf16(v0[0], v0[1]); w.y = cvt_pk_bf16(v0[2], v0[3]); w.z = cvt_pk_bf16(v1[0], v1[1]); w.w = cvt_pk_bf16(v1[2], v1[3]);
                    *(u32x4*)(rowp + bj * 128) = w; } }
    }
};

struct CvItem { const float* src; unsigned char* dst; int ld, pitch, f8; };
__device__ __forceinline__ CvItem cv_item(const Ctx& C, unsigned char* wsl, int it) {
    constexpr int I0 = 512, I1 = 256, I2 = 256, I3 = 768, I4 = 256, I5 = 32768, I6 = 16384;
    CvItem q; int r = it;
    if (r < I0) { const int nbk = r & 63, kb = r >> 6; q.src = C.in[I_WIN] + (size_t)(128 * kb) * 2048 + 32 * nbk; q.ld = 2048; q.dst = wsl + WS_WIN + ((size_t)(32 * nbk) * 1024 + 128 * kb) * 2; q.pitch = 2048; q.f8 = 0; return q; } r -= I0;
    if (r < I1) { const int job = r >> 3, sub = r & 7, nbk = sub & 3, kb = sub >> 2;
        const int half = job & 1, which = (job >> 1) & 1, nb = (job >> 2) & 3, dir = job >> 4;
        q.src = C.in[which ? I_WX : I_WA] + (size_t)(dir * 4 + nb) * 65536 + (size_t)(128 * kb) * 256 + 128 * half + 32 * nbk; q.ld = 256;
        q.dst = wsl + WS_GATE + (((size_t)nb * 1024 + 256 * (2 * dir + half) + 128 * which + 32 * nbk) * 256 + 128 * kb) * 2; q.pitch = 512; q.f8 = 0; return q; } r -= I1;
    if (r < I2) { const int nbk = r & 31, kb = r >> 5; q.src = C.in[I_LOUT] + (size_t)(128 * kb) * 1024 + 32 * nbk; q.ld = 1024; q.dst = wsl + WS_LOUT + ((size_t)(32 * nbk) * 1024 + 128 * kb) * 2; q.pitch = 2048; q.f8 = 0; return q; } r -= I2;
    if (r < I3) { const int nbk = r % 96, kb = r / 96; q.src = C.in[I_WQKV] + (size_t)(128 * kb) * 3072 + 32 * nbk; q.ld = 3072; q.dst = wsl + WS_QKV + ((size_t)(32 * nbk) * 1024 + 128 * kb) * 2; q.pitch = 2048; q.f8 = 0; return q; } r -= I3;
    if (r < I4) { const int nbk = r & 31, kb = r >> 5; q.src = C.in[I_NOUT] + (size_t)(128 * kb) * 1024 + 32 * nbk; q.ld = 1024; q.dst = wsl + WS_NOUT + ((size_t)(32 * nbk) * 1024 + 128 * kb) * 2; q.pitch = 2048; q.f8 = 0; return q; } r -= I4;
    q.f8 = 1; q.pitch = 1024;
    if (r < I5) { const int mat = r >> 9, sub = r & 511, nbk = sub & 63, kb = sub >> 6; const int n0 = 32 * nbk, bj = n0 >> 10, f0 = n0 & 1023, pn = f0 >> 7, jj = f0 & 127;
        q.src = C.in[I_WGU] + (size_t)mat * 1024 * 2048 + (size_t)(128 * kb) * 2048 + n0; q.ld = 2048; q.dst = wsl + WS_WGU + ((size_t)mat * 2048 + 256 * pn + 128 * bj + jj) * 1024 + 128 * kb; return q; } r -= I5;
    if (r < I6) { const int mat = r >> 8, sub = r & 255, nbk = sub & 31, kb = sub >> 5;
        q.src = C.in[I_WD] + (size_t)mat * 1024 * 1024 + (size_t)(128 * kb) * 1024 + 32 * nbk; q.ld = 1024; q.dst = wsl + WS_WD + ((size_t)mat * 1024 + 32 * nbk) * 1024 + 128 * kb; return q; } r -= I6;
    { const int nbk = r % 96, kb = r / 96; q.src = C.in[I_WQKV] + (size_t)(128 * kb) * 3072 + 32 * nbk; q.ld = 3072; q.dst = wsl + WS_QKV8 + (size_t)(32 * nbk) * 1024 + 128 * kb; return q; }
}
__device__ __forceinline__ void phase_convert(const Ctx& C) {
    PHASE_IDS
    LAS float* scr = (LAS float*)(C.lds + wave * 16896);
    const int gw = C.bid * NWAVES + wave, NGW = C.G * NWAVES;
    constexpr int NIT = 512 + 256 + 256 + 768 + 256 + 32768 + 16384 + 768;
    if (gw < NIT) {
        const int r = lane >> 3, q4 = lane & 7, c = lane & 15, nn = lane >> 4;
        CvItem cur = cv_item(C, wsl, gw); int it = gw;
        f32x4 v[16];
#pragma unroll
        for (int i = 0; i < 16; ++i) v[i] = __builtin_nontemporal_load((const f32x4*)(cur.src + (size_t)(8 * i + r) * cur.ld + 4 * q4));
        for (;;) {
#pragma unroll
            for (int i = 0; i < 16; ++i) { LAS float* sp = scr + (8 * i + r) * 33 + 4 * q4; sp[0] = v[i][0]; sp[1] = v[i][1]; sp[2] = v[i][2]; sp[3] = v[i][3]; }
            const int nit = it + NGW; CvItem nxt = cur;
            if (nit < NIT) { nxt = cv_item(C, wsl, nit);
#pragma unroll
                for (int i = 0; i < 16; ++i) v[i] = __builtin_nontemporal_load((const f32x4*)(nxt.src + (size_t)(8 * i + r) * nxt.ld + 4 * q4)); }
            asm volatile("s_waitcnt lgkmcnt(0)" ::: "memory");
            if (cur.f8) {
#pragma unroll
                for (int j = 0; j < 8; ++j) { const int n = nn + 4 * j; const LAS float* sp = scr + (8 * c) * 33 + n;
                    u32x2 o; o.x = pk4_fp8(sp[0] * 64.0f, sp[33] * 64.0f, sp[2 * 33] * 64.0f, sp[3 * 33] * 64.0f); o.y = pk4_fp8(sp[4 * 33] * 64.0f, sp[5 * 33] * 64.0f, sp[6 * 33] * 64.0f, sp[7 * 33] * 64.0f);
                    *(u32x2*)(cur.dst + (size_t)n * cur.pitch + 8 * c) = o; }
            } else {
#pragma unroll
                for (int j = 0; j < 8; ++j) { const int n = nn + 4 * j; const LAS float* sp = scr + (8 * c) * 33 + n;
                    u32x4 o; o.x = pk2(sp[0], sp[33]); o.y = pk2(sp[2 * 33], sp[3 * 33]); o.z = pk2(sp[4 * 33], sp[5 * 33]); o.w = pk2(sp[6 * 33], sp[7 * 33]);
                    *(u32x4*)(cur.dst + (size_t)n * cur.pitch + 16 * c) = o; }
            }
            asm volatile("s_waitcnt lgkmcnt(0)" ::: "memory");
            if (nit >= NIT) break;
            cur = nxt; it = nit;
        }
    }
    const int gt = C.bid * NTHREADS + tid, NGT = C.G * NTHREADS;
    for (int i = gt; i < 2048; i += NGT) ((float*)(wsl + WS_CTL + CT_SPL))[i] = 8.0f * 1.44269504089f * log1pf(expf(-C.in[I_LAM][i]));
    for (int i = gt; i < 2 * 32 * 2048; i += NGT) { const int le = i >> 11, r = i & 2047, pn = r >> 8, bj = (r >> 7) & 1, ii = r & 127;
        ((float*)(wsl + WS_BIAS))[i] = C.in[I_BGU][(size_t)le * 2048 + bj * 1024 + 128 * pn + ii] + (bj ? 1.0f : 0.0f); }
    for (int i = gt; i < 2 * 32 * 1024; i += NGT) ((float*)(wsl + WS_BD))[i] = C.in[I_BD][i];
    for (int i = gt; i < 4096; i += NGT) { const int ut = i >> 8, which = (i >> 7) & 1, jj = i & 127, dir = ut >> 3, nb = (ut >> 1) & 3, half = ut & 1;
        ((float*)(wsl + WS_GBIAS))[i] = C.in[which ? I_BX : I_BA][dir * 1024 + 256 * nb + 128 * half + jj]; }
    for (int i0 = gt; i0 < NTOK * 128; i0 += 4 * NGT) { f32x4 a[4], b[4];
#pragma unroll
        for (int u = 0; u < 4; ++u) { const int i = i0 + u * NGT; if (i < NTOK * 128) { const int row = i >> 7, oc = i & 127;
            const float* src = (row < NGRID ? C.in[I_X] + (size_t)row * D : C.in[I_META] + (size_t)((row - NGRID) & 15) * D) + 8 * oc;
            a[u] = __builtin_nontemporal_load((const f32x4*)src); b[u] = __builtin_nontemporal_load((const f32x4*)(src + 4)); } }
#pragma unroll
        for (int u = 0; u < 4; ++u) { const int i = i0 + u * NGT; if (i < NTOK * 128) { const int row = i >> 7, oc = i & 127;
            u32x4 w; w.x = pk2(a[u][0], a[u][1]); w.y = pk2(a[u][2], a[u][3]); w.z = pk2(b[u][0], b[u][1]); w.w = pk2(b[u][2], b[u][3]);
            *(u32x4*)((bf16_t*)(wsl + WS_HB) + (size_t)row * D + 8 * oc) = w; } } }
}

__device__ __forceinline__ void phase_conv(const Ctx& C) {
    PHASE_IDS
    const bf16_t* XR = (const bf16_t*)(wsl + WS_XR); bf16_t* XC = (bf16_t*)(wsl + WS_XC);
    const float* cw = C.in[I_CONVW]; const float* cb = C.in[I_CONVB];
    const int gt = C.bid * NTHREADS + tid, NGT = C.G * NTHREADS;
    for (int i = gt; i < NTOK * 128; i += NGT) { const int row = i >> 7, ch = 8 * (i & 127);
        int b, s; if (row < NGRID) { b = row >> 12; s = NMETA + (row & (SEQ - 1)); } else { b = (row - NGRID) >> 4; s = (row - NGRID) & 15; }
        float a[8];
        { const f32x4 t0 = *(const f32x4*)(cb + ch), t1 = *(const f32x4*)(cb + ch + 4);
#pragma unroll
          for (int j = 0; j < 4; ++j) { a[j] = t0[j]; a[4 + j] = t1[j]; } }
#pragma unroll
        for (int j = 0; j < 4; ++j) { const int sj = s - 2 + j;
            if (sj >= 0 && sj < LSEQ) { const u32x4 xw = *(const u32x4*)(XR + (size_t)seqrow(b, sj) * D + ch);
                const f32x4 w0 = *(const f32x4*)(cw + j * 1024 + ch), w1 = *(const f32x4*)(cw + j * 1024 + ch + 4);
                a[0] += w0[0] * bflo(xw.x); a[1] += w0[1] * bfhi(xw.x); a[2] += w0[2] * bflo(xw.y); a[3] += w0[3] * bfhi(xw.y);
                a[4] += w1[0] * bflo(xw.z); a[5] += w1[1] * bfhi(xw.z); a[6] += w1[2] * bflo(xw.w); a[7] += w1[3] * bfhi(xw.w); } }
        u32x4 w; w.x = pk2(a[0], a[1]); w.y = pk2(a[2], a[3]); w.z = pk2(a[4], a[5]); w.w = pk2(a[6], a[7]);
        *(u32x4*)(XC + (size_t)row * D + ch) = w; }
}

template <int N> __device__ __forceinline__ float dpp_shr(float oldv, float v) {
    return __builtin_bit_cast(float, __builtin_amdgcn_update_dpp(__builtin_bit_cast(int, oldv), __builtin_bit_cast(int, v), 0x110 + N, 0xf, 0xf, false));
}
__device__ __forceinline__ void scan_group(float (&a)[8], float (&b)[8]) {
#pragma unroll
    for (int c = 0; c < 8; ++c) {
        { const float ap = dpp_shr<1>(1.0f, a[c]), bp = dpp_shr<1>(0.0f, b[c]); b[c] = a[c] * bp + b[c]; a[c] = a[c] * ap; }
        { const float ap = dpp_shr<2>(1.0f, a[c]), bp = dpp_shr<2>(0.0f, b[c]); b[c] = a[c] * bp + b[c]; a[c] = a[c] * ap; }
        { const float ap = dpp_shr<4>(1.0f, a[c]), bp = dpp_shr<4>(0.0f, b[c]); b[c] = a[c] * bp + b[c]; a[c] = a[c] * ap; }
        { const float ap = dpp_shr<8>(1.0f, a[c]), bp = dpp_shr<8>(0.0f, b[c]); b[c] = a[c] * bp + b[c]; a[c] = a[c] * ap; }
    }
}
__device__ __forceinline__ void unpack8(const u32x4 w, float (&o)[8]) { o[0] = bflo(w.x); o[1] = bfhi(w.x); o[2] = bflo(w.y); o[3] = bfhi(w.y); o[4] = bflo(w.z); o[5] = bfhi(w.z); o[6] = bflo(w.w); o[7] = bfhi(w.w); }
__device__ __forceinline__ void phase_scan(const Ctx& C) {
    PHASE_IDS
    const unsigned char* LB = wsl + WS_LA; const float* spl = (const float*)(wsl + WS_CTL + CT_SPL); const bf16_t* GY = (const bf16_t*)(wsl + WS_GY);
    bf16_t* HF = (bf16_t*)(wsl + WS_HF); bf16_t* Gout = (bf16_t*)(wsl + WS_G);
    LAS float* agg = (LAS float*)C.lds;
    const int w = wave, oct = lane >> 4, p = lane & 15;
    for (int it0 = (C.G == 256 ? C.gc : C.bid); it0 < NB * 32; it0 += C.G) {
        const int item = (C.G == 256) ? (((it0 >> 3) >> 2) << 5) + ((it0 & 7) << 2) + ((it0 >> 3) & 3) : it0;
        const int b = item >> 5, g = item & 31;
        for (int dir = 0; dir < 2; ++dir) {
            const unsigned char* lb = LB + (((size_t)dir * 32 + g) * MPAD) * 64 + 16 * oct;
            float cs[8];
            { const f32x4 p0 = *(const f32x4*)(spl + dir * 1024 + 32 * g + 8 * oct), p1 = *(const f32x4*)(spl + dir * 1024 + 32 * g + 8 * oct + 4);
#pragma unroll
              for (int c = 0; c < 4; ++c) { cs[c] = p0[c] * (-1.0f / 256.0f); cs[4 + c] = p1[c] * (-1.0f / 256.0f); } }
            float S[8];
#pragma unroll
            for (int c = 0; c < 8; ++c) S[c] = 0.f;
            {
                const int u = p, s = dir ? LSEQ - 1 - u : u, row = seqrow(b, s);
                float a[8], x[8]; { const u32x4 rec = *(const u32x4*)(lb + (size_t)row * 64); u32x2 t; t.x = rec.x; t.y = rec.y; unpack8_fp8(t, a); t.x = rec.z; t.y = rec.w; unpack8_fp8(t, x); }
#pragma unroll
                for (int c = 0; c < 8; ++c) { a[c] = fast_exp2(a[c] * cs[c]); x[c] *= 0.125f; }
                scan_group(a, x);
                if (w == 0) {
                    if (dir == 0) { u32x4 o; o.x = pk2(x[0], x[1]); o.y = pk2(x[2], x[3]); o.z = pk2(x[4], x[5]); o.w = pk2(x[6], x[7]); *(u32x4*)(HF + ((size_t)g * MPAD + row) * 32 + 8 * oct) = o; }
                    else { float hf[8], gy[8]; unpack8(*(const u32x4*)(HF + ((size_t)g * MPAD + row) * 32 + 8 * oct), hf); unpack8(*(const u32x4*)(GY + ((size_t)g * MPAD + row) * 32 + 8 * oct), gy);
                        u32x4 o; o.x = pk2((hf[0] + x[0]) * gy[0], (hf[1] + x[1]) * gy[1]); o.y = pk2((hf[2] + x[2]) * gy[2], (hf[3] + x[3]) * gy[3]);
                        o.z = pk2((hf[4] + x[4]) * gy[4], (hf[5] + x[5]) * gy[5]); o.w = pk2((hf[6] + x[6]) * gy[6], (hf[7] + x[7]) * gy[7]);
                        *(u32x4*)(Gout + (size_t)row * D + 32 * g + 8 * oct) = o; }
                }
#pragma unroll
                for (int c = 0; c < 8; ++c) S[c] = __shfl(x[c], (lane & 48) | 15);
            }
            u32x4 na[4];
#pragma unroll
            for (int j = 0; j < 4; ++j) { const int u = 16 + 64 * w + 16 * j + p, s = dir ? LSEQ - 1 - u : u; const int rw = seqrow(b, s);
                na[j] = __builtin_nontemporal_load((const u32x4*)(lb + (size_t)rw * 64)); }
            for (int r = 0; r < 8; ++r) {
                float Pw[4][8], Hw[4][8]; int rows[4];
                float Aw[8], Hc[8];
#pragma unroll
                for (int c = 0; c < 8; ++c) { Aw[c] = 1.f; Hc[c] = 0.f; }
                u32x4 ra[4], rhf[4], rgy[4];
#pragma unroll
                for (int j = 0; j < 4; ++j) { const int u = 16 + 512 * r + 64 * w + 16 * j + p, s = dir ? LSEQ - 1 - u : u; rows[j] = seqrow(b, s); ra[j] = na[j]; }
                if (r < 7) {
#pragma unroll
                    for (int j = 0; j < 4; ++j) { const int u = 16 + 512 * (r + 1) + 64 * w + 16 * j + p, s = dir ? LSEQ - 1 - u : u; const int rw = seqrow(b, s);
                        na[j] = __builtin_nontemporal_load((const u32x4*)(lb + (size_t)rw * 64)); } }
                if (dir == 1) {
#pragma unroll
                    for (int j = 0; j < 4; ++j) { const size_t go = ((size_t)g * MPAD + rows[j]) * 32 + 8 * oct; rhf[j] = *(const u32x4*)(HF + go); rgy[j] = __builtin_nontemporal_load((const u32x4*)(GY + go)); } }
#pragma unroll
                for (int j = 0; j < 4; ++j) {
                    float a[8], x[8]; { u32x2 t; t.x = ra[j].x; t.y = ra[j].y; unpack8_fp8(t, a); t.x = ra[j].z; t.y = ra[j].w; unpack8_fp8(t, x); }
#pragma unroll
                    for (int c = 0; c < 8; ++c) { a[c] = fast_exp2(a[c] * cs[c]); x[c] *= 0.125f; }
                    scan_group(a, x);
#pragma unroll
                    for (int c = 0; c < 8; ++c) { Hw[j][c] = a[c] * Hc[c] + x[c]; Pw[j][c] = a[c] * Aw[c]; }
#pragma unroll
                    for (int c = 0; c < 8; ++c) { Aw[c] = __shfl(Pw[j][c], (lane & 48) | 15); Hc[c] = __shfl(Hw[j][c], (lane & 48) | 15); }
                }
                LAS float* ag = agg + (r & 1) * 512;
                if (p == 0) {
#pragma unroll
                    for (int c = 0; c < 8; ++c) { ag[(w * 32 + oct * 8 + c) * 2] = Aw[c]; ag[(w * 32 + oct * 8 + c) * 2 + 1] = Hc[c]; }
                }
                __syncthreads();
                float Sin[8];
#pragma unroll
                for (int c = 0; c < 8; ++c) Sin[c] = S[c];
#pragma unroll
                for (int ww = 0; ww < 8; ++ww) {
#pragma unroll
                    for (int c = 0; c < 8; ++c) { const float A = ag[(ww * 32 + oct * 8 + c) * 2], H = ag[(ww * 32 + oct * 8 + c) * 2 + 1];
                        if (ww == w) Sin[c] = S[c];
                        S[c] = A * S[c] + H; }
                }
#pragma unroll
                for (int j = 0; j < 4; ++j) {
                    float h[8];
#pragma unroll
                    for (int c = 0; c < 8; ++c) h[c] = Pw[j][c] * Sin[c] + Hw[j][c];
                    const size_t go = ((size_t)g * MPAD + rows[j]) * 32 + 8 * oct;
                    if (dir == 0) { u32x4 o; o.x = pk2(h[0], h[1]); o.y = pk2(h[2], h[3]); o.z = pk2(h[4], h[5]); o.w = pk2(h[6], h[7]); *(u32x4*)(HF + go) = o; }
                    else { float hf[8], gy[8]; unpack8(rhf[j], hf); unpack8(rgy[j], gy);
                        u32x4 o; o.x = pk2((hf[0] + h[0]) * gy[0], (hf[1] + h[1]) * gy[1]); o.y = pk2((hf[2] + h[2]) * gy[2], (hf[3] + h[3]) * gy[3]);
                        o.z = pk2((hf[4] + h[4]) * gy[4], (hf[5] + h[5]) * gy[5]); o.w = pk2((hf[6] + h[6]) * gy[6], (hf[7] + h[7]) * gy[7]);
                        *(u32x4*)(Gout + (size_t)rows[j] * D + 32 * g + 8 * oct) = o; }
                }
            }
            __syncthreads();
        }
    }
}

template <int K> __device__ __forceinline__ f32x4 mini_mma(const bf16_t* W, int ldw, const bf16_t* A, int lda, int lane) {
    const bf16_t* wp = W + (size_t)(lane & 15) * ldw + 8 * (lane >> 4); const bf16_t* ap = A + (size_t)(lane & 15) * lda + 8 * (lane >> 4);
    f32x4 acc = {0.f, 0.f, 0.f, 0.f};
    constexpr int KB = K < 512 ? K : 512, NS = KB / 32;
#pragma unroll 1
    for (int k0 = 0; k0 < K; k0 += KB) { bf16x8 wf[NS], af[NS];
#pragma unroll
        for (int i = 0; i < NS; ++i) { wf[i] = *(const bf16x8*)(wp + k0 + 32 * i); af[i] = *(const bf16x8*)(ap + k0 + 32 * i); }
#pragma unroll
        for (int i = 0; i < NS; ++i) acc = __builtin_amdgcn_mfma_f32_16x16x32_bf16(wf[i], af[i], acc, 0, 0, 0); }
    return acc;
}
__device__ __forceinline__ void mini_win(const Ctx& C) {
    PHASE_IDS
    const bf16_t* HB = (const bf16_t*)(C.ws + WS_HB); const bf16_t* WT = (const bf16_t*)(C.ws + WS_WIN); bf16_t* XR = (bf16_t*)(C.ws + WS_XR); bf16_t* GY = (bf16_t*)(C.ws + WS_GY);
    const int fr = lane & 15, fq = lane >> 4;
    for (int wt = C.gc * NWAVES + wave; wt < 8 * 128; wt += C.G * NWAVES) { const int rg = wt & 7, cb = wt >> 3, row = NGRID + 16 * rg + fr, c = 16 * cb + 4 * fq;
        const f32x4 a = mini_mma<1024>(WT + (size_t)(16 * cb) * 1024, 1024, HB + (size_t)(NGRID + 16 * rg) * 1024, 1024, lane);
        if (c < 1024) { u32x2 w; w.x = cvt_pk_bf16(a[0], a[1]); w.y = cvt_pk_bf16(a[2], a[3]); *(u32x2*)(XR + (size_t)row * D + c) = w; }
        else { const int yc = c - 1024; float o[4];
#pragma unroll
            for (int j = 0; j < 4; ++j) { const float v = a[j]; const float z = 1.5957691216f * (v + 0.044715f * v * v * v); o[j] = v * sigmoidf_(z); }
            u32x2 w; w.x = cvt_pk_bf16(o[0], o[1]); w.y = cvt_pk_bf16(o[2], o[3]); *(u32x2*)(GY + ((size_t)(yc >> 5) * MPAD + row) * 32 + (yc & 31)) = w; } }
}
__device__ __forceinline__ void mini_gate(const Ctx& C) {
    PHASE_IDS
    const bf16_t* XC = (const bf16_t*)(C.ws + WS_XC); const bf16_t* GT = (const bf16_t*)(C.ws + WS_GATE); unsigned char* LB = C.ws + WS_LA;
    const float* ba = C.in[I_BA]; const float* bx = C.in[I_BX]; const float* spl = (const float*)(C.ws + WS_CTL + CT_SPL);
    const int fr = lane & 15, fq = lane >> 4;
    for (int wt = C.gc * NWAVES + wave; wt < 8 * 2 * 64; wt += C.G * NWAVES) { const int rg = wt & 7, dir = (wt >> 3) & 1, chg = wt >> 4, ch0 = 16 * chg, nb = ch0 >> 8, half = (ch0 >> 7) & 1, jj0 = ch0 & 127;
        const bf16_t* A = XC + (size_t)(NGRID + 16 * rg) * 1024 + 256 * nb; const bf16_t* Wa = GT + ((size_t)nb * 1024 + 256 * (2 * dir + half) + jj0) * 256;
        const f32x4 za = mini_mma<256>(Wa, 256, A, 1024, lane), zx = mini_mma<256>(Wa + 128 * 256, 256, A, 1024, lane);
        const int row = NGRID + 16 * rg + fr, ch = ch0 + 4 * fq;
        const f32x4 cba = *(const f32x4*)(ba + dir * 1024 + ch), cbx = *(const f32x4*)(bx + dir * 1024 + ch), csp = *(const f32x4*)(spl + dir * 1024 + ch);
        const u32x2 xw = *(const u32x2*)(XC + (size_t)row * D + ch); const float xc[4] = {bflo(xw.x), bfhi(xw.x), bflo(xw.y), bfhi(xw.y)};
        float sg[4], bb[4];
#pragma unroll
        for (int j = 0; j < 4; ++j) { const float sga = sigmoidf_(za[j] + cba[j]); const float a2 = fast_exp2(-2.0f * csp[j] * sga);
            const float mult = (dir == 0 && fr == 0) ? 8.0f : 8.0f * __builtin_amdgcn_sqrtf(fmaxf(1.0f - a2, 0.0f));
            sg[j] = sga * 256.0f; bb[j] = __builtin_amdgcn_fmed3f(mult * sigmoidf_(zx[j] + cbx[j]) * xc[j], -448.0f, 448.0f); }
        unsigned char* o = LB + (((size_t)dir * 32 + (ch >> 5)) * MPAD + row) * 64 + 16 * ((ch & 31) >> 3) + (ch & 7);
        *(unsigned*)o = pk4_fp8(sg[0], sg[1], sg[2], sg[3]); *(unsigned*)(o + 8) = pk4_fp8(bb[0], bb[1], bb[2], bb[3]); }
}
__device__ __forceinline__ void mini_lout(const Ctx& C) {
    PHASE_IDS
    const bf16_t* G = (const bf16_t*)(C.ws + WS_G); const bf16_t* WT = (const bf16_t*)(C.ws + WS_LOUT); bf16_t* PRE = (bf16_t*)(C.ws + WS_PRE); const float* meta = C.in[I_META];
    const int fr = lane & 15, fq = lane >> 4;
    for (int wt = C.gc * NWAVES + wave; wt < 8 * 64; wt += C.G * NWAVES) { const int rg = wt & 7, cb = wt >> 3, row = NGRID + 16 * rg + fr, c = 16 * cb + 4 * fq;
        const f32x4 a = mini_mma<1024>(WT + (size_t)(16 * cb) * 1024, 1024, G + (size_t)(NGRID + 16 * rg) * 1024, 1024, lane);
        const f32x4 r = *(const f32x4*)(meta + (size_t)fr * D + c);
        u32x2 w; w.x = cvt_pk_bf16(r[0] * DN_ALPHA + a[0], r[1] * DN_ALPHA + a[1]); w.y = cvt_pk_bf16(r[2] * DN_ALPHA + a[2], r[3] * DN_ALPHA + a[3]); *(u32x2*)(PRE + (size_t)row * D + c) = w; }
}
__device__ __forceinline__ void mini_kv(const Ctx& C) {
    PHASE_IDS
    const bf16_t* HB = (const bf16_t*)(C.ws + WS_HB); const bf16_t* WT = (const bf16_t*)(C.ws + WS_QKV); bf16_t* Kx = (bf16_t*)(C.ws + WS_K); bf16_t* VT = (bf16_t*)(C.ws + WS_VT);
    const int fr = lane & 15, fq = lane >> 4;
    for (int wt = C.gc * NWAVES + wave; wt < 2 * 8 * 64; wt += C.G * NWAVES) { const int rg = wt & 7, cb = (wt >> 3) & 63, isv = wt >> 9;
        const bf16_t* A = HB + (size_t)(NGRID + 16 * rg) * 1024;
        if (!isv) { const f32x4 a = mini_mma<1024>(WT + (size_t)(1024 + 16 * cb) * 1024, 1024, A, 1024, lane);
            u32x2 w; w.x = cvt_pk_bf16(a[0], a[1]); w.y = cvt_pk_bf16(a[2], a[3]); *(u32x2*)(Kx + (size_t)(NGRID + 16 * rg + fr) * D + 16 * cb + 4 * fq) = w; }
        else { const f32x4 a = mini_mma<1024>(A, 1024, WT + (size_t)(2048 + 16 * cb) * 1024, 1024, lane);
            u32x2 w; w.x = cvt_pk_bf16(a[0], a[1]); w.y = cvt_pk_bf16(a[2], a[3]); *(u32x2*)(VT + (size_t)(16 * cb + fr) * MPAD + NGRID + 16 * rg + 4 * fq) = w; } }
}

constexpr int RWT_PITCH = 516;
__device__ __forceinline__ void phase_lnr(const Ctx& C, int layer, int nrows) {
    PHASE_IDS
    const bf16_t* PRE = (const bf16_t*)(wsl + WS_PRE); bf16_t* HB = (bf16_t*)(wsl + WS_HB); unsigned char* HB8 = wsl + WS_HB8;
    const float* lg = C.in[I_LNMG] + layer * D; const float* lb = C.in[I_LNMB] + layer * D;
    const float* rw = C.in[I_RW] + (size_t)layer * D * NEXP; const float* rb = C.in[I_RB] + layer * NEXP;
    int* eid = (int*)(wsl + WS_CTL + CT_EID) + (size_t)layer * NTOK * 4; float* gatev = (float*)(wsl + WS_CTL + CT_GATEV) + (size_t)layer * NTOK * 4;
    unsigned* bc = (unsigned*)(wsl + WS_CTL + CT_BC) + ((size_t)layer * 256 + C.bid) * 32;
    LAS unsigned* RWt = (LAS unsigned*)C.lds; LAS unsigned* hist = (LAS unsigned*)(C.lds + 32 * RWT_PITCH * 4);
#pragma unroll
    for (int i = 0; i < 8; ++i) { const int idx = tid + NTHREADS * i, pc = idx >> 3, e4 = (idx & 7) * 4, ch = 2 * pc;
        const f32x4 w0 = *(const f32x4*)(rw + (size_t)ch * NEXP + e4), w1 = *(const f32x4*)(rw + (size_t)(ch + 1) * NEXP + e4);
        const int slot = 4 * ((ch & 511) >> 3) + 256 * (ch >> 9) + ((ch & 7) >> 1);
        RWt[(e4 + 0) * RWT_PITCH + slot] = pk2(w0[0], w1[0]); RWt[(e4 + 1) * RWT_PITCH + slot] = pk2(w0[1], w1[1]); RWt[(e4 + 2) * RWT_PITCH + slot] = pk2(w0[2], w1[2]); RWt[(e4 + 3) * RWT_PITCH + slot] = pk2(w0[3], w1[3]); }
    if (tid < 32) hist[tid] = 0u;
    __syncthreads();
    float gg[2][8], gb[2][8];
#pragma unroll
    for (int j = 0; j < 2; ++j) { const f32x4 a0 = *(const f32x4*)(lg + 8 * lane + 512 * j), a1 = *(const f32x4*)(lg + 8 * lane + 512 * j + 4), b0 = *(const f32x4*)(lb + 8 * lane + 512 * j), b1 = *(const f32x4*)(lb + 8 * lane + 512 * j + 4);
#pragma unroll
        for (int i = 0; i < 4; ++i) { gg[j][i] = a0[i]; gg[j][4 + i] = a1[i]; gb[j][i] = b0[i]; gb[j][4 + i] = b1[i]; } }
    const float rbias = rb[lane >> 1];
    const int gw = C.bid * NWAVES + wave, NGW = C.G * NWAVES;
    u32x4 nv[2];
    if (gw < nrows) {
#pragma unroll
        for (int j = 0; j < 2; ++j) nv[j] = __builtin_nontemporal_load((const u32x4*)(PRE + (size_t)gw * D + 8 * lane + 512 * j)); }
    for (int row = gw; row < nrows; row += NGW) {
        float v[2][8]; float s = 0.f; u32x4 hp[2];
#pragma unroll
        for (int j = 0; j < 2; ++j) { unpack8(nv[j], v[j]); s += ((v[j][0] + v[j][1]) + (v[j][2] + v[j][3])) + ((v[j][4] + v[j][5]) + (v[j][6] + v[j][7])); }
        if (row + NGW < nrows) {
#pragma unroll
            for (int j = 0; j < 2; ++j) nv[j] = __builtin_nontemporal_load((const u32x4*)(PRE + (size_t)(row + NGW) * D + 8 * lane + 512 * j)); }
        const float mean = wave_sum_dpp(s) * (1.0f / D); float q = 0.f;
#pragma unroll
        for (int j = 0; j < 2; ++j)
#pragma unroll
            for (int i = 0; i < 8; ++i) { v[j][i] -= mean; q += v[j][i] * v[j][i]; }
        const float rstd = __builtin_amdgcn_rsqf(wave_sum_dpp(q) * (1.0f / D) + LN_EPS);
#pragma unroll
        for (int j = 0; j < 2; ++j) {
#pragma unroll
            for (int i = 0; i < 8; ++i) v[j][i] = v[j][i] * rstd * gg[j][i] + gb[j][i];
            u32x4 w; w.x = pk2(v[j][0], v[j][1]); w.y = pk2(v[j][2], v[j][3]); w.z = pk2(v[j][4], v[j][5]); w.w = pk2(v[j][6], v[j][7]);
            *(u32x4*)(HB + (size_t)row * D + 8 * lane + 512 * j) = w; hp[j] = w;
            u32x2 w8; w8.x = pk4_fp8(v[j][0], v[j][1], v[j][2], v[j][3]); w8.y = pk4_fp8(v[j][4], v[j][5], v[j][6], v[j][7]);
            *(u32x2*)(HB8 + (size_t)row * D + 8 * lane + 512 * j) = w8; }
        float pl[32];
#pragma unroll
        for (int e0 = 0; e0 < 32; e0 += 8) {
            u32x4 wv[8][2];
#pragma unroll
            for (int ee = 0; ee < 8; ++ee)
#pragma unroll
                for (int j = 0; j < 2; ++j) wv[ee][j] = *(const LAS u32x4*)(RWt + (e0 + ee) * RWT_PITCH + 4 * lane + 256 * j);
            __builtin_amdgcn_sched_barrier(0);
#pragma unroll
            for (int ee = 0; ee < 8; ++ee) { float a = 0.f;
#pragma unroll
                for (int j = 0; j < 2; ++j) { a = dot2_bf16(hp[j].x, wv[ee][j].x, a);
                    a = dot2_bf16(hp[j].y, wv[ee][j].y, a);
                    a = dot2_bf16(hp[j].z, wv[ee][j].z, a);
                    a = dot2_bf16(hp[j].w, wv[ee][j].w, a); }
                pl[e0 + ee] = a; }
        }
        float q16[16], q8[8], q4[4], q2[2], q1;
        { const bool hi = (lane & 32) != 0;
#pragma unroll
          for (int e = 0; e < 16; ++e) { const float mine = hi ? pl[16 + e] : pl[e], other = hi ? pl[e] : pl[16 + e]; q16[e] = mine + __shfl_xor(other, 32); } }
        { const bool hi = (lane & 16) != 0;
#pragma unroll
          for (int e = 0; e < 8; ++e) { const float mine = hi ? q16[8 + e] : q16[e], other = hi ? q16[e] : q16[8 + e]; q8[e] = mine + __shfl_xor(other, 16); } }
        { const bool hi = (lane & 8) != 0;
#pragma unroll
          for (int e = 0; e < 4; ++e) { const float mine = hi ? q8[4 + e] : q8[e], other = hi ? q8[e] : q8[4 + e]; q4[e] = mine + dpp_movf<0x128>(other); } }
        { const bool hi = (lane & 4) != 0;
#pragma unroll
          for (int e = 0; e < 2; ++e) { const float mine = hi ? q4[2 + e] : q4[e], other = hi ? q4[e] : q4[2 + e]; q2[e] = mine + __shfl_xor(other, 4); } }
        { const bool hi = (lane & 2) != 0; const float mine = hi ? q2[1] : q2[0], other = hi ? q2[0] : q2[1]; q1 = mine + dpp_movf<0x4E>(other); }
        q1 += dpp_movf<0xB1>(q1);
        float lv = q1 + rbias; lv = (lv == lv) ? lv : -3.0e38f;
        const int le = lane >> 1;
        int rank = 0;
#pragma unroll
        for (int j = 0; j < 32; ++j) { const float lj = readlane_f(lv, 2 * j); rank += (lj > lv || (lj == lv && j < le)) ? 1 : 0; }
        const unsigned long long m0 = __ballot(rank == 0);
        const float mxl = readlane_f(lv, (int)__builtin_ctzll(m0));
        const float pe = rank < 4 ? __expf(lv - mxl) : 0.f;
        const float den = wave_sum_dpp(pe) * 0.5f;
        if (rank < 4 && (lane & 1) == 0) { eid[(size_t)row * 4 + rank] = le; gatev[(size_t)row * 4 + rank] = pe / den;
            __hip_atomic_fetch_add(&hist[le], 1u, __ATOMIC_RELAXED, __HIP_MEMORY_SCOPE_WORKGROUP); }
    }
    __syncthreads();
    if (tid < 32) bc[tid] = hist[tid];
}

__device__ __forceinline__ void phase_pos(const Ctx& C, int layer, int nrows) {
    PHASE_IDS
    const unsigned* bcAll = (const unsigned*)(wsl + WS_CTL + CT_BC) + (size_t)layer * 256 * 32;
    const int* eid = (const int*)(wsl + WS_CTL + CT_EID) + (size_t)layer * NTOK * 4; int* posv = (int*)(wsl + WS_CTL + CT_POS) + (size_t)layer * NTOK * 4;
    int* texp = (int*)(wsl + WS_CTL + CT_TEXP) + layer * 1024;
    int* tokoff = (int*)(wsl + WS_TOK) + (size_t)layer * (1 * MiB / 4);
    LAS unsigned* partT = (LAS unsigned*)C.lds; LAS unsigned* partP = partT + 512; LAS unsigned* tot = partP + 512; LAS unsigned* cnt = tot + 32;
    { const int e = tid & 31, part = tid >> 5; unsigned t = 0, pr = 0;
      unsigned vv[16];
#pragma unroll
      for (int i = 0; i < 16; ++i) { const int bq = part + 16 * i; vv[i] = bq < C.G ? bcAll[(size_t)bq * 32 + e] : 0u; }
#pragma unroll
      for (int i = 0; i < 16; ++i) { const int bq = part + 16 * i; t += vv[i]; if (bq < C.bid) pr += vv[i]; }
      partT[part * 32 + e] = t; partP[part * 32 + e] = pr; }
    __syncthreads();
    if (tid < 32) { unsigned t = 0, pr = 0; for (int i = 0; i < 16; ++i) { t += partT[i * 32 + tid]; pr += partP[i * 32 + tid]; } tot[tid] = t; cnt[tid] = pr; }
    __syncthreads();
    if (tid < 32) { unsigned off = 0; for (int e = 0; e < tid; ++e) off += (tot[e] + 255u) & ~255u;
        const unsigned mine = (tot[tid] + 255u) & ~255u;
        if (C.bid == 0) { for (unsigned t = off >> 8; t < ((off + mine) >> 8); ++t) texp[t] = tid; if (tid == 31) texp[1023] = (int)((off + mine) >> 8);
            for (unsigned p = off + tot[tid]; p < off + mine; ++p) tokoff[p] = 0; }
        cnt[tid] += off; }
    __syncthreads();
    const int gw = C.bid * NWAVES + wave, NGW = C.G * NWAVES;
    for (int row = gw; row < nrows; row += NGW) {
        int pos = 0;
        if (lane < 4) { const int e = eid[(size_t)row * 4 + lane]; pos = (int)__hip_atomic_fetch_add(&cnt[e], 1u, __ATOMIC_RELAXED, __HIP_MEMORY_SCOPE_WORKGROUP); posv[(size_t)row * 4 + lane] = pos; }
        if (lane < 4) tokoff[pos] = row * 1024;
    }
}

__device__ __forceinline__ void phase_combine(const Ctx& C, int layer, int nrows, bool final_out) {
    PHASE_IDS
    bf16_t* HB = (bf16_t*)(wsl + WS_HB); unsigned char* HB8 = wsl + WS_HB8; const unsigned char* YS = wsl + WS_YS;
    const float* lg = C.in[I_LNFG] + layer * D; const float* lb = C.in[I_LNFB] + layer * D;
    const float* gatev = (const float*)(wsl + WS_CTL + CT_GATEV) + (size_t)layer * NTOK * 4; const int* posv = (const int*)(wsl + WS_CTL + CT_POS) + (size_t)layer * NTOK * 4;
    float gg[2][8], gb[2][8];
#pragma unroll
    for (int j = 0; j < 2; ++j) { const f32x4 a0 = *(const f32x4*)(lg + 8 * lane + 512 * j), a1 = *(const f32x4*)(lg + 8 * lane + 512 * j + 4), b0 = *(const f32x4*)(lb + 8 * lane + 512 * j), b1 = *(const f32x4*)(lb + 8 * lane + 512 * j + 4);
#pragma unroll
        for (int i = 0; i < 4; ++i) { gg[j][i] = a0[i]; gg[j][4 + i] = a1[i]; gb[j][i] = b0[i]; gb[j][4 + i] = b1[i]; } }
    const int gw = C.bid * NWAVES + wave, NGW = C.G * NWAVES;
    f32x4 g1 = {0.f, 0.f, 0.f, 0.f}, g2 = g1; int p1[4] = {0, 0, 0, 0}, p2[4] = {0, 0, 0, 0};
    u32x4 hwn[2]; u32x2 ywn[4][2];
#define CB_ROUTE(row_, gq, pq) do { gq = *(const f32x4*)(gatev + (size_t)(row_) * 4); const u32x4 _pp = *(const u32x4*)(posv + (size_t)(row_) * 4); pq[0] = (int)_pp.x; pq[1] = (int)_pp.y; pq[2] = (int)_pp.z; pq[3] = (int)_pp.w; } while (0)
#define CB_DATA(row_, pq) do { _Pragma("unroll") for (int j = 0; j < 2; ++j) { hwn[j] = *(const u32x4*)(HB + (size_t)(row_) * D + 8 * lane + 512 * j); \
            _Pragma("unroll") for (int k = 0; k < 4; ++k) ywn[k][j] = __builtin_nontemporal_load((const u32x2*)(YS + (size_t)pq[k] * D + 8 * lane + 512 * j)); } } while (0)
    if (gw < nrows) { CB_ROUTE(gw, g1, p1); CB_DATA(gw, p1); }
    if (gw + NGW < nrows) CB_ROUTE(gw + NGW, g2, p2);
    for (int row = gw; row < nrows; row += NGW) {
        const f32x4 gk4 = g1 * 0.125f; u32x4 hw[2]; u32x2 yw[4][2];
#pragma unroll
        for (int j = 0; j < 2; ++j) { hw[j] = hwn[j];
#pragma unroll
            for (int k = 0; k < 4; ++k) yw[k][j] = ywn[k][j]; }
        g1 = g2;
#pragma unroll
        for (int k = 0; k < 4; ++k) p1[k] = p2[k];
        if (row + NGW < nrows) CB_DATA(row + NGW, p1);
        if (row + 2 * NGW < nrows) CB_ROUTE(row + 2 * NGW, g2, p2);
        float v[2][8]; float s = 0.f;
#pragma unroll
        for (int j = 0; j < 2; ++j) { float h[8]; unpack8(hw[j], h);
#pragma unroll
            for (int i = 0; i < 8; ++i) v[j][i] = h[i] * DN_ALPHA;
#pragma unroll
            for (int k = 0; k < 4; ++k) { float y[8]; unpack8_fp8(yw[k][j], y);
#pragma unroll
                for (int i = 0; i < 8; ++i) v[j][i] += gk4[k] * y[i]; }
#pragma unroll
            for (int i = 0; i < 8; ++i) s += v[j][i]; }
        const float mean = wave_sum_dpp(s) * (1.0f / D); float q = 0.f;
#pragma unroll
        for (int j = 0; j < 2; ++j)
#pragma unroll
            for (int i = 0; i < 8; ++i) { v[j][i] -= mean; q += v[j][i] * v[j][i]; }
        const float rstd = __builtin_amdgcn_rsqf(wave_sum_dpp(q) * (1.0f / D) + LN_EPS);
#pragma unroll
        for (int j = 0; j < 2; ++j) {
#pragma unroll
            for (int i = 0; i < 8; ++i) v[j][i] = v[j][i] * rstd * gg[j][i] + gb[j][i];
            if (final_out) { *(f32x4*)(C.out + (size_t)row * D + 8 * lane + 512 * j) = (f32x4){v[j][0], v[j][1], v[j][2], v[j][3]}; *(f32x4*)(C.out + (size_t)row * D + 8 * lane + 512 * j + 4) = (f32x4){v[j][4], v[j][5], v[j][6], v[j][7]}; }
            else { u32x4 w; w.x = pk2(v[j][0], v[j][1]); w.y = pk2(v[j][2], v[j][3]); w.z = pk2(v[j][4], v[j][5]); w.w = pk2(v[j][6], v[j][7]); *(u32x4*)(HB + (size_t)row * D + 8 * lane + 512 * j) = w;
                u32x2 w8; w8.x = pk4_fp8(v[j][0], v[j][1], v[j][2], v[j][3]); w8.y = pk4_fp8(v[j][4], v[j][5], v[j][6], v[j][7]); *(u32x2*)(HB8 + (size_t)row * D + 8 * lane + 512 * j) = w8; } }
    }
#undef CB_ROUTE
#undef CB_DATA
}

constexpr int AT_KS = 0, AT_VTS = 73728, AT_VPITCH = 1168, AT_KM = AT_VTS + 64 * AT_VPITCH, AT_VTM = AT_KM + 2048, AT_RPB = AT_VTM + 2048, AT_MB = AT_RPB + 1920, AT_END = AT_MB + 64;
static_assert(AT_END <= LDS_BYTES, "attention LDS map");
__device__ __forceinline__ void phase_attn(const Ctx& C) {
    PHASE_IDS
    bf16_t* O = (bf16_t*)(wsl + WS_O);
    const float* rpb = C.in[I_RPB]; const float* mbias = C.in[I_MBIAS];
    LAS unsigned char* lds = C.lds;
    const int w = wave, lq = lane & 15, g = lane >> 4;
    const int qr = w >> 2, qg = w & 3, c0 = 16 * qg, kcb = qg == 0 ? 0 : (qg == 1 ? 8 : (qg == 2 ? 24 : 32));
    int bidx[2][4];
    { const int c_ = c0 + lq, cs_ = min(max(c_ - 8, 0), 48);
#pragma unroll
      for (int blk = 0; blk < 2; ++blk)
#pragma unroll
          for (int e = 0; e < 4; ++e) { const int kc = kcb + 16 * blk + 4 * g + e; bidx[blk][e] = ((kc >= cs_ && kc < cs_ + 16) ? (kc - c_ + 15) : 31) * 4; } }
    const __amdgpu_buffer_rsrc_t rsrc = __builtin_amdgcn_make_buffer_rsrc((void*)wsl, 0, 0xFFFFFFFF, 0x00020000);
    const int kvoff = (((tid >> 3) & 63) * D + 8 * (tid & 7)) * 2, vvoff = ((tid >> 3) * MPAD + 8 * (tid & 7)) * 2;
    const int qvoff = (lq * D + 8 * g) * 2;
    const int mvoff = tid < 128 ? ((tid >> 3) * D + 8 * (tid & 7)) * 2 : (((tid - 128) >> 1) * MPAD + 8 * ((tid - 128) & 1)) * 2;
    const int klds = AT_KS + ((((tid >> 3) & 63)) * 8 + ((tid & 7) ^ ((tid >> 3) & 7))) * 16;
    const int vlds = AT_VTS + (tid >> 3) * AT_VPITCH + (tid & 7) * 16;
    for (int su = (C.G == 256 ? C.gc : C.bid); su < 256; su += C.G) {
        int bh, strip; if (C.G == 256) { bh = (su & 7) * 16 + (su >> 4); strip = (su >> 3) & 1; } else { bh = su >> 1; strip = su & 1; }
        const int b = bh >> 4, h = bh & 15, rp0 = strip * 16;
        const unsigned kbase = (unsigned)WS_K + (unsigned)((b * SEQ) * D + 64 * h) * 2u, vbase = (unsigned)WS_VT + (unsigned)((64 * h) * MPAD + b * SEQ) * 2u;
        const unsigned qbase = (unsigned)WS_Q + (unsigned)((b * SEQ + qr * 64 + c0) * D + 64 * h) * 2u;
        int R0 = min(max(2 * rp0 - 4, 0), 55);
        __syncthreads();
        {
            u32x4 kreg[9], vreg[9];
#pragma unroll
            for (int i = 0; i < 9; ++i) { kreg[i] = __builtin_amdgcn_raw_buffer_load_b128(rsrc, kvoff, (int)(kbase + (unsigned)(R0 + i) * 64u * D * 2u), 0);
                vreg[i] = __builtin_amdgcn_raw_buffer_load_b128(rsrc, vvoff, (int)(vbase + (unsigned)(R0 + i) * 128u), 0); }
            u32x4 mreg = {0u, 0u, 0u, 0u};
            if (tid < 256) mreg = __builtin_amdgcn_raw_buffer_load_b128(rsrc, mvoff, (int)(tid < 128 ? (unsigned)WS_K + (unsigned)((NGRID + 16 * b) * D + 64 * h) * 2u : (unsigned)WS_VT + (unsigned)((64 * h) * MPAD + NGRID + 16 * b) * 2u), 0);
            float rpreg = 0.f, mbreg = 0.f;
            if (tid < 480) rpreg = (tid & 31) < 31 ? rpb[h * 465 + (tid >> 5) * 31 + (tid & 31)] * 1.44269504089f : -1.0e30f;
            if (tid < 16) mbreg = mbias[h * 16 + tid] * 1.44269504089f;
#pragma unroll
            for (int i = 0; i < 9; ++i) { const int slot = (R0 + i) % 9; *(LAS u32x4*)(lds + klds + slot * 8192) = kreg[i]; *(LAS u32x4*)(lds + vlds + slot * 128) = vreg[i]; }
            if (tid < 128) { const int m = tid >> 3, ch = tid & 7; *(LAS u32x4*)(lds + AT_KM + (m * 8 + (ch ^ (m & 7))) * 16) = mreg; }
            else if (tid < 256) { const int i = tid - 128, d = i >> 1, hf = i & 1; *(LAS u32x4*)(lds + AT_VTM + d * 32 + hf * 16) = mreg; }
            if (tid < 480) ((LAS float*)(lds + AT_RPB))[tid] = rpreg;
            if (tid < 16) ((LAS float*)(lds + AT_MB))[tid] = mbreg;
        }
        u32x4 qreg[2];
        qreg[0] = __builtin_amdgcn_raw_buffer_load_b128(rsrc, qvoff, (int)(qbase + (unsigned)(2 * rp0) * 64u * D * 2u), 0);
        qreg[1] = __builtin_amdgcn_raw_buffer_load_b128(rsrc, qvoff, (int)(qbase + (unsigned)(2 * rp0) * 64u * D * 2u + 64u), 0);
        __syncthreads();
        for (int rp = rp0; rp < rp0 + 16; ++rp) {
            const int R0n = rp + 1 < rp0 + 16 ? min(max(2 * (rp + 1) - 4, 0), 55) : R0, nnew = R0n - R0;
            const u32x4 qcur[2] = {qreg[0], qreg[1]};
            u32x4 nk[2], nv[2];
#pragma unroll
            for (int i = 0; i < 2; ++i) if (i < nnew) { nk[i] = __builtin_amdgcn_raw_buffer_load_b128(rsrc, kvoff, (int)(kbase + (unsigned)(R0 + 9 + i) * 64u * D * 2u), 0);
                nv[i] = __builtin_amdgcn_raw_buffer_load_b128(rsrc, vvoff, (int)(vbase + (unsigned)(R0 + 9 + i) * 128u), 0); }
            if (rp + 1 < rp0 + 16) { qreg[0] = __builtin_amdgcn_raw_buffer_load_b128(rsrc, qvoff, (int)(qbase + (unsigned)(2 * rp + 2) * 64u * D * 2u), 0);
                qreg[1] = __builtin_amdgcn_raw_buffer_load_b128(rsrc, qvoff, (int)(qbase + (unsigned)(2 * rp + 2) * 64u * D * 2u + 64u), 0); }
            const int r = 2 * rp + qr;
            const int rs = min(max(r - 4, 0), 56), s0 = rs % 9;
            const size_t qrow = (size_t)(b * SEQ + r * 64 + c0 + lq);
            bf16x8 qf[2]; qf[0] = __builtin_bit_cast(bf16x8, qcur[0]); qf[1] = __builtin_bit_cast(bf16x8, qcur[1]);
            f32x4 sc[8][2], sm;
#pragma unroll
            for (int j = 0; j < 8; ++j) { const int slot = s0 + j - (s0 + j >= 9 ? 9 : 0);
#pragma unroll
                for (int blk = 0; blk < 2; ++blk) { f32x4 a = {0.f, 0.f, 0.f, 0.f}; const int kc = kcb + 16 * blk + lq;
#pragma unroll
                    for (int ks = 0; ks < 2; ++ks) { const bf16x8 kf = *(const LAS bf16x8*)(lds + AT_KS + slot * 8192 + (kc * 8 + ((4 * ks + g) ^ (kc & 7))) * 16);
                        a = __builtin_amdgcn_mfma_f32_16x16x32_bf16(kf, qf[ks], a, 0, 0, 0); }
                    sc[j][blk] = a; } }
            { f32x4 a = {0.f, 0.f, 0.f, 0.f};
#pragma unroll
              for (int ks = 0; ks < 2; ++ks) { const bf16x8 kf = *(const LAS bf16x8*)(lds + AT_KM + (lq * 8 + ((4 * ks + g) ^ (lq & 7))) * 16);
                  a = __builtin_amdgcn_mfma_f32_16x16x32_bf16(kf, qf[ks], a, 0, 0, 0); }
              sm = a; }
            const LAS unsigned char* RProw = lds + AT_RPB + (rs - r + 7) * 128; const LAS float* MB = (const LAS float*)(lds + AT_MB);
            float mx = -3.0e38f;
#pragma unroll
            for (int j = 0; j < 8; ++j)
#pragma unroll
                for (int blk = 0; blk < 2; ++blk)
#pragma unroll
                    for (int e = 0; e < 4; ++e) { const float sv = sc[j][blk][e] + *(const LAS float*)(RProw + j * 128 + bidx[blk][e]); sc[j][blk][e] = sv; mx = fmaxf(mx, sv); }
#pragma unroll
            for (int e = 0; e < 4; ++e) { sm[e] += MB[4 * g + e]; mx = fmaxf(mx, sm[e]); }
            mx = fmaxf(mx, __shfl_xor(mx, 16)); mx = fmaxf(mx, __shfl_xor(mx, 32));
            float sum = 0.f;
#pragma unroll
            for (int j = 0; j < 8; ++j)
#pragma unroll
                for (int blk = 0; blk < 2; ++blk)
#pragma unroll
                    for (int e = 0; e < 4; ++e) { const float pv = fast_exp2(sc[j][blk][e] - mx); sc[j][blk][e] = pv; sum += pv; }
#pragma unroll
            for (int e = 0; e < 4; ++e) { const float pv = fast_exp2(sm[e] - mx); sm[e] = pv; sum += pv; }
            sum += __shfl_xor(sum, 16); sum += __shfl_xor(sum, 32);
            f32x4 o[4];
#pragma unroll
            for (int db = 0; db < 4; ++db) o[db] = (f32x4){0.f, 0.f, 0.f, 0.f};
#pragma unroll
            for (int j = 0; j < 8; ++j) { const int slot = s0 + j - (s0 + j >= 9 ? 9 : 0);
                u32x4 pw; pw.x = cvt_pk_bf16(sc[j][0][0], sc[j][0][1]); pw.y = cvt_pk_bf16(sc[j][0][2], sc[j][0][3]); pw.z = cvt_pk_bf16(sc[j][1][0], sc[j][1][1]); pw.w = cvt_pk_bf16(sc[j][1][2], sc[j][1][3]);
                const bf16x8 pb = __builtin_bit_cast(bf16x8, pw);
#pragma unroll
                for (int db = 0; db < 4; ++db) { const int d = 16 * db + lq; const LAS unsigned char* vp = lds + AT_VTS + d * AT_VPITCH + (slot * 64 + kcb + 4 * g) * 2;
                    const u32x2 lo = *(const LAS u32x2*)vp, hi = *(const LAS u32x2*)(vp + 32);
                    u32x4 aw; aw.x = lo.x; aw.y = lo.y; aw.z = hi.x; aw.w = hi.y;
                    o[db] = __builtin_amdgcn_mfma_f32_16x16x32_bf16(__builtin_bit_cast(bf16x8, aw), pb, o[db], 0, 0, 0); }
            }
            { u32x4 pw; pw.x = cvt_pk_bf16(sm[0], sm[1]); pw.y = cvt_pk_bf16(sm[2], sm[3]); pw.z = 0u; pw.w = 0u; const bf16x8 pb = __builtin_bit_cast(bf16x8, pw);
#pragma unroll
              for (int db = 0; db < 4; ++db) { const int d = 16 * db + lq; const u32x2 lo = *(const LAS u32x2*)(lds + AT_VTM + d * 32 + 8 * g);
                  u32x4 aw; aw.x = lo.x; aw.y = lo.y; aw.z = 0u; aw.w = 0u;
                  o[db] = __builtin_amdgcn_mfma_f32_16x16x32_bf16(__builtin_bit_cast(bf16x8, aw), pb, o[db], 0, 0, 0); } }
            const float inv = 1.0f / sum;
#pragma unroll
            for (int db = 0; db < 4; ++db) { u32x2 ow; ow.x = cvt_pk_bf16(o[db][0] * inv, o[db][1] * inv); ow.y = cvt_pk_bf16(o[db][2] * inv, o[db][3] * inv);
                *(u32x2*)(O + qrow * D + 64 * h + 16 * db + 4 * g) = ow; }
            __syncthreads();
#pragma unroll
            for (int i = 0; i < 2; ++i) if (i < nnew) { const int slot = (R0 + 9 + i) % 9; *(LAS u32x4*)(lds + klds + slot * 8192) = nk[i]; *(LAS u32x4*)(lds + vlds + slot * 128) = nv[i]; }
            R0 = R0n;
            __syncthreads();
        }
    }
}
#define XB_TMO      128
#define XB_XCNT(j)  (256  + 64 * (j))
#define XB_XSUB(j)  (1280 + 64 * (j))
#define XB_XGEN(j)  (2304 + 64 * (j))
#define XB_TOP      3328
#define XB_TOPGEN   3392
#define XCD_BAR_WORDS 3456
#define XB_SPIN_CAP (1u << 22)
__device__ __forceinline__ unsigned xb_ld(unsigned* p)              { return __hip_atomic_load(p, __ATOMIC_RELAXED, __HIP_MEMORY_SCOPE_AGENT); }
__device__ __forceinline__ unsigned xb_add(unsigned* p, unsigned v) { return __hip_atomic_fetch_add(p, v, __ATOMIC_RELAXED, __HIP_MEMORY_SCOPE_AGENT); }
__device__ __forceinline__ unsigned xb_xcc_id() { return (unsigned)__builtin_amdgcn_s_getreg((3 << 11) | 20) & 0xFu; }
#define XB_SPIN(cond, bar) do { unsigned _sp = 0; while (cond) { __builtin_amdgcn_s_sleep(1); \
    if ((++_sp & 255u) == 0u) { if (xb_ld(&(bar)[XB_TMO])) break; if (_sp > XB_SPIN_CAP) { atomicAdd(&(bar)[XB_TMO], 1u); break; } } } } while (0)
struct XcdBarrier { unsigned* bar; unsigned x; volatile LAS unsigned* st; };
__device__ __forceinline__ XcdBarrier xcd_barrier_post(unsigned* bar, volatile LAS unsigned* st) {
    XcdBarrier b; b.bar = bar; b.x = xb_xcc_id(); b.st = st;
    if (threadIdx.x == 0) st[2] = xb_add(&bar[XB_XCNT(b.x)], 1u);
    return b;
}
__device__ __forceinline__ void xcd_barrier_complete(unsigned* bar, unsigned x, unsigned& nloc, unsigned& nx) {
    const unsigned G = gridDim.x * gridDim.y * gridDim.z;
    unsigned sum, cnt, mine, sp = 0u;
    for (;;) {
        sum = 0u; cnt = 0u; mine = 0u;
#pragma unroll
        for (unsigned j = 0; j < 16; ++j) { const unsigned c = xb_ld(&bar[XB_XCNT(j)]); sum += c; cnt += (c > 0u) ? 1u : 0u; mine = (j == x) ? c : mine; }
        if (sum == G) break;
        __builtin_amdgcn_s_sleep(1);
        if ((++sp & 255u) == 0u) { if (xb_ld(&bar[XB_TMO])) break; if (sp > XB_SPIN_CAP) { atomicAdd(&bar[XB_TMO], 1u); break; } }
    }
    nloc = mine > 0u ? mine : 1u; nx = cnt > 0u ? cnt : 1u;
}
__device__ __forceinline__ void xcd_barrier(const XcdBarrier& b) {
    asm volatile("s_waitcnt vmcnt(0)" ::: "memory");
    __syncthreads();
    if (threadIdx.x == 0) {
        unsigned* bar = b.bar;
        __builtin_amdgcn_s_waitcnt(0);
        unsigned nloc = b.st[0], nx = b.st[1];
        if (nloc == 0u) { xcd_barrier_complete(bar, b.x, nloc, nx); b.st[0] = nloc; b.st[1] = nx; }
        const unsigned old = xb_add(&bar[XB_XSUB(b.x)], 1u);
        const unsigned gen = old / nloc;
        if (old + 1u == (gen + 1u) * nloc) {
            __builtin_amdgcn_fence(__ATOMIC_RELEASE, "agent");
            asm volatile("s_waitcnt vmcnt(0)" ::: "memory");
            const unsigned og = xb_add(&bar[XB_TOP], 1u);
            const unsigned tg = og / nx;
            if (og + 1u == (tg + 1u) * nx) xb_add(&bar[XB_TOPGEN], 1u);
            else XB_SPIN(xb_ld(&bar[XB_TOPGEN]) == tg, bar);
            __builtin_amdgcn_fence(__ATOMIC_ACQUIRE, "agent");
            xb_add(&bar[XB_XGEN(b.x)], 1u);
            asm volatile("s_waitcnt vmcnt(0)" ::: "memory");
        } else {
            XB_SPIN(xb_ld(&bar[XB_XGEN(b.x)]) == gen, bar);
            __builtin_amdgcn_fence(__ATOMIC_ACQUIRE, "agent");
            asm volatile("s_waitcnt vmcnt(0)" ::: "memory");
        }
    }
    __syncthreads();
}
__device__ __forceinline__ int moe_prep(const Ctx& C, const int* texp) {
    LAS int* t = (LAS int*)(C.lds + pg8::TEXP_OFF); const int tid = fresh_tid();
    const int a = texp[tid], b = texp[tid + 512];
    t[tid] = a; t[tid + 512] = b;
    __syncthreads();
    return __builtin_amdgcn_readfirstlane(t[1023]);
}
constexpr size_t CT_BAR = 131072;
constexpr int LDS_BARST = LDS_BYTES - 64;

constexpr int N_PHASES = 20;
__global__ void __launch_bounds__(NTHREADS, 2) hybrid_fwd(Params P) {
    extern __shared__ __attribute__((aligned(16))) unsigned char smem[];
    cg::grid_group grid = cg::this_grid();
    Ctx C; C.lds = (LAS unsigned char*)smem; C.G = gridDim.x; C.bid = blockIdx.x;
    C.ws = P.ws; C.in = P.in; C.out = P.out;
    unsigned char* const ws0 = P.ws;
#define ws fresh_ws(ws0)
    const int lo = P.ph_lo, hi = P.ph_hi;
#ifndef PH_MASK
#define PH_MASK 0xFFFFFFFFu
#endif
#define IN(k) (((PH_MASK >> (k)) & 1u) && lo <= (k) && (k) < hi)
#ifndef REPEAT_MASK
#define REPEAT_MASK 0u
#endif
#define REPS(k) ((((unsigned)REPEAT_MASK >> (k)) & 1u) ? 2 : 1)
#ifndef N_CG_SYNCS
#define N_CG_SYNCS 0
#endif
#define SEAM(k) do { if (IN(k) && IN((k) + 1)) { if ((k) < N_CG_SYNCS) grid.sync(); else xcd_barrier(bar); } } while (0)
    if (threadIdx.x < 16) ((LAS unsigned*)(smem + LDS_BARST))[threadIdx.x] = 0u;
    __syncthreads();
    const XcdBarrier bar = xcd_barrier_post((unsigned*)(ws + WS_CTL + CT_BAR), (volatile LAS unsigned*)(smem + LDS_BARST));
    C.gc = C.bid;
    #define PH_BODY_0 phase_convert(C);
    if (IN(0)) { PH_BODY_0 } if (REPS(0) > 1 && IN(0)) { xcd_barrier(bar); PH_BODY_0 }
    SEAM(0);
    if (IN(0) && IN(1)) {
        unsigned* barw = (unsigned*)(ws + WS_CTL + CT_BAR); bool eq = (C.G % 8) == 0;
#pragma unroll
        for (int j = 0; j < 16; ++j) { const unsigned cj = xb_ld(&barw[XB_XCNT(j)]); eq = eq && (cj == (j < 8 ? (unsigned)(C.G / 8) : 0u)); }
        const unsigned rank = ((volatile LAS unsigned*)(smem + LDS_BARST))[2];
        C.gc = __builtin_amdgcn_readfirstlane(eq ? (int)(rank * 8u + bar.x) : C.bid);
    }
    #define PH_BODY_1 { DenseSched S{(unsigned)WS_HB, (unsigned)WS_WIN, 1024, 1024, 128, 8, C.G, C.gc}; EpiWin E{(bf16_t*)(ws + WS_XR), (bf16_t*)(ws + WS_GY)}; \
        pg8::gemm_phase<false, false>(C.lds, ws, 1024, 1024, 1024, S, E); mini_win(C); }
    if (IN(1)) { PH_BODY_1 } if (REPS(1) > 1 && IN(1)) { xcd_barrier(bar); PH_BODY_1 }
    SEAM(1);
    #define PH_BODY_2 phase_conv(C);
    if (IN(2)) { PH_BODY_2 } if (REPS(2) > 1 && IN(2)) { xcd_barrier(bar); PH_BODY_2 }
    SEAM(2);
    #define PH_BODY_3 { GateSched S{(unsigned)WS_XC, (unsigned)WS_GATE, 128, C.G, C.gc}; \
        EpiGate E{(const bf16_t*)(ws + WS_XC), (unsigned char*)(ws + WS_LA), (const float*)(ws + WS_CTL + CT_SPL), (unsigned)WS_GBIAS}; \
        pg8::gemm_phase<false, false>(C.lds, ws, 256, 1024, 256, S, E); mini_gate(C); }
    if (IN(3)) { PH_BODY_3 } if (REPS(3) > 1 && IN(3)) { xcd_barrier(bar); PH_BODY_3 }
    SEAM(3);
    #define PH_BODY_4 phase_scan(C);
    if (IN(4)) { PH_BODY_4 } if (REPS(4) > 1 && IN(4)) { xcd_barrier(bar); PH_BODY_4 }
    SEAM(4);
    #define PH_BODY_5 { DenseSched S{(unsigned)WS_G, (unsigned)WS_LOUT, 1024, 1024, 128, 4, C.G, C.gc}; EpiRes<true> E{(bf16_t*)(ws + WS_PRE), P.in[I_X], P.in[I_META], nullptr, NTOK}; \
        pg8::gemm_phase<false, false>(C.lds, ws, 1024, 1024, 1024, S, E); mini_lout(C); }
    if (IN(5)) { PH_BODY_5 } if (REPS(5) > 1 && IN(5)) { xcd_barrier(bar); PH_BODY_5 }
    SEAM(5);
    #define PH_BODY_6 phase_lnr(C, 0, NTOK);
    if (IN(6)) { PH_BODY_6 } if (REPS(6) > 1 && IN(6)) { xcd_barrier(bar); PH_BODY_6 }
    SEAM(6);
    #define PH_BODY_7 phase_pos(C, 0, NTOK);
    if (IN(7)) { PH_BODY_7 } if (REPS(7) > 1 && IN(7)) { xcd_barrier(bar); PH_BODY_7 }
    SEAM(7);
    #define PH_BODY_8 { const int nM = moe_prep(C, (const int*)(ws + WS_CTL + CT_TEXP)); \
        MoeSched S{(unsigned)WS_HB8, (unsigned)WS_WGU, (unsigned)WS_TOK, (const LAS int*)(C.lds + pg8::TEXP_OFF), 2048u * 1024u, nM, 8, C.G, C.gc}; EpiGlu E{(unsigned char*)(ws + WS_ACT), (unsigned)WS_BIAS}; \
        pg8::gemm_phase<true, true>(C.lds, ws, 512, 512, 512, S, E); }
    if (IN(8)) { PH_BODY_8 } if (REPS(8) > 1 && IN(8)) { xcd_barrier(bar); PH_BODY_8 }
#ifdef PROBE_NULL8
    if (IN(8)) { xcd_barrier(bar); { const int nM = moe_prep(C, (const int*)(ws + WS_CTL + CT_TEXP));
        MoeSched S{(unsigned)WS_HB8, (unsigned)WS_WGU, (unsigned)WS_TOK, (const LAS int*)(C.lds + pg8::TEXP_OFF), 2048u * 1024u, nM, 8, C.G, C.gc}; EpiNull E{};
        pg8::gemm_phase<true, true>(C.lds, ws, 512, 512, 512, S, E); } }
#endif
    SEAM(8);
    #define PH_BODY_9 { const int nM = moe_prep(C, (const int*)(ws + WS_CTL + CT_TEXP)); \
        MoeSched S{(unsigned)WS_ACT, (unsigned)WS_WD, 0u, (const LAS int*)(C.lds + pg8::TEXP_OFF), 1024u * 1024u, nM, 4, C.G, C.gc}; EpiDown E{(unsigned char*)(ws + WS_YS), (unsigned)WS_BD}; \
        pg8::gemm_phase<true, false>(C.lds, ws, 512, 512, 512, S, E); }
    if (IN(9)) { PH_BODY_9 } if (REPS(9) > 1 && IN(9)) { xcd_barrier(bar); PH_BODY_9 }
    SEAM(9);
    #define PH_BODY_10 phase_combine(C, 0, NTOK, false);
    if (IN(10)) { PH_BODY_10 } if (REPS(10) > 1 && IN(10)) { xcd_barrier(bar); PH_BODY_10 }
    SEAM(10);
    #define PH_BODY_11 { QkvSched S{(unsigned)WS_HB8, (unsigned)WS_QKV8, 128, C.G, C.gc}; EpiQkv E{(bf16_t*)(ws + WS_Q), (bf16_t*)(ws + WS_K), (bf16_t*)(ws + WS_VT)}; \
        pg8::gemm_phase<true, false>(C.lds, ws, 512, 512, 512, S, E); mini_kv(C); }
    if (IN(11)) { PH_BODY_11 } if (REPS(11) > 1 && IN(11)) { xcd_barrier(bar); PH_BODY_11 }
    SEAM(11);
    #define PH_BODY_12 phase_attn(C);
    if (IN(12)) { PH_BODY_12 } if (REPS(12) > 1 && IN(12)) { xcd_barrier(bar); PH_BODY_12 }
    SEAM(12);
    #define PH_BODY_13 { DenseSched S{(unsigned)WS_O, (unsigned)WS_NOUT, 1024, 1024, 128, 4, C.G, C.gc}; EpiRes<false> E{(bf16_t*)(ws + WS_PRE), nullptr, nullptr, (const bf16_t*)(ws + WS_HB), NGRID}; \
        pg8::gemm_phase<false, false>(C.lds, ws, 1024, 1024, 1024, S, E); }
    if (IN(13)) { PH_BODY_13 } if (REPS(13) > 1 && IN(13)) { xcd_barrier(bar); PH_BODY_13 }
    SEAM(13);
    #define PH_BODY_14 phase_lnr(C, 1, NGRID);
    if (IN(14)) { PH_BODY_14 } if (REPS(14) > 1 && IN(14)) { xcd_barrier(bar); PH_BODY_14 }
    SEAM(14);
    #define PH_BODY_15 phase_pos(C, 1, NGRID);
    if (IN(15)) { PH_BODY_15 } if (REPS(15) > 1 && IN(15)) { xcd_barrier(bar); PH_BODY_15 }
    SEAM(15);
    #define PH_BODY_16 { const int nM = moe_prep(C, (const int*)(ws + WS_CTL + CT_TEXP) + 1024); \
        MoeSched S{(unsigned)WS_HB8, (unsigned)(WS_WGU + (size_t)32 * 2048 * 1024), (unsigned)(WS_TOK + 1 * MiB), (const LAS int*)(C.lds + pg8::TEXP_OFF), 2048u * 1024u, nM, 8, C.G, C.gc}; EpiGlu E{(unsigned char*)(ws + WS_ACT), (unsigned)(WS_BIAS + 32 * 2048 * 4)}; \
        pg8::gemm_phase<true, true>(C.lds, ws, 512, 512, 512, S, E); }
    if (IN(16)) { PH_BODY_16 } if (REPS(16) > 1 && IN(16)) { xcd_barrier(bar); PH_BODY_16 }
    SEAM(16);
    #define PH_BODY_17 { const int nM = moe_prep(C, (const int*)(ws + WS_CTL + CT_TEXP) + 1024); \
        MoeSched S{(unsigned)WS_ACT, (unsigned)(WS_WD + (size_t)32 * 1024 * 1024), 0u, (const LAS int*)(C.lds + pg8::TEXP_OFF), 1024u * 1024u, nM, 4, C.G, C.gc}; EpiDown E{(unsigned char*)(ws + WS_YS), (unsigned)(WS_BD + 32 * 1024 * 4)}; \
        pg8::gemm_phase<true, false>(C.lds, ws, 512, 512, 512, S, E); }
    if (IN(17)) { PH_BODY_17 } if (REPS(17) > 1 && IN(17)) { xcd_barrier(bar); PH_BODY_17 }
    SEAM(17);
    #define PH_BODY_18 phase_combine(C, 1, NGRID, true);
    if (IN(18)) { PH_BODY_18 } if (REPS(18) > 1 && IN(18)) { xcd_barrier(bar); PH_BODY_18 }
#undef ws
#undef IN
#undef SEAM
}

#ifndef MK_PER_PHASE
#define MK_PER_PHASE 0
#endif
extern "C" void kernel_launch(void* const* d_in, const int* in_sizes, int n_in, void* d_out, int out_size, void* d_ws, size_t ws_size, hipStream_t stream) {
    static int grid = 0;
    if (grid == 0) {
        if (n_in != 25 || ws_size < WS_END || out_size != NGRID * D) { fprintf(stderr, "kernel_launch: unexpected problem (n_in %d, ws %zu, out %d)\n", n_in, ws_size, out_size); grid = -1; return; }
        int dev = 0, cus = 0, per_cu = 0;
        if (hipGetDevice(&dev) != hipSuccess || hipDeviceGetAttribute(&cus, hipDeviceAttributeMultiprocessorCount, dev) != hipSuccess) { grid = -1; return; }
        if (hipFuncSetAttribute((const void*)hybrid_fwd, hipFuncAttributeMaxDynamicSharedMemorySize, LDS_BYTES) != hipSuccess) { fprintf(stderr, "kernel_launch: hipFuncSetAttribute failed\n"); grid = -1; return; }
        if (hipOccupancyMaxActiveBlocksPerMultiprocessor(&per_cu, (const void*)hybrid_fwd, NTHREADS, LDS_BYTES) != hipSuccess || per_cu < 1) { fprintf(stderr, "kernel_launch: occupancy query failed (%d)\n", per_cu); grid = -1; return; }
        grid = cus * 1;
        if (grid > 256) grid = 256;
    }
    if (grid < 0) return;
    if (hipMemsetAsync((char*)d_ws + WS_CTL + CT_BAR, 0, 16384, stream) != hipSuccess) { fprintf(stderr, "kernel_launch: memset failed\n"); return; }
    Params p{};
    for (int i = 0; i < 25; ++i) p.in[i] = (const float*)d_in[i];
    p.out = (float*)d_out; p.ws = (unsigned char*)d_ws;
#if MK_PER_PHASE
    for (int ph = 0; ph < 19; ++ph) { p.ph_lo = ph; p.ph_hi = ph + 1; void* args[] = {&p};
        hipError_t e = hipLaunchCooperativeKernel((void*)hybrid_fwd, dim3(grid), dim3(NTHREADS), args, LDS_BYTES, stream);
        if (e != hipSuccess) { fprintf(stderr, "launch phase %d failed: %s\n", ph, hipGetErrorString(e)); break; } }
#else
    p.ph_lo = 0; p.ph_hi = 19; void* args[] = {&p};
    hipError_t e = hipLaunchCooperativeKernel((void*)hybrid_fwd, dim3(grid), dim3(NTHREADS), args, LDS_BYTES, stream);
    if (e != hipSuccess) fprintf(stderr, "cooperative launch failed: %s (grid %d)\n", hipGetErrorString(e), grid);
#endif
}
```

```cpp
#include <hip/hip_runtime.h>
#include <hip/hip_cooperative_groups.h>
#include <cstdio>
#include <cstdint>
namespace cg = cooperative_groups;

#define LAS __attribute__((address_space(3)))
typedef unsigned short bf16_t;
typedef short bf16x8 __attribute__((ext_vector_type(8)));
typedef float f32x4 __attribute__((ext_vector_type(4)));
typedef float f32x2 __attribute__((ext_vector_type(2)));
typedef unsigned u32x4 __attribute__((ext_vector_type(4)));
typedef unsigned u32x2 __attribute__((ext_vector_type(2)));

constexpr int NB = 8, SEQ = 4096, D = 1024, NMETA = 16, LSEQ = SEQ + NMETA;
constexpr int NGRID = NB * SEQ;
constexpr int NTOK = NGRID + NB * NMETA;
constexpr int MPAD = 33024;
constexpr int NEXP = 32, TOPK = 4;
constexpr int PMAX = 139776;
constexpr int MTMAX = PMAX / 256;
constexpr float DN_ALPHA = 1.41421356237f;
constexpr float LN_EPS = 1e-5f;
constexpr int NTHREADS = 512, NWAVES = 8;

constexpr size_t MiB = 1u << 20;
constexpr size_t ACT_BYTES = (size_t)MPAD * D * 2;
constexpr size_t WS_CTL   = 0;
constexpr size_t WS_WIN   = 4 * MiB;
constexpr size_t WS_GATE  = WS_WIN + 4 * MiB;
constexpr size_t WS_LOUT  = WS_GATE + 2 * MiB;
constexpr size_t WS_QKV   = WS_LOUT + 2 * MiB;
constexpr size_t WS_NOUT  = WS_QKV + 6 * MiB;
constexpr size_t WS_WGU   = WS_NOUT + 2 * MiB;
constexpr size_t WS_WD    = WS_WGU + 128 * MiB;
constexpr size_t WS_HB    = WS_WD + 64 * MiB;
constexpr size_t WS_HB8   = WS_HB + 65 * MiB;
constexpr size_t WS_PRE   = WS_HB8 + 33 * MiB;
constexpr size_t WS_H     = WS_PRE + 129 * MiB;
constexpr size_t WS_SCR   = WS_H + 129 * MiB;
constexpr size_t WS_XR = WS_SCR, WS_XC = WS_XR + 65 * MiB, WS_GY = WS_XC + 65 * MiB, WS_LA = WS_GY + 65 * MiB, WS_BB = WS_LA + 130 * MiB, WS_HF = WS_BB + 130 * MiB, WS_G = WS_HF + 65 * MiB;
constexpr size_t WS_SCR_END0 = WS_G + 65 * MiB;
constexpr size_t WS_XS = WS_SCR, WS_ACT = WS_XS + 137 * MiB, WS_YS = WS_ACT + 137 * MiB;
constexpr size_t WS_SCR_END1 = WS_YS + 274 * MiB;
constexpr size_t WS_Q = WS_SCR, WS_K = WS_Q + 65 * MiB, WS_VT = WS_K + 65 * MiB, WS_O = WS_VT + 65 * MiB;
constexpr size_t WS_BIAS = (WS_SCR_END0 > WS_SCR_END1 ? WS_SCR_END0 : WS_SCR_END1);
constexpr size_t WS_BD = WS_BIAS + 2 * 32 * 2048 * 4;
constexpr size_t WS_GBIAS = WS_BD + 2 * 32 * 1024 * 4;
constexpr size_t WS_TOK = WS_BIAS + 1 * MiB;
constexpr size_t WS_QKV8 = WS_TOK + 2 * MiB;
constexpr size_t WS_END = WS_QKV8 + 3 * MiB;
static_assert((size_t)PMAX * 4 <= 1 * MiB, "token offset table");
static_assert(ACT_BYTES <= 65 * MiB && (size_t)PMAX * D * 2 <= 274 * MiB && (size_t)PMAX * D <= 137 * MiB && (size_t)MPAD * D <= 33 * MiB && (size_t)MPAD * D * 4 <= 129 * MiB, "ws map");
static_assert(WS_END <= (size_t)2040 * MiB, "ws map must fit 4x the largest input tensor");
constexpr size_t CT_BC      = 4096;
constexpr size_t CT_TEXP    = CT_BC + 2 * 256 * 32 * 4;
constexpr size_t CT_SPL     = CT_TEXP + 2 * 1024 * 4;
constexpr size_t CT_EID     = 256 * 1024;
constexpr size_t CT_GATEV   = CT_EID + 2 * (size_t)NTOK * 4 * 4;
constexpr size_t CT_POS     = CT_GATEV + 2 * (size_t)NTOK * 4 * 4;
static_assert(CT_POS + 2 * (size_t)NTOK * 4 * 4 <= 4 * MiB, "ctl map");

constexpr int LDS_BYTES = 155648;

__device__ __forceinline__ unsigned f2bf(float f) { unsigned u = __builtin_bit_cast(unsigned, f); return (u + 0x7fffu + ((u >> 16) & 1u)) >> 16; }
__device__ __forceinline__ unsigned cvt_pk_bf16(float lo, float hi);
__device__ __forceinline__ unsigned pk2(float lo, float hi) { return cvt_pk_bf16(lo, hi); }
typedef __bf16 bf16x2_t __attribute__((ext_vector_type(2)));
__device__ __forceinline__ unsigned cvt_pk_bf16(float lo, float hi) { const f32x2 v = {lo, hi}; return __builtin_bit_cast(unsigned, __builtin_convertvector(v, bf16x2_t)); }
__device__ __forceinline__ unsigned pk4_fp8(float a, float b, float c, float d) { int w = __builtin_amdgcn_cvt_pk_fp8_f32(a, b, 0, false); w = __builtin_amdgcn_cvt_pk_fp8_f32(c, d, w, true); return (unsigned)w; }
__device__ __forceinline__ float dot2_bf16(unsigned a, unsigned b, float c) { return __builtin_amdgcn_fdot2_f32_bf16(__builtin_bit_cast(bf16x2_t, a), __builtin_bit_cast(bf16x2_t, b), c, false); }
__device__ __forceinline__ void unpack8_fp8(const u32x2 w, float (&o)[8]) { const f32x2 a = __builtin_amdgcn_cvt_pk_f32_fp8((int)w.x, false), b = __builtin_amdgcn_cvt_pk_f32_fp8((int)w.x, true), c = __builtin_amdgcn_cvt_pk_f32_fp8((int)w.y, false), d = __builtin_amdgcn_cvt_pk_f32_fp8((int)w.y, true);
    o[0] = a.x; o[1] = a.y; o[2] = b.x; o[3] = b.y; o[4] = c.x; o[5] = c.y; o[6] = d.x; o[7] = d.y; }
__device__ __forceinline__ float bflo(unsigned w) { return __builtin_bit_cast(float, w << 16); }
__device__ __forceinline__ float bfhi(unsigned w) { return __builtin_bit_cast(float, w & 0xffff0000u); }
__device__ __forceinline__ void unpack8(const u32x4 w, float (&o)[8]);
__device__ __forceinline__ float fast_exp2(float x) { return __builtin_amdgcn_exp2f(x); }
__device__ __forceinline__ float fast_rcp(float x) { return __builtin_amdgcn_rcpf(x); }
__device__ __forceinline__ float sigmoidf_(float x) { return fast_rcp(1.0f + fast_exp2(-1.44269504089f * x)); }
__device__ __forceinline__ float wave_sum(float v) {
#pragma unroll
    for (int o = 1; o < 64; o <<= 1) v += __shfl_xor(v, o);
    return v;
}
template <int CTRL> __device__ __forceinline__ float dpp_movf(float v) { return __builtin_bit_cast(float, __builtin_amdgcn_update_dpp(0, __builtin_bit_cast(int, v), CTRL, 0xf, 0xf, true)); }
__device__ __forceinline__ float readlane_f(float v, int l) { return __builtin_bit_cast(float, __builtin_amdgcn_readlane(__builtin_bit_cast(int, v), l)); }
__device__ __forceinline__ float wave_sum_dpp(float v) {
    v += dpp_movf<0xB1>(v);
    v += dpp_movf<0x4E>(v);
    v += dpp_movf<0x141>(v);
    v += dpp_movf<0x140>(v);
    return (readlane_f(v, 0) + readlane_f(v, 16)) + (readlane_f(v, 32) + readlane_f(v, 48));
}
__device__ __forceinline__ int seqrow(int b, int s) { return s < NMETA ? NGRID + NMETA * b + s : SEQ * b + (s - NMETA); }

struct Params {
    const float* in[25];
    float* out;
    unsigned char* ws;
    int ph_lo, ph_hi;
};
struct Ctx {
    LAS unsigned char* lds;
    int G, bid, gc;
    unsigned char* ws;
    const float* const* in;
    float* out;
};
__device__ __forceinline__ int fresh_tid() { int t = threadIdx.x; asm volatile("" : "+v"(t)); return t; }
__device__ __forceinline__ unsigned char* fresh_ws(unsigned char* p) { asm volatile("" : "+s"(p)); return p; }
#define PHASE_IDS unsigned char* const wsl = fresh_ws(C.ws); (void)wsl; const int tid = fresh_tid(); const int lane = tid & 63; const int wave = __builtin_amdgcn_readfirstlane(tid >> 6); (void)lane; (void)wave;
enum { I_X = 0, I_META, I_WIN, I_CONVW, I_CONVB, I_WA, I_BA, I_WX, I_BX, I_LAM, I_LOUT, I_WQKV, I_RPB, I_MBIAS, I_NOUT, I_LNMG, I_LNMB, I_RW, I_RB, I_WGU, I_BGU, I_WD, I_BD, I_LNFG, I_LNFB };

namespace pg8 {
constexpr int BM = 256, BK = 64, HALF = 128, HTB = HALF * BK * 2, STAGE_BYTES = 8 * HTB, NXCD = 8, WGM = 8;
constexpr int SIDE_OFF = STAGE_BYTES, TEXP_OFF = STAGE_BYTES + 2048, TOK_OFF = STAGE_BYTES + 2048 + 4096;
__device__ __forceinline__ int lds_byte(int r, int c) { const int st = (r >> 4) * 2 + (c >> 5), rr = r & 15, cc = c & 31, ob = rr * 64 + cc * 2; return st * 1024 + (ob ^ (((ob >> 9) & 1) << 5)); }
__device__ __forceinline__ void stage_rc(int b, int& R, int& C) { const int st = b / 1024, sb = b % 1024, swz = sb ^ (((sb >> 9) & 1) << 5); R = (st >> 1) * 16 + swz / 64; C = (st & 1) * 32 + (swz % 64) / 2; }
__device__ __forceinline__ int perm32(int rho) { const int n = rho >> 4, i = rho & 15; return 8 * (i >> 2) + 4 * n + (i & 3); }

typedef int v8i __attribute__((ext_vector_type(8)));
typedef int v4i __attribute__((ext_vector_type(4)));
__device__ __forceinline__ v8i cat8(bf16x8 a, bf16x8 b) { const v4i x = __builtin_bit_cast(v4i, a), y = __builtin_bit_cast(v4i, b); return __builtin_shufflevector(x, y, 0, 1, 2, 3, 4, 5, 6, 7); }
struct Unit { unsigned ao, bo, to; int pm, pn, aux; };

__device__ __forceinline__ void tile_of(int L, int nM, int nN, int& pm, int& pn) {
    const int nwg = nM * nN; int wgid = L;
    { const int q = nwg / NXCD, r = nwg % NXCD, xcd = wgid % NXCD, off = wgid / NXCD; wgid = (xcd < r ? xcd * (q + 1) : r * (q + 1) + (xcd - r) * q) + off; }
    const int nig = WGM * nN, gid = wgid / nig, fm = gid * WGM, gsz = (nM - fm) < WGM ? (nM - fm) : WGM;
    pm = fm + ((wgid % nig) % gsz); pn = (wgid % nig) / gsz;
}

template <bool F8, bool GATHER, class Epi, class Sched>
__device__ __forceinline__ void gemm_phase(LAS unsigned char* lds, const unsigned char* wsbase, const int K, const int lda, const int ldb, const Sched& S, const Epi& E) {
    const __amdgpu_buffer_rsrc_t rsrc = __builtin_amdgcn_make_buffer_rsrc((void*)wsbase, 0, 0xFFFFFFFF, 0x00020000);
    const int tid = fresh_tid(), wid = __builtin_amdgcn_readfirstlane(tid >> 6), lane = tid & 63, wr = wid >> 2, wc = wid & 3;
    const int nt = K / BK;
    int f8scales = 0; if constexpr (F8) { f8scales = Epi::SCALES; asm volatile("" : "+v"(f8scales)); }
    int voffA, voffB;
    { int R, C; stage_rc(tid * 16, R, C); const int Rb = Epi::PERM ? ((R & ~31) + perm32(R & 31)) : R; voffA = ((GATHER ? 0 : R * lda) + C) * 2; voffB = (Rb * ldb + C) * 2; }
    const int tokb = (16 * (wid >> 1) + (lane >> 2)) * 4;
    const unsigned kstep = (unsigned)(BK * 2);
    const unsigned hstepA = (unsigned)HALF * lda * 2, hstepB = (unsigned)HALF * ldb * 2;
    const unsigned ldsw = (unsigned)wid * 1024u;
    const int aoff = lds_byte(wr * 64 + (lane & 15), (lane >> 4) * 8), boff = lds_byte(wc * 32 + (lane & 15), (lane >> 4) * 8);
#define PG8_SA(b, h) (((b) * 2 + (h)) * HTB)
#define PG8_SB(b, h) ((4 + (b) * 2 + (h)) * HTB)
#define PG8_STAGE(bufoff, gbase, voff) do { _Pragma("unroll") for (int _i = 0; _i < 2; ++_i) \
        __builtin_amdgcn_raw_ptr_buffer_load_lds(rsrc, (LAS void*)(lds + (bufoff) + ldsl + _i * 8192), 16, voff, __builtin_amdgcn_readfirstlane((int)((gbase) + (unsigned)_i * (hstep##voff >> 1))), 0, 0); } while (0)
#define hstepvoffA hstepA
#define hstepvoffB hstepB
#define PG8_STAGE_A(bufoff, aoffs, h, par) do { if constexpr (GATHER) { _Pragma("unroll") for (int _i = 0; _i < 2; ++_i) { \
            const int _tk = *(const LAS int*)(lds + TOK_OFF + (par) * 1024 + tokb + ((h) * 128 + _i * 64) * 4); \
            __builtin_amdgcn_raw_ptr_buffer_load_lds(rsrc, (LAS void*)(lds + (bufoff) + ldsl + _i * 8192), 16, _tk + voffA, __builtin_amdgcn_readfirstlane((int)(aoffs)), 0, 0); } } \
        else { PG8_STAGE(bufoff, (aoffs) + (unsigned)(h) * hstepA, voffA); } } while (0)
#define PG8_TOK(unit, par) do { if constexpr (GATHER) { if (wid == 0) __builtin_amdgcn_raw_ptr_buffer_load_lds(rsrc, (LAS void*)(lds + TOK_OFF + (par) * 1024), 16, lane * 16, (int)(unit).to, 0, 0); } } while (0)
#define PG8_LDA(dst, b, h) do { _Pragma("unroll") for (int m = 0; m < 4; ++m) _Pragma("unroll") for (int k = 0; k < 2; ++k) dst[m][k] = *(const LAS bf16x8*)(lds + PG8_SA(b, h) + aoff + m * 2048 + k * 1024); } while (0)
#define PG8_LDB(dst, b, h) do { _Pragma("unroll") for (int n = 0; n < 2; ++n) _Pragma("unroll") for (int k = 0; k < 2; ++k) dst[n][k] = *(const LAS bf16x8*)(lds + PG8_SB(b, h) + boff + n * 2048 + k * 1024); } while (0)
#define PG8_MMA(ai, bj, At, Bt) do { __builtin_amdgcn_s_setprio(1); _Pragma("unroll") for (int m = 0; m < 4; ++m) _Pragma("unroll") for (int n = 0; n < 2; ++n) { \
        if constexpr (F8) { asm volatile("v_mfma_scale_f32_16x16x128_f8f6f4 %0, %1, %2, %0, %3, %3 op_sel:[0,1,0] op_sel_hi:[0,0,0]" : "+v"(acc[ai][bj][m][n]) : "v"(cat8(Bt[n][0], Bt[n][1])), "v"(cat8(At[m][0], At[m][1])), "v"(f8scales)); } \
        else { _Pragma("unroll") for (int k = 0; k < 2; ++k) acc[ai][bj][m][n] = __builtin_amdgcn_mfma_f32_16x16x32_bf16(Bt[n][k], At[m][k], acc[ai][bj][m][n], 0, 0, 0); } } \
        __builtin_amdgcn_s_setprio(0); } while (0)
#define PG8_WAIT_V(n) asm volatile("s_waitcnt vmcnt(" #n ")" ::: "memory")
#define PG8_WAIT_L(n) asm volatile("s_waitcnt lgkmcnt(" #n ")" ::: "memory")
#define PG8_BAR __builtin_amdgcn_s_barrier()
#define PG8_SCHED __builtin_amdgcn_sched_barrier(0)
    Unit cur, nxt; int ui = 0;
    if (!S.next(0, cur)) return;
    f32x4 acc[2][2][4][2];
    bf16x8 At[4][2], B0[2][2], B1[2][2];
#define PG8_INIT(par) do { if constexpr (Epi::SIDE) { const int _l = fresh_tid() & 63; E.init(acc, (const LAS float*)(lds + SIDE_OFF + (par) * 1024), wc, _l >> 4); } \
        else { _Pragma("unroll") for (int a = 0; a < 2; ++a) _Pragma("unroll") for (int b = 0; b < 2; ++b) _Pragma("unroll") for (int m = 0; m < 4; ++m) _Pragma("unroll") for (int n = 0; n < 2; ++n) acc[a][b][m][n] = (f32x4){0.f, 0.f, 0.f, 0.f}; } } while (0)
    unsigned cA = cur.ao, cB = cur.bo;
    unsigned ldsl = ldsw; asm volatile("" : "+s"(ldsl));
#define PG8_SIDE(unit, par) do { if constexpr (Epi::SIDE) { if (wid == 0) __builtin_amdgcn_raw_ptr_buffer_load_lds(rsrc, (LAS void*)(lds + SIDE_OFF + (par) * 1024), 16, lane * 16, (int)E.side_off(unit), 0, 0); } } while (0)
    PG8_SIDE(cur, 0);
    if constexpr (GATHER) PG8_TOK(cur, 0);
    if constexpr (GATHER || Epi::SIDE) { asm volatile("s_waitcnt vmcnt(0)" ::: "memory"); PG8_BAR; }
    PG8_INIT(0);
    PG8_STAGE(PG8_SB(0, 0), cB, voffB); PG8_STAGE(PG8_SB(0, 1), cB + hstepB, voffB); PG8_STAGE_A(PG8_SA(0, 0), cA, 0, 0); PG8_STAGE_A(PG8_SA(0, 1), cA, 1, 0);
    if (wr == 1) PG8_BAR;
    PG8_WAIT_V(2); PG8_BAR;
    PG8_STAGE(PG8_SB(1, 0), cB + kstep, voffB); PG8_STAGE_A(PG8_SA(1, 0), cA + kstep, 0, 0); PG8_STAGE(PG8_SB(1, 1), cB + hstepB + kstep, voffB);
    PG8_WAIT_V(6); PG8_BAR;
    for (;;) {
        const bool has_next = S.next(ui + 1, nxt);
        if (has_next) { PG8_TOK(nxt, (ui + 1) & 1); PG8_SIDE(nxt, (ui + 1) & 1); }
        const unsigned nA = has_next ? nxt.ao : cA, nB = has_next ? nxt.bo : cB;
#pragma unroll 1
        for (int t = 0; t < nt; t += 2) {
            const bool last = (t == nt - 2);
            ldsl = ldsw; asm volatile("" : "+s"(ldsl));
            const int parc = ui & 1, parn = (ui + ((last && has_next) ? 1 : 0)) & 1;
            const unsigned a1 = cA + (unsigned)(t + 1) * kstep;
            const unsigned a2 = last ? nA : cA + (unsigned)(t + 2) * kstep, b2 = last ? nB : cB + (unsigned)(t + 2) * kstep;
            const unsigned a3 = a2 + kstep, b3 = b2 + kstep;
            PG8_LDB(B0, 0, 0); PG8_LDB(B1, 0, 1); PG8_SCHED; PG8_LDA(At, 0, 0); PG8_STAGE_A(PG8_SA(1, 1), a1, 1, parc);
            PG8_WAIT_V(8); PG8_WAIT_L(0); PG8_BAR; PG8_MMA(0, 0, At, B0); PG8_MMA(0, 1, At, B1); PG8_BAR; PG8_SCHED;
            PG8_LDA(At, 0, 1); PG8_STAGE(PG8_SB(0, 0), b2, voffB); PG8_STAGE(PG8_SB(0, 1), b2 + hstepB, voffB); PG8_STAGE_A(PG8_SA(0, 0), a2, 0, parn);
            PG8_WAIT_V(8); PG8_WAIT_L(0); PG8_BAR; PG8_MMA(1, 0, At, B0); PG8_MMA(1, 1, At, B1); PG8_BAR; PG8_SCHED;
            PG8_LDB(B0, 1, 0); PG8_LDB(B1, 1, 1); PG8_SCHED; PG8_LDA(At, 1, 0); PG8_STAGE_A(PG8_SA(0, 1), a2, 1, parn);
            PG8_WAIT_V(8); PG8_WAIT_L(0); PG8_BAR; PG8_MMA(0, 0, At, B0); PG8_MMA(0, 1, At, B1); PG8_BAR; PG8_SCHED;
            PG8_LDA(At, 1, 1); PG8_STAGE(PG8_SB(1, 0), b3, voffB); PG8_STAGE(PG8_SB(1, 1), b3 + hstepB, voffB); PG8_STAGE_A(PG8_SA(1, 0), a3, 0, parn);
            PG8_WAIT_V(8); PG8_WAIT_L(0); PG8_BAR; PG8_MMA(1, 0, At, B0); PG8_MMA(1, 1, At, B1); PG8_BAR; PG8_SCHED;
        }
        if constexpr (F8) asm volatile("s_nop 15\n\ts_nop 15" ::: "memory");
        if (wr == 0) PG8_BAR;
        { const int l2 = fresh_tid() & 63; E(acc, cur, wr, wc, l2 & 15, l2 >> 4, (const LAS float*)(lds + SIDE_OFF + (ui & 1) * 1024)); }
        if (!has_next) break;
        cur = nxt; cA = nA; cB = nB; ++ui;
        PG8_INIT(ui & 1);
        if (wr == 1) PG8_BAR;
    }
    PG8_WAIT_V(0);
    PG8_BAR;
#undef PG8_SA
#undef PG8_SB
#undef PG8_STAGE
#undef PG8_STAGE_A
#undef PG8_TOK
#undef PG8_SIDE
#undef PG8_INIT
#undef hstepvoffA
#undef hstepvoffB
#undef PG8_LDA
#undef PG8_LDB
#undef PG8_MMA
#undef PG8_WAIT_V
#undef PG8_WAIT_L
#undef PG8_BAR
#undef PG8_SCHED
}
}

using pg8::Unit;

struct DenseSched {
    unsigned A, Bt; int lda, ldb, nM, nN, G, c;
    __device__ __forceinline__ bool next(int i, Unit& u) const {
        const int L = i * G + c; if (L >= nM * nN) return false;
        pg8::tile_of(L, nM, nN, u.pm, u.pn); u.aux = 0; u.to = 0;
        u.ao = A + (unsigned)u.pm * 256 * lda * 2; u.bo = Bt + (unsigned)u.pn * 256 * ldb * 2; return true;
    }
};
struct GateSched {
    unsigned XC, GT; int nM, G, c;
    __device__ __forceinline__ bool next(int i, Unit& u) const {
        const int per = nM * 4; const int L = i * G + c; if (L >= 4 * per) return false;
        const int nb = L / per; pg8::tile_of(L - nb * per, nM, 4, u.pm, u.pn); u.aux = nb; u.to = 0;
        u.ao = XC + ((unsigned)u.pm * 256 * 1024 + 256 * nb) * 2; u.bo = GT + ((unsigned)nb * 1024 + 256 * u.pn) * 256 * 2; return true;
    }
};
struct QkvSched {
    unsigned HB, WT; int nM, G, c;
    __device__ __forceinline__ bool next(int i, Unit& u) const {
        const int n0 = nM * 8, n1 = 4 * nM; const int L = i * G + c; if (L >= n0 + n1) return false; u.to = 0;
        if (L < n0) { pg8::tile_of(L, nM, 8, u.pm, u.pn); u.aux = 0; u.ao = HB + (unsigned)u.pm * 256 * 1024; u.bo = WT + (unsigned)u.pn * 256 * 1024; }
        else { pg8::tile_of(L - n0, 4, nM, u.pm, u.pn); u.aux = 1; u.ao = WT + (unsigned)(2048 + u.pm * 256) * 1024; u.bo = HB + (unsigned)u.pn * 256 * 1024; }
        return true;
    }
};
struct MoeSched {
    unsigned A, W, tok; const LAS int* texp; unsigned wstride; int nM, nN, G, c;
    __device__ __forceinline__ bool next(int i, Unit& u) const {
        const int L = i * G + c; if (L >= nM * nN) return false;
        pg8::tile_of(L, nM, nN, u.pm, u.pn);
        const int e = __builtin_amdgcn_readfirstlane(texp[u.pm]); u.aux = e;
        u.ao = tok ? A : A + (unsigned)u.pm * 256 * 1024; u.to = tok + (unsigned)u.pm * 1024; u.bo = W + (unsigned)e * wstride + (unsigned)u.pn * 256 * 1024; return true;
    }
};

#define EPI_ARGS const f32x4 (&acc)[2][2][4][2], const Unit& u, int wr, int wc, int fr, int fq, const LAS float* side
struct EpiWin {
    static constexpr bool PERM = true, SIDE = false;
    bf16_t* XR; bf16_t* GY;
    __device__ __forceinline__ void operator()(EPI_ARGS) const {
        const int row0 = u.pm * 256 + wr * 64 + fr;
        if (u.pn < 4) {
            const int col0 = u.pn * 256 + wc * 32 + 8 * fq;
#pragma unroll
            for (int ai = 0; ai < 2; ++ai)
#pragma unroll
                for (int m = 0; m < 4; ++m) { bf16_t* rowp = XR + (size_t)(row0 + ai * 128 + m * 16) * D + col0;
#pragma unroll
                    for (int bj = 0; bj < 2; ++bj) { const f32x4 v0 = acc[ai][bj][m][0], v1 = acc[ai][bj][m][1];
                        u32x4 w; w.x = cvt_pk_bf16(v0[0], v0[1]); w.y = cvt_pk_bf16(v0[2], v0[3]); w.z = cvt_pk_bf16(v1[0], v1[1]); w.w = cvt_pk_bf16(v1[2], v1[3]);
                        *(u32x4*)(rowp + bj * 128) = w; } }
        } else {
#pragma unroll
            for (int ai = 0; ai < 2; ++ai)
#pragma unroll
                for (int m = 0; m < 4; ++m) { const int row = row0 + ai * 128 + m * 16;
#pragma unroll
                    for (int bj = 0; bj < 2; ++bj) { const int g = (u.pn - 4) * 8 + bj * 4 + wc;
                        float o[8];
#pragma unroll
                        for (int n = 0; n < 2; ++n)
#pragma unroll
                            for (int j = 0; j < 4; ++j) { const float v = acc[ai][bj][m][n][j]; const float z = 1.5957691216f * (v + 0.044715f * v * v * v); o[n * 4 + j] = v * sigmoidf_(z); }
                        u32x4 w; w.x = cvt_pk_bf16(o[0], o[1]); w.y = cvt_pk_bf16(o[2], o[3]); w.z = cvt_pk_bf16(o[4], o[5]); w.w = cvt_pk_bf16(o[6], o[7]);
                        *(u32x4*)(GY + ((size_t)g * MPAD + row) * 32 + 8 * fq) = w; } }
        }
    }
};
struct EpiGate {
    static constexpr bool PERM = true, SIDE = true;
    const bf16_t* XC; unsigned char* LB; const float* spl; unsigned bias_off;
    __device__ __forceinline__ unsigned side_off(const Unit& u) const { return bias_off + (unsigned)((((u.pn >> 1) * 4 + u.aux) * 2 + (u.pn & 1)) * 1024); }
    __device__ __forceinline__ void init(f32x4 (&acc)[2][2][4][2], const LAS float* side, int wc, int fq) const {
#pragma unroll
        for (int bj = 0; bj < 2; ++bj)
#pragma unroll
            for (int n = 0; n < 2; ++n) { const f32x4 b = *(const LAS f32x4*)(side + 128 * bj + 32 * wc + 8 * fq + 4 * n);
#pragma unroll
                for (int ai = 0; ai < 2; ++ai)
#pragma unroll
                    for (int m = 0; m < 4; ++m) acc[ai][bj][m][n] = b; }
    }
    __device__ __forceinline__ void operator()(EPI_ARGS) const {
        const int nb = u.aux, dir = u.pn >> 1, half = u.pn & 1;
        const int ch0 = 256 * nb + 128 * half + 32 * wc + 8 * fq, g = ch0 >> 5;
        const int row0 = u.pm * 256 + wr * 64 + fr;
        float csp[8];
        { const f32x4 p0 = *(const f32x4*)(spl + dir * 1024 + ch0), p1 = *(const f32x4*)(spl + dir * 1024 + ch0 + 4);
#pragma unroll
          for (int j = 0; j < 4; ++j) { csp[j] = (-2.0f / 256.0f) * p0[j]; csp[4 + j] = (-2.0f / 256.0f) * p1[j]; } }
        u32x4 xnext = *(const u32x4*)(XC + (size_t)row0 * D + ch0);
#pragma unroll
        for (int ai = 0; ai < 2; ++ai)
#pragma unroll
            for (int m = 0; m < 4; ++m) { const int row = row0 + ai * 128 + m * 16;
                const u32x4 xw = xnext;
                { const int it = ai * 4 + m + 1, rn = row0 + (it >> 2) * 128 + (it & 3) * 16; if (it < 8) xnext = *(const u32x4*)(XC + (size_t)rn * D + ch0); }
                float xc[8]; unpack8(xw, xc);
                const bool start = dir == 1 && (row & (SEQ - 1)) == SEQ - 1;
                float sg[8], bb[8];
#pragma unroll
                for (int n = 0; n < 2; ++n)
#pragma unroll
                    for (int j = 0; j < 4; ++j) { const int i = n * 4 + j;
                        const float sga = fast_rcp(__builtin_fmaf(fast_exp2(-1.44269504089f * acc[ai][0][m][n][j]), 1.0f / 256.0f, 1.0f / 256.0f));
                        const float a2 = fast_exp2(__builtin_fmaf(csp[i], sga, 6.0f));
                        const float mult = __builtin_amdgcn_sqrtf(__builtin_fabsf(64.0f - a2));
                        sg[i] = sga; bb[i] = __builtin_amdgcn_fmed3f(mult * sigmoidf_(acc[ai][1][m][n][j]) * xc[i], -448.0f, 448.0f); }
                if (start) {
#pragma unroll
                    for (int n = 0; n < 2; ++n)
#pragma unroll
                        for (int j = 0; j < 4; ++j) bb[n * 4 + j] = __builtin_amdgcn_fmed3f(8.0f * sigmoidf_(acc[ai][1][m][n][j]) * xc[n * 4 + j], -448.0f, 448.0f); }
                u32x4 w; w.x = pk4_fp8(sg[0], sg[1], sg[2], sg[3]); w.y = pk4_fp8(sg[4], sg[5], sg[6], sg[7]); w.z = pk4_fp8(bb[0], bb[1], bb[2], bb[3]); w.w = pk4_fp8(bb[4], bb[5], bb[6], bb[7]);
                *(u32x4*)(LB + (((size_t)dir * 32 + g) * MPAD + row) * 64 + 16 * fq) = w; }
    }
};
template <bool LAYER0> struct EpiRes {
    static constexpr bool PERM = true, SIDE = false;
    bf16_t* PRE; const float* x; const float* meta; const bf16_t* HB; int nrows;
    __device__ __forceinline__ void operator()(EPI_ARGS) const {
        const int row0 = u.pm * 256 + wr * 64 + fr, col0 = u.pn * 256 + wc * 32 + 8 * fq;
#pragma unroll
        for (int ai = 0; ai < 2; ++ai)
#pragma unroll
            for (int m = 0; m < 4; ++m) { const int row = row0 + ai * 128 + m * 16;
                if (row < nrows) {
#pragma unroll
                    for (int bj = 0; bj < 2; ++bj) { const int c = col0 + bj * 128; float r[8];
                        if (LAYER0) { const float* rp = (row < NGRID ? x + (size_t)row * D : meta + (size_t)((row - NGRID) & 15) * D) + c; const f32x4 r0 = *(const f32x4*)rp, r1 = *(const f32x4*)(rp + 4);
                            r[0] = r0[0]; r[1] = r0[1]; r[2] = r0[2]; r[3] = r0[3]; r[4] = r1[0]; r[5] = r1[1]; r[6] = r1[2]; r[7] = r1[3]; }
                        else { const u32x4 rw = *(const u32x4*)(HB + (size_t)row * D + c); r[0] = bflo(rw.x); r[1] = bfhi(rw.x); r[2] = bflo(rw.y); r[3] = bfhi(rw.y); r[4] = bflo(rw.z); r[5] = bfhi(rw.z); r[6] = bflo(rw.w); r[7] = bfhi(rw.w); }
                        const f32x4 a0 = acc[ai][bj][m][0], a1 = acc[ai][bj][m][1];
                        u32x4 w; w.x = cvt_pk_bf16(r[0] * DN_ALPHA + a0[0], r[1] * DN_ALPHA + a0[1]); w.y = cvt_pk_bf16(r[2] * DN_ALPHA + a0[2], r[3] * DN_ALPHA + a0[3]);
                        w.z = cvt_pk_bf16(r[4] * DN_ALPHA + a1[0], r[5] * DN_ALPHA + a1[1]); w.w = cvt_pk_bf16(r[6] * DN_ALPHA + a1[2], r[7] * DN_ALPHA + a1[3]);
                        *(u32x4*)(PRE + (size_t)row * D + c) = w; }
                }
                asm volatile("" ::: "memory"); }
    }
};
struct EpiGlu {
    static constexpr bool PERM = true, SIDE = true; static constexpr int SCALES = 0x7F79;
    unsigned char* ACT; unsigned bias_off;
    __device__ __forceinline__ unsigned side_off(const Unit& u) const { return bias_off + (unsigned)((u.aux * 8 + u.pn) * 1024); }
    __device__ __forceinline__ void init(f32x4 (&acc)[2][2][4][2], const LAS float* side, int wc, int fq) const {
#pragma unroll
        for (int bj = 0; bj < 2; ++bj)
#pragma unroll
            for (int n = 0; n < 2; ++n) { const f32x4 b = *(const LAS f32x4*)(side + 128 * bj + 32 * wc + 8 * fq + 4 * n);
#pragma unroll
                for (int ai = 0; ai < 2; ++ai)
#pragma unroll
                    for (int m = 0; m < 4; ++m) acc[ai][bj][m][n] = b; }
    }
    __device__ __forceinline__ void operator()(EPI_ARGS) const {
        const int f0 = 128 * u.pn + 32 * wc + 8 * fq;
        const int row0 = u.pm * 256 + wr * 64 + fr;
#pragma unroll
        for (int ai = 0; ai < 2; ++ai)
#pragma unroll
            for (int m = 0; m < 4; ++m) { const int row = row0 + ai * 128 + m * 16; float o[8];
#pragma unroll
                for (int n = 0; n < 2; ++n)
#pragma unroll
                    for (int j = 0; j < 4; ++j) { const int i = n * 4 + j;
                        const float glu = fminf(acc[ai][0][m][n][j], 7.0f);
                        const float lin1 = __builtin_amdgcn_fmed3f(acc[ai][1][m][n][j], -6.0f, 8.0f);
                        const float r4 = fast_rcp(__builtin_fmaf(fast_exp2(glu * (-1.702f * 1.44269504089f)), 0.25f, 0.25f));
                        o[i] = (glu * r4) * lin1; }
                u32x2 w; w.x = pk4_fp8(o[0], o[1], o[2], o[3]); w.y = pk4_fp8(o[4], o[5], o[6], o[7]);
                *(u32x2*)(ACT + (size_t)row * D + f0) = w; }
    }
};
struct EpiNull {
    static constexpr bool PERM = true, SIDE = false; static constexpr int SCALES = 0x7F79;
    __device__ __forceinline__ void operator()(EPI_ARGS) const {
#pragma unroll
        for (int ai = 0; ai < 2; ++ai)
#pragma unroll
            for (int bj = 0; bj < 2; ++bj)
#pragma unroll
                for (int m = 0; m < 4; ++m)
#pragma unroll
                    for (int n = 0; n < 2; ++n) asm volatile("" :: "v"(acc[ai][bj][m][n]));
    }
};
struct EpiDown {
    static constexpr bool PERM = true, SIDE = true; static constexpr int SCALES = 0x7D79;
    unsigned char* YS; unsigned bias_off;
    __device__ __forceinline__ unsigned side_off(const Unit& u) const { return bias_off + (unsigned)((u.aux * 4 + u.pn) * 1024); }
    __device__ __forceinline__ void init(f32x4 (&acc)[2][2][4][2], const LAS float* side, int wc, int fq) const {
#pragma unroll
        for (int bj = 0; bj < 2; ++bj)
#pragma unroll
            for (int n = 0; n < 2; ++n) { const f32x4 b = *(const LAS f32x4*)(side + 128 * bj + 32 * wc + 8 * fq + 4 * n);
#pragma unroll
                for (int ai = 0; ai < 2; ++ai)
#pragma unroll
                    for (int m = 0; m < 4; ++m) acc[ai][bj][m][n] = b; }
    }
    __device__ __forceinline__ void operator()(EPI_ARGS) const {
        const int row0 = u.pm * 256 + wr * 64 + fr, col0 = u.pn * 256 + wc * 32 + 8 * fq;
#pragma unroll
        for (int ai = 0; ai < 2; ++ai)
#pragma unroll
            for (int m = 0; m < 4; ++m) { unsigned char* rowp = YS + (size_t)(row0 + ai * 128 + m * 16) * D + col0;
#pragma unroll
                for (int bj = 0; bj < 2; ++bj) { const f32x4 v0 = acc[ai][bj][m][0] * 8.0f, v1 = acc[ai][bj][m][1] * 8.0f;
                    u32x2 w; w.x = pk4_fp8(v0[0], v0[1], v0[2], v0[3]); w.y = pk4_fp8(v1[0], v1[1], v1[2], v1[3]);
                    *(u32x2*)(rowp + bj * 128) = w; } }
    }
};
struct EpiQkv {
    static constexpr bool PERM = true, SIDE = false; static constexpr int SCALES = 0x7F79;
    bf16_t* Q; bf16_t* Kx; bf16_t* VT;
    __device__ __forceinline__ void operator()(EPI_ARGS) const {
        const int row0 = u.pm * 256 + wr * 64 + fr; bf16_t* base; int ldc, colt; float sc = 1.0f;
        if (u.aux == 0) { ldc = D; if (u.pn < 4) { base = Q; colt = u.pn * 256; sc = 0.125f * 1.44269504089f; } else { base = Kx; colt = (u.pn - 4) * 256; } }
        else { base = VT; ldc = MPAD; colt = u.pn * 256; }
        const int col0 = colt + wc * 32 + 8 * fq;
#pragma unroll
        for (int ai = 0; ai < 2; ++ai)
#pragma unroll
            for (int m = 0; m < 4; ++m) { bf16_t* rowp = base + (size_t)(row0 + ai * 128 + m * 16) * ldc + col0;
#pragma unroll
                for (int bj = 0; bj < 2; ++bj) { const f32x4 v0 = acc[ai][bj][m][0] * sc, v1 = acc[ai][bj][m][1] * sc;
                    u32x4 w; w.x = cvt_pk_bf16(v0[0], v0[1]); w.y = cvt_pk_bf16(v0[2], v0[3]); w.z = cvt_pk_bf16(v1[0], v1[1]); w.w = cvt_pk_bf16(v1[2], v1[3]);
                    *(u32x4*)(rowp + bj * 128) = w; } }
    }
};

struct CvItem { const float* src; unsigned char* dst; int ld, pitch, f8; };
__device__ __forceinline__ CvItem cv_item(const Ctx& C, unsigned char* wsl, int it) {
    constexpr int I0 = 512, I1 = 256, I2 = 256, I3 = 768, I4 = 256, I5 = 32768, I6 = 16384;
    CvItem q; int r = it;
    if (r < I0) { const int nbk = r & 63, kb = r >> 6; q.src = C.in[I_WIN] + (size_t)(128 * kb) * 2048 + 32 * nbk; q.ld = 2048; q.dst = wsl + WS_WIN + ((size_t)(32 * nbk) * 1024 + 128 * kb) * 2; q.pitch = 2048; q.f8 = 0; return q; } r -= I0;
    if (r < I1) { const int job = r >> 3, sub = r & 7, nbk = sub & 3, kb = sub >> 2;
        const int half = job & 1, which = (job >> 1) & 1, nb = (job >> 2) & 3, dir = job >> 4;
        q.src = C.in[which ? I_WX : I_WA] + (size_t)(dir * 4 + nb) * 65536 + (size_t)(128 * kb) * 256 + 128 * half + 32 * nbk; q.ld = 256;
        q.dst = wsl + WS_GATE + (((size_t)nb * 1024 + 256 * (2 * dir + half) + 128 * which + 32 * nbk) * 256 + 128 * kb) * 2; q.pitch = 512; q.f8 = 0; return q; } r -= I1;
    if (r < I2) { const int nbk = r & 31, kb = r >> 5; q.src = C.in[I_LOUT] + (size_t)(128 * kb) * 1024 + 32 * nbk; q.ld = 1024; q.dst = wsl + WS_LOUT + ((size_t)(32 * nbk) * 1024 + 128 * kb) * 2; q.pitch = 2048; q.f8 = 0; return q; } r -= I2;
    if (r < I3) { const int nbk = r % 96, kb = r / 96; q.src = C.in[I_WQKV] + (size_t)(128 * kb) * 3072 + 32 * nbk; q.ld = 3072; q.dst = wsl + WS_QKV + ((size_t)(32 * nbk) * 1024 + 128 * kb) * 2; q.pitch = 2048; q.f8 = 0; return q; } r -= I3;
    if (r < I4) { const int nbk = r & 31, kb = r >> 5; q.src = C.in[I_NOUT] + (size_t)(128 * kb) * 1024 + 32 * nbk; q.ld = 1024; q.dst = wsl + WS_NOUT + ((size_t)(32 * nbk) * 1024 + 128 * kb) * 2; q.pitch = 2048; q.f8 = 0; return q; } r -= I4;
    q.f8 = 1; q.pitch = 1024;
    if (r < I5) { const int mat = r >> 9, sub = r & 511, nbk = sub & 63, kb = sub >> 6; const int n0 = 32 * nbk, bj = n0 >> 10, f0 = n0 & 1023, pn = f0 >> 7, jj = f0 & 127;
        q.src = C.in[I_WGU] + (size_t)mat * 1024 * 2048 + (size_t)(128 * kb) * 2048 + n0; q.ld = 2048; q.dst = wsl + WS_WGU + ((size_t)mat * 2048 + 256 * pn + 128 * bj + jj) * 1024 + 128 * kb; return q; } r -= I5;
    if (r < I6) { const int mat = r >> 8, sub = r & 255, nbk = sub & 31, kb = sub >> 5;
        q.src = C.in[I_WD] + (size_t)mat * 1024 * 1024 + (size_t)(128 * kb) * 1024 + 32 * nbk; q.ld = 1024; q.dst = wsl + WS_WD + ((size_t)mat * 1024 + 32 * nbk) * 1024 + 128 * kb; return q; } r -= I6;
    { const int nbk = r % 96, kb = r / 96; q.src = C.in[I_WQKV] + (size_t)(128 * kb) * 3072 + 32 * nbk; q.ld = 3072; q.dst = wsl + WS_QKV8 + (size_t)(32 * nbk) * 1024 + 128 * kb; return q; }
}
__device__ __forceinline__ void phase_convert(const Ctx& C) {
    PHASE_IDS
    LAS float* scr = (LAS float*)(C.lds + wave * 16896);
    const int gw = C.bid * NWAVES + wave, NGW = C.G * NWAVES;
    constexpr int NIT = 512 + 256 + 256 + 768 + 256 + 32768 + 16384 + 768;
    if (gw < NIT) {
        const int r = lane >> 3, q4 = lane & 7, c = lane & 15, nn = lane >> 4;
        CvItem cur = cv_item(C, wsl, gw); int it = gw;
        f32x4 v[16];
#pragma unroll
        for (int i = 0; i < 16; ++i) v[i] = __builtin_nontemporal_load((const f32x4*)(cur.src + (size_t)(8 * i + r) * cur.ld + 4 * q4));
        for (;;) {
#pragma unroll
            for (int i = 0; i < 16; ++i) { LAS float* sp = scr + (8 * i + r) * 33 + 4 * q4; sp[0] = v[i][0]; sp[1] = v[i][1]; sp[2] = v[i][2]; sp[3] = v[i][3]; }
            const int nit = it + NGW; CvItem nxt = cur;
            if (nit < NIT) { nxt = cv_item(C, wsl, nit);
#pragma unroll
                for (int i = 0; i < 16; ++i) v[i] = __builtin_nontemporal_load((const f32x4*)(nxt.src + (size_t)(8 * i + r) * nxt.ld + 4 * q4)); }
            asm volatile("s_waitcnt lgkmcnt(0)" ::: "memory");
            if (cur.f8) {
#pragma unroll
                for (int j = 0; j < 8; ++j) { const int n = nn + 4 * j; const LAS float* sp = scr + (8 * c) * 33 + n;
                    u32x2 o; o.x = pk4_fp8(sp[0] * 64.0f, sp[33] * 64.0f, sp[2 * 33] * 64.0f, sp[3 * 33] * 64.0f); o.y = pk4_fp8(sp[4 * 33] * 64.0f, sp[5 * 33] * 64.0f, sp[6 * 33] * 64.0f, sp[7 * 33] * 64.0f);
                    *(u32x2*)(cur.dst + (size_t)n * cur.pitch + 8 * c) = o; }
            } else {
#pragma unroll
                for (int j = 0; j < 8; ++j) { const int n = nn + 4 * j; const LAS float* sp = scr + (8 * c) * 33 + n;
                    u32x4 o; o.x = pk2(sp[0], sp[33]); o.y = pk2(sp[2 * 33], sp[3 * 33]); o.z = pk2(sp[4 * 33], sp[5 * 33]); o.w = pk2(sp[6 * 33], sp[7 * 33]);
                    *(u32x4*)(cur.dst + (size_t)n * cur.pitch + 16 * c) = o; }
            }
            asm volatile("s_waitcnt lgkmcnt(0)" ::: "memory");
            if (nit >= NIT) break;
            cur = nxt; it = nit;
        }
    }
    const int gt = C.bid * NTHREADS + tid, NGT = C.G * NTHREADS;
    for (int i = gt; i < 2048; i += NGT) ((float*)(wsl + WS_CTL + CT_SPL))[i] = 8.0f * 1.44269504089f * log1pf(expf(-C.in[I_LAM][i]));
    for (int i = gt; i < 2 * 32 * 2048; i += NGT) { const int le = i >> 11, r = i & 2047, pn = r >> 8, bj = (r >> 7) & 1, ii = r & 127;
        ((float*)(wsl + WS_BIAS))[i] = C.in[I_BGU][(size_t)le * 2048 + bj * 1024 + 128 * pn + ii] + (bj ? 1.0f : 0.0f); }
    for (int i = gt; i < 2 * 32 * 1024; i += NGT) ((float*)(wsl + WS_BD))[i] = C.in[I_BD][i];
    for (int i = gt; i < 4096; i += NGT) { const int ut = i >> 8, which = (i >> 7) & 1, jj = i & 127, dir = ut >> 3, nb = (ut >> 1) & 3, half = ut & 1;
        ((float*)(wsl + WS_GBIAS))[i] = C.in[which ? I_BX : I_BA][dir * 1024 + 256 * nb + 128 * half + jj]; }
    for (int i0 = gt; i0 < NTOK * 128; i0 += 4 * NGT) { f32x4 a[4], b[4];
#pragma unroll
        for (int u = 0; u < 4; ++u) { const int i = i0 + u * NGT; if (i < NTOK * 128) { const int row = i >> 7, oc = i & 127;
            const float* src = (row < NGRID ? C.in[I_X] + (size_t)row * D : C.in[I_META] + (size_t)((row - NGRID) & 15) * D) + 8 * oc;
            a[u] = __builtin_nontemporal_load((const f32x4*)src); b[u] = __builtin_nontemporal_load((const f32x4*)(src + 4)); } }
#pragma unroll
        for (int u = 0; u < 4; ++u) { const int i = i0 + u * NGT; if (i < NTOK * 128) { const int row = i >> 7, oc = i & 127;
            u32x4 w; w.x = pk2(a[u][0], a[u][1]); w.y = pk2(a[u][2], a[u][3]); w.z = pk2(b[u][0], b[u][1]); w.w = pk2(b[u][2], b[u][3]);
            *(u32x4*)((bf16_t*)(wsl + WS_HB) + (size_t)row * D + 8 * oc) = w; } } }
}

__device__ __forceinline__ void phase_conv(const Ctx& C) {
    PHASE_IDS
    const bf16_t* XR = (const bf16_t*)(wsl + WS_XR); bf16_t* XC = (bf16_t*)(wsl + WS_XC);
    const float* cw = C.in[I_CONVW]; const float* cb = C.in[I_CONVB];
    const int gt = C.bid * NTHREADS + tid, NGT = C.G * NTHREADS;
    for (int i = gt; i < NTOK * 128; i += NGT) { const int row = i >> 7, ch = 8 * (i & 127);
        int b, s; if (row < NGRID) { b = row >> 12; s = NMETA + (row & (SEQ - 1)); } else { b = (row - NGRID) >> 4; s = (row - NGRID) & 15; }
        float a[8];
        { const f32x4 t0 = *(const f32x4*)(cb + ch), t1 = *(const f32x4*)(cb + ch + 4);
#pragma unroll
          for (int j = 0; j < 4; ++j) { a[j] = t0[j]; a[4 + j] = t1[j]; } }
#pragma unroll
        for (int j = 0; j < 4; ++j) { const int sj = s - 2 + j;
            if (sj >= 0 && sj < LSEQ) { const u32x4 xw = *(const u32x4*)(XR + (size_t)seqrow(b, sj) * D + ch);
                const f32x4 w0 = *(const f32x4*)(cw + j * 1024 + ch), w1 = *(const f32x4*)(cw + j * 1024 + ch + 4);
                a[0] += w0[0] * bflo(xw.x); a[1] += w0[1] * bfhi(xw.x); a[2] += w0[2] * bflo(xw.y); a[3] += w0[3] * bfhi(xw.y);
                a[4] += w1[0] * bflo(xw.z); a[5] += w1[1] * bfhi(xw.z); a[6] += w1[2] * bflo(xw.w); a[7] += w1[3] * bfhi(xw.w); } }
        u32x4 w; w.x = pk2(a[0], a[1]); w.y = pk2(a[2], a[3]); w.z = pk2(a[4], a[5]); w.w = pk2(a[6], a[7]);
        *(u32x4*)(XC + (size_t)row * D + ch) = w; }
}

template <int N> __device__ __forceinline__ float dpp_shr(float oldv, float v) {
    return __builtin_bit_cast(float, __builtin_amdgcn_update_dpp(__builtin_bit_cast(int, oldv), __builtin_bit_cast(int, v), 0x110 + N, 0xf, 0xf, false));
}
__device__ __forceinline__ void scan_group(float (&a)[8], float (&b)[8]) {
#pragma unroll
    for (int c = 0; c < 8; ++c) {
        { const float ap = dpp_shr<1>(1.0f, a[c]), bp = dpp_shr<1>(0.0f, b[c]); b[c] = a[c] * bp + b[c]; a[c] = a[c] * ap; }
        { const float ap = dpp_shr<2>(1.0f, a[c]), bp = dpp_shr<2>(0.0f, b[c]); b[c] = a[c] * bp + b[c]; a[c] = a[c] * ap; }
        { const float ap = dpp_shr<4>(1.0f, a[c]), bp = dpp_shr<4>(0.0f, b[c]); b[c] = a[c] * bp + b[c]; a[c] = a[c] * ap; }
        { const float ap = dpp_shr<8>(1.0f, a[c]), bp = dpp_shr<8>(0.0f, b[c]); b[c] = a[c] * bp + b[c]; a[c] = a[c] * ap; }
    }
}
__device__ __forceinline__ void unpack8(const u32x4 w, float (&o)[8]) { o[0] = bflo(w.x); o[1] = bfhi(w.x); o[2] = bflo(w.y); o[3] = bfhi(w.y); o[4] = bflo(w.z); o[5] = bfhi(w.z); o[6] = bflo(w.w); o[7] = bfhi(w.w); }
__device__ __forceinline__ void phase_scan(const Ctx& C) {
    PHASE_IDS
    const unsigned char* LB = wsl + WS_LA; const float* spl = (const float*)(wsl + WS_CTL + CT_SPL); const bf16_t* GY = (const bf16_t*)(wsl + WS_GY);
    bf16_t* HF = (bf16_t*)(wsl + WS_HF); bf16_t* Gout = (bf16_t*)(wsl + WS_G);
    LAS float* agg = (LAS float*)C.lds;
    const int w = wave, oct = lane >> 4, p = lane & 15;
    for (int it0 = (C.G == 256 ? C.gc : C.bid); it0 < NB * 32; it0 += C.G) {
        const int item = (C.G == 256) ? (((it0 >> 3) >> 2) << 5) + ((it0 & 7) << 2) + ((it0 >> 3) & 3) : it0;
        const int b = item >> 5, g = item & 31;
        for (int dir = 0; dir < 2; ++dir) {
            const unsigned char* lb = LB + (((size_t)dir * 32 + g) * MPAD) * 64 + 16 * oct;
            float cs[8];
            { const f32x4 p0 = *(const f32x4*)(spl + dir * 1024 + 32 * g + 8 * oct), p1 = *(const f32x4*)(spl + dir * 1024 + 32 * g + 8 * oct + 4);
#pragma unroll
              for (int c = 0; c < 4; ++c) { cs[c] = p0[c] * (-1.0f / 256.0f); cs[4 + c] = p1[c] * (-1.0f / 256.0f); } }
            float S[8];
#pragma unroll
            for (int c = 0; c < 8; ++c) S[c] = 0.f;
            {
                const int u = p, s = dir ? LSEQ - 1 - u : u, row = seqrow(b, s);
                float a[8], x[8]; { const u32x4 rec = *(const u32x4*)(lb + (size_t)row * 64); u32x2 t; t.x = rec.x; t.y = rec.y; unpack8_fp8(t, a); t.x = rec.z; t.y = rec.w; unpack8_fp8(t, x); }
#pragma unroll
                for (int c = 0; c < 8; ++c) { a[c] = fast_exp2(a[c] * cs[c]); x[c] *= 0.125f; }
                scan_group(a, x);
                if (w == 0) {
                    if (dir == 0) { u32x4 o; o.x = pk2(x[0], x[1]); o.y = pk2(x[2], x[3]); o.z = pk2(x[4], x[5]); o.w = pk2(x[6], x[7]); *(u32x4*)(HF + ((size_t)g * MPAD + row) * 32 + 8 * oct) = o; }
                    else { float hf[8], gy[8]; unpack8(*(const u32x4*)(HF + ((size_t)g * MPAD + row) * 32 + 8 * oct), hf); unpack8(*(const u32x4*)(GY + ((size_t)g * MPAD + row) * 32 + 8 * oct), gy);
                        u32x4 o; o.x = pk2((hf[0] + x[0]) * gy[0], (hf[1] + x[1]) * gy[1]); o.y = pk2((hf[2] + x[2]) * gy[2], (hf[3] + x[3]) * gy[3]);
                        o.z = pk2((hf[4] + x[4]) * gy[4], (hf[5] + x[5]) * gy[5]); o.w = pk2((hf[6] + x[6]) * gy[6], (hf[7] + x[7]) * gy[7]);
                        *(u32x4*)(Gout + (size_t)row * D + 32 * g + 8 * oct) = o; }
                }
#pragma unroll
                for (int c = 0; c < 8; ++c) S[c] = __shfl(x[c], (lane & 48) | 15);
            }
            u32x4 na[4];
#pragma unroll
            for (int j = 0; j < 4; ++j) { const int u = 16 + 64 * w + 16 * j + p, s = dir ? LSEQ - 1 - u : u; const int rw = seqrow(b, s);
                na[j] = __builtin_nontemporal_load((const u32x4*)(lb + (size_t)rw * 64)); }
            for (int r = 0; r < 8; ++r) {
                float Pw[4][8], Hw[4][8]; int rows[4];
                float Aw[8], Hc[8];
#pragma unroll
                for (int c = 0; c < 8; ++c) { Aw[c] = 1.f; Hc[c] = 0.f; }
                u32x4 ra[4], rhf[4], rgy[4];
#pragma unroll
                for (int j = 0; j < 4; ++j) { const int u = 16 + 512 * r + 64 * w + 16 * j + p, s = dir ? LSEQ - 1 - u : u; rows[j] = seqrow(b, s); ra[j] = na[j]; }
                if (r < 7) {
#pragma unroll
                    for (int j = 0; j < 4; ++j) { const int u = 16 + 512 * (r + 1) + 64 * w + 16 * j + p, s = dir ? LSEQ - 1 - u : u; const int rw = seqrow(b, s);
                        na[j] = __builtin_nontemporal_load((const u32x4*)(lb + (size_t)rw * 64)); } }
                if (dir == 1) {
#pragma unroll
                    for (int j = 0; j < 4; ++j) { const size_t go = ((size_t)g * MPAD + rows[j]) * 32 + 8 * oct; rhf[j] = *(const u32x4*)(HF + go); rgy[j] = __builtin_nontemporal_load((const u32x4*)(GY + go)); } }
#pragma unroll
                for (int j = 0; j < 4; ++j) {
                    float a[8], x[8]; { u32x2 t; t.x = ra[j].x; t.y = ra[j].y; unpack8_fp8(t, a); t.x = ra[j].z; t.y = ra[j].w; unpack8_fp8(t, x); }
#pragma unroll
                    for (int c = 0; c < 8; ++c) { a[c] = fast_exp2(a[c] * cs[c]); x[c] *= 0.125f; }
                    scan_group(a, x);
#pragma unroll
                    for (int c = 0; c < 8; ++c) { Hw[j][c] = a[c] * Hc[c] + x[c]; Pw[j][c] = a[c] * Aw[c]; }
#pragma unroll
                    for (int c = 0; c < 8; ++c) { Aw[c] = __shfl(Pw[j][c], (lane & 48) | 15); Hc[c] = __shfl(Hw[j][c], (lane & 48) | 15); }
                }
                LAS float* ag = agg + (r & 1) * 512;
                if (p == 0) {
#pragma unroll
                    for (int c = 0; c < 8; ++c) { ag[(w * 32 + oct * 8 + c) * 2] = Aw[c]; ag[(w * 32 + oct * 8 + c) * 2 + 1] = Hc[c]; }
                }
                __syncthreads();
                float Sin[8];
#pragma unroll
                for (int c = 0; c < 8; ++c) Sin[c] = S[c];
#pragma unroll
                for (int ww = 0; ww < 8; ++ww) {
#pragma unroll
                    for (int c = 0; c < 8; ++c) { const float A = ag[(ww * 32 + oct * 8 + c) * 2], H = ag[(ww * 32 + oct * 8 + c) * 2 + 1];
                        if (ww == w) Sin[c] = S[c];
                        S[c] = A * S[c] + H; }
                }
#pragma unroll
                for (int j = 0; j < 4; ++j) {
                    float h[8];
#pragma unroll
                    for (int c = 0; c < 8; ++c) h[c] = Pw[j][c] * Sin[c] + Hw[j][c];
                    const size_t go = ((size_t)g * MPAD + rows[j]) * 32 + 8 * oct;
                    if (dir == 0) { u32x4 o; o.x = pk2(h[0], h[1]); o.y = pk2(h[2], h[3]); o.z = pk2(h[4], h[5]); o.w = pk2(h[6], h[7]); *(u32x4*)(HF + go) = o; }
                    else { float hf[8], gy[8]; unpack8(rhf[j], hf); unpack8(rgy[j], gy);
                        u32x4 o; o.x = pk2((hf[0] + h[0]) * gy[0], (hf[1] + h[1]) * gy[1]); o.y = pk2((hf[2] + h[2]) * gy[2], (hf[3] + h[3]) * gy[3]);
                        o.z = pk2((hf[4] + h[4]) * gy[4], (hf[5] + h[5]) * gy[5]); o.w = pk2((hf[6] + h[6]) * gy[6], (hf[7] + h[7]) * gy[7]);
                        *(u32x4*)(Gout + (size_t)rows[j] * D + 32 * g + 8 * oct) = o; }
                }
            }
            __syncthreads();
        }
    }
}

template <int K> __device__ __forceinline__ f32x4 mini_mma(const bf16_t* W, int ldw, const bf16_t* A, int lda, int lane) {
    const bf16_t* wp = W + (size_t)(lane & 15) * ldw + 8 * (lane >> 4); const bf16_t* ap = A + (size_t)(lane & 15) * lda + 8 * (lane >> 4);
    f32x4 acc = {0.f, 0.f, 0.f, 0.f};
    constexpr int KB = K < 512 ? K : 512, NS = KB / 32;
#pragma unroll 1
    for (int k0 = 0; k0 < K; k0 += KB) { bf16x8 wf[NS], af[NS];
#pragma unroll
        for (int i = 0; i < NS; ++i) { wf[i] = *(const bf16x8*)(wp + k0 + 32 * i); af[i] = *(const bf16x8*)(ap + k0 + 32 * i); }
#pragma unroll
        for (int i = 0; i < NS; ++i) acc = __builtin_amdgcn_mfma_f32_16x16x32_bf16(wf[i], af[i], acc, 0, 0, 0); }
    return acc;
}
__device__ __forceinline__ void mini_win(const Ctx& C) {
    PHASE_IDS
    const bf16_t* HB = (const bf16_t*)(C.ws + WS_HB); const bf16_t* WT = (const bf16_t*)(C.ws + WS_WIN); bf16_t* XR = (bf16_t*)(C.ws + WS_XR); bf16_t* GY = (bf16_t*)(C.ws + WS_GY);
    const int fr = lane & 15, fq = lane >> 4;
    for (int wt = C.gc * NWAVES + wave; wt < 8 * 128; wt += C.G * NWAVES) { const int rg = wt & 7, cb = wt >> 3, row = NGRID + 16 * rg + fr, c = 16 * cb + 4 * fq;
        const f32x4 a = mini_mma<1024>(WT + (size_t)(16 * cb) * 1024, 1024, HB + (size_t)(NGRID + 16 * rg) * 1024, 1024, lane);
        if (c < 1024) { u32x2 w; w.x = cvt_pk_bf16(a[0], a[1]); w.y = cvt_pk_bf16(a[2], a[3]); *(u32x2*)(XR + (size_t)row * D + c) = w; }
        else { const int yc = c - 1024; float o[4];
#pragma unroll
            for (int j = 0; j < 4; ++j) { const float v = a[j]; const float z = 1.5957691216f * (v + 0.044715f * v * v * v); o[j] = v * sigmoidf_(z); }
            u32x2 w; w.x = cvt_pk_bf16(o[0], o[1]); w.y = cvt_pk_bf16(o[2], o[3]); *(u32x2*)(GY + ((size_t)(yc >> 5) * MPAD + row) * 32 + (yc & 31)) = w; } }
}
__device__ __forceinline__ void mini_gate(const Ctx& C) {
    PHASE_IDS
    const bf16_t* XC = (const bf16_t*)(C.ws + WS_XC); const bf16_t* GT = (const bf16_t*)(C.ws + WS_GATE); unsigned char* LB = C.ws + WS_LA;
    const float* ba = C.in[I_BA]; const float* bx = C.in[I_BX]; const float* spl = (const float*)(C.ws + WS_CTL + CT_SPL);
    const int fr = lane & 15, fq = lane >> 4;
    for (int wt = C.gc * NWAVES + wave; wt < 8 * 2 * 64; wt += C.G * NWAVES) { const int rg = wt & 7, dir = (wt >> 3) & 1, chg = wt >> 4, ch0 = 16 * chg, nb = ch0 >> 8, half = (ch0 >> 7) & 1, jj0 = ch0 & 127;
        const bf16_t* A = XC + (size_t)(NGRID + 16 * rg) * 1024 + 256 * nb; const bf16_t* Wa = GT + ((size_t)nb * 1024 + 256 * (2 * dir + half) + jj0) * 256;
        const f32x4 za = mini_mma<256>(Wa, 256, A, 1024, lane), zx = mini_mma<256>(Wa + 128 * 256, 256, A, 1024, lane);
        const int row = NGRID + 16 * rg + fr, ch = ch0 + 4 * fq;
        const f32x4 cba = *(const f32x4*)(ba + dir * 1024 + ch), cbx = *(const f32x4*)(bx + dir * 1024 + ch), csp = *(const f32x4*)(spl + dir * 1024 + ch);
        const u32x2 xw = *(const u32x2*)(XC + (size_t)row * D + ch); const float xc[4] = {bflo(xw.x), bfhi(xw.x), bflo(xw.y), bfhi(xw.y)};
        float sg[4], bb[4];
#pragma unroll
        for (int j = 0; j < 4; ++j) { const float sga = sigmoidf_(za[j] + cba[j]); const float a2 = fast_exp2(-2.0f * csp[j] * sga);
            const float mult = (dir == 0 && fr == 0) ? 8.0f : 8.0f * __builtin_amdgcn_sqrtf(fmaxf(1.0f - a2, 0.0f));
            sg[j] = sga * 256.0f; bb[j] = __builtin_amdgcn_fmed3f(mult * sigmoidf_(zx[j] + cbx[j]) * xc[j], -448.0f, 448.0f); }
        unsigned char* o = LB + (((size_t)dir * 32 + (ch >> 5)) * MPAD + row) * 64 + 16 * ((ch & 31) >> 3) + (ch & 7);
        *(unsigned*)o = pk4_fp8(sg[0], sg[1], sg[2], sg[3]); *(unsigned*)(o + 8) = pk4_fp8(bb[0], bb[1], bb[2], bb[3]); }
}
__device__ __forceinline__ void mini_lout(const Ctx& C) {
    PHASE_IDS
    const bf16_t* G = (const bf16_t*)(C.ws + WS_G); const bf16_t* WT = (const bf16_t*)(C.ws + WS_LOUT); bf16_t* PRE = (bf16_t*)(C.ws + WS_PRE); const float* meta = C.in[I_META];
    const int fr = lane & 15, fq = lane >> 4;
    for (int wt = C.gc * NWAVES + wave; wt < 8 * 64; wt += C.G * NWAVES) { const int rg = wt & 7, cb = wt >> 3, row = NGRID + 16 * rg + fr, c = 16 * cb + 4 * fq;
        const f32x4 a = mini_mma<1024>(WT + (size_t)(16 * cb) * 1024, 1024, G + (size_t)(NGRID + 16 * rg) * 1024, 1024, lane);
        const f32x4 r = *(const f32x4*)(meta + (size_t)fr * D + c);
        u32x2 w; w.x = cvt_pk_bf16(r[0] * DN_ALPHA + a[0], r[1] * DN_ALPHA + a[1]); w.y = cvt_pk_bf16(r[2] * DN_ALPHA + a[2], r[3] * DN_ALPHA + a[3]); *(u32x2*)(PRE + (size_t)row * D + c) = w; }
}
__device__ __forceinline__ void mini_kv(const Ctx& C) {
    PHASE_IDS
    const bf16_t* HB = (const bf16_t*)(C.ws + WS_HB); const bf16_t* WT = (const bf16_t*)(C.ws + WS_QKV); bf16_t* Kx = (bf16_t*)(C.ws + WS_K); bf16_t* VT = (bf16_t*)(C.ws + WS_VT);
    const int fr = lane & 15, fq = lane >> 4;
    for (int wt = C.gc * NWAVES + wave; wt < 2 * 8 * 64; wt += C.G * NWAVES) { const int rg = wt & 7, cb = (wt >> 3) & 63, isv = wt >> 9;
        const bf16_t* A = HB + (size_t)(NGRID + 16 * rg) * 1024;
        if (!isv) { const f32x4 a = mini_mma<1024>(WT + (size_t)(1024 + 16 * cb) * 1024, 1024, A, 1024, lane);
            u32x2 w; w.x = cvt_pk_bf16(a[0], a[1]); w.y = cvt_pk_bf16(a[2], a[3]); *(u32x2*)(Kx + (size_t)(NGRID + 16 * rg + fr) * D + 16 * cb + 4 * fq) = w; }
        else { const f32x4 a = mini_mma<1024>(A, 1024, WT + (size_t)(2048 + 16 * cb) * 1024, 1024, lane);
            u32x2 w; w.x = cvt_pk_bf16(a[0], a[1]); w.y = cvt_pk_bf16(a[2], a[3]); *(u32x2*)(VT + (size_t)(16 * cb + fr) * MPAD + NGRID + 16 * rg + 4 * fq) = w; } }
}

constexpr int RWT_PITCH = 516;
__device__ __forceinline__ void phase_lnr(const Ctx& C, int layer, int nrows) {
    PHASE_IDS
    const bf16_t* PRE = (const bf16_t*)(wsl + WS_PRE); bf16_t* HB = (bf16_t*)(wsl + WS_HB); unsigned char* HB8 = wsl + WS_HB8;
    const float* lg = C.in[I_LNMG] + layer * D; const float* lb = C.in[I_LNMB] + layer * D;
    const float* rw = C.in[I_RW] + (size_t)layer * D * NEXP; const float* rb = C.in[I_RB] + layer * NEXP;
    int* eid = (int*)(wsl + WS_CTL + CT_EID) + (size_t)layer * NTOK * 4; float* gatev = (float*)(wsl + WS_CTL + CT_GATEV) + (size_t)layer * NTOK * 4;
    unsigned* bc = (unsigned*)(wsl + WS_CTL + CT_BC) + ((size_t)layer * 256 + C.bid) * 32;
    LAS unsigned* RWt = (LAS unsigned*)C.lds; LAS unsigned* hist = (LAS unsigned*)(C.lds + 32 * RWT_PITCH * 4);
#pragma unroll
    for (int i = 0; i < 8; ++i) { const int idx = tid + NTHREADS * i, pc = idx >> 3, e4 = (idx & 7) * 4, ch = 2 * pc;
        const f32x4 w0 = *(const f32x4*)(rw + (size_t)ch * NEXP + e4), w1 = *(const f32x4*)(rw + (size_t)(ch + 1) * NEXP + e4);
        const int slot = 4 * ((ch & 511) >> 3) + 256 * (ch >> 9) + ((ch & 7) >> 1);
        RWt[(e4 + 0) * RWT_PITCH + slot] = pk2(w0[0], w1[0]); RWt[(e4 + 1) * RWT_PITCH + slot] = pk2(w0[1], w1[1]); RWt[(e4 + 2) * RWT_PITCH + slot] = pk2(w0[2], w1[2]); RWt[(e4 + 3) * RWT_PITCH + slot] = pk2(w0[3], w1[3]); }
    if (tid < 32) hist[tid] = 0u;
    __syncthreads();
    float gg[2][8], gb[2][8];
#pragma unroll
    for (int j = 0; j < 2; ++j) { const f32x4 a0 = *(const f32x4*)(lg + 8 * lane + 512 * j), a1 = *(const f32x4*)(lg + 8 * lane + 512 * j + 4), b0 = *(const f32x4*)(lb + 8 * lane + 512 * j), b1 = *(const f32x4*)(lb + 8 * lane + 512 * j + 4);
#pragma unroll
        for (int i = 0; i < 4; ++i) { gg[j][i] = a0[i]; gg[j][4 + i] = a1[i]; gb[j][i] = b0[i]; gb[j][4 + i] = b1[i]; } }
    const float rbias = rb[lane >> 1];
    const int gw = C.bid * NWAVES + wave, NGW = C.G * NWAVES;
    u32x4 nv[2];
    if (gw < nrows) {
#pragma unroll
        for (int j = 0; j < 2; ++j) nv[j] = __builtin_nontemporal_load((const u32x4*)(PRE + (size_t)gw * D + 8 * lane + 512 * j)); }
    for (int row = gw; row < nrows; row += NGW) {
        float v[2][8]; float s = 0.f; u32x4 hp[2];
#pragma unroll
        for (int j = 0; j < 2; ++j) { unpack8(nv[j], v[j]); s += ((v[j][0] + v[j][1]) + (v[j][2] + v[j][3])) + ((v[j][4] + v[j][5]) + (v[j][6] + v[j][7])); }
        if (row + NGW < nrows) {
#pragma unroll
            for (int j = 0; j < 2; ++j) nv[j] = __builtin_nontemporal_load((const u32x4*)(PRE + (size_t)(row + NGW) * D + 8 * lane + 512 * j)); }
        const float mean = wave_sum_dpp(s) * (1.0f / D); float q = 0.f;
#pragma unroll
        for (int j = 0; j < 2; ++j)
#pragma unroll
            for (int i = 0; i < 8; ++i) { v[j][i] -= mean; q += v[j][i] * v[j][i]; }
        const float rstd = __builtin_amdgcn_rsqf(wave_sum_dpp(q) * (1.0f / D) + LN_EPS);
#pragma unroll
        for (int j = 0; j < 2; ++j) {
#pragma unroll
            for (int i = 0; i < 8; ++i) v[j][i] = v[j][i] * rstd * gg[j][i] + gb[j][i];
            u32x4 w; w.x = pk2(v[j][0], v[j][1]); w.y = pk2(v[j][2], v[j][3]); w.z = pk2(v[j][4], v[j][5]); w.w = pk2(v[j][6], v[j][7]);
            *(u32x4*)(HB + (size_t)row * D + 8 * lane + 512 * j) = w; hp[j] = w;
            u32x2 w8; w8.x = pk4_fp8(v[j][0], v[j][1], v[j][2], v[j][3]); w8.y = pk4_fp8(v[j][4], v[j][5], v[j][6], v[j][7]);
            *(u32x2*)(HB8 + (size_t)row * D + 8 * lane + 512 * j) = w8; }
        float pl[32];
#pragma unroll
        for (int e0 = 0; e0 < 32; e0 += 8) {
            u32x4 wv[8][2];
#pragma unroll
            for (int ee = 0; ee < 8; ++ee)
#pragma unroll
                for (int j = 0; j < 2; ++j) wv[ee][j] = *(const LAS u32x4*)(RWt + (e0 + ee) * RWT_PITCH + 4 * lane + 256 * j);
            __builtin_amdgcn_sched_barrier(0);
#pragma unroll
            for (int ee = 0; ee < 8; ++ee) { float a = 0.f;
#pragma unroll
                for (int j = 0; j < 2; ++j) { a = dot2_bf16(hp[j].x, wv[ee][j].x, a);
                    a = dot2_bf16(hp[j].y, wv[ee][j].y, a);
                    a = dot2_bf16(hp[j].z, wv[ee][j].z, a);
                    a = dot2_bf16(hp[j].w, wv[ee][j].w, a); }
                pl[e0 + ee] = a; }
        }
        float q16[16], q8[8], q4[4], q2[2], q1;
        { const bool hi = (lane & 32) != 0;
#pragma unroll
          for (int e = 0; e < 16; ++e) { const float mine = hi ? pl[16 + e] : pl[e], other = hi ? pl[e] : pl[16 + e]; q16[e] = mine + __shfl_xor(other, 32); } }
        { const bool hi = (lane & 16) != 0;
#pragma unroll
          for (int e = 0; e < 8; ++e) { const float mine = hi ? q16[8 + e] : q16[e], other = hi ? q16[e] : q16[8 + e]; q8[e] = mine + __shfl_xor(other, 16); } }
        { const bool hi = (lane & 8) != 0;
#pragma unroll
          for (int e = 0; e < 4; ++e) { const float mine = hi ? q8[4 + e] : q8[e], other = hi ? q8[e] : q8[4 + e]; q4[e] = mine + dpp_movf<0x128>(other); } }
        { const bool hi = (lane & 4) != 0;
#pragma unroll
          for (int e = 0; e < 2; ++e) { const float mine = hi ? q4[2 + e] : q4[e], other = hi ? q4[e] : q4[2 + e]; q2[e] = mine + __shfl_xor(other, 4); } }
        { const bool hi = (lane & 2) != 0; const float mine = hi ? q2[1] : q2[0], other = hi ? q2[0] : q2[1]; q1 = mine + dpp_movf<0x4E>(other); }
        q1 += dpp_movf<0xB1>(q1);
        float lv = q1 + rbias; lv = (lv == lv) ? lv : -3.0e38f;
        const int le = lane >> 1;
        int rank = 0;
#pragma unroll
        for (int j = 0; j < 32; ++j) { const float lj = readlane_f(lv, 2 * j); rank += (lj > lv || (lj == lv && j < le)) ? 1 : 0; }
        const unsigned long long m0 = __ballot(rank == 0);
        const float mxl = readlane_f(lv, (int)__builtin_ctzll(m0));
        const float pe = rank < 4 ? __expf(lv - mxl) : 0.f;
        const float den = wave_sum_dpp(pe) * 0.5f;
        if (rank < 4 && (lane & 1) == 0) { eid[(size_t)row * 4 + rank] = le; gatev[(size_t)row * 4 + rank] = pe / den;
            __hip_atomic_fetch_add(&hist[le], 1u, __ATOMIC_RELAXED, __HIP_MEMORY_SCOPE_WORKGROUP); }
    }
    __syncthreads();
    if (tid < 32) bc[tid] = hist[tid];
}

__device__ __forceinline__ void phase_pos(const Ctx& C, int layer, int nrows) {
    PHASE_IDS
    const unsigned* bcAll = (const unsigned*)(wsl + WS_CTL + CT_BC) + (size_t)layer * 256 * 32;
    const int* eid = (const int*)(wsl + WS_CTL + CT_EID) + (size_t)layer * NTOK * 4; int* posv = (int*)(wsl + WS_CTL + CT_POS) + (size_t)layer * NTOK * 4;
    int* texp = (int*)(wsl + WS_CTL + CT_TEXP) + layer * 1024;
    int* tokoff = (int*)(wsl + WS_TOK) + (size_t)layer * (1 * MiB / 4);
    LAS unsigned* partT = (LAS unsigned*)C.lds; LAS unsigned* partP = partT + 512; LAS unsigned* tot = partP + 512; LAS unsigned* cnt = tot + 32;
    { const int e = tid & 31, part = tid >> 5; unsigned t = 0, pr = 0;
      unsigned vv[16];
#pragma unroll
      for (int i = 0; i < 16; ++i) { const int bq = part + 16 * i; vv[i] = bq < C.G ? bcAll[(size_t)bq * 32 + e] : 0u; }
#pragma unroll
      for (int i = 0; i < 16; ++i) { const int bq = part + 16 * i; t += vv[i]; if (bq < C.bid) pr += vv[i]; }
      partT[part * 32 + e] = t; partP[part * 32 + e] = pr; }
    __syncthreads();
    if (tid < 32) { unsigned t = 0, pr = 0; for (int i = 0; i < 16; ++i) { t += partT[i * 32 + tid]; pr += partP[i * 32 + tid]; } tot[tid] = t; cnt[tid] = pr; }
    __syncthreads();
    if (tid < 32) { unsigned off = 0; for (int e = 0; e < tid; ++e) off += (tot[e] + 255u) & ~255u;
        const unsigned mine = (tot[tid] + 255u) & ~255u;
        if (C.bid == 0) { for (unsigned t = off >> 8; t < ((off + mine) >> 8); ++t) texp[t] = tid; if (tid == 31) texp[1023] = (int)((off + mine) >> 8);
            for (unsigned p = off + tot[tid]; p < off + mine; ++p) tokoff[p] = 0; }
        cnt[tid] += off; }
    __syncthreads();
    const int gw = C.bid * NWAVES + wave, NGW = C.G * NWAVES;
    for (int row = gw; row < nrows; row += NGW) {
        int pos = 0;
        if (lane < 4) { const int e = eid[(size_t)row * 4 + lane]; pos = (int)__hip_atomic_fetch_add(&cnt[e], 1u, __ATOMIC_RELAXED, __HIP_MEMORY_SCOPE_WORKGROUP); posv[(size_t)row * 4 + lane] = pos; }
        if (lane < 4) tokoff[pos] = row * 1024;
    }
}

__device__ __forceinline__ void phase_combine(const Ctx& C, int layer, int nrows, bool final_out) {
    PHASE_IDS
    bf16_t* HB = (bf16_t*)(wsl + WS_HB); unsigned char* HB8 = wsl + WS_HB8; const unsigned char* YS = wsl + WS_YS;
    const float* lg = C.in[I_LNFG] + layer * D; const float* lb = C.in[I_LNFB] + layer * D;
    const float* gatev = (const float*)(wsl + WS_CTL + CT_GATEV) + (size_t)layer * NTOK * 4; const int* posv = (const int*)(wsl + WS_CTL + CT_POS) + (size_t)layer * NTOK * 4;
    float gg[2][8], gb[2][8];
#pragma unroll
    for (int j = 0; j < 2; ++j) { const f32x4 a0 = *(const f32x4*)(lg + 8 * lane + 512 * j), a1 = *(const f32x4*)(lg + 8 * lane + 512 * j + 4), b0 = *(const f32x4*)(lb + 8 * lane + 512 * j), b1 = *(const f32x4*)(lb + 8 * lane + 512 * j + 4);
#pragma unroll
        for (int i = 0; i < 4; ++i) { gg[j][i] = a0[i]; gg[j][4 + i] = a1[i]; gb[j][i] = b0[i]; gb[j][4 + i] = b1[i]; } }
    const int gw = C.bid * NWAVES + wave, NGW = C.G * NWAVES;
    f32x4 g1 = {0.f, 0.f, 0.f, 0.f}, g2 = g1; int p1[4] = {0, 0, 0, 0}, p2[4] = {0, 0, 0, 0};
    u32x4 hwn[2]; u32x2 ywn[4][2];
#define CB_ROUTE(row_, gq, pq) do { gq = *(const f32x4*)(gatev + (size_t)(row_) * 4); const u32x4 _pp = *(const u32x4*)(posv + (size_t)(row_) * 4); pq[0] = (int)_pp.x; pq[1] = (int)_pp.y; pq[2] = (int)_pp.z; pq[3] = (int)_pp.w; } while (0)
#define CB_DATA(row_, pq) do { _Pragma("unroll") for (int j = 0; j < 2; ++j) { hwn[j] = *(const u32x4*)(HB + (size_t)(row_) * D + 8 * lane + 512 * j); \
            _Pragma("unroll") for (int k = 0; k < 4; ++k) ywn[k][j] = __builtin_nontemporal_load((const u32x2*)(YS + (size_t)pq[k] * D + 8 * lane + 512 * j)); } } while (0)
    if (gw < nrows) { CB_ROUTE(gw, g1, p1); CB_DATA(gw, p1); }
    if (gw + NGW < nrows) CB_ROUTE(gw + NGW, g2, p2);
    for (int row = gw; row < nrows; row += NGW) {
        const f32x4 gk4 = g1 * 0.125f; u32x4 hw[2]; u32x2 yw[4][2];
#pragma unroll
        for (int j = 0; j < 2; ++j) { hw[j] = hwn[j];
#pragma unroll
            for (int k = 0; k < 4; ++k) yw[k][j] = ywn[k][j]; }
        g1 = g2;
#pragma unroll
        for (int k = 0; k < 4; ++k) p1[k] = p2[k];
        if (row + NGW < nrows) CB_DATA(row + NGW, p1);
        if (row + 2 * NGW < nrows) CB_ROUTE(row + 2 * NGW, g2, p2);
        float v[2][8]; float s = 0.f;
#pragma unroll
        for (int j = 0; j < 2; ++j) { float h[8]; unpack8(hw[j], h);
#pragma unroll
            for (int i = 0; i < 8; ++i) v[j][i] = h[i] * DN_ALPHA;
#pragma unroll
            for (int k = 0; k < 4; ++k) { float y[8]; unpack8_fp8(yw[k][j], y);
#pragma unroll
                for (int i = 0; i < 8; ++i) v[j][i] += gk4[k] * y[i]; }
#pragma unroll
            for (int i = 0; i < 8; ++i) s += v[j][i]; }
        const float mean = wave_sum_dpp(s) * (1.0f / D); float q = 0.f;
#pragma unroll
        for (int j = 0; j < 2; ++j)
#pragma unroll
            for (int i = 0; i < 8; ++i) { v[j][i] -= mean; q += v[j][i] * v[j][i]; }
        const float rstd = __builtin_amdgcn_rsqf(wave_sum_dpp(q) * (1.0f / D) + LN_EPS);
#pragma unroll
        for (int j = 0; j < 2; ++j) {
#pragma unroll
            for (int i = 0; i < 8; ++i) v[j][i] = v[j][i] * rstd * gg[j][i] + gb[j][i];
            if (final_out) { *(f32x4*)(C.out + (size_t)row * D + 8 * lane + 512 * j) = (f32x4){v[j][0], v[j][1], v[j][2], v[j][3]}; *(f32x4*)(C.out + (size_t)row * D + 8 * lane + 512 * j + 4) = (f32x4){v[j][4], v[j][5], v[j][6], v[j][7]}; }
            else { u32x4 w; w.x = pk2(v[j][0], v[j][1]); w.y = pk2(v[j][2], v[j][3]); w.z = pk2(v[j][4], v[j][5]); w.w = pk2(v[j][6], v[j][7]); *(u32x4*)(HB + (size_t)row * D + 8 * lane + 512 * j) = w;
                u32x2 w8; w8.x = pk4_fp8(v[j][0], v[j][1], v[j][2], v[j][3]); w8.y = pk4_fp8(v[j][4], v[j][5], v[j][6], v[j][7]); *(u32x2*)(HB8 + (size_t)row * D + 8 * lane + 512 * j) = w8; } }
    }
#undef CB_ROUTE
#undef CB_DATA
}

constexpr int AT_KS = 0, AT_VTS = 73728, AT_VPITCH = 1168, AT_KM = AT_VTS + 64 * AT_VPITCH, AT_VTM = AT_KM + 2048, AT_RPB = AT_VTM + 2048, AT_MB = AT_RPB + 1920, AT_END = AT_MB + 64;
static_assert(AT_END <= LDS_BYTES, "attention LDS map");
__device__ __forceinline__ void phase_attn(const Ctx& C) {
    PHASE_IDS
    bf16_t* O = (bf16_t*)(wsl + WS_O);
    const float* rpb = C.in[I_RPB]; const float* mbias = C.in[I_MBIAS];
    LAS unsigned char* lds = C.lds;
    const int w = wave, lq = lane & 15, g = lane >> 4;
    const int qr = w >> 2, qg = w & 3, c0 = 16 * qg, kcb = qg == 0 ? 0 : (qg == 1 ? 8 : (qg == 2 ? 24 : 32));
    int bidx[2][4];
    { const int c_ = c0 + lq, cs_ = min(max(c_ - 8, 0), 48);
#pragma unroll
      for (int blk = 0; blk < 2; ++blk)
#pragma unroll
          for (int e = 0; e < 4; ++e) { const int kc = kcb + 16 * blk + 4 * g + e; bidx[blk][e] = ((kc >= cs_ && kc < cs_ + 16) ? (kc - c_ + 15) : 31) * 4; } }
    const __amdgpu_buffer_rsrc_t rsrc = __builtin_amdgcn_make_buffer_rsrc((void*)wsl, 0, 0xFFFFFFFF, 0x00020000);
    const int kvoff = (((tid >> 3) & 63) * D + 8 * (tid & 7)) * 2, vvoff = ((tid >> 3) * MPAD + 8 * (tid & 7)) * 2;
    const int qvoff = (lq * D + 8 * g) * 2;
    const int mvoff = tid < 128 ? ((tid >> 3) * D + 8 * (tid & 7)) * 2 : (((tid - 128) >> 1) * MPAD + 8 * ((tid - 128) & 1)) * 2;
    const int klds = AT_KS + ((((tid >> 3) & 63)) * 8 + ((tid & 7) ^ ((tid >> 3) & 7))) * 16;
    const int vlds = AT_VTS + (tid >> 3) * AT_VPITCH + (tid & 7) * 16;
    for (int su = (C.G == 256 ? C.gc : C.bid); su < 256; su += C.G) {
        int bh, strip; if (C.G == 256) { bh = (su & 7) * 16 + (su >> 4); strip = (su >> 3) & 1; } else { bh = su >> 1; strip = su & 1; }
        const int b = bh >> 4, h = bh & 15, rp0 = strip * 16;
        const unsigned kbase = (unsigned)WS_K + (unsigned)((b * SEQ) * D + 64 * h) * 2u, vbase = (unsigned)WS_VT + (unsigned)((64 * h) * MPAD + b * SEQ) * 2u;
        const unsigned qbase = (unsigned)WS_Q + (unsigned)((b * SEQ + qr * 64 + c0) * D + 64 * h) * 2u;
        int R0 = min(max(2 * rp0 - 4, 0), 55);
        __syncthreads();
        {
            u32x4 kreg[9], vreg[9];
#pragma unroll
            for (int i = 0; i < 9; ++i) { kreg[i] = __builtin_amdgcn_raw_buffer_load_b128(rsrc, kvoff, (int)(kbase + (unsigned)(R0 + i) * 64u * D * 2u), 0);
                vreg[i] = __builtin_amdgcn_raw_buffer_load_b128(rsrc, vvoff, (int)(vbase + (unsigned)(R0 + i) * 128u), 0); }
            u32x4 mreg = {0u, 0u, 0u, 0u};
            if (tid < 256) mreg = __builtin_amdgcn_raw_buffer_load_b128(rsrc, mvoff, (int)(tid < 128 ? (unsigned)WS_K + (unsigned)((NGRID + 16 * b) * D + 64 * h) * 2u : (unsigned)WS_VT + (unsigned)((64 * h) * MPAD + NGRID + 16 * b) * 2u), 0);
            float rpreg = 0.f, mbreg = 0.f;
            if (tid < 480) rpreg = (tid & 31) < 31 ? rpb[h * 465 + (tid >> 5) * 31 + (tid & 31)] * 1.44269504089f : -1.0e30f;
            if (tid < 16) mbreg = mbias[h * 16 + tid] * 1.44269504089f;
#pragma unroll
            for (int i = 0; i < 9; ++i) { const int slot = (R0 + i) % 9; *(LAS u32x4*)(lds + klds + slot * 8192) = kreg[i]; *(LAS u32x4*)(lds + vlds + slot * 128) = vreg[i]; }
            if (tid < 128) { const int m = tid >> 3, ch = tid & 7; *(LAS u32x4*)(lds + AT_KM + (m * 8 + (ch ^ (m & 7))) * 16) = mreg; }
            else if (tid < 256) { const int i = tid - 128, d = i >> 1, hf = i & 1; *(LAS u32x4*)(lds + AT_VTM + d * 32 + hf * 16) = mreg; }
            if (tid < 480) ((LAS float*)(lds + AT_RPB))[tid] = rpreg;
            if (tid < 16) ((LAS float*)(lds + AT_MB))[tid] = mbreg;
        }
        u32x4 qreg[2];
        qreg[0] = __builtin_amdgcn_raw_buffer_load_b128(rsrc, qvoff, (int)(qbase + (unsigned)(2 * rp0) * 64u * D * 2u), 0);
        qreg[1] = __builtin_amdgcn_raw_buffer_load_b128(rsrc, qvoff, (int)(qbase + (unsigned)(2 * rp0) * 64u * D * 2u + 64u), 0);
        __syncthreads();
        for (int rp = rp0; rp < rp0 + 16; ++rp) {
            const int R0n = rp + 1 < rp0 + 16 ? min(max(2 * (rp + 1) - 4, 0), 55) : R0, nnew = R0n - R0;
            const u32x4 qcur[2] = {qreg[0], qreg[1]};
            u32x4 nk[2], nv[2];
#pragma unroll
            for (int i = 0; i < 2; ++i) if (i < nnew) { nk[i] = __builtin_amdgcn_raw_buffer_load_b128(rsrc, kvoff, (int)(kbase + (unsigned)(R0 + 9 + i) * 64u * D * 2u), 0);
                nv[i] = __builtin_amdgcn_raw_buffer_load_b128(rsrc, vvoff, (int)(vbase + (unsigned)(R0 + 9 + i) * 128u), 0); }
            if (rp + 1 < rp0 + 16) { qreg[0] = __builtin_amdgcn_raw_buffer_load_b128(rsrc, qvoff, (int)(qbase + (unsigned)(2 * rp + 2) * 64u * D * 2u), 0);
                qreg[1] = __builtin_amdgcn_raw_buffer_load_b128(rsrc, qvoff, (int)(qbase + (unsigned)(2 * rp + 2) * 64u * D * 2u + 64u), 0); }
            const int r = 2 * rp + qr;
            const int rs = min(max(r - 4, 0), 56), s0 = rs % 9;
            const size_t qrow = (size_t)(b * SEQ + r * 64 + c0 + lq);
            bf16x8 qf[2]; qf[0] = __builtin_bit_cast(bf16x8, qcur[0]); qf[1] = __builtin_bit_cast(bf16x8, qcur[1]);
            f32x4 sc[8][2], sm;
#pragma unroll
            for (int j = 0; j < 8; ++j) { const int slot = s0 + j - (s0 + j >= 9 ? 9 : 0);
#pragma unroll
                for (int blk = 0; blk < 2; ++blk) { f32x4 a = {0.f, 0.f, 0.f, 0.f}; const int kc = kcb + 16 * blk + lq;
#pragma unroll
                    for (int ks = 0; ks < 2; ++ks) { const bf16x8 kf = *(const LAS bf16x8*)(lds + AT_KS + slot * 8192 + (kc * 8 + ((4 * ks + g) ^ (kc & 7))) * 16);
                        a = __builtin_amdgcn_mfma_f32_16x16x32_bf16(kf, qf[ks], a, 0, 0, 0); }
                    sc[j][blk] = a; } }
            { f32x4 a = {0.f, 0.f, 0.f, 0.f};
#pragma unroll
              for (int ks = 0; ks < 2; ++ks) { const bf16x8 kf = *(const LAS bf16x8*)(lds + AT_KM + (lq * 8 + ((4 * ks + g) ^ (lq & 7))) * 16);
                  a = __builtin_amdgcn_mfma_f32_16x16x32_bf16(kf, qf[ks], a, 0, 0, 0); }
              sm = a; }
            const LAS unsigned char* RProw = lds + AT_RPB + (rs - r + 7) * 128; const LAS float* MB = (const LAS float*)(lds + AT_MB);
            float mx = -3.0e38f;
#pragma unroll
            for (int j = 0; j < 8; ++j)
#pragma unroll
                for (int blk = 0; blk < 2; ++blk)
#pragma unroll
                    for (int e = 0; e < 4; ++e) { const float sv = sc[j][blk][e] + *(const LAS float*)(RProw + j * 128 + bidx[blk][e]); sc[j][blk][e] = sv; mx = fmaxf(mx, sv); }
#pragma unroll
            for (int e = 0; e < 4; ++e) { sm[e] += MB[4 * g + e]; mx = fmaxf(mx, sm[e]); }
            mx = fmaxf(mx, __shfl_xor(mx, 16)); mx = fmaxf(mx, __shfl_xor(mx, 32));
            float sum = 0.f;
#pragma unroll
            for (int j = 0; j < 8; ++j)
#pragma unroll
                for (int blk = 0; blk < 2; ++blk)
#pragma unroll
                    for (int e = 0; e < 4; ++e) { const float pv = fast_exp2(sc[j][blk][e] - mx); sc[j][blk][e] = pv; sum += pv; }
#pragma unroll
            for (int e = 0; e < 4; ++e) { const float pv = fast_exp2(sm[e] - mx); sm[e] = pv; sum += pv; }
            sum += __shfl_xor(sum, 16); sum += __shfl_xor(sum, 32);
            f32x4 o[4];
#pragma unroll
            for (int db = 0; db < 4; ++db) o[db] = (f32x4){0.f, 0.f, 0.f, 0.f};
#pragma unroll
            for (int j = 0; j < 8; ++j) { const int slot = s0 + j - (s0 + j >= 9 ? 9 : 0);
                u32x4 pw; pw.x = cvt_pk_bf16(sc[j][0][0], sc[j][0][1]); pw.y = cvt_pk_bf16(sc[j][0][2], sc[j][0][3]); pw.z = cvt_pk_bf16(sc[j][1][0], sc[j][1][1]); pw.w = cvt_pk_bf16(sc[j][1][2], sc[j][1][3]);
                const bf16x8 pb = __builtin_bit_cast(bf16x8, pw);
#pragma unroll
                for (int db = 0; db < 4; ++db) { const int d = 16 * db + lq; const LAS unsigned char* vp = lds + AT_VTS + d * AT_VPITCH + (slot * 64 + kcb + 4 * g) * 2;
                    const u32x2 lo = *(const LAS u32x2*)vp, hi = *(const LAS u32x2*)(vp + 32);
                    u32x4 aw; aw.x = lo.x; aw.y = lo.y; aw.z = hi.x; aw.w = hi.y;
                    o[db] = __builtin_amdgcn_mfma_f32_16x16x32_bf16(__builtin_bit_cast(bf16x8, aw), pb, o[db], 0, 0, 0); }
            }
            { u32x4 pw; pw.x = cvt_pk_bf16(sm[0], sm[1]); pw.y = cvt_pk_bf16(sm[2], sm[3]); pw.z = 0u; pw.w = 0u; const bf16x8 pb = __builtin_bit_cast(bf16x8, pw);
#pragma unroll
              for (int db = 0; db < 4; ++db) { const int d = 16 * db + lq; const u32x2 lo = *(const LAS u32x2*)(lds + AT_VTM + d * 32 + 8 * g);
                  u32x4 aw; aw.x = lo.x; aw.y = lo.y; aw.z = 0u; aw.w = 0u;
                  o[db] = __builtin_amdgcn_mfma_f32_16x16x32_bf16(__builtin_bit_cast(bf16x8, aw), pb, o[db], 0, 0, 0); } }
            const float inv = 1.0f / sum;
#pragma unroll
            for (int db = 0; db < 4; ++db) { u32x2 ow; ow.x = cvt_pk_bf16(o[db][0] * inv, o[db][1] * inv); ow.y = cvt_pk_bf16(o[db][2] * inv, o[db][3] * inv);
                *(u32x2*)(O + qrow * D + 64 * h + 16 * db + 4 * g) = ow; }
            __syncthreads();
#pragma unroll
            for (int i = 0; i < 2; ++i) if (i < nnew) { const int slot = (R0 + 9 + i) % 9; *(LAS u32x4*)(lds + klds + slot * 8192) = nk[i]; *(LAS u32x4*)(lds + vlds + slot * 128) = nv[i]; }
            R0 = R0n;
            __syncthreads();
        }
    }
}
#define XB_TMO      128
#define XB_XCNT(j)  (256  + 64 * (j))
#define XB_XSUB(j)  (1280 + 64 * (j))
#define XB_XGEN(j)  (2304 + 64 * (j))
#define XB_TOP      3328
#define XB_TOPGEN   3392
#define XCD_BAR_WORDS 3456
#define XB_SPIN_CAP (1u << 22)
__device__ __forceinline__ unsigned xb_ld(unsigned* p)              { return __hip_atomic_load(p, __ATOMIC_RELAXED, __HIP_MEMORY_SCOPE_AGENT); }
__device__ __forceinline__ unsigned xb_add(unsigned* p, unsigned v) { return __hip_atomic_fetch_add(p, v, __ATOMIC_RELAXED, __HIP_MEMORY_SCOPE_AGENT); }
__device__ __forceinline__ unsigned xb_xcc_id() { return (unsigned)__builtin_amdgcn_s_getreg((3 << 11) | 20) & 0xFu; }
#define XB_SPIN(cond, bar) do { unsigned _sp = 0; while (cond) { __builtin_amdgcn_s_sleep(1); \
    if ((++_sp & 255u) == 0u) { if (xb_ld(&(bar)[XB_TMO])) break; if (_sp > XB_SPIN_CAP) { atomicAdd(&(bar)[XB_TMO], 1u); break; } } } } while (0)
struct XcdBarrier { unsigned* bar; unsigned x; volatile LAS unsigned* st; };
__device__ __forceinline__ XcdBarrier xcd_barrier_post(unsigned* bar, volatile LAS unsigned* st) {
    XcdBarrier b; b.bar = bar; b.x = xb_xcc_id(); b.st = st;
    if (threadIdx.x == 0) st[2] = xb_add(&bar[XB_XCNT(b.x)], 1u);
    return b;
}
__device__ __forceinline__ void xcd_barrier_complete(unsigned* bar, unsigned x, unsigned& nloc, unsigned& nx) {
    const unsigned G = gridDim.x * gridDim.y * gridDim.z;
    unsigned sum, cnt, mine, sp = 0u;
    for (;;) {
        sum = 0u; cnt = 0u; mine = 0u;
#pragma unroll
        for (unsigned j = 0; j < 16; ++j) { const unsigned c = xb_ld(&bar[XB_XCNT(j)]); sum += c; cnt += (c > 0u) ? 1u : 0u; mine = (j == x) ? c : mine; }
        if (sum == G) break;
        __builtin_amdgcn_s_sleep(1);
        if ((++sp & 255u) == 0u) { if (xb_ld(&bar[XB_TMO])) break; if (sp > XB_SPIN_CAP) { atomicAdd(&bar[XB_TMO], 1u); break; } }
    }
    nloc = mine > 0u ? mine : 1u; nx = cnt > 0u ? cnt : 1u;
}
__device__ __forceinline__ void xcd_barrier(const XcdBarrier& b) {
    asm volatile("s_waitcnt vmcnt(0)" ::: "memory");
    __syncthreads();
    if (threadIdx.x == 0) {
        unsigned* bar = b.bar;
        __builtin_amdgcn_s_waitcnt(0);
        unsigned nloc = b.st[0], nx = b.st[1];
        if (nloc == 0u) { xcd_barrier_complete(bar, b.x, nloc, nx); b.st[0] = nloc; b.st[1] = nx; }
        const unsigned old = xb_add(&bar[XB_XSUB(b.x)], 1u);
        const unsigned gen = old / nloc;
        if (old + 1u == (gen + 1u) * nloc) {
            __builtin_amdgcn_fence(__ATOMIC_RELEASE, "agent");
            asm volatile("s_waitcnt vmcnt(0)" ::: "memory");
            const unsigned og = xb_add(&bar[XB_TOP], 1u);
            const unsigned tg = og / nx;
            if (og + 1u == (tg + 1u) * nx) xb_add(&bar[XB_TOPGEN], 1u);
            else XB_SPIN(xb_ld(&bar[XB_TOPGEN]) == tg, bar);
            __builtin_amdgcn_fence(__ATOMIC_ACQUIRE, "agent");
            xb_add(&bar[XB_XGEN(b.x)], 1u);
            asm volatile("s_waitcnt vmcnt(0)" ::: "memory");
        } else {
            XB_SPIN(xb_ld(&bar[XB_XGEN(b.x)]) == gen, bar);
            __builtin_amdgcn_fence(__ATOMIC_ACQUIRE, "agent");
            asm volatile("s_waitcnt vmcnt(0)" ::: "memory");
        }
    }
    __syncthreads();
}
__device__ __forceinline__ int moe_prep(const Ctx& C, const int* texp) {
    LAS int* t = (LAS int*)(C.lds + pg8::TEXP_OFF); const int tid = fresh_tid();
    const int a = texp[tid], b = texp[tid + 512];
    t[tid] = a; t[tid + 512] = b;
    __syncthreads();
    return __builtin_amdgcn_readfirstlane(t[1023]);
}
constexpr size_t CT_BAR = 131072;
constexpr int LDS_BARST = LDS_BYTES - 64;

constexpr int N_PHASES = 20;
__global__ void __launch_bounds__(NTHREADS, 2) hybrid_fwd(Params P) {
    extern __shared__ __attribute__((aligned(16))) unsigned char smem[];
    cg::grid_group grid = cg::this_grid();
    Ctx C; C.lds = (LAS unsigned char*)smem; C.G = gridDim.x; C.bid = blockIdx.x;
    C.ws = P.ws; C.in = P.in; C.out = P.out;
    unsigned char* const ws0 = P.ws;
#define ws fresh_ws(ws0)
    const int lo = P.ph_lo, hi = P.ph_hi;
#ifndef PH_MASK
#define PH_MASK 0xFFFFFFFFu
#endif
#define IN(k) (((PH_MASK >> (k)) & 1u) && lo <= (k) && (k) < hi)
#ifndef REPEAT_MASK
#define REPEAT_MASK 0u
#endif
#define REPS(k) ((((unsigned)REPEAT_MASK >> (k)) & 1u) ? 2 : 1)
#ifndef N_CG_SYNCS
#define N_CG_SYNCS 0
#endif
#define SEAM(k) do { if (IN(k) && IN((k) + 1)) { if ((k) < N_CG_SYNCS) grid.sync(); else xcd_barrier(bar); } } while (0)
    if (threadIdx.x < 16) ((LAS unsigned*)(smem + LDS_BARST))[threadIdx.x] = 0u;
    __syncthreads();
    const XcdBarrier bar = xcd_barrier_post((unsigned*)(ws + WS_CTL + CT_BAR), (volatile LAS unsigned*)(smem + LDS_BARST));
    C.gc = C.bid;
    #define PH_BODY_0 phase_convert(C);
    if (IN(0)) { PH_BODY_0 } if (REPS(0) > 1 && IN(0)) { xcd_barrier(bar); PH_BODY_0 }
    SEAM(0);
    if (IN(0) && IN(1)) {
        unsigned* barw = (unsigned*)(ws + WS_CTL + CT_BAR); bool eq = (C.G % 8) == 0;
#pragma unroll
        for (int j = 0; j < 16; ++j) { const unsigned cj = xb_ld(&barw[XB_XCNT(j)]); eq = eq && (cj == (j < 8 ? (unsigned)(C.G / 8) : 0u)); }
        const unsigned rank = ((volatile LAS unsigned*)(smem + LDS_BARST))[2];
        C.gc = __builtin_amdgcn_readfirstlane(eq ? (int)(rank * 8u + bar.x) : C.bid);
    }
    #define PH_BODY_1 { DenseSched S{(unsigned)WS_HB, (unsigned)WS_WIN, 1024, 1024, 128, 8, C.G, C.gc}; EpiWin E{(bf16_t*)(ws + WS_XR), (bf16_t*)(ws + WS_GY)}; \
        pg8::gemm_phase<false, false>(C.lds, ws, 1024, 1024, 1024, S, E); mini_win(C); }
    if (IN(1)) { PH_BODY_1 } if (REPS(1) > 1 && IN(1)) { xcd_barrier(bar); PH_BODY_1 }
    SEAM(1);
    #define PH_BODY_2 phase_conv(C);
    if (IN(2)) { PH_BODY_2 } if (REPS(2) > 1 && IN(2)) { xcd_barrier(bar); PH_BODY_2 }
    SEAM(2);
    #define PH_BODY_3 { GateSched S{(unsigned)WS_XC, (unsigned)WS_GATE, 128, C.G, C.gc}; \
        EpiGate E{(const bf16_t*)(ws + WS_XC), (unsigned char*)(ws + WS_LA), (const float*)(ws + WS_CTL + CT_SPL), (unsigned)WS_GBIAS}; \
        pg8::gemm_phase<false, false>(C.lds, ws, 256, 1024, 256, S, E); mini_gate(C); }
    if (IN(3)) { PH_BODY_3 } if (REPS(3) > 1 && IN(3)) { xcd_barrier(bar); PH_BODY_3 }
    SEAM(3);
    #define PH_BODY_4 phase_scan(C);
    if (IN(4)) { PH_BODY_4 } if (REPS(4) > 1 && IN(4)) { xcd_barrier(bar); PH_BODY_4 }
    SEAM(4);
    #define PH_BODY_5 { DenseSched S{(unsigned)WS_G, (unsigned)WS_LOUT, 1024, 1024, 128, 4, C.G, C.gc}; EpiRes<true> E{(bf16_t*)(ws + WS_PRE), P.in[I_X], P.in[I_META], nullptr, NTOK}; \
        pg8::gemm_phase<false, false>(C.lds, ws, 1024, 1024, 1024, S, E); mini_lout(C); }
    if (IN(5)) { PH_BODY_5 } if (REPS(5) > 1 && IN(5)) { xcd_barrier(bar); PH_BODY_5 }
    SEAM(5);
    #define PH_BODY_6 phase_lnr(C, 0, NTOK);
    if (IN(6)) { PH_BODY_6 } if (REPS(6) > 1 && IN(6)) { xcd_barrier(bar); PH_BODY_6 }
    SEAM(6);
    #define PH_BODY_7 phase_pos(C, 0, NTOK);
    if (IN(7)) { PH_BODY_7 } if (REPS(7) > 1 && IN(7)) { xcd_barrier(bar); PH_BODY_7 }
    SEAM(7);
    #define PH_BODY_8 { const int nM = moe_prep(C, (const int*)(ws + WS_CTL + CT_TEXP)); \
        MoeSched S{(unsigned)WS_HB8, (unsigned)WS_WGU, (unsigned)WS_TOK, (const LAS int*)(C.lds + pg8::TEXP_OFF), 2048u * 1024u, nM, 8, C.G, C.gc}; EpiGlu E{(unsigned char*)(ws + WS_ACT), (unsigned)WS_BIAS}; \
        pg8::gemm_phase<true, true>(C.lds, ws, 512, 512, 512, S, E); }
    if (IN(8)) { PH_BODY_8 } if (REPS(8) > 1 && IN(8)) { xcd_barrier(bar); PH_BODY_8 }
#ifdef PROBE_NULL8
    if (IN(8)) { xcd_barrier(bar); { const int nM = moe_prep(C, (const int*)(ws + WS_CTL + CT_TEXP));
        MoeSched S{(unsigned)WS_HB8, (unsigned)WS_WGU, (unsigned)WS_TOK, (const LAS int*)(C.lds + pg8::TEXP_OFF), 2048u * 1024u, nM, 8, C.G, C.gc}; EpiNull E{};
        pg8::gemm_phase<true, true>(C.lds, ws, 512, 512, 512, S, E); } }
#endif
    SEAM(8);
    #define PH_BODY_9 { const int nM = moe_prep(C, (const int*)(ws + WS_CTL + CT_TEXP)); \
        MoeSched S{(unsigned)WS_ACT, (unsigned)WS_WD, 0u, (const LAS int*)(C.lds + pg8::TEXP_OFF), 1024u * 1024u, nM, 4, C.G, C.gc}; EpiDown E{(unsigned char*)(ws + WS_YS), (unsigned)WS_BD}; \
        pg8::gemm_phase<true, false>(C.lds, ws, 512, 512, 512, S, E); }
    if (IN(9)) { PH_BODY_9 } if (REPS(9) > 1 && IN(9)) { xcd_barrier(bar); PH_BODY_9 }
    SEAM(9);
    #define PH_BODY_10 phase_combine(C, 0, NTOK, false);
    if (IN(10)) { PH_BODY_10 } if (REPS(10) > 1 && IN(10)) { xcd_barrier(bar); PH_BODY_10 }
    SEAM(10);
    #define PH_BODY_11 { QkvSched S{(unsigned)WS_HB8, (unsigned)WS_QKV8, 128, C.G, C.gc}; EpiQkv E{(bf16_t*)(ws + WS_Q), (bf16_t*)(ws + WS_K), (bf16_t*)(ws + WS_VT)}; \
        pg8::gemm_phase<true, false>(C.lds, ws, 512, 512, 512, S, E); mini_kv(C); }
    if (IN(11)) { PH_BODY_11 } if (REPS(11) > 1 && IN(11)) { xcd_barrier(bar); PH_BODY_11 }
    SEAM(11);
    #define PH_BODY_12 phase_attn(C);
    if (IN(12)) { PH_BODY_12 } if (REPS(12) > 1 && IN(12)) { xcd_barrier(bar); PH_BODY_12 }
    SEAM(12);
    #define PH_BODY_13 { DenseSched S{(unsigned)WS_O, (unsigned)WS_NOUT, 1024, 1024, 128, 4, C.G, C.gc}; EpiRes<false> E{(bf16_t*)(ws + WS_PRE), nullptr, nullptr, (const bf16_t*)(ws + WS_HB), NGRID}; \
        pg8::gemm_phase<false, false>(C.lds, ws, 1024, 1024, 1024, S, E); }
    if (IN(13)) { PH_BODY_13 } if (REPS(13) > 1 && IN(13)) { xcd_barrier(bar); PH_BODY_13 }
    SEAM(13);
    #define PH_BODY_14 phase_lnr(C, 1, NGRID);
    if (IN(14)) { PH_BODY_14 } if (REPS(14) > 1 && IN(14)) { xcd_barrier(bar); PH_BODY_14 }
    SEAM(14);
    #define PH_BODY_15 phase_pos(C, 1, NGRID);
    if (IN(15)) { PH_BODY_15 } if (REPS(15) > 1 && IN(15)) { xcd_barrier(bar); PH_BODY_15 }
    SEAM(15);
    #define PH_BODY_16 { const int nM = moe_prep(C, (const int*)(ws + WS_CTL + CT_TEXP) + 1024); \
        MoeSched S{(unsigned)WS_HB8, (unsigned)(WS_WGU + (size_t)32 * 2048 * 1024), (unsigned)(WS_TOK + 1 * MiB), (const LAS int*)(C.lds + pg8::TEXP_OFF), 2048u * 1024u, nM, 8, C.G, C.gc}; EpiGlu E{(unsigned char*)(ws + WS_ACT), (unsigned)(WS_BIAS + 32 * 2048 * 4)}; \
        pg8::gemm_phase<true, true>(C.lds, ws, 512, 512, 512, S, E); }
    if (IN(16)) { PH_BODY_16 } if (REPS(16) > 1 && IN(16)) { xcd_barrier(bar); PH_BODY_16 }
    SEAM(16);
    #define PH_BODY_17 { const int nM = moe_prep(C, (const int*)(ws + WS_CTL + CT_TEXP) + 1024); \
        MoeSched S{(unsigned)WS_ACT, (unsigned)(WS_WD + (size_t)32 * 1024 * 1024), 0u, (const LAS int*)(C.lds + pg8::TEXP_OFF), 1024u * 1024u, nM, 4, C.G, C.gc}; EpiDown E{(unsigned char*)(ws + WS_YS), (unsigned)(WS_BD + 32 * 1024 * 4)}; \
        pg8::gemm_phase<true, false>(C.lds, ws, 512, 512, 512, S, E); }
    if (IN(17)) { PH_BODY_17 } if (REPS(17) > 1 && IN(17)) { xcd_barrier(bar); PH_BODY_17 }
    SEAM(17);
    #define PH_BODY_18 phase_combine(C, 1, NGRID, true);
    if (IN(18)) { PH_BODY_18 } if (REPS(18) > 1 && IN(18)) { xcd_barrier(bar); PH_BODY_18 }
#undef ws
#undef IN
#undef SEAM
}

#ifndef MK_PER_PHASE
#define MK_PER_PHASE 0
#endif
extern "C" void kernel_launch(void* const* d_in, const int* in_sizes, int n_in, void* d_out, int out_size, void* d_ws, size_t ws_size, hipStream_t stream) {
    static int grid = 0;
    if (grid == 0) {
        if (n_in != 25 || ws_size < WS_END || out_size != NGRID * D) { fprintf(stderr, "kernel_launch: unexpected problem (n_in %d, ws %zu, out %d)\n", n_in, ws_size, out_size); grid = -1; return; }
        int dev = 0, cus = 0, per_cu = 0;
        if (hipGetDevice(&dev) != hipSuccess || hipDeviceGetAttribute(&cus, hipDeviceAttributeMultiprocessorCount, dev) != hipSuccess) { grid = -1; return; }
        if (hipFuncSetAttribute((const void*)hybrid_fwd, hipFuncAttributeMaxDynamicSharedMemorySize, LDS_BYTES) != hipSuccess) { fprintf(stderr, "kernel_launch: hipFuncSetAttribute failed\n"); grid = -1; return; }
        if (hipOccupancyMaxActiveBlocksPerMultiprocessor(&per_cu, (const void*)hybrid_fwd, NTHREADS, LDS_BYTES) != hipSuccess || per_cu < 1) { fprintf(stderr, "kernel_launch: occupancy query failed (%d)\n", per_cu); grid = -1; return; }
        grid = cus * 1;
        if (grid > 256) grid = 256;
    }
    if (grid < 0) return;
    if (hipMemsetAsync((char*)d_ws + WS_CTL + CT_BAR, 0, 16384, stream) != hipSuccess) { fprintf(stderr, "kernel_launch: memset failed\n"); return; }
    Params p{};
    for (int i = 0; i < 25; ++i) p.in[i] = (const float*)d_in[i];
    p.out = (float*)d_out; p.ws = (unsigned char*)d_ws;
#if MK_PER_PHASE
    for (int ph = 0; ph < 19; ++ph) { p.ph_lo = ph; p.ph_hi = ph + 1; void* args[] = {&p};
        hipError_t e = hipLaunchCooperativeKernel((void*)hybrid_fwd, dim3(grid), dim3(NTHREADS), args, LDS_BYTES, stream);
        if (e != hipSuccess) { fprintf(stderr, "launch phase %d failed: %s\n", ph, hipGetErrorString(e)); break; } }
#else
    p.ph_lo = 0; p.ph_hi = 19; void* args[] = {&p};
    hipError_t e = hipLaunchCooperativeKernel((void*)hybrid_fwd, dim3(grid), dim3(NTHREADS), args, LDS_BYTES, stream);
    if (e != hipSuccess) fprintf(stderr, "cooperative launch failed: %s (grid %d)\n", hipGetErrorString(e), grid);
#endif
}
```

```cpp
#include <hip/hip_runtime.h>
#include <hip/hip_cooperative_groups.h>
#include <cstdio>
#include <cstdint>
namespace cg = cooperative_groups;

#define LAS __attribute__((address_space(3)))
typedef unsigned short bf16_t;
typedef short bf16x8 __attribute__((ext_vector_type(8)));
typedef float f32x4 __attribute__((ext_vector_type(4)));
typedef float f32x2 __attribute__((ext_vector_type(2)));
typedef unsigned u32x4 __attribute__((ext_vector_type(4)));
typedef unsigned u32x2 __attribute__((ext_vector_type(2)));

constexpr int NB = 8, SEQ = 4096, D = 1024, NMETA = 16, LSEQ = SEQ + NMETA;
constexpr int NGRID = NB * SEQ;
constexpr int NTOK = NGRID + NB * NMETA;
constexpr int MPAD = 33024;
constexpr int NEXP = 32, TOPK = 4;
constexpr int PMAX = 139776;
constexpr int MTMAX = PMAX / 256;
constexpr float DN_ALPHA = 1.41421356237f;
constexpr float LN_EPS = 1e-5f;
constexpr int NTHREADS = 512, NWAVES = 8;

constexpr size_t MiB = 1u << 20;
constexpr size_t ACT_BYTES = (size_t)MPAD * D * 2;
constexpr size_t WS_CTL   = 0;
constexpr size_t WS_WIN   = 4 * MiB;
constexpr size_t WS_GATE  = WS_WIN + 4 * MiB;
constexpr size_t WS_LOUT  = WS_GATE + 2 * MiB;
constexpr size_t WS_QKV   = WS_LOUT + 2 * MiB;
constexpr size_t WS_NOUT  = WS_QKV + 6 * MiB;
constexpr size_t WS_WGU   = WS_NOUT + 2 * MiB;
constexpr size_t WS_WD    = WS_WGU + 128 * MiB;
constexpr size_t WS_HB    = WS_WD + 64 * MiB;
constexpr size_t WS_HB8   = WS_HB + 65 * MiB;
constexpr size_t WS_PRE   = WS_HB8 + 33 * MiB;
constexpr size_t WS_H     = WS_PRE + 129 * MiB;
constexpr size_t WS_SCR   = WS_H + 129 * MiB;
constexpr size_t WS_XR = WS_SCR, WS_XC = WS_XR + 65 * MiB, WS_GY = WS_XC + 65 * MiB, WS_LA = WS_GY + 65 * MiB, WS_BB = WS_LA + 130 * MiB, WS_HF = WS_BB + 130 * MiB, WS_G = WS_HF + 65 * MiB;
constexpr size_t WS_SCR_END0 = WS_G + 65 * MiB;
constexpr size_t WS_XS = WS_SCR, WS_ACT = WS_XS + 137 * MiB, WS_YS = WS_ACT + 137 * MiB;
constexpr size_t WS_SCR_END1 = WS_YS + 274 * MiB;
constexpr size_t WS_Q = WS_SCR, WS_K = WS_Q + 65 * MiB, WS_VT = WS_K + 65 * MiB, WS_O = WS_VT + 65 * MiB;
constexpr size_t WS_BIAS = (WS_SCR_END0 > WS_SCR_END1 ? WS_SCR_END0 : WS_SCR_END1);
constexpr size_t WS_BD = WS_BIAS + 2 * 32 * 2048 * 4;
constexpr size_t WS_GBIAS = WS_BD + 2 * 32 * 1024 * 4;
constexpr size_t WS_TOK = WS_BIAS + 1 * MiB;
constexpr size_t WS_QKV8 = WS_TOK + 2 * MiB;
constexpr size_t WS_END = WS_QKV8 + 3 * MiB;
static_assert((size_t)PMAX * 4 <= 1 * MiB, "token offset table");
static_assert(ACT_BYTES <= 65 * MiB && (size_t)PMAX * D * 2 <= 274 * MiB && (size_t)PMAX * D <= 137 * MiB && (size_t)MPAD * D <= 33 * MiB && (size_t)MPAD * D * 4 <= 129 * MiB, "ws map");
static_assert(WS_END <= (size_t)2040 * MiB, "ws map must fit 4x the largest input tensor");
constexpr size_t CT_BC      = 4096;
constexpr size_t CT_TEXP    = CT_BC + 2 * 256 * 32 * 4;
constexpr size_t CT_SPL     = CT_TEXP + 2 * 1024 * 4;
constexpr size_t CT_EID     = 256 * 1024;
constexpr size_t CT_GATEV   = CT_EID + 2 * (size_t)NTOK * 4 * 4;
constexpr size_t CT_POS     = CT_GATEV + 2 * (size_t)NTOK * 4 * 4;
static_assert(CT_POS + 2 * (size_t)NTOK * 4 * 4 <= 4 * MiB, "ctl map");

constexpr int LDS_BYTES = 155648;

__device__ __forceinline__ unsigned f2bf(float f) { unsigned u = __builtin_bit_cast(unsigned, f); return (u + 0x7fffu + ((u >> 16) & 1u)) >> 16; }
__device__ __forceinline__ unsigned cvt_pk_bf16(float lo, float hi);
__device__ __forceinline__ unsigned pk2(float lo, float hi) { return cvt_pk_bf16(lo, hi); }
typedef __bf16 bf16x2_t __attribute__((ext_vector_type(2)));
__device__ __forceinline__ unsigned cvt_pk_bf16(float lo, float hi) { const f32x2 v = {lo, hi}; return __builtin_bit_cast(unsigned, __builtin_convertvector(v, bf16x2_t)); }
__device__ __forceinline__ unsigned pk4_fp8(float a, float b, float c, float d) { int w = __builtin_amdgcn_cvt_pk_fp8_f32(a, b, 0, false); w = __builtin_amdgcn_cvt_pk_fp8_f32(c, d, w, true); return (unsigned)w; }
__device__ __forceinline__ float dot2_bf16(unsigned a, unsigned b, float c) { return __builtin_amdgcn_fdot2_f32_bf16(__builtin_bit_cast(bf16x2_t, a), __builtin_bit_cast(bf16x2_t, b), c, false); }
__device__ __forceinline__ void unpack8_fp8(const u32x2 w, float (&o)[8]) { const f32x2 a = __builtin_amdgcn_cvt_pk_f32_fp8((int)w.x, false), b = __builtin_amdgcn_cvt_pk_f32_fp8((int)w.x, true), c = __builtin_amdgcn_cvt_pk_f32_fp8((int)w.y, false), d = __builtin_amdgcn_cvt_pk_f32_fp8((int)w.y, true);
    o[0] = a.x; o[1] = a.y; o[2] = b.x; o[3] = b.y; o[4] = c.x; o[5] = c.y; o[6] = d.x; o[7] = d.y; }
__device__ __forceinline__ float bflo(unsigned w) { return __builtin_bit_cast(float, w << 16); }
__device__ __forceinline__ float bfhi(unsigned w) { return __builtin_bit_cast(float, w & 0xffff0000u); }
__device__ __forceinline__ void unpack8(const u32x4 w, float (&o)[8]);
__device__ __forceinline__ float fast_exp2(float x) { return __builtin_amdgcn_exp2f(x); }
__device__ __forceinline__ float fast_rcp(float x) { return __builtin_amdgcn_rcpf(x); }
__device__ __forceinline__ float sigmoidf_(float x) { return fast_rcp(1.0f + fast_exp2(-1.44269504089f * x)); }
__device__ __forceinline__ float wave_sum(float v) {
#pragma unroll
    for (int o = 1; o < 64; o <<= 1) v += __shfl_xor(v, o);
    return v;
}
template <int CTRL> __device__ __forceinline__ float dpp_movf(float v) { return __builtin_bit_cast(float, __builtin_amdgcn_update_dpp(0, __builtin_bit_cast(int, v), CTRL, 0xf, 0xf, true)); }
__device__ __forceinline__ float readlane_f(float v, int l) { return __builtin_bit_cast(float, __builtin_amdgcn_readlane(__builtin_bit_cast(int, v), l)); }
__device__ __forceinline__ float wave_sum_dpp(float v) {
    v += dpp_movf<0xB1>(v);
    v += dpp_movf<0x4E>(v);
    v += dpp_movf<0x141>(v);
    v += dpp_movf<0x140>(v);
    return (readlane_f(v, 0) + readlane_f(v, 16)) + (readlane_f(v, 32) + readlane_f(v, 48));
}
__device__ __forceinline__ int seqrow(int b, int s) { return s < NMETA ? NGRID + NMETA * b + s : SEQ * b + (s - NMETA); }

struct Params {
    const float* in[25];
    float* out;
    unsigned char* ws;
    int ph_lo, ph_hi;
};
struct Ctx {
    LAS unsigned char* lds;
    int G, bid, gc;
    unsigned char* ws;
    const float* const* in;
    float* out;
};
__device__ __forceinline__ int fresh_tid() { int t = threadIdx.x; asm volatile("" : "+v"(t)); return t; }
__device__ __forceinline__ unsigned char* fresh_ws(unsigned char* p) { asm volatile("" : "+s"(p)); return p; }
#define PHASE_IDS unsigned char* const wsl = fresh_ws(C.ws); (void)wsl; const int tid = fresh_tid(); const int lane = tid & 63; const int wave = __builtin_amdgcn_readfirstlane(tid >> 6); (void)lane; (void)wave;
enum { I_X = 0, I_META, I_WIN, I_CONVW, I_CONVB, I_WA, I_BA, I_WX, I_BX, I_LAM, I_LOUT, I_WQKV, I_RPB, I_MBIAS, I_NOUT, I_LNMG, I_LNMB, I_RW, I_RB, I_WGU, I_BGU, I_WD, I_BD, I_LNFG, I_LNFB };

namespace pg8 {
constexpr int BM = 256, BK = 64, HALF = 128, HTB = HALF * BK * 2, STAGE_BYTES = 8 * HTB, NXCD = 8, WGM = 8;
constexpr int SIDE_OFF = STAGE_BYTES, TEXP_OFF = STAGE_BYTES + 2048, TOK_OFF = STAGE_BYTES + 2048 + 4096;
__device__ __forceinline__ int lds_byte(int r, int c) { const int st = (r >> 4) * 2 + (c >> 5), rr = r & 15, cc = c & 31, ob = rr * 64 + cc * 2; return st * 1024 + (ob ^ (((ob >> 9) & 1) << 5)); }
__device__ __forceinline__ void stage_rc(int b, int& R, int& C) { const int st = b / 1024, sb = b % 1024, swz = sb ^ (((sb >> 9) & 1) << 5); R = (st >> 1) * 16 + swz / 64; C = (st & 1) * 32 + (swz % 64) / 2; }
__device__ __forceinline__ int perm32(int rho) { const int n = rho >> 4, i = rho & 15; return 8 * (i >> 2) + 4 * n + (i & 3); }

typedef int v8i __attribute__((ext_vector_type(8)));
typedef int v4i __attribute__((ext_vector_type(4)));
__device__ __forceinline__ v8i cat8(bf16x8 a, bf16x8 b) { const v4i x = __builtin_bit_cast(v4i, a), y = __builtin_bit_cast(v4i, b); return __builtin_shufflevector(x, y, 0, 1, 2, 3, 4, 5, 6, 7); }
struct Unit { unsigned ao, bo, to; int pm, pn, aux; };

__device__ __forceinline__ void tile_of(int L, int nM, int nN, int& pm, int& pn) {
    const int nwg = nM * nN; int wgid = L;
    { const int q = nwg / NXCD, r = nwg % NXCD, xcd = wgid % NXCD, off = wgid / NXCD; wgid = (xcd < r ? xcd * (q + 1) : r * (q + 1) + (xcd - r) * q) + off; }
    const int nig = WGM * nN, gid = wgid / nig, fm = gid * WGM, gsz = (nM - fm) < WGM ? (nM - fm) : WGM;
    pm = fm + ((wgid % nig) % gsz); pn = (wgid % nig) / gsz;
}

template <bool F8, bool GATHER, class Epi, class Sched>
__device__ __forceinline__ void gemm_phase(LAS unsigned char* lds, const unsigned char* wsbase, const int K, const int lda, const int ldb, const Sched& S, const Epi& E) {
    const __amdgpu_buffer_rsrc_t rsrc = __builtin_amdgcn_make_buffer_rsrc((void*)wsbase, 0, 0xFFFFFFFF, 0x00020000);
    const int tid = fresh_tid(), wid = __builtin_amdgcn_readfirstlane(tid >> 6), lane = tid & 63, wr = wid >> 2, wc = wid & 3;
    const int nt = K / BK;
    int f8scales = 0; if constexpr (F8) { f8scales = Epi::SCALES; asm volatile("" : "+v"(f8scales)); }
    int voffA, voffB;
    { int R, C; stage_rc(tid * 16, R, C); const int Rb = Epi::PERM ? ((R & ~31) + perm32(R & 31)) : R; voffA = ((GATHER ? 0 : R * lda) + C) * 2; voffB = (Rb * ldb + C) * 2; }
    const int tokb = (16 * (wid >> 1) + (lane >> 2)) * 4;
    const unsigned kstep = (unsigned)(BK * 2);
    const unsigned hstepA = (unsigned)HALF * lda * 2, hstepB = (unsigned)HALF * ldb * 2;
    const unsigned ldsw = (unsigned)wid * 1024u;
    const int aoff = lds_byte(wr * 64 + (lane & 15), (lane >> 4) * 8), boff = lds_byte(wc * 32 + (lane & 15), (lane >> 4) * 8);
#define PG8_SA(b, h) (((b) * 2 + (h)) * HTB)
#define PG8_SB(b, h) ((4 + (b) * 2 + (h)) * HTB)
#define PG8_STAGE(bufoff, gbase, voff) do { _Pragma("unroll") for (int _i = 0; _i < 2; ++_i) \
        __builtin_amdgcn_raw_ptr_buffer_load_lds(rsrc, (LAS void*)(lds + (bufoff) + ldsl + _i * 8192), 16, voff, __builtin_amdgcn_readfirstlane((int)((gbase) + (unsigned)_i * (hstep##voff >> 1))), 0, 0); } while (0)
#define hstepvoffA hstepA
#define hstepvoffB hstepB
#define PG8_STAGE_A(bufoff, aoffs, h, par) do { if constexpr (GATHER) { _Pragma("unroll") for (int _i = 0; _i < 2; ++_i) { \
            const int _tk = *(const LAS int*)(lds + TOK_OFF + (par) * 1024 + tokb + ((h) * 128 + _i * 64) * 4); \
            __builtin_amdgcn_raw_ptr_buffer_load_lds(rsrc, (LAS void*)(lds + (bufoff) + ldsl + _i * 8192), 16, _tk + voffA, __builtin_amdgcn_readfirstlane((int)(aoffs)), 0, 0); } } \
        else { PG8_STAGE(bufoff, (aoffs) + (unsigned)(h) * hstepA, voffA); } } while (0)
#define PG8_TOK(unit, par) do { if constexpr (GATHER) { if (wid == 0) __builtin_amdgcn_raw_ptr_buffer_load_lds(rsrc, (LAS void*)(lds + TOK_OFF + (par) * 1024), 16, lane * 16, (int)(unit).to, 0, 0); } } while (0)
#define PG8_LDA(dst, b, h) do { _Pragma("unroll") for (int m = 0; m < 4; ++m) _Pragma("unroll") for (int k = 0; k < 2; ++k) dst[m][k] = *(const LAS bf16x8*)(lds + PG8_SA(b, h) + aoff + m * 2048 + k * 1024); } while (0)
#define PG8_LDB(dst, b, h) do { _Pragma("unroll") for (int n = 0; n < 2; ++n) _Pragma("unroll") for (int k = 0; k < 2; ++k) dst[n][k] = *(const LAS bf16x8*)(lds + PG8_SB(b, h) + boff + n * 2048 + k * 1024); } while (0)
#define PG8_MMA(ai, bj, At, Bt) do { __builtin_amdgcn_s_setprio(1); _Pragma("unroll") for (int m = 0; m < 4; ++m) _Pragma("unroll") for (int n = 0; n < 2; ++n) { \
        if constexpr (F8) { asm volatile("v_mfma_scale_f32_16x16x128_f8f6f4 %0, %1, %2, %0, %3, %3 op_sel:[0,1,0] op_sel_hi:[0,0,0]" : "+v"(acc[ai][bj][m][n]) : "v"(cat8(Bt[n][0], Bt[n][1])), "v"(cat8(At[m][0], At[m][1])), "v"(f8scales)); } \
        else { _Pragma("unroll") for (int k = 0; k < 2; ++k) acc[ai][bj][m][n] = __builtin_amdgcn_mfma_f32_16x16x32_bf16(Bt[n][k], At[m][k], acc[ai][bj][m][n], 0, 0, 0); } } \
        __builtin_amdgcn_s_setprio(0); } while (0)
#define PG8_WAIT_V(n) asm volatile("s_waitcnt vmcnt(" #n ")" ::: "memory")
#define PG8_WAIT_L(n) asm volatile("s_waitcnt lgkmcnt(" #n ")" ::: "memory")
#define PG8_BAR __builtin_amdgcn_s_barrier()
#define PG8_SCHED __builtin_amdgcn_sched_barrier(0)
    Unit cur, nxt; int ui = 0;
    if (!S.next(0, cur)) return;
    f32x4 acc[2][2][4][2];
    bf16x8 At[4][2], B0[2][2], B1[2][2];
#define PG8_INIT(par) do { if constexpr (Epi::SIDE) { const int _l = fresh_tid() & 63; E.init(acc, (const LAS float*)(lds + SIDE_OFF + (par) * 1024), wc, _l >> 4); } \
        else { _Pragma("unroll") for (int a = 0; a < 2; ++a) _Pragma("unroll") for (int b = 0; b < 2; ++b) _Pragma("unroll") for (int m = 0; m < 4; ++m) _Pragma("unroll") for (int n = 0; n < 2; ++n) acc[a][b][m][n] = (f32x4){0.f, 0.f, 0.f, 0.f}; } } while (0)
    unsigned cA = cur.ao, cB = cur.bo;
    unsigned ldsl = ldsw; asm volatile("" : "+s"(ldsl));
#define PG8_SIDE(unit, par) do { if constexpr (Epi::SIDE) { if (wid == 0) __builtin_amdgcn_raw_ptr_buffer_load_lds(rsrc, (LAS void*)(lds + SIDE_OFF + (par) * 1024), 16, lane * 16, (int)E.side_off(unit), 0, 0); } } while (0)
    PG8_SIDE(cur, 0);
    if constexpr (GATHER) PG8_TOK(cur, 0);
    if constexpr (GATHER || Epi::SIDE) { asm volatile("s_waitcnt vmcnt(0)" ::: "memory"); PG8_BAR; }
    PG8_INIT(0);
    PG8_STAGE(PG8_SB(0, 0), cB, voffB); PG8_STAGE(PG8_SB(0, 1), cB + hstepB, voffB); PG8_STAGE_A(PG8_SA(0, 0), cA, 0, 0); PG8_STAGE_A(PG8_SA(0, 1), cA, 1, 0);
    if (wr == 1) PG8_BAR;
    PG8_WAIT_V(2); PG8_BAR;
    PG8_STAGE(PG8_SB(1, 0), cB + kstep, voffB); PG8_STAGE_A(PG8_SA(1, 0), cA + kstep, 0, 0); PG8_STAGE(PG8_SB(1, 1), cB + hstepB + kstep, voffB);
    PG8_WAIT_V(6); PG8_BAR;
    for (;;) {
        const bool has_next = S.next(ui + 1, nxt);
        if (has_next) { PG8_TOK(nxt, (ui + 1) & 1); PG8_SIDE(nxt, (ui + 1) & 1); }
        const unsigned nA = has_next ? nxt.ao : cA, nB = has_next ? nxt.bo : cB;
#pragma unroll 1
        for (int t = 0; t < nt; t += 2) {
            const bool last = (t == nt - 2);
            ldsl = ldsw; asm volatile("" : "+s"(ldsl));
            const int parc = ui & 1, parn = (ui + ((last && has_next) ? 1 : 0)) & 1;
            const unsigned a1 = cA + (unsigned)(t + 1) * kstep;
            const unsigned a2 = last ? nA : cA + (unsigned)(t + 2) * kstep, b2 = last ? nB : cB + (unsigned)(t + 2) * kstep;
            const unsigned a3 = a2 + kstep, b3 = b2 + kstep;
            PG8_LDB(B0, 0, 0); PG8_LDB(B1, 0, 1); PG8_SCHED; PG8_LDA(At, 0, 0); PG8_STAGE_A(PG8_SA(1, 1), a1, 1, parc);
            PG8_WAIT_V(8); PG8_WAIT_L(0); PG8_BAR; PG8_MMA(0, 0, At, B0); PG8_MMA(0, 1, At, B1); PG8_BAR; PG8_SCHED;
            PG8_LDA(At, 0, 1); PG8_STAGE(PG8_SB(0, 0), b2, voffB); PG8_STAGE(PG8_SB(0, 1), b2 + hstepB, voffB); PG8_STAGE_A(PG8_SA(0, 0), a2, 0, parn);
            PG8_WAIT_V(8); PG8_WAIT_L(0); PG8_BAR; PG8_MMA(1, 0, At, B0); PG8_MMA(1, 1, At, B1); PG8_BAR; PG8_SCHED;
            PG8_LDB(B0, 1, 0); PG8_LDB(B1, 1, 1); PG8_SCHED; PG8_LDA(At, 1, 0); PG8_STAGE_A(PG8_SA(0, 1), a2, 1, parn);
            PG8_WAIT_V(8); PG8_WAIT_L(0); PG8_BAR; PG8_MMA(0, 0, At, B0); PG8_MMA(0, 1, At, B1); PG8_BAR; PG8_SCHED;
            PG8_LDA(At, 1, 1); PG8_STAGE(PG8_SB(1, 0), b3, voffB); PG8_STAGE(PG8_SB(1, 1), b3 + hstepB, voffB); PG8_STAGE_A(PG8_SA(1, 0), a3, 0, parn);
            PG8_WAIT_V(8); PG8_WAIT_L(0); PG8_BAR; PG8_MMA(1, 0, At, B0); PG8_MMA(1, 1, At, B1); PG8_BAR; PG8_SCHED;
        }
        if constexpr (F8) asm volatile("s_nop 15\n\ts_nop 15" ::: "memory");
        if (wr == 0) PG8_BAR;
        { const int l2 = fresh_tid() & 63; E(acc, cur, wr, wc, l2 & 15, l2 >> 4, (const LAS float*)(lds + SIDE_OFF + (ui & 1) * 1024)); }
        if (!has_next) break;
        cur = nxt; cA = nA; cB = nB; ++ui;
        PG8_INIT(ui & 1);
        if (wr == 1) PG8_BAR;
    }
    PG8_WAIT_V(0);
    PG8_BAR;
#undef PG8_SA
#undef PG8_SB
#undef PG8_STAGE
#undef PG8_STAGE_A
#undef PG8_TOK
#undef PG8_SIDE
#undef PG8_INIT
#undef hstepvoffA
#undef hstepvoffB
#undef PG8_LDA
#undef PG8_LDB
#undef PG8_MMA
#undef PG8_WAIT_V
#undef PG8_WAIT_L
#undef PG8_BAR
#undef PG8_SCHED
}
}

using pg8::Unit;

struct DenseSched {
    unsigned A, Bt; int lda, ldb, nM, nN, G, c;
    __device__ __forceinline__ bool next(int i, Unit& u) const {
        const int L = i * G + c; if (L >= nM * nN) return false;
        pg8::tile_of(L, nM, nN, u.pm, u.pn); u.aux = 0; u.to = 0;
        u.ao = A + (unsigned)u.pm * 256 * lda * 2; u.bo = Bt + (unsigned)u.pn * 256 * ldb * 2; return true;
    }
};
struct GateSched {
    unsigned XC, GT; int nM, G, c;
    __device__ __forceinline__ bool next(int i, Unit& u) const {
        const int per = nM * 4; const int L = i * G + c; if (L >= 4 * per) return false;
        const int nb = L / per; pg8::tile_of(L - nb * per, nM, 4, u.pm, u.pn); u.aux = nb; u.to = 0;
        u.ao = XC + ((unsigned)u.pm * 256 * 1024 + 256 * nb) * 2; u.bo = GT + ((unsigned)nb * 1024 + 256 * u.pn) * 256 * 2; return true;
    }
};
struct QkvSched {
    unsigned HB, WT; int nM, G, c;
    __device__ __forceinline__ bool next(int i, Unit& u) const {
        const int n0 = nM * 8, n1 = 4 * nM; const int L = i * G + c; if (L >= n0 + n1) return false; u.to = 0;
        if (L < n0) { pg8::tile_of(L, nM, 8, u.pm, u.pn); u.aux = 0; u.ao = HB + (unsigned)u.pm * 256 * 1024; u.bo = WT + (unsigned)u.pn * 256 * 1024; }
        else { pg8::tile_of(L - n0, 4, nM, u.pm, u.pn); u.aux = 1; u.ao = WT + (unsigned)(2048 + u.pm * 256) * 1024; u.bo = HB + (unsigned)u.pn * 256 * 1024; }
        return true;
    }
};
struct MoeSched {
    unsigned A, W, tok; const LAS int* texp; unsigned wstride; int nM, nN, G, c;
    __device__ __forceinline__ bool next(int i, Unit& u) const {
        const int L = i * G + c; if (L >= nM * nN) return false;
        pg8::tile_of(L, nM, nN, u.pm, u.pn);
        const int e = __builtin_amdgcn_readfirstlane(texp[u.pm]); u.aux = e;
        u.ao = tok ? A : A + (unsigned)u.pm * 256 * 1024; u.to = tok + (unsigned)u.pm * 1024; u.bo = W + (unsigned)e * wstride + (unsigned)u.pn * 256 * 1024; return true;
    }
};

#define EPI_ARGS const f32x4 (&acc)[2][2][4][2], const Unit& u, int wr, int wc, int fr, int fq, const LAS float* side
struct EpiWin {
    static constexpr bool PERM = true, SIDE = false;
    bf16_t* XR; bf16_t* GY;
    __device__ __forceinline__ void operator()(EPI_ARGS) const {
        const int row0 = u.pm * 256 + wr * 64 + fr;
        if (u.pn < 4) {
            const int col0 = u.pn * 256 + wc * 32 + 8 * fq;
#pragma unroll
            for (int ai = 0; ai < 2; ++ai)
#pragma unroll
                for (int m = 0; m < 4; ++m) { bf16_t* rowp = XR + (size_t)(row0 + ai * 128 + m * 16) * D + col0;
#pragma unroll
                    for (int bj = 0; bj < 2; ++bj) { const f32x4 v0 = acc[ai][bj][m][0], v1 = acc[ai][bj][m][1];
                        u32x4 w; w.x = cvt_pk_bf16(v0[0], v0[1]); w.y = cvt_pk_bf16(v0[2], v0[3]); w.z = cvt_pk_bf16(v1[0], v1[1]); w.w = cvt_pk_bf16(v1[2], v1[3]);
                        *(u32x4*)(rowp + bj * 128) = w; } }
        } else {
#pragma unroll
            for (int ai = 0; ai < 2; ++ai)
#pragma unroll
                for (int m = 0; m < 4; ++m) { const int row = row0 + ai * 128 + m * 16;
#pragma unroll
                    for (int bj = 0; bj < 2; ++bj) { const int g = (u.pn - 4) * 8 + bj * 4 + wc;
                        float o[8];
#pragma unroll
                        for (int n = 0; n < 2; ++n)
#pragma unroll
                            for (int j = 0; j < 4; ++j) { const float v = acc[ai][bj][m][n][j]; const float z = 1.5957691216f * (v + 0.044715f * v * v * v); o[n * 4 + j] = v * sigmoidf_(z); }
                        u32x4 w; w.x = cvt_pk_bf16(o[0], o[1]); w.y = cvt_pk_bf16(o[2], o[3]); w.z = cvt_pk_bf16(o[4], o[5]); w.w = cvt_pk_bf16(o[6], o[7]);
                        *(u32x4*)(GY + ((size_t)g * MPAD + row) * 32 + 8 * fq) = w; } }
        }
    }
};
struct EpiGate {
    static constexpr bool PERM = true, SIDE = true;
    const bf16_t* XC; unsigned char* LB; const float* spl; unsigned bias_off;
    __device__ __forceinline__ unsigned side_off(const Unit& u) const { return bias_off + (unsigned)((((u.pn >> 1) * 4 + u.aux) * 2 + (u.pn & 1)) * 1024); }
    __device__ __forceinline__ void init(f32x4 (&acc)[2][2][4][2], const LAS float* side, int wc, int fq) const {
#pragma unroll
        for (int bj = 0; bj < 2; ++bj)
#pragma unroll
            for (int n = 0; n < 2; ++n) { const f32x4 b = *(const LAS f32x4*)(side + 128 * bj + 32 * wc + 8 * fq + 4 * n);
#pragma unroll
                for (int ai = 0; ai < 2; ++ai)
#pragma unroll
                    for (int m = 0; m < 4; ++m) acc[ai][bj][m][n] = b; }
    }
    __device__ __forceinline__ void operator()(EPI_ARGS) const {
        const int nb = u.aux, dir = u.pn >> 1, half = u.pn & 1;
        const int ch0 = 256 * nb + 128 * half + 32 * wc + 8 * fq, g = ch0 >> 5;
        const int row0 = u.pm * 256 + wr * 64 + fr;
        float csp[8];
        { const f32x4 p0 = *(const f32x4*)(spl + dir * 1024 + ch0), p1 = *(const f32x4*)(spl + dir * 1024 + ch0 + 4);
#pragma unroll
          for (int j = 0; j < 4; ++j) { csp[j] = (-2.0f / 256.0f) * p0[j]; csp[4 + j] = (-2.0f / 256.0f) * p1[j]; } }
        u32x4 xnext = *(const u32x4*)(XC + (size_t)row0 * D + ch0);
#pragma unroll
        for (int ai = 0; ai < 2; ++ai)
#pragma unroll
            for (int m = 0; m < 4; ++m) { const int row = row0 + ai * 128 + m * 16;
                const u32x4 xw = xnext;
                { const int it = ai * 4 + m + 1, rn = row0 + (it >> 2) * 128 + (it & 3) * 16; if (it < 8) xnext = *(const u32x4*)(XC + (size_t)rn * D + ch0); }
                float xc[8]; unpack8(xw, xc);
                const bool start = dir == 1 && (row & (SEQ - 1)) == SEQ - 1;
                float sg[8], bb[8];
#pragma unroll
                for (int n = 0; n < 2; ++n)
#pragma unroll
                    for (int j = 0; j < 4; ++j) { const int i = n * 4 + j;
                        const float sga = fast_rcp(__builtin_fmaf(fast_exp2(-1.44269504089f * acc[ai][0][m][n][j]), 1.0f / 256.0f, 1.0f / 256.0f));
                        const float a2 = fast_exp2(__builtin_fmaf(csp[i], sga, 6.0f));
                        const float mult = __builtin_amdgcn_sqrtf(__builtin_fabsf(64.0f - a2));
                        sg[i] = sga; bb[i] = __builtin_amdgcn_fmed3f(mult * sigmoidf_(acc[ai][1][m][n][j]) * xc[i], -448.0f, 448.0f); }
                if (start) {
#pragma unroll
                    for (int n = 0; n < 2; ++n)
#pragma unroll
                        for (int j = 0; j < 4; ++j) bb[n * 4 + j] = __builtin_amdgcn_fmed3f(8.0f * sigmoidf_(acc[ai][1][m][n][j]) * xc[n * 4 + j], -448.0f, 448.0f); }
                u32x4 w; w.x = pk4_fp8(sg[0], sg[1], sg[2], sg[3]); w.y = pk4_fp8(sg[4], sg[5], sg[6], sg[7]); w.z = pk4_fp8(bb[0], bb[1], bb[2], bb[3]); w.w = pk4_fp8(bb[4], bb[5], bb[6], bb[7]);
                *(u32x4*)(LB + (((size_t)dir * 32 + g) * MPAD + row) * 64 + 16 * fq) = w; }
    }
};
template <bool LAYER0> struct EpiRes {
    static constexpr bool PERM = true, SIDE = false;
    bf16_t* PRE; const float* x; const float* meta; const bf16_t* HB; int nrows;
    __device__ __forceinline__ void operator()(EPI_ARGS) const {
        const int row0 = u.pm * 256 + wr * 64 + fr, col0 = u.pn * 256 + wc * 32 + 8 * fq;
#pragma unroll
        for (int ai = 0; ai < 2; ++ai)
#pragma unroll
            for (int m = 0; m < 4; ++m) { const int row = row0 + ai * 128 + m * 16;
                if (row < nrows) {
#pragma unroll
                    for (int bj = 0; bj < 2; ++bj) { const int c = col0 + bj * 128; float r[8];
                        if (LAYER0) { const float* rp = (row < NGRID ? x + (size_t)row * D : meta + (size_t)((row - NGRID) & 15) * D) + c; const f32x4 r0 = *(const f32x4*)rp, r1 = *(const f32x4*)(rp + 4);
                            r[0] = r0[0]; r[1] = r0[1]; r[2] = r0[2]; r[3] = r0[3]; r[4] = r1[0]; r[5] = r1[1]; r[6] = r1[2]; r[7] = r1[3]; }
                        else { const u32x4 rw = *(const u32x4*)(HB + (size_t)row * D + c); r[0] = bflo(rw.x); r[1] = bfhi(rw.x); r[2] = bflo(rw.y); r[3] = bfhi(rw.y); r[4] = bflo(rw.z); r[5] = bfhi(rw.z); r[6] = bflo(rw.w); r[7] = bfhi(rw.w); }
                        const f32x4 a0 = acc[ai][bj][m][0], a1 = acc[ai][bj][m][1];
                        u32x4 w; w.x = cvt_pk_bf16(r[0] * DN_ALPHA + a0[0], r[1] * DN_ALPHA + a0[1]); w.y = cvt_pk_bf16(r[2] * DN_ALPHA + a0[2], r[3] * DN_ALPHA + a0[3]);
                        w.z = cvt_pk_bf16(r[4] * DN_ALPHA + a1[0], r[5] * DN_ALPHA + a1[1]); w.w = cvt_pk_bf16(r[6] * DN_ALPHA + a1[2], r[7] * DN_ALPHA + a1[3]);
                        *(u32x4*)(PRE + (size_t)row * D + c) = w; }
                }
                asm volatile("" ::: "memory"); }
    }
};
struct EpiGlu {
    static constexpr bool PERM = true, SIDE = true; static constexpr int SCALES = 0x7F79;
    unsigned char* ACT; unsigned bias_off;
    __device__ __forceinline__ unsigned side_off(const Unit& u) const { return bias_off + (unsigned)((u.aux * 8 + u.pn) * 1024); }
    __device__ __forceinline__ void init(f32x4 (&acc)[2][2][4][2], const LAS float* side, int wc, int fq) const {
#pragma unroll
        for (int bj = 0; bj < 2; ++bj)
#pragma unroll
            for (int n = 0; n < 2; ++n) { const f32x4 b = *(const LAS f32x4*)(side + 128 * bj + 32 * wc + 8 * fq + 4 * n);
#pragma unroll
                for (int ai = 0; ai < 2; ++ai)
#pragma unroll
                    for (int m = 0; m < 4; ++m) acc[ai][bj][m][n] = b; }
    }
    __device__ __forceinline__ void operator()(EPI_ARGS) const {
        const int f0 = 128 * u.pn + 32 * wc + 8 * fq;
        const int row0 = u.pm * 256 + wr * 64 + fr;
#pragma unroll
        for (int ai = 0; ai < 2; ++ai)
#pragma unroll
            for (int m = 0; m < 4; ++m) { const int row = row0 + ai * 128 + m * 16; float o[8];
#pragma unroll
                for (int n = 0; n < 2; ++n)
#pragma unroll
                    for (int j = 0; j < 4; ++j) { const int i = n * 4 + j;
                        const float glu = fminf(acc[ai][0][m][n][j], 7.0f);
                        const float lin1 = __builtin_amdgcn_fmed3f(acc[ai][1][m][n][j], -6.0f, 8.0f);
                        const float r4 = fast_rcp(__builtin_fmaf(fast_exp2(glu * (-1.702f * 1.44269504089f)), 0.25f, 0.25f));
                        o[i] = (glu * r4) * lin1; }
                u32x2 w; w.x = pk4_fp8(o[0], o[1], o[2], o[3]); w.y = pk4_fp8(o[4], o[5], o[6], o[7]);
                *(u32x2*)(ACT + (size_t)row * D + f0) = w; }
    }
};
struct EpiNull {
    static constexpr bool PERM = true, SIDE = false; static constexpr int SCALES = 0x7F79;
    __device__ __forceinline__ void operator()(EPI_ARGS) const {
#pragma unroll
        for (int ai = 0; ai < 2; ++ai)
#pragma unroll
            for (int bj = 0; bj < 2; ++bj)
#pragma unroll
                for (int m = 0; m < 4; ++m)
#pragma unroll
                    for (int n = 0; n < 2; ++n) asm volatile("" :: "v"(acc[ai][bj][m][n]));
    }
};
struct EpiDown {
    static constexpr bool PERM = true, SIDE = true; static constexpr int SCALES = 0x7D79;
    unsigned char* YS; unsigned bias_off;
    __device__ __forceinline__ unsigned side_off(const Unit& u) const { return bias_off + (unsigned)((u.aux * 4 + u.pn) * 1024); }
    __device__ __forceinline__ void init(f32x4 (&acc)[2][2][4][2], const LAS float* side, int wc, int fq) const {
#pragma unroll
        for (int bj = 0; bj < 2; ++bj)
#pragma unroll
            for (int n = 0; n < 2; ++n) { const f32x4 b = *(const LAS f32x4*)(side + 128 * bj + 32 * wc + 8 * fq + 4 * n);
#pragma unroll
                for (int ai = 0; ai < 2; ++ai)
#pragma unroll
                    for (int m = 0; m < 4; ++m) acc[ai][bj][m][n] = b; }
    }
    __device__ __forceinline__ void operator()(EPI_ARGS) const {
        const int row0 = u.pm * 256 + wr * 64 + fr, col0 = u.pn * 256 + wc * 32 + 8 * fq;
#pragma unroll
        for (int ai = 0; ai < 2; ++ai)
#pragma unroll
            for (int m = 0; m < 4; ++m) { unsigned char* rowp = YS + (size_t)(row0 + ai * 128 + m * 16) * D + col0;
#pragma unroll
                for (int bj = 0; bj < 2; ++bj) { const f32x4 v0 = acc[ai][bj][m][0] * 8.0f, v1 = acc[ai][bj][m][1] * 8.0f;
                    u32x2 w; w.x = pk4_fp8(v0[0], v0[1], v0[2], v0[3]); w.y = pk4_fp8(v1[0], v1[1], v1[2], v1[3]);
                    *(u32x2*)(rowp + bj * 128) = w; } }
    }
};
struct EpiQkv {
    static constexpr bool PERM = true, SIDE = false; static constexpr int SCALES = 0x7F79;
    bf16_t* Q; bf16_t* Kx; bf16_t* VT;
    __device__ __forceinline__ void operator()(EPI_ARGS) const {
        const int row0 = u.pm * 256 + wr * 64 + fr; bf16_t* base; int ldc, colt; float sc = 1.0f;
        if (u.aux == 0) { ldc = D; if (u.pn < 4) { base = Q; colt = u.pn * 256; sc = 0.125f * 1.44269504089f; } else { base = Kx; colt = (u.pn - 4) * 256; } }
        else { base = VT; ldc = MPAD; colt = u.pn * 256; }
        const int col0 = colt + wc * 32 + 8 * fq;
#pragma unroll
        for (int ai = 0; ai < 2; ++ai)
#pragma unroll
            for (int m = 0; m < 4; ++m) { bf16_t* rowp = base + (size_t)(row0 + ai * 128 + m * 16) * ldc + col0;
#pragma unroll
                for (int bj = 0; bj < 2; ++bj) { const f32x4 v0 = acc[ai][bj][m][0] * sc, v1 = acc[ai][bj][m][1] * sc;
                    u32x4 w; w.x = cvt_pk_bf16(v0[0], v0[1]); w.y = cvt_pk_bf16(v0[2], v0[3]); w.z = cvt_pk_bf16(v1[0], v1[1]); w.w = cvt_pk_bf16(v1[2], v1[3]);
                    *(u32x4*)(rowp + bj * 128) = w; } }
    }
};

struct CvItem { const float* src; unsigned char* dst; int ld, pitch, f8; };
__device__ __forceinline__ CvItem cv_item(const Ctx& C, unsigned char* wsl, int it) {
    constexpr int I0 = 512, I1 = 256, I2 = 256, I3 = 768, I4 = 256, I5 = 32768, I6 = 16384;
    CvItem q; int r = it;
    if (r < I0) { const int nbk = r & 63, kb = r >> 6; q.src = C.in[I_WIN] + (size_t)(128 * kb) * 2048 + 32 * nbk; q.ld = 2048; q.dst = wsl + WS_WIN + ((size_t)(32 * nbk) * 1024 + 128 * kb) * 2; q.pitch = 2048; q.f8 = 0; return q; } r -= I0;
    if (r < I1) { const int job = r >> 3, sub = r & 7, nbk = sub & 3, kb = sub >> 2;
        const int half = job & 1, which = (job >> 1) & 1, nb = (job >> 2) & 3, dir = job >> 4;
        q.src = C.in[which ? I_WX : I_WA] + (size_t)(dir * 4 + nb) * 65536 + (size_t)(128 * kb) * 256 + 128 * half + 32 * nbk; q.ld = 256;
        q.dst = wsl + WS_GATE + (((size_t)nb * 1024 + 256 * (2 * dir + half) + 128 * which + 32 * nbk) * 256 + 128 * kb) * 2; q.pitch = 512; q.f8 = 0; return q; } r -= I1;
    if (r < I2) { const int nbk = r & 31, kb = r >> 5; q.src = C.in[I_LOUT] + (size_t)(128 * kb) * 1024 + 32 * nbk; q.ld = 1024; q.dst = wsl + WS_LOUT + ((size_t)(32 * nbk) * 1024 + 128 * kb) * 2; q.pitch = 2048; q.f8 = 0; return q; } r -= I2;
    if (r < I3) { const int nbk = r % 96, kb = r / 96; q.src = C.in[I_WQKV] + (size_t)(128 * kb) * 3072 + 32 * nbk; q.ld = 3072; q.dst = wsl + WS_QKV + ((size_t)(32 * nbk) * 1024 + 128 * kb) * 2; q.pitch = 2048; q.f8 = 0; return q; } r -= I3;
    if (r < I4) { const int nbk = r & 31, kb = r >> 5; q.src = C.in[I_NOUT] + (size_t)(128 * kb) * 1024 + 32 * nbk; q.ld = 1024; q.dst = wsl + WS_NOUT + ((size_t)(32 * nbk) * 1024 + 128 * kb) * 2; q.pitch = 2048; q.f8 = 0; return q; } r -= I4;
    q.f8 = 1; q.pitch = 1024;
    if (r < I5) { const int mat = r >> 9, sub = r & 511, nbk = sub & 63, kb = sub >> 6; const int n0 = 32 * nbk, bj = n0 >> 10, f0 = n0 & 1023, pn = f0 >> 7, jj = f0 & 127;
        q.src = C.in[I_WGU] + (size_t)mat * 1024 * 2048 + (size_t)(128 * kb) * 2048 + n0; q.ld = 2048; q.dst = wsl + WS_WGU + ((size_t)mat * 2048 + 256 * pn + 128 * bj + jj) * 1024 + 128 * kb; return q; } r -= I5;
    if (r < I6) { const int mat = r >> 8, sub = r & 255, nbk = sub & 31, kb = sub >> 5;
        q.src = C.in[I_WD] + (size_t)mat * 1024 * 1024 + (size_t)(128 * kb) * 1024 + 32 * nbk; q.ld = 1024; q.dst = wsl + WS_WD + ((size_t)mat * 1024 + 32 * nbk) * 1024 + 128 * kb; return q; } r -= I6;
    { const int nbk = r % 96, kb = r / 96; q.src = C.in[I_WQKV] + (size_t)(128 * kb) * 3072 + 32 * nbk; q.ld = 3072; q.dst = wsl + WS_QKV8 + (size_t)(32 * nbk) * 1024 + 128 * kb; return q; }
}
__device__ __forceinline__ void phase_convert(const Ctx& C) {
    PHASE_IDS
    LAS float* scr = (LAS float*)(C.lds + wave * 16896);
    const int gw = C.bid * NWAVES + wave, NGW = C.G * NWAVES;
    constexpr int NIT = 512 + 256 + 256 + 768 + 256 + 32768 + 16384 + 768;
    if (gw < NIT) {
        const int r = lane >> 3, q4 = lane & 7, c = lane & 15, nn = lane >> 4;
        CvItem cur = cv_item(C, wsl, gw); int it = gw;
        f32x4 v[16];
#pragma unroll
        for (int i = 0; i < 16; ++i) v[i] = __builtin_nontemporal_load((const f32x4*)(cur.src + (size_t)(8 * i + r) * cur.ld + 4 * q4));
        for (;;) {
#pragma unroll
            for (int i = 0; i < 16; ++i) { LAS float* sp = scr + (8 * i + r) * 33 + 4 * q4; sp[0] = v[i][0]; sp[1] = v[i][1]; sp[2] = v[i][2]; sp[3] = v[i][3]; }
            const int nit = it + NGW; CvItem nxt = cur;
            if (nit < NIT) { nxt = cv_item(C, wsl, nit);
#pragma unroll
                for (int i = 0; i < 16; ++i) v[i] = __builtin_nontemporal_load((const f32x4*)(nxt.src + (size_t)(8 * i + r) * nxt.ld + 4 * q4)); }
            asm volatile("s_waitcnt lgkmcnt(0)" ::: "memory");
            if (cur.f8) {
#pragma unroll
                for (int j = 0; j < 8; ++j) { const int n = nn + 4 * j; const LAS float* sp = scr + (8 * c) * 33 + n;
                    u32x2 o; o.x = pk4_fp8(sp[0] * 64.0f, sp[33] * 64.0f, sp[2 * 33] * 64.0f, sp[3 * 33] * 64.0f); o.y = pk4_fp8(sp[4 * 33] * 64.0f, sp[5 * 33] * 64.0f, sp[6 * 33] * 64.0f, sp[7 * 33] * 64.0f);
                    *(u32x2*)(cur.dst + (size_t)n * cur.pitch + 8 * c) = o; }
            } else {
#pragma unroll
                for (int j = 0; j < 8; ++j) { const int n = nn + 4 * j; const LAS float* sp = scr + (8 * c) * 33 + n;
                    u32x4 o; o.x = pk2(sp[0], sp[33]); o.y = pk2(sp[2 * 33], sp[3 * 33]); o.z = pk2(sp[4 * 33], sp[5 * 33]); o.w = pk2(sp[6 * 33], sp[7 * 33]);
                    *(u32x4*)(cur.dst + (size_t)n * cur.pitch + 16 * c) = o; }
            }
            asm volatile("s_waitcnt lgkmcnt(0)" ::: "memory");
            if (nit >= NIT) break;
            cur = nxt; it = nit;
        }
    }
    const int gt = C.bid * NTHREADS + tid, NGT = C.G * NTHREADS;
    for (int i = gt; i < 2048; i += NGT) ((float*)(wsl + WS_CTL + CT_SPL))[i] = 8.0f * 1.44269504089f * log1pf(expf(-C.in[I_LAM][i]));
    for (int i = gt; i < 2 * 32 * 2048; i += NGT) { const int le = i >> 11, r = i & 2047, pn = r >> 8, bj = (r >> 7) & 1, ii = r & 127;
        ((float*)(wsl + WS_BIAS))[i] = C.in[I_BGU][(size_t)le * 2048 + bj * 1024 + 128 * pn + ii] + (bj ? 1.0f : 0.0f); }
    for (int i = gt; i < 2 * 32 * 1024; i += NGT) ((float*)(wsl + WS_BD))[i] = C.in[I_BD][i];
    for (int i = gt; i < 4096; i += NGT) { const int ut = i >> 8, which = (i >> 7) & 1, jj = i & 127, dir = ut >> 3, nb = (ut >> 1) & 3, half = ut & 1;
        ((float*)(wsl + WS_GBIAS))[i] = C.in[which ? I_BX : I_BA][dir * 1024 + 256 * nb + 128 * half + jj]; }
    for (int i0 = gt; i0 < NTOK * 128; i0 += 4 * NGT) { f32x4 a[4], b[4];
#pragma unroll
        for (int u = 0; u < 4; ++u) { const int i = i0 + u * NGT; if (i < NTOK * 128) { const int row = i >> 7, oc = i & 127;
            const float* src = (row < NGRID ? C.in[I_X] + (size_t)row * D : C.in[I_META] + (size_t)((row - NGRID) & 15) * D) + 8 * oc;
            a[u] = __builtin_nontemporal_load((const f32x4*)src); b[u] = __builtin_nontemporal_load((const f32x4*)(src + 4)); } }
#pragma unroll
        for (int u = 0; u < 4; ++u) { const int i = i0 + u * NGT; if (i < NTOK * 128) { const int row = i >> 7, oc = i & 127;
            u32x4 w; w.x = pk2(a[u][0], a[u][1]); w.y = pk2(a[u][2], a[u][3]); w.z = pk2(b[u][0], b[u][1]); w.w = pk2(b[u][2], b[u][3]);
            *(u32x4*)((bf16_t*)(wsl + WS_HB) + (size_t)row * D + 8 * oc) = w; } } }
}

__device__ __forceinline__ void phase_conv(const Ctx& C) {
    PHASE_IDS
    const bf16_t* XR = (const bf16_t*)(wsl + WS_XR); bf16_t* XC = (bf16_t*)(wsl + WS_XC);
    const float* cw = C.in[I_CONVW]; const float* cb = C.in[I_CONVB];
    const int gt = C.bid * NTHREADS + tid, NGT = C.G * NTHREADS;
    for (int i = gt; i < NTOK * 128; i += NGT) { const int row = i >> 7, ch = 8 * (i & 127);
        int b, s; if (row < NGRID) { b = row >> 12; s = NMETA + (row & (SEQ - 1)); } else { b = (row - NGRID) >> 4; s = (row - NGRID) & 15; }
        float a[8];
        { const f32x4 t0 = *(const f32x4*)(cb + ch), t1 = *(const f32x4*)(cb + ch + 4);
#pragma unroll
          for (int j = 0; j < 4; ++j) { a[j] = t0[j]; a[4 + j] = t1[j]; } }
#pragma unroll
        for (int j = 0; j < 4; ++j) { const int sj = s - 2 + j;
            if (sj >= 0 && sj < LSEQ) { const u32x4 xw = *(const u32x4*)(XR + (size_t)seqrow(b, sj) * D + ch);
                const f32x4 w0 = *(const f32x4*)(cw + j * 1024 + ch), w1 = *(const f32x4*)(cw + j * 1024 + ch + 4);
                a[0] += w0[0] * bflo(xw.x); a[1] += w0[1] * bfhi(xw.x); a[2] += w0[2] * bflo(xw.y); a[3] += w0[3] * bfhi(xw.y);
                a[4] += w1[0] * bflo(xw.z); a[5] += w1[1] * bfhi(xw.z); a[6] += w1[2] * bflo(xw.w); a[7] += w1[3] * bfhi(xw.w); } }
        u32x4 w; w.x = pk2(a[0], a[1]); w.y = pk2(a[2], a[3]); w.z = pk2(a[4], a[5]); w.w = pk2(a[6], a[7]);
        *(u32x4*)(XC + (size_t)row * D + ch) = w; }
}

template <int N> __device__ __forceinline__ float dpp_shr(float oldv, float v) {
    return __builtin_bit_cast(float, __builtin_amdgcn_update_dpp(__builtin_bit_cast(int, oldv), __builtin_bit_cast(int, v), 0x110 + N, 0xf, 0xf, false));
}
__device__ __forceinline__ void scan_group(float (&a)[8], float (&b)[8]) {
#pragma unroll
    for (int c = 0; c < 8; ++c) {
        { const float ap = dpp_shr<1>(1.0f, a[c]), bp = dpp_shr<1>(0.0f, b[c]); b[c] = a[c] * bp + b[c]; a[c] = a[c] * ap; }
        { const float ap = dpp_shr<2>(1.0f, a[c]), bp = dpp_shr<2>(0.0f, b[c]); b[c] = a[c] * bp + b[c]; a[c] = a[c] * ap; }
        { const float ap = dpp_shr<4>(1.0f, a[c]), bp = dpp_shr<4>(0.0f, b[c]); b[c] = a[c] * bp + b[c]; a[c] = a[c] * ap; }
        { const float ap = dpp_shr<8>(1.0f, a[c]), bp = dpp_shr<8>(0.0f, b[c]); b[c] = a[c] * bp + b[c]; a[c] = a[c] * ap; }
    }
}
__device__ __forceinline__ void unpack8(const u32x4 w, float (&o)[8]) { o[0] = bflo(w.x); o[1] = bfhi(w.x); o[2] = bflo(w.y); o[3] = bfhi(w.y); o[4] = bflo(w.z); o[5] = bfhi(w.z); o[6] = bflo(w.w); o[7] = bfhi(w.w); }
__device__ __forceinline__ void phase_scan(const Ctx& C) {
    PHASE_IDS
    const unsigned char* LB = wsl + WS_LA; const float* spl = (const float*)(wsl + WS_CTL + CT_SPL); const bf16_t* GY = (const bf16_t*)(wsl + WS_GY);
    bf16_t* HF = (bf16_t*)(wsl + WS_HF); bf16_t* Gout = (bf16_t*)(wsl + WS_G);
    LAS float* agg = (LAS float*)C.lds;
    const int w = wave, oct = lane >> 4, p = lane & 15;
    for (int it0 = (C.G == 256 ? C.gc : C.bid); it0 < NB * 32; it0 += C.G) {
        const int item = (C.G == 256) ? (((it0 >> 3) >> 2) << 5) + ((it0 & 7) << 2) + ((it0 >> 3) & 3) : it0;
        const int b = item >> 5, g = item & 31;
        for (int dir = 0; dir < 2; ++dir) {
            const unsigned char* lb = LB + (((size_t)dir * 32 + g) * MPAD) * 64 + 16 * oct;
            float cs[8];
            { const f32x4 p0 = *(const f32x4*)(spl + dir * 1024 + 32 * g + 8 * oct), p1 = *(const f32x4*)(spl + dir * 1024 + 32 * g + 8 * oct + 4);
#pragma unroll
              for (int c = 0; c < 4; ++c) { cs[c] = p0[c] * (-1.0f / 256.0f); cs[4 + c] = p1[c] * (-1.0f / 256.0f); } }
            float S[8];
#pragma unroll
            for (int c = 0; c < 8; ++c) S[c] = 0.f;
            {
                const int u = p, s = dir ? LSEQ - 1 - u : u, row = seqrow(b, s);
                float a[8], x[8]; { const u32x4 rec = *(const u32x4*)(lb + (size_t)row * 64); u32x2 t; t.x = rec.x; t.y = rec.y; unpack8_fp8(t, a); t.x = rec.z; t.y = rec.w; unpack8_fp8(t, x); }
#pragma unroll
                for (int c = 0; c < 8; ++c) { a[c] = fast_exp2(a[c] * cs[c]); x[c] *= 0.125f; }
                scan_group(a, x);
                if (w == 0) {
                    if (dir == 0) { u32x4 o; o.x = pk2(x[0], x[1]); o.y = pk2(x[2], x[3]); o.z = pk2(x[4], x[5]); o.w = pk2(x[6], x[7]); *(u32x4*)(HF + ((size_t)g * MPAD + row) * 32 + 8 * oct) = o; }
                    else { float hf[8], gy[8]; unpack8(*(const u32x4*)(HF + ((size_t)g * MPAD + row) * 32 + 8 * oct), hf); unpack8(*(const u32x4*)(GY + ((size_t)g * MPAD + row) * 32 + 8 * oct), gy);
                        u32x4 o; o.x = pk2((hf[0] + x[0]) * gy[0], (hf[1] + x[1]) * gy[1]); o.y = pk2((hf[2] + x[2]) * gy[2], (hf[3] + x[3]) * gy[3]);
                        o.z = pk2((hf[4] + x[4]) * gy[4], (hf[5] + x[5]) * gy[5]); o.w = pk2((hf[6] + x[6]) * gy[6], (hf[7] + x[7]) * gy[7]);
                        *(u32x4*)(Gout + (size_t)row * D + 32 * g + 8 * oct) = o; }
                }
#pragma unroll
                for (int c = 0; c < 8; ++c) S[c] = __shfl(x[c], (lane & 48) | 15);
            }
            u32x4 na[4];
#pragma unroll
            for (int j = 0; j < 4; ++j) { const int u = 16 + 64 * w + 16 * j + p, s = dir ? LSEQ - 1 - u : u; const int rw = seqrow(b, s);
                na[j] = __builtin_nontemporal_load((const u32x4*)(lb + (size_t)rw * 64)); }
            for (int r = 0; r < 8; ++r) {
                float Pw[4][8], Hw[4][8]; int rows[4];
                float Aw[8], Hc[8];
#pragma unroll
                for (int c = 0; c < 8; ++c) { Aw[c] = 1.f; Hc[c] = 0.f; }
                u32x4 ra[4], rhf[4], rgy[4];
#pragma unroll
                for (int j = 0; j < 4; ++j) { const int u = 16 + 512 * r + 64 * w + 16 * j + p, s = dir ? LSEQ - 1 - u : u; rows[j] = seqrow(b, s); ra[j] = na[j]; }
                if (r < 7) {
#pragma unroll
                    for (int j = 0; j < 4; ++j) { const int u = 16 + 512 * (r + 1) + 64 * w + 16 * j + p, s = dir ? LSEQ - 1 - u : u; const int rw = seqrow(b, s);
                        na[j] = __builtin_nontemporal_load((const u32x4*)(lb + (size_t)rw * 64)); } }
                if (dir == 1) {
#pragma unroll
                    for (int j = 0; j < 4; ++j) { const size_t go = ((size_t)g * MPAD + rows[j]) * 32 + 8 * oct; rhf[j] = *(const u32x4*)(HF + go); rgy[j] = __builtin_nontemporal_load((const u32x4*)(GY + go)); } }
#pragma unroll
                for (int j = 0; j < 4; ++j) {
                    float a[8], x[8]; { u32x2 t; t.x = ra[j].x; t.y = ra[j].y; unpack8_fp8(t, a); t.x = ra[j].z; t.y = ra[j].w; unpack8_fp8(t, x); }
#pragma unroll
                    for (int c = 0; c < 8; ++c) { a[c] = fast_exp2(a[c] * cs[c]); x[c] *= 0.125f; }
                    scan_group(a, x);
#pragma unroll
                    for (int c = 0; c < 8; ++c) { Hw[j][c] = a[c] * Hc[c] + x[c]; Pw[j][c] = a[c] * Aw[c]; }
#pragma unroll
                    for (int c = 0; c < 8; ++c) { Aw[c] = __shfl(Pw[j][c], (lane & 48) | 15); Hc[c] = __shfl(Hw[j][c], (lane & 48) | 15); }
                }
                LAS float* ag = agg + (r & 1) * 512;
                if (p == 0) {
#pragma unroll
                    for (int c = 0; c < 8; ++c) { ag[(w * 32 + oct * 8 + c) * 2] = Aw[c]; ag[(w * 32 + oct * 8 + c) * 2 + 1] = Hc[c]; }
                }
                __syncthreads();
                float Sin[8];
#pragma unroll
                for (int c = 0; c < 8; ++c) Sin[c] = S[c];
#pragma unroll
                for (int ww = 0; ww < 8; ++ww) {
#pragma unroll
                    for (int c = 0; c < 8; ++c) { const float A = ag[(ww * 32 + oct * 8 + c) * 2], H = ag[(ww * 32 + oct * 8 + c) * 2 + 1];
                        if (ww == w) Sin[c] = S[c];
                        S[c] = A * S[c] + H; }
                }
#pragma unroll
                for (int j = 0; j < 4; ++j) {
                    float h[8];
#pragma unroll
                    for (int c = 0; c < 8; ++c) h[c] = Pw[j][c] * Sin[c] + Hw[j][c];
                    const size_t go = ((size_t)g * MPAD + rows[j]) * 32 + 8 * oct;
                    if (dir == 0) { u32x4 o; o.x = pk2(h[0], h[1]); o.y = pk2(h[2], h[3]); o.z = pk2(h[4], h[5]); o.w = pk2(h[6], h[7]); *(u32x4*)(HF + go) = o; }
                    else { float hf[8], gy[8]; unpack8(rhf[j], hf); unpack8(rgy[j], gy);
                        u32x4 o; o.x = pk2((hf[0] + h[0]) * gy[0], (hf[1] + h[1]) * gy[1]); o.y = pk2((hf[2] + h[2]) * gy[2], (hf[3] + h[3]) * gy[3]);
                        o.z = pk2((hf[4] + h[4]) * gy[4], (hf[5] + h[5]) * gy[5]); o.w = pk2((hf[6] + h[6]) * gy[6], (hf[7] + h[7]) * gy[7]);
                        *(u32x4*)(Gout + (size_t)rows[j] * D + 32 * g + 8 * oct) = o; }
                }
            }
            __syncthreads();
        }
    }
}

template <int K> __device__ __forceinline__ f32x4 mini_mma(const bf16_t* W, int ldw, const bf16_t* A, int lda, int lane) {
    const bf16_t* wp = W + (size_t)(lane & 15) * ldw + 8 * (lane >> 4); const bf16_t* ap = A + (size_t)(lane & 15) * lda + 8 * (lane >> 4);
    f32x4 acc = {0.f, 0.f, 0.f, 0.f};
    constexpr int KB = K < 512 ? K : 512, NS = KB / 32;
#pragma unroll 1
    for (int k0 = 0; k0 < K; k0 += KB) { bf16x8 wf[NS], af[NS];
#pragma unroll
        for (int i = 0; i < NS; ++i) { wf[i] = *(const bf16x8*)(wp + k0 + 32 * i); af[i] = *(const bf16x8*)(ap + k0 + 32 * i); }
#pragma unroll
        for (int i = 0; i < NS; ++i) acc = __builtin_amdgcn_mfma_f32_16x16x32_bf16(wf[i], af[i], acc, 0, 0, 0); }
    return acc;
}
__device__ __forceinline__ void mini_win(const Ctx& C) {
    PHASE_IDS
    const bf16_t* HB = (const bf16_t*)(C.ws + WS_HB); const bf16_t* WT = (const bf16_t*)(C.ws + WS_WIN); bf16_t* XR = (bf16_t*)(C.ws + WS_XR); bf16_t* GY = (bf16_t*)(C.ws + WS_GY);
    const int fr = lane & 15, fq = lane >> 4;
    for (int wt = C.gc * NWAVES + wave; wt < 8 * 128; wt += C.G * NWAVES) { const int rg = wt & 7, cb = wt >> 3, row = NGRID + 16 * rg + fr, c = 16 * cb + 4 * fq;
        const f32x4 a = mini_mma<1024>(WT + (size_t)(16 * cb) * 1024, 1024, HB + (size_t)(NGRID + 16 * rg) * 1024, 1024, lane);
        if (c < 1024) { u32x2 w; w.x = cvt_pk_bf16(a[0], a[1]); w.y = cvt_pk_bf16(a[2], a[3]); *(u32x2*)(XR + (size_t)row * D + c) = w; }
        else { const int yc = c - 1024; float o[4];
#pragma unroll
            for (int j = 0; j < 4; ++j) { const float v = a[j]; const float z = 1.5957691216f * (v + 0.044715f * v * v * v); o[j] = v * sigmoidf_(z); }
            u32x2 w; w.x = cvt_pk_bf16(o[0], o[1]); w.y = cvt_pk_bf16(o[2], o[3]); *(u32x2*)(GY + ((size_t)(yc >> 5) * MPAD + row) * 32 + (yc & 31)) = w; } }
}
__device__ __forceinline__ void mini_gate(const Ctx& C) {
    PHASE_IDS
    const bf16_t* XC = (const bf16_t*)(C.ws + WS_XC); const bf16_t* GT = (const bf16_t*)(C.ws + WS_GATE); unsigned char* LB = C.ws + WS_LA;
    const float* ba = C.in[I_BA]; const float* bx = C.in[I_BX]; const float* spl = (const float*)(C.ws + WS_CTL + CT_SPL);
    const int fr = lane & 15, fq = lane >> 4;
    for (int wt = C.gc * NWAVES + wave; wt < 8 * 2 * 64; wt += C.G * NWAVES) { const int rg = wt & 7, dir = (wt >> 3) & 1, chg = wt >> 4, ch0 = 16 * chg, nb = ch0 >> 8, half = (ch0 >> 7) & 1, jj0 = ch0 & 127;
        const bf16_t* A = XC + (size_t)(NGRID + 16 * rg) * 1024 + 256 * nb; const bf16_t* Wa = GT + ((size_t)nb * 1024 + 256 * (2 * dir + half) + jj0) * 256;
        const f32x4 za = mini_mma<256>(Wa, 256, A, 1024, lane), zx = mini_mma<256>(Wa + 128 * 256, 256, A, 1024, lane);
        const int row = NGRID + 16 * rg + fr, ch = ch0 + 4 * fq;
        const f32x4 cba = *(const f32x4*)(ba + dir * 1024 + ch), cbx = *(const f32x4*)(bx + dir * 1024 + ch), csp = *(const f32x4*)(spl + dir * 1024 + ch);
        const u32x2 xw = *(const u32x2*)(XC + (size_t)row * D + ch); const float xc[4] = {bflo(xw.x), bfhi(xw.x), bflo(xw.y), bfhi(xw.y)};
        float sg[4], bb[4];
#pragma unroll
        for (int j = 0; j < 4; ++j) { const float sga = sigmoidf_(za[j] + cba[j]); const float a2 = fast_exp2(-2.0f * csp[j] * sga);
            const float mult = (dir == 0 && fr == 0) ? 8.0f : 8.0f * __builtin_amdgcn_sqrtf(fmaxf(1.0f - a2, 0.0f));
            sg[j] = sga * 256.0f; bb[j] = __builtin_amdgcn_fmed3f(mult * sigmoidf_(zx[j] + cbx[j]) * xc[j], -448.0f, 448.0f); }
        unsigned char* o = LB + (((size_t)dir * 32 + (ch >> 5)) * MPAD + row) * 64 + 16 * ((ch & 31) >> 3) + (ch & 7);
        *(unsigned*)o = pk4_fp8(sg[0], sg[1], sg[2], sg[3]); *(unsigned*)(o + 8) = pk4_fp8(bb[0], bb[1], bb[2], bb[3]); }
}
__device__ __forceinline__ void mini_lout(const Ctx& C) {
    PHASE_IDS
    const bf16_t* G = (const bf16_t*)(C.ws + WS_G); const bf16_t* WT = (const bf16_t*)(C.ws + WS_LOUT); bf16_t* PRE = (bf16_t*)(C.ws + WS_PRE); const float* meta = C.in[I_META];
    const int fr = lane & 15, fq = lane >> 4;
    for (int wt = C.gc * NWAVES + wave; wt < 8 * 64; wt += C.G * NWAVES) { const int rg = wt & 7, cb = wt >> 3, row = NGRID + 16 * rg + fr, c = 16 * cb + 4 * fq;
        const f32x4 a = mini_mma<1024>(WT + (size_t)(16 * cb) * 1024, 1024, G + (size_t)(NGRID + 16 * rg) * 1024, 1024, lane);
        const f32x4 r = *(const f32x4*)(meta + (size_t)fr * D + c);
        u32x2 w; w.x = cvt_pk_bf16(r[0] * DN_ALPHA + a[0], r[1] * DN_ALPHA + a[1]); w.y = cvt_pk_bf16(r[2] * DN_ALPHA + a[2], r[3] * DN_ALPHA + a[3]); *(u32x2*)(PRE + (size_t)row * D + c) = w; }
}
__device__ __forceinline__ void mini_kv(const Ctx& C) {
    PHASE_IDS
    const bf16_t* HB = (const bf16_t*)(C.ws + WS_HB); const bf16_t* WT = (const bf16_t*)(C.ws + WS_QKV); bf16_t* Kx = (bf16_t*)(C.ws + WS_K); bf16_t* VT = (bf16_t*)(C.ws + WS_VT);
    const int fr = lane & 15, fq = lane >> 4;
    for (int wt = C.gc * NWAVES + wave; wt < 2 * 8 * 64; wt += C.G * NWAVES) { const int rg = wt & 7, cb = (wt >> 3) & 63, isv = wt >> 9;
        const bf16_t* A = HB + (size_t)(NGRID + 16 * rg) * 1024;
        if (!isv) { const f32x4 a = mini_mma<1024>(WT + (size_t)(1024 + 16 * cb) * 1024, 1024, A, 1024, lane);
            u32x2 w; w.x = cvt_pk_bf16(a[0], a[1]); w.y = cvt_pk_bf16(a[2], a[3]); *(u32x2*)(Kx + (size_t)(NGRID + 16 * rg + fr) * D + 16 * cb + 4 * fq) = w; }
        else { const f32x4 a = mini_mma<1024>(A, 1024, WT + (size_t)(2048 + 16 * cb) * 1024, 1024, lane);
            u32x2 w; w.x = cvt_pk_bf16(a[0], a[1]); w.y = cvt_pk_bf16(a[2], a[3]); *(u32x2*)(VT + (size_t)(16 * cb + fr) * MPAD + NGRID + 16 * rg + 4 * fq) = w; } }
}

constexpr int RW_PITCH = 2080;
__device__ __forceinline__ void phase_lnr(const Ctx& C, int layer, int nrows) {
    PHASE_IDS
    const bf16_t* PRE = (const bf16_t*)(wsl + WS_PRE); bf16_t* HB = (bf16_t*)(wsl + WS_HB); unsigned char* HB8 = wsl + WS_HB8;
    const float* lg = C.in[I_LNMG] + layer * D; const float* lb = C.in[I_LNMB] + layer * D;
    const float* rw = C.in[I_RW] + (size_t)layer * D * NEXP; const float* rb = C.in[I_RB] + layer * NEXP;
    int* eid = (int*)(wsl + WS_CTL + CT_EID) + (size_t)layer * NTOK * 4; float* gatev = (float*)(wsl + WS_CTL + CT_GATEV) + (size_t)layer * NTOK * 4;
    unsigned* bc = (unsigned*)(wsl + WS_CTL + CT_BC) + ((size_t)layer * 256 + C.bid) * 32;
    LAS unsigned char* RWt = C.lds; LAS unsigned char* rowb = C.lds + 32 * RW_PITCH + wave * (4 * RW_PITCH);
    LAS float* lgt = (LAS float*)(C.lds + 32 * RW_PITCH + NWAVES * 4 * RW_PITCH) + wave * 128; LAS unsigned* hist = (LAS unsigned*)(C.lds + 32 * RW_PITCH + NWAVES * 4 * RW_PITCH + NWAVES * 512);
#pragma unroll
    for (int i = 0; i < 8; ++i) { const int idx = tid + NTHREADS * i, pc = idx >> 3, e4 = (idx & 7) * 4, ch = 2 * pc;
        const f32x4 w0 = *(const f32x4*)(rw + (size_t)ch * NEXP + e4), w1 = *(const f32x4*)(rw + (size_t)(ch + 1) * NEXP + e4);
#pragma unroll
        for (int q = 0; q < 4; ++q) *(LAS unsigned*)(RWt + (e4 + q) * RW_PITCH + pc * 4) = pk2(w0[q], w1[q]); }
    if (tid < 32) hist[tid] = 0u;
    __syncthreads();
    float gg[2][8], gb[2][8];
#pragma unroll
    for (int j = 0; j < 2; ++j) { const f32x4 a0 = *(const f32x4*)(lg + 8 * lane + 512 * j), a1 = *(const f32x4*)(lg + 8 * lane + 512 * j + 4), b0 = *(const f32x4*)(lb + 8 * lane + 512 * j), b1 = *(const f32x4*)(lb + 8 * lane + 512 * j + 4);
#pragma unroll
        for (int i = 0; i < 4; ++i) { gg[j][i] = a0[i]; gg[j][4 + i] = a1[i]; gb[j][i] = b0[i]; gb[j][4 + i] = b1[i]; } }
    const float rbias = rb[lane >> 1];
    const int gw = C.bid * NWAVES + wave, NGW = C.G * NWAVES;
    const int nmine = gw < nrows ? (nrows - gw + NGW - 1) / NGW : 0;
    u32x4 nv[2];
    if (nmine > 0) {
#pragma unroll
        for (int j = 0; j < 2; ++j) nv[j] = __builtin_nontemporal_load((const u32x4*)(PRE + (size_t)gw * D + 8 * lane + 512 * j)); }
    const int fr = lane & 15, fq = lane >> 4;
    for (int i0 = 0; i0 < nmine; i0 += 4) {
#pragma unroll
        for (int ii = 0; ii < 4; ++ii) if (i0 + ii < nmine) {
            const int row = gw + NGW * (i0 + ii);
            float v[2][8]; float s = 0.f;
#pragma unroll
            for (int j = 0; j < 2; ++j) { unpack8(nv[j], v[j]); s += ((v[j][0] + v[j][1]) + (v[j][2] + v[j][3])) + ((v[j][4] + v[j][5]) + (v[j][6] + v[j][7])); }
            if (i0 + ii + 1 < nmine) {
#pragma unroll
                for (int j = 0; j < 2; ++j) nv[j] = __builtin_nontemporal_load((const u32x4*)(PRE + (size_t)(row + NGW) * D + 8 * lane + 512 * j)); }
            const float mean = wave_sum_dpp(s) * (1.0f / D); float q = 0.f;
#pragma unroll
            for (int j = 0; j < 2; ++j)
#pragma unroll
                for (int i = 0; i < 8; ++i) { v[j][i] -= mean; q += v[j][i] * v[j][i]; }
            const float rstd = __builtin_amdgcn_rsqf(wave_sum_dpp(q) * (1.0f / D) + LN_EPS);
#pragma unroll
            for (int j = 0; j < 2; ++j) {
#pragma unroll
                for (int i = 0; i < 8; ++i) v[j][i] = v[j][i] * rstd * gg[j][i] + gb[j][i];
                u32x4 w; w.x = pk2(v[j][0], v[j][1]); w.y = pk2(v[j][2], v[j][3]); w.z = pk2(v[j][4], v[j][5]); w.w = pk2(v[j][6], v[j][7]);
                *(u32x4*)(HB + (size_t)row * D + 8 * lane + 512 * j) = w;
                *(LAS u32x4*)(rowb + ii * RW_PITCH + 16 * lane + 1024 * j) = w;
                u32x2 w8; w8.x = pk4_fp8(v[j][0], v[j][1], v[j][2], v[j][3]); w8.y = pk4_fp8(v[j][4], v[j][5], v[j][6], v[j][7]);
                *(u32x2*)(HB8 + (size_t)row * D + 8 * lane + 512 * j) = w8; }
        }
        asm volatile("s_waitcnt lgkmcnt(0)" ::: "memory");
        f32x4 l0 = {0.f, 0.f, 0.f, 0.f}, l1 = {0.f, 0.f, 0.f, 0.f};
        { const LAS unsigned char* ap = RWt + fr * RW_PITCH + 16 * fq; const LAS unsigned char* bp = rowb + (fr & 3) * RW_PITCH + 16 * fq;
#pragma unroll
          for (int ks = 0; ks < 32; ++ks) { const bf16x8 b = *(const LAS bf16x8*)(bp + 64 * ks), a0 = *(const LAS bf16x8*)(ap + 64 * ks), a1 = *(const LAS bf16x8*)(ap + 16 * RW_PITCH + 64 * ks);
              l0 = __builtin_amdgcn_mfma_f32_16x16x32_bf16(a0, b, l0, 0, 0, 0); l1 = __builtin_amdgcn_mfma_f32_16x16x32_bf16(a1, b, l1, 0, 0, 0); } }
        if (fr < 4) { *(LAS f32x4*)(lgt + fr * 32 + 4 * fq) = l0; *(LAS f32x4*)(lgt + fr * 32 + 16 + 4 * fq) = l1; }
        asm volatile("s_waitcnt lgkmcnt(0)" ::: "memory");
#pragma unroll
        for (int ii = 0; ii < 4; ++ii) if (i0 + ii < nmine) {
            const int row = gw + NGW * (i0 + ii);
            float lv = lgt[ii * 32 + (lane >> 1)] + rbias; lv = (lv == lv) ? lv : -3.0e38f;
            const int le = lane >> 1;
            int rank = 0;
#pragma unroll
            for (int j = 0; j < 32; ++j) { const float lj = readlane_f(lv, 2 * j); rank += (lj > lv || (lj == lv && j < le)) ? 1 : 0; }
            const unsigned long long m0 = __ballot(rank == 0);
            const float mxl = readlane_f(lv, (int)__builtin_ctzll(m0));
            const float pe = rank < 4 ? __expf(lv - mxl) : 0.f;
            const float den = wave_sum_dpp(pe) * 0.5f;
            if (rank < 4 && (lane & 1) == 0) { eid[(size_t)row * 4 + rank] = le; gatev[(size_t)row * 4 + rank] = pe / den;
                __hip_atomic_fetch_add(&hist[le], 1u, __ATOMIC_RELAXED, __HIP_MEMORY_SCOPE_WORKGROUP); }
        }
        asm volatile("s_waitcnt lgkmcnt(0)" ::: "memory");
    }
    __syncthreads();
    if (tid < 32) bc[tid] = hist[tid];
}

__device__ __forceinline__ void phase_pos(const Ctx& C, int layer, int nrows) {
    PHASE_IDS
    const unsigned* bcAll = (const unsigned*)(wsl + WS_CTL + CT_BC) + (size_t)layer * 256 * 32;
    const int* eid = (const int*)(wsl + WS_CTL + CT_EID) + (size_t)layer * NTOK * 4; int* posv = (int*)(wsl + WS_CTL + CT_POS) + (size_t)layer * NTOK * 4;
    int* texp = (int*)(wsl + WS_CTL + CT_TEXP) + layer * 1024;
    int* tokoff = (int*)(wsl + WS_TOK) + (size_t)layer * (1 * MiB / 4);
    LAS unsigned* partT = (LAS unsigned*)C.lds; LAS unsigned* partP = partT + 512; LAS unsigned* tot = partP + 512; LAS unsigned* cnt = tot + 32;
    { const int e = tid & 31, part = tid >> 5; unsigned t = 0, pr = 0;
      unsigned vv[16];
#pragma unroll
      for (int i = 0; i < 16; ++i) { const int bq = part + 16 * i; vv[i] = bq < C.G ? bcAll[(size_t)bq * 32 + e] : 0u; }
#pragma unroll
      for (int i = 0; i < 16; ++i) { const int bq = part + 16 * i; t += vv[i]; if (bq < C.bid) pr += vv[i]; }
      partT[part * 32 + e] = t; partP[part * 32 + e] = pr; }
    __syncthreads();
    if (tid < 32) { unsigned t = 0, pr = 0; for (int i = 0; i < 16; ++i) { t += partT[i * 32 + tid]; pr += partP[i * 32 + tid]; } tot[tid] = t; cnt[tid] = pr; }
    __syncthreads();
    if (tid < 32) { unsigned off = 0; for (int e = 0; e < tid; ++e) off += (tot[e] + 255u) & ~255u;
        const unsigned mine = (tot[tid] + 255u) & ~255u;
        if (C.bid == 0) { for (unsigned t = off >> 8; t < ((off + mine) >> 8); ++t) texp[t] = tid; if (tid == 31) texp[1023] = (int)((off + mine) >> 8);
            for (unsigned p = off + tot[tid]; p < off + mine; ++p) tokoff[p] = 0; }
        cnt[tid] += off; }
    __syncthreads();
    const int gw = C.bid * NWAVES + wave, NGW = C.G * NWAVES;
    for (int row = gw; row < nrows; row += NGW) {
        int pos = 0;
        if (lane < 4) { const int e = eid[(size_t)row * 4 + lane]; pos = (int)__hip_atomic_fetch_add(&cnt[e], 1u, __ATOMIC_RELAXED, __HIP_MEMORY_SCOPE_WORKGROUP); posv[(size_t)row * 4 + lane] = pos; }
        if (lane < 4) tokoff[pos] = row * 1024;
    }
}

__device__ __forceinline__ void phase_combine(const Ctx& C, int layer, int nrows, bool final_out) {
    PHASE_IDS
    bf16_t* HB = (bf16_t*)(wsl + WS_HB); unsigned char* HB8 = wsl + WS_HB8; const unsigned char* YS = wsl + WS_YS;
    const float* lg = C.in[I_LNFG] + layer * D; const float* lb = C.in[I_LNFB] + layer * D;
    const float* gatev = (const float*)(wsl + WS_CTL + CT_GATEV) + (size_t)layer * NTOK * 4; const int* posv = (const int*)(wsl + WS_CTL + CT_POS) + (size_t)layer * NTOK * 4;
    float gg[2][8], gb[2][8];
#pragma unroll
    for (int j = 0; j < 2; ++j) { const f32x4 a0 = *(const f32x4*)(lg + 8 * lane + 512 * j), a1 = *(const f32x4*)(lg + 8 * lane + 512 * j + 4), b0 = *(const f32x4*)(lb + 8 * lane + 512 * j), b1 = *(const f32x4*)(lb + 8 * lane + 512 * j + 4);
#pragma unroll
        for (int i = 0; i < 4; ++i) { gg[j][i] = a0[i]; gg[j][4 + i] = a1[i]; gb[j][i] = b0[i]; gb[j][4 + i] = b1[i]; } }
    const int gw = C.bid * NWAVES + wave, NGW = C.G * NWAVES;
    f32x4 g1 = {0.f, 0.f, 0.f, 0.f}, g2 = g1; int p1[4] = {0, 0, 0, 0}, p2[4] = {0, 0, 0, 0};
    u32x4 hwn[2]; u32x2 ywn[4][2];
#define CB_ROUTE(row_, gq, pq) do { gq = *(const f32x4*)(gatev + (size_t)(row_) * 4); const u32x4 _pp = *(const u32x4*)(posv + (size_t)(row_) * 4); pq[0] = (int)_pp.x; pq[1] = (int)_pp.y; pq[2] = (int)_pp.z; pq[3] = (int)_pp.w; } while (0)
#define CB_DATA(row_, pq) do { _Pragma("unroll") for (int j = 0; j < 2; ++j) { hwn[j] = *(const u32x4*)(HB + (size_t)(row_) * D + 8 * lane + 512 * j); \
            _Pragma("unroll") for (int k = 0; k < 4; ++k) ywn[k][j] = __builtin_nontemporal_load((const u32x2*)(YS + (size_t)pq[k] * D + 8 * lane + 512 * j)); } } while (0)
    if (gw < nrows) { CB_ROUTE(gw, g1, p1); CB_DATA(gw, p1); }
    if (gw + NGW < nrows) CB_ROUTE(gw + NGW, g2, p2);
    for (int row = gw; row < nrows; row += NGW) {
        const f32x4 gk4 = g1 * 0.125f; u32x4 hw[2]; u32x2 yw[4][2];
#pragma unroll
        for (int j = 0; j < 2; ++j) { hw[j] = hwn[j];
#pragma unroll
            for (int k = 0; k < 4; ++k) yw[k][j] = ywn[k][j]; }
        g1 = g2;
#pragma unroll
        for (int k = 0; k < 4; ++k) p1[k] = p2[k];
        if (row + NGW < nrows) CB_DATA(row + NGW, p1);
        if (row + 2 * NGW < nrows) CB_ROUTE(row + 2 * NGW, g2, p2);
        float v[2][8]; float s = 0.f;
#pragma unroll
        for (int j = 0; j < 2; ++j) { float h[8]; unpack8(hw[j], h);
#pragma unroll
            for (int i = 0; i < 8; ++i) v[j][i] = h[i] * DN_ALPHA;
#pragma unroll
            for (int k = 0; k < 4; ++k) { float y[8]; unpack8_fp8(yw[k][j], y);
#pragma unroll
                for (int i = 0; i < 8; ++i) v[j][i] += gk4[k] * y[i]; }
#pragma unroll
            for (int i = 0; i < 8; ++i) s += v[j][i]; }
        const float mean = wave_sum_dpp(s) * (1.0f / D); float q = 0.f;
#pragma unroll
        for (int j = 0; j < 2; ++j)
#pragma unroll
            for (int i = 0; i < 8; ++i) { v[j][i] -= mean; q += v[j][i] * v[j][i]; }
        const float rstd = __builtin_amdgcn_rsqf(wave_sum_dpp(q) * (1.0f / D) + LN_EPS);
#pragma unroll
        for (int j = 0; j < 2; ++j) {
#pragma unroll
            for (int i = 0; i < 8; ++i) v[j][i] = v[j][i] * rstd * gg[j][i] + gb[j][i];
            if (final_out) { *(f32x4*)(C.out + (size_t)row * D + 8 * lane + 512 * j) = (f32x4){v[j][0], v[j][1], v[j][2], v[j][3]}; *(f32x4*)(C.out + (size_t)row * D + 8 * lane + 512 * j + 4) = (f32x4){v[j][4], v[j][5], v[j][6], v[j][7]}; }
            else { u32x4 w; w.x = pk2(v[j][0], v[j][1]); w.y = pk2(v[j][2], v[j][3]); w.z = pk2(v[j][4], v[j][5]); w.w = pk2(v[j][6], v[j][7]); *(u32x4*)(HB + (size_t)row * D + 8 * lane + 512 * j) = w;
                u32x2 w8; w8.x = pk4_fp8(v[j][0], v[j][1], v[j][2], v[j][3]); w8.y = pk4_fp8(v[j][4], v[j][5], v[j][6], v[j][7]); *(u32x2*)(HB8 + (size_t)row * D + 8 * lane + 512 * j) = w8; } }
    }
#undef CB_ROUTE
#undef CB_DATA
}

constexpr int AT_KS = 0, AT_VTS = 73728, AT_VPITCH = 1168, AT_KM = AT_VTS + 64 * AT_VPITCH, AT_VTM = AT_KM + 2048, AT_RPB = AT_VTM + 2048, AT_MB = AT_RPB + 1920, AT_END = AT_MB + 64;
static_assert(AT_END <= LDS_BYTES, "attention LDS map");
__device__ __forceinline__ void phase_attn(const Ctx& C) {
    PHASE_IDS
    bf16_t* O = (bf16_t*)(wsl + WS_O);
    const float* rpb = C.in[I_RPB]; const float* mbias = C.in[I_MBIAS];
    LAS unsigned char* lds = C.lds;
    const int w = wave, lq = lane & 15, g = lane >> 4;
    const int qr = w >> 2, qg = w & 3, c0 = 16 * qg, kcb = qg == 0 ? 0 : (qg == 1 ? 8 : (qg == 2 ? 24 : 32));
    int bidx[2][4];
    { const int c_ = c0 + lq, cs_ = min(max(c_ - 8, 0), 48);
#pragma unroll
      for (int blk = 0; blk < 2; ++blk)
#pragma unroll
          for (int e = 0; e < 4; ++e) { const int kc = kcb + 16 * blk + 4 * g + e; bidx[blk][e] = ((kc >= cs_ && kc < cs_ + 16) ? (kc - c_ + 15) : 31) * 4; } }
    const __amdgpu_buffer_rsrc_t rsrc = __builtin_amdgcn_make_buffer_rsrc((void*)wsl, 0, 0xFFFFFFFF, 0x00020000);
    const int kvoff = (((tid >> 3) & 63) * D + 8 * (tid & 7)) * 2, vvoff = ((tid >> 3) * MPAD + 8 * (tid & 7)) * 2;
    const int qvoff = (lq * D + 8 * g) * 2;
    const int mvoff = tid < 128 ? ((tid >> 3) * D + 8 * (tid & 7)) * 2 : (((tid - 128) >> 1) * MPAD + 8 * ((tid - 128) & 1)) * 2;
    const int klds = AT_KS + ((((tid >> 3) & 63)) * 8 + ((tid & 7) ^ ((tid >> 3) & 7))) * 16;
    const int vlds = AT_VTS + (tid >> 3) * AT_VPITCH + (tid & 7) * 16;
    for (int su = (C.G == 256 ? C.gc : C.bid); su < 256; su += C.G) {
        int bh, strip; if (C.G == 256) { bh = (su & 7) * 16 + (su >> 4); strip = (su >> 3) & 1; } else { bh = su >> 1; strip = su & 1; }
        const int b = bh >> 4, h = bh & 15, rp0 = strip * 16;
        const unsigned kbase = (unsigned)WS_K + (unsigned)((b * SEQ) * D + 64 * h) * 2u, vbase = (unsigned)WS_VT + (unsigned)((64 * h) * MPAD + b * SEQ) * 2u;
        const unsigned qbase = (unsigned)WS_Q + (unsigned)((b * SEQ + qr * 64 + c0) * D + 64 * h) * 2u;
        int R0 = min(max(2 * rp0 - 4, 0), 55);
        __syncthreads();
        {
            u32x4 kreg[9], vreg[9];
#pragma unroll
            for (int i = 0; i < 9; ++i) { kreg[i] = __builtin_amdgcn_raw_buffer_load_b128(rsrc, kvoff, (int)(kbase + (unsigned)(R0 + i) * 64u * D * 2u), 0);
                vreg[i] = __builtin_amdgcn_raw_buffer_load_b128(rsrc, vvoff, (int)(vbase + (unsigned)(R0 + i) * 128u), 0); }
            u32x4 mreg = {0u, 0u, 0u, 0u};
            if (tid < 256) mreg = __builtin_amdgcn_raw_buffer_load_b128(rsrc, mvoff, (int)(tid < 128 ? (unsigned)WS_K + (unsigned)((NGRID + 16 * b) * D + 64 * h) * 2u : (unsigned)WS_VT + (unsigned)((64 * h) * MPAD + NGRID + 16 * b) * 2u), 0);
            float rpreg = 0.f, mbreg = 0.f;
            if (tid < 480) rpreg = (tid & 31) < 31 ? rpb[h * 465 + (tid >> 5) * 31 + (tid & 31)] * 1.44269504089f : -1.0e30f;
            if (tid < 16) mbreg = mbias[h * 16 + tid] * 1.44269504089f;
#pragma unroll
            for (int i = 0; i < 9; ++i) { const int slot = (R0 + i) % 9; *(LAS u32x4*)(lds + klds + slot * 8192) = kreg[i]; *(LAS u32x4*)(lds + vlds + slot * 128) = vreg[i]; }
            if (tid < 128) { const int m = tid >> 3, ch = tid & 7; *(LAS u32x4*)(lds + AT_KM + (m * 8 + (ch ^ (m & 7))) * 16) = mreg; }
            else if (tid < 256) { const int i = tid - 128, d = i >> 1, hf = i & 1; *(LAS u32x4*)(lds + AT_VTM + d * 32 + hf * 16) = mreg; }
            if (tid < 480) ((LAS float*)(lds + AT_RPB))[tid] = rpreg;
            if (tid < 16) ((LAS float*)(lds + AT_MB))[tid] = mbreg;
        }
        u32x4 qreg[2];
        qreg[0] = __builtin_amdgcn_raw_buffer_load_b128(rsrc, qvoff, (int)(qbase + (unsigned)(2 * rp0) * 64u * D * 2u), 0);
        qreg[1] = __builtin_amdgcn_raw_buffer_load_b128(rsrc, qvoff, (int)(qbase + (unsigned)(2 * rp0) * 64u * D * 2u + 64u), 0);
        __syncthreads();
        for (int rp = rp0; rp < rp0 + 16; ++rp) {
            const int R0n = rp + 1 < rp0 + 16 ? min(max(2 * (rp + 1) - 4, 0), 55) : R0, nnew = R0n - R0;
            const u32x4 qcur[2] = {qreg[0], qreg[1]};
            u32x4 nk[2], nv[2];
#pragma unroll
            for (int i = 0; i < 2; ++i) if (i < nnew) { nk[i] = __builtin_amdgcn_raw_buffer_load_b128(rsrc, kvoff, (int)(kbase + (unsigned)(R0 + 9 + i) * 64u * D * 2u), 0);
                nv[i] = __builtin_amdgcn_raw_buffer_load_b128(rsrc, vvoff, (int)(vbase + (unsigned)(R0 + 9 + i) * 128u), 0); }
            if (rp + 1 < rp0 + 16) { qreg[0] = __builtin_amdgcn_raw_buffer_load_b128(rsrc, qvoff, (int)(qbase + (unsigned)(2 * rp + 2) * 64u * D * 2u), 0);
                qreg[1] = __builtin_amdgcn_raw_buffer_load_b128(rsrc, qvoff, (int)(qbase + (unsigned)(2 * rp + 2) * 64u * D * 2u + 64u), 0); }
            const int r = 2 * rp + qr;
            const int rs = min(max(r - 4, 0), 56), s0 = rs % 9;
            const size_t qrow = (size_t)(b * SEQ + r * 64 + c0 + lq);
            bf16x8 qf[2]; qf[0] = __builtin_bit_cast(bf16x8, qcur[0]); qf[1] = __builtin_bit_cast(bf16x8, qcur[1]);
            f32x4 sc[8][2], sm;
#pragma unroll
            for (int j = 0; j < 8; ++j) { const int slot = s0 + j - (s0 + j >= 9 ? 9 : 0);
#pragma unroll
                for (int blk = 0; blk < 2; ++blk) { f32x4 a = {0.f, 0.f, 0.f, 0.f}; const int kc = kcb + 16 * blk + lq;
#pragma unroll
                    for (int ks = 0; ks < 2; ++ks) { const bf16x8 kf = *(const LAS bf16x8*)(lds + AT_KS + slot * 8192 + (kc * 8 + ((4 * ks + g) ^ (kc & 7))) * 16);
                        a = __builtin_amdgcn_mfma_f32_16x16x32_bf16(kf, qf[ks], a, 0, 0, 0); }
                    sc[j][blk] = a; } }
            { f32x4 a = {0.f, 0.f, 0.f, 0.f};
#pragma unroll
              for (int ks = 0; ks < 2; ++ks) { const bf16x8 kf = *(const LAS bf16x8*)(lds + AT_KM + (lq * 8 + ((4 * ks + g) ^ (lq & 7))) * 16);
                  a = __builtin_amdgcn_mfma_f32_16x16x32_bf16(kf, qf[ks], a, 0, 0, 0); }
              sm = a; }
            const LAS unsigned char* RProw = lds + AT_RPB + (rs - r + 7) * 128; const LAS float* MB = (const LAS float*)(lds + AT_MB);
            float mx = -3.0e38f;
#pragma unroll
            for (int j = 0; j < 8; ++j)
#pragma unroll
                for (int blk = 0; blk < 2; ++blk)
#pragma unroll
                    for (int e = 0; e < 4; ++e) { const float sv = sc[j][blk][e] + *(const LAS float*)(RProw + j * 128 + bidx[blk][e]); sc[j][blk][e] = sv; mx = fmaxf(mx, sv); }
#pragma unroll
            for (int e = 0; e < 4; ++e) { sm[e] += MB[4 * g + e]; mx = fmaxf(mx, sm[e]); }
            mx = fmaxf(mx, __shfl_xor(mx, 16)); mx = fmaxf(mx, __shfl_xor(mx, 32));
            float sum = 0.f;
#pragma unroll
            for (int j = 0; j < 8; ++j)
#pragma unroll
                for (int blk = 0; blk < 2; ++blk)
#pragma unroll
                    for (int e = 0; e < 4; ++e) { const float pv = fast_exp2(sc[j][blk][e] - mx); sc[j][blk][e] = pv; sum += pv; }
#pragma unroll
            for (int e = 0; e < 4; ++e) { const float pv = fast_exp2(sm[e] - mx); sm[e] = pv; sum += pv; }
            sum += __shfl_xor(sum, 16); sum += __shfl_xor(sum, 32);
            f32x4 o[4];
#pragma unroll
            for (int db = 0; db < 4; ++db) o[db] = (f32x4){0.f, 0.f, 0.f, 0.f};
#pragma unroll
            for (int j = 0; j < 8; ++j) { const int slot = s0 + j - (s0 + j >= 9 ? 9 : 0);
                u32x4 pw; pw.x = cvt_pk_bf16(sc[j][0][0], sc[j][0][1]); pw.y = cvt_pk_bf16(sc[j][0][2], sc[j][0][3]); pw.z = cvt_pk_bf16(sc[j][1][0], sc[j][1][1]); pw.w = cvt_pk_bf16(sc[j][1][2], sc[j][1][3]);
                const bf16x8 pb = __builtin_bit_cast(bf16x8, pw);
#pragma unroll
                for (int db = 0; db < 4; ++db) { const int d = 16 * db + lq; const LAS unsigned char* vp = lds + AT_VTS + d * AT_VPITCH + (slot * 64 + kcb + 4 * g) * 2;
                    const u32x2 lo = *(const LAS u32x2*)vp, hi = *(const LAS u32x2*)(vp + 32);
                    u32x4 aw; aw.x = lo.x; aw.y = lo.y; aw.z = hi.x; aw.w = hi.y;
                    o[db] = __builtin_amdgcn_mfma_f32_16x16x32_bf16(__builtin_bit_cast(bf16x8, aw), pb, o[db], 0, 0, 0); }
            }
            { u32x4 pw; pw.x = cvt_pk_bf16(sm[0], sm[1]); pw.y = cvt_pk_bf16(sm[2], sm[3]); pw.z = 0u; pw.w = 0u; const bf16x8 pb = __builtin_bit_cast(bf16x8, pw);
#pragma unroll
              for (int db = 0; db < 4; ++db) { const int d = 16 * db + lq; const u32x2 lo = *(const LAS u32x2*)(lds + AT_VTM + d * 32 + 8 * g);
                  u32x4 aw; aw.x = lo.x; aw.y = lo.y; aw.z = 0u; aw.w = 0u;
                  o[db] = __builtin_amdgcn_mfma_f32_16x16x32_bf16(__builtin_bit_cast(bf16x8, aw), pb, o[db], 0, 0, 0); } }
            const float inv = 1.0f / sum;
#pragma unroll
            for (int db = 0; db < 4; ++db) { u32x2 ow; ow.x = cvt_pk_bf16(o[db][0] * inv, o[db][1] * inv); ow.y = cvt_pk_bf16(o[db][2] * inv, o[db][3] * inv);
                *(u32x2*)(O + qrow * D + 64 * h + 16 * db + 4 * g) = ow; }
            __syncthreads();
#pragma unroll
            for (int i = 0; i < 2; ++i) if (i < nnew) { const int slot = (R0 + 9 + i) % 9; *(LAS u32x4*)(lds + klds + slot * 8192) = nk[i]; *(LAS u32x4*)(lds + vlds + slot * 128) = nv[i]; }
            R0 = R0n;
            __syncthreads();
        }
    }
}
#define XB_TMO      128
#define XB_XCNT(j)  (256  + 64 * (j))
#define XB_XSUB(j)  (1280 + 64 * (j))
#define XB_XGEN(j)  (2304 + 64 * (j))
#define XB_TOP      3328
#define XB_TOPGEN   3392
#define XCD_BAR_WORDS 3456
#define XB_SPIN_CAP (1u << 22)
__device__ __forceinline__ unsigned xb_ld(unsigned* p)              { return __hip_atomic_load(p, __ATOMIC_RELAXED, __HIP_MEMORY_SCOPE_AGENT); }
__device__ __forceinline__ unsigned xb_add(unsigned* p, unsigned v) { return __hip_atomic_fetch_add(p, v, __ATOMIC_RELAXED, __HIP_MEMORY_SCOPE_AGENT); }
__device__ __forceinline__ unsigned xb_xcc_id() { return (unsigned)__builtin_amdgcn_s_getreg((3 << 11) | 20) & 0xFu; }
#define XB_SPIN(cond, bar) do { unsigned _sp = 0; while (cond) { __builtin_amdgcn_s_sleep(1); \
    if ((++_sp & 255u) == 0u) { if (xb_ld(&(bar)[XB_TMO])) break; if (_sp > XB_SPIN_CAP) { atomicAdd(&(bar)[XB_TMO], 1u); break; } } } } while (0)
struct XcdBarrier { unsigned* bar; unsigned x; volatile LAS unsigned* st; };
__device__ __forceinline__ XcdBarrier xcd_barrier_post(unsigned* bar, volatile LAS unsigned* st) {
    XcdBarrier b; b.bar = bar; b.x = xb_xcc_id(); b.st = st;
    if (threadIdx.x == 0) st[2] = xb_add(&bar[XB_XCNT(b.x)], 1u);
    return b;
}
__device__ __forceinline__ void xcd_barrier_complete(unsigned* bar, unsigned x, unsigned& nloc, unsigned& nx) {
    const unsigned G = gridDim.x * gridDim.y * gridDim.z;
    unsigned sum, cnt, mine, sp = 0u;
    for (;;) {
        sum = 0u; cnt = 0u; mine = 0u;
#pragma unroll
        for (unsigned j = 0; j < 16; ++j) { const unsigned c = xb_ld(&bar[XB_XCNT(j)]); sum += c; cnt += (c > 0u) ? 1u : 0u; mine = (j == x) ? c : mine; }
        if (sum == G) break;
        __builtin_amdgcn_s_sleep(1);
        if ((++sp & 255u) == 0u) { if (xb_ld(&bar[XB_TMO])) break; if (sp > XB_SPIN_CAP) { atomicAdd(&bar[XB_TMO], 1u); break; } }
    }
    nloc = mine > 0u ? mine : 1u; nx = cnt > 0u ? cnt : 1u;
}
__device__ __forceinline__ void xcd_barrier(const XcdBarrier& b) {
    asm volatile("s_waitcnt vmcnt(0)" ::: "memory");
    __syncthreads();
    if (threadIdx.x == 0) {
        unsigned* bar = b.bar;
        __builtin_amdgcn_s_waitcnt(0);
        unsigned nloc = b.st[0], nx = b.st[1];
        if (nloc == 0u) { xcd_barrier_complete(bar, b.x, nloc, nx); b.st[0] = nloc; b.st[1] = nx; }
        const unsigned old = xb_add(&bar[XB_XSUB(b.x)], 1u);
        const unsigned gen = old / nloc;
        if (old + 1u == (gen + 1u) * nloc) {
            __builtin_amdgcn_fence(__ATOMIC_RELEASE, "agent");
            asm volatile("s_waitcnt vmcnt(0)" ::: "memory");
            const unsigned og = xb_add(&bar[XB_TOP], 1u);
            const unsigned tg = og / nx;
            if (og + 1u == (tg + 1u) * nx) xb_add(&bar[XB_TOPGEN], 1u);
            else XB_SPIN(xb_ld(&bar[XB_TOPGEN]) == tg, bar);
            __builtin_amdgcn_fence(__ATOMIC_ACQUIRE, "agent");
            xb_add(&bar[XB_XGEN(b.x)], 1u);
            asm volatile("s_waitcnt vmcnt(0)" ::: "memory");
        } else {
            XB_SPIN(xb_ld(&bar[XB_XGEN(b.x)]) == gen, bar);
            __builtin_amdgcn_fence(__ATOMIC_ACQUIRE, "agent");
            asm volatile("s_waitcnt vmcnt(0)" ::: "memory");
        }
    }
    __syncthreads();
}
__device__ __forceinline__ int moe_prep(const Ctx& C, const int* texp) {
    LAS int* t = (LAS int*)(C.lds + pg8::TEXP_OFF); const int tid = fresh_tid();
    const int a = texp[tid], b = texp[tid + 512];
    t[tid] = a; t[tid + 512] = b;
    __syncthreads();
    return __builtin_amdgcn_readfirstlane(t[1023]);
}
constexpr size_t CT_BAR = 131072;
constexpr int LDS_BARST = LDS_BYTES - 64;

constexpr int N_PHASES = 20;
__global__ void __launch_bounds__(NTHREADS, 2) hybrid_fwd(Params P) {
    extern __shared__ __attribute__((aligned(16))) unsigned char smem[];
    cg::grid_group grid = cg::this_grid();
    Ctx C; C.lds = (LAS unsigned char*)smem; C.G = gridDim.x; C.bid = blockIdx.x;
    C.ws = P.ws; C.in = P.in; C.out = P.out;
    unsigned char* const ws0 = P.ws;
#define ws fresh_ws(ws0)
    const int lo = P.ph_lo, hi = P.ph_hi;
#ifndef PH_MASK
#define PH_MASK 0xFFFFFFFFu
#endif
#define IN(k) (((PH_MASK >> (k)) & 1u) && lo <= (k) && (k) < hi)
#ifndef REPEAT_MASK
#define REPEAT_MASK 0u
#endif
#define REPS(k) ((((unsigned)REPEAT_MASK >> (k)) & 1u) ? 2 : 1)
#ifndef N_CG_SYNCS
#define N_CG_SYNCS 0
#endif
#define SEAM(k) do { if (IN(k) && IN((k) + 1)) { if ((k) < N_CG_SYNCS) grid.sync(); else xcd_barrier(bar); } } while (0)
    if (threadIdx.x < 16) ((LAS unsigned*)(smem + LDS_BARST))[threadIdx.x] = 0u;
    __syncthreads();
    const XcdBarrier bar = xcd_barrier_post((unsigned*)(ws + WS_CTL + CT_BAR), (volatile LAS unsigned*)(smem + LDS_BARST));
    C.gc = C.bid;
    #define PH_BODY_0 phase_convert(C);
    if (IN(0)) { PH_BODY_0 } if (REPS(0) > 1 && IN(0)) { xcd_barrier(bar); PH_BODY_0 }
    SEAM(0);
    if (IN(0) && IN(1)) {
        unsigned* barw = (unsigned*)(ws + WS_CTL + CT_BAR); bool eq = (C.G % 8) == 0;
#pragma unroll
        for (int j = 0; j < 16; ++j) { const unsigned cj = xb_ld(&barw[XB_XCNT(j)]); eq = eq && (cj == (j < 8 ? (unsigned)(C.G / 8) : 0u)); }
        const unsigned rank = ((volatile LAS unsigned*)(smem + LDS_BARST))[2];
        C.gc = __builtin_amdgcn_readfirstlane(eq ? (int)(rank * 8u + bar.x) : C.bid);
    }
    #define PH_BODY_1 { DenseSched S{(unsigned)WS_HB, (unsigned)WS_WIN, 1024, 1024, 128, 8, C.G, C.gc}; EpiWin E{(bf16_t*)(ws + WS_XR), (bf16_t*)(ws + WS_GY)}; \
        pg8::gemm_phase<false, false>(C.lds, ws, 1024, 1024, 1024, S, E); mini_win(C); }
    if (IN(1)) { PH_BODY_1 } if (REPS(1) > 1 && IN(1)) { xcd_barrier(bar); PH_BODY_1 }
    SEAM(1);
    #define PH_BODY_2 phase_conv(C);
    if (IN(2)) { PH_BODY_2 } if (REPS(2) > 1 && IN(2)) { xcd_barrier(bar); PH_BODY_2 }
    SEAM(2);
    #define PH_BODY_3 { GateSched S{(unsigned)WS_XC, (unsigned)WS_GATE, 128, C.G, C.gc}; \
        EpiGate E{(const bf16_t*)(ws + WS_XC), (unsigned char*)(ws + WS_LA), (const float*)(ws + WS_CTL + CT_SPL), (unsigned)WS_GBIAS}; \
        pg8::gemm_phase<false, false>(C.lds, ws, 256, 1024, 256, S, E); mini_gate(C); }
    if (IN(3)) { PH_BODY_3 } if (REPS(3) > 1 && IN(3)) { xcd_barrier(bar); PH_BODY_3 }
    SEAM(3);
    #define PH_BODY_4 phase_scan(C);
    if (IN(4)) { PH_BODY_4 } if (REPS(4) > 1 && IN(4)) { xcd_barrier(bar); PH_BODY_4 }
    SEAM(4);
    #define PH_BODY_5 { DenseSched S{(unsigned)WS_G, (unsigned)WS_LOUT, 1024, 1024, 128, 4, C.G, C.gc}; EpiRes<true> E{(bf16_t*)(ws + WS_PRE), P.in[I_X], P.in[I_META], nullptr, NTOK}; \
        pg8::gemm_phase<false, false>(C.lds, ws, 1024, 1024, 1024, S, E); mini_lout(C); }
    if (IN(5)) { PH_BODY_5 } if (REPS(5) > 1 && IN(5)) { xcd_barrier(bar); PH_BODY_5 }
    SEAM(5);
    #define PH_BODY_6 phase_lnr(C, 0, NTOK);
    if (IN(6)) { PH_BODY_6 } if (REPS(6) > 1 && IN(6)) { xcd_barrier(bar); PH_BODY_6 }
    SEAM(6);
    #define PH_BODY_7 phase_pos(C, 0, NTOK);
    if (IN(7)) { PH_BODY_7 } if (REPS(7) > 1 && IN(7)) { xcd_barrier(bar); PH_BODY_7 }
    SEAM(7);
    #define PH_BODY_8 { const int nM = moe_prep(C, (const int*)(ws + WS_CTL + CT_TEXP)); \
        MoeSched S{(unsigned)WS_HB8, (unsigned)WS_WGU, (unsigned)WS_TOK, (const LAS int*)(C.lds + pg8::TEXP_OFF), 2048u * 1024u, nM, 8, C.G, C.gc}; EpiGlu E{(unsigned char*)(ws + WS_ACT), (unsigned)WS_BIAS}; \
        pg8::gemm_phase<true, true>(C.lds, ws, 512, 512, 512, S, E); }
    if (IN(8)) { PH_BODY_8 } if (REPS(8) > 1 && IN(8)) { xcd_barrier(bar); PH_BODY_8 }
#ifdef PROBE_NULL8
    if (IN(8)) { xcd_barrier(bar); { const int nM = moe_prep(C, (const int*)(ws + WS_CTL + CT_TEXP));
        MoeSched S{(unsigned)WS_HB8, (unsigned)WS_WGU, (unsigned)WS_TOK, (const LAS int*)(C.lds + pg8::TEXP_OFF), 2048u * 1024u, nM, 8, C.G, C.gc}; EpiNull E{};
        pg8::gemm_phase<true, true>(C.lds, ws, 512, 512, 512, S, E); } }
#endif
    SEAM(8);
    #define PH_BODY_9 { const int nM = moe_prep(C, (const int*)(ws + WS_CTL + CT_TEXP)); \
        MoeSched S{(unsigned)WS_ACT, (unsigned)WS_WD, 0u, (const LAS int*)(C.lds + pg8::TEXP_OFF), 1024u * 1024u, nM, 4, C.G, C.gc}; EpiDown E{(unsigned char*)(ws + WS_YS), (unsigned)WS_BD}; \
        pg8::gemm_phase<true, false>(C.lds, ws, 512, 512, 512, S, E); }
    if (IN(9)) { PH_BODY_9 } if (REPS(9) > 1 && IN(9)) { xcd_barrier(bar); PH_BODY_9 }
    SEAM(9);
    #define PH_BODY_10 phase_combine(C, 0, NTOK, false);
    if (IN(10)) { PH_BODY_10 } if (REPS(10) > 1 && IN(10)) { xcd_barrier(bar); PH_BODY_10 }
    SEAM(10);
    #define PH_BODY_11 { QkvSched S{(unsigned)WS_HB8, (unsigned)WS_QKV8, 128, C.G, C.gc}; EpiQkv E{(bf16_t*)(ws + WS_Q), (bf16_t*)(ws + WS_K), (bf16_t*)(ws + WS_VT)}; \
        pg8::gemm_phase<true, false>(C.lds, ws, 512, 512, 512, S, E); mini_kv(C); }
    if (IN(11)) { PH_BODY_11 } if (REPS(11) > 1 && IN(11)) { xcd_barrier(bar); PH_BODY_11 }
    SEAM(11);
    #define PH_BODY_12 phase_attn(C);
    if (IN(12)) { PH_BODY_12 } if (REPS(12) > 1 && IN(12)) { xcd_barrier(bar); PH_BODY_12 }
    SEAM(12);
    #define PH_BODY_13 { DenseSched S{(unsigned)WS_O, (unsigned)WS_NOUT, 1024, 1024, 128, 4, C.G, C.gc}; EpiRes<false> E{(bf16_t*)(ws + WS_PRE), nullptr, nullptr, (const bf16_t*)(ws + WS_HB), NGRID}; \
        pg8::gemm_phase<false, false>(C.lds, ws, 1024, 1024, 1024, S, E); }
    if (IN(13)) { PH_BODY_13 } if (REPS(13) > 1 && IN(13)) { xcd_barrier(bar); PH_BODY_13 }
    SEAM(13);
    #define PH_BODY_14 phase_lnr(C, 1, NGRID);
    if (IN(14)) { PH_BODY_14 } if (REPS(14) > 1 && IN(14)) { xcd_barrier(bar); PH_BODY_14 }
    SEAM(14);
    #define PH_BODY_15 phase_pos(C, 1, NGRID);
    if (IN(15)) { PH_BODY_15 } if (REPS(15) > 1 && IN(15)) { xcd_barrier(bar); PH_BODY_15 }
    SEAM(15);
    #define PH_BODY_16 { const int nM = moe_prep(C, (const int*)(ws + WS_CTL + CT_TEXP) + 1024); \
        MoeSched S{(unsigned)WS_HB8, (unsigned)(WS_WGU + (size_t)32 * 2048 * 1024), (unsigned)(WS_TOK + 1 * MiB), (const LAS int*)(C.lds + pg8::TEXP_OFF), 2048u * 1024u, nM, 8, C.G, C.gc}; EpiGlu E{(unsigned char*)(ws + WS_ACT), (unsigned)(WS_BIAS + 32 * 2048 * 4)}; \
        pg8::gemm_phase<true, true>(C.lds, ws, 512, 512, 512, S, E); }
    if (IN(16)) { PH_BODY_16 } if (REPS(16) > 1 && IN(16)) { xcd_barrier(bar); PH_BODY_16 }
    SEAM(16);
    #define PH_BODY_17 { const int nM = moe_prep(C, (const int*)(ws + WS_CTL + CT_TEXP) + 1024); \
        MoeSched S{(unsigned)WS_ACT, (unsigned)(WS_WD + (size_t)32 * 1024 * 1024), 0u, (const LAS int*)(C.lds + pg8::TEXP_OFF), 1024u * 1024u, nM, 4, C.G, C.gc}; EpiDown E{(unsigned char*)(ws + WS_YS), (unsigned)(WS_BD + 32 * 1024 * 4)}; \
        pg8::gemm_phase<true, false>(C.lds, ws, 512, 512, 512, S, E); }
    if (IN(17)) { PH_BODY_17 } if (REPS(17) > 1 && IN(17)) { xcd_barrier(bar); PH_BODY_17 }
    SEAM(17);
    #define PH_BODY_18 phase_combine(C, 1, NGRID, true);
    if (IN(18)) { PH_BODY_18 } if (REPS(18) > 1 && IN(18)) { xcd_barrier(bar); PH_BODY_18 }
#undef ws
#undef IN
#undef SEAM
}

#ifndef MK_PER_PHASE
#define MK_PER_PHASE 0
#endif
extern "C" void kernel_launch(void* const* d_in, const int* in_sizes, int n_in, void* d_out, int out_size, void* d_ws, size_t ws_size, hipStream_t stream) {
    static int grid = 0;
    if (grid == 0) {
        if (n_in != 25 || ws_size < WS_END || out_size != NGRID * D) { fprintf(stderr, "kernel_launch: unexpected problem (n_in %d, ws %zu, out %d)\n", n_in, ws_size, out_size); grid = -1; return; }
        int dev = 0, cus = 0, per_cu = 0;
        if (hipGetDevice(&dev) != hipSuccess || hipDeviceGetAttribute(&cus, hipDeviceAttributeMultiprocessorCount, dev) != hipSuccess) { grid = -1; return; }
        if (hipFuncSetAttribute((const void*)hybrid_fwd, hipFuncAttributeMaxDynamicSharedMemorySize, LDS_BYTES) != hipSuccess) { fprintf(stderr, "kernel_launch: hipFuncSetAttribute failed\n"); grid = -1; return; }
        if (hipOccupancyMaxActiveBlocksPerMultiprocessor(&per_cu, (const void*)hybrid_fwd, NTHREADS, LDS_BYTES) != hipSuccess || per_cu < 1) { fprintf(stderr, "kernel_launch: occupancy query failed (%d)\n", per_cu); grid = -1; return; }
        grid = cus * 1;
        if (grid > 256) grid = 256;
    }
    if (grid < 0) return;
    if (hipMemsetAsync((char*)d_ws + WS_CTL + CT_BAR, 0, 16384, stream) != hipSuccess) { fprintf(stderr, "kernel_launch: memset failed\n"); return; }
    Params p{};
    for (int i = 0; i < 25; ++i) p.in[i] = (const float*)d_in[i];
    p.out = (float*)d_out; p.ws = (unsigned char*)d_ws;
#if MK_PER_PHASE
    for (int ph = 0; ph < 19; ++ph) { p.ph_lo = ph; p.ph_hi = ph + 1; void* args[] = {&p};
        hipError_t e = hipLaunchCooperativeKernel((void*)hybrid_fwd, dim3(grid), dim3(NTHREADS), args, LDS_BYTES, stream);
        if (e != hipSuccess) { fprintf(stderr, "launch phase %d failed: %s\n", ph, hipGetErrorString(e)); break; } }
#else
    p.ph_lo = 0; p.ph_hi = 19; void* args[] = {&p};
    hipError_t e = hipLaunchCooperativeKernel((void*)hybrid_fwd, dim3(grid), dim3(NTHREADS), args, LDS_BYTES, stream);
    if (e != hipSuccess) fprintf(stderr, "cooperative launch failed: %s (grid %d)\n", hipGetErrorString(e), grid);
#endif
}
```

```cpp
#include <hip/hip_runtime.h>
#include <hip/hip_cooperative_groups.h>
#include <cstdio>
#include <cstdint>
namespace cg = cooperative_groups;

#define LAS __attribute__((address_space(3)))
typedef unsigned short bf16_t;
typedef short bf16x8 __attribute__((ext_vector_type(8)));
typedef float f32x4 __attribute__((ext_vector_type(4)));
typedef float f32x2 __attribute__((ext_vector_type(2)));
typedef unsigned u32x4 __attribute__((ext_vector_type(4)));
typedef unsigned u32x2 __attribute__((ext_vector_type(2)));

constexpr int NB = 8, SEQ = 4096, D = 1024, NMETA = 16, LSEQ = SEQ + NMETA;
constexpr int NGRID = NB * SEQ;
constexpr int NTOK = NGRID + NB * NMETA;
constexpr int MPAD = 33024;
constexpr int NEXP = 32, TOPK = 4;
constexpr int PMAX = 139776;
constexpr int MTMAX = PMAX / 256;
constexpr float DN_ALPHA = 1.41421356237f;
constexpr float LN_EPS = 1e-5f;
constexpr int NTHREADS = 512, NWAVES = 8;

constexpr size_t MiB = 1u << 20;
constexpr size_t ACT_BYTES = (size_t)MPAD * D * 2;
constexpr size_t WS_CTL   = 0;
constexpr size_t WS_WIN   = 4 * MiB;
constexpr size_t WS_GATE  = WS_WIN + 4 * MiB;
constexpr size_t WS_LOUT  = WS_GATE + 2 * MiB;
constexpr size_t WS_QKV   = WS_LOUT + 2 * MiB;
constexpr size_t WS_NOUT  = WS_QKV + 6 * MiB;
constexpr size_t WS_WGU   = WS_NOUT + 2 * MiB;
constexpr size_t WS_WD    = WS_WGU + 128 * MiB;
constexpr size_t WS_HB    = WS_WD + 64 * MiB;
constexpr size_t WS_HB8   = WS_HB + 65 * MiB;
constexpr size_t WS_PRE   = WS_HB8 + 33 * MiB;
constexpr size_t WS_H     = WS_PRE + 129 * MiB;
constexpr size_t WS_SCR   = WS_H + 129 * MiB;
constexpr size_t WS_XR = WS_SCR, WS_XC = WS_XR + 65 * MiB, WS_GY = WS_XC + 65 * MiB, WS_LA = WS_GY + 65 * MiB, WS_BB = WS_LA + 130 * MiB, WS_HF = WS_BB + 130 * MiB, WS_G = WS_HF + 65 * MiB;
constexpr size_t WS_SCR_END0 = WS_G + 65 * MiB;
constexpr size_t WS_XS = WS_SCR, WS_ACT = WS_XS + 137 * MiB, WS_YS = WS_ACT + 137 * MiB;
constexpr size_t WS_SCR_END1 = WS_YS + 274 * MiB;
constexpr size_t WS_Q = WS_SCR, WS_K = WS_Q + 65 * MiB, WS_VT = WS_K + 65 * MiB, WS_O = WS_VT + 65 * MiB;
constexpr size_t WS_BIAS = (WS_SCR_END0 > WS_SCR_END1 ? WS_SCR_END0 : WS_SCR_END1);
constexpr size_t WS_BD = WS_BIAS + 2 * 32 * 2048 * 4;
constexpr size_t WS_GBIAS = WS_BD + 2 * 32 * 1024 * 4;
constexpr size_t WS_TOK = WS_BIAS + 1 * MiB;
constexpr size_t WS_QKV8 = WS_TOK + 2 * MiB;
constexpr size_t WS_END = WS_QKV8 + 3 * MiB;
static_assert((size_t)PMAX * 4 <= 1 * MiB, "token offset table");
static_assert(ACT_BYTES <= 65 * MiB && (size_t)PMAX * D * 2 <= 274 * MiB && (size_t)PMAX * D <= 137 * MiB && (size_t)MPAD * D <= 33 * MiB && (size_t)MPAD * D * 4 <= 129 * MiB, "ws map");
static_assert(WS_END <= (size_t)2040 * MiB, "ws map must fit 4x the largest input tensor");
constexpr size_t CT_BC      = 4096;
constexpr size_t CT_TEXP    = CT_BC + 2 * 256 * 32 * 4;
constexpr size_t CT_SPL     = CT_TEXP + 2 * 1024 * 4;
constexpr size_t CT_EID     = 256 * 1024;
constexpr size_t CT_GATEV   = CT_EID + 2 * (size_t)NTOK * 4 * 4;
constexpr size_t CT_POS     = CT_GATEV + 2 * (size_t)NTOK * 4 * 4;
static_assert(CT_POS + 2 * (size_t)NTOK * 4 * 4 <= 4 * MiB, "ctl map");

constexpr int LDS_BYTES = 155648;

__device__ __forceinline__ unsigned f2bf(float f) { unsigned u = __builtin_bit_cast(unsigned, f); return (u + 0x7fffu + ((u >> 16) & 1u)) >> 16; }
__device__ __forceinline__ unsigned cvt_pk_bf16(float lo, float hi);
__device__ __forceinline__ unsigned pk2(float lo, float hi) { return cvt_pk_bf16(lo, hi); }
typedef __bf16 bf16x2_t __attribute__((ext_vector_type(2)));
__device__ __forceinline__ unsigned cvt_pk_bf16(float lo, float hi) { const f32x2 v = {lo, hi}; return __builtin_bit_cast(unsigned, __builtin_convertvector(v, bf16x2_t)); }
__device__ __forceinline__ unsigned pk4_fp8(float a, float b, float c, float d) { int w = __builtin_amdgcn_cvt_pk_fp8_f32(a, b, 0, false); w = __builtin_amdgcn_cvt_pk_fp8_f32(c, d, w, true); return (unsigned)w; }
__device__ __forceinline__ float dot2_bf16(unsigned a, unsigned b, float c) { return __builtin_amdgcn_fdot2_f32_bf16(__builtin_bit_cast(bf16x2_t, a), __builtin_bit_cast(bf16x2_t, b), c, false); }
__device__ __forceinline__ void unpack8_fp8(const u32x2 w, float (&o)[8]) { const f32x2 a = __builtin_amdgcn_cvt_pk_f32_fp8((int)w.x, false), b = __builtin_amdgcn_cvt_pk_f32_fp8((int)w.x, true), c = __builtin_amdgcn_cvt_pk_f32_fp8((int)w.y, false), d = __builtin_amdgcn_cvt_pk_f32_fp8((int)w.y, true);
    o[0] = a.x; o[1] = a.y; o[2] = b.x; o[3] = b.y; o[4] = c.x; o[5] = c.y; o[6] = d.x; o[7] = d.y; }
__device__ __forceinline__ float bflo(unsigned w) { return __builtin_bit_cast(float, w << 16); }
__device__ __forceinline__ float bfhi(unsigned w) { return __builtin_bit_cast(float, w & 0xffff0000u); }
__device__ __forceinline__ void unpack8(const u32x4 w, float (&o)[8]);
__device__ __forceinline__ float fast_exp2(float x) { return __builtin_amdgcn_exp2f(x); }
__device__ __forceinline__ float fast_rcp(float x) { return __builtin_amdgcn_rcpf(x); }
__device__ __forceinline__ float sigmoidf_(float x) { return fast_rcp(1.0f + fast_exp2(-1.44269504089f * x)); }
__device__ __forceinline__ float wave_sum(float v) {
#pragma unroll
    for (int o = 1; o < 64; o <<= 1) v += __shfl_xor(v, o);
    return v;
}
template <int CTRL> __device__ __forceinline__ float dpp_movf(float v) { return __builtin_bit_cast(float, __builtin_amdgcn_update_dpp(0, __builtin_bit_cast(int, v), CTRL, 0xf, 0xf, true)); }
__device__ __forceinline__ float readlane_f(float v, int l) { return __builtin_bit_cast(float, __builtin_amdgcn_readlane(__builtin_bit_cast(int, v), l)); }
__device__ __forceinline__ float wave_sum_dpp(float v) {
    v += dpp_movf<0xB1>(v);
    v += dpp_movf<0x4E>(v);
    v += dpp_movf<0x141>(v);
    v += dpp_movf<0x140>(v);
    return (readlane_f(v, 0) + readlane_f(v, 16)) + (readlane_f(v, 32) + readlane_f(v, 48));
}
__device__ __forceinline__ int seqrow(int b, int s) { return s < NMETA ? NGRID + NMETA * b + s : SEQ * b + (s - NMETA); }

struct Params {
    const float* in[25];
    float* out;
    unsigned char* ws;
    int ph_lo, ph_hi;
};
struct Ctx {
    LAS unsigned char* lds;
    int G, bid, gc;
    unsigned char* ws;
    const float* const* in;
    float* out;
};
__device__ __forceinline__ int fresh_tid() { int t = threadIdx.x; asm volatile("" : "+v"(t)); return t; }
__device__ __forceinline__ unsigned char* fresh_ws(unsigned char* p) { asm volatile("" : "+s"(p)); return p; }
#define PHASE_IDS unsigned char* const wsl = fresh_ws(C.ws); (void)wsl; const int tid = fresh_tid(); const int lane = tid & 63; const int wave = __builtin_amdgcn_readfirstlane(tid >> 6); (void)lane; (void)wave;
enum { I_X = 0, I_META, I_WIN, I_CONVW, I_CONVB, I_WA, I_BA, I_WX, I_BX, I_LAM, I_LOUT, I_WQKV, I_RPB, I_MBIAS, I_NOUT, I_LNMG, I_LNMB, I_RW, I_RB, I_WGU, I_BGU, I_WD, I_BD, I_LNFG, I_LNFB };

namespace pg8 {
constexpr int BM = 256, BK = 64, HALF = 128, HTB = HALF * BK * 2, STAGE_BYTES = 8 * HTB, NXCD = 8, WGM = 8;
constexpr int SIDE_OFF = STAGE_BYTES, TEXP_OFF = STAGE_BYTES + 2048, TOK_OFF = STAGE_BYTES + 2048 + 4096;
__device__ __forceinline__ int lds_byte(int r, int c) { const int st = (r >> 4) * 2 + (c >> 5), rr = r & 15, cc = c & 31, ob = rr * 64 + cc * 2; return st * 1024 + (ob ^ (((ob >> 9) & 1) << 5)); }
__device__ __forceinline__ void stage_rc(int b, int& R, int& C) { const int st = b / 1024, sb = b % 1024, swz = sb ^ (((sb >> 9) & 1) << 5); R = (st >> 1) * 16 + swz / 64; C = (st & 1) * 32 + (swz % 64) / 2; }
__device__ __forceinline__ int perm32(int rho) { const int n = rho >> 4, i = rho & 15; return 8 * (i >> 2) + 4 * n + (i & 3); }

typedef int v8i __attribute__((ext_vector_type(8)));
typedef int v4i __attribute__((ext_vector_type(4)));
__device__ __forceinline__ v8i cat8(bf16x8 a, bf16x8 b) { const v4i x = __builtin_bit_cast(v4i, a), y = __builtin_bit_cast(v4i, b); return __builtin_shufflevector(x, y, 0, 1, 2, 3, 4, 5, 6, 7); }
struct Unit { unsigned ao, bo, to; int pm, pn, aux; };

__device__ __forceinline__ void tile_of(int L, int nM, int nN, int& pm, int& pn) {
    const int nwg = nM * nN; int wgid = L;
    { const int q = nwg / NXCD, r = nwg % NXCD, xcd = wgid % NXCD, off = wgid / NXCD; wgid = (xcd < r ? xcd * (q + 1) : r * (q + 1) + (xcd - r) * q) + off; }
    const int nig = WGM * nN, gid = wgid / nig, fm = gid * WGM, gsz = (nM - fm) < WGM ? (nM - fm) : WGM;
    pm = fm + ((wgid % nig) % gsz); pn = (wgid % nig) / gsz;
}

template <bool F8, bool GATHER, class Epi, class Sched>
__device__ __forceinline__ void gemm_phase(LAS unsigned char* lds, const unsigned char* wsbase, const int K, const int lda, const int ldb, const Sched& S, const Epi& E) {
    const __amdgpu_buffer_rsrc_t rsrc = __builtin_amdgcn_make_buffer_rsrc((void*)wsbase, 0, 0xFFFFFFFF, 0x00020000);
    const int tid = fresh_tid(), wid = __builtin_amdgcn_readfirstlane(tid >> 6), lane = tid & 63, wr = wid >> 2, wc = wid & 3;
    const int nt = K / BK;
    int f8scales = 0; if constexpr (F8) { f8scales = Epi::SCALES; asm volatile("" : "+v"(f8scales)); }
    int voffA, voffB;
    { int R, C; stage_rc(tid * 16, R, C); const int Rb = Epi::PERM ? ((R & ~31) + perm32(R & 31)) : R; voffA = ((GATHER ? 0 : R * lda) + C) * 2; voffB = (Rb * ldb + C) * 2; }
    const int tokb = (16 * (wid >> 1) + (lane >> 2)) * 4;
    const unsigned kstep = (unsigned)(BK * 2);
    const unsigned hstepA = (unsigned)HALF * lda * 2, hstepB = (unsigned)HALF * ldb * 2;
    const unsigned ldsw = (unsigned)wid * 1024u;
    const int aoff = lds_byte(wr * 64 + (lane & 15), (lane >> 4) * 8), boff = lds_byte(wc * 32 + (lane & 15), (lane >> 4) * 8);
#define PG8_SA(b, h) (((b) * 2 + (h)) * HTB)
#define PG8_SB(b, h) ((4 + (b) * 2 + (h)) * HTB)
#define PG8_STAGE(bufoff, gbase, voff) do { _Pragma("unroll") for (int _i = 0; _i < 2; ++_i) \
        __builtin_amdgcn_raw_ptr_buffer_load_lds(rsrc, (LAS void*)(lds + (bufoff) + ldsl + _i * 8192), 16, voff, __builtin_amdgcn_readfirstlane((int)((gbase) + (unsigned)_i * (hstep##voff >> 1))), 0, 0); } while (0)
#define hstepvoffA hstepA
#define hstepvoffB hstepB
#define PG8_STAGE_A(bufoff, aoffs, h, par) do { if constexpr (GATHER) { _Pragma("unroll") for (int _i = 0; _i < 2; ++_i) { \
            const int _tk = *(const LAS int*)(lds + TOK_OFF + (par) * 1024 + tokb + ((h) * 128 + _i * 64) * 4); \
            __builtin_amdgcn_raw_ptr_buffer_load_lds(rsrc, (LAS void*)(lds + (bufoff) + ldsl + _i * 8192), 16, _tk + voffA, __builtin_amdgcn_readfirstlane((int)(aoffs)), 0, 0); } } \
        else { PG8_STAGE(bufoff, (aoffs) + (unsigned)(h) * hstepA, voffA); } } while (0)
#define PG8_TOK(unit, par) do { if constexpr (GATHER) { if (wid == 0) __builtin_amdgcn_raw_ptr_buffer_load_lds(rsrc, (LAS void*)(lds + TOK_OFF + (par) * 1024), 16, lane * 16, (int)(unit).to, 0, 0); } } while (0)
#define PG8_LDA(dst, b, h) do { _Pragma("unroll") for (int m = 0; m < 4; ++m) _Pragma("unroll") for (int k = 0; k < 2; ++k) dst[m][k] = *(const LAS bf16x8*)(lds + PG8_SA(b, h) + aoff + m * 2048 + k * 1024); } while (0)
#define PG8_LDB(dst, b, h) do { _Pragma("unroll") for (int n = 0; n < 2; ++n) _Pragma("unroll") for (int k = 0; k < 2; ++k) dst[n][k] = *(const LAS bf16x8*)(lds + PG8_SB(b, h) + boff + n * 2048 + k * 1024); } while (0)
#define PG8_MMA(ai, bj, At, Bt) do { __builtin_amdgcn_s_setprio(1); _Pragma("unroll") for (int m = 0; m < 4; ++m) _Pragma("unroll") for (int n = 0; n < 2; ++n) { \
        if constexpr (F8) { asm volatile("v_mfma_scale_f32_16x16x128_f8f6f4 %0, %1, %2, %0, %3, %3 op_sel:[0,1,0] op_sel_hi:[0,0,0]" : "+v"(acc[ai][bj][m][n]) : "v"(cat8(Bt[n][0], Bt[n][1])), "v"(cat8(At[m][0], At[m][1])), "v"(f8scales)); } \
        else { _Pragma("unroll") for (int k = 0; k < 2; ++k) acc[ai][bj][m][n] = __builtin_amdgcn_mfma_f32_16x16x32_bf16(Bt[n][k], At[m][k], acc[ai][bj][m][n], 0, 0, 0); } } \
        __builtin_amdgcn_s_setprio(0); } while (0)
#define PG8_WAIT_V(n) asm volatile("s_waitcnt vmcnt(" #n ")" ::: "memory")
#define PG8_WAIT_L(n) asm volatile("s_waitcnt lgkmcnt(" #n ")" ::: "memory")
#define PG8_BAR __builtin_amdgcn_s_barrier()
#define PG8_SCHED __builtin_amdgcn_sched_barrier(0)
    Unit cur, nxt; int ui = 0;
    if (!S.next(0, cur)) return;
    f32x4 acc[2][2][4][2];
    bf16x8 At[4][2], B0[2][2], B1[2][2];
#define PG8_INIT(par) do { if constexpr (Epi::SIDE) { const int _l = fresh_tid() & 63; E.init(acc, (const LAS float*)(lds + SIDE_OFF + (par) * 1024), wc, _l >> 4); } \
        else { _Pragma("unroll") for (int a = 0; a < 2; ++a) _Pragma("unroll") for (int b = 0; b < 2; ++b) _Pragma("unroll") for (int m = 0; m < 4; ++m) _Pragma("unroll") for (int n = 0; n < 2; ++n) acc[a][b][m][n] = (f32x4){0.f, 0.f, 0.f, 0.f}; } } while (0)
    unsigned cA = cur.ao, cB = cur.bo;
    unsigned ldsl = ldsw; asm volatile("" : "+s"(ldsl));
#define PG8_SIDE(unit, par) do { if constexpr (Epi::SIDE) { if (wid == 0) __builtin_amdgcn_raw_ptr_buffer_load_lds(rsrc, (LAS void*)(lds + SIDE_OFF + (par) * 1024), 16, lane * 16, (int)E.side_off(unit), 0, 0); } } while (0)
    PG8_SIDE(cur, 0);
    if constexpr (GATHER) PG8_TOK(cur, 0);
    if constexpr (GATHER || Epi::SIDE) { asm volatile("s_waitcnt vmcnt(0)" ::: "memory"); PG8_BAR; }
    PG8_INIT(0);
    PG8_STAGE(PG8_SB(0, 0), cB, voffB); PG8_STAGE(PG8_SB(0, 1), cB + hstepB, voffB); PG8_STAGE_A(PG8_SA(0, 0), cA, 0, 0); PG8_STAGE_A(PG8_SA(0, 1), cA, 1, 0);
    if (wr == 1) PG8_BAR;
    PG8_WAIT_V(2); PG8_BAR;
    PG8_STAGE(PG8_SB(1, 0), cB + kstep, voffB); PG8_STAGE_A(PG8_SA(1, 0), cA + kstep, 0, 0); PG8_STAGE(PG8_SB(1, 1), cB + hstepB + kstep, voffB);
    PG8_WAIT_V(6); PG8_BAR;
    for (;;) {
        const bool has_next = S.next(ui + 1, nxt);
        if (has_next) { PG8_TOK(nxt, (ui + 1) & 1); PG8_SIDE(nxt, (ui + 1) & 1); }
        const unsigned nA = has_next ? nxt.ao : cA, nB = has_next ? nxt.bo : cB;
#pragma unroll 1
        for (int t = 0; t < nt; t += 2) {
            const bool last = (t == nt - 2);
            ldsl = ldsw; asm volatile("" : "+s"(ldsl));
            const int parc = ui & 1, parn = (ui + ((last && has_next) ? 1 : 0)) & 1;
            const unsigned a1 = cA + (unsigned)(t + 1) * kstep;
            const unsigned a2 = last ? nA : cA + (unsigned)(t + 2) * kstep, b2 = last ? nB : cB + (unsigned)(t + 2) * kstep;
            const unsigned a3 = a2 + kstep, b3 = b2 + kstep;
            PG8_LDB(B0, 0, 0); PG8_LDB(B1, 0, 1); PG8_SCHED; PG8_LDA(At, 0, 0); PG8_STAGE_A(PG8_SA(1, 1), a1, 1, parc);
            PG8_WAIT_V(8); PG8_WAIT_L(0); PG8_BAR; PG8_MMA(0, 0, At, B0); PG8_MMA(0, 1, At, B1); PG8_BAR; PG8_SCHED;
            PG8_LDA(At, 0, 1); PG8_STAGE(PG8_SB(0, 0), b2, voffB); PG8_STAGE(PG8_SB(0, 1), b2 + hstepB, voffB); PG8_STAGE_A(PG8_SA(0, 0), a2, 0, parn);
            PG8_WAIT_V(8); PG8_WAIT_L(0); PG8_BAR; PG8_MMA(1, 0, At, B0); PG8_MMA(1, 1, At, B1); PG8_BAR; PG8_SCHED;
            PG8_LDB(B0, 1, 0); PG8_LDB(B1, 1, 1); PG8_SCHED; PG8_LDA(At, 1, 0); PG8_STAGE_A(PG8_SA(0, 1), a2, 1, parn);
            PG8_WAIT_V(8); PG8_WAIT_L(0); PG8_BAR; PG8_MMA(0, 0, At, B0); PG8_MMA(0, 1, At, B1); PG8_BAR; PG8_SCHED;
            PG8_LDA(At, 1, 1); PG8_STAGE(PG8_SB(1, 0), b3, voffB); PG8_STAGE(PG8_SB(1, 1), b3 + hstepB, voffB); PG8_STAGE_A(PG8_SA(1, 0), a3, 0, parn);
            PG8_WAIT_V(8); PG8_WAIT_L(0); PG8_BAR; PG8_MMA(1, 0, At, B0); PG8_MMA(1, 1, At, B1); PG8_BAR; PG8_SCHED;
        }
        if constexpr (F8) asm volatile("s_nop 15\n\ts_nop 15" ::: "memory");
        if (wr == 0) PG8_BAR;
        { const int l2 = fresh_tid() & 63; E(acc, cur, wr, wc, l2 & 15, l2 >> 4, (const LAS float*)(lds + SIDE_OFF + (ui & 1) * 1024)); }
        if (!has_next) break;
        cur = nxt; cA = nA; cB = nB; ++ui;
        PG8_INIT(ui & 1);
        if (wr == 1) PG8_BAR;
    }
    PG8_WAIT_V(0);
    PG8_BAR;
#undef PG8_SA
#undef PG8_SB
#undef PG8_STAGE
#undef PG8_STAGE_A
#undef PG8_TOK
#undef PG8_SIDE
#undef PG8_INIT
#undef hstepvoffA
#undef hstepvoffB
#undef PG8_LDA
#undef PG8_LDB
#undef PG8_MMA
#undef PG8_WAIT_V
#undef PG8_WAIT_L
#undef PG8_BAR
#undef PG8_SCHED
}
}

using pg8::Unit;

struct DenseSched {
    unsigned A, Bt; int lda, ldb, nM, nN, G, c;
    __device__ __forceinline__ bool next(int i, Unit& u) const {
        const int L = i * G + c; if (L >= nM * nN) return false;
        pg8::tile_of(L, nM, nN, u.pm, u.pn); u.aux = 0; u.to = 0;
        u.ao = A + (unsigned)u.pm * 256 * lda * 2; u.bo = Bt + (unsigned)u.pn * 256 * ldb * 2; return true;
    }
};
struct GateSched {
    unsigned XC, GT; int nM, G, c;
    __device__ __forceinline__ bool next(int i, Unit& u) const {
        const int per = nM * 4; const int L = i * G + c; if (L >= 4 * per) return false;
        const int nb = L / per; pg8::tile_of(L - nb * per, nM, 4, u.pm, u.pn); u.aux = nb; u.to = 0;
        u.ao = XC + ((unsigned)u.pm * 256 * 1024 + 256 * nb) * 2; u.bo = GT + ((unsigned)nb * 1024 + 256 * u.pn) * 256 * 2; return true;
    }
};
struct QkvSched {
    unsigned HB, WT; int nM, G, c;
    __device__ __forceinline__ bool next(int i, Unit& u) const {
        const int n0 = nM * 8, n1 = 4 * nM; const int L = i * G + c; if (L >= n0 + n1) return false; u.to = 0;
        if (L < n0) { pg8::tile_of(L, nM, 8, u.pm, u.pn); u.aux = 0; u.ao = HB + (unsigned)u.pm * 256 * 1024; u.bo = WT + (unsigned)u.pn * 256 * 1024; }
        else { pg8::tile_of(L - n0, 4, nM, u.pm, u.pn); u.aux = 1; u.ao = WT + (unsigned)(2048 + u.pm * 256) * 1024; u.bo = HB + (unsigned)u.pn * 256 * 1024; }
        return true;
    }
};
struct MoeSched {
    unsigned A, W, tok; const LAS int* texp; unsigned wstride; int nM, nN, G, c;
    __device__ __forceinline__ bool next(int i, Unit& u) const {
        const int L = i * G + c; if (L >= nM * nN) return false;
        pg8::tile_of(L, nM, nN, u.pm, u.pn);
        const int e = __builtin_amdgcn_readfirstlane(texp[u.pm]); u.aux = e;
        u.ao = tok ? A : A + (unsigned)u.pm * 256 * 1024; u.to = tok + (unsigned)u.pm * 1024; u.bo = W + (unsigned)e * wstride + (unsigned)u.pn * 256 * 1024; return true;
    }
};

#define EPI_ARGS const f32x4 (&acc)[2][2][4][2], const Unit& u, int wr, int wc, int fr, int fq, const LAS float* side
struct EpiWin {
    static constexpr bool PERM = true, SIDE = false;
    bf16_t* XR; bf16_t* GY;
    __device__ __forceinline__ void operator()(EPI_ARGS) const {
        const int row0 = u.pm * 256 + wr * 64 + fr;
        if (u.pn < 4) {
            const int col0 = u.pn * 256 + wc * 32 + 8 * fq;
#pragma unroll
            for (int ai = 0; ai < 2; ++ai)
#pragma unroll
                for (int m = 0; m < 4; ++m) { bf16_t* rowp = XR + (size_t)(row0 + ai * 128 + m * 16) * D + col0;
#pragma unroll
                    for (int bj = 0; bj < 2; ++bj) { const f32x4 v0 = acc[ai][bj][m][0], v1 = acc[ai][bj][m][1];
                        u32x4 w; w.x = cvt_pk_bf16(v0[0], v0[1]); w.y = cvt_pk_bf16(v0[2], v0[3]); w.z = cvt_pk_bf16(v1[0], v1[1]); w.w = cvt_pk_bf16(v1[2], v1[3]);
                        *(u32x4*)(rowp + bj * 128) = w; } }
        } else {
#pragma unroll
            for (int ai = 0; ai < 2; ++ai)
#pragma unroll
                for (int m = 0; m < 4; ++m) { const int row = row0 + ai * 128 + m * 16;
#pragma unroll
                    for (int bj = 0; bj < 2; ++bj) { const int g = (u.pn - 4) * 8 + bj * 4 + wc;
                        float o[8];
#pragma unroll
                        for (int n = 0; n < 2; ++n)
#pragma unroll
                            for (int j = 0; j < 4; ++j) { const float v = acc[ai][bj][m][n][j]; const float z = 1.5957691216f * (v + 0.044715f * v * v * v); o[n * 4 + j] = v * sigmoidf_(z); }
                        u32x4 w; w.x = cvt_pk_bf16(o[0], o[1]); w.y = cvt_pk_bf16(o[2], o[3]); w.z = cvt_pk_bf16(o[4], o[5]); w.w = cvt_pk_bf16(o[6], o[7]);
                        *(u32x4*)(GY + ((size_t)g * MPAD + row) * 32 + 8 * fq) = w; } }
        }
    }
};
struct EpiGate {
    static constexpr bool PERM = true, SIDE = true;
    const bf16_t* XC; unsigned char* LB; const float* spl; unsigned bias_off;
    __device__ __forceinline__ unsigned side_off(const Unit& u) const { return bias_off + (unsigned)((((u.pn >> 1) * 4 + u.aux) * 2 + (u.pn & 1)) * 1024); }
    __device__ __forceinline__ void init(f32x4 (&acc)[2][2][4][2], const LAS float* side, int wc, int fq) const {
#pragma unroll
        for (int bj = 0; bj < 2; ++bj)
#pragma unroll
            for (int n = 0; n < 2; ++n) { const f32x4 b = *(const LAS f32x4*)(side + 128 * bj + 32 * wc + 8 * fq + 4 * n);
#pragma unroll
                for (int ai = 0; ai < 2; ++ai)
#pragma unroll
                    for (int m = 0; m < 4; ++m) acc[ai][bj][m][n] = b; }
    }
    __device__ __forceinline__ void operator()(EPI_ARGS) const {
        const int nb = u.aux, dir = u.pn >> 1, half = u.pn & 1;
        const int ch0 = 256 * nb + 128 * half + 32 * wc + 8 * fq, g = ch0 >> 5;
        const int row0 = u.pm * 256 + wr * 64 + fr;
        float csp[8];
        { const f32x4 p0 = *(const f32x4*)(spl + dir * 1024 + ch0), p1 = *(const f32x4*)(spl + dir * 1024 + ch0 + 4);
#pragma unroll
          for (int j = 0; j < 4; ++j) { csp[j] = (-2.0f / 256.0f) * p0[j]; csp[4 + j] = (-2.0f / 256.0f) * p1[j]; } }
        u32x4 xnext = *(const u32x4*)(XC + (size_t)row0 * D + ch0);
#pragma unroll
        for (int ai = 0; ai < 2; ++ai)
#pragma unroll
            for (int m = 0; m < 4; ++m) { const int row = row0 + ai * 128 + m * 16;
                const u32x4 xw = xnext;
                { const int it = ai * 4 + m + 1, rn = row0 + (it >> 2) * 128 + (it & 3) * 16; if (it < 8) xnext = *(const u32x4*)(XC + (size_t)rn * D + ch0); }
                float xc[8]; unpack8(xw, xc);
                const bool start = dir == 1 && (row & (SEQ - 1)) == SEQ - 1;
                float sg[8], bb[8];
#pragma unroll
                for (int n = 0; n < 2; ++n)
#pragma unroll
                    for (int j = 0; j < 4; ++j) { const int i = n * 4 + j;
                        const float sga = fast_rcp(__builtin_fmaf(fast_exp2(-1.44269504089f * acc[ai][0][m][n][j]), 1.0f / 256.0f, 1.0f / 256.0f));
                        const float a2 = fast_exp2(__builtin_fmaf(csp[i], sga, 6.0f));
                        const float mult = __builtin_amdgcn_sqrtf(__builtin_fabsf(64.0f - a2));
                        sg[i] = sga; bb[i] = __builtin_amdgcn_fmed3f(mult * sigmoidf_(acc[ai][1][m][n][j]) * xc[i], -448.0f, 448.0f); }
                if (start) {
#pragma unroll
                    for (int n = 0; n < 2; ++n)
#pragma unroll
                        for (int j = 0; j < 4; ++j) bb[n * 4 + j] = __builtin_amdgcn_fmed3f(8.0f * sigmoidf_(acc[ai][1][m][n][j]) * xc[n * 4 + j], -448.0f, 448.0f); }
                u32x4 w; w.x = pk4_fp8(sg[0], sg[1], sg[2], sg[3]); w.y = pk4_fp8(sg[4], sg[5], sg[6], sg[7]); w.z = pk4_fp8(bb[0], bb[1], bb[2], bb[3]); w.w = pk4_fp8(bb[4], bb[5], bb[6], bb[7]);
                *(u32x4*)(LB + (((size_t)dir * 32 + g) * MPAD + row) * 64 + 16 * fq) = w; }
    }
};
template <bool LAYER0> struct EpiRes {
    static constexpr bool PERM = true, SIDE = false;
    bf16_t* PRE; const float* x; const float* meta; const bf16_t* HB; int nrows;
    __device__ __forceinline__ void operator()(EPI_ARGS) const {
        const int row0 = u.pm * 256 + wr * 64 + fr, col0 = u.pn * 256 + wc * 32 + 8 * fq;
#pragma unroll
        for (int ai = 0; ai < 2; ++ai)
#pragma unroll
            for (int m = 0; m < 4; ++m) { const int row = row0 + ai * 128 + m * 16;
                if (row < nrows) {
#pragma unroll
                    for (int bj = 0; bj < 2; ++bj) { const int c = col0 + bj * 128; float r[8];
                        if (LAYER0) { const float* rp = (row < NGRID ? x + (size_t)row * D : meta + (size_t)((row - NGRID) & 15) * D) + c; const f32x4 r0 = *(const f32x4*)rp, r1 = *(const f32x4*)(rp + 4);
                            r[0] = r0[0]; r[1] = r0[1]; r[2] = r0[2]; r[3] = r0[3]; r[4] = r1[0]; r[5] = r1[1]; r[6] = r1[2]; r[7] = r1[3]; }
                        else { const u32x4 rw = *(const u32x4*)(HB + (size_t)row * D + c); r[0] = bflo(rw.x); r[1] = bfhi(rw.x); r[2] = bflo(rw.y); r[3] = bfhi(rw.y); r[4] = bflo(rw.z); r[5] = bfhi(rw.z); r[6] = bflo(rw.w); r[7] = bfhi(rw.w); }
                        const f32x4 a0 = acc[ai][bj][m][0], a1 = acc[ai][bj][m][1];
                        u32x4 w; w.x = cvt_pk_bf16(r[0] * DN_ALPHA + a0[0], r[1] * DN_ALPHA + a0[1]); w.y = cvt_pk_bf16(r[2] * DN_ALPHA + a0[2], r[3] * DN_ALPHA + a0[3]);
                        w.z = cvt_pk_bf16(r[4] * DN_ALPHA + a1[0], r[5] * DN_ALPHA + a1[1]); w.w = cvt_pk_bf16(r[6] * DN_ALPHA + a1[2], r[7] * DN_ALPHA + a1[3]);
                        *(u32x4*)(PRE + (size_t)row * D + c) = w; }
                }
                asm volatile("" ::: "memory"); }
    }
};
struct EpiGlu {
    static constexpr bool PERM = true, SIDE = true; static constexpr int SCALES = 0x7F79;
    unsigned char* ACT; unsigned bias_off;
    __device__ __forceinline__ unsigned side_off(const Unit& u) const { return bias_off + (unsigned)((u.aux * 8 + u.pn) * 1024); }
    __device__ __forceinline__ void init(f32x4 (&acc)[2][2][4][2], const LAS float* side, int wc, int fq) const {
#pragma unroll
        for (int bj = 0; bj < 2; ++bj)
#pragma unroll
            for (int n = 0; n < 2; ++n) { const f32x4 b = *(const LAS f32x4*)(side + 128 * bj + 32 * wc + 8 * fq + 4 * n);
#pragma unroll
                for (int ai = 0; ai < 2; ++ai)
#pragma unroll
                    for (int m = 0; m < 4; ++m) acc[ai][bj][m][n] = b; }
    }
    __device__ __forceinline__ void operator()(EPI_ARGS) const {
        const int f0 = 128 * u.pn + 32 * wc + 8 * fq;
        const int row0 = u.pm * 256 + wr * 64 + fr;
#pragma unroll
        for (int ai = 0; ai < 2; ++ai)
#pragma unroll
            for (int m = 0; m < 4; ++m) { const int row = row0 + ai * 128 + m * 16; float o[8];
#pragma unroll
                for (int n = 0; n < 2; ++n)
#pragma unroll
                    for (int j = 0; j < 4; ++j) { const int i = n * 4 + j;
                        const float glu = fminf(acc[ai][0][m][n][j], 7.0f);
                        const float lin1 = __builtin_amdgcn_fmed3f(acc[ai][1][m][n][j], -6.0f, 8.0f);
                        const float r4 = fast_rcp(__builtin_fmaf(fast_exp2(glu * (-1.702f * 1.44269504089f)), 0.25f, 0.25f));
                        o[i] = (glu * r4) * lin1; }
                u32x2 w; w.x = pk4_fp8(o[0], o[1], o[2], o[3]); w.y = pk4_fp8(o[4], o[5], o[6], o[7]);
                *(u32x2*)(ACT + (size_t)row * D + f0) = w; }
    }
};
struct EpiNull {
    static constexpr bool PERM = true, SIDE = false; static constexpr int SCALES = 0x7F79;
    __device__ __forceinline__ void operator()(EPI_ARGS) const {
#pragma unroll
        for (int ai = 0; ai < 2; ++ai)
#pragma unroll
            for (int bj = 0; bj < 2; ++bj)
#pragma unroll
                for (int m = 0; m < 4; ++m)
#pragma unroll
                    for (int n = 0; n < 2; ++n) asm volatile("" :: "v"(acc[ai][bj][m][n]));
    }
};
struct EpiDown {
    static constexpr bool PERM = true, SIDE = true; static constexpr int SCALES = 0x7D79;
    unsigned char* YS; unsigned bias_off;
    __device__ __forceinline__ unsigned side_off(const Unit& u) const { return bias_off + (unsigned)((u.aux * 4 + u.pn) * 1024); }
    __device__ __forceinline__ void init(f32x4 (&acc)[2][2][4][2], const LAS float* side, int wc, int fq) const {
#pragma unroll
        for (int bj = 0; bj < 2; ++bj)
#pragma unroll
            for (int n = 0; n < 2; ++n) { const f32x4 b = *(const LAS f32x4*)(side + 128 * bj + 32 * wc + 8 * fq + 4 * n);
#pragma unroll
                for (int ai = 0; ai < 2; ++ai)
#pragma unroll
                    for (int m = 0; m < 4; ++m) acc[ai][bj][m][n] = b; }
    }
    __device__ __forceinline__ void operator()(EPI_ARGS) const {
        const int row0 = u.pm * 256 + wr * 64 + fr, col0 = u.pn * 256 + wc * 32 + 8 * fq;
#pragma unroll
        for (int ai = 0; ai < 2; ++ai)
#pragma unroll
            for (int m = 0; m < 4; ++m) { unsigned char* rowp = YS + (size_t)(row0 + ai * 128 + m * 16) * D + col0;
#pragma unroll
                for (int bj = 0; bj < 2; ++bj) { const f32x4 v0 = acc[ai][bj][m][0] * 8.0f, v1 = acc[ai][bj][m][1] * 8.0f;
                    u32x2 w; w.x = pk4_fp8(v0[0], v0[1], v0[2], v0[3]); w.y = pk4_fp8(v1[0], v1[1], v1[2], v1[3]);
                    *(u32x2*)(rowp + bj * 128) = w; } }
    }
};
struct EpiQkv {
    static constexpr bool PERM = true, SIDE = false; static constexpr int SCALES = 0x7F79;
    bf16_t* Q; bf16_t* Kx; bf16_t* VT;
    __device__ __forceinline__ void operator()(EPI_ARGS) const {
        const int row0 = u.pm * 256 + wr * 64 + fr; bf16_t* base; int ldc, colt; float sc = 1.0f;
        if (u.aux == 0) { ldc = D; if (u.pn < 4) { base = Q; colt = u.pn * 256; sc = 0.125f * 1.44269504089f; } else { base = Kx; colt = (u.pn - 4) * 256; } }
        else { base = VT; ldc = MPAD; colt = u.pn * 256; }
        const int col0 = colt + wc * 32 + 8 * fq;
#pragma unroll
        for (int ai = 0; ai < 2; ++ai)
#pragma unroll
            for (int m = 0; m < 4; ++m) { bf16_t* rowp = base + (size_t)(row0 + ai * 128 + m * 16) * ldc + col0;
#pragma unroll
                for (int bj = 0; bj < 2; ++bj) { const f32x4 v0 = acc[ai][bj][m][0] * sc, v1 = acc[ai][bj][m][1] * sc;
                    u32x4 w; w.x = cvt_pk_bf16(v0[0], v0[1]); w.y = cvt_pk_bf16(v0[2], v0[3]); w.z = cvt_pk_bf16(v1[0], v1[1]); w.w = cvt_pk_bf16(v1[2], v1[3]);
                    *(u32x4*)(rowp + bj * 128) = w; } }
    }
};

struct CvItem { const float* src; unsigned char* dst; int ld, pitch, f8; };
__device__ __forceinline__ CvItem cv_item(const Ctx& C, unsigned char* wsl, int it) {
    constexpr int I0 = 512, I1 = 256, I2 = 256, I3 = 768, I4 = 256, I5 = 32768, I6 = 16384;
    CvItem q; int r = it;
    if (r < I0) { const int nbk = r & 63, kb = r >> 6; q.src = C.in[I_WIN] + (size_t)(128 * kb) * 2048 + 32 * nbk; q.ld = 2048; q.dst = wsl + WS_WIN + ((size_t)(32 * nbk) * 1024 + 128 * kb) * 2; q.pitch = 2048; q.f8 = 0; return q; } r -= I0;
    if (r < I1) { const int job = r >> 3, sub = r & 7, nbk = sub & 3, kb = sub >> 2;
        const int half = job & 1, which = (job >> 1) & 1, nb = (job >> 2) & 3, dir = job >> 4;
        q.src = C.in[which ? I_WX : I_WA] + (size_t)(dir * 4 + nb) * 65536 + (size_t)(128 * kb) * 256 + 128 * half + 32 * nbk; q.ld = 256;
        q.dst = wsl + WS_GATE + (((size_t)nb * 1024 + 256 * (2 * dir + half) + 128 * which + 32 * nbk) * 256 + 128 * kb) * 2; q.pitch = 512; q.f8 = 0; return q; } r -= I1;
    if (r < I2) { const int nbk = r & 31, kb = r >> 5; q.src = C.in[I_LOUT] + (size_t)(128 * kb) * 1024 + 32 * nbk; q.ld = 1024; q.dst = wsl + WS_LOUT + ((size_t)(32 * nbk) * 1024 + 128 * kb) * 2; q.pitch = 2048; q.f8 = 0; return q; } r -= I2;
    if (r < I3) { const int nbk = r % 96, kb = r / 96; q.src = C.in[I_WQKV] + (size_t)(128 * kb) * 3072 + 32 * nbk; q.ld = 3072; q.dst = wsl + WS_QKV + ((size_t)(32 * nbk) * 1024 + 128 * kb) * 2; q.pitch = 2048; q.f8 = 0; return q; } r -= I3;
    if (r < I4) { const int nbk = r & 31, kb = r >> 5; q.src = C.in[I_NOUT] + (size_t)(128 * kb) * 1024 + 32 * nbk; q.ld = 1024; q.dst = wsl + WS_NOUT + ((size_t)(32 * nbk) * 1024 + 128 * kb) * 2; q.pitch = 2048; q.f8 = 0; return q; } r -= I4;
    q.f8 = 1; q.pitch = 1024;
    if (r < I5) { const int mat = r >> 9, sub = r & 511, nbk = sub & 63, kb = sub >> 6; const int n0 = 32 * nbk, bj = n0 >> 10, f0 = n0 & 1023, pn = f0 >> 7, jj = f0 & 127;
        q.src = C.in[I_WGU] + (size_t)mat * 1024 * 2048 + (size_t)(128 * kb) * 2048 + n0; q.ld = 2048; q.dst = wsl + WS_WGU + ((size_t)mat * 2048 + 256 * pn + 128 * bj + jj) * 1024 + 128 * kb; return q; } r -= I5;
    if (r < I6) { const int mat = r >> 8, sub = r & 255, nbk = sub & 31, kb = sub >> 5;
        q.src = C.in[I_WD] + (size_t)mat * 1024 * 1024 + (size_t)(128 * kb) * 1024 + 32 * nbk; q.ld = 1024; q.dst = wsl + WS_WD + ((size_t)mat * 1024 + 32 * nbk) * 1024 + 128 * kb; return q; } r -= I6;
    { const int nbk = r % 96, kb = r / 96; q.src = C.in[I_WQKV] + (size_t)(128 * kb) * 3072 + 32 * nbk; q.ld = 3072; q.dst = wsl + WS_QKV8 + (size_t)(32 * nbk) * 1024 + 128 * kb; return q; }
}
__device__ __forceinline__ void phase_convert(const Ctx& C) {
    PHASE_IDS
    LAS float* scr = (LAS float*)(C.lds + wave * 16896);
    const int gw = C.bid * NWAVES + wave, NGW = C.G * NWAVES;
    constexpr int NIT = 512 + 256 + 256 + 768 + 256 + 32768 + 16384 + 768;
    if (gw < NIT) {
        const int r = lane >> 3, q4 = lane & 7, c = lane & 15, nn = lane >> 4;
        CvItem cur = cv_item(C, wsl, gw); int it = gw;
        f32x4 v[16];
#pragma unroll
        for (int i = 0; i < 16; ++i) v[i] = __builtin_nontemporal_load((const f32x4*)(cur.src + (size_t)(8 * i + r) * cur.ld + 4 * q4));
        for (;;) {
#pragma unroll
            for (int i = 0; i < 16; ++i) { LAS float* sp = scr + (8 * i + r) * 33 + 4 * q4; sp[0] = v[i][0]; sp[1] = v[i][1]; sp[2] = v[i][2]; sp[3] = v[i][3]; }
            const int nit = it + NGW; CvItem nxt = cur;
            if (nit < NIT) { nxt = cv_item(C, wsl, nit);
#pragma unroll
                for (int i = 0; i < 16; ++i) v[i] = __builtin_nontemporal_load((const f32x4*)(nxt.src + (size_t)(8 * i + r) * nxt.ld + 4 * q4)); }
            asm volatile("s_waitcnt lgkmcnt(0)" ::: "memory");
            if (cur.f8) {
#pragma unroll
                for (int j = 0; j < 8; ++j) { const int n = nn + 4 * j; const LAS float* sp = scr + (8 * c) * 33 + n;
                    u32x2 o; o.x = pk4_fp8(sp[0] * 64.0f, sp[33] * 64.0f, sp[2 * 33] * 64.0f, sp[3 * 33] * 64.0f); o.y = pk4_fp8(sp[4 * 33] * 64.0f, sp[5 * 33] * 64.0f, sp[6 * 33] * 64.0f, sp[7 * 33] * 64.0f);
                    *(u32x2*)(cur.dst + (size_t)n * cur.pitch + 8 * c) = o; }
            } else {
#pragma unroll
                for (int j = 0; j < 8; ++j) { const int n = nn + 4 * j; const LAS float* sp = scr + (8 * c) * 33 + n;
                    u32x4 o; o.x = pk2(sp[0], sp[33]); o.y = pk2(sp[2 * 33], sp[3 * 33]); o.z = pk2(sp[4 * 33], sp[5 * 33]); o.w = pk2(sp[6 * 33], sp[7 * 33]);
                    *(u32x4*)(cur.dst + (size_t)n * cur.pitch + 16 * c) = o; }
            }
            asm volatile("s_waitcnt lgkmcnt(0)" ::: "memory");
            if (nit >= NIT) break;
            cur = nxt; it = nit;
        }
    }
    const int gt = C.bid * NTHREADS + tid, NGT = C.G * NTHREADS;
    for (int i = gt; i < 2048; i += NGT) ((float*)(wsl + WS_CTL + CT_SPL))[i] = 8.0f * 1.44269504089f * log1pf(expf(-C.in[I_LAM][i]));
    for (int i = gt; i < 2 * 32 * 2048; i += NGT) { const int le = i >> 11, r = i & 2047, pn = r >> 8, bj = (r >> 7) & 1, ii = r & 127;
        ((float*)(wsl + WS_BIAS))[i] = C.in[I_BGU][(size_t)le * 2048 + bj * 1024 + 128 * pn + ii] + (bj ? 1.0f : 0.0f); }
    for (int i = gt; i < 2 * 32 * 1024; i += NGT) ((float*)(wsl + WS_BD))[i] = C.in[I_BD][i];
    for (int i = gt; i < 4096; i += NGT) { const int ut = i >> 8, which = (i >> 7) & 1, jj = i & 127, dir = ut >> 3, nb = (ut >> 1) & 3, half = ut & 1;
        ((float*)(wsl + WS_GBIAS))[i] = C.in[which ? I_BX : I_BA][dir * 1024 + 256 * nb + 128 * half + jj]; }
    for (int i0 = gt; i0 < NTOK * 128; i0 += 4 * NGT) { f32x4 a[4], b[4];
#pragma unroll
        for (int u = 0; u < 4; ++u) { const int i = i0 + u * NGT; if (i < NTOK * 128) { const int row = i >> 7, oc = i & 127;
            const float* src = (row < NGRID ? C.in[I_X] + (size_t)row * D : C.in[I_META] + (size_t)((row - NGRID) & 15) * D) + 8 * oc;
            a[u] = __builtin_nontemporal_load((const f32x4*)src); b[u] = __builtin_nontemporal_load((const f32x4*)(src + 4)); } }
#pragma unroll
        for (int u = 0; u < 4; ++u) { const int i = i0 + u * NGT; if (i < NTOK * 128) { const int row = i >> 7, oc = i & 127;
            u32x4 w; w.x = pk2(a[u][0], a[u][1]); w.y = pk2(a[u][2], a[u][3]); w.z = pk2(b[u][0], b[u][1]); w.w = pk2(b[u][2], b[u][3]);
            *(u32x4*)((bf16_t*)(wsl + WS_HB) + (size_t)row * D + 8 * oc) = w; } } }
}

__device__ __forceinline__ void phase_conv(const Ctx& C) {
    PHASE_IDS
    const bf16_t* XR = (const bf16_t*)(wsl + WS_XR); bf16_t* XC = (bf16_t*)(wsl + WS_XC);
    const float* cw = C.in[I_CONVW]; const float* cb = C.in[I_CONVB];
    const int gt = C.bid * NTHREADS + tid, NGT = C.G * NTHREADS;
    for (int i = gt; i < NTOK * 128; i += NGT) { const int row = i >> 7, ch = 8 * (i & 127);
        int b, s; if (row < NGRID) { b = row >> 12; s = NMETA + (row & (SEQ - 1)); } else { b = (row - NGRID) >> 4; s = (row - NGRID) & 15; }
        float a[8];
        { const f32x4 t0 = *(const f32x4*)(cb + ch), t1 = *(const f32x4*)(cb + ch + 4);
#pragma unroll
          for (int j = 0; j < 4; ++j) { a[j] = t0[j]; a[4 + j] = t1[j]; } }
#pragma unroll
        for (int j = 0; j < 4; ++j) { const int sj = s - 2 + j;
            if (sj >= 0 && sj < LSEQ) { const u32x4 xw = *(const u32x4*)(XR + (size_t)seqrow(b, sj) * D + ch);
                const f32x4 w0 = *(const f32x4*)(cw + j * 1024 + ch), w1 = *(const f32x4*)(cw + j * 1024 + ch + 4);
                a[0] += w0[0] * bflo(xw.x); a[1] += w0[1] * bfhi(xw.x); a[2] += w0[2] * bflo(xw.y); a[3] += w0[3] * bfhi(xw.y);
                a[4] += w1[0] * bflo(xw.z); a[5] += w1[1] * bfhi(xw.z); a[6] += w1[2] * bflo(xw.w); a[7] += w1[3] * bfhi(xw.w); } }
        u32x4 w; w.x = pk2(a[0], a[1]); w.y = pk2(a[2], a[3]); w.z = pk2(a[4], a[5]); w.w = pk2(a[6], a[7]);
        *(u32x4*)(XC + (size_t)row * D + ch) = w; }
}

template <int N> __device__ __forceinline__ float dpp_shr(float oldv, float v) {
    return __builtin_bit_cast(float, __builtin_amdgcn_update_dpp(__builtin_bit_cast(int, oldv), __builtin_bit_cast(int, v), 0x110 + N, 0xf, 0xf, false));
}
__device__ __forceinline__ void scan_group(float (&a)[8], float (&b)[8]) {
#define SG_STEP(N) _Pragma("unroll") for (int c = 0; c < 8; ++c) { \
        asm volatile("v_fmac_f32_dpp %0, %0, %1 row_shr:" #N " row_mask:0xf bank_mask:0xf bound_ctrl:1" : "+v"(b[c]) : "v"(a[c])); } \
    _Pragma("unroll") for (int c = 0; c < 8; ++c) { \
        asm volatile("v_mul_f32_dpp %0, %0, %0 row_shr:" #N " row_mask:0xf bank_mask:0xf" : "+v"(a[c])); }
    asm volatile("s_nop 1" ::: "memory");
    SG_STEP(1) SG_STEP(2) SG_STEP(4) SG_STEP(8)
    asm volatile("s_nop 1" ::: "memory");
#undef SG_STEP
}
__device__ __forceinline__ void unpack8(const u32x4 w, float (&o)[8]) { o[0] = bflo(w.x); o[1] = bfhi(w.x); o[2] = bflo(w.y); o[3] = bfhi(w.y); o[4] = bflo(w.z); o[5] = bfhi(w.z); o[6] = bflo(w.w); o[7] = bfhi(w.w); }
__device__ __forceinline__ void phase_scan(const Ctx& C) {
    PHASE_IDS
    const unsigned char* LB = wsl + WS_LA; const float* spl = (const float*)(wsl + WS_CTL + CT_SPL); const bf16_t* GY = (const bf16_t*)(wsl + WS_GY);
    bf16_t* HF = (bf16_t*)(wsl + WS_HF); bf16_t* Gout = (bf16_t*)(wsl + WS_G);
    LAS float* agg = (LAS float*)C.lds;
    const int w = wave, oct = lane >> 4, p = lane & 15;
    for (int it0 = (C.G == 256 ? C.gc : C.bid); it0 < NB * 32; it0 += C.G) {
        const int item = (C.G == 256) ? (((it0 >> 3) >> 2) << 5) + ((it0 & 7) << 2) + ((it0 >> 3) & 3) : it0;
        const int b = item >> 5, g = item & 31;
        for (int dir = 0; dir < 2; ++dir) {
            const unsigned char* lb = LB + (((size_t)dir * 32 + g) * MPAD) * 64 + 16 * oct;
            float cs[8];
            { const f32x4 p0 = *(const f32x4*)(spl + dir * 1024 + 32 * g + 8 * oct), p1 = *(const f32x4*)(spl + dir * 1024 + 32 * g + 8 * oct + 4);
#pragma unroll
              for (int c = 0; c < 4; ++c) { cs[c] = p0[c] * (-1.0f / 256.0f); cs[4 + c] = p1[c] * (-1.0f / 256.0f); } }
            float S[8];
#pragma unroll
            for (int c = 0; c < 8; ++c) S[c] = 0.f;
            {
                const int u = p, s = dir ? LSEQ - 1 - u : u, row = seqrow(b, s);
                float a[8], x[8]; { const u32x4 rec = *(const u32x4*)(lb + (size_t)row * 64); u32x2 t; t.x = rec.x; t.y = rec.y; unpack8_fp8(t, a); t.x = rec.z; t.y = rec.w; unpack8_fp8(t, x); }
#pragma unroll
                for (int c = 0; c < 8; ++c) { a[c] = fast_exp2(a[c] * cs[c]); x[c] *= 0.125f; }
                scan_group(a, x);
                if (w == 0) {
                    if (dir == 0) { u32x4 o; o.x = pk2(x[0], x[1]); o.y = pk2(x[2], x[3]); o.z = pk2(x[4], x[5]); o.w = pk2(x[6], x[7]); *(u32x4*)(HF + ((size_t)g * MPAD + row) * 32 + 8 * oct) = o; }
                    else { float hf[8], gy[8]; unpack8(*(const u32x4*)(HF + ((size_t)g * MPAD + row) * 32 + 8 * oct), hf); unpack8(*(const u32x4*)(GY + ((size_t)g * MPAD + row) * 32 + 8 * oct), gy);
                        u32x4 o; o.x = pk2((hf[0] + x[0]) * gy[0], (hf[1] + x[1]) * gy[1]); o.y = pk2((hf[2] + x[2]) * gy[2], (hf[3] + x[3]) * gy[3]);
                        o.z = pk2((hf[4] + x[4]) * gy[4], (hf[5] + x[5]) * gy[5]); o.w = pk2((hf[6] + x[6]) * gy[6], (hf[7] + x[7]) * gy[7]);
                        *(u32x4*)(Gout + (size_t)row * D + 32 * g + 8 * oct) = o; }
                }
#pragma unroll
                for (int c = 0; c < 8; ++c) S[c] = __shfl(x[c], (lane & 48) | 15);
            }
            u32x4 na[4];
#pragma unroll
            for (int j = 0; j < 4; ++j) { const int u = 16 + 64 * w + 16 * j + p, s = dir ? LSEQ - 1 - u : u; const int rw = seqrow(b, s);
                na[j] = __builtin_nontemporal_load((const u32x4*)(lb + (size_t)rw * 64)); }
            for (int r = 0; r < 8; ++r) {
                float Pw[4][8], Hw[4][8]; int rows[4];
                float Aw[8], Hc[8];
#pragma unroll
                for (int c = 0; c < 8; ++c) { Aw[c] = 1.f; Hc[c] = 0.f; }
                u32x4 ra[4], rhf[4], rgy[4];
#pragma unroll
                for (int j = 0; j < 4; ++j) { const int u = 16 + 512 * r + 64 * w + 16 * j + p, s = dir ? LSEQ - 1 - u : u; rows[j] = seqrow(b, s); ra[j] = na[j]; }
                if (r < 7) {
#pragma unroll
                    for (int j = 0; j < 4; ++j) { const int u = 16 + 512 * (r + 1) + 64 * w + 16 * j + p, s = dir ? LSEQ - 1 - u : u; const int rw = seqrow(b, s);
                        na[j] = __builtin_nontemporal_load((const u32x4*)(lb + (size_t)rw * 64)); } }
                if (dir == 1) {
#pragma unroll
                    for (int j = 0; j < 4; ++j) { const size_t go = ((size_t)g * MPAD + rows[j]) * 32 + 8 * oct; rhf[j] = *(const u32x4*)(HF + go); rgy[j] = __builtin_nontemporal_load((const u32x4*)(GY + go)); } }
#pragma unroll
                for (int j = 0; j < 4; ++j) {
                    float a[8], x[8]; { u32x2 t; t.x = ra[j].x; t.y = ra[j].y; unpack8_fp8(t, a); t.x = ra[j].z; t.y = ra[j].w; unpack8_fp8(t, x); }
#pragma unroll
                    for (int c = 0; c < 8; ++c) { a[c] = fast_exp2(a[c] * cs[c]); x[c] *= 0.125f; }
                    scan_group(a, x);
#pragma unroll
                    for (int c = 0; c < 8; ++c) { Hw[j][c] = a[c] * Hc[c] + x[c]; Pw[j][c] = a[c] * Aw[c]; }
#pragma unroll
                    for (int c = 0; c < 8; ++c) { Aw[c] = __shfl(Pw[j][c], (lane & 48) | 15); Hc[c] = __shfl(Hw[j][c], (lane & 48) | 15); }
                }
                LAS float* ag = agg + (r & 1) * 512;
                if (p == 0) {
#pragma unroll
                    for (int c = 0; c < 8; ++c) { ag[(w * 32 + oct * 8 + c) * 2] = Aw[c]; ag[(w * 32 + oct * 8 + c) * 2 + 1] = Hc[c]; }
                }
                __syncthreads();
                float Sin[8];
#pragma unroll
                for (int c = 0; c < 8; ++c) Sin[c] = S[c];
#pragma unroll
                for (int ww = 0; ww < 8; ++ww) {
#pragma unroll
                    for (int c = 0; c < 8; ++c) { const float A = ag[(ww * 32 + oct * 8 + c) * 2], H = ag[(ww * 32 + oct * 8 + c) * 2 + 1];
                        if (ww == w) Sin[c] = S[c];
                        S[c] = A * S[c] + H; }
                }
#pragma unroll
                for (int j = 0; j < 4; ++j) {
                    float h[8];
#pragma unroll
                    for (int c = 0; c < 8; ++c) h[c] = Pw[j][c] * Sin[c] + Hw[j][c];
                    const size_t go = ((size_t)g * MPAD + rows[j]) * 32 + 8 * oct;
                    if (dir == 0) { u32x4 o; o.x = pk2(h[0], h[1]); o.y = pk2(h[2], h[3]); o.z = pk2(h[4], h[5]); o.w = pk2(h[6], h[7]); *(u32x4*)(HF + go) = o; }
                    else { float hf[8], gy[8]; unpack8(rhf[j], hf); unpack8(rgy[j], gy);
                        u32x4 o; o.x = pk2((hf[0] + h[0]) * gy[0], (hf[1] + h[1]) * gy[1]); o.y = pk2((hf[2] + h[2]) * gy[2], (hf[3] + h[3]) * gy[3]);
                        o.z = pk2((hf[4] + h[4]) * gy[4], (hf[5] + h[5]) * gy[5]); o.w = pk2((hf[6] + h[6]) * gy[6], (hf[7] + h[7]) * gy[7]);
                        *(u32x4*)(Gout + (size_t)rows[j] * D + 32 * g + 8 * oct) = o; }
                }
            }
            __syncthreads();
        }
    }
}

template <int K> __device__ __forceinline__ f32x4 mini_mma(const bf16_t* W, int ldw, const bf16_t* A, int lda, int lane) {
    const bf16_t* wp = W + (size_t)(lane & 15) * ldw + 8 * (lane >> 4); const bf16_t* ap = A + (size_t)(lane & 15) * lda + 8 * (lane >> 4);
    f32x4 acc = {0.f, 0.f, 0.f, 0.f};
    constexpr int KB = K < 512 ? K : 512, NS = KB / 32;
#pragma unroll 1
    for (int k0 = 0; k0 < K; k0 += KB) { bf16x8 wf[NS], af[NS];
#pragma unroll
        for (int i = 0; i < NS; ++i) { wf[i] = *(const bf16x8*)(wp + k0 + 32 * i); af[i] = *(const bf16x8*)(ap + k0 + 32 * i); }
#pragma unroll
        for (int i = 0; i < NS; ++i) acc = __builtin_amdgcn_mfma_f32_16x16x32_bf16(wf[i], af[i], acc, 0, 0, 0); }
    return acc;
}
__device__ __forceinline__ void mini_win(const Ctx& C) {
    PHASE_IDS
    const bf16_t* HB = (const bf16_t*)(C.ws + WS_HB); const bf16_t* WT = (const bf16_t*)(C.ws + WS_WIN); bf16_t* XR = (bf16_t*)(C.ws + WS_XR); bf16_t* GY = (bf16_t*)(C.ws + WS_GY);
    const int fr = lane & 15, fq = lane >> 4;
    for (int wt = C.gc * NWAVES + wave; wt < 8 * 128; wt += C.G * NWAVES) { const int rg = wt & 7, cb = wt >> 3, row = NGRID + 16 * rg + fr, c = 16 * cb + 4 * fq;
        const f32x4 a = mini_mma<1024>(WT + (size_t)(16 * cb) * 1024, 1024, HB + (size_t)(NGRID + 16 * rg) * 1024, 1024, lane);
        if (c < 1024) { u32x2 w; w.x = cvt_pk_bf16(a[0], a[1]); w.y = cvt_pk_bf16(a[2], a[3]); *(u32x2*)(XR + (size_t)row * D + c) = w; }
        else { const int yc = c - 1024; float o[4];
#pragma unroll
            for (int j = 0; j < 4; ++j) { const float v = a[j]; const float z = 1.5957691216f * (v + 0.044715f * v * v * v); o[j] = v * sigmoidf_(z); }
            u32x2 w; w.x = cvt_pk_bf16(o[0], o[1]); w.y = cvt_pk_bf16(o[2], o[3]); *(u32x2*)(GY + ((size_t)(yc >> 5) * MPAD + row) * 32 + (yc & 31)) = w; } }
}
__device__ __forceinline__ void mini_gate(const Ctx& C) {
    PHASE_IDS
    const bf16_t* XC = (const bf16_t*)(C.ws + WS_XC); const bf16_t* GT = (const bf16_t*)(C.ws + WS_GATE); unsigned char* LB = C.ws + WS_LA;
    const float* ba = C.in[I_BA]; const float* bx = C.in[I_BX]; const float* spl = (const float*)(C.ws + WS_CTL + CT_SPL);
    const int fr = lane & 15, fq = lane >> 4;
    for (int wt = C.gc * NWAVES + wave; wt < 8 * 2 * 64; wt += C.G * NWAVES) { const int rg = wt & 7, dir = (wt >> 3) & 1, chg = wt >> 4, ch0 = 16 * chg, nb = ch0 >> 8, half = (ch0 >> 7) & 1, jj0 = ch0 & 127;
        const bf16_t* A = XC + (size_t)(NGRID + 16 * rg) * 1024 + 256 * nb; const bf16_t* Wa = GT + ((size_t)nb * 1024 + 256 * (2 * dir + half) + jj0) * 256;
        const f32x4 za = mini_mma<256>(Wa, 256, A, 1024, lane), zx = mini_mma<256>(Wa + 128 * 256, 256, A, 1024, lane);
        const int row = NGRID + 16 * rg + fr, ch = ch0 + 4 * fq;
        const f32x4 cba = *(const f32x4*)(ba + dir * 1024 + ch), cbx = *(const f32x4*)(bx + dir * 1024 + ch), csp = *(const f32x4*)(spl + dir * 1024 + ch);
        const u32x2 xw = *(const u32x2*)(XC + (size_t)row * D + ch); const float xc[4] = {bflo(xw.x), bfhi(xw.x), bflo(xw.y), bfhi(xw.y)};
        float sg[4], bb[4];
#pragma unroll
        for (int j = 0; j < 4; ++j) { const float sga = sigmoidf_(za[j] + cba[j]); const float a2 = fast_exp2(-2.0f * csp[j] * sga);
            const float mult = (dir == 0 && fr == 0) ? 8.0f : 8.0f * __builtin_amdgcn_sqrtf(fmaxf(1.0f - a2, 0.0f));
            sg[j] = sga * 256.0f; bb[j] = __builtin_amdgcn_fmed3f(mult * sigmoidf_(zx[j] + cbx[j]) * xc[j], -448.0f, 448.0f); }
        unsigned char* o = LB + (((size_t)dir * 32 + (ch >> 5)) * MPAD + row) * 64 + 16 * ((ch & 31) >> 3) + (ch & 7);
        *(unsigned*)o = pk4_fp8(sg[0], sg[1], sg[2], sg[3]); *(unsigned*)(o + 8) = pk4_fp8(bb[0], bb[1], bb[2], bb[3]); }
}
__device__ __forceinline__ void mini_lout(const Ctx& C) {
    PHASE_IDS
    const bf16_t* G = (const bf16_t*)(C.ws + WS_G); const bf16_t* WT = (const bf16_t*)(C.ws + WS_LOUT); bf16_t* PRE = (bf16_t*)(C.ws + WS_PRE); const float* meta = C.in[I_META];
    const int fr = lane & 15, fq = lane >> 4;
    for (int wt = C.gc * NWAVES + wave; wt < 8 * 64; wt += C.G * NWAVES) { const int rg = wt & 7, cb = wt >> 3, row = NGRID + 16 * rg + fr, c = 16 * cb + 4 * fq;
        const f32x4 a = mini_mma<1024>(WT + (size_t)(16 * cb) * 1024, 1024, G + (size_t)(NGRID + 16 * rg) * 1024, 1024, lane);
        const f32x4 r = *(const f32x4*)(meta + (size_t)fr * D + c);
        u32x2 w; w.x = cvt_pk_bf16(r[0] * DN_ALPHA + a[0], r[1] * DN_ALPHA + a[1]); w.y = cvt_pk_bf16(r[2] * DN_ALPHA + a[2], r[3] * DN_ALPHA + a[3]); *(u32x2*)(PRE + (size_t)row * D + c) = w; }
}
__device__ __forceinline__ void mini_kv(const Ctx& C) {
    PHASE_IDS
    const bf16_t* HB = (const bf16_t*)(C.ws + WS_HB); const bf16_t* WT = (const bf16_t*)(C.ws + WS_QKV); bf16_t* Kx = (bf16_t*)(C.ws + WS_K); bf16_t* VT = (bf16_t*)(C.ws + WS_VT);
    const int fr = lane & 15, fq = lane >> 4;
    for (int wt = C.gc * NWAVES + wave; wt < 2 * 8 * 64; wt += C.G * NWAVES) { const int rg = wt & 7, cb = (wt >> 3) & 63, isv = wt >> 9;
        const bf16_t* A = HB + (size_t)(NGRID + 16 * rg) * 1024;
        if (!isv) { const f32x4 a = mini_mma<1024>(WT + (size_t)(1024 + 16 * cb) * 1024, 1024, A, 1024, lane);
            u32x2 w; w.x = cvt_pk_bf16(a[0], a[1]); w.y = cvt_pk_bf16(a[2], a[3]); *(u32x2*)(Kx + (size_t)(NGRID + 16 * rg + fr) * D + 16 * cb + 4 * fq) = w; }
        else { const f32x4 a = mini_mma<1024>(A, 1024, WT + (size_t)(2048 + 16 * cb) * 1024, 1024, lane);
            u32x2 w; w.x = cvt_pk_bf16(a[0], a[1]); w.y = cvt_pk_bf16(a[2], a[3]); *(u32x2*)(VT + (size_t)(16 * cb + fr) * MPAD + NGRID + 16 * rg + 4 * fq) = w; } }
}

constexpr int RW_PITCH = 2080;
__device__ __forceinline__ void phase_lnr(const Ctx& C, int layer, int nrows) {
    PHASE_IDS
    const bf16_t* PRE = (const bf16_t*)(wsl + WS_PRE); bf16_t* HB = (bf16_t*)(wsl + WS_HB); unsigned char* HB8 = wsl + WS_HB8;
    const float* lg = C.in[I_LNMG] + layer * D; const float* lb = C.in[I_LNMB] + layer * D;
    const float* rw = C.in[I_RW] + (size_t)layer * D * NEXP; const float* rb = C.in[I_RB] + layer * NEXP;
    int* eid = (int*)(wsl + WS_CTL + CT_EID) + (size_t)layer * NTOK * 4; float* gatev = (float*)(wsl + WS_CTL + CT_GATEV) + (size_t)layer * NTOK * 4;
    unsigned* bc = (unsigned*)(wsl + WS_CTL + CT_BC) + ((size_t)layer * 256 + C.bid) * 32;
    LAS unsigned char* RWt = C.lds; LAS unsigned char* rowb = C.lds + 32 * RW_PITCH + wave * (4 * RW_PITCH);
    LAS float* lgt = (LAS float*)(C.lds + 32 * RW_PITCH + NWAVES * 4 * RW_PITCH) + wave * 128; LAS unsigned* hist = (LAS unsigned*)(C.lds + 32 * RW_PITCH + NWAVES * 4 * RW_PITCH + NWAVES * 512);
#pragma unroll
    for (int i = 0; i < 8; ++i) { const int idx = tid + NTHREADS * i, pc = idx >> 3, e4 = (idx & 7) * 4, ch = 2 * pc;
        const f32x4 w0 = *(const f32x4*)(rw + (size_t)ch * NEXP + e4), w1 = *(const f32x4*)(rw + (size_t)(ch + 1) * NEXP + e4);
#pragma unroll
        for (int q = 0; q < 4; ++q) *(LAS unsigned*)(RWt + (e4 + q) * RW_PITCH + pc * 4) = pk2(w0[q], w1[q]); }
    if (tid < 32) hist[tid] = 0u;
    __syncthreads();
    float gg[2][8], gb[2][8];
#pragma unroll
    for (int j = 0; j < 2; ++j) { const f32x4 a0 = *(const f32x4*)(lg + 8 * lane + 512 * j), a1 = *(const f32x4*)(lg + 8 * lane + 512 * j + 4), b0 = *(const f32x4*)(lb + 8 * lane + 512 * j), b1 = *(const f32x4*)(lb + 8 * lane + 512 * j + 4);
#pragma unroll
        for (int i = 0; i < 4; ++i) { gg[j][i] = a0[i]; gg[j][4 + i] = a1[i]; gb[j][i] = b0[i]; gb[j][4 + i] = b1[i]; } }
    const float rbias = rb[lane >> 1];
    const int gw = C.bid * NWAVES + wave, NGW = C.G * NWAVES;
    const int nmine = gw < nrows ? (nrows - gw + NGW - 1) / NGW : 0;
    u32x4 nv[2];
    if (nmine > 0) {
#pragma unroll
        for (int j = 0; j < 2; ++j) nv[j] = __builtin_nontemporal_load((const u32x4*)(PRE + (size_t)gw * D + 8 * lane + 512 * j)); }
    const int fr = lane & 15, fq = lane >> 4;
    for (int i0 = 0; i0 < nmine; i0 += 4) {
#pragma unroll
        for (int ii = 0; ii < 4; ++ii) if (i0 + ii < nmine) {
            const int row = gw + NGW * (i0 + ii);
            float v[2][8]; float s = 0.f;
#pragma unroll
            for (int j = 0; j < 2; ++j) { unpack8(nv[j], v[j]); s += ((v[j][0] + v[j][1]) + (v[j][2] + v[j][3])) + ((v[j][4] + v[j][5]) + (v[j][6] + v[j][7])); }
            if (i0 + ii + 1 < nmine) {
#pragma unroll
                for (int j = 0; j < 2; ++j) nv[j] = __builtin_nontemporal_load((const u32x4*)(PRE + (size_t)(row + NGW) * D + 8 * lane + 512 * j)); }
            const float mean = wave_sum_dpp(s) * (1.0f / D); float q = 0.f;
#pragma unroll
            for (int j = 0; j < 2; ++j)
#pragma unroll
                for (int i = 0; i < 8; ++i) { v[j][i] -= mean; q += v[j][i] * v[j][i]; }
            const float rstd = __builtin_amdgcn_rsqf(wave_sum_dpp(q) * (1.0f / D) + LN_EPS);
#pragma unroll
            for (int j = 0; j < 2; ++j) {
#pragma unroll
                for (int i = 0; i < 8; ++i) v[j][i] = v[j][i] * rstd * gg[j][i] + gb[j][i];
                u32x4 w; w.x = pk2(v[j][0], v[j][1]); w.y = pk2(v[j][2], v[j][3]); w.z = pk2(v[j][4], v[j][5]); w.w = pk2(v[j][6], v[j][7]);
                *(u32x4*)(HB + (size_t)row * D + 8 * lane + 512 * j) = w;
                *(LAS u32x4*)(rowb + ii * RW_PITCH + 16 * lane + 1024 * j) = w;
                u32x2 w8; w8.x = pk4_fp8(v[j][0], v[j][1], v[j][2], v[j][3]); w8.y = pk4_fp8(v[j][4], v[j][5], v[j][6], v[j][7]);
                *(u32x2*)(HB8 + (size_t)row * D + 8 * lane + 512 * j) = w8; }
        }
        asm volatile("s_waitcnt lgkmcnt(0)" ::: "memory");
        f32x4 l0 = {0.f, 0.f, 0.f, 0.f}, l1 = {0.f, 0.f, 0.f, 0.f};
        { const LAS unsigned char* ap = RWt + fr * RW_PITCH + 16 * fq; const LAS unsigned char* bp = rowb + (fr & 3) * RW_PITCH + 16 * fq;
#pragma unroll
          for (int ks = 0; ks < 32; ++ks) { const bf16x8 b = *(const LAS bf16x8*)(bp + 64 * ks), a0 = *(const LAS bf16x8*)(ap + 64 * ks), a1 = *(const LAS bf16x8*)(ap + 16 * RW_PITCH + 64 * ks);
              l0 = __builtin_amdgcn_mfma_f32_16x16x32_bf16(a0, b, l0, 0, 0, 0); l1 = __builtin_amdgcn_mfma_f32_16x16x32_bf16(a1, b, l1, 0, 0, 0); } }
        if (fr < 4) { *(LAS f32x4*)(lgt + fr * 32 + 4 * fq) = l0; *(LAS f32x4*)(lgt + fr * 32 + 16 + 4 * fq) = l1; }
        asm volatile("s_waitcnt lgkmcnt(0)" ::: "memory");
#pragma unroll
        for (int ii = 0; ii < 4; ++ii) if (i0 + ii < nmine) {
            const int row = gw + NGW * (i0 + ii);
            float lv = lgt[ii * 32 + (lane >> 1)] + rbias; lv = (lv == lv) ? lv : -3.0e38f;
            const int le = lane >> 1;
            int rank = 0;
#pragma unroll
            for (int j = 0; j < 32; ++j) { const float lj = readlane_f(lv, 2 * j); rank += (lj > lv || (lj == lv && j < le)) ? 1 : 0; }
            const unsigned long long m0 = __ballot(rank == 0);
            const float mxl = readlane_f(lv, (int)__builtin_ctzll(m0));
            const float pe = rank < 4 ? __expf(lv - mxl) : 0.f;
            const float den = wave_sum_dpp(pe) * 0.5f;
            if (rank < 4 && (lane & 1) == 0) { eid[(size_t)row * 4 + rank] = le; gatev[(size_t)row * 4 + rank] = pe / den;
                __hip_atomic_fetch_add(&hist[le], 1u, __ATOMIC_RELAXED, __HIP_MEMORY_SCOPE_WORKGROUP); }
        }
        asm volatile("s_waitcnt lgkmcnt(0)" ::: "memory");
    }
    __syncthreads();
    if (tid < 32) bc[tid] = hist[tid];
}

__device__ __forceinline__ void phase_pos(const Ctx& C, int layer, int nrows) {
    PHASE_IDS
    const unsigned* bcAll = (const unsigned*)(wsl + WS_CTL + CT_BC) + (size_t)layer * 256 * 32;
    const int* eid = (const int*)(wsl + WS_CTL + CT_EID) + (size_t)layer * NTOK * 4; int* posv = (int*)(wsl + WS_CTL + CT_POS) + (size_t)layer * NTOK * 4;
    int* texp = (int*)(wsl + WS_CTL + CT_TEXP) + layer * 1024;
    int* tokoff = (int*)(wsl + WS_TOK) + (size_t)layer * (1 * MiB / 4);
    LAS unsigned* partT = (LAS unsigned*)C.lds; LAS unsigned* partP = partT + 512; LAS unsigned* tot = partP + 512; LAS unsigned* cnt = tot + 32;
    { const int e = tid & 31, part = tid >> 5; unsigned t = 0, pr = 0;
      unsigned vv[16];
#pragma unroll
      for (int i = 0; i < 16; ++i) { const int bq = part + 16 * i; vv[i] = bq < C.G ? bcAll[(size_t)bq * 32 + e] : 0u; }
#pragma unroll
      for (int i = 0; i < 16; ++i) { const int bq = part + 16 * i; t += vv[i]; if (bq < C.bid) pr += vv[i]; }
      partT[part * 32 + e] = t; partP[part * 32 + e] = pr; }
    __syncthreads();
    if (tid < 32) { unsigned t = 0, pr = 0; for (int i = 0; i < 16; ++i) { t += partT[i * 32 + tid]; pr += partP[i * 32 + tid]; } tot[tid] = t; cnt[tid] = pr; }
    __syncthreads();
    if (tid < 32) { unsigned off = 0; for (int e = 0; e < tid; ++e) off += (tot[e] + 255u) & ~255u;
        const unsigned mine = (tot[tid] + 255u) & ~255u;
        if (C.bid == 0) { for (unsigned t = off >> 8; t < ((off + mine) >> 8); ++t) texp[t] = tid; if (tid == 31) texp[1023] = (int)((off + mine) >> 8);
            for (unsigned p = off + tot[tid]; p < off + mine; ++p) tokoff[p] = 0; }
        cnt[tid] += off; }
    __syncthreads();
    const int gw = C.bid * NWAVES + wave, NGW = C.G * NWAVES;
    for (int row = gw; row < nrows; row += NGW) {
        int pos = 0;
        if (lane < 4) { const int e = eid[(size_t)row * 4 + lane]; pos = (int)__hip_atomic_fetch_add(&cnt[e], 1u, __ATOMIC_RELAXED, __HIP_MEMORY_SCOPE_WORKGROUP); posv[(size_t)row * 4 + lane] = pos; }
        if (lane < 4) tokoff[pos] = row * 1024;
    }
}

__device__ __forceinline__ void phase_combine(const Ctx& C, int layer, int nrows, bool final_out) {
    PHASE_IDS
    bf16_t* HB = (bf16_t*)(wsl + WS_HB); unsigned char* HB8 = wsl + WS_HB8; const unsigned char* YS = wsl + WS_YS;
    const float* lg = C.in[I_LNFG] + layer * D; const float* lb = C.in[I_LNFB] + layer * D;
    const float* gatev = (const float*)(wsl + WS_CTL + CT_GATEV) + (size_t)layer * NTOK * 4; const int* posv = (const int*)(wsl + WS_CTL + CT_POS) + (size_t)layer * NTOK * 4;
    float gg[2][8], gb[2][8];
#pragma unroll
    for (int j = 0; j < 2; ++j) { const f32x4 a0 = *(const f32x4*)(lg + 8 * lane + 512 * j), a1 = *(const f32x4*)(lg + 8 * lane + 512 * j + 4), b0 = *(const f32x4*)(lb + 8 * lane + 512 * j), b1 = *(const f32x4*)(lb + 8 * lane + 512 * j + 4);
#pragma unroll
        for (int i = 0; i < 4; ++i) { gg[j][i] = a0[i]; gg[j][4 + i] = a1[i]; gb[j][i] = b0[i]; gb[j][4 + i] = b1[i]; } }
    const int gw = C.bid * NWAVES + wave, NGW = C.G * NWAVES;
    f32x4 g1 = {0.f, 0.f, 0.f, 0.f}, g2 = g1; int p1[4] = {0, 0, 0, 0}, p2[4] = {0, 0, 0, 0};
    u32x4 hwn[2]; u32x2 ywn[4][2];
#define CB_ROUTE(row_, gq, pq) do { gq = *(const f32x4*)(gatev + (size_t)(row_) * 4); const u32x4 _pp = *(const u32x4*)(posv + (size_t)(row_) * 4); pq[0] = (int)_pp.x; pq[1] = (int)_pp.y; pq[2] = (int)_pp.z; pq[3] = (int)_pp.w; } while (0)
#define CB_DATA(row_, pq) do { _Pragma("unroll") for (int j = 0; j < 2; ++j) { hwn[j] = *(const u32x4*)(HB + (size_t)(row_) * D + 8 * lane + 512 * j); \
            _Pragma("unroll") for (int k = 0; k < 4; ++k) ywn[k][j] = __builtin_nontemporal_load((const u32x2*)(YS + (size_t)pq[k] * D + 8 * lane + 512 * j)); } } while (0)
    if (gw < nrows) { CB_ROUTE(gw, g1, p1); CB_DATA(gw, p1); }
    if (gw + NGW < nrows) CB_ROUTE(gw + NGW, g2, p2);
    for (int row = gw; row < nrows; row += NGW) {
        const f32x4 gk4 = g1 * 0.125f; u32x4 hw[2]; u32x2 yw[4][2];
#pragma unroll
        for (int j = 0; j < 2; ++j) { hw[j] = hwn[j];
#pragma unroll
            for (int k = 0; k < 4; ++k) yw[k][j] = ywn[k][j]; }
        g1 = g2;
#pragma unroll
        for (int k = 0; k < 4; ++k) p1[k] = p2[k];
        if (row + NGW < nrows) CB_DATA(row + NGW, p1);
        if (row + 2 * NGW < nrows) CB_ROUTE(row + 2 * NGW, g2, p2);
        float v[2][8]; float s = 0.f;
#pragma unroll
        for (int j = 0; j < 2; ++j) { float h[8]; unpack8(hw[j], h);
#pragma unroll
            for (int i = 0; i < 8; ++i) v[j][i] = h[i] * DN_ALPHA;
#pragma unroll
            for (int k = 0; k < 4; ++k) { float y[8]; unpack8_fp8(yw[k][j], y);
#pragma unroll
                for (int i = 0; i < 8; ++i) v[j][i] += gk4[k] * y[i]; }
#pragma unroll
            for (int i = 0; i < 8; ++i) s += v[j][i]; }
        const float mean = wave_sum_dpp(s) * (1.0f / D); float q = 0.f;
#pragma unroll
        for (int j = 0; j < 2; ++j)
#pragma unroll
            for (int i = 0; i < 8; ++i) { v[j][i] -= mean; q += v[j][i] * v[j][i]; }
        const float rstd = __builtin_amdgcn_rsqf(wave_sum_dpp(q) * (1.0f / D) + LN_EPS);
#pragma unroll
        for (int j = 0; j < 2; ++j) {
#pragma unroll
            for (int i = 0; i < 8; ++i) v[j][i] = v[j][i] * rstd * gg[j][i] + gb[j][i];
            if (final_out) { *(f32x4*)(C.out + (size_t)row * D + 8 * lane + 512 * j) = (f32x4){v[j][0], v[j][1], v[j][2], v[j][3]}; *(f32x4*)(C.out + (size_t)row * D + 8 * lane + 512 * j + 4) = (f32x4){v[j][4], v[j][5], v[j][6], v[j][7]}; }
            else { u32x4 w; w.x = pk2(v[j][0], v[j][1]); w.y = pk2(v[j][2], v[j][3]); w.z = pk2(v[j][4], v[j][5]); w.w = pk2(v[j][6], v[j][7]); *(u32x4*)(HB + (size_t)row * D + 8 * lane + 512 * j) = w;
                u32x2 w8; w8.x = pk4_fp8(v[j][0], v[j][1], v[j][2], v[j][3]); w8.y = pk4_fp8(v[j][4], v[j][5], v[j][6], v[j][7]); *(u32x2*)(HB8 + (size_t)row * D + 8 * lane + 512 * j) = w8; } }
    }
#undef CB_ROUTE
#undef CB_DATA
}

constexpr int AT_KS = 0, AT_VTS = 73728, AT_VPITCH = 1168, AT_KM = AT_VTS + 64 * AT_VPITCH, AT_VTM = AT_KM + 2048, AT_RPB = AT_VTM + 2048, AT_MB = AT_RPB + 1920, AT_END = AT_MB + 64;
static_assert(AT_END <= LDS_BYTES, "attention LDS map");
__device__ __forceinline__ void phase_attn(const Ctx& C) {
    PHASE_IDS
    bf16_t* O = (bf16_t*)(wsl + WS_O);
    const float* rpb = C.in[I_RPB]; const float* mbias = C.in[I_MBIAS];
    LAS unsigned char* lds = C.lds;
    const int w = wave, lq = lane & 15, g = lane >> 4;
    const int qr = w >> 2, qg = w & 3, c0 = 16 * qg, kcb = qg == 0 ? 0 : (qg == 1 ? 8 : (qg == 2 ? 24 : 32));
    int bidx[2][4];
    { const int c_ = c0 + lq, cs_ = min(max(c_ - 8, 0), 48);
#pragma unroll
      for (int blk = 0; blk < 2; ++blk)
#pragma unroll
          for (int e = 0; e < 4; ++e) { const int kc = kcb + 16 * blk + 4 * g + e; bidx[blk][e] = ((kc >= cs_ && kc < cs_ + 16) ? (kc - c_ + 15) : 31) * 4; } }
    const __amdgpu_buffer_rsrc_t rsrc = __builtin_amdgcn_make_buffer_rsrc((void*)wsl, 0, 0xFFFFFFFF, 0x00020000);
    const int kvoff = (((tid >> 3) & 63) * D + 8 * (tid & 7)) * 2, vvoff = ((tid >> 3) * MPAD + 8 * (tid & 7)) * 2;
    const int qvoff = (lq * D + 8 * g) * 2;
    const int mvoff = tid < 128 ? ((tid >> 3) * D + 8 * (tid & 7)) * 2 : (((tid - 128) >> 1) * MPAD + 8 * ((tid - 128) & 1)) * 2;
    const int klds = AT_KS + ((((tid >> 3) & 63)) * 8 + ((tid & 7) ^ ((tid >> 3) & 7))) * 16;
    const int vlds = AT_VTS + (tid >> 3) * AT_VPITCH + (tid & 7) * 16;
    for (int su = (C.G == 256 ? C.gc : C.bid); su < 256; su += C.G) {
        int bh, strip; if (C.G == 256) { bh = (su & 7) * 16 + (su >> 4); strip = (su >> 3) & 1; } else { bh = su >> 1; strip = su & 1; }
        const int b = bh >> 4, h = bh & 15, rp0 = strip * 16;
        const unsigned kbase = (unsigned)WS_K + (unsigned)((b * SEQ) * D + 64 * h) * 2u, vbase = (unsigned)WS_VT + (unsigned)((64 * h) * MPAD + b * SEQ) * 2u;
        const unsigned qbase = (unsigned)WS_Q + (unsigned)((b * SEQ + qr * 64 + c0) * D + 64 * h) * 2u;
        int R0 = min(max(2 * rp0 - 4, 0), 55);
        __syncthreads();
        {
            u32x4 kreg[9], vreg[9];
#pragma unroll
            for (int i = 0; i < 9; ++i) { kreg[i] = __builtin_amdgcn_raw_buffer_load_b128(rsrc, kvoff, (int)(kbase + (unsigned)(R0 + i) * 64u * D * 2u), 0);
                vreg[i] = __builtin_amdgcn_raw_buffer_load_b128(rsrc, vvoff, (int)(vbase + (unsigned)(R0 + i) * 128u), 0); }
            u32x4 mreg = {0u, 0u, 0u, 0u};
            if (tid < 256) mreg = __builtin_amdgcn_raw_buffer_load_b128(rsrc, mvoff, (int)(tid < 128 ? (unsigned)WS_K + (unsigned)((NGRID + 16 * b) * D + 64 * h) * 2u : (unsigned)WS_VT + (unsigned)((64 * h) * MPAD + NGRID + 16 * b) * 2u), 0);
            float rpreg = 0.f, mbreg = 0.f;
            if (tid < 480) rpreg = (tid & 31) < 31 ? rpb[h * 465 + (tid >> 5) * 31 + (tid & 31)] * 1.44269504089f : -1.0e30f;
            if (tid < 16) mbreg = mbias[h * 16 + tid] * 1.44269504089f;
#pragma unroll
            for (int i = 0; i < 9; ++i) { const int slot = (R0 + i) % 9; *(LAS u32x4*)(lds + klds + slot * 8192) = kreg[i]; *(LAS u32x4*)(lds + vlds + slot * 128) = vreg[i]; }
            if (tid < 128) { const int m = tid >> 3, ch = tid & 7; *(LAS u32x4*)(lds + AT_KM + (m * 8 + (ch ^ (m & 7))) * 16) = mreg; }
            else if (tid < 256) { const int i = tid - 128, d = i >> 1, hf = i & 1; *(LAS u32x4*)(lds + AT_VTM + d * 32 + hf * 16) = mreg; }
            if (tid < 480) ((LAS float*)(lds + AT_RPB))[tid] = rpreg;
            if (tid < 16) ((LAS float*)(lds + AT_MB))[tid] = mbreg;
        }
        u32x4 qreg[2];
        qreg[0] = __builtin_amdgcn_raw_buffer_load_b128(rsrc, qvoff, (int)(qbase + (unsigned)(2 * rp0) * 64u * D * 2u), 0);
        qreg[1] = __builtin_amdgcn_raw_buffer_load_b128(rsrc, qvoff, (int)(qbase + (unsigned)(2 * rp0) * 64u * D * 2u + 64u), 0);
        __syncthreads();
        for (int rp = rp0; rp < rp0 + 16; ++rp) {
            const int R0n = rp + 1 < rp0 + 16 ? min(max(2 * (rp + 1) - 4, 0), 55) : R0, nnew = R0n - R0;
            const u32x4 qcur[2] = {qreg[0], qreg[1]};
            u32x4 nk[2], nv[2];
#pragma unroll
            for (int i = 0; i < 2; ++i) if (i < nnew) { nk[i] = __builtin_amdgcn_raw_buffer_load_b128(rsrc, kvoff, (int)(kbase + (unsigned)(R0 + 9 + i) * 64u * D * 2u), 0);
                nv[i] = __builtin_amdgcn_raw_buffer_load_b128(rsrc, vvoff, (int)(vbase + (unsigned)(R0 + 9 + i) * 128u), 0); }
            if (rp + 1 < rp0 + 16) { qreg[0] = __builtin_amdgcn_raw_buffer_load_b128(rsrc, qvoff, (int)(qbase + (unsigned)(2 * rp + 2) * 64u * D * 2u), 0);
                qreg[1] = __builtin_amdgcn_raw_buffer_load_b128(rsrc, qvoff, (int)(qbase + (unsigned)(2 * rp + 2) * 64u * D * 2u + 64u), 0); }
            const int r = 2 * rp + qr;
            const int rs = min(max(r - 4, 0), 56), s0 = rs % 9;
            const size_t qrow = (size_t)(b * SEQ + r * 64 + c0 + lq);
            bf16x8 qf[2]; qf[0] = __builtin_bit_cast(bf16x8, qcur[0]); qf[1] = __builtin_bit_cast(bf16x8, qcur[1]);
            f32x4 sc[8][2], sm;
#pragma unroll
            for (int j = 0; j < 8; ++j) { const int slot = s0 + j - (s0 + j >= 9 ? 9 : 0);
#pragma unroll
                for (int blk = 0; blk < 2; ++blk) { f32x4 a = {0.f, 0.f, 0.f, 0.f}; const int kc = kcb + 16 * blk + lq;
#pragma unroll
                    for (int ks = 0; ks < 2; ++ks) { const bf16x8 kf = *(const LAS bf16x8*)(lds + AT_KS + slot * 8192 + (kc * 8 + ((4 * ks + g) ^ (kc & 7))) * 16);
                        a = __builtin_amdgcn_mfma_f32_16x16x32_bf16(kf, qf[ks], a, 0, 0, 0); }
                    sc[j][blk] = a; } }
            { f32x4 a = {0.f, 0.f, 0.f, 0.f};
#pragma unroll
              for (int ks = 0; ks < 2; ++ks) { const bf16x8 kf = *(const LAS bf16x8*)(lds + AT_KM + (lq * 8 + ((4 * ks + g) ^ (lq & 7))) * 16);
                  a = __builtin_amdgcn_mfma_f32_16x16x32_bf16(kf, qf[ks], a, 0, 0, 0); }
              sm = a; }
            const LAS unsigned char* RProw = lds + AT_RPB + (rs - r + 7) * 128; const LAS float* MB = (const LAS float*)(lds + AT_MB);
            float mx = -3.0e38f;
#pragma unroll
            for (int j = 0; j < 8; ++j)
#pragma unroll
                for (int blk = 0; blk < 2; ++blk)
#pragma unroll
                    for (int e = 0; e < 4; ++e) { const float sv = sc[j][blk][e] + *(const LAS float*)(RProw + j * 128 + bidx[blk][e]); sc[j][blk][e] = sv; mx = fmaxf(mx, sv); }
#pragma unroll
            for (int e = 0; e < 4; ++e) { sm[e] += MB[4 * g + e]; mx = fmaxf(mx, sm[e]); }
            mx = fmaxf(mx, __shfl_xor(mx, 16)); mx = fmaxf(mx, __shfl_xor(mx, 32));
            float sum = 0.f;
#pragma unroll
            for (int j = 0; j < 8; ++j)
#pragma unroll
                for (int blk = 0; blk < 2; ++blk)
#pragma unroll
                    for (int e = 0; e < 4; ++e) { const float pv = fast_exp2(sc[j][blk][e] - mx); sc[j][blk][e] = pv; sum += pv; }
#pragma unroll
            for (int e = 0; e < 4; ++e) { const float pv = fast_exp2(sm[e] - mx); sm[e] = pv; sum += pv; }
            sum += __shfl_xor(sum, 16); sum += __shfl_xor(sum, 32);
            f32x4 o[4];
#pragma unroll
            for (int db = 0; db < 4; ++db) o[db] = (f32x4){0.f, 0.f, 0.f, 0.f};
#pragma unroll
            for (int j = 0; j < 8; ++j) { const int slot = s0 + j - (s0 + j >= 9 ? 9 : 0);
                u32x4 pw; pw.x = cvt_pk_bf16(sc[j][0][0], sc[j][0][1]); pw.y = cvt_pk_bf16(sc[j][0][2], sc[j][0][3]); pw.z = cvt_pk_bf16(sc[j][1][0], sc[j][1][1]); pw.w = cvt_pk_bf16(sc[j][1][2], sc[j][1][3]);
                const bf16x8 pb = __builtin_bit_cast(bf16x8, pw);
#pragma unroll
                for (int db = 0; db < 4; ++db) { const int d = 16 * db + lq; const LAS unsigned char* vp = lds + AT_VTS + d * AT_VPITCH + (slot * 64 + kcb + 4 * g) * 2;
                    const u32x2 lo = *(const LAS u32x2*)vp, hi = *(const LAS u32x2*)(vp + 32);
                    u32x4 aw; aw.x = lo.x; aw.y = lo.y; aw.z = hi.x; aw.w = hi.y;
                    o[db] = __builtin_amdgcn_mfma_f32_16x16x32_bf16(__builtin_bit_cast(bf16x8, aw), pb, o[db], 0, 0, 0); }
            }
            { u32x4 pw; pw.x = cvt_pk_bf16(sm[0], sm[1]); pw.y = cvt_pk_bf16(sm[2], sm[3]); pw.z = 0u; pw.w = 0u; const bf16x8 pb = __builtin_bit_cast(bf16x8, pw);
#pragma unroll
              for (int db = 0; db < 4; ++db) { const int d = 16 * db + lq; const u32x2 lo = *(const LAS u32x2*)(lds + AT_VTM + d * 32 + 8 * g);
                  u32x4 aw; aw.x = lo.x; aw.y = lo.y; aw.z = 0u; aw.w = 0u;
                  o[db] = __builtin_amdgcn_mfma_f32_16x16x32_bf16(__builtin_bit_cast(bf16x8, aw), pb, o[db], 0, 0, 0); } }
            const float inv = 1.0f / sum;
#pragma unroll
            for (int db = 0; db < 4; ++db) { u32x2 ow; ow.x = cvt_pk_bf16(o[db][0] * inv, o[db][1] * inv); ow.y = cvt_pk_bf16(o[db][2] * inv, o[db][3] * inv);
                *(u32x2*)(O + qrow * D + 64 * h + 16 * db + 4 * g) = ow; }
            __syncthreads();
#pragma unroll
            for (int i = 0; i < 2; ++i) if (i < nnew) { const int slot = (R0 + 9 + i) % 9; *(LAS u32x4*)(lds + klds + slot * 8192) = nk[i]; *(LAS u32x4*)(lds + vlds + slot * 128) = nv[i]; }
            R0 = R0n;
            __syncthreads();
        }
    }
}
#define XB_TMO      128
#define XB_XCNT(j)  (256  + 64 * (j))
#define XB_XSUB(j)  (1280 + 64 * (j))
#define XB_XGEN(j)  (2304 + 64 * (j))
#define XB_TOP      3328
#define XB_TOPGEN   3392
#define XCD_BAR_WORDS 3456
#define XB_SPIN_CAP (1u << 22)
__device__ __forceinline__ unsigned xb_ld(unsigned* p)              { return __hip_atomic_load(p, __ATOMIC_RELAXED, __HIP_MEMORY_SCOPE_AGENT); }
__device__ __forceinline__ unsigned xb_add(unsigned* p, unsigned v) { return __hip_atomic_fetch_add(p, v, __ATOMIC_RELAXED, __HIP_MEMORY_SCOPE_AGENT); }
__device__ __forceinline__ unsigned xb_xcc_id() { return (unsigned)__builtin_amdgcn_s_getreg((3 << 11) | 20) & 0xFu; }
#define XB_SPIN(cond, bar) do { unsigned _sp = 0; while (cond) { __builtin_amdgcn_s_sleep(1); \
    if ((++_sp & 255u) == 0u) { if (xb_ld(&(bar)[XB_TMO])) break; if (_sp > XB_SPIN_CAP) { atomicAdd(&(bar)[XB_TMO], 1u); break; } } } } while (0)
struct XcdBarrier { unsigned* bar; unsigned x; volatile LAS unsigned* st; };
__device__ __forceinline__ XcdBarrier xcd_barrier_post(unsigned* bar, volatile LAS unsigned* st) {
    XcdBarrier b; b.bar = bar; b.x = xb_xcc_id(); b.st = st;
    if (threadIdx.x == 0) st[2] = xb_add(&bar[XB_XCNT(b.x)], 1u);
    return b;
}
__device__ __forceinline__ void xcd_barrier_complete(unsigned* bar, unsigned x, unsigned& nloc, unsigned& nx) {
    const unsigned G = gridDim.x * gridDim.y * gridDim.z;
    unsigned sum, cnt, mine, sp = 0u;
    for (;;) {
        sum = 0u; cnt = 0u; mine = 0u;
#pragma unroll
        for (unsigned j = 0; j < 16; ++j) { const unsigned c = xb_ld(&bar[XB_XCNT(j)]); sum += c; cnt += (c > 0u) ? 1u : 0u; mine = (j == x) ? c : mine; }
        if (sum == G) break;
        __builtin_amdgcn_s_sleep(1);
        if ((++sp & 255u) == 0u) { if (xb_ld(&bar[XB_TMO])) break; if (sp > XB_SPIN_CAP) { atomicAdd(&bar[XB_TMO], 1u); break; } }
    }
    nloc = mine > 0u ? mine : 1u; nx = cnt > 0u ? cnt : 1u;
}
__device__ __forceinline__ void xcd_barrier(const XcdBarrier& b) {
    asm volatile("s_waitcnt vmcnt(0)" ::: "memory");
    __syncthreads();
    if (threadIdx.x == 0) {
        unsigned* bar = b.bar;
        __builtin_amdgcn_s_waitcnt(0);
        unsigned nloc = b.st[0], nx = b.st[1];
        if (nloc == 0u) { xcd_barrier_complete(bar, b.x, nloc, nx); b.st[0] = nloc; b.st[1] = nx; }
        const unsigned old = xb_add(&bar[XB_XSUB(b.x)], 1u);
        const unsigned gen = old / nloc;
        if (old + 1u == (gen + 1u) * nloc) {
            __builtin_amdgcn_fence(__ATOMIC_RELEASE, "agent");
            asm volatile("s_waitcnt vmcnt(0)" ::: "memory");
            const unsigned og = xb_add(&bar[XB_TOP], 1u);
            const unsigned tg = og / nx;
            if (og + 1u == (tg + 1u) * nx) xb_add(&bar[XB_TOPGEN], 1u);
            else XB_SPIN(xb_ld(&bar[XB_TOPGEN]) == tg, bar);
            __builtin_amdgcn_fence(__ATOMIC_ACQUIRE, "agent");
            xb_add(&bar[XB_XGEN(b.x)], 1u);
            asm volatile("s_waitcnt vmcnt(0)" ::: "memory");
        } else {
            XB_SPIN(xb_ld(&bar[XB_XGEN(b.x)]) == gen, bar);
            __builtin_amdgcn_fence(__ATOMIC_ACQUIRE, "agent");
            asm volatile("s_waitcnt vmcnt(0)" ::: "memory");
        }
    }
    __syncthreads();
}
__device__ __forceinline__ int moe_prep(const Ctx& C, const int* texp) {
    LAS int* t = (LAS int*)(C.lds + pg8::TEXP_OFF); const int tid = fresh_tid();
    const int a = texp[tid], b = texp[tid + 512];
    t[tid] = a; t[tid + 512] = b;
    __syncthreads();
    return __builtin_amdgcn_readfirstlane(t[1023]);
}
constexpr size_t CT_BAR = 131072;
constexpr int LDS_BARST = LDS_BYTES - 64;

constexpr int N_PHASES = 20;
__global__ void __launch_bounds__(NTHREADS, 2) hybrid_fwd(Params P) {
    extern __shared__ __attribute__((aligned(16))) unsigned char smem[];
    cg::grid_group grid = cg::this_grid();
    Ctx C; C.lds = (LAS unsigned char*)smem; C.G = gridDim.x; C.bid = blockIdx.x;
    C.ws = P.ws; C.in = P.in; C.out = P.out;
    unsigned char* const ws0 = P.ws;
#define ws fresh_ws(ws0)
    const int lo = P.ph_lo, hi = P.ph_hi;
#ifndef PH_MASK
#define PH_MASK 0xFFFFFFFFu
#endif
#define IN(k) (((PH_MASK >> (k)) & 1u) && lo <= (k) && (k) < hi)
#ifndef REPEAT_MASK
#define REPEAT_MASK 0u
#endif
#define REPS(k) ((((unsigned)REPEAT_MASK >> (k)) & 1u) ? 2 : 1)
#ifndef N_CG_SYNCS
#define N_CG_SYNCS 0
#endif
#define SEAM(k) do { if (IN(k) && IN((k) + 1)) { if ((k) < N_CG_SYNCS) grid.sync(); else xcd_barrier(bar); } } while (0)
    if (threadIdx.x < 16) ((LAS unsigned*)(smem + LDS_BARST))[threadIdx.x] = 0u;
    __syncthreads();
    const XcdBarrier bar = xcd_barrier_post((unsigned*)(ws + WS_CTL + CT_BAR), (volatile LAS unsigned*)(smem + LDS_BARST));
    C.gc = C.bid;
    #define PH_BODY_0 phase_convert(C);
    if (IN(0)) { PH_BODY_0 } if (REPS(0) > 1 && IN(0)) { xcd_barrier(bar); PH_BODY_0 }
    SEAM(0);
    if (IN(0) && IN(1)) {
        unsigned* barw = (unsigned*)(ws + WS_CTL + CT_BAR); bool eq = (C.G % 8) == 0;
#pragma unroll
        for (int j = 0; j < 16; ++j) { const unsigned cj = xb_ld(&barw[XB_XCNT(j)]); eq = eq && (cj == (j < 8 ? (unsigned)(C.G / 8) : 0u)); }
        const unsigned rank = ((volatile LAS unsigned*)(smem + LDS_BARST))[2];
        C.gc = __builtin_amdgcn_readfirstlane(eq ? (int)(rank * 8u + bar.x) : C.bid);
    }
    #define PH_BODY_1 { DenseSched S{(unsigned)WS_HB, (unsigned)WS_WIN, 1024, 1024, 128, 8, C.G, C.gc}; EpiWin E{(bf16_t*)(ws + WS_XR), (bf16_t*)(ws + WS_GY)}; \
        pg8::gemm_phase<false, false>(C.lds, ws, 1024, 1024, 1024, S, E); mini_win(C); }
    if (IN(1)) { PH_BODY_1 } if (REPS(1) > 1 && IN(1)) { xcd_barrier(bar); PH_BODY_1 }
    SEAM(1);
    #define PH_BODY_2 phase_conv(C);
    if (IN(2)) { PH_BODY_2 } if (REPS(2) > 1 && IN(2)) { xcd_barrier(bar); PH_BODY_2 }
    SEAM(2);
    #define PH_BODY_3 { GateSched S{(unsigned)WS_XC, (unsigned)WS_GATE, 128, C.G, C.gc}; \
        EpiGate E{(const bf16_t*)(ws + WS_XC), (unsigned char*)(ws + WS_LA), (const float*)(ws + WS_CTL + CT_SPL), (unsigned)WS_GBIAS}; \
        pg8::gemm_phase<false, false>(C.lds, ws, 256, 1024, 256, S, E); mini_gate(C); }
    if (IN(3)) { PH_BODY_3 } if (REPS(3) > 1 && IN(3)) { xcd_barrier(bar); PH_BODY_3 }
    SEAM(3);
    #define PH_BODY_4 phase_scan(C);
    if (IN(4)) { PH_BODY_4 } if (REPS(4) > 1 && IN(4)) { xcd_barrier(bar); PH_BODY_4 }
    SEAM(4);
    #define PH_BODY_5 { DenseSched S{(unsigned)WS_G, (unsigned)WS_LOUT, 1024, 1024, 128, 4, C.G, C.gc}; EpiRes<true> E{(bf16_t*)(ws + WS_PRE), P.in[I_X], P.in[I_META], nullptr, NTOK}; \
        pg8::gemm_phase<false, false>(C.lds, ws, 1024, 1024, 1024, S, E); mini_lout(C); }
    if (IN(5)) { PH_BODY_5 } if (REPS(5) > 1 && IN(5)) { xcd_barrier(bar); PH_BODY_5 }
    SEAM(5);
    #define PH_BODY_6 phase_lnr(C, 0, NTOK);
    if (IN(6)) { PH_BODY_6 } if (REPS(6) > 1 && IN(6)) { xcd_barrier(bar); PH_BODY_6 }
    SEAM(6);
    #define PH_BODY_7 phase_pos(C, 0, NTOK);
    if (IN(7)) { PH_BODY_7 } if (REPS(7) > 1 && IN(7)) { xcd_barrier(bar); PH_BODY_7 }
    SEAM(7);
    #define PH_BODY_8 { const int nM = moe_prep(C, (const int*)(ws + WS_CTL + CT_TEXP)); \
        MoeSched S{(unsigned)WS_HB8, (unsigned)WS_WGU, (unsigned)WS_TOK, (const LAS int*)(C.lds + pg8::TEXP_OFF), 2048u * 1024u, nM, 8, C.G, C.gc}; EpiGlu E{(unsigned char*)(ws + WS_ACT), (unsigned)WS_BIAS}; \
        pg8::gemm_phase<true, true>(C.lds, ws, 512, 512, 512, S, E); }
    if (IN(8)) { PH_BODY_8 } if (REPS(8) > 1 && IN(8)) { xcd_barrier(bar); PH_BODY_8 }
#ifdef PROBE_NULL8
    if (IN(8)) { xcd_barrier(bar); { const int nM = moe_prep(C, (const int*)(ws + WS_CTL + CT_TEXP));
        MoeSched S{(unsigned)WS_HB8, (unsigned)WS_WGU, (unsigned)WS_TOK, (const LAS int*)(C.lds + pg8::TEXP_OFF), 2048u * 1024u, nM, 8, C.G, C.gc}; EpiNull E{};
        pg8::gemm_phase<true, true>(C.lds, ws, 512, 512, 512, S, E); } }
#endif
    SEAM(8);
    #define PH_BODY_9 { const int nM = moe_prep(C, (const int*)(ws + WS_CTL + CT_TEXP)); \
        MoeSched S{(unsigned)WS_ACT, (unsigned)WS_WD, 0u, (const LAS int*)(C.lds + pg8::TEXP_OFF), 1024u * 1024u, nM, 4, C.G, C.gc}; EpiDown E{(unsigned char*)(ws + WS_YS), (unsigned)WS_BD}; \
        pg8::gemm_phase<true, false>(C.lds, ws, 512, 512, 512, S, E); }
    if (IN(9)) { PH_BODY_9 } if (REPS(9) > 1 && IN(9)) { xcd_barrier(bar); PH_BODY_9 }
    SEAM(9);
    #define PH_BODY_10 phase_combine(C, 0, NTOK, false);
    if (IN(10)) { PH_BODY_10 } if (REPS(10) > 1 && IN(10)) { xcd_barrier(bar); PH_BODY_10 }
    SEAM(10);
    #define PH_BODY_11 { QkvSched S{(unsigned)WS_HB8, (unsigned)WS_QKV8, 128, C.G, C.gc}; EpiQkv E{(bf16_t*)(ws + WS_Q), (bf16_t*)(ws + WS_K), (bf16_t*)(ws + WS_VT)}; \
        pg8::gemm_phase<true, false>(C.lds, ws, 512, 512, 512, S, E); mini_kv(C); }
    if (IN(11)) { PH_BODY_11 } if (REPS(11) > 1 && IN(11)) { xcd_barrier(bar); PH_BODY_11 }
    SEAM(11);
    #define PH_BODY_12 phase_attn(C);
    if (IN(12)) { PH_BODY_12 } if (REPS(12) > 1 && IN(12)) { xcd_barrier(bar); PH_BODY_12 }
    SEAM(12);
    #define PH_BODY_13 { DenseSched S{(unsigned)WS_O, (unsigned)WS_NOUT, 1024, 1024, 128, 4, C.G, C.gc}; EpiRes<false> E{(bf16_t*)(ws + WS_PRE), nullptr, nullptr, (const bf16_t*)(ws + WS_HB), NGRID}; \
        pg8::gemm_phase<false, false>(C.lds, ws, 1024, 1024, 1024, S, E); }
    if (IN(13)) { PH_BODY_13 } if (REPS(13) > 1 && IN(13)) { xcd_barrier(bar); PH_BODY_13 }
    SEAM(13);
    #define PH_BODY_14 phase_lnr(C, 1, NGRID);
    if (IN(14)) { PH_BODY_14 } if (REPS(14) > 1 && IN(14)) { xcd_barrier(bar); PH_BODY_14 }
    SEAM(14);
    #define PH_BODY_15 phase_pos(C, 1, NGRID);
    if (IN(15)) { PH_BODY_15 } if (REPS(15) > 1 && IN(15)) { xcd_barrier(bar); PH_BODY_15 }
    SEAM(15);
    #define PH_BODY_16 { const int nM = moe_prep(C, (const int*)(ws + WS_CTL + CT_TEXP) + 1024); \
        MoeSched S{(unsigned)WS_HB8, (unsigned)(WS_WGU + (size_t)32 * 2048 * 1024), (unsigned)(WS_TOK + 1 * MiB), (const LAS int*)(C.lds + pg8::TEXP_OFF), 2048u * 1024u, nM, 8, C.G, C.gc}; EpiGlu E{(unsigned char*)(ws + WS_ACT), (unsigned)(WS_BIAS + 32 * 2048 * 4)}; \
        pg8::gemm_phase<true, true>(C.lds, ws, 512, 512, 512, S, E); }
    if (IN(16)) { PH_BODY_16 } if (REPS(16) > 1 && IN(16)) { xcd_barrier(bar); PH_BODY_16 }
    SEAM(16);
    #define PH_BODY_17 { const int nM = moe_prep(C, (const int*)(ws + WS_CTL + CT_TEXP) + 1024); \
        MoeSched S{(unsigned)WS_ACT, (unsigned)(WS_WD + (size_t)32 * 1024 * 1024), 0u, (const LAS int*)(C.lds + pg8::TEXP_OFF), 1024u * 1024u, nM, 4, C.G, C.gc}; EpiDown E{(unsigned char*)(ws + WS_YS), (unsigned)(WS_BD + 32 * 1024 * 4)}; \
        pg8::gemm_phase<true, false>(C.lds, ws, 512, 512, 512, S, E); }
    if (IN(17)) { PH_BODY_17 } if (REPS(17) > 1 && IN(17)) { xcd_barrier(bar); PH_BODY_17 }
    SEAM(17);
    #define PH_BODY_18 phase_combine(C, 1, NGRID, true);
    if (IN(18)) { PH_BODY_18 } if (REPS(18) > 1 && IN(18)) { xcd_barrier(bar); PH_BODY_18 }
#undef ws
#undef IN
#undef SEAM
}

#ifndef MK_PER_PHASE
#define MK_PER_PHASE 0
#endif
extern "C" void kernel_launch(void* const* d_in, const int* in_sizes, int n_in, void* d_out, int out_size, void* d_ws, size_t ws_size, hipStream_t stream) {
    static int grid = 0;
    if (grid == 0) {
        if (n_in != 25 || ws_size < WS_END || out_size != NGRID * D) { fprintf(stderr, "kernel_launch: unexpected problem (n_in %d, ws %zu, out %d)\n", n_in, ws_size, out_size); grid = -1; return; }
        int dev = 0, cus = 0, per_cu = 0;
        if (hipGetDevice(&dev) != hipSuccess || hipDeviceGetAttribute(&cus, hipDeviceAttributeMultiprocessorCount, dev) != hipSuccess) { grid = -1; return; }
        if (hipFuncSetAttribute((const void*)hybrid_fwd, hipFuncAttributeMaxDynamicSharedMemorySize, LDS_BYTES) != hipSuccess) { fprintf(stderr, "kernel_launch: hipFuncSetAttribute failed\n"); grid = -1; return; }
        if (hipOccupancyMaxActiveBlocksPerMultiprocessor(&per_cu, (const void*)hybrid_fwd, NTHREADS, LDS_BYTES) != hipSuccess || per_cu < 1) { fprintf(stderr, "kernel_launch: occupancy query failed (%d)\n", per_cu); grid = -1; return; }
        grid = cus * 1;
        if (grid > 256) grid = 256;
    }
    if (grid < 0) return;
    if (hipMemsetAsync((char*)d_ws + WS_CTL + CT_BAR, 0, 16384, stream) != hipSuccess) { fprintf(stderr, "kernel_launch: memset failed\n"); return; }
    Params p{};
    for (int i = 0; i < 25; ++i) p.in[i] = (const float*)d_in[i];
    p.out = (float*)d_out; p.ws = (unsigned char*)d_ws;
#if MK_PER_PHASE
    for (int ph = 0; ph < 19; ++ph) { p.ph_lo = ph; p.ph_hi = ph + 1; void* args[] = {&p};
        hipError_t e = hipLaunchCooperativeKernel((void*)hybrid_fwd, dim3(grid), dim3(NTHREADS), args, LDS_BYTES, stream);
        if (e != hipSuccess) { fprintf(stderr, "launch phase %d failed: %s\n", ph, hipGetErrorString(e)); break; } }
#else
    p.ph_lo = 0; p.ph_hi = 19; void* args[] = {&p};
    hipError_t e = hipLaunchCooperativeKernel((void*)hybrid_fwd, dim3(grid), dim3(NTHREADS), args, LDS_BYTES, stream);
    if (e != hipSuccess) fprintf(stderr, "cooperative launch failed: %s (grid %d)\n", hipGetErrorString(e), grid);
#endif
}
```

```cpp
#include <hip/hip_runtime.h>
#include <hip/hip_cooperative_groups.h>
#include <cstdio>
#include <cstdint>
namespace cg = cooperative_groups;

#define LAS __attribute__((address_space(3)))
typedef unsigned short bf16_t;
typedef short bf16x8 __attribute__((ext_vector_type(8)));
typedef float f32x4 __attribute__((ext_vector_type(4)));
typedef float f32x2 __attribute__((ext_vector_type(2)));
typedef unsigned u32x4 __attribute__((ext_vector_type(4)));
typedef unsigned u32x2 __attribute__((ext_vector_type(2)));

constexpr int NB = 8, SEQ = 4096, D = 1024, NMETA = 16, LSEQ = SEQ + NMETA;
constexpr int NGRID = NB * SEQ;
constexpr int NTOK = NGRID + NB * NMETA;
constexpr int MPAD = 33024;
constexpr int NEXP = 32, TOPK = 4;
constexpr int PMAX = 139776;
constexpr int MTMAX = PMAX / 256;
constexpr float DN_ALPHA = 1.41421356237f;
constexpr float LN_EPS = 1e-5f;
constexpr int NTHREADS = 512, NWAVES = 8;

constexpr size_t MiB = 1u << 20;
constexpr size_t ACT_BYTES = (size_t)MPAD * D * 2;
constexpr size_t WS_CTL   = 0;
constexpr size_t WS_WIN   = 4 * MiB;
constexpr size_t WS_GATE  = WS_WIN + 4 * MiB;
constexpr size_t WS_LOUT  = WS_GATE + 2 * MiB;
constexpr size_t WS_QKV   = WS_LOUT + 2 * MiB;
constexpr size_t WS_NOUT  = WS_QKV + 6 * MiB;
constexpr size_t WS_WGU   = WS_NOUT + 2 * MiB;
constexpr size_t WS_WD    = WS_WGU + 128 * MiB;
constexpr size_t WS_HB    = WS_WD + 64 * MiB;
constexpr size_t WS_HB8   = WS_HB + 65 * MiB;
constexpr size_t WS_PRE   = WS_HB8 + 33 * MiB;
constexpr size_t WS_H     = WS_PRE + 129 * MiB;
constexpr size_t WS_SCR   = WS_H + 129 * MiB;
constexpr size_t WS_XR = WS_SCR, WS_XC = WS_XR + 65 * MiB, WS_GY = WS_XC + 65 * MiB, WS_LA = WS_GY + 65 * MiB, WS_BB = WS_LA + 130 * MiB, WS_HF = WS_BB + 130 * MiB, WS_G = WS_HF + 65 * MiB;
constexpr size_t WS_SCR_END0 = WS_G + 65 * MiB;
constexpr size_t WS_XS = WS_SCR, WS_ACT = WS_XS + 137 * MiB, WS_YS = WS_ACT + 137 * MiB;
constexpr size_t WS_SCR_END1 = WS_YS + 274 * MiB;
constexpr size_t WS_Q = WS_SCR, WS_K = WS_Q + 65 * MiB, WS_VT = WS_K + 65 * MiB, WS_O = WS_VT + 65 * MiB;
constexpr size_t WS_BIAS = (WS_SCR_END0 > WS_SCR_END1 ? WS_SCR_END0 : WS_SCR_END1);
constexpr size_t WS_BD = WS_BIAS + 2 * 32 * 2048 * 4;
constexpr size_t WS_GBIAS = WS_BD + 2 * 32 * 1024 * 4;
constexpr size_t WS_TOK = WS_BIAS + 1 * MiB;
constexpr size_t WS_QKV8 = WS_TOK + 2 * MiB;
constexpr size_t WS_END = WS_QKV8 + 3 * MiB;
static_assert((size_t)PMAX * 4 <= 1 * MiB, "token offset table");
static_assert(ACT_BYTES <= 65 * MiB && (size_t)PMAX * D * 2 <= 274 * MiB && (size_t)PMAX * D <= 137 * MiB && (size_t)MPAD * D <= 33 * MiB && (size_t)MPAD * D * 4 <= 129 * MiB, "ws map");
static_assert(WS_END <= (size_t)2040 * MiB, "ws map must fit 4x the largest input tensor");
constexpr size_t CT_BC      = 4096;
constexpr size_t CT_TEXP    = CT_BC + 2 * 256 * 32 * 4;
constexpr size_t CT_SPL     = CT_TEXP + 2 * 1024 * 4;
constexpr size_t CT_EID     = 256 * 1024;
constexpr size_t CT_GATEV   = CT_EID + 2 * (size_t)NTOK * 4 * 4;
constexpr size_t CT_POS     = CT_GATEV + 2 * (size_t)NTOK * 4 * 4;
static_assert(CT_POS + 2 * (size_t)NTOK * 4 * 4 <= 4 * MiB, "ctl map");

constexpr int LDS_BYTES = 155648;

__device__ __forceinline__ unsigned f2bf(float f) { unsigned u = __builtin_bit_cast(unsigned, f); return (u + 0x7fffu + ((u >> 16) & 1u)) >> 16; }
__device__ __forceinline__ unsigned cvt_pk_bf16(float lo, float hi);
__device__ __forceinline__ unsigned pk2(float lo, float hi) { return cvt_pk_bf16(lo, hi); }
typedef __bf16 bf16x2_t __attribute__((ext_vector_type(2)));
__device__ __forceinline__ unsigned cvt_pk_bf16(float lo, float hi) { const f32x2 v = {lo, hi}; return __builtin_bit_cast(unsigned, __builtin_convertvector(v, bf16x2_t)); }
__device__ __forceinline__ unsigned pk4_fp8(float a, float b, float c, float d) { int w = __builtin_amdgcn_cvt_pk_fp8_f32(a, b, 0, false); w = __builtin_amdgcn_cvt_pk_fp8_f32(c, d, w, true); return (unsigned)w; }
__device__ __forceinline__ float dot2_bf16(unsigned a, unsigned b, float c) { return __builtin_amdgcn_fdot2_f32_bf16(__builtin_bit_cast(bf16x2_t, a), __builtin_bit_cast(bf16x2_t, b), c, false); }
__device__ __forceinline__ void unpack8_fp8(const u32x2 w, float (&o)[8]) { const f32x2 a = __builtin_amdgcn_cvt_pk_f32_fp8((int)w.x, false), b = __builtin_amdgcn_cvt_pk_f32_fp8((int)w.x, true), c = __builtin_amdgcn_cvt_pk_f32_fp8((int)w.y, false), d = __builtin_amdgcn_cvt_pk_f32_fp8((int)w.y, true);
    o[0] = a.x; o[1] = a.y; o[2] = b.x; o[3] = b.y; o[4] = c.x; o[5] = c.y; o[6] = d.x; o[7] = d.y; }
__device__ __forceinline__ float bflo(unsigned w) { return __builtin_bit_cast(float, w << 16); }
__device__ __forceinline__ float bfhi(unsigned w) { return __builtin_bit_cast(float, w & 0xffff0000u); }
__device__ __forceinline__ void unpack8(const u32x4 w, float (&o)[8]);
__device__ __forceinline__ float fast_exp2(float x) { return __builtin_amdgcn_exp2f(x); }
__device__ __forceinline__ float fast_rcp(float x) { return __builtin_amdgcn_rcpf(x); }
__device__ __forceinline__ float sigmoidf_(float x) { return fast_rcp(1.0f + fast_exp2(-1.44269504089f * x)); }
__device__ __forceinline__ float wave_sum(float v) {
#pragma unroll
    for (int o = 1; o < 64; o <<= 1) v += __shfl_xor(v, o);
    return v;
}
template <int CTRL> __device__ __forceinline__ float dpp_movf(float v) { return __builtin_bit_cast(float, __builtin_amdgcn_update_dpp(0, __builtin_bit_cast(int, v), CTRL, 0xf, 0xf, true)); }
__device__ __forceinline__ float readlane_f(float v, int l) { return __builtin_bit_cast(float, __builtin_amdgcn_readlane(__builtin_bit_cast(int, v), l)); }
__device__ __forceinline__ float wave_sum_dpp(float v) {
    v += dpp_movf<0xB1>(v);
    v += dpp_movf<0x4E>(v);
    v += dpp_movf<0x141>(v);
    v += dpp_movf<0x140>(v);
    return (readlane_f(v, 0) + readlane_f(v, 16)) + (readlane_f(v, 32) + readlane_f(v, 48));
}
__device__ __forceinline__ int seqrow(int b, int s) { return s < NMETA ? NGRID + NMETA * b + s : SEQ * b + (s - NMETA); }
__device__ __forceinline__ int batch_row(int b, int lr) { return lr < SEQ ? b * SEQ + lr : NGRID + 16 * b + (lr - SEQ); }

struct Params {
    const float* in[25];
    float* out;
    unsigned char* ws;
    int ph_lo, ph_hi;
};
struct Ctx {
    LAS unsigned char* lds;
    int G, bid, gc;
    int vx, vr, gs;
    unsigned char* ws;
    const float* const* in;
    float* out;
};
__device__ __forceinline__ int fresh_tid() { int t = threadIdx.x; asm volatile("" : "+v"(t)); return t; }
__device__ __forceinline__ unsigned char* fresh_ws(unsigned char* p) { asm volatile("" : "+s"(p)); return p; }
#define PHASE_IDS unsigned char* const wsl = fresh_ws(C.ws); (void)wsl; const int tid = fresh_tid(); const int lane = tid & 63; const int wave = __builtin_amdgcn_readfirstlane(tid >> 6); (void)lane; (void)wave;
enum { I_X = 0, I_META, I_WIN, I_CONVW, I_CONVB, I_WA, I_BA, I_WX, I_BX, I_LAM, I_LOUT, I_WQKV, I_RPB, I_MBIAS, I_NOUT, I_LNMG, I_LNMB, I_RW, I_RB, I_WGU, I_BGU, I_WD, I_BD, I_LNFG, I_LNFB };

namespace pg8 {
constexpr int BM = 256, BK = 64, HALF = 128, HTB = HALF * BK * 2, STAGE_BYTES = 8 * HTB, NXCD = 8, WGM = 8;
constexpr int SIDE_OFF = STAGE_BYTES, TEXP_OFF = STAGE_BYTES + 2048, TOK_OFF = STAGE_BYTES + 2048 + 4096;
__device__ __forceinline__ int lds_byte(int r, int c) { const int st = (r >> 4) * 2 + (c >> 5), rr = r & 15, cc = c & 31, ob = rr * 64 + cc * 2; return st * 1024 + (ob ^ (((ob >> 9) & 1) << 5)); }
__device__ __forceinline__ void stage_rc(int b, int& R, int& C) { const int st = b / 1024, sb = b % 1024, swz = sb ^ (((sb >> 9) & 1) << 5); R = (st >> 1) * 16 + swz / 64; C = (st & 1) * 32 + (swz % 64) / 2; }
__device__ __forceinline__ int perm32(int rho) { const int n = rho >> 4, i = rho & 15; return 8 * (i >> 2) + 4 * n + (i & 3); }

typedef int v8i __attribute__((ext_vector_type(8)));
typedef int v4i __attribute__((ext_vector_type(4)));
__device__ __forceinline__ v8i cat8(bf16x8 a, bf16x8 b) { const v4i x = __builtin_bit_cast(v4i, a), y = __builtin_bit_cast(v4i, b); return __builtin_shufflevector(x, y, 0, 1, 2, 3, 4, 5, 6, 7); }
struct Unit { unsigned ao, bo, to; int pm, pn, aux; };

__device__ __forceinline__ void tile_of(int L, int nM, int nN, int& pm, int& pn) {
    const int nwg = nM * nN; int wgid = L;
    { const int q = nwg / NXCD, r = nwg % NXCD, xcd = wgid % NXCD, off = wgid / NXCD; wgid = (xcd < r ? xcd * (q + 1) : r * (q + 1) + (xcd - r) * q) + off; }
    const int nig = WGM * nN, gid = wgid / nig, fm = gid * WGM, gsz = (nM - fm) < WGM ? (nM - fm) : WGM;
    pm = fm + ((wgid % nig) % gsz); pn = (wgid % nig) / gsz;
}

template <bool F8, bool GATHER, class Epi, class Sched>
__device__ __forceinline__ void gemm_phase(LAS unsigned char* lds, const unsigned char* wsbase, const int K, const int lda, const int ldb, const Sched& S, const Epi& E) {
    const __amdgpu_buffer_rsrc_t rsrc = __builtin_amdgcn_make_buffer_rsrc((void*)wsbase, 0, 0xFFFFFFFF, 0x00020000);
    const int tid = fresh_tid(), wid = __builtin_amdgcn_readfirstlane(tid >> 6), lane = tid & 63, wr = wid >> 2, wc = wid & 3;
    const int nt = K / BK;
    int f8scales = 0; if constexpr (F8) { f8scales = Epi::SCALES; asm volatile("" : "+v"(f8scales)); }
    int voffA, voffB;
    { int R, C; stage_rc(tid * 16, R, C); const int Rb = Epi::PERM ? ((R & ~31) + perm32(R & 31)) : R; voffA = ((GATHER ? 0 : R * lda) + C) * 2; voffB = (Rb * ldb + C) * 2; }
    const int tokb = (16 * (wid >> 1) + (lane >> 2)) * 4;
    const unsigned kstep = (unsigned)(BK * 2);
    const unsigned hstepA = (unsigned)HALF * lda * 2, hstepB = (unsigned)HALF * ldb * 2;
    const unsigned ldsw = (unsigned)wid * 1024u;
    const int aoff = lds_byte(wr * 64 + (lane & 15), (lane >> 4) * 8), boff = lds_byte(wc * 32 + (lane & 15), (lane >> 4) * 8);
#define PG8_SA(b, h) (((b) * 2 + (h)) * HTB)
#define PG8_SB(b, h) ((4 + (b) * 2 + (h)) * HTB)
#define PG8_STAGE(bufoff, gbase, voff) do { _Pragma("unroll") for (int _i = 0; _i < 2; ++_i) \
        __builtin_amdgcn_raw_ptr_buffer_load_lds(rsrc, (LAS void*)(lds + (bufoff) + ldsl + _i * 8192), 16, voff, __builtin_amdgcn_readfirstlane((int)((gbase) + (unsigned)_i * (hstep##voff >> 1))), 0, 0); } while (0)
#define hstepvoffA hstepA
#define hstepvoffB hstepB
#define PG8_STAGE_A(bufoff, aoffs, h, par) do { if constexpr (GATHER) { _Pragma("unroll") for (int _i = 0; _i < 2; ++_i) { \
            const int _tk = *(const LAS int*)(lds + TOK_OFF + (par) * 1024 + tokb + ((h) * 128 + _i * 64) * 4); \
            __builtin_amdgcn_raw_ptr_buffer_load_lds(rsrc, (LAS void*)(lds + (bufoff) + ldsl + _i * 8192), 16, _tk + voffA, __builtin_amdgcn_readfirstlane((int)(aoffs)), 0, 0); } } \
        else { PG8_STAGE(bufoff, (aoffs) + (unsigned)(h) * hstepA, voffA); } } while (0)
#define PG8_TOK(unit, par) do { if constexpr (GATHER) { if (wid == 0) __builtin_amdgcn_raw_ptr_buffer_load_lds(rsrc, (LAS void*)(lds + TOK_OFF + (par) * 1024), 16, lane * 16, (int)(unit).to, 0, 0); } } while (0)
#define PG8_LDA(dst, b, h) do { _Pragma("unroll") for (int m = 0; m < 4; ++m) _Pragma("unroll") for (int k = 0; k < 2; ++k) dst[m][k] = *(const LAS bf16x8*)(lds + PG8_SA(b, h) + aoff + m * 2048 + k * 1024); } while (0)
#define PG8_LDB(dst, b, h) do { _Pragma("unroll") for (int n = 0; n < 2; ++n) _Pragma("unroll") for (int k = 0; k < 2; ++k) dst[n][k] = *(const LAS bf16x8*)(lds + PG8_SB(b, h) + boff + n * 2048 + k * 1024); } while (0)
#define PG8_MMA(ai, bj, At, Bt) do { __builtin_amdgcn_s_setprio(1); _Pragma("unroll") for (int m = 0; m < 4; ++m) _Pragma("unroll") for (int n = 0; n < 2; ++n) { \
        if constexpr (F8) { asm volatile("v_mfma_scale_f32_16x16x128_f8f6f4 %0, %1, %2, %0, %3, %3 op_sel:[0,1,0] op_sel_hi:[0,0,0]" : "+v"(acc[ai][bj][m][n]) : "v"(cat8(Bt[n][0], Bt[n][1])), "v"(cat8(At[m][0], At[m][1])), "v"(f8scales)); } \
        else { _Pragma("unroll") for (int k = 0; k < 2; ++k) acc[ai][bj][m][n] = __builtin_amdgcn_mfma_f32_16x16x32_bf16(Bt[n][k], At[m][k], acc[ai][bj][m][n], 0, 0, 0); } } \
        __builtin_amdgcn_s_setprio(0); } while (0)
#define PG8_WAIT_V(n) asm volatile("s_waitcnt vmcnt(" #n ")" ::: "memory")
#define PG8_WAIT_L(n) asm volatile("s_waitcnt lgkmcnt(" #n ")" ::: "memory")
#define PG8_BAR __builtin_amdgcn_s_barrier()
#define PG8_SCHED __builtin_amdgcn_sched_barrier(0)
    Unit cur, nxt; int ui = 0;
    if (!S.next(0, cur)) return;
    f32x4 acc[2][2][4][2];
    bf16x8 At[4][2], B0[2][2], B1[2][2];
#define PG8_INIT(par) do { if constexpr (Epi::SIDE) { const int _l = fresh_tid() & 63; E.init(acc, (const LAS float*)(lds + SIDE_OFF + (par) * 1024), wc, _l >> 4); } \
        else { _Pragma("unroll") for (int a = 0; a < 2; ++a) _Pragma("unroll") for (int b = 0; b < 2; ++b) _Pragma("unroll") for (int m = 0; m < 4; ++m) _Pragma("unroll") for (int n = 0; n < 2; ++n) acc[a][b][m][n] = (f32x4){0.f, 0.f, 0.f, 0.f}; } } while (0)
    unsigned cA = cur.ao, cB = cur.bo;
    unsigned ldsl = ldsw; asm volatile("" : "+s"(ldsl));
#define PG8_SIDE(unit, par) do { if constexpr (Epi::SIDE) { if (wid == 0) __builtin_amdgcn_raw_ptr_buffer_load_lds(rsrc, (LAS void*)(lds + SIDE_OFF + (par) * 1024), 16, lane * 16, (int)E.side_off(unit), 0, 0); } } while (0)
    PG8_SIDE(cur, 0);
    if constexpr (GATHER) PG8_TOK(cur, 0);
    if constexpr (GATHER || Epi::SIDE) { asm volatile("s_waitcnt vmcnt(0)" ::: "memory"); PG8_BAR; }
    PG8_INIT(0);
    PG8_STAGE(PG8_SB(0, 0), cB, voffB); PG8_STAGE(PG8_SB(0, 1), cB + hstepB, voffB); PG8_STAGE_A(PG8_SA(0, 0), cA, 0, 0); PG8_STAGE_A(PG8_SA(0, 1), cA, 1, 0);
    if (wr == 1) PG8_BAR;
    PG8_WAIT_V(2); PG8_BAR;
    PG8_STAGE(PG8_SB(1, 0), cB + kstep, voffB); PG8_STAGE_A(PG8_SA(1, 0), cA + kstep, 0, 0); PG8_STAGE(PG8_SB(1, 1), cB + hstepB + kstep, voffB);
    PG8_WAIT_V(6); PG8_BAR;
    for (;;) {
        const bool has_next = S.next(ui + 1, nxt);
        if (has_next) { PG8_TOK(nxt, (ui + 1) & 1); PG8_SIDE(nxt, (ui + 1) & 1); }
        const unsigned nA = has_next ? nxt.ao : cA, nB = has_next ? nxt.bo : cB;
#pragma unroll 1
        for (int t = 0; t < nt; t += 2) {
            const bool last = (t == nt - 2);
            ldsl = ldsw; asm volatile("" : "+s"(ldsl));
            const int parc = ui & 1, parn = (ui + ((last && has_next) ? 1 : 0)) & 1;
            const unsigned a1 = cA + (unsigned)(t + 1) * kstep;
            const unsigned a2 = last ? nA : cA + (unsigned)(t + 2) * kstep, b2 = last ? nB : cB + (unsigned)(t + 2) * kstep;
            const unsigned a3 = a2 + kstep, b3 = b2 + kstep;
            PG8_LDB(B0, 0, 0); PG8_LDB(B1, 0, 1); PG8_SCHED; PG8_LDA(At, 0, 0); PG8_STAGE_A(PG8_SA(1, 1), a1, 1, parc);
            PG8_WAIT_V(8); PG8_WAIT_L(0); PG8_BAR; PG8_MMA(0, 0, At, B0); PG8_MMA(0, 1, At, B1); PG8_BAR; PG8_SCHED;
            PG8_LDA(At, 0, 1); PG8_STAGE(PG8_SB(0, 0), b2, voffB); PG8_STAGE(PG8_SB(0, 1), b2 + hstepB, voffB); PG8_STAGE_A(PG8_SA(0, 0), a2, 0, parn);
            PG8_WAIT_V(8); PG8_WAIT_L(0); PG8_BAR; PG8_MMA(1, 0, At, B0); PG8_MMA(1, 1, At, B1); PG8_BAR; PG8_SCHED;
            PG8_LDB(B0, 1, 0); PG8_LDB(B1, 1, 1); PG8_SCHED; PG8_LDA(At, 1, 0); PG8_STAGE_A(PG8_SA(0, 1), a2, 1, parn);
            PG8_WAIT_V(8); PG8_WAIT_L(0); PG8_BAR; PG8_MMA(0, 0, At, B0); PG8_MMA(0, 1, At, B1); PG8_BAR; PG8_SCHED;
            PG8_LDA(At, 1, 1); PG8_STAGE(PG8_SB(1, 0), b3, voffB); PG8_STAGE(PG8_SB(1, 1), b3 + hstepB, voffB); PG8_STAGE_A(PG8_SA(1, 0), a3, 0, parn);
            PG8_WAIT_V(8); PG8_WAIT_L(0); PG8_BAR; PG8_MMA(1, 0, At, B0); PG8_MMA(1, 1, At, B1); PG8_BAR; PG8_SCHED;
        }
        if constexpr (F8) asm volatile("s_nop 15\n\ts_nop 15" ::: "memory");
        if (wr == 0) PG8_BAR;
        { const int l2 = fresh_tid() & 63; E(acc, cur, wr, wc, l2 & 15, l2 >> 4, (const LAS float*)(lds + SIDE_OFF + (ui & 1) * 1024)); }
        if (!has_next) break;
        cur = nxt; cA = nA; cB = nB; ++ui;
        PG8_INIT(ui & 1);
        if (wr == 1) PG8_BAR;
    }
    PG8_WAIT_V(0);
    PG8_BAR;
#undef PG8_SA
#undef PG8_SB
#undef PG8_STAGE
#undef PG8_STAGE_A
#undef PG8_TOK
#undef PG8_SIDE
#undef PG8_INIT
#undef hstepvoffA
#undef hstepvoffB
#undef PG8_LDA
#undef PG8_LDB
#undef PG8_MMA
#undef PG8_WAIT_V
#undef PG8_WAIT_L
#undef PG8_BAR
#undef PG8_SCHED
}
}

using pg8::Unit;

struct DenseSched {
    unsigned A, Bt; int lda, ldb, nN, gs, vr, vx;
    __device__ __forceinline__ bool next(int i, Unit& u) const {
        const int L = i * gs + vr; if (vx >= 8 || L >= 16 * nN) return false;
        u.pm = 16 * vx + L / nN; u.pn = L % nN; u.aux = 0; u.to = 0;
        u.ao = A + (unsigned)u.pm * 256 * lda * 2; u.bo = Bt + (unsigned)u.pn * 256 * ldb * 2; return true;
    }
};
struct GateSched {
    unsigned XC, GT; int gs, vr, vx;
    __device__ __forceinline__ bool next(int i, Unit& u) const {
        const int L = i * gs + vr; if (vx >= 8 || L >= 256) return false;
        const int nb = L >> 6; u.pm = 16 * vx + ((L & 63) >> 2); u.pn = L & 3; u.aux = nb; u.to = 0;
        u.ao = XC + ((unsigned)u.pm * 256 * 1024 + 256 * nb) * 2; u.bo = GT + ((unsigned)nb * 1024 + 256 * u.pn) * 256 * 2; return true;
    }
};
struct QkvSched {
    unsigned HB, WT; int gs, vr, vx;
    __device__ __forceinline__ bool next(int i, Unit& u) const {
        const int L = i * gs + vr; if (vx >= 8 || L >= 128 + 64) return false; u.to = 0;
        if (L < 128) { u.pm = 16 * vx + (L >> 3); u.pn = L & 7; u.aux = 0; u.ao = HB + (unsigned)u.pm * 256 * 1024; u.bo = WT + (unsigned)u.pn * 256 * 1024; }
        else { const int Ly = L - 128; u.pm = Ly & 3; u.pn = 16 * vx + (Ly >> 2); u.aux = 1; u.ao = WT + (unsigned)(2048 + u.pm * 256) * 1024; u.bo = HB + (unsigned)u.pn * 256 * 1024; }
        return true;
    }
};
struct MoeSched {
    unsigned A, W, tok; const LAS int* texp; unsigned wstride; int nM, nN, G, c;
    __device__ __forceinline__ bool next(int i, Unit& u) const {
        const int L = i * G + c; if (L >= nM * nN) return false;
        pg8::tile_of(L, nM, nN, u.pm, u.pn);
        const int e = __builtin_amdgcn_readfirstlane(texp[u.pm]); u.aux = e;
        u.ao = tok ? A : A + (unsigned)u.pm * 256 * 1024; u.to = tok + (unsigned)u.pm * 1024; u.bo = W + (unsigned)e * wstride + (unsigned)u.pn * 256 * 1024; return true;
    }
};

#define EPI_ARGS const f32x4 (&acc)[2][2][4][2], const Unit& u, int wr, int wc, int fr, int fq, const LAS float* side
struct EpiWin {
    static constexpr bool PERM = true, SIDE = false;
    bf16_t* XR; bf16_t* GY;
    __device__ __forceinline__ void operator()(EPI_ARGS) const {
        const int row0 = u.pm * 256 + wr * 64 + fr;
        if (u.pn < 4) {
            const int col0 = u.pn * 256 + wc * 32 + 8 * fq;
#pragma unroll
            for (int ai = 0; ai < 2; ++ai)
#pragma unroll
                for (int m = 0; m < 4; ++m) { bf16_t* rowp = XR + (size_t)(row0 + ai * 128 + m * 16) * D + col0;
#pragma unroll
                    for (int bj = 0; bj < 2; ++bj) { const f32x4 v0 = acc[ai][bj][m][0], v1 = acc[ai][bj][m][1];
                        u32x4 w; w.x = cvt_pk_bf16(v0[0], v0[1]); w.y = cvt_pk_bf16(v0[2], v0[3]); w.z = cvt_pk_bf16(v1[0], v1[1]); w.w = cvt_pk_bf16(v1[2], v1[3]);
                        *(u32x4*)(rowp + bj * 128) = w; } }
        } else {
#pragma unroll
            for (int ai = 0; ai < 2; ++ai)
#pragma unroll
                for (int m = 0; m < 4; ++m) { const int row = row0 + ai * 128 + m * 16;
#pragma unroll
                    for (int bj = 0; bj < 2; ++bj) { const int g = (u.pn - 4) * 8 + bj * 4 + wc;
                        float o[8];
#pragma unroll
                        for (int n = 0; n < 2; ++n)
#pragma unroll
                            for (int j = 0; j < 4; ++j) { const float v = acc[ai][bj][m][n][j]; const float z = 1.5957691216f * (v + 0.044715f * v * v * v); o[n * 4 + j] = v * sigmoidf_(z); }
                        u32x4 w; w.x = cvt_pk_bf16(o[0], o[1]); w.y = cvt_pk_bf16(o[2], o[3]); w.z = cvt_pk_bf16(o[4], o[5]); w.w = cvt_pk_bf16(o[6], o[7]);
                        *(u32x4*)(GY + ((size_t)g * MPAD + row) * 32 + 8 * fq) = w; } }
        }
    }
};
struct EpiGate {
    static constexpr bool PERM = true, SIDE = true;
    const bf16_t* XC; unsigned char* LB; const float* spl; unsigned bias_off;
    __device__ __forceinline__ unsigned side_off(const Unit& u) const { return bias_off + (unsigned)((((u.pn >> 1) * 4 + u.aux) * 2 + (u.pn & 1)) * 1024); }
    __device__ __forceinline__ void init(f32x4 (&acc)[2][2][4][2], const LAS float* side, int wc, int fq) const {
#pragma unroll
        for (int bj = 0; bj < 2; ++bj)
#pragma unroll
            for (int n = 0; n < 2; ++n) { const f32x4 b = *(const LAS f32x4*)(side + 128 * bj + 32 * wc + 8 * fq + 4 * n);
#pragma unroll
                for (int ai = 0; ai < 2; ++ai)
#pragma unroll
                    for (int m = 0; m < 4; ++m) acc[ai][bj][m][n] = b; }
    }
    __device__ __forceinline__ void operator()(EPI_ARGS) const {
        const int nb = u.aux, dir = u.pn >> 1, half = u.pn & 1;
        const int ch0 = 256 * nb + 128 * half + 32 * wc + 8 * fq, g = ch0 >> 5;
        const int row0 = u.pm * 256 + wr * 64 + fr;
        float csp[8];
        { const f32x4 p0 = *(const f32x4*)(spl + dir * 1024 + ch0), p1 = *(const f32x4*)(spl + dir * 1024 + ch0 + 4);
#pragma unroll
          for (int j = 0; j < 4; ++j) { csp[j] = (-2.0f / 256.0f) * p0[j]; csp[4 + j] = (-2.0f / 256.0f) * p1[j]; } }
        u32x4 xnext = *(const u32x4*)(XC + (size_t)row0 * D + ch0);
#pragma unroll
        for (int ai = 0; ai < 2; ++ai)
#pragma unroll
            for (int m = 0; m < 4; ++m) { const int row = row0 + ai * 128 + m * 16;
                const u32x4 xw = xnext;
                { const int it = ai * 4 + m + 1, rn = row0 + (it >> 2) * 128 + (it & 3) * 16; if (it < 8) xnext = *(const u32x4*)(XC + (size_t)rn * D + ch0); }
                float xc[8]; unpack8(xw, xc);
                const bool start = dir == 1 && (row & (SEQ - 1)) == SEQ - 1;
                float sg[8], bb[8];
#pragma unroll
                for (int n = 0; n < 2; ++n)
#pragma unroll
                    for (int j = 0; j < 4; ++j) { const int i = n * 4 + j;
                        const float sga = fast_rcp(__builtin_fmaf(fast_exp2(-1.44269504089f * acc[ai][0][m][n][j]), 1.0f / 256.0f, 1.0f / 256.0f));
                        const float a2 = fast_exp2(__builtin_fmaf(csp[i], sga, 6.0f));
                        const float mult = __builtin_amdgcn_sqrtf(__builtin_fabsf(64.0f - a2));
                        sg[i] = sga; bb[i] = __builtin_amdgcn_fmed3f(mult * sigmoidf_(acc[ai][1][m][n][j]) * xc[i], -448.0f, 448.0f); }
                if (start) {
#pragma unroll
                    for (int n = 0; n < 2; ++n)
#pragma unroll
                        for (int j = 0; j < 4; ++j) bb[n * 4 + j] = __builtin_amdgcn_fmed3f(8.0f * sigmoidf_(acc[ai][1][m][n][j]) * xc[n * 4 + j], -448.0f, 448.0f); }
                u32x4 w; w.x = pk4_fp8(sg[0], sg[1], sg[2], sg[3]); w.y = pk4_fp8(sg[4], sg[5], sg[6], sg[7]); w.z = pk4_fp8(bb[0], bb[1], bb[2], bb[3]); w.w = pk4_fp8(bb[4], bb[5], bb[6], bb[7]);
                *(u32x4*)(LB + (((size_t)dir * 32 + g) * MPAD + row) * 64 + 16 * fq) = w; }
    }
};
template <bool LAYER0> struct EpiRes {
    static constexpr bool PERM = true, SIDE = false;
    bf16_t* PRE; const float* x; const float* meta; const bf16_t* HB; int nrows;
    __device__ __forceinline__ void operator()(EPI_ARGS) const {
        const int row0 = u.pm * 256 + wr * 64 + fr, col0 = u.pn * 256 + wc * 32 + 8 * fq;
#pragma unroll
        for (int ai = 0; ai < 2; ++ai)
#pragma unroll
            for (int m = 0; m < 4; ++m) { const int row = row0 + ai * 128 + m * 16;
                if (row < nrows) {
#pragma unroll
                    for (int bj = 0; bj < 2; ++bj) { const int c = col0 + bj * 128; float r[8];
                        if (LAYER0) { const float* rp = (row < NGRID ? x + (size_t)row * D : meta + (size_t)((row - NGRID) & 15) * D) + c; const f32x4 r0 = *(const f32x4*)rp, r1 = *(const f32x4*)(rp + 4);
                            r[0] = r0[0]; r[1] = r0[1]; r[2] = r0[2]; r[3] = r0[3]; r[4] = r1[0]; r[5] = r1[1]; r[6] = r1[2]; r[7] = r1[3]; }
                        else { const u32x4 rw = *(const u32x4*)(HB + (size_t)row * D + c); r[0] = bflo(rw.x); r[1] = bfhi(rw.x); r[2] = bflo(rw.y); r[3] = bfhi(rw.y); r[4] = bflo(rw.z); r[5] = bfhi(rw.z); r[6] = bflo(rw.w); r[7] = bfhi(rw.w); }
                        const f32x4 a0 = acc[ai][bj][m][0], a1 = acc[ai][bj][m][1];
                        u32x4 w; w.x = cvt_pk_bf16(r[0] * DN_ALPHA + a0[0], r[1] * DN_ALPHA + a0[1]); w.y = cvt_pk_bf16(r[2] * DN_ALPHA + a0[2], r[3] * DN_ALPHA + a0[3]);
                        w.z = cvt_pk_bf16(r[4] * DN_ALPHA + a1[0], r[5] * DN_ALPHA + a1[1]); w.w = cvt_pk_bf16(r[6] * DN_ALPHA + a1[2], r[7] * DN_ALPHA + a1[3]);
                        *(u32x4*)(PRE + (size_t)row * D + c) = w; }
                }
                asm volatile("" ::: "memory"); }
    }
};
struct EpiGlu {
    static constexpr bool PERM = true, SIDE = true; static constexpr int SCALES = 0x7F79;
    unsigned char* ACT; unsigned bias_off;
    __device__ __forceinline__ unsigned side_off(const Unit& u) const { return bias_off + (unsigned)((u.aux * 8 + u.pn) * 1024); }
    __device__ __forceinline__ void init(f32x4 (&acc)[2][2][4][2], const LAS float* side, int wc, int fq) const {
#pragma unroll
        for (int bj = 0; bj < 2; ++bj)
#pragma unroll
            for (int n = 0; n < 2; ++n) { const f32x4 b = *(const LAS f32x4*)(side + 128 * bj + 32 * wc + 8 * fq + 4 * n);
#pragma unroll
                for (int ai = 0; ai < 2; ++ai)
#pragma unroll
                    for (int m = 0; m < 4; ++m) acc[ai][bj][m][n] = b; }
    }
    __device__ __forceinline__ void operator()(EPI_ARGS) const {
        const int f0 = 128 * u.pn + 32 * wc + 8 * fq;
        const int row0 = u.pm * 256 + wr * 64 + fr;
#pragma unroll
        for (int ai = 0; ai < 2; ++ai)
#pragma unroll
            for (int m = 0; m < 4; ++m) { const int row = row0 + ai * 128 + m * 16; float o[8];
#pragma unroll
                for (int n = 0; n < 2; ++n)
#pragma unroll
                    for (int j = 0; j < 4; ++j) { const int i = n * 4 + j;
                        const float glu = fminf(acc[ai][0][m][n][j], 7.0f);
                        const float lin1 = __builtin_amdgcn_fmed3f(acc[ai][1][m][n][j], -6.0f, 8.0f);
                        const float r4 = fast_rcp(__builtin_fmaf(fast_exp2(glu * (-1.702f * 1.44269504089f)), 0.25f, 0.25f));
                        o[i] = (glu * r4) * lin1; }
                u32x2 w; w.x = pk4_fp8(o[0], o[1], o[2], o[3]); w.y = pk4_fp8(o[4], o[5], o[6], o[7]);
                *(u32x2*)(ACT + (size_t)row * D + f0) = w; }
    }
};
struct EpiNull {
    static constexpr bool PERM = true, SIDE = false; static constexpr int SCALES = 0x7F79;
    __device__ __forceinline__ void operator()(EPI_ARGS) const {
#pragma unroll
        for (int ai = 0; ai < 2; ++ai)
#pragma unroll
            for (int bj = 0; bj < 2; ++bj)
#pragma unroll
                for (int m = 0; m < 4; ++m)
#pragma unroll
                    for (int n = 0; n < 2; ++n) asm volatile("" :: "v"(acc[ai][bj][m][n]));
    }
};
struct EpiDown {
    static constexpr bool PERM = true, SIDE = true; static constexpr int SCALES = 0x7D79;
    unsigned char* YS; unsigned bias_off;
    __device__ __forceinline__ unsigned side_off(const Unit& u) const { return bias_off + (unsigned)((u.aux * 4 + u.pn) * 1024); }
    __device__ __forceinline__ void init(f32x4 (&acc)[2][2][4][2], const LAS float* side, int wc, int fq) const {
#pragma unroll
        for (int bj = 0; bj < 2; ++bj)
#pragma unroll
            for (int n = 0; n < 2; ++n) { const f32x4 b = *(const LAS f32x4*)(side + 128 * bj + 32 * wc + 8 * fq + 4 * n);
#pragma unroll
                for (int ai = 0; ai < 2; ++ai)
#pragma unroll
                    for (int m = 0; m < 4; ++m) acc[ai][bj][m][n] = b; }
    }
    __device__ __forceinline__ void operator()(EPI_ARGS) const {
        const int row0 = u.pm * 256 + wr * 64 + fr, col0 = u.pn * 256 + wc * 32 + 8 * fq;
#pragma unroll
        for (int ai = 0; ai < 2; ++ai)
#pragma unroll
            for (int m = 0; m < 4; ++m) { unsigned char* rowp = YS + (size_t)(row0 + ai * 128 + m * 16) * D + col0;
#pragma unroll
                for (int bj = 0; bj < 2; ++bj) { const f32x4 v0 = acc[ai][bj][m][0] * 8.0f, v1 = acc[ai][bj][m][1] * 8.0f;
                    u32x2 w; w.x = pk4_fp8(v0[0], v0[1], v0[2], v0[3]); w.y = pk4_fp8(v1[0], v1[1], v1[2], v1[3]);
                    *(u32x2*)(rowp + bj * 128) = w; } }
    }
};
struct EpiQkv {
    static constexpr bool PERM = true, SIDE = false; static constexpr int SCALES = 0x7F79;
    bf16_t* Q; bf16_t* Kx; bf16_t* VT;
    __device__ __forceinline__ void operator()(EPI_ARGS) const {
        const int row0 = u.pm * 256 + wr * 64 + fr; bf16_t* base; int ldc, colt; float sc = 1.0f;
        if (u.aux == 0) { ldc = D; if (u.pn < 4) { base = Q; colt = u.pn * 256; sc = 0.125f * 1.44269504089f; } else { base = Kx; colt = (u.pn - 4) * 256; } }
        else { base = VT; ldc = MPAD; colt = u.pn * 256; }
        const int col0 = colt + wc * 32 + 8 * fq;
#pragma unroll
        for (int ai = 0; ai < 2; ++ai)
#pragma unroll
            for (int m = 0; m < 4; ++m) { bf16_t* rowp = base + (size_t)(row0 + ai * 128 + m * 16) * ldc + col0;
#pragma unroll
                for (int bj = 0; bj < 2; ++bj) { const f32x4 v0 = acc[ai][bj][m][0] * sc, v1 = acc[ai][bj][m][1] * sc;
                    u32x4 w; w.x = cvt_pk_bf16(v0[0], v0[1]); w.y = cvt_pk_bf16(v0[2], v0[3]); w.z = cvt_pk_bf16(v1[0], v1[1]); w.w = cvt_pk_bf16(v1[2], v1[3]);
                    *(u32x4*)(rowp + bj * 128) = w; } }
    }
};

struct CvItem { const float* src; unsigned char* dst; int ld, pitch, f8; };
__device__ __forceinline__ CvItem cv_item(const Ctx& C, unsigned char* wsl, int it) {
    constexpr int I0 = 512, I1 = 256, I2 = 256, I3 = 768, I4 = 256, I5 = 32768, I6 = 16384;
    CvItem q; int r = it;
    if (r < I0) { const int nbk = r & 63, kb = r >> 6; q.src = C.in[I_WIN] + (size_t)(128 * kb) * 2048 + 32 * nbk; q.ld = 2048; q.dst = wsl + WS_WIN + ((size_t)(32 * nbk) * 1024 + 128 * kb) * 2; q.pitch = 2048; q.f8 = 0; return q; } r -= I0;
    if (r < I1) { const int job = r >> 3, sub = r & 7, nbk = sub & 3, kb = sub >> 2;
        const int half = job & 1, which = (job >> 1) & 1, nb = (job >> 2) & 3, dir = job >> 4;
        q.src = C.in[which ? I_WX : I_WA] + (size_t)(dir * 4 + nb) * 65536 + (size_t)(128 * kb) * 256 + 128 * half + 32 * nbk; q.ld = 256;
        q.dst = wsl + WS_GATE + (((size_t)nb * 1024 + 256 * (2 * dir + half) + 128 * which + 32 * nbk) * 256 + 128 * kb) * 2; q.pitch = 512; q.f8 = 0; return q; } r -= I1;
    if (r < I2) { const int nbk = r & 31, kb = r >> 5; q.src = C.in[I_LOUT] + (size_t)(128 * kb) * 1024 + 32 * nbk; q.ld = 1024; q.dst = wsl + WS_LOUT + ((size_t)(32 * nbk) * 1024 + 128 * kb) * 2; q.pitch = 2048; q.f8 = 0; return q; } r -= I2;
    if (r < I3) { const int nbk = r % 96, kb = r / 96; q.src = C.in[I_WQKV] + (size_t)(128 * kb) * 3072 + 32 * nbk; q.ld = 3072; q.dst = wsl + WS_QKV + ((size_t)(32 * nbk) * 1024 + 128 * kb) * 2; q.pitch = 2048; q.f8 = 0; return q; } r -= I3;
    if (r < I4) { const int nbk = r & 31, kb = r >> 5; q.src = C.in[I_NOUT] + (size_t)(128 * kb) * 1024 + 32 * nbk; q.ld = 1024; q.dst = wsl + WS_NOUT + ((size_t)(32 * nbk) * 1024 + 128 * kb) * 2; q.pitch = 2048; q.f8 = 0; return q; } r -= I4;
    q.f8 = 1; q.pitch = 1024;
    if (r < I5) { const int mat = r >> 9, sub = r & 511, nbk = sub & 63, kb = sub >> 6; const int n0 = 32 * nbk, bj = n0 >> 10, f0 = n0 & 1023, pn = f0 >> 7, jj = f0 & 127;
        q.src = C.in[I_WGU] + (size_t)mat * 1024 * 2048 + (size_t)(128 * kb) * 2048 + n0; q.ld = 2048; q.dst = wsl + WS_WGU + ((size_t)mat * 2048 + 256 * pn + 128 * bj + jj) * 1024 + 128 * kb; return q; } r -= I5;
    if (r < I6) { const int mat = r >> 8, sub = r & 255, nbk = sub & 31, kb = sub >> 5;
        q.src = C.in[I_WD] + (size_t)mat * 1024 * 1024 + (size_t)(128 * kb) * 1024 + 32 * nbk; q.ld = 1024; q.dst = wsl + WS_WD + ((size_t)mat * 1024 + 32 * nbk) * 1024 + 128 * kb; return q; } r -= I6;
    { const int nbk = r % 96, kb = r / 96; q.src = C.in[I_WQKV] + (size_t)(128 * kb) * 3072 + 32 * nbk; q.ld = 3072; q.dst = wsl + WS_QKV8 + (size_t)(32 * nbk) * 1024 + 128 * kb; return q; }
}
__device__ __forceinline__ void phase_convert(const Ctx& C) {
    PHASE_IDS
    LAS float* scr = (LAS float*)(C.lds + wave * 16896);
    const int gw = C.bid * NWAVES + wave, NGW = C.G * NWAVES;
    constexpr int NIT = 512 + 256 + 256 + 768 + 256 + 32768 + 16384 + 768;
    if (gw < NIT) {
        const int r = lane >> 3, q4 = lane & 7, c = lane & 15, nn = lane >> 4;
        CvItem cur = cv_item(C, wsl, gw); int it = gw;
        f32x4 v[16];
#pragma unroll
        for (int i = 0; i < 16; ++i) v[i] = __builtin_nontemporal_load((const f32x4*)(cur.src + (size_t)(8 * i + r) * cur.ld + 4 * q4));
        for (;;) {
#pragma unroll
            for (int i = 0; i < 16; ++i) { LAS float* sp = scr + (8 * i + r) * 33 + 4 * q4; sp[0] = v[i][0]; sp[1] = v[i][1]; sp[2] = v[i][2]; sp[3] = v[i][3]; }
            const int nit = it + NGW; CvItem nxt = cur;
            if (nit < NIT) { nxt = cv_item(C, wsl, nit);
#pragma unroll
                for (int i = 0; i < 16; ++i) v[i] = __builtin_nontemporal_load((const f32x4*)(nxt.src + (size_t)(8 * i + r) * nxt.ld + 4 * q4)); }
            asm volatile("s_waitcnt lgkmcnt(0)" ::: "memory");
            if (cur.f8) {
#pragma unroll
                for (int j = 0; j < 8; ++j) { const int n = nn + 4 * j; const LAS float* sp = scr + (8 * c) * 33 + n;
                    u32x2 o; o.x = pk4_fp8(sp[0] * 64.0f, sp[33] * 64.0f, sp[2 * 33] * 64.0f, sp[3 * 33] * 64.0f); o.y = pk4_fp8(sp[4 * 33] * 64.0f, sp[5 * 33] * 64.0f, sp[6 * 33] * 64.0f, sp[7 * 33] * 64.0f);
                    *(u32x2*)(cur.dst + (size_t)n * cur.pitch + 8 * c) = o; }
            } else {
#pragma unroll
                for (int j = 0; j < 8; ++j) { const int n = nn + 4 * j; const LAS float* sp = scr + (8 * c) * 33 + n;
                    u32x4 o; o.x = pk2(sp[0], sp[33]); o.y = pk2(sp[2 * 33], sp[3 * 33]); o.z = pk2(sp[4 * 33], sp[5 * 33]); o.w = pk2(sp[6 * 33], sp[7 * 33]);
                    *(u32x4*)(cur.dst + (size_t)n * cur.pitch + 16 * c) = o; }
            }
            asm volatile("s_waitcnt lgkmcnt(0)" ::: "memory");
            if (nit >= NIT) break;
            cur = nxt; it = nit;
        }
    }
    const int gt = C.bid * NTHREADS + tid, NGT = C.G * NTHREADS;
    for (int i = gt; i < 2048; i += NGT) ((float*)(wsl + WS_CTL + CT_SPL))[i] = 8.0f * 1.44269504089f * log1pf(expf(-C.in[I_LAM][i]));
    for (int i = gt; i < 2 * 32 * 2048; i += NGT) { const int le = i >> 11, r = i & 2047, pn = r >> 8, bj = (r >> 7) & 1, ii = r & 127;
        ((float*)(wsl + WS_BIAS))[i] = C.in[I_BGU][(size_t)le * 2048 + bj * 1024 + 128 * pn + ii] + (bj ? 1.0f : 0.0f); }
    for (int i = gt; i < 2 * 32 * 1024; i += NGT) ((float*)(wsl + WS_BD))[i] = C.in[I_BD][i];
    for (int i = gt; i < 4096; i += NGT) { const int ut = i >> 8, which = (i >> 7) & 1, jj = i & 127, dir = ut >> 3, nb = (ut >> 1) & 3, half = ut & 1;
        ((float*)(wsl + WS_GBIAS))[i] = C.in[which ? I_BX : I_BA][dir * 1024 + 256 * nb + 128 * half + jj]; }
    for (int i0 = gt; i0 < NTOK * 128; i0 += 4 * NGT) { f32x4 a[4], b[4];
#pragma unroll
        for (int u = 0; u < 4; ++u) { const int i = i0 + u * NGT; if (i < NTOK * 128) { const int row = i >> 7, oc = i & 127;
            const float* src = (row < NGRID ? C.in[I_X] + (size_t)row * D : C.in[I_META] + (size_t)((row - NGRID) & 15) * D) + 8 * oc;
            a[u] = __builtin_nontemporal_load((const f32x4*)src); b[u] = __builtin_nontemporal_load((const f32x4*)(src + 4)); } }
#pragma unroll
        for (int u = 0; u < 4; ++u) { const int i = i0 + u * NGT; if (i < NTOK * 128) { const int row = i >> 7, oc = i & 127;
            u32x4 w; w.x = pk2(a[u][0], a[u][1]); w.y = pk2(a[u][2], a[u][3]); w.z = pk2(b[u][0], b[u][1]); w.w = pk2(b[u][2], b[u][3]);
            *(u32x4*)((bf16_t*)(wsl + WS_HB) + (size_t)row * D + 8 * oc) = w; } } }
}

__device__ __forceinline__ void phase_conv(const Ctx& C) {
    PHASE_IDS
    const bf16_t* XR = (const bf16_t*)(wsl + WS_XR); bf16_t* XC = (bf16_t*)(wsl + WS_XC);
    const float* cw = C.in[I_CONVW]; const float* cb = C.in[I_CONVB];
    const int gt = C.vr * NTHREADS + tid, NGT = C.gs * NTHREADS;
    for (int i = gt; C.vx < 8 && i < LSEQ * 128; i += NGT) { const int row = batch_row(C.vx, i >> 7), ch = 8 * (i & 127);
        int b, s; if (row < NGRID) { b = row >> 12; s = NMETA + (row & (SEQ - 1)); } else { b = (row - NGRID) >> 4; s = (row - NGRID) & 15; }
        float a[8];
        { const f32x4 t0 = *(const f32x4*)(cb + ch), t1 = *(const f32x4*)(cb + ch + 4);
#pragma unroll
          for (int j = 0; j < 4; ++j) { a[j] = t0[j]; a[4 + j] = t1[j]; } }
#pragma unroll
        for (int j = 0; j < 4; ++j) { const int sj = s - 2 + j;
            if (sj >= 0 && sj < LSEQ) { const u32x4 xw = *(const u32x4*)(XR + (size_t)seqrow(b, sj) * D + ch);
                const f32x4 w0 = *(const f32x4*)(cw + j * 1024 + ch), w1 = *(const f32x4*)(cw + j * 1024 + ch + 4);
                a[0] += w0[0] * bflo(xw.x); a[1] += w0[1] * bfhi(xw.x); a[2] += w0[2] * bflo(xw.y); a[3] += w0[3] * bfhi(xw.y);
                a[4] += w1[0] * bflo(xw.z); a[5] += w1[1] * bfhi(xw.z); a[6] += w1[2] * bflo(xw.w); a[7] += w1[3] * bfhi(xw.w); } }
        u32x4 w; w.x = pk2(a[0], a[1]); w.y = pk2(a[2], a[3]); w.z = pk2(a[4], a[5]); w.w = pk2(a[6], a[7]);
        *(u32x4*)(XC + (size_t)row * D + ch) = w; }
}

template <int N> __device__ __forceinline__ float dpp_shr(float oldv, float v) {
    return __builtin_bit_cast(float, __builtin_amdgcn_update_dpp(__builtin_bit_cast(int, oldv), __builtin_bit_cast(int, v), 0x110 + N, 0xf, 0xf, false));
}
__device__ __forceinline__ void scan_group(float (&a)[8], float (&b)[8]) {
#define SG_STEP(N) _Pragma("unroll") for (int c = 0; c < 8; ++c) { \
        asm volatile("v_fmac_f32_dpp %0, %0, %1 row_shr:" #N " row_mask:0xf bank_mask:0xf bound_ctrl:1" : "+v"(b[c]) : "v"(a[c])); } \
    _Pragma("unroll") for (int c = 0; c < 8; ++c) { \
        asm volatile("v_mul_f32_dpp %0, %0, %0 row_shr:" #N " row_mask:0xf bank_mask:0xf" : "+v"(a[c])); }
    asm volatile("s_nop 1" ::: "memory");
    SG_STEP(1) SG_STEP(2) SG_STEP(4) SG_STEP(8)
    asm volatile("s_nop 1" ::: "memory");
#undef SG_STEP
}
__device__ __forceinline__ void unpack8(const u32x4 w, float (&o)[8]) { o[0] = bflo(w.x); o[1] = bfhi(w.x); o[2] = bflo(w.y); o[3] = bfhi(w.y); o[4] = bflo(w.z); o[5] = bfhi(w.z); o[6] = bflo(w.w); o[7] = bfhi(w.w); }
__device__ __forceinline__ void phase_scan(const Ctx& C) {
    PHASE_IDS
    const unsigned char* LB = wsl + WS_LA; const float* spl = (const float*)(wsl + WS_CTL + CT_SPL); const bf16_t* GY = (const bf16_t*)(wsl + WS_GY);
    bf16_t* HF = (bf16_t*)(wsl + WS_HF); bf16_t* Gout = (bf16_t*)(wsl + WS_G);
    LAS float* agg = (LAS float*)C.lds;
    const int w = wave, oct = lane >> 4, p = lane & 15;
    for (int g = C.vr; C.vx < 8 && g < 32; g += C.gs) {
        const int b = C.vx;
        for (int dir = 0; dir < 2; ++dir) {
            const unsigned char* lb = LB + (((size_t)dir * 32 + g) * MPAD) * 64 + 16 * oct;
            float cs[8];
            { const f32x4 p0 = *(const f32x4*)(spl + dir * 1024 + 32 * g + 8 * oct), p1 = *(const f32x4*)(spl + dir * 1024 + 32 * g + 8 * oct + 4);
#pragma unroll
              for (int c = 0; c < 4; ++c) { cs[c] = p0[c] * (-1.0f / 256.0f); cs[4 + c] = p1[c] * (-1.0f / 256.0f); } }
            float S[8];
#pragma unroll
            for (int c = 0; c < 8; ++c) S[c] = 0.f;
            {
                const int u = p, s = dir ? LSEQ - 1 - u : u, row = seqrow(b, s);
                float a[8], x[8]; { const u32x4 rec = *(const u32x4*)(lb + (size_t)row * 64); u32x2 t; t.x = rec.x; t.y = rec.y; unpack8_fp8(t, a); t.x = rec.z; t.y = rec.w; unpack8_fp8(t, x); }
#pragma unroll
                for (int c = 0; c < 8; ++c) { a[c] = fast_exp2(a[c] * cs[c]); x[c] *= 0.125f; }
                scan_group(a, x);
                if (w == 0) {
                    if (dir == 0) { u32x4 o; o.x = pk2(x[0], x[1]); o.y = pk2(x[2], x[3]); o.z = pk2(x[4], x[5]); o.w = pk2(x[6], x[7]); *(u32x4*)(HF + ((size_t)g * MPAD + row) * 32 + 8 * oct) = o; }
                    else { float hf[8], gy[8]; unpack8(*(const u32x4*)(HF + ((size_t)g * MPAD + row) * 32 + 8 * oct), hf); unpack8(*(const u32x4*)(GY + ((size_t)g * MPAD + row) * 32 + 8 * oct), gy);
                        u32x4 o; o.x = pk2((hf[0] + x[0]) * gy[0], (hf[1] + x[1]) * gy[1]); o.y = pk2((hf[2] + x[2]) * gy[2], (hf[3] + x[3]) * gy[3]);
                        o.z = pk2((hf[4] + x[4]) * gy[4], (hf[5] + x[5]) * gy[5]); o.w = pk2((hf[6] + x[6]) * gy[6], (hf[7] + x[7]) * gy[7]);
                        *(u32x4*)(Gout + (size_t)row * D + 32 * g + 8 * oct) = o; }
                }
#pragma unroll
                for (int c = 0; c < 8; ++c) S[c] = __shfl(x[c], (lane & 48) | 15);
            }
            u32x4 na[4];
#pragma unroll
            for (int j = 0; j < 4; ++j) { const int u = 16 + 64 * w + 16 * j + p, s = dir ? LSEQ - 1 - u : u; const int rw = seqrow(b, s);
                na[j] = __builtin_nontemporal_load((const u32x4*)(lb + (size_t)rw * 64)); }
            for (int r = 0; r < 8; ++r) {
                float Pw[4][8], Hw[4][8]; int rows[4];
                float Aw[8], Hc[8];
#pragma unroll
                for (int c = 0; c < 8; ++c) { Aw[c] = 1.f; Hc[c] = 0.f; }
                u32x4 ra[4], rhf[4], rgy[4];
#pragma unroll
                for (int j = 0; j < 4; ++j) { const int u = 16 + 512 * r + 64 * w + 16 * j + p, s = dir ? LSEQ - 1 - u : u; rows[j] = seqrow(b, s); ra[j] = na[j]; }
                if (r < 7) {
#pragma unroll
                    for (int j = 0; j < 4; ++j) { const int u = 16 + 512 * (r + 1) + 64 * w + 16 * j + p, s = dir ? LSEQ - 1 - u : u; const int rw = seqrow(b, s);
                        na[j] = __builtin_nontemporal_load((const u32x4*)(lb + (size_t)rw * 64)); } }
                if (dir == 1) {
#pragma unroll
                    for (int j = 0; j < 4; ++j) { const size_t go = ((size_t)g * MPAD + rows[j]) * 32 + 8 * oct; rhf[j] = *(const u32x4*)(HF + go); rgy[j] = __builtin_nontemporal_load((const u32x4*)(GY + go)); } }
#pragma unroll
                for (int j = 0; j < 4; ++j) {
                    float a[8], x[8]; { u32x2 t; t.x = ra[j].x; t.y = ra[j].y; unpack8_fp8(t, a); t.x = ra[j].z; t.y = ra[j].w; unpack8_fp8(t, x); }
#pragma unroll
                    for (int c = 0; c < 8; ++c) { a[c] = fast_exp2(a[c] * cs[c]); x[c] *= 0.125f; }
                    scan_group(a, x);
#pragma unroll
                    for (int c = 0; c < 8; ++c) { Hw[j][c] = a[c] * Hc[c] + x[c]; Pw[j][c] = a[c] * Aw[c]; }
#pragma unroll
                    for (int c = 0; c < 8; ++c) { Aw[c] = __shfl(Pw[j][c], (lane & 48) | 15); Hc[c] = __shfl(Hw[j][c], (lane & 48) | 15); }
                }
                LAS float* ag = agg + (r & 1) * 512;
                if (p == 0) {
#pragma unroll
                    for (int c = 0; c < 8; ++c) { ag[(w * 32 + oct * 8 + c) * 2] = Aw[c]; ag[(w * 32 + oct * 8 + c) * 2 + 1] = Hc[c]; }
                }
                __syncthreads();
                float Sin[8];
#pragma unroll
                for (int c = 0; c < 8; ++c) Sin[c] = S[c];
#pragma unroll
                for (int ww = 0; ww < 8; ++ww) {
#pragma unroll
                    for (int c = 0; c < 8; ++c) { const float A = ag[(ww * 32 + oct * 8 + c) * 2], H = ag[(ww * 32 + oct * 8 + c) * 2 + 1];
                        if (ww == w) Sin[c] = S[c];
                        S[c] = A * S[c] + H; }
                }
#pragma unroll
                for (int j = 0; j < 4; ++j) {
                    float h[8];
#pragma unroll
                    for (int c = 0; c < 8; ++c) h[c] = Pw[j][c] * Sin[c] + Hw[j][c];
                    const size_t go = ((size_t)g * MPAD + rows[j]) * 32 + 8 * oct;
                    if (dir == 0) { u32x4 o; o.x = pk2(h[0], h[1]); o.y = pk2(h[2], h[3]); o.z = pk2(h[4], h[5]); o.w = pk2(h[6], h[7]); *(u32x4*)(HF + go) = o; }
                    else { float hf[8], gy[8]; unpack8(rhf[j], hf); unpack8(rgy[j], gy);
                        u32x4 o; o.x = pk2((hf[0] + h[0]) * gy[0], (hf[1] + h[1]) * gy[1]); o.y = pk2((hf[2] + h[2]) * gy[2], (hf[3] + h[3]) * gy[3]);
                        o.z = pk2((hf[4] + h[4]) * gy[4], (hf[5] + h[5]) * gy[5]); o.w = pk2((hf[6] + h[6]) * gy[6], (hf[7] + h[7]) * gy[7]);
                        *(u32x4*)(Gout + (size_t)rows[j] * D + 32 * g + 8 * oct) = o; }
                }
            }
            __syncthreads();
        }
    }
}

template <int K> __device__ __forceinline__ f32x4 mini_mma(const bf16_t* W, int ldw, const bf16_t* A, int lda, int lane) {
    const bf16_t* wp = W + (size_t)(lane & 15) * ldw + 8 * (lane >> 4); const bf16_t* ap = A + (size_t)(lane & 15) * lda + 8 * (lane >> 4);
    f32x4 acc = {0.f, 0.f, 0.f, 0.f};
    constexpr int KB = K < 512 ? K : 512, NS = KB / 32;
#pragma unroll 1
    for (int k0 = 0; k0 < K; k0 += KB) { bf16x8 wf[NS], af[NS];
#pragma unroll
        for (int i = 0; i < NS; ++i) { wf[i] = *(const bf16x8*)(wp + k0 + 32 * i); af[i] = *(const bf16x8*)(ap + k0 + 32 * i); }
#pragma unroll
        for (int i = 0; i < NS; ++i) acc = __builtin_amdgcn_mfma_f32_16x16x32_bf16(wf[i], af[i], acc, 0, 0, 0); }
    return acc;
}
__device__ __forceinline__ void mini_win(const Ctx& C) {
    PHASE_IDS
    const bf16_t* HB = (const bf16_t*)(C.ws + WS_HB); const bf16_t* WT = (const bf16_t*)(C.ws + WS_WIN); bf16_t* XR = (bf16_t*)(C.ws + WS_XR); bf16_t* GY = (bf16_t*)(C.ws + WS_GY);
    const int fr = lane & 15, fq = lane >> 4;
    for (int wt = (C.vr * NWAVES + wave) * 8 + C.vx; C.vx < 8 && wt < 8 * 128; wt += C.gs * NWAVES * 8) { const int rg = wt & 7, cb = wt >> 3, row = NGRID + 16 * rg + fr, c = 16 * cb + 4 * fq;
        const f32x4 a = mini_mma<1024>(WT + (size_t)(16 * cb) * 1024, 1024, HB + (size_t)(NGRID + 16 * rg) * 1024, 1024, lane);
        if (c < 1024) { u32x2 w; w.x = cvt_pk_bf16(a[0], a[1]); w.y = cvt_pk_bf16(a[2], a[3]); *(u32x2*)(XR + (size_t)row * D + c) = w; }
        else { const int yc = c - 1024; float o[4];
#pragma unroll
            for (int j = 0; j < 4; ++j) { const float v = a[j]; const float z = 1.5957691216f * (v + 0.044715f * v * v * v); o[j] = v * sigmoidf_(z); }
            u32x2 w; w.x = cvt_pk_bf16(o[0], o[1]); w.y = cvt_pk_bf16(o[2], o[3]); *(u32x2*)(GY + ((size_t)(yc >> 5) * MPAD + row) * 32 + (yc & 31)) = w; } }
}
__device__ __forceinline__ void mini_gate(const Ctx& C) {
    PHASE_IDS
    const bf16_t* XC = (const bf16_t*)(C.ws + WS_XC); const bf16_t* GT = (const bf16_t*)(C.ws + WS_GATE); unsigned char* LB = C.ws + WS_LA;
    const float* ba = C.in[I_BA]; const float* bx = C.in[I_BX]; const float* spl = (const float*)(C.ws + WS_CTL + CT_SPL);
    const int fr = lane & 15, fq = lane >> 4;
    for (int wt = (C.vr * NWAVES + wave) * 8 + C.vx; C.vx < 8 && wt < 8 * 2 * 64; wt += C.gs * NWAVES * 8) { const int rg = wt & 7, dir = (wt >> 3) & 1, chg = wt >> 4, ch0 = 16 * chg, nb = ch0 >> 8, half = (ch0 >> 7) & 1, jj0 = ch0 & 127;
        const bf16_t* A = XC + (size_t)(NGRID + 16 * rg) * 1024 + 256 * nb; const bf16_t* Wa = GT + ((size_t)nb * 1024 + 256 * (2 * dir + half) + jj0) * 256;
        const f32x4 za = mini_mma<256>(Wa, 256, A, 1024, lane), zx = mini_mma<256>(Wa + 128 * 256, 256, A, 1024, lane);
        const int row = NGRID + 16 * rg + fr, ch = ch0 + 4 * fq;
        const f32x4 cba = *(const f32x4*)(ba + dir * 1024 + ch), cbx = *(const f32x4*)(bx + dir * 1024 + ch), csp = *(const f32x4*)(spl + dir * 1024 + ch);
        const u32x2 xw = *(const u32x2*)(XC + (size_t)row * D + ch); const float xc[4] = {bflo(xw.x), bfhi(xw.x), bflo(xw.y), bfhi(xw.y)};
        float sg[4], bb[4];
#pragma unroll
        for (int j = 0; j < 4; ++j) { const float sga = sigmoidf_(za[j] + cba[j]); const float a2 = fast_exp2(-2.0f * csp[j] * sga);
            const float mult = (dir == 0 && fr == 0) ? 8.0f : 8.0f * __builtin_amdgcn_sqrtf(fmaxf(1.0f - a2, 0.0f));
            sg[j] = sga * 256.0f; bb[j] = __builtin_amdgcn_fmed3f(mult * sigmoidf_(zx[j] + cbx[j]) * xc[j], -448.0f, 448.0f); }
        unsigned char* o = LB + (((size_t)dir * 32 + (ch >> 5)) * MPAD + row) * 64 + 16 * ((ch & 31) >> 3) + (ch & 7);
        *(unsigned*)o = pk4_fp8(sg[0], sg[1], sg[2], sg[3]); *(unsigned*)(o + 8) = pk4_fp8(bb[0], bb[1], bb[2], bb[3]); }
}
__device__ __forceinline__ void mini_lout(const Ctx& C) {
    PHASE_IDS
    const bf16_t* G = (const bf16_t*)(C.ws + WS_G); const bf16_t* WT = (const bf16_t*)(C.ws + WS_LOUT); bf16_t* PRE = (bf16_t*)(C.ws + WS_PRE); const float* meta = C.in[I_META];
    const int fr = lane & 15, fq = lane >> 4;
    for (int wt = (C.vr * NWAVES + wave) * 8 + C.vx; C.vx < 8 && wt < 8 * 64; wt += C.gs * NWAVES * 8) { const int rg = wt & 7, cb = wt >> 3, row = NGRID + 16 * rg + fr, c = 16 * cb + 4 * fq;
        const f32x4 a = mini_mma<1024>(WT + (size_t)(16 * cb) * 1024, 1024, G + (size_t)(NGRID + 16 * rg) * 1024, 1024, lane);
        const f32x4 r = *(const f32x4*)(meta + (size_t)fr * D + c);
        u32x2 w; w.x = cvt_pk_bf16(r[0] * DN_ALPHA + a[0], r[1] * DN_ALPHA + a[1]); w.y = cvt_pk_bf16(r[2] * DN_ALPHA + a[2], r[3] * DN_ALPHA + a[3]); *(u32x2*)(PRE + (size_t)row * D + c) = w; }
}
__device__ __forceinline__ void mini_kv(const Ctx& C) {
    PHASE_IDS
    const bf16_t* HB = (const bf16_t*)(C.ws + WS_HB); const bf16_t* WT = (const bf16_t*)(C.ws + WS_QKV); bf16_t* Kx = (bf16_t*)(C.ws + WS_K); bf16_t* VT = (bf16_t*)(C.ws + WS_VT);
    const int fr = lane & 15, fq = lane >> 4;
    for (int wt = (C.vr * NWAVES + wave) * 8 + C.vx; C.vx < 8 && wt < 2 * 8 * 64; wt += C.gs * NWAVES * 8) { const int rg = wt & 7, cb = (wt >> 3) & 63, isv = wt >> 9;
        const bf16_t* A = HB + (size_t)(NGRID + 16 * rg) * 1024;
        if (!isv) { const f32x4 a = mini_mma<1024>(WT + (size_t)(1024 + 16 * cb) * 1024, 1024, A, 1024, lane);
            u32x2 w; w.x = cvt_pk_bf16(a[0], a[1]); w.y = cvt_pk_bf16(a[2], a[3]); *(u32x2*)(Kx + (size_t)(NGRID + 16 * rg + fr) * D + 16 * cb + 4 * fq) = w; }
        else { const f32x4 a = mini_mma<1024>(A, 1024, WT + (size_t)(2048 + 16 * cb) * 1024, 1024, lane);
            u32x2 w; w.x = cvt_pk_bf16(a[0], a[1]); w.y = cvt_pk_bf16(a[2], a[3]); *(u32x2*)(VT + (size_t)(16 * cb + fr) * MPAD + NGRID + 16 * rg + 4 * fq) = w; } }
}

constexpr int RW_PITCH = 2080;
__device__ __forceinline__ void phase_lnr(const Ctx& C, int layer, int nrows) {
    PHASE_IDS
    const bf16_t* PRE = (const bf16_t*)(wsl + WS_PRE); bf16_t* HB = (bf16_t*)(wsl + WS_HB); unsigned char* HB8 = wsl + WS_HB8;
    const float* lg = C.in[I_LNMG] + layer * D; const float* lb = C.in[I_LNMB] + layer * D;
    const float* rw = C.in[I_RW] + (size_t)layer * D * NEXP; const float* rb = C.in[I_RB] + layer * NEXP;
    int* eid = (int*)(wsl + WS_CTL + CT_EID) + (size_t)layer * NTOK * 4; float* gatev = (float*)(wsl + WS_CTL + CT_GATEV) + (size_t)layer * NTOK * 4;
    unsigned* bc = (unsigned*)(wsl + WS_CTL + CT_BC) + ((size_t)layer * 256 + C.bid) * 32;
    LAS unsigned char* RWt = C.lds; LAS unsigned char* rowb = C.lds + 32 * RW_PITCH + wave * (4 * RW_PITCH);
    LAS float* lgt = (LAS float*)(C.lds + 32 * RW_PITCH + NWAVES * 4 * RW_PITCH) + wave * 128; LAS unsigned* hist = (LAS unsigned*)(C.lds + 32 * RW_PITCH + NWAVES * 4 * RW_PITCH + NWAVES * 512);
#pragma unroll
    for (int i = 0; i < 8; ++i) { const int idx = tid + NTHREADS * i, pc = idx >> 3, e4 = (idx & 7) * 4, ch = 2 * pc;
        const f32x4 w0 = *(const f32x4*)(rw + (size_t)ch * NEXP + e4), w1 = *(const f32x4*)(rw + (size_t)(ch + 1) * NEXP + e4);
#pragma unroll
        for (int q = 0; q < 4; ++q) *(LAS unsigned*)(RWt + (e4 + q) * RW_PITCH + pc * 4) = pk2(w0[q], w1[q]); }
    if (tid < 32) hist[tid] = 0u;
    __syncthreads();
    float gg[2][8], gb[2][8];
#pragma unroll
    for (int j = 0; j < 2; ++j) { const f32x4 a0 = *(const f32x4*)(lg + 8 * lane + 512 * j), a1 = *(const f32x4*)(lg + 8 * lane + 512 * j + 4), b0 = *(const f32x4*)(lb + 8 * lane + 512 * j), b1 = *(const f32x4*)(lb + 8 * lane + 512 * j + 4);
#pragma unroll
        for (int i = 0; i < 4; ++i) { gg[j][i] = a0[i]; gg[j][4 + i] = a1[i]; gb[j][i] = b0[i]; gb[j][4 + i] = b1[i]; } }
    const float rbias = rb[lane >> 1];
    const int gw = C.vr * NWAVES + wave, NGW = C.gs * NWAVES, nper = nrows == NTOK ? LSEQ : SEQ, bq = C.vx;
    const int nmine = (bq < 8 && gw < nper) ? (nper - gw + NGW - 1) / NGW : 0;
    u32x4 nv[2];
    if (nmine > 0) {
#pragma unroll
        for (int j = 0; j < 2; ++j) nv[j] = __builtin_nontemporal_load((const u32x4*)(PRE + (size_t)batch_row(bq, gw) * D + 8 * lane + 512 * j)); }
    const int fr = lane & 15, fq = lane >> 4;
    for (int i0 = 0; i0 < nmine; i0 += 4) {
#pragma unroll
        for (int ii = 0; ii < 4; ++ii) if (i0 + ii < nmine) {
            const int row = batch_row(bq, gw + NGW * (i0 + ii));
            float v[2][8]; float s = 0.f;
#pragma unroll
            for (int j = 0; j < 2; ++j) { unpack8(nv[j], v[j]); s += ((v[j][0] + v[j][1]) + (v[j][2] + v[j][3])) + ((v[j][4] + v[j][5]) + (v[j][6] + v[j][7])); }
            if (i0 + ii + 1 < nmine) {
#pragma unroll
                for (int j = 0; j < 2; ++j) nv[j] = __builtin_nontemporal_load((const u32x4*)(PRE + (size_t)batch_row(bq, gw + NGW * (i0 + ii + 1)) * D + 8 * lane + 512 * j)); }
            const float mean = wave_sum_dpp(s) * (1.0f / D); float q = 0.f;
#pragma unroll
            for (int j = 0; j < 2; ++j)
#pragma unroll
                for (int i = 0; i < 8; ++i) { v[j][i] -= mean; q += v[j][i] * v[j][i]; }
            const float rstd = __builtin_amdgcn_rsqf(wave_sum_dpp(q) * (1.0f / D) + LN_EPS);
#pragma unroll
            for (int j = 0; j < 2; ++j) {
#pragma unroll
                for (int i = 0; i < 8; ++i) v[j][i] = v[j][i] * rstd * gg[j][i] + gb[j][i];
                u32x4 w; w.x = pk2(v[j][0], v[j][1]); w.y = pk2(v[j][2], v[j][3]); w.z = pk2(v[j][4], v[j][5]); w.w = pk2(v[j][6], v[j][7]);
                *(u32x4*)(HB + (size_t)row * D + 8 * lane + 512 * j) = w;
                *(LAS u32x4*)(rowb + ii * RW_PITCH + 16 * lane + 1024 * j) = w;
                u32x2 w8; w8.x = pk4_fp8(v[j][0], v[j][1], v[j][2], v[j][3]); w8.y = pk4_fp8(v[j][4], v[j][5], v[j][6], v[j][7]);
                *(u32x2*)(HB8 + (size_t)row * D + 8 * lane + 512 * j) = w8; }
        }
        asm volatile("s_waitcnt lgkmcnt(0)" ::: "memory");
        f32x4 l0 = {0.f, 0.f, 0.f, 0.f}, l1 = {0.f, 0.f, 0.f, 0.f};
        { const LAS unsigned char* ap = RWt + fr * RW_PITCH + 16 * fq; const LAS unsigned char* bp = rowb + (fr & 3) * RW_PITCH + 16 * fq;
#pragma unroll
          for (int ks = 0; ks < 32; ++ks) { const bf16x8 b = *(const LAS bf16x8*)(bp + 64 * ks), a0 = *(const LAS bf16x8*)(ap + 64 * ks), a1 = *(const LAS bf16x8*)(ap + 16 * RW_PITCH + 64 * ks);
              l0 = __builtin_amdgcn_mfma_f32_16x16x32_bf16(a0, b, l0, 0, 0, 0); l1 = __builtin_amdgcn_mfma_f32_16x16x32_bf16(a1, b, l1, 0, 0, 0); } }
        if (fr < 4) { *(LAS f32x4*)(lgt + fr * 32 + 4 * fq) = l0; *(LAS f32x4*)(lgt + fr * 32 + 16 + 4 * fq) = l1; }
        asm volatile("s_waitcnt lgkmcnt(0)" ::: "memory");
#pragma unroll
        for (int ii = 0; ii < 4; ++ii) if (i0 + ii < nmine) {
            const int row = batch_row(bq, gw + NGW * (i0 + ii));
            float lv = lgt[ii * 32 + (lane >> 1)] + rbias; lv = (lv == lv) ? lv : -3.0e38f;
            const int le = lane >> 1;
            int rank = 0;
#pragma unroll
            for (int j = 0; j < 32; ++j) { const float lj = readlane_f(lv, 2 * j); rank += (lj > lv || (lj == lv && j < le)) ? 1 : 0; }
            const unsigned long long m0 = __ballot(rank == 0);
            const float mxl = readlane_f(lv, (int)__builtin_ctzll(m0));
            const float pe = rank < 4 ? __expf(lv - mxl) : 0.f;
            const float den = wave_sum_dpp(pe) * 0.5f;
            if (rank < 4 && (lane & 1) == 0) { eid[(size_t)row * 4 + rank] = le; gatev[(size_t)row * 4 + rank] = pe / den;
                __hip_atomic_fetch_add(&hist[le], 1u, __ATOMIC_RELAXED, __HIP_MEMORY_SCOPE_WORKGROUP); }
        }
        asm volatile("s_waitcnt lgkmcnt(0)" ::: "memory");
    }
    __syncthreads();
    if (tid < 32) bc[tid] = hist[tid];
}

__device__ __forceinline__ void phase_pos(const Ctx& C, int layer, int nrows) {
    PHASE_IDS
    const unsigned* bcAll = (const unsigned*)(wsl + WS_CTL + CT_BC) + (size_t)layer * 256 * 32;
    const int* eid = (const int*)(wsl + WS_CTL + CT_EID) + (size_t)layer * NTOK * 4; int* posv = (int*)(wsl + WS_CTL + CT_POS) + (size_t)layer * NTOK * 4;
    int* texp = (int*)(wsl + WS_CTL + CT_TEXP) + layer * 1024;
    int* tokoff = (int*)(wsl + WS_TOK) + (size_t)layer * (1 * MiB / 4);
    LAS unsigned* partT = (LAS unsigned*)C.lds; LAS unsigned* partP = partT + 512; LAS unsigned* tot = partP + 512; LAS unsigned* cnt = tot + 32;
    { const int e = tid & 31, part = tid >> 5; unsigned t = 0, pr = 0;
      unsigned vv[16];
#pragma unroll
      for (int i = 0; i < 16; ++i) { const int bq = part + 16 * i; vv[i] = bq < C.G ? bcAll[(size_t)bq * 32 + e] : 0u; }
#pragma unroll
      for (int i = 0; i < 16; ++i) { const int bq = part + 16 * i; t += vv[i]; if (bq < C.bid) pr += vv[i]; }
      partT[part * 32 + e] = t; partP[part * 32 + e] = pr; }
    __syncthreads();
    if (tid < 32) { unsigned t = 0, pr = 0; for (int i = 0; i < 16; ++i) { t += partT[i * 32 + tid]; pr += partP[i * 32 + tid]; } tot[tid] = t; cnt[tid] = pr; }
    __syncthreads();
    if (tid < 32) { unsigned off = 0; for (int e = 0; e < tid; ++e) off += (tot[e] + 255u) & ~255u;
        const unsigned mine = (tot[tid] + 255u) & ~255u;
        if (C.bid == 0) { for (unsigned t = off >> 8; t < ((off + mine) >> 8); ++t) texp[t] = tid; if (tid == 31) texp[1023] = (int)((off + mine) >> 8);
            for (unsigned p = off + tot[tid]; p < off + mine; ++p) tokoff[p] = 0; }
        cnt[tid] += off; }
    __syncthreads();
    const int gw = C.vr * NWAVES + wave, NGW = C.gs * NWAVES, nper = C.vx < 8 ? (nrows == NTOK ? LSEQ : SEQ) : 0;
    for (int lr = gw; lr < nper; lr += NGW) { const int row = batch_row(C.vx, lr);
        int pos = 0;
        if (lane < 4) { const int e = eid[(size_t)row * 4 + lane]; pos = (int)__hip_atomic_fetch_add(&cnt[e], 1u, __ATOMIC_RELAXED, __HIP_MEMORY_SCOPE_WORKGROUP); posv[(size_t)row * 4 + lane] = pos; }
        if (lane < 4) tokoff[pos] = row * 1024;
    }
}

__device__ __forceinline__ void phase_combine(const Ctx& C, int layer, int nrows, bool final_out) {
    PHASE_IDS
    bf16_t* HB = (bf16_t*)(wsl + WS_HB); unsigned char* HB8 = wsl + WS_HB8; const unsigned char* YS = wsl + WS_YS;
    const float* lg = C.in[I_LNFG] + layer * D; const float* lb = C.in[I_LNFB] + layer * D;
    const float* gatev = (const float*)(wsl + WS_CTL + CT_GATEV) + (size_t)layer * NTOK * 4; const int* posv = (const int*)(wsl + WS_CTL + CT_POS) + (size_t)layer * NTOK * 4;
    float gg[2][8], gb[2][8];
#pragma unroll
    for (int j = 0; j < 2; ++j) { const f32x4 a0 = *(const f32x4*)(lg + 8 * lane + 512 * j), a1 = *(const f32x4*)(lg + 8 * lane + 512 * j + 4), b0 = *(const f32x4*)(lb + 8 * lane + 512 * j), b1 = *(const f32x4*)(lb + 8 * lane + 512 * j + 4);
#pragma unroll
        for (int i = 0; i < 4; ++i) { gg[j][i] = a0[i]; gg[j][4 + i] = a1[i]; gb[j][i] = b0[i]; gb[j][4 + i] = b1[i]; } }
    const int gw = C.vr * NWAVES + wave, NGW = C.gs * NWAVES, nper = C.vx < 8 ? (nrows == NTOK ? LSEQ : SEQ) : 0, bq = C.vx;
    f32x4 g1 = {0.f, 0.f, 0.f, 0.f}, g2 = g1; int p1[4] = {0, 0, 0, 0}, p2[4] = {0, 0, 0, 0};
    u32x4 hwn[2]; u32x2 ywn[4][2];
#define CB_ROUTE(row_, gq, pq) do { gq = *(const f32x4*)(gatev + (size_t)(row_) * 4); const u32x4 _pp = *(const u32x4*)(posv + (size_t)(row_) * 4); pq[0] = (int)_pp.x; pq[1] = (int)_pp.y; pq[2] = (int)_pp.z; pq[3] = (int)_pp.w; } while (0)
#define CB_DATA(row_, pq) do { _Pragma("unroll") for (int j = 0; j < 2; ++j) { hwn[j] = *(const u32x4*)(HB + (size_t)(row_) * D + 8 * lane + 512 * j); \
            _Pragma("unroll") for (int k = 0; k < 4; ++k) ywn[k][j] = __builtin_nontemporal_load((const u32x2*)(YS + (size_t)pq[k] * D + 8 * lane + 512 * j)); } } while (0)
    if (gw < nper) { CB_ROUTE(batch_row(bq, gw), g1, p1); CB_DATA(batch_row(bq, gw), p1); }
    if (gw + NGW < nper) CB_ROUTE(batch_row(bq, gw + NGW), g2, p2);
    for (int lr = gw; lr < nper; lr += NGW) { const int row = batch_row(bq, lr);
        const f32x4 gk4 = g1 * 0.125f; u32x4 hw[2]; u32x2 yw[4][2];
#pragma unroll
        for (int j = 0; j < 2; ++j) { hw[j] = hwn[j];
#pragma unroll
            for (int k = 0; k < 4; ++k) yw[k][j] = ywn[k][j]; }
        g1 = g2;
#pragma unroll
        for (int k = 0; k < 4; ++k) p1[k] = p2[k];
        if (lr + NGW < nper) CB_DATA(batch_row(bq, lr + NGW), p1);
        if (lr + 2 * NGW < nper) CB_ROUTE(batch_row(bq, lr + 2 * NGW), g2, p2);
        float v[2][8]; float s = 0.f;
#pragma unroll
        for (int j = 0; j < 2; ++j) { float h[8]; unpack8(hw[j], h);
#pragma unroll
            for (int i = 0; i < 8; ++i) v[j][i] = h[i] * DN_ALPHA;
#pragma unroll
            for (int k = 0; k < 4; ++k) { float y[8]; unpack8_fp8(yw[k][j], y);
#pragma unroll
                for (int i = 0; i < 8; ++i) v[j][i] += gk4[k] * y[i]; }
#pragma unroll
            for (int i = 0; i < 8; ++i) s += v[j][i]; }
        const float mean = wave_sum_dpp(s) * (1.0f / D); float q = 0.f;
#pragma unroll
        for (int j = 0; j < 2; ++j)
#pragma unroll
            for (int i = 0; i < 8; ++i) { v[j][i] -= mean; q += v[j][i] * v[j][i]; }
        const float rstd = __builtin_amdgcn_rsqf(wave_sum_dpp(q) * (1.0f / D) + LN_EPS);
#pragma unroll
        for (int j = 0; j < 2; ++j) {
#pragma unroll
            for (int i = 0; i < 8; ++i) v[j][i] = v[j][i] * rstd * gg[j][i] + gb[j][i];
            if (final_out) { *(f32x4*)(C.out + (size_t)row * D + 8 * lane + 512 * j) = (f32x4){v[j][0], v[j][1], v[j][2], v[j][3]}; *(f32x4*)(C.out + (size_t)row * D + 8 * lane + 512 * j + 4) = (f32x4){v[j][4], v[j][5], v[j][6], v[j][7]}; }
            else { u32x4 w; w.x = pk2(v[j][0], v[j][1]); w.y = pk2(v[j][2], v[j][3]); w.z = pk2(v[j][4], v[j][5]); w.w = pk2(v[j][6], v[j][7]); *(u32x4*)(HB + (size_t)row * D + 8 * lane + 512 * j) = w;
                u32x2 w8; w8.x = pk4_fp8(v[j][0], v[j][1], v[j][2], v[j][3]); w8.y = pk4_fp8(v[j][4], v[j][5], v[j][6], v[j][7]); *(u32x2*)(HB8 + (size_t)row * D + 8 * lane + 512 * j) = w8; } }
    }
#undef CB_ROUTE
#undef CB_DATA
}

constexpr int AT_KS = 0, AT_VTS = 73728, AT_VPITCH = 1168, AT_KM = AT_VTS + 64 * AT_VPITCH, AT_VTM = AT_KM + 2048, AT_RPB = AT_VTM + 2048, AT_MB = AT_RPB + 1920, AT_END = AT_MB + 64;
static_assert(AT_END <= LDS_BYTES, "attention LDS map");
__device__ __forceinline__ void phase_attn(const Ctx& C) {
    PHASE_IDS
    bf16_t* O = (bf16_t*)(wsl + WS_O);
    const float* rpb = C.in[I_RPB]; const float* mbias = C.in[I_MBIAS];
    LAS unsigned char* lds = C.lds;
    const int w = wave, lq = lane & 15, g = lane >> 4;
    const int qr = w >> 2, qg = w & 3, c0 = 16 * qg, kcb = qg == 0 ? 0 : (qg == 1 ? 8 : (qg == 2 ? 24 : 32));
    int bidx[2][4];
    { const int c_ = c0 + lq, cs_ = min(max(c_ - 8, 0), 48);
#pragma unroll
      for (int blk = 0; blk < 2; ++blk)
#pragma unroll
          for (int e = 0; e < 4; ++e) { const int kc = kcb + 16 * blk + 4 * g + e; bidx[blk][e] = ((kc >= cs_ && kc < cs_ + 16) ? (kc - c_ + 15) : 31) * 4; } }
    const __amdgpu_buffer_rsrc_t rsrc = __builtin_amdgcn_make_buffer_rsrc((void*)wsl, 0, 0xFFFFFFFF, 0x00020000);
    const int kvoff = (((tid >> 3) & 63) * D + 8 * (tid & 7)) * 2, vvoff = ((tid >> 3) * MPAD + 8 * (tid & 7)) * 2;
    const int qvoff = (lq * D + 8 * g) * 2;
    const int mvoff = tid < 128 ? ((tid >> 3) * D + 8 * (tid & 7)) * 2 : (((tid - 128) >> 1) * MPAD + 8 * ((tid - 128) & 1)) * 2;
    const int klds = AT_KS + ((((tid >> 3) & 63)) * 8 + ((tid & 7) ^ ((tid >> 3) & 7))) * 16;
    const int vlds = AT_VTS + (tid >> 3) * AT_VPITCH + (tid & 7) * 16;
    for (int su = C.vr; C.vx < 8 && su < 32; su += C.gs) {
        const int b = C.vx, h = su >> 1, strip = su & 1, rp0 = strip * 16;
        const unsigned kbase = (unsigned)WS_K + (unsigned)((b * SEQ) * D + 64 * h) * 2u, vbase = (unsigned)WS_VT + (unsigned)((64 * h) * MPAD + b * SEQ) * 2u;
        const unsigned qbase = (unsigned)WS_Q + (unsigned)((b * SEQ + qr * 64 + c0) * D + 64 * h) * 2u;
        int R0 = min(max(2 * rp0 - 4, 0), 55);
        __syncthreads();
        {
            u32x4 kreg[9], vreg[9];
#pragma unroll
            for (int i = 0; i < 9; ++i) { kreg[i] = __builtin_amdgcn_raw_buffer_load_b128(rsrc, kvoff, (int)(kbase + (unsigned)(R0 + i) * 64u * D * 2u), 0);
                vreg[i] = __builtin_amdgcn_raw_buffer_load_b128(rsrc, vvoff, (int)(vbase + (unsigned)(R0 + i) * 128u), 0); }
            u32x4 mreg = {0u, 0u, 0u, 0u};
            if (tid < 256) mreg = __builtin_amdgcn_raw_buffer_load_b128(rsrc, mvoff, (int)(tid < 128 ? (unsigned)WS_K + (unsigned)((NGRID + 16 * b) * D + 64 * h) * 2u : (unsigned)WS_VT + (unsigned)((64 * h) * MPAD + NGRID + 16 * b) * 2u), 0);
            float rpreg = 0.f, mbreg = 0.f;
            if (tid < 480) rpreg = (tid & 31) < 31 ? rpb[h * 465 + (tid >> 5) * 31 + (tid & 31)] * 1.44269504089f : -1.0e30f;
            if (tid < 16) mbreg = mbias[h * 16 + tid] * 1.44269504089f;
#pragma unroll
            for (int i = 0; i < 9; ++i) { const int slot = (R0 + i) % 9; *(LAS u32x4*)(lds + klds + slot * 8192) = kreg[i]; *(LAS u32x4*)(lds + vlds + slot * 128) = vreg[i]; }
            if (tid < 128) { const int m = tid >> 3, ch = tid & 7; *(LAS u32x4*)(lds + AT_KM + (m * 8 + (ch ^ (m & 7))) * 16) = mreg; }
            else if (tid < 256) { const int i = tid - 128, d = i >> 1, hf = i & 1; *(LAS u32x4*)(lds + AT_VTM + d * 32 + hf * 16) = mreg; }
            if (tid < 480) ((LAS float*)(lds + AT_RPB))[tid] = rpreg;
            if (tid < 16) ((LAS float*)(lds + AT_MB))[tid] = mbreg;
        }
        u32x4 qreg[2];
        qreg[0] = __builtin_amdgcn_raw_buffer_load_b128(rsrc, qvoff, (int)(qbase + (unsigned)(2 * rp0) * 64u * D * 2u), 0);
        qreg[1] = __builtin_amdgcn_raw_buffer_load_b128(rsrc, qvoff, (int)(qbase + (unsigned)(2 * rp0) * 64u * D * 2u + 64u), 0);
        __syncthreads();
        for (int rp = rp0; rp < rp0 + 16; ++rp) {
            const int R0n = rp + 1 < rp0 + 16 ? min(max(2 * (rp + 1) - 4, 0), 55) : R0, nnew = R0n - R0;
            const u32x4 qcur[2] = {qreg[0], qreg[1]};
            u32x4 nk[2], nv[2];
#pragma unroll
            for (int i = 0; i < 2; ++i) if (i < nnew) { nk[i] = __builtin_amdgcn_raw_buffer_load_b128(rsrc, kvoff, (int)(kbase + (unsigned)(R0 + 9 + i) * 64u * D * 2u), 0);
                nv[i] = __builtin_amdgcn_raw_buffer_load_b128(rsrc, vvoff, (int)(vbase + (unsigned)(R0 + 9 + i) * 128u), 0); }
            if (rp + 1 < rp0 + 16) { qreg[0] = __builtin_amdgcn_raw_buffer_load_b128(rsrc, qvoff, (int)(qbase + (unsigned)(2 * rp + 2) * 64u * D * 2u), 0);
                qreg[1] = __builtin_amdgcn_raw_buffer_load_b128(rsrc, qvoff, (int)(qbase + (unsigned)(2 * rp + 2) * 64u * D * 2u + 64u), 0); }
            const int r = 2 * rp + qr;
            const int rs = min(max(r - 4, 0), 56), s0 = rs % 9;
            const size_t qrow = (size_t)(b * SEQ + r * 64 + c0 + lq);
            bf16x8 qf[2]; qf[0] = __builtin_bit_cast(bf16x8, qcur[0]); qf[1] = __builtin_bit_cast(bf16x8, qcur[1]);
            f32x4 sc[8][2], sm;
#pragma unroll
            for (int j = 0; j < 8; ++j) { const int slot = s0 + j - (s0 + j >= 9 ? 9 : 0);
#pragma unroll
                for (int blk = 0; blk < 2; ++blk) { f32x4 a = {0.f, 0.f, 0.f, 0.f}; const int kc = kcb + 16 * blk + lq;
#pragma unroll
                    for (int ks = 0; ks < 2; ++ks) { const bf16x8 kf = *(const LAS bf16x8*)(lds + AT_KS + slot * 8192 + (kc * 8 + ((4 * ks + g) ^ (kc & 7))) * 16);
                        a = __builtin_amdgcn_mfma_f32_16x16x32_bf16(kf, qf[ks], a, 0, 0, 0); }
                    sc[j][blk] = a; } }
            { f32x4 a = {0.f, 0.f, 0.f, 0.f};
#pragma unroll
              for (int ks = 0; ks < 2; ++ks) { const bf16x8 kf = *(const LAS bf16x8*)(lds + AT_KM + (lq * 8 + ((4 * ks + g) ^ (lq & 7))) * 16);
                  a = __builtin_amdgcn_mfma_f32_16x16x32_bf16(kf, qf[ks], a, 0, 0, 0); }
              sm = a; }
            const LAS unsigned char* RProw = lds + AT_RPB + (rs - r + 7) * 128; const LAS float* MB = (const LAS float*)(lds + AT_MB);
            float mx = -3.0e38f;
#pragma unroll
            for (int j = 0; j < 8; ++j)
#pragma unroll
                for (int blk = 0; blk < 2; ++blk)
#pragma unroll
                    for (int e = 0; e < 4; ++e) { const float sv = sc[j][blk][e] + *(const LAS float*)(RProw + j * 128 + bidx[blk][e]); sc[j][blk][e] = sv; mx = fmaxf(mx, sv); }
#pragma unroll
            for (int e = 0; e < 4; ++e) { sm[e] += MB[4 * g + e]; mx = fmaxf(mx, sm[e]); }
            mx = fmaxf(mx, __shfl_xor(mx, 16)); mx = fmaxf(mx, __shfl_xor(mx, 32));
            float sum = 0.f;
#pragma unroll
            for (int j = 0; j < 8; ++j)
#pragma unroll
                for (int blk = 0; blk < 2; ++blk)
#pragma unroll
                    for (int e = 0; e < 4; ++e) { const float pv = fast_exp2(sc[j][blk][e] - mx); sc[j][blk][e] = pv; sum += pv; }
#pragma unroll
            for (int e = 0; e < 4; ++e) { const float pv = fast_exp2(sm[e] - mx); sm[e] = pv; sum += pv; }
            sum += __shfl_xor(sum, 16); sum += __shfl_xor(sum, 32);
            f32x4 o[4];
#pragma unroll
            for (int db = 0; db < 4; ++db) o[db] = (f32x4){0.f, 0.f, 0.f, 0.f};
#pragma unroll
            for (int j = 0; j < 8; ++j) { const int slot = s0 + j - (s0 + j >= 9 ? 9 : 0);
                u32x4 pw; pw.x = cvt_pk_bf16(sc[j][0][0], sc[j][0][1]); pw.y = cvt_pk_bf16(sc[j][0][2], sc[j][0][3]); pw.z = cvt_pk_bf16(sc[j][1][0], sc[j][1][1]); pw.w = cvt_pk_bf16(sc[j][1][2], sc[j][1][3]);
                const bf16x8 pb = __builtin_bit_cast(bf16x8, pw);
#pragma unroll
                for (int db = 0; db < 4; ++db) { const int d = 16 * db + lq; const LAS unsigned char* vp = lds + AT_VTS + d * AT_VPITCH + (slot * 64 + kcb + 4 * g) * 2;
                    const u32x2 lo = *(const LAS u32x2*)vp, hi = *(const LAS u32x2*)(vp + 32);
                    u32x4 aw; aw.x = lo.x; aw.y = lo.y; aw.z = hi.x; aw.w = hi.y;
                    o[db] = __builtin_amdgcn_mfma_f32_16x16x32_bf16(__builtin_bit_cast(bf16x8, aw), pb, o[db], 0, 0, 0); }
            }
            { u32x4 pw; pw.x = cvt_pk_bf16(sm[0], sm[1]); pw.y = cvt_pk_bf16(sm[2], sm[3]); pw.z = 0u; pw.w = 0u; const bf16x8 pb = __builtin_bit_cast(bf16x8, pw);
#pragma unroll
              for (int db = 0; db < 4; ++db) { const int d = 16 * db + lq; const u32x2 lo = *(const LAS u32x2*)(lds + AT_VTM + d * 32 + 8 * g);
                  u32x4 aw; aw.x = lo.x; aw.y = lo.y; aw.z = 0u; aw.w = 0u;
                  o[db] = __builtin_amdgcn_mfma_f32_16x16x32_bf16(__builtin_bit_cast(bf16x8, aw), pb, o[db], 0, 0, 0); } }
            const float inv = 1.0f / sum;
#pragma unroll
            for (int db = 0; db < 4; ++db) { u32x2 ow; ow.x = cvt_pk_bf16(o[db][0] * inv, o[db][1] * inv); ow.y = cvt_pk_bf16(o[db][2] * inv, o[db][3] * inv);
                *(u32x2*)(O + qrow * D + 64 * h + 16 * db + 4 * g) = ow; }
            __syncthreads();
#pragma unroll
            for (int i = 0; i < 2; ++i) if (i < nnew) { const int slot = (R0 + 9 + i) % 9; *(LAS u32x4*)(lds + klds + slot * 8192) = nk[i]; *(LAS u32x4*)(lds + vlds + slot * 128) = nv[i]; }
            R0 = R0n;
            __syncthreads();
        }
    }
}
#define XB_TMO      128
#define XB_XCNT(j)  (256  + 64 * (j))
#define XB_XSUB(j)  (1280 + 64 * (j))
#define XB_XGEN(j)  (2304 + 64 * (j))
#define XB_TOP      3328
#define XB_TOPGEN   3392
#define XCD_BAR_WORDS 3456
#define XB_LSUB(j)  (4096 + 64 * (j))
#define XB_LGEN(j)  (5120 + 64 * (j))
#define XB_SPIN_CAP (1u << 22)
__device__ __forceinline__ unsigned xb_ld(unsigned* p)              { return __hip_atomic_load(p, __ATOMIC_RELAXED, __HIP_MEMORY_SCOPE_AGENT); }
__device__ __forceinline__ unsigned xb_add(unsigned* p, unsigned v) { return __hip_atomic_fetch_add(p, v, __ATOMIC_RELAXED, __HIP_MEMORY_SCOPE_AGENT); }
__device__ __forceinline__ unsigned xb_xcc_id() { return (unsigned)__builtin_amdgcn_s_getreg((3 << 11) | 20) & 0xFu; }
#define XB_SPIN(cond, bar) do { unsigned _sp = 0; while (cond) { __builtin_amdgcn_s_sleep(1); \
    if ((++_sp & 255u) == 0u) { if (xb_ld(&(bar)[XB_TMO])) break; if (_sp > XB_SPIN_CAP) { atomicAdd(&(bar)[XB_TMO], 1u); break; } } } } while (0)
struct XcdBarrier { unsigned* bar; unsigned x; volatile LAS unsigned* st; };
__device__ __forceinline__ XcdBarrier xcd_barrier_post(unsigned* bar, volatile LAS unsigned* st) {
    XcdBarrier b; b.bar = bar; b.x = xb_xcc_id(); b.st = st;
    if (threadIdx.x == 0) st[2] = xb_add(&bar[XB_XCNT(b.x)], 1u);
    return b;
}
__device__ __forceinline__ void xcd_barrier_complete(unsigned* bar, unsigned x, unsigned& nloc, unsigned& nx) {
    const unsigned G = gridDim.x * gridDim.y * gridDim.z;
    unsigned sum, cnt, mine, sp = 0u;
    for (;;) {
        sum = 0u; cnt = 0u; mine = 0u;
#pragma unroll
        for (unsigned j = 0; j < 16; ++j) { const unsigned c = xb_ld(&bar[XB_XCNT(j)]); sum += c; cnt += (c > 0u) ? 1u : 0u; mine = (j == x) ? c : mine; }
        if (sum == G) break;
        __builtin_amdgcn_s_sleep(1);
        if ((++sp & 255u) == 0u) { if (xb_ld(&bar[XB_TMO])) break; if (sp > XB_SPIN_CAP) { atomicAdd(&bar[XB_TMO], 1u); break; } }
    }
    nloc = mine > 0u ? mine : 1u; nx = cnt > 0u ? cnt : 1u;
}
__device__ __forceinline__ void xcd_barrier(const XcdBarrier& b) {
    asm volatile("s_waitcnt vmcnt(0)" ::: "memory");
    __syncthreads();
    if (threadIdx.x == 0) {
        unsigned* bar = b.bar;
        __builtin_amdgcn_s_waitcnt(0);
        unsigned nloc = b.st[0], nx = b.st[1];
        if (nloc == 0u) { xcd_barrier_complete(bar, b.x, nloc, nx); b.st[0] = nloc; b.st[1] = nx; }
        const unsigned old = xb_add(&bar[XB_XSUB(b.x)], 1u);
        const unsigned gen = old / nloc;
        if (old + 1u == (gen + 1u) * nloc) {
            __builtin_amdgcn_fence(__ATOMIC_RELEASE, "agent");
            asm volatile("s_waitcnt vmcnt(0)" ::: "memory");
            const unsigned og = xb_add(&bar[XB_TOP], 1u);
            const unsigned tg = og / nx;
            if (og + 1u == (tg + 1u) * nx) xb_add(&bar[XB_TOPGEN], 1u);
            else XB_SPIN(xb_ld(&bar[XB_TOPGEN]) == tg, bar);
            __builtin_amdgcn_fence(__ATOMIC_ACQUIRE, "agent");
            xb_add(&bar[XB_XGEN(b.x)], 1u);
            asm volatile("s_waitcnt vmcnt(0)" ::: "memory");
        } else {
            XB_SPIN(xb_ld(&bar[XB_XGEN(b.x)]) == gen, bar);
            __builtin_amdgcn_fence(__ATOMIC_ACQUIRE, "agent");
            asm volatile("s_waitcnt vmcnt(0)" ::: "memory");
        }
    }
    __syncthreads();
}
__device__ __forceinline__ void xcd_local_barrier(const XcdBarrier& b) {
    asm volatile("s_waitcnt vmcnt(0)" ::: "memory");
    __syncthreads();
    if (threadIdx.x == 0) {
        unsigned* bar = b.bar;
        __builtin_amdgcn_s_waitcnt(0);
        const unsigned nloc = b.st[0];
        const unsigned old = xb_add(&bar[XB_LSUB(b.x)], 1u);
        const unsigned gen = old / nloc;
        if (old + 1u == (gen + 1u) * nloc) xb_add(&bar[XB_LGEN(b.x)], 1u);
        else XB_SPIN(xb_ld(&bar[XB_LGEN(b.x)]) == gen, bar);
        __builtin_amdgcn_fence(__ATOMIC_ACQUIRE, "agent");
        asm volatile("s_waitcnt vmcnt(0)" ::: "memory");
    }
    __syncthreads();
}
__device__ __forceinline__ int moe_prep(const Ctx& C, const int* texp) {
    LAS int* t = (LAS int*)(C.lds + pg8::TEXP_OFF); const int tid = fresh_tid();
    const int a = texp[tid], b = texp[tid + 512];
    t[tid] = a; t[tid + 512] = b;
    __syncthreads();
    return __builtin_amdgcn_readfirstlane(t[1023]);
}
constexpr size_t CT_BAR = 131072;
constexpr int LDS_BARST = LDS_BYTES - 64;

constexpr int N_PHASES = 20;
__global__ void __launch_bounds__(NTHREADS, 2) hybrid_fwd(Params P) {
    extern __shared__ __attribute__((aligned(16))) unsigned char smem[];
    cg::grid_group grid = cg::this_grid();
    Ctx C; C.lds = (LAS unsigned char*)smem; C.G = gridDim.x; C.bid = blockIdx.x;
    C.ws = P.ws; C.in = P.in; C.out = P.out;
    unsigned char* const ws0 = P.ws;
#define ws fresh_ws(ws0)
    const int lo = P.ph_lo, hi = P.ph_hi;
#ifndef PH_MASK
#define PH_MASK 0xFFFFFFFFu
#endif
#define IN(k) (((PH_MASK >> (k)) & 1u) && lo <= (k) && (k) < hi)
#ifndef REPEAT_MASK
#define REPEAT_MASK 0u
#endif
#define REPS(k) ((((unsigned)REPEAT_MASK >> (k)) & 1u) ? 2 : 1)
#ifndef N_CG_SYNCS
#define N_CG_SYNCS 0
#endif
#ifndef LOCAL_SEAM_MASK
#define LOCAL_SEAM_MASK 0x3C3Eu
#endif
#define SEAM(k) do { if (IN(k) && IN((k) + 1)) { if ((k) < N_CG_SYNCS) grid.sync(); else if (((LOCAL_SEAM_MASK >> (k)) & 1u) && loc) xcd_local_barrier(bar); else xcd_barrier(bar); } } while (0)
    if (threadIdx.x < 16) ((LAS unsigned*)(smem + LDS_BARST))[threadIdx.x] = 0u;
    __syncthreads();
    const XcdBarrier bar = xcd_barrier_post((unsigned*)(ws + WS_CTL + CT_BAR), (volatile LAS unsigned*)(smem + LDS_BARST));
    C.gc = C.bid;
    C.gs = C.G >= 8 ? C.G / 8 : 1; C.vx = C.bid / C.gs; C.vr = C.bid % C.gs;
    bool loc = false;
    #define PH_BODY_0 phase_convert(C);
    if (IN(0)) { PH_BODY_0 } if (REPS(0) > 1 && IN(0)) { xcd_barrier(bar); PH_BODY_0 }
    SEAM(0);
    if (IN(0) && IN(1)) {
        unsigned* barw = (unsigned*)(ws + WS_CTL + CT_BAR); bool eq = (C.G % 8) == 0;
#pragma unroll
        for (int j = 0; j < 16; ++j) { const unsigned cj = xb_ld(&barw[XB_XCNT(j)]); eq = eq && (cj == (j < 8 ? (unsigned)(C.G / 8) : 0u)); }
        const unsigned rank = ((volatile LAS unsigned*)(smem + LDS_BARST))[2];
        C.gc = __builtin_amdgcn_readfirstlane(eq ? (int)(rank * 8u + bar.x) : C.bid);
        if (__builtin_amdgcn_readfirstlane((int)eq)) { C.vx = __builtin_amdgcn_readfirstlane((int)bar.x); C.vr = __builtin_amdgcn_readfirstlane((int)rank); loc = true; }
    }
    #define PH_BODY_1 { DenseSched S{(unsigned)WS_HB, (unsigned)WS_WIN, 1024, 1024, 8, C.gs, C.vr, C.vx}; EpiWin E{(bf16_t*)(ws + WS_XR), (bf16_t*)(ws + WS_GY)}; \
        pg8::gemm_phase<false, false>(C.lds, ws, 1024, 1024, 1024, S, E); mini_win(C); }
    if (IN(1)) { PH_BODY_1 } if (REPS(1) > 1 && IN(1)) { xcd_barrier(bar); PH_BODY_1 }
    SEAM(1);
    #define PH_BODY_2 phase_conv(C);
    if (IN(2)) { PH_BODY_2 } if (REPS(2) > 1 && IN(2)) { xcd_barrier(bar); PH_BODY_2 }
    SEAM(2);
    #define PH_BODY_3 { GateSched S{(unsigned)WS_XC, (unsigned)WS_GATE, C.gs, C.vr, C.vx}; \
        EpiGate E{(const bf16_t*)(ws + WS_XC), (unsigned char*)(ws + WS_LA), (const float*)(ws + WS_CTL + CT_SPL), (unsigned)WS_GBIAS}; \
        pg8::gemm_phase<false, false>(C.lds, ws, 256, 1024, 256, S, E); mini_gate(C); }
    if (IN(3)) { PH_BODY_3 } if (REPS(3) > 1 && IN(3)) { xcd_barrier(bar); PH_BODY_3 }
    SEAM(3);
    #define PH_BODY_4 phase_scan(C);
    if (IN(4)) { PH_BODY_4 } if (REPS(4) > 1 && IN(4)) { xcd_barrier(bar); PH_BODY_4 }
    SEAM(4);
    #define PH_BODY_5 { DenseSched S{(unsigned)WS_G, (unsigned)WS_LOUT, 1024, 1024, 4, C.gs, C.vr, C.vx}; EpiRes<true> E{(bf16_t*)(ws + WS_PRE), P.in[I_X], P.in[I_META], nullptr, NTOK}; \
        pg8::gemm_phase<false, false>(C.lds, ws, 1024, 1024, 1024, S, E); mini_lout(C); }
    if (IN(5)) { PH_BODY_5 } if (REPS(5) > 1 && IN(5)) { xcd_barrier(bar); PH_BODY_5 }
    SEAM(5);
    #define PH_BODY_6 phase_lnr(C, 0, NTOK);
    if (IN(6)) { PH_BODY_6 } if (REPS(6) > 1 && IN(6)) { xcd_barrier(bar); PH_BODY_6 }
    SEAM(6);
    #define PH_BODY_7 phase_pos(C, 0, NTOK);
    if (IN(7)) { PH_BODY_7 } if (REPS(7) > 1 && IN(7)) { xcd_barrier(bar); PH_BODY_7 }
    SEAM(7);
    #define PH_BODY_8 { const int nM = moe_prep(C, (const int*)(ws + WS_CTL + CT_TEXP)); \
        MoeSched S{(unsigned)WS_HB8, (unsigned)WS_WGU, (unsigned)WS_TOK, (const LAS int*)(C.lds + pg8::TEXP_OFF), 2048u * 1024u, nM, 8, C.G, C.gc}; EpiGlu E{(unsigned char*)(ws + WS_ACT), (unsigned)WS_BIAS}; \
        pg8::gemm_phase<true, true>(C.lds, ws, 512, 512, 512, S, E); }
    if (IN(8)) { PH_BODY_8 } if (REPS(8) > 1 && IN(8)) { xcd_barrier(bar); PH_BODY_8 }
#ifdef PROBE_NULL8
    if (IN(8)) { xcd_barrier(bar); { const int nM = moe_prep(C, (const int*)(ws + WS_CTL + CT_TEXP));
        MoeSched S{(unsigned)WS_HB8, (unsigned)WS_WGU, (unsigned)WS_TOK, (const LAS int*)(C.lds + pg8::TEXP_OFF), 2048u * 1024u, nM, 8, C.G, C.gc}; EpiNull E{};
        pg8::gemm_phase<true, true>(C.lds, ws, 512, 512, 512, S, E); } }
#endif
    SEAM(8);
    #define PH_BODY_9 { const int nM = moe_prep(C, (const int*)(ws + WS_CTL + CT_TEXP)); \
        MoeSched S{(unsigned)WS_ACT, (unsigned)WS_WD, 0u, (const LAS int*)(C.lds + pg8::TEXP_OFF), 1024u * 1024u, nM, 4, C.G, C.gc}; EpiDown E{(unsigned char*)(ws + WS_YS), (unsigned)WS_BD}; \
        pg8::gemm_phase<true, false>(C.lds, ws, 512, 512, 512, S, E); }
    if (IN(9)) { PH_BODY_9 } if (REPS(9) > 1 && IN(9)) { xcd_barrier(bar); PH_BODY_9 }
    SEAM(9);
    #define PH_BODY_10 phase_combine(C, 0, NTOK, false);
    if (IN(10)) { PH_BODY_10 } if (REPS(10) > 1 && IN(10)) { xcd_barrier(bar); PH_BODY_10 }
    SEAM(10);
    #define PH_BODY_11 { QkvSched S{(unsigned)WS_HB8, (unsigned)WS_QKV8, C.gs, C.vr, C.vx}; EpiQkv E{(bf16_t*)(ws + WS_Q), (bf16_t*)(ws + WS_K), (bf16_t*)(ws + WS_VT)}; \
        pg8::gemm_phase<true, false>(C.lds, ws, 512, 512, 512, S, E); mini_kv(C); }
    if (IN(11)) { PH_BODY_11 } if (REPS(11) > 1 && IN(11)) { xcd_barrier(bar); PH_BODY_11 }
    SEAM(11);
    #define PH_BODY_12 phase_attn(C);
    if (IN(12)) { PH_BODY_12 } if (REPS(12) > 1 && IN(12)) { xcd_barrier(bar); PH_BODY_12 }
    SEAM(12);
    #define PH_BODY_13 { DenseSched S{(unsigned)WS_O, (unsigned)WS_NOUT, 1024, 1024, 4, C.gs, C.vr, C.vx}; EpiRes<false> E{(bf16_t*)(ws + WS_PRE), nullptr, nullptr, (const bf16_t*)(ws + WS_HB), NGRID}; \
        pg8::gemm_phase<false, false>(C.lds, ws, 1024, 1024, 1024, S, E); }
    if (IN(13)) { PH_BODY_13 } if (REPS(13) > 1 && IN(13)) { xcd_barrier(bar); PH_BODY_13 }
    SEAM(13);
    #define PH_BODY_14 phase_lnr(C, 1, NGRID);
    if (IN(14)) { PH_BODY_14 } if (REPS(14) > 1 && IN(14)) { xcd_barrier(bar); PH_BODY_14 }
    SEAM(14);
    #define PH_BODY_15 phase_pos(C, 1, NGRID);
    if (IN(15)) { PH_BODY_15 } if (REPS(15) > 1 && IN(15)) { xcd_barrier(bar); PH_BODY_15 }
    SEAM(15);
    #define PH_BODY_16 { const int nM = moe_prep(C, (const int*)(ws + WS_CTL + CT_TEXP) + 1024); \
        MoeSched S{(unsigned)WS_HB8, (unsigned)(WS_WGU + (size_t)32 * 2048 * 1024), (unsigned)(WS_TOK + 1 * MiB), (const LAS int*)(C.lds + pg8::TEXP_OFF), 2048u * 1024u, nM, 8, C.G, C.gc}; EpiGlu E{(unsigned char*)(ws + WS_ACT), (unsigned)(WS_BIAS + 32 * 2048 * 4)}; \
        pg8::gemm_phase<true, true>(C.lds, ws, 512, 512, 512, S, E); }
    if (IN(16)) { PH_BODY_16 } if (REPS(16) > 1 && IN(16)) { xcd_barrier(bar); PH_BODY_16 }
    SEAM(16);
    #define PH_BODY_17 { const int nM = moe_prep(C, (const int*)(ws + WS_CTL + CT_TEXP) + 1024); \
        MoeSched S{(unsigned)WS_ACT, (unsigned)(WS_WD + (size_t)32 * 1024 * 1024), 0u, (const LAS int*)(C.lds + pg8::TEXP_OFF), 1024u * 1024u, nM, 4, C.G, C.gc}; EpiDown E{(unsigned char*)(ws + WS_YS), (unsigned)(WS_BD + 32 * 1024 * 4)}; \
        pg8::gemm_phase<true, false>(C.lds, ws, 512, 512, 512, S, E); }
    if (IN(17)) { PH_BODY_17 } if (REPS(17) > 1 && IN(17)) { xcd_barrier(bar); PH_BODY_17 }
    SEAM(17);
    #define PH_BODY_18 phase_combine(C, 1, NGRID, true);
    if (IN(18)) { PH_BODY_18 } if (REPS(18) > 1 && IN(18)) { xcd_barrier(bar); PH_BODY_18 }
#undef ws
#undef IN
#undef SEAM
}

#ifndef MK_PER_PHASE
#define MK_PER_PHASE 0
#endif
extern "C" void kernel_launch(void* const* d_in, const int* in_sizes, int n_in, void* d_out, int out_size, void* d_ws, size_t ws_size, hipStream_t stream) {
    static int grid = 0;
    if (grid == 0) {
        if (n_in != 25 || ws_size < WS_END || out_size != NGRID * D) { fprintf(stderr, "kernel_launch: unexpected problem (n_in %d, ws %zu, out %d)\n", n_in, ws_size, out_size); grid = -1; return; }
        int dev = 0, cus = 0, per_cu = 0;
        if (hipGetDevice(&dev) != hipSuccess || hipDeviceGetAttribute(&cus, hipDeviceAttributeMultiprocessorCount, dev) != hipSuccess) { grid = -1; return; }
        if (hipFuncSetAttribute((const void*)hybrid_fwd, hipFuncAttributeMaxDynamicSharedMemorySize, LDS_BYTES) != hipSuccess) { fprintf(stderr, "kernel_launch: hipFuncSetAttribute failed\n"); grid = -1; return; }
        if (hipOccupancyMaxActiveBlocksPerMultiprocessor(&per_cu, (const void*)hybrid_fwd, NTHREADS, LDS_BYTES) != hipSuccess || per_cu < 1) { fprintf(stderr, "kernel_launch: occupancy query failed (%d)\n", per_cu); grid = -1; return; }
        grid = cus * 1;
        if (grid > 256) grid = 256;
    }
    if (grid < 0) return;
    if (hipMemsetAsync((char*)d_ws + WS_CTL + CT_BAR, 0, 32768, stream) != hipSuccess) { fprintf(stderr, "kernel_launch: memset failed\n"); return; }
    Params p{};
    for (int i = 0; i < 25; ++i) p.in[i] = (const float*)d_in[i];
    p.out = (float*)d_out; p.ws = (unsigned char*)d_ws;
#if MK_PER_PHASE
    for (int ph = 0; ph < 19; ++ph) { p.ph_lo = ph; p.ph_hi = ph + 1; void* args[] = {&p};
        hipError_t e = hipLaunchCooperativeKernel((void*)hybrid_fwd, dim3(grid), dim3(NTHREADS), args, LDS_BYTES, stream);
        if (e != hipSuccess) { fprintf(stderr, "launch phase %d failed: %s\n", ph, hipGetErrorString(e)); break; } }
#else
    p.ph_lo = 0; p.ph_hi = 19; void* args[] = {&p};
    hipError_t e = hipLaunchCooperativeKernel((void*)hybrid_fwd, dim3(grid), dim3(NTHREADS), args, LDS_BYTES, stream);
    if (e != hipSuccess) fprintf(stderr, "cooperative launch failed: %s (grid %d)\n", hipGetErrorString(e), grid);
#endif
}
```

```cpp
#include <hip/hip_runtime.h>
#include <hip/hip_cooperative_groups.h>
#include <cstdio>
#include <cstdint>
namespace cg = cooperative_groups;

#define LAS __attribute__((address_space(3)))
typedef unsigned short bf16_t;
typedef short bf16x8 __attribute__((ext_vector_type(8)));
typedef float f32x4 __attribute__((ext_vector_type(4)));
typedef float f32x2 __attribute__((ext_vector_type(2)));
typedef unsigned u32x4 __attribute__((ext_vector_type(4)));
typedef unsigned u32x2 __attribute__((ext_vector_type(2)));

constexpr int NB = 8, SEQ = 4096, D = 1024, NMETA = 16, LSEQ = SEQ + NMETA;
constexpr int NGRID = NB * SEQ;
constexpr int NTOK = NGRID + NB * NMETA;
constexpr int MPAD = 33024;
constexpr int NEXP = 32, TOPK = 4;
constexpr int PMAX = 139776;
constexpr int MTMAX = PMAX / 256;
constexpr float DN_ALPHA = 1.41421356237f;
constexpr float LN_EPS = 1e-5f;
constexpr int NTHREADS = 512, NWAVES = 8;

constexpr size_t MiB = 1u << 20;
constexpr size_t ACT_BYTES = (size_t)MPAD * D * 2;
constexpr size_t WS_CTL   = 0;
constexpr size_t WS_WIN   = 4 * MiB;
constexpr size_t WS_GATE  = WS_WIN + 4 * MiB;
constexpr size_t WS_LOUT  = WS_GATE + 2 * MiB;
constexpr size_t WS_QKV   = WS_LOUT + 2 * MiB;
constexpr size_t WS_NOUT  = WS_QKV + 6 * MiB;
constexpr size_t WS_WGU   = WS_NOUT + 2 * MiB;
constexpr size_t WS_WD    = WS_WGU + 128 * MiB;
constexpr size_t WS_HB    = WS_WD + 64 * MiB;
constexpr size_t WS_HB8   = WS_HB + 65 * MiB;
constexpr size_t WS_PRE   = WS_HB8 + 33 * MiB;
constexpr size_t WS_H     = WS_PRE + 129 * MiB;
constexpr size_t WS_SCR   = WS_H + 129 * MiB;
constexpr size_t WS_XR = WS_SCR, WS_XC = WS_XR + 65 * MiB, WS_GY = WS_XC + 65 * MiB, WS_LA = WS_GY + 65 * MiB, WS_BB = WS_LA + 130 * MiB, WS_HF = WS_BB + 130 * MiB, WS_G = WS_HF + 65 * MiB;
constexpr size_t WS_SCR_END0 = WS_G + 65 * MiB;
constexpr size_t WS_XS = WS_SCR, WS_ACT = WS_XS + 137 * MiB, WS_YS = WS_ACT + 137 * MiB;
constexpr size_t WS_SCR_END1 = WS_YS + 274 * MiB;
constexpr size_t WS_Q = WS_SCR, WS_K = WS_Q + 65 * MiB, WS_VT = WS_K + 65 * MiB, WS_O = WS_VT + 65 * MiB;
constexpr size_t WS_BIAS = (WS_SCR_END0 > WS_SCR_END1 ? WS_SCR_END0 : WS_SCR_END1);
constexpr size_t WS_BD = WS_BIAS + 2 * 32 * 2048 * 4;
constexpr size_t WS_GBIAS = WS_BD + 2 * 32 * 1024 * 4;
constexpr size_t WS_TOK = WS_BIAS + 1 * MiB;
constexpr size_t WS_QKV8 = WS_TOK + 2 * MiB;
constexpr int TCAP = MPAD;
constexpr size_t WS_TOK2 = WS_QKV8 + 3 * MiB;
constexpr size_t WS_END = WS_TOK2 + 9 * MiB;
static_assert((size_t)2 * 32 * TCAP * 4 <= 9 * MiB, "token offset tables");
static_assert(ACT_BYTES <= 65 * MiB && (size_t)PMAX * D * 2 <= 274 * MiB && (size_t)PMAX * D <= 137 * MiB && (size_t)MPAD * D <= 33 * MiB && (size_t)MPAD * D * 4 <= 129 * MiB, "ws map");
static_assert(WS_END <= (size_t)2040 * MiB, "ws map must fit 4x the largest input tensor");
constexpr size_t CT_BC      = 4096;
constexpr size_t CT_TEXP    = CT_BC + 2 * 256 * 32 * 4;
constexpr size_t CT_SPL     = CT_TEXP + 2 * 1024 * 4;
constexpr size_t CT_EID     = 256 * 1024;
constexpr size_t CT_GATEV   = CT_EID + 2 * (size_t)NTOK * 4 * 4;
constexpr size_t CT_POS     = CT_GATEV + 2 * (size_t)NTOK * 4 * 4;
static_assert(CT_POS + 2 * (size_t)NTOK * 4 * 4 <= 4 * MiB, "ctl map");

constexpr int LDS_BYTES = 155648;

__device__ __forceinline__ unsigned f2bf(float f) { unsigned u = __builtin_bit_cast(unsigned, f); return (u + 0x7fffu + ((u >> 16) & 1u)) >> 16; }
__device__ __forceinline__ unsigned cvt_pk_bf16(float lo, float hi);
__device__ __forceinline__ unsigned pk2(float lo, float hi) { return cvt_pk_bf16(lo, hi); }
typedef __bf16 bf16x2_t __attribute__((ext_vector_type(2)));
__device__ __forceinline__ unsigned cvt_pk_bf16(float lo, float hi) { const f32x2 v = {lo, hi}; return __builtin_bit_cast(unsigned, __builtin_convertvector(v, bf16x2_t)); }
__device__ __forceinline__ unsigned pk4_fp8(float a, float b, float c, float d) { int w = __builtin_amdgcn_cvt_pk_fp8_f32(a, b, 0, false); w = __builtin_amdgcn_cvt_pk_fp8_f32(c, d, w, true); return (unsigned)w; }
__device__ __forceinline__ float dot2_bf16(unsigned a, unsigned b, float c) { return __builtin_amdgcn_fdot2_f32_bf16(__builtin_bit_cast(bf16x2_t, a), __builtin_bit_cast(bf16x2_t, b), c, false); }
__device__ __forceinline__ void unpack8_fp8(const u32x2 w, float (&o)[8]) { const f32x2 a = __builtin_amdgcn_cvt_pk_f32_fp8((int)w.x, false), b = __builtin_amdgcn_cvt_pk_f32_fp8((int)w.x, true), c = __builtin_amdgcn_cvt_pk_f32_fp8((int)w.y, false), d = __builtin_amdgcn_cvt_pk_f32_fp8((int)w.y, true);
    o[0] = a.x; o[1] = a.y; o[2] = b.x; o[3] = b.y; o[4] = c.x; o[5] = c.y; o[6] = d.x; o[7] = d.y; }
__device__ __forceinline__ float bflo(unsigned w) { return __builtin_bit_cast(float, w << 16); }
__device__ __forceinline__ float bfhi(unsigned w) { return __builtin_bit_cast(float, w & 0xffff0000u); }
__device__ __forceinline__ void unpack8(const u32x4 w, float (&o)[8]);
__device__ __forceinline__ float fast_exp2(float x) { return __builtin_amdgcn_exp2f(x); }
__device__ __forceinline__ float fast_rcp(float x) { return __builtin_amdgcn_rcpf(x); }
__device__ __forceinline__ float sigmoidf_(float x) { return fast_rcp(1.0f + fast_exp2(-1.44269504089f * x)); }
__device__ __forceinline__ float wave_sum(float v) {
#pragma unroll
    for (int o = 1; o < 64; o <<= 1) v += __shfl_xor(v, o);
    return v;
}
template <int CTRL> __device__ __forceinline__ float dpp_movf(float v) { return __builtin_bit_cast(float, __builtin_amdgcn_update_dpp(0, __builtin_bit_cast(int, v), CTRL, 0xf, 0xf, true)); }
__device__ __forceinline__ float readlane_f(float v, int l) { return __builtin_bit_cast(float, __builtin_amdgcn_readlane(__builtin_bit_cast(int, v), l)); }
__device__ __forceinline__ float wave_sum_dpp(float v) {
    v += dpp_movf<0xB1>(v);
    v += dpp_movf<0x4E>(v);
    v += dpp_movf<0x141>(v);
    v += dpp_movf<0x140>(v);
    return (readlane_f(v, 0) + readlane_f(v, 16)) + (readlane_f(v, 32) + readlane_f(v, 48));
}
__device__ __forceinline__ int seqrow(int b, int s) { return s < NMETA ? NGRID + NMETA * b + s : SEQ * b + (s - NMETA); }
__device__ __forceinline__ int batch_row(int b, int lr) { return lr < SEQ ? b * SEQ + lr : NGRID + 16 * b + (lr - SEQ); }

struct Params {
    const float* in[25];
    float* out;
    unsigned char* ws;
    int ph_lo, ph_hi;
};
struct Ctx {
    LAS unsigned char* lds;
    int G, bid, gc;
    int vx, vr, gs;
    unsigned char* ws;
    const float* const* in;
    float* out;
};
__device__ __forceinline__ int fresh_tid() { int t = threadIdx.x; asm volatile("" : "+v"(t)); return t; }
__device__ __forceinline__ unsigned char* fresh_ws(unsigned char* p) { asm volatile("" : "+s"(p)); return p; }
#define PHASE_IDS unsigned char* const wsl = fresh_ws(C.ws); (void)wsl; const int tid = fresh_tid(); const int lane = tid & 63; const int wave = __builtin_amdgcn_readfirstlane(tid >> 6); (void)lane; (void)wave;
enum { I_X = 0, I_META, I_WIN, I_CONVW, I_CONVB, I_WA, I_BA, I_WX, I_BX, I_LAM, I_LOUT, I_WQKV, I_RPB, I_MBIAS, I_NOUT, I_LNMG, I_LNMB, I_RW, I_RB, I_WGU, I_BGU, I_WD, I_BD, I_LNFG, I_LNFB };

namespace pg8 {
constexpr int BM = 256, BK = 64, HALF = 128, HTB = HALF * BK * 2, STAGE_BYTES = 8 * HTB, NXCD = 8, WGM = 8;
constexpr int SIDE_OFF = STAGE_BYTES, TEXP_OFF = STAGE_BYTES + 2048, TOK_OFF = STAGE_BYTES + 2048 + 4096;
__device__ __forceinline__ int lds_byte(int r, int c) { const int st = (r >> 4) * 2 + (c >> 5), rr = r & 15, cc = c & 31, ob = rr * 64 + cc * 2; return st * 1024 + (ob ^ (((ob >> 9) & 1) << 5)); }
__device__ __forceinline__ void stage_rc(int b, int& R, int& C) { const int st = b / 1024, sb = b % 1024, swz = sb ^ (((sb >> 9) & 1) << 5); R = (st >> 1) * 16 + swz / 64; C = (st & 1) * 32 + (swz % 64) / 2; }
__device__ __forceinline__ int perm32(int rho) { const int n = rho >> 4, i = rho & 15; return 8 * (i >> 2) + 4 * n + (i & 3); }

typedef int v8i __attribute__((ext_vector_type(8)));
typedef int v4i __attribute__((ext_vector_type(4)));
__device__ __forceinline__ v8i cat8(bf16x8 a, bf16x8 b) { const v4i x = __builtin_bit_cast(v4i, a), y = __builtin_bit_cast(v4i, b); return __builtin_shufflevector(x, y, 0, 1, 2, 3, 4, 5, 6, 7); }
struct Unit { unsigned ao, bo, to; int pm, pn, aux; };

__device__ __forceinline__ void tile_of(int L, int nM, int nN, int& pm, int& pn) {
    const int nwg = nM * nN; int wgid = L;
    { const int q = nwg / NXCD, r = nwg % NXCD, xcd = wgid % NXCD, off = wgid / NXCD; wgid = (xcd < r ? xcd * (q + 1) : r * (q + 1) + (xcd - r) * q) + off; }
    const int nig = WGM * nN, gid = wgid / nig, fm = gid * WGM, gsz = (nM - fm) < WGM ? (nM - fm) : WGM;
    pm = fm + ((wgid % nig) % gsz); pn = (wgid % nig) / gsz;
}

template <bool F8, bool GATHER, class Epi, class Sched>
__device__ __forceinline__ void gemm_phase(LAS unsigned char* lds, const unsigned char* wsbase, const int K, const int lda, const int ldb, const Sched& S, const Epi& E) {
    const __amdgpu_buffer_rsrc_t rsrc = __builtin_amdgcn_make_buffer_rsrc((void*)wsbase, 0, 0xFFFFFFFF, 0x00020000);
    const int tid = fresh_tid(), wid = __builtin_amdgcn_readfirstlane(tid >> 6), lane = tid & 63, wr = wid >> 2, wc = wid & 3;
    const int nt = K / BK;
    int f8scales = 0; if constexpr (F8) { f8scales = Epi::SCALES; asm volatile("" : "+v"(f8scales)); }
    int voffA, voffB;
    { int R, C; stage_rc(tid * 16, R, C); const int Rb = Epi::PERM ? ((R & ~31) + perm32(R & 31)) : R; voffA = ((GATHER ? 0 : R * lda) + C) * 2; voffB = (Rb * ldb + C) * 2; }
    const int tokb = (16 * (wid >> 1) + (lane >> 2)) * 4;
    const unsigned kstep = (unsigned)(BK * 2);
    const unsigned hstepA = (unsigned)HALF * lda * 2, hstepB = (unsigned)HALF * ldb * 2;
    const unsigned ldsw = (unsigned)wid * 1024u;
    const int aoff = lds_byte(wr * 64 + (lane & 15), (lane >> 4) * 8), boff = lds_byte(wc * 32 + (lane & 15), (lane >> 4) * 8);
#define PG8_SA(b, h) (((b) * 2 + (h)) * HTB)
#define PG8_SB(b, h) ((4 + (b) * 2 + (h)) * HTB)
#define PG8_STAGE(bufoff, gbase, voff) do { _Pragma("unroll") for (int _i = 0; _i < 2; ++_i) \
        __builtin_amdgcn_raw_ptr_buffer_load_lds(rsrc, (LAS void*)(lds + (bufoff) + ldsl + _i * 8192), 16, voff, __builtin_amdgcn_readfirstlane((int)((gbase) + (unsigned)_i * (hstep##voff >> 1))), 0, 0); } while (0)
#define hstepvoffA hstepA
#define hstepvoffB hstepB
#define PG8_STAGE_A(bufoff, aoffs, h, par) do { if constexpr (GATHER) { _Pragma("unroll") for (int _i = 0; _i < 2; ++_i) { \
            const int _tk = *(const LAS int*)(lds + TOK_OFF + (par) * 1024 + tokb + ((h) * 128 + _i * 64) * 4); \
            __builtin_amdgcn_raw_ptr_buffer_load_lds(rsrc, (LAS void*)(lds + (bufoff) + ldsl + _i * 8192), 16, _tk + voffA, __builtin_amdgcn_readfirstlane((int)(aoffs)), 0, 0); } } \
        else { PG8_STAGE(bufoff, (aoffs) + (unsigned)(h) * hstepA, voffA); } } while (0)
#define PG8_TOK(unit, par) do { if constexpr (GATHER) { if (wid == 0) __builtin_amdgcn_raw_ptr_buffer_load_lds(rsrc, (LAS void*)(lds + TOK_OFF + (par) * 1024), 16, lane * 16, (int)(unit).to, 0, 0); } } while (0)
#define PG8_LDA(dst, b, h) do { _Pragma("unroll") for (int m = 0; m < 4; ++m) _Pragma("unroll") for (int k = 0; k < 2; ++k) dst[m][k] = *(const LAS bf16x8*)(lds + PG8_SA(b, h) + aoff + m * 2048 + k * 1024); } while (0)
#define PG8_LDB(dst, b, h) do { _Pragma("unroll") for (int n = 0; n < 2; ++n) _Pragma("unroll") for (int k = 0; k < 2; ++k) dst[n][k] = *(const LAS bf16x8*)(lds + PG8_SB(b, h) + boff + n * 2048 + k * 1024); } while (0)
#define PG8_MMA(ai, bj, At, Bt) do { __builtin_amdgcn_s_setprio(1); _Pragma("unroll") for (int m = 0; m < 4; ++m) _Pragma("unroll") for (int n = 0; n < 2; ++n) { \
        if constexpr (F8) { asm volatile("v_mfma_scale_f32_16x16x128_f8f6f4 %0, %1, %2, %0, %3, %3 op_sel:[0,1,0] op_sel_hi:[0,0,0]" : "+v"(acc[ai][bj][m][n]) : "v"(cat8(Bt[n][0], Bt[n][1])), "v"(cat8(At[m][0], At[m][1])), "v"(f8scales)); } \
        else { _Pragma("unroll") for (int k = 0; k < 2; ++k) acc[ai][bj][m][n] = __builtin_amdgcn_mfma_f32_16x16x32_bf16(Bt[n][k], At[m][k], acc[ai][bj][m][n], 0, 0, 0); } } \
        __builtin_amdgcn_s_setprio(0); } while (0)
#define PG8_WAIT_V(n) asm volatile("s_waitcnt vmcnt(" #n ")" ::: "memory")
#define PG8_WAIT_L(n) asm volatile("s_waitcnt lgkmcnt(" #n ")" ::: "memory")
#define PG8_BAR __builtin_amdgcn_s_barrier()
#define PG8_SCHED __builtin_amdgcn_sched_barrier(0)
    Unit cur, nxt; int ui = 0;
    if (!S.next(0, cur)) return;
    f32x4 acc[2][2][4][2];
    bf16x8 At[4][2], B0[2][2], B1[2][2];
#define PG8_INIT(par) do { if constexpr (Epi::SIDE) { const int _l = fresh_tid() & 63; E.init(acc, (const LAS float*)(lds + SIDE_OFF + (par) * 1024), wc, _l >> 4); } \
        else { _Pragma("unroll") for (int a = 0; a < 2; ++a) _Pragma("unroll") for (int b = 0; b < 2; ++b) _Pragma("unroll") for (int m = 0; m < 4; ++m) _Pragma("unroll") for (int n = 0; n < 2; ++n) acc[a][b][m][n] = (f32x4){0.f, 0.f, 0.f, 0.f}; } } while (0)
    unsigned cA = cur.ao, cB = cur.bo;
    unsigned ldsl = ldsw; asm volatile("" : "+s"(ldsl));
#define PG8_SIDE(unit, par) do { if constexpr (Epi::SIDE) { if (wid == 0) __builtin_amdgcn_raw_ptr_buffer_load_lds(rsrc, (LAS void*)(lds + SIDE_OFF + (par) * 1024), 16, lane * 16, (int)E.side_off(unit), 0, 0); } } while (0)
    PG8_SIDE(cur, 0);
    if constexpr (GATHER) PG8_TOK(cur, 0);
    if constexpr (GATHER || Epi::SIDE) { asm volatile("s_waitcnt vmcnt(0)" ::: "memory"); PG8_BAR; }
    PG8_INIT(0);
    PG8_STAGE(PG8_SB(0, 0), cB, voffB); PG8_STAGE(PG8_SB(0, 1), cB + hstepB, voffB); PG8_STAGE_A(PG8_SA(0, 0), cA, 0, 0); PG8_STAGE_A(PG8_SA(0, 1), cA, 1, 0);
    if (wr == 1) PG8_BAR;
    PG8_WAIT_V(2); PG8_BAR;
    PG8_STAGE(PG8_SB(1, 0), cB + kstep, voffB); PG8_STAGE_A(PG8_SA(1, 0), cA + kstep, 0, 0); PG8_STAGE(PG8_SB(1, 1), cB + hstepB + kstep, voffB);
    PG8_WAIT_V(6); PG8_BAR;
    for (;;) {
        const bool has_next = S.next(ui + 1, nxt);
        if (has_next) { PG8_TOK(nxt, (ui + 1) & 1); PG8_SIDE(nxt, (ui + 1) & 1); }
        const unsigned nA = has_next ? nxt.ao : cA, nB = has_next ? nxt.bo : cB;
#pragma unroll 1
        for (int t = 0; t < nt; t += 2) {
            const bool last = (t == nt - 2);
            ldsl = ldsw; asm volatile("" : "+s"(ldsl));
            const int parc = ui & 1, parn = (ui + ((last && has_next) ? 1 : 0)) & 1;
            const unsigned a1 = cA + (unsigned)(t + 1) * kstep;
            const unsigned a2 = last ? nA : cA + (unsigned)(t + 2) * kstep, b2 = last ? nB : cB + (unsigned)(t + 2) * kstep;
            const unsigned a3 = a2 + kstep, b3 = b2 + kstep;
            PG8_LDB(B0, 0, 0); PG8_LDB(B1, 0, 1); PG8_SCHED; PG8_LDA(At, 0, 0); PG8_STAGE_A(PG8_SA(1, 1), a1, 1, parc);
            PG8_WAIT_V(8); PG8_WAIT_L(0); PG8_BAR; PG8_MMA(0, 0, At, B0); PG8_MMA(0, 1, At, B1); PG8_BAR; PG8_SCHED;
            PG8_LDA(At, 0, 1); PG8_STAGE(PG8_SB(0, 0), b2, voffB); PG8_STAGE(PG8_SB(0, 1), b2 + hstepB, voffB); PG8_STAGE_A(PG8_SA(0, 0), a2, 0, parn);
            PG8_WAIT_V(8); PG8_WAIT_L(0); PG8_BAR; PG8_MMA(1, 0, At, B0); PG8_MMA(1, 1, At, B1); PG8_BAR; PG8_SCHED;
            PG8_LDB(B0, 1, 0); PG8_LDB(B1, 1, 1); PG8_SCHED; PG8_LDA(At, 1, 0); PG8_STAGE_A(PG8_SA(0, 1), a2, 1, parn);
            PG8_WAIT_V(8); PG8_WAIT_L(0); PG8_BAR; PG8_MMA(0, 0, At, B0); PG8_MMA(0, 1, At, B1); PG8_BAR; PG8_SCHED;
            PG8_LDA(At, 1, 1); PG8_STAGE(PG8_SB(1, 0), b3, voffB); PG8_STAGE(PG8_SB(1, 1), b3 + hstepB, voffB); PG8_STAGE_A(PG8_SA(1, 0), a3, 0, parn);
            PG8_WAIT_V(8); PG8_WAIT_L(0); PG8_BAR; PG8_MMA(1, 0, At, B0); PG8_MMA(1, 1, At, B1); PG8_BAR; PG8_SCHED;
        }
        if constexpr (F8) asm volatile("s_nop 15\n\ts_nop 15" ::: "memory");
        if (wr == 0) PG8_BAR;
        { const int l2 = fresh_tid() & 63; E(acc, cur, wr, wc, l2 & 15, l2 >> 4, (const LAS float*)(lds + SIDE_OFF + (ui & 1) * 1024)); }
        if (!has_next) break;
        cur = nxt; cA = nA; cB = nB; ++ui;
        PG8_INIT(ui & 1);
        if (wr == 1) PG8_BAR;
    }
    PG8_WAIT_V(0);
    PG8_BAR;
#undef PG8_SA
#undef PG8_SB
#undef PG8_STAGE
#undef PG8_STAGE_A
#undef PG8_TOK
#undef PG8_SIDE
#undef PG8_INIT
#undef hstepvoffA
#undef hstepvoffB
#undef PG8_LDA
#undef PG8_LDB
#undef PG8_MMA
#undef PG8_WAIT_V
#undef PG8_WAIT_L
#undef PG8_BAR
#undef PG8_SCHED
}
}

using pg8::Unit;

struct DenseSched {
    unsigned A, Bt; int lda, ldb, nN, gs, vr, vx;
    __device__ __forceinline__ bool next(int i, Unit& u) const {
        const int L = i * gs + vr; if (vx >= 8 || L >= 16 * nN) return false;
        u.pm = 16 * vx + L / nN; u.pn = L % nN; u.aux = 0; u.to = 0;
        u.ao = A + (unsigned)u.pm * 256 * lda * 2; u.bo = Bt + (unsigned)u.pn * 256 * ldb * 2; return true;
    }
};
struct GateSched {
    unsigned XC, GT; int gs, vr, vx;
    __device__ __forceinline__ bool next(int i, Unit& u) const {
        const int L = i * gs + vr; if (vx >= 8 || L >= 256) return false;
        const int nb = L >> 6; u.pm = 16 * vx + ((L & 63) >> 2); u.pn = L & 3; u.aux = nb; u.to = 0;
        u.ao = XC + ((unsigned)u.pm * 256 * 1024 + 256 * nb) * 2; u.bo = GT + ((unsigned)nb * 1024 + 256 * u.pn) * 256 * 2; return true;
    }
};
struct QkvSched {
    unsigned HB, WT; int gs, vr, vx;
    __device__ __forceinline__ bool next(int i, Unit& u) const {
        const int L = i * gs + vr; if (vx >= 8 || L >= 128 + 64) return false; u.to = 0;
        if (L < 128) { u.pm = 16 * vx + (L >> 3); u.pn = L & 7; u.aux = 0; u.ao = HB + (unsigned)u.pm * 256 * 1024; u.bo = WT + (unsigned)u.pn * 256 * 1024; }
        else { const int Ly = L - 128; u.pm = Ly & 3; u.pn = 16 * vx + (Ly >> 2); u.aux = 1; u.ao = WT + (unsigned)(2048 + u.pm * 256) * 1024; u.bo = HB + (unsigned)u.pn * 256 * 1024; }
        return true;
    }
};
struct MoeSched {
    unsigned A, W, tok; const LAS int* texp; unsigned wstride; int nM, nN, G, c;
    __device__ __forceinline__ bool next(int i, Unit& u) const {
        const int L = i * G + c; if (L >= nM * nN) return false;
        pg8::tile_of(L, nM, nN, u.pm, u.pn);
        const int ej = __builtin_amdgcn_readfirstlane(texp[u.pm]), e = ej & 255; u.aux = e;
        u.ao = tok ? A : A + (unsigned)u.pm * 256 * 1024; u.to = tok + (unsigned)(e * TCAP + (ej >> 8) * 256) * 4u; u.bo = W + (unsigned)e * wstride + (unsigned)u.pn * 256 * 1024; return true;
    }
};

#define EPI_ARGS const f32x4 (&acc)[2][2][4][2], const Unit& u, int wr, int wc, int fr, int fq, const LAS float* side
struct EpiWin {
    static constexpr bool PERM = true, SIDE = false;
    bf16_t* XR; bf16_t* GY;
    __device__ __forceinline__ void operator()(EPI_ARGS) const {
        const int row0 = u.pm * 256 + wr * 64 + fr;
        if (u.pn < 4) {
            const int col0 = u.pn * 256 + wc * 32 + 8 * fq;
#pragma unroll
            for (int ai = 0; ai < 2; ++ai)
#pragma unroll
                for (int m = 0; m < 4; ++m) { bf16_t* rowp = XR + (size_t)(row0 + ai * 128 + m * 16) * D + col0;
#pragma unroll
                    for (int bj = 0; bj < 2; ++bj) { const f32x4 v0 = acc[ai][bj][m][0], v1 = acc[ai][bj][m][1];
                        u32x4 w; w.x = cvt_pk_bf16(v0[0], v0[1]); w.y = cvt_pk_bf16(v0[2], v0[3]); w.z = cvt_pk_bf16(v1[0], v1[1]); w.w = cvt_pk_bf16(v1[2], v1[3]);
                        *(u32x4*)(rowp + bj * 128) = w; } }
        } else {
#pragma unroll
            for (int ai = 0; ai < 2; ++ai)
#pragma unroll
                for (int m = 0; m < 4; ++m) { const int row = row0 + ai * 128 + m * 16;
#pragma unroll
                    for (int bj = 0; bj < 2; ++bj) { const int g = (u.pn - 4) * 8 + bj * 4 + wc;
                        float o[8];
#pragma unroll
                        for (int n = 0; n < 2; ++n)
#pragma unroll
                            for (int j = 0; j < 4; ++j) { const float v = acc[ai][bj][m][n][j]; const float z = 1.5957691216f * (v + 0.044715f * v * v * v); o[n * 4 + j] = v * sigmoidf_(z); }
                        u32x4 w; w.x = cvt_pk_bf16(o[0], o[1]); w.y = cvt_pk_bf16(o[2], o[3]); w.z = cvt_pk_bf16(o[4], o[5]); w.w = cvt_pk_bf16(o[6], o[7]);
                        *(u32x4*)(GY + ((size_t)g * MPAD + row) * 32 + 8 * fq) = w; } }
        }
    }
};
struct EpiGate {
    static constexpr bool PERM = true, SIDE = true;
    const bf16_t* XC; unsigned char* LB; const float* spl; unsigned bias_off;
    __device__ __forceinline__ unsigned side_off(const Unit& u) const { return bias_off + (unsigned)((((u.pn >> 1) * 4 + u.aux) * 2 + (u.pn & 1)) * 1024); }
    __device__ __forceinline__ void init(f32x4 (&acc)[2][2][4][2], const LAS float* side, int wc, int fq) const {
#pragma unroll
        for (int bj = 0; bj < 2; ++bj)
#pragma unroll
            for (int n = 0; n < 2; ++n) { const f32x4 b = *(const LAS f32x4*)(side + 128 * bj + 32 * wc + 8 * fq + 4 * n);
#pragma unroll
                for (int ai = 0; ai < 2; ++ai)
#pragma unroll
                    for (int m = 0; m < 4; ++m) acc[ai][bj][m][n] = b; }
    }
    __device__ __forceinline__ void operator()(EPI_ARGS) const {
        const int nb = u.aux, dir = u.pn >> 1, half = u.pn & 1;
        const int ch0 = 256 * nb + 128 * half + 32 * wc + 8 * fq, g = ch0 >> 5;
        const int row0 = u.pm * 256 + wr * 64 + fr;
        float csp[8];
        { const f32x4 p0 = *(const f32x4*)(spl + dir * 1024 + ch0), p1 = *(const f32x4*)(spl + dir * 1024 + ch0 + 4);
#pragma unroll
          for (int j = 0; j < 4; ++j) { csp[j] = (-2.0f / 256.0f) * p0[j]; csp[4 + j] = (-2.0f / 256.0f) * p1[j]; } }
        u32x4 xnext = *(const u32x4*)(XC + (size_t)row0 * D + ch0);
#pragma unroll
        for (int ai = 0; ai < 2; ++ai)
#pragma unroll
            for (int m = 0; m < 4; ++m) { const int row = row0 + ai * 128 + m * 16;
                const u32x4 xw = xnext;
                { const int it = ai * 4 + m + 1, rn = row0 + (it >> 2) * 128 + (it & 3) * 16; if (it < 8) xnext = *(const u32x4*)(XC + (size_t)rn * D + ch0); }
                float xc[8]; unpack8(xw, xc);
                const bool start = dir == 1 && (row & (SEQ - 1)) == SEQ - 1;
                float sg[8], bb[8];
#pragma unroll
                for (int n = 0; n < 2; ++n)
#pragma unroll
                    for (int j = 0; j < 4; ++j) { const int i = n * 4 + j;
                        const float sga = fast_rcp(__builtin_fmaf(fast_exp2(-1.44269504089f * acc[ai][0][m][n][j]), 1.0f / 256.0f, 1.0f / 256.0f));
                        const float a2 = fast_exp2(__builtin_fmaf(csp[i], sga, 6.0f));
                        const float mult = __builtin_amdgcn_sqrtf(__builtin_fabsf(64.0f - a2));
                        sg[i] = sga; bb[i] = __builtin_amdgcn_fmed3f(mult * sigmoidf_(acc[ai][1][m][n][j]) * xc[i], -448.0f, 448.0f); }
                if (start) {
#pragma unroll
                    for (int n = 0; n < 2; ++n)
#pragma unroll
                        for (int j = 0; j < 4; ++j) bb[n * 4 + j] = __builtin_amdgcn_fmed3f(8.0f * sigmoidf_(acc[ai][1][m][n][j]) * xc[n * 4 + j], -448.0f, 448.0f); }
                u32x4 w; w.x = pk4_fp8(sg[0], sg[1], sg[2], sg[3]); w.y = pk4_fp8(sg[4], sg[5], sg[6], sg[7]); w.z = pk4_fp8(bb[0], bb[1], bb[2], bb[3]); w.w = pk4_fp8(bb[4], bb[5], bb[6], bb[7]);
                *(u32x4*)(LB + (((size_t)dir * 32 + g) * MPAD + row) * 64 + 16 * fq) = w; }
    }
};
template <bool LAYER0> struct EpiRes {
    static constexpr bool PERM = true, SIDE = false;
    bf16_t* PRE; const float* x; const float* meta; const bf16_t* HB; int nrows;
    __device__ __forceinline__ void operator()(EPI_ARGS) const {
        const int row0 = u.pm * 256 + wr * 64 + fr, col0 = u.pn * 256 + wc * 32 + 8 * fq;
#pragma unroll
        for (int ai = 0; ai < 2; ++ai)
#pragma unroll
            for (int m = 0; m < 4; ++m) { const int row = row0 + ai * 128 + m * 16;
                if (row < nrows) {
#pragma unroll
                    for (int bj = 0; bj < 2; ++bj) { const int c = col0 + bj * 128; float r[8];
                        if (LAYER0) { const float* rp = (row < NGRID ? x + (size_t)row * D : meta + (size_t)((row - NGRID) & 15) * D) + c; const f32x4 r0 = *(const f32x4*)rp, r1 = *(const f32x4*)(rp + 4);
                            r[0] = r0[0]; r[1] = r0[1]; r[2] = r0[2]; r[3] = r0[3]; r[4] = r1[0]; r[5] = r1[1]; r[6] = r1[2]; r[7] = r1[3]; }
                        else { const u32x4 rw = *(const u32x4*)(HB + (size_t)row * D + c); r[0] = bflo(rw.x); r[1] = bfhi(rw.x); r[2] = bflo(rw.y); r[3] = bfhi(rw.y); r[4] = bflo(rw.z); r[5] = bfhi(rw.z); r[6] = bflo(rw.w); r[7] = bfhi(rw.w); }
                        const f32x4 a0 = acc[ai][bj][m][0], a1 = acc[ai][bj][m][1];
                        u32x4 w; w.x = cvt_pk_bf16(r[0] * DN_ALPHA + a0[0], r[1] * DN_ALPHA + a0[1]); w.y = cvt_pk_bf16(r[2] * DN_ALPHA + a0[2], r[3] * DN_ALPHA + a0[3]);
                        w.z = cvt_pk_bf16(r[4] * DN_ALPHA + a1[0], r[5] * DN_ALPHA + a1[1]); w.w = cvt_pk_bf16(r[6] * DN_ALPHA + a1[2], r[7] * DN_ALPHA + a1[3]);
                        *(u32x4*)(PRE + (size_t)row * D + c) = w; }
                }
                asm volatile("" ::: "memory"); }
    }
};
struct EpiGlu {
    static constexpr bool PERM = true, SIDE = true; static constexpr int SCALES = 0x7F79;
    unsigned char* ACT; unsigned bias_off;
    __device__ __forceinline__ unsigned side_off(const Unit& u) const { return bias_off + (unsigned)((u.aux * 8 + u.pn) * 1024); }
    __device__ __forceinline__ void init(f32x4 (&acc)[2][2][4][2], const LAS float* side, int wc, int fq) const {
#pragma unroll
        for (int bj = 0; bj < 2; ++bj)
#pragma unroll
            for (int n = 0; n < 2; ++n) { const f32x4 b = *(const LAS f32x4*)(side + 128 * bj + 32 * wc + 8 * fq + 4 * n);
#pragma unroll
                for (int ai = 0; ai < 2; ++ai)
#pragma unroll
                    for (int m = 0; m < 4; ++m) acc[ai][bj][m][n] = b; }
    }
    __device__ __forceinline__ void operator()(EPI_ARGS) const {
        const int f0 = 128 * u.pn + 32 * wc + 8 * fq;
        const int row0 = u.pm * 256 + wr * 64 + fr;
#pragma unroll
        for (int ai = 0; ai < 2; ++ai)
#pragma unroll
            for (int m = 0; m < 4; ++m) { const int row = row0 + ai * 128 + m * 16; float o[8];
#pragma unroll
                for (int n = 0; n < 2; ++n)
#pragma unroll
                    for (int j = 0; j < 4; ++j) { const int i = n * 4 + j;
                        const float glu = fminf(acc[ai][0][m][n][j], 7.0f);
                        const float lin1 = __builtin_amdgcn_fmed3f(acc[ai][1][m][n][j], -6.0f, 8.0f);
                        const float r4 = fast_rcp(__builtin_fmaf(fast_exp2(glu * (-1.702f * 1.44269504089f)), 0.25f, 0.25f));
                        o[i] = (glu * r4) * lin1; }
                u32x2 w; w.x = pk4_fp8(o[0], o[1], o[2], o[3]); w.y = pk4_fp8(o[4], o[5], o[6], o[7]);
                *(u32x2*)(ACT + (size_t)row * D + f0) = w; }
    }
};
struct EpiNull {
    static constexpr bool PERM = true, SIDE = false; static constexpr int SCALES = 0x7F79;
    __device__ __forceinline__ void operator()(EPI_ARGS) const {
#pragma unroll
        for (int ai = 0; ai < 2; ++ai)
#pragma unroll
            for (int bj = 0; bj < 2; ++bj)
#pragma unroll
                for (int m = 0; m < 4; ++m)
#pragma unroll
                    for (int n = 0; n < 2; ++n) asm volatile("" :: "v"(acc[ai][bj][m][n]));
    }
};
struct EpiDown {
    static constexpr bool PERM = true, SIDE = true; static constexpr int SCALES = 0x7D79;
    unsigned char* YS; unsigned bias_off;
    __device__ __forceinline__ unsigned side_off(const Unit& u) const { return bias_off + (unsigned)((u.aux * 4 + u.pn) * 1024); }
    __device__ __forceinline__ void init(f32x4 (&acc)[2][2][4][2], const LAS float* side, int wc, int fq) const {
#pragma unroll
        for (int bj = 0; bj < 2; ++bj)
#pragma unroll
            for (int n = 0; n < 2; ++n) { const f32x4 b = *(const LAS f32x4*)(side + 128 * bj + 32 * wc + 8 * fq + 4 * n);
#pragma unroll
                for (int ai = 0; ai < 2; ++ai)
#pragma unroll
                    for (int m = 0; m < 4; ++m) acc[ai][bj][m][n] = b; }
    }
    __device__ __forceinline__ void operator()(EPI_ARGS) const {
        const int row0 = u.pm * 256 + wr * 64 + fr, col0 = u.pn * 256 + wc * 32 + 8 * fq;
#pragma unroll
        for (int ai = 0; ai < 2; ++ai)
#pragma unroll
            for (int m = 0; m < 4; ++m) { unsigned char* rowp = YS + (size_t)(row0 + ai * 128 + m * 16) * D + col0;
#pragma unroll
                for (int bj = 0; bj < 2; ++bj) { const f32x4 v0 = acc[ai][bj][m][0] * 8.0f, v1 = acc[ai][bj][m][1] * 8.0f;
                    u32x2 w; w.x = pk4_fp8(v0[0], v0[1], v0[2], v0[3]); w.y = pk4_fp8(v1[0], v1[1], v1[2], v1[3]);
                    *(u32x2*)(rowp + bj * 128) = w; } }
    }
};
struct EpiQkv {
    static constexpr bool PERM = true, SIDE = false; static constexpr int SCALES = 0x7F79;
    bf16_t* Q; bf16_t* Kx; bf16_t* VT;
    __device__ __forceinline__ void operator()(EPI_ARGS) const {
        const int row0 = u.pm * 256 + wr * 64 + fr; bf16_t* base; int ldc, colt; float sc = 1.0f;
        if (u.aux == 0) { ldc = D; if (u.pn < 4) { base = Q; colt = u.pn * 256; sc = 0.125f * 1.44269504089f; } else { base = Kx; colt = (u.pn - 4) * 256; } }
        else { base = VT; ldc = MPAD; colt = u.pn * 256; }
        const int col0 = colt + wc * 32 + 8 * fq;
#pragma unroll
        for (int ai = 0; ai < 2; ++ai)
#pragma unroll
            for (int m = 0; m < 4; ++m) { bf16_t* rowp = base + (size_t)(row0 + ai * 128 + m * 16) * ldc + col0;
#pragma unroll
                for (int bj = 0; bj < 2; ++bj) { const f32x4 v0 = acc[ai][bj][m][0] * sc, v1 = acc[ai][bj][m][1] * sc;
                    u32x4 w; w.x = cvt_pk_bf16(v0[0], v0[1]); w.y = cvt_pk_bf16(v0[2], v0[3]); w.z = cvt_pk_bf16(v1[0], v1[1]); w.w = cvt_pk_bf16(v1[2], v1[3]);
                    *(u32x4*)(rowp + bj * 128) = w; } }
    }
};

struct CvItem { const float* src; unsigned char* dst; int ld, pitch, f8; };
__device__ __forceinline__ CvItem cv_item(const Ctx& C, unsigned char* wsl, int it) {
    constexpr int I0 = 512, I1 = 256, I2 = 256, I3 = 768, I4 = 256, I5 = 32768, I6 = 16384;
    CvItem q; int r = it;
    if (r < I0) { const int nbk = r & 63, kb = r >> 6; q.src = C.in[I_WIN] + (size_t)(128 * kb) * 2048 + 32 * nbk; q.ld = 2048; q.dst = wsl + WS_WIN + ((size_t)(32 * nbk) * 1024 + 128 * kb) * 2; q.pitch = 2048; q.f8 = 0; return q; } r -= I0;
    if (r < I1) { const int job = r >> 3, sub = r & 7, nbk = sub & 3, kb = sub >> 2;
        const int half = job & 1, which = (job >> 1) & 1, nb = (job >> 2) & 3, dir = job >> 4;
        q.src = C.in[which ? I_WX : I_WA] + (size_t)(dir * 4 + nb) * 65536 + (size_t)(128 * kb) * 256 + 128 * half + 32 * nbk; q.ld = 256;
        q.dst = wsl + WS_GATE + (((size_t)nb * 1024 + 256 * (2 * dir + half) + 128 * which + 32 * nbk) * 256 + 128 * kb) * 2; q.pitch = 512; q.f8 = 0; return q; } r -= I1;
    if (r < I2) { const int nbk = r & 31, kb = r >> 5; q.src = C.in[I_LOUT] + (size_t)(128 * kb) * 1024 + 32 * nbk; q.ld = 1024; q.dst = wsl + WS_LOUT + ((size_t)(32 * nbk) * 1024 + 128 * kb) * 2; q.pitch = 2048; q.f8 = 0; return q; } r -= I2;
    if (r < I3) { const int nbk = r % 96, kb = r / 96; q.src = C.in[I_WQKV] + (size_t)(128 * kb) * 3072 + 32 * nbk; q.ld = 3072; q.dst = wsl + WS_QKV + ((size_t)(32 * nbk) * 1024 + 128 * kb) * 2; q.pitch = 2048; q.f8 = 0; return q; } r -= I3;
    if (r < I4) { const int nbk = r & 31, kb = r >> 5; q.src = C.in[I_NOUT] + (size_t)(128 * kb) * 1024 + 32 * nbk; q.ld = 1024; q.dst = wsl + WS_NOUT + ((size_t)(32 * nbk) * 1024 + 128 * kb) * 2; q.pitch = 2048; q.f8 = 0; return q; } r -= I4;
    q.f8 = 1; q.pitch = 1024;
    if (r < I5) { const int mat = r >> 9, sub = r & 511, nbk = sub & 63, kb = sub >> 6; const int n0 = 32 * nbk, bj = n0 >> 10, f0 = n0 & 1023, pn = f0 >> 7, jj = f0 & 127;
        q.src = C.in[I_WGU] + (size_t)mat * 1024 * 2048 + (size_t)(128 * kb) * 2048 + n0; q.ld = 2048; q.dst = wsl + WS_WGU + ((size_t)mat * 2048 + 256 * pn + 128 * bj + jj) * 1024 + 128 * kb; return q; } r -= I5;
    if (r < I6) { const int mat = r >> 8, sub = r & 255, nbk = sub & 31, kb = sub >> 5;
        q.src = C.in[I_WD] + (size_t)mat * 1024 * 1024 + (size_t)(128 * kb) * 1024 + 32 * nbk; q.ld = 1024; q.dst = wsl + WS_WD + ((size_t)mat * 1024 + 32 * nbk) * 1024 + 128 * kb; return q; } r -= I6;
    { const int nbk = r % 96, kb = r / 96; q.src = C.in[I_WQKV] + (size_t)(128 * kb) * 3072 + 32 * nbk; q.ld = 3072; q.dst = wsl + WS_QKV8 + (size_t)(32 * nbk) * 1024 + 128 * kb; return q; }
}
__device__ __forceinline__ void phase_convert(const Ctx& C) {
    PHASE_IDS
    LAS float* scr = (LAS float*)(C.lds + wave * 16896);
    const int gw = C.bid * NWAVES + wave, NGW = C.G * NWAVES;
    constexpr int NIT = 512 + 256 + 256 + 768 + 256 + 32768 + 16384 + 768;
    if (gw < NIT) {
        const int r = lane >> 3, q4 = lane & 7, c = lane & 15, nn = lane >> 4;
        CvItem cur = cv_item(C, wsl, gw); int it = gw;
        f32x4 v[16];
#pragma unroll
        for (int i = 0; i < 16; ++i) v[i] = __builtin_nontemporal_load((const f32x4*)(cur.src + (size_t)(8 * i + r) * cur.ld + 4 * q4));
        for (;;) {
#pragma unroll
            for (int i = 0; i < 16; ++i) { LAS float* sp = scr + (8 * i + r) * 33 + 4 * q4; sp[0] = v[i][0]; sp[1] = v[i][1]; sp[2] = v[i][2]; sp[3] = v[i][3]; }
            const int nit = it + NGW; CvItem nxt = cur;
            if (nit < NIT) { nxt = cv_item(C, wsl, nit);
#pragma unroll
                for (int i = 0; i < 16; ++i) v[i] = __builtin_nontemporal_load((const f32x4*)(nxt.src + (size_t)(8 * i + r) * nxt.ld + 4 * q4)); }
            asm volatile("s_waitcnt lgkmcnt(0)" ::: "memory");
            if (cur.f8) {
#pragma unroll
                for (int j = 0; j < 8; ++j) { const int n = nn + 4 * j; const LAS float* sp = scr + (8 * c) * 33 + n;
                    u32x2 o; o.x = pk4_fp8(sp[0] * 64.0f, sp[33] * 64.0f, sp[2 * 33] * 64.0f, sp[3 * 33] * 64.0f); o.y = pk4_fp8(sp[4 * 33] * 64.0f, sp[5 * 33] * 64.0f, sp[6 * 33] * 64.0f, sp[7 * 33] * 64.0f);
                    *(u32x2*)(cur.dst + (size_t)n * cur.pitch + 8 * c) = o; }
            } else {
#pragma unroll
                for (int j = 0; j < 8; ++j) { const int n = nn + 4 * j; const LAS float* sp = scr + (8 * c) * 33 + n;
                    u32x4 o; o.x = pk2(sp[0], sp[33]); o.y = pk2(sp[2 * 33], sp[3 * 33]); o.z = pk2(sp[4 * 33], sp[5 * 33]); o.w = pk2(sp[6 * 33], sp[7 * 33]);
                    *(u32x4*)(cur.dst + (size_t)n * cur.pitch + 16 * c) = o; }
            }
            asm volatile("s_waitcnt lgkmcnt(0)" ::: "memory");
            if (nit >= NIT) break;
            cur = nxt; it = nit;
        }
    }
    const int gt = C.bid * NTHREADS + tid, NGT = C.G * NTHREADS;
    for (int i = gt; i < 2 * 32 * TCAP; i += NGT) ((int*)(wsl + WS_TOK2))[i] = 0;
    if (gt < 64) ((unsigned*)(wsl + WS_CTL + CT_BC))[gt] = 0u;
    for (int i = gt; i < 2048; i += NGT) ((float*)(wsl + WS_CTL + CT_SPL))[i] = 8.0f * 1.44269504089f * log1pf(expf(-C.in[I_LAM][i]));
    for (int i = gt; i < 2 * 32 * 2048; i += NGT) { const int le = i >> 11, r = i & 2047, pn = r >> 8, bj = (r >> 7) & 1, ii = r & 127;
        ((float*)(wsl + WS_BIAS))[i] = C.in[I_BGU][(size_t)le * 2048 + bj * 1024 + 128 * pn + ii] + (bj ? 1.0f : 0.0f); }
    for (int i = gt; i < 2 * 32 * 1024; i += NGT) ((float*)(wsl + WS_BD))[i] = C.in[I_BD][i];
    for (int i = gt; i < 4096; i += NGT) { const int ut = i >> 8, which = (i >> 7) & 1, jj = i & 127, dir = ut >> 3, nb = (ut >> 1) & 3, half = ut & 1;
        ((float*)(wsl + WS_GBIAS))[i] = C.in[which ? I_BX : I_BA][dir * 1024 + 256 * nb + 128 * half + jj]; }
    for (int i0 = gt; i0 < NTOK * 128; i0 += 4 * NGT) { f32x4 a[4], b[4];
#pragma unroll
        for (int u = 0; u < 4; ++u) { const int i = i0 + u * NGT; if (i < NTOK * 128) { const int row = i >> 7, oc = i & 127;
            const float* src = (row < NGRID ? C.in[I_X] + (size_t)row * D : C.in[I_META] + (size_t)((row - NGRID) & 15) * D) + 8 * oc;
            a[u] = __builtin_nontemporal_load((const f32x4*)src); b[u] = __builtin_nontemporal_load((const f32x4*)(src + 4)); } }
#pragma unroll
        for (int u = 0; u < 4; ++u) { const int i = i0 + u * NGT; if (i < NTOK * 128) { const int row = i >> 7, oc = i & 127;
            u32x4 w; w.x = pk2(a[u][0], a[u][1]); w.y = pk2(a[u][2], a[u][3]); w.z = pk2(b[u][0], b[u][1]); w.w = pk2(b[u][2], b[u][3]);
            *(u32x4*)((bf16_t*)(wsl + WS_HB) + (size_t)row * D + 8 * oc) = w; } } }
}

__device__ __forceinline__ void phase_conv(const Ctx& C) {
    PHASE_IDS
    const bf16_t* XR = (const bf16_t*)(wsl + WS_XR); bf16_t* XC = (bf16_t*)(wsl + WS_XC);
    const float* cw = C.in[I_CONVW]; const float* cb = C.in[I_CONVB];
    const int gt = C.vr * NTHREADS + tid, NGT = C.gs * NTHREADS;
    for (int i = gt; C.vx < 8 && i < LSEQ * 128; i += NGT) { const int row = batch_row(C.vx, i >> 7), ch = 8 * (i & 127);
        int b, s; if (row < NGRID) { b = row >> 12; s = NMETA + (row & (SEQ - 1)); } else { b = (row - NGRID) >> 4; s = (row - NGRID) & 15; }
        float a[8];
        { const f32x4 t0 = *(const f32x4*)(cb + ch), t1 = *(const f32x4*)(cb + ch + 4);
#pragma unroll
          for (int j = 0; j < 4; ++j) { a[j] = t0[j]; a[4 + j] = t1[j]; } }
#pragma unroll
        for (int j = 0; j < 4; ++j) { const int sj = s - 2 + j;
            if (sj >= 0 && sj < LSEQ) { const u32x4 xw = *(const u32x4*)(XR + (size_t)seqrow(b, sj) * D + ch);
                const f32x4 w0 = *(const f32x4*)(cw + j * 1024 + ch), w1 = *(const f32x4*)(cw + j * 1024 + ch + 4);
                a[0] += w0[0] * bflo(xw.x); a[1] += w0[1] * bfhi(xw.x); a[2] += w0[2] * bflo(xw.y); a[3] += w0[3] * bfhi(xw.y);
                a[4] += w1[0] * bflo(xw.z); a[5] += w1[1] * bfhi(xw.z); a[6] += w1[2] * bflo(xw.w); a[7] += w1[3] * bfhi(xw.w); } }
        u32x4 w; w.x = pk2(a[0], a[1]); w.y = pk2(a[2], a[3]); w.z = pk2(a[4], a[5]); w.w = pk2(a[6], a[7]);
        *(u32x4*)(XC + (size_t)row * D + ch) = w; }
}

template <int N> __device__ __forceinline__ float dpp_shr(float oldv, float v) {
    return __builtin_bit_cast(float, __builtin_amdgcn_update_dpp(__builtin_bit_cast(int, oldv), __builtin_bit_cast(int, v), 0x110 + N, 0xf, 0xf, false));
}
__device__ __forceinline__ void scan_group(float (&a)[8], float (&b)[8]) {
#define SG_STEP(N) _Pragma("unroll") for (int c = 0; c < 8; ++c) { \
        asm volatile("v_fmac_f32_dpp %0, %0, %1 row_shr:" #N " row_mask:0xf bank_mask:0xf bound_ctrl:1" : "+v"(b[c]) : "v"(a[c])); } \
    _Pragma("unroll") for (int c = 0; c < 8; ++c) { \
        asm volatile("v_mul_f32_dpp %0, %0, %0 row_shr:" #N " row_mask:0xf bank_mask:0xf" : "+v"(a[c])); }
    asm volatile("s_nop 1" ::: "memory");
    SG_STEP(1) SG_STEP(2) SG_STEP(4) SG_STEP(8)
    asm volatile("s_nop 1" ::: "memory");
#undef SG_STEP
}
__device__ __forceinline__ void unpack8(const u32x4 w, float (&o)[8]) { o[0] = bflo(w.x); o[1] = bfhi(w.x); o[2] = bflo(w.y); o[3] = bfhi(w.y); o[4] = bflo(w.z); o[5] = bfhi(w.z); o[6] = bflo(w.w); o[7] = bfhi(w.w); }
__device__ __forceinline__ void phase_scan(const Ctx& C) {
    PHASE_IDS
    const unsigned char* LB = wsl + WS_LA; const float* spl = (const float*)(wsl + WS_CTL + CT_SPL); const bf16_t* GY = (const bf16_t*)(wsl + WS_GY);
    bf16_t* HF = (bf16_t*)(wsl + WS_HF); bf16_t* Gout = (bf16_t*)(wsl + WS_G);
    LAS float* agg = (LAS float*)C.lds;
    const int w = wave, oct = lane >> 4, p = lane & 15;
    for (int g = C.vr; C.vx < 8 && g < 32; g += C.gs) {
        const int b = C.vx;
        for (int dir = 0; dir < 2; ++dir) {
            const unsigned char* lb = LB + (((size_t)dir * 32 + g) * MPAD) * 64 + 16 * oct;
            float cs[8];
            { const f32x4 p0 = *(const f32x4*)(spl + dir * 1024 + 32 * g + 8 * oct), p1 = *(const f32x4*)(spl + dir * 1024 + 32 * g + 8 * oct + 4);
#pragma unroll
              for (int c = 0; c < 4; ++c) { cs[c] = p0[c] * (-1.0f / 256.0f); cs[4 + c] = p1[c] * (-1.0f / 256.0f); } }
            float S[8];
#pragma unroll
            for (int c = 0; c < 8; ++c) S[c] = 0.f;
            {
                const int u = p, s = dir ? LSEQ - 1 - u : u, row = seqrow(b, s);
                float a[8], x[8]; { const u32x4 rec = *(const u32x4*)(lb + (size_t)row * 64); u32x2 t; t.x = rec.x; t.y = rec.y; unpack8_fp8(t, a); t.x = rec.z; t.y = rec.w; unpack8_fp8(t, x); }
#pragma unroll
                for (int c = 0; c < 8; ++c) { a[c] = fast_exp2(a[c] * cs[c]); x[c] *= 0.125f; }
                scan_group(a, x);
                if (w == 0) {
                    if (dir == 0) { u32x4 o; o.x = pk2(x[0], x[1]); o.y = pk2(x[2], x[3]); o.z = pk2(x[4], x[5]); o.w = pk2(x[6], x[7]); *(u32x4*)(HF + ((size_t)g * MPAD + row) * 32 + 8 * oct) = o; }
                    else { float hf[8], gy[8]; unpack8(*(const u32x4*)(HF + ((size_t)g * MPAD + row) * 32 + 8 * oct), hf); unpack8(*(const u32x4*)(GY + ((size_t)g * MPAD + row) * 32 + 8 * oct), gy);
                        u32x4 o; o.x = pk2((hf[0] + x[0]) * gy[0], (hf[1] + x[1]) * gy[1]); o.y = pk2((hf[2] + x[2]) * gy[2], (hf[3] + x[3]) * gy[3]);
                        o.z = pk2((hf[4] + x[4]) * gy[4], (hf[5] + x[5]) * gy[5]); o.w = pk2((hf[6] + x[6]) * gy[6], (hf[7] + x[7]) * gy[7]);
                        *(u32x4*)(Gout + (size_t)row * D + 32 * g + 8 * oct) = o; }
                }
#pragma unroll
                for (int c = 0; c < 8; ++c) S[c] = __shfl(x[c], (lane & 48) | 15);
            }
            u32x4 na[4];
#pragma unroll
            for (int j = 0; j < 4; ++j) { const int u = 16 + 64 * w + 16 * j + p, s = dir ? LSEQ - 1 - u : u; const int rw = seqrow(b, s);
                na[j] = __builtin_nontemporal_load((const u32x4*)(lb + (size_t)rw * 64)); }
            for (int r = 0; r < 8; ++r) {
                float Pw[4][8], Hw[4][8]; int rows[4];
                float Aw[8], Hc[8];
#pragma unroll
                for (int c = 0; c < 8; ++c) { Aw[c] = 1.f; Hc[c] = 0.f; }
                u32x4 ra[4], rhf[4], rgy[4];
#pragma unroll
                for (int j = 0; j < 4; ++j) { const int u = 16 + 512 * r + 64 * w + 16 * j + p, s = dir ? LSEQ - 1 - u : u; rows[j] = seqrow(b, s); ra[j] = na[j]; }
                if (r < 7) {
#pragma unroll
                    for (int j = 0; j < 4; ++j) { const int u = 16 + 512 * (r + 1) + 64 * w + 16 * j + p, s = dir ? LSEQ - 1 - u : u; const int rw = seqrow(b, s);
                        na[j] = __builtin_nontemporal_load((const u32x4*)(lb + (size_t)rw * 64)); } }
                if (dir == 1) {
#pragma unroll
                    for (int j = 0; j < 4; ++j) { const size_t go = ((size_t)g * MPAD + rows[j]) * 32 + 8 * oct; rhf[j] = *(const u32x4*)(HF + go); rgy[j] = __builtin_nontemporal_load((const u32x4*)(GY + go)); } }
#pragma unroll
                for (int j = 0; j < 4; ++j) {
                    float a[8], x[8]; { u32x2 t; t.x = ra[j].x; t.y = ra[j].y; unpack8_fp8(t, a); t.x = ra[j].z; t.y = ra[j].w; unpack8_fp8(t, x); }
#pragma unroll
                    for (int c = 0; c < 8; ++c) { a[c] = fast_exp2(a[c] * cs[c]); x[c] *= 0.125f; }
                    scan_group(a, x);
#pragma unroll
                    for (int c = 0; c < 8; ++c) { Hw[j][c] = a[c] * Hc[c] + x[c]; Pw[j][c] = a[c] * Aw[c]; }
#pragma unroll
                    for (int c = 0; c < 8; ++c) { Aw[c] = __shfl(Pw[j][c], (lane & 48) | 15); Hc[c] = __shfl(Hw[j][c], (lane & 48) | 15); }
                }
                LAS float* ag = agg + (r & 1) * 512;
                if (p == 0) {
#pragma unroll
                    for (int c = 0; c < 8; ++c) { ag[(w * 32 + oct * 8 + c) * 2] = Aw[c]; ag[(w * 32 + oct * 8 + c) * 2 + 1] = Hc[c]; }
                }
                __syncthreads();
                float Sin[8];
#pragma unroll
                for (int c = 0; c < 8; ++c) Sin[c] = S[c];
#pragma unroll
                for (int ww = 0; ww < 8; ++ww) {
#pragma unroll
                    for (int c = 0; c < 8; ++c) { const float A = ag[(ww * 32 + oct * 8 + c) * 2], H = ag[(ww * 32 + oct * 8 + c) * 2 + 1];
                        if (ww == w) Sin[c] = S[c];
                        S[c] = A * S[c] + H; }
                }
#pragma unroll
                for (int j = 0; j < 4; ++j) {
                    float h[8];
#pragma unroll
                    for (int c = 0; c < 8; ++c) h[c] = Pw[j][c] * Sin[c] + Hw[j][c];
                    const size_t go = ((size_t)g * MPAD + rows[j]) * 32 + 8 * oct;
                    if (dir == 0) { u32x4 o; o.x = pk2(h[0], h[1]); o.y = pk2(h[2], h[3]); o.z = pk2(h[4], h[5]); o.w = pk2(h[6], h[7]); *(u32x4*)(HF + go) = o; }
                    else { float hf[8], gy[8]; unpack8(rhf[j], hf); unpack8(rgy[j], gy);
                        u32x4 o; o.x = pk2((hf[0] + h[0]) * gy[0], (hf[1] + h[1]) * gy[1]); o.y = pk2((hf[2] + h[2]) * gy[2], (hf[3] + h[3]) * gy[3]);
                        o.z = pk2((hf[4] + h[4]) * gy[4], (hf[5] + h[5]) * gy[5]); o.w = pk2((hf[6] + h[6]) * gy[6], (hf[7] + h[7]) * gy[7]);
                        *(u32x4*)(Gout + (size_t)rows[j] * D + 32 * g + 8 * oct) = o; }
                }
            }
            __syncthreads();
        }
    }
}

template <int K> __device__ __forceinline__ f32x4 mini_mma(const bf16_t* W, int ldw, const bf16_t* A, int lda, int lane) {
    const bf16_t* wp = W + (size_t)(lane & 15) * ldw + 8 * (lane >> 4); const bf16_t* ap = A + (size_t)(lane & 15) * lda + 8 * (lane >> 4);
    f32x4 acc = {0.f, 0.f, 0.f, 0.f};
    constexpr int KB = K < 512 ? K : 512, NS = KB / 32;
#pragma unroll 1
    for (int k0 = 0; k0 < K; k0 += KB) { bf16x8 wf[NS], af[NS];
#pragma unroll
        for (int i = 0; i < NS; ++i) { wf[i] = *(const bf16x8*)(wp + k0 + 32 * i); af[i] = *(const bf16x8*)(ap + k0 + 32 * i); }
#pragma unroll
        for (int i = 0; i < NS; ++i) acc = __builtin_amdgcn_mfma_f32_16x16x32_bf16(wf[i], af[i], acc, 0, 0, 0); }
    return acc;
}
__device__ __forceinline__ void mini_win(const Ctx& C) {
    PHASE_IDS
    const bf16_t* HB = (const bf16_t*)(C.ws + WS_HB); const bf16_t* WT = (const bf16_t*)(C.ws + WS_WIN); bf16_t* XR = (bf16_t*)(C.ws + WS_XR); bf16_t* GY = (bf16_t*)(C.ws + WS_GY);
    const int fr = lane & 15, fq = lane >> 4;
    for (int wt = (C.vr * NWAVES + wave) * 8 + C.vx; C.vx < 8 && wt < 8 * 128; wt += C.gs * NWAVES * 8) { const int rg = wt & 7, cb = wt >> 3, row = NGRID + 16 * rg + fr, c = 16 * cb + 4 * fq;
        const f32x4 a = mini_mma<1024>(WT + (size_t)(16 * cb) * 1024, 1024, HB + (size_t)(NGRID + 16 * rg) * 1024, 1024, lane);
        if (c < 1024) { u32x2 w; w.x = cvt_pk_bf16(a[0], a[1]); w.y = cvt_pk_bf16(a[2], a[3]); *(u32x2*)(XR + (size_t)row * D + c) = w; }
        else { const int yc = c - 1024; float o[4];
#pragma unroll
            for (int j = 0; j < 4; ++j) { const float v = a[j]; const float z = 1.5957691216f * (v + 0.044715f * v * v * v); o[j] = v * sigmoidf_(z); }
            u32x2 w; w.x = cvt_pk_bf16(o[0], o[1]); w.y = cvt_pk_bf16(o[2], o[3]); *(u32x2*)(GY + ((size_t)(yc >> 5) * MPAD + row) * 32 + (yc & 31)) = w; } }
}
__device__ __forceinline__ void mini_gate(const Ctx& C) {
    PHASE_IDS
    const bf16_t* XC = (const bf16_t*)(C.ws + WS_XC); const bf16_t* GT = (const bf16_t*)(C.ws + WS_GATE); unsigned char* LB = C.ws + WS_LA;
    const float* ba = C.in[I_BA]; const float* bx = C.in[I_BX]; const float* spl = (const float*)(C.ws + WS_CTL + CT_SPL);
    const int fr = lane & 15, fq = lane >> 4;
    for (int wt = (C.vr * NWAVES + wave) * 8 + C.vx; C.vx < 8 && wt < 8 * 2 * 64; wt += C.gs * NWAVES * 8) { const int rg = wt & 7, dir = (wt >> 3) & 1, chg = wt >> 4, ch0 = 16 * chg, nb = ch0 >> 8, half = (ch0 >> 7) & 1, jj0 = ch0 & 127;
        const bf16_t* A = XC + (size_t)(NGRID + 16 * rg) * 1024 + 256 * nb; const bf16_t* Wa = GT + ((size_t)nb * 1024 + 256 * (2 * dir + half) + jj0) * 256;
        const f32x4 za = mini_mma<256>(Wa, 256, A, 1024, lane), zx = mini_mma<256>(Wa + 128 * 256, 256, A, 1024, lane);
        const int row = NGRID + 16 * rg + fr, ch = ch0 + 4 * fq;
        const f32x4 cba = *(const f32x4*)(ba + dir * 1024 + ch), cbx = *(const f32x4*)(bx + dir * 1024 + ch), csp = *(const f32x4*)(spl + dir * 1024 + ch);
        const u32x2 xw = *(const u32x2*)(XC + (size_t)row * D + ch); const float xc[4] = {bflo(xw.x), bfhi(xw.x), bflo(xw.y), bfhi(xw.y)};
        float sg[4], bb[4];
#pragma unroll
        for (int j = 0; j < 4; ++j) { const float sga = sigmoidf_(za[j] + cba[j]); const float a2 = fast_exp2(-2.0f * csp[j] * sga);
            const float mult = (dir == 0 && fr == 0) ? 8.0f : 8.0f * __builtin_amdgcn_sqrtf(fmaxf(1.0f - a2, 0.0f));
            sg[j] = sga * 256.0f; bb[j] = __builtin_amdgcn_fmed3f(mult * sigmoidf_(zx[j] + cbx[j]) * xc[j], -448.0f, 448.0f); }
        unsigned char* o = LB + (((size_t)dir * 32 + (ch >> 5)) * MPAD + row) * 64 + 16 * ((ch & 31) >> 3) + (ch & 7);
        *(unsigned*)o = pk4_fp8(sg[0], sg[1], sg[2], sg[3]); *(unsigned*)(o + 8) = pk4_fp8(bb[0], bb[1], bb[2], bb[3]); }
}
__device__ __forceinline__ void mini_lout(const Ctx& C) {
    PHASE_IDS
    const bf16_t* G = (const bf16_t*)(C.ws + WS_G); const bf16_t* WT = (const bf16_t*)(C.ws + WS_LOUT); bf16_t* PRE = (bf16_t*)(C.ws + WS_PRE); const float* meta = C.in[I_META];
    const int fr = lane & 15, fq = lane >> 4;
    for (int wt = (C.vr * NWAVES + wave) * 8 + C.vx; C.vx < 8 && wt < 8 * 64; wt += C.gs * NWAVES * 8) { const int rg = wt & 7, cb = wt >> 3, row = NGRID + 16 * rg + fr, c = 16 * cb + 4 * fq;
        const f32x4 a = mini_mma<1024>(WT + (size_t)(16 * cb) * 1024, 1024, G + (size_t)(NGRID + 16 * rg) * 1024, 1024, lane);
        const f32x4 r = *(const f32x4*)(meta + (size_t)fr * D + c);
        u32x2 w; w.x = cvt_pk_bf16(r[0] * DN_ALPHA + a[0], r[1] * DN_ALPHA + a[1]); w.y = cvt_pk_bf16(r[2] * DN_ALPHA + a[2], r[3] * DN_ALPHA + a[3]); *(u32x2*)(PRE + (size_t)row * D + c) = w; }
}
__device__ __forceinline__ void mini_kv(const Ctx& C) {
    PHASE_IDS
    const bf16_t* HB = (const bf16_t*)(C.ws + WS_HB); const bf16_t* WT = (const bf16_t*)(C.ws + WS_QKV); bf16_t* Kx = (bf16_t*)(C.ws + WS_K); bf16_t* VT = (bf16_t*)(C.ws + WS_VT);
    const int fr = lane & 15, fq = lane >> 4;
    for (int wt = (C.vr * NWAVES + wave) * 8 + C.vx; C.vx < 8 && wt < 2 * 8 * 64; wt += C.gs * NWAVES * 8) { const int rg = wt & 7, cb = (wt >> 3) & 63, isv = wt >> 9;
        const bf16_t* A = HB + (size_t)(NGRID + 16 * rg) * 1024;
        if (!isv) { const f32x4 a = mini_mma<1024>(WT + (size_t)(1024 + 16 * cb) * 1024, 1024, A, 1024, lane);
            u32x2 w; w.x = cvt_pk_bf16(a[0], a[1]); w.y = cvt_pk_bf16(a[2], a[3]); *(u32x2*)(Kx + (size_t)(NGRID + 16 * rg + fr) * D + 16 * cb + 4 * fq) = w; }
        else { const f32x4 a = mini_mma<1024>(A, 1024, WT + (size_t)(2048 + 16 * cb) * 1024, 1024, lane);
            u32x2 w; w.x = cvt_pk_bf16(a[0], a[1]); w.y = cvt_pk_bf16(a[2], a[3]); *(u32x2*)(VT + (size_t)(16 * cb + fr) * MPAD + NGRID + 16 * rg + 4 * fq) = w; } }
}

constexpr int RW_PITCH = 2080;
__device__ __forceinline__ void phase_lnr(const Ctx& C, int layer, int nrows) {
    PHASE_IDS
    const bf16_t* PRE = (const bf16_t*)(wsl + WS_PRE); bf16_t* HB = (bf16_t*)(wsl + WS_HB); unsigned char* HB8 = wsl + WS_HB8;
    const float* lg = C.in[I_LNMG] + layer * D; const float* lb = C.in[I_LNMB] + layer * D;
    const float* rw = C.in[I_RW] + (size_t)layer * D * NEXP; const float* rb = C.in[I_RB] + layer * NEXP;
    int* eid = (int*)(wsl + WS_CTL + CT_EID) + (size_t)layer * NTOK * 4; float* gatev = (float*)(wsl + WS_CTL + CT_GATEV) + (size_t)layer * NTOK * 4;
    unsigned* gcnt = (unsigned*)(wsl + WS_CTL + CT_BC) + layer * 32; int* posv = (int*)(wsl + WS_CTL + CT_POS) + (size_t)layer * NTOK * 4; int* tok2 = (int*)(wsl + WS_TOK2) + (size_t)layer * 32 * TCAP;
    LAS unsigned char* RWt = C.lds; LAS unsigned char* rowb = C.lds + 32 * RW_PITCH + wave * (4 * RW_PITCH);
    LAS float* lgt = (LAS float*)(C.lds + 32 * RW_PITCH + NWAVES * 4 * RW_PITCH) + wave * 128; LAS unsigned* hist = (LAS unsigned*)(C.lds + 32 * RW_PITCH + NWAVES * 4 * RW_PITCH + NWAVES * 512);
#pragma unroll
    for (int i = 0; i < 8; ++i) { const int idx = tid + NTHREADS * i, pc = idx >> 3, e4 = (idx & 7) * 4, ch = 2 * pc;
        const f32x4 w0 = *(const f32x4*)(rw + (size_t)ch * NEXP + e4), w1 = *(const f32x4*)(rw + (size_t)(ch + 1) * NEXP + e4);
#pragma unroll
        for (int q = 0; q < 4; ++q) *(LAS unsigned*)(RWt + (e4 + q) * RW_PITCH + pc * 4) = pk2(w0[q], w1[q]); }
    if (tid < 32) hist[tid] = 0u;
    __syncthreads();
    float gg[2][8], gb[2][8];
#pragma unroll
    for (int j = 0; j < 2; ++j) { const f32x4 a0 = *(const f32x4*)(lg + 8 * lane + 512 * j), a1 = *(const f32x4*)(lg + 8 * lane + 512 * j + 4), b0 = *(const f32x4*)(lb + 8 * lane + 512 * j), b1 = *(const f32x4*)(lb + 8 * lane + 512 * j + 4);
#pragma unroll
        for (int i = 0; i < 4; ++i) { gg[j][i] = a0[i]; gg[j][4 + i] = a1[i]; gb[j][i] = b0[i]; gb[j][4 + i] = b1[i]; } }
    const float rbias = rb[lane >> 1];
    const int gw = C.vr * NWAVES + wave, NGW = C.gs * NWAVES, nper = nrows == NTOK ? LSEQ : SEQ, bq = C.vx;
    const int nmine = (bq < 8 && gw < nper) ? (nper - gw + NGW - 1) / NGW : 0;
    u32x4 nv[2];
    if (nmine > 0) {
#pragma unroll
        for (int j = 0; j < 2; ++j) nv[j] = __builtin_nontemporal_load((const u32x4*)(PRE + (size_t)batch_row(bq, gw) * D + 8 * lane + 512 * j)); }
    const int fr = lane & 15, fq = lane >> 4;
    for (int i0 = 0; i0 < nmine; i0 += 4) {
#pragma unroll
        for (int ii = 0; ii < 4; ++ii) if (i0 + ii < nmine) {
            const int row = batch_row(bq, gw + NGW * (i0 + ii));
            float v[2][8]; float s = 0.f;
#pragma unroll
            for (int j = 0; j < 2; ++j) { unpack8(nv[j], v[j]); s += ((v[j][0] + v[j][1]) + (v[j][2] + v[j][3])) + ((v[j][4] + v[j][5]) + (v[j][6] + v[j][7])); }
            if (i0 + ii + 1 < nmine) {
#pragma unroll
                for (int j = 0; j < 2; ++j) nv[j] = __builtin_nontemporal_load((const u32x4*)(PRE + (size_t)batch_row(bq, gw + NGW * (i0 + ii + 1)) * D + 8 * lane + 512 * j)); }
            const float mean = wave_sum_dpp(s) * (1.0f / D); float q = 0.f;
#pragma unroll
            for (int j = 0; j < 2; ++j)
#pragma unroll
                for (int i = 0; i < 8; ++i) { v[j][i] -= mean; q += v[j][i] * v[j][i]; }
            const float rstd = __builtin_amdgcn_rsqf(wave_sum_dpp(q) * (1.0f / D) + LN_EPS);
#pragma unroll
            for (int j = 0; j < 2; ++j) {
#pragma unroll
                for (int i = 0; i < 8; ++i) v[j][i] = v[j][i] * rstd * gg[j][i] + gb[j][i];
                u32x4 w; w.x = pk2(v[j][0], v[j][1]); w.y = pk2(v[j][2], v[j][3]); w.z = pk2(v[j][4], v[j][5]); w.w = pk2(v[j][6], v[j][7]);
                *(u32x4*)(HB + (size_t)row * D + 8 * lane + 512 * j) = w;
                *(LAS u32x4*)(rowb + ii * RW_PITCH + 16 * lane + 1024 * j) = w;
                u32x2 w8; w8.x = pk4_fp8(v[j][0], v[j][1], v[j][2], v[j][3]); w8.y = pk4_fp8(v[j][4], v[j][5], v[j][6], v[j][7]);
                *(u32x2*)(HB8 + (size_t)row * D + 8 * lane + 512 * j) = w8; }
        }
        asm volatile("s_waitcnt lgkmcnt(0)" ::: "memory");
        f32x4 l0 = {0.f, 0.f, 0.f, 0.f}, l1 = {0.f, 0.f, 0.f, 0.f};
        { const LAS unsigned char* ap = RWt + fr * RW_PITCH + 16 * fq; const LAS unsigned char* bp = rowb + (fr & 3) * RW_PITCH + 16 * fq;
#pragma unroll
          for (int ks = 0; ks < 32; ++ks) { const bf16x8 b = *(const LAS bf16x8*)(bp + 64 * ks), a0 = *(const LAS bf16x8*)(ap + 64 * ks), a1 = *(const LAS bf16x8*)(ap + 16 * RW_PITCH + 64 * ks);
              l0 = __builtin_amdgcn_mfma_f32_16x16x32_bf16(a0, b, l0, 0, 0, 0); l1 = __builtin_amdgcn_mfma_f32_16x16x32_bf16(a1, b, l1, 0, 0, 0); } }
        if (fr < 4) { *(LAS f32x4*)(lgt + fr * 32 + 4 * fq) = l0; *(LAS f32x4*)(lgt + fr * 32 + 16 + 4 * fq) = l1; }
        asm volatile("s_waitcnt lgkmcnt(0)" ::: "memory");
#pragma unroll
        for (int ii = 0; ii < 4; ++ii) if (i0 + ii < nmine) {
            const int row = batch_row(bq, gw + NGW * (i0 + ii));
            float lv = lgt[ii * 32 + (lane >> 1)] + rbias; lv = (lv == lv) ? lv : -3.0e38f;
            const int le = lane >> 1;
            int rank = 0;
#pragma unroll
            for (int j = 0; j < 32; ++j) { const float lj = readlane_f(lv, 2 * j); rank += (lj > lv || (lj == lv && j < le)) ? 1 : 0; }
            const unsigned long long m0 = __ballot(rank == 0);
            const float mxl = readlane_f(lv, (int)__builtin_ctzll(m0));
            const float pe = rank < 4 ? __expf(lv - mxl) : 0.f;
            const float den = wave_sum_dpp(pe) * 0.5f;
            if (rank < 4 && (lane & 1) == 0) { eid[(size_t)row * 4 + rank] = le; gatev[(size_t)row * 4 + rank] = pe / den;
                posv[(size_t)row * 4 + rank] = (int)__hip_atomic_fetch_add(&hist[le], 1u, __ATOMIC_RELAXED, __HIP_MEMORY_SCOPE_WORKGROUP); }
        }
        asm volatile("s_waitcnt lgkmcnt(0)" ::: "memory");
    }
    asm volatile("s_waitcnt vmcnt(0)" ::: "memory");
    __syncthreads();
    if (tid < 32) hist[32 + tid] = __hip_atomic_fetch_add(&gcnt[tid], hist[tid], __ATOMIC_RELAXED, __HIP_MEMORY_SCOPE_AGENT);
    __syncthreads();
    for (int i0 = 0; i0 < nmine; i0 += 16) { const int i = i0 + (lane >> 2), k = lane & 3;
        if (i < nmine) { const int row = batch_row(bq, gw + NGW * i); const int e = eid[(size_t)row * 4 + k], p = (int)hist[32 + e] + posv[(size_t)row * 4 + k];
            posv[(size_t)row * 4 + k] = (e << 24) | p; tok2[(size_t)e * TCAP + p] = row * 1024; } }
}

__device__ __forceinline__ void phase_pos(const Ctx& C, int layer, int nrows) {
    PHASE_IDS
    const unsigned* bcAll = (const unsigned*)(wsl + WS_CTL + CT_BC) + (size_t)layer * 256 * 32;
    const int* eid = (const int*)(wsl + WS_CTL + CT_EID) + (size_t)layer * NTOK * 4; int* posv = (int*)(wsl + WS_CTL + CT_POS) + (size_t)layer * NTOK * 4;
    int* texp = (int*)(wsl + WS_CTL + CT_TEXP) + layer * 1024;
    int* tokoff = (int*)(wsl + WS_TOK) + (size_t)layer * (1 * MiB / 4);
    LAS unsigned* partT = (LAS unsigned*)C.lds; LAS unsigned* partP = partT + 512; LAS unsigned* tot = partP + 512; LAS unsigned* cnt = tot + 32;
    { const int e = tid & 31, part = tid >> 5; unsigned t = 0, pr = 0;
      unsigned vv[16];
#pragma unroll
      for (int i = 0; i < 16; ++i) { const int bq = part + 16 * i; vv[i] = bq < C.G ? bcAll[(size_t)bq * 32 + e] : 0u; }
#pragma unroll
      for (int i = 0; i < 16; ++i) { const int bq = part + 16 * i; t += vv[i]; if (bq < C.bid) pr += vv[i]; }
      partT[part * 32 + e] = t; partP[part * 32 + e] = pr; }
    __syncthreads();
    if (tid < 32) { unsigned t = 0, pr = 0; for (int i = 0; i < 16; ++i) { t += partT[i * 32 + tid]; pr += partP[i * 32 + tid]; } tot[tid] = t; cnt[tid] = pr; }
    __syncthreads();
    if (tid < 32) { unsigned off = 0; for (int e = 0; e < tid; ++e) off += (tot[e] + 255u) & ~255u;
        const unsigned mine = (tot[tid] + 255u) & ~255u;
        if (C.bid == 0) { for (unsigned t = off >> 8; t < ((off + mine) >> 8); ++t) texp[t] = tid; if (tid == 31) texp[1023] = (int)((off + mine) >> 8);
            for (unsigned p = off + tot[tid]; p < off + mine; ++p) tokoff[p] = 0; }
        cnt[tid] += off; }
    __syncthreads();
    const int gw = C.vr * NWAVES + wave, NGW = C.gs * NWAVES, nper = C.vx < 8 ? (nrows == NTOK ? LSEQ : SEQ) : 0;
    for (int lr = gw; lr < nper; lr += NGW) { const int row = batch_row(C.vx, lr);
        int pos = 0;
        if (lane < 4) { const int e = eid[(size_t)row * 4 + lane]; pos = (int)__hip_atomic_fetch_add(&cnt[e], 1u, __ATOMIC_RELAXED, __HIP_MEMORY_SCOPE_WORKGROUP); posv[(size_t)row * 4 + lane] = pos; }
        if (lane < 4) tokoff[pos] = row * 1024;
    }
}

__device__ __forceinline__ void phase_combine(const Ctx& C, int layer, int nrows, bool final_out) {
    PHASE_IDS
    bf16_t* HB = (bf16_t*)(wsl + WS_HB); unsigned char* HB8 = wsl + WS_HB8; const unsigned char* YS = wsl + WS_YS;
    const float* lg = C.in[I_LNFG] + layer * D; const float* lb = C.in[I_LNFB] + layer * D;
    const float* gatev = (const float*)(wsl + WS_CTL + CT_GATEV) + (size_t)layer * NTOK * 4; const int* posv = (const int*)(wsl + WS_CTL + CT_POS) + (size_t)layer * NTOK * 4;
    float gg[2][8], gb[2][8];
#pragma unroll
    for (int j = 0; j < 2; ++j) { const f32x4 a0 = *(const f32x4*)(lg + 8 * lane + 512 * j), a1 = *(const f32x4*)(lg + 8 * lane + 512 * j + 4), b0 = *(const f32x4*)(lb + 8 * lane + 512 * j), b1 = *(const f32x4*)(lb + 8 * lane + 512 * j + 4);
#pragma unroll
        for (int i = 0; i < 4; ++i) { gg[j][i] = a0[i]; gg[j][4 + i] = a1[i]; gb[j][i] = b0[i]; gb[j][4 + i] = b1[i]; } }
    const int gw = C.vr * NWAVES + wave, NGW = C.gs * NWAVES, nper = C.vx < 8 ? (nrows == NTOK ? LSEQ : SEQ) : 0, bq = C.vx;
    LAS int* ofs = (LAS int*)C.lds;
    { unsigned* gcnt = (unsigned*)(wsl + WS_CTL + CT_BC) + layer * 32;
      if (tid < 32) ofs[64 + tid] = (int)((__hip_atomic_load(&gcnt[tid], __ATOMIC_RELAXED, __HIP_MEMORY_SCOPE_AGENT) + 255u) & ~255u);
      __syncthreads();
      if (tid < 32) { int a = 0; for (int e = 0; e < tid; ++e) a += ofs[64 + e]; ofs[tid] = a; }
      __syncthreads(); }
    f32x4 g1 = {0.f, 0.f, 0.f, 0.f}, g2 = g1; int p1[4] = {0, 0, 0, 0}, p2[4] = {0, 0, 0, 0};
    u32x4 hwn[2]; u32x2 ywn[4][2];
#define CB_ROUTE(row_, gq, pq) do { gq = *(const f32x4*)(gatev + (size_t)(row_) * 4); const u32x4 _pp = *(const u32x4*)(posv + (size_t)(row_) * 4); pq[0] = ofs[_pp.x >> 24] + (int)(_pp.x & 0xFFFFFFu); pq[1] = ofs[_pp.y >> 24] + (int)(_pp.y & 0xFFFFFFu); pq[2] = ofs[_pp.z >> 24] + (int)(_pp.z & 0xFFFFFFu); pq[3] = ofs[_pp.w >> 24] + (int)(_pp.w & 0xFFFFFFu); } while (0)
#define CB_DATA(row_, pq) do { _Pragma("unroll") for (int j = 0; j < 2; ++j) { hwn[j] = *(const u32x4*)(HB + (size_t)(row_) * D + 8 * lane + 512 * j); \
            _Pragma("unroll") for (int k = 0; k < 4; ++k) ywn[k][j] = __builtin_nontemporal_load((const u32x2*)(YS + (size_t)pq[k] * D + 8 * lane + 512 * j)); } } while (0)
    if (gw < nper) { CB_ROUTE(batch_row(bq, gw), g1, p1); CB_DATA(batch_row(bq, gw), p1); }
    if (gw + NGW < nper) CB_ROUTE(batch_row(bq, gw + NGW), g2, p2);
    for (int lr = gw; lr < nper; lr += NGW) { const int row = batch_row(bq, lr);
        const f32x4 gk4 = g1 * 0.125f; u32x4 hw[2]; u32x2 yw[4][2];
#pragma unroll
        for (int j = 0; j < 2; ++j) { hw[j] = hwn[j];
#pragma unroll
            for (int k = 0; k < 4; ++k) yw[k][j] = ywn[k][j]; }
        g1 = g2;
#pragma unroll
        for (int k = 0; k < 4; ++k) p1[k] = p2[k];
        if (lr + NGW < nper) CB_DATA(batch_row(bq, lr + NGW), p1);
        if (lr + 2 * NGW < nper) CB_ROUTE(batch_row(bq, lr + 2 * NGW), g2, p2);
        float v[2][8]; float s = 0.f;
#pragma unroll
        for (int j = 0; j < 2; ++j) { float h[8]; unpack8(hw[j], h);
#pragma unroll
            for (int i = 0; i < 8; ++i) v[j][i] = h[i] * DN_ALPHA;
#pragma unroll
            for (int k = 0; k < 4; ++k) { float y[8]; unpack8_fp8(yw[k][j], y);
#pragma unroll
                for (int i = 0; i < 8; ++i) v[j][i] += gk4[k] * y[i]; }
#pragma unroll
            for (int i = 0; i < 8; ++i) s += v[j][i]; }
        const float mean = wave_sum_dpp(s) * (1.0f / D); float q = 0.f;
#pragma unroll
        for (int j = 0; j < 2; ++j)
#pragma unroll
            for (int i = 0; i < 8; ++i) { v[j][i] -= mean; q += v[j][i] * v[j][i]; }
        const float rstd = __builtin_amdgcn_rsqf(wave_sum_dpp(q) * (1.0f / D) + LN_EPS);
#pragma unroll
        for (int j = 0; j < 2; ++j) {
#pragma unroll
            for (int i = 0; i < 8; ++i) v[j][i] = v[j][i] * rstd * gg[j][i] + gb[j][i];
            if (final_out) { *(f32x4*)(C.out + (size_t)row * D + 8 * lane + 512 * j) = (f32x4){v[j][0], v[j][1], v[j][2], v[j][3]}; *(f32x4*)(C.out + (size_t)row * D + 8 * lane + 512 * j + 4) = (f32x4){v[j][4], v[j][5], v[j][6], v[j][7]}; }
            else { u32x4 w; w.x = pk2(v[j][0], v[j][1]); w.y = pk2(v[j][2], v[j][3]); w.z = pk2(v[j][4], v[j][5]); w.w = pk2(v[j][6], v[j][7]); *(u32x4*)(HB + (size_t)row * D + 8 * lane + 512 * j) = w;
                u32x2 w8; w8.x = pk4_fp8(v[j][0], v[j][1], v[j][2], v[j][3]); w8.y = pk4_fp8(v[j][4], v[j][5], v[j][6], v[j][7]); *(u32x2*)(HB8 + (size_t)row * D + 8 * lane + 512 * j) = w8; } }
    }
#undef CB_ROUTE
#undef CB_DATA
}

constexpr int AT_KS = 0, AT_VTS = 73728, AT_VPITCH = 1168, AT_KM = AT_VTS + 64 * AT_VPITCH, AT_VTM = AT_KM + 2048, AT_RPB = AT_VTM + 2048, AT_MB = AT_RPB + 1920, AT_END = AT_MB + 64;
static_assert(AT_END <= LDS_BYTES, "attention LDS map");
__device__ __forceinline__ void phase_attn(const Ctx& C) {
    PHASE_IDS
    bf16_t* O = (bf16_t*)(wsl + WS_O);
    const float* rpb = C.in[I_RPB]; const float* mbias = C.in[I_MBIAS];
    LAS unsigned char* lds = C.lds;
    const int w = wave, lq = lane & 15, g = lane >> 4;
    const int qr = w >> 2, qg = w & 3, c0 = 16 * qg, kcb = qg == 0 ? 0 : (qg == 1 ? 8 : (qg == 2 ? 24 : 32));
    int bidx[2][4];
    { const int c_ = c0 + lq, cs_ = min(max(c_ - 8, 0), 48);
#pragma unroll
      for (int blk = 0; blk < 2; ++blk)
#pragma unroll
          for (int e = 0; e < 4; ++e) { const int kc = kcb + 16 * blk + 4 * g + e; bidx[blk][e] = ((kc >= cs_ && kc < cs_ + 16) ? (kc - c_ + 15) : 31) * 4; } }
    const __amdgpu_buffer_rsrc_t rsrc = __builtin_amdgcn_make_buffer_rsrc((void*)wsl, 0, 0xFFFFFFFF, 0x00020000);
    const int kvoff = (((tid >> 3) & 63) * D + 8 * (tid & 7)) * 2, vvoff = ((tid >> 3) * MPAD + 8 * (tid & 7)) * 2;
    const int qvoff = (lq * D + 8 * g) * 2;
    const int mvoff = tid < 128 ? ((tid >> 3) * D + 8 * (tid & 7)) * 2 : (((tid - 128) >> 1) * MPAD + 8 * ((tid - 128) & 1)) * 2;
    const int klds = AT_KS + ((((tid >> 3) & 63)) * 8 + ((tid & 7) ^ ((tid >> 3) & 7))) * 16;
    const int vlds = AT_VTS + (tid >> 3) * AT_VPITCH + (tid & 7) * 16;
    for (int su = C.vr; C.vx < 8 && su < 32; su += C.gs) {
        const int b = C.vx, h = su >> 1, strip = su & 1, rp0 = strip * 16;
        const unsigned kbase = (unsigned)WS_K + (unsigned)((b * SEQ) * D + 64 * h) * 2u, vbase = (unsigned)WS_VT + (unsigned)((64 * h) * MPAD + b * SEQ) * 2u;
        const unsigned qbase = (unsigned)WS_Q + (unsigned)((b * SEQ + qr * 64 + c0) * D + 64 * h) * 2u;
        int R0 = min(max(2 * rp0 - 4, 0), 55);
        __syncthreads();
        {
            u32x4 kreg[9], vreg[9];
#pragma unroll
            for (int i = 0; i < 9; ++i) { kreg[i] = __builtin_amdgcn_raw_buffer_load_b128(rsrc, kvoff, (int)(kbase + (unsigned)(R0 + i) * 64u * D * 2u), 0);
                vreg[i] = __builtin_amdgcn_raw_buffer_load_b128(rsrc, vvoff, (int)(vbase + (unsigned)(R0 + i) * 128u), 0); }
            u32x4 mreg = {0u, 0u, 0u, 0u};
            if (tid < 256) mreg = __builtin_amdgcn_raw_buffer_load_b128(rsrc, mvoff, (int)(tid < 128 ? (unsigned)WS_K + (unsigned)((NGRID + 16 * b) * D + 64 * h) * 2u : (unsigned)WS_VT + (unsigned)((64 * h) * MPAD + NGRID + 16 * b) * 2u), 0);
            float rpreg = 0.f, mbreg = 0.f;
            if (tid < 480) rpreg = (tid & 31) < 31 ? rpb[h * 465 + (tid >> 5) * 31 + (tid & 31)] * 1.44269504089f : -1.0e30f;
            if (tid < 16) mbreg = mbias[h * 16 + tid] * 1.44269504089f;
#pragma unroll
            for (int i = 0; i < 9; ++i) { const int slot = (R0 + i) % 9; *(LAS u32x4*)(lds + klds + slot * 8192) = kreg[i]; *(LAS u32x4*)(lds + vlds + slot * 128) = vreg[i]; }
            if (tid < 128) { const int m = tid >> 3, ch = tid & 7; *(LAS u32x4*)(lds + AT_KM + (m * 8 + (ch ^ (m & 7))) * 16) = mreg; }
            else if (tid < 256) { const int i = tid - 128, d = i >> 1, hf = i & 1; *(LAS u32x4*)(lds + AT_VTM + d * 32 + hf * 16) = mreg; }
            if (tid < 480) ((LAS float*)(lds + AT_RPB))[tid] = rpreg;
            if (tid < 16) ((LAS float*)(lds + AT_MB))[tid] = mbreg;
        }
        u32x4 qreg[2];
        qreg[0] = __builtin_amdgcn_raw_buffer_load_b128(rsrc, qvoff, (int)(qbase + (unsigned)(2 * rp0) * 64u * D * 2u), 0);
        qreg[1] = __builtin_amdgcn_raw_buffer_load_b128(rsrc, qvoff, (int)(qbase + (unsigned)(2 * rp0) * 64u * D * 2u + 64u), 0);
        __syncthreads();
        for (int rp = rp0; rp < rp0 + 16; ++rp) {
            const int R0n = rp + 1 < rp0 + 16 ? min(max(2 * (rp + 1) - 4, 0), 55) : R0, nnew = R0n - R0;
            const u32x4 qcur[2] = {qreg[0], qreg[1]};
            u32x4 nk[2], nv[2];
#pragma unroll
            for (int i = 0; i < 2; ++i) if (i < nnew) { nk[i] = __builtin_amdgcn_raw_buffer_load_b128(rsrc, kvoff, (int)(kbase + (unsigned)(R0 + 9 + i) * 64u * D * 2u), 0);
                nv[i] = __builtin_amdgcn_raw_buffer_load_b128(rsrc, vvoff, (int)(vbase + (unsigned)(R0 + 9 + i) * 128u), 0); }
            if (rp + 1 < rp0 + 16) { qreg[0] = __builtin_amdgcn_raw_buffer_load_b128(rsrc, qvoff, (int)(qbase + (unsigned)(2 * rp + 2) * 64u * D * 2u), 0);
                qreg[1] = __builtin_amdgcn_raw_buffer_load_b128(rsrc, qvoff, (int)(qbase + (unsigned)(2 * rp + 2) * 64u * D * 2u + 64u), 0); }
            const int r = 2 * rp + qr;
            const int rs = min(max(r - 4, 0), 56), s0 = rs % 9;
            const size_t qrow = (size_t)(b * SEQ + r * 64 + c0 + lq);
            bf16x8 qf[2]; qf[0] = __builtin_bit_cast(bf16x8, qcur[0]); qf[1] = __builtin_bit_cast(bf16x8, qcur[1]);
            f32x4 sc[8][2], sm;
#pragma unroll
            for (int j = 0; j < 8; ++j) { const int slot = s0 + j - (s0 + j >= 9 ? 9 : 0);
#pragma unroll
                for (int blk = 0; blk < 2; ++blk) { f32x4 a = {0.f, 0.f, 0.f, 0.f}; const int kc = kcb + 16 * blk + lq;
#pragma unroll
                    for (int ks = 0; ks < 2; ++ks) { const bf16x8 kf = *(const LAS bf16x8*)(lds + AT_KS + slot * 8192 + (kc * 8 + ((4 * ks + g) ^ (kc & 7))) * 16);
                        a = __builtin_amdgcn_mfma_f32_16x16x32_bf16(kf, qf[ks], a, 0, 0, 0); }
                    sc[j][blk] = a; } }
            { f32x4 a = {0.f, 0.f, 0.f, 0.f};
#pragma unroll
              for (int ks = 0; ks < 2; ++ks) { const bf16x8 kf = *(const LAS bf16x8*)(lds + AT_KM + (lq * 8 + ((4 * ks + g) ^ (lq & 7))) * 16);
                  a = __builtin_amdgcn_mfma_f32_16x16x32_bf16(kf, qf[ks], a, 0, 0, 0); }
              sm = a; }
            const LAS unsigned char* RProw = lds + AT_RPB + (rs - r + 7) * 128; const LAS float* MB = (const LAS float*)(lds + AT_MB);
            float mx = -3.0e38f;
#pragma unroll
            for (int j = 0; j < 8; ++j)
#pragma unroll
                for (int blk = 0; blk < 2; ++blk)
#pragma unroll
                    for (int e = 0; e < 4; ++e) { const float sv = sc[j][blk][e] + *(const LAS float*)(RProw + j * 128 + bidx[blk][e]); sc[j][blk][e] = sv; mx = fmaxf(mx, sv); }
#pragma unroll
            for (int e = 0; e < 4; ++e) { sm[e] += MB[4 * g + e]; mx = fmaxf(mx, sm[e]); }
            mx = fmaxf(mx, __shfl_xor(mx, 16)); mx = fmaxf(mx, __shfl_xor(mx, 32));
            float sum = 0.f;
#pragma unroll
            for (int j = 0; j < 8; ++j)
#pragma unroll
                for (int blk = 0; blk < 2; ++blk)
#pragma unroll
                    for (int e = 0; e < 4; ++e) { const float pv = fast_exp2(sc[j][blk][e] - mx); sc[j][blk][e] = pv; sum += pv; }
#pragma unroll
            for (int e = 0; e < 4; ++e) { const float pv = fast_exp2(sm[e] - mx); sm[e] = pv; sum += pv; }
            sum += __shfl_xor(sum, 16); sum += __shfl_xor(sum, 32);
            f32x4 o[4];
#pragma unroll
            for (int db = 0; db < 4; ++db) o[db] = (f32x4){0.f, 0.f, 0.f, 0.f};
#pragma unroll
            for (int j = 0; j < 8; ++j) { const int slot = s0 + j - (s0 + j >= 9 ? 9 : 0);
                u32x4 pw; pw.x = cvt_pk_bf16(sc[j][0][0], sc[j][0][1]); pw.y = cvt_pk_bf16(sc[j][0][2], sc[j][0][3]); pw.z = cvt_pk_bf16(sc[j][1][0], sc[j][1][1]); pw.w = cvt_pk_bf16(sc[j][1][2], sc[j][1][3]);
                const bf16x8 pb = __builtin_bit_cast(bf16x8, pw);
#pragma unroll
                for (int db = 0; db < 4; ++db) { const int d = 16 * db + lq; const LAS unsigned char* vp = lds + AT_VTS + d * AT_VPITCH + (slot * 64 + kcb + 4 * g) * 2;
                    const u32x2 lo = *(const LAS u32x2*)vp, hi = *(const LAS u32x2*)(vp + 32);
                    u32x4 aw; aw.x = lo.x; aw.y = lo.y; aw.z = hi.x; aw.w = hi.y;
                    o[db] = __builtin_amdgcn_mfma_f32_16x16x32_bf16(__builtin_bit_cast(bf16x8, aw), pb, o[db], 0, 0, 0); }
            }
            { u32x4 pw; pw.x = cvt_pk_bf16(sm[0], sm[1]); pw.y = cvt_pk_bf16(sm[2], sm[3]); pw.z = 0u; pw.w = 0u; const bf16x8 pb = __builtin_bit_cast(bf16x8, pw);
#pragma unroll
              for (int db = 0; db < 4; ++db) { const int d = 16 * db + lq; const u32x2 lo = *(const LAS u32x2*)(lds + AT_VTM + d * 32 + 8 * g);
                  u32x4 aw; aw.x = lo.x; aw.y = lo.y; aw.z = 0u; aw.w = 0u;
                  o[db] = __builtin_amdgcn_mfma_f32_16x16x32_bf16(__builtin_bit_cast(bf16x8, aw), pb, o[db], 0, 0, 0); } }
            const float inv = 1.0f / sum;
#pragma unroll
            for (int db = 0; db < 4; ++db) { u32x2 ow; ow.x = cvt_pk_bf16(o[db][0] * inv, o[db][1] * inv); ow.y = cvt_pk_bf16(o[db][2] * inv, o[db][3] * inv);
                *(u32x2*)(O + qrow * D + 64 * h + 16 * db + 4 * g) = ow; }
            __syncthreads();
#pragma unroll
            for (int i = 0; i < 2; ++i) if (i < nnew) { const int slot = (R0 + 9 + i) % 9; *(LAS u32x4*)(lds + klds + slot * 8192) = nk[i]; *(LAS u32x4*)(lds + vlds + slot * 128) = nv[i]; }
            R0 = R0n;
            __syncthreads();
        }
    }
}
#define XB_TMO      128
#define XB_XCNT(j)  (256  + 64 * (j))
#define XB_XSUB(j)  (1280 + 64 * (j))
#define XB_XGEN(j)  (2304 + 64 * (j))
#define XB_TOP      3328
#define XB_TOPGEN   3392
#define XCD_BAR_WORDS 3456
#define XB_LSUB(j)  (4096 + 64 * (j))
#define XB_LGEN(j)  (5120 + 64 * (j))
#define XB_SPIN_CAP (1u << 22)
__device__ __forceinline__ unsigned xb_ld(unsigned* p)              { return __hip_atomic_load(p, __ATOMIC_RELAXED, __HIP_MEMORY_SCOPE_AGENT); }
__device__ __forceinline__ unsigned xb_add(unsigned* p, unsigned v) { return __hip_atomic_fetch_add(p, v, __ATOMIC_RELAXED, __HIP_MEMORY_SCOPE_AGENT); }
__device__ __forceinline__ unsigned xb_xcc_id() { return (unsigned)__builtin_amdgcn_s_getreg((3 << 11) | 20) & 0xFu; }
#define XB_SPIN(cond, bar) do { unsigned _sp = 0; while (cond) { __builtin_amdgcn_s_sleep(1); \
    if ((++_sp & 255u) == 0u) { if (xb_ld(&(bar)[XB_TMO])) break; if (_sp > XB_SPIN_CAP) { atomicAdd(&(bar)[XB_TMO], 1u); break; } } } } while (0)
struct XcdBarrier { unsigned* bar; unsigned x; volatile LAS unsigned* st; };
__device__ __forceinline__ XcdBarrier xcd_barrier_post(unsigned* bar, volatile LAS unsigned* st) {
    XcdBarrier b; b.bar = bar; b.x = xb_xcc_id(); b.st = st;
    if (threadIdx.x == 0) st[2] = xb_add(&bar[XB_XCNT(b.x)], 1u);
    return b;
}
__device__ __forceinline__ void xcd_barrier_complete(unsigned* bar, unsigned x, unsigned& nloc, unsigned& nx) {
    const unsigned G = gridDim.x * gridDim.y * gridDim.z;
    unsigned sum, cnt, mine, sp = 0u;
    for (;;) {
        sum = 0u; cnt = 0u; mine = 0u;
#pragma unroll
        for (unsigned j = 0; j < 16; ++j) { const unsigned c = xb_ld(&bar[XB_XCNT(j)]); sum += c; cnt += (c > 0u) ? 1u : 0u; mine = (j == x) ? c : mine; }
        if (sum == G) break;
        __builtin_amdgcn_s_sleep(1);
        if ((++sp & 255u) == 0u) { if (xb_ld(&bar[XB_TMO])) break; if (sp > XB_SPIN_CAP) { atomicAdd(&bar[XB_TMO], 1u); break; } }
    }
    nloc = mine > 0u ? mine : 1u; nx = cnt > 0u ? cnt : 1u;
}
__device__ __forceinline__ void xcd_barrier(const XcdBarrier& b) {
    asm volatile("s_waitcnt vmcnt(0)" ::: "memory");
    __syncthreads();
    if (threadIdx.x == 0) {
        unsigned* bar = b.bar;
        __builtin_amdgcn_s_waitcnt(0);
        unsigned nloc = b.st[0], nx = b.st[1];
        if (nloc == 0u) { xcd_barrier_complete(bar, b.x, nloc, nx); b.st[0] = nloc; b.st[1] = nx; }
        const unsigned old = xb_add(&bar[XB_XSUB(b.x)], 1u);
        const unsigned gen = old / nloc;
        if (old + 1u == (gen + 1u) * nloc) {
            __builtin_amdgcn_fence(__ATOMIC_RELEASE, "agent");
            asm volatile("s_waitcnt vmcnt(0)" ::: "memory");
            const unsigned og = xb_add(&bar[XB_TOP], 1u);
            const unsigned tg = og / nx;
            if (og + 1u == (tg + 1u) * nx) xb_add(&bar[XB_TOPGEN], 1u);
            else XB_SPIN(xb_ld(&bar[XB_TOPGEN]) == tg, bar);
            __builtin_amdgcn_fence(__ATOMIC_ACQUIRE, "agent");
            xb_add(&bar[XB_XGEN(b.x)], 1u);
            asm volatile("s_waitcnt vmcnt(0)" ::: "memory");
        } else {
            XB_SPIN(xb_ld(&bar[XB_XGEN(b.x)]) == gen, bar);
            __builtin_amdgcn_fence(__ATOMIC_ACQUIRE, "agent");
            asm volatile("s_waitcnt vmcnt(0)" ::: "memory");
        }
    }
    __syncthreads();
}
__device__ __forceinline__ void xcd_local_barrier(const XcdBarrier& b) {
    asm volatile("s_waitcnt vmcnt(0)" ::: "memory");
    __syncthreads();
    if (threadIdx.x == 0) {
        unsigned* bar = b.bar;
        __builtin_amdgcn_s_waitcnt(0);
        const unsigned nloc = b.st[0];
        const unsigned old = xb_add(&bar[XB_LSUB(b.x)], 1u);
        const unsigned gen = old / nloc;
        if (old + 1u == (gen + 1u) * nloc) xb_add(&bar[XB_LGEN(b.x)], 1u);
        else XB_SPIN(xb_ld(&bar[XB_LGEN(b.x)]) == gen, bar);
        __builtin_amdgcn_fence(__ATOMIC_ACQUIRE, "agent");
        asm volatile("s_waitcnt vmcnt(0)" ::: "memory");
    }
    __syncthreads();
}
__device__ __forceinline__ int moe_prep(const Ctx& C, int layer) {
    LAS int* t = (LAS int*)(C.lds + pg8::TEXP_OFF); LAS int* first = (LAS int*)(C.lds + pg8::TOK_OFF); const int tid = fresh_tid();
    unsigned* gcnt = (unsigned*)(C.ws + WS_CTL + CT_BC) + layer * 32;
    if (tid < 32) first[64 + tid] = (int)((__hip_atomic_load(&gcnt[tid], __ATOMIC_RELAXED, __HIP_MEMORY_SCOPE_AGENT) + 255u) >> 8);
    __syncthreads();
    if (tid < 33) { int a = 0; for (int e = 0; e < tid; ++e) a += first[64 + e]; first[tid] = a; }
    __syncthreads();
    const int nM = first[32];
#pragma unroll
    for (int h = 0; h < 2; ++h) { const int pm = tid + 512 * h; int e = 0;
#pragma unroll
        for (int q = 1; q < 32; ++q) e += (first[q] <= pm) ? 1 : 0;
        t[pm] = pm < nM ? (e | ((pm - first[e]) << 8)) : 0; }
    __syncthreads();
    return __builtin_amdgcn_readfirstlane(nM);
}
constexpr size_t CT_BAR = 131072;
constexpr int LDS_BARST = LDS_BYTES - 64;

constexpr int N_PHASES = 20;
__global__ void __launch_bounds__(NTHREADS, 2) hybrid_fwd(Params P) {
    extern __shared__ __attribute__((aligned(16))) unsigned char smem[];
    cg::grid_group grid = cg::this_grid();
    Ctx C; C.lds = (LAS unsigned char*)smem; C.G = gridDim.x; C.bid = blockIdx.x;
    C.ws = P.ws; C.in = P.in; C.out = P.out;
    unsigned char* const ws0 = P.ws;
#define ws fresh_ws(ws0)
    const int lo = P.ph_lo, hi = P.ph_hi;
#ifndef PH_MASK
#define PH_MASK 0xFFFFFFFFu
#endif
#define IN(k) (((PH_MASK >> (k)) & 1u) && lo <= (k) && (k) < hi)
#ifndef REPEAT_MASK
#define REPEAT_MASK 0u
#endif
#define REPS(k) ((((unsigned)REPEAT_MASK >> (k)) & 1u) ? 2 : 1)
#ifndef N_CG_SYNCS
#define N_CG_SYNCS 0
#endif
#ifndef LOCAL_SEAM_MASK
#define LOCAL_SEAM_MASK 0x3C3Eu
#endif
#define SEAM(k) do { if (IN(k)) { if ((k) < N_CG_SYNCS) grid.sync(); else if (((LOCAL_SEAM_MASK >> (k)) & 1u) && loc) xcd_local_barrier(bar); else xcd_barrier(bar); } } while (0)
    if (threadIdx.x < 16) ((LAS unsigned*)(smem + LDS_BARST))[threadIdx.x] = 0u;
    __syncthreads();
    const XcdBarrier bar = xcd_barrier_post((unsigned*)(ws + WS_CTL + CT_BAR), (volatile LAS unsigned*)(smem + LDS_BARST));
    C.gc = C.bid;
    C.gs = C.G >= 8 ? C.G / 8 : 1; C.vx = C.bid / C.gs; C.vr = C.bid % C.gs;
    bool loc = false;
    #define PH_BODY_0 phase_convert(C);
    if (IN(0)) { PH_BODY_0 } if (REPS(0) > 1 && IN(0)) { xcd_barrier(bar); PH_BODY_0 }
    SEAM(0);
    if (IN(0) && IN(1)) {
        unsigned* barw = (unsigned*)(ws + WS_CTL + CT_BAR); bool eq = (C.G % 8) == 0;
#pragma unroll
        for (int j = 0; j < 16; ++j) { const unsigned cj = xb_ld(&barw[XB_XCNT(j)]); eq = eq && (cj == (j < 8 ? (unsigned)(C.G / 8) : 0u)); }
        const unsigned rank = ((volatile LAS unsigned*)(smem + LDS_BARST))[2];
        C.gc = __builtin_amdgcn_readfirstlane(eq ? (int)(rank * 8u + bar.x) : C.bid);
        if (__builtin_amdgcn_readfirstlane((int)eq)) { C.vx = __builtin_amdgcn_readfirstlane((int)bar.x); C.vr = __builtin_amdgcn_readfirstlane((int)rank); loc = true; }
    }
    #define PH_BODY_1 { DenseSched S{(unsigned)WS_HB, (unsigned)WS_WIN, 1024, 1024, 8, C.gs, C.vr, C.vx}; EpiWin E{(bf16_t*)(ws + WS_XR), (bf16_t*)(ws + WS_GY)}; \
        pg8::gemm_phase<false, false>(C.lds, ws, 1024, 1024, 1024, S, E); mini_win(C); }
    if (IN(1)) { PH_BODY_1 } if (REPS(1) > 1 && IN(1)) { xcd_barrier(bar); PH_BODY_1 }
    SEAM(1);
    #define PH_BODY_2 phase_conv(C);
    if (IN(2)) { PH_BODY_2 } if (REPS(2) > 1 && IN(2)) { xcd_barrier(bar); PH_BODY_2 }
    SEAM(2);
    #define PH_BODY_3 { GateSched S{(unsigned)WS_XC, (unsigned)WS_GATE, C.gs, C.vr, C.vx}; \
        EpiGate E{(const bf16_t*)(ws + WS_XC), (unsigned char*)(ws + WS_LA), (const float*)(ws + WS_CTL + CT_SPL), (unsigned)WS_GBIAS}; \
        pg8::gemm_phase<false, false>(C.lds, ws, 256, 1024, 256, S, E); mini_gate(C); }
    if (IN(3)) { PH_BODY_3 } if (REPS(3) > 1 && IN(3)) { xcd_barrier(bar); PH_BODY_3 }
    SEAM(3);
    #define PH_BODY_4 phase_scan(C);
    if (IN(4)) { PH_BODY_4 } if (REPS(4) > 1 && IN(4)) { xcd_barrier(bar); PH_BODY_4 }
    SEAM(4);
    #define PH_BODY_5 { DenseSched S{(unsigned)WS_G, (unsigned)WS_LOUT, 1024, 1024, 4, C.gs, C.vr, C.vx}; EpiRes<true> E{(bf16_t*)(ws + WS_PRE), P.in[I_X], P.in[I_META], nullptr, NTOK}; \
        pg8::gemm_phase<false, false>(C.lds, ws, 1024, 1024, 1024, S, E); mini_lout(C); }
    if (IN(5)) { PH_BODY_5 } if (REPS(5) > 1 && IN(5)) { xcd_barrier(bar); PH_BODY_5 }
    SEAM(5);
    #define PH_BODY_6 phase_lnr(C, 0, NTOK);
    if (IN(6)) { PH_BODY_6 } if (REPS(6) > 1 && IN(6)) { xcd_barrier(bar); PH_BODY_6 }
    SEAM(6);
    #define PH_BODY_8 { const int nM = moe_prep(C, 0); \
        MoeSched S{(unsigned)WS_HB8, (unsigned)WS_WGU, (unsigned)WS_TOK2, (const LAS int*)(C.lds + pg8::TEXP_OFF), 2048u * 1024u, nM, 8, C.G, C.gc}; EpiGlu E{(unsigned char*)(ws + WS_ACT), (unsigned)WS_BIAS}; \
        pg8::gemm_phase<true, true>(C.lds, ws, 512, 512, 512, S, E); }
    if (IN(8)) { PH_BODY_8 } if (REPS(8) > 1 && IN(8)) { xcd_barrier(bar); PH_BODY_8 }
#ifdef PROBE_NULL8
    if (IN(8)) { xcd_barrier(bar); { const int nM = moe_prep(C, 0);
        MoeSched S{(unsigned)WS_HB8, (unsigned)WS_WGU, (unsigned)WS_TOK2, (const LAS int*)(C.lds + pg8::TEXP_OFF), 2048u * 1024u, nM, 8, C.G, C.gc}; EpiNull E{};
        pg8::gemm_phase<true, true>(C.lds, ws, 512, 512, 512, S, E); } }
#endif
    SEAM(8);
    #define PH_BODY_9 { const int nM = moe_prep(C, 0); \
        MoeSched S{(unsigned)WS_ACT, (unsigned)WS_WD, 0u, (const LAS int*)(C.lds + pg8::TEXP_OFF), 1024u * 1024u, nM, 4, C.G, C.gc}; EpiDown E{(unsigned char*)(ws + WS_YS), (unsigned)WS_BD}; \
        pg8::gemm_phase<true, false>(C.lds, ws, 512, 512, 512, S, E); }
    if (IN(9)) { PH_BODY_9 } if (REPS(9) > 1 && IN(9)) { xcd_barrier(bar); PH_BODY_9 }
    SEAM(9);
    #define PH_BODY_10 phase_combine(C, 0, NTOK, false);
    if (IN(10)) { PH_BODY_10 } if (REPS(10) > 1 && IN(10)) { xcd_barrier(bar); PH_BODY_10 }
    SEAM(10);
    #define PH_BODY_11 { QkvSched S{(unsigned)WS_HB8, (unsigned)WS_QKV8, C.gs, C.vr, C.vx}; EpiQkv E{(bf16_t*)(ws + WS_Q), (bf16_t*)(ws + WS_K), (bf16_t*)(ws + WS_VT)}; \
        pg8::gemm_phase<true, false>(C.lds, ws, 512, 512, 512, S, E); mini_kv(C); }
    if (IN(11)) { PH_BODY_11 } if (REPS(11) > 1 && IN(11)) { xcd_barrier(bar); PH_BODY_11 }
    SEAM(11);
    #define PH_BODY_12 phase_attn(C);
    if (IN(12)) { PH_BODY_12 } if (REPS(12) > 1 && IN(12)) { xcd_barrier(bar); PH_BODY_12 }
    SEAM(12);
    #define PH_BODY_13 { DenseSched S{(unsigned)WS_O, (unsigned)WS_NOUT, 1024, 1024, 4, C.gs, C.vr, C.vx}; EpiRes<false> E{(bf16_t*)(ws + WS_PRE), nullptr, nullptr, (const bf16_t*)(ws + WS_HB), NGRID}; \
        pg8::gemm_phase<false, false>(C.lds, ws, 1024, 1024, 1024, S, E); }
    if (IN(13)) { PH_BODY_13 } if (REPS(13) > 1 && IN(13)) { xcd_barrier(bar); PH_BODY_13 }
    SEAM(13);
    #define PH_BODY_14 phase_lnr(C, 1, NGRID);
    if (IN(14)) { PH_BODY_14 } if (REPS(14) > 1 && IN(14)) { xcd_barrier(bar); PH_BODY_14 }
    SEAM(14);

    #define PH_BODY_16 { const int nM = moe_prep(C, 1); \
        MoeSched S{(unsigned)WS_HB8, (unsigned)(WS_WGU + (size_t)32 * 2048 * 1024), (unsigned)(WS_TOK2 + (size_t)32 * TCAP * 4), (const LAS int*)(C.lds + pg8::TEXP_OFF), 2048u * 1024u, nM, 8, C.G, C.gc}; EpiGlu E{(unsigned char*)(ws + WS_ACT), (unsigned)(WS_BIAS + 32 * 2048 * 4)}; \
        pg8::gemm_phase<true, true>(C.lds, ws, 512, 512, 512, S, E); }
    if (IN(16)) { PH_BODY_16 } if (REPS(16) > 1 && IN(16)) { xcd_barrier(bar); PH_BODY_16 }
    SEAM(16);
    #define PH_BODY_17 { const int nM = moe_prep(C, 1); \
        MoeSched S{(unsigned)WS_ACT, (unsigned)(WS_WD + (size_t)32 * 1024 * 1024), 0u, (const LAS int*)(C.lds + pg8::TEXP_OFF), 1024u * 1024u, nM, 4, C.G, C.gc}; EpiDown E{(unsigned char*)(ws + WS_YS), (unsigned)(WS_BD + 32 * 1024 * 4)}; \
        pg8::gemm_phase<true, false>(C.lds, ws, 512, 512, 512, S, E); }
    if (IN(17)) { PH_BODY_17 } if (REPS(17) > 1 && IN(17)) { xcd_barrier(bar); PH_BODY_17 }
    SEAM(17);
    #define PH_BODY_18 phase_combine(C, 1, NGRID, true);
    if (IN(18)) { PH_BODY_18 } if (REPS(18) > 1 && IN(18)) { xcd_barrier(bar); PH_BODY_18 }
#undef ws
#undef IN
#undef SEAM
}

#ifndef MK_PER_PHASE
#define MK_PER_PHASE 0
#endif
extern "C" void kernel_launch(void* const* d_in, const int* in_sizes, int n_in, void* d_out, int out_size, void* d_ws, size_t ws_size, hipStream_t stream) {
    static int grid = 0;
    if (grid == 0) {
        if (n_in != 25 || ws_size < WS_END || out_size != NGRID * D) { fprintf(stderr, "kernel_launch: unexpected problem (n_in %d, ws %zu, out %d)\n", n_in, ws_size, out_size); grid = -1; return; }
        int dev = 0, cus = 0, per_cu = 0;
        if (hipGetDevice(&dev) != hipSuccess || hipDeviceGetAttribute(&cus, hipDeviceAttributeMultiprocessorCount, dev) != hipSuccess) { grid = -1; return; }
        if (hipFuncSetAttribute((const void*)hybrid_fwd, hipFuncAttributeMaxDynamicSharedMemorySize, LDS_BYTES) != hipSuccess) { fprintf(stderr, "kernel_launch: hipFuncSetAttribute failed\n"); grid = -1; return; }
        if (hipOccupancyMaxActiveBlocksPerMultiprocessor(&per_cu, (const void*)hybrid_fwd, NTHREADS, LDS_BYTES) != hipSuccess || per_cu < 1) { fprintf(stderr, "kernel_launch: occupancy query failed (%d)\n", per_cu); grid = -1; return; }
        grid = cus * 1;
        if (grid > 256) grid = 256;
    }
    if (grid < 0) return;
    if (hipMemsetAsync((char*)d_ws + WS_CTL + CT_BAR, 0, 32768, stream) != hipSuccess) { fprintf(stderr, "kernel_launch: memset failed\n"); return; }
    Params p{};
    for (int i = 0; i < 25; ++i) p.in[i] = (const float*)d_in[i];
    p.out = (float*)d_out; p.ws = (unsigned char*)d_ws;
#if MK_PER_PHASE
    for (int ph = 0; ph < 19; ++ph) { p.ph_lo = ph; p.ph_hi = ph + 1; void* args[] = {&p};
        hipError_t e = hipLaunchCooperativeKernel((void*)hybrid_fwd, dim3(grid), dim3(NTHREADS), args, LDS_BYTES, stream);
        if (e != hipSuccess) { fprintf(stderr, "launch phase %d failed: %s\n", ph, hipGetErrorString(e)); break; } }
#else
    p.ph_lo = 0; p.ph_hi = 19; void* args[] = {&p};
    hipError_t e = hipLaunchCooperativeKernel((void*)hybrid_fwd, dim3(grid), dim3(NTHREADS), args, LDS_BYTES, stream);
    if (e != hipSuccess) fprintf(stderr, "cooperative launch failed: %s (grid %d)\n", hipGetErrorString(e), grid);
#endif
}
```

```cpp
#include <hip/hip_runtime.h>
#include <hip/hip_cooperative_groups.h>
#include <cstdio>
#include <cstdint>
namespace cg = cooperative_groups;

#define LAS __attribute__((address_space(3)))
typedef unsigned short bf16_t;
typedef short bf16x8 __attribute__((ext_vector_type(8)));
typedef float f32x4 __attribute__((ext_vector_type(4)));
typedef float f32x2 __attribute__((ext_vector_type(2)));
typedef unsigned u32x4 __attribute__((ext_vector_type(4)));
typedef unsigned u32x2 __attribute__((ext_vector_type(2)));

constexpr int NB = 8, SEQ = 4096, D = 1024, NMETA = 16, LSEQ = SEQ + NMETA;
constexpr int NGRID = NB * SEQ;
constexpr int NTOK = NGRID + NB * NMETA;
constexpr int MPAD = 33024;
constexpr int NEXP = 32, TOPK = 4;
constexpr int PMAX = 139776;
constexpr int MTMAX = PMAX / 256;
constexpr float DN_ALPHA = 1.41421356237f;
constexpr float LN_EPS = 1e-5f;
constexpr int NTHREADS = 512, NWAVES = 8;

constexpr size_t MiB = 1u << 20;
constexpr size_t ACT_BYTES = (size_t)MPAD * D * 2;
constexpr size_t WS_CTL   = 0;
constexpr size_t WS_WIN   = 4 * MiB;
constexpr size_t WS_GATE  = WS_WIN + 4 * MiB;
constexpr size_t WS_LOUT  = WS_GATE + 2 * MiB;
constexpr size_t WS_QKV   = WS_LOUT + 2 * MiB;
constexpr size_t WS_NOUT  = WS_QKV + 6 * MiB;
constexpr size_t WS_WGU   = WS_NOUT + 2 * MiB;
constexpr size_t WS_WD    = WS_WGU + 128 * MiB;
constexpr size_t WS_HB    = WS_WD + 64 * MiB;
constexpr size_t WS_HB8   = WS_HB + 65 * MiB;
constexpr size_t WS_PRE   = WS_HB8 + 33 * MiB;
constexpr size_t WS_H     = WS_PRE + 129 * MiB;
constexpr size_t WS_SCR   = WS_H + 129 * MiB;
constexpr size_t WS_XR = WS_SCR, WS_XC = WS_XR + 65 * MiB, WS_GY = WS_XC + 65 * MiB, WS_LA = WS_GY + 65 * MiB, WS_BB = WS_LA + 130 * MiB, WS_HF = WS_BB + 130 * MiB, WS_G = WS_HF + 65 * MiB;
constexpr size_t WS_SCR_END0 = WS_G + 65 * MiB;
constexpr size_t WS_XS = WS_SCR, WS_ACT = WS_XS + 137 * MiB, WS_YS = WS_ACT + 137 * MiB;
constexpr size_t WS_SCR_END1 = WS_YS + 274 * MiB;
constexpr size_t WS_Q = WS_SCR, WS_K = WS_Q + 65 * MiB, WS_VT = WS_K + 65 * MiB, WS_O = WS_VT + 65 * MiB;
constexpr size_t WS_BIAS = (WS_SCR_END0 > WS_SCR_END1 ? WS_SCR_END0 : WS_SCR_END1);
constexpr size_t WS_BD = WS_BIAS + 2 * 32 * 2048 * 4;
constexpr size_t WS_GBIAS = WS_BD + 2 * 32 * 1024 * 4;
constexpr size_t WS_TOK = WS_BIAS + 1 * MiB;
constexpr size_t WS_QKV8 = WS_TOK + 2 * MiB;
constexpr int TCAP = MPAD;
constexpr size_t WS_TOK2 = WS_QKV8 + 3 * MiB;
constexpr size_t WS_LOUT8 = WS_TOK2 + 9 * MiB;
constexpr size_t WS_END = WS_LOUT8 + 1 * MiB;
static_assert((size_t)2 * 32 * TCAP * 4 <= 9 * MiB, "token offset tables");
static_assert(ACT_BYTES <= 65 * MiB && (size_t)PMAX * D * 2 <= 274 * MiB && (size_t)PMAX * D <= 137 * MiB && (size_t)MPAD * D <= 33 * MiB && (size_t)MPAD * D * 4 <= 129 * MiB, "ws map");
static_assert(WS_END <= (size_t)2040 * MiB, "ws map must fit 4x the largest input tensor");
constexpr size_t CT_BC      = 4096;
constexpr size_t CT_TEXP    = CT_BC + 2 * 256 * 32 * 4;
constexpr size_t CT_SPL     = CT_TEXP + 2 * 1024 * 4;
constexpr size_t CT_EID     = 256 * 1024;
constexpr size_t CT_GATEV   = CT_EID + 2 * (size_t)NTOK * 4 * 4;
constexpr size_t CT_POS     = CT_GATEV + 2 * (size_t)NTOK * 4 * 4;
static_assert(CT_POS + 2 * (size_t)NTOK * 4 * 4 <= 4 * MiB, "ctl map");

constexpr int LDS_BYTES = 155648;

__device__ __forceinline__ unsigned f2bf(float f) { unsigned u = __builtin_bit_cast(unsigned, f); return (u + 0x7fffu + ((u >> 16) & 1u)) >> 16; }
__device__ __forceinline__ unsigned cvt_pk_bf16(float lo, float hi);
__device__ __forceinline__ unsigned pk2(float lo, float hi) { return cvt_pk_bf16(lo, hi); }
typedef __bf16 bf16x2_t __attribute__((ext_vector_type(2)));
__device__ __forceinline__ unsigned cvt_pk_bf16(float lo, float hi) { const f32x2 v = {lo, hi}; return __builtin_bit_cast(unsigned, __builtin_convertvector(v, bf16x2_t)); }
__device__ __forceinline__ float sat8(float v) { return __builtin_amdgcn_fmed3f(v, -448.0f, 448.0f); }
__device__ __forceinline__ unsigned pk4_fp8(float a, float b, float c, float d) { int w = __builtin_amdgcn_cvt_pk_fp8_f32(a, b, 0, false); w = __builtin_amdgcn_cvt_pk_fp8_f32(c, d, w, true); return (unsigned)w; }
__device__ __forceinline__ float dot2_bf16(unsigned a, unsigned b, float c) { return __builtin_amdgcn_fdot2_f32_bf16(__builtin_bit_cast(bf16x2_t, a), __builtin_bit_cast(bf16x2_t, b), c, false); }
__device__ __forceinline__ void unpack8_fp8(const u32x2 w, float (&o)[8]) { const f32x2 a = __builtin_amdgcn_cvt_pk_f32_fp8((int)w.x, false), b = __builtin_amdgcn_cvt_pk_f32_fp8((int)w.x, true), c = __builtin_amdgcn_cvt_pk_f32_fp8((int)w.y, false), d = __builtin_amdgcn_cvt_pk_f32_fp8((int)w.y, true);
    o[0] = a.x; o[1] = a.y; o[2] = b.x; o[3] = b.y; o[4] = c.x; o[5] = c.y; o[6] = d.x; o[7] = d.y; }
__device__ __forceinline__ float bflo(unsigned w) { return __builtin_bit_cast(float, w << 16); }
__device__ __forceinline__ float bfhi(unsigned w) { return __builtin_bit_cast(float, w & 0xffff0000u); }
__device__ __forceinline__ void unpack8(const u32x4 w, float (&o)[8]);
__device__ __forceinline__ float fast_exp2(float x) { return __builtin_amdgcn_exp2f(x); }
__device__ __forceinline__ float fast_rcp(float x) { return __builtin_amdgcn_rcpf(x); }
__device__ __forceinline__ float sigmoidf_(float x) { return fast_rcp(1.0f + fast_exp2(-1.44269504089f * x)); }
__device__ __forceinline__ float wave_sum(float v) {
#pragma unroll
    for (int o = 1; o < 64; o <<= 1) v += __shfl_xor(v, o);
    return v;
}
template <int CTRL> __device__ __forceinline__ float dpp_movf(float v) { return __builtin_bit_cast(float, __builtin_amdgcn_update_dpp(0, __builtin_bit_cast(int, v), CTRL, 0xf, 0xf, true)); }
__device__ __forceinline__ float readlane_f(float v, int l) { return __builtin_bit_cast(float, __builtin_amdgcn_readlane(__builtin_bit_cast(int, v), l)); }
__device__ __forceinline__ float wave_sum_dpp(float v) {
    v += dpp_movf<0xB1>(v);
    v += dpp_movf<0x4E>(v);
    v += dpp_movf<0x141>(v);
    v += dpp_movf<0x140>(v);
    return (readlane_f(v, 0) + readlane_f(v, 16)) + (readlane_f(v, 32) + readlane_f(v, 48));
}
__device__ __forceinline__ int seqrow(int b, int s) { return s < NMETA ? NGRID + NMETA * b + s : SEQ * b + (s - NMETA); }
__device__ __forceinline__ int batch_row(int b, int lr) { return lr < SEQ ? b * SEQ + lr : NGRID + 16 * b + (lr - SEQ); }

struct Params {
    const float* in[25];
    float* out;
    unsigned char* ws;
    int ph_lo, ph_hi;
};
struct Ctx {
    LAS unsigned char* lds;
    int G, bid, gc;
    int vx, vr, gs;
    unsigned char* ws;
    const float* const* in;
    float* out;
};
__device__ __forceinline__ int fresh_tid() { int t = threadIdx.x; asm volatile("" : "+v"(t)); return t; }
__device__ __forceinline__ unsigned char* fresh_ws(unsigned char* p) { asm volatile("" : "+s"(p)); return p; }
#define PHASE_IDS unsigned char* const wsl = fresh_ws(C.ws); (void)wsl; const int tid = fresh_tid(); const int lane = tid & 63; const int wave = __builtin_amdgcn_readfirstlane(tid >> 6); (void)lane; (void)wave;
enum { I_X = 0, I_META, I_WIN, I_CONVW, I_CONVB, I_WA, I_BA, I_WX, I_BX, I_LAM, I_LOUT, I_WQKV, I_RPB, I_MBIAS, I_NOUT, I_LNMG, I_LNMB, I_RW, I_RB, I_WGU, I_BGU, I_WD, I_BD, I_LNFG, I_LNFB };

namespace pg8 {
constexpr int BM = 256, BK = 64, HALF = 128, HTB = HALF * BK * 2, STAGE_BYTES = 8 * HTB, NXCD = 8, WGM = 8;
constexpr int SIDE_OFF = STAGE_BYTES, TEXP_OFF = STAGE_BYTES + 2048, TOK_OFF = STAGE_BYTES + 2048 + 4096;
__device__ __forceinline__ int lds_byte(int r, int c) { const int st = (r >> 4) * 2 + (c >> 5), rr = r & 15, cc = c & 31, ob = rr * 64 + cc * 2; return st * 1024 + (ob ^ (((ob >> 9) & 1) << 5)); }
__device__ __forceinline__ void stage_rc(int b, int& R, int& C) { const int st = b / 1024, sb = b % 1024, swz = sb ^ (((sb >> 9) & 1) << 5); R = (st >> 1) * 16 + swz / 64; C = (st & 1) * 32 + (swz % 64) / 2; }
__device__ __forceinline__ int perm32(int rho) { const int n = rho >> 4, i = rho & 15; return 8 * (i >> 2) + 4 * n + (i & 3); }

typedef int v8i __attribute__((ext_vector_type(8)));
typedef int v4i __attribute__((ext_vector_type(4)));
__device__ __forceinline__ v8i cat8(bf16x8 a, bf16x8 b) { const v4i x = __builtin_bit_cast(v4i, a), y = __builtin_bit_cast(v4i, b); return __builtin_shufflevector(x, y, 0, 1, 2, 3, 4, 5, 6, 7); }
struct Unit { unsigned ao, bo, to; int pm, pn, aux; };

__device__ __forceinline__ void tile_of(int L, int nM, int nN, int& pm, int& pn) {
    const int nwg = nM * nN; int wgid = L;
    { const int q = nwg / NXCD, r = nwg % NXCD, xcd = wgid % NXCD, off = wgid / NXCD; wgid = (xcd < r ? xcd * (q + 1) : r * (q + 1) + (xcd - r) * q) + off; }
    const int nig = WGM * nN, gid = wgid / nig, fm = gid * WGM, gsz = (nM - fm) < WGM ? (nM - fm) : WGM;
    pm = fm + ((wgid % nig) % gsz); pn = (wgid % nig) / gsz;
}

template <bool F8, bool GATHER, class Epi, class Sched>
__device__ __forceinline__ void gemm_phase(LAS unsigned char* lds, const unsigned char* wsbase, const int K, const int lda, const int ldb, const Sched& S, const Epi& E) {
    const __amdgpu_buffer_rsrc_t rsrc = __builtin_amdgcn_make_buffer_rsrc((void*)wsbase, 0, 0xFFFFFFFF, 0x00020000);
    const int tid = fresh_tid(), wid = __builtin_amdgcn_readfirstlane(tid >> 6), lane = tid & 63, wr = wid >> 2, wc = wid & 3;
    const int nt = K / BK;
    int f8scales = 0; if constexpr (F8) { f8scales = Epi::SCALES; asm volatile("" : "+v"(f8scales)); }
    int voffA, voffB;
    { int R, C; stage_rc(tid * 16, R, C); const int Rb = Epi::PERM ? ((R & ~31) + perm32(R & 31)) : R; voffA = ((GATHER ? 0 : R * lda) + C) * 2; voffB = (Rb * ldb + C) * 2; }
    const int tokb = (16 * (wid >> 1) + (lane >> 2)) * 4;
    const unsigned kstep = (unsigned)(BK * 2);
    const unsigned hstepA = (unsigned)HALF * lda * 2, hstepB = (unsigned)HALF * ldb * 2;
    const unsigned ldsw = (unsigned)wid * 1024u;
    const int aoff = lds_byte(wr * 64 + (lane & 15), (lane >> 4) * 8), boff = lds_byte(wc * 32 + (lane & 15), (lane >> 4) * 8);
#define PG8_SA(b, h) (((b) * 2 + (h)) * HTB)
#define PG8_SB(b, h) ((4 + (b) * 2 + (h)) * HTB)
#define PG8_STAGE(bufoff, gbase, voff) do { _Pragma("unroll") for (int _i = 0; _i < 2; ++_i) \
        __builtin_amdgcn_raw_ptr_buffer_load_lds(rsrc, (LAS void*)(lds + (bufoff) + ldsl + _i * 8192), 16, voff, __builtin_amdgcn_readfirstlane((int)((gbase) + (unsigned)_i * (hstep##voff >> 1))), 0, 0); } while (0)
#define hstepvoffA hstepA
#define hstepvoffB hstepB
#define PG8_STAGE_A(bufoff, aoffs, h, par) do { if constexpr (GATHER) { _Pragma("unroll") for (int _i = 0; _i < 2; ++_i) { \
            const int _tk = *(const LAS int*)(lds + TOK_OFF + (par) * 1024 + tokb + ((h) * 128 + _i * 64) * 4); \
            __builtin_amdgcn_raw_ptr_buffer_load_lds(rsrc, (LAS void*)(lds + (bufoff) + ldsl + _i * 8192), 16, _tk + voffA, __builtin_amdgcn_readfirstlane((int)(aoffs)), 0, 0); } } \
        else { PG8_STAGE(bufoff, (aoffs) + (unsigned)(h) * hstepA, voffA); } } while (0)
#define PG8_TKLD(h, par) const int _tk0 = GATHER ? *(const LAS int*)(lds + TOK_OFF + (par) * 1024 + tokb + (h) * 512) : 0, _tk1 = GATHER ? *(const LAS int*)(lds + TOK_OFF + (par) * 1024 + tokb + (h) * 512 + 256) : 0
#define PG8_STAGE_AT(bufoff, aoffs, h) do { if constexpr (GATHER) { \
            __builtin_amdgcn_raw_ptr_buffer_load_lds(rsrc, (LAS void*)(lds + (bufoff) + ldsl), 16, _tk0 + voffA, __builtin_amdgcn_readfirstlane((int)(aoffs)), 0, 0); \
            __builtin_amdgcn_raw_ptr_buffer_load_lds(rsrc, (LAS void*)(lds + (bufoff) + ldsl + 8192), 16, _tk1 + voffA, __builtin_amdgcn_readfirstlane((int)(aoffs)), 0, 0); } \
        else { PG8_STAGE(bufoff, (aoffs) + (unsigned)(h) * hstepA, voffA); } } while (0)
#define PG8_TOK(unit, par) do { if constexpr (GATHER) { if (wid == 0) __builtin_amdgcn_raw_ptr_buffer_load_lds(rsrc, (LAS void*)(lds + TOK_OFF + (par) * 1024), 16, lane * 16, (int)(unit).to, 0, 0); } } while (0)
#define PG8_LDA(dst, b, h) do { _Pragma("unroll") for (int m = 0; m < 4; ++m) _Pragma("unroll") for (int k = 0; k < 2; ++k) dst[m][k] = *(const LAS bf16x8*)(lds + PG8_SA(b, h) + aoff + m * 2048 + k * 1024); } while (0)
#define PG8_LDB(dst, b, h) do { _Pragma("unroll") for (int n = 0; n < 2; ++n) _Pragma("unroll") for (int k = 0; k < 2; ++k) dst[n][k] = *(const LAS bf16x8*)(lds + PG8_SB(b, h) + boff + n * 2048 + k * 1024); } while (0)
#define PG8_MMA(ai, bj, At, Bt) do { __builtin_amdgcn_s_setprio(1); _Pragma("unroll") for (int m = 0; m < 4; ++m) _Pragma("unroll") for (int n = 0; n < 2; ++n) { \
        if constexpr (F8) { asm volatile("v_mfma_scale_f32_16x16x128_f8f6f4 %0, %1, %2, %0, %3, %3 op_sel:[0,1,0] op_sel_hi:[0,0,0]" : "+v"(acc[ai][bj][m][n]) : "v"(cat8(Bt[n][0], Bt[n][1])), "v"(cat8(At[m][0], At[m][1])), "v"(f8scales)); } \
        else { _Pragma("unroll") for (int k = 0; k < 2; ++k) acc[ai][bj][m][n] = __builtin_amdgcn_mfma_f32_16x16x32_bf16(Bt[n][k], At[m][k], acc[ai][bj][m][n], 0, 0, 0); } } \
        __builtin_amdgcn_s_setprio(0); } while (0)
#define PG8_WAIT_V(n) asm volatile("s_waitcnt vmcnt(" #n ")" ::: "memory")
#define PG8_WAIT_L(n) asm volatile("s_waitcnt lgkmcnt(" #n ")" ::: "memory")
#define PG8_BAR __builtin_amdgcn_s_barrier()
#define PG8_SCHED __builtin_amdgcn_sched_barrier(0)
    Unit cur, nxt; int ui = 0;
    if (!S.next(0, cur)) return;
    f32x4 acc[2][2][4][2];
    bf16x8 At[4][2], B0[2][2], B1[2][2];
#define PG8_INIT(par) do { if constexpr (Epi::SIDE) { const int _l = fresh_tid() & 63; E.init(acc, (const LAS float*)(lds + SIDE_OFF + (par) * 1024), wc, _l >> 4); } \
        else { _Pragma("unroll") for (int a = 0; a < 2; ++a) _Pragma("unroll") for (int b = 0; b < 2; ++b) _Pragma("unroll") for (int m = 0; m < 4; ++m) _Pragma("unroll") for (int n = 0; n < 2; ++n) acc[a][b][m][n] = (f32x4){0.f, 0.f, 0.f, 0.f}; } } while (0)
    unsigned cA = cur.ao, cB = cur.bo;
    unsigned ldsl = ldsw; asm volatile("" : "+s"(ldsl));
#define PG8_SIDE(unit, par) do { if constexpr (Epi::SIDE) { if (wid == 0) __builtin_amdgcn_raw_ptr_buffer_load_lds(rsrc, (LAS void*)(lds + SIDE_OFF + (par) * 1024), 16, lane * 16, (int)E.side_off(unit), 0, 0); } } while (0)
    PG8_SIDE(cur, 0);
    if constexpr (GATHER) PG8_TOK(cur, 0);
    if constexpr (GATHER || Epi::SIDE) { asm volatile("s_waitcnt vmcnt(0)" ::: "memory"); PG8_BAR; }
    PG8_INIT(0);
    PG8_STAGE(PG8_SB(0, 0), cB, voffB); PG8_STAGE(PG8_SB(0, 1), cB + hstepB, voffB); PG8_STAGE_A(PG8_SA(0, 0), cA, 0, 0); PG8_STAGE_A(PG8_SA(0, 1), cA, 1, 0);
    if (wr == 1) PG8_BAR;
    PG8_WAIT_V(2); PG8_BAR;
    PG8_STAGE(PG8_SB(1, 0), cB + kstep, voffB); PG8_STAGE_A(PG8_SA(1, 0), cA + kstep, 0, 0); PG8_STAGE(PG8_SB(1, 1), cB + hstepB + kstep, voffB);
    PG8_WAIT_V(6); PG8_BAR;
    for (;;) {
        const bool has_next = S.next(ui + 1, nxt);
        if (has_next) { PG8_TOK(nxt, (ui + 1) & 1); PG8_SIDE(nxt, (ui + 1) & 1); }
        const unsigned nA = has_next ? nxt.ao : cA, nB = has_next ? nxt.bo : cB;
#pragma unroll 1
        for (int t = 0; t < nt; t += 2) {
            const bool last = (t == nt - 2);
            ldsl = ldsw; asm volatile("" : "+s"(ldsl));
            const int parc = ui & 1, parn = (ui + ((last && has_next) ? 1 : 0)) & 1;
            const unsigned a1 = cA + (unsigned)(t + 1) * kstep;
            const unsigned a2 = last ? nA : cA + (unsigned)(t + 2) * kstep, b2 = last ? nB : cB + (unsigned)(t + 2) * kstep;
            const unsigned a3 = a2 + kstep, b3 = b2 + kstep;
            { PG8_TKLD(1, parc); PG8_LDB(B0, 0, 0); PG8_LDB(B1, 0, 1); PG8_SCHED; PG8_LDA(At, 0, 0); PG8_STAGE_AT(PG8_SA(1, 1), a1, 1); }
            PG8_WAIT_V(8); PG8_WAIT_L(0); PG8_BAR; PG8_MMA(0, 0, At, B0); PG8_MMA(0, 1, At, B1); PG8_BAR; PG8_SCHED;
            { PG8_TKLD(0, parn); PG8_LDA(At, 0, 1); PG8_STAGE(PG8_SB(0, 0), b2, voffB); PG8_STAGE(PG8_SB(0, 1), b2 + hstepB, voffB); PG8_STAGE_AT(PG8_SA(0, 0), a2, 0); }
            PG8_WAIT_V(8); PG8_WAIT_L(0); PG8_BAR; PG8_MMA(1, 0, At, B0); PG8_MMA(1, 1, At, B1); PG8_BAR; PG8_SCHED;
            { PG8_TKLD(1, parn); PG8_LDB(B0, 1, 0); PG8_LDB(B1, 1, 1); PG8_SCHED; PG8_LDA(At, 1, 0); PG8_STAGE_AT(PG8_SA(0, 1), a2, 1); }
            PG8_WAIT_V(8); PG8_WAIT_L(0); PG8_BAR; PG8_MMA(0, 0, At, B0); PG8_MMA(0, 1, At, B1); PG8_BAR; PG8_SCHED;
            { PG8_TKLD(0, parn); PG8_LDA(At, 1, 1); PG8_STAGE(PG8_SB(1, 0), b3, voffB); PG8_STAGE(PG8_SB(1, 1), b3 + hstepB, voffB); PG8_STAGE_AT(PG8_SA(1, 0), a3, 0); }
            PG8_WAIT_V(8); PG8_WAIT_L(0); PG8_BAR; PG8_MMA(1, 0, At, B0); PG8_MMA(1, 1, At, B1); PG8_BAR; PG8_SCHED;
        }
        if constexpr (F8) asm volatile("s_nop 15\n\ts_nop 15" ::: "memory");
        if (wr == 0) PG8_BAR;
        { const int l2 = fresh_tid() & 63; E(acc, cur, wr, wc, l2 & 15, l2 >> 4, (const LAS float*)(lds + SIDE_OFF + (ui & 1) * 1024)); }
        if (!has_next) break;
        cur = nxt; cA = nA; cB = nB; ++ui;
        PG8_INIT(ui & 1);
        if (wr == 1) PG8_BAR;
    }
    PG8_WAIT_V(0);
    PG8_BAR;
#undef PG8_SA
#undef PG8_SB
#undef PG8_STAGE
#undef PG8_STAGE_A
#undef PG8_TKLD
#undef PG8_STAGE_AT
#undef PG8_TOK
#undef PG8_SIDE
#undef PG8_INIT
#undef hstepvoffA
#undef hstepvoffB
#undef PG8_LDA
#undef PG8_LDB
#undef PG8_MMA
#undef PG8_WAIT_V
#undef PG8_WAIT_L
#undef PG8_BAR
#undef PG8_SCHED
}
}

using pg8::Unit;

struct DenseSched {
    unsigned A, Bt; int lda, ldb, nN, gs, vr, vx;
    __device__ __forceinline__ bool next(int i, Unit& u) const {
        const int L = i * gs + vr; if (vx >= 8 || L >= 16 * nN) return false;
        u.pm = 16 * vx + L / nN; u.pn = L % nN; u.aux = 0; u.to = 0;
        u.ao = A + (unsigned)u.pm * 256 * lda * 2; u.bo = Bt + (unsigned)u.pn * 256 * ldb * 2; return true;
    }
};
struct GateSched {
    unsigned XC, GT; int gs, vr, vx;
    __device__ __forceinline__ bool next(int i, Unit& u) const {
        const int L = i * gs + vr; if (vx >= 8 || L >= 256) return false;
        const int nb = L >> 6; u.pm = 16 * vx + ((L & 63) >> 2); u.pn = L & 3; u.aux = nb; u.to = 0;
        u.ao = XC + ((unsigned)u.pm * 256 * 1024 + 256 * nb) * 2; u.bo = GT + ((unsigned)nb * 1024 + 256 * u.pn) * 256 * 2; return true;
    }
};
struct QkvSched {
    unsigned HB, WT; int gs, vr, vx;
    __device__ __forceinline__ bool next(int i, Unit& u) const {
        const int L = i * gs + vr; if (vx >= 8 || L >= 128 + 64) return false; u.to = 0;
        if (L < 128) { u.pm = 16 * vx + (L >> 3); u.pn = L & 7; u.aux = 0; u.ao = HB + (unsigned)u.pm * 256 * 1024; u.bo = WT + (unsigned)u.pn * 256 * 1024; }
        else { const int Ly = L - 128; u.pm = Ly & 3; u.pn = 16 * vx + (Ly >> 2); u.aux = 1; u.ao = WT + (unsigned)(2048 + u.pm * 256) * 1024; u.bo = HB + (unsigned)u.pn * 256 * 1024; }
        return true;
    }
};
struct MoeSched {
    unsigned A, W, tok; const LAS int* texp; unsigned wstride; int nM, nN, G, c;
    __device__ __forceinline__ bool next(int i, Unit& u) const {
        const int L = i * G + c; if (L >= nM * nN) return false;
        pg8::tile_of(L, nM, nN, u.pm, u.pn);
        const int ej = __builtin_amdgcn_readfirstlane(texp[u.pm]), e = ej & 255; u.aux = e;
        u.ao = tok ? A : A + (unsigned)u.pm * 256 * 1024; u.to = tok + (unsigned)(e * TCAP + (ej >> 8) * 256) * 4u; u.bo = W + (unsigned)e * wstride + (unsigned)u.pn * 256 * 1024; return true;
    }
};

#define EPI_ARGS const f32x4 (&acc)[2][2][4][2], const Unit& u, int wr, int wc, int fr, int fq, const LAS float* side
struct EpiWin {
    static constexpr bool PERM = true, SIDE = false;
    bf16_t* XR; bf16_t* GY;
    __device__ __forceinline__ void operator()(EPI_ARGS) const {
        const int row0 = u.pm * 256 + wr * 64 + fr;
        if (u.pn < 4) {
            const int col0 = u.pn * 256 + wc * 32 + 8 * fq;
#pragma unroll
            for (int ai = 0; ai < 2; ++ai)
#pragma unroll
                for (int m = 0; m < 4; ++m) { bf16_t* rowp = XR + (size_t)(row0 + ai * 128 + m * 16) * D + col0;
#pragma unroll
                    for (int bj = 0; bj < 2; ++bj) { const f32x4 v0 = acc[ai][bj][m][0], v1 = acc[ai][bj][m][1];
                        u32x4 w; w.x = cvt_pk_bf16(v0[0], v0[1]); w.y = cvt_pk_bf16(v0[2], v0[3]); w.z = cvt_pk_bf16(v1[0], v1[1]); w.w = cvt_pk_bf16(v1[2], v1[3]);
                        *(u32x4*)(rowp + bj * 128) = w; } }
        } else {
#pragma unroll
            for (int ai = 0; ai < 2; ++ai)
#pragma unroll
                for (int m = 0; m < 4; ++m) { const int row = row0 + ai * 128 + m * 16;
#pragma unroll
                    for (int bj = 0; bj < 2; ++bj) { const int g = (u.pn - 4) * 8 + bj * 4 + wc;
                        float o[8];
#pragma unroll
                        for (int n = 0; n < 2; ++n)
#pragma unroll
                            for (int j = 0; j < 4; ++j) { const float v = acc[ai][bj][m][n][j]; const float z = 1.5957691216f * (v + 0.044715f * v * v * v); o[n * 4 + j] = v * sigmoidf_(z); }
                        u32x4 w; w.x = cvt_pk_bf16(o[0], o[1]); w.y = cvt_pk_bf16(o[2], o[3]); w.z = cvt_pk_bf16(o[4], o[5]); w.w = cvt_pk_bf16(o[6], o[7]);
                        *(u32x4*)(GY + ((size_t)g * MPAD + row) * 32 + 8 * fq) = w; } }
        }
    }
};
struct EpiGate {
    static constexpr bool PERM = true, SIDE = true;
    const bf16_t* XC; unsigned char* LB; const float* spl; unsigned bias_off;
    __device__ __forceinline__ unsigned side_off(const Unit& u) const { return bias_off + (unsigned)((((u.pn >> 1) * 4 + u.aux) * 2 + (u.pn & 1)) * 1024); }
    __device__ __forceinline__ void init(f32x4 (&acc)[2][2][4][2], const LAS float* side, int wc, int fq) const {
#pragma unroll
        for (int bj = 0; bj < 2; ++bj)
#pragma unroll
            for (int n = 0; n < 2; ++n) { const f32x4 b = *(const LAS f32x4*)(side + 128 * bj + 32 * wc + 8 * fq + 4 * n);
#pragma unroll
                for (int ai = 0; ai < 2; ++ai)
#pragma unroll
                    for (int m = 0; m < 4; ++m) acc[ai][bj][m][n] = b; }
    }
    __device__ __forceinline__ void operator()(EPI_ARGS) const {
        const int nb = u.aux, dir = u.pn >> 1, half = u.pn & 1;
        const int ch0 = 256 * nb + 128 * half + 32 * wc + 8 * fq, g = ch0 >> 5;
        const int row0 = u.pm * 256 + wr * 64 + fr;
        float csp[8];
        { const f32x4 p0 = *(const f32x4*)(spl + dir * 1024 + ch0), p1 = *(const f32x4*)(spl + dir * 1024 + ch0 + 4);
#pragma unroll
          for (int j = 0; j < 4; ++j) { csp[j] = (-2.0f / 256.0f) * p0[j]; csp[4 + j] = (-2.0f / 256.0f) * p1[j]; } }
        u32x4 xnext = *(const u32x4*)(XC + (size_t)row0 * D + ch0);
#pragma unroll
        for (int ai = 0; ai < 2; ++ai)
#pragma unroll
            for (int m = 0; m < 4; ++m) { const int row = row0 + ai * 128 + m * 16;
                const u32x4 xw = xnext;
                { const int it = ai * 4 + m + 1, rn = row0 + (it >> 2) * 128 + (it & 3) * 16; if (it < 8) xnext = *(const u32x4*)(XC + (size_t)rn * D + ch0); }
                float xc[8]; unpack8(xw, xc);
                const bool start = dir == 1 && (row & (SEQ - 1)) == SEQ - 1;
                float sg[8], bb[8];
#pragma unroll
                for (int n = 0; n < 2; ++n)
#pragma unroll
                    for (int j = 0; j < 4; ++j) { const int i = n * 4 + j;
                        const float sga = fast_rcp(__builtin_fmaf(fast_exp2(-1.44269504089f * acc[ai][0][m][n][j]), 1.0f / 256.0f, 1.0f / 256.0f));
                        const float a2 = fast_exp2(__builtin_fmaf(csp[i], sga, 6.0f));
                        const float mult = __builtin_amdgcn_sqrtf(__builtin_fabsf(64.0f - a2));
                        sg[i] = sga; bb[i] = __builtin_amdgcn_fmed3f(mult * sigmoidf_(acc[ai][1][m][n][j]) * xc[i], -448.0f, 448.0f); }
                if (start) {
#pragma unroll
                    for (int n = 0; n < 2; ++n)
#pragma unroll
                        for (int j = 0; j < 4; ++j) bb[n * 4 + j] = __builtin_amdgcn_fmed3f(8.0f * sigmoidf_(acc[ai][1][m][n][j]) * xc[n * 4 + j], -448.0f, 448.0f); }
                u32x4 w; w.x = pk4_fp8(sg[0], sg[1], sg[2], sg[3]); w.y = pk4_fp8(sg[4], sg[5], sg[6], sg[7]); w.z = pk4_fp8(bb[0], bb[1], bb[2], bb[3]); w.w = pk4_fp8(bb[4], bb[5], bb[6], bb[7]);
                *(u32x4*)(LB + (((size_t)dir * 32 + g) * MPAD + row) * 64 + 16 * fq) = w; }
    }
};
template <bool LAYER0> struct EpiRes {
    static constexpr bool PERM = true, SIDE = false; static constexpr int SCALES = LAYER0 ? 0x7E79 : 0x7D79;
    bf16_t* PRE; const float* x; const float* meta; const bf16_t* HB; int nrows;
    __device__ __forceinline__ void operator()(EPI_ARGS) const {
        const int row0 = u.pm * 256 + wr * 64 + fr, col0 = u.pn * 256 + wc * 32 + 8 * fq;
#pragma unroll
        for (int ai = 0; ai < 2; ++ai)
#pragma unroll
            for (int m = 0; m < 4; ++m) { const int row = row0 + ai * 128 + m * 16;
                if (row < nrows) {
#pragma unroll
                    for (int bj = 0; bj < 2; ++bj) { const int c = col0 + bj * 128; float r[8];
                        if (LAYER0) { const float* rp = (row < NGRID ? x + (size_t)row * D : meta + (size_t)((row - NGRID) & 15) * D) + c; const f32x4 r0 = *(const f32x4*)rp, r1 = *(const f32x4*)(rp + 4);
                            r[0] = r0[0]; r[1] = r0[1]; r[2] = r0[2]; r[3] = r0[3]; r[4] = r1[0]; r[5] = r1[1]; r[6] = r1[2]; r[7] = r1[3]; }
                        else { const u32x4 rw = *(const u32x4*)(HB + (size_t)row * D + c); r[0] = bflo(rw.x); r[1] = bfhi(rw.x); r[2] = bflo(rw.y); r[3] = bfhi(rw.y); r[4] = bflo(rw.z); r[5] = bfhi(rw.z); r[6] = bflo(rw.w); r[7] = bfhi(rw.w); }
                        const f32x4 a0 = acc[ai][bj][m][0], a1 = acc[ai][bj][m][1];
                        u32x4 w; w.x = cvt_pk_bf16(r[0] * DN_ALPHA + a0[0], r[1] * DN_ALPHA + a0[1]); w.y = cvt_pk_bf16(r[2] * DN_ALPHA + a0[2], r[3] * DN_ALPHA + a0[3]);
                        w.z = cvt_pk_bf16(r[4] * DN_ALPHA + a1[0], r[5] * DN_ALPHA + a1[1]); w.w = cvt_pk_bf16(r[6] * DN_ALPHA + a1[2], r[7] * DN_ALPHA + a1[3]);
                        *(u32x4*)(PRE + (size_t)row * D + c) = w; }
                }
                asm volatile("" ::: "memory"); }
    }
};
struct EpiGlu {
    static constexpr bool PERM = true, SIDE = true; static constexpr int SCALES = 0x7F79;
    unsigned char* ACT; unsigned bias_off;
    __device__ __forceinline__ unsigned side_off(const Unit& u) const { return bias_off + (unsigned)((u.aux * 8 + u.pn) * 1024); }
    __device__ __forceinline__ void init(f32x4 (&acc)[2][2][4][2], const LAS float* side, int wc, int fq) const {
#pragma unroll
        for (int bj = 0; bj < 2; ++bj)
#pragma unroll
            for (int n = 0; n < 2; ++n) { const f32x4 b = *(const LAS f32x4*)(side + 128 * bj + 32 * wc + 8 * fq + 4 * n);
#pragma unroll
                for (int ai = 0; ai < 2; ++ai)
#pragma unroll
                    for (int m = 0; m < 4; ++m) acc[ai][bj][m][n] = b; }
    }
    __device__ __forceinline__ void operator()(EPI_ARGS) const {
        const int f0 = 128 * u.pn + 32 * wc + 8 * fq;
        const int row0 = u.pm * 256 + wr * 64 + fr;
#pragma unroll
        for (int ai = 0; ai < 2; ++ai)
#pragma unroll
            for (int m = 0; m < 4; ++m) { const int row = row0 + ai * 128 + m * 16; float o[8];
#pragma unroll
                for (int n = 0; n < 2; ++n)
#pragma unroll
                    for (int j = 0; j < 4; ++j) { const int i = n * 4 + j;
                        const float glu = fminf(acc[ai][0][m][n][j], 7.0f);
                        const float lin1 = __builtin_amdgcn_fmed3f(acc[ai][1][m][n][j], -6.0f, 8.0f);
                        const float r4 = fast_rcp(__builtin_fmaf(fast_exp2(glu * (-1.702f * 1.44269504089f)), 0.25f, 0.25f));
                        o[i] = (glu * r4) * lin1; }
                u32x2 w; w.x = pk4_fp8(o[0], o[1], o[2], o[3]); w.y = pk4_fp8(o[4], o[5], o[6], o[7]);
                *(u32x2*)(ACT + (size_t)row * D + f0) = w; }
    }
};
struct EpiDown {
    static constexpr bool PERM = true, SIDE = true; static constexpr int SCALES = 0x7D79;
    unsigned char* YS; unsigned bias_off;
    __device__ __forceinline__ unsigned side_off(const Unit& u) const { return bias_off + (unsigned)((u.aux * 4 + u.pn) * 1024); }
    __device__ __forceinline__ void init(f32x4 (&acc)[2][2][4][2], const LAS float* side, int wc, int fq) const {
#pragma unroll
        for (int bj = 0; bj < 2; ++bj)
#pragma unroll
            for (int n = 0; n < 2; ++n) { const f32x4 b = *(const LAS f32x4*)(side + 128 * bj + 32 * wc + 8 * fq + 4 * n);
#pragma unroll
                for (int ai = 0; ai < 2; ++ai)
#pragma unroll
                    for (int m = 0; m < 4; ++m) acc[ai][bj][m][n] = b; }
    }
    __device__ __forceinline__ void operator()(EPI_ARGS) const {
        const int row0 = u.pm * 256 + wr * 64 + fr, col0 = u.pn * 256 + wc * 32 + 8 * fq;
#pragma unroll
        for (int ai = 0; ai < 2; ++ai)
#pragma unroll
            for (int m = 0; m < 4; ++m) { unsigned char* rowp = YS + (size_t)(row0 + ai * 128 + m * 16) * D + col0;
#pragma unroll
                for (int bj = 0; bj < 2; ++bj) { const f32x4 v0 = acc[ai][bj][m][0] * 8.0f, v1 = acc[ai][bj][m][1] * 8.0f;
                    u32x2 w; w.x = pk4_fp8(sat8(v0[0]), sat8(v0[1]), sat8(v0[2]), sat8(v0[3])); w.y = pk4_fp8(sat8(v1[0]), sat8(v1[1]), sat8(v1[2]), sat8(v1[3]));
                    *(u32x2*)(rowp + bj * 128) = w; } }
    }
};
struct EpiQkv {
    static constexpr bool PERM = true, SIDE = false; static constexpr int SCALES = 0x7F79;
    bf16_t* Q; bf16_t* Kx; bf16_t* VT;
    __device__ __forceinline__ void operator()(EPI_ARGS) const {
        const int row0 = u.pm * 256 + wr * 64 + fr; bf16_t* base; int ldc, colt; float sc = 1.0f;
        if (u.aux == 0) { ldc = D; if (u.pn < 4) { base = Q; colt = u.pn * 256; sc = 0.125f * 1.44269504089f; } else { base = Kx; colt = (u.pn - 4) * 256; } }
        else { base = VT; ldc = MPAD; colt = u.pn * 256; }
        const int col0 = colt + wc * 32 + 8 * fq;
#pragma unroll
        for (int ai = 0; ai < 2; ++ai)
#pragma unroll
            for (int m = 0; m < 4; ++m) { bf16_t* rowp = base + (size_t)(row0 + ai * 128 + m * 16) * ldc + col0;
#pragma unroll
                for (int bj = 0; bj < 2; ++bj) { const f32x4 v0 = acc[ai][bj][m][0] * sc, v1 = acc[ai][bj][m][1] * sc;
                    u32x4 w; w.x = cvt_pk_bf16(v0[0], v0[1]); w.y = cvt_pk_bf16(v0[2], v0[3]); w.z = cvt_pk_bf16(v1[0], v1[1]); w.w = cvt_pk_bf16(v1[2], v1[3]);
                    *(u32x4*)(rowp + bj * 128) = w; } }
    }
};

struct CvItem { const float* src; unsigned char* dst; int ld, pitch, f8; };
__device__ __forceinline__ CvItem cv_item(const Ctx& C, unsigned char* wsl, int it) {
    constexpr int I0 = 512, I1 = 256, I2 = 256, I3 = 768, I4 = 256, I5 = 32768, I6 = 16384;
    CvItem q; int r = it;
    if (r < I0) { const int nbk = r & 63, kb = r >> 6; q.src = C.in[I_WIN] + (size_t)(128 * kb) * 2048 + 32 * nbk; q.ld = 2048; q.dst = wsl + WS_WIN + ((size_t)(32 * nbk) * 1024 + 128 * kb) * 2; q.pitch = 2048; q.f8 = 0; return q; } r -= I0;
    if (r < I1) { const int job = r >> 3, sub = r & 7, nbk = sub & 3, kb = sub >> 2;
        const int half = job & 1, which = (job >> 1) & 1, nb = (job >> 2) & 3, dir = job >> 4;
        q.src = C.in[which ? I_WX : I_WA] + (size_t)(dir * 4 + nb) * 65536 + (size_t)(128 * kb) * 256 + 128 * half + 32 * nbk; q.ld = 256;
        q.dst = wsl + WS_GATE + (((size_t)nb * 1024 + 256 * (2 * dir + half) + 128 * which + 32 * nbk) * 256 + 128 * kb) * 2; q.pitch = 512; q.f8 = 0; return q; } r -= I1;
    if (r < I2) { const int nbk = r & 31, kb = r >> 5; q.src = C.in[I_LOUT] + (size_t)(128 * kb) * 1024 + 32 * nbk; q.ld = 1024; q.dst = wsl + WS_LOUT + ((size_t)(32 * nbk) * 1024 + 128 * kb) * 2; q.pitch = 2048; q.f8 = 0; return q; } r -= I2;
    if (r < I3) { const int nbk = r % 96, kb = r / 96; q.src = C.in[I_WQKV] + (size_t)(128 * kb) * 3072 + 32 * nbk; q.ld = 3072; q.dst = wsl + WS_QKV + ((size_t)(32 * nbk) * 1024 + 128 * kb) * 2; q.pitch = 2048; q.f8 = 0; return q; } r -= I3;
    if (r < I4) { const int nbk = r & 31, kb = r >> 5; q.src = C.in[I_NOUT] + (size_t)(128 * kb) * 1024 + 32 * nbk; q.ld = 1024; q.dst = wsl + WS_NOUT + (size_t)(32 * nbk) * 1024 + 128 * kb; q.pitch = 1024; q.f8 = 1; return q; } r -= I4;
    q.f8 = 1; q.pitch = 1024;
    if (r < I5) { const int mat = r >> 9, sub = r & 511, nbk = sub & 63, kb = sub >> 6; const int n0 = 32 * nbk, bj = n0 >> 10, f0 = n0 & 1023, pn = f0 >> 7, jj = f0 & 127;
        q.src = C.in[I_WGU] + (size_t)mat * 1024 * 2048 + (size_t)(128 * kb) * 2048 + n0; q.ld = 2048; q.dst = wsl + WS_WGU + ((size_t)mat * 2048 + 256 * pn + 128 * bj + jj) * 1024 + 128 * kb; return q; } r -= I5;
    if (r < I6) { const int mat = r >> 8, sub = r & 255, nbk = sub & 31, kb = sub >> 5;
        q.src = C.in[I_WD] + (size_t)mat * 1024 * 1024 + (size_t)(128 * kb) * 1024 + 32 * nbk; q.ld = 1024; q.dst = wsl + WS_WD + ((size_t)mat * 1024 + 32 * nbk) * 1024 + 128 * kb; return q; } r -= I6;
    if (r < 768) { const int nbk = r % 96, kb = r / 96; q.src = C.in[I_WQKV] + (size_t)(128 * kb) * 3072 + 32 * nbk; q.ld = 3072; q.dst = wsl + WS_QKV8 + (size_t)(32 * nbk) * 1024 + 128 * kb; return q; } r -= 768;
    { const int nbk = r & 31, kb = r >> 5; q.src = C.in[I_LOUT] + (size_t)(128 * kb) * 1024 + 32 * nbk; q.ld = 1024; q.dst = wsl + WS_LOUT8 + (size_t)(32 * nbk) * 1024 + 128 * kb; return q; }
}
__device__ __forceinline__ void phase_convert(const Ctx& C) {
    PHASE_IDS
    LAS float* scr = (LAS float*)(C.lds + wave * 16896);
    const int gw = C.bid * NWAVES + wave, NGW = C.G * NWAVES;
    constexpr int NIT = 512 + 256 + 256 + 768 + 256 + 32768 + 16384 + 768 + 256;
#define CV_LOAD(v, q) do { _Pragma("unroll") for (int i = 0; i < 16; ++i) v[i] = __builtin_nontemporal_load((const f32x4*)((q).src + (size_t)(8 * i + r) * (q).ld + 4 * q4)); } while (0)
#define CV_TOLDS(v) do { _Pragma("unroll") for (int i = 0; i < 16; ++i) { LAS float* sp = scr + (8 * i + r) * 33 + 4 * q4; sp[0] = v[i][0]; sp[1] = v[i][1]; sp[2] = v[i][2]; sp[3] = v[i][3]; } } while (0)
#define CV_OUT(q) do { asm volatile("s_waitcnt lgkmcnt(0)" ::: "memory"); \
        if ((q).f8) { _Pragma("unroll") for (int j = 0; j < 8; ++j) { const int n = nn + 4 * j; const LAS float* sp = scr + (8 * c) * 33 + n; \
                u32x2 o; o.x = pk4_fp8(sp[0] * 64.0f, sp[33] * 64.0f, sp[2 * 33] * 64.0f, sp[3 * 33] * 64.0f); o.y = pk4_fp8(sp[4 * 33] * 64.0f, sp[5 * 33] * 64.0f, sp[6 * 33] * 64.0f, sp[7 * 33] * 64.0f); \
                *(u32x2*)((q).dst + (size_t)n * (q).pitch + 8 * c) = o; } } \
        else { _Pragma("unroll") for (int j = 0; j < 8; ++j) { const int n = nn + 4 * j; const LAS float* sp = scr + (8 * c) * 33 + n; \
                u32x4 o; o.x = pk2(sp[0], sp[33]); o.y = pk2(sp[2 * 33], sp[3 * 33]); o.z = pk2(sp[4 * 33], sp[5 * 33]); o.w = pk2(sp[6 * 33], sp[7 * 33]); \
                *(u32x4*)((q).dst + (size_t)n * (q).pitch + 16 * c) = o; } } \
        asm volatile("s_waitcnt lgkmcnt(0)" ::: "memory"); } while (0)
    if (gw < NIT) {
        const int r = lane >> 3, q4 = lane & 7, c = lane & 15, nn = lane >> 4;
        CvItem ia = cv_item(C, wsl, gw), ib = ia; int ita = gw, itb = gw + NGW;
        f32x4 va[16], vb[16];
        CV_LOAD(va, ia);
        if (itb < NIT) { ib = cv_item(C, wsl, itb); CV_LOAD(vb, ib); }
        for (;;) {
            CV_TOLDS(va);
            const int na = ita + 2 * NGW; CvItem nia = ia;
            if (na < NIT) { nia = cv_item(C, wsl, na); CV_LOAD(va, nia); }
            CV_OUT(ia);
            if (itb >= NIT) break;
            CV_TOLDS(vb);
            const int nb = itb + 2 * NGW; CvItem nib = ib;
            if (nb < NIT) { nib = cv_item(C, wsl, nb); CV_LOAD(vb, nib); }
            CV_OUT(ib);
            if (na >= NIT) break;
            ia = nia; ita = na; ib = nib; itb = nb;
        }
    }
#undef CV_LOAD
#undef CV_TOLDS
#undef CV_OUT
    const int gt = C.bid * NTHREADS + tid, NGT = C.G * NTHREADS;
    for (int i = gt; i < 2 * 32 * TCAP; i += NGT) ((int*)(wsl + WS_TOK2))[i] = 0;
    if (gt < 64) ((unsigned*)(wsl + WS_CTL + CT_BC))[gt] = 0u;
    for (int i = gt; i < 2048; i += NGT) ((float*)(wsl + WS_CTL + CT_SPL))[i] = 8.0f * 1.44269504089f * log1pf(expf(-C.in[I_LAM][i]));
    for (int i = gt; i < 2 * 32 * 2048; i += NGT) { const int le = i >> 11, r = i & 2047, pn = r >> 8, bj = (r >> 7) & 1, ii = r & 127;
        ((float*)(wsl + WS_BIAS))[i] = C.in[I_BGU][(size_t)le * 2048 + bj * 1024 + 128 * pn + ii] + (bj ? 1.0f : 0.0f); }
    for (int i = gt; i < 2 * 32 * 1024; i += NGT) ((float*)(wsl + WS_BD))[i] = C.in[I_BD][i];
    for (int i = gt; i < 4096; i += NGT) { const int ut = i >> 8, which = (i >> 7) & 1, jj = i & 127, dir = ut >> 3, nb = (ut >> 1) & 3, half = ut & 1;
        ((float*)(wsl + WS_GBIAS))[i] = C.in[which ? I_BX : I_BA][dir * 1024 + 256 * nb + 128 * half + jj]; }
    for (int i0 = gt; i0 < NTOK * 128; i0 += 4 * NGT) { f32x4 a[4], b[4];
#pragma unroll
        for (int u = 0; u < 4; ++u) { const int i = i0 + u * NGT; if (i < NTOK * 128) { const int row = i >> 7, oc = i & 127;
            const float* src = (row < NGRID ? C.in[I_X] + (size_t)row * D : C.in[I_META] + (size_t)((row - NGRID) & 15) * D) + 8 * oc;
            a[u] = __builtin_nontemporal_load((const f32x4*)src); b[u] = __builtin_nontemporal_load((const f32x4*)(src + 4)); } }
#pragma unroll
        for (int u = 0; u < 4; ++u) { const int i = i0 + u * NGT; if (i < NTOK * 128) { const int row = i >> 7, oc = i & 127;
            u32x4 w; w.x = pk2(a[u][0], a[u][1]); w.y = pk2(a[u][2], a[u][3]); w.z = pk2(b[u][0], b[u][1]); w.w = pk2(b[u][2], b[u][3]);
            *(u32x4*)((bf16_t*)(wsl + WS_HB) + (size_t)row * D + 8 * oc) = w; } } }
}

__device__ __forceinline__ void phase_conv(const Ctx& C) {
    PHASE_IDS
    const bf16_t* XR = (const bf16_t*)(wsl + WS_XR); bf16_t* XC = (bf16_t*)(wsl + WS_XC);
    const float* cw = C.in[I_CONVW]; const float* cb = C.in[I_CONVB];
    const int gt = C.vr * NTHREADS + tid, NGT = C.gs * NTHREADS;
    for (int i = gt; C.vx < 8 && i < LSEQ * 128; i += NGT) { const int row = batch_row(C.vx, i >> 7), ch = 8 * (i & 127);
        int b, s; if (row < NGRID) { b = row >> 12; s = NMETA + (row & (SEQ - 1)); } else { b = (row - NGRID) >> 4; s = (row - NGRID) & 15; }
        float a[8];
        { const f32x4 t0 = *(const f32x4*)(cb + ch), t1 = *(const f32x4*)(cb + ch + 4);
#pragma unroll
          for (int j = 0; j < 4; ++j) { a[j] = t0[j]; a[4 + j] = t1[j]; } }
#pragma unroll
        for (int j = 0; j < 4; ++j) { const int sj = s - 2 + j;
            if (sj >= 0 && sj < LSEQ) { const u32x4 xw = *(const u32x4*)(XR + (size_t)seqrow(b, sj) * D + ch);
                const f32x4 w0 = *(const f32x4*)(cw + j * 1024 + ch), w1 = *(const f32x4*)(cw + j * 1024 + ch + 4);
                a[0] += w0[0] * bflo(xw.x); a[1] += w0[1] * bfhi(xw.x); a[2] += w0[2] * bflo(xw.y); a[3] += w0[3] * bfhi(xw.y);
                a[4] += w1[0] * bflo(xw.z); a[5] += w1[1] * bfhi(xw.z); a[6] += w1[2] * bflo(xw.w); a[7] += w1[3] * bfhi(xw.w); } }
        u32x4 w; w.x = pk2(a[0], a[1]); w.y = pk2(a[2], a[3]); w.z = pk2(a[4], a[5]); w.w = pk2(a[6], a[7]);
        *(u32x4*)(XC + (size_t)row * D + ch) = w; }
}

template <int N> __device__ __forceinline__ float dpp_shr(float oldv, float v) {
    return __builtin_bit_cast(float, __builtin_amdgcn_update_dpp(__builtin_bit_cast(int, oldv), __builtin_bit_cast(int, v), 0x110 + N, 0xf, 0xf, false));
}
__device__ __forceinline__ void scan_group(float (&a)[8], float (&b)[8]) {
#define SG_STEP(N) _Pragma("unroll") for (int c = 0; c < 8; ++c) { \
        asm volatile("v_fmac_f32_dpp %0, %0, %1 row_shr:" #N " row_mask:0xf bank_mask:0xf bound_ctrl:1" : "+v"(b[c]) : "v"(a[c])); } \
    _Pragma("unroll") for (int c = 0; c < 8; ++c) { \
        asm volatile("v_mul_f32_dpp %0, %0, %0 row_shr:" #N " row_mask:0xf bank_mask:0xf" : "+v"(a[c])); }
    asm volatile("s_nop 1" ::: "memory");
    SG_STEP(1) SG_STEP(2) SG_STEP(4) SG_STEP(8)
    asm volatile("s_nop 1" ::: "memory");
#undef SG_STEP
}
__device__ __forceinline__ void unpack8(const u32x4 w, float (&o)[8]) { o[0] = bflo(w.x); o[1] = bfhi(w.x); o[2] = bflo(w.y); o[3] = bfhi(w.y); o[4] = bflo(w.z); o[5] = bfhi(w.z); o[6] = bflo(w.w); o[7] = bfhi(w.w); }
#define SCAN_OUT(row_, gv) do { u32x2 _o8; _o8.x = pk4_fp8(__builtin_amdgcn_fmed3f(2.0f * gv[0], -448.0f, 448.0f), __builtin_amdgcn_fmed3f(2.0f * gv[1], -448.0f, 448.0f), __builtin_amdgcn_fmed3f(2.0f * gv[2], -448.0f, 448.0f), __builtin_amdgcn_fmed3f(2.0f * gv[3], -448.0f, 448.0f)); \
        _o8.y = pk4_fp8(__builtin_amdgcn_fmed3f(2.0f * gv[4], -448.0f, 448.0f), __builtin_amdgcn_fmed3f(2.0f * gv[5], -448.0f, 448.0f), __builtin_amdgcn_fmed3f(2.0f * gv[6], -448.0f, 448.0f), __builtin_amdgcn_fmed3f(2.0f * gv[7], -448.0f, 448.0f)); \
        *(u32x2*)(G8 + (size_t)(row_) * D + 32 * g + 8 * oct) = _o8; \
        if ((row_) >= NGRID) { u32x4 _o; _o.x = pk2(gv[0], gv[1]); _o.y = pk2(gv[2], gv[3]); _o.z = pk2(gv[4], gv[5]); _o.w = pk2(gv[6], gv[7]); *(u32x4*)(Gout + (size_t)(row_) * D + 32 * g + 8 * oct) = _o; } } while (0)
__device__ __forceinline__ void phase_scan(const Ctx& C) {
    PHASE_IDS
    const unsigned char* LB = wsl + WS_LA; const float* spl = (const float*)(wsl + WS_CTL + CT_SPL); const bf16_t* GY = (const bf16_t*)(wsl + WS_GY);
    bf16_t* HF = (bf16_t*)(wsl + WS_HF); bf16_t* Gout = (bf16_t*)(wsl + WS_G); unsigned char* G8 = wsl + WS_BB;
    LAS float* agg = (LAS float*)C.lds;
    const int w = wave, oct = lane >> 4, p = lane & 15;
    for (int g = C.vr; C.vx < 8 && g < 32; g += C.gs) {
        const int b = C.vx;
        for (int dir = 0; dir < 2; ++dir) {
            const unsigned char* lb = LB + (((size_t)dir * 32 + g) * MPAD) * 64 + 16 * oct;
            float cs[8];
            { const f32x4 p0 = *(const f32x4*)(spl + dir * 1024 + 32 * g + 8 * oct), p1 = *(const f32x4*)(spl + dir * 1024 + 32 * g + 8 * oct + 4);
#pragma unroll
              for (int c = 0; c < 4; ++c) { cs[c] = p0[c] * (-1.0f / 256.0f); cs[4 + c] = p1[c] * (-1.0f / 256.0f); } }
            float S[8];
#pragma unroll
            for (int c = 0; c < 8; ++c) S[c] = 0.f;
            {
                const int u = p, s = dir ? LSEQ - 1 - u : u, row = seqrow(b, s);
                float a[8], x[8]; { const u32x4 rec = *(const u32x4*)(lb + (size_t)row * 64); u32x2 t; t.x = rec.x; t.y = rec.y; unpack8_fp8(t, a); t.x = rec.z; t.y = rec.w; unpack8_fp8(t, x); }
#pragma unroll
                for (int c = 0; c < 8; ++c) { a[c] = fast_exp2(a[c] * cs[c]); x[c] *= 0.125f; }
                scan_group(a, x);
                if (w == 0) {
                    if (dir == 0) { u32x4 o; o.x = pk2(x[0], x[1]); o.y = pk2(x[2], x[3]); o.z = pk2(x[4], x[5]); o.w = pk2(x[6], x[7]); *(u32x4*)(HF + ((size_t)g * MPAD + row) * 32 + 8 * oct) = o; }
                    else { float hf[8], gy[8]; unpack8(*(const u32x4*)(HF + ((size_t)g * MPAD + row) * 32 + 8 * oct), hf); unpack8(*(const u32x4*)(GY + ((size_t)g * MPAD + row) * 32 + 8 * oct), gy);
                        float gv[8];
#pragma unroll
                        for (int c = 0; c < 8; ++c) gv[c] = (hf[c] + x[c]) * gy[c];
                        SCAN_OUT(row, gv); }
                }
#pragma unroll
                for (int c = 0; c < 8; ++c) S[c] = __shfl(x[c], (lane & 48) | 15);
            }
            u32x4 na[4];
#pragma unroll
            for (int j = 0; j < 4; ++j) { const int u = 16 + 64 * w + 16 * j + p, s = dir ? LSEQ - 1 - u : u; const int rw = seqrow(b, s);
                na[j] = __builtin_nontemporal_load((const u32x4*)(lb + (size_t)rw * 64)); }
            for (int r = 0; r < 8; ++r) {
                float Pw[4][8], Hw[4][8]; int rows[4];
                float Aw[8], Hc[8];
#pragma unroll
                for (int c = 0; c < 8; ++c) { Aw[c] = 1.f; Hc[c] = 0.f; }
                u32x4 ra[4], rhf[4], rgy[4];
#pragma unroll
                for (int j = 0; j < 4; ++j) { const int u = 16 + 512 * r + 64 * w + 16 * j + p, s = dir ? LSEQ - 1 - u : u; rows[j] = seqrow(b, s); ra[j] = na[j]; }
                if (r < 7) {
#pragma unroll
                    for (int j = 0; j < 4; ++j) { const int u = 16 + 512 * (r + 1) + 64 * w + 16 * j + p, s = dir ? LSEQ - 1 - u : u; const int rw = seqrow(b, s);
                        na[j] = __builtin_nontemporal_load((const u32x4*)(lb + (size_t)rw * 64)); } }
                if (dir == 1) {
#pragma unroll
                    for (int j = 0; j < 4; ++j) { const size_t go = ((size_t)g * MPAD + rows[j]) * 32 + 8 * oct; rhf[j] = *(const u32x4*)(HF + go); rgy[j] = __builtin_nontemporal_load((const u32x4*)(GY + go)); } }
#pragma unroll
                for (int j = 0; j < 4; ++j) {
                    float a[8], x[8]; { u32x2 t; t.x = ra[j].x; t.y = ra[j].y; unpack8_fp8(t, a); t.x = ra[j].z; t.y = ra[j].w; unpack8_fp8(t, x); }
#pragma unroll
                    for (int c = 0; c < 8; ++c) { a[c] = fast_exp2(a[c] * cs[c]); x[c] *= 0.125f; }
                    scan_group(a, x);
#pragma unroll
                    for (int c = 0; c < 8; ++c) { Hw[j][c] = a[c] * Hc[c] + x[c]; Pw[j][c] = a[c] * Aw[c]; }
#pragma unroll
                    for (int c = 0; c < 8; ++c) { Aw[c] = __shfl(Pw[j][c], (lane & 48) | 15); Hc[c] = __shfl(Hw[j][c], (lane & 48) | 15); }
                }
                LAS float* ag = agg + (r & 1) * 512;
                if (p == 0) {
#pragma unroll
                    for (int c = 0; c < 8; ++c) { ag[(w * 32 + oct * 8 + c) * 2] = Aw[c]; ag[(w * 32 + oct * 8 + c) * 2 + 1] = Hc[c]; }
                }
                __syncthreads();
                float Sin[8];
#pragma unroll
                for (int c = 0; c < 8; ++c) Sin[c] = S[c];
#pragma unroll
                for (int ww = 0; ww < 8; ++ww) {
#pragma unroll
                    for (int c = 0; c < 8; ++c) { const float A = ag[(ww * 32 + oct * 8 + c) * 2], H = ag[(ww * 32 + oct * 8 + c) * 2 + 1];
                        if (ww == w) Sin[c] = S[c];
                        S[c] = A * S[c] + H; }
                }
#pragma unroll
                for (int j = 0; j < 4; ++j) {
                    float h[8];
#pragma unroll
                    for (int c = 0; c < 8; ++c) h[c] = Pw[j][c] * Sin[c] + Hw[j][c];
                    const size_t go = ((size_t)g * MPAD + rows[j]) * 32 + 8 * oct;
                    if (dir == 0) { u32x4 o; o.x = pk2(h[0], h[1]); o.y = pk2(h[2], h[3]); o.z = pk2(h[4], h[5]); o.w = pk2(h[6], h[7]); *(u32x4*)(HF + go) = o; }
                    else { float hf[8], gy[8]; unpack8(rhf[j], hf); unpack8(rgy[j], gy);
                        float gv[8];
#pragma unroll
                        for (int c = 0; c < 8; ++c) gv[c] = (hf[c] + h[c]) * gy[c];
                        SCAN_OUT(rows[j], gv); }
                }
            }
            __syncthreads();
        }
    }
}

template <int K> __device__ __forceinline__ f32x4 mini_mma(const bf16_t* W, int ldw, const bf16_t* A, int lda, int lane) {
    const bf16_t* wp = W + (size_t)(lane & 15) * ldw + 8 * (lane >> 4); const bf16_t* ap = A + (size_t)(lane & 15) * lda + 8 * (lane >> 4);
    f32x4 acc = {0.f, 0.f, 0.f, 0.f};
    constexpr int KB = K < 512 ? K : 512, NS = KB / 32;
#pragma unroll 1
    for (int k0 = 0; k0 < K; k0 += KB) { bf16x8 wf[NS], af[NS];
#pragma unroll
        for (int i = 0; i < NS; ++i) { wf[i] = *(const bf16x8*)(wp + k0 + 32 * i); af[i] = *(const bf16x8*)(ap + k0 + 32 * i); }
#pragma unroll
        for (int i = 0; i < NS; ++i) acc = __builtin_amdgcn_mfma_f32_16x16x32_bf16(wf[i], af[i], acc, 0, 0, 0); }
    return acc;
}
__device__ __forceinline__ void mini_win(const Ctx& C) {
    PHASE_IDS
    const bf16_t* HB = (const bf16_t*)(C.ws + WS_HB); const bf16_t* WT = (const bf16_t*)(C.ws + WS_WIN); bf16_t* XR = (bf16_t*)(C.ws + WS_XR); bf16_t* GY = (bf16_t*)(C.ws + WS_GY);
    const int fr = lane & 15, fq = lane >> 4;
    for (int wt = (C.vr * NWAVES + wave) * 8 + C.vx; C.vx < 8 && wt < 8 * 128; wt += C.gs * NWAVES * 8) { const int rg = wt & 7, cb = wt >> 3, row = NGRID + 16 * rg + fr, c = 16 * cb + 4 * fq;
        const f32x4 a = mini_mma<1024>(WT + (size_t)(16 * cb) * 1024, 1024, HB + (size_t)(NGRID + 16 * rg) * 1024, 1024, lane);
        if (c < 1024) { u32x2 w; w.x = cvt_pk_bf16(a[0], a[1]); w.y = cvt_pk_bf16(a[2], a[3]); *(u32x2*)(XR + (size_t)row * D + c) = w; }
        else { const int yc = c - 1024; float o[4];
#pragma unroll
            for (int j = 0; j < 4; ++j) { const float v = a[j]; const float z = 1.5957691216f * (v + 0.044715f * v * v * v); o[j] = v * sigmoidf_(z); }
            u32x2 w; w.x = cvt_pk_bf16(o[0], o[1]); w.y = cvt_pk_bf16(o[2], o[3]); *(u32x2*)(GY + ((size_t)(yc >> 5) * MPAD + row) * 32 + (yc & 31)) = w; } }
}
__device__ __forceinline__ void mini_gate(const Ctx& C) {
    PHASE_IDS
    const bf16_t* XC = (const bf16_t*)(C.ws + WS_XC); const bf16_t* GT = (const bf16_t*)(C.ws + WS_GATE); unsigned char* LB = C.ws + WS_LA;
    const float* ba = C.in[I_BA]; const float* bx = C.in[I_BX]; const float* spl = (const float*)(C.ws + WS_CTL + CT_SPL);
    const int fr = lane & 15, fq = lane >> 4;
    for (int wt = (C.vr * NWAVES + wave) * 8 + C.vx; C.vx < 8 && wt < 8 * 2 * 64; wt += C.gs * NWAVES * 8) { const int rg = wt & 7, dir = (wt >> 3) & 1, chg = wt >> 4, ch0 = 16 * chg, nb = ch0 >> 8, half = (ch0 >> 7) & 1, jj0 = ch0 & 127;
        const bf16_t* A = XC + (size_t)(NGRID + 16 * rg) * 1024 + 256 * nb; const bf16_t* Wa = GT + ((size_t)nb * 1024 + 256 * (2 * dir + half) + jj0) * 256;
        const f32x4 za = mini_mma<256>(Wa, 256, A, 1024, lane), zx = mini_mma<256>(Wa + 128 * 256, 256, A, 1024, lane);
        const int row = NGRID + 16 * rg + fr, ch = ch0 + 4 * fq;
        const f32x4 cba = *(const f32x4*)(ba + dir * 1024 + ch), cbx = *(const f32x4*)(bx + dir * 1024 + ch), csp = *(const f32x4*)(spl + dir * 1024 + ch);
        const u32x2 xw = *(const u32x2*)(XC + (size_t)row * D + ch); const float xc[4] = {bflo(xw.x), bfhi(xw.x), bflo(xw.y), bfhi(xw.y)};
        float sg[4], bb[4];
#pragma unroll
        for (int j = 0; j < 4; ++j) { const float sga = sigmoidf_(za[j] + cba[j]); const float a2 = fast_exp2(-2.0f * csp[j] * sga);
            const float mult = (dir == 0 && fr == 0) ? 8.0f : 8.0f * __builtin_amdgcn_sqrtf(fmaxf(1.0f - a2, 0.0f));
            sg[j] = sga * 256.0f; bb[j] = __builtin_amdgcn_fmed3f(mult * sigmoidf_(zx[j] + cbx[j]) * xc[j], -448.0f, 448.0f); }
        unsigned char* o = LB + (((size_t)dir * 32 + (ch >> 5)) * MPAD + row) * 64 + 16 * ((ch & 31) >> 3) + (ch & 7);
        *(unsigned*)o = pk4_fp8(sg[0], sg[1], sg[2], sg[3]); *(unsigned*)(o + 8) = pk4_fp8(bb[0], bb[1], bb[2], bb[3]); }
}
__device__ __forceinline__ void mini_lout(const Ctx& C) {
    PHASE_IDS
    const bf16_t* G = (const bf16_t*)(C.ws + WS_G); const bf16_t* WT = (const bf16_t*)(C.ws + WS_LOUT); bf16_t* PRE = (bf16_t*)(C.ws + WS_PRE); const float* meta = C.in[I_META];
    const int fr = lane & 15, fq = lane >> 4;
    for (int wt = (C.vr * NWAVES + wave) * 8 + C.vx; C.vx < 8 && wt < 8 * 64; wt += C.gs * NWAVES * 8) { const int rg = wt & 7, cb = wt >> 3, row = NGRID + 16 * rg + fr, c = 16 * cb + 4 * fq;
        const f32x4 a = mini_mma<1024>(WT + (size_t)(16 * cb) * 1024, 1024, G + (size_t)(NGRID + 16 * rg) * 1024, 1024, lane);
        const f32x4 r = *(const f32x4*)(meta + (size_t)fr * D + c);
        u32x2 w; w.x = cvt_pk_bf16(r[0] * DN_ALPHA + a[0], r[1] * DN_ALPHA + a[1]); w.y = cvt_pk_bf16(r[2] * DN_ALPHA + a[2], r[3] * DN_ALPHA + a[3]); *(u32x2*)(PRE + (size_t)row * D + c) = w; }
}
__device__ __forceinline__ void mini_kv(const Ctx& C) {
    PHASE_IDS
    const bf16_t* HB = (const bf16_t*)(C.ws + WS_HB); const bf16_t* WT = (const bf16_t*)(C.ws + WS_QKV); bf16_t* Kx = (bf16_t*)(C.ws + WS_K); bf16_t* VT = (bf16_t*)(C.ws + WS_VT);
    const int fr = lane & 15, fq = lane >> 4;
    for (int wt = (C.vr * NWAVES + wave) * 8 + C.vx; C.vx < 8 && wt < 2 * 8 * 64; wt += C.gs * NWAVES * 8) { const int rg = wt & 7, cb = (wt >> 3) & 63, isv = wt >> 9;
        const bf16_t* A = HB + (size_t)(NGRID + 16 * rg) * 1024;
        if (!isv) { const f32x4 a = mini_mma<1024>(WT + (size_t)(1024 + 16 * cb) * 1024, 1024, A, 1024, lane);
            u32x2 w; w.x = cvt_pk_bf16(a[0], a[1]); w.y = cvt_pk_bf16(a[2], a[3]); *(u32x2*)(Kx + (size_t)(NGRID + 16 * rg + fr) * D + 16 * cb + 4 * fq) = w; }
        else { const f32x4 a = mini_mma<1024>(A, 1024, WT + (size_t)(2048 + 16 * cb) * 1024, 1024, lane);
            u32x2 w; w.x = cvt_pk_bf16(a[0], a[1]); w.y = cvt_pk_bf16(a[2], a[3]); *(u32x2*)(VT + (size_t)(16 * cb + fr) * MPAD + NGRID + 16 * rg + 4 * fq) = w; } }
}

constexpr int RW_PITCH = 2080;
__device__ __forceinline__ void phase_lnr(const Ctx& C, int layer, int nrows) {
    PHASE_IDS
    const bf16_t* PRE = (const bf16_t*)(wsl + WS_PRE); bf16_t* HB = (bf16_t*)(wsl + WS_HB); unsigned char* HB8 = wsl + WS_HB8;
    const float* lg = C.in[I_LNMG] + layer * D; const float* lb = C.in[I_LNMB] + layer * D;
    const float* rw = C.in[I_RW] + (size_t)layer * D * NEXP; const float* rb = C.in[I_RB] + layer * NEXP;
    int* eid = (int*)(wsl + WS_CTL + CT_EID) + (size_t)layer * NTOK * 4; float* gatev = (float*)(wsl + WS_CTL + CT_GATEV) + (size_t)layer * NTOK * 4;
    unsigned* gcnt = (unsigned*)(wsl + WS_CTL + CT_BC) + layer * 32; int* posv = (int*)(wsl + WS_CTL + CT_POS) + (size_t)layer * NTOK * 4; int* tok2 = (int*)(wsl + WS_TOK2) + (size_t)layer * 32 * TCAP;
    LAS unsigned char* RWt = C.lds; LAS unsigned char* rowb = C.lds + 32 * RW_PITCH + wave * (4 * RW_PITCH);
    LAS float* lgt = (LAS float*)(C.lds + 32 * RW_PITCH + NWAVES * 4 * RW_PITCH) + wave * 128; LAS unsigned* hist = (LAS unsigned*)(C.lds + 32 * RW_PITCH + NWAVES * 4 * RW_PITCH + NWAVES * 512);
#pragma unroll
    for (int i = 0; i < 8; ++i) { const int idx = tid + NTHREADS * i, pc = idx >> 3, e4 = (idx & 7) * 4, ch = 2 * pc;
        const f32x4 w0 = *(const f32x4*)(rw + (size_t)ch * NEXP + e4), w1 = *(const f32x4*)(rw + (size_t)(ch + 1) * NEXP + e4);
#pragma unroll
        for (int q = 0; q < 4; ++q) *(LAS unsigned*)(RWt + (e4 + q) * RW_PITCH + pc * 4) = pk2(w0[q], w1[q]); }
    if (tid < 32) hist[tid] = 0u;
    __syncthreads();
    float gg[2][8], gb[2][8];
#pragma unroll
    for (int j = 0; j < 2; ++j) { const f32x4 a0 = *(const f32x4*)(lg + 8 * lane + 512 * j), a1 = *(const f32x4*)(lg + 8 * lane + 512 * j + 4), b0 = *(const f32x4*)(lb + 8 * lane + 512 * j), b1 = *(const f32x4*)(lb + 8 * lane + 512 * j + 4);
#pragma unroll
        for (int i = 0; i < 4; ++i) { gg[j][i] = a0[i]; gg[j][4 + i] = a1[i]; gb[j][i] = b0[i]; gb[j][4 + i] = b1[i]; } }
    const float rbias = rb[lane >> 1];
    const int gw = C.vr * NWAVES + wave, NGW = C.gs * NWAVES, nper = nrows == NTOK ? LSEQ : SEQ, bq = C.vx;
    const int nmine = (bq < 8 && gw < nper) ? (nper - gw + NGW - 1) / NGW : 0;
    u32x4 nv[2];
    if (nmine > 0) {
#pragma unroll
        for (int j = 0; j < 2; ++j) nv[j] = __builtin_nontemporal_load((const u32x4*)(PRE + (size_t)batch_row(bq, gw) * D + 8 * lane + 512 * j)); }
    const int fr = lane & 15, fq = lane >> 4;
    for (int i0 = 0; i0 < nmine; i0 += 4) {
#pragma unroll
        for (int ii = 0; ii < 4; ++ii) if (i0 + ii < nmine) {
            const int row = batch_row(bq, gw + NGW * (i0 + ii));
            float v[2][8]; float s = 0.f;
#pragma unroll
            for (int j = 0; j < 2; ++j) { unpack8(nv[j], v[j]); s += ((v[j][0] + v[j][1]) + (v[j][2] + v[j][3])) + ((v[j][4] + v[j][5]) + (v[j][6] + v[j][7])); }
            if (i0 + ii + 1 < nmine) {
#pragma unroll
                for (int j = 0; j < 2; ++j) nv[j] = __builtin_nontemporal_load((const u32x4*)(PRE + (size_t)batch_row(bq, gw + NGW * (i0 + ii + 1)) * D + 8 * lane + 512 * j)); }
            const float mean = wave_sum_dpp(s) * (1.0f / D); float q = 0.f;
#pragma unroll
            for (int j = 0; j < 2; ++j)
#pragma unroll
                for (int i = 0; i < 8; ++i) { v[j][i] -= mean; q += v[j][i] * v[j][i]; }
            const float rstd = __builtin_amdgcn_rsqf(wave_sum_dpp(q) * (1.0f / D) + LN_EPS);
#pragma unroll
            for (int j = 0; j < 2; ++j) {
#pragma unroll
                for (int i = 0; i < 8; ++i) v[j][i] = v[j][i] * rstd * gg[j][i] + gb[j][i];
                u32x4 w; w.x = pk2(v[j][0], v[j][1]); w.y = pk2(v[j][2], v[j][3]); w.z = pk2(v[j][4], v[j][5]); w.w = pk2(v[j][6], v[j][7]);
                *(u32x4*)(HB + (size_t)row * D + 8 * lane + 512 * j) = w;
                *(LAS u32x4*)(rowb + ii * RW_PITCH + 16 * lane + 1024 * j) = w;
                u32x2 w8; w8.x = pk4_fp8(v[j][0], v[j][1], v[j][2], v[j][3]); w8.y = pk4_fp8(v[j][4], v[j][5], v[j][6], v[j][7]);
                *(u32x2*)(HB8 + (size_t)row * D + 8 * lane + 512 * j) = w8; }
        }
        asm volatile("s_waitcnt lgkmcnt(0)" ::: "memory");
        f32x4 l0 = {0.f, 0.f, 0.f, 0.f}, l1 = {0.f, 0.f, 0.f, 0.f};
        { const LAS unsigned char* ap = RWt + fr * RW_PITCH + 16 * fq; const LAS unsigned char* bp = rowb + (fr & 3) * RW_PITCH + 16 * fq;
#pragma unroll
          for (int ks = 0; ks < 32; ++ks) { const bf16x8 b = *(const LAS bf16x8*)(bp + 64 * ks), a0 = *(const LAS bf16x8*)(ap + 64 * ks), a1 = *(const LAS bf16x8*)(ap + 16 * RW_PITCH + 64 * ks);
              l0 = __builtin_amdgcn_mfma_f32_16x16x32_bf16(a0, b, l0, 0, 0, 0); l1 = __builtin_amdgcn_mfma_f32_16x16x32_bf16(a1, b, l1, 0, 0, 0); } }
        if (fr < 4) { *(LAS f32x4*)(lgt + fr * 32 + 4 * fq) = l0; *(LAS f32x4*)(lgt + fr * 32 + 16 + 4 * fq) = l1; }
        asm volatile("s_waitcnt lgkmcnt(0)" ::: "memory");
#pragma unroll
        for (int ii = 0; ii < 4; ++ii) if (i0 + ii < nmine) {
            const int row = batch_row(bq, gw + NGW * (i0 + ii));
            float lv = lgt[ii * 32 + (lane >> 1)] + rbias; lv = (lv == lv) ? lv : -3.0e38f;
            const int le = lane >> 1;
            int rank = 0;
#pragma unroll
            for (int j = 0; j < 32; ++j) { const float lj = readlane_f(lv, 2 * j); rank += (lj > lv || (lj == lv && j < le)) ? 1 : 0; }
            const unsigned long long m0 = __ballot(rank == 0);
            const float mxl = readlane_f(lv, (int)__builtin_ctzll(m0));
            const float pe = rank < 4 ? __expf(lv - mxl) : 0.f;
            const float den = wave_sum_dpp(pe) * 0.5f;
            if (rank < 4 && (lane & 1) == 0) { eid[(size_t)row * 4 + rank] = le; gatev[(size_t)row * 4 + rank] = pe / den;
                posv[(size_t)row * 4 + rank] = (int)__hip_atomic_fetch_add(&hist[le], 1u, __ATOMIC_RELAXED, __HIP_MEMORY_SCOPE_WORKGROUP); }
        }
        asm volatile("s_waitcnt lgkmcnt(0)" ::: "memory");
    }
    asm volatile("s_waitcnt vmcnt(0)" ::: "memory");
    __syncthreads();
    if (tid < 32) hist[32 + tid] = __hip_atomic_fetch_add(&gcnt[tid], hist[tid], __ATOMIC_RELAXED, __HIP_MEMORY_SCOPE_AGENT);
    __syncthreads();
    for (int i0 = 0; i0 < nmine; i0 += 16) { const int i = i0 + (lane >> 2), k = lane & 3;
        if (i < nmine) { const int row = batch_row(bq, gw + NGW * i); const int e = eid[(size_t)row * 4 + k], p = (int)hist[32 + e] + posv[(size_t)row * 4 + k];
            posv[(size_t)row * 4 + k] = (e << 24) | p; tok2[(size_t)e * TCAP + p] = row * 1024; } }
}

__device__ __forceinline__ void phase_combine(const Ctx& C, int layer, int nrows, bool final_out) {
    PHASE_IDS
    bf16_t* HB = (bf16_t*)(wsl + WS_HB); unsigned char* HB8 = wsl + WS_HB8; const unsigned char* YS = wsl + WS_YS;
    const float* lg = C.in[I_LNFG] + layer * D; const float* lb = C.in[I_LNFB] + layer * D;
    const float* gatev = (const float*)(wsl + WS_CTL + CT_GATEV) + (size_t)layer * NTOK * 4; const int* posv = (const int*)(wsl + WS_CTL + CT_POS) + (size_t)layer * NTOK * 4;
    float gg[2][8], gb[2][8];
#pragma unroll
    for (int j = 0; j < 2; ++j) { const f32x4 a0 = *(const f32x4*)(lg + 8 * lane + 512 * j), a1 = *(const f32x4*)(lg + 8 * lane + 512 * j + 4), b0 = *(const f32x4*)(lb + 8 * lane + 512 * j), b1 = *(const f32x4*)(lb + 8 * lane + 512 * j + 4);
#pragma unroll
        for (int i = 0; i < 4; ++i) { gg[j][i] = a0[i]; gg[j][4 + i] = a1[i]; gb[j][i] = b0[i]; gb[j][4 + i] = b1[i]; } }
    const int gw = C.vr * NWAVES + wave, NGW = C.gs * NWAVES, nper = C.vx < 8 ? (nrows == NTOK ? LSEQ : SEQ) : 0, bq = C.vx;
    LAS int* ofs = (LAS int*)C.lds;
    { unsigned* gcnt = (unsigned*)(wsl + WS_CTL + CT_BC) + layer * 32;
      if (tid < 32) ofs[64 + tid] = (int)((__hip_atomic_load(&gcnt[tid], __ATOMIC_RELAXED, __HIP_MEMORY_SCOPE_AGENT) + 255u) & ~255u);
      __syncthreads();
      if (tid < 32) { int a = 0; for (int e = 0; e < tid; ++e) a += ofs[64 + e]; ofs[tid] = a; }
      __syncthreads(); }
    f32x4 g1 = {0.f, 0.f, 0.f, 0.f}, g2 = g1; int p1[4] = {0, 0, 0, 0}, p2[4] = {0, 0, 0, 0};
    u32x4 hwn[2]; u32x2 ywn[4][2];
#define CB_ROUTE(row_, gq, pq) do { gq = *(const f32x4*)(gatev + (size_t)(row_) * 4); const u32x4 _pp = *(const u32x4*)(posv + (size_t)(row_) * 4); pq[0] = ofs[_pp.x >> 24] + (int)(_pp.x & 0xFFFFFFu); pq[1] = ofs[_pp.y >> 24] + (int)(_pp.y & 0xFFFFFFu); pq[2] = ofs[_pp.z >> 24] + (int)(_pp.z & 0xFFFFFFu); pq[3] = ofs[_pp.w >> 24] + (int)(_pp.w & 0xFFFFFFu); } while (0)
#define CB_DATA(row_, pq) do { _Pragma("unroll") for (int j = 0; j < 2; ++j) { hwn[j] = *(const u32x4*)(HB + (size_t)(row_) * D + 8 * lane + 512 * j); \
            _Pragma("unroll") for (int k = 0; k < 4; ++k) ywn[k][j] = __builtin_nontemporal_load((const u32x2*)(YS + (size_t)pq[k] * D + 8 * lane + 512 * j)); } } while (0)
    if (gw < nper) { CB_ROUTE(batch_row(bq, gw), g1, p1); CB_DATA(batch_row(bq, gw), p1); }
    if (gw + NGW < nper) CB_ROUTE(batch_row(bq, gw + NGW), g2, p2);
    for (int lr = gw; lr < nper; lr += NGW) { const int row = batch_row(bq, lr);
        const f32x4 gk4 = g1 * 0.125f; u32x4 hw[2]; u32x2 yw[4][2];
#pragma unroll
        for (int j = 0; j < 2; ++j) { hw[j] = hwn[j];
#pragma unroll
            for (int k = 0; k < 4; ++k) yw[k][j] = ywn[k][j]; }
        g1 = g2;
#pragma unroll
        for (int k = 0; k < 4; ++k) p1[k] = p2[k];
        if (lr + NGW < nper) CB_DATA(batch_row(bq, lr + NGW), p1);
        if (lr + 2 * NGW < nper) CB_ROUTE(batch_row(bq, lr + 2 * NGW), g2, p2);
        float v[2][8]; float s = 0.f;
#pragma unroll
        for (int j = 0; j < 2; ++j) { float h[8]; unpack8(hw[j], h);
#pragma unroll
            for (int i = 0; i < 8; ++i) v[j][i] = h[i] * DN_ALPHA;
#pragma unroll
            for (int k = 0; k < 4; ++k) { float y[8]; unpack8_fp8(yw[k][j], y);
#pragma unroll
                for (int i = 0; i < 8; ++i) v[j][i] += gk4[k] * y[i]; }
#pragma unroll
            for (int i = 0; i < 8; ++i) s += v[j][i]; }
        const float mean = wave_sum_dpp(s) * (1.0f / D); float q = 0.f;
#pragma unroll
        for (int j = 0; j < 2; ++j)
#pragma unroll
            for (int i = 0; i < 8; ++i) { v[j][i] -= mean; q += v[j][i] * v[j][i]; }
        const float rstd = __builtin_amdgcn_rsqf(wave_sum_dpp(q) * (1.0f / D) + LN_EPS);
#pragma unroll
        for (int j = 0; j < 2; ++j) {
#pragma unroll
            for (int i = 0; i < 8; ++i) v[j][i] = v[j][i] * rstd * gg[j][i] + gb[j][i];
            if (final_out) { *(f32x4*)(C.out + (size_t)row * D + 8 * lane + 512 * j) = (f32x4){v[j][0], v[j][1], v[j][2], v[j][3]}; *(f32x4*)(C.out + (size_t)row * D + 8 * lane + 512 * j + 4) = (f32x4){v[j][4], v[j][5], v[j][6], v[j][7]}; }
            else { u32x4 w; w.x = pk2(v[j][0], v[j][1]); w.y = pk2(v[j][2], v[j][3]); w.z = pk2(v[j][4], v[j][5]); w.w = pk2(v[j][6], v[j][7]); *(u32x4*)(HB + (size_t)row * D + 8 * lane + 512 * j) = w;
                u32x2 w8; w8.x = pk4_fp8(v[j][0], v[j][1], v[j][2], v[j][3]); w8.y = pk4_fp8(v[j][4], v[j][5], v[j][6], v[j][7]); *(u32x2*)(HB8 + (size_t)row * D + 8 * lane + 512 * j) = w8; } }
    }
#undef CB_ROUTE
#undef CB_DATA
}

constexpr int AT_KS = 0, AT_VTS = 73728, AT_VPITCH = 1168, AT_KM = AT_VTS + 64 * AT_VPITCH, AT_VTM = AT_KM + 2048, AT_RPB = AT_VTM + 2048, AT_MB = AT_RPB + 1920, AT_END = AT_MB + 64;
static_assert(AT_END <= LDS_BYTES, "attention LDS map");
__device__ __forceinline__ void phase_attn(const Ctx& C) {
    PHASE_IDS
    unsigned char* O8 = wsl + WS_O;
    const float* rpb = C.in[I_RPB]; const float* mbias = C.in[I_MBIAS];
    LAS unsigned char* lds = C.lds;
    const int w = wave, lq = lane & 15, g = lane >> 4;
    const int qr = w >> 2, qg = w & 3, c0 = 16 * qg, kcb = qg == 0 ? 0 : (qg == 1 ? 8 : (qg == 2 ? 24 : 32));
    int bidx[2][4];
    { const int c_ = c0 + lq, cs_ = min(max(c_ - 8, 0), 48);
#pragma unroll
      for (int blk = 0; blk < 2; ++blk)
#pragma unroll
          for (int e = 0; e < 4; ++e) { const int kc = kcb + 16 * blk + 4 * g + e; bidx[blk][e] = ((kc >= cs_ && kc < cs_ + 16) ? (kc - c_ + 15) : 31) * 4; } }
    const __amdgpu_buffer_rsrc_t rsrc = __builtin_amdgcn_make_buffer_rsrc((void*)wsl, 0, 0xFFFFFFFF, 0x00020000);
    const int kvoff = (((tid >> 3) & 63) * D + 8 * (tid & 7)) * 2, vvoff = ((tid >> 3) * MPAD + 8 * (tid & 7)) * 2;
    const int qvoff = (lq * D + 8 * g) * 2;
    const int mvoff = tid < 128 ? ((tid >> 3) * D + 8 * (tid & 7)) * 2 : (((tid - 128) >> 1) * MPAD + 8 * ((tid - 128) & 1)) * 2;
    const int klds = AT_KS + ((((tid >> 3) & 63)) * 8 + ((tid & 7) ^ ((tid >> 3) & 7))) * 16;
    const int vlds = AT_VTS + (tid >> 3) * AT_VPITCH + (tid & 7) * 16;
    for (int su = C.vr; C.vx < 8 && su < 32; su += C.gs) {
        const int b = C.vx, h = su >> 1, strip = su & 1, rp0 = strip * 16;
        const unsigned kbase = (unsigned)WS_K + (unsigned)((b * SEQ) * D + 64 * h) * 2u, vbase = (unsigned)WS_VT + (unsigned)((64 * h) * MPAD + b * SEQ) * 2u;
        const unsigned qbase = (unsigned)WS_Q + (unsigned)((b * SEQ + qr * 64 + c0) * D + 64 * h) * 2u;
        int R0 = min(max(2 * rp0 - 4, 0), 55);
        __syncthreads();
        {
            u32x4 kreg[9], vreg[9];
#pragma unroll
            for (int i = 0; i < 9; ++i) { kreg[i] = __builtin_amdgcn_raw_buffer_load_b128(rsrc, kvoff, (int)(kbase + (unsigned)(R0 + i) * 64u * D * 2u), 0);
                vreg[i] = __builtin_amdgcn_raw_buffer_load_b128(rsrc, vvoff, (int)(vbase + (unsigned)(R0 + i) * 128u), 0); }
            u32x4 mreg = {0u, 0u, 0u, 0u};
            if (tid < 256) mreg = __builtin_amdgcn_raw_buffer_load_b128(rsrc, mvoff, (int)(tid < 128 ? (unsigned)WS_K + (unsigned)((NGRID + 16 * b) * D + 64 * h) * 2u : (unsigned)WS_VT + (unsigned)((64 * h) * MPAD + NGRID + 16 * b) * 2u), 0);
            float rpreg = 0.f, mbreg = 0.f;
            if (tid < 480) rpreg = (tid & 31) < 31 ? rpb[h * 465 + (tid >> 5) * 31 + (tid & 31)] * 1.44269504089f : -1.0e30f;
            if (tid < 16) mbreg = mbias[h * 16 + tid] * 1.44269504089f;
#pragma unroll
            for (int i = 0; i < 9; ++i) { const int slot = (R0 + i) % 9; *(LAS u32x4*)(lds + klds + slot * 8192) = kreg[i]; *(LAS u32x4*)(lds + vlds + slot * 128) = vreg[i]; }
            if (tid < 128) { const int m = tid >> 3, ch = tid & 7; *(LAS u32x4*)(lds + AT_KM + (m * 8 + (ch ^ (m & 7))) * 16) = mreg; }
            else if (tid < 256) { const int i = tid - 128, d = i >> 1, hf = i & 1; *(LAS u32x4*)(lds + AT_VTM + d * 32 + hf * 16) = mreg; }
            if (tid < 480) ((LAS float*)(lds + AT_RPB))[tid] = rpreg;
            if (tid < 16) ((LAS float*)(lds + AT_MB))[tid] = mbreg;
        }
        u32x4 qreg[2];
        qreg[0] = __builtin_amdgcn_raw_buffer_load_b128(rsrc, qvoff, (int)(qbase + (unsigned)(2 * rp0) * 64u * D * 2u), 0);
        qreg[1] = __builtin_amdgcn_raw_buffer_load_b128(rsrc, qvoff, (int)(qbase + (unsigned)(2 * rp0) * 64u * D * 2u + 64u), 0);
        __syncthreads();
        for (int rp = rp0; rp < rp0 + 16; ++rp) {
            const int R0n = rp + 1 < rp0 + 16 ? min(max(2 * (rp + 1) - 4, 0), 55) : R0, nnew = R0n - R0;
            const u32x4 qcur[2] = {qreg[0], qreg[1]};
            u32x4 nk[2], nv[2];
#pragma unroll
            for (int i = 0; i < 2; ++i) if (i < nnew) { nk[i] = __builtin_amdgcn_raw_buffer_load_b128(rsrc, kvoff, (int)(kbase + (unsigned)(R0 + 9 + i) * 64u * D * 2u), 0);
                nv[i] = __builtin_amdgcn_raw_buffer_load_b128(rsrc, vvoff, (int)(vbase + (unsigned)(R0 + 9 + i) * 128u), 0); }
            if (rp + 1 < rp0 + 16) { qreg[0] = __builtin_amdgcn_raw_buffer_load_b128(rsrc, qvoff, (int)(qbase + (unsigned)(2 * rp + 2) * 64u * D * 2u), 0);
                qreg[1] = __builtin_amdgcn_raw_buffer_load_b128(rsrc, qvoff, (int)(qbase + (unsigned)(2 * rp + 2) * 64u * D * 2u + 64u), 0); }
            const int r = 2 * rp + qr;
            const int rs = min(max(r - 4, 0), 56), s0 = rs % 9;
            const size_t qrow = (size_t)(b * SEQ + r * 64 + c0 + lq);
            bf16x8 qf[2]; qf[0] = __builtin_bit_cast(bf16x8, qcur[0]); qf[1] = __builtin_bit_cast(bf16x8, qcur[1]);
            const LAS unsigned char* RProw = lds + AT_RPB + (rs - r + 7) * 128; const LAS float* MB = (const LAS float*)(lds + AT_MB);
            f32x4 sc[8][2], sm;
#pragma unroll
            for (int j = 0; j < 8; ++j) { const int slot = s0 + j - (s0 + j >= 9 ? 9 : 0);
#pragma unroll
                for (int blk = 0; blk < 2; ++blk) { f32x4 a; const int kc = kcb + 16 * blk + lq;
#pragma unroll
                    for (int e = 0; e < 4; ++e) a[e] = *(const LAS float*)(RProw + j * 128 + bidx[blk][e]);
#pragma unroll
                    for (int ks = 0; ks < 2; ++ks) { const bf16x8 kf = *(const LAS bf16x8*)(lds + AT_KS + slot * 8192 + (kc * 8 + ((4 * ks + g) ^ (kc & 7))) * 16);
                        a = __builtin_amdgcn_mfma_f32_16x16x32_bf16(kf, qf[ks], a, 0, 0, 0); }
                    sc[j][blk] = a; } }
            { f32x4 a = *(const LAS f32x4*)(MB + 4 * g);
#pragma unroll
              for (int ks = 0; ks < 2; ++ks) { const bf16x8 kf = *(const LAS bf16x8*)(lds + AT_KM + (lq * 8 + ((4 * ks + g) ^ (lq & 7))) * 16);
                  a = __builtin_amdgcn_mfma_f32_16x16x32_bf16(kf, qf[ks], a, 0, 0, 0); }
              sm = a; }
            float mx = -3.0e38f;
#pragma unroll
            for (int j = 0; j < 8; ++j)
#pragma unroll
                for (int blk = 0; blk < 2; ++blk)
#pragma unroll
                    for (int e = 0; e < 4; ++e) mx = fmaxf(mx, sc[j][blk][e]);
#pragma unroll
            for (int e = 0; e < 4; ++e) mx = fmaxf(mx, sm[e]);
            mx = fmaxf(mx, __shfl_xor(mx, 16)); mx = fmaxf(mx, __shfl_xor(mx, 32));
            float sum = 0.f;
#pragma unroll
            for (int j = 0; j < 8; ++j)
#pragma unroll
                for (int blk = 0; blk < 2; ++blk)
#pragma unroll
                    for (int e = 0; e < 4; ++e) { const float pv = fast_exp2(sc[j][blk][e] - mx); sc[j][blk][e] = pv; sum += pv; }
#pragma unroll
            for (int e = 0; e < 4; ++e) { const float pv = fast_exp2(sm[e] - mx); sm[e] = pv; sum += pv; }
            sum += __shfl_xor(sum, 16); sum += __shfl_xor(sum, 32);
            f32x4 o[4];
#pragma unroll
            for (int db = 0; db < 4; ++db) o[db] = (f32x4){0.f, 0.f, 0.f, 0.f};
#pragma unroll
            for (int j = 0; j < 8; ++j) { const int slot = s0 + j - (s0 + j >= 9 ? 9 : 0);
                u32x4 pw; pw.x = cvt_pk_bf16(sc[j][0][0], sc[j][0][1]); pw.y = cvt_pk_bf16(sc[j][0][2], sc[j][0][3]); pw.z = cvt_pk_bf16(sc[j][1][0], sc[j][1][1]); pw.w = cvt_pk_bf16(sc[j][1][2], sc[j][1][3]);
                const bf16x8 pb = __builtin_bit_cast(bf16x8, pw);
#pragma unroll
                for (int db = 0; db < 4; ++db) { const int d = 16 * db + lq; const LAS unsigned char* vp = lds + AT_VTS + d * AT_VPITCH + (slot * 64 + kcb + 4 * g) * 2;
                    const u32x2 lo = *(const LAS u32x2*)vp, hi = *(const LAS u32x2*)(vp + 32);
                    u32x4 aw; aw.x = lo.x; aw.y = lo.y; aw.z = hi.x; aw.w = hi.y;
                    o[db] = __builtin_amdgcn_mfma_f32_16x16x32_bf16(__builtin_bit_cast(bf16x8, aw), pb, o[db], 0, 0, 0); }
            }
            { u32x4 pw; pw.x = cvt_pk_bf16(sm[0], sm[1]); pw.y = cvt_pk_bf16(sm[2], sm[3]); pw.z = 0u; pw.w = 0u; const bf16x8 pb = __builtin_bit_cast(bf16x8, pw);
#pragma unroll
              for (int db = 0; db < 4; ++db) { const int d = 16 * db + lq; const u32x2 lo = *(const LAS u32x2*)(lds + AT_VTM + d * 32 + 8 * g);
                  u32x4 aw; aw.x = lo.x; aw.y = lo.y; aw.z = 0u; aw.w = 0u;
                  o[db] = __builtin_amdgcn_mfma_f32_16x16x32_bf16(__builtin_bit_cast(bf16x8, aw), pb, o[db], 0, 0, 0); } }
            const float inv = 4.0f / sum;
#pragma unroll
            for (int db = 0; db < 4; ++db) *(unsigned*)(O8 + qrow * D + 64 * h + 16 * db + 4 * g) = pk4_fp8(sat8(o[db][0] * inv), sat8(o[db][1] * inv), sat8(o[db][2] * inv), sat8(o[db][3] * inv));
            __syncthreads();
#pragma unroll
            for (int i = 0; i < 2; ++i) if (i < nnew) { const int slot = (R0 + 9 + i) % 9; *(LAS u32x4*)(lds + klds + slot * 8192) = nk[i]; *(LAS u32x4*)(lds + vlds + slot * 128) = nv[i]; }
            R0 = R0n;
            __syncthreads();
        }
    }
}
#define XB_TMO      128
#define XB_XCNT(j)  (256  + 64 * (j))
#define XB_XSUB(j)  (1280 + 64 * (j))
#define XB_XGEN(j)  (2304 + 64 * (j))
#define XB_TOP      3328
#define XB_TOPGEN   3392
#define XCD_BAR_WORDS 3456
#define XB_LSUB(j)  (4096 + 64 * (j))
#define XB_LGEN(j)  (5120 + 64 * (j))
#define XB_SPIN_CAP (1u << 22)
__device__ __forceinline__ unsigned xb_ld(unsigned* p)              { return __hip_atomic_load(p, __ATOMIC_RELAXED, __HIP_MEMORY_SCOPE_AGENT); }
__device__ __forceinline__ unsigned xb_add(unsigned* p, unsigned v) { return __hip_atomic_fetch_add(p, v, __ATOMIC_RELAXED, __HIP_MEMORY_SCOPE_AGENT); }
__device__ __forceinline__ unsigned xb_xcc_id() { return (unsigned)__builtin_amdgcn_s_getreg((3 << 11) | 20) & 0xFu; }
#define XB_SPIN(cond, bar) do { unsigned _sp = 0; while (cond) { __builtin_amdgcn_s_sleep(1); \
    if ((++_sp & 255u) == 0u) { if (xb_ld(&(bar)[XB_TMO])) break; if (_sp > XB_SPIN_CAP) { atomicAdd(&(bar)[XB_TMO], 1u); break; } } } } while (0)
struct XcdBarrier { unsigned* bar; unsigned x; volatile LAS unsigned* st; };
__device__ __forceinline__ XcdBarrier xcd_barrier_post(unsigned* bar, volatile LAS unsigned* st) {
    XcdBarrier b; b.bar = bar; b.x = xb_xcc_id(); b.st = st;
    if (threadIdx.x == 0) st[2] = xb_add(&bar[XB_XCNT(b.x)], 1u);
    return b;
}
__device__ __forceinline__ void xcd_barrier_complete(unsigned* bar, unsigned x, unsigned& nloc, unsigned& nx) {
    const unsigned G = gridDim.x * gridDim.y * gridDim.z;
    unsigned sum, cnt, mine, sp = 0u;
    for (;;) {
        sum = 0u; cnt = 0u; mine = 0u;
#pragma unroll
        for (unsigned j = 0; j < 16; ++j) { const unsigned c = xb_ld(&bar[XB_XCNT(j)]); sum += c; cnt += (c > 0u) ? 1u : 0u; mine = (j == x) ? c : mine; }
        if (sum == G) break;
        __builtin_amdgcn_s_sleep(1);
        if ((++sp & 255u) == 0u) { if (xb_ld(&bar[XB_TMO])) break; if (sp > XB_SPIN_CAP) { atomicAdd(&bar[XB_TMO], 1u); break; } }
    }
    nloc = mine > 0u ? mine : 1u; nx = cnt > 0u ? cnt : 1u;
}
__device__ __forceinline__ void xcd_barrier(const XcdBarrier& b) {
    asm volatile("s_waitcnt vmcnt(0)" ::: "memory");
    __syncthreads();
    if (threadIdx.x == 0) {
        unsigned* bar = b.bar;
        __builtin_amdgcn_s_waitcnt(0);
        unsigned nloc = b.st[0], nx = b.st[1];
        if (nloc == 0u) { xcd_barrier_complete(bar, b.x, nloc, nx); b.st[0] = nloc; b.st[1] = nx; }
        const unsigned old = xb_add(&bar[XB_XSUB(b.x)], 1u);
        const unsigned gen = old / nloc;
        if (old + 1u == (gen + 1u) * nloc) {
            __builtin_amdgcn_fence(__ATOMIC_RELEASE, "agent");
            asm volatile("s_waitcnt vmcnt(0)" ::: "memory");
            const unsigned og = xb_add(&bar[XB_TOP], 1u);
            const unsigned tg = og / nx;
            if (og + 1u == (tg + 1u) * nx) xb_add(&bar[XB_TOPGEN], 1u);
            else XB_SPIN(xb_ld(&bar[XB_TOPGEN]) == tg, bar);
            __builtin_amdgcn_fence(__ATOMIC_ACQUIRE, "agent");
            xb_add(&bar[XB_XGEN(b.x)], 1u);
            asm volatile("s_waitcnt vmcnt(0)" ::: "memory");
        } else {
            XB_SPIN(xb_ld(&bar[XB_XGEN(b.x)]) == gen, bar);
            __builtin_amdgcn_fence(__ATOMIC_ACQUIRE, "agent");
            asm volatile("s_waitcnt vmcnt(0)" ::: "memory");
        }
    }
    __syncthreads();
}
__device__ __forceinline__ void xcd_local_barrier(const XcdBarrier& b) {
    asm volatile("s_waitcnt vmcnt(0)" ::: "memory");
    __syncthreads();
    if (threadIdx.x == 0) {
        unsigned* bar = b.bar;
        __builtin_amdgcn_s_waitcnt(0);
        const unsigned nloc = b.st[0];
        const unsigned old = xb_add(&bar[XB_LSUB(b.x)], 1u);
        const unsigned gen = old / nloc;
        if (old + 1u == (gen + 1u) * nloc) xb_add(&bar[XB_LGEN(b.x)], 1u);
        else XB_SPIN(xb_ld(&bar[XB_LGEN(b.x)]) == gen, bar);
        __builtin_amdgcn_fence(__ATOMIC_ACQUIRE, "agent");
        asm volatile("s_waitcnt vmcnt(0)" ::: "memory");
    }
    __syncthreads();
}
__device__ __forceinline__ int moe_prep(const Ctx& C, int layer) {
    LAS int* t = (LAS int*)(C.lds + pg8::TEXP_OFF); LAS int* first = (LAS int*)(C.lds + pg8::TOK_OFF); const int tid = fresh_tid();
    unsigned* gcnt = (unsigned*)(C.ws + WS_CTL + CT_BC) + layer * 32;
    if (tid < 32) first[64 + tid] = (int)((__hip_atomic_load(&gcnt[tid], __ATOMIC_RELAXED, __HIP_MEMORY_SCOPE_AGENT) + 255u) >> 8);
    __syncthreads();
    if (tid < 33) { int a = 0; for (int e = 0; e < tid; ++e) a += first[64 + e]; first[tid] = a; }
    __syncthreads();
    const int nM = first[32];
#pragma unroll
    for (int h = 0; h < 2; ++h) { const int pm = tid + 512 * h; int e = 0;
#pragma unroll
        for (int q = 1; q < 32; ++q) e += (first[q] <= pm) ? 1 : 0;
        t[pm] = pm < nM ? (e | ((pm - first[e]) << 8)) : 0; }
    __syncthreads();
    return __builtin_amdgcn_readfirstlane(nM);
}
constexpr size_t CT_BAR = 131072;
constexpr int LDS_BARST = LDS_BYTES - 64;

constexpr int N_PHASES = 20;
__global__ void __launch_bounds__(NTHREADS, 2) hybrid_fwd(Params P) {
    extern __shared__ __attribute__((aligned(16))) unsigned char smem[];
    cg::grid_group grid = cg::this_grid();
    Ctx C; C.lds = (LAS unsigned char*)smem; C.G = gridDim.x; C.bid = blockIdx.x;
    C.ws = P.ws; C.in = P.in; C.out = P.out;
    unsigned char* const ws0 = P.ws;
#define ws fresh_ws(ws0)
    const int lo = P.ph_lo, hi = P.ph_hi;
#ifndef PH_MASK
#define PH_MASK 0xFFFFFFFFu
#endif
#define IN(k) (((PH_MASK >> (k)) & 1u) && lo <= (k) && (k) < hi)
#ifndef REPEAT_MASK
#define REPEAT_MASK 0u
#endif
#define REPS(k) ((((unsigned)REPEAT_MASK >> (k)) & 1u) ? 2 : 1)
#ifndef N_CG_SYNCS
#define N_CG_SYNCS 0
#endif
#ifndef LOCAL_SEAM_MASK
#define LOCAL_SEAM_MASK 0x3C3Eu
#endif
#define SEAM(k) do { if (IN(k)) { if ((k) < N_CG_SYNCS) grid.sync(); else if (((LOCAL_SEAM_MASK >> (k)) & 1u) && loc) xcd_local_barrier(bar); else xcd_barrier(bar); } } while (0)
    if (threadIdx.x < 16) ((LAS unsigned*)(smem + LDS_BARST))[threadIdx.x] = 0u;
    __syncthreads();
    const XcdBarrier bar = xcd_barrier_post((unsigned*)(ws + WS_CTL + CT_BAR), (volatile LAS unsigned*)(smem + LDS_BARST));
    C.gc = C.bid;
    C.gs = C.G >= 8 ? C.G / 8 : 1; C.vx = C.bid / C.gs; C.vr = C.bid % C.gs;
    bool loc = false;
    #define PH_BODY_0 phase_convert(C);
    if (IN(0)) { PH_BODY_0 } if (REPS(0) > 1 && IN(0)) { xcd_barrier(bar); PH_BODY_0 }
    SEAM(0);
    if (IN(0) && IN(1)) {
        unsigned* barw = (unsigned*)(ws + WS_CTL + CT_BAR); bool eq = (C.G % 8) == 0;
#pragma unroll
        for (int j = 0; j < 16; ++j) { const unsigned cj = xb_ld(&barw[XB_XCNT(j)]); eq = eq && (cj == (j < 8 ? (unsigned)(C.G / 8) : 0u)); }
        const unsigned rank = ((volatile LAS unsigned*)(smem + LDS_BARST))[2];
        C.gc = __builtin_amdgcn_readfirstlane(eq ? (int)(rank * 8u + bar.x) : C.bid);
        if (__builtin_amdgcn_readfirstlane((int)eq)) { C.vx = __builtin_amdgcn_readfirstlane((int)bar.x); C.vr = __builtin_amdgcn_readfirstlane((int)rank); loc = true; }
    }
    #define PH_BODY_1 { DenseSched S{(unsigned)WS_HB, (unsigned)WS_WIN, 1024, 1024, 8, C.gs, C.vr, C.vx}; EpiWin E{(bf16_t*)(ws + WS_XR), (bf16_t*)(ws + WS_GY)}; \
        pg8::gemm_phase<false, false>(C.lds, ws, 1024, 1024, 1024, S, E); mini_win(C); }
    if (IN(1)) { PH_BODY_1 } if (REPS(1) > 1 && IN(1)) { xcd_barrier(bar); PH_BODY_1 }
    SEAM(1);
    #define PH_BODY_2 phase_conv(C);
    if (IN(2)) { PH_BODY_2 } if (REPS(2) > 1 && IN(2)) { xcd_barrier(bar); PH_BODY_2 }
    SEAM(2);
    #define PH_BODY_3 { GateSched S{(unsigned)WS_XC, (unsigned)WS_GATE, C.gs, C.vr, C.vx}; \
        EpiGate E{(const bf16_t*)(ws + WS_XC), (unsigned char*)(ws + WS_LA), (const float*)(ws + WS_CTL + CT_SPL), (unsigned)WS_GBIAS}; \
        pg8::gemm_phase<false, false>(C.lds, ws, 256, 1024, 256, S, E); mini_gate(C); }
    if (IN(3)) { PH_BODY_3 } if (REPS(3) > 1 && IN(3)) { xcd_barrier(bar); PH_BODY_3 }
    SEAM(3);
    #define PH_BODY_4 phase_scan(C);
    if (IN(4)) { PH_BODY_4 } if (REPS(4) > 1 && IN(4)) { xcd_barrier(bar); PH_BODY_4 }
    SEAM(4);
    #define PH_BODY_5 { DenseSched S{(unsigned)WS_BB, (unsigned)WS_LOUT8, 512, 512, 4, C.gs, C.vr, C.vx}; EpiRes<true> E{(bf16_t*)(ws + WS_PRE), P.in[I_X], P.in[I_META], nullptr, NTOK}; \
        pg8::gemm_phase<true, false>(C.lds, ws, 512, 512, 512, S, E); mini_lout(C); }
    if (IN(5)) { PH_BODY_5 } if (REPS(5) > 1 && IN(5)) { xcd_barrier(bar); PH_BODY_5 }
    SEAM(5);
    #define PH_BODY_6 phase_lnr(C, 0, NTOK);
    if (IN(6)) { PH_BODY_6 } if (REPS(6) > 1 && IN(6)) { xcd_barrier(bar); PH_BODY_6 }
    SEAM(6);
    #define PH_BODY_8 { const int nM = moe_prep(C, 0); \
        MoeSched S{(unsigned)WS_HB8, (unsigned)WS_WGU, (unsigned)WS_TOK2, (const LAS int*)(C.lds + pg8::TEXP_OFF), 2048u * 1024u, nM, 8, C.G, C.gc}; EpiGlu E{(unsigned char*)(ws + WS_ACT), (unsigned)WS_BIAS}; \
        pg8::gemm_phase<true, true>(C.lds, ws, 512, 512, 512, S, E); }
    if (IN(8)) { PH_BODY_8 } if (REPS(8) > 1 && IN(8)) { xcd_barrier(bar); PH_BODY_8 }
    SEAM(8);
    #define PH_BODY_9 { const int nM = moe_prep(C, 0); \
        MoeSched S{(unsigned)WS_ACT, (unsigned)WS_WD, 0u, (const LAS int*)(C.lds + pg8::TEXP_OFF), 1024u * 1024u, nM, 4, C.G, C.gc}; EpiDown E{(unsigned char*)(ws + WS_YS), (unsigned)WS_BD}; \
        pg8::gemm_phase<true, false>(C.lds, ws, 512, 512, 512, S, E); }
    if (IN(9)) { PH_BODY_9 } if (REPS(9) > 1 && IN(9)) { xcd_barrier(bar); PH_BODY_9 }
    SEAM(9);
    #define PH_BODY_10 phase_combine(C, 0, NTOK, false);
    if (IN(10)) { PH_BODY_10 } if (REPS(10) > 1 && IN(10)) { xcd_barrier(bar); PH_BODY_10 }
    SEAM(10);
    #define PH_BODY_11 { QkvSched S{(unsigned)WS_HB8, (unsigned)WS_QKV8, C.gs, C.vr, C.vx}; EpiQkv E{(bf16_t*)(ws + WS_Q), (bf16_t*)(ws + WS_K), (bf16_t*)(ws + WS_VT)}; \
        pg8::gemm_phase<true, false>(C.lds, ws, 512, 512, 512, S, E); mini_kv(C); }
    if (IN(11)) { PH_BODY_11 } if (REPS(11) > 1 && IN(11)) { xcd_barrier(bar); PH_BODY_11 }
    SEAM(11);
    #define PH_BODY_12 phase_attn(C);
    if (IN(12)) { PH_BODY_12 } if (REPS(12) > 1 && IN(12)) { xcd_barrier(bar); PH_BODY_12 }
    SEAM(12);
    #define PH_BODY_13 { DenseSched S{(unsigned)WS_O, (unsigned)WS_NOUT, 512, 512, 4, C.gs, C.vr, C.vx}; EpiRes<false> E{(bf16_t*)(ws + WS_PRE), nullptr, nullptr, (const bf16_t*)(ws + WS_HB), NGRID}; \
        pg8::gemm_phase<true, false>(C.lds, ws, 512, 512, 512, S, E); }
    if (IN(13)) { PH_BODY_13 } if (REPS(13) > 1 && IN(13)) { xcd_barrier(bar); PH_BODY_13 }
    SEAM(13);
    #define PH_BODY_14 phase_lnr(C, 1, NGRID);
    if (IN(14)) { PH_BODY_14 } if (REPS(14) > 1 && IN(14)) { xcd_barrier(bar); PH_BODY_14 }
    SEAM(14);

    #define PH_BODY_16 { const int nM = moe_prep(C, 1); \
        MoeSched S{(unsigned)WS_HB8, (unsigned)(WS_WGU + (size_t)32 * 2048 * 1024), (unsigned)(WS_TOK2 + (size_t)32 * TCAP * 4), (const LAS int*)(C.lds + pg8::TEXP_OFF), 2048u * 1024u, nM, 8, C.G, C.gc}; EpiGlu E{(unsigned char*)(ws + WS_ACT), (unsigned)(WS_BIAS + 32 * 2048 * 4)}; \
        pg8::gemm_phase<true, true>(C.lds, ws, 512, 512, 512, S, E); }
    if (IN(16)) { PH_BODY_16 } if (REPS(16) > 1 && IN(16)) { xcd_barrier(bar); PH_BODY_16 }
    SEAM(16);
    #define PH_BODY_17 { const int nM = moe_prep(C, 1); \
        MoeSched S{(unsigned)WS_ACT, (unsigned)(WS_WD + (size_t)32 * 1024 * 1024), 0u, (const LAS int*)(C.lds + pg8::TEXP_OFF), 1024u * 1024u, nM, 4, C.G, C.gc}; EpiDown E{(unsigned char*)(ws + WS_YS), (unsigned)(WS_BD + 32 * 1024 * 4)}; \
        pg8::gemm_phase<true, false>(C.lds, ws, 512, 512, 512, S, E); }
    if (IN(17)) { PH_BODY_17 } if (REPS(17) > 1 && IN(17)) { xcd_barrier(bar); PH_BODY_17 }
    SEAM(17);
    #define PH_BODY_18 phase_combine(C, 1, NGRID, true);
    if (IN(18)) { PH_BODY_18 } if (REPS(18) > 1 && IN(18)) { xcd_barrier(bar); PH_BODY_18 }
#undef ws
#undef IN
#undef SEAM
}

#ifndef MK_PER_PHASE
#define MK_PER_PHASE 0
#endif
extern "C" void kernel_launch(void* const* d_in, const int* in_sizes, int n_in, void* d_out, int out_size, void* d_ws, size_t ws_size, hipStream_t stream) {
    static int grid = 0;
    if (grid == 0) {
        if (n_in != 25 || ws_size < WS_END || out_size != NGRID * D) { fprintf(stderr, "kernel_launch: unexpected problem (n_in %d, ws %zu, out %d)\n", n_in, ws_size, out_size); grid = -1; return; }
        int dev = 0, cus = 0, per_cu = 0;
        if (hipGetDevice(&dev) != hipSuccess || hipDeviceGetAttribute(&cus, hipDeviceAttributeMultiprocessorCount, dev) != hipSuccess) { grid = -1; return; }
        if (hipFuncSetAttribute((const void*)hybrid_fwd, hipFuncAttributeMaxDynamicSharedMemorySize, LDS_BYTES) != hipSuccess) { fprintf(stderr, "kernel_launch: hipFuncSetAttribute failed\n"); grid = -1; return; }
        if (hipOccupancyMaxActiveBlocksPerMultiprocessor(&per_cu, (const void*)hybrid_fwd, NTHREADS, LDS_BYTES) != hipSuccess || per_cu < 1) { fprintf(stderr, "kernel_launch: occupancy query failed (%d)\n", per_cu); grid = -1; return; }
        grid = cus * 1;
        if (grid > 256) grid = 256;
    }
    if (grid < 0) return;
    if (hipMemsetAsync((char*)d_ws + WS_CTL + CT_BAR, 0, 32768, stream) != hipSuccess) { fprintf(stderr, "kernel_launch: memset failed\n"); return; }
    Params p{};
    for (int i = 0; i < 25; ++i) p.in[i] = (const float*)d_in[i];
    p.out = (float*)d_out; p.ws = (unsigned char*)d_ws;
#if MK_PER_PHASE
    for (int ph = 0; ph < 19; ++ph) { p.ph_lo = ph; p.ph_hi = ph + 1; void* args[] = {&p};
        hipError_t e = hipLaunchCooperativeKernel((void*)hybrid_fwd, dim3(grid), dim3(NTHREADS), args, LDS_BYTES, stream);
        if (e != hipSuccess) { fprintf(stderr, "launch phase %d failed: %s\n", ph, hipGetErrorString(e)); break; } }
#else
    p.ph_lo = 0; p.ph_hi = 19; void* args[] = {&p};
    hipError_t e = hipLaunchCooperativeKernel((void*)hybrid_fwd, dim3(grid), dim3(NTHREADS), args, LDS_BYTES, stream);
    if (e != hipSuccess) fprintf(stderr, "cooperative launch failed: %s (grid %d)\n", hipGetErrorString(e), grid);
#endif
}
```

```cpp
#include <hip/hip_runtime.h>
#include <hip/hip_cooperative_groups.h>
#include <cstdio>
#include <cstdint>
namespace cg = cooperative_groups;

#define LAS __attribute__((address_space(3)))
typedef unsigned short bf16_t;
typedef short bf16x8 __attribute__((ext_vector_type(8)));
typedef float f32x4 __attribute__((ext_vector_type(4)));
typedef float f32x2 __attribute__((ext_vector_type(2)));
typedef unsigned u32x4 __attribute__((ext_vector_type(4)));
typedef unsigned u32x2 __attribute__((ext_vector_type(2)));

constexpr int NB = 8, SEQ = 4096, D = 1024, NMETA = 16, LSEQ = SEQ + NMETA;
constexpr int NGRID = NB * SEQ;
constexpr int NTOK = NGRID + NB * NMETA;
constexpr int MPAD = 33024;
constexpr int NEXP = 32, TOPK = 4;
constexpr int PMAX = 139776;
constexpr int MTMAX = PMAX / 256;
constexpr float DN_ALPHA = 1.41421356237f;
constexpr float LN_EPS = 1e-5f;
constexpr int NTHREADS = 512, NWAVES = 8;

constexpr size_t MiB = 1u << 20;
constexpr size_t ACT_BYTES = (size_t)MPAD * D * 2;
constexpr size_t WS_CTL   = 0;
constexpr size_t WS_WIN   = 4 * MiB;
constexpr size_t WS_GATE  = WS_WIN + 4 * MiB;
constexpr size_t WS_LOUT  = WS_GATE + 2 * MiB;
constexpr size_t WS_QKV   = WS_LOUT + 2 * MiB;
constexpr size_t WS_NOUT  = WS_QKV + 6 * MiB;
constexpr size_t WS_WGU   = WS_NOUT + 2 * MiB;
constexpr size_t WS_WD    = WS_WGU + 128 * MiB;
constexpr size_t WS_HB    = WS_WD + 64 * MiB;
constexpr size_t WS_HB8   = WS_HB + 65 * MiB;
constexpr size_t WS_PRE   = WS_HB8 + 33 * MiB;
constexpr size_t WS_H     = WS_PRE + 129 * MiB;
constexpr size_t WS_WIN8  = WS_H;
constexpr size_t WS_SCR   = WS_H + 129 * MiB;
constexpr size_t WS_XR = WS_SCR, WS_XC = WS_XR + 65 * MiB, WS_GY = WS_XC + 65 * MiB, WS_LA = WS_GY + 65 * MiB, WS_BB = WS_LA + 130 * MiB, WS_HF = WS_BB + 130 * MiB, WS_G = WS_HF + 65 * MiB;
constexpr size_t WS_SCR_END0 = WS_G + 65 * MiB;
constexpr size_t WS_XS = WS_SCR, WS_ACT = WS_XS + 137 * MiB, WS_YS = WS_ACT + 137 * MiB;
constexpr size_t WS_SCR_END1 = WS_YS + 274 * MiB;
constexpr size_t WS_Q = WS_SCR, WS_K = WS_Q + 65 * MiB, WS_VT = WS_K + 65 * MiB, WS_O = WS_VT + 65 * MiB;
constexpr size_t WS_BIAS = (WS_SCR_END0 > WS_SCR_END1 ? WS_SCR_END0 : WS_SCR_END1);
constexpr size_t WS_BD = WS_BIAS + 2 * 32 * 2048 * 4;
constexpr size_t WS_GBIAS = WS_BD + 2 * 32 * 1024 * 4;
constexpr size_t WS_TOK = WS_BIAS + 1 * MiB;
constexpr size_t WS_QKV8 = WS_TOK + 2 * MiB;
constexpr int TCAP = MPAD;
constexpr size_t WS_TOK2 = WS_QKV8 + 3 * MiB;
constexpr size_t WS_LOUT8 = WS_TOK2 + 9 * MiB;
constexpr size_t WS_RWT = WS_LOUT8 + 1 * MiB;
constexpr size_t WS_END = WS_RWT + 1 * MiB;
static_assert((size_t)2 * 32 * TCAP * 4 <= 9 * MiB, "token offset tables");
static_assert(ACT_BYTES <= 65 * MiB && (size_t)PMAX * D * 2 <= 274 * MiB && (size_t)PMAX * D <= 137 * MiB && (size_t)MPAD * D <= 33 * MiB && (size_t)MPAD * D * 4 <= 129 * MiB, "ws map");
static_assert(WS_END <= (size_t)2040 * MiB, "ws map must fit 4x the largest input tensor");
constexpr size_t CT_BC      = 4096;
constexpr size_t CT_TEXP    = CT_BC + 2 * 256 * 32 * 4;
constexpr size_t CT_SPL     = CT_TEXP + 2 * 1024 * 4;
constexpr size_t CT_EID     = 256 * 1024;
constexpr size_t CT_GATEV   = CT_EID + 2 * (size_t)NTOK * 4 * 4;
constexpr size_t CT_POS     = CT_GATEV + 2 * (size_t)NTOK * 4 * 4;
static_assert(CT_POS + 2 * (size_t)NTOK * 4 * 4 <= 4 * MiB, "ctl map");

constexpr int LDS_BYTES = 155648;

__device__ __forceinline__ unsigned f2bf(float f) { unsigned u = __builtin_bit_cast(unsigned, f); return (u + 0x7fffu + ((u >> 16) & 1u)) >> 16; }
__device__ __forceinline__ unsigned cvt_pk_bf16(float lo, float hi);
__device__ __forceinline__ unsigned pk2(float lo, float hi) { return cvt_pk_bf16(lo, hi); }
typedef __bf16 bf16x2_t __attribute__((ext_vector_type(2)));
__device__ __forceinline__ unsigned cvt_pk_bf16(float lo, float hi) { const f32x2 v = {lo, hi}; return __builtin_bit_cast(unsigned, __builtin_convertvector(v, bf16x2_t)); }
__device__ __forceinline__ u32x4 widen16(const u32x2 a, const u32x2 b) {
    const auto rx = __builtin_amdgcn_permlane16_swap(a.x, b.x, false, false), ry = __builtin_amdgcn_permlane16_swap(a.y, b.y, false, false);
    u32x4 o; o.x = rx[0]; o.y = ry[0]; o.z = rx[1]; o.w = ry[1]; return o;
}
__device__ __forceinline__ float quad16_max(float v) {
    const unsigned b = __float_as_uint(v); const auto p = __builtin_amdgcn_permlane16_swap(b, b, false, false);
    const float m = fmaxf(__uint_as_float(p[0]), __uint_as_float(p[1])); const unsigned c = __float_as_uint(m); const auto q = __builtin_amdgcn_permlane32_swap(c, c, false, false);
    return fmaxf(__uint_as_float(q[0]), __uint_as_float(q[1]));
}
__device__ __forceinline__ float quad16_sum(float v) {
    const unsigned b = __float_as_uint(v); const auto p = __builtin_amdgcn_permlane16_swap(b, b, false, false);
    const float m = __uint_as_float(p[0]) + __uint_as_float(p[1]); const unsigned c = __float_as_uint(m); const auto q = __builtin_amdgcn_permlane32_swap(c, c, false, false);
    return __uint_as_float(q[0]) + __uint_as_float(q[1]);
}
__device__ __forceinline__ float sat8(float v) { return __builtin_amdgcn_fmed3f(v, -448.0f, 448.0f); }
__device__ __forceinline__ unsigned pk4_fp8(float a, float b, float c, float d) { int w = __builtin_amdgcn_cvt_pk_fp8_f32(a, b, 0, false); w = __builtin_amdgcn_cvt_pk_fp8_f32(c, d, w, true); return (unsigned)w; }
__device__ __forceinline__ float dot2_bf16(unsigned a, unsigned b, float c) { return __builtin_amdgcn_fdot2_f32_bf16(__builtin_bit_cast(bf16x2_t, a), __builtin_bit_cast(bf16x2_t, b), c, false); }
__device__ __forceinline__ void unpack8_fp8(const u32x2 w, float (&o)[8]) { const f32x2 a = __builtin_amdgcn_cvt_pk_f32_fp8((int)w.x, false), b = __builtin_amdgcn_cvt_pk_f32_fp8((int)w.x, true), c = __builtin_amdgcn_cvt_pk_f32_fp8((int)w.y, false), d = __builtin_amdgcn_cvt_pk_f32_fp8((int)w.y, true);
    o[0] = a.x; o[1] = a.y; o[2] = b.x; o[3] = b.y; o[4] = c.x; o[5] = c.y; o[6] = d.x; o[7] = d.y; }
__device__ __forceinline__ float bflo(unsigned w) { return __builtin_bit_cast(float, w << 16); }
__device__ __forceinline__ float bfhi(unsigned w) { return __builtin_bit_cast(float, w & 0xffff0000u); }
__device__ __forceinline__ void unpack8(const u32x4 w, float (&o)[8]);
__device__ __forceinline__ float fast_exp2(float x) { return __builtin_amdgcn_exp2f(x); }
__device__ __forceinline__ float fast_rcp(float x) { return __builtin_amdgcn_rcpf(x); }
__device__ __forceinline__ float sigmoidf_(float x) { return fast_rcp(1.0f + fast_exp2(-1.44269504089f * x)); }
__device__ __forceinline__ float wave_sum(float v) {
#pragma unroll
    for (int o = 1; o < 64; o <<= 1) v += __shfl_xor(v, o);
    return v;
}
template <int CTRL> __device__ __forceinline__ float dpp_movf(float v) { return __builtin_bit_cast(float, __builtin_amdgcn_update_dpp(0, __builtin_bit_cast(int, v), CTRL, 0xf, 0xf, true)); }
__device__ __forceinline__ float readlane_f(float v, int l) { return __builtin_bit_cast(float, __builtin_amdgcn_readlane(__builtin_bit_cast(int, v), l)); }
__device__ __forceinline__ float wave_sum_dpp(float v) {
    v += dpp_movf<0xB1>(v);
    v += dpp_movf<0x4E>(v);
    v += dpp_movf<0x141>(v);
    v += dpp_movf<0x140>(v);
    return (readlane_f(v, 0) + readlane_f(v, 16)) + (readlane_f(v, 32) + readlane_f(v, 48));
}
__device__ __forceinline__ float half_sum_dpp(float v, int hf) {
    v += dpp_movf<0xB1>(v); v += dpp_movf<0x4E>(v); v += dpp_movf<0x141>(v); v += dpp_movf<0x140>(v);
    const float lo = readlane_f(v, 0) + readlane_f(v, 16), hi = readlane_f(v, 32) + readlane_f(v, 48);
    return hf ? hi : lo;
}
__device__ __forceinline__ float half_max_dpp(float v, int hf) {
    v = fmaxf(v, dpp_movf<0xB1>(v)); v = fmaxf(v, dpp_movf<0x4E>(v)); v = fmaxf(v, dpp_movf<0x141>(v)); v = fmaxf(v, dpp_movf<0x140>(v));
    const float lo = fmaxf(readlane_f(v, 0), readlane_f(v, 16)), hi = fmaxf(readlane_f(v, 32), readlane_f(v, 48));
    return hf ? hi : lo;
}
__device__ __forceinline__ float wave_max_dpp(float v) {
    v = fmaxf(v, dpp_movf<0xB1>(v)); v = fmaxf(v, dpp_movf<0x4E>(v)); v = fmaxf(v, dpp_movf<0x141>(v)); v = fmaxf(v, dpp_movf<0x140>(v));
    return fmaxf(fmaxf(readlane_f(v, 0), readlane_f(v, 16)), fmaxf(readlane_f(v, 32), readlane_f(v, 48)));
}
__device__ __forceinline__ int seqrow(int b, int s) { return s < NMETA ? NGRID + NMETA * b + s : SEQ * b + (s - NMETA); }
__device__ __forceinline__ int batch_row(int b, int lr) { return lr < SEQ ? b * SEQ + lr : NGRID + 16 * b + (lr - SEQ); }

struct Params {
    const float* in[25];
    float* out;
    unsigned char* ws;
    int ph_lo, ph_hi;
};
struct Ctx {
    LAS unsigned char* lds;
    int G, bid, gc;
    int vx, vr, gs;
    unsigned char* ws;
    const float* const* in;
    float* out;
};
__device__ __forceinline__ int fresh_tid() { int t = threadIdx.x; asm volatile("" : "+v"(t)); return t; }
#define GAS __attribute__((address_space(1)))
__device__ __forceinline__ unsigned char* fresh_ws(unsigned char* p) { unsigned long long v = (unsigned long long)p; asm volatile("" : "+s"(v)); return (unsigned char*)(GAS unsigned char*)v; }
__device__ __forceinline__ const float* gin(const float* p) { return (const float*)(const GAS float*)(unsigned long long)p; }
__device__ __forceinline__ float* gout(float* p) { return (float*)(GAS float*)(unsigned long long)p; }
__device__ __forceinline__ __amdgpu_buffer_rsrc_t wt_rsrc(const void* base) { return __builtin_amdgcn_make_buffer_rsrc((void*)base, 0, 0xFFFFFFFF, 0x00020000); }
__device__ __forceinline__ void wt_store16(__amdgpu_buffer_rsrc_t r, unsigned off, u32x4 v) { __builtin_amdgcn_raw_buffer_store_b128(v, r, (int)off, 0, 16); }
__device__ __forceinline__ void wt_store8(__amdgpu_buffer_rsrc_t r, unsigned off, u32x2 v) { __builtin_amdgcn_raw_buffer_store_b64(v, r, (int)off, 0, 16); }
__device__ __forceinline__ void wt_store4(__amdgpu_buffer_rsrc_t r, unsigned off, unsigned v) { __builtin_amdgcn_raw_buffer_store_b32(v, r, (int)off, 0, 16); }
#define PHASE_IDS unsigned char* const wsl = fresh_ws(C.ws); (void)wsl; const int tid = fresh_tid(); const int lane = tid & 63; const int wave = __builtin_amdgcn_readfirstlane(tid >> 6); (void)lane; (void)wave;
enum { I_X = 0, I_META, I_WIN, I_CONVW, I_CONVB, I_WA, I_BA, I_WX, I_BX, I_LAM, I_LOUT, I_WQKV, I_RPB, I_MBIAS, I_NOUT, I_LNMG, I_LNMB, I_RW, I_RB, I_WGU, I_BGU, I_WD, I_BD, I_LNFG, I_LNFB };

namespace pg8 {
constexpr int BM = 256, BK = 64, HALF = 128, HTB = HALF * BK * 2, STAGE_BYTES = 8 * HTB, NXCD = 8, WGM = 8;
constexpr int SIDE_OFF = STAGE_BYTES, TEXP_OFF = STAGE_BYTES + 2048, TOK_OFF = STAGE_BYTES + 2048 + 4096;
__device__ __forceinline__ int lds_byte(int r, int c) { const int st = (r >> 4) * 2 + (c >> 5), rr = r & 15, cc = c & 31, ob = rr * 64 + cc * 2; return st * 1024 + (ob ^ (((ob >> 9) & 1) << 5)); }
__device__ __forceinline__ void stage_rc(int b, int& R, int& C) { const int st = b / 1024, sb = b % 1024, swz = sb ^ (((sb >> 9) & 1) << 5); R = (st >> 1) * 16 + swz / 64; C = (st & 1) * 32 + (swz % 64) / 2; }
__device__ __forceinline__ int perm32(int rho) { const int n = rho >> 4, i = rho & 15; return 8 * (i >> 2) + 4 * n + (i & 3); }

typedef int v8i __attribute__((ext_vector_type(8)));
typedef int v4i __attribute__((ext_vector_type(4)));
__device__ __forceinline__ v8i cat8(bf16x8 a, bf16x8 b) { const v4i x = __builtin_bit_cast(v4i, a), y = __builtin_bit_cast(v4i, b); return __builtin_shufflevector(x, y, 0, 1, 2, 3, 4, 5, 6, 7); }
struct Unit { unsigned ao, bo, to; int pm, pn, aux; };

__device__ __forceinline__ void tile_of(int L, int nM, int nN, int& pm, int& pn) {
    const int nwg = nM * nN; int wgid = L;
    { const int q = nwg / NXCD, r = nwg % NXCD, xcd = wgid % NXCD, off = wgid / NXCD; wgid = (xcd < r ? xcd * (q + 1) : r * (q + 1) + (xcd - r) * q) + off; }
    const int nig = WGM * nN, gid = wgid / nig, fm = gid * WGM, gsz = (nM - fm) < WGM ? (nM - fm) : WGM;
    pm = fm + ((wgid % nig) % gsz); pn = (wgid % nig) / gsz;
}

template <bool F8, bool GATHER, class Epi, class Sched>
__device__ __forceinline__ void gemm_phase(LAS unsigned char* lds, const unsigned char* wsbase, const int K, const int lda, const int ldb, const Sched& S, const Epi& E) {
    const __amdgpu_buffer_rsrc_t rsrc = __builtin_amdgcn_make_buffer_rsrc((void*)wsbase, 0, 0xFFFFFFFF, 0x00020000);
    const int tid = fresh_tid(), wid = __builtin_amdgcn_readfirstlane(tid >> 6), lane = tid & 63, wr = wid >> 2, wc = wid & 3;
    const int nt = K / BK;
    int f8scales = 0; if constexpr (F8) { f8scales = Epi::SCALES; asm volatile("" : "+v"(f8scales)); }
    int voffA, voffB;
    { int R, C; stage_rc(tid * 16, R, C); const int Rb = Epi::PERM ? ((R & ~31) + perm32(R & 31)) : R; voffA = ((GATHER ? 0 : R * lda) + C) * 2; voffB = (Rb * ldb + C) * 2; }
    const int tokb = (16 * (wid >> 1) + (lane >> 2)) * 4;
    const unsigned kstep = (unsigned)(BK * 2);
    const unsigned hstepA = (unsigned)HALF * lda * 2, hstepB = (unsigned)HALF * ldb * 2;
    const unsigned ldsw = (unsigned)wid * 1024u;
    const int aoff = lds_byte(wr * 64 + (lane & 15), (lane >> 4) * 8), boff = lds_byte(wc * 32 + (lane & 15), (lane >> 4) * 8);
#define PG8_SA(b, h) (((b) * 2 + (h)) * HTB)
#define PG8_SB(b, h) ((4 + (b) * 2 + (h)) * HTB)
#define PG8_STAGE(bufoff, gbase, voff) do { _Pragma("unroll") for (int _i = 0; _i < 2; ++_i) \
        __builtin_amdgcn_raw_ptr_buffer_load_lds(rsrc, (LAS void*)(lds + (bufoff) + ldsl + _i * 8192), 16, voff, __builtin_amdgcn_readfirstlane((int)((gbase) + (unsigned)_i * (hstep##voff >> 1))), 0, 0); } while (0)
#define hstepvoffA hstepA
#define hstepvoffB hstepB
#define PG8_STAGE_A(bufoff, aoffs, h, par) do { if constexpr (GATHER) { _Pragma("unroll") for (int _i = 0; _i < 2; ++_i) { \
            const int _tk = *(const LAS int*)(lds + TOK_OFF + (par) * 1024 + tokb + ((h) * 128 + _i * 64) * 4); \
            __builtin_amdgcn_raw_ptr_buffer_load_lds(rsrc, (LAS void*)(lds + (bufoff) + ldsl + _i * 8192), 16, _tk + voffA, __builtin_amdgcn_readfirstlane((int)(aoffs)), 0, 0); } } \
        else { PG8_STAGE(bufoff, (aoffs) + (unsigned)(h) * hstepA, voffA); } } while (0)
#define PG8_TKLD(h, par) const int _tk0 = GATHER ? *(const LAS int*)(lds + TOK_OFF + (par) * 1024 + tokb + (h) * 512) : 0, _tk1 = GATHER ? *(const LAS int*)(lds + TOK_OFF + (par) * 1024 + tokb + (h) * 512 + 256) : 0
#define PG8_STAGE_AT(bufoff, aoffs, h) do { if constexpr (GATHER) { \
            __builtin_amdgcn_raw_ptr_buffer_load_lds(rsrc, (LAS void*)(lds + (bufoff) + ldsl), 16, _tk0 + voffA, __builtin_amdgcn_readfirstlane((int)(aoffs)), 0, 0); \
            __builtin_amdgcn_raw_ptr_buffer_load_lds(rsrc, (LAS void*)(lds + (bufoff) + ldsl + 8192), 16, _tk1 + voffA, __builtin_amdgcn_readfirstlane((int)(aoffs)), 0, 0); } \
        else { PG8_STAGE(bufoff, (aoffs) + (unsigned)(h) * hstepA, voffA); } } while (0)
#define PG8_TOK(unit, par) do { if constexpr (GATHER) { if (wid == 0) __builtin_amdgcn_raw_ptr_buffer_load_lds(rsrc, (LAS void*)(lds + TOK_OFF + (par) * 1024), 16, lane * 16, (int)(unit).to, 0, 0); } } while (0)
#define PG8_LDA(dst, b, h) do { _Pragma("unroll") for (int m = 0; m < 4; ++m) _Pragma("unroll") for (int k = 0; k < 2; ++k) dst[m][k] = *(const LAS bf16x8*)(lds + PG8_SA(b, h) + aoff + m * 2048 + k * 1024); } while (0)
#define PG8_LDB(dst, b, h) do { _Pragma("unroll") for (int n = 0; n < 2; ++n) _Pragma("unroll") for (int k = 0; k < 2; ++k) dst[n][k] = *(const LAS bf16x8*)(lds + PG8_SB(b, h) + boff + n * 2048 + k * 1024); } while (0)
#define PG8_MMA(ai, bj, At, Bt) do { __builtin_amdgcn_s_setprio(1); _Pragma("unroll") for (int m = 0; m < 4; ++m) _Pragma("unroll") for (int n = 0; n < 2; ++n) { \
        if constexpr (F8) { asm volatile("v_mfma_scale_f32_16x16x128_f8f6f4 %0, %1, %2, %0, %3, %3 op_sel:[0,1,0] op_sel_hi:[0,0,0]" : "+v"(acc[ai][bj][m][n]) : "v"(cat8(Bt[n][0], Bt[n][1])), "v"(cat8(At[m][0], At[m][1])), "v"(f8scales)); } \
        else { _Pragma("unroll") for (int k = 0; k < 2; ++k) acc[ai][bj][m][n] = __builtin_amdgcn_mfma_f32_16x16x32_bf16(Bt[n][k], At[m][k], acc[ai][bj][m][n], 0, 0, 0); } } \
        __builtin_amdgcn_s_setprio(0); } while (0)
#define PG8_WAIT_V(n) asm volatile("s_waitcnt vmcnt(" #n ")" ::: "memory")
#define PG8_WAIT_L(n) asm volatile("s_waitcnt lgkmcnt(" #n ")" ::: "memory")
#define PG8_BAR __builtin_amdgcn_s_barrier()
#define PG8_SCHED __builtin_amdgcn_sched_barrier(0)
    Unit cur, nxt; int ui = 0;
    if (!S.next(0, cur)) return;
    f32x4 acc[2][2][4][2];
    bf16x8 At[4][2], B0[2][2], B1[2][2];
#define PG8_INIT(par) do { if constexpr (Epi::SIDE) { const int _l = fresh_tid() & 63; E.init(acc, (const LAS float*)(lds + SIDE_OFF + (par) * 1024), wc, _l >> 4); } \
        else { _Pragma("unroll") for (int a = 0; a < 2; ++a) _Pragma("unroll") for (int b = 0; b < 2; ++b) _Pragma("unroll") for (int m = 0; m < 4; ++m) _Pragma("unroll") for (int n = 0; n < 2; ++n) acc[a][b][m][n] = (f32x4){0.f, 0.f, 0.f, 0.f}; } } while (0)
    unsigned cA = cur.ao, cB = cur.bo;
    unsigned ldsl = ldsw; asm volatile("" : "+s"(ldsl));
#define PG8_SIDE(unit, par) do { if constexpr (Epi::SIDE) { if (wid == 0) __builtin_amdgcn_raw_ptr_buffer_load_lds(rsrc, (LAS void*)(lds + SIDE_OFF + (par) * 1024), 16, lane * 16, (int)E.side_off(unit), 0, 0); } } while (0)
    PG8_SIDE(cur, 0);
    if constexpr (GATHER) PG8_TOK(cur, 0);
    PG8_STAGE(PG8_SB(0, 0), cB, voffB); PG8_STAGE(PG8_SB(0, 1), cB + hstepB, voffB); PG8_STAGE(PG8_SB(1, 0), cB + kstep, voffB); PG8_STAGE(PG8_SB(1, 1), cB + hstepB + kstep, voffB);
    if constexpr (GATHER || Epi::SIDE) { PG8_WAIT_V(8); PG8_BAR; }
    PG8_INIT(0);
    PG8_STAGE_A(PG8_SA(0, 0), cA, 0, 0); PG8_STAGE_A(PG8_SA(0, 1), cA, 1, 0); PG8_STAGE_A(PG8_SA(1, 0), cA + kstep, 0, 0);
    if (wr == 1) PG8_BAR;
    PG8_WAIT_V(4); PG8_BAR;
    PG8_WAIT_V(2); PG8_BAR;
    for (;;) {
        const bool has_next = S.next(ui + 1, nxt);
        if (has_next) { PG8_TOK(nxt, (ui + 1) & 1); PG8_SIDE(nxt, (ui + 1) & 1); }
        const unsigned nA = has_next ? nxt.ao : cA, nB = has_next ? nxt.bo : cB;
#pragma unroll 1
        for (int t = 0; t < nt; t += 2) {
            const bool last = (t == nt - 2);
            ldsl = ldsw; asm volatile("" : "+s"(ldsl));
            const int parc = ui & 1, parn = (ui + ((last && has_next) ? 1 : 0)) & 1;
            const unsigned a1 = cA + (unsigned)(t + 1) * kstep;
            const unsigned a2 = last ? nA : cA + (unsigned)(t + 2) * kstep, b2 = last ? nB : cB + (unsigned)(t + 2) * kstep;
            const unsigned a3 = a2 + kstep, b3 = b2 + kstep;
            { PG8_TKLD(1, parc); PG8_LDB(B0, 0, 0); PG8_LDB(B1, 0, 1); PG8_SCHED; PG8_LDA(At, 0, 0); PG8_STAGE_AT(PG8_SA(1, 1), a1, 1); }
            PG8_WAIT_V(8); PG8_WAIT_L(0); PG8_BAR; PG8_MMA(0, 0, At, B0); PG8_MMA(0, 1, At, B1); PG8_BAR; PG8_SCHED;
            { PG8_TKLD(0, parn); PG8_LDA(At, 0, 1); PG8_STAGE(PG8_SB(0, 0), b2, voffB); PG8_STAGE(PG8_SB(0, 1), b2 + hstepB, voffB); PG8_STAGE_AT(PG8_SA(0, 0), a2, 0); }
            PG8_WAIT_V(8); PG8_WAIT_L(0); PG8_BAR; PG8_MMA(1, 0, At, B0); PG8_MMA(1, 1, At, B1); PG8_BAR; PG8_SCHED;
            { PG8_TKLD(1, parn); PG8_LDB(B0, 1, 0); PG8_LDB(B1, 1, 1); PG8_SCHED; PG8_LDA(At, 1, 0); PG8_STAGE_AT(PG8_SA(0, 1), a2, 1); }
            PG8_WAIT_V(8); PG8_WAIT_L(0); PG8_BAR; PG8_MMA(0, 0, At, B0); PG8_MMA(0, 1, At, B1); PG8_BAR; PG8_SCHED;
            { PG8_TKLD(0, parn); PG8_LDA(At, 1, 1); PG8_STAGE(PG8_SB(1, 0), b3, voffB); PG8_STAGE(PG8_SB(1, 1), b3 + hstepB, voffB); PG8_STAGE_AT(PG8_SA(1, 0), a3, 0); }
            PG8_WAIT_V(8); PG8_WAIT_L(0); PG8_BAR; PG8_MMA(1, 0, At, B0); PG8_MMA(1, 1, At, B1); PG8_BAR; PG8_SCHED;
        }
        if constexpr (F8) asm volatile("s_nop 15" ::: "memory");
        if (wr == 0) PG8_BAR;
        { const int l2 = fresh_tid() & 63; E(acc, cur, wr, wc, l2 & 15, l2 >> 4, (const LAS float*)(lds + SIDE_OFF + (ui & 1) * 1024)); }
        if (!has_next) break;
        cur = nxt; cA = nA; cB = nB; ++ui;
        PG8_INIT(ui & 1);
        if (wr == 1) PG8_BAR;
    }
    PG8_WAIT_V(0);
    PG8_BAR;
#undef PG8_SA
#undef PG8_SB
#undef PG8_STAGE
#undef PG8_STAGE_A
#undef PG8_TKLD
#undef PG8_STAGE_AT
#undef PG8_TOK
#undef PG8_SIDE
#undef PG8_INIT
#undef hstepvoffA
#undef hstepvoffB
#undef PG8_LDA
#undef PG8_LDB
#undef PG8_MMA
#undef PG8_WAIT_V
#undef PG8_WAIT_L
#undef PG8_BAR
#undef PG8_SCHED
}
}

using pg8::Unit;

struct DenseSched {
    unsigned A, Bt; int lda, ldb, nN, gs, vr, vx;
    __device__ __forceinline__ bool next(int i, Unit& u) const {
        const int L = i * gs + vr; if (vx >= 8 || L >= 16 * nN) return false;
        u.pm = 16 * vx + L / nN; u.pn = L % nN; u.aux = 0; u.to = 0;
        if (nN == 8 && (gs & 7) == 0) u.pn = (u.pn + 4 * i) & 7;
        u.ao = A + (unsigned)u.pm * 256 * lda * 2; u.bo = Bt + (unsigned)u.pn * 256 * ldb * 2; return true;
    }
};
struct GateSched {
    unsigned XC, GT; int gs, vr, vx;
    __device__ __forceinline__ bool next(int i, Unit& u) const {
        const int L = i * gs + vr; if (vx >= 8 || L >= 256) return false;
        const int nb = L >> 6; u.pm = 16 * vx + ((L & 63) >> 2); u.pn = L & 3; u.aux = nb; u.to = 0;
        u.ao = XC + ((unsigned)u.pm * 256 * 1024 + 256 * nb) * 2; u.bo = GT + ((unsigned)nb * 1024 + 256 * u.pn) * 256 * 2; return true;
    }
};
struct QkvSched {
    unsigned HB, WT; int gs, vr, vx;
    __device__ __forceinline__ bool next(int i, Unit& u) const {
        const int L = i * gs + vr; if (vx >= 8 || L >= 128 + 64) return false; u.to = 0;
        if (L < 128) { u.pm = 16 * vx + (L >> 3); u.pn = L & 7; u.aux = 0; u.ao = HB + (unsigned)u.pm * 256 * 1024; u.bo = WT + (unsigned)u.pn * 256 * 1024; }
        else { const int Ly = L - 128; u.pm = Ly & 3; u.pn = 16 * vx + (Ly >> 2); u.aux = 1; u.ao = WT + (unsigned)(2048 + u.pm * 256) * 1024; u.bo = HB + (unsigned)u.pn * 256 * 1024; }
        return true;
    }
};
struct MoeSched {
    unsigned A, W, tok; const LAS int* texp; unsigned wstride; int nM, nN, G, c, xs, xr, xg;
    __device__ __forceinline__ bool next(int i, Unit& u) const {
        if (xs >= 0) {
            const int m0 = (xs * nM) >> 3, m1 = ((xs + 1) * nM) >> 3, L = i * xg + xr; if (L >= (m1 - m0) * nN) return false;
            const int GS = nN == 8 ? 4 : 8, nig = GS * nN, gid = L / nig, fm = m0 + gid * GS, gsz = (m1 - fm) < GS ? (m1 - fm) : GS, wi = L % nig;
            if (gsz == GS) { u.pm = fm + wi % GS; u.pn = wi / GS; } else { u.pm = fm + wi % gsz; u.pn = wi / gsz; }
        } else {
            const int L = i * G + c; if (L >= nM * nN) return false;
            pg8::tile_of(L, nM, nN, u.pm, u.pn); }
        const int ej = __builtin_amdgcn_readfirstlane(texp[u.pm]), e = ej & 255; u.aux = e;
        u.ao = tok ? A : A + (unsigned)u.pm * 256 * 1024; u.to = tok + (unsigned)(e * TCAP + (ej >> 8) * 256) * 4u; u.bo = W + (unsigned)e * wstride + (unsigned)u.pn * 256 * 1024; return true;
    }
};

#define EPI_ARGS const f32x4 (&acc)[2][2][4][2], const Unit& u, int wr, int wc, int fr, int fq, const LAS float* side
struct EpiWin {
    static constexpr bool PERM = true, SIDE = false; static constexpr int SCALES = 0x7F79;
    bf16_t* XR; bf16_t* GY;
    __device__ __forceinline__ void operator()(EPI_ARGS) const {
        const int row0 = u.pm * 256 + wr * 64 + fr;
        if (u.pn < 4) {
            const int col0 = u.pn * 256 + wc * 32 + 8 * fq;
#pragma unroll
            for (int ai = 0; ai < 2; ++ai)
#pragma unroll
                for (int m = 0; m < 4; ++m) { bf16_t* rowp = XR + (size_t)(row0 + ai * 128 + m * 16) * D + col0;
#pragma unroll
                    for (int bj = 0; bj < 2; ++bj) { const f32x4 v0 = acc[ai][bj][m][0], v1 = acc[ai][bj][m][1];
                        u32x4 w; w.x = cvt_pk_bf16(v0[0], v0[1]); w.y = cvt_pk_bf16(v0[2], v0[3]); w.z = cvt_pk_bf16(v1[0], v1[1]); w.w = cvt_pk_bf16(v1[2], v1[3]);
                        *(u32x4*)(rowp + bj * 128) = w; } }
        } else {
#pragma unroll
            for (int ai = 0; ai < 2; ++ai)
#pragma unroll
                for (int m = 0; m < 4; ++m) { const int row = row0 + ai * 128 + m * 16;
#pragma unroll
                    for (int bj = 0; bj < 2; ++bj) { const int g = (u.pn - 4) * 8 + bj * 4 + wc;
                        float o[8];
#pragma unroll
                        for (int n = 0; n < 2; ++n)
#pragma unroll
                            for (int j = 0; j < 4; ++j) { const float v = acc[ai][bj][m][n][j];
                                const float t = __builtin_fmaf(v * v, -1.44269504089f * 1.5957691216f * 0.044715f, -1.44269504089f * 1.5957691216f); o[n * 4 + j] = v * fast_rcp(__builtin_fmaf(fast_exp2(v * t), 4.0f, 4.0f)); }
                        u32x4 w; w.x = cvt_pk_bf16(o[0], o[1]); w.y = cvt_pk_bf16(o[2], o[3]); w.z = cvt_pk_bf16(o[4], o[5]); w.w = cvt_pk_bf16(o[6], o[7]);
                        *(u32x4*)(GY + ((size_t)g * MPAD + row) * 32 + 8 * fq) = w; } }
        }
    }
};
struct EpiGate {
    static constexpr bool PERM = true, SIDE = true;
    const bf16_t* XC; unsigned char* LB; const float* spl; unsigned bias_off;
    __device__ __forceinline__ unsigned side_off(const Unit& u) const { return bias_off + (unsigned)((((u.pn >> 1) * 4 + u.aux) * 2 + (u.pn & 1)) * 1024); }
    __device__ __forceinline__ void init(f32x4 (&acc)[2][2][4][2], const LAS float* side, int wc, int fq) const {
#pragma unroll
        for (int bj = 0; bj < 2; ++bj)
#pragma unroll
            for (int n = 0; n < 2; ++n) { const f32x4 b = *(const LAS f32x4*)(side + 128 * bj + 32 * wc + 8 * fq + 4 * n);
#pragma unroll
                for (int ai = 0; ai < 2; ++ai)
#pragma unroll
                    for (int m = 0; m < 4; ++m) acc[ai][bj][m][n] = b; }
    }
    __device__ __forceinline__ void operator()(EPI_ARGS) const {
        const int nb = u.aux, dir = u.pn >> 1, half = u.pn & 1;
        const int ch0 = 256 * nb + 128 * half + 32 * wc + 8 * fq, g = ch0 >> 5;
        const int row0 = u.pm * 256 + wr * 64 + fr;
        float csp[8];
        { const f32x4 p0 = *(const f32x4*)(spl + dir * 1024 + ch0), p1 = *(const f32x4*)(spl + dir * 1024 + ch0 + 4);
#pragma unroll
          for (int j = 0; j < 4; ++j) { csp[j] = (-2.0f / 256.0f) * p0[j]; csp[4 + j] = (-2.0f / 256.0f) * p1[j]; } }
        u32x4 xall[8];
#pragma unroll
        for (int it = 0; it < 8; ++it) xall[it] = *(const u32x4*)(XC + (size_t)(row0 + (it >> 2) * 128 + (it & 3) * 16) * D + ch0);
#pragma unroll
        for (int ai = 0; ai < 2; ++ai)
#pragma unroll
            for (int m = 0; m < 4; ++m) { const int row = row0 + ai * 128 + m * 16;
                const u32x4 xw = xall[ai * 4 + m];
                float xc[8]; unpack8(xw, xc);
                float sg[8], bb[8];
#pragma unroll
                for (int n = 0; n < 2; ++n)
#pragma unroll
                    for (int j = 0; j < 4; ++j) { const int i = n * 4 + j;
                        const float sga = fast_rcp(__builtin_fmaf(fast_exp2(-1.44269504089f * acc[ai][0][m][n][j]), 1.0f / 256.0f, 1.0f / 256.0f));
                        sg[i] = sga; bb[i] = __builtin_amdgcn_fmed3f(fast_rcp(__builtin_fmaf(fast_exp2(-1.44269504089f * acc[ai][1][m][n][j]), 0.125f, 0.125f)) * xc[i], -448.0f, 448.0f); }
                u32x4 w; w.x = pk4_fp8(sg[0], sg[1], sg[2], sg[3]); w.y = pk4_fp8(sg[4], sg[5], sg[6], sg[7]); w.z = pk4_fp8(bb[0], bb[1], bb[2], bb[3]); w.w = pk4_fp8(bb[4], bb[5], bb[6], bb[7]);
                *(u32x4*)(LB + (((size_t)dir * 32 + g) * MPAD + row) * 64 + 16 * fq) = w; }
    }
};
template <bool LAYER0, bool RESF32 = LAYER0> struct EpiRes {
    static constexpr bool PERM = true, SIDE = false; static constexpr int SCALES = LAYER0 ? 0x7E79 : 0x7D79;
    bf16_t* PRE; const float* x; const float* meta; const bf16_t* HB; int nrows;
    __device__ __forceinline__ void operator()(EPI_ARGS) const {
        const int row0 = u.pm * 256 + wr * 64 + fr, col0 = u.pn * 256 + wc * 32 + 8 * fq;
        if constexpr (!RESF32) {
            u32x4 rall[8][2];
#pragma unroll
            for (int it = 0; it < 8; ++it)
#pragma unroll
                for (int bj = 0; bj < 2; ++bj) rall[it][bj] = *(const u32x4*)(HB + (size_t)(row0 + (it >> 2) * 128 + (it & 3) * 16) * D + col0 + bj * 128);
#pragma unroll
            for (int ai = 0; ai < 2; ++ai)
#pragma unroll
                for (int m = 0; m < 4; ++m) { const int row = row0 + ai * 128 + m * 16;
#pragma unroll
                    for (int bj = 0; bj < 2; ++bj) { const int c = col0 + bj * 128; const u32x4 rw = rall[ai * 4 + m][bj]; float r[8];
                        r[0] = bflo(rw.x); r[1] = bfhi(rw.x); r[2] = bflo(rw.y); r[3] = bfhi(rw.y); r[4] = bflo(rw.z); r[5] = bfhi(rw.z); r[6] = bflo(rw.w); r[7] = bfhi(rw.w);
                        const f32x4 a0 = acc[ai][bj][m][0], a1 = acc[ai][bj][m][1];
                        u32x4 w; w.x = cvt_pk_bf16(r[0] * DN_ALPHA + a0[0], r[1] * DN_ALPHA + a0[1]); w.y = cvt_pk_bf16(r[2] * DN_ALPHA + a0[2], r[3] * DN_ALPHA + a0[3]);
                        w.z = cvt_pk_bf16(r[4] * DN_ALPHA + a1[0], r[5] * DN_ALPHA + a1[1]); w.w = cvt_pk_bf16(r[6] * DN_ALPHA + a1[2], r[7] * DN_ALPHA + a1[3]);
                        *(u32x4*)(PRE + (size_t)row * D + c) = w; }
                    asm volatile("" ::: "memory"); }
        } else {
#pragma unroll
        for (int ai = 0; ai < 2; ++ai)
#pragma unroll
            for (int m = 0; m < 4; ++m) { const int row = row0 + ai * 128 + m * 16;
                if (row < nrows) {
#pragma unroll
                    for (int bj = 0; bj < 2; ++bj) { const int c = col0 + bj * 128; float r[8];
                        { const float* rp = (row < NGRID ? x + (size_t)row * D : meta + (size_t)((row - NGRID) & 15) * D) + c; const f32x4 r0 = *(const f32x4*)rp, r1 = *(const f32x4*)(rp + 4);
                            r[0] = r0[0]; r[1] = r0[1]; r[2] = r0[2]; r[3] = r0[3]; r[4] = r1[0]; r[5] = r1[1]; r[6] = r1[2]; r[7] = r1[3]; }
                        const f32x4 a0 = acc[ai][bj][m][0], a1 = acc[ai][bj][m][1];
                        u32x4 w; w.x = cvt_pk_bf16(r[0] * DN_ALPHA + a0[0], r[1] * DN_ALPHA + a0[1]); w.y = cvt_pk_bf16(r[2] * DN_ALPHA + a0[2], r[3] * DN_ALPHA + a0[3]);
                        w.z = cvt_pk_bf16(r[4] * DN_ALPHA + a1[0], r[5] * DN_ALPHA + a1[1]); w.w = cvt_pk_bf16(r[6] * DN_ALPHA + a1[2], r[7] * DN_ALPHA + a1[3]);
                        *(u32x4*)(PRE + (size_t)row * D + c) = w; }
                }
                asm volatile("" ::: "memory"); }
        }
    }
};
struct EpiGlu {
    static constexpr bool PERM = true, SIDE = true; static constexpr int SCALES = 0x7F79;
    unsigned char* ACT; unsigned bias_off;
    __device__ __forceinline__ unsigned side_off(const Unit& u) const { return bias_off + (unsigned)((u.aux * 8 + u.pn) * 1024); }
    __device__ __forceinline__ void init(f32x4 (&acc)[2][2][4][2], const LAS float* side, int wc, int fq) const {
#pragma unroll
        for (int bj = 0; bj < 2; ++bj)
#pragma unroll
            for (int n = 0; n < 2; ++n) { const f32x4 b = *(const LAS f32x4*)(side + 128 * bj + 32 * wc + 8 * fq + 4 * n);
#pragma unroll
                for (int ai = 0; ai < 2; ++ai)
#pragma unroll
                    for (int m = 0; m < 4; ++m) acc[ai][bj][m][n] = b; }
    }
    __device__ __forceinline__ void operator()(EPI_ARGS) const {
        const int row0 = u.pm * 256 + wr * 64 + fr;
#pragma unroll
        for (int ai = 0; ai < 2; ++ai)
#pragma unroll
            for (int mp = 0; mp < 2; ++mp) { u32x2 wq[2];
#pragma unroll
              for (int mh = 0; mh < 2; ++mh) { const int m = 2 * mp + mh; float o[8];
#pragma unroll
                for (int n = 0; n < 2; ++n)
#pragma unroll
                    for (int j = 0; j < 4; ++j) { const int i = n * 4 + j;
                        const float glu = fminf(acc[ai][0][m][n][j], 7.0f);
                        const float lin1 = __builtin_amdgcn_fmed3f(acc[ai][1][m][n][j], -6.0f, 8.0f);
                        const float r4 = fast_rcp(__builtin_fmaf(fast_exp2(glu * (-1.702f * 1.44269504089f)), 0.25f, 0.25f));
                        o[i] = (glu * r4) * lin1; }
                wq[mh].x = pk4_fp8(o[0], o[1], o[2], o[3]); wq[mh].y = pk4_fp8(o[4], o[5], o[6], o[7]); }
              *(u32x4*)(ACT + (size_t)(row0 + ai * 128 + (2 * mp + (fq & 1)) * 16) * D + 128 * u.pn + 32 * wc + (fq >> 1) * 16) = widen16(wq[0], wq[1]); }
    }
};
struct EpiDown {
    static constexpr bool PERM = true, SIDE = true; static constexpr int SCALES = 0x7D7C;
    unsigned char* YS; unsigned bias_off;
    __device__ __forceinline__ unsigned side_off(const Unit& u) const { return bias_off + (unsigned)((u.aux * 4 + u.pn) * 1024); }
    __device__ __forceinline__ void init(f32x4 (&acc)[2][2][4][2], const LAS float* side, int wc, int fq) const {
#pragma unroll
        for (int bj = 0; bj < 2; ++bj)
#pragma unroll
            for (int n = 0; n < 2; ++n) { const f32x4 b = *(const LAS f32x4*)(side + 128 * bj + 32 * wc + 8 * fq + 4 * n);
#pragma unroll
                for (int ai = 0; ai < 2; ++ai)
#pragma unroll
                    for (int m = 0; m < 4; ++m) acc[ai][bj][m][n] = b; }
    }
    __device__ __forceinline__ void operator()(EPI_ARGS) const {
        const int row0 = u.pm * 256 + wr * 64 + fr;
#pragma unroll
        for (int ai = 0; ai < 2; ++ai)
#pragma unroll
            for (int m = 0; m < 4; ++m) { u32x2 w[2];
#pragma unroll
                for (int bj = 0; bj < 2; ++bj) { const f32x4 v0 = acc[ai][bj][m][0], v1 = acc[ai][bj][m][1];
                    w[bj].x = pk4_fp8(sat8(v0[0]), sat8(v0[1]), sat8(v0[2]), sat8(v0[3])); w[bj].y = pk4_fp8(sat8(v1[0]), sat8(v1[1]), sat8(v1[2]), sat8(v1[3])); }
                *(u32x4*)(YS + (size_t)(row0 + ai * 128 + m * 16) * D + u.pn * 256 + wc * 32 + (fq & 1) * 128 + (fq >> 1) * 16) = widen16(w[0], w[1]); }
    }
};
struct EpiQkv {
    static constexpr bool PERM = true, SIDE = false; static constexpr int SCALES = 0x7F79;
    bf16_t* Q; bf16_t* Kx; bf16_t* VT;
    __device__ __forceinline__ void operator()(EPI_ARGS) const {
        const int row0 = u.pm * 256 + wr * 64 + fr; bf16_t* base; int ldc, colt;
        if (u.aux == 0) { ldc = D; if (u.pn < 4) { base = Q; colt = u.pn * 256; } else { base = Kx; colt = (u.pn - 4) * 256; } }
        else { base = VT; ldc = MPAD; colt = u.pn * 256; }
        const int col0 = colt + wc * 32 + 8 * fq;
#pragma unroll
        for (int ai = 0; ai < 2; ++ai)
#pragma unroll
            for (int m = 0; m < 4; ++m) { bf16_t* rowp = base + (size_t)(row0 + ai * 128 + m * 16) * ldc + col0;
#pragma unroll
                for (int bj = 0; bj < 2; ++bj) { const f32x4 v0 = acc[ai][bj][m][0], v1 = acc[ai][bj][m][1];
                    u32x4 w; w.x = cvt_pk_bf16(v0[0], v0[1]); w.y = cvt_pk_bf16(v0[2], v0[3]); w.z = cvt_pk_bf16(v1[0], v1[1]); w.w = cvt_pk_bf16(v1[2], v1[3]);
                    *(u32x4*)(rowp + bj * 128) = w; } }
    }
};

struct CvItem { const float* src; unsigned char* dst; unsigned char* dst2; int ld, pitch, f8; float scl; };
__device__ __forceinline__ CvItem cv_item(const Ctx& C, unsigned char* wsl, int it) {
    constexpr int I0 = 0, I1 = 256, I2 = 0, I3 = 0, I4 = 256, I5 = 32768, I6 = 16384;
    CvItem q; int r = it; q.scl = 64.0f; q.dst2 = nullptr;
    if (r < I0) { const int nbk = r & 63, kb = r >> 6; q.src = gin(C.in[I_WIN]) + (size_t)(128 * kb) * 2048 + 32 * nbk; q.ld = 2048; q.dst = wsl + WS_WIN + ((size_t)(32 * nbk) * 1024 + 128 * kb) * 2; q.pitch = 2048; q.f8 = 0; return q; } r -= I0;
    if (r < I1) { const int job = r >> 3, sub = r & 7, nbk = sub & 3, kb = sub >> 2;
        const int half = job & 1, which = (job >> 1) & 1, nb = (job >> 2) & 3, dir = job >> 4;
        q.src = C.in[which ? I_WX : I_WA] + (size_t)(dir * 4 + nb) * 65536 + (size_t)(128 * kb) * 256 + 128 * half + 32 * nbk; q.ld = 256;
        q.dst = wsl + WS_GATE + (((size_t)nb * 1024 + 256 * (2 * dir + half) + 128 * which + 32 * nbk) * 256 + 128 * kb) * 2; q.pitch = 512; q.f8 = 0; return q; } r -= I1;
    if (r < I2) { const int nbk = r & 31, kb = r >> 5; q.src = gin(C.in[I_LOUT]) + (size_t)(128 * kb) * 1024 + 32 * nbk; q.ld = 1024; q.dst = wsl + WS_LOUT + ((size_t)(32 * nbk) * 1024 + 128 * kb) * 2; q.pitch = 2048; q.f8 = 0; return q; } r -= I2;
    if (r < I3) { const int nbk = r % 96, kb = r / 96; q.src = gin(C.in[I_WQKV]) + (size_t)(128 * kb) * 3072 + 32 * nbk; q.ld = 3072; q.dst = wsl + WS_QKV + ((size_t)(32 * nbk) * 1024 + 128 * kb) * 2; q.pitch = 2048; q.f8 = 0; return q; } r -= I3;
    if (r < I4) { const int nbk = r & 31, kb = r >> 5; q.src = gin(C.in[I_NOUT]) + (size_t)(128 * kb) * 1024 + 32 * nbk; q.ld = 1024; q.dst = wsl + WS_NOUT + (size_t)(32 * nbk) * 1024 + 128 * kb; q.pitch = 1024; q.f8 = 1; return q; } r -= I4;
    q.f8 = 1; q.pitch = 1024;
    if (r < I5) { const int mat = r >> 9, sub = r & 511, nbk = sub & 63, kb = sub >> 6; const int n0 = 32 * nbk, bj = n0 >> 10, f0 = n0 & 1023, pn = f0 >> 7, jj = f0 & 127;
        q.src = gin(C.in[I_WGU]) + (size_t)mat * 1024 * 2048 + (size_t)(128 * kb) * 2048 + n0; q.ld = 2048; q.dst = wsl + WS_WGU + ((size_t)mat * 2048 + 256 * pn + 128 * bj + jj) * 1024 + 128 * kb; return q; } r -= I5;
    if (r < I6) { const int mat = r >> 8, sub = r & 255, nbk = sub & 31, kb = sub >> 5;
        q.src = gin(C.in[I_WD]) + (size_t)mat * 1024 * 1024 + (size_t)(128 * kb) * 1024 + 32 * nbk; q.ld = 1024; q.dst = wsl + WS_WD + ((size_t)mat * 1024 + 32 * nbk) * 1024 + 128 * kb; return q; } r -= I6;
    if (r < 768) { const int nbk = r % 96, kb = r / 96; if (nbk < 32) q.scl = 64.0f * 0.125f * 1.44269504089f; q.src = gin(C.in[I_WQKV]) + (size_t)(128 * kb) * 3072 + 32 * nbk; q.ld = 3072; q.dst = wsl + WS_QKV8 + (size_t)(32 * nbk) * 1024 + 128 * kb; q.dst2 = wsl + WS_QKV + ((size_t)(32 * nbk) * 1024 + 128 * kb) * 2; return q; } r -= 768;
    if (r < 256) { const int nbk = r & 31, kb = r >> 5; q.src = gin(C.in[I_LOUT]) + (size_t)(128 * kb) * 1024 + 32 * nbk; q.ld = 1024; q.dst = wsl + WS_LOUT8 + (size_t)(32 * nbk) * 1024 + 128 * kb; q.dst2 = wsl + WS_LOUT + ((size_t)(32 * nbk) * 1024 + 128 * kb) * 2; return q; } r -= 256;
    { const int nbk = r & 63, kb = r >> 6; q.src = gin(C.in[I_WIN]) + (size_t)(128 * kb) * 2048 + 32 * nbk; q.ld = 2048; q.dst = wsl + WS_WIN8 + (size_t)(32 * nbk) * 1024 + 128 * kb; q.dst2 = wsl + WS_WIN + ((size_t)(32 * nbk) * 1024 + 128 * kb) * 2; return q; }
}
__device__ __forceinline__ void phase_convert(const Ctx& C) {
    PHASE_IDS
    LAS float* scr = (LAS float*)(C.lds + wave * 16896);
    const int gw = C.bid * NWAVES + wave, NGW = C.G * NWAVES;
    constexpr int NIT = 256 + 256 + 32768 + 16384 + 768 + 256 + 512;
    if (gw < NIT) {
        const int r = lane >> 3, q4 = lane & 7, c = lane & 15, nn = lane >> 4;
        CvItem cur = cv_item(C, wsl, gw); int it = gw;
        f32x4 v[16];
#pragma unroll
        for (int i = 0; i < 16; ++i) v[i] = __builtin_nontemporal_load((const f32x4*)(cur.src + (size_t)(8 * i + r) * cur.ld + 4 * q4));
        for (;;) {
#pragma unroll
            for (int i = 0; i < 16; ++i) { LAS float* sp = scr + (8 * i + r) * 33 + 4 * q4; sp[0] = v[i][0]; sp[1] = v[i][1]; sp[2] = v[i][2]; sp[3] = v[i][3]; }
            const int nit = it + NGW; CvItem nxt = cur;
            if (nit < NIT) { nxt = cv_item(C, wsl, nit);
#pragma unroll
                for (int i = 0; i < 16; ++i) v[i] = __builtin_nontemporal_load((const f32x4*)(nxt.src + (size_t)(8 * i + r) * nxt.ld + 4 * q4)); }
            asm volatile("s_waitcnt lgkmcnt(0)" ::: "memory");
            if (cur.f8) {
#pragma unroll
                for (int j = 0; j < 8; ++j) { const int n = nn + 4 * j; const LAS float* sp = scr + (8 * c) * 33 + n;
                    const float cs = cur.scl; u32x2 o; o.x = pk4_fp8(sp[0] * cs, sp[33] * cs, sp[2 * 33] * cs, sp[3 * 33] * cs); o.y = pk4_fp8(sp[4 * 33] * cs, sp[5 * 33] * cs, sp[6 * 33] * cs, sp[7 * 33] * cs);
                    *(u32x2*)(cur.dst + (size_t)n * cur.pitch + 8 * c) = o; }
                if (cur.dst2) {
#pragma unroll
                    for (int j = 0; j < 8; ++j) { const int n = nn + 4 * j; const LAS float* sp = scr + (8 * c) * 33 + n;
                        u32x4 o; o.x = pk2(sp[0], sp[33]); o.y = pk2(sp[2 * 33], sp[3 * 33]); o.z = pk2(sp[4 * 33], sp[5 * 33]); o.w = pk2(sp[6 * 33], sp[7 * 33]);
                        *(u32x4*)(cur.dst2 + (size_t)n * 2048 + 16 * c) = o; } }
            } else {
#pragma unroll
                for (int j = 0; j < 8; ++j) { const int n = nn + 4 * j; const LAS float* sp = scr + (8 * c) * 33 + n;
                    u32x4 o; o.x = pk2(sp[0], sp[33]); o.y = pk2(sp[2 * 33], sp[3 * 33]); o.z = pk2(sp[4 * 33], sp[5 * 33]); o.w = pk2(sp[6 * 33], sp[7 * 33]);
                    *(u32x4*)(cur.dst + (size_t)n * cur.pitch + 16 * c) = o; }
            }
            asm volatile("s_waitcnt lgkmcnt(0)" ::: "memory");
            if (nit >= NIT) break;
            cur = nxt; it = nit;
        }
    }
    const int gt = C.bid * NTHREADS + tid, NGT = C.G * NTHREADS;
    for (int i = gt; i < 2 * 32 * TCAP; i += NGT) ((int*)(wsl + WS_TOK2))[i] = 0;
    if (gt < 64) ((unsigned*)(wsl + WS_CTL + CT_BC))[gt] = 0u;
    for (int i = gt; i < 2 * 32 * 512; i += NGT) { const int layer = i >> 14, e = (i >> 9) & 31, pc = i & 511; const float* rwl = gin(C.in[I_RW]) + (size_t)layer * D * NEXP;
        *(unsigned*)(wsl + WS_RWT + (size_t)layer * 66560 + e * 2080 + pc * 4) = pk2(rwl[(size_t)(2 * pc) * NEXP + e], rwl[(size_t)(2 * pc + 1) * NEXP + e]); }
    for (int i = gt; i < 2048; i += NGT) ((float*)(wsl + WS_CTL + CT_SPL))[i] = 8.0f * 1.44269504089f * log1pf(expf(-gin(C.in[I_LAM])[i]));
    for (int i = gt; i < 2 * 32 * 2048; i += NGT) { const int le = i >> 11, r = i & 2047, pn = r >> 8, bj = (r >> 7) & 1, ii = r & 127;
        ((float*)(wsl + WS_BIAS))[i] = gin(C.in[I_BGU])[(size_t)le * 2048 + bj * 1024 + 128 * pn + ii] + (bj ? 1.0f : 0.0f); }
    for (int i = gt; i < 2 * 32 * 1024; i += NGT) ((float*)(wsl + WS_BD))[i] = 8.0f * gin(C.in[I_BD])[i];
    for (int i = gt; i < 4096; i += NGT) { const int ut = i >> 8, which = (i >> 7) & 1, jj = i & 127, dir = ut >> 3, nb = (ut >> 1) & 3, half = ut & 1;
        ((float*)(wsl + WS_GBIAS))[i] = C.in[which ? I_BX : I_BA][dir * 1024 + 256 * nb + 128 * half + jj]; }
    for (int i0 = gt; i0 < NTOK * 128; i0 += 8 * NGT) { f32x4 a[8], b[8];
#pragma unroll
        for (int u = 0; u < 8; ++u) { const int i = i0 + u * NGT; if (i < NTOK * 128) { const int row = i >> 7, oc = i & 127;
            const float* src = (row < NGRID ? gin(C.in[I_X]) + (size_t)row * D : gin(C.in[I_META]) + (size_t)((row - NGRID) & 15) * D) + 8 * oc;
            a[u] = __builtin_nontemporal_load((const f32x4*)src); b[u] = __builtin_nontemporal_load((const f32x4*)(src + 4)); } }
#pragma unroll
        for (int u = 0; u < 8; ++u) { const int i = i0 + u * NGT; if (i < NTOK * 128) { const int row = i >> 7, oc = i & 127;
            u32x4 w; w.x = pk2(a[u][0], a[u][1]); w.y = pk2(a[u][2], a[u][3]); w.z = pk2(b[u][0], b[u][1]); w.w = pk2(b[u][2], b[u][3]);
            *(u32x4*)((bf16_t*)(wsl + WS_HB) + (size_t)row * D + 8 * oc) = w;
            u32x2 w8; w8.x = pk4_fp8(a[u][0], a[u][1], a[u][2], a[u][3]); w8.y = pk4_fp8(b[u][0], b[u][1], b[u][2], b[u][3]);
            *(u32x2*)(wsl + WS_HB8 + (size_t)row * D + 8 * oc) = w8; } } }
}

__device__ __forceinline__ void phase_conv(const Ctx& C) {
    PHASE_IDS
    const bf16_t* XR = (const bf16_t*)(wsl + WS_XR); bf16_t* XC = (bf16_t*)(wsl + WS_XC);
    const float* cw = gin(C.in[I_CONVW]); const float* cb = gin(C.in[I_CONVB]);
    const int gt = C.vr * NTHREADS + tid, NGT = C.gs * NTHREADS;
    if (C.vx >= 8) return;
    const int ch = 8 * (gt & 127);
    float wt[4][8], bs[8];
    { const f32x4 t0 = *(const f32x4*)(cb + ch), t1 = *(const f32x4*)(cb + ch + 4);
#pragma unroll
      for (int j = 0; j < 4; ++j) { bs[j] = t0[j]; bs[4 + j] = t1[j]; }
#pragma unroll
      for (int j = 0; j < 4; ++j) { const f32x4 w0 = *(const f32x4*)(cw + j * 1024 + ch), w1 = *(const f32x4*)(cw + j * 1024 + ch + 4);
#pragma unroll
          for (int c = 0; c < 4; ++c) { wt[j][c] = w0[c]; wt[j][4 + c] = w1[c]; } } }
    for (int i = gt; i < LSEQ * 128; i += NGT) { const int row = batch_row(C.vx, i >> 7);
        int b, s; if (row < NGRID) { b = row >> 12; s = NMETA + (row & (SEQ - 1)); } else { b = (row - NGRID) >> 4; s = (row - NGRID) & 15; }
        float a[8];
#pragma unroll
        for (int c = 0; c < 8; ++c) a[c] = bs[c];
        u32x4 xw[4];
#pragma unroll
        for (int j = 0; j < 4; ++j) { const int sj = s - 2 + j; const int sc = sj < 0 ? 0 : (sj >= LSEQ ? LSEQ - 1 : sj);
            xw[j] = *(const u32x4*)(XR + (size_t)seqrow(b, sc) * D + ch); }
#pragma unroll
        for (int j = 0; j < 4; ++j) { const int sj = s - 2 + j; const float m = (sj >= 0 && sj < LSEQ) ? 1.0f : 0.0f;
            float x[8]; unpack8(xw[j], x);
#pragma unroll
            for (int c = 0; c < 8; ++c) a[c] += wt[j][c] * (m * x[c]); }
        u32x4 w; w.x = pk2(a[0], a[1]); w.y = pk2(a[2], a[3]); w.z = pk2(a[4], a[5]); w.w = pk2(a[6], a[7]);
        *(u32x4*)(XC + (size_t)row * D + ch) = w; }
}

template <int N> __device__ __forceinline__ float dpp_shr(float oldv, float v) {
    return __builtin_bit_cast(float, __builtin_amdgcn_update_dpp(__builtin_bit_cast(int, oldv), __builtin_bit_cast(int, v), 0x110 + N, 0xf, 0xf, false));
}
__device__ __forceinline__ void scan_group(float (&a)[8], float (&b)[8]) {
#define SG_STEP(N) _Pragma("unroll") for (int c = 0; c < 8; ++c) { \
        asm volatile("v_fmac_f32_dpp %0, %0, %1 row_shr:" #N " row_mask:0xf bank_mask:0xf bound_ctrl:1" : "+v"(b[c]) : "v"(a[c])); } \
    _Pragma("unroll") for (int c = 0; c < 8; ++c) { \
        asm volatile("v_mul_f32_dpp %0, %0, %0 row_shr:" #N " row_mask:0xf bank_mask:0xf" : "+v"(a[c])); }
    asm volatile("s_nop 1" ::: "memory");
    SG_STEP(1) SG_STEP(2) SG_STEP(4) SG_STEP(8)
    asm volatile("s_nop 1" ::: "memory");
#undef SG_STEP
}
__device__ __forceinline__ void unpack8(const u32x4 w, float (&o)[8]) { o[0] = bflo(w.x); o[1] = bfhi(w.x); o[2] = bflo(w.y); o[3] = bfhi(w.y); o[4] = bflo(w.z); o[5] = bfhi(w.z); o[6] = bflo(w.w); o[7] = bfhi(w.w); }
#define SCAN_OUT(row_, gv) do { u32x2 _o8; _o8.x = pk4_fp8(__builtin_amdgcn_fmed3f(gv[0], -448.0f, 448.0f), __builtin_amdgcn_fmed3f(gv[1], -448.0f, 448.0f), __builtin_amdgcn_fmed3f(gv[2], -448.0f, 448.0f), __builtin_amdgcn_fmed3f(gv[3], -448.0f, 448.0f)); \
        _o8.y = pk4_fp8(__builtin_amdgcn_fmed3f(gv[4], -448.0f, 448.0f), __builtin_amdgcn_fmed3f(gv[5], -448.0f, 448.0f), __builtin_amdgcn_fmed3f(gv[6], -448.0f, 448.0f), __builtin_amdgcn_fmed3f(gv[7], -448.0f, 448.0f)); \
        *(u32x2*)(G8 + (size_t)(row_) * D + 32 * g + 8 * oct) = _o8; \
        if ((row_) >= NGRID) { u32x4 _o; _o.x = pk2(0.5f * gv[0], 0.5f * gv[1]); _o.y = pk2(0.5f * gv[2], 0.5f * gv[3]); _o.z = pk2(0.5f * gv[4], 0.5f * gv[5]); _o.w = pk2(0.5f * gv[6], 0.5f * gv[7]); *(u32x4*)(Gout + (size_t)(row_) * D + 32 * g + 8 * oct) = _o; } } while (0)
__device__ __forceinline__ void phase_scan(const Ctx& C) {
    PHASE_IDS
    const unsigned char* LB = wsl + WS_LA; const float* spl = (const float*)(wsl + WS_CTL + CT_SPL); const bf16_t* GY = (const bf16_t*)(wsl + WS_GY);
    bf16_t* HF = (bf16_t*)(wsl + WS_HF); bf16_t* Gout = (bf16_t*)(wsl + WS_G); unsigned char* G8 = wsl + WS_BB;
    LAS float* agg = (LAS float*)C.lds;
    const int w = wave, oct = lane >> 4, p = lane & 15;
    for (int g = C.vr; C.vx < 8 && g < 32; g += C.gs) {
        const int b = C.vx;
        u32x4 na[4], hrec;
        for (int dir = 0; dir < 2; ++dir) {
            const unsigned char* lb = LB + (((size_t)dir * 32 + g) * MPAD) * 64 + 16 * oct;
            float cs[8];
            { const f32x4 p0 = *(const f32x4*)(spl + dir * 1024 + 32 * g + 8 * oct), p1 = *(const f32x4*)(spl + dir * 1024 + 32 * g + 8 * oct + 4);
#pragma unroll
              for (int c = 0; c < 4; ++c) { cs[c] = p0[c] * (-1.0f / 256.0f); cs[4 + c] = p1[c] * (-1.0f / 256.0f); } }
            float S[8];
#pragma unroll
            for (int c = 0; c < 8; ++c) S[c] = 0.f;
            if (dir == 0) {
#pragma unroll
                for (int j = 0; j < 4; ++j) { const int u = 16 + 64 * w + 4 * p + j; na[j] = __builtin_nontemporal_load((const u32x4*)(lb + (size_t)seqrow(b, u) * 64)); }
                hrec = *(const u32x4*)(lb + (size_t)seqrow(b, p) * 64); }
            {
                const int u = p, s = dir ? LSEQ - 1 - u : u, row = seqrow(b, s);
                float a[8], x[8]; { const u32x4 rec = hrec; u32x2 t; t.x = rec.x; t.y = rec.y; unpack8_fp8(t, a); t.x = rec.z; t.y = rec.w; unpack8_fp8(t, x); }
#pragma unroll
                for (int c = 0; c < 8; ++c) { a[c] = fast_exp2(a[c] * cs[c]);
                    const float mu = __builtin_amdgcn_sqrtf(__builtin_fmaf(-a[c], a[c], 1.0f)); x[c] *= (p == 0) ? 1.0f : mu; }
                scan_group(a, x);
                if (w == 0) {
                    if (dir == 0) { u32x4 o; o.x = pk2(x[0], x[1]); o.y = pk2(x[2], x[3]); o.z = pk2(x[4], x[5]); o.w = pk2(x[6], x[7]); *(u32x4*)(HF + ((size_t)g * MPAD + row) * 32 + 8 * oct) = o; }
                    else { float hf[8], gy[8]; unpack8(*(const u32x4*)(HF + ((size_t)g * MPAD + row) * 32 + 8 * oct), hf); unpack8(*(const u32x4*)(GY + ((size_t)g * MPAD + row) * 32 + 8 * oct), gy);
                        float gv[8];
#pragma unroll
                        for (int c = 0; c < 8; ++c) gv[c] = (hf[c] + x[c]) * gy[c];
                        SCAN_OUT(row, gv); }
                }
#pragma unroll
                for (int c = 0; c < 8; ++c) S[c] = __shfl(x[c], (lane & 48) | 15);
            }
            for (int r = 0; r < 8; ++r) {
                float Pw[4][8], Hw[4][8]; int rows[4];
                u32x4 ra[4], rhf[4], rgy[4];
#pragma unroll
                for (int j = 0; j < 4; ++j) { const int u = 16 + 512 * r + 64 * w + 4 * p + j, s = dir ? LSEQ - 1 - u : u; rows[j] = seqrow(b, s); ra[j] = na[j]; }
                if (r < 7) {
#pragma unroll
                    for (int j = 0; j < 4; ++j) { const int u = 16 + 512 * (r + 1) + 64 * w + 4 * p + j, s = dir ? LSEQ - 1 - u : u; const int rw = seqrow(b, s);
                        na[j] = __builtin_nontemporal_load((const u32x4*)(lb + (size_t)rw * 64)); } }
                else if (dir == 0) {
                    const unsigned char* lb1 = LB + (((size_t)32 + g) * MPAD) * 64 + 16 * oct;
#pragma unroll
                    for (int j = 0; j < 4; ++j) { const int u = 16 + 64 * w + 4 * p + j; na[j] = __builtin_nontemporal_load((const u32x4*)(lb1 + (size_t)seqrow(b, LSEQ - 1 - u) * 64)); }
                    hrec = *(const u32x4*)(lb1 + (size_t)seqrow(b, LSEQ - 1 - p) * 64); }
                if (dir == 1) {
#pragma unroll
                    for (int j = 0; j < 4; ++j) { const size_t go = ((size_t)g * MPAD + rows[j]) * 32 + 8 * oct; rhf[j] = *(const u32x4*)(HF + go); rgy[j] = __builtin_nontemporal_load((const u32x4*)(GY + go)); } }
#pragma unroll
                for (int j = 0; j < 4; ++j) {
                    float a[8], x[8]; { u32x2 t; t.x = ra[j].x; t.y = ra[j].y; unpack8_fp8(t, a); t.x = ra[j].z; t.y = ra[j].w; unpack8_fp8(t, x); }
#pragma unroll
                    for (int c = 0; c < 8; ++c) { a[c] = fast_exp2(a[c] * cs[c]); x[c] *= __builtin_amdgcn_sqrtf(__builtin_fmaf(-a[c], a[c], 1.0f)); }
                    if (j == 0) {
#pragma unroll
                        for (int c = 0; c < 8; ++c) { Hw[0][c] = x[c]; Pw[0][c] = a[c]; }
                    } else {
#pragma unroll
                        for (int c = 0; c < 8; ++c) { Hw[j][c] = a[c] * Hw[j - 1][c] + x[c]; Pw[j][c] = a[c] * Pw[j - 1][c]; }
                    }
                }
                float LA[8], LH[8];
#pragma unroll
                for (int c = 0; c < 8; ++c) { LA[c] = Pw[3][c]; LH[c] = Hw[3][c]; }
                scan_group(LA, LH);
                LAS float* ag = agg + (r & 1) * 512;
                if (p == 15) {
#pragma unroll
                    for (int c = 0; c < 8; ++c) { ag[(w * 32 + oct * 8 + c) * 2] = LA[c]; ag[(w * 32 + oct * 8 + c) * 2 + 1] = LH[c]; }
                }
                float EA[8], EH[8];
#pragma unroll
                for (int c = 0; c < 8; ++c) { EA[c] = dpp_shr<1>(1.0f, LA[c]); EH[c] = dpp_shr<1>(0.0f, LH[c]); }
                __syncthreads();
                float Sin[8];
#pragma unroll
                for (int c = 0; c < 8; ++c) Sin[c] = S[c];
#pragma unroll
                for (int ww = 0; ww < 8; ++ww) {
                    if (ww == w) { asm volatile("" ::: "memory");
#pragma unroll
                        for (int c = 0; c < 8; ++c) Sin[c] = S[c]; }
#pragma unroll
                    for (int c = 0; c < 8; ++c) { const float A = ag[(ww * 32 + oct * 8 + c) * 2], H = ag[(ww * 32 + oct * 8 + c) * 2 + 1];
                        S[c] = A * S[c] + H; }
                }
#pragma unroll
                for (int c = 0; c < 8; ++c) Sin[c] = EA[c] * Sin[c] + EH[c];
#pragma unroll
                for (int j = 0; j < 4; ++j) {
                    float h[8];
#pragma unroll
                    for (int c = 0; c < 8; ++c) h[c] = Pw[j][c] * Sin[c] + Hw[j][c];
                    const size_t go = ((size_t)g * MPAD + rows[j]) * 32 + 8 * oct;
                    if (dir == 0) { u32x4 o; o.x = pk2(h[0], h[1]); o.y = pk2(h[2], h[3]); o.z = pk2(h[4], h[5]); o.w = pk2(h[6], h[7]); *(u32x4*)(HF + go) = o; }
                    else { float hf[8], gy[8]; unpack8(rhf[j], hf); unpack8(rgy[j], gy);
                        float gv[8];
#pragma unroll
                        for (int c = 0; c < 8; ++c) gv[c] = (hf[c] + h[c]) * gy[c];
                        SCAN_OUT(rows[j], gv); }
                }
            }
            __syncthreads();
        }
    }
}

template <int K> __device__ __forceinline__ f32x4 mini_mma(const bf16_t* W, int ldw, const bf16_t* A, int lda, int lane) {
    const bf16_t* wp = W + (size_t)(lane & 15) * ldw + 8 * (lane >> 4); const bf16_t* ap = A + (size_t)(lane & 15) * lda + 8 * (lane >> 4);
    f32x4 acc = {0.f, 0.f, 0.f, 0.f};
    constexpr int KB = K < 512 ? K : 512, NS = KB / 32;
#pragma unroll 1
    for (int k0 = 0; k0 < K; k0 += KB) { bf16x8 wf[NS], af[NS];
#pragma unroll
        for (int i = 0; i < NS; ++i) { wf[i] = *(const bf16x8*)(wp + k0 + 32 * i); af[i] = *(const bf16x8*)(ap + k0 + 32 * i); }
#pragma unroll
        for (int i = 0; i < NS; ++i) acc = __builtin_amdgcn_mfma_f32_16x16x32_bf16(wf[i], af[i], acc, 0, 0, 0); }
    return acc;
}
__device__ __forceinline__ void mini_win(const Ctx& C) {
    PHASE_IDS
    const bf16_t* HB = (const bf16_t*)(C.ws + WS_HB); const bf16_t* WT = (const bf16_t*)(C.ws + WS_WIN); bf16_t* XR = (bf16_t*)(C.ws + WS_XR); bf16_t* GY = (bf16_t*)(C.ws + WS_GY);
    const int fr = lane & 15, fq = lane >> 4;
    const int sp = wave & 1, pr = wave >> 1, npr = C.gs * 4;
    for (int it = 0; it < (128 + npr - 1) / npr; ++it) { const int rg = C.vx, cb = C.vr * 4 + pr + it * npr, row = NGRID + 16 * rg + fr, c = 16 * cb + 4 * fq; const bool valid = C.vx < 8 && cb < 128;
        f32x4 a = {0.f, 0.f, 0.f, 0.f};
        if (valid) a = mini_mma<512>(WT + (size_t)(16 * cb) * 1024 + 512 * sp, 1024, HB + (size_t)(NGRID + 16 * rg) * 1024 + 512 * sp, 1024, lane);
        if (sp) *(LAS f32x4*)(C.lds + pr * 1024 + lane * 16) = a;
        __syncthreads();
        if (!sp && valid) a = a + *(const LAS f32x4*)(C.lds + pr * 1024 + lane * 16);
        __syncthreads();
        if (sp || !valid) continue;
        if (c < 1024) { u32x2 w; w.x = cvt_pk_bf16(a[0], a[1]); w.y = cvt_pk_bf16(a[2], a[3]); *(u32x2*)(XR + (size_t)row * D + c) = w; }
        else { const int yc = c - 1024; float o[4];
#pragma unroll
            for (int j = 0; j < 4; ++j) { const float v = a[j]; const float z = 1.5957691216f * (v + 0.044715f * v * v * v); o[j] = 0.25f * v * sigmoidf_(z); }
            u32x2 w; w.x = cvt_pk_bf16(o[0], o[1]); w.y = cvt_pk_bf16(o[2], o[3]); *(u32x2*)(GY + ((size_t)(yc >> 5) * MPAD + row) * 32 + (yc & 31)) = w; } }
}
__device__ __forceinline__ void mini_gate(const Ctx& C) {
    PHASE_IDS
    const bf16_t* XC = (const bf16_t*)(C.ws + WS_XC); const bf16_t* GT = (const bf16_t*)(C.ws + WS_GATE); unsigned char* LB = C.ws + WS_LA;
    const float* ba = gin(C.in[I_BA]); const float* bx = gin(C.in[I_BX]); const float* spl = (const float*)(C.ws + WS_CTL + CT_SPL);
    const int fr = lane & 15, fq = lane >> 4;
    const int sp = wave & 1, pr = wave >> 1, npr = C.gs * 4;
    for (int it = 0; it < (128 + npr - 1) / npr; ++it) { const int tt = C.vr * 4 + pr + it * npr, rg = C.vx, dir = tt & 1, chg = tt >> 1, ch0 = 16 * chg, nb = ch0 >> 8, half = (ch0 >> 7) & 1, jj0 = ch0 & 127; const bool valid = C.vx < 8 && tt < 128;
        const bf16_t* A = XC + (size_t)(NGRID + 16 * rg) * 1024 + 256 * nb; const bf16_t* Wa = GT + ((size_t)nb * 1024 + 256 * (2 * dir + half) + jj0) * 256;
        f32x4 za = {0.f, 0.f, 0.f, 0.f}, zx = za;
        const int row = NGRID + 16 * rg + fr, ch = ch0 + 4 * fq;
        f32x4 cba = za, cbx = za, csp = za; u32x2 xw = {0u, 0u};
        if (valid && !sp) { cba = *(const f32x4*)(ba + dir * 1024 + ch); cbx = *(const f32x4*)(bx + dir * 1024 + ch); csp = *(const f32x4*)(spl + dir * 1024 + ch); xw = *(const u32x2*)(XC + (size_t)row * D + ch); }
        if (valid) { if (sp) zx = mini_mma<256>(Wa + 128 * 256, 256, A, 1024, lane); else za = mini_mma<256>(Wa, 256, A, 1024, lane); }
        if (sp) *(LAS f32x4*)(C.lds + pr * 1024 + lane * 16) = zx;
        __syncthreads();
        if (!sp && valid) zx = *(const LAS f32x4*)(C.lds + pr * 1024 + lane * 16);
        __syncthreads();
        if (sp || !valid) continue;
        const float xc[4] = {bflo(xw.x), bfhi(xw.x), bflo(xw.y), bfhi(xw.y)};
        float sg[4], bb[4];
#pragma unroll
        for (int j = 0; j < 4; ++j) { const float sga = sigmoidf_(za[j] + cba[j]);
            sg[j] = sga * 256.0f; bb[j] = __builtin_amdgcn_fmed3f(8.0f * sigmoidf_(zx[j] + cbx[j]) * xc[j], -448.0f, 448.0f); }
        unsigned char* o = LB + (((size_t)dir * 32 + (ch >> 5)) * MPAD + row) * 64 + 16 * ((ch & 31) >> 3) + (ch & 7);
        *(unsigned*)o = pk4_fp8(sg[0], sg[1], sg[2], sg[3]); *(unsigned*)(o + 8) = pk4_fp8(bb[0], bb[1], bb[2], bb[3]); }
}
__device__ __forceinline__ void mini_lout(const Ctx& C) {
    PHASE_IDS
    const bf16_t* G = (const bf16_t*)(C.ws + WS_G); const bf16_t* WT = (const bf16_t*)(C.ws + WS_LOUT); bf16_t* PRE = (bf16_t*)(C.ws + WS_PRE); const float* meta = gin(C.in[I_META]);
    const int fr = lane & 15, fq = lane >> 4;
    const int sp = wave & 3, pr = wave >> 2, npr = C.gs * 2;
    for (int it = 0; it < (64 + npr - 1) / npr; ++it) { const int rg = C.vx, cb = C.vr * 2 + pr + it * npr, row = NGRID + 16 * rg + fr, c = 16 * cb + 4 * fq; const bool valid = C.vx < 8 && cb < 64;
        f32x4 a = {0.f, 0.f, 0.f, 0.f}, r = a;
        if (valid && !sp) r = *(const f32x4*)(meta + (size_t)fr * D + c);
        if (valid) a = mini_mma<256>(WT + (size_t)(16 * cb) * 1024 + 256 * sp, 1024, G + (size_t)(NGRID + 16 * rg) * 1024 + 256 * sp, 1024, lane);
        if (sp) *(LAS f32x4*)(C.lds + (pr * 3 + sp - 1) * 1024 + lane * 16) = a;
        __syncthreads();
        if (!sp && valid) { const LAS unsigned char* q = C.lds + pr * 3 * 1024 + lane * 16; a = (a + *(const LAS f32x4*)q) + (*(const LAS f32x4*)(q + 1024) + *(const LAS f32x4*)(q + 2048)); }
        __syncthreads();
        if (sp || !valid) continue;
        u32x2 w; w.x = cvt_pk_bf16(r[0] * DN_ALPHA + a[0], r[1] * DN_ALPHA + a[1]); w.y = cvt_pk_bf16(r[2] * DN_ALPHA + a[2], r[3] * DN_ALPHA + a[3]); *(u32x2*)(PRE + (size_t)row * D + c) = w; }
}
__device__ __forceinline__ void mini_kv(const Ctx& C) {
    PHASE_IDS
    const bf16_t* HB = (const bf16_t*)(C.ws + WS_HB); const bf16_t* WT = (const bf16_t*)(C.ws + WS_QKV); bf16_t* Kx = (bf16_t*)(C.ws + WS_K); bf16_t* VT = (bf16_t*)(C.ws + WS_VT);
    const int fr = lane & 15, fq = lane >> 4;
    const int sp = wave & 1, pr = wave >> 1, npr = C.gs * 4;
    for (int it = 0; it < (128 + npr - 1) / npr; ++it) { const int rg = C.vx, tt = C.vr * 4 + pr + it * npr, cb = tt & 63, isv = tt >> 6; const bool valid = C.vx < 8 && tt < 128;
        const bf16_t* A = HB + (size_t)(NGRID + 16 * rg) * 1024 + 512 * sp;
        f32x4 a = {0.f, 0.f, 0.f, 0.f};
        if (valid) { if (!isv) a = mini_mma<512>(WT + (size_t)(1024 + 16 * cb) * 1024 + 512 * sp, 1024, A, 1024, lane);
                     else a = mini_mma<512>(A, 1024, WT + (size_t)(2048 + 16 * cb) * 1024 + 512 * sp, 1024, lane); }
        if (sp) *(LAS f32x4*)(C.lds + pr * 1024 + lane * 16) = a;
        __syncthreads();
        if (!sp && valid) a = a + *(const LAS f32x4*)(C.lds + pr * 1024 + lane * 16);
        __syncthreads();
        if (sp || !valid) continue;
        if (!isv) {
            u32x2 w; w.x = cvt_pk_bf16(a[0], a[1]); w.y = cvt_pk_bf16(a[2], a[3]); *(u32x2*)(Kx + (size_t)(NGRID + 16 * rg + fr) * D + 16 * cb + 4 * fq) = w; }
        else {
            u32x2 w; w.x = cvt_pk_bf16(a[0], a[1]); w.y = cvt_pk_bf16(a[2], a[3]); *(u32x2*)(VT + (size_t)(16 * cb + fr) * MPAD + NGRID + 16 * rg + 4 * fq) = w; } }
}

constexpr int LDS_KEEP = LDS_BYTES - 64 - 256;
constexpr int RW_PITCH = 2080;
__device__ __forceinline__ void phase_lnr(const Ctx& C, int layer, int nrows) {
    PHASE_IDS
    const bf16_t* PRE = (const bf16_t*)(wsl + WS_PRE); bf16_t* HB = (bf16_t*)(wsl + WS_HB); unsigned char* HB8 = wsl + WS_HB8;
    const float* lg = gin(C.in[I_LNMG]) + layer * D; const float* lb = gin(C.in[I_LNMB]) + layer * D;
    const float* rw = gin(C.in[I_RW]) + (size_t)layer * D * NEXP; const float* rb = gin(C.in[I_RB]) + layer * NEXP;
    int* eid = (int*)(wsl + WS_CTL + CT_EID) + (size_t)layer * NTOK * 4; float* gatev = (float*)(wsl + WS_CTL + CT_GATEV) + (size_t)layer * NTOK * 4;
    unsigned* gcnt = (unsigned*)(wsl + WS_CTL + CT_BC) + layer * 32; int* posv = (int*)(wsl + WS_CTL + CT_POS) + (size_t)layer * NTOK * 4; int* tok2 = (int*)(wsl + WS_TOK2) + (size_t)layer * 32 * TCAP;
    LAS unsigned char* RWt = C.lds; LAS unsigned char* rowb = C.lds + 32 * RW_PITCH + wave * (4 * RW_PITCH);
    LAS float* lgt = (LAS float*)(C.lds + 32 * RW_PITCH + NWAVES * 4 * RW_PITCH) + wave * 128; LAS unsigned* hist = (LAS unsigned*)(C.lds + 32 * RW_PITCH + NWAVES * 4 * RW_PITCH + NWAVES * 512);
    { const __amdgpu_buffer_rsrc_t rr = __builtin_amdgcn_make_buffer_rsrc((void*)wsl, 0, 0xFFFFFFFF, 0x00020000);
      for (int pc = wave; pc < 65; pc += NWAVES) __builtin_amdgcn_raw_ptr_buffer_load_lds(rr, (LAS void*)(RWt + pc * 1024), 16, lane * 16, (int)((unsigned)WS_RWT + (unsigned)layer * 66560u + (unsigned)pc * 1024u), 0, 0); }
    float gg[2][8], gb[2][8];
#pragma unroll
    for (int j = 0; j < 2; ++j) { const f32x4 a0 = *(const f32x4*)(lg + 8 * lane + 512 * j), a1 = *(const f32x4*)(lg + 8 * lane + 512 * j + 4), b0 = *(const f32x4*)(lb + 8 * lane + 512 * j), b1 = *(const f32x4*)(lb + 8 * lane + 512 * j + 4);
#pragma unroll
        for (int i = 0; i < 4; ++i) { gg[j][i] = a0[i]; gg[j][4 + i] = a1[i]; gb[j][i] = b0[i]; gb[j][4 + i] = b1[i]; } }
    const float rbias = rb[lane & 31]; const __amdgpu_buffer_rsrc_t wsr = wt_rsrc(wsl);
    const int gw = C.vr * NWAVES + wave, NGW = C.gs * NWAVES, nper = nrows == NTOK ? LSEQ : SEQ, bq = C.vx;
    const int nmine = (bq < 8 && gw < nper) ? (nper - gw + NGW - 1) / NGW : 0;
    u32x4 nv[2];
    if (nmine > 0) {
#pragma unroll
        for (int j = 0; j < 2; ++j) nv[j] = __builtin_nontemporal_load((const u32x4*)(PRE + (size_t)batch_row(bq, gw) * D + 8 * lane + 512 * j)); }
    if (tid < 32) hist[tid] = 0u;
    asm volatile("s_waitcnt vmcnt(0)" ::: "memory");
    __syncthreads();
    const int fr = lane & 15, fq = lane >> 4;
    for (int i0 = 0; i0 < nmine; i0 += 4) {
#pragma unroll
        for (int ii = 0; ii < 4; ++ii) if (i0 + ii < nmine) {
            const int row = batch_row(bq, gw + NGW * (i0 + ii));
            float v[2][8]; float s = 0.f;
#pragma unroll
            for (int j = 0; j < 2; ++j) { unpack8(nv[j], v[j]); s += ((v[j][0] + v[j][1]) + (v[j][2] + v[j][3])) + ((v[j][4] + v[j][5]) + (v[j][6] + v[j][7])); }
            if (i0 + ii + 1 < nmine) {
#pragma unroll
                for (int j = 0; j < 2; ++j) nv[j] = __builtin_nontemporal_load((const u32x4*)(PRE + (size_t)batch_row(bq, gw + NGW * (i0 + ii + 1)) * D + 8 * lane + 512 * j)); }
            const float mean = wave_sum_dpp(s) * (1.0f / D); float q = 0.f;
#pragma unroll
            for (int j = 0; j < 2; ++j)
#pragma unroll
                for (int i = 0; i < 8; ++i) { v[j][i] -= mean; q += v[j][i] * v[j][i]; }
            const float rstd = __builtin_amdgcn_rsqf(wave_sum_dpp(q) * (1.0f / D) + LN_EPS);
#pragma unroll
            for (int j = 0; j < 2; ++j) {
#pragma unroll
                for (int i = 0; i < 8; ++i) v[j][i] = v[j][i] * rstd * gg[j][i] + gb[j][i];
                u32x4 w; w.x = pk2(v[j][0], v[j][1]); w.y = pk2(v[j][2], v[j][3]); w.z = pk2(v[j][4], v[j][5]); w.w = pk2(v[j][6], v[j][7]);
                wt_store16(wsr, (unsigned)WS_HB + ((unsigned)row * D + 8 * lane + 512 * j) * 2u, w);
                *(LAS u32x4*)(rowb + ii * RW_PITCH + 16 * lane + 1024 * j) = w;
                u32x2 w8; w8.x = pk4_fp8(v[j][0], v[j][1], v[j][2], v[j][3]); w8.y = pk4_fp8(v[j][4], v[j][5], v[j][6], v[j][7]);
                wt_store8(wsr, (unsigned)WS_HB8 + (unsigned)row * D + 8 * lane + 512 * j, w8); }
        }
        asm volatile("s_waitcnt lgkmcnt(0)" ::: "memory");
        f32x4 l0 = {0.f, 0.f, 0.f, 0.f}, l1 = {0.f, 0.f, 0.f, 0.f};
        { const LAS unsigned char* ap = RWt + fr * RW_PITCH + 16 * fq; const LAS unsigned char* bp = rowb + (fr & 3) * RW_PITCH + 16 * fq;
#pragma unroll
          for (int ks = 0; ks < 32; ++ks) { const bf16x8 b = *(const LAS bf16x8*)(bp + 64 * ks), a0 = *(const LAS bf16x8*)(ap + 64 * ks), a1 = *(const LAS bf16x8*)(ap + 16 * RW_PITCH + 64 * ks);
              l0 = __builtin_amdgcn_mfma_f32_16x16x32_bf16(a0, b, l0, 0, 0, 0); l1 = __builtin_amdgcn_mfma_f32_16x16x32_bf16(a1, b, l1, 0, 0, 0); } }
        if (fr < 4) { *(LAS f32x4*)(lgt + fr * 32 + 4 * fq) = l0; *(LAS f32x4*)(lgt + fr * 32 + 16 + 4 * fq) = l1; }
        asm volatile("s_waitcnt lgkmcnt(0)" ::: "memory");
#pragma unroll
        for (int pp = 0; pp < 2; ++pp) if (i0 + 2 * pp < nmine) {
            const int hf = lane >> 5, ii = 2 * pp + hf, le = lane & 31; const bool rv = i0 + ii < nmine;
            const int row = batch_row(bq, gw + NGW * (i0 + (rv ? ii : 2 * pp)));
            float lv = lgt[64 * pp + lane] + rbias; lv = (lv == lv) ? lv : -3.0e38f;
            int rank = 4; bool taken = false; float mxl = 0.f;
#pragma unroll
            for (int r = 0; r < 4; ++r) { const float mx = half_max_dpp(taken ? -INFINITY : lv, hf);
                const unsigned long long mm = __ballot(!taken && lv == mx);
                const unsigned m32 = hf ? (unsigned)(mm >> 32) : (unsigned)mm;
                const bool mine = le == (int)__builtin_ctz(m32 | 0x80000000u);
                if (r == 0) mxl = mx;
                rank = mine ? r : rank; taken = taken || mine; }
            const float pe = rank < 4 ? __expf(lv - mxl) : 0.f;
            const float den = half_sum_dpp(pe, hf);
            if (rv && rank < 4) { eid[(size_t)row * 4 + rank] = le; gatev[(size_t)row * 4 + rank] = pe / den;
                posv[(size_t)row * 4 + rank] = (int)__hip_atomic_fetch_add(&hist[le], 1u, __ATOMIC_RELAXED, __HIP_MEMORY_SCOPE_WORKGROUP); }
        }
        asm volatile("s_waitcnt lgkmcnt(0)" ::: "memory");
    }
    asm volatile("s_waitcnt vmcnt(0)" ::: "memory");
    int e0 = 0, l0 = 0;
    { const int i = lane >> 2, k = lane & 3; if (i < nmine) { const int row = batch_row(bq, gw + NGW * i); e0 = eid[(size_t)row * 4 + k]; l0 = posv[(size_t)row * 4 + k]; } }
    __syncthreads();
    if (tid < 32) hist[32 + tid] = __hip_atomic_fetch_add(&gcnt[tid], hist[tid], __ATOMIC_RELAXED, __HIP_MEMORY_SCOPE_AGENT);
    __syncthreads();
    for (int i0 = 0; i0 < nmine; i0 += 16) { const int i = i0 + (lane >> 2), k = lane & 3;
        if (i < nmine) { const int row = batch_row(bq, gw + NGW * i); const int e = i0 ? eid[(size_t)row * 4 + k] : e0, p = (int)hist[32 + e] + (i0 ? posv[(size_t)row * 4 + k] : l0);
            posv[(size_t)row * 4 + k] = (e << 24) | p; tok2[(size_t)e * TCAP + p] = row * 1024; } }
}

__device__ __forceinline__ void phase_combine(const Ctx& C, int layer, int nrows, bool final_out) {
    PHASE_IDS
    bf16_t* HB = (bf16_t*)(wsl + WS_HB); unsigned char* HB8 = wsl + WS_HB8; const unsigned char* YS = wsl + WS_YS;
    const float* lg = gin(C.in[I_LNFG]) + layer * D; const float* lb = gin(C.in[I_LNFB]) + layer * D;
    const float* gatev = (const float*)(wsl + WS_CTL + CT_GATEV) + (size_t)layer * NTOK * 4; const int* posv = (const int*)(wsl + WS_CTL + CT_POS) + (size_t)layer * NTOK * 4;
    float gg[2][8], gb[2][8];
#pragma unroll
    for (int j = 0; j < 2; ++j) { const f32x4 a0 = *(const f32x4*)(lg + 8 * lane + 512 * j), a1 = *(const f32x4*)(lg + 8 * lane + 512 * j + 4), b0 = *(const f32x4*)(lb + 8 * lane + 512 * j), b1 = *(const f32x4*)(lb + 8 * lane + 512 * j + 4);
#pragma unroll
        for (int i = 0; i < 4; ++i) { gg[j][i] = a0[i]; gg[j][4 + i] = a1[i]; gb[j][i] = b0[i]; gb[j][4 + i] = b1[i]; } }
    const int gw = C.vr * NWAVES + wave, NGW = C.gs * NWAVES, nper = C.vx < 8 ? (nrows == NTOK ? LSEQ : SEQ) : 0, bq = C.vx;
    const LAS int* ofs = (const LAS int*)(C.lds + LDS_KEEP);
    f32x4 g1 = {0.f, 0.f, 0.f, 0.f}, g2 = g1; int p1[4] = {0, 0, 0, 0}, p2[4] = {0, 0, 0, 0};
    u32x4 hwn[2]; u32x2 ywn[4][2];
#define CB_ROUTE(row_, gq, pq) do { gq = *(const f32x4*)(gatev + (size_t)(row_) * 4); const u32x4 _pp = *(const u32x4*)(posv + (size_t)(row_) * 4); pq[0] = ofs[_pp.x >> 24] + (int)(_pp.x & 0xFFFFFFu); pq[1] = ofs[_pp.y >> 24] + (int)(_pp.y & 0xFFFFFFu); pq[2] = ofs[_pp.z >> 24] + (int)(_pp.z & 0xFFFFFFu); pq[3] = ofs[_pp.w >> 24] + (int)(_pp.w & 0xFFFFFFu); } while (0)
#define CB_DATA(row_, pq) do { _Pragma("unroll") for (int j = 0; j < 2; ++j) { hwn[j] = *(const u32x4*)(HB + (size_t)(row_) * D + 8 * lane + 512 * j); \
            _Pragma("unroll") for (int k = 0; k < 4; ++k) ywn[k][j] = __builtin_nontemporal_load((const u32x2*)(YS + (size_t)pq[k] * D + 8 * lane + 512 * j)); } } while (0)
    if (gw < nper) CB_ROUTE(batch_row(bq, gw), g1, p1);
    if (gw + NGW < nper) CB_ROUTE(batch_row(bq, gw + NGW), g2, p2);
    if (gw < nper) CB_DATA(batch_row(bq, gw), p1);
    for (int lr = gw; lr < nper; lr += NGW) { const int row = batch_row(bq, lr);
        const f32x4 gk4 = g1 * 0.125f; u32x4 hw[2]; u32x2 yw[4][2];
#pragma unroll
        for (int j = 0; j < 2; ++j) { hw[j] = hwn[j];
#pragma unroll
            for (int k = 0; k < 4; ++k) yw[k][j] = ywn[k][j]; }
        g1 = g2;
#pragma unroll
        for (int k = 0; k < 4; ++k) p1[k] = p2[k];
        if (lr + NGW < nper) CB_DATA(batch_row(bq, lr + NGW), p1);
        if (lr + 2 * NGW < nper) CB_ROUTE(batch_row(bq, lr + 2 * NGW), g2, p2);
        float v[2][8]; float s = 0.f;
#pragma unroll
        for (int j = 0; j < 2; ++j) { float h[8]; unpack8(hw[j], h);
#pragma unroll
            for (int i = 0; i < 8; ++i) v[j][i] = h[i] * DN_ALPHA;
#pragma unroll
            for (int k = 0; k < 4; ++k) { float y[8]; unpack8_fp8(yw[k][j], y);
#pragma unroll
                for (int i = 0; i < 8; ++i) v[j][i] += gk4[k] * y[i]; }
#pragma unroll
            for (int i = 0; i < 8; ++i) s += v[j][i]; }
        const float mean = wave_sum_dpp(s) * (1.0f / D); float q = 0.f;
#pragma unroll
        for (int j = 0; j < 2; ++j)
#pragma unroll
            for (int i = 0; i < 8; ++i) { v[j][i] -= mean; q += v[j][i] * v[j][i]; }
        const float rstd = __builtin_amdgcn_rsqf(wave_sum_dpp(q) * (1.0f / D) + LN_EPS);
#pragma unroll
        for (int j = 0; j < 2; ++j) {
#pragma unroll
            for (int i = 0; i < 8; ++i) v[j][i] = v[j][i] * rstd * gg[j][i] + gb[j][i];
            if (final_out) { *(f32x4*)(gout(C.out) + (size_t)row * D + 8 * lane + 512 * j) = (f32x4){v[j][0], v[j][1], v[j][2], v[j][3]}; *(f32x4*)(gout(C.out) + (size_t)row * D + 8 * lane + 512 * j + 4) = (f32x4){v[j][4], v[j][5], v[j][6], v[j][7]}; }
            else { u32x4 w; w.x = pk2(v[j][0], v[j][1]); w.y = pk2(v[j][2], v[j][3]); w.z = pk2(v[j][4], v[j][5]); w.w = pk2(v[j][6], v[j][7]); *(u32x4*)(HB + (size_t)row * D + 8 * lane + 512 * j) = w;
                u32x2 w8; w8.x = pk4_fp8(v[j][0], v[j][1], v[j][2], v[j][3]); w8.y = pk4_fp8(v[j][4], v[j][5], v[j][6], v[j][7]); *(u32x2*)(HB8 + (size_t)row * D + 8 * lane + 512 * j) = w8; } }
    }
#undef CB_ROUTE
#undef CB_DATA
}

constexpr int AT_KS = 0, AT_VTS = 73728, AT_VPITCH = 1168, AT_KM = AT_VTS + 64 * AT_VPITCH, AT_VTM = AT_KM + 2048, AT_RPB = AT_VTM + 2048, AT_MB = AT_RPB + 1920, AT_END = AT_MB + 64;
static_assert(AT_END <= LDS_BYTES, "attention LDS map");
__device__ __forceinline__ void phase_attn(const Ctx& C) {
    PHASE_IDS
    unsigned char* O8 = wsl + WS_O;
    const float* rpb = gin(C.in[I_RPB]); const float* mbias = gin(C.in[I_MBIAS]);
    LAS unsigned char* lds = C.lds;
    const int w = wave, lq = lane & 15, g = lane >> 4;
    const int qr = w >> 2, qg = w & 3, c0 = 16 * qg, kcb = qg == 0 ? 0 : (qg == 1 ? 8 : (qg == 2 ? 24 : 32));
    int bidx[2][4];
    { const int c_ = c0 + lq, cs_ = min(max(c_ - 8, 0), 48);
#pragma unroll
      for (int blk = 0; blk < 2; ++blk)
#pragma unroll
          for (int e = 0; e < 4; ++e) { const int kc = kcb + 16 * blk + 4 * g + e; bidx[blk][e] = ((kc >= cs_ && kc < cs_ + 16) ? (kc - c_ + 15) : 31) * 4; } }
    unsigned kmask[2];
    { const int c_ = c0 + lq, cs_ = min(max(c_ - 8, 0), 48);
#pragma unroll
      for (int h2 = 0; h2 < 2; ++h2) { const int k0 = kcb + 4 * g + 2 * h2, k1 = k0 + 1; kmask[h2] = ((k0 >= cs_ && k0 < cs_ + 16) ? 0x0000FFFFu : 0u) | ((k1 >= cs_ && k1 < cs_ + 16) ? 0xFFFF0000u : 0u); } }
    const __amdgpu_buffer_rsrc_t rsrc = __builtin_amdgcn_make_buffer_rsrc((void*)wsl, 0, 0xFFFFFFFF, 0x00020000);
    const int kvoff = (((tid >> 3) & 63) * D + 8 * (tid & 7)) * 2, vvoff = ((tid >> 3) * MPAD + 8 * (tid & 7)) * 2;
    const int qvoff = (lq * D + 8 * g) * 2;
    const int mvoff = tid < 128 ? ((tid >> 3) * D + 8 * (tid & 7)) * 2 : (((tid - 128) >> 1) * MPAD + 8 * ((tid - 128) & 1)) * 2;
    const int klds = AT_KS + ((((tid >> 3) & 63)) * 8 + ((tid & 7) ^ ((tid >> 3) & 7))) * 16;
    const int vlds = AT_VTS + (tid >> 3) * AT_VPITCH + (tid & 7) * 16;
    for (int su = C.vr; C.vx < 8 && su < 32; su += C.gs) {
        const int b = C.vx, h = su >> 1, strip = su & 1, rp0 = strip * 16;
        const unsigned kbase = (unsigned)WS_K + (unsigned)((b * SEQ) * D + 64 * h) * 2u, vbase = (unsigned)WS_VT + (unsigned)((64 * h) * MPAD + b * SEQ) * 2u;
        const unsigned qbase = (unsigned)WS_Q + (unsigned)((b * SEQ + qr * 64 + c0) * D + 64 * h) * 2u;
        int R0 = min(max(2 * rp0 - 4, 0), 55);
        __syncthreads();
        {
            u32x4 kreg[9], vreg[9];
#pragma unroll
            for (int i = 0; i < 9; ++i) { kreg[i] = __builtin_amdgcn_raw_buffer_load_b128(rsrc, kvoff, (int)(kbase + (unsigned)(R0 + i) * 64u * D * 2u), 0);
                vreg[i] = __builtin_amdgcn_raw_buffer_load_b128(rsrc, vvoff, (int)(vbase + (unsigned)(R0 + i) * 128u), 0); }
            u32x4 mreg = {0u, 0u, 0u, 0u};
            if (tid < 256) mreg = __builtin_amdgcn_raw_buffer_load_b128(rsrc, mvoff, (int)(tid < 128 ? (unsigned)WS_K + (unsigned)((NGRID + 16 * b) * D + 64 * h) * 2u : (unsigned)WS_VT + (unsigned)((64 * h) * MPAD + NGRID + 16 * b) * 2u), 0);
            float rpreg = 0.f, mbreg = 0.f;
            if (tid < 480) rpreg = (tid & 31) < 31 ? rpb[h * 465 + (tid >> 5) * 31 + (tid & 31)] * 1.44269504089f : -1.0e30f;
            if (tid < 16) mbreg = mbias[h * 16 + tid] * 1.44269504089f;
#pragma unroll
            for (int i = 0; i < 9; ++i) { const int slot = (R0 + i) % 9; *(LAS u32x4*)(lds + klds + slot * 8192) = kreg[i]; *(LAS u32x4*)(lds + vlds + slot * 128) = vreg[i]; }
            if (tid < 128) { const int m = tid >> 3, ch = tid & 7; *(LAS u32x4*)(lds + AT_KM + (m * 8 + (ch ^ (m & 7))) * 16) = mreg; }
            else if (tid < 256) { const int i = tid - 128, d = i >> 1, hf = i & 1; *(LAS u32x4*)(lds + AT_VTM + d * 32 + hf * 16) = mreg; }
            if (tid < 480) ((LAS float*)(lds + AT_RPB))[tid] = rpreg;
            if (tid < 16) ((LAS float*)(lds + AT_MB))[tid] = mbreg;
        }
        u32x4 qreg[2];
        qreg[0] = __builtin_amdgcn_raw_buffer_load_b128(rsrc, qvoff, (int)(qbase + (unsigned)(2 * rp0) * 64u * D * 2u), 0);
        qreg[1] = __builtin_amdgcn_raw_buffer_load_b128(rsrc, qvoff, (int)(qbase + (unsigned)(2 * rp0) * 64u * D * 2u + 64u), 0);
        __syncthreads();
        for (int rp = rp0; rp < rp0 + 16; ++rp) {
            const int R0n = rp + 1 < rp0 + 16 ? min(max(2 * (rp + 1) - 4, 0), 55) : R0, nnew = R0n - R0;
            const u32x4 qcur[2] = {qreg[0], qreg[1]};
            u32x4 nk[2], nv[2];
#pragma unroll
            for (int i = 0; i < 2; ++i) if (i < nnew) { nk[i] = __builtin_amdgcn_raw_buffer_load_b128(rsrc, kvoff, (int)(kbase + (unsigned)(R0 + 9 + i) * 64u * D * 2u), 0);
                nv[i] = __builtin_amdgcn_raw_buffer_load_b128(rsrc, vvoff, (int)(vbase + (unsigned)(R0 + 9 + i) * 128u), 0); }
            if (rp + 1 < rp0 + 16) { qreg[0] = __builtin_amdgcn_raw_buffer_load_b128(rsrc, qvoff, (int)(qbase + (unsigned)(2 * rp + 2) * 64u * D * 2u), 0);
                qreg[1] = __builtin_amdgcn_raw_buffer_load_b128(rsrc, qvoff, (int)(qbase + (unsigned)(2 * rp + 2) * 64u * D * 2u + 64u), 0); }
            const int r = 2 * rp + qr;
            const int rs = min(max(r - 4, 0), 56), s0 = rs % 9;
            const size_t qrow = (size_t)(b * SEQ + r * 64 + c0 + lq);
            bf16x8 qf[2]; qf[0] = __builtin_bit_cast(bf16x8, qcur[0]); qf[1] = __builtin_bit_cast(bf16x8, qcur[1]);
            const LAS unsigned char* RProw = lds + AT_RPB + (rs - r + 7) * 128; const LAS float* MB = (const LAS float*)(lds + AT_MB);
            f32x4 sc[8][2], sm;
#pragma unroll
            for (int j = 0; j < 8; ++j) { const int slot = s0 + j - (s0 + j >= 9 ? 9 : 0);
#pragma unroll
                for (int blk = 0; blk < 2; ++blk) { f32x4 a; const int kc = kcb + 16 * blk + lq;
#pragma unroll
                    for (int e = 0; e < 4; ++e) a[e] = *(const LAS float*)(RProw + j * 128 + bidx[blk][e]);
#pragma unroll
                    for (int ks = 0; ks < 2; ++ks) { const bf16x8 kf = *(const LAS bf16x8*)(lds + AT_KS + slot * 8192 + (kc * 8 + ((4 * ks + g) ^ (kc & 7))) * 16);
                        a = __builtin_amdgcn_mfma_f32_16x16x32_bf16(kf, qf[ks], a, 0, 0, 0); }
                    sc[j][blk] = a; } }
            { f32x4 a = *(const LAS f32x4*)(MB + 4 * g);
#pragma unroll
              for (int ks = 0; ks < 2; ++ks) { const bf16x8 kf = *(const LAS bf16x8*)(lds + AT_KM + (lq * 8 + ((4 * ks + g) ^ (lq & 7))) * 16);
                  a = __builtin_amdgcn_mfma_f32_16x16x32_bf16(kf, qf[ks], a, 0, 0, 0); }
              sm = a; }
            float mx = -3.0e38f; f32x4 mg[8];
#pragma unroll
            for (int j = 0; j < 8; ++j)
#pragma unroll
                for (int e = 0; e < 4; ++e) { mg[j][e] = fmaxf(sc[j][0][e], sc[j][1][e]); mx = fmaxf(mx, mg[j][e]); }
#pragma unroll
            for (int e = 0; e < 4; ++e) mx = fmaxf(mx, sm[e]);
            mx = quad16_max(mx);
            float sum = 0.f;
#pragma unroll
            for (int j = 0; j < 8; ++j)
#pragma unroll
                for (int e = 0; e < 4; ++e) { const float pv = fast_exp2(mg[j][e] - mx); mg[j][e] = pv; sum += pv; }
#pragma unroll
            for (int e = 0; e < 4; ++e) { const float pv = fast_exp2(sm[e] - mx); sm[e] = pv; sum += pv; }
            sum = quad16_sum(sum);
            f32x4 o[4];
#pragma unroll
            for (int db = 0; db < 4; ++db) o[db] = (f32x4){0.f, 0.f, 0.f, 0.f};
#pragma unroll
            for (int j = 0; j < 8; ++j) { const int slot = s0 + j - (s0 + j >= 9 ? 9 : 0);
                const unsigned p01 = cvt_pk_bf16(mg[j][0], mg[j][1]), p23 = cvt_pk_bf16(mg[j][2], mg[j][3]);
                u32x4 pw; pw.x = p01 & kmask[0]; pw.y = p23 & kmask[1]; pw.z = p01 & ~kmask[0]; pw.w = p23 & ~kmask[1];
                const bf16x8 pb = __builtin_bit_cast(bf16x8, pw);
#pragma unroll
                for (int db = 0; db < 4; ++db) { const int d = 16 * db + lq; const LAS unsigned char* vp = lds + AT_VTS + d * AT_VPITCH + (slot * 64 + kcb + 4 * g) * 2;
                    const u32x2 lo = *(const LAS u32x2*)vp, hi = *(const LAS u32x2*)(vp + 32);
                    u32x4 aw; aw.x = lo.x; aw.y = lo.y; aw.z = hi.x; aw.w = hi.y;
                    o[db] = __builtin_amdgcn_mfma_f32_16x16x32_bf16(__builtin_bit_cast(bf16x8, aw), pb, o[db], 0, 0, 0); }
            }
            { u32x4 pw; pw.x = cvt_pk_bf16(sm[0], sm[1]); pw.y = cvt_pk_bf16(sm[2], sm[3]); pw.z = 0u; pw.w = 0u; const bf16x8 pb = __builtin_bit_cast(bf16x8, pw);
#pragma unroll
              for (int db = 0; db < 4; ++db) { const int d = 16 * db + lq; const u32x2 lo = *(const LAS u32x2*)(lds + AT_VTM + d * 32 + 8 * g);
                  u32x4 aw; aw.x = lo.x; aw.y = lo.y; aw.z = 0u; aw.w = 0u;
                  o[db] = __builtin_amdgcn_mfma_f32_16x16x32_bf16(__builtin_bit_cast(bf16x8, aw), pb, o[db], 0, 0, 0); } }
            const float inv = 4.0f / sum; unsigned ox[4];
#pragma unroll
            for (int db = 0; db < 4; ++db) ox[db] = pk4_fp8(sat8(o[db][0] * inv), sat8(o[db][1] * inv), sat8(o[db][2] * inv), sat8(o[db][3] * inv));
            {
                const auto a02 = __builtin_amdgcn_permlane32_swap(ox[0], ox[2], false, false), a13 = __builtin_amdgcn_permlane32_swap(ox[1], ox[3], false, false);
                const auto pq = __builtin_amdgcn_permlane16_swap(a02[0], a13[0], false, false), rs = __builtin_amdgcn_permlane16_swap(a02[1], a13[1], false, false);
                u32x4 ow; ow.x = pq[0]; ow.y = pq[1]; ow.z = rs[0]; ow.w = rs[1];
                *(u32x4*)(O8 + qrow * D + 64 * h + 16 * g) = ow; }
            __syncthreads();
#pragma unroll
            for (int i = 0; i < 2; ++i) if (i < nnew) { const int slot = (R0 + 9 + i) % 9; *(LAS u32x4*)(lds + klds + slot * 8192) = nk[i]; *(LAS u32x4*)(lds + vlds + slot * 128) = nv[i]; }
            R0 = R0n;
            __syncthreads();
        }
    }
}
#define XB_TMO      128
#define XB_XCNT(j)  (256  + 64 * (j))
#define XB_XSUB(j)  (1280 + 64 * (j))
#define XB_XGEN(j)  (2304 + 64 * (j))
#define XB_TOP      3328
#define XB_TOPGEN   3392
#define XCD_BAR_WORDS 3456
#define XB_LSUB(j)  (4096 + 64 * (j))
#define XB_LGEN(j)  (5120 + 64 * (j))
#define XB_SPIN_CAP (1u << 22)
__device__ __forceinline__ unsigned xb_ld(unsigned* p)              { return __hip_atomic_load(p, __ATOMIC_RELAXED, __HIP_MEMORY_SCOPE_AGENT); }
__device__ __forceinline__ unsigned xb_add(unsigned* p, unsigned v) { return __hip_atomic_fetch_add(p, v, __ATOMIC_RELAXED, __HIP_MEMORY_SCOPE_AGENT); }
__device__ __forceinline__ unsigned xb_xcc_id() { return (unsigned)__builtin_amdgcn_s_getreg((3 << 11) | 20) & 0xFu; }
#define XB_SPIN(cond, bar) do { unsigned _sp = 0; while (cond) { __builtin_amdgcn_s_sleep(1); \
    if ((++_sp & 255u) == 0u) { if (xb_ld(&(bar)[XB_TMO])) break; if (_sp > XB_SPIN_CAP) { atomicAdd(&(bar)[XB_TMO], 1u); break; } } } } while (0)
struct XcdBarrier { unsigned* bar; unsigned x; volatile LAS unsigned* st; };
__device__ __forceinline__ XcdBarrier xcd_barrier_post(unsigned* bar, volatile LAS unsigned* st) {
    XcdBarrier b; b.bar = bar; b.x = xb_xcc_id(); b.st = st;
    if (threadIdx.x == 0) st[2] = xb_add(&bar[XB_XCNT(b.x)], 1u);
    return b;
}
__device__ __forceinline__ void xcd_barrier_complete(unsigned* bar, unsigned x, unsigned& nloc, unsigned& nx) {
    const unsigned G = gridDim.x * gridDim.y * gridDim.z;
    unsigned sum, cnt, mine, sp = 0u;
    for (;;) {
        sum = 0u; cnt = 0u; mine = 0u;
#pragma unroll
        for (unsigned j = 0; j < 16; ++j) { const unsigned c = xb_ld(&bar[XB_XCNT(j)]); sum += c; cnt += (c > 0u) ? 1u : 0u; mine = (j == x) ? c : mine; }
        if (sum == G) break;
        __builtin_amdgcn_s_sleep(1);
        if ((++sp & 255u) == 0u) { if (xb_ld(&bar[XB_TMO])) break; if (sp > XB_SPIN_CAP) { atomicAdd(&bar[XB_TMO], 1u); break; } }
    }
    nloc = mine > 0u ? mine : 1u; nx = cnt > 0u ? cnt : 1u;
}
__device__ __forceinline__ void xcd_barrier(const XcdBarrier& b) {
    asm volatile("s_waitcnt vmcnt(0)" ::: "memory");
    __syncthreads();
    if (threadIdx.x == 0) {
        unsigned* bar = b.bar;
        __builtin_amdgcn_s_waitcnt(0);
        unsigned nloc = b.st[0], nx = b.st[1];
        if (nloc == 0u) { xcd_barrier_complete(bar, b.x, nloc, nx); b.st[0] = nloc; b.st[1] = nx; }
        asm volatile("buffer_inv sc1" ::: "memory");
        const unsigned old = xb_add(&bar[XB_XSUB(b.x)], 1u);
        const unsigned gen = old / nloc;
        if (old + 1u == (gen + 1u) * nloc) {
            __builtin_amdgcn_fence(__ATOMIC_RELEASE, "agent");
            asm volatile("s_waitcnt vmcnt(0)" ::: "memory");
            const unsigned og = xb_add(&bar[XB_TOP], 1u);
            const unsigned tg = og / nx;
            if (og + 1u == (tg + 1u) * nx) xb_add(&bar[XB_TOPGEN], 1u);
            else XB_SPIN(xb_ld(&bar[XB_TOPGEN]) == tg, bar);
            xb_add(&bar[XB_XGEN(b.x)], 1u);
            asm volatile("s_waitcnt vmcnt(0)" ::: "memory");
        } else {
            XB_SPIN(xb_ld(&bar[XB_XGEN(b.x)]) == gen, bar);
            asm volatile("s_waitcnt vmcnt(0)" ::: "memory");
        }
    }
    __syncthreads();
}
__device__ __forceinline__ void xcd_local_barrier(const XcdBarrier& b) {
    asm volatile("s_waitcnt vmcnt(0)" ::: "memory");
    __syncthreads();
    if (threadIdx.x == 0) {
        unsigned* bar = b.bar;
        __builtin_amdgcn_s_waitcnt(0);
        const unsigned nloc = b.st[0];
        asm volatile("buffer_inv sc1" ::: "memory");
        const unsigned old = xb_add(&bar[XB_LSUB(b.x)], 1u);
        const unsigned gen = old / nloc;
        if (old + 1u == (gen + 1u) * nloc) xb_add(&bar[XB_LGEN(b.x)], 1u);
        else XB_SPIN(xb_ld(&bar[XB_LGEN(b.x)]) == gen, bar);
        asm volatile("s_waitcnt vmcnt(0)" ::: "memory");
    }
    __syncthreads();
}
__device__ __forceinline__ int moe_prep(const Ctx& C, int layer) {
    LAS int* t = (LAS int*)(C.lds + pg8::TEXP_OFF); LAS int* first = (LAS int*)(C.lds + pg8::TOK_OFF); const int tid = fresh_tid();
    unsigned* gcnt = (unsigned*)(C.ws + WS_CTL + CT_BC) + layer * 32;
    if (tid < 32) first[64 + tid] = (int)((__hip_atomic_load(&gcnt[tid], __ATOMIC_RELAXED, __HIP_MEMORY_SCOPE_AGENT) + 255u) >> 8);
    __syncthreads();
    if (tid < 33) { int a = 0; for (int e = 0; e < tid; ++e) a += first[64 + e]; first[tid] = a; ((LAS int*)(C.lds + LDS_KEEP))[tid] = a * 256; }
    __syncthreads();
    const int nM = first[32];
#pragma unroll
    for (int h = 0; h < 2; ++h) { const int pm = tid + 512 * h; int e = 0;
#pragma unroll
        for (int q = 1; q < 32; ++q) e += (first[q] <= pm) ? 1 : 0;
        t[pm] = pm < nM ? (e | ((pm - first[e]) << 8)) : 0; }
    __syncthreads();
    return __builtin_amdgcn_readfirstlane(nM);
}
constexpr size_t CT_BAR = 131072;
constexpr int LDS_BARST = LDS_BYTES - 64;

constexpr int N_PHASES = 20;
__global__ void __launch_bounds__(NTHREADS, 2) hybrid_fwd(Params P) {
    extern __shared__ __attribute__((aligned(16))) unsigned char smem[];
    cg::grid_group grid = cg::this_grid();
    Ctx C; C.lds = (LAS unsigned char*)smem; C.G = gridDim.x; C.bid = blockIdx.x;
    C.ws = P.ws; C.in = P.in; C.out = P.out;
    unsigned char* const ws0 = P.ws;
#define ws fresh_ws(ws0)
    const int lo = P.ph_lo, hi = P.ph_hi;
#ifndef PH_MASK
#define PH_MASK 0xFFFFFFFFu
#endif
#define IN(k) (((PH_MASK >> (k)) & 1u) && lo <= (k) && (k) < hi)
#ifndef REPEAT_MASK
#define REPEAT_MASK 0u
#endif
#define REPS(k) ((((unsigned)REPEAT_MASK >> (k)) & 1u) ? 2 : 1)
#ifndef N_CG_SYNCS
#define N_CG_SYNCS 0
#endif
#ifndef LOCAL_SEAM_MASK
#define LOCAL_SEAM_MASK 0x13D3Eu
#endif
#define SEAM(k) do { if (IN(k)) { if ((k) < N_CG_SYNCS) grid.sync(); else if (((LOCAL_SEAM_MASK >> (k)) & 1u) && loc) xcd_local_barrier(bar); else xcd_barrier(bar); } } while (0)
    if (threadIdx.x < 16) ((LAS unsigned*)(smem + LDS_BARST))[threadIdx.x] = 0u;
    __syncthreads();
    const XcdBarrier bar = xcd_barrier_post((unsigned*)(ws + WS_CTL + CT_BAR), (volatile LAS unsigned*)(smem + LDS_BARST));
    C.gc = C.bid;
    C.gs = C.G >= 8 ? C.G / 8 : 1; C.vx = C.bid / C.gs; C.vr = C.bid % C.gs;
    bool loc = false; int nMk = 0;
    #define PH_BODY_0 phase_convert(C);
    if (IN(0)) { PH_BODY_0 } if (REPS(0) > 1 && IN(0)) { xcd_barrier(bar); PH_BODY_0 }
    SEAM(0);
    if (IN(0) && IN(1)) {
        unsigned* barw = (unsigned*)(ws + WS_CTL + CT_BAR); bool eq = (C.G % 8) == 0;
#pragma unroll
        for (int j = 0; j < 16; ++j) { const unsigned cj = xb_ld(&barw[XB_XCNT(j)]); eq = eq && (cj == (j < 8 ? (unsigned)(C.G / 8) : 0u)); }
        const unsigned rank = ((volatile LAS unsigned*)(smem + LDS_BARST))[2];
        C.gc = __builtin_amdgcn_readfirstlane(eq ? (int)(rank * 8u + bar.x) : C.bid);
        if (__builtin_amdgcn_readfirstlane((int)eq)) { C.vx = __builtin_amdgcn_readfirstlane((int)bar.x); C.vr = __builtin_amdgcn_readfirstlane((int)rank); loc = true; }
    }
    #define PH_BODY_1 { DenseSched S{(unsigned)WS_HB8, (unsigned)WS_WIN8, 512, 512, 8, C.gs, C.vr, C.vx}; EpiWin E{(bf16_t*)(ws + WS_XR), (bf16_t*)(ws + WS_GY)}; \
        pg8::gemm_phase<true, false>(C.lds, ws, 512, 512, 512, S, E); mini_win(C); }
    if (IN(1)) { PH_BODY_1 } if (REPS(1) > 1 && IN(1)) { xcd_barrier(bar); PH_BODY_1 }
    SEAM(1);
    #define PH_BODY_2 phase_conv(C);
    if (IN(2)) { PH_BODY_2 } if (REPS(2) > 1 && IN(2)) { xcd_barrier(bar); PH_BODY_2 }
    SEAM(2);
    #define PH_BODY_3 { GateSched S{(unsigned)WS_XC, (unsigned)WS_GATE, C.gs, C.vr, C.vx}; \
        EpiGate E{(const bf16_t*)(ws + WS_XC), (unsigned char*)(ws + WS_LA), (const float*)(ws + WS_CTL + CT_SPL), (unsigned)WS_GBIAS}; \
        pg8::gemm_phase<false, false>(C.lds, ws, 256, 1024, 256, S, E); mini_gate(C); }
    if (IN(3)) { PH_BODY_3 } if (REPS(3) > 1 && IN(3)) { xcd_barrier(bar); PH_BODY_3 }
    SEAM(3);
    #define PH_BODY_4 phase_scan(C);
    if (IN(4)) { PH_BODY_4 } if (REPS(4) > 1 && IN(4)) { xcd_barrier(bar); PH_BODY_4 }
    SEAM(4);
    #define PH_BODY_5 { DenseSched S{(unsigned)WS_BB, (unsigned)WS_LOUT8, 512, 512, 4, C.gs, C.vr, C.vx}; EpiRes<true, false> E{(bf16_t*)(ws + WS_PRE), nullptr, nullptr, (const bf16_t*)(ws + WS_HB), NTOK}; \
        pg8::gemm_phase<true, false>(C.lds, ws, 512, 512, 512, S, E); mini_lout(C); }
    if (IN(5)) { PH_BODY_5 } if (REPS(5) > 1 && IN(5)) { xcd_barrier(bar); PH_BODY_5 }
    SEAM(5);
    #define PH_BODY_6 phase_lnr(C, 0, NTOK);
    if (IN(6)) { PH_BODY_6 } if (REPS(6) > 1 && IN(6)) { xcd_barrier(bar); PH_BODY_6 }
    SEAM(6);
    #define PH_BODY_8 { const int nM = nMk = moe_prep(C, 0); \
        MoeSched S{(unsigned)WS_HB8, (unsigned)WS_WGU, (unsigned)WS_TOK2, (const LAS int*)(C.lds + pg8::TEXP_OFF), 2048u * 1024u, nM, 8, C.G, C.gc, loc ? C.vx : -1, C.vr, C.gs}; EpiGlu E{(unsigned char*)(ws + WS_ACT), (unsigned)WS_BIAS}; \
        pg8::gemm_phase<true, true>(C.lds, ws, 512, 512, 512, S, E); }
    if (IN(8)) { PH_BODY_8 } if (REPS(8) > 1 && IN(8)) { xcd_barrier(bar); PH_BODY_8 }
    SEAM(8);
    #define PH_BODY_9 { const int nM = nMk;        \
        MoeSched S{(unsigned)WS_ACT, (unsigned)WS_WD, 0u, (const LAS int*)(C.lds + pg8::TEXP_OFF), 1024u * 1024u, nM, 4, C.G, C.gc, loc ? C.vx : -1, C.vr, C.gs}; EpiDown E{(unsigned char*)(ws + WS_YS), (unsigned)WS_BD}; \
        pg8::gemm_phase<true, false>(C.lds, ws, 512, 512, 512, S, E); }
    if (IN(9)) { PH_BODY_9 } if (REPS(9) > 1 && IN(9)) { xcd_barrier(bar); PH_BODY_9 }
    SEAM(9);
    #define PH_BODY_10 phase_combine(C, 0, NTOK, false);
    if (IN(10)) { PH_BODY_10 } if (REPS(10) > 1 && IN(10)) { xcd_barrier(bar); PH_BODY_10 }
    SEAM(10);
    #define PH_BODY_11 { QkvSched S{(unsigned)WS_HB8, (unsigned)WS_QKV8, C.gs, C.vr, C.vx}; EpiQkv E{(bf16_t*)(ws + WS_Q), (bf16_t*)(ws + WS_K), (bf16_t*)(ws + WS_VT)}; \
        pg8::gemm_phase<true, false>(C.lds, ws, 512, 512, 512, S, E); mini_kv(C); }
    if (IN(11)) { PH_BODY_11 } if (REPS(11) > 1 && IN(11)) { xcd_barrier(bar); PH_BODY_11 }
    SEAM(11);
    #define PH_BODY_12 phase_attn(C);
    if (IN(12)) { PH_BODY_12 } if (REPS(12) > 1 && IN(12)) { xcd_barrier(bar); PH_BODY_12 }
    SEAM(12);
    #define PH_BODY_13 { DenseSched S{(unsigned)WS_O, (unsigned)WS_NOUT, 512, 512, 4, C.gs, C.vr, C.vx}; EpiRes<false> E{(bf16_t*)(ws + WS_PRE), nullptr, nullptr, (const bf16_t*)(ws + WS_HB), NGRID}; \
        pg8::gemm_phase<true, false>(C.lds, ws, 512, 512, 512, S, E); }
    if (IN(13)) { PH_BODY_13 } if (REPS(13) > 1 && IN(13)) { xcd_barrier(bar); PH_BODY_13 }
    SEAM(13);
    #define PH_BODY_14 phase_lnr(C, 1, NGRID);
    if (IN(14)) { PH_BODY_14 } if (REPS(14) > 1 && IN(14)) { xcd_barrier(bar); PH_BODY_14 }
    SEAM(14);

    #define PH_BODY_16 { const int nM = nMk = moe_prep(C, 1); \
        MoeSched S{(unsigned)WS_HB8, (unsigned)(WS_WGU + (size_t)32 * 2048 * 1024), (unsigned)(WS_TOK2 + (size_t)32 * TCAP * 4), (const LAS int*)(C.lds + pg8::TEXP_OFF), 2048u * 1024u, nM, 8, C.G, C.gc, loc ? C.vx : -1, C.vr, C.gs}; EpiGlu E{(unsigned char*)(ws + WS_ACT), (unsigned)(WS_BIAS + 32 * 2048 * 4)}; \
        pg8::gemm_phase<true, true>(C.lds, ws, 512, 512, 512, S, E); }
    if (IN(16)) { PH_BODY_16 } if (REPS(16) > 1 && IN(16)) { xcd_barrier(bar); PH_BODY_16 }
    SEAM(16);
    #define PH_BODY_17 { const int nM = nMk; \
        MoeSched S{(unsigned)WS_ACT, (unsigned)(WS_WD + (size_t)32 * 1024 * 1024), 0u, (const LAS int*)(C.lds + pg8::TEXP_OFF), 1024u * 1024u, nM, 4, C.G, C.gc, loc ? C.vx : -1, C.vr, C.gs}; EpiDown E{(unsigned char*)(ws + WS_YS), (unsigned)(WS_BD + 32 * 1024 * 4)}; \
        pg8::gemm_phase<true, false>(C.lds, ws, 512, 512, 512, S, E); }
    if (IN(17)) { PH_BODY_17 } if (REPS(17) > 1 && IN(17)) { xcd_barrier(bar); PH_BODY_17 }
    SEAM(17);
    #define PH_BODY_18 phase_combine(C, 1, NGRID, true);
    if (IN(18)) { PH_BODY_18 } if (REPS(18) > 1 && IN(18)) { xcd_barrier(bar); PH_BODY_18 }
#undef ws
#undef IN
#undef SEAM
}

#ifndef MK_PER_PHASE
#define MK_PER_PHASE 0
#endif
extern "C" void kernel_launch(void* const* d_in, const int* in_sizes, int n_in, void* d_out, int out_size, void* d_ws, size_t ws_size, hipStream_t stream) {
    static int grid = 0;
    if (grid == 0) {
        if (n_in != 25 || ws_size < WS_END || out_size != NGRID * D) { fprintf(stderr, "kernel_launch: unexpected problem (n_in %d, ws %zu, out %d)\n", n_in, ws_size, out_size); grid = -1; return; }
        int dev = 0, cus = 0, per_cu = 0;
        if (hipGetDevice(&dev) != hipSuccess || hipDeviceGetAttribute(&cus, hipDeviceAttributeMultiprocessorCount, dev) != hipSuccess) { grid = -1; return; }
        if (hipFuncSetAttribute((const void*)hybrid_fwd, hipFuncAttributeMaxDynamicSharedMemorySize, LDS_BYTES) != hipSuccess) { fprintf(stderr, "kernel_launch: hipFuncSetAttribute failed\n"); grid = -1; return; }
        if (hipOccupancyMaxActiveBlocksPerMultiprocessor(&per_cu, (const void*)hybrid_fwd, NTHREADS, LDS_BYTES) != hipSuccess || per_cu < 1) { fprintf(stderr, "kernel_launch: occupancy query failed (%d)\n", per_cu); grid = -1; return; }
        grid = cus * 1;
        if (grid > 256) grid = 256;
    }
    if (grid < 0) return;
    if (hipMemsetAsync((char*)d_ws + WS_CTL + CT_BAR, 0, 32768, stream) != hipSuccess) { fprintf(stderr, "kernel_launch: memset failed\n"); return; }
    Params p{};
    for (int i = 0; i < 25; ++i) p.in[i] = (const float*)d_in[i];
    p.out = (float*)d_out; p.ws = (unsigned char*)d_ws;
#if MK_PER_PHASE
    for (int ph = 0; ph < 19; ++ph) { p.ph_lo = ph; p.ph_hi = ph + 1; void* args[] = {&p};
        hipError_t e = hipLaunchCooperativeKernel((void*)hybrid_fwd, dim3(grid), dim3(NTHREADS), args, LDS_BYTES, stream);
        if (e != hipSuccess) { fprintf(stderr, "launch phase %d failed: %s\n", ph, hipGetErrorString(e)); break; } }
#else
    p.ph_lo = 0; p.ph_hi = 19; void* args[] = {&p};
    hipError_t e = hipLaunchCooperativeKernel((void*)hybrid_fwd, dim3(grid), dim3(NTHREADS), args, LDS_BYTES, stream);
    if (e != hipSuccess) fprintf(stderr, "cooperative launch failed: %s (grid %d)\n", hipGetErrorString(e), grid);
#endif
}
```
